# Optimizing an MI355X kernel written in HIP

```python
import math
import jax, jax.numpy as jnp
from jax import lax
import numpy as np

D_MODEL = 1024
BATCH = 4
SEQ = 4096
DEPTH = 4

ROPE_THETA = 10000.0
LN_EPS = 1e-5
ATT_GROUPS = ((128, 1), (512, 4), (2048, 16))
ATT_HEADS_PER_GROUP = 4
ATT_HEADS = ATT_HEADS_PER_GROUP * len(ATT_GROUPS)
ATT_HEAD_DIM = 128
ATT_BLOCK = 128
ATT_OUT = ATT_HEADS_PER_GROUP * ATT_HEAD_DIM
LRU_WIDTH = D_MODEL
LRU_BLOCKS = 16
LRU_BLOCK_DIM = LRU_WIDTH // LRU_BLOCKS
CONV_WIDTH = 4
LRU_C = 8.0
RET_HEADS = 4
RET_DK = 256
RET_DV = 256
RET_CHUNK = 128
PEER_HEADS = 8
PEER_NKEYS = 128
PEER_EXPERTS = PEER_NKEYS * PEER_NKEYS
PEER_QDIM = 256
PEER_TOPK = 16
PEER_BLOCK = 128
DEEPNORM_ALPHA = (2 * DEPTH) ** 0.25
DEEPNORM_BETA = (8 * DEPTH) ** -0.25
IN_SPLITS = (ATT_HEADS * ATT_HEAD_DIM,) * 3 + (LRU_WIDTH,) * 2 + (RET_HEADS * RET_DK, RET_HEADS * RET_DK, RET_HEADS * RET_DV, RET_HEADS * RET_DV) + (D_MODEL,) * 3
D_IN = sum(IN_SPLITS)
BR_SPLITS = (ATT_OUT, LRU_WIDTH, RET_HEADS * RET_DV)
D_BR = sum(BR_SPLITS)

kernel_name = "hybrid_dilated_lru_retention_peer"


def layer_norm(x, g, b):
    xf = x.astype(jnp.float32)
    mu = jnp.mean(xf, axis=-1, keepdims=True)
    var = jnp.mean(jnp.square(xf - mu), axis=-1, keepdims=True)
    return ((xf - mu) * lax.rsqrt(var + LN_EPS) * g + b).astype(x.dtype)


def rope_tables(seq, dim):
    inv = ROPE_THETA ** (-jnp.arange(0, dim, 2, dtype=jnp.float32) / dim)
    ang = jnp.arange(seq, dtype=jnp.float32)[:, None] * inv[None, :]
    return jnp.cos(ang), jnp.sin(ang)


def apply_rope(t, cos, sin):
    half = t.shape[-1] // 2
    t1 = t[..., :half].astype(jnp.float32)
    t2 = t[..., half:].astype(jnp.float32)
    c = cos[None, :, None, :]
    s = sin[None, :, None, :]
    return jnp.concatenate([t1 * c - t2 * s, t1 * s + t2 * c], axis=-1).astype(t.dtype)


def dilated_group(q, k, v, window, dil):
    B, S, H, E = q.shape
    span = dil * ATT_BLOCK
    Sp = -(-S // span) * span
    L = Sp // dil
    nb = L // ATT_BLOCK
    sub_win = window // dil

    def prep(t):
        t = jnp.pad(t, ((0, 0), (0, Sp - S), (0, 0), (0, 0)))
        t = t.reshape(B, L, dil, H, E).transpose(0, 2, 3, 1, 4)
        return t.reshape(B, dil, H, nb, ATT_BLOCK, E)

    qb, kb, vb = prep(q), prep(k), prep(v)
    pad_prev = ((0, 0), (0, 0), (0, 0), (1, 0), (0, 0), (0, 0))
    kcat = jnp.concatenate([jnp.pad(kb[:, :, :, :-1], pad_prev), kb], axis=4)
    vcat = jnp.concatenate([jnp.pad(vb[:, :, :, :-1], pad_prev), vb], axis=4)
    s = jnp.einsum('bdhnqe,bdhnke->bdhnqk', qb, kcat).astype(jnp.float32) * (E ** -0.5)
    qi = jnp.arange(ATT_BLOCK)[:, None] + ATT_BLOCK
    kj = jnp.arange(2 * ATT_BLOCK)[None, :]
    delta = qi - kj
    blk = jnp.arange(nb)[:, None, None]
    mask = (delta >= 0)[None] & (delta <= sub_win)[None] & (blk * ATT_BLOCK + kj[None] - ATT_BLOCK >= 0)
    s = jnp.where(mask, s, -jnp.inf)
    lse = jax.nn.logsumexp(s, axis=-1, keepdims=True)
    p = jnp.exp(s - lse)
    o = jnp.einsum('bdhnqk,bdhnke->bdhnqe', p.astype(vcat.dtype), vcat)
    o = o.reshape(B, dil, H, L, E).transpose(0, 3, 1, 2, 4).reshape(B, Sp, H, E)[:, :S]
    lse = lse[..., 0].reshape(B, dil, H, L).transpose(0, 3, 1, 2).reshape(B, Sp, H)[:, :S]
    return o, lse


def rg_lru(xc, wa, ba, wx, bx, lam):
    B, S, C = xc.shape
    xr = xc.reshape(B, S, LRU_BLOCKS, LRU_BLOCK_DIM)
    r = jax.nn.sigmoid((jnp.einsum('bsgi,gio->bsgo', xr, wa).reshape(B, S, C) + ba).astype(jnp.float32))
    i = jax.nn.sigmoid((jnp.einsum('bsgi,gio->bsgo', xr, wx).reshape(B, S, C) + bx).astype(jnp.float32))
    log_a = -LRU_C * r * jax.nn.softplus(-lam.astype(jnp.float32))
    a = jnp.exp(log_a)
    b = jnp.sqrt(-jnp.expm1(2.0 * log_a)) * (i * xc.astype(jnp.float32))

    def combine(left, right):
        a1, b1 = left
        a2, b2 = right
        return a1 * a2, a2 * b1 + b2

    _, h = lax.associative_scan(combine, (a, b), axis=1)
    return h


def retention(q, k, v):
    B, S, H, Dk = q.shape
    Dv = v.shape[-1]
    n = S // RET_CHUNK
    log_g = jnp.log(1.0 - 2.0 ** (-5.0 - jnp.arange(H, dtype=jnp.float32)))
    idx = jnp.arange(RET_CHUNK, dtype=jnp.float32)
    diff = idx[:, None] - idx[None, :]
    dmat = jnp.where(diff >= 0, jnp.exp(jnp.maximum(diff, 0.0)[None] * log_g[:, None, None]), 0.0)
    xi = jnp.exp((idx[None] + 1.0) * log_g[:, None])[..., None]
    zeta = jnp.exp((RET_CHUNK - 1.0 - idx[None]) * log_g[:, None])[..., None]
    g_chunk = jnp.exp(RET_CHUNK * log_g)[:, None, None]

    def chunks(t):
        return t.reshape(B, n, RET_CHUNK, H, t.shape[-1]).transpose(1, 0, 3, 2, 4)

    def step(R, inp):
        qc, kc, vc = inp
        inner = jnp.einsum('bhij,bhjv->bhiv', jnp.einsum('bhik,bhjk->bhij', qc, kc) * dmat, vc)
        cross = jnp.einsum('bhik,bhkv->bhiv', qc, R) * xi
        R_new = g_chunk * R + jnp.einsum('bhjk,bhjv->bhkv', kc * zeta, vc)
        return R_new, inner + cross

    R0 = jnp.zeros((B, H, Dk, Dv), jnp.float32)
    _, out = lax.scan(step, R0, (chunks(q), chunks(k), chunks(v)))
    return out.transpose(1, 0, 3, 2, 4).reshape(B, S, H, Dv)


def token_mixers(x, w_in, conv_w, conv_b, lru_wa, lru_ba, lru_wx, lru_bx, lru_lambda, w_branch, w_out, cos_a, sin_a, cos_r, sin_r):
    B, S, _ = x.shape
    proj = jnp.einsum('bsd,de->bse', x, w_in)
    aq, ak, av, lx, lg, rq, rk, rv, rg, ga, gb, gc = jnp.split(proj, np.cumsum(IN_SPLITS)[:-1].tolist(), axis=-1)

    aq = apply_rope(aq.reshape(B, S, ATT_HEADS, ATT_HEAD_DIM), cos_a, sin_a)
    ak = apply_rope(ak.reshape(B, S, ATT_HEADS, ATT_HEAD_DIM), cos_a, sin_a)
    av = av.reshape(B, S, ATT_HEADS, ATT_HEAD_DIM)
    outs, lses = [], []
    for g, (win, dil) in enumerate(ATT_GROUPS):
        sl = slice(g * ATT_HEADS_PER_GROUP, (g + 1) * ATT_HEADS_PER_GROUP)
        o, l = dilated_group(aq[:, :, sl], ak[:, :, sl], av[:, :, sl], win, dil)
        outs.append(o)
        lses.append(l)
    wgt = jax.nn.softmax(jnp.stack(lses), axis=0)
    y_a = jnp.sum(wgt[..., None] * jnp.stack(outs).astype(jnp.float32), axis=0)
    y_a = y_a.reshape(B, S, ATT_OUT).astype(x.dtype)

    xc = lax.conv_general_dilated(lx, conv_w[:, None, :], window_strides=(1,), padding=[(CONV_WIDTH - 1, 0)],
                                  dimension_numbers=('NWC', 'WIO', 'NWC'), feature_group_count=LRU_WIDTH) + conv_b
    h = rg_lru(xc, lru_wa, lru_ba, lru_wx, lru_bx, lru_lambda)
    y_b = (h * jax.nn.gelu(lg.astype(jnp.float32), approximate=False)).astype(x.dtype)

    rq = apply_rope(rq.reshape(B, S, RET_HEADS, RET_DK), cos_r, sin_r).astype(jnp.float32)
    rk = apply_rope(rk.reshape(B, S, RET_HEADS, RET_DK), cos_r, sin_r).astype(jnp.float32) * (RET_DK ** -0.5)
    rv = rv.reshape(B, S, RET_HEADS, RET_DV).astype(jnp.float32)
    ret = retention(rq, rk, rv)
    mu = jnp.mean(ret, axis=-1, keepdims=True)
    var = jnp.mean(jnp.square(ret - mu), axis=-1, keepdims=True)
    ret = ((ret - mu) * lax.rsqrt(var + LN_EPS)).reshape(B, S, RET_HEADS * RET_DV)
    y_c = (jax.nn.silu(rg.astype(jnp.float32)) * ret).astype(x.dtype)

    wb_a, wb_b, wb_c = jnp.split(w_branch, np.cumsum(BR_SPLITS)[:-1].tolist(), axis=0)
    merged = (jax.nn.sigmoid(ga) * (y_a @ wb_a) + jax.nn.sigmoid(gb) * (y_b @ wb_b)
              + jax.nn.sigmoid(gc) * (y_c @ wb_c))
    return merged @ w_out


def peer_ffn(x, wq, k1, k2, U, V):
    B, S, D = x.shape
    xt = x.reshape(-1, D)
    N = xt.shape[0]
    q = (xt @ wq).astype(jnp.float32).reshape(N, PEER_HEADS, PEER_QDIM)
    half = PEER_QDIM // 2
    s1 = jnp.einsum('nhc,hkc->nhk', q[..., :half], k1.astype(jnp.float32))
    s2 = jnp.einsum('nhc,hkc->nhk', q[..., half:], k2.astype(jnp.float32))
    v1, i1 = lax.top_k(s1, PEER_TOPK)
    v2, i2 = lax.top_k(s2, PEER_TOPK)
    cand = (v1[..., :, None] + v2[..., None, :]).reshape(N, PEER_HEADS, PEER_TOPK * PEER_TOPK)
    cv, ci = lax.top_k(cand, PEER_TOPK)
    e = (jnp.take_along_axis(i1, ci // PEER_TOPK, axis=-1) * PEER_NKEYS
         + jnp.take_along_axis(i2, ci % PEER_TOPK, axis=-1))
    g = jax.nn.softmax(cv, axis=-1)
    nb = N // PEER_BLOCK

    def block(args):
        xb, eb, gbk = args
        u = U[eb]
        pre = jnp.einsum('thkd,td->thk', u, xb).astype(jnp.float32)
        act = (jax.nn.gelu(pre, approximate=False) * gbk).astype(V.dtype)
        return jnp.einsum('thk,thkd->td', act, V[eb])

    y = lax.map(block, (xt.reshape(nb, PEER_BLOCK, D), e.reshape(nb, PEER_BLOCK, PEER_HEADS, PEER_TOPK),
                        g.reshape(nb, PEER_BLOCK, PEER_HEADS, PEER_TOPK)))
    return y.reshape(B, S, D).astype(x.dtype)


def setup_inputs(seed: int = 0) -> dict:
    key = jax.random.key(seed)
    ks = jax.random.split(key, 24)
    D = D_MODEL
    nrm = jax.random.normal
    x = nrm(ks[0], (BATCH, SEQ, D), jnp.float32)
    w_in = nrm(ks[1], (DEPTH, D, D_IN), jnp.float32) * D ** -0.5
    conv_w = nrm(ks[2], (DEPTH, CONV_WIDTH, LRU_WIDTH), jnp.float32) * CONV_WIDTH ** -0.5
    conv_b = 0.01 * nrm(ks[3], (DEPTH, LRU_WIDTH), jnp.float32)
    lru_wa = nrm(ks[4], (DEPTH, LRU_BLOCKS, LRU_BLOCK_DIM, LRU_BLOCK_DIM), jnp.float32) * LRU_BLOCK_DIM ** -0.5
    lru_ba = 0.01 * nrm(ks[5], (DEPTH, LRU_WIDTH), jnp.float32)
    lru_wx = nrm(ks[6], (DEPTH, LRU_BLOCKS, LRU_BLOCK_DIM, LRU_BLOCK_DIM), jnp.float32) * LRU_BLOCK_DIM ** -0.5
    lru_bx = 0.01 * nrm(ks[7], (DEPTH, LRU_WIDTH), jnp.float32)
    a_c = jax.random.uniform(ks[8], (DEPTH, LRU_WIDTH), jnp.float32, minval=0.9, maxval=0.999)
    a0 = a_c ** (1.0 / LRU_C)
    lru_lambda = jnp.log(a0) - jnp.log1p(-a0)
    w_branch = jnp.concatenate([
        nrm(ks[9], (DEPTH, BR_SPLITS[0], D), jnp.float32) * BR_SPLITS[0] ** -0.5,
        nrm(ks[10], (DEPTH, BR_SPLITS[1], D), jnp.float32) * BR_SPLITS[1] ** -0.5,
        nrm(ks[11], (DEPTH, BR_SPLITS[2], D), jnp.float32) * BR_SPLITS[2] ** -0.5], axis=1)
    w_out = nrm(ks[12], (DEPTH, D, D), jnp.float32) * D ** -0.5 * DEEPNORM_BETA
    ln1_g = 1.0 + 0.02 * nrm(ks[13], (DEPTH, D), jnp.float32)
    ln1_b = 0.02 * nrm(ks[14], (DEPTH, D), jnp.float32)
    peer_wq = nrm(ks[15], (DEPTH, D, PEER_HEADS * PEER_QDIM), jnp.float32) * D ** -0.5
    peer_k1 = nrm(ks[16], (DEPTH, PEER_HEADS, PEER_NKEYS, PEER_QDIM // 2), jnp.float32) * (PEER_QDIM // 2) ** -0.5
    peer_k2 = nrm(ks[17], (DEPTH, PEER_HEADS, PEER_NKEYS, PEER_QDIM // 2), jnp.float32) * (PEER_QDIM // 2) ** -0.5
    peer_u = nrm(ks[18], (DEPTH, PEER_EXPERTS, D), jnp.float32) * D ** -0.5
    peer_v = nrm(ks[19], (DEPTH, PEER_EXPERTS, D), jnp.float32) * PEER_HEADS ** -0.5 * DEEPNORM_BETA
    ln2_g = 1.0 + 0.02 * nrm(ks[20], (DEPTH, D), jnp.float32)
    ln2_b = 0.02 * nrm(ks[21], (DEPTH, D), jnp.float32)
    return {"x": x, "w_in": w_in, "conv_w": conv_w, "conv_b": conv_b, "lru_wa": lru_wa, "lru_ba": lru_ba,
            "lru_wx": lru_wx, "lru_bx": lru_bx, "lru_lambda": lru_lambda, "w_branch": w_branch, "w_out": w_out,
            "ln1_g": ln1_g, "ln1_b": ln1_b, "peer_wq": peer_wq, "peer_k1": peer_k1, "peer_k2": peer_k2,
            "peer_u": peer_u, "peer_v": peer_v, "ln2_g": ln2_g, "ln2_b": ln2_b}


def reference(x, w_in, conv_w, conv_b, lru_wa, lru_ba, lru_wx, lru_bx, lru_lambda, w_branch, w_out,
              ln1_g, ln1_b, peer_wq, peer_k1, peer_k2, peer_u, peer_v, ln2_g, ln2_b):
    S = x.shape[1]
    cos_a, sin_a = rope_tables(S, ATT_HEAD_DIM)
    cos_r, sin_r = rope_tables(S, RET_DK)
    for l in range(DEPTH):
        m = token_mixers(x, w_in[l], conv_w[l], conv_b[l], lru_wa[l], lru_ba[l], lru_wx[l], lru_bx[l],
                         lru_lambda[l], w_branch[l], w_out[l], cos_a, sin_a, cos_r, sin_r)
        x = layer_norm(DEEPNORM_ALPHA * x + m, ln1_g[l], ln1_b[l])
        f = peer_ffn(x, peer_wq[l], peer_k1[l], peer_k2[l], peer_u[l], peer_v[l])
        x = layer_norm(DEEPNORM_ALPHA * x + f, ln2_g[l], ln2_b[l])
    return x
```

```cpp
#include <hip/hip_runtime.h>
#include <cstdio>
#include <cstdint>
#include <cmath>
#include <cfloat>
__device__ __forceinline__ int mk_tid() { int t = (int)threadIdx.x; asm volatile("" : "+v"(t)); return t; }
namespace pg8 {
#define PG8_LAS __attribute__((address_space(3)))
typedef unsigned short bf16_t;
typedef short bf16x8 __attribute__((ext_vector_type(8)));
typedef float f32x4 __attribute__((ext_vector_type(4)));
typedef unsigned u32x4 __attribute__((ext_vector_type(4)));
constexpr int BM = 256, BK = 64, HALF = 128, HTB = HALF * BK * 2  , STAGE_BYTES = 8 * HTB, NXCD = 8, WGM = 8;

__host__ __device__ __forceinline__ int lds_byte(int r, int c) { const int st = (r >> 4) * 2 + (c >> 5), rr = r & 15, cc = c & 31, ob = rr * 64 + cc * 2; return st * 1024 + (ob ^ (((ob >> 9) & 1) << 5)); }
__host__ __device__ __forceinline__ void stage_rc(int b, int& R, int& C) { const int st = b / 1024, sb = b % 1024, swz = sb ^ (((sb >> 9) & 1) << 5); R = (st >> 1) * 16 + swz / 64; C = (st & 1) * 32 + (swz % 64) / 2; }
__host__ __device__ __forceinline__ int perm32(int rho) { const int n = rho >> 4, i = rho & 15; return 8 * (i >> 2) + 4 * n + (i & 3); }

struct Unit { int pm, pn; };
struct Gemm { const bf16_t* A; const bf16_t* Bt; int M, N, K; };

struct StaticOrder {
    int nM, nN, nwg, G, c;
    __host__ __device__ void init(int M, int N, int G_, int c_) { nM = M / BM; nN = N / BM; nwg = nM * nN; G = G_; c = c_; }
    __host__ __device__ bool next(int i, Unit& u) const {
        const long L = (long)i * G + c; if (L >= nwg) return false;
        int wgid = (int)L; { const int q = nwg / NXCD, r = nwg % NXCD, xcd = wgid % NXCD, off = wgid / NXCD; wgid = (xcd < r ? xcd * (q + 1) : r * (q + 1) + (xcd - r) * q) + off; }
        const int nig = WGM * nN, gid = wgid / nig, fm = gid * WGM, gsz = (nM - fm) < WGM ? (nM - fm) : WGM;
        u.pm = fm + ((wgid % nig) % gsz); u.pn = (wgid % nig) / gsz; return true;
    }
    __device__ __forceinline__ void a_ready(const Unit&) const {}
    __device__ __forceinline__ void done(const Unit&) const {}
};
__device__ __forceinline__ unsigned cvt_pk_bf16(float lo, float hi) { unsigned r; asm volatile("v_cvt_pk_bf16_f32 %0, %1, %2" : "=v"(r) : "v"(lo), "v"(hi)); return r; }
typedef float f32x2 __attribute__((ext_vector_type(2)));
__device__ __forceinline__ f32x2 gelu_pk(f32x2 v) {
    const f32x2 av = __builtin_elementwise_abs(v), d = av * 0.2316418882f + 1.0f;
    f32x2 t; t.x = __builtin_amdgcn_rcpf(d.x); t.y = __builtin_amdgcn_rcpf(d.y);
    f32x2 q = t * 0.5307027145f + (-0.7265760135f); q = q * t + 0.7107068705f; q = q * t + (-0.142248368f); q = q * t + 0.127414796f; q = q * t;
    const f32x2 s = (v * v) * (-0.72134752044f);
    f32x2 e; e.x = __builtin_amdgcn_exp2f(s.x); e.y = __builtin_amdgcn_exp2f(s.y);
    const f32x2 m = v * (q * e), r = v - m;
    f32x2 o; o.x = v.x < 0.f ? m.x : r.x; o.y = v.y < 0.f ? m.y : r.y; return o;
}

struct EpiF32 {
    static constexpr bool PERM = false, AFTER_DRAIN = false;
    float* C; int ldc; const float* bias;
    __device__ __forceinline__ void operator()(const f32x4 (&acc)[2][2][4][2], const Unit& u, int wr, int wc, int fr, int fq) const {
        const int row0 = u.pm * BM + wr * 64 + fr, col0 = u.pn * BM + wc * 32 + 4 * fq;
        f32x4 bv[2][2];
#pragma unroll
        for (int bj = 0; bj < 2; ++bj)
#pragma unroll
            for (int n = 0; n < 2; ++n) bv[bj][n] = bias ? *(const f32x4*)(bias + col0 + bj * HALF + n * 16) : (f32x4){0.f, 0.f, 0.f, 0.f};
#pragma unroll
        for (int ai = 0; ai < 2; ++ai)
#pragma unroll
            for (int m = 0; m < 4; ++m) { float* rowp = C + (size_t)(row0 + ai * HALF + m * 16) * ldc + col0;
#pragma unroll
                for (int bj = 0; bj < 2; ++bj)
#pragma unroll
                    for (int n = 0; n < 2; ++n) *(f32x4*)(rowp + bj * HALF + n * 16) = acc[ai][bj][m][n] + bv[bj][n]; }
    }
};
template <int ACT  > struct EpiBf16 {
    static constexpr bool PERM = true, AFTER_DRAIN = false;
    bf16_t* O; int ldc; const float* bias; int split_cols; size_t split_stride;
    __device__ __forceinline__ void operator()(const f32x4 (&acc)[2][2][4][2], const Unit& u, int wr, int wc, int fr, int fq) const {
        const int row0 = u.pm * BM + wr * 64 + fr; int colt = u.pn * BM; bf16_t* base = O;
        if (split_cols) { const int t = colt / split_cols; base += (size_t)t * split_stride; colt -= t * split_cols; }
        const int col0 = colt + wc * 32 + 8 * fq, bcol0 = u.pn * BM + wc * 32 + 8 * fq;
        f32x4 bv[2][2];
#pragma unroll
        for (int bj = 0; bj < 2; ++bj)
#pragma unroll
            for (int n = 0; n < 2; ++n) bv[bj][n] = bias ? *(const f32x4*)(bias + bcol0 + bj * HALF + 4 * n) : (f32x4){0.f, 0.f, 0.f, 0.f};
#pragma unroll
        for (int ai = 0; ai < 2; ++ai)
#pragma unroll
            for (int m = 0; m < 4; ++m) { bf16_t* rowp = base + (size_t)(row0 + ai * HALF + m * 16) * ldc + col0;
#pragma unroll
                for (int bj = 0; bj < 2; ++bj) { f32x4 v0 = acc[ai][bj][m][0] + bv[bj][0], v1 = acc[ai][bj][m][1] + bv[bj][1];
                    if (ACT == 1) { f32x2 a = gelu_pk((f32x2){v0[0], v0[1]}), b = gelu_pk((f32x2){v0[2], v0[3]}), c = gelu_pk((f32x2){v1[0], v1[1]}), d = gelu_pk((f32x2){v1[2], v1[3]});
                        v0 = (f32x4){a.x, a.y, b.x, b.y}; v1 = (f32x4){c.x, c.y, d.x, d.y}; }
                    if (ACT == 2) {
#pragma unroll
                        for (int j = 0; j < 4; ++j) { v0[j] = 0.5f * v0[j] * (1.0f + erff(v0[j] * 0.70710678f)); v1[j] = 0.5f * v1[j] * (1.0f + erff(v1[j] * 0.70710678f)); } }
                    u32x4 w; w.x = cvt_pk_bf16(v0[0], v0[1]); w.y = cvt_pk_bf16(v0[2], v0[3]); w.z = cvt_pk_bf16(v1[0], v1[1]); w.w = cvt_pk_bf16(v1[2], v1[3]);
                    *(u32x4*)(rowp + bj * HALF) = w; } }
    }
};

template <class Epi, class Sched, bool STAMP = false>
__device__ __forceinline__ void gemm_phase(PG8_LAS unsigned char* lds, const Gemm g, const Sched& S, const Epi& E, unsigned long long* stamps) {
    const int tid = mk_tid(), wid = __builtin_amdgcn_readfirstlane(tid >> 6), lane = tid & 63, wr = wid >> 2, wc = wid & 3, fr = lane & 15, fq = lane >> 4;
    const int K = g.K, nt = K / BK;
    int ts_lo = 0, ts_hi = 0, nts = 0; const unsigned long long rt_entry = STAMP ? (unsigned long long)wall_clock64() : 0ull;
#define PG8_STAMP() do { if (STAMP && wid == 0 && nts < 64) { const unsigned long long _c = (unsigned long long)clock64(); \
        ts_lo = (lane == nts) ? (int)(unsigned)_c : ts_lo; ts_hi = (lane == nts) ? (int)(unsigned)(_c >> 32) : ts_hi; ++nts; } } while (0)
    PG8_STAMP();
    unsigned voffA[2], voffB[2];
#pragma unroll
    for (int i = 0; i < 2; ++i) { int R, C; stage_rc(tid * 16 + i * 8192, R, C); const int Rb = Epi::PERM ? ((R & ~31) + perm32(R & 31)) : R;
        voffA[i] = (unsigned)(R * K + C) * 2u; voffB[i] = (unsigned)(Rb * K + C) * 2u; }
    const size_t kstep = (size_t)(BK * 2);
    const size_t hstep = (size_t)HALF * K * 2;
    const size_t tstep = 2 * hstep;
    const unsigned ldsw = (unsigned)wid * 1024u;
    const int aoff = lds_byte(wr * 64 + fr, fq * 8), boff = lds_byte(wc * 32 + fr, fq * 8);
#define PG8_SA(b, h) (((b) * 2 + (h)) * HTB)
#define PG8_SB(b, h) ((4 + (b) * 2 + (h)) * HTB)
#define PG8_STAGE(bufoff, gbase, voff) do { _Pragma("unroll") for (int _i = 0; _i < 2; ++_i) \
        __builtin_amdgcn_global_load_lds((const unsigned*)((const char*)(gbase) + (voff)[_i]), (PG8_LAS unsigned*)(lds + (bufoff) + ldsw + _i * 8192), 16, 0, 0); } while (0)
#define PG8_LDA(dst, b, h) do { _Pragma("unroll") for (int m = 0; m < 4; ++m) _Pragma("unroll") for (int k = 0; k < 2; ++k) dst[m][k] = *(const PG8_LAS bf16x8*)(lds + PG8_SA(b, h) + aoff + m * 2048 + k * 1024); } while (0)
#define PG8_LDB(dst, b, h) do { _Pragma("unroll") for (int n = 0; n < 2; ++n) _Pragma("unroll") for (int k = 0; k < 2; ++k) dst[n][k] = *(const PG8_LAS bf16x8*)(lds + PG8_SB(b, h) + boff + n * 2048 + k * 1024); } while (0)
#define PG8_MMA(ai, bj, At, Bt) do { __builtin_amdgcn_s_setprio(1); _Pragma("unroll") for (int m = 0; m < 4; ++m) _Pragma("unroll") for (int n = 0; n < 2; ++n) _Pragma("unroll") for (int k = 0; k < 2; ++k) \
        acc[ai][bj][m][n] = __builtin_amdgcn_mfma_f32_16x16x32_bf16(Bt[n][k], At[m][k], acc[ai][bj][m][n], 0, 0, 0); __builtin_amdgcn_s_setprio(0); } while (0)
#define PG8_WAIT_V(n) asm volatile("s_waitcnt vmcnt(" #n ")" ::: "memory")
#define PG8_WAIT_L(n) asm volatile("s_waitcnt lgkmcnt(" #n ")" ::: "memory")
#define PG8_BAR __builtin_amdgcn_s_barrier()
#define PG8_SCHED __builtin_amdgcn_sched_barrier(0)
    Unit cur, nxt; int ui = 0;
    if (!S.next(0, cur)) return;
    f32x4 acc[2][2][4][2];
#pragma unroll
    for (int a = 0; a < 2; ++a)
#pragma unroll
        for (int b = 0; b < 2; ++b)
#pragma unroll
            for (int m = 0; m < 4; ++m)
#pragma unroll
                for (int n = 0; n < 2; ++n) acc[a][b][m][n] = (f32x4){0.f, 0.f, 0.f, 0.f};
    bf16x8 At[4][2], B0[2][2], B1[2][2];
    const char* cA = (const char*)g.A + (size_t)cur.pm * tstep; const char* cB = (const char*)g.Bt + (size_t)cur.pn * tstep;
    S.a_ready(cur);
    PG8_STAGE(PG8_SB(0, 0), cB, voffB); PG8_STAGE(PG8_SA(0, 0), cA, voffA); PG8_STAGE(PG8_SB(0, 1), cB + hstep, voffB); PG8_STAGE(PG8_SA(0, 1), cA + hstep, voffA);
    if (wr == 1) PG8_BAR;
    PG8_WAIT_V(4); PG8_BAR;
    PG8_STAGE(PG8_SB(1, 0), cB + kstep, voffB); PG8_STAGE(PG8_SA(1, 0), cA + kstep, voffA); PG8_STAGE(PG8_SB(1, 1), cB + hstep + kstep, voffB);
    PG8_WAIT_V(6); PG8_BAR;
    PG8_STAMP();
    for (;;) {
        const bool has_next = S.next(ui + 1, nxt);
        const char* nA = has_next ? (const char*)g.A + (size_t)nxt.pm * tstep : cA; const char* nB = has_next ? (const char*)g.Bt + (size_t)nxt.pn * tstep : cB;
        for (int t = 0; t < nt; t += 2) {
            const bool last = (t == nt - 2);
            const char* a1 = cA + (size_t)(t + 1) * kstep;
            const char* a2 = last ? nA : cA + (size_t)(t + 2) * kstep; const char* b2 = last ? nB : cB + (size_t)(t + 2) * kstep;
            const char* a3 = a2 + kstep; const char* b3 = b2 + kstep;
            if (last && has_next) S.a_ready(nxt);
            PG8_LDB(B0, 0, 0); PG8_SCHED; PG8_LDA(At, 0, 0); PG8_STAGE(PG8_SA(1, 1), a1 + hstep, voffA);
            PG8_WAIT_L(8); PG8_BAR; PG8_WAIT_L(0); PG8_MMA(0, 0, At, B0); PG8_BAR; PG8_SCHED;
            PG8_LDB(B1, 0, 1); PG8_STAGE(PG8_SB(0, 0), b2, voffB);
            PG8_BAR; PG8_WAIT_L(0); PG8_MMA(0, 1, At, B1); PG8_BAR;
            PG8_LDA(At, 0, 1); PG8_STAGE(PG8_SA(0, 0), a2, voffA);
            PG8_BAR; PG8_WAIT_L(0); PG8_MMA(1, 0, At, B0); PG8_BAR; PG8_SCHED;
            PG8_STAGE(PG8_SB(0, 1), b2 + hstep, voffB);
            PG8_WAIT_V(6); PG8_BAR; PG8_MMA(1, 1, At, B1); PG8_BAR;
            PG8_LDB(B0, 1, 0); PG8_SCHED; PG8_LDA(At, 1, 0); PG8_STAGE(PG8_SA(0, 1), a2 + hstep, voffA);
            PG8_WAIT_L(8); PG8_BAR; PG8_WAIT_L(0); PG8_MMA(0, 0, At, B0); PG8_BAR; PG8_SCHED;
            PG8_LDB(B1, 1, 1); PG8_STAGE(PG8_SB(1, 0), b3, voffB);
            PG8_BAR; PG8_WAIT_L(0); PG8_MMA(0, 1, At, B1); PG8_BAR;
            PG8_LDA(At, 1, 1); PG8_STAGE(PG8_SA(1, 0), a3, voffA);
            PG8_BAR; PG8_WAIT_L(0); PG8_MMA(1, 0, At, B0); PG8_BAR; PG8_SCHED;
            PG8_STAGE(PG8_SB(1, 1), b3 + hstep, voffB);
            PG8_WAIT_V(6); PG8_BAR; PG8_MMA(1, 1, At, B1); PG8_BAR;
        }
        PG8_STAMP();
        if constexpr (!Epi::AFTER_DRAIN) { E(acc, cur, wr, wc, fr, fq); S.done(cur); }
        PG8_STAMP();
        if (!has_next) break;
#pragma unroll
        for (int a = 0; a < 2; ++a)
#pragma unroll
            for (int b = 0; b < 2; ++b)
#pragma unroll
                for (int m = 0; m < 4; ++m)
#pragma unroll
                    for (int n = 0; n < 2; ++n) acc[a][b][m][n] = (f32x4){0.f, 0.f, 0.f, 0.f};
        cur = nxt; cA = nA; cB = nB; ++ui;
    }
    PG8_WAIT_V(0);
    if (wr == 0) PG8_BAR;
    PG8_BAR;
    if constexpr (Epi::AFTER_DRAIN) { E.fused(acc, cur, wr, wc, fr, fq, lds, wid, lane); S.done(cur); }
    PG8_STAMP();
    if (STAMP && wid == 0) { stamps[lane] = lane < nts ? (((unsigned long long)(unsigned)ts_hi << 32) | (unsigned)ts_lo) : 0ull;
        if (lane == 62) stamps[62] = rt_entry; if (lane == 63) stamps[63] = (unsigned long long)wall_clock64(); }
#undef PG8_STAMP
#undef PG8_SA
#undef PG8_SB
#undef PG8_STAGE
#undef PG8_LDA
#undef PG8_LDB
#undef PG8_MMA
#undef PG8_WAIT_V
#undef PG8_WAIT_L
#undef PG8_BAR
#undef PG8_SCHED
}
}
#define XB_TMO      128
#define XB_XCNT(j)  (256  + 64 * (j))
#define XB_XSUB(j)  (1280 + 64 * (j))
#define XB_XGEN(j)  (2304 + 64 * (j))
#define XB_TOP      3328
#define XB_TOPGEN   3392
#define XCD_BAR_WORDS 3456
#define XB_SPIN_CAP (1u << 18)
#define LAS __attribute__((address_space(3)))

__device__ __forceinline__ unsigned xb_ld(unsigned* p)              { return __hip_atomic_load(p, __ATOMIC_RELAXED, __HIP_MEMORY_SCOPE_AGENT); }
__device__ __forceinline__ unsigned xb_add(unsigned* p, unsigned v) { return __hip_atomic_fetch_add(p, v, __ATOMIC_RELAXED, __HIP_MEMORY_SCOPE_AGENT); }
__device__ __forceinline__ unsigned xb_xcc_id() { return (unsigned)__builtin_amdgcn_s_getreg((3 << 11) | 20) & 0xFu; }
#define XB_SPIN(cond, bar) do { unsigned _sp = 0; while (cond) { __builtin_amdgcn_s_sleep(1); \
    if ((++_sp & 255u) == 0u) { if (xb_ld(&(bar)[XB_TMO])) break; if (_sp > XB_SPIN_CAP) { atomicAdd(&(bar)[XB_TMO], 1u); break; } } } } while (0)

struct XcdBarrier {
    unsigned* bar; unsigned x;
    volatile LAS unsigned* st;
};

__device__ __forceinline__ XcdBarrier xcd_barrier_post(unsigned* bar, volatile LAS unsigned* st) {
    XcdBarrier b; b.bar = bar; b.x = xb_xcc_id(); b.st = st;
    if (threadIdx.x == 0) (void)xb_add(&bar[XB_XCNT(b.x)], 1u);
    return b;
}
__device__ __forceinline__ void xcd_barrier_complete(unsigned* bar, unsigned x, unsigned& nloc, unsigned& nx) {
    const unsigned G = gridDim.x * gridDim.y * gridDim.z;
    unsigned sum, cnt, mine, sp = 0u;
    for (;;) {
        sum = 0u; cnt = 0u; mine = 0u;
#pragma unroll
        for (unsigned j = 0; j < 16; ++j) { const unsigned c = xb_ld(&bar[XB_XCNT(j)]); sum += c; cnt += (c > 0u) ? 1u : 0u; mine = (j == x) ? c : mine; }
        if (sum == G) break;
        __builtin_amdgcn_s_sleep(1);
        if ((++sp & 255u) == 0u) { if (xb_ld(&bar[XB_TMO])) break; if (sp > XB_SPIN_CAP) { atomicAdd(&bar[XB_TMO], 1u); break; } }
    }
    nloc = mine > 0u ? mine : 1u; nx = cnt > 0u ? cnt : 1u;
}

__device__ __forceinline__ void xcd_barrier(const XcdBarrier& b) {
    asm volatile("s_waitcnt vmcnt(0)" ::: "memory");
    __syncthreads();
    if (threadIdx.x == 0) {
        unsigned* bar = b.bar;
        __builtin_amdgcn_s_waitcnt(0);
        unsigned nloc = b.st[0], nx = b.st[1];
        if (nloc == 0u) { xcd_barrier_complete(bar, b.x, nloc, nx); b.st[0] = nloc; b.st[1] = nx; }
        const unsigned old = xb_add(&bar[XB_XSUB(b.x)], 1u);
        const unsigned gen = old / nloc;
        if (old + 1u == (gen + 1u) * nloc) {
            __builtin_amdgcn_fence(__ATOMIC_RELEASE, "agent");
            asm volatile("s_waitcnt vmcnt(0)" ::: "memory");
            const unsigned og = xb_add(&bar[XB_TOP], 1u);
            const unsigned tg = og / nx;
            if (og + 1u == (tg + 1u) * nx) xb_add(&bar[XB_TOPGEN], 1u);
            else XB_SPIN(xb_ld(&bar[XB_TOPGEN]) == tg, bar);
            __builtin_amdgcn_fence(__ATOMIC_ACQUIRE, "agent");
            xb_add(&bar[XB_XGEN(b.x)], 1u);
            asm volatile("s_waitcnt vmcnt(0)" ::: "memory");
        } else {
            XB_SPIN(xb_ld(&bar[XB_XGEN(b.x)]) == gen, bar);
            __builtin_amdgcn_fence(__ATOMIC_ACQUIRE, "agent");
            asm volatile("s_waitcnt vmcnt(0)" ::: "memory");
        }
    }
    __syncthreads();
}

namespace mk {
using pg8::bf16_t; using pg8::bf16x8; using pg8::f32x4; using pg8::u32x4;
typedef short s16x4 __attribute__((ext_vector_type(4)));
typedef unsigned u32x2 __attribute__((ext_vector_type(2)));
typedef __bf16 bf16x2v __attribute__((ext_vector_type(2)));
typedef int i32x4 __attribute__((ext_vector_type(4)));
#define DI __device__ __forceinline__

constexpr int D = 1024, SEQ = 4096, NTOK = 16384, DEPTH = 4, DIN = 13824;
constexpr int OFF_AQ = 0, OFF_AK = 1536, OFF_AV = 3072, OFF_LX = 4608, OFF_LG = 5632, OFF_RQ = 6656, OFF_RK = 7680, OFF_RV = 8704, OFF_RG = 9728, OFF_GA = 10752;
constexpr float ALPHA = 1.681792830507429f;
constexpr float LN_EPS = 1e-5f;
constexpr int NPH = 12;
constexpr int LDS_BYTES = 148 * 1024;
constexpr int LDS_BAR_OFF = LDS_BYTES - 16;

constexpr size_t WS_CTL  = 0;
constexpr size_t WS_COSA = 16384;
constexpr size_t WS_SINA = WS_COSA + (size_t)4096 * 64 * 4;
constexpr size_t WS_COSR = WS_SINA + (size_t)4096 * 64 * 4;
constexpr size_t WS_SINR = WS_COSR + (size_t)4096 * 128 * 4;
constexpr size_t WS_CCH  = WS_SINR + (size_t)4096 * 128 * 4;
constexpr size_t WS_WAT  = WS_CCH + 4096;
constexpr size_t WS_WXT  = WS_WAT + 131072;
constexpr size_t WS_LSTA = WS_WXT + 131072;
constexpr size_t WS_LSTH = WS_LSTA + 524288;
constexpr size_t WS_K1B  = WS_LSTH + 524288;
constexpr size_t WS_K2B  = WS_K1B + 262144;
constexpr size_t WS_XF   = WS_K2B + 262144;
constexpr size_t WS_XB   = WS_XF + (size_t)NTOK * D * 4;
constexpr size_t WS_WINT = WS_XB + (size_t)NTOK * D * 2;
constexpr size_t WS_WBAT = WS_WINT + (size_t)DIN * 1024 * 2;
constexpr size_t WS_WBBT = WS_WBAT + (size_t)1024 * 512 * 2;
constexpr size_t WS_WBCT = WS_WBBT + (size_t)1024 * 1024 * 2;
constexpr size_t WS_WOT  = WS_WBCT + (size_t)1024 * 1024 * 2;
constexpr size_t WS_WQT  = WS_WOT + (size_t)1024 * 1024 * 2;
constexpr size_t WS_UB   = WS_WQT + (size_t)2048 * 1024 * 2;
constexpr size_t WS_VB   = WS_UB + (size_t)16384 * 1024 * 2;
constexpr size_t WS_PROJ = WS_VB + (size_t)16384 * 1024 * 2;
constexpr size_t WS_OATT = WS_PROJ + (size_t)NTOK * DIN * 2;
constexpr size_t WS_LSE  = WS_OATT + (size_t)NTOK * 1536 * 2;
constexpr size_t WS_KVB  = WS_LSE + (size_t)NTOK * 12 * 4;
constexpr size_t WS_YA   = WS_KVB + (size_t)16 * 32 * 65536 * 2;
constexpr size_t WS_YB   = WS_YA + (size_t)NTOK * 512 * 2;
constexpr size_t WS_YC   = WS_YB + (size_t)NTOK * 1024 * 2;
constexpr size_t WS_MRGF = WS_YC + (size_t)NTOK * 1024 * 2;
constexpr size_t WS_MRGB = WS_MRGF + (size_t)NTOK * 1024 * 4;
constexpr size_t WS_END  = WS_MRGB + (size_t)NTOK * 1024 * 2;
constexpr size_t WS_Q    = WS_PROJ;
constexpr size_t WS_EID  = WS_PROJ + (size_t)NTOK * 2048 * 2;
constexpr size_t WS_GATE = WS_EID + (size_t)NTOK * 128 * 4;
static_assert(WS_END <= (size_t)1073741824, "workspace too large");
static_assert(WS_PROJ % 256 == 0 && WS_KVB % 256 == 0 && WS_MRGF % 256 == 0, "alignment");

struct Args { const float* in[20]; float* out; unsigned char* ws; double ropeA, ropeR; int ph_lo, ph_hi; };

DI float bflo(unsigned w) { return __uint_as_float(w << 16); }
DI float bfhi(unsigned w) { return __uint_as_float(w & 0xffff0000u); }
DI float bf2f(bf16_t v) { return __uint_as_float(((unsigned)v) << 16); }
DI unsigned pk2(float lo, float hi) { return pg8::cvt_pk_bf16(lo, hi); }
DI bf16_t f2bf(float f) { return (bf16_t)(pk2(f, 0.f) & 0xffffu); }
DI f32x4 mfma16(bf16x8 a, bf16x8 b, f32x4 c) { return __builtin_amdgcn_mfma_f32_16x16x32_bf16(a, b, c, 0, 0, 0); }
DI s16x4 trrd(LAS unsigned char* p) { return __builtin_amdgcn_ds_read_tr16_b64_v4i16((LAS s16x4*)p); }
DI bf16x8 cat8(s16x4 lo, s16x4 hi) { return __builtin_shufflevector(lo, hi, 0, 1, 2, 3, 4, 5, 6, 7); }
DI float wsum(float v) { v += __shfl_xor(v, 32); v += __shfl_xor(v, 16); v += __shfl_xor(v, 8); v += __shfl_xor(v, 4); v += __shfl_xor(v, 2); v += __shfl_xor(v, 1); return v; }
DI float sigm(float x) { return 1.f / (1.f + __expf(-x)); }
DI float gelu_erf(float x) { return 0.5f * x * (1.f + erff(x * 0.70710678118654752f)); }
DI float dot2(unsigned w, unsigned x, float acc) { return __builtin_amdgcn_fdot2_f32_bf16(__builtin_bit_cast(bf16x2v, w), __builtin_bit_cast(bf16x2v, x), acc, false); }
DI float log2gamma(int h) { return log2f(1.0f - exp2f(-5.0f - (float)h)); }

DI void sincos_d(double x, double& s, double& c) {
    const double n = rint(x * 0.63661977236758134308);
    double y = fma(-n, 1.57079632679489655800e+00, x); y = fma(-n, 6.12323399573676603587e-17, y);
    const double y2 = y * y;
    const double sp = y + y * y2 * (-1.0 / 6 + y2 * (1.0 / 120 + y2 * (-1.0 / 5040 + y2 * (1.0 / 362880 + y2 * (-1.0 / 39916800 + y2 * (1.0 / 6227020800.0))))));
    const double cp = 1.0 + y2 * (-0.5 + y2 * (1.0 / 24 + y2 * (-1.0 / 720 + y2 * (1.0 / 40320 + y2 * (-1.0 / 3628800 + y2 * (1.0 / 479001600.0 + y2 * (-1.0 / 87178291200.0)))))));
    const int q = ((int)n) & 3;
    s = (q == 0) ? sp : (q == 1) ? cp : (q == 2) ? -sp : -cp;
    c = (q == 0) ? cp : (q == 1) ? -sp : (q == 2) ? -cp : sp;
}

DI void tconv_tile(const float* src, int ldsrc, bf16_t* dst, int lddst, int k0, int n0, LAS float* t) {
    const int tid = mk_tid();
#pragma unroll
    for (int i = 0; i < 8; ++i) { const int idx = tid + 512 * i, r = idx >> 6, c = idx & 63; t[r * 65 + c] = src[(size_t)(k0 + r) * ldsrc + n0 + c]; }
    __syncthreads();
#pragma unroll
    for (int i = 0; i < 8; ++i) { const int idx = tid + 512 * i, n = idx >> 6, k = idx & 63; dst[(size_t)(n0 + n) * lddst + k0 + k] = f2bf(t[k * 65 + n]); }
    __syncthreads();
}
DI void conv_unit(const float* src, bf16_t* dst, int unit) {
    const size_t i = (size_t)unit * 4096 + (size_t)mk_tid() * 8;
    const f32x4 a = *(const f32x4*)(src + i), b = *(const f32x4*)(src + i + 4);
    u32x4 o; o.x = pk2(a[0], a[1]); o.y = pk2(a[2], a[3]); o.z = pk2(b[0], b[1]); o.w = pk2(b[2], b[3]);
    *(u32x4*)(dst + i) = o;
}
DI void phase_conv(const Args& a, int layer, LAS unsigned char* lds) {
    unsigned char* ws = a.ws;
    LAS float* t = (LAS float*)lds;
    const int J0 = 3456, J1 = J0 + 128, J2 = J1 + 256, J3 = J2 + 256, J4 = J3 + 256, J5 = J4 + 512, J6 = J5 + 32, J7 = J6 + 4096, J8 = J7 + 4096, J9 = J8 + 64, J10 = J9 + 1;
    const int total = J10;
    for (int u = blockIdx.x; u < total; u += gridDim.x) {
        if (u < J0) { const int kt = u / 216, nt = u % 216; tconv_tile(a.in[1] + (size_t)layer * 1024 * DIN, DIN, (bf16_t*)(ws + WS_WINT), 1024, kt * 64, nt * 64, t); }
        else if (u < J1) { const int v = u - J0, kt = v / 16, nt = v % 16; tconv_tile(a.in[9] + (size_t)layer * 2560 * 1024, 1024, (bf16_t*)(ws + WS_WBAT), 512, kt * 64, nt * 64, t); }
        else if (u < J2) { const int v = u - J1, kt = v / 16, nt = v % 16; tconv_tile(a.in[9] + (size_t)layer * 2560 * 1024 + (size_t)512 * 1024, 1024, (bf16_t*)(ws + WS_WBBT), 1024, kt * 64, nt * 64, t); }
        else if (u < J3) { const int v = u - J2, kt = v / 16, nt = v % 16; tconv_tile(a.in[9] + (size_t)layer * 2560 * 1024 + (size_t)1536 * 1024, 1024, (bf16_t*)(ws + WS_WBCT), 1024, kt * 64, nt * 64, t); }
        else if (u < J4) { const int v = u - J3, kt = v / 16, nt = v % 16; tconv_tile(a.in[10] + (size_t)layer * 1024 * 1024, 1024, (bf16_t*)(ws + WS_WOT), 1024, kt * 64, nt * 64, t); }
        else if (u < J5) { const int v = u - J4, kt = v / 32, nt = v % 32; tconv_tile(a.in[13] + (size_t)layer * 1024 * 2048, 2048, (bf16_t*)(ws + WS_WQT), 1024, kt * 64, nt * 64, t); }
        else if (u < J6) { const int v = u - J5, blk = v & 15, which = v >> 4;
            tconv_tile(a.in[which ? 6 : 4] + ((size_t)layer * 16 + blk) * 4096, 64, (bf16_t*)(ws + (which ? WS_WXT : WS_WAT)) + blk * 4096, 64, 0, 0, t); }
        else if (u < J7) { conv_unit(a.in[16] + (size_t)layer * 16384 * 1024, (bf16_t*)(ws + WS_UB), u - J6); }
        else if (u < J8) { conv_unit(a.in[17] + (size_t)layer * 16384 * 1024, (bf16_t*)(ws + WS_VB), u - J7); }
        else if (u < J9) { const int v = u - J8; if (v < 32) conv_unit(a.in[14] + (size_t)layer * 131072, (bf16_t*)(ws + WS_K1B), v); else conv_unit(a.in[15] + (size_t)layer * 131072, (bf16_t*)(ws + WS_K2B), v - 32); }
        else { for (int c = mk_tid(); c < 1024; c += 512) { const float lam = a.in[8][layer * 1024 + c]; ((float*)(ws + WS_CCH))[c] = -8.0f * log1pf(expf(-lam)); } }
    }
}

DI void phase_prologue(const Args& a) {
    unsigned char* ws = a.ws;
    const int tid = mk_tid();
    for (int u = blockIdx.x; u < 4096 + 1536; u += gridDim.x) {
        if (u < 4096) { const size_t i = (size_t)u * 4096 + (size_t)tid * 8;
            const f32x4 p = *(const f32x4*)(a.in[0] + i), q = *(const f32x4*)(a.in[0] + i + 4);
            *(f32x4*)((float*)(ws + WS_XF) + i) = p; *(f32x4*)((float*)(ws + WS_XF) + i + 4) = q;
            u32x4 o; o.x = pk2(p[0], p[1]); o.y = pk2(p[2], p[3]); o.z = pk2(q[0], q[1]); o.w = pk2(q[2], q[3]);
            *(u32x4*)((bf16_t*)(ws + WS_XB) + i) = o; }
        else { const int idx = (u - 4096) * 512 + tid;
            const int pos = idx / 192, i = idx % 192;
            const bool isA = i < 64; const int fi = isA ? i : i - 64; const double r = isA ? a.ropeA : a.ropeR;
            double inv = 1.0; for (int k = 0; k < fi; ++k) inv *= r;
            double s, c; sincos_d((double)pos * inv, s, c);
            if (isA) { ((float*)(ws + WS_COSA))[pos * 64 + fi] = (float)c; ((float*)(ws + WS_SINA))[pos * 64 + fi] = (float)s; }
            else { ((float*)(ws + WS_COSR))[pos * 128 + fi] = (float)c; ((float*)(ws + WS_SINR))[pos * 128 + fi] = (float)s; } }
    }
}

DI void phase_rope(const Args& a) {
    unsigned char* ws = a.ws; bf16_t* proj = (bf16_t*)(ws + WS_PROJ);
    for (int u = blockIdx.x; u < NTOK / 8; u += gridDim.x) {
#pragma unroll 1
        for (int i = 0; i < 5; ++i) {
            const int idx = mk_tid() + 512 * i, tk = u * 8 + idx / 320; int it = idx % 320;
            int off, hd, half, head, ch; const float* ct; const float* st; float sc = 1.0f;
            if (it < 192) { off = (it < 96) ? OFF_AQ : OFF_AK; if (it >= 96) it -= 96; hd = 128; half = 64; head = it >> 3; ch = it & 7; ct = (const float*)(ws + WS_COSA); st = (const float*)(ws + WS_SINA); }
            else { it -= 192; off = (it < 64) ? OFF_RQ : OFF_RK; if (it >= 64) { it -= 64; sc = 0.0625f; } hd = 256; half = 128; head = it >> 4; ch = it & 15; ct = (const float*)(ws + WS_COSR); st = (const float*)(ws + WS_SINR); }
            const int pos = tk & (SEQ - 1);
            bf16_t* p1 = proj + (size_t)tk * DIN + off + head * hd + ch * 8; bf16_t* p2 = p1 + half;
            const u32x4 x1 = *(const u32x4*)p1, x2 = *(const u32x4*)p2;
            const float* cp = ct + (size_t)pos * half + ch * 8; const float* sp = st + (size_t)pos * half + ch * 8;
            const f32x4 c0 = *(const f32x4*)cp, c1 = *(const f32x4*)(cp + 4), s0 = *(const f32x4*)sp, s1 = *(const f32x4*)(sp + 4);
            float t1[8], t2[8], cc[8], ss[8];
#pragma unroll
            for (int q = 0; q < 4; ++q) { t1[2 * q] = bflo(x1[q]); t1[2 * q + 1] = bfhi(x1[q]); t2[2 * q] = bflo(x2[q]); t2[2 * q + 1] = bfhi(x2[q]); cc[q] = c0[q]; cc[4 + q] = c1[q]; ss[q] = s0[q]; ss[4 + q] = s1[q]; }
            u32x4 o1, o2;
#pragma unroll
            for (int q = 0; q < 4; ++q) {
                const float a0 = (t1[2 * q] * cc[2 * q] - t2[2 * q] * ss[2 * q]) * sc, a1 = (t1[2 * q + 1] * cc[2 * q + 1] - t2[2 * q + 1] * ss[2 * q + 1]) * sc;
                const float b0 = (t1[2 * q] * ss[2 * q] + t2[2 * q] * cc[2 * q]) * sc, b1 = (t1[2 * q + 1] * ss[2 * q + 1] + t2[2 * q + 1] * cc[2 * q + 1]) * sc;
                o1[q] = pk2(a0, a1); o2[q] = pk2(b0, b1); }
            *(u32x4*)p1 = o1; *(u32x4*)p2 = o2;
        }
    }
}

DI void attn_unit(const Args& a, int unit, LAS unsigned char* lds) {
    unsigned char* ws = a.ws;
    const int tid = mk_tid(), lane = tid & 63, w = __builtin_amdgcn_readfirstlane(tid >> 6), g = lane >> 4, l15 = lane & 15, tq4 = l15 >> 2, tp4 = l15 & 3;
    const int b = unit / 384, rem = unit % 384, h = rem >> 5, bi = rem & 31;
    const int grp = h >> 2, d = (grp == 0) ? 1 : ((grp == 1) ? 4 : 16), nb = 32 / d, r = bi / nb, n = bi % nb;
    const bf16_t* proj = (const bf16_t*)(ws + WS_PROJ) + (size_t)b * SEQ * DIN;
    LAS unsigned char* Ks = lds; LAS unsigned char* Vs = lds + 256 * 288;
#pragma unroll
    for (int i = 0; i < 8; ++i) {
        const int idx = tid + 512 * i, row = idx >> 4, ch = idx & 15, m = 128 * (n - 1) + row;
        u32x4 kv = {0u, 0u, 0u, 0u}, vv = {0u, 0u, 0u, 0u};
        if (m >= 0) { const bf16_t* p = proj + (size_t)(m * d + r) * DIN + h * 128 + ch * 8; kv = *(const u32x4*)(p + OFF_AK); vv = *(const u32x4*)(p + OFF_AV); }
        *(LAS u32x4*)(Ks + row * 288 + ch * 16) = kv; *(LAS u32x4*)(Vs + row * 288 + ch * 16) = vv;
    }
    const int qi = 16 * w + l15;
    const size_t tq = (size_t)(128 * n + qi) * d + r;
    bf16x8 qf[4];
#pragma unroll
    for (int ks = 0; ks < 4; ++ks) qf[ks] = *(const bf16x8*)(proj + tq * DIN + OFF_AQ + h * 128 + 32 * ks + 8 * g);
    __syncthreads();
    const int s0 = w >> 1;
    f32x4 sacc[10];
#pragma unroll
    for (int jj = 0; jj < 10; ++jj) {
        f32x4 acc = {0.f, 0.f, 0.f, 0.f};
#pragma unroll
        for (int ks = 0; ks < 4; ++ks) { const bf16x8 kf = *(const LAS bf16x8*)(Ks + (32 * s0 + 16 * jj + l15) * 288 + (32 * ks + 8 * g) * 2); acc = mfma16(kf, qf[ks], acc); }
        sacc[jj] = acc;
    }
    const float scale = 0.08838834764831845f;
    float mx = -1e30f;
#pragma unroll
    for (int jj = 0; jj < 10; ++jj)
#pragma unroll
        for (int rg = 0; rg < 4; ++rg) {
            const int j = 32 * s0 + 16 * jj + 4 * g + rg;
            const bool valid = (j >= qi) && (j <= qi + 128) && (n > 0 || j >= 128);
            const float s = valid ? sacc[jj][rg] * scale : -1e30f;
            sacc[jj][rg] = s; mx = fmaxf(mx, s);
        }
    mx = fmaxf(mx, __shfl_xor(mx, 16)); mx = fmaxf(mx, __shfl_xor(mx, 32));
    float sum = 0.f;
#pragma unroll
    for (int jj = 0; jj < 10; ++jj)
#pragma unroll
        for (int rg = 0; rg < 4; ++rg) { const float p = __expf(sacc[jj][rg] - mx); sacc[jj][rg] = p; sum += p; }
    sum += __shfl_xor(sum, 16); sum += __shfl_xor(sum, 32);
    f32x4 oacc[8];
#pragma unroll
    for (int db = 0; db < 8; ++db) oacc[db] = (f32x4){0.f, 0.f, 0.f, 0.f};
#pragma unroll
    for (int s = 0; s < 5; ++s) {
        u32x4 pw; pw.x = pk2(sacc[2 * s][0], sacc[2 * s][1]); pw.y = pk2(sacc[2 * s][2], sacc[2 * s][3]); pw.z = pk2(sacc[2 * s + 1][0], sacc[2 * s + 1][1]); pw.w = pk2(sacc[2 * s + 1][2], sacc[2 * s + 1][3]);
        const bf16x8 pb = __builtin_bit_cast(bf16x8, pw);
        const int k0 = 32 * (s0 + s) + 4 * g + tq4;
#pragma unroll
        for (int db = 0; db < 8; ++db) {
            const s16x4 lo = trrd(Vs + k0 * 288 + (16 * db + 4 * tp4) * 2), hi = trrd(Vs + (k0 + 16) * 288 + (16 * db + 4 * tp4) * 2);
            oacc[db] = mfma16(cat8(lo, hi), pb, oacc[db]);
        }
    }
    const float inv = 1.0f / sum;
    bf16_t* op = (bf16_t*)(ws + WS_OATT) + ((size_t)b * SEQ + tq) * 1536 + h * 128 + 4 * g;
#pragma unroll
    for (int db = 0; db < 8; ++db) { u32x2 o; o.x = pk2(oacc[db][0] * inv, oacc[db][1] * inv); o.y = pk2(oacc[db][2] * inv, oacc[db][3] * inv); *(u32x2*)(op + 16 * db) = o; }
    if (g == 0) ((float*)(ws + WS_LSE))[((size_t)b * SEQ + tq) * 12 + h] = mx + __logf(sum);
    __syncthreads();
}

DI void retkv_unit(const Args& a, int unit, LAS unsigned char* lds) {
    unsigned char* ws = a.ws;
    const int tid = mk_tid(), lane = tid & 63, w = __builtin_amdgcn_readfirstlane(tid >> 6), g = lane >> 4, l15 = lane & 15, tq4 = l15 >> 2, tp4 = l15 & 3;
    const int b = unit >> 7, h = (unit >> 5) & 3, c = unit & 31;
    const bf16_t* proj = (const bf16_t*)(ws + WS_PROJ) + ((size_t)b * SEQ + c * 128) * DIN;
    LAS unsigned char* Ks = lds; LAS unsigned char* Vs = lds + 128 * 544;
    const float l2g = log2gamma(h);
#pragma unroll
    for (int i = 0; i < 8; ++i) {
        const int idx = tid + 512 * i, row = idx >> 5, ch = idx & 31;
        const bf16_t* p = proj + (size_t)row * DIN + h * 256 + ch * 8;
        const u32x4 kv = *(const u32x4*)(p + OFF_RK), vv = *(const u32x4*)(p + OFF_RV);
        const float z = exp2f((float)(127 - row) * l2g);
        u32x4 kz;
#pragma unroll
        for (int q = 0; q < 4; ++q) kz[q] = pk2(bflo(kv[q]) * z, bfhi(kv[q]) * z);
        *(LAS u32x4*)(Ks + row * 544 + ch * 16) = kz; *(LAS u32x4*)(Vs + row * 544 + ch * 16) = vv;
    }
    __syncthreads();
#pragma unroll 1
    for (int nh = 0; nh < 2; ++nh) {
        f32x4 acc[2][8];
#pragma unroll
        for (int mb = 0; mb < 2; ++mb)
#pragma unroll
            for (int nb = 0; nb < 8; ++nb) acc[mb][nb] = (f32x4){0.f, 0.f, 0.f, 0.f};
#pragma unroll
        for (int ks = 0; ks < 4; ++ks) {
            const int j0 = 32 * ks + 4 * g + tq4;
            bf16x8 af[2];
#pragma unroll
            for (int mb = 0; mb < 2; ++mb) { const int col = 32 * w + 16 * mb + 4 * tp4; af[mb] = cat8(trrd(Vs + j0 * 544 + col * 2), trrd(Vs + (j0 + 16) * 544 + col * 2)); }
#pragma unroll
            for (int nb = 0; nb < 8; ++nb) {
                const int col = 128 * nh + 16 * nb + 4 * tp4;
                const bf16x8 bfr = cat8(trrd(Ks + j0 * 544 + col * 2), trrd(Ks + (j0 + 16) * 544 + col * 2));
#pragma unroll
                for (int mb = 0; mb < 2; ++mb) acc[mb][nb] = mfma16(af[mb], bfr, acc[mb][nb]);
            }
        }
        bf16_t* kvb = (bf16_t*)(ws + WS_KVB) + ((size_t)((b * 4 + h) * 32 + c)) * 65536 + 128 * nh;
#pragma unroll
        for (int mb = 0; mb < 2; ++mb)
#pragma unroll
            for (int nb = 0; nb < 8; ++nb)
#pragma unroll
                for (int rg = 0; rg < 4; ++rg) kvb[(size_t)(32 * w + 16 * mb + 4 * g + rg) * 256 + 16 * nb + l15] = f2bf(acc[mb][nb][rg]);
    }
    __syncthreads();
}

DI void lru_unit(const Args& a, int layer, int unit, bool fin, LAS unsigned char* lds) {
    unsigned char* ws = a.ws;
    const int tid = mk_tid(), lane = tid & 63, w = __builtin_amdgcn_readfirstlane(tid >> 6), g = lane >> 4, l15 = lane & 15;
    const int b = unit >> 9, c = (unit >> 4) & 31, blk = unit & 15;
    LAS bf16_t* lxs = (LAS bf16_t*)lds;
    LAS float* xcf = (LAS float*)(lds + 16896);
    LAS unsigned char* xcb = lds + 49664;
    LAS float* rgt = (LAS float*)(lds + 68096);
    LAS float* igt = (LAS float*)(lds + 100864);
    LAS float* wst = (LAS float*)(lds + 133632);
    const bf16_t* proj = (const bf16_t*)(ws + WS_PROJ) + (size_t)b * SEQ * DIN;
    for (int idx = tid; idx < 131 * 8; idx += 512) {
        const int row = idx >> 3, ch = idx & 7, tk = c * 128 - 3 + row;
        u32x4 v = {0u, 0u, 0u, 0u};
        if (tk >= 0) v = *(const u32x4*)(proj + (size_t)tk * DIN + OFF_LX + blk * 64 + ch * 8);
        *(LAS u32x4*)(lxs + row * 64 + ch * 8) = v;
    }
    __syncthreads();
    {
        const int ch = tid & 63, gc = blk * 64 + ch;
        const float* cw = a.in[2] + (size_t)layer * 4096;
        const float cw0 = cw[gc], cw1 = cw[1024 + gc], cw2 = cw[2048 + gc], cw3 = cw[3072 + gc], cb = a.in[3][layer * 1024 + gc];
#pragma unroll
        for (int i = 0; i < 16; ++i) {
            const int t = (tid >> 6) + 8 * i;
            const float xc = cb + cw0 * bf2f(lxs[t * 64 + ch]) + cw1 * bf2f(lxs[(t + 1) * 64 + ch]) + cw2 * bf2f(lxs[(t + 2) * 64 + ch]) + cw3 * bf2f(lxs[(t + 3) * 64 + ch]);
            xcf[t * 64 + ch] = xc; *(LAS bf16_t*)(xcb + t * 144 + ch * 2) = f2bf(xc);
        }
    }
    __syncthreads();
#pragma unroll
    for (int gate = 0; gate < 2; ++gate) {
        const bf16_t* WT = (const bf16_t*)(ws + (gate ? WS_WXT : WS_WAT)) + blk * 4096;
        const float* bias = a.in[gate ? 7 : 5] + layer * 1024 + blk * 64;
        LAS float* dst = gate ? igt : rgt;
#pragma unroll
        for (int nb = 0; nb < 4; ++nb) {
            f32x4 acc = {0.f, 0.f, 0.f, 0.f};
#pragma unroll
            for (int ks = 0; ks < 2; ++ks) {
                const bf16x8 af = *(const LAS bf16x8*)(xcb + (16 * w + l15) * 144 + (32 * ks + 8 * g) * 2);
                const bf16x8 bfr = *(const bf16x8*)(WT + (16 * nb + l15) * 64 + 32 * ks + 8 * g);
                acc = mfma16(af, bfr, acc);
            }
            const float bv = bias[16 * nb + l15];
#pragma unroll
            for (int rg = 0; rg < 4; ++rg) dst[(16 * w + 4 * g + rg) * 64 + 16 * nb + l15] = sigm(acc[rg] + bv);
        }
    }
    __syncthreads();
    const int ch = lane, gc = blk * 64 + ch;
    const float cc = ((const float*)(ws + WS_CCH))[gc];
    float av[16], bv[16]; float Aw = 1.0f, Hw = 0.0f;
#pragma unroll
    for (int tt = 0; tt < 16; ++tt) {
        const int t = 16 * w + tt;
        const float la = cc * rgt[t * 64 + ch];
        const float aa = __expf(la);
        const float bb = sqrtf(-expm1f(2.0f * la)) * igt[t * 64 + ch] * xcf[t * 64 + ch];
        av[tt] = aa; bv[tt] = bb; Hw = aa * Hw + bb; Aw *= aa;
    }
    wst[w * 64 + ch] = Aw; wst[512 + w * 64 + ch] = Hw;
    __syncthreads();
    float* LA = (float*)(ws + WS_LSTA); float* LH = (float*)(ws + WS_LSTH);
    if (!fin) {
        if (w == 0) {
            float A = 1.0f, H = 0.0f;
#pragma unroll
            for (int ww = 0; ww < 8; ++ww) { const float A_ = wst[ww * 64 + ch], H_ = wst[512 + ww * 64 + ch]; H = A_ * H + H_; A *= A_; }
            LA[(size_t)(b * 32 + c) * 1024 + gc] = A; LH[(size_t)(b * 32 + c) * 1024 + gc] = H;
        }
    } else {
        float hcur = 0.0f;
        for (int cp = 0; cp < c; ++cp) hcur = LA[(size_t)(b * 32 + cp) * 1024 + gc] * hcur + LH[(size_t)(b * 32 + cp) * 1024 + gc];
        for (int ww = 0; ww < w; ++ww) hcur = wst[ww * 64 + ch] * hcur + wst[512 + ww * 64 + ch];
        bf16_t* yb = (bf16_t*)(ws + WS_YB) + ((size_t)b * SEQ + c * 128 + 16 * w) * 1024 + gc;
        const bf16_t* lgp = proj + (size_t)(c * 128 + 16 * w) * DIN + OFF_LG + gc;
#pragma unroll
        for (int tt = 0; tt < 16; ++tt) {
            hcur = av[tt] * hcur + bv[tt];
            const float lgv = bf2f(lgp[(size_t)tt * DIN]);
            yb[(size_t)tt * 1024] = f2bf(hcur * gelu_erf(lgv));
        }
    }
    __syncthreads();
}

DI void retscan_unit(const Args& a, int unit) {
    unsigned char* ws = a.ws;
    const int e8 = unit * 512 + mk_tid();
    const int bh = e8 >> 13, within = e8 & 8191, h = bh & 3;
    const float g128 = exp2f(128.0f * log2gamma(h));
    bf16_t* base = (bf16_t*)(ws + WS_KVB) + (size_t)bh * 32 * 65536 + (size_t)within * 8;
    float st[8];
#pragma unroll
    for (int q = 0; q < 8; ++q) st[q] = 0.f;
    for (int c = 0; c < 32; ++c) {
        u32x4* p = (u32x4*)(base + (size_t)c * 65536);
        const u32x4 kv = *p;
        u32x4 o;
#pragma unroll
        for (int q = 0; q < 4; ++q) o[q] = pk2(st[2 * q], st[2 * q + 1]);
        *p = o;
#pragma unroll
        for (int q = 0; q < 4; ++q) { st[2 * q] = g128 * st[2 * q] + bflo(kv[q]); st[2 * q + 1] = g128 * st[2 * q + 1] + bfhi(kv[q]); }
    }
}

DI void attmerge_unit(const Args& a, int unit) {
    unsigned char* ws = a.ws;
    const int idx = unit * 512 + mk_tid(), t = idx >> 6, hp = (idx >> 4) & 3, dc = idx & 15;
    const float* lse = (const float*)(ws + WS_LSE) + (size_t)t * 12;
    const float l0 = lse[hp], l1 = lse[4 + hp], l2 = lse[8 + hp];
    const float m = fmaxf(l0, fmaxf(l1, l2));
    float w0 = __expf(l0 - m), w1 = __expf(l1 - m), w2 = __expf(l2 - m);
    const float is = 1.0f / (w0 + w1 + w2); w0 *= is; w1 *= is; w2 *= is;
    const bf16_t* o = (const bf16_t*)(ws + WS_OATT) + (size_t)t * 1536 + hp * 128 + dc * 8;
    const u32x4 a0 = *(const u32x4*)o, a1 = *(const u32x4*)(o + 512), a2 = *(const u32x4*)(o + 1024);
    u32x4 r;
#pragma unroll
    for (int q = 0; q < 4; ++q) r[q] = pk2(w0 * bflo(a0[q]) + w1 * bflo(a1[q]) + w2 * bflo(a2[q]), w0 * bfhi(a0[q]) + w1 * bfhi(a1[q]) + w2 * bfhi(a2[q]));
    *(u32x4*)((bf16_t*)(ws + WS_YA) + (size_t)t * 512 + hp * 128 + dc * 8) = r;
}

DI void retout_unit(const Args& a, int unit, LAS unsigned char* lds) {
    unsigned char* ws = a.ws;
    const int tid = mk_tid(), lane = tid & 63, w = __builtin_amdgcn_readfirstlane(tid >> 6), g = lane >> 4, l15 = lane & 15, tq4 = l15 >> 2, tp4 = l15 & 3;
    const int b = unit >> 7, h = (unit >> 5) & 3, c = unit & 31;
    const bf16_t* proj = (const bf16_t*)(ws + WS_PROJ) + ((size_t)b * SEQ + c * 128) * DIN;
    const bf16_t* rt = (const bf16_t*)(ws + WS_KVB) + ((size_t)((b * 4 + h) * 32 + c)) * 65536;
    LAS unsigned char* RA = lds; LAS unsigned char* RB = lds + 128 * 544;
    const float l2g = log2gamma(h);
    const int qi = 16 * w + l15;
    bf16x8 qf[8];
#pragma unroll
    for (int ks = 0; ks < 8; ++ks) qf[ks] = *(const bf16x8*)(proj + (size_t)qi * DIN + OFF_RQ + h * 256 + 32 * ks + 8 * g);
#pragma unroll
    for (int i = 0; i < 8; ++i) {
        const int idx = tid + 512 * i, row = idx >> 5, ch = idx & 31;
        *(LAS u32x4*)(RA + row * 544 + ch * 16) = *(const u32x4*)(proj + (size_t)row * DIN + OFF_RK + h * 256 + ch * 8);
        *(LAS u32x4*)(RB + row * 544 + ch * 16) = *(const u32x4*)(rt + (size_t)row * 256 + ch * 8);
    }
    __syncthreads();
    f32x4 sacc[8], oacc[16];
#pragma unroll
    for (int jj = 0; jj < 8; ++jj) {
        f32x4 acc = {0.f, 0.f, 0.f, 0.f};
        if (jj <= w) {
#pragma unroll
            for (int ks = 0; ks < 8; ++ks) { const bf16x8 kf = *(const LAS bf16x8*)(RA + (16 * jj + l15) * 544 + (32 * ks + 8 * g) * 2); acc = mfma16(kf, qf[ks], acc); }
        }
        sacc[jj] = acc;
    }
#pragma unroll
    for (int db = 0; db < 8; ++db) {
        f32x4 acc = {0.f, 0.f, 0.f, 0.f};
#pragma unroll
        for (int ks = 0; ks < 8; ++ks) { const bf16x8 rf = *(const LAS bf16x8*)(RB + (16 * db + l15) * 544 + (32 * ks + 8 * g) * 2); acc = mfma16(rf, qf[ks], acc); }
        oacc[db] = acc;
    }
    __syncthreads();
#pragma unroll
    for (int i = 0; i < 8; ++i) {
        const int idx = tid + 512 * i, row = idx >> 5, ch = idx & 31;
        *(LAS u32x4*)(RA + row * 544 + ch * 16) = *(const u32x4*)(proj + (size_t)row * DIN + OFF_RV + h * 256 + ch * 8);
        *(LAS u32x4*)(RB + row * 544 + ch * 16) = *(const u32x4*)(rt + (size_t)(128 + row) * 256 + ch * 8);
    }
    __syncthreads();
#pragma unroll
    for (int db = 0; db < 8; ++db) {
        f32x4 acc = {0.f, 0.f, 0.f, 0.f};
#pragma unroll
        for (int ks = 0; ks < 8; ++ks) { const bf16x8 rf = *(const LAS bf16x8*)(RB + (16 * db + l15) * 544 + (32 * ks + 8 * g) * 2); acc = mfma16(rf, qf[ks], acc); }
        oacc[8 + db] = acc;
    }
    const float xi = exp2f((float)(qi + 1) * l2g);
#pragma unroll
    for (int db = 0; db < 16; ++db) oacc[db] = oacc[db] * xi;
#pragma unroll
    for (int jj = 0; jj < 8; ++jj)
#pragma unroll
        for (int rg = 0; rg < 4; ++rg) { const int j = 16 * jj + 4 * g + rg; sacc[jj][rg] = (qi >= j) ? sacc[jj][rg] * exp2f((float)(qi - j) * l2g) : 0.f; }
#pragma unroll
    for (int s = 0; s < 4; ++s) {
        if (2 * s <= w) {
            u32x4 pw; pw.x = pk2(sacc[2 * s][0], sacc[2 * s][1]); pw.y = pk2(sacc[2 * s][2], sacc[2 * s][3]); pw.z = pk2(sacc[2 * s + 1][0], sacc[2 * s + 1][1]); pw.w = pk2(sacc[2 * s + 1][2], sacc[2 * s + 1][3]);
            const bf16x8 pb = __builtin_bit_cast(bf16x8, pw);
            const int k0 = 32 * s + 4 * g + tq4;
#pragma unroll
            for (int db = 0; db < 16; ++db) {
                const s16x4 lo = trrd(RA + k0 * 544 + (16 * db + 4 * tp4) * 2), hi = trrd(RA + (k0 + 16) * 544 + (16 * db + 4 * tp4) * 2);
                oacc[db] = mfma16(cat8(lo, hi), pb, oacc[db]);
            }
        }
    }
    float s1 = 0.f;
#pragma unroll
    for (int db = 0; db < 16; ++db) s1 += (oacc[db][0] + oacc[db][1]) + (oacc[db][2] + oacc[db][3]);
    s1 += __shfl_xor(s1, 16); s1 += __shfl_xor(s1, 32);
    const float mean = s1 * (1.0f / 256.0f);
    float s2 = 0.f;
#pragma unroll
    for (int db = 0; db < 16; ++db)
#pragma unroll
        for (int rg = 0; rg < 4; ++rg) { const float dd = oacc[db][rg] - mean; s2 += dd * dd; }
    s2 += __shfl_xor(s2, 16); s2 += __shfl_xor(s2, 32);
    const float rstd = rsqrtf(s2 * (1.0f / 256.0f) + LN_EPS);
    const bf16_t* rgp = proj + (size_t)qi * DIN + OFF_RG + h * 256 + 4 * g;
    bf16_t* yc = (bf16_t*)(ws + WS_YC) + ((size_t)b * SEQ + c * 128 + qi) * 1024 + h * 256 + 4 * g;
#pragma unroll
    for (int db = 0; db < 16; ++db) {
        const u32x2 gw = *(const u32x2*)(rgp + 16 * db);
        const float g0 = bflo(gw.x), g1 = bfhi(gw.x), g2 = bflo(gw.y), g3 = bfhi(gw.y);
        u32x2 o;
        o.x = pk2(g0 * sigm(g0) * (oacc[db][0] - mean) * rstd, g1 * sigm(g1) * (oacc[db][1] - mean) * rstd);
        o.y = pk2(g2 * sigm(g2) * (oacc[db][2] - mean) * rstd, g3 * sigm(g3) * (oacc[db][3] - mean) * rstd);
        *(u32x2*)(yc + 16 * db) = o;
    }
    __syncthreads();
}

struct EpiBranch {
    static constexpr bool PERM = false, AFTER_DRAIN = false;
    const bf16_t* gate; float* mf; bf16_t* mb; int mode;
    __device__ __forceinline__ void operator()(const f32x4 (&acc)[2][2][4][2], const pg8::Unit& u, int wr, int wc, int fr, int fq) const {
        const int row0 = u.pm * 256 + wr * 64 + fr, col0 = u.pn * 256 + wc * 32 + 4 * fq;
#pragma unroll
        for (int ai = 0; ai < 2; ++ai)
#pragma unroll
            for (int m = 0; m < 4; ++m) {
                const size_t row = (size_t)(row0 + ai * 128 + m * 16);
#pragma unroll
                for (int bj = 0; bj < 2; ++bj)
#pragma unroll
                    for (int n = 0; n < 2; ++n) {
                        const int col = col0 + bj * 128 + n * 16;
                        const u32x2 gw = *(const u32x2*)(gate + row * DIN + col);
                        f32x4 v = acc[ai][bj][m][n];
                        v[0] *= sigm(bflo(gw.x)); v[1] *= sigm(bfhi(gw.x)); v[2] *= sigm(bflo(gw.y)); v[3] *= sigm(bfhi(gw.y));
                        float* mp = mf + row * 1024 + col;
                        if (mode == 0) *(f32x4*)mp = v;
                        else if (mode == 1) *(f32x4*)mp = *(const f32x4*)mp + v;
                        else { const f32x4 t = *(const f32x4*)mp + v; u32x2 o; o.x = pk2(t[0], t[1]); o.y = pk2(t[2], t[3]); *(u32x2*)(mb + row * 1024 + col) = o; }
                    }
            }
    }
};
struct EpiOut {
    static constexpr bool PERM = false, AFTER_DRAIN = false;
    const float* xf; float* z;
    __device__ __forceinline__ void operator()(const f32x4 (&acc)[2][2][4][2], const pg8::Unit& u, int wr, int wc, int fr, int fq) const {
        const int row0 = u.pm * 256 + wr * 64 + fr, col0 = u.pn * 256 + wc * 32 + 4 * fq;
#pragma unroll
        for (int ai = 0; ai < 2; ++ai)
#pragma unroll
            for (int m = 0; m < 4; ++m) {
                const size_t row = (size_t)(row0 + ai * 128 + m * 16);
#pragma unroll
                for (int bj = 0; bj < 2; ++bj)
#pragma unroll
                    for (int n = 0; n < 2; ++n) { const int col = col0 + bj * 128 + n * 16; *(f32x4*)(z + row * 1024 + col) = *(const f32x4*)(xf + row * 1024 + col) * ALPHA + acc[ai][bj][m][n]; }
            }
    }
};

DI void ln_row(const float* z, const float* gam, const float* bet, float* of, bf16_t* ob, int lane) {
    f32x4 v[4]; float s = 0.f;
#pragma unroll
    for (int i = 0; i < 4; ++i) { v[i] = *(const f32x4*)(z + 256 * i + 4 * lane); s += (v[i][0] + v[i][1]) + (v[i][2] + v[i][3]); }
    const float mean = wsum(s) * (1.0f / 1024.0f);
    float q = 0.f;
#pragma unroll
    for (int i = 0; i < 4; ++i)
#pragma unroll
        for (int j = 0; j < 4; ++j) { const float d = v[i][j] - mean; q += d * d; }
    const float rstd = rsqrtf(wsum(q) * (1.0f / 1024.0f) + LN_EPS);
#pragma unroll
    for (int i = 0; i < 4; ++i) {
        const f32x4 gg = *(const f32x4*)(gam + 256 * i + 4 * lane), bb = *(const f32x4*)(bet + 256 * i + 4 * lane);
        f32x4 o;
#pragma unroll
        for (int j = 0; j < 4; ++j) o[j] = (v[i][j] - mean) * rstd * gg[j] + bb[j];
        *(f32x4*)(of + 256 * i + 4 * lane) = o;
        u32x2 pb; pb.x = pk2(o[0], o[1]); pb.y = pk2(o[2], o[3]); *(u32x2*)(ob + 256 * i + 4 * lane) = pb;
    }
}
DI void phase_ln1(const Args& a, int layer) {
    unsigned char* ws = a.ws;
    const int lane = mk_tid() & 63, w = mk_tid() >> 6;
    for (int u = blockIdx.x; u < NTOK / 8; u += gridDim.x) {
        const size_t row = (size_t)u * 8 + w;
        ln_row((const float*)(ws + WS_MRGF) + row * 1024, a.in[11] + layer * 1024, a.in[12] + layer * 1024, (float*)(ws + WS_XF) + row * 1024, (bf16_t*)(ws + WS_XB) + row * 1024, lane);
    }
}

DI void ins16(float (&L)[16], float x) {
#pragma unroll
    for (int k = 0; k < 16; ++k) { const float hi = fmaxf(L[k], x); x = fminf(L[k], x); L[k] = hi; }
}
DI void merge16(float (&L)[16], int xr) {
    float t[16];
#pragma unroll
    for (int k = 0; k < 16; ++k) t[k] = __shfl_xor(L[k], xr);
#pragma unroll
    for (int k = 0; k < 8; ++k) { const float x = t[k]; t[k] = t[15 - k]; t[15 - k] = x; }
#pragma unroll
    for (int k = 0; k < 16; ++k) t[k] = fmaxf(L[k], t[k]);
#define MK_CE_STAGE(dd) _Pragma("unroll") for (int k = 0; k < 16; ++k) if ((k & (dd)) == 0) { const float hi = fmaxf(t[k], t[k + (dd)]), lo = fminf(t[k], t[k + (dd)]); t[k] = hi; t[k + (dd)] = lo; }
    MK_CE_STAGE(8) MK_CE_STAGE(4) MK_CE_STAGE(2) MK_CE_STAGE(1)
#undef MK_CE_STAGE
#pragma unroll
    for (int k = 0; k < 16; ++k) L[k] = t[k];
}
DI float sel16(const float (&L)[16], unsigned idx) {
    float r = L[0];
#pragma unroll
    for (int k = 1; k < 16; ++k) r = (idx == (unsigned)k) ? L[k] : r;
    return r;
}
DI void top16_half(const bf16_t* qp, const bf16_t* kb, float (&L)[16], int g, int l15) {
    bf16x8 qf[4];
#pragma unroll
    for (int ks = 0; ks < 4; ++ks) qf[ks] = *(const bf16x8*)(qp + 32 * ks + 8 * g);
#pragma unroll
    for (int k = 0; k < 16; ++k) L[k] = -FLT_MAX;
#pragma unroll
    for (int kbk = 0; kbk < 8; ++kbk) {
        f32x4 acc = {0.f, 0.f, 0.f, 0.f};
#pragma unroll
        for (int ks = 0; ks < 4; ++ks) { const bf16x8 kf = *(const bf16x8*)(kb + (size_t)(16 * kbk + l15) * 128 + 32 * ks + 8 * g); acc = mfma16(kf, qf[ks], acc); }
#pragma unroll
        for (int rg = 0; rg < 4; ++rg) { const unsigned key = (unsigned)(16 * kbk + 4 * g + rg); ins16(L, __uint_as_float((__float_as_uint(acc[rg]) & ~0x7Fu) | key)); }
    }
    merge16(L, 16); merge16(L, 32);
}
DI void topk_unit(const Args& a, int unit, LAS unsigned char* lds) {
    unsigned char* ws = a.ws;
    const int tid = mk_tid(), lane = tid & 63, w = __builtin_amdgcn_readfirstlane(tid >> 6), g = lane >> 4, l15 = lane & 15;
    const int tg = w & 3, hs = w >> 2;
    const size_t t = (size_t)unit * 64 + tg * 16 + l15;
    const bf16_t* Q = (const bf16_t*)(ws + WS_Q);
    float K1[16], K2[16];
#pragma unroll
    for (int k = 0; k < 16; ++k) { K1[k] = 0.f; K2[k] = 0.f; }
#pragma unroll 1
    for (int hh = 0; hh < 4; ++hh) {
        const int h = hs * 4 + hh;
        float l1[16], l2[16];
        top16_half(Q + t * 2048 + h * 256, (const bf16_t*)(ws + WS_K1B) + (size_t)h * 16384, l1, g, l15);
        top16_half(Q + t * 2048 + h * 256 + 128, (const bf16_t*)(ws + WS_K2B) + (size_t)h * 16384, l2, g, l15);
        const bool mine = (g == hh);
#pragma unroll
        for (int k = 0; k < 16; ++k) { K1[k] = mine ? l1[k] : K1[k]; K2[k] = mine ? l2[k] : K2[k]; }
    }
    const int h = hs * 4 + g;
    float F[16];
#pragma unroll
    for (int k = 0; k < 16; ++k) F[k] = -FLT_MAX;
#pragma unroll
    for (int ia = 0; ia < 16; ++ia)
#pragma unroll
        for (int ib = 0; ib < 16 / (ia + 1); ++ib) {
            const float s = __uint_as_float(__float_as_uint(K1[ia]) & ~0x7Fu) + __uint_as_float(__float_as_uint(K2[ib]) & ~0x7Fu);
            ins16(F, __uint_as_float((__float_as_uint(s) & ~0xFFu) | (unsigned)(ia * 16 + ib)));
        }
    LAS int* row = (LAS int*)lds + tid * 33;
#pragma unroll
    for (int k = 0; k < 16; ++k) { row[k] = (int)(__float_as_uint(K1[k]) & 0x7Fu); row[16 + k] = (int)(__float_as_uint(K2[k]) & 0x7Fu); }
    float gt[16]; int ei[16]; float gs = 0.f;
    const float cv0 = __uint_as_float(__float_as_uint(F[0]) & ~0xFFu);
#pragma unroll
    for (int k = 0; k < 16; ++k) {
        const unsigned bits = __float_as_uint(F[k]);
        const float cv = __uint_as_float(bits & ~0xFFu);
        gt[k] = __expf(cv - cv0); gs += gt[k];
        const int ia = (int)((bits >> 4) & 15u), ib = (int)(bits & 15u);
        ei[k] = row[ia] * 128 + row[16 + ib];
    }
    const float ig = 1.0f / gs;
    int* ep = (int*)(ws + WS_EID) + (t * 8 + h) * 16; float* gp = (float*)(ws + WS_GATE) + (t * 8 + h) * 16;
#pragma unroll
    for (int q = 0; q < 4; ++q) {
        *(i32x4*)(ep + 4 * q) = (i32x4){ei[4 * q], ei[4 * q + 1], ei[4 * q + 2], ei[4 * q + 3]};
        *(f32x4*)(gp + 4 * q) = (f32x4){gt[4 * q] * ig, gt[4 * q + 1] * ig, gt[4 * q + 2] * ig, gt[4 * q + 3] * ig};
    }
}

DI void peer_half(const bf16_t* UB, const bf16_t* VB, int ereg, float greg, const u32x4& xa, const u32x4& xb, float (&y)[16], int lane) {
#pragma unroll 1
    for (int k = 0; k < 64; k += 4) {
        int ee[4]; float gg[4]; u32x4 ua[4], ub[4], va[4], vb[4];
#pragma unroll
        for (int j = 0; j < 4; ++j) { ee[j] = __builtin_amdgcn_readlane(ereg, k + j); gg[j] = __uint_as_float(__builtin_amdgcn_readlane(__float_as_uint(greg), k + j)); }
#pragma unroll
        for (int j = 0; j < 4; ++j) {
            const bf16_t* up = UB + (size_t)ee[j] * 1024 + 8 * lane; const bf16_t* vp = VB + (size_t)ee[j] * 1024 + 8 * lane;
            ua[j] = *(const u32x4*)up; ub[j] = *(const u32x4*)(up + 512); va[j] = *(const u32x4*)vp; vb[j] = *(const u32x4*)(vp + 512);
        }
#pragma unroll
        for (int j = 0; j < 4; ++j) {
            float p = 0.f;
#pragma unroll
            for (int q = 0; q < 4; ++q) { p = dot2(ua[j][q], xa[q], p); p = dot2(ub[j][q], xb[q], p); }
            p = wsum(p);
            const float act = gelu_erf(p) * gg[j];
#pragma unroll
            for (int q = 0; q < 4; ++q) { y[2 * q] += act * bflo(va[j][q]); y[2 * q + 1] += act * bfhi(va[j][q]); y[8 + 2 * q] += act * bflo(vb[j][q]); y[8 + 2 * q + 1] += act * bfhi(vb[j][q]); }
        }
    }
}
DI void peer_unit(const Args& a, int layer, int unit) {
    unsigned char* ws = a.ws;
    const int lane = mk_tid() & 63, w = __builtin_amdgcn_readfirstlane(mk_tid() >> 6);
    const bf16_t* UB = (const bf16_t*)(ws + WS_UB); const bf16_t* VB = (const bf16_t*)(ws + WS_VB);
    const float* gam = a.in[18] + layer * 1024; const float* bet = a.in[19] + layer * 1024;
    const f32x4 ga0 = *(const f32x4*)(gam + 8 * lane), ga1 = *(const f32x4*)(gam + 8 * lane + 4), ga2 = *(const f32x4*)(gam + 512 + 8 * lane), ga3 = *(const f32x4*)(gam + 512 + 8 * lane + 4);
    const f32x4 be0 = *(const f32x4*)(bet + 8 * lane), be1 = *(const f32x4*)(bet + 8 * lane + 4), be2 = *(const f32x4*)(bet + 512 + 8 * lane), be3 = *(const f32x4*)(bet + 512 + 8 * lane + 4);
#pragma unroll 1
    for (int i = 0; i < 8; ++i) {
        const size_t t = (size_t)unit * 64 + w * 8 + i;
        bf16_t* xbp = (bf16_t*)(ws + WS_XB) + t * 1024; float* xfp = (float*)(ws + WS_XF) + t * 1024;
        const u32x4 xa = *(const u32x4*)(xbp + 8 * lane), xb = *(const u32x4*)(xbp + 512 + 8 * lane);
        const int* ep = (const int*)(ws + WS_EID) + t * 128; const float* gp = (const float*)(ws + WS_GATE) + t * 128;
        const int e0 = ep[lane], e1 = ep[64 + lane]; const float g0 = gp[lane], g1 = gp[64 + lane];
        float y[16];
#pragma unroll
        for (int q = 0; q < 16; ++q) y[q] = 0.f;
        peer_half(UB, VB, e0, g0, xa, xb, y, lane);
        peer_half(UB, VB, e1, g1, xa, xb, y, lane);
        const f32x4 x0 = *(const f32x4*)(xfp + 8 * lane), x1 = *(const f32x4*)(xfp + 8 * lane + 4), x2 = *(const f32x4*)(xfp + 512 + 8 * lane), x3 = *(const f32x4*)(xfp + 512 + 8 * lane + 4);
        float z[16]; float s = 0.f;
#pragma unroll
        for (int q = 0; q < 4; ++q) { z[q] = ALPHA * x0[q] + y[q]; z[4 + q] = ALPHA * x1[q] + y[4 + q]; z[8 + q] = ALPHA * x2[q] + y[8 + q]; z[12 + q] = ALPHA * x3[q] + y[12 + q]; }
#pragma unroll
        for (int q = 0; q < 16; ++q) s += z[q];
        const float mean = wsum(s) * (1.0f / 1024.0f);
        float qq = 0.f;
#pragma unroll
        for (int q = 0; q < 16; ++q) { const float d = z[q] - mean; qq += d * d; }
        const float rstd = rsqrtf(wsum(qq) * (1.0f / 1024.0f) + LN_EPS);
        f32x4 o0, o1, o2, o3;
#pragma unroll
        for (int q = 0; q < 4; ++q) { o0[q] = (z[q] - mean) * rstd * ga0[q] + be0[q]; o1[q] = (z[4 + q] - mean) * rstd * ga1[q] + be1[q]; o2[q] = (z[8 + q] - mean) * rstd * ga2[q] + be2[q]; o3[q] = (z[12 + q] - mean) * rstd * ga3[q] + be3[q]; }
        *(f32x4*)(xfp + 8 * lane) = o0; *(f32x4*)(xfp + 8 * lane + 4) = o1; *(f32x4*)(xfp + 512 + 8 * lane) = o2; *(f32x4*)(xfp + 512 + 8 * lane + 4) = o3;
        if (layer == DEPTH - 1) { float* op = a.out + t * 1024; *(f32x4*)(op + 8 * lane) = o0; *(f32x4*)(op + 8 * lane + 4) = o1; *(f32x4*)(op + 512 + 8 * lane) = o2; *(f32x4*)(op + 512 + 8 * lane + 4) = o3; }
        u32x4 p0, p1; p0.x = pk2(o0[0], o0[1]); p0.y = pk2(o0[2], o0[3]); p0.z = pk2(o1[0], o1[1]); p0.w = pk2(o1[2], o1[3]); p1.x = pk2(o2[0], o2[1]); p1.y = pk2(o2[2], o2[3]); p1.z = pk2(o3[0], o3[1]); p1.w = pk2(o3[2], o3[3]);
        *(u32x4*)(xbp + 8 * lane) = p0; *(u32x4*)(xbp + 512 + 8 * lane) = p1;
    }
}
}

namespace mk {
constexpr int LDS_ARG_OFF = LDS_BYTES - 16 - 256;
#define MK_NOINL __device__ __forceinline__
DI Args load_args(LAS unsigned char* lds) {
    int aoff = LDS_ARG_OFF; asm volatile("" : "+s"(aoff));
    Args a; const LAS unsigned long long* p = (const LAS unsigned long long*)(lds + aoff);
#pragma unroll
    for (int i = 0; i < 20; ++i) a.in[i] = (const float*)(const __attribute__((address_space(1))) float*)p[i];
    a.out = (float*)(__attribute__((address_space(1))) float*)p[20]; a.ws = (unsigned char*)(__attribute__((address_space(1))) unsigned char*)p[21]; a.ropeA = __longlong_as_double((long long)p[22]); a.ropeR = __longlong_as_double((long long)p[23]); a.ph_lo = 0; a.ph_hi = 0;
    return a;
}
#define MK_LOADARGS const Args a = load_args(lds); unsigned char* ws = a.ws; const int G = (int)gridDim.x, bid = (int)blockIdx.x; (void)ws; (void)G; (void)bid
MK_NOINL void PG_prologue(LAS unsigned char* lds) { MK_LOADARGS; phase_prologue(a); }
MK_NOINL void P0_conv(LAS unsigned char* lds, int layer) { MK_LOADARGS; phase_conv(a, layer, lds); }
MK_NOINL void P1_inproj(LAS unsigned char* lds, int layer) { MK_LOADARGS; (void)layer;
    pg8::Gemm gm; gm.A = (const bf16_t*)(ws + WS_XB); gm.Bt = (const bf16_t*)(ws + WS_WINT); gm.M = NTOK; gm.N = DIN; gm.K = 1024;
    pg8::StaticOrder S; S.init(NTOK, DIN, G, bid);
    pg8::EpiBf16<0> E; E.O = (bf16_t*)(ws + WS_PROJ); E.ldc = DIN; E.bias = nullptr; E.split_cols = 0; E.split_stride = 0;
    pg8::gemm_phase<pg8::EpiBf16<0>, pg8::StaticOrder, false>(lds, gm, S, E, nullptr); }
MK_NOINL void P2_rope(LAS unsigned char* lds, int layer) { MK_LOADARGS; (void)layer; phase_rope(a); }
MK_NOINL void P3a_attn(LAS unsigned char* lds, int layer) { MK_LOADARGS; (void)layer; for (int u = bid; u < 1536; u += G) attn_unit(a, u, lds); }
MK_NOINL void P3b_retkv(LAS unsigned char* lds, int layer) { MK_LOADARGS; (void)layer; for (int u = bid; u < 512; u += G) retkv_unit(a, u, lds); }
MK_NOINL void P3c_lru(LAS unsigned char* lds, int layer, int fin) { MK_LOADARGS; for (int u = bid; u < 2048; u += G) lru_unit(a, layer, u, fin != 0, lds); }
MK_NOINL void P4_scan_merge(LAS unsigned char* lds, int layer) { MK_LOADARGS; (void)layer;
    for (int u = bid; u < 256; u += G) retscan_unit(a, u);
    for (int u = bid; u < 2048; u += G) attmerge_unit(a, u); }
MK_NOINL void P5_retout(LAS unsigned char* lds, int layer) { MK_LOADARGS; (void)layer; for (int u = bid; u < 512; u += G) retout_unit(a, u, lds); }
MK_NOINL void P6_branch(LAS unsigned char* lds, int layer) { MK_LOADARGS; (void)layer;
#pragma unroll 1
    for (int s = 0; s < 3; ++s) {
        pg8::Gemm gm; gm.A = (const bf16_t*)(ws + (s == 0 ? WS_YA : (s == 1 ? WS_YB : WS_YC))); gm.Bt = (const bf16_t*)(ws + (s == 0 ? WS_WBAT : (s == 1 ? WS_WBBT : WS_WBCT)));
        gm.M = NTOK; gm.N = 1024; gm.K = (s == 0) ? 512 : 1024;
        pg8::StaticOrder S; S.init(NTOK, 1024, G, bid);
        EpiBranch E; E.gate = (const bf16_t*)(ws + WS_PROJ) + OFF_GA + 1024 * s; E.mf = (float*)(ws + WS_MRGF); E.mb = (bf16_t*)(ws + WS_MRGB); E.mode = s;
        pg8::gemm_phase<EpiBranch, pg8::StaticOrder, false>(lds, gm, S, E, nullptr);
    } }
MK_NOINL void P7_outproj(LAS unsigned char* lds, int layer) { MK_LOADARGS; (void)layer;
    pg8::Gemm gm; gm.A = (const bf16_t*)(ws + WS_MRGB); gm.Bt = (const bf16_t*)(ws + WS_WOT); gm.M = NTOK; gm.N = 1024; gm.K = 1024;
    pg8::StaticOrder S; S.init(NTOK, 1024, G, bid);
    EpiOut E; E.xf = (const float*)(ws + WS_XF); E.z = (float*)(ws + WS_MRGF);
    pg8::gemm_phase<EpiOut, pg8::StaticOrder, false>(lds, gm, S, E, nullptr); }
MK_NOINL void P8_ln1(LAS unsigned char* lds, int layer) { MK_LOADARGS; phase_ln1(a, layer); }
MK_NOINL void P9_wq(LAS unsigned char* lds, int layer) { MK_LOADARGS; (void)layer;
    pg8::Gemm gm; gm.A = (const bf16_t*)(ws + WS_XB); gm.Bt = (const bf16_t*)(ws + WS_WQT); gm.M = NTOK; gm.N = 2048; gm.K = 1024;
    pg8::StaticOrder S; S.init(NTOK, 2048, G, bid);
    pg8::EpiBf16<0> E; E.O = (bf16_t*)(ws + WS_Q); E.ldc = 2048; E.bias = nullptr; E.split_cols = 0; E.split_stride = 0;
    pg8::gemm_phase<pg8::EpiBf16<0>, pg8::StaticOrder, false>(lds, gm, S, E, nullptr); }
MK_NOINL void P10_topk(LAS unsigned char* lds, int layer) { MK_LOADARGS; (void)layer; for (int u = bid; u < NTOK / 64; u += G) topk_unit(a, u, lds); }
MK_NOINL void P11_peer(LAS unsigned char* lds, int layer) { MK_LOADARGS; for (int u = bid; u < NTOK / 64; u += G) peer_unit(a, layer, u); }
}

#ifndef MK_PHASE_MASK
#define MK_PHASE_MASK 0xFFFu
#endif
#define MK_RUN(k) ((((MK_PHASE_MASK) >> ((k) - pb)) & 1u) && (k) >= ph_lo && (k) < ph_hi)
#define MK_NPHASES (1 + mk::DEPTH * mk::NPH)
#define MK_SYNC(k) do { if ((k) >= ph_lo && (k) + 1 < ph_hi) xcd_barrier(bar); } while (0)
__global__ __launch_bounds__(512, 2) void mk_fwd(mk::Args a) {
    using namespace mk;
    extern __shared__ __attribute__((aligned(16))) unsigned char smem_raw[];
    LAS unsigned char* lds = (LAS unsigned char*)smem_raw;
    const int ph_lo = a.ph_lo, ph_hi = a.ph_hi;
    {
        const unsigned* src = (const unsigned*)&a;
        if (threadIdx.x < sizeof(Args) / 4) ((LAS unsigned*)(lds + LDS_ARG_OFF))[threadIdx.x] = src[threadIdx.x];
        if (threadIdx.x == 0) { LAS unsigned* st = (LAS unsigned*)(lds + LDS_BAR_OFF); st[0] = 0u; st[1] = 0u; st[2] = 0u; st[3] = 0u; }
    }
    __syncthreads();
    XcdBarrier bar; bar.bar = (unsigned*)(a.ws + WS_CTL); bar.x = 0u; bar.st = (volatile LAS unsigned*)(lds + LDS_BAR_OFF);
    if (ph_hi - ph_lo > 1) bar = xcd_barrier_post((unsigned*)(a.ws + WS_CTL), (volatile LAS unsigned*)(lds + LDS_BAR_OFF));
    if (0 >= ph_lo && 0 < ph_hi) PG_prologue(lds);
    MK_SYNC(0);
#pragma unroll 1
    for (int layer = 0; layer < DEPTH; ++layer) {
        const int pb = 1 + layer * NPH;
        if (MK_RUN(pb + 0)) P0_conv(lds, layer);
        MK_SYNC(pb + 0);
        if (MK_RUN(pb + 1)) P1_inproj(lds, layer);
        MK_SYNC(pb + 1);
        if (MK_RUN(pb + 2)) P2_rope(lds, layer);
        MK_SYNC(pb + 2);
        if (MK_RUN(pb + 3)) { P3a_attn(lds, layer); P3b_retkv(lds, layer); P3c_lru(lds, layer, 0); }
        MK_SYNC(pb + 3);
        if (MK_RUN(pb + 4)) { P4_scan_merge(lds, layer); P3c_lru(lds, layer, 1); }
        MK_SYNC(pb + 4);
        if (MK_RUN(pb + 5)) P5_retout(lds, layer);
        MK_SYNC(pb + 5);
        if (MK_RUN(pb + 6)) P6_branch(lds, layer);
        MK_SYNC(pb + 6);
        if (MK_RUN(pb + 7)) P7_outproj(lds, layer);
        MK_SYNC(pb + 7);
        if (MK_RUN(pb + 8)) P8_ln1(lds, layer);
        MK_SYNC(pb + 8);
        if (MK_RUN(pb + 9)) P9_wq(lds, layer);
        MK_SYNC(pb + 9);
        if (MK_RUN(pb + 10)) P10_topk(lds, layer);
        MK_SYNC(pb + 10);
        if (MK_RUN(pb + 11)) P11_peer(lds, layer);
        MK_SYNC(pb + 11);
    }
}

#ifndef MK_SINGLE
#define MK_SINGLE 0
#endif
extern "C" void kernel_launch(void* const* d_in, const int* in_sizes, int n_in, void* d_out, int out_size, void* d_ws, size_t ws_size, hipStream_t stream) {
    using namespace mk;
    static int grid = 0;
    if (grid == 0) {
        if (n_in != 20 || out_size != NTOK * D || ws_size < WS_END) { fprintf(stderr, "kernel_launch: unexpected shapes (n_in %d, out %d, ws %zu, need %zu)\n", n_in, out_size, ws_size, (size_t)WS_END); grid = -1; return; }
        int dev = 0, cus = 0, per_cu = 0;
        if (hipGetDevice(&dev) != hipSuccess || hipDeviceGetAttribute(&cus, hipDeviceAttributeMultiprocessorCount, dev) != hipSuccess) { grid = -1; return; }
        if (hipFuncSetAttribute((const void*)mk_fwd, hipFuncAttributeMaxDynamicSharedMemorySize, LDS_BYTES) != hipSuccess) { fprintf(stderr, "kernel_launch: hipFuncSetAttribute failed\n"); grid = -1; return; }
        if (hipOccupancyMaxActiveBlocksPerMultiprocessor(&per_cu, (const void*)mk_fwd, 512, LDS_BYTES) != hipSuccess || per_cu < 1) { fprintf(stderr, "kernel_launch: occupancy query says %d blocks per CU\n", per_cu); (void)hipGetLastError(); grid = -1; return; }
        grid = cus;
    }
    if (grid < 0) return;
    (void)in_sizes;
    Args a{};
    for (int i = 0; i < 20; ++i) a.in[i] = (const float*)d_in[i];
    a.out = (float*)d_out; a.ws = (unsigned char*)d_ws;
    a.ropeA = pow(10000.0, -2.0 / 128.0); a.ropeR = pow(10000.0, -2.0 / 256.0);
#if MK_SINGLE
    (void)hipMemsetAsync((unsigned char*)d_ws + WS_CTL, 0, 16384, stream);
    a.ph_lo = 0; a.ph_hi = MK_NPHASES;
    hipLaunchKernelGGL(mk_fwd, dim3(grid), dim3(512), LDS_BYTES, stream, a);
#else
    for (int p = 0; p < MK_NPHASES; ++p) { a.ph_lo = p; a.ph_hi = p + 1; hipLaunchKernelGGL(mk_fwd, dim3(grid), dim3(512), LDS_BYTES, stream, a); }
#endif
}
```

```cpp
#include <hip/hip_runtime.h>
#include <cstdio>
#include <cstdint>
#include <cmath>
#include <cfloat>
__device__ __forceinline__ int mk_tid() { int t = (int)threadIdx.x; asm volatile("" : "+v"(t)); return t; }
namespace pg8 {
#define PG8_LAS __attribute__((address_space(3)))
typedef unsigned short bf16_t;
typedef short bf16x8 __attribute__((ext_vector_type(8)));
typedef float f32x4 __attribute__((ext_vector_type(4)));
typedef unsigned u32x4 __attribute__((ext_vector_type(4)));
constexpr int BM = 256, BK = 64, HALF = 128, HTB = HALF * BK * 2  , STAGE_BYTES = 8 * HTB, NXCD = 8, WGM = 8;

__host__ __device__ __forceinline__ int lds_byte(int r, int c) { const int st = (r >> 4) * 2 + (c >> 5), rr = r & 15, cc = c & 31, ob = rr * 64 + cc * 2; return st * 1024 + (ob ^ (((ob >> 9) & 1) << 5)); }
__host__ __device__ __forceinline__ void stage_rc(int b, int& R, int& C) { const int st = b / 1024, sb = b % 1024, swz = sb ^ (((sb >> 9) & 1) << 5); R = (st >> 1) * 16 + swz / 64; C = (st & 1) * 32 + (swz % 64) / 2; }
__host__ __device__ __forceinline__ int perm32(int rho) { const int n = rho >> 4, i = rho & 15; return 8 * (i >> 2) + 4 * n + (i & 3); }

struct Unit { int pm, pn; };
struct Gemm { const bf16_t* A; const bf16_t* Bt; int M, N, K; };

struct StaticOrder {
    int nM, nN, nwg, G, c;
    __host__ __device__ void init(int M, int N, int G_, int c_) { nM = M / BM; nN = N / BM; nwg = nM * nN; G = G_; c = c_; }
    __host__ __device__ bool next(int i, Unit& u) const {
        const long L = (long)i * G + c; if (L >= nwg) return false;
        int wgid = (int)L; { const int q = nwg / NXCD, r = nwg % NXCD, xcd = wgid % NXCD, off = wgid / NXCD; wgid = (xcd < r ? xcd * (q + 1) : r * (q + 1) + (xcd - r) * q) + off; }
        const int nig = WGM * nN, gid = wgid / nig, fm = gid * WGM, gsz = (nM - fm) < WGM ? (nM - fm) : WGM;
        u.pm = fm + ((wgid % nig) % gsz); u.pn = (wgid % nig) / gsz; return true;
    }
    __device__ __forceinline__ void a_ready(const Unit&) const {}
    __device__ __forceinline__ void done(const Unit&) const {}
};
__device__ __forceinline__ unsigned cvt_pk_bf16(float lo, float hi) { unsigned r; asm volatile("v_cvt_pk_bf16_f32 %0, %1, %2" : "=v"(r) : "v"(lo), "v"(hi)); return r; }
typedef float f32x2 __attribute__((ext_vector_type(2)));
__device__ __forceinline__ f32x2 gelu_pk(f32x2 v) {
    const f32x2 av = __builtin_elementwise_abs(v), d = av * 0.2316418882f + 1.0f;
    f32x2 t; t.x = __builtin_amdgcn_rcpf(d.x); t.y = __builtin_amdgcn_rcpf(d.y);
    f32x2 q = t * 0.5307027145f + (-0.7265760135f); q = q * t + 0.7107068705f; q = q * t + (-0.142248368f); q = q * t + 0.127414796f; q = q * t;
    const f32x2 s = (v * v) * (-0.72134752044f);
    f32x2 e; e.x = __builtin_amdgcn_exp2f(s.x); e.y = __builtin_amdgcn_exp2f(s.y);
    const f32x2 m = v * (q * e), r = v - m;
    f32x2 o; o.x = v.x < 0.f ? m.x : r.x; o.y = v.y < 0.f ? m.y : r.y; return o;
}

struct EpiF32 {
    static constexpr bool PERM = false, AFTER_DRAIN = false;
    float* C; int ldc; const float* bias;
    __device__ __forceinline__ void operator()(const f32x4 (&acc)[2][2][4][2], const Unit& u, int wr, int wc, int fr, int fq) const {
        const int row0 = u.pm * BM + wr * 64 + fr, col0 = u.pn * BM + wc * 32 + 4 * fq;
        f32x4 bv[2][2];
#pragma unroll
        for (int bj = 0; bj < 2; ++bj)
#pragma unroll
            for (int n = 0; n < 2; ++n) bv[bj][n] = bias ? *(const f32x4*)(bias + col0 + bj * HALF + n * 16) : (f32x4){0.f, 0.f, 0.f, 0.f};
#pragma unroll
        for (int ai = 0; ai < 2; ++ai)
#pragma unroll
            for (int m = 0; m < 4; ++m) { float* rowp = C + (size_t)(row0 + ai * HALF + m * 16) * ldc + col0;
#pragma unroll
                for (int bj = 0; bj < 2; ++bj)
#pragma unroll
                    for (int n = 0; n < 2; ++n) *(f32x4*)(rowp + bj * HALF + n * 16) = acc[ai][bj][m][n] + bv[bj][n]; }
    }
};
template <int ACT  > struct EpiBf16 {
    static constexpr bool PERM = true, AFTER_DRAIN = false;
    bf16_t* O; int ldc; const float* bias; int split_cols; size_t split_stride;
    __device__ __forceinline__ void operator()(const f32x4 (&acc)[2][2][4][2], const Unit& u, int wr, int wc, int fr, int fq) const {
        const int row0 = u.pm * BM + wr * 64 + fr; int colt = u.pn * BM; bf16_t* base = O;
        if (split_cols) { const int t = colt / split_cols; base += (size_t)t * split_stride; colt -= t * split_cols; }
        const int col0 = colt + wc * 32 + 8 * fq, bcol0 = u.pn * BM + wc * 32 + 8 * fq;
        f32x4 bv[2][2];
#pragma unroll
        for (int bj = 0; bj < 2; ++bj)
#pragma unroll
            for (int n = 0; n < 2; ++n) bv[bj][n] = bias ? *(const f32x4*)(bias + bcol0 + bj * HALF + 4 * n) : (f32x4){0.f, 0.f, 0.f, 0.f};
#pragma unroll
        for (int ai = 0; ai < 2; ++ai)
#pragma unroll
            for (int m = 0; m < 4; ++m) { bf16_t* rowp = base + (size_t)(row0 + ai * HALF + m * 16) * ldc + col0;
#pragma unroll
                for (int bj = 0; bj < 2; ++bj) { f32x4 v0 = acc[ai][bj][m][0] + bv[bj][0], v1 = acc[ai][bj][m][1] + bv[bj][1];
                    if (ACT == 1) { f32x2 a = gelu_pk((f32x2){v0[0], v0[1]}), b = gelu_pk((f32x2){v0[2], v0[3]}), c = gelu_pk((f32x2){v1[0], v1[1]}), d = gelu_pk((f32x2){v1[2], v1[3]});
                        v0 = (f32x4){a.x, a.y, b.x, b.y}; v1 = (f32x4){c.x, c.y, d.x, d.y}; }
                    if (ACT == 2) {
#pragma unroll
                        for (int j = 0; j < 4; ++j) { v0[j] = 0.5f * v0[j] * (1.0f + erff(v0[j] * 0.70710678f)); v1[j] = 0.5f * v1[j] * (1.0f + erff(v1[j] * 0.70710678f)); } }
                    u32x4 w; w.x = cvt_pk_bf16(v0[0], v0[1]); w.y = cvt_pk_bf16(v0[2], v0[3]); w.z = cvt_pk_bf16(v1[0], v1[1]); w.w = cvt_pk_bf16(v1[2], v1[3]);
                    *(u32x4*)(rowp + bj * HALF) = w; } }
    }
};

template <class Epi, class Sched, bool STAMP = false>
__device__ __forceinline__ void gemm_phase(PG8_LAS unsigned char* lds, const Gemm g, const Sched& S, const Epi& E, unsigned long long* stamps) {
    const int tid = mk_tid(), wid = __builtin_amdgcn_readfirstlane(tid >> 6), lane = tid & 63, wr = wid >> 2, wc = wid & 3, fr = lane & 15, fq = lane >> 4;
    const int K = g.K, nt = K / BK;
    int ts_lo = 0, ts_hi = 0, nts = 0; const unsigned long long rt_entry = STAMP ? (unsigned long long)wall_clock64() : 0ull;
#define PG8_STAMP() do { if (STAMP && wid == 0 && nts < 64) { const unsigned long long _c = (unsigned long long)clock64(); \
        ts_lo = (lane == nts) ? (int)(unsigned)_c : ts_lo; ts_hi = (lane == nts) ? (int)(unsigned)(_c >> 32) : ts_hi; ++nts; } } while (0)
    PG8_STAMP();
    unsigned voffA[2], voffB[2];
#pragma unroll
    for (int i = 0; i < 2; ++i) { int R, C; stage_rc(tid * 16 + i * 8192, R, C); const int Rb = Epi::PERM ? ((R & ~31) + perm32(R & 31)) : R;
        voffA[i] = (unsigned)(R * K + C) * 2u; voffB[i] = (unsigned)(Rb * K + C) * 2u; }
    const size_t kstep = (size_t)(BK * 2);
    const size_t hstep = (size_t)HALF * K * 2;
    const size_t tstep = 2 * hstep;
    const unsigned ldsw = (unsigned)wid * 1024u;
    const int aoff = lds_byte(wr * 64 + fr, fq * 8), boff = lds_byte(wc * 32 + fr, fq * 8);
#define PG8_SA(b, h) (((b) * 2 + (h)) * HTB)
#define PG8_SB(b, h) ((4 + (b) * 2 + (h)) * HTB)
#define PG8_STAGE(bufoff, gbase, voff) do { _Pragma("unroll") for (int _i = 0; _i < 2; ++_i) \
        __builtin_amdgcn_global_load_lds((const unsigned*)((const char*)(gbase) + (voff)[_i]), (PG8_LAS unsigned*)(lds + (bufoff) + ldsw + _i * 8192), 16, 0, 0); } while (0)
#define PG8_LDA(dst, b, h) do { _Pragma("unroll") for (int m = 0; m < 4; ++m) _Pragma("unroll") for (int k = 0; k < 2; ++k) dst[m][k] = *(const PG8_LAS bf16x8*)(lds + PG8_SA(b, h) + aoff + m * 2048 + k * 1024); } while (0)
#define PG8_LDB(dst, b, h) do { _Pragma("unroll") for (int n = 0; n < 2; ++n) _Pragma("unroll") for (int k = 0; k < 2; ++k) dst[n][k] = *(const PG8_LAS bf16x8*)(lds + PG8_SB(b, h) + boff + n * 2048 + k * 1024); } while (0)
#define PG8_MMA(ai, bj, At, Bt) do { __builtin_amdgcn_s_setprio(1); _Pragma("unroll") for (int m = 0; m < 4; ++m) _Pragma("unroll") for (int n = 0; n < 2; ++n) _Pragma("unroll") for (int k = 0; k < 2; ++k) \
        acc[ai][bj][m][n] = __builtin_amdgcn_mfma_f32_16x16x32_bf16(Bt[n][k], At[m][k], acc[ai][bj][m][n], 0, 0, 0); __builtin_amdgcn_s_setprio(0); } while (0)
#define PG8_WAIT_V(n) asm volatile("s_waitcnt vmcnt(" #n ")" ::: "memory")
#define PG8_WAIT_L(n) asm volatile("s_waitcnt lgkmcnt(" #n ")" ::: "memory")
#define PG8_BAR __builtin_amdgcn_s_barrier()
#define PG8_SCHED __builtin_amdgcn_sched_barrier(0)
    Unit cur, nxt; int ui = 0;
    if (!S.next(0, cur)) return;
    f32x4 acc[2][2][4][2];
#pragma unroll
    for (int a = 0; a < 2; ++a)
#pragma unroll
        for (int b = 0; b < 2; ++b)
#pragma unroll
            for (int m = 0; m < 4; ++m)
#pragma unroll
                for (int n = 0; n < 2; ++n) acc[a][b][m][n] = (f32x4){0.f, 0.f, 0.f, 0.f};
    bf16x8 At[4][2], B0[2][2], B1[2][2];
    const char* cA = (const char*)g.A + (size_t)cur.pm * tstep; const char* cB = (const char*)g.Bt + (size_t)cur.pn * tstep;
    S.a_ready(cur);
    PG8_STAGE(PG8_SB(0, 0), cB, voffB); PG8_STAGE(PG8_SA(0, 0), cA, voffA); PG8_STAGE(PG8_SB(0, 1), cB + hstep, voffB); PG8_STAGE(PG8_SA(0, 1), cA + hstep, voffA);
    if (wr == 1) PG8_BAR;
    PG8_WAIT_V(4); PG8_BAR;
    PG8_STAGE(PG8_SB(1, 0), cB + kstep, voffB); PG8_STAGE(PG8_SA(1, 0), cA + kstep, voffA); PG8_STAGE(PG8_SB(1, 1), cB + hstep + kstep, voffB);
    PG8_WAIT_V(6); PG8_BAR;
    PG8_STAMP();
    for (;;) {
        const bool has_next = S.next(ui + 1, nxt);
        const char* nA = has_next ? (const char*)g.A + (size_t)nxt.pm * tstep : cA; const char* nB = has_next ? (const char*)g.Bt + (size_t)nxt.pn * tstep : cB;
        for (int t = 0; t < nt; t += 2) {
            const bool last = (t == nt - 2);
            const char* a1 = cA + (size_t)(t + 1) * kstep;
            const char* a2 = last ? nA : cA + (size_t)(t + 2) * kstep; const char* b2 = last ? nB : cB + (size_t)(t + 2) * kstep;
            const char* a3 = a2 + kstep; const char* b3 = b2 + kstep;
            if (last && has_next) S.a_ready(nxt);
            PG8_LDB(B0, 0, 0); PG8_SCHED; PG8_LDA(At, 0, 0); PG8_STAGE(PG8_SA(1, 1), a1 + hstep, voffA);
            PG8_WAIT_L(8); PG8_BAR; PG8_WAIT_L(0); PG8_MMA(0, 0, At, B0); PG8_BAR; PG8_SCHED;
            PG8_LDB(B1, 0, 1); PG8_STAGE(PG8_SB(0, 0), b2, voffB);
            PG8_BAR; PG8_WAIT_L(0); PG8_MMA(0, 1, At, B1); PG8_BAR;
            PG8_LDA(At, 0, 1); PG8_STAGE(PG8_SA(0, 0), a2, voffA);
            PG8_BAR; PG8_WAIT_L(0); PG8_MMA(1, 0, At, B0); PG8_BAR; PG8_SCHED;
            PG8_STAGE(PG8_SB(0, 1), b2 + hstep, voffB);
            PG8_WAIT_V(6); PG8_BAR; PG8_MMA(1, 1, At, B1); PG8_BAR;
            PG8_LDB(B0, 1, 0); PG8_SCHED; PG8_LDA(At, 1, 0); PG8_STAGE(PG8_SA(0, 1), a2 + hstep, voffA);
            PG8_WAIT_L(8); PG8_BAR; PG8_WAIT_L(0); PG8_MMA(0, 0, At, B0); PG8_BAR; PG8_SCHED;
            PG8_LDB(B1, 1, 1); PG8_STAGE(PG8_SB(1, 0), b3, voffB);
            PG8_BAR; PG8_WAIT_L(0); PG8_MMA(0, 1, At, B1); PG8_BAR;
            PG8_LDA(At, 1, 1); PG8_STAGE(PG8_SA(1, 0), a3, voffA);
            PG8_BAR; PG8_WAIT_L(0); PG8_MMA(1, 0, At, B0); PG8_BAR; PG8_SCHED;
            PG8_STAGE(PG8_SB(1, 1), b3 + hstep, voffB);
            PG8_WAIT_V(6); PG8_BAR; PG8_MMA(1, 1, At, B1); PG8_BAR;
        }
        PG8_STAMP();
        if constexpr (!Epi::AFTER_DRAIN) { E(acc, cur, wr, wc, fr, fq); S.done(cur); }
        PG8_STAMP();
        if (!has_next) break;
#pragma unroll
        for (int a = 0; a < 2; ++a)
#pragma unroll
            for (int b = 0; b < 2; ++b)
#pragma unroll
                for (int m = 0; m < 4; ++m)
#pragma unroll
                    for (int n = 0; n < 2; ++n) acc[a][b][m][n] = (f32x4){0.f, 0.f, 0.f, 0.f};
        cur = nxt; cA = nA; cB = nB; ++ui;
    }
    PG8_WAIT_V(0);
    if (wr == 0) PG8_BAR;
    PG8_BAR;
    if constexpr (Epi::AFTER_DRAIN) { E.fused(acc, cur, wr, wc, fr, fq, lds, wid, lane); S.done(cur); }
    PG8_STAMP();
    if (STAMP && wid == 0) { stamps[lane] = lane < nts ? (((unsigned long long)(unsigned)ts_hi << 32) | (unsigned)ts_lo) : 0ull;
        if (lane == 62) stamps[62] = rt_entry; if (lane == 63) stamps[63] = (unsigned long long)wall_clock64(); }
#undef PG8_STAMP
#undef PG8_SA
#undef PG8_SB
#undef PG8_STAGE
#undef PG8_LDA
#undef PG8_LDB
#undef PG8_MMA
#undef PG8_WAIT_V
#undef PG8_WAIT_L
#undef PG8_BAR
#undef PG8_SCHED
}
}
#define XB_TMO      128
#define XB_XCNT(j)  (256  + 64 * (j))
#define XB_XSUB(j)  (1280 + 64 * (j))
#define XB_XGEN(j)  (2304 + 64 * (j))
#define XB_TOP      3328
#define XB_TOPGEN   3392
#define XCD_BAR_WORDS 3456
#define XB_SPIN_CAP (1u << 18)
#define LAS __attribute__((address_space(3)))

__device__ __forceinline__ unsigned xb_ld(unsigned* p)              { return __hip_atomic_load(p, __ATOMIC_RELAXED, __HIP_MEMORY_SCOPE_AGENT); }
__device__ __forceinline__ unsigned xb_add(unsigned* p, unsigned v) { return __hip_atomic_fetch_add(p, v, __ATOMIC_RELAXED, __HIP_MEMORY_SCOPE_AGENT); }
__device__ __forceinline__ unsigned xb_xcc_id() { return (unsigned)__builtin_amdgcn_s_getreg((3 << 11) | 20) & 0xFu; }
#define XB_SPIN(cond, bar) do { unsigned _sp = 0; while (cond) { __builtin_amdgcn_s_sleep(1); \
    if ((++_sp & 255u) == 0u) { if (xb_ld(&(bar)[XB_TMO])) break; if (_sp > XB_SPIN_CAP) { atomicAdd(&(bar)[XB_TMO], 1u); break; } } } } while (0)

struct XcdBarrier {
    unsigned* bar; unsigned x;
    volatile LAS unsigned* st;
};

__device__ __forceinline__ XcdBarrier xcd_barrier_post(unsigned* bar, volatile LAS unsigned* st) {
    XcdBarrier b; b.bar = bar; b.x = xb_xcc_id(); b.st = st;
    if (threadIdx.x == 0) (void)xb_add(&bar[XB_XCNT(b.x)], 1u);
    return b;
}
__device__ __forceinline__ void xcd_barrier_complete(unsigned* bar, unsigned x, unsigned& nloc, unsigned& nx) {
    const unsigned G = gridDim.x * gridDim.y * gridDim.z;
    unsigned sum, cnt, mine, sp = 0u;
    for (;;) {
        sum = 0u; cnt = 0u; mine = 0u;
#pragma unroll
        for (unsigned j = 0; j < 16; ++j) { const unsigned c = xb_ld(&bar[XB_XCNT(j)]); sum += c; cnt += (c > 0u) ? 1u : 0u; mine = (j == x) ? c : mine; }
        if (sum == G) break;
        __builtin_amdgcn_s_sleep(1);
        if ((++sp & 255u) == 0u) { if (xb_ld(&bar[XB_TMO])) break; if (sp > XB_SPIN_CAP) { atomicAdd(&bar[XB_TMO], 1u); break; } }
    }
    nloc = mine > 0u ? mine : 1u; nx = cnt > 0u ? cnt : 1u;
}

__device__ __forceinline__ void xcd_barrier(const XcdBarrier& b) {
    asm volatile("s_waitcnt vmcnt(0)" ::: "memory");
    __syncthreads();
    if (threadIdx.x == 0) {
        unsigned* bar = b.bar;
        __builtin_amdgcn_s_waitcnt(0);
        unsigned nloc = b.st[0], nx = b.st[1];
        if (nloc == 0u) { xcd_barrier_complete(bar, b.x, nloc, nx); b.st[0] = nloc; b.st[1] = nx; }
        const unsigned old = xb_add(&bar[XB_XSUB(b.x)], 1u);
        const unsigned gen = old / nloc;
        if (old + 1u == (gen + 1u) * nloc) {
            __builtin_amdgcn_fence(__ATOMIC_RELEASE, "agent");
            asm volatile("s_waitcnt vmcnt(0)" ::: "memory");
            const unsigned og = xb_add(&bar[XB_TOP], 1u);
            const unsigned tg = og / nx;
            if (og + 1u == (tg + 1u) * nx) xb_add(&bar[XB_TOPGEN], 1u);
            else XB_SPIN(xb_ld(&bar[XB_TOPGEN]) == tg, bar);
            __builtin_amdgcn_fence(__ATOMIC_ACQUIRE, "agent");
            xb_add(&bar[XB_XGEN(b.x)], 1u);
            asm volatile("s_waitcnt vmcnt(0)" ::: "memory");
        } else {
            XB_SPIN(xb_ld(&bar[XB_XGEN(b.x)]) == gen, bar);
            __builtin_amdgcn_fence(__ATOMIC_ACQUIRE, "agent");
            asm volatile("s_waitcnt vmcnt(0)" ::: "memory");
        }
    }
    __syncthreads();
}

namespace mk {
using pg8::bf16_t; using pg8::bf16x8; using pg8::f32x4; using pg8::u32x4;
typedef short s16x4 __attribute__((ext_vector_type(4)));
typedef unsigned u32x2 __attribute__((ext_vector_type(2)));
typedef __bf16 bf16x2v __attribute__((ext_vector_type(2)));
typedef int i32x4 __attribute__((ext_vector_type(4)));
#define DI __device__ __forceinline__

constexpr int D = 1024, SEQ = 4096, NTOK = 16384, DEPTH = 4, DIN = 13824;
constexpr int OFF_AQ = 0, OFF_AK = 1536, OFF_AV = 3072, OFF_LX = 4608, OFF_LG = 5632, OFF_RQ = 6656, OFF_RK = 7680, OFF_RV = 8704, OFF_RG = 9728, OFF_GA = 10752;
constexpr float ALPHA = 1.681792830507429f;
constexpr float LN_EPS = 1e-5f;
constexpr int NPH = 12;
constexpr int LDS_BYTES = 148 * 1024;
constexpr int LDS_BAR_OFF = LDS_BYTES - 16;

constexpr size_t WS_CTL  = 0;
constexpr size_t WS_COSA = 16384;
constexpr size_t WS_SINA = WS_COSA + (size_t)4096 * 64 * 4;
constexpr size_t WS_COSR = WS_SINA + (size_t)4096 * 64 * 4;
constexpr size_t WS_SINR = WS_COSR + (size_t)4096 * 128 * 4;
constexpr size_t WS_CCH  = WS_SINR + (size_t)4096 * 128 * 4;
constexpr size_t WS_WAT  = WS_CCH + 4096;
constexpr size_t WS_WXT  = WS_WAT + 131072;
constexpr size_t WS_LSTA = WS_WXT + 131072;
constexpr size_t WS_LSTH = WS_LSTA + 524288;
constexpr size_t WS_K1B  = WS_LSTH + 524288;
constexpr size_t WS_K2B  = WS_K1B + 262144;
constexpr size_t WS_XF   = WS_K2B + 262144;
constexpr size_t WS_XB   = WS_XF + (size_t)NTOK * D * 4;
constexpr size_t WS_WINT = WS_XB + (size_t)NTOK * D * 2;
constexpr size_t WS_WBAT = WS_WINT + (size_t)DIN * 1024 * 2;
constexpr size_t WS_WBBT = WS_WBAT + (size_t)1024 * 512 * 2;
constexpr size_t WS_WBCT = WS_WBBT + (size_t)1024 * 1024 * 2;
constexpr size_t WS_WOT  = WS_WBCT + (size_t)1024 * 1024 * 2;
constexpr size_t WS_WQT  = WS_WOT + (size_t)1024 * 1024 * 2;
constexpr size_t WS_UB   = WS_WQT + (size_t)2048 * 1024 * 2;
constexpr size_t WS_VB   = WS_UB + (size_t)16384 * 1024 * 2;
constexpr size_t WS_PROJ = WS_VB + (size_t)16384 * 1024 * 2;
constexpr size_t WS_OATT = WS_PROJ + (size_t)NTOK * DIN * 2;
constexpr size_t WS_LSE  = WS_OATT + (size_t)NTOK * 1536 * 2;
constexpr size_t WS_KVB  = WS_LSE + (size_t)NTOK * 12 * 4;
constexpr size_t WS_YA   = WS_KVB + (size_t)16 * 32 * 65536 * 2;
constexpr size_t WS_YB   = WS_YA + (size_t)NTOK * 512 * 2;
constexpr size_t WS_YC   = WS_YB + (size_t)NTOK * 1024 * 2;
constexpr size_t WS_MRGF = WS_YC + (size_t)NTOK * 1024 * 2;
constexpr size_t WS_MRGB = WS_MRGF + (size_t)NTOK * 1024 * 4;
constexpr size_t WS_END  = WS_MRGB + (size_t)NTOK * 1024 * 2;
constexpr size_t WS_Q    = WS_PROJ;
constexpr size_t WS_EID  = WS_PROJ + (size_t)NTOK * 2048 * 2;
constexpr size_t WS_GATE = WS_EID + (size_t)NTOK * 128 * 4;
static_assert(WS_END <= (size_t)1073741824, "workspace too large");
static_assert(WS_PROJ % 256 == 0 && WS_KVB % 256 == 0 && WS_MRGF % 256 == 0, "alignment");

struct Args { const float* in[20]; float* out; unsigned char* ws; double ropeA, ropeR; int ph_lo, ph_hi; };

DI float bflo(unsigned w) { return __uint_as_float(w << 16); }
DI float bfhi(unsigned w) { return __uint_as_float(w & 0xffff0000u); }
DI float bf2f(bf16_t v) { return __uint_as_float(((unsigned)v) << 16); }
DI unsigned pk2(float lo, float hi) { return pg8::cvt_pk_bf16(lo, hi); }
DI bf16_t f2bf(float f) { return (bf16_t)(pk2(f, 0.f) & 0xffffu); }
DI f32x4 mfma16(bf16x8 a, bf16x8 b, f32x4 c) { return __builtin_amdgcn_mfma_f32_16x16x32_bf16(a, b, c, 0, 0, 0); }
DI s16x4 trrd(LAS unsigned char* p) { return __builtin_amdgcn_ds_read_tr16_b64_v4i16((LAS s16x4*)p); }
DI bf16x8 cat8(s16x4 lo, s16x4 hi) { return __builtin_shufflevector(lo, hi, 0, 1, 2, 3, 4, 5, 6, 7); }
DI float wsum(float v) { v += __shfl_xor(v, 32); v += __shfl_xor(v, 16); v += __shfl_xor(v, 8); v += __shfl_xor(v, 4); v += __shfl_xor(v, 2); v += __shfl_xor(v, 1); return v; }
DI float sigm(float x) { return 1.f / (1.f + __expf(-x)); }
DI float gelu_erf(float x) { return 0.5f * x * (1.f + erff(x * 0.70710678118654752f)); }
DI float dot2(unsigned w, unsigned x, float acc) { return __builtin_amdgcn_fdot2_f32_bf16(__builtin_bit_cast(bf16x2v, w), __builtin_bit_cast(bf16x2v, x), acc, false); }
DI float log2gamma(int h) { return log2f(1.0f - exp2f(-5.0f - (float)h)); }

DI void sincos_d(double x, double& s, double& c) {
    const double n = rint(x * 0.63661977236758134308);
    double y = fma(-n, 1.57079632679489655800e+00, x); y = fma(-n, 6.12323399573676603587e-17, y);
    const double y2 = y * y;
    const double sp = y + y * y2 * (-1.0 / 6 + y2 * (1.0 / 120 + y2 * (-1.0 / 5040 + y2 * (1.0 / 362880 + y2 * (-1.0 / 39916800 + y2 * (1.0 / 6227020800.0))))));
    const double cp = 1.0 + y2 * (-0.5 + y2 * (1.0 / 24 + y2 * (-1.0 / 720 + y2 * (1.0 / 40320 + y2 * (-1.0 / 3628800 + y2 * (1.0 / 479001600.0 + y2 * (-1.0 / 87178291200.0)))))));
    const int q = ((int)n) & 3;
    s = (q == 0) ? sp : (q == 1) ? cp : (q == 2) ? -sp : -cp;
    c = (q == 0) ? cp : (q == 1) ? -sp : (q == 2) ? -cp : sp;
}

DI void tconv_tile(const float* src, int ldsrc, bf16_t* dst, int lddst, int k0, int n0, LAS float* t) {
    const int tid = mk_tid();
#pragma unroll
    for (int i = 0; i < 8; ++i) { const int idx = tid + 512 * i, r = idx >> 6, c = idx & 63; t[r * 65 + c] = src[(size_t)(k0 + r) * ldsrc + n0 + c]; }
    __syncthreads();
#pragma unroll
    for (int i = 0; i < 8; ++i) { const int idx = tid + 512 * i, n = idx >> 6, k = idx & 63; dst[(size_t)(n0 + n) * lddst + k0 + k] = f2bf(t[k * 65 + n]); }
    __syncthreads();
}
DI void conv_unit(const float* src, bf16_t* dst, int unit) {
    const size_t i = (size_t)unit * 4096 + (size_t)mk_tid() * 8;
    const f32x4 a = *(const f32x4*)(src + i), b = *(const f32x4*)(src + i + 4);
    u32x4 o; o.x = pk2(a[0], a[1]); o.y = pk2(a[2], a[3]); o.z = pk2(b[0], b[1]); o.w = pk2(b[2], b[3]);
    *(u32x4*)(dst + i) = o;
}
DI void phase_conv(const Args& a, int layer, LAS unsigned char* lds) {
    unsigned char* ws = a.ws;
    LAS float* t = (LAS float*)lds;
    const int J0 = 3456, J1 = J0 + 128, J2 = J1 + 256, J3 = J2 + 256, J4 = J3 + 256, J5 = J4 + 512, J6 = J5 + 32, J7 = J6 + 4096, J8 = J7 + 4096, J9 = J8 + 64, J10 = J9 + 1;
    const int total = J10;
    for (int u = blockIdx.x; u < total; u += gridDim.x) {
        if (u < J0) { const int kt = u / 216, nt = u % 216; tconv_tile(a.in[1] + (size_t)layer * 1024 * DIN, DIN, (bf16_t*)(ws + WS_WINT), 1024, kt * 64, nt * 64, t); }
        else if (u < J1) { const int v = u - J0, kt = v / 16, nt = v % 16; tconv_tile(a.in[9] + (size_t)layer * 2560 * 1024, 1024, (bf16_t*)(ws + WS_WBAT), 512, kt * 64, nt * 64, t); }
        else if (u < J2) { const int v = u - J1, kt = v / 16, nt = v % 16; tconv_tile(a.in[9] + (size_t)layer * 2560 * 1024 + (size_t)512 * 1024, 1024, (bf16_t*)(ws + WS_WBBT), 1024, kt * 64, nt * 64, t); }
        else if (u < J3) { const int v = u - J2, kt = v / 16, nt = v % 16; tconv_tile(a.in[9] + (size_t)layer * 2560 * 1024 + (size_t)1536 * 1024, 1024, (bf16_t*)(ws + WS_WBCT), 1024, kt * 64, nt * 64, t); }
        else if (u < J4) { const int v = u - J3, kt = v / 16, nt = v % 16; tconv_tile(a.in[10] + (size_t)layer * 1024 * 1024, 1024, (bf16_t*)(ws + WS_WOT), 1024, kt * 64, nt * 64, t); }
        else if (u < J5) { const int v = u - J4, kt = v / 32, nt = v % 32; tconv_tile(a.in[13] + (size_t)layer * 1024 * 2048, 2048, (bf16_t*)(ws + WS_WQT), 1024, kt * 64, nt * 64, t); }
        else if (u < J6) { const int v = u - J5, blk = v & 15, which = v >> 4;
            tconv_tile(a.in[which ? 6 : 4] + ((size_t)layer * 16 + blk) * 4096, 64, (bf16_t*)(ws + (which ? WS_WXT : WS_WAT)) + blk * 4096, 64, 0, 0, t); }
        else if (u < J7) { conv_unit(a.in[16] + (size_t)layer * 16384 * 1024, (bf16_t*)(ws + WS_UB), u - J6); }
        else if (u < J8) { conv_unit(a.in[17] + (size_t)layer * 16384 * 1024, (bf16_t*)(ws + WS_VB), u - J7); }
        else if (u < J9) { const int v = u - J8; if (v < 32) conv_unit(a.in[14] + (size_t)layer * 131072, (bf16_t*)(ws + WS_K1B), v); else conv_unit(a.in[15] + (size_t)layer * 131072, (bf16_t*)(ws + WS_K2B), v - 32); }
        else { for (int c = mk_tid(); c < 1024; c += 512) { const float lam = a.in[8][layer * 1024 + c]; ((float*)(ws + WS_CCH))[c] = -8.0f * log1pf(expf(-lam)); } }
    }
}

DI void phase_prologue(const Args& a) {
    unsigned char* ws = a.ws;
    const int tid = mk_tid();
    for (int u = blockIdx.x; u < 4096 + 1536; u += gridDim.x) {
        if (u < 4096) { const size_t i = (size_t)u * 4096 + (size_t)tid * 8;
            const f32x4 p = *(const f32x4*)(a.in[0] + i), q = *(const f32x4*)(a.in[0] + i + 4);
            *(f32x4*)((float*)(ws + WS_XF) + i) = p; *(f32x4*)((float*)(ws + WS_XF) + i + 4) = q;
            u32x4 o; o.x = pk2(p[0], p[1]); o.y = pk2(p[2], p[3]); o.z = pk2(q[0], q[1]); o.w = pk2(q[2], q[3]);
            *(u32x4*)((bf16_t*)(ws + WS_XB) + i) = o; }
        else { const int idx = (u - 4096) * 512 + tid;
            const int pos = idx / 192, i = idx % 192;
            const bool isA = i < 64; const int fi = isA ? i : i - 64; const double r = isA ? a.ropeA : a.ropeR;
            double inv = 1.0; for (int k = 0; k < fi; ++k) inv *= r;
            double s, c; sincos_d((double)pos * inv, s, c);
            if (isA) { ((float*)(ws + WS_COSA))[pos * 64 + fi] = (float)c; ((float*)(ws + WS_SINA))[pos * 64 + fi] = (float)s; }
            else { ((float*)(ws + WS_COSR))[pos * 128 + fi] = (float)c; ((float*)(ws + WS_SINR))[pos * 128 + fi] = (float)s; } }
    }
}

DI void phase_rope(const Args& a) {
    unsigned char* ws = a.ws; bf16_t* proj = (bf16_t*)(ws + WS_PROJ);
    for (int u = blockIdx.x; u < NTOK / 8; u += gridDim.x) {
#pragma unroll 1
        for (int i = 0; i < 5; ++i) {
            const int idx = mk_tid() + 512 * i, tk = u * 8 + idx / 320; int it = idx % 320;
            int off, hd, half, head, ch; const float* ct; const float* st; float sc = 1.0f;
            if (it < 192) { off = (it < 96) ? OFF_AQ : OFF_AK; if (it >= 96) it -= 96; hd = 128; half = 64; head = it >> 3; ch = it & 7; ct = (const float*)(ws + WS_COSA); st = (const float*)(ws + WS_SINA); }
            else { it -= 192; off = (it < 64) ? OFF_RQ : OFF_RK; if (it >= 64) { it -= 64; sc = 0.0625f; } hd = 256; half = 128; head = it >> 4; ch = it & 15; ct = (const float*)(ws + WS_COSR); st = (const float*)(ws + WS_SINR); }
            const int pos = tk & (SEQ - 1);
            bf16_t* p1 = proj + (size_t)tk * DIN + off + head * hd + ch * 8; bf16_t* p2 = p1 + half;
            const u32x4 x1 = *(const u32x4*)p1, x2 = *(const u32x4*)p2;
            const float* cp = ct + (size_t)pos * half + ch * 8; const float* sp = st + (size_t)pos * half + ch * 8;
            const f32x4 c0 = *(const f32x4*)cp, c1 = *(const f32x4*)(cp + 4), s0 = *(const f32x4*)sp, s1 = *(const f32x4*)(sp + 4);
            float t1[8], t2[8], cc[8], ss[8];
#pragma unroll
            for (int q = 0; q < 4; ++q) { t1[2 * q] = bflo(x1[q]); t1[2 * q + 1] = bfhi(x1[q]); t2[2 * q] = bflo(x2[q]); t2[2 * q + 1] = bfhi(x2[q]); cc[q] = c0[q]; cc[4 + q] = c1[q]; ss[q] = s0[q]; ss[4 + q] = s1[q]; }
            u32x4 o1, o2;
#pragma unroll
            for (int q = 0; q < 4; ++q) {
                const float a0 = (t1[2 * q] * cc[2 * q] - t2[2 * q] * ss[2 * q]) * sc, a1 = (t1[2 * q + 1] * cc[2 * q + 1] - t2[2 * q + 1] * ss[2 * q + 1]) * sc;
                const float b0 = (t1[2 * q] * ss[2 * q] + t2[2 * q] * cc[2 * q]) * sc, b1 = (t1[2 * q + 1] * ss[2 * q + 1] + t2[2 * q + 1] * cc[2 * q + 1]) * sc;
                o1[q] = pk2(a0, a1); o2[q] = pk2(b0, b1); }
            *(u32x4*)p1 = o1; *(u32x4*)p2 = o2;
        }
    }
}

DI void attn_unit(const Args& a, int unit, LAS unsigned char* lds) {
    unsigned char* ws = a.ws;
    const int tid = mk_tid(), lane = tid & 63, w = __builtin_amdgcn_readfirstlane(tid >> 6), g = lane >> 4, l15 = lane & 15, tq4 = l15 >> 2, tp4 = l15 & 3;
    const int b = unit / 384, rem = unit % 384, h = rem >> 5, bi = rem & 31;
    const int grp = h >> 2, d = (grp == 0) ? 1 : ((grp == 1) ? 4 : 16), nb = 32 / d, r = bi / nb, n = bi % nb;
    const bf16_t* proj = (const bf16_t*)(ws + WS_PROJ) + (size_t)b * SEQ * DIN;
    LAS unsigned char* Ks = lds; LAS unsigned char* Vs = lds + 256 * 288;
#pragma unroll
    for (int i = 0; i < 8; ++i) {
        const int idx = tid + 512 * i, row = idx >> 4, ch = idx & 15, m = 128 * (n - 1) + row;
        u32x4 kv = {0u, 0u, 0u, 0u}, vv = {0u, 0u, 0u, 0u};
        if (m >= 0) { const bf16_t* p = proj + (size_t)(m * d + r) * DIN + h * 128 + ch * 8; kv = *(const u32x4*)(p + OFF_AK); vv = *(const u32x4*)(p + OFF_AV); }
        *(LAS u32x4*)(Ks + row * 288 + ch * 16) = kv; *(LAS u32x4*)(Vs + row * 288 + ch * 16) = vv;
    }
    const int qi = 16 * w + l15;
    const size_t tq = (size_t)(128 * n + qi) * d + r;
    bf16x8 qf[4];
#pragma unroll
    for (int ks = 0; ks < 4; ++ks) qf[ks] = *(const bf16x8*)(proj + tq * DIN + OFF_AQ + h * 128 + 32 * ks + 8 * g);
    __syncthreads();
    const int s0 = w >> 1;
    f32x4 sacc[10];
#pragma unroll
    for (int jj = 0; jj < 10; ++jj) {
        f32x4 acc = {0.f, 0.f, 0.f, 0.f};
#pragma unroll
        for (int ks = 0; ks < 4; ++ks) { const bf16x8 kf = *(const LAS bf16x8*)(Ks + (32 * s0 + 16 * jj + l15) * 288 + (32 * ks + 8 * g) * 2); acc = mfma16(kf, qf[ks], acc); }
        sacc[jj] = acc;
    }
    const float scale = 0.08838834764831845f;
    float mx = -1e30f;
#pragma unroll
    for (int jj = 0; jj < 10; ++jj)
#pragma unroll
        for (int rg = 0; rg < 4; ++rg) {
            const int j = 32 * s0 + 16 * jj + 4 * g + rg;
            const bool valid = (j >= qi) && (j <= qi + 128) && (n > 0 || j >= 128);
            const float s = valid ? sacc[jj][rg] * scale : -1e30f;
            sacc[jj][rg] = s; mx = fmaxf(mx, s);
        }
    mx = fmaxf(mx, __shfl_xor(mx, 16)); mx = fmaxf(mx, __shfl_xor(mx, 32));
    float sum = 0.f;
#pragma unroll
    for (int jj = 0; jj < 10; ++jj)
#pragma unroll
        for (int rg = 0; rg < 4; ++rg) { const float p = __expf(sacc[jj][rg] - mx); sacc[jj][rg] = p; sum += p; }
    sum += __shfl_xor(sum, 16); sum += __shfl_xor(sum, 32);
    f32x4 oacc[8];
#pragma unroll
    for (int db = 0; db < 8; ++db) oacc[db] = (f32x4){0.f, 0.f, 0.f, 0.f};
#pragma unroll
    for (int s = 0; s < 5; ++s) {
        u32x4 pw; pw.x = pk2(sacc[2 * s][0], sacc[2 * s][1]); pw.y = pk2(sacc[2 * s][2], sacc[2 * s][3]); pw.z = pk2(sacc[2 * s + 1][0], sacc[2 * s + 1][1]); pw.w = pk2(sacc[2 * s + 1][2], sacc[2 * s + 1][3]);
        const bf16x8 pb = __builtin_bit_cast(bf16x8, pw);
        const int k0 = 32 * (s0 + s) + 4 * g + tq4;
#pragma unroll
        for (int db = 0; db < 8; ++db) {
            const s16x4 lo = trrd(Vs + k0 * 288 + (16 * db + 4 * tp4) * 2), hi = trrd(Vs + (k0 + 16) * 288 + (16 * db + 4 * tp4) * 2);
            oacc[db] = mfma16(cat8(lo, hi), pb, oacc[db]);
        }
    }
    const float inv = 1.0f / sum;
    bf16_t* op = (bf16_t*)(ws + WS_OATT) + ((size_t)b * SEQ + tq) * 1536 + h * 128 + 4 * g;
#pragma unroll
    for (int db = 0; db < 8; ++db) { u32x2 o; o.x = pk2(oacc[db][0] * inv, oacc[db][1] * inv); o.y = pk2(oacc[db][2] * inv, oacc[db][3] * inv); *(u32x2*)(op + 16 * db) = o; }
    if (g == 0) ((float*)(ws + WS_LSE))[((size_t)b * SEQ + tq) * 12 + h] = mx + __logf(sum);
    __syncthreads();
}

DI void retkv_unit(const Args& a, int unit, LAS unsigned char* lds) {
    unsigned char* ws = a.ws;
    const int tid = mk_tid(), lane = tid & 63, w = __builtin_amdgcn_readfirstlane(tid >> 6), g = lane >> 4, l15 = lane & 15, tq4 = l15 >> 2, tp4 = l15 & 3;
    const int b = unit >> 7, h = (unit >> 5) & 3, c = unit & 31;
    const bf16_t* proj = (const bf16_t*)(ws + WS_PROJ) + ((size_t)b * SEQ + c * 128) * DIN;
    LAS unsigned char* Ks = lds; LAS unsigned char* Vs = lds + 128 * 544;
    const float l2g = log2gamma(h);
#pragma unroll
    for (int i = 0; i < 8; ++i) {
        const int idx = tid + 512 * i, row = idx >> 5, ch = idx & 31;
        const bf16_t* p = proj + (size_t)row * DIN + h * 256 + ch * 8;
        const u32x4 kv = *(const u32x4*)(p + OFF_RK), vv = *(const u32x4*)(p + OFF_RV);
        const float z = exp2f((float)(127 - row) * l2g);
        u32x4 kz;
#pragma unroll
        for (int q = 0; q < 4; ++q) kz[q] = pk2(bflo(kv[q]) * z, bfhi(kv[q]) * z);
        *(LAS u32x4*)(Ks + row * 544 + ch * 16) = kz; *(LAS u32x4*)(Vs + row * 544 + ch * 16) = vv;
    }
    __syncthreads();
#pragma unroll 1
    for (int nh = 0; nh < 2; ++nh) {
        f32x4 acc[2][8];
#pragma unroll
        for (int mb = 0; mb < 2; ++mb)
#pragma unroll
            for (int nb = 0; nb < 8; ++nb) acc[mb][nb] = (f32x4){0.f, 0.f, 0.f, 0.f};
#pragma unroll
        for (int ks = 0; ks < 4; ++ks) {
            const int j0 = 32 * ks + 4 * g + tq4;
            bf16x8 af[2];
#pragma unroll
            for (int mb = 0; mb < 2; ++mb) { const int col = 32 * w + 16 * mb + 4 * tp4; af[mb] = cat8(trrd(Vs + j0 * 544 + col * 2), trrd(Vs + (j0 + 16) * 544 + col * 2)); }
#pragma unroll
            for (int nb = 0; nb < 8; ++nb) {
                const int col = 128 * nh + 16 * nb + 4 * tp4;
                const bf16x8 bfr = cat8(trrd(Ks + j0 * 544 + col * 2), trrd(Ks + (j0 + 16) * 544 + col * 2));
#pragma unroll
                for (int mb = 0; mb < 2; ++mb) acc[mb][nb] = mfma16(af[mb], bfr, acc[mb][nb]);
            }
        }
        bf16_t* kvb = (bf16_t*)(ws + WS_KVB) + ((size_t)((b * 4 + h) * 32 + c)) * 65536 + 128 * nh;
#pragma unroll
        for (int mb = 0; mb < 2; ++mb)
#pragma unroll
            for (int nb = 0; nb < 8; ++nb)
#pragma unroll
                for (int rg = 0; rg < 4; ++rg) kvb[(size_t)(32 * w + 16 * mb + 4 * g + rg) * 256 + 16 * nb + l15] = f2bf(acc[mb][nb][rg]);
    }
    __syncthreads();
}

DI void lru_unit(const Args& a, int layer, int unit, bool fin, LAS unsigned char* lds) {
    unsigned char* ws = a.ws;
    const int tid = mk_tid(), lane = tid & 63, w = __builtin_amdgcn_readfirstlane(tid >> 6), g = lane >> 4, l15 = lane & 15;
    const int b = unit >> 9, c = (unit >> 4) & 31, blk = unit & 15;
    LAS bf16_t* lxs = (LAS bf16_t*)lds;
    LAS float* xcf = (LAS float*)(lds + 16896);
    LAS unsigned char* xcb = lds + 49664;
    LAS float* rgt = (LAS float*)(lds + 68096);
    LAS float* igt = (LAS float*)(lds + 100864);
    LAS float* wst = (LAS float*)(lds + 133632);
    const bf16_t* proj = (const bf16_t*)(ws + WS_PROJ) + (size_t)b * SEQ * DIN;
    for (int idx = tid; idx < 131 * 8; idx += 512) {
        const int row = idx >> 3, ch = idx & 7, tk = c * 128 - 3 + row;
        u32x4 v = {0u, 0u, 0u, 0u};
        if (tk >= 0) v = *(const u32x4*)(proj + (size_t)tk * DIN + OFF_LX + blk * 64 + ch * 8);
        *(LAS u32x4*)(lxs + row * 64 + ch * 8) = v;
    }
    __syncthreads();
    {
        const int ch = tid & 63, gc = blk * 64 + ch;
        const float* cw = a.in[2] + (size_t)layer * 4096;
        const float cw0 = cw[gc], cw1 = cw[1024 + gc], cw2 = cw[2048 + gc], cw3 = cw[3072 + gc], cb = a.in[3][layer * 1024 + gc];
#pragma unroll
        for (int i = 0; i < 16; ++i) {
            const int t = (tid >> 6) + 8 * i;
            const float xc = cb + cw0 * bf2f(lxs[t * 64 + ch]) + cw1 * bf2f(lxs[(t + 1) * 64 + ch]) + cw2 * bf2f(lxs[(t + 2) * 64 + ch]) + cw3 * bf2f(lxs[(t + 3) * 64 + ch]);
            xcf[t * 64 + ch] = xc; *(LAS bf16_t*)(xcb + t * 144 + ch * 2) = f2bf(xc);
        }
    }
    __syncthreads();
#pragma unroll
    for (int gate = 0; gate < 2; ++gate) {
        const bf16_t* WT = (const bf16_t*)(ws + (gate ? WS_WXT : WS_WAT)) + blk * 4096;
        const float* bias = a.in[gate ? 7 : 5] + layer * 1024 + blk * 64;
        LAS float* dst = gate ? igt : rgt;
#pragma unroll
        for (int nb = 0; nb < 4; ++nb) {
            f32x4 acc = {0.f, 0.f, 0.f, 0.f};
#pragma unroll
            for (int ks = 0; ks < 2; ++ks) {
                const bf16x8 af = *(const LAS bf16x8*)(xcb + (16 * w + l15) * 144 + (32 * ks + 8 * g) * 2);
                const bf16x8 bfr = *(const bf16x8*)(WT + (16 * nb + l15) * 64 + 32 * ks + 8 * g);
                acc = mfma16(af, bfr, acc);
            }
            const float bv = bias[16 * nb + l15];
#pragma unroll
            for (int rg = 0; rg < 4; ++rg) dst[(16 * w + 4 * g + rg) * 64 + 16 * nb + l15] = sigm(acc[rg] + bv);
        }
    }
    __syncthreads();
    const int ch = lane, gc = blk * 64 + ch;
    const float cc = ((const float*)(ws + WS_CCH))[gc];
    float av[16], bv[16]; float Aw = 1.0f, Hw = 0.0f;
#pragma unroll
    for (int tt = 0; tt < 16; ++tt) {
        const int t = 16 * w + tt;
        const float la = cc * rgt[t * 64 + ch];
        const float aa = __expf(la);
        const float bb = sqrtf(-expm1f(2.0f * la)) * igt[t * 64 + ch] * xcf[t * 64 + ch];
        av[tt] = aa; bv[tt] = bb; Hw = aa * Hw + bb; Aw *= aa;
    }
    wst[w * 64 + ch] = Aw; wst[512 + w * 64 + ch] = Hw;
    __syncthreads();
    float* LA = (float*)(ws + WS_LSTA); float* LH = (float*)(ws + WS_LSTH);
    if (!fin) {
        if (w == 0) {
            float A = 1.0f, H = 0.0f;
#pragma unroll
            for (int ww = 0; ww < 8; ++ww) { const float A_ = wst[ww * 64 + ch], H_ = wst[512 + ww * 64 + ch]; H = A_ * H + H_; A *= A_; }
            LA[(size_t)(b * 32 + c) * 1024 + gc] = A; LH[(size_t)(b * 32 + c) * 1024 + gc] = H;
        }
    } else {
        float hcur = 0.0f;
        for (int cp = 0; cp < c; ++cp) hcur = LA[(size_t)(b * 32 + cp) * 1024 + gc] * hcur + LH[(size_t)(b * 32 + cp) * 1024 + gc];
        for (int ww = 0; ww < w; ++ww) hcur = wst[ww * 64 + ch] * hcur + wst[512 + ww * 64 + ch];
        bf16_t* yb = (bf16_t*)(ws + WS_YB) + ((size_t)b * SEQ + c * 128 + 16 * w) * 1024 + gc;
        const bf16_t* lgp = proj + (size_t)(c * 128 + 16 * w) * DIN + OFF_LG + gc;
#pragma unroll
        for (int tt = 0; tt < 16; ++tt) {
            hcur = av[tt] * hcur + bv[tt];
            const float lgv = bf2f(lgp[(size_t)tt * DIN]);
            yb[(size_t)tt * 1024] = f2bf(hcur * gelu_erf(lgv));
        }
    }
    __syncthreads();
}

DI void retscan_unit(const Args& a, int unit) {
    unsigned char* ws = a.ws;
    const int e8 = unit * 512 + mk_tid();
    const int bh = e8 >> 13, within = e8 & 8191, h = bh & 3;
    const float g128 = exp2f(128.0f * log2gamma(h));
    bf16_t* base = (bf16_t*)(ws + WS_KVB) + (size_t)bh * 32 * 65536 + (size_t)within * 8;
    float st[8];
#pragma unroll
    for (int q = 0; q < 8; ++q) st[q] = 0.f;
    for (int c = 0; c < 32; ++c) {
        u32x4* p = (u32x4*)(base + (size_t)c * 65536);
        const u32x4 kv = *p;
        u32x4 o;
#pragma unroll
        for (int q = 0; q < 4; ++q) o[q] = pk2(st[2 * q], st[2 * q + 1]);
        *p = o;
#pragma unroll
        for (int q = 0; q < 4; ++q) { st[2 * q] = g128 * st[2 * q] + bflo(kv[q]); st[2 * q + 1] = g128 * st[2 * q + 1] + bfhi(kv[q]); }
    }
}

DI void attmerge_unit(const Args& a, int unit) {
    unsigned char* ws = a.ws;
    const int idx = unit * 512 + mk_tid(), t = idx >> 6, hp = (idx >> 4) & 3, dc = idx & 15;
    const float* lse = (const float*)(ws + WS_LSE) + (size_t)t * 12;
    const float l0 = lse[hp], l1 = lse[4 + hp], l2 = lse[8 + hp];
    const float m = fmaxf(l0, fmaxf(l1, l2));
    float w0 = __expf(l0 - m), w1 = __expf(l1 - m), w2 = __expf(l2 - m);
    const float is = 1.0f / (w0 + w1 + w2); w0 *= is; w1 *= is; w2 *= is;
    const bf16_t* o = (const bf16_t*)(ws + WS_OATT) + (size_t)t * 1536 + hp * 128 + dc * 8;
    const u32x4 a0 = *(const u32x4*)o, a1 = *(const u32x4*)(o + 512), a2 = *(const u32x4*)(o + 1024);
    u32x4 r;
#pragma unroll
    for (int q = 0; q < 4; ++q) r[q] = pk2(w0 * bflo(a0[q]) + w1 * bflo(a1[q]) + w2 * bflo(a2[q]), w0 * bfhi(a0[q]) + w1 * bfhi(a1[q]) + w2 * bfhi(a2[q]));
    *(u32x4*)((bf16_t*)(ws + WS_YA) + (size_t)t * 512 + hp * 128 + dc * 8) = r;
}

DI void retout_unit(const Args& a, int unit, LAS unsigned char* lds) {
    unsigned char* ws = a.ws;
    const int tid = mk_tid(), lane = tid & 63, w = __builtin_amdgcn_readfirstlane(tid >> 6), g = lane >> 4, l15 = lane & 15, tq4 = l15 >> 2, tp4 = l15 & 3;
    const int b = unit >> 7, h = (unit >> 5) & 3, c = unit & 31;
    const bf16_t* proj = (const bf16_t*)(ws + WS_PROJ) + ((size_t)b * SEQ + c * 128) * DIN;
    const bf16_t* rt = (const bf16_t*)(ws + WS_KVB) + ((size_t)((b * 4 + h) * 32 + c)) * 65536;
    LAS unsigned char* RA = lds; LAS unsigned char* RB = lds + 128 * 544;
    const float l2g = log2gamma(h);
    const int qi = 16 * w + l15;
    bf16x8 qf[8];
#pragma unroll
    for (int ks = 0; ks < 8; ++ks) qf[ks] = *(const bf16x8*)(proj + (size_t)qi * DIN + OFF_RQ + h * 256 + 32 * ks + 8 * g);
#pragma unroll
    for (int i = 0; i < 8; ++i) {
        const int idx = tid + 512 * i, row = idx >> 5, ch = idx & 31;
        *(LAS u32x4*)(RA + row * 544 + ch * 16) = *(const u32x4*)(proj + (size_t)row * DIN + OFF_RK + h * 256 + ch * 8);
        *(LAS u32x4*)(RB + row * 544 + ch * 16) = *(const u32x4*)(rt + (size_t)row * 256 + ch * 8);
    }
    __syncthreads();
    f32x4 sacc[8], oacc[16];
#pragma unroll
    for (int jj = 0; jj < 8; ++jj) {
        f32x4 acc = {0.f, 0.f, 0.f, 0.f};
        if (jj <= w) {
#pragma unroll
            for (int ks = 0; ks < 8; ++ks) { const bf16x8 kf = *(const LAS bf16x8*)(RA + (16 * jj + l15) * 544 + (32 * ks + 8 * g) * 2); acc = mfma16(kf, qf[ks], acc); }
        }
        sacc[jj] = acc;
    }
#pragma unroll
    for (int db = 0; db < 8; ++db) {
        f32x4 acc = {0.f, 0.f, 0.f, 0.f};
#pragma unroll
        for (int ks = 0; ks < 8; ++ks) { const bf16x8 rf = *(const LAS bf16x8*)(RB + (16 * db + l15) * 544 + (32 * ks + 8 * g) * 2); acc = mfma16(rf, qf[ks], acc); }
        oacc[db] = acc;
    }
    __syncthreads();
#pragma unroll
    for (int i = 0; i < 8; ++i) {
        const int idx = tid + 512 * i, row = idx >> 5, ch = idx & 31;
        *(LAS u32x4*)(RA + row * 544 + ch * 16) = *(const u32x4*)(proj + (size_t)row * DIN + OFF_RV + h * 256 + ch * 8);
        *(LAS u32x4*)(RB + row * 544 + ch * 16) = *(const u32x4*)(rt + (size_t)(128 + row) * 256 + ch * 8);
    }
    __syncthreads();
#pragma unroll
    for (int db = 0; db < 8; ++db) {
        f32x4 acc = {0.f, 0.f, 0.f, 0.f};
#pragma unroll
        for (int ks = 0; ks < 8; ++ks) { const bf16x8 rf = *(const LAS bf16x8*)(RB + (16 * db + l15) * 544 + (32 * ks + 8 * g) * 2); acc = mfma16(rf, qf[ks], acc); }
        oacc[8 + db] = acc;
    }
    const float xi = exp2f((float)(qi + 1) * l2g);
#pragma unroll
    for (int db = 0; db < 16; ++db) oacc[db] = oacc[db] * xi;
#pragma unroll
    for (int jj = 0; jj < 8; ++jj)
#pragma unroll
        for (int rg = 0; rg < 4; ++rg) { const int j = 16 * jj + 4 * g + rg; sacc[jj][rg] = (qi >= j) ? sacc[jj][rg] * exp2f((float)(qi - j) * l2g) : 0.f; }
#pragma unroll
    for (int s = 0; s < 4; ++s) {
        if (2 * s <= w) {
            u32x4 pw; pw.x = pk2(sacc[2 * s][0], sacc[2 * s][1]); pw.y = pk2(sacc[2 * s][2], sacc[2 * s][3]); pw.z = pk2(sacc[2 * s + 1][0], sacc[2 * s + 1][1]); pw.w = pk2(sacc[2 * s + 1][2], sacc[2 * s + 1][3]);
            const bf16x8 pb = __builtin_bit_cast(bf16x8, pw);
            const int k0 = 32 * s + 4 * g + tq4;
#pragma unroll
            for (int db = 0; db < 16; ++db) {
                const s16x4 lo = trrd(RA + k0 * 544 + (16 * db + 4 * tp4) * 2), hi = trrd(RA + (k0 + 16) * 544 + (16 * db + 4 * tp4) * 2);
                oacc[db] = mfma16(cat8(lo, hi), pb, oacc[db]);
            }
        }
    }
    float s1 = 0.f;
#pragma unroll
    for (int db = 0; db < 16; ++db) s1 += (oacc[db][0] + oacc[db][1]) + (oacc[db][2] + oacc[db][3]);
    s1 += __shfl_xor(s1, 16); s1 += __shfl_xor(s1, 32);
    const float mean = s1 * (1.0f / 256.0f);
    float s2 = 0.f;
#pragma unroll
    for (int db = 0; db < 16; ++db)
#pragma unroll
        for (int rg = 0; rg < 4; ++rg) { const float dd = oacc[db][rg] - mean; s2 += dd * dd; }
    s2 += __shfl_xor(s2, 16); s2 += __shfl_xor(s2, 32);
    const float rstd = rsqrtf(s2 * (1.0f / 256.0f) + LN_EPS);
    const bf16_t* rgp = proj + (size_t)qi * DIN + OFF_RG + h * 256 + 4 * g;
    bf16_t* yc = (bf16_t*)(ws + WS_YC) + ((size_t)b * SEQ + c * 128 + qi) * 1024 + h * 256 + 4 * g;
#pragma unroll
    for (int db = 0; db < 16; ++db) {
        const u32x2 gw = *(const u32x2*)(rgp + 16 * db);
        const float g0 = bflo(gw.x), g1 = bfhi(gw.x), g2 = bflo(gw.y), g3 = bfhi(gw.y);
        u32x2 o;
        o.x = pk2(g0 * sigm(g0) * (oacc[db][0] - mean) * rstd, g1 * sigm(g1) * (oacc[db][1] - mean) * rstd);
        o.y = pk2(g2 * sigm(g2) * (oacc[db][2] - mean) * rstd, g3 * sigm(g3) * (oacc[db][3] - mean) * rstd);
        *(u32x2*)(yc + 16 * db) = o;
    }
    __syncthreads();
}

struct EpiBranch {
    static constexpr bool PERM = false, AFTER_DRAIN = false;
    const bf16_t* gate; float* mf; bf16_t* mb; int mode;
    __device__ __forceinline__ void operator()(const f32x4 (&acc)[2][2][4][2], const pg8::Unit& u, int wr, int wc, int fr, int fq) const {
        const int row0 = u.pm * 256 + wr * 64 + fr, col0 = u.pn * 256 + wc * 32 + 4 * fq;
#pragma unroll
        for (int ai = 0; ai < 2; ++ai)
#pragma unroll
            for (int m = 0; m < 4; ++m) {
                const size_t row = (size_t)(row0 + ai * 128 + m * 16);
#pragma unroll
                for (int bj = 0; bj < 2; ++bj)
#pragma unroll
                    for (int n = 0; n < 2; ++n) {
                        const int col = col0 + bj * 128 + n * 16;
                        const u32x2 gw = *(const u32x2*)(gate + row * DIN + col);
                        f32x4 v = acc[ai][bj][m][n];
                        v[0] *= sigm(bflo(gw.x)); v[1] *= sigm(bfhi(gw.x)); v[2] *= sigm(bflo(gw.y)); v[3] *= sigm(bfhi(gw.y));
                        float* mp = mf + row * 1024 + col;
                        if (mode == 0) *(f32x4*)mp = v;
                        else if (mode == 1) *(f32x4*)mp = *(const f32x4*)mp + v;
                        else { const f32x4 t = *(const f32x4*)mp + v; u32x2 o; o.x = pk2(t[0], t[1]); o.y = pk2(t[2], t[3]); *(u32x2*)(mb + row * 1024 + col) = o; }
                    }
            }
    }
};
struct EpiOut {
    static constexpr bool PERM = false, AFTER_DRAIN = false;
    const float* xf; float* z;
    __device__ __forceinline__ void operator()(const f32x4 (&acc)[2][2][4][2], const pg8::Unit& u, int wr, int wc, int fr, int fq) const {
        const int row0 = u.pm * 256 + wr * 64 + fr, col0 = u.pn * 256 + wc * 32 + 4 * fq;
#pragma unroll
        for (int ai = 0; ai < 2; ++ai)
#pragma unroll
            for (int m = 0; m < 4; ++m) {
                const size_t row = (size_t)(row0 + ai * 128 + m * 16);
#pragma unroll
                for (int bj = 0; bj < 2; ++bj)
#pragma unroll
                    for (int n = 0; n < 2; ++n) { const int col = col0 + bj * 128 + n * 16; *(f32x4*)(z + row * 1024 + col) = *(const f32x4*)(xf + row * 1024 + col) * ALPHA + acc[ai][bj][m][n]; }
            }
    }
};

DI void ln_row(const float* z, const float* gam, const float* bet, float* of, bf16_t* ob, int lane) {
    f32x4 v[4]; float s = 0.f;
#pragma unroll
    for (int i = 0; i < 4; ++i) { v[i] = *(const f32x4*)(z + 256 * i + 4 * lane); s += (v[i][0] + v[i][1]) + (v[i][2] + v[i][3]); }
    const float mean = wsum(s) * (1.0f / 1024.0f);
    float q = 0.f;
#pragma unroll
    for (int i = 0; i < 4; ++i)
#pragma unroll
        for (int j = 0; j < 4; ++j) { const float d = v[i][j] - mean; q += d * d; }
    const float rstd = rsqrtf(wsum(q) * (1.0f / 1024.0f) + LN_EPS);
#pragma unroll
    for (int i = 0; i < 4; ++i) {
        const f32x4 gg = *(const f32x4*)(gam + 256 * i + 4 * lane), bb = *(const f32x4*)(bet + 256 * i + 4 * lane);
        f32x4 o;
#pragma unroll
        for (int j = 0; j < 4; ++j) o[j] = (v[i][j] - mean) * rstd * gg[j] + bb[j];
        *(f32x4*)(of + 256 * i + 4 * lane) = o;
        u32x2 pb; pb.x = pk2(o[0], o[1]); pb.y = pk2(o[2], o[3]); *(u32x2*)(ob + 256 * i + 4 * lane) = pb;
    }
}
DI void phase_ln1(const Args& a, int layer) {
    unsigned char* ws = a.ws;
    const int lane = mk_tid() & 63, w = mk_tid() >> 6;
    for (int u = blockIdx.x; u < NTOK / 8; u += gridDim.x) {
        const size_t row = (size_t)u * 8 + w;
        ln_row((const float*)(ws + WS_MRGF) + row * 1024, a.in[11] + layer * 1024, a.in[12] + layer * 1024, (float*)(ws + WS_XF) + row * 1024, (bf16_t*)(ws + WS_XB) + row * 1024, lane);
    }
}

DI void ins16(float (&L)[16], float x) {
#pragma unroll
    for (int k = 0; k < 16; ++k) { const float hi = fmaxf(L[k], x); x = fminf(L[k], x); L[k] = hi; }
}
DI void merge16(float (&L)[16], int xr) {
    float t[16];
#pragma unroll
    for (int k = 0; k < 16; ++k) t[k] = __shfl_xor(L[k], xr);
#pragma unroll
    for (int k = 0; k < 8; ++k) { const float x = t[k]; t[k] = t[15 - k]; t[15 - k] = x; }
#pragma unroll
    for (int k = 0; k < 16; ++k) t[k] = fmaxf(L[k], t[k]);
#define MK_CE_STAGE(dd) _Pragma("unroll") for (int k = 0; k < 16; ++k) if ((k & (dd)) == 0) { const float hi = fmaxf(t[k], t[k + (dd)]), lo = fminf(t[k], t[k + (dd)]); t[k] = hi; t[k + (dd)] = lo; }
    MK_CE_STAGE(8) MK_CE_STAGE(4) MK_CE_STAGE(2) MK_CE_STAGE(1)
#undef MK_CE_STAGE
#pragma unroll
    for (int k = 0; k < 16; ++k) L[k] = t[k];
}
DI float sel16(const float (&L)[16], unsigned idx) {
    float r = L[0];
#pragma unroll
    for (int k = 1; k < 16; ++k) r = (idx == (unsigned)k) ? L[k] : r;
    return r;
}
DI void top16_half(const bf16_t* qp, const bf16_t* kb, float (&L)[16], int g, int l15) {
    bf16x8 qf[4];
#pragma unroll
    for (int ks = 0; ks < 4; ++ks) qf[ks] = *(const bf16x8*)(qp + 32 * ks + 8 * g);
#pragma unroll
    for (int k = 0; k < 16; ++k) L[k] = -FLT_MAX;
#pragma unroll
    for (int kbk = 0; kbk < 8; ++kbk) {
        f32x4 acc = {0.f, 0.f, 0.f, 0.f};
#pragma unroll
        for (int ks = 0; ks < 4; ++ks) { const bf16x8 kf = *(const bf16x8*)(kb + (size_t)(16 * kbk + l15) * 128 + 32 * ks + 8 * g); acc = mfma16(kf, qf[ks], acc); }
#pragma unroll
        for (int rg = 0; rg < 4; ++rg) { const unsigned key = (unsigned)(16 * kbk + 4 * g + rg); ins16(L, __uint_as_float((__float_as_uint(acc[rg]) & ~0x7Fu) | key)); }
    }
    merge16(L, 16); merge16(L, 32);
}
DI void topk_unit(const Args& a, int unit, LAS unsigned char* lds) {
    unsigned char* ws = a.ws;
    const int tid = mk_tid(), lane = tid & 63, w = __builtin_amdgcn_readfirstlane(tid >> 6), g = lane >> 4, l15 = lane & 15;
    const int tg = w & 3, hs = w >> 2;
    const size_t t = (size_t)unit * 64 + tg * 16 + l15;
    const bf16_t* Q = (const bf16_t*)(ws + WS_Q);
    float K1[16], K2[16];
#pragma unroll
    for (int k = 0; k < 16; ++k) { K1[k] = 0.f; K2[k] = 0.f; }
#pragma unroll 1
    for (int hh = 0; hh < 4; ++hh) {
        const int h = hs * 4 + hh;
        float l1[16], l2[16];
        top16_half(Q + t * 2048 + h * 256, (const bf16_t*)(ws + WS_K1B) + (size_t)h * 16384, l1, g, l15);
        top16_half(Q + t * 2048 + h * 256 + 128, (const bf16_t*)(ws + WS_K2B) + (size_t)h * 16384, l2, g, l15);
        const bool mine = (g == hh);
#pragma unroll
        for (int k = 0; k < 16; ++k) { K1[k] = mine ? l1[k] : K1[k]; K2[k] = mine ? l2[k] : K2[k]; }
    }
    const int h = hs * 4 + g;
    float F[16];
#pragma unroll
    for (int k = 0; k < 16; ++k) F[k] = -FLT_MAX;
#pragma unroll
    for (int ia = 0; ia < 16; ++ia)
#pragma unroll
        for (int ib = 0; ib < 16 / (ia + 1); ++ib) {
            const float s = __uint_as_float(__float_as_uint(K1[ia]) & ~0x7Fu) + __uint_as_float(__float_as_uint(K2[ib]) & ~0x7Fu);
            ins16(F, __uint_as_float((__float_as_uint(s) & ~0xFFu) | (unsigned)(ia * 16 + ib)));
        }
    LAS int* row = (LAS int*)lds + tid * 33;
#pragma unroll
    for (int k = 0; k < 16; ++k) { row[k] = (int)(__float_as_uint(K1[k]) & 0x7Fu); row[16 + k] = (int)(__float_as_uint(K2[k]) & 0x7Fu); }
    float gt[16]; int ei[16]; float gs = 0.f;
    const float cv0 = __uint_as_float(__float_as_uint(F[0]) & ~0xFFu);
#pragma unroll
    for (int k = 0; k < 16; ++k) {
        const unsigned bits = __float_as_uint(F[k]);
        const float cv = __uint_as_float(bits & ~0xFFu);
        gt[k] = __expf(cv - cv0); gs += gt[k];
        const int ia = (int)((bits >> 4) & 15u), ib = (int)(bits & 15u);
        ei[k] = row[ia] * 128 + row[16 + ib];
    }
    const float ig = 1.0f / gs;
    int* ep = (int*)(ws + WS_EID) + (t * 8 + h) * 16; float* gp = (float*)(ws + WS_GATE) + (t * 8 + h) * 16;
#pragma unroll
    for (int q = 0; q < 4; ++q) {
        *(i32x4*)(ep + 4 * q) = (i32x4){ei[4 * q], ei[4 * q + 1], ei[4 * q + 2], ei[4 * q + 3]};
        *(f32x4*)(gp + 4 * q) = (f32x4){gt[4 * q] * ig, gt[4 * q + 1] * ig, gt[4 * q + 2] * ig, gt[4 * q + 3] * ig};
    }
}

DI void peer_half(const bf16_t* UB, const bf16_t* VB, int ereg, float greg, const u32x4& xa, const u32x4& xb, float (&y)[16], int lane) {
#pragma unroll 1
    for (int k = 0; k < 64; k += 4) {
        int ee[4]; float gg[4]; u32x4 ua[4], ub[4], va[4], vb[4];
#pragma unroll
        for (int j = 0; j < 4; ++j) { ee[j] = __builtin_amdgcn_readlane(ereg, k + j); gg[j] = __uint_as_float(__builtin_amdgcn_readlane(__float_as_uint(greg), k + j)); }
#pragma unroll
        for (int j = 0; j < 4; ++j) {
            const bf16_t* up = UB + (size_t)ee[j] * 1024 + 8 * lane; const bf16_t* vp = VB + (size_t)ee[j] * 1024 + 8 * lane;
            ua[j] = *(const u32x4*)up; ub[j] = *(const u32x4*)(up + 512); va[j] = *(const u32x4*)vp; vb[j] = *(const u32x4*)(vp + 512);
        }
#pragma unroll
        for (int j = 0; j < 4; ++j) {
            float p = 0.f;
#pragma unroll
            for (int q = 0; q < 4; ++q) { p = dot2(ua[j][q], xa[q], p); p = dot2(ub[j][q], xb[q], p); }
            p = wsum(p);
            const float act = gelu_erf(p) * gg[j];
#pragma unroll
            for (int q = 0; q < 4; ++q) { y[2 * q] += act * bflo(va[j][q]); y[2 * q + 1] += act * bfhi(va[j][q]); y[8 + 2 * q] += act * bflo(vb[j][q]); y[8 + 2 * q + 1] += act * bfhi(vb[j][q]); }
        }
    }
}
DI void peer_unit(const Args& a, int layer, int unit) {
    unsigned char* ws = a.ws;
    const int lane = mk_tid() & 63, w = __builtin_amdgcn_readfirstlane(mk_tid() >> 6);
    const bf16_t* UB = (const bf16_t*)(ws + WS_UB); const bf16_t* VB = (const bf16_t*)(ws + WS_VB);
    const float* gam = a.in[18] + layer * 1024; const float* bet = a.in[19] + layer * 1024;
    const f32x4 ga0 = *(const f32x4*)(gam + 8 * lane), ga1 = *(const f32x4*)(gam + 8 * lane + 4), ga2 = *(const f32x4*)(gam + 512 + 8 * lane), ga3 = *(const f32x4*)(gam + 512 + 8 * lane + 4);
    const f32x4 be0 = *(const f32x4*)(bet + 8 * lane), be1 = *(const f32x4*)(bet + 8 * lane + 4), be2 = *(const f32x4*)(bet + 512 + 8 * lane), be3 = *(const f32x4*)(bet + 512 + 8 * lane + 4);
#pragma unroll 1
    for (int i = 0; i < 8; ++i) {
        const size_t t = (size_t)unit * 64 + w * 8 + i;
        bf16_t* xbp = (bf16_t*)(ws + WS_XB) + t * 1024; float* xfp = (float*)(ws + WS_XF) + t * 1024;
        const u32x4 xa = *(const u32x4*)(xbp + 8 * lane), xb = *(const u32x4*)(xbp + 512 + 8 * lane);
        const int* ep = (const int*)(ws + WS_EID) + t * 128; const float* gp = (const float*)(ws + WS_GATE) + t * 128;
        const int e0 = ep[lane], e1 = ep[64 + lane]; const float g0 = gp[lane], g1 = gp[64 + lane];
        float y[16];
#pragma unroll
        for (int q = 0; q < 16; ++q) y[q] = 0.f;
        peer_half(UB, VB, e0, g0, xa, xb, y, lane);
        peer_half(UB, VB, e1, g1, xa, xb, y, lane);
        const f32x4 x0 = *(const f32x4*)(xfp + 8 * lane), x1 = *(const f32x4*)(xfp + 8 * lane + 4), x2 = *(const f32x4*)(xfp + 512 + 8 * lane), x3 = *(const f32x4*)(xfp + 512 + 8 * lane + 4);
        float z[16]; float s = 0.f;
#pragma unroll
        for (int q = 0; q < 4; ++q) { z[q] = ALPHA * x0[q] + y[q]; z[4 + q] = ALPHA * x1[q] + y[4 + q]; z[8 + q] = ALPHA * x2[q] + y[8 + q]; z[12 + q] = ALPHA * x3[q] + y[12 + q]; }
#pragma unroll
        for (int q = 0; q < 16; ++q) s += z[q];
        const float mean = wsum(s) * (1.0f / 1024.0f);
        float qq = 0.f;
#pragma unroll
        for (int q = 0; q < 16; ++q) { const float d = z[q] - mean; qq += d * d; }
        const float rstd = rsqrtf(wsum(qq) * (1.0f / 1024.0f) + LN_EPS);
        f32x4 o0, o1, o2, o3;
#pragma unroll
        for (int q = 0; q < 4; ++q) { o0[q] = (z[q] - mean) * rstd * ga0[q] + be0[q]; o1[q] = (z[4 + q] - mean) * rstd * ga1[q] + be1[q]; o2[q] = (z[8 + q] - mean) * rstd * ga2[q] + be2[q]; o3[q] = (z[12 + q] - mean) * rstd * ga3[q] + be3[q]; }
        *(f32x4*)(xfp + 8 * lane) = o0; *(f32x4*)(xfp + 8 * lane + 4) = o1; *(f32x4*)(xfp + 512 + 8 * lane) = o2; *(f32x4*)(xfp + 512 + 8 * lane + 4) = o3;
        if (layer == DEPTH - 1) { float* op = a.out + t * 1024; *(f32x4*)(op + 8 * lane) = o0; *(f32x4*)(op + 8 * lane + 4) = o1; *(f32x4*)(op + 512 + 8 * lane) = o2; *(f32x4*)(op + 512 + 8 * lane + 4) = o3; }
        u32x4 p0, p1; p0.x = pk2(o0[0], o0[1]); p0.y = pk2(o0[2], o0[3]); p0.z = pk2(o1[0], o1[1]); p0.w = pk2(o1[2], o1[3]); p1.x = pk2(o2[0], o2[1]); p1.y = pk2(o2[2], o2[3]); p1.z = pk2(o3[0], o3[1]); p1.w = pk2(o3[2], o3[3]);
        *(u32x4*)(xbp + 8 * lane) = p0; *(u32x4*)(xbp + 512 + 8 * lane) = p1;
    }
}
}

namespace mk {
constexpr int LDS_ARG_OFF = LDS_BYTES - 16 - 256;
#define MK_NOINL __device__ __forceinline__
DI Args load_args(LAS unsigned char* lds) {
    int aoff = LDS_ARG_OFF; asm volatile("" : "+s"(aoff));
    Args a; const LAS unsigned long long* p = (const LAS unsigned long long*)(lds + aoff);
#pragma unroll
    for (int i = 0; i < 20; ++i) a.in[i] = (const float*)(const __attribute__((address_space(1))) float*)p[i];
    a.out = (float*)(__attribute__((address_space(1))) float*)p[20]; a.ws = (unsigned char*)(__attribute__((address_space(1))) unsigned char*)p[21]; a.ropeA = __longlong_as_double((long long)p[22]); a.ropeR = __longlong_as_double((long long)p[23]); a.ph_lo = 0; a.ph_hi = 0;
    return a;
}
#define MK_LOADARGS const Args a = load_args(lds); unsigned char* ws = a.ws; const int G = (int)gridDim.x, bid = (int)blockIdx.x; (void)ws; (void)G; (void)bid
MK_NOINL void PG_prologue(LAS unsigned char* lds) { MK_LOADARGS; phase_prologue(a); }
MK_NOINL void P0_conv(LAS unsigned char* lds, int layer) { MK_LOADARGS; phase_conv(a, layer, lds); }
MK_NOINL void P1_inproj(LAS unsigned char* lds, int layer) { MK_LOADARGS; (void)layer;
    pg8::Gemm gm; gm.A = (const bf16_t*)(ws + WS_XB); gm.Bt = (const bf16_t*)(ws + WS_WINT); gm.M = NTOK; gm.N = DIN; gm.K = 1024;
    pg8::StaticOrder S; S.init(NTOK, DIN, G, bid);
    pg8::EpiBf16<0> E; E.O = (bf16_t*)(ws + WS_PROJ); E.ldc = DIN; E.bias = nullptr; E.split_cols = 0; E.split_stride = 0;
    pg8::gemm_phase<pg8::EpiBf16<0>, pg8::StaticOrder, false>(lds, gm, S, E, nullptr); }
MK_NOINL void P2_rope(LAS unsigned char* lds, int layer) { MK_LOADARGS; (void)layer; phase_rope(a); }
MK_NOINL void P3a_attn(LAS unsigned char* lds, int layer) { MK_LOADARGS; (void)layer; for (int u = bid; u < 1536; u += G) attn_unit(a, u, lds); }
MK_NOINL void P3b_retkv(LAS unsigned char* lds, int layer) { MK_LOADARGS; (void)layer; for (int u = bid; u < 512; u += G) retkv_unit(a, u, lds); }
MK_NOINL void P3c_lru(LAS unsigned char* lds, int layer, int fin) { MK_LOADARGS; for (int u = bid; u < 2048; u += G) lru_unit(a, layer, u, fin != 0, lds); }
MK_NOINL void P4_scan_merge(LAS unsigned char* lds, int layer) { MK_LOADARGS; (void)layer;
    for (int u = bid; u < 256; u += G) retscan_unit(a, u);
    for (int u = bid; u < 2048; u += G) attmerge_unit(a, u); }
MK_NOINL void P5_retout(LAS unsigned char* lds, int layer) { MK_LOADARGS; (void)layer; for (int u = bid; u < 512; u += G) retout_unit(a, u, lds); }
MK_NOINL void P6_branch(LAS unsigned char* lds, int layer) { MK_LOADARGS; (void)layer;
#pragma unroll 1
    for (int s = 0; s < 3; ++s) {
        pg8::Gemm gm; gm.A = (const bf16_t*)(ws + (s == 0 ? WS_YA : (s == 1 ? WS_YB : WS_YC))); gm.Bt = (const bf16_t*)(ws + (s == 0 ? WS_WBAT : (s == 1 ? WS_WBBT : WS_WBCT)));
        gm.M = NTOK; gm.N = 1024; gm.K = (s == 0) ? 512 : 1024;
        pg8::StaticOrder S; S.init(NTOK, 1024, G, bid);
        EpiBranch E; E.gate = (const bf16_t*)(ws + WS_PROJ) + OFF_GA + 1024 * s; E.mf = (float*)(ws + WS_MRGF); E.mb = (bf16_t*)(ws + WS_MRGB); E.mode = s;
        pg8::gemm_phase<EpiBranch, pg8::StaticOrder, false>(lds, gm, S, E, nullptr);
    } }
MK_NOINL void P7_outproj(LAS unsigned char* lds, int layer) { MK_LOADARGS; (void)layer;
    pg8::Gemm gm; gm.A = (const bf16_t*)(ws + WS_MRGB); gm.Bt = (const bf16_t*)(ws + WS_WOT); gm.M = NTOK; gm.N = 1024; gm.K = 1024;
    pg8::StaticOrder S; S.init(NTOK, 1024, G, bid);
    EpiOut E; E.xf = (const float*)(ws + WS_XF); E.z = (float*)(ws + WS_MRGF);
    pg8::gemm_phase<EpiOut, pg8::StaticOrder, false>(lds, gm, S, E, nullptr); }
MK_NOINL void P8_ln1(LAS unsigned char* lds, int layer) { MK_LOADARGS; phase_ln1(a, layer); }
MK_NOINL void P9_wq(LAS unsigned char* lds, int layer) { MK_LOADARGS; (void)layer;
    pg8::Gemm gm; gm.A = (const bf16_t*)(ws + WS_XB); gm.Bt = (const bf16_t*)(ws + WS_WQT); gm.M = NTOK; gm.N = 2048; gm.K = 1024;
    pg8::StaticOrder S; S.init(NTOK, 2048, G, bid);
    pg8::EpiBf16<0> E; E.O = (bf16_t*)(ws + WS_Q); E.ldc = 2048; E.bias = nullptr; E.split_cols = 0; E.split_stride = 0;
    pg8::gemm_phase<pg8::EpiBf16<0>, pg8::StaticOrder, false>(lds, gm, S, E, nullptr); }
MK_NOINL void P10_topk(LAS unsigned char* lds, int layer) { MK_LOADARGS; (void)layer; for (int u = bid; u < NTOK / 64; u += G) topk_unit(a, u, lds); }
MK_NOINL void P11_peer(LAS unsigned char* lds, int layer) { MK_LOADARGS; for (int u = bid; u < NTOK / 64; u += G) peer_unit(a, layer, u); }
}

#ifndef MK_PHASE_MASK
#define MK_PHASE_MASK 0xFFFu
#endif
#define MK_RUN(k) ((((MK_PHASE_MASK) >> ((k) - pb)) & 1u) && (k) >= ph_lo && (k) < ph_hi)
#define MK_NPHASES (1 + mk::DEPTH * mk::NPH)
#define MK_SYNC(k) do { if ((k) >= ph_lo && (k) + 1 < ph_hi) xcd_barrier(bar); } while (0)
__global__ __launch_bounds__(512, 2) void mk_fwd(mk::Args a) {
    using namespace mk;
    extern __shared__ __attribute__((aligned(16))) unsigned char smem_raw[];
    LAS unsigned char* lds = (LAS unsigned char*)smem_raw;
    const int ph_lo = a.ph_lo, ph_hi = a.ph_hi;
    {
        const unsigned* src = (const unsigned*)&a;
        if (threadIdx.x < sizeof(Args) / 4) ((LAS unsigned*)(lds + LDS_ARG_OFF))[threadIdx.x] = src[threadIdx.x];
        if (threadIdx.x == 0) { LAS unsigned* st = (LAS unsigned*)(lds + LDS_BAR_OFF); st[0] = 0u; st[1] = 0u; st[2] = 0u; st[3] = 0u; }
    }
    __syncthreads();
    XcdBarrier bar; bar.bar = (unsigned*)(a.ws + WS_CTL); bar.x = 0u; bar.st = (volatile LAS unsigned*)(lds + LDS_BAR_OFF);
    if (ph_hi - ph_lo > 1) bar = xcd_barrier_post((unsigned*)(a.ws + WS_CTL), (volatile LAS unsigned*)(lds + LDS_BAR_OFF));
    if (0 >= ph_lo && 0 < ph_hi) PG_prologue(lds);
    MK_SYNC(0);
#pragma unroll 1
    for (int layer = 0; layer < DEPTH; ++layer) {
        const int pb = 1 + layer * NPH;
        if (MK_RUN(pb + 0)) P0_conv(lds, layer);
        MK_SYNC(pb + 0);
        if (MK_RUN(pb + 1)) P1_inproj(lds, layer);
        MK_SYNC(pb + 1);
        if (MK_RUN(pb + 2)) P2_rope(lds, layer);
        MK_SYNC(pb + 2);
        if (MK_RUN(pb + 3)) { P3a_attn(lds, layer); P3b_retkv(lds, layer); P3c_lru(lds, layer, 0); }
        MK_SYNC(pb + 3);
        if (MK_RUN(pb + 4)) { P4_scan_merge(lds, layer); P3c_lru(lds, layer, 1); }
        MK_SYNC(pb + 4);
        if (MK_RUN(pb + 5)) P5_retout(lds, layer);
        MK_SYNC(pb + 5);
        if (MK_RUN(pb + 6)) P6_branch(lds, layer);
        MK_SYNC(pb + 6);
        if (MK_RUN(pb + 7)) P7_outproj(lds, layer);
        MK_SYNC(pb + 7);
        if (MK_RUN(pb + 8)) P8_ln1(lds, layer);
        MK_SYNC(pb + 8);
        if (MK_RUN(pb + 9)) P9_wq(lds, layer);
        MK_SYNC(pb + 9);
        if (MK_RUN(pb + 10)) P10_topk(lds, layer);
        MK_SYNC(pb + 10);
        if (MK_RUN(pb + 11)) P11_peer(lds, layer);
        MK_SYNC(pb + 11);
    }
}

#ifndef MK_SINGLE
#define MK_SINGLE 1
#endif
extern "C" void kernel_launch(void* const* d_in, const int* in_sizes, int n_in, void* d_out, int out_size, void* d_ws, size_t ws_size, hipStream_t stream) {
    using namespace mk;
    static int grid = 0;
    if (grid == 0) {
        if (n_in != 20 || out_size != NTOK * D || ws_size < WS_END) { fprintf(stderr, "kernel_launch: unexpected shapes (n_in %d, out %d, ws %zu, need %zu)\n", n_in, out_size, ws_size, (size_t)WS_END); grid = -1; return; }
        int dev = 0, cus = 0, per_cu = 0;
        if (hipGetDevice(&dev) != hipSuccess || hipDeviceGetAttribute(&cus, hipDeviceAttributeMultiprocessorCount, dev) != hipSuccess) { grid = -1; return; }
        if (hipFuncSetAttribute((const void*)mk_fwd, hipFuncAttributeMaxDynamicSharedMemorySize, LDS_BYTES) != hipSuccess) { fprintf(stderr, "kernel_launch: hipFuncSetAttribute failed\n"); grid = -1; return; }
        if (hipOccupancyMaxActiveBlocksPerMultiprocessor(&per_cu, (const void*)mk_fwd, 512, LDS_BYTES) != hipSuccess || per_cu < 1) { fprintf(stderr, "kernel_launch: occupancy query says %d blocks per CU\n", per_cu); (void)hipGetLastError(); grid = -1; return; }
        grid = cus;
    }
    if (grid < 0) return;
    (void)in_sizes;
    Args a{};
    for (int i = 0; i < 20; ++i) a.in[i] = (const float*)d_in[i];
    a.out = (float*)d_out; a.ws = (unsigned char*)d_ws;
    a.ropeA = pow(10000.0, -2.0 / 128.0); a.ropeR = pow(10000.0, -2.0 / 256.0);
#if MK_SINGLE
    (void)hipMemsetAsync((unsigned char*)d_ws + WS_CTL, 0, 16384, stream);
    a.ph_lo = 0; a.ph_hi = MK_NPHASES;
    hipLaunchKernelGGL(mk_fwd, dim3(grid), dim3(512), LDS_BYTES, stream, a);
#else
    for (int p = 0; p < MK_NPHASES; ++p) { a.ph_lo = p; a.ph_hi = p + 1; hipLaunchKernelGGL(mk_fwd, dim3(grid), dim3(512), LDS_BYTES, stream, a); }
#endif
}
```

```cpp
#include <hip/hip_runtime.h>
#include <cstdio>
#include <cstdint>
#include <cmath>
#include <cfloat>
__device__ __forceinline__ int mk_tid() { int t = (int)threadIdx.x; asm volatile("" : "+v"(t)); return t; }
namespace pg8 {
#define PG8_LAS __attribute__((address_space(3)))
typedef unsigned short bf16_t;
typedef short bf16x8 __attribute__((ext_vector_type(8)));
typedef float f32x4 __attribute__((ext_vector_type(4)));
typedef unsigned u32x4 __attribute__((ext_vector_type(4)));
constexpr int BM = 256, BK = 64, HALF = 128, HTB = HALF * BK * 2  , STAGE_BYTES = 8 * HTB, NXCD = 8, WGM = 8;

__host__ __device__ __forceinline__ int lds_byte(int r, int c) { const int st = (r >> 4) * 2 + (c >> 5), rr = r & 15, cc = c & 31, ob = rr * 64 + cc * 2; return st * 1024 + (ob ^ (((ob >> 9) & 1) << 5)); }
__host__ __device__ __forceinline__ void stage_rc(int b, int& R, int& C) { const int st = b / 1024, sb = b % 1024, swz = sb ^ (((sb >> 9) & 1) << 5); R = (st >> 1) * 16 + swz / 64; C = (st & 1) * 32 + (swz % 64) / 2; }
__host__ __device__ __forceinline__ int perm32(int rho) { const int n = rho >> 4, i = rho & 15; return 8 * (i >> 2) + 4 * n + (i & 3); }

struct Unit { int pm, pn; };
struct Gemm { const bf16_t* A; const bf16_t* Bt; int M, N, K; };

struct StaticOrder {
    int nM, nN, nwg, G, c;
    __host__ __device__ void init(int M, int N, int G_, int c_) { nM = M / BM; nN = N / BM; nwg = nM * nN; G = G_; c = c_; }
    __host__ __device__ bool next(int i, Unit& u) const {
        const long L = (long)i * G + c; if (L >= nwg) return false;
        int wgid = (int)L; { const int q = nwg / NXCD, r = nwg % NXCD, xcd = wgid % NXCD, off = wgid / NXCD; wgid = (xcd < r ? xcd * (q + 1) : r * (q + 1) + (xcd - r) * q) + off; }
        const int nig = WGM * nN, gid = wgid / nig, fm = gid * WGM, gsz = (nM - fm) < WGM ? (nM - fm) : WGM;
        u.pm = fm + ((wgid % nig) % gsz); u.pn = (wgid % nig) / gsz; return true;
    }
    __device__ __forceinline__ void a_ready(const Unit&) const {}
    __device__ __forceinline__ void done(const Unit&) const {}
};
__device__ __forceinline__ unsigned cvt_pk_bf16(float lo, float hi) { unsigned r; asm volatile("v_cvt_pk_bf16_f32 %0, %1, %2" : "=v"(r) : "v"(lo), "v"(hi)); return r; }
typedef float f32x2 __attribute__((ext_vector_type(2)));
__device__ __forceinline__ f32x2 gelu_pk(f32x2 v) {
    const f32x2 av = __builtin_elementwise_abs(v), d = av * 0.2316418882f + 1.0f;
    f32x2 t; t.x = __builtin_amdgcn_rcpf(d.x); t.y = __builtin_amdgcn_rcpf(d.y);
    f32x2 q = t * 0.5307027145f + (-0.7265760135f); q = q * t + 0.7107068705f; q = q * t + (-0.142248368f); q = q * t + 0.127414796f; q = q * t;
    const f32x2 s = (v * v) * (-0.72134752044f);
    f32x2 e; e.x = __builtin_amdgcn_exp2f(s.x); e.y = __builtin_amdgcn_exp2f(s.y);
    const f32x2 m = v * (q * e), r = v - m;
    f32x2 o; o.x = v.x < 0.f ? m.x : r.x; o.y = v.y < 0.f ? m.y : r.y; return o;
}

struct EpiF32 {
    static constexpr bool PERM = false, AFTER_DRAIN = false;
    float* C; int ldc; const float* bias;
    __device__ __forceinline__ void operator()(const f32x4 (&acc)[2][2][4][2], const Unit& u, int wr, int wc, int fr, int fq) const {
        const int row0 = u.pm * BM + wr * 64 + fr, col0 = u.pn * BM + wc * 32 + 4 * fq;
        f32x4 bv[2][2];
#pragma unroll
        for (int bj = 0; bj < 2; ++bj)
#pragma unroll
            for (int n = 0; n < 2; ++n) bv[bj][n] = bias ? *(const f32x4*)(bias + col0 + bj * HALF + n * 16) : (f32x4){0.f, 0.f, 0.f, 0.f};
#pragma unroll
        for (int ai = 0; ai < 2; ++ai)
#pragma unroll
            for (int m = 0; m < 4; ++m) { float* rowp = C + (size_t)(row0 + ai * HALF + m * 16) * ldc + col0;
#pragma unroll
                for (int bj = 0; bj < 2; ++bj)
#pragma unroll
                    for (int n = 0; n < 2; ++n) *(f32x4*)(rowp + bj * HALF + n * 16) = acc[ai][bj][m][n] + bv[bj][n]; }
    }
};
template <int ACT  > struct EpiBf16 {
    static constexpr bool PERM = true, AFTER_DRAIN = false;
    bf16_t* O; int ldc; const float* bias; int split_cols; size_t split_stride;
    __device__ __forceinline__ void operator()(const f32x4 (&acc)[2][2][4][2], const Unit& u, int wr, int wc, int fr, int fq) const {
        const int row0 = u.pm * BM + wr * 64 + fr; int colt = u.pn * BM; bf16_t* base = O;
        if (split_cols) { const int t = colt / split_cols; base += (size_t)t * split_stride; colt -= t * split_cols; }
        const int col0 = colt + wc * 32 + 8 * fq, bcol0 = u.pn * BM + wc * 32 + 8 * fq;
        f32x4 bv[2][2];
#pragma unroll
        for (int bj = 0; bj < 2; ++bj)
#pragma unroll
            for (int n = 0; n < 2; ++n) bv[bj][n] = bias ? *(const f32x4*)(bias + bcol0 + bj * HALF + 4 * n) : (f32x4){0.f, 0.f, 0.f, 0.f};
#pragma unroll
        for (int ai = 0; ai < 2; ++ai)
#pragma unroll
            for (int m = 0; m < 4; ++m) { bf16_t* rowp = base + (size_t)(row0 + ai * HALF + m * 16) * ldc + col0;
#pragma unroll
                for (int bj = 0; bj < 2; ++bj) { f32x4 v0 = acc[ai][bj][m][0] + bv[bj][0], v1 = acc[ai][bj][m][1] + bv[bj][1];
                    if (ACT == 1) { f32x2 a = gelu_pk((f32x2){v0[0], v0[1]}), b = gelu_pk((f32x2){v0[2], v0[3]}), c = gelu_pk((f32x2){v1[0], v1[1]}), d = gelu_pk((f32x2){v1[2], v1[3]});
                        v0 = (f32x4){a.x, a.y, b.x, b.y}; v1 = (f32x4){c.x, c.y, d.x, d.y}; }
                    if (ACT == 2) {
#pragma unroll
                        for (int j = 0; j < 4; ++j) { v0[j] = 0.5f * v0[j] * (1.0f + erff(v0[j] * 0.70710678f)); v1[j] = 0.5f * v1[j] * (1.0f + erff(v1[j] * 0.70710678f)); } }
                    u32x4 w; w.x = cvt_pk_bf16(v0[0], v0[1]); w.y = cvt_pk_bf16(v0[2], v0[3]); w.z = cvt_pk_bf16(v1[0], v1[1]); w.w = cvt_pk_bf16(v1[2], v1[3]);
                    *(u32x4*)(rowp + bj * HALF) = w; } }
    }
};

template <class Epi, class Sched, bool STAMP = false>
__device__ __forceinline__ void gemm_phase(PG8_LAS unsigned char* lds, const Gemm g, const Sched& S, const Epi& E, unsigned long long* stamps) {
    const int tid = mk_tid(), wid = __builtin_amdgcn_readfirstlane(tid >> 6), lane = tid & 63, wr = wid >> 2, wc = wid & 3, fr = lane & 15, fq = lane >> 4;
    const int K = g.K, nt = K / BK;
    int ts_lo = 0, ts_hi = 0, nts = 0; const unsigned long long rt_entry = STAMP ? (unsigned long long)wall_clock64() : 0ull;
#define PG8_STAMP() do { if (STAMP && wid == 0 && nts < 64) { const unsigned long long _c = (unsigned long long)clock64(); \
        ts_lo = (lane == nts) ? (int)(unsigned)_c : ts_lo; ts_hi = (lane == nts) ? (int)(unsigned)(_c >> 32) : ts_hi; ++nts; } } while (0)
    PG8_STAMP();
    unsigned voffA[2], voffB[2];
#pragma unroll
    for (int i = 0; i < 2; ++i) { int R, C; stage_rc(tid * 16 + i * 8192, R, C); const int Rb = Epi::PERM ? ((R & ~31) + perm32(R & 31)) : R;
        voffA[i] = (unsigned)(R * K + C) * 2u; voffB[i] = (unsigned)(Rb * K + C) * 2u; }
    const size_t kstep = (size_t)(BK * 2);
    const size_t hstep = (size_t)HALF * K * 2;
    const size_t tstep = 2 * hstep;
    const unsigned ldsw = (unsigned)wid * 1024u;
    const int aoff = lds_byte(wr * 64 + fr, fq * 8), boff = lds_byte(wc * 32 + fr, fq * 8);
#define PG8_SA(b, h) (((b) * 2 + (h)) * HTB)
#define PG8_SB(b, h) ((4 + (b) * 2 + (h)) * HTB)
#define PG8_STAGE(bufoff, gbase, voff) do { _Pragma("unroll") for (int _i = 0; _i < 2; ++_i) \
        __builtin_amdgcn_global_load_lds((const unsigned*)((const char*)(gbase) + (voff)[_i]), (PG8_LAS unsigned*)(lds + (bufoff) + ldsw + _i * 8192), 16, 0, 0); } while (0)
#define PG8_LDA(dst, b, h) do { _Pragma("unroll") for (int m = 0; m < 4; ++m) _Pragma("unroll") for (int k = 0; k < 2; ++k) dst[m][k] = *(const PG8_LAS bf16x8*)(lds + PG8_SA(b, h) + aoff + m * 2048 + k * 1024); } while (0)
#define PG8_LDB(dst, b, h) do { _Pragma("unroll") for (int n = 0; n < 2; ++n) _Pragma("unroll") for (int k = 0; k < 2; ++k) dst[n][k] = *(const PG8_LAS bf16x8*)(lds + PG8_SB(b, h) + boff + n * 2048 + k * 1024); } while (0)
#define PG8_MMA(ai, bj, At, Bt) do { __builtin_amdgcn_s_setprio(1); _Pragma("unroll") for (int m = 0; m < 4; ++m) _Pragma("unroll") for (int n = 0; n < 2; ++n) _Pragma("unroll") for (int k = 0; k < 2; ++k) \
        acc[ai][bj][m][n] = __builtin_amdgcn_mfma_f32_16x16x32_bf16(Bt[n][k], At[m][k], acc[ai][bj][m][n], 0, 0, 0); __builtin_amdgcn_s_setprio(0); } while (0)
#define PG8_WAIT_V(n) asm volatile("s_waitcnt vmcnt(" #n ")" ::: "memory")
#define PG8_WAIT_L(n) asm volatile("s_waitcnt lgkmcnt(" #n ")" ::: "memory")
#define PG8_BAR __builtin_amdgcn_s_barrier()
#define PG8_SCHED __builtin_amdgcn_sched_barrier(0)
    Unit cur, nxt; int ui = 0;
    if (!S.next(0, cur)) return;
    f32x4 acc[2][2][4][2];
#pragma unroll
    for (int a = 0; a < 2; ++a)
#pragma unroll
        for (int b = 0; b < 2; ++b)
#pragma unroll
            for (int m = 0; m < 4; ++m)
#pragma unroll
                for (int n = 0; n < 2; ++n) acc[a][b][m][n] = (f32x4){0.f, 0.f, 0.f, 0.f};
    bf16x8 At[4][2], B0[2][2], B1[2][2];
    const char* cA = (const char*)g.A + (size_t)cur.pm * tstep; const char* cB = (const char*)g.Bt + (size_t)cur.pn * tstep;
    S.a_ready(cur);
    PG8_STAGE(PG8_SB(0, 0), cB, voffB); PG8_STAGE(PG8_SA(0, 0), cA, voffA); PG8_STAGE(PG8_SB(0, 1), cB + hstep, voffB); PG8_STAGE(PG8_SA(0, 1), cA + hstep, voffA);
    if (wr == 1) PG8_BAR;
    PG8_WAIT_V(4); PG8_BAR;
    PG8_STAGE(PG8_SB(1, 0), cB + kstep, voffB); PG8_STAGE(PG8_SA(1, 0), cA + kstep, voffA); PG8_STAGE(PG8_SB(1, 1), cB + hstep + kstep, voffB);
    PG8_WAIT_V(6); PG8_BAR;
    PG8_STAMP();
    for (;;) {
        const bool has_next = S.next(ui + 1, nxt);
        const char* nA = has_next ? (const char*)g.A + (size_t)nxt.pm * tstep : cA; const char* nB = has_next ? (const char*)g.Bt + (size_t)nxt.pn * tstep : cB;
        for (int t = 0; t < nt; t += 2) {
            const bool last = (t == nt - 2);
            const char* a1 = cA + (size_t)(t + 1) * kstep;
            const char* a2 = last ? nA : cA + (size_t)(t + 2) * kstep; const char* b2 = last ? nB : cB + (size_t)(t + 2) * kstep;
            const char* a3 = a2 + kstep; const char* b3 = b2 + kstep;
            if (last && has_next) S.a_ready(nxt);
            PG8_LDB(B0, 0, 0); PG8_SCHED; PG8_LDA(At, 0, 0); PG8_STAGE(PG8_SA(1, 1), a1 + hstep, voffA);
            PG8_WAIT_L(8); PG8_BAR; PG8_WAIT_L(0); PG8_MMA(0, 0, At, B0); PG8_BAR; PG8_SCHED;
            PG8_LDB(B1, 0, 1); PG8_STAGE(PG8_SB(0, 0), b2, voffB);
            PG8_BAR; PG8_WAIT_L(0); PG8_MMA(0, 1, At, B1); PG8_BAR;
            PG8_LDA(At, 0, 1); PG8_STAGE(PG8_SA(0, 0), a2, voffA);
            PG8_BAR; PG8_WAIT_L(0); PG8_MMA(1, 0, At, B0); PG8_BAR; PG8_SCHED;
            PG8_STAGE(PG8_SB(0, 1), b2 + hstep, voffB);
            PG8_WAIT_V(6); PG8_BAR; PG8_MMA(1, 1, At, B1); PG8_BAR;
            PG8_LDB(B0, 1, 0); PG8_SCHED; PG8_LDA(At, 1, 0); PG8_STAGE(PG8_SA(0, 1), a2 + hstep, voffA);
            PG8_WAIT_L(8); PG8_BAR; PG8_WAIT_L(0); PG8_MMA(0, 0, At, B0); PG8_BAR; PG8_SCHED;
            PG8_LDB(B1, 1, 1); PG8_STAGE(PG8_SB(1, 0), b3, voffB);
            PG8_BAR; PG8_WAIT_L(0); PG8_MMA(0, 1, At, B1); PG8_BAR;
            PG8_LDA(At, 1, 1); PG8_STAGE(PG8_SA(1, 0), a3, voffA);
            PG8_BAR; PG8_WAIT_L(0); PG8_MMA(1, 0, At, B0); PG8_BAR; PG8_SCHED;
            PG8_STAGE(PG8_SB(1, 1), b3 + hstep, voffB);
            PG8_WAIT_V(6); PG8_BAR; PG8_MMA(1, 1, At, B1); PG8_BAR;
        }
        PG8_STAMP();
        if constexpr (!Epi::AFTER_DRAIN) { E(acc, cur, wr, wc, fr, fq); S.done(cur); }
        PG8_STAMP();
        if (!has_next) break;
#pragma unroll
        for (int a = 0; a < 2; ++a)
#pragma unroll
            for (int b = 0; b < 2; ++b)
#pragma unroll
                for (int m = 0; m < 4; ++m)
#pragma unroll
                    for (int n = 0; n < 2; ++n) acc[a][b][m][n] = (f32x4){0.f, 0.f, 0.f, 0.f};
        cur = nxt; cA = nA; cB = nB; ++ui;
    }
    PG8_WAIT_V(0);
    if (wr == 0) PG8_BAR;
    PG8_BAR;
    if constexpr (Epi::AFTER_DRAIN) { E.fused(acc, cur, wr, wc, fr, fq, lds, wid, lane); S.done(cur); }
    PG8_STAMP();
    if (STAMP && wid == 0) { stamps[lane] = lane < nts ? (((unsigned long long)(unsigned)ts_hi << 32) | (unsigned)ts_lo) : 0ull;
        if (lane == 62) stamps[62] = rt_entry; if (lane == 63) stamps[63] = (unsigned long long)wall_clock64(); }
#undef PG8_STAMP
#undef PG8_SA
#undef PG8_SB
#undef PG8_STAGE
#undef PG8_LDA
#undef PG8_LDB
#undef PG8_MMA
#undef PG8_WAIT_V
#undef PG8_WAIT_L
#undef PG8_BAR
#undef PG8_SCHED
}
}
#define XB_TMO      128
#define XB_XCNT(j)  (256  + 64 * (j))
#define XB_XSUB(j)  (1280 + 64 * (j))
#define XB_XGEN(j)  (2304 + 64 * (j))
#define XB_TOP      3328
#define XB_TOPGEN   3392
#define XCD_BAR_WORDS 3456
#define XB_SPIN_CAP (1u << 18)
#define LAS __attribute__((address_space(3)))

__device__ __forceinline__ unsigned xb_ld(unsigned* p)              { return __hip_atomic_load(p, __ATOMIC_RELAXED, __HIP_MEMORY_SCOPE_AGENT); }
__device__ __forceinline__ unsigned xb_add(unsigned* p, unsigned v) { return __hip_atomic_fetch_add(p, v, __ATOMIC_RELAXED, __HIP_MEMORY_SCOPE_AGENT); }
__device__ __forceinline__ unsigned xb_xcc_id() { return (unsigned)__builtin_amdgcn_s_getreg((3 << 11) | 20) & 0xFu; }
#define XB_SPIN(cond, bar) do { unsigned _sp = 0; while (cond) { __builtin_amdgcn_s_sleep(1); \
    if ((++_sp & 255u) == 0u) { if (xb_ld(&(bar)[XB_TMO])) break; if (_sp > XB_SPIN_CAP) { atomicAdd(&(bar)[XB_TMO], 1u); break; } } } } while (0)

struct XcdBarrier {
    unsigned* bar; unsigned x;
    volatile LAS unsigned* st;
};

__device__ __forceinline__ XcdBarrier xcd_barrier_post(unsigned* bar, volatile LAS unsigned* st) {
    XcdBarrier b; b.bar = bar; b.x = xb_xcc_id(); b.st = st;
    if (threadIdx.x == 0) (void)xb_add(&bar[XB_XCNT(b.x)], 1u);
    return b;
}
__device__ __forceinline__ void xcd_barrier_complete(unsigned* bar, unsigned x, unsigned& nloc, unsigned& nx) {
    const unsigned G = gridDim.x * gridDim.y * gridDim.z;
    unsigned sum, cnt, mine, sp = 0u;
    for (;;) {
        sum = 0u; cnt = 0u; mine = 0u;
#pragma unroll
        for (unsigned j = 0; j < 16; ++j) { const unsigned c = xb_ld(&bar[XB_XCNT(j)]); sum += c; cnt += (c > 0u) ? 1u : 0u; mine = (j == x) ? c : mine; }
        if (sum == G) break;
        __builtin_amdgcn_s_sleep(1);
        if ((++sp & 255u) == 0u) { if (xb_ld(&bar[XB_TMO])) break; if (sp > XB_SPIN_CAP) { atomicAdd(&bar[XB_TMO], 1u); break; } }
    }
    nloc = mine > 0u ? mine : 1u; nx = cnt > 0u ? cnt : 1u;
}

__device__ __forceinline__ void xcd_barrier(const XcdBarrier& b) {
    asm volatile("s_waitcnt vmcnt(0)" ::: "memory");
    __syncthreads();
    if (threadIdx.x == 0) {
        unsigned* bar = b.bar;
        __builtin_amdgcn_s_waitcnt(0);
        unsigned nloc = b.st[0], nx = b.st[1];
        if (nloc == 0u) { xcd_barrier_complete(bar, b.x, nloc, nx); b.st[0] = nloc; b.st[1] = nx; }
        const unsigned old = xb_add(&bar[XB_XSUB(b.x)], 1u);
        const unsigned gen = old / nloc;
        if (old + 1u == (gen + 1u) * nloc) {
            __builtin_amdgcn_fence(__ATOMIC_RELEASE, "agent");
            asm volatile("s_waitcnt vmcnt(0)" ::: "memory");
            const unsigned og = xb_add(&bar[XB_TOP], 1u);
            const unsigned tg = og / nx;
            if (og + 1u == (tg + 1u) * nx) xb_add(&bar[XB_TOPGEN], 1u);
            else XB_SPIN(xb_ld(&bar[XB_TOPGEN]) == tg, bar);
            __builtin_amdgcn_fence(__ATOMIC_ACQUIRE, "agent");
            xb_add(&bar[XB_XGEN(b.x)], 1u);
            asm volatile("s_waitcnt vmcnt(0)" ::: "memory");
        } else {
            XB_SPIN(xb_ld(&bar[XB_XGEN(b.x)]) == gen, bar);
            __builtin_amdgcn_fence(__ATOMIC_ACQUIRE, "agent");
            asm volatile("s_waitcnt vmcnt(0)" ::: "memory");
        }
    }
    __syncthreads();
}

namespace mk {
using pg8::bf16_t; using pg8::bf16x8; using pg8::f32x4; using pg8::u32x4;
typedef short s16x4 __attribute__((ext_vector_type(4)));
typedef unsigned u32x2 __attribute__((ext_vector_type(2)));
typedef __bf16 bf16x2v __attribute__((ext_vector_type(2)));
typedef int i32x4 __attribute__((ext_vector_type(4)));
#define DI __device__ __forceinline__

constexpr int D = 1024, SEQ = 4096, NTOK = 16384, DEPTH = 4, DIN = 13824;
constexpr int OFF_AQ = 0, OFF_AK = 1536, OFF_AV = 3072, OFF_LX = 4608, OFF_LG = 5632, OFF_RQ = 6656, OFF_RK = 7680, OFF_RV = 8704, OFF_RG = 9728, OFF_GA = 10752;
constexpr float ALPHA = 1.681792830507429f;
constexpr float LN_EPS = 1e-5f;
constexpr int NPH = 12;
constexpr int LDS_BYTES = 148 * 1024;
constexpr int LDS_BAR_OFF = LDS_BYTES - 16;

constexpr size_t WS_CTL  = 0;
constexpr size_t WS_COSA = 16384;
constexpr size_t WS_SINA = WS_COSA + (size_t)4096 * 64 * 4;
constexpr size_t WS_COSR = WS_SINA + (size_t)4096 * 64 * 4;
constexpr size_t WS_SINR = WS_COSR + (size_t)4096 * 128 * 4;
constexpr size_t WS_CCH  = WS_SINR + (size_t)4096 * 128 * 4;
constexpr size_t WS_WAT  = WS_CCH + 4096;
constexpr size_t WS_WXT  = WS_WAT + 131072;
constexpr size_t WS_LSTA = WS_WXT + 131072;
constexpr size_t WS_LSTH = WS_LSTA + 524288;
constexpr size_t WS_K1B  = WS_LSTH + 524288;
constexpr size_t WS_K2B  = WS_K1B + 262144;
constexpr size_t WS_XF   = WS_K2B + 262144;
constexpr size_t WS_XB   = WS_XF + (size_t)NTOK * D * 4;
constexpr size_t WS_WINT = WS_XB + (size_t)NTOK * D * 2;
constexpr size_t WS_WBAT = WS_WINT + (size_t)DIN * 1024 * 2;
constexpr size_t WS_WBBT = WS_WBAT + (size_t)1024 * 512 * 2;
constexpr size_t WS_WBCT = WS_WBBT + (size_t)1024 * 1024 * 2;
constexpr size_t WS_WOT  = WS_WBCT + (size_t)1024 * 1024 * 2;
constexpr size_t WS_WQT  = WS_WOT + (size_t)1024 * 1024 * 2;
constexpr size_t WS_UV8  = WS_WQT + (size_t)2048 * 1024 * 2;
constexpr size_t WS_UVS  = WS_UV8 + (size_t)16384 * 2048;
constexpr size_t WS_PROJ = WS_UVS + (size_t)16384 * 8;
constexpr size_t WS_OATT = WS_PROJ + (size_t)NTOK * DIN * 2;
constexpr size_t WS_LSE  = WS_OATT + (size_t)NTOK * 1536 * 2;
constexpr size_t WS_KVB  = WS_LSE + (size_t)NTOK * 12 * 4;
constexpr size_t WS_YA   = WS_KVB + (size_t)16 * 32 * 65536 * 2;
constexpr size_t WS_YB   = WS_YA + (size_t)NTOK * 512 * 2;
constexpr size_t WS_YC   = WS_YB + (size_t)NTOK * 1024 * 2;
constexpr size_t WS_MRGF = WS_YC + (size_t)NTOK * 1024 * 2;
constexpr size_t WS_MRGB = WS_MRGF + (size_t)NTOK * 1024 * 4;
constexpr size_t WS_END  = WS_MRGB + (size_t)NTOK * 1024 * 2;
constexpr size_t WS_Q    = WS_PROJ;
constexpr size_t WS_EID  = WS_PROJ + (size_t)NTOK * 2048 * 2;
constexpr size_t WS_GATE = WS_EID + (size_t)NTOK * 128 * 4;
static_assert(WS_END <= (size_t)1073741824, "workspace too large");
static_assert(WS_PROJ % 256 == 0 && WS_KVB % 256 == 0 && WS_MRGF % 256 == 0, "alignment");

struct Args { const float* in[20]; float* out; unsigned char* ws; double ropeA, ropeR; int ph_lo, ph_hi; };

DI float bflo(unsigned w) { return __uint_as_float(w << 16); }
DI float bfhi(unsigned w) { return __uint_as_float(w & 0xffff0000u); }
DI float bf2f(bf16_t v) { return __uint_as_float(((unsigned)v) << 16); }
DI unsigned pk2(float lo, float hi) { return pg8::cvt_pk_bf16(lo, hi); }
DI bf16_t f2bf(float f) { return (bf16_t)(pk2(f, 0.f) & 0xffffu); }
DI f32x4 mfma16(bf16x8 a, bf16x8 b, f32x4 c) { return __builtin_amdgcn_mfma_f32_16x16x32_bf16(a, b, c, 0, 0, 0); }
DI s16x4 trrd(LAS unsigned char* p) { return __builtin_amdgcn_ds_read_tr16_b64_v4i16((LAS s16x4*)p); }
DI bf16x8 cat8(s16x4 lo, s16x4 hi) { return __builtin_shufflevector(lo, hi, 0, 1, 2, 3, 4, 5, 6, 7); }
DI float wsum(float v) { v += __shfl_xor(v, 32); v += __shfl_xor(v, 16); v += __shfl_xor(v, 8); v += __shfl_xor(v, 4); v += __shfl_xor(v, 2); v += __shfl_xor(v, 1); return v; }
DI float sigm(float x) { return 1.f / (1.f + __expf(-x)); }
DI float gelu_erf(float x) { return 0.5f * x * (1.f + erff(x * 0.70710678118654752f)); }
DI float dot2(unsigned w, unsigned x, float acc) { return __builtin_amdgcn_fdot2_f32_bf16(__builtin_bit_cast(bf16x2v, w), __builtin_bit_cast(bf16x2v, x), acc, false); }
DI float log2gamma(int h) { return log2f(1.0f - exp2f(-5.0f - (float)h)); }

DI void sincos_d(double x, double& s, double& c) {
    const double n = rint(x * 0.63661977236758134308);
    double y = fma(-n, 1.57079632679489655800e+00, x); y = fma(-n, 6.12323399573676603587e-17, y);
    const double y2 = y * y;
    const double sp = y + y * y2 * (-1.0 / 6 + y2 * (1.0 / 120 + y2 * (-1.0 / 5040 + y2 * (1.0 / 362880 + y2 * (-1.0 / 39916800 + y2 * (1.0 / 6227020800.0))))));
    const double cp = 1.0 + y2 * (-0.5 + y2 * (1.0 / 24 + y2 * (-1.0 / 720 + y2 * (1.0 / 40320 + y2 * (-1.0 / 3628800 + y2 * (1.0 / 479001600.0 + y2 * (-1.0 / 87178291200.0)))))));
    const int q = ((int)n) & 3;
    s = (q == 0) ? sp : (q == 1) ? cp : (q == 2) ? -sp : -cp;
    c = (q == 0) ? cp : (q == 1) ? -sp : (q == 2) ? -cp : sp;
}

DI void tconv_tile(const float* src, int ldsrc, bf16_t* dst, int lddst, int k0, int n0, LAS float* t) {
    const int tid = mk_tid();
#pragma unroll
    for (int i = 0; i < 8; ++i) { const int idx = tid + 512 * i, r = idx >> 6, c = idx & 63; t[r * 65 + c] = src[(size_t)(k0 + r) * ldsrc + n0 + c]; }
    __syncthreads();
#pragma unroll
    for (int i = 0; i < 8; ++i) { const int idx = tid + 512 * i, n = idx >> 6, k = idx & 63; dst[(size_t)(n0 + n) * lddst + k0 + k] = f2bf(t[k * 65 + n]); }
    __syncthreads();
}
DI void conv_unit(const float* src, bf16_t* dst, int unit) {
    const size_t i = (size_t)unit * 4096 + (size_t)mk_tid() * 8;
    const f32x4 a = *(const f32x4*)(src + i), b = *(const f32x4*)(src + i + 4);
    u32x4 o; o.x = pk2(a[0], a[1]); o.y = pk2(a[2], a[3]); o.z = pk2(b[0], b[1]); o.w = pk2(b[2], b[3]);
    *(u32x4*)(dst + i) = o;
}
DI void conv_fp8_rows(const float* src, unsigned char* ws, int unit, int isV) {
    const int tid = mk_tid(), lane = tid & 63, w = tid >> 6;
    const size_t row = (size_t)unit * 8 + w;
    const float* sp = src + row * 1024 + 4 * lane;
    f32x4 v[4]; float m = 0.f;
#pragma unroll
    for (int i = 0; i < 4; ++i) { v[i] = *(const f32x4*)(sp + 256 * i); m = fmaxf(m, fmaxf(fmaxf(fabsf(v[i][0]), fabsf(v[i][1])), fmaxf(fabsf(v[i][2]), fabsf(v[i][3])))); }
    m = fmaxf(m, __shfl_xor(m, 32)); m = fmaxf(m, __shfl_xor(m, 16)); m = fmaxf(m, __shfl_xor(m, 8)); m = fmaxf(m, __shfl_xor(m, 4)); m = fmaxf(m, __shfl_xor(m, 2)); m = fmaxf(m, __shfl_xor(m, 1));
    const float sc = (m > 0.f) ? 384.0f / m : 1.0f, inv = (m > 0.f) ? m * (1.0f / 384.0f) : 1.0f;
    unsigned char* dp = ws + WS_UV8 + row * 2048 + (isV ? 1024 : 0) + 4 * lane;
#pragma unroll
    for (int i = 0; i < 4; ++i) { int wd = __builtin_amdgcn_cvt_pk_fp8_f32(v[i][0] * sc, v[i][1] * sc, 0, false); wd = __builtin_amdgcn_cvt_pk_fp8_f32(v[i][2] * sc, v[i][3] * sc, wd, true); *(int*)(dp + 256 * i) = wd; }
    if (lane == 0) ((float*)(ws + WS_UVS))[row * 2 + isV] = inv;
}
DI void phase_conv(const Args& a, int layer, LAS unsigned char* lds) {
    unsigned char* ws = a.ws;
    LAS float* t = (LAS float*)lds;
    const int J0 = 3456, J1 = J0 + 128, J2 = J1 + 256, J3 = J2 + 256, J4 = J3 + 256, J5 = J4 + 512, J6 = J5 + 32, J7 = J6 + 2048, J8 = J7 + 2048, J9 = J8 + 64, J10 = J9 + 1;
    const int total = J10;
    for (int u = blockIdx.x; u < total; u += gridDim.x) {
        if (u < J0) { const int kt = u / 216, nt = u % 216; tconv_tile(a.in[1] + (size_t)layer * 1024 * DIN, DIN, (bf16_t*)(ws + WS_WINT), 1024, kt * 64, nt * 64, t); }
        else if (u < J1) { const int v = u - J0, kt = v / 16, nt = v % 16; tconv_tile(a.in[9] + (size_t)layer * 2560 * 1024, 1024, (bf16_t*)(ws + WS_WBAT), 512, kt * 64, nt * 64, t); }
        else if (u < J2) { const int v = u - J1, kt = v / 16, nt = v % 16; tconv_tile(a.in[9] + (size_t)layer * 2560 * 1024 + (size_t)512 * 1024, 1024, (bf16_t*)(ws + WS_WBBT), 1024, kt * 64, nt * 64, t); }
        else if (u < J3) { const int v = u - J2, kt = v / 16, nt = v % 16; tconv_tile(a.in[9] + (size_t)layer * 2560 * 1024 + (size_t)1536 * 1024, 1024, (bf16_t*)(ws + WS_WBCT), 1024, kt * 64, nt * 64, t); }
        else if (u < J4) { const int v = u - J3, kt = v / 16, nt = v % 16; tconv_tile(a.in[10] + (size_t)layer * 1024 * 1024, 1024, (bf16_t*)(ws + WS_WOT), 1024, kt * 64, nt * 64, t); }
        else if (u < J5) { const int v = u - J4, kt = v / 32, nt = v % 32; tconv_tile(a.in[13] + (size_t)layer * 1024 * 2048, 2048, (bf16_t*)(ws + WS_WQT), 1024, kt * 64, nt * 64, t); }
        else if (u < J6) { const int v = u - J5, blk = v & 15, which = v >> 4;
            tconv_tile(a.in[which ? 6 : 4] + ((size_t)layer * 16 + blk) * 4096, 64, (bf16_t*)(ws + (which ? WS_WXT : WS_WAT)) + blk * 4096, 64, 0, 0, t); }
        else if (u < J7) { conv_fp8_rows(a.in[16] + (size_t)layer * 16384 * 1024, ws, u - J6, 0); }
        else if (u < J8) { conv_fp8_rows(a.in[17] + (size_t)layer * 16384 * 1024, ws, u - J7, 1); }
        else if (u < J9) { const int v = u - J8; if (v < 32) conv_unit(a.in[14] + (size_t)layer * 131072, (bf16_t*)(ws + WS_K1B), v); else conv_unit(a.in[15] + (size_t)layer * 131072, (bf16_t*)(ws + WS_K2B), v - 32); }
        else { for (int c = mk_tid(); c < 1024; c += 512) { const float lam = a.in[8][layer * 1024 + c]; ((float*)(ws + WS_CCH))[c] = -8.0f * log1pf(expf(-lam)); } }
    }
}

DI void phase_prologue(const Args& a) {
    unsigned char* ws = a.ws;
    const int tid = mk_tid();
    for (int u = blockIdx.x; u < 4096 + 1536; u += gridDim.x) {
        if (u < 4096) { const size_t i = (size_t)u * 4096 + (size_t)tid * 8;
            const f32x4 p = *(const f32x4*)(a.in[0] + i), q = *(const f32x4*)(a.in[0] + i + 4);
            *(f32x4*)((float*)(ws + WS_XF) + i) = p; *(f32x4*)((float*)(ws + WS_XF) + i + 4) = q;
            u32x4 o; o.x = pk2(p[0], p[1]); o.y = pk2(p[2], p[3]); o.z = pk2(q[0], q[1]); o.w = pk2(q[2], q[3]);
            *(u32x4*)((bf16_t*)(ws + WS_XB) + i) = o; }
        else { const int idx = (u - 4096) * 512 + tid;
            const int pos = idx / 192, i = idx % 192;
            const bool isA = i < 64; const int fi = isA ? i : i - 64; const double r = isA ? a.ropeA : a.ropeR;
            double inv = 1.0; for (int k = 0; k < fi; ++k) inv *= r;
            double s, c; sincos_d((double)pos * inv, s, c);
            if (isA) { ((float*)(ws + WS_COSA))[pos * 64 + fi] = (float)c; ((float*)(ws + WS_SINA))[pos * 64 + fi] = (float)s; }
            else { ((float*)(ws + WS_COSR))[pos * 128 + fi] = (float)c; ((float*)(ws + WS_SINR))[pos * 128 + fi] = (float)s; } }
    }
}

DI void phase_rope(const Args& a) {
    unsigned char* ws = a.ws; bf16_t* proj = (bf16_t*)(ws + WS_PROJ);
    for (int u = blockIdx.x; u < NTOK / 8; u += gridDim.x) {
#pragma unroll 1
        for (int i = 0; i < 5; ++i) {
            const int idx = mk_tid() + 512 * i, tk = u * 8 + idx / 320; int it = idx % 320;
            int off, hd, half, head, ch; const float* ct; const float* st; float sc = 1.0f;
            if (it < 192) { off = (it < 96) ? OFF_AQ : OFF_AK; if (it >= 96) it -= 96; hd = 128; half = 64; head = it >> 3; ch = it & 7; ct = (const float*)(ws + WS_COSA); st = (const float*)(ws + WS_SINA); }
            else { it -= 192; off = (it < 64) ? OFF_RQ : OFF_RK; if (it >= 64) { it -= 64; sc = 0.0625f; } hd = 256; half = 128; head = it >> 4; ch = it & 15; ct = (const float*)(ws + WS_COSR); st = (const float*)(ws + WS_SINR); }
            const int pos = tk & (SEQ - 1);
            bf16_t* p1 = proj + (size_t)tk * DIN + off + head * hd + ch * 8; bf16_t* p2 = p1 + half;
            const u32x4 x1 = *(const u32x4*)p1, x2 = *(const u32x4*)p2;
            const float* cp = ct + (size_t)pos * half + ch * 8; const float* sp = st + (size_t)pos * half + ch * 8;
            const f32x4 c0 = *(const f32x4*)cp, c1 = *(const f32x4*)(cp + 4), s0 = *(const f32x4*)sp, s1 = *(const f32x4*)(sp + 4);
            float t1[8], t2[8], cc[8], ss[8];
#pragma unroll
            for (int q = 0; q < 4; ++q) { t1[2 * q] = bflo(x1[q]); t1[2 * q + 1] = bfhi(x1[q]); t2[2 * q] = bflo(x2[q]); t2[2 * q + 1] = bfhi(x2[q]); cc[q] = c0[q]; cc[4 + q] = c1[q]; ss[q] = s0[q]; ss[4 + q] = s1[q]; }
            u32x4 o1, o2;
#pragma unroll
            for (int q = 0; q < 4; ++q) {
                const float a0 = (t1[2 * q] * cc[2 * q] - t2[2 * q] * ss[2 * q]) * sc, a1 = (t1[2 * q + 1] * cc[2 * q + 1] - t2[2 * q + 1] * ss[2 * q + 1]) * sc;
                const float b0 = (t1[2 * q] * ss[2 * q] + t2[2 * q] * cc[2 * q]) * sc, b1 = (t1[2 * q + 1] * ss[2 * q + 1] + t2[2 * q + 1] * cc[2 * q + 1]) * sc;
                o1[q] = pk2(a0, a1); o2[q] = pk2(b0, b1); }
            *(u32x4*)p1 = o1; *(u32x4*)p2 = o2;
        }
    }
}

DI void attn_unit(const Args& a, int unit, LAS unsigned char* lds) {
    unsigned char* ws = a.ws;
    const int tid = mk_tid(), lane = tid & 63, w = __builtin_amdgcn_readfirstlane(tid >> 6), g = lane >> 4, l15 = lane & 15, tq4 = l15 >> 2, tp4 = l15 & 3;
    const int b = unit / 384, rem = unit % 384, h = rem >> 5, bi = rem & 31;
    const int grp = h >> 2, d = (grp == 0) ? 1 : ((grp == 1) ? 4 : 16), nb = 32 / d, r = bi / nb, n = bi % nb;
    const bf16_t* proj = (const bf16_t*)(ws + WS_PROJ) + (size_t)b * SEQ * DIN;
    LAS unsigned char* Ks = lds; LAS unsigned char* Vs = lds + 256 * 288;
#pragma unroll
    for (int i = 0; i < 8; ++i) {
        const int idx = tid + 512 * i, row = idx >> 4, ch = idx & 15, m = 128 * (n - 1) + row;
        u32x4 kv = {0u, 0u, 0u, 0u}, vv = {0u, 0u, 0u, 0u};
        if (m >= 0) { const bf16_t* p = proj + (size_t)(m * d + r) * DIN + h * 128 + ch * 8; kv = *(const u32x4*)(p + OFF_AK); vv = *(const u32x4*)(p + OFF_AV); }
        *(LAS u32x4*)(Ks + row * 288 + ch * 16) = kv; *(LAS u32x4*)(Vs + row * 288 + ch * 16) = vv;
    }
    const int qi = 16 * w + l15;
    const size_t tq = (size_t)(128 * n + qi) * d + r;
    bf16x8 qf[4];
#pragma unroll
    for (int ks = 0; ks < 4; ++ks) qf[ks] = *(const bf16x8*)(proj + tq * DIN + OFF_AQ + h * 128 + 32 * ks + 8 * g);
    __syncthreads();
    const int s0 = w >> 1;
    f32x4 sacc[10];
#pragma unroll
    for (int jj = 0; jj < 10; ++jj) {
        f32x4 acc = {0.f, 0.f, 0.f, 0.f};
#pragma unroll
        for (int ks = 0; ks < 4; ++ks) { const bf16x8 kf = *(const LAS bf16x8*)(Ks + (32 * s0 + 16 * jj + l15) * 288 + (32 * ks + 8 * g) * 2); acc = mfma16(kf, qf[ks], acc); }
        sacc[jj] = acc;
    }
    const float scale = 0.08838834764831845f;
    float mx = -1e30f;
#pragma unroll
    for (int jj = 0; jj < 10; ++jj)
#pragma unroll
        for (int rg = 0; rg < 4; ++rg) {
            const int j = 32 * s0 + 16 * jj + 4 * g + rg;
            const bool valid = (j >= qi) && (j <= qi + 128) && (n > 0 || j >= 128);
            const float s = valid ? sacc[jj][rg] * scale : -1e30f;
            sacc[jj][rg] = s; mx = fmaxf(mx, s);
        }
    mx = fmaxf(mx, __shfl_xor(mx, 16)); mx = fmaxf(mx, __shfl_xor(mx, 32));
    float sum = 0.f;
#pragma unroll
    for (int jj = 0; jj < 10; ++jj)
#pragma unroll
        for (int rg = 0; rg < 4; ++rg) { const float p = __expf(sacc[jj][rg] - mx); sacc[jj][rg] = p; sum += p; }
    sum += __shfl_xor(sum, 16); sum += __shfl_xor(sum, 32);
    f32x4 oacc[8];
#pragma unroll
    for (int db = 0; db < 8; ++db) oacc[db] = (f32x4){0.f, 0.f, 0.f, 0.f};
#pragma unroll
    for (int s = 0; s < 5; ++s) {
        u32x4 pw; pw.x = pk2(sacc[2 * s][0], sacc[2 * s][1]); pw.y = pk2(sacc[2 * s][2], sacc[2 * s][3]); pw.z = pk2(sacc[2 * s + 1][0], sacc[2 * s + 1][1]); pw.w = pk2(sacc[2 * s + 1][2], sacc[2 * s + 1][3]);
        const bf16x8 pb = __builtin_bit_cast(bf16x8, pw);
        const int k0 = 32 * (s0 + s) + 4 * g + tq4;
#pragma unroll
        for (int db = 0; db < 8; ++db) {
            const s16x4 lo = trrd(Vs + k0 * 288 + (16 * db + 4 * tp4) * 2), hi = trrd(Vs + (k0 + 16) * 288 + (16 * db + 4 * tp4) * 2);
            oacc[db] = mfma16(cat8(lo, hi), pb, oacc[db]);
        }
    }
    const float inv = 1.0f / sum;
    bf16_t* op = (bf16_t*)(ws + WS_OATT) + ((size_t)b * SEQ + tq) * 1536 + h * 128 + 4 * g;
#pragma unroll
    for (int db = 0; db < 8; ++db) { u32x2 o; o.x = pk2(oacc[db][0] * inv, oacc[db][1] * inv); o.y = pk2(oacc[db][2] * inv, oacc[db][3] * inv); *(u32x2*)(op + 16 * db) = o; }
    if (g == 0) ((float*)(ws + WS_LSE))[((size_t)b * SEQ + tq) * 12 + h] = mx + __logf(sum);
    __syncthreads();
}

DI void retkv_unit(const Args& a, int unit, LAS unsigned char* lds) {
    unsigned char* ws = a.ws;
    const int tid = mk_tid(), lane = tid & 63, w = __builtin_amdgcn_readfirstlane(tid >> 6), g = lane >> 4, l15 = lane & 15, tq4 = l15 >> 2, tp4 = l15 & 3;
    const int b = unit >> 7, h = (unit >> 5) & 3, c = unit & 31;
    const bf16_t* proj = (const bf16_t*)(ws + WS_PROJ) + ((size_t)b * SEQ + c * 128) * DIN;
    LAS unsigned char* Ks = lds; LAS unsigned char* Vs = lds + 128 * 544;
    const float l2g = log2gamma(h);
#pragma unroll
    for (int i = 0; i < 8; ++i) {
        const int idx = tid + 512 * i, row = idx >> 5, ch = idx & 31;
        const bf16_t* p = proj + (size_t)row * DIN + h * 256 + ch * 8;
        const u32x4 kv = *(const u32x4*)(p + OFF_RK), vv = *(const u32x4*)(p + OFF_RV);
        const float z = exp2f((float)(127 - row) * l2g);
        u32x4 kz;
#pragma unroll
        for (int q = 0; q < 4; ++q) kz[q] = pk2(bflo(kv[q]) * z, bfhi(kv[q]) * z);
        *(LAS u32x4*)(Ks + row * 544 + ch * 16) = kz; *(LAS u32x4*)(Vs + row * 544 + ch * 16) = vv;
    }
    __syncthreads();
#pragma unroll 1
    for (int nh = 0; nh < 2; ++nh) {
        f32x4 acc[2][8];
#pragma unroll
        for (int mb = 0; mb < 2; ++mb)
#pragma unroll
            for (int nb = 0; nb < 8; ++nb) acc[mb][nb] = (f32x4){0.f, 0.f, 0.f, 0.f};
#pragma unroll
        for (int ks = 0; ks < 4; ++ks) {
            const int j0 = 32 * ks + 4 * g + tq4;
            bf16x8 af[2];
#pragma unroll
            for (int mb = 0; mb < 2; ++mb) { const int col = 32 * w + 16 * mb + 4 * tp4; af[mb] = cat8(trrd(Vs + j0 * 544 + col * 2), trrd(Vs + (j0 + 16) * 544 + col * 2)); }
#pragma unroll
            for (int nb = 0; nb < 8; ++nb) {
                const int col = 128 * nh + 16 * nb + 4 * tp4;
                const bf16x8 bfr = cat8(trrd(Ks + j0 * 544 + col * 2), trrd(Ks + (j0 + 16) * 544 + col * 2));
#pragma unroll
                for (int mb = 0; mb < 2; ++mb) acc[mb][nb] = mfma16(af[mb], bfr, acc[mb][nb]);
            }
        }
        bf16_t* kvb = (bf16_t*)(ws + WS_KVB) + ((size_t)((b * 4 + h) * 32 + c)) * 65536 + 128 * nh;
#pragma unroll
        for (int mb = 0; mb < 2; ++mb)
#pragma unroll
            for (int nb = 0; nb < 8; ++nb)
#pragma unroll
                for (int rg = 0; rg < 4; ++rg) kvb[(size_t)(32 * w + 16 * mb + 4 * g + rg) * 256 + 16 * nb + l15] = f2bf(acc[mb][nb][rg]);
    }
    __syncthreads();
}

DI void lru_unit(const Args& a, int layer, int unit, bool fin, LAS unsigned char* lds) {
    unsigned char* ws = a.ws;
    const int tid = mk_tid(), lane = tid & 63, w = __builtin_amdgcn_readfirstlane(tid >> 6), g = lane >> 4, l15 = lane & 15;
    const int b = unit >> 9, c = (unit >> 4) & 31, blk = unit & 15;
    LAS bf16_t* lxs = (LAS bf16_t*)lds;
    LAS float* xcf = (LAS float*)(lds + 16896);
    LAS unsigned char* xcb = lds + 49664;
    LAS float* rgt = (LAS float*)(lds + 68096);
    LAS float* igt = (LAS float*)(lds + 100864);
    LAS float* wst = (LAS float*)(lds + 133632);
    const bf16_t* proj = (const bf16_t*)(ws + WS_PROJ) + (size_t)b * SEQ * DIN;
    for (int idx = tid; idx < 131 * 8; idx += 512) {
        const int row = idx >> 3, ch = idx & 7, tk = c * 128 - 3 + row;
        u32x4 v = {0u, 0u, 0u, 0u};
        if (tk >= 0) v = *(const u32x4*)(proj + (size_t)tk * DIN + OFF_LX + blk * 64 + ch * 8);
        *(LAS u32x4*)(lxs + row * 64 + ch * 8) = v;
    }
    __syncthreads();
    {
        const int ch = tid & 63, gc = blk * 64 + ch;
        const float* cw = a.in[2] + (size_t)layer * 4096;
        const float cw0 = cw[gc], cw1 = cw[1024 + gc], cw2 = cw[2048 + gc], cw3 = cw[3072 + gc], cb = a.in[3][layer * 1024 + gc];
#pragma unroll
        for (int i = 0; i < 16; ++i) {
            const int t = (tid >> 6) + 8 * i;
            const float xc = cb + cw0 * bf2f(lxs[t * 64 + ch]) + cw1 * bf2f(lxs[(t + 1) * 64 + ch]) + cw2 * bf2f(lxs[(t + 2) * 64 + ch]) + cw3 * bf2f(lxs[(t + 3) * 64 + ch]);
            xcf[t * 64 + ch] = xc; *(LAS bf16_t*)(xcb + t * 144 + ch * 2) = f2bf(xc);
        }
    }
    __syncthreads();
#pragma unroll
    for (int gate = 0; gate < 2; ++gate) {
        const bf16_t* WT = (const bf16_t*)(ws + (gate ? WS_WXT : WS_WAT)) + blk * 4096;
        const float* bias = a.in[gate ? 7 : 5] + layer * 1024 + blk * 64;
        LAS float* dst = gate ? igt : rgt;
#pragma unroll
        for (int nb = 0; nb < 4; ++nb) {
            f32x4 acc = {0.f, 0.f, 0.f, 0.f};
#pragma unroll
            for (int ks = 0; ks < 2; ++ks) {
                const bf16x8 af = *(const LAS bf16x8*)(xcb + (16 * w + l15) * 144 + (32 * ks + 8 * g) * 2);
                const bf16x8 bfr = *(const bf16x8*)(WT + (16 * nb + l15) * 64 + 32 * ks + 8 * g);
                acc = mfma16(af, bfr, acc);
            }
            const float bv = bias[16 * nb + l15];
#pragma unroll
            for (int rg = 0; rg < 4; ++rg) dst[(16 * w + 4 * g + rg) * 64 + 16 * nb + l15] = sigm(acc[rg] + bv);
        }
    }
    __syncthreads();
    const int ch = lane, gc = blk * 64 + ch;
    const float cc = ((const float*)(ws + WS_CCH))[gc];
    float av[16], bv[16]; float Aw = 1.0f, Hw = 0.0f;
#pragma unroll
    for (int tt = 0; tt < 16; ++tt) {
        const int t = 16 * w + tt;
        const float la = cc * rgt[t * 64 + ch];
        const float aa = __expf(la);
        const float bb = sqrtf(-expm1f(2.0f * la)) * igt[t * 64 + ch] * xcf[t * 64 + ch];
        av[tt] = aa; bv[tt] = bb; Hw = aa * Hw + bb; Aw *= aa;
    }
    wst[w * 64 + ch] = Aw; wst[512 + w * 64 + ch] = Hw;
    __syncthreads();
    float* LA = (float*)(ws + WS_LSTA); float* LH = (float*)(ws + WS_LSTH);
    if (!fin) {
        if (w == 0) {
            float A = 1.0f, H = 0.0f;
#pragma unroll
            for (int ww = 0; ww < 8; ++ww) { const float A_ = wst[ww * 64 + ch], H_ = wst[512 + ww * 64 + ch]; H = A_ * H + H_; A *= A_; }
            LA[(size_t)(b * 32 + c) * 1024 + gc] = A; LH[(size_t)(b * 32 + c) * 1024 + gc] = H;
        }
    } else {
        float hcur = 0.0f;
#pragma unroll
        for (int c0 = 0; c0 < 32; c0 += 16) {
            if (c0 < c) {
                float ta[16], th[16];
#pragma unroll
                for (int q = 0; q < 16; ++q) { const int cp = (c0 + q < c) ? c0 + q : 0; ta[q] = LA[(size_t)(b * 32 + cp) * 1024 + gc]; th[q] = LH[(size_t)(b * 32 + cp) * 1024 + gc]; }
#pragma unroll
                for (int q = 0; q < 16; ++q) hcur = (c0 + q < c) ? ta[q] * hcur + th[q] : hcur;
            }
        }
        for (int ww = 0; ww < w; ++ww) hcur = wst[ww * 64 + ch] * hcur + wst[512 + ww * 64 + ch];
        bf16_t* yb = (bf16_t*)(ws + WS_YB) + ((size_t)b * SEQ + c * 128 + 16 * w) * 1024 + gc;
        const bf16_t* lgp = proj + (size_t)(c * 128 + 16 * w) * DIN + OFF_LG + gc;
#pragma unroll
        for (int tt = 0; tt < 16; ++tt) {
            hcur = av[tt] * hcur + bv[tt];
            const float lgv = bf2f(lgp[(size_t)tt * DIN]);
            yb[(size_t)tt * 1024] = f2bf(hcur * gelu_erf(lgv));
        }
    }
    __syncthreads();
}

DI void retscan_unit(const Args& a, int unit) {
    unsigned char* ws = a.ws;
    const int e8 = unit * 512 + mk_tid();
    const int bh = e8 >> 13, within = e8 & 8191, h = bh & 3;
    const float g128 = exp2f(128.0f * log2gamma(h));
    bf16_t* base = (bf16_t*)(ws + WS_KVB) + (size_t)bh * 32 * 65536 + (size_t)within * 8;
    float st[8];
#pragma unroll
    for (int q = 0; q < 8; ++q) st[q] = 0.f;
    for (int c = 0; c < 32; ++c) {
        u32x4* p = (u32x4*)(base + (size_t)c * 65536);
        const u32x4 kv = *p;
        u32x4 o;
#pragma unroll
        for (int q = 0; q < 4; ++q) o[q] = pk2(st[2 * q], st[2 * q + 1]);
        *p = o;
#pragma unroll
        for (int q = 0; q < 4; ++q) { st[2 * q] = g128 * st[2 * q] + bflo(kv[q]); st[2 * q + 1] = g128 * st[2 * q + 1] + bfhi(kv[q]); }
    }
}

DI void attmerge_unit(const Args& a, int unit) {
    unsigned char* ws = a.ws;
    const int idx = unit * 512 + mk_tid(), t = idx >> 6, hp = (idx >> 4) & 3, dc = idx & 15;
    const float* lse = (const float*)(ws + WS_LSE) + (size_t)t * 12;
    const float l0 = lse[hp], l1 = lse[4 + hp], l2 = lse[8 + hp];
    const float m = fmaxf(l0, fmaxf(l1, l2));
    float w0 = __expf(l0 - m), w1 = __expf(l1 - m), w2 = __expf(l2 - m);
    const float is = 1.0f / (w0 + w1 + w2); w0 *= is; w1 *= is; w2 *= is;
    const bf16_t* o = (const bf16_t*)(ws + WS_OATT) + (size_t)t * 1536 + hp * 128 + dc * 8;
    const u32x4 a0 = *(const u32x4*)o, a1 = *(const u32x4*)(o + 512), a2 = *(const u32x4*)(o + 1024);
    u32x4 r;
#pragma unroll
    for (int q = 0; q < 4; ++q) r[q] = pk2(w0 * bflo(a0[q]) + w1 * bflo(a1[q]) + w2 * bflo(a2[q]), w0 * bfhi(a0[q]) + w1 * bfhi(a1[q]) + w2 * bfhi(a2[q]));
    *(u32x4*)((bf16_t*)(ws + WS_YA) + (size_t)t * 512 + hp * 128 + dc * 8) = r;
}

DI void retout_unit(const Args& a, int unit, LAS unsigned char* lds) {
    unsigned char* ws = a.ws;
    const int tid = mk_tid(), lane = tid & 63, w = __builtin_amdgcn_readfirstlane(tid >> 6), g = lane >> 4, l15 = lane & 15, tq4 = l15 >> 2, tp4 = l15 & 3;
    const int b = unit >> 7, h = (unit >> 5) & 3, c = unit & 31;
    const bf16_t* proj = (const bf16_t*)(ws + WS_PROJ) + ((size_t)b * SEQ + c * 128) * DIN;
    const bf16_t* rt = (const bf16_t*)(ws + WS_KVB) + ((size_t)((b * 4 + h) * 32 + c)) * 65536;
    LAS unsigned char* RA = lds; LAS unsigned char* RB = lds + 128 * 544;
    const float l2g = log2gamma(h);
    const int qi = 16 * w + l15;
    bf16x8 qf[8];
#pragma unroll
    for (int ks = 0; ks < 8; ++ks) qf[ks] = *(const bf16x8*)(proj + (size_t)qi * DIN + OFF_RQ + h * 256 + 32 * ks + 8 * g);
#pragma unroll
    for (int i = 0; i < 8; ++i) {
        const int idx = tid + 512 * i, row = idx >> 5, ch = idx & 31;
        *(LAS u32x4*)(RA + row * 544 + ch * 16) = *(const u32x4*)(proj + (size_t)row * DIN + OFF_RK + h * 256 + ch * 8);
        *(LAS u32x4*)(RB + row * 544 + ch * 16) = *(const u32x4*)(rt + (size_t)row * 256 + ch * 8);
    }
    __syncthreads();
    f32x4 sacc[8], oacc[16];
#pragma unroll
    for (int jj = 0; jj < 8; ++jj) {
        f32x4 acc = {0.f, 0.f, 0.f, 0.f};
        if (jj <= w) {
#pragma unroll
            for (int ks = 0; ks < 8; ++ks) { const bf16x8 kf = *(const LAS bf16x8*)(RA + (16 * jj + l15) * 544 + (32 * ks + 8 * g) * 2); acc = mfma16(kf, qf[ks], acc); }
        }
        sacc[jj] = acc;
    }
#pragma unroll
    for (int db = 0; db < 8; ++db) {
        f32x4 acc = {0.f, 0.f, 0.f, 0.f};
#pragma unroll
        for (int ks = 0; ks < 8; ++ks) { const bf16x8 rf = *(const LAS bf16x8*)(RB + (16 * db + l15) * 544 + (32 * ks + 8 * g) * 2); acc = mfma16(rf, qf[ks], acc); }
        oacc[db] = acc;
    }
    __syncthreads();
#pragma unroll
    for (int i = 0; i < 8; ++i) {
        const int idx = tid + 512 * i, row = idx >> 5, ch = idx & 31;
        *(LAS u32x4*)(RA + row * 544 + ch * 16) = *(const u32x4*)(proj + (size_t)row * DIN + OFF_RV + h * 256 + ch * 8);
        *(LAS u32x4*)(RB + row * 544 + ch * 16) = *(const u32x4*)(rt + (size_t)(128 + row) * 256 + ch * 8);
    }
    __syncthreads();
#pragma unroll
    for (int db = 0; db < 8; ++db) {
        f32x4 acc = {0.f, 0.f, 0.f, 0.f};
#pragma unroll
        for (int ks = 0; ks < 8; ++ks) { const bf16x8 rf = *(const LAS bf16x8*)(RB + (16 * db + l15) * 544 + (32 * ks + 8 * g) * 2); acc = mfma16(rf, qf[ks], acc); }
        oacc[8 + db] = acc;
    }
    const float xi = exp2f((float)(qi + 1) * l2g);
#pragma unroll
    for (int db = 0; db < 16; ++db) oacc[db] = oacc[db] * xi;
#pragma unroll
    for (int jj = 0; jj < 8; ++jj)
#pragma unroll
        for (int rg = 0; rg < 4; ++rg) { const int j = 16 * jj + 4 * g + rg; sacc[jj][rg] = (qi >= j) ? sacc[jj][rg] * exp2f((float)(qi - j) * l2g) : 0.f; }
#pragma unroll
    for (int s = 0; s < 4; ++s) {
        if (2 * s <= w) {
            u32x4 pw; pw.x = pk2(sacc[2 * s][0], sacc[2 * s][1]); pw.y = pk2(sacc[2 * s][2], sacc[2 * s][3]); pw.z = pk2(sacc[2 * s + 1][0], sacc[2 * s + 1][1]); pw.w = pk2(sacc[2 * s + 1][2], sacc[2 * s + 1][3]);
            const bf16x8 pb = __builtin_bit_cast(bf16x8, pw);
            const int k0 = 32 * s + 4 * g + tq4;
#pragma unroll
            for (int db = 0; db < 16; ++db) {
                const s16x4 lo = trrd(RA + k0 * 544 + (16 * db + 4 * tp4) * 2), hi = trrd(RA + (k0 + 16) * 544 + (16 * db + 4 * tp4) * 2);
                oacc[db] = mfma16(cat8(lo, hi), pb, oacc[db]);
            }
        }
    }
    float s1 = 0.f;
#pragma unroll
    for (int db = 0; db < 16; ++db) s1 += (oacc[db][0] + oacc[db][1]) + (oacc[db][2] + oacc[db][3]);
    s1 += __shfl_xor(s1, 16); s1 += __shfl_xor(s1, 32);
    const float mean = s1 * (1.0f / 256.0f);
    float s2 = 0.f;
#pragma unroll
    for (int db = 0; db < 16; ++db)
#pragma unroll
        for (int rg = 0; rg < 4; ++rg) { const float dd = oacc[db][rg] - mean; s2 += dd * dd; }
    s2 += __shfl_xor(s2, 16); s2 += __shfl_xor(s2, 32);
    const float rstd = rsqrtf(s2 * (1.0f / 256.0f) + LN_EPS);
    const bf16_t* rgp = proj + (size_t)qi * DIN + OFF_RG + h * 256 + 4 * g;
    bf16_t* yc = (bf16_t*)(ws + WS_YC) + ((size_t)b * SEQ + c * 128 + qi) * 1024 + h * 256 + 4 * g;
#pragma unroll
    for (int db = 0; db < 16; ++db) {
        const u32x2 gw = *(const u32x2*)(rgp + 16 * db);
        const float g0 = bflo(gw.x), g1 = bfhi(gw.x), g2 = bflo(gw.y), g3 = bfhi(gw.y);
        u32x2 o;
        o.x = pk2(g0 * sigm(g0) * (oacc[db][0] - mean) * rstd, g1 * sigm(g1) * (oacc[db][1] - mean) * rstd);
        o.y = pk2(g2 * sigm(g2) * (oacc[db][2] - mean) * rstd, g3 * sigm(g3) * (oacc[db][3] - mean) * rstd);
        *(u32x2*)(yc + 16 * db) = o;
    }
    __syncthreads();
}

struct EpiBranch {
    static constexpr bool PERM = false, AFTER_DRAIN = false;
    const bf16_t* gate; float* mf; bf16_t* mb; int mode;
    __device__ __forceinline__ void operator()(const f32x4 (&acc)[2][2][4][2], const pg8::Unit& u, int wr, int wc, int fr, int fq) const {
        const int row0 = u.pm * 256 + wr * 64 + fr, col0 = u.pn * 256 + wc * 32 + 4 * fq;
#pragma unroll
        for (int ai = 0; ai < 2; ++ai)
#pragma unroll
            for (int m = 0; m < 4; ++m) {
                const size_t row = (size_t)(row0 + ai * 128 + m * 16);
#pragma unroll
                for (int bj = 0; bj < 2; ++bj)
#pragma unroll
                    for (int n = 0; n < 2; ++n) {
                        const int col = col0 + bj * 128 + n * 16;
                        const u32x2 gw = *(const u32x2*)(gate + row * DIN + col);
                        f32x4 v = acc[ai][bj][m][n];
                        v[0] *= sigm(bflo(gw.x)); v[1] *= sigm(bfhi(gw.x)); v[2] *= sigm(bflo(gw.y)); v[3] *= sigm(bfhi(gw.y));
                        float* mp = mf + row * 1024 + col;
                        if (mode == 0) *(f32x4*)mp = v;
                        else if (mode == 1) *(f32x4*)mp = *(const f32x4*)mp + v;
                        else { const f32x4 t = *(const f32x4*)mp + v; u32x2 o; o.x = pk2(t[0], t[1]); o.y = pk2(t[2], t[3]); *(u32x2*)(mb + row * 1024 + col) = o; }
                    }
            }
    }
};
struct EpiOut {
    static constexpr bool PERM = false, AFTER_DRAIN = false;
    const float* xf; float* z;
    __device__ __forceinline__ void operator()(const f32x4 (&acc)[2][2][4][2], const pg8::Unit& u, int wr, int wc, int fr, int fq) const {
        const int row0 = u.pm * 256 + wr * 64 + fr, col0 = u.pn * 256 + wc * 32 + 4 * fq;
#pragma unroll
        for (int ai = 0; ai < 2; ++ai)
#pragma unroll
            for (int m = 0; m < 4; ++m) {
                const size_t row = (size_t)(row0 + ai * 128 + m * 16);
#pragma unroll
                for (int bj = 0; bj < 2; ++bj)
#pragma unroll
                    for (int n = 0; n < 2; ++n) { const int col = col0 + bj * 128 + n * 16; *(f32x4*)(z + row * 1024 + col) = *(const f32x4*)(xf + row * 1024 + col) * ALPHA + acc[ai][bj][m][n]; }
            }
    }
};

DI void ln_row(const float* z, const float* gam, const float* bet, float* of, bf16_t* ob, int lane) {
    f32x4 v[4]; float s = 0.f;
#pragma unroll
    for (int i = 0; i < 4; ++i) { v[i] = *(const f32x4*)(z + 256 * i + 4 * lane); s += (v[i][0] + v[i][1]) + (v[i][2] + v[i][3]); }
    const float mean = wsum(s) * (1.0f / 1024.0f);
    float q = 0.f;
#pragma unroll
    for (int i = 0; i < 4; ++i)
#pragma unroll
        for (int j = 0; j < 4; ++j) { const float d = v[i][j] - mean; q += d * d; }
    const float rstd = rsqrtf(wsum(q) * (1.0f / 1024.0f) + LN_EPS);
#pragma unroll
    for (int i = 0; i < 4; ++i) {
        const f32x4 gg = *(const f32x4*)(gam + 256 * i + 4 * lane), bb = *(const f32x4*)(bet + 256 * i + 4 * lane);
        f32x4 o;
#pragma unroll
        for (int j = 0; j < 4; ++j) o[j] = (v[i][j] - mean) * rstd * gg[j] + bb[j];
        *(f32x4*)(of + 256 * i + 4 * lane) = o;
        u32x2 pb; pb.x = pk2(o[0], o[1]); pb.y = pk2(o[2], o[3]); *(u32x2*)(ob + 256 * i + 4 * lane) = pb;
    }
}
DI void phase_ln1(const Args& a, int layer) {
    unsigned char* ws = a.ws;
    const int lane = mk_tid() & 63, w = mk_tid() >> 6;
    for (int u = blockIdx.x; u < NTOK / 8; u += gridDim.x) {
        const size_t row = (size_t)u * 8 + w;
        ln_row((const float*)(ws + WS_MRGF) + row * 1024, a.in[11] + layer * 1024, a.in[12] + layer * 1024, (float*)(ws + WS_XF) + row * 1024, (bf16_t*)(ws + WS_XB) + row * 1024, lane);
    }
}

DI void ins16(float (&L)[16], float x) {
#pragma unroll
    for (int k = 0; k < 16; ++k) { const float hi = fmaxf(L[k], x); x = fminf(L[k], x); L[k] = hi; }
}
DI void merge16(float (&L)[16], int xr) {
    float t[16];
#pragma unroll
    for (int k = 0; k < 16; ++k) t[k] = __shfl_xor(L[k], xr);
#pragma unroll
    for (int k = 0; k < 8; ++k) { const float x = t[k]; t[k] = t[15 - k]; t[15 - k] = x; }
#pragma unroll
    for (int k = 0; k < 16; ++k) t[k] = fmaxf(L[k], t[k]);
#define MK_CE_STAGE(dd) _Pragma("unroll") for (int k = 0; k < 16; ++k) if ((k & (dd)) == 0) { const float hi = fmaxf(t[k], t[k + (dd)]), lo = fminf(t[k], t[k + (dd)]); t[k] = hi; t[k + (dd)] = lo; }
    MK_CE_STAGE(8) MK_CE_STAGE(4) MK_CE_STAGE(2) MK_CE_STAGE(1)
#undef MK_CE_STAGE
#pragma unroll
    for (int k = 0; k < 16; ++k) L[k] = t[k];
}
DI float sel16(const float (&L)[16], unsigned idx) {
    float r = L[0];
#pragma unroll
    for (int k = 1; k < 16; ++k) r = (idx == (unsigned)k) ? L[k] : r;
    return r;
}
DI void top16_half(const bf16_t* qp, const bf16_t* kb, float (&L)[16], int g, int l15) {
    bf16x8 qf[4];
#pragma unroll
    for (int ks = 0; ks < 4; ++ks) qf[ks] = *(const bf16x8*)(qp + 32 * ks + 8 * g);
#pragma unroll
    for (int k = 0; k < 16; ++k) L[k] = -FLT_MAX;
#pragma unroll
    for (int kbk = 0; kbk < 8; ++kbk) {
        f32x4 acc = {0.f, 0.f, 0.f, 0.f};
#pragma unroll
        for (int ks = 0; ks < 4; ++ks) { const bf16x8 kf = *(const bf16x8*)(kb + (size_t)(16 * kbk + l15) * 128 + 32 * ks + 8 * g); acc = mfma16(kf, qf[ks], acc); }
#pragma unroll
        for (int rg = 0; rg < 4; ++rg) { const unsigned key = (unsigned)(16 * kbk + 4 * g + rg); ins16(L, __uint_as_float((__float_as_uint(acc[rg]) & ~0x7Fu) | key)); }
    }
    merge16(L, 16); merge16(L, 32);
}
DI void topk_unit(const Args& a, int unit, LAS unsigned char* lds) {
    unsigned char* ws = a.ws;
    const int tid = mk_tid(), lane = tid & 63, w = __builtin_amdgcn_readfirstlane(tid >> 6), g = lane >> 4, l15 = lane & 15;
    const int tg = w & 3, hs = w >> 2;
    const size_t t = (size_t)unit * 64 + tg * 16 + l15;
    const bf16_t* Q = (const bf16_t*)(ws + WS_Q);
    float K1[16], K2[16];
#pragma unroll
    for (int k = 0; k < 16; ++k) { K1[k] = 0.f; K2[k] = 0.f; }
#pragma unroll 1
    for (int hh = 0; hh < 4; ++hh) {
        const int h = hs * 4 + hh;
        float l1[16], l2[16];
        top16_half(Q + t * 2048 + h * 256, (const bf16_t*)(ws + WS_K1B) + (size_t)h * 16384, l1, g, l15);
        top16_half(Q + t * 2048 + h * 256 + 128, (const bf16_t*)(ws + WS_K2B) + (size_t)h * 16384, l2, g, l15);
        const bool mine = (g == hh);
#pragma unroll
        for (int k = 0; k < 16; ++k) { K1[k] = mine ? l1[k] : K1[k]; K2[k] = mine ? l2[k] : K2[k]; }
    }
    const int h = hs * 4 + g;
    float F[16];
#pragma unroll
    for (int k = 0; k < 16; ++k) F[k] = -FLT_MAX;
#pragma unroll
    for (int ia = 0; ia < 16; ++ia)
#pragma unroll
        for (int ib = 0; ib < 16 / (ia + 1); ++ib) {
            const float s = __uint_as_float(__float_as_uint(K1[ia]) & ~0x7Fu) + __uint_as_float(__float_as_uint(K2[ib]) & ~0x7Fu);
            ins16(F, __uint_as_float((__float_as_uint(s) & ~0xFFu) | (unsigned)(ia * 16 + ib)));
        }
    LAS int* row = (LAS int*)lds + tid * 33;
#pragma unroll
    for (int k = 0; k < 16; ++k) { row[k] = (int)(__float_as_uint(K1[k]) & 0x7Fu); row[16 + k] = (int)(__float_as_uint(K2[k]) & 0x7Fu); }
    float gt[16]; int ei[16]; float gs = 0.f;
    const float cv0 = __uint_as_float(__float_as_uint(F[0]) & ~0xFFu);
#pragma unroll
    for (int k = 0; k < 16; ++k) {
        const unsigned bits = __float_as_uint(F[k]);
        const float cv = __uint_as_float(bits & ~0xFFu);
        gt[k] = __expf(cv - cv0); gs += gt[k];
        const int ia = (int)((bits >> 4) & 15u), ib = (int)(bits & 15u);
        ei[k] = row[ia] * 128 + row[16 + ib];
    }
    const float ig = 1.0f / gs;
    int* ep = (int*)(ws + WS_EID) + (t * 8 + h) * 16; float* gp = (float*)(ws + WS_GATE) + (t * 8 + h) * 16;
#pragma unroll
    for (int q = 0; q < 4; ++q) {
        *(i32x4*)(ep + 4 * q) = (i32x4){ei[4 * q], ei[4 * q + 1], ei[4 * q + 2], ei[4 * q + 3]};
        *(f32x4*)(gp + 4 * q) = (f32x4){gt[4 * q] * ig, gt[4 * q + 1] * ig, gt[4 * q + 2] * ig, gt[4 * q + 3] * ig};
    }
}

typedef float f32x2 __attribute__((ext_vector_type(2)));
DI float dpp_f(float v, const int ctrl, const int rmask) { return v; }
#define MK_DPP_ADD(v, ctrl, rmask) v += __int_as_float(__builtin_amdgcn_update_dpp(0, __float_as_int(v), (ctrl), (rmask), 0xf, false))
DI float wsum_dpp(float v) {
    MK_DPP_ADD(v, 0xB1, 0xf); MK_DPP_ADD(v, 0x4E, 0xf); MK_DPP_ADD(v, 0x141, 0xf); MK_DPP_ADD(v, 0x140, 0xf);
    MK_DPP_ADD(v, 0x142, 0xa); MK_DPP_ADD(v, 0x143, 0xc);
    return __int_as_float(__builtin_amdgcn_readlane(__float_as_int(v), 63));
}
DI float gelu_as(float v) {
    const float av = fabsf(v), t = __builtin_amdgcn_rcpf(av * 0.2316418882f + 1.0f);
    float q = t * 0.5307027145f + (-0.7265760135f); q = q * t + 0.7107068705f; q = q * t + (-0.142248368f); q = q * t + 0.127414796f; q = q * t;
    const float e = __builtin_amdgcn_exp2f(v * v * (-0.72134752044f));
    const float m = v * (q * e);
    return v < 0.f ? m : v - m;
}
#define MK_PEER_LOAD1(j, ereg, kk) { const int e_ = __builtin_amdgcn_readlane(ereg, (kk)); \
        const u32x4* p_ = (const u32x4*)(UV + (size_t)(unsigned)e_ * 2048u); UW[j] = p_[lane]; VW[j] = p_[64 + lane]; }
#define MK_PEER_COMP1(j, usreg, gvreg, kk) { \
        const float us_ = __uint_as_float(__builtin_amdgcn_readlane(__float_as_uint(usreg), (kk))), gv_ = __uint_as_float(__builtin_amdgcn_readlane(__float_as_uint(gvreg), (kk))); \
        f32x2 p2_ = {0.f, 0.f}; \
        _Pragma("unroll") for (int q = 0; q < 4; ++q) { const f32x2 lo_ = __builtin_amdgcn_cvt_pk_f32_fp8((int)UW[j][q], false), hi_ = __builtin_amdgcn_cvt_pk_f32_fp8((int)UW[j][q], true); \
            p2_ += lo_ * x2[2 * q]; p2_ += hi_ * x2[2 * q + 1]; } \
        const float p_ = wsum_dpp(p2_.x + p2_.y) * us_; \
        const float act_ = gelu_as(p_) * gv_; const f32x2 a2_ = {act_, act_}; \
        _Pragma("unroll") for (int q = 0; q < 4; ++q) { const f32x2 lo_ = __builtin_amdgcn_cvt_pk_f32_fp8((int)VW[j][q], false), hi_ = __builtin_amdgcn_cvt_pk_f32_fp8((int)VW[j][q], true); \
            y2[2 * q] += a2_ * lo_; y2[2 * q + 1] += a2_ * hi_; } \
        __builtin_amdgcn_sched_barrier(0); }
DI void peer_token(const unsigned char* UV, int e0, int e1, float us0, float us1, float gv0, float gv1, const f32x2 (&x2)[8], f32x2 (&y2)[8], int lane) {
    u32x4 UW[8], VW[8];
#pragma unroll
    for (int j = 0; j < 8; ++j) MK_PEER_LOAD1(j, e0, j)
#pragma unroll 1
    for (int k = 0; k < 56; k += 8) {
#pragma unroll
        for (int j = 0; j < 8; ++j) { MK_PEER_COMP1(j, us0, gv0, k + j) MK_PEER_LOAD1(j, e0, k + 8 + j) }
    }
#pragma unroll
    for (int j = 0; j < 8; ++j) { MK_PEER_COMP1(j, us0, gv0, 56 + j) MK_PEER_LOAD1(j, e1, j) }
#pragma unroll 1
    for (int k = 0; k < 56; k += 8) {
#pragma unroll
        for (int j = 0; j < 8; ++j) { MK_PEER_COMP1(j, us1, gv1, k + j) MK_PEER_LOAD1(j, e1, k + 8 + j) }
    }
#pragma unroll
    for (int j = 0; j < 8; ++j) { MK_PEER_COMP1(j, us1, gv1, 56 + j) }
}
DI void peer_unit(const Args& a, int layer, int unit) {
    unsigned char* ws = a.ws;
    const int tid = mk_tid(), lane = tid & 63, w = __builtin_amdgcn_readfirstlane(tid >> 6);
    const unsigned char* UV = ws + WS_UV8; const float* SC = (const float*)(ws + WS_UVS);
#pragma unroll 1
    for (int i = 0; i < 8; ++i) {
        const size_t t = (size_t)unit * 64 + w * 8 + i;
        f32x2 x2[8], y2[8];
        int e0, e1; float us0, us1, gv0, gv1;
        {
            const int ln = mk_tid() & 63;
            const bf16_t* xbp = (const bf16_t*)(ws + WS_XB) + t * 1024 + 16 * ln;
            const u32x4 xa = *(const u32x4*)xbp, xb = *(const u32x4*)(xbp + 8);
#pragma unroll
            for (int q = 0; q < 4; ++q) { x2[q] = (f32x2){bflo(xa[q]), bfhi(xa[q])}; x2[4 + q] = (f32x2){bflo(xb[q]), bfhi(xb[q])}; }
            const int* ep = (const int*)(ws + WS_EID) + t * 128; const float* gp = (const float*)(ws + WS_GATE) + t * 128;
            e0 = ep[ln]; e1 = ep[64 + ln]; const float g0 = gp[ln], g1 = gp[64 + ln];
            const f32x2 s0 = *(const f32x2*)(SC + 2 * e0), s1 = *(const f32x2*)(SC + 2 * e1);
            us0 = s0.x; us1 = s1.x; gv0 = g0 * s0.y; gv1 = g1 * s1.y;
        }
#pragma unroll
        for (int q = 0; q < 8; ++q) y2[q] = (f32x2){0.f, 0.f};
        peer_token(UV, e0, e1, us0, us1, gv0, gv1, x2, y2, lane);
        {
            const int ln = mk_tid() & 63;
            float* xfp = (float*)(ws + WS_XF) + t * 1024 + 16 * ln; bf16_t* xbp = (bf16_t*)(ws + WS_XB) + t * 1024 + 16 * ln;
            const float* gam = a.in[18] + layer * 1024 + 16 * ln; const float* bet = a.in[19] + layer * 1024 + 16 * ln;
            float z[16]; float s = 0.f;
#pragma unroll
            for (int q = 0; q < 4; ++q) { const f32x4 xr = *(const f32x4*)(xfp + 4 * q);
#pragma unroll
                for (int j = 0; j < 4; ++j) { z[4 * q + j] = ALPHA * xr[j] + y2[2 * q + (j >> 1)][j & 1]; s += z[4 * q + j]; } }
            const float mean = wsum(s) * (1.0f / 1024.0f);
            float qq = 0.f;
#pragma unroll
            for (int q = 0; q < 16; ++q) { const float d = z[q] - mean; qq += d * d; }
            const float rstd = rsqrtf(wsum(qq) * (1.0f / 1024.0f) + LN_EPS);
            f32x4 o[4];
#pragma unroll
            for (int q = 0; q < 4; ++q) { const f32x4 gq = *(const f32x4*)(gam + 4 * q), bq = *(const f32x4*)(bet + 4 * q);
#pragma unroll
                for (int j = 0; j < 4; ++j) o[q][j] = (z[4 * q + j] - mean) * rstd * gq[j] + bq[j]; }
#pragma unroll
            for (int q = 0; q < 4; ++q) *(f32x4*)(xfp + 4 * q) = o[q];
            if (layer == DEPTH - 1) { float* op = a.out + t * 1024 + 16 * ln;
#pragma unroll
                for (int q = 0; q < 4; ++q) *(f32x4*)(op + 4 * q) = o[q]; }
            u32x4 p0, p1; p0.x = pk2(o[0][0], o[0][1]); p0.y = pk2(o[0][2], o[0][3]); p0.z = pk2(o[1][0], o[1][1]); p0.w = pk2(o[1][2], o[1][3]);
            p1.x = pk2(o[2][0], o[2][1]); p1.y = pk2(o[2][2], o[2][3]); p1.z = pk2(o[3][0], o[3][1]); p1.w = pk2(o[3][2], o[3][3]);
            *(u32x4*)xbp = p0; *(u32x4*)(xbp + 8) = p1;
        }
    }
}
}

namespace mk {
constexpr int LDS_ARG_OFF = LDS_BYTES - 16 - 256;
#define MK_NOINL __device__ __forceinline__
DI unsigned long long rfl64(unsigned long long v) { const unsigned lo = __builtin_amdgcn_readfirstlane((unsigned)v), hi = __builtin_amdgcn_readfirstlane((unsigned)(v >> 32)); return ((unsigned long long)hi << 32) | lo; }
DI Args load_args(LAS unsigned char* lds) {
    int aoff = LDS_ARG_OFF; asm volatile("" : "+s"(aoff));
    Args a; const LAS unsigned long long* p = (const LAS unsigned long long*)(lds + aoff);
#pragma unroll
    for (int i = 0; i < 20; ++i) a.in[i] = (const float*)(const __attribute__((address_space(1))) float*)rfl64(p[i]);
    a.out = (float*)(__attribute__((address_space(1))) float*)rfl64(p[20]); a.ws = (unsigned char*)(__attribute__((address_space(1))) unsigned char*)rfl64(p[21]);
    a.ropeA = __longlong_as_double((long long)rfl64(p[22])); a.ropeR = __longlong_as_double((long long)rfl64(p[23])); a.ph_lo = 0; a.ph_hi = 0;
    return a;
}
#define MK_LOADARGS const Args a = load_args(lds); unsigned char* ws = a.ws; const int G = (int)gridDim.x, bid = (int)blockIdx.x; (void)ws; (void)G; (void)bid
MK_NOINL void PG_prologue(LAS unsigned char* lds) { MK_LOADARGS; phase_prologue(a); }
MK_NOINL void P0_conv(LAS unsigned char* lds, int layer) { MK_LOADARGS; phase_conv(a, layer, lds); }
MK_NOINL void P1_inproj(LAS unsigned char* lds, int layer) { MK_LOADARGS; (void)layer;
    pg8::Gemm gm; gm.A = (const bf16_t*)(ws + WS_XB); gm.Bt = (const bf16_t*)(ws + WS_WINT); gm.M = NTOK; gm.N = DIN; gm.K = 1024;
    pg8::StaticOrder S; S.init(NTOK, DIN, G, bid);
    pg8::EpiBf16<0> E; E.O = (bf16_t*)(ws + WS_PROJ); E.ldc = DIN; E.bias = nullptr; E.split_cols = 0; E.split_stride = 0;
    pg8::gemm_phase<pg8::EpiBf16<0>, pg8::StaticOrder, false>(lds, gm, S, E, nullptr); }
MK_NOINL void P2_rope(LAS unsigned char* lds, int layer) { MK_LOADARGS; (void)layer; phase_rope(a); }
MK_NOINL void P3a_attn(LAS unsigned char* lds, int layer) { MK_LOADARGS; (void)layer; for (int u = bid; u < 1536; u += G) attn_unit(a, u, lds); }
MK_NOINL void P3b_retkv(LAS unsigned char* lds, int layer) { MK_LOADARGS; (void)layer; for (int u = bid; u < 512; u += G) retkv_unit(a, u, lds); }
MK_NOINL void P3c_lru(LAS unsigned char* lds, int layer, int fin) { MK_LOADARGS; for (int u = bid; u < 2048; u += G) lru_unit(a, layer, u, fin != 0, lds); }
MK_NOINL void P4a_scan(LAS unsigned char* lds, int layer) { MK_LOADARGS; (void)layer; for (int u = bid; u < 256; u += G) retscan_unit(a, u); }
MK_NOINL void P4c_merge(LAS unsigned char* lds, int layer) { MK_LOADARGS; (void)layer; for (int u = bid; u < 2048; u += G) attmerge_unit(a, u); }
MK_NOINL void P5_retout(LAS unsigned char* lds, int layer) { MK_LOADARGS; (void)layer; for (int u = bid; u < 512; u += G) retout_unit(a, u, lds); }
MK_NOINL void P6_branch(LAS unsigned char* lds, int layer) { MK_LOADARGS; (void)layer;
#pragma unroll 1
    for (int s = 0; s < 3; ++s) {
        pg8::Gemm gm; gm.A = (const bf16_t*)(ws + (s == 0 ? WS_YA : (s == 1 ? WS_YB : WS_YC))); gm.Bt = (const bf16_t*)(ws + (s == 0 ? WS_WBAT : (s == 1 ? WS_WBBT : WS_WBCT)));
        gm.M = NTOK; gm.N = 1024; gm.K = (s == 0) ? 512 : 1024;
        pg8::StaticOrder S; S.init(NTOK, 1024, G, bid);
        EpiBranch E; E.gate = (const bf16_t*)(ws + WS_PROJ) + OFF_GA + 1024 * s; E.mf = (float*)(ws + WS_MRGF); E.mb = (bf16_t*)(ws + WS_MRGB); E.mode = s;
        pg8::gemm_phase<EpiBranch, pg8::StaticOrder, false>(lds, gm, S, E, nullptr);
    } }
MK_NOINL void P7_outproj(LAS unsigned char* lds, int layer) { MK_LOADARGS; (void)layer;
    pg8::Gemm gm; gm.A = (const bf16_t*)(ws + WS_MRGB); gm.Bt = (const bf16_t*)(ws + WS_WOT); gm.M = NTOK; gm.N = 1024; gm.K = 1024;
    pg8::StaticOrder S; S.init(NTOK, 1024, G, bid);
    EpiOut E; E.xf = (const float*)(ws + WS_XF); E.z = (float*)(ws + WS_MRGF);
    pg8::gemm_phase<EpiOut, pg8::StaticOrder, false>(lds, gm, S, E, nullptr); }
MK_NOINL void P8_ln1(LAS unsigned char* lds, int layer) { MK_LOADARGS; phase_ln1(a, layer); }
MK_NOINL void P9_wq(LAS unsigned char* lds, int layer) { MK_LOADARGS; (void)layer;
    pg8::Gemm gm; gm.A = (const bf16_t*)(ws + WS_XB); gm.Bt = (const bf16_t*)(ws + WS_WQT); gm.M = NTOK; gm.N = 2048; gm.K = 1024;
    pg8::StaticOrder S; S.init(NTOK, 2048, G, bid);
    pg8::EpiBf16<0> E; E.O = (bf16_t*)(ws + WS_Q); E.ldc = 2048; E.bias = nullptr; E.split_cols = 0; E.split_stride = 0;
    pg8::gemm_phase<pg8::EpiBf16<0>, pg8::StaticOrder, false>(lds, gm, S, E, nullptr); }
MK_NOINL void P10_topk(LAS unsigned char* lds, int layer) { MK_LOADARGS; (void)layer; for (int u = bid; u < NTOK / 64; u += G) topk_unit(a, u, lds); }
MK_NOINL void P11_peer(LAS unsigned char* lds, int layer) { MK_LOADARGS; for (int u = bid; u < NTOK / 64; u += G) peer_unit(a, layer, u); }
DI void mk_sync(LAS unsigned char* lds) {
    const Args a = load_args(lds);
    XcdBarrier b; b.bar = (unsigned*)(a.ws + WS_CTL); b.x = xb_xcc_id(); b.st = (volatile LAS unsigned*)(lds + LDS_BAR_OFF);
    xcd_barrier(b);
}
}

#ifndef MK_PHASE_MASK
#define MK_PHASE_MASK 0xFFFu
#endif
#define MK_RUN(k) ((((MK_PHASE_MASK) >> ((k) - pb)) & 1u) && (k) >= ph_lo && (k) < ph_hi)
#define MK_NPHASES (1 + mk::DEPTH * mk::NPH)
#ifndef MK_REP_MASK
#define MK_REP_MASK 0u
#endif
#define MK_REPS(bit) for (int rep_ = 0; rep_ < ((((MK_REP_MASK) >> (bit)) & 1u) ? 2 : 1); ++rep_)
#define MK_SYNC(k) do { if ((k) >= ph_lo && (k) + 1 < ph_hi) mk::mk_sync(lds); } while (0)
__global__ __launch_bounds__(512, 2) void mk_fwd(mk::Args a) {
    using namespace mk;
    extern __shared__ __attribute__((aligned(16))) unsigned char smem_raw[];
    LAS unsigned char* lds = (LAS unsigned char*)smem_raw;
    const int ph_lo = a.ph_lo, ph_hi = a.ph_hi;
    {
        const unsigned* src = (const unsigned*)&a;
        if (threadIdx.x < sizeof(Args) / 4) ((LAS unsigned*)(lds + LDS_ARG_OFF))[threadIdx.x] = src[threadIdx.x];
        if (threadIdx.x == 0) { LAS unsigned* st = (LAS unsigned*)(lds + LDS_BAR_OFF); st[0] = 0u; st[1] = 0u; st[2] = 0u; st[3] = 0u; }
    }
    __syncthreads();
    if (ph_hi - ph_lo > 1) (void)xcd_barrier_post((unsigned*)(a.ws + WS_CTL), (volatile LAS unsigned*)(lds + LDS_BAR_OFF));
    if (0 >= ph_lo && 0 < ph_hi) PG_prologue(lds);
    MK_SYNC(0);
#pragma unroll 1
    for (int layer = 0; layer < DEPTH; ++layer) {
        const int pb = 1 + layer * NPH;
        if (MK_RUN(pb + 0)) MK_REPS(0) P0_conv(lds, layer);
        MK_SYNC(pb + 0);
        if (MK_RUN(pb + 1)) MK_REPS(1) P1_inproj(lds, layer);
        MK_SYNC(pb + 1);
        if (MK_RUN(pb + 2)) P2_rope(lds, layer);
        MK_SYNC(pb + 2);
        if (MK_RUN(pb + 3)) { MK_REPS(3) P3a_attn(lds, layer); MK_REPS(12) P3b_retkv(lds, layer); MK_REPS(13) P3c_lru(lds, layer, 0); }
        MK_SYNC(pb + 3);
        if (MK_RUN(pb + 4)) { P4a_scan(lds, layer); MK_REPS(4) { P4c_merge(lds, layer); P3c_lru(lds, layer, 1); } }
        MK_SYNC(pb + 4);
        if (MK_RUN(pb + 5)) MK_REPS(5) P5_retout(lds, layer);
        MK_SYNC(pb + 5);
        if (MK_RUN(pb + 6)) MK_REPS(6) P6_branch(lds, layer);
        MK_SYNC(pb + 6);
        if (MK_RUN(pb + 7)) MK_REPS(7) P7_outproj(lds, layer);
        MK_SYNC(pb + 7);
        if (MK_RUN(pb + 8)) MK_REPS(8) P8_ln1(lds, layer);
        MK_SYNC(pb + 8);
        if (MK_RUN(pb + 9)) MK_REPS(9) P9_wq(lds, layer);
        MK_SYNC(pb + 9);
        if (MK_RUN(pb + 10)) MK_REPS(10) P10_topk(lds, layer);
        MK_SYNC(pb + 10);
        if (MK_RUN(pb + 11)) P11_peer(lds, layer);
        MK_SYNC(pb + 11);
    }
}

#ifndef MK_SINGLE
#define MK_SINGLE 1
#endif
extern "C" void kernel_launch(void* const* d_in, const int* in_sizes, int n_in, void* d_out, int out_size, void* d_ws, size_t ws_size, hipStream_t stream) {
    using namespace mk;
    static int grid = 0;
    if (grid == 0) {
        if (n_in != 20 || out_size != NTOK * D || ws_size < WS_END) { fprintf(stderr, "kernel_launch: unexpected shapes (n_in %d, out %d, ws %zu, need %zu)\n", n_in, out_size, ws_size, (size_t)WS_END); grid = -1; return; }
        int dev = 0, cus = 0, per_cu = 0;
        if (hipGetDevice(&dev) != hipSuccess || hipDeviceGetAttribute(&cus, hipDeviceAttributeMultiprocessorCount, dev) != hipSuccess) { grid = -1; return; }
        if (hipFuncSetAttribute((const void*)mk_fwd, hipFuncAttributeMaxDynamicSharedMemorySize, LDS_BYTES) != hipSuccess) { fprintf(stderr, "kernel_launch: hipFuncSetAttribute failed\n"); grid = -1; return; }
        if (hipOccupancyMaxActiveBlocksPerMultiprocessor(&per_cu, (const void*)mk_fwd, 512, LDS_BYTES) != hipSuccess || per_cu < 1) { fprintf(stderr, "kernel_launch: occupancy query says %d blocks per CU\n", per_cu); (void)hipGetLastError(); grid = -1; return; }
        grid = cus;
    }
    if (grid < 0) return;
    (void)in_sizes;
    Args a{};
    for (int i = 0; i < 20; ++i) a.in[i] = (const float*)d_in[i];
    a.out = (float*)d_out; a.ws = (unsigned char*)d_ws;
    a.ropeA = pow(10000.0, -2.0 / 128.0); a.ropeR = pow(10000.0, -2.0 / 256.0);
#if MK_SINGLE
    (void)hipMemsetAsync((unsigned char*)d_ws + WS_CTL, 0, 16384, stream);
    a.ph_lo = 0; a.ph_hi = MK_NPHASES;
    hipLaunchKernelGGL(mk_fwd, dim3(grid), dim3(512), LDS_BYTES, stream, a);
#else
    for (int p = 0; p < MK_NPHASES; ++p) { a.ph_lo = p; a.ph_hi = p + 1; hipLaunchKernelGGL(mk_fwd, dim3(grid), dim3(512), LDS_BYTES, stream, a); }
#endif
}
```

```cpp
#include <hip/hip_runtime.h>
#include <cstdio>
#include <cstdint>
#include <cmath>
#include <cfloat>
__device__ __forceinline__ int mk_tid() { int t = (int)threadIdx.x; asm volatile("" : "+v"(t)); return t; }
namespace pg8 {
#define PG8_LAS __attribute__((address_space(3)))
typedef unsigned short bf16_t;
typedef short bf16x8 __attribute__((ext_vector_type(8)));
typedef float f32x4 __attribute__((ext_vector_type(4)));
typedef unsigned u32x4 __attribute__((ext_vector_type(4)));
constexpr int BM = 256, BK = 64, HALF = 128, HTB = HALF * BK * 2  , STAGE_BYTES = 8 * HTB, NXCD = 8, WGM = 8;

__host__ __device__ __forceinline__ int lds_byte(int r, int c) { const int st = (r >> 4) * 2 + (c >> 5), rr = r & 15, cc = c & 31, ob = rr * 64 + cc * 2; return st * 1024 + (ob ^ (((ob >> 9) & 1) << 5)); }
__host__ __device__ __forceinline__ void stage_rc(int b, int& R, int& C) { const int st = b / 1024, sb = b % 1024, swz = sb ^ (((sb >> 9) & 1) << 5); R = (st >> 1) * 16 + swz / 64; C = (st & 1) * 32 + (swz % 64) / 2; }
__host__ __device__ __forceinline__ int perm32(int rho) { const int n = rho >> 4, i = rho & 15; return 8 * (i >> 2) + 4 * n + (i & 3); }

struct Unit { int pm, pn; };
struct Gemm { const bf16_t* A; const bf16_t* Bt; int M, N, K; };

struct StaticOrder {
    int nM, nN, nwg, G, c;
    __host__ __device__ void init(int M, int N, int G_, int c_) { nM = M / BM; nN = N / BM; nwg = nM * nN; G = G_; c = c_; }
    __host__ __device__ bool next(int i, Unit& u) const {
        const long L = (long)i * G + c; if (L >= nwg) return false;
        int wgid = (int)L; { const int q = nwg / NXCD, r = nwg % NXCD, xcd = wgid % NXCD, off = wgid / NXCD; wgid = (xcd < r ? xcd * (q + 1) : r * (q + 1) + (xcd - r) * q) + off; }
        const int nig = WGM * nN, gid = wgid / nig, fm = gid * WGM, gsz = (nM - fm) < WGM ? (nM - fm) : WGM;
        u.pm = fm + ((wgid % nig) % gsz); u.pn = (wgid % nig) / gsz; return true;
    }
    __device__ __forceinline__ void a_ready(const Unit&) const {}
    __device__ __forceinline__ void done(const Unit&) const {}
};
__device__ __forceinline__ unsigned cvt_pk_bf16(float lo, float hi) { unsigned r; asm volatile("v_cvt_pk_bf16_f32 %0, %1, %2" : "=v"(r) : "v"(lo), "v"(hi)); return r; }
typedef float f32x2 __attribute__((ext_vector_type(2)));
__device__ __forceinline__ f32x2 gelu_pk(f32x2 v) {
    const f32x2 av = __builtin_elementwise_abs(v), d = av * 0.2316418882f + 1.0f;
    f32x2 t; t.x = __builtin_amdgcn_rcpf(d.x); t.y = __builtin_amdgcn_rcpf(d.y);
    f32x2 q = t * 0.5307027145f + (-0.7265760135f); q = q * t + 0.7107068705f; q = q * t + (-0.142248368f); q = q * t + 0.127414796f; q = q * t;
    const f32x2 s = (v * v) * (-0.72134752044f);
    f32x2 e; e.x = __builtin_amdgcn_exp2f(s.x); e.y = __builtin_amdgcn_exp2f(s.y);
    const f32x2 m = v * (q * e), r = v - m;
    f32x2 o; o.x = v.x < 0.f ? m.x : r.x; o.y = v.y < 0.f ? m.y : r.y; return o;
}

struct EpiF32 {
    static constexpr bool PERM = false, AFTER_DRAIN = false;
    float* C; int ldc; const float* bias;
    __device__ __forceinline__ void operator()(const f32x4 (&acc)[2][2][4][2], const Unit& u, int wr, int wc, int fr, int fq) const {
        const int row0 = u.pm * BM + wr * 64 + fr, col0 = u.pn * BM + wc * 32 + 4 * fq;
        f32x4 bv[2][2];
#pragma unroll
        for (int bj = 0; bj < 2; ++bj)
#pragma unroll
            for (int n = 0; n < 2; ++n) bv[bj][n] = bias ? *(const f32x4*)(bias + col0 + bj * HALF + n * 16) : (f32x4){0.f, 0.f, 0.f, 0.f};
#pragma unroll
        for (int ai = 0; ai < 2; ++ai)
#pragma unroll
            for (int m = 0; m < 4; ++m) { float* rowp = C + (size_t)(row0 + ai * HALF + m * 16) * ldc + col0;
#pragma unroll
                for (int bj = 0; bj < 2; ++bj)
#pragma unroll
                    for (int n = 0; n < 2; ++n) *(f32x4*)(rowp + bj * HALF + n * 16) = acc[ai][bj][m][n] + bv[bj][n]; }
    }
};
template <int ACT  > struct EpiBf16 {
    static constexpr bool PERM = true, AFTER_DRAIN = false;
    bf16_t* O; int ldc; const float* bias; int split_cols; size_t split_stride;
    __device__ __forceinline__ void operator()(const f32x4 (&acc)[2][2][4][2], const Unit& u, int wr, int wc, int fr, int fq) const {
        const int row0 = u.pm * BM + wr * 64 + fr; int colt = u.pn * BM; bf16_t* base = O;
        if (split_cols) { const int t = colt / split_cols; base += (size_t)t * split_stride; colt -= t * split_cols; }
        const int col0 = colt + wc * 32 + 8 * fq, bcol0 = u.pn * BM + wc * 32 + 8 * fq;
        f32x4 bv[2][2];
#pragma unroll
        for (int bj = 0; bj < 2; ++bj)
#pragma unroll
            for (int n = 0; n < 2; ++n) bv[bj][n] = bias ? *(const f32x4*)(bias + bcol0 + bj * HALF + 4 * n) : (f32x4){0.f, 0.f, 0.f, 0.f};
#pragma unroll
        for (int ai = 0; ai < 2; ++ai)
#pragma unroll
            for (int m = 0; m < 4; ++m) { bf16_t* rowp = base + (size_t)(row0 + ai * HALF + m * 16) * ldc + col0;
#pragma unroll
                for (int bj = 0; bj < 2; ++bj) { f32x4 v0 = acc[ai][bj][m][0] + bv[bj][0], v1 = acc[ai][bj][m][1] + bv[bj][1];
                    if (ACT == 1) { f32x2 a = gelu_pk((f32x2){v0[0], v0[1]}), b = gelu_pk((f32x2){v0[2], v0[3]}), c = gelu_pk((f32x2){v1[0], v1[1]}), d = gelu_pk((f32x2){v1[2], v1[3]});
                        v0 = (f32x4){a.x, a.y, b.x, b.y}; v1 = (f32x4){c.x, c.y, d.x, d.y}; }
                    if (ACT == 2) {
#pragma unroll
                        for (int j = 0; j < 4; ++j) { v0[j] = 0.5f * v0[j] * (1.0f + erff(v0[j] * 0.70710678f)); v1[j] = 0.5f * v1[j] * (1.0f + erff(v1[j] * 0.70710678f)); } }
                    u32x4 w; w.x = cvt_pk_bf16(v0[0], v0[1]); w.y = cvt_pk_bf16(v0[2], v0[3]); w.z = cvt_pk_bf16(v1[0], v1[1]); w.w = cvt_pk_bf16(v1[2], v1[3]);
                    *(u32x4*)(rowp + bj * HALF) = w; } }
    }
};

typedef int i32x8 __attribute__((ext_vector_type(8)));
typedef short s16x16 __attribute__((ext_vector_type(16)));
__device__ __forceinline__ i32x8 pg8_cat16(bf16x8 a, bf16x8 b) { return __builtin_bit_cast(i32x8, (s16x16)__builtin_shufflevector(a, b, 0, 1, 2, 3, 4, 5, 6, 7, 8, 9, 10, 11, 12, 13, 14, 15)); }
template <class Epi, class Sched, bool STAMP = false, bool F8 = false>
__device__ __forceinline__ void gemm_phase(PG8_LAS unsigned char* lds, const Gemm g, const Sched& S, const Epi& E, unsigned long long* stamps) {
    const int tid = mk_tid(), wid = __builtin_amdgcn_readfirstlane(tid >> 6), lane = tid & 63, wr = wid >> 2, wc = wid & 3, fr = lane & 15, fq = lane >> 4;
    const int K = g.K, nt = K / BK;
    int ts_lo = 0, ts_hi = 0, nts = 0; const unsigned long long rt_entry = STAMP ? (unsigned long long)wall_clock64() : 0ull;
#define PG8_STAMP() do { if (STAMP && wid == 0 && nts < 64) { const unsigned long long _c = (unsigned long long)clock64(); \
        ts_lo = (lane == nts) ? (int)(unsigned)_c : ts_lo; ts_hi = (lane == nts) ? (int)(unsigned)(_c >> 32) : ts_hi; ++nts; } } while (0)
    PG8_STAMP();
    unsigned voffA, voffB;
    { int R, C; stage_rc(tid * 16, R, C); const int Rb = Epi::PERM ? ((R & ~31) + perm32(R & 31)) : R;
        voffA = (unsigned)(R * K + C) * 2u; voffB = (unsigned)(Rb * K + C) * 2u; }
    const size_t qstep = (size_t)64 * K * 2;
    const size_t kstep = (size_t)(BK * 2);
    const size_t hstep = (size_t)HALF * K * 2;
    const size_t tstep = 2 * hstep;
    const unsigned ldsw = (unsigned)wid * 1024u;
    const int aoff = lds_byte(wr * 64 + fr, fq * 8), boff = lds_byte(wc * 32 + fr, fq * 8);
#define PG8_SA(b, h) (((b) * 2 + (h)) * HTB)
#define PG8_SB(b, h) ((4 + (b) * 2 + (h)) * HTB)
#define PG8_STAGE(bufoff, gbase, voff) do { const char* _g0 = (const char*)(gbase); const char* _g1 = _g0 + qstep; asm volatile("" : "+s"(_g0), "+s"(_g1));   \
        __builtin_amdgcn_global_load_lds((const unsigned*)(_g0 + (voff)), (PG8_LAS unsigned*)(lds + (bufoff) + ldsw), 16, 0, 0); \
        __builtin_amdgcn_global_load_lds((const unsigned*)(_g1 + (voff)), (PG8_LAS unsigned*)(lds + (bufoff) + ldsw + 8192), 16, 0, 0); } while (0)
#define PG8_LDA(dst, b, h) do { _Pragma("unroll") for (int m = 0; m < 4; ++m) _Pragma("unroll") for (int k = 0; k < 2; ++k) dst[m][k] = *(const PG8_LAS bf16x8*)(lds + PG8_SA(b, h) + aoff + m * 2048 + k * 1024); } while (0)
#define PG8_LDB(dst, b, h) do { _Pragma("unroll") for (int n = 0; n < 2; ++n) _Pragma("unroll") for (int k = 0; k < 2; ++k) dst[n][k] = *(const PG8_LAS bf16x8*)(lds + PG8_SB(b, h) + boff + n * 2048 + k * 1024); } while (0)
#define PG8_MMA(ai, bj, At, Bt) do { __builtin_amdgcn_s_setprio(1); _Pragma("unroll") for (int m = 0; m < 4; ++m) _Pragma("unroll") for (int n = 0; n < 2; ++n) { \
        if constexpr (F8) acc[ai][bj][m][n] = __builtin_amdgcn_mfma_scale_f32_16x16x128_f8f6f4(pg8_cat16(Bt[n][0], Bt[n][1]), pg8_cat16(At[m][0], At[m][1]), acc[ai][bj][m][n], 0, 0, 0, 0, 0, 0); \
        else { _Pragma("unroll") for (int k = 0; k < 2; ++k) acc[ai][bj][m][n] = __builtin_amdgcn_mfma_f32_16x16x32_bf16(Bt[n][k], At[m][k], acc[ai][bj][m][n], 0, 0, 0); } } \
        __builtin_amdgcn_s_setprio(0); } while (0)
#define PG8_WAIT_V(n) asm volatile("s_waitcnt vmcnt(" #n ")" ::: "memory")
#define PG8_WAIT_L(n) asm volatile("s_waitcnt lgkmcnt(" #n ")" ::: "memory")
#define PG8_BAR __builtin_amdgcn_s_barrier()
#define PG8_SCHED __builtin_amdgcn_sched_barrier(0)
    Unit cur, nxt; int ui = 0;
    if (!S.next(0, cur)) return;
    f32x4 acc[2][2][4][2];
    bf16x8 At[4][2], B0[2][2], B1[2][2];
    const char* cA = (const char*)g.A + (size_t)cur.pm * tstep; const char* cB = (const char*)g.Bt + (size_t)cur.pn * tstep;
    S.a_ready(cur);
    PG8_STAGE(PG8_SB(0, 0), cB, voffB); PG8_STAGE(PG8_SA(0, 0), cA, voffA); PG8_STAGE(PG8_SB(0, 1), cB + hstep, voffB); PG8_STAGE(PG8_SA(0, 1), cA + hstep, voffA);
    if (wr == 1) PG8_BAR;
    PG8_WAIT_V(4); PG8_BAR;
    PG8_STAGE(PG8_SB(1, 0), cB + kstep, voffB); PG8_STAGE(PG8_SA(1, 0), cA + kstep, voffA); PG8_STAGE(PG8_SB(1, 1), cB + hstep + kstep, voffB);
    PG8_WAIT_V(6); PG8_BAR;
    PG8_STAMP();
#pragma unroll
    for (int a = 0; a < 2; ++a)
#pragma unroll
        for (int b = 0; b < 2; ++b)
#pragma unroll
            for (int m = 0; m < 4; ++m)
#pragma unroll
                for (int n = 0; n < 2; ++n) acc[a][b][m][n] = (f32x4){0.f, 0.f, 0.f, 0.f};
    for (;;) {
        const bool has_next = S.next(ui + 1, nxt);
        const char* nA = has_next ? (const char*)g.A + (size_t)nxt.pm * tstep : cA; const char* nB = has_next ? (const char*)g.Bt + (size_t)nxt.pn * tstep : cB;
        for (int t = 0; t < nt; t += 2) {
            const bool last = (t == nt - 2);
            const char* a1 = cA + (size_t)(t + 1) * kstep;
            const char* a2 = last ? nA : cA + (size_t)(t + 2) * kstep; const char* b2 = last ? nB : cB + (size_t)(t + 2) * kstep;
            const char* a3 = a2 + kstep; const char* b3 = b2 + kstep;
            if (last && has_next) S.a_ready(nxt);
            PG8_LDB(B0, 0, 0); PG8_SCHED; PG8_LDA(At, 0, 0); PG8_STAGE(PG8_SA(1, 1), a1 + hstep, voffA);
            PG8_WAIT_L(8); PG8_BAR; PG8_WAIT_L(0); PG8_MMA(0, 0, At, B0); PG8_BAR; PG8_SCHED;
            PG8_LDB(B1, 0, 1); PG8_STAGE(PG8_SB(0, 0), b2, voffB);
            PG8_BAR; PG8_WAIT_L(0); PG8_MMA(0, 1, At, B1); PG8_BAR;
            PG8_LDA(At, 0, 1); PG8_STAGE(PG8_SA(0, 0), a2, voffA);
            PG8_BAR; PG8_WAIT_L(0); PG8_MMA(1, 0, At, B0); PG8_BAR; PG8_SCHED;
            PG8_STAGE(PG8_SB(0, 1), b2 + hstep, voffB);
            PG8_WAIT_V(6); PG8_BAR; PG8_MMA(1, 1, At, B1); PG8_BAR;
            PG8_LDB(B0, 1, 0); PG8_SCHED; PG8_LDA(At, 1, 0); PG8_STAGE(PG8_SA(0, 1), a2 + hstep, voffA);
            PG8_WAIT_L(8); PG8_BAR; PG8_WAIT_L(0); PG8_MMA(0, 0, At, B0); PG8_BAR; PG8_SCHED;
            PG8_LDB(B1, 1, 1); PG8_STAGE(PG8_SB(1, 0), b3, voffB);
            PG8_BAR; PG8_WAIT_L(0); PG8_MMA(0, 1, At, B1); PG8_BAR;
            PG8_LDA(At, 1, 1); PG8_STAGE(PG8_SA(1, 0), a3, voffA);
            PG8_BAR; PG8_WAIT_L(0); PG8_MMA(1, 0, At, B0); PG8_BAR; PG8_SCHED;
            PG8_STAGE(PG8_SB(1, 1), b3 + hstep, voffB);
            PG8_WAIT_V(6); PG8_BAR; PG8_MMA(1, 1, At, B1); PG8_BAR;
        }
        PG8_STAMP();
        if constexpr (!Epi::AFTER_DRAIN) { E(acc, cur, wr, wc, fr, fq); S.done(cur); }
        PG8_STAMP();
        if (!has_next) break;
#pragma unroll
        for (int a = 0; a < 2; ++a)
#pragma unroll
            for (int b = 0; b < 2; ++b)
#pragma unroll
                for (int m = 0; m < 4; ++m)
#pragma unroll
                    for (int n = 0; n < 2; ++n) acc[a][b][m][n] = (f32x4){0.f, 0.f, 0.f, 0.f};
        cur = nxt; cA = nA; cB = nB; ++ui;
    }
    PG8_WAIT_V(0);
    if (wr == 0) PG8_BAR;
    PG8_BAR;
    if constexpr (Epi::AFTER_DRAIN) { E.fused(acc, cur, wr, wc, fr, fq, lds, wid, lane); S.done(cur); }
    PG8_STAMP();
    if (STAMP && wid == 0) { stamps[lane] = lane < nts ? (((unsigned long long)(unsigned)ts_hi << 32) | (unsigned)ts_lo) : 0ull;
        if (lane == 62) stamps[62] = rt_entry; if (lane == 63) stamps[63] = (unsigned long long)wall_clock64(); }
#undef PG8_STAMP
#undef PG8_SA
#undef PG8_SB
#undef PG8_STAGE
#undef PG8_LDA
#undef PG8_LDB
#undef PG8_MMA
#undef PG8_WAIT_V
#undef PG8_WAIT_L
#undef PG8_BAR
#undef PG8_SCHED
}
}
#define XB_TMO      128
#define XB_XCNT(j)  (256  + 64 * (j))
#define XB_XSUB(j)  (1280 + 64 * (j))
#define XB_XGEN(j)  (2304 + 64 * (j))
#define XB_TOP      3328
#define XB_TOPGEN   3392
#define XCD_BAR_WORDS 3456
#define XB_SPIN_CAP (1u << 18)
#define LAS __attribute__((address_space(3)))

__device__ __forceinline__ unsigned xb_ld(unsigned* p)              { return __hip_atomic_load(p, __ATOMIC_RELAXED, __HIP_MEMORY_SCOPE_AGENT); }
__device__ __forceinline__ unsigned xb_add(unsigned* p, unsigned v) { return __hip_atomic_fetch_add(p, v, __ATOMIC_RELAXED, __HIP_MEMORY_SCOPE_AGENT); }
__device__ __forceinline__ unsigned xb_xcc_id() { return (unsigned)__builtin_amdgcn_s_getreg((3 << 11) | 20) & 0xFu; }
#define XB_SPIN(cond, bar) do { unsigned _sp = 0; while (cond) { __builtin_amdgcn_s_sleep(1); \
    if ((++_sp & 255u) == 0u) { if (xb_ld(&(bar)[XB_TMO])) break; if (_sp > XB_SPIN_CAP) { atomicAdd(&(bar)[XB_TMO], 1u); break; } } } } while (0)

struct XcdBarrier {
    unsigned* bar; unsigned x;
    volatile LAS unsigned* st;
};

__device__ __forceinline__ XcdBarrier xcd_barrier_post(unsigned* bar, volatile LAS unsigned* st) {
    XcdBarrier b; b.bar = bar; b.x = xb_xcc_id(); b.st = st;
    if (threadIdx.x == 0) (void)xb_add(&bar[XB_XCNT(b.x)], 1u);
    return b;
}
__device__ __forceinline__ void xcd_barrier_complete(unsigned* bar, unsigned x, unsigned& nloc, unsigned& nx) {
    const unsigned G = gridDim.x * gridDim.y * gridDim.z;
    unsigned sum, cnt, mine, sp = 0u;
    for (;;) {
        sum = 0u; cnt = 0u; mine = 0u;
#pragma unroll
        for (unsigned j = 0; j < 16; ++j) { const unsigned c = xb_ld(&bar[XB_XCNT(j)]); sum += c; cnt += (c > 0u) ? 1u : 0u; mine = (j == x) ? c : mine; }
        if (sum == G) break;
        __builtin_amdgcn_s_sleep(1);
        if ((++sp & 255u) == 0u) { if (xb_ld(&bar[XB_TMO])) break; if (sp > XB_SPIN_CAP) { atomicAdd(&bar[XB_TMO], 1u); break; } }
    }
    nloc = mine > 0u ? mine : 1u; nx = cnt > 0u ? cnt : 1u;
}

__device__ __forceinline__ void xcd_barrier(const XcdBarrier& b) {
    asm volatile("s_waitcnt vmcnt(0)" ::: "memory");
    __syncthreads();
    if (threadIdx.x == 0) {
        unsigned* bar = b.bar;
        __builtin_amdgcn_s_waitcnt(0);
        unsigned nloc = b.st[0], nx = b.st[1];
        if (nloc == 0u) { xcd_barrier_complete(bar, b.x, nloc, nx); b.st[0] = nloc; b.st[1] = nx; }
        const unsigned old = xb_add(&bar[XB_XSUB(b.x)], 1u);
        const unsigned gen = old / nloc;
        if (old + 1u == (gen + 1u) * nloc) {
            __builtin_amdgcn_fence(__ATOMIC_RELEASE, "agent");
            asm volatile("s_waitcnt vmcnt(0)" ::: "memory");
            const unsigned og = xb_add(&bar[XB_TOP], 1u);
            const unsigned tg = og / nx;
            if (og + 1u == (tg + 1u) * nx) xb_add(&bar[XB_TOPGEN], 1u);
            else XB_SPIN(xb_ld(&bar[XB_TOPGEN]) == tg, bar);
            __builtin_amdgcn_fence(__ATOMIC_ACQUIRE, "agent");
            xb_add(&bar[XB_XGEN(b.x)], 1u);
            asm volatile("s_waitcnt vmcnt(0)" ::: "memory");
        } else {
            XB_SPIN(xb_ld(&bar[XB_XGEN(b.x)]) == gen, bar);
            __builtin_amdgcn_fence(__ATOMIC_ACQUIRE, "agent");
            asm volatile("s_waitcnt vmcnt(0)" ::: "memory");
        }
    }
    __syncthreads();
}

namespace mk {
using pg8::bf16_t; using pg8::bf16x8; using pg8::f32x4; using pg8::u32x4;
typedef short s16x4 __attribute__((ext_vector_type(4)));
typedef unsigned u32x2 __attribute__((ext_vector_type(2)));
typedef __bf16 bf16x2v __attribute__((ext_vector_type(2)));
typedef int i32x4 __attribute__((ext_vector_type(4)));
#define DI __device__ __forceinline__

constexpr int D = 1024, SEQ = 4096, NTOK = 16384, DEPTH = 4, DIN = 13824;
constexpr int OFF_AQ = 0, OFF_AK = 1536, OFF_AV = 3072, OFF_LX = 4608, OFF_LG = 5632, OFF_RQ = 6656, OFF_RK = 7680, OFF_RV = 8704, OFF_RG = 9728, OFF_GA = 10752;
constexpr float ALPHA = 1.681792830507429f;
constexpr float LN_EPS = 1e-5f;
constexpr int NPH = 12;
constexpr int LDS_BYTES = 148 * 1024;
constexpr int LDS_BAR_OFF = LDS_BYTES - 16;

constexpr size_t WS_CTL  = 0;
constexpr size_t WS_COSA = 16384;
constexpr size_t WS_SINA = WS_COSA + (size_t)4096 * 64 * 4;
constexpr size_t WS_COSR = WS_SINA + (size_t)4096 * 64 * 4;
constexpr size_t WS_SINR = WS_COSR + (size_t)4096 * 128 * 4;
constexpr size_t WS_CCH  = WS_SINR + (size_t)4096 * 128 * 4;
constexpr size_t WS_WAT  = WS_CCH + 4096;
constexpr size_t WS_WXT  = WS_WAT + 131072;
constexpr size_t WS_LSTA = WS_WXT + 131072;
constexpr size_t WS_LSTH = WS_LSTA + 524288;
constexpr size_t WS_K1B  = WS_LSTH + 524288;
constexpr size_t WS_K2B  = WS_K1B + 262144;
constexpr size_t WS_XF   = WS_K2B + 262144;
constexpr size_t WS_XB   = WS_XF + (size_t)NTOK * D * 4;
constexpr size_t WS_WINT = WS_XB + (size_t)NTOK * D * 2;
constexpr size_t WS_WSC  = WS_WINT + (size_t)DIN * 1024;
constexpr size_t WS_X8   = WS_WSC + (size_t)DIN * 4 + 256 - ((size_t)DIN * 4) % 256;
constexpr size_t WS_XS   = WS_X8 + (size_t)NTOK * 1024;
constexpr size_t WS_WBAT = WS_XS + (size_t)NTOK * 4;
constexpr size_t WS_WBBT = WS_WBAT + (size_t)1024 * 512 * 2;
constexpr size_t WS_WBCT = WS_WBBT + (size_t)1024 * 1024 * 2;
constexpr size_t WS_WOT  = WS_WBCT + (size_t)1024 * 1024 * 2;
constexpr size_t WS_WQT  = WS_WOT + (size_t)1024 * 1024 * 2;
constexpr size_t WS_UV8  = WS_WQT + (size_t)2048 * 1024 * 2;
constexpr size_t WS_UVS  = WS_UV8 + (size_t)16384 * 2048;
constexpr size_t WS_PROJ = WS_UVS + (size_t)16384 * 8;
constexpr size_t WS_OATT = WS_PROJ + (size_t)NTOK * DIN * 2;
constexpr size_t WS_LSE  = WS_OATT + (size_t)NTOK * 1536 * 2;
constexpr size_t WS_KVB  = WS_LSE + (size_t)NTOK * 12 * 4;
constexpr size_t WS_YA   = WS_KVB + (size_t)16 * 32 * 65536 * 2;
constexpr size_t WS_YB   = WS_YA + (size_t)NTOK * 512 * 2;
constexpr size_t WS_YC   = WS_YB + (size_t)NTOK * 1024 * 2;
constexpr size_t WS_MRGF = WS_YC + (size_t)NTOK * 1024 * 2;
constexpr size_t WS_MRGB = WS_MRGF + (size_t)NTOK * 1024 * 4;
constexpr size_t WS_END  = WS_MRGB + (size_t)NTOK * 1024 * 2;
constexpr size_t WS_Q    = WS_PROJ;
constexpr size_t WS_EID  = WS_PROJ + (size_t)NTOK * 2048 * 2;
constexpr size_t WS_GATE = WS_EID + (size_t)NTOK * 128 * 4;
static_assert(WS_END <= (size_t)1073741824, "workspace too large");
static_assert(WS_PROJ % 256 == 0 && WS_KVB % 256 == 0 && WS_MRGF % 256 == 0, "alignment");

struct Args { const float* in[20]; float* out; unsigned char* ws; double ropeA, ropeR; int ph_lo, ph_hi; };

DI float bflo(unsigned w) { return __uint_as_float(w << 16); }
DI float bfhi(unsigned w) { return __uint_as_float(w & 0xffff0000u); }
DI float bf2f(bf16_t v) { return __uint_as_float(((unsigned)v) << 16); }
DI unsigned pk2(float lo, float hi) { return pg8::cvt_pk_bf16(lo, hi); }
DI bf16_t f2bf(float f) { return (bf16_t)(pk2(f, 0.f) & 0xffffu); }
DI f32x4 mfma16(bf16x8 a, bf16x8 b, f32x4 c) { return __builtin_amdgcn_mfma_f32_16x16x32_bf16(a, b, c, 0, 0, 0); }
DI s16x4 trrd(LAS unsigned char* p) { return __builtin_amdgcn_ds_read_tr16_b64_v4i16((LAS s16x4*)p); }
DI bf16x8 cat8(s16x4 lo, s16x4 hi) { return __builtin_shufflevector(lo, hi, 0, 1, 2, 3, 4, 5, 6, 7); }
DI float wsum(float v) { v += __shfl_xor(v, 32); v += __shfl_xor(v, 16); v += __shfl_xor(v, 8); v += __shfl_xor(v, 4); v += __shfl_xor(v, 2); v += __shfl_xor(v, 1); return v; }
DI float sigm(float x) { return __builtin_amdgcn_rcpf(1.f + __builtin_amdgcn_exp2f(x * -1.4426950408889634f)); }
DI float gelu_erf(float x) { return 0.5f * x * (1.f + erff(x * 0.70710678118654752f)); }
DI float dot2(unsigned w, unsigned x, float acc) { return __builtin_amdgcn_fdot2_f32_bf16(__builtin_bit_cast(bf16x2v, w), __builtin_bit_cast(bf16x2v, x), acc, false); }
DI float log2gamma(int h) { return log2f(1.0f - exp2f(-5.0f - (float)h)); }

DI float dpp_f(float v, const int ctrl, const int rmask) { return v; }
#define MK_DPP_ADD(v, ctrl, rmask) v += __int_as_float(__builtin_amdgcn_update_dpp(0, __float_as_int(v), (ctrl), (rmask), 0xf, false))
DI float wsum_dpp(float v) {
    MK_DPP_ADD(v, 0xB1, 0xf); MK_DPP_ADD(v, 0x4E, 0xf); MK_DPP_ADD(v, 0x141, 0xf); MK_DPP_ADD(v, 0x140, 0xf);
    MK_DPP_ADD(v, 0x142, 0xa); MK_DPP_ADD(v, 0x143, 0xc);
    return __int_as_float(__builtin_amdgcn_readlane(__float_as_int(v), 63));
}
DI float gelu_as(float v) {
    const float av = fabsf(v), t = __builtin_amdgcn_rcpf(av * 0.2316418882f + 1.0f);
    float q = t * 0.5307027145f + (-0.7265760135f); q = q * t + 0.7107068705f; q = q * t + (-0.142248368f); q = q * t + 0.127414796f; q = q * t;
    const float e = __builtin_amdgcn_exp2f(v * v * (-0.72134752044f));
    const float m = v * (q * e);
    return v < 0.f ? m : v - m;
}
DI void sincos_d(double x, double& s, double& c) {
    const double n = rint(x * 0.63661977236758134308);
    double y = fma(-n, 1.57079632679489655800e+00, x); y = fma(-n, 6.12323399573676603587e-17, y);
    const double y2 = y * y;
    const double sp = y + y * y2 * (-1.0 / 6 + y2 * (1.0 / 120 + y2 * (-1.0 / 5040 + y2 * (1.0 / 362880 + y2 * (-1.0 / 39916800 + y2 * (1.0 / 6227020800.0))))));
    const double cp = 1.0 + y2 * (-0.5 + y2 * (1.0 / 24 + y2 * (-1.0 / 720 + y2 * (1.0 / 40320 + y2 * (-1.0 / 3628800 + y2 * (1.0 / 479001600.0 + y2 * (-1.0 / 87178291200.0)))))));
    const int q = ((int)n) & 3;
    s = (q == 0) ? sp : (q == 1) ? cp : (q == 2) ? -sp : -cp;
    c = (q == 0) ? cp : (q == 1) ? -sp : (q == 2) ? -cp : sp;
}

DI int wperm(int n) {
    if (n < 3072) { const int j = n & 127, jj = j & 63; return (n & ~127) + 8 * (jj >> 2) + (jj & 3) + ((j >= 64) ? 4 : 0); }
    if (n >= OFF_RQ && n < OFF_RV) { const int j = n & 255, jj = j & 127; return (n & ~255) + 8 * (jj >> 2) + (jj & 3) + ((j >= 128) ? 4 : 0); }
    return n;
}

template <bool WPERM>
DI void tconv_tile(const float* src, int ldsrc, bf16_t* dst, int lddst, int k0, int n0, LAS float* t) {
    const int tid = mk_tid();
#pragma unroll
    for (int i = 0; i < 8; ++i) { const int idx = tid + 512 * i, r = idx >> 6, c = idx & 63; t[r * 65 + c] = src[(size_t)(k0 + r) * ldsrc + n0 + c]; }
    __syncthreads();
#pragma unroll
    for (int i = 0; i < 8; ++i) { const int idx = tid + 512 * i, n = idx >> 6, k = idx & 63; const int nr = WPERM ? wperm(n0 + n) : (n0 + n); dst[(size_t)nr * lddst + k0 + k] = f2bf(t[k * 65 + n]); }
    __syncthreads();
}
DI void conv_unit(const float* src, bf16_t* dst, int unit) {
    const size_t i = (size_t)unit * 4096 + (size_t)mk_tid() * 8;
    const f32x4 a = *(const f32x4*)(src + i), b = *(const f32x4*)(src + i + 4);
    u32x4 o; o.x = pk2(a[0], a[1]); o.y = pk2(a[2], a[3]); o.z = pk2(b[0], b[1]); o.w = pk2(b[2], b[3]);
    *(u32x4*)(dst + i) = o;
}
DI void w8_unit(const float* src, unsigned char* ws, int unit, LAS float* t) {
    const int tid = mk_tid(), c = tid & 63, rg = tid >> 6, n0 = unit * 64;
    LAS float* red = t + 64 * 65;
    LAS float* scl = red + 512;
    float m = 0.f;
#pragma unroll 8
    for (int k = rg * 128; k < rg * 128 + 128; ++k) m = fmaxf(m, fabsf(src[(size_t)k * DIN + n0 + c]));
    red[rg * 64 + c] = m;
    __syncthreads();
    if (tid < 64) { float mm = red[tid];
#pragma unroll
        for (int q = 1; q < 8; ++q) mm = fmaxf(mm, red[q * 64 + tid]);
        scl[tid] = (mm > 0.f) ? 240.0f / mm : 1.0f;
        ((float*)(ws + WS_WSC))[wperm(n0 + tid)] = (mm > 0.f) ? mm * (1.0f / 240.0f) : 1.0f; }
    __syncthreads();
    unsigned char* dst = ws + WS_WINT;
#pragma unroll 1
    for (int k0 = 0; k0 < 1024; k0 += 64) {
#pragma unroll
        for (int i = 0; i < 8; ++i) { const int idx = tid + 512 * i, r = idx >> 6, cc = idx & 63; t[r * 65 + cc] = src[(size_t)(k0 + r) * DIN + n0 + cc] * scl[cc]; }
        __syncthreads();
#pragma unroll
        for (int i = 0; i < 2; ++i) { const int idx = tid + 512 * i, n = idx >> 4, k4 = idx & 15;
            int wd = __builtin_amdgcn_cvt_pk_fp8_f32(t[(4 * k4) * 65 + n], t[(4 * k4 + 1) * 65 + n], 0, false);
            wd = __builtin_amdgcn_cvt_pk_fp8_f32(t[(4 * k4 + 2) * 65 + n], t[(4 * k4 + 3) * 65 + n], wd, true);
            *(int*)(dst + (size_t)wperm(n0 + n) * 1024 + k0 + 4 * k4) = wd; }
        __syncthreads();
    }
}
DI void row_to_fp8(const f32x4 (&o)[4], unsigned char* x8row, float* xs, int ln) {
    float m = 0.f;
#pragma unroll
    for (int q = 0; q < 4; ++q) m = fmaxf(m, fmaxf(fmaxf(fabsf(o[q][0]), fabsf(o[q][1])), fmaxf(fabsf(o[q][2]), fabsf(o[q][3]))));
    m = fmaxf(m, __shfl_xor(m, 32)); m = fmaxf(m, __shfl_xor(m, 16)); m = fmaxf(m, __shfl_xor(m, 8)); m = fmaxf(m, __shfl_xor(m, 4)); m = fmaxf(m, __shfl_xor(m, 2)); m = fmaxf(m, __shfl_xor(m, 1));
    const float sc = (m > 0.f) ? 240.0f / m : 1.0f;
    u32x4 w;
#pragma unroll
    for (int q = 0; q < 4; ++q) { int wd = __builtin_amdgcn_cvt_pk_fp8_f32(o[q][0] * sc, o[q][1] * sc, 0, false); wd = __builtin_amdgcn_cvt_pk_fp8_f32(o[q][2] * sc, o[q][3] * sc, wd, true); w[q] = (unsigned)wd; }
    *(u32x4*)(x8row + 16 * ln) = w;
    if (ln == 0) *xs = (m > 0.f) ? m * (1.0f / 240.0f) : 1.0f;
}
DI void conv_fp8_rows(const float* src, unsigned char* ws, int unit, int isV) {
    const int tid = mk_tid(), lane = tid & 63, w = tid >> 6;
    const size_t row = (size_t)unit * 8 + w;
    const float* sp = src + row * 1024 + 4 * lane;
    f32x4 v[4]; float m = 0.f;
#pragma unroll
    for (int i = 0; i < 4; ++i) { v[i] = *(const f32x4*)(sp + 256 * i); m = fmaxf(m, fmaxf(fmaxf(fabsf(v[i][0]), fabsf(v[i][1])), fmaxf(fabsf(v[i][2]), fabsf(v[i][3])))); }
    m = fmaxf(m, __shfl_xor(m, 32)); m = fmaxf(m, __shfl_xor(m, 16)); m = fmaxf(m, __shfl_xor(m, 8)); m = fmaxf(m, __shfl_xor(m, 4)); m = fmaxf(m, __shfl_xor(m, 2)); m = fmaxf(m, __shfl_xor(m, 1));
    const float sc = (m > 0.f) ? 384.0f / m : 1.0f, inv = (m > 0.f) ? m * (1.0f / 384.0f) : 1.0f;
    unsigned char* dp = ws + WS_UV8 + row * 2048 + (isV ? 1024 : 0) + 4 * lane;
#pragma unroll
    for (int i = 0; i < 4; ++i) { int wd = __builtin_amdgcn_cvt_pk_fp8_f32(v[i][0] * sc, v[i][1] * sc, 0, false); wd = __builtin_amdgcn_cvt_pk_fp8_f32(v[i][2] * sc, v[i][3] * sc, wd, true); *(int*)(dp + 256 * i) = wd; }
    if (lane == 0) ((float*)(ws + WS_UVS))[row * 2 + isV] = inv;
}
DI void phase_conv(const Args& a, int layer, LAS unsigned char* lds) {
    unsigned char* ws = a.ws;
    LAS float* t = (LAS float*)lds;
    const int J0 = 216, J1 = J0 + 128, J2 = J1 + 256, J3 = J2 + 256, J4 = J3 + 256, J5 = J4 + 512, J6 = J5 + 32, J7 = J6 + 2048, J8 = J7 + 2048, J9 = J8 + 64, J10 = J9 + 1;
    const int total = J10;
    for (int u = blockIdx.x; u < total; u += gridDim.x) {
        if (u < J0) { w8_unit(a.in[1] + (size_t)layer * 1024 * DIN, ws, u, t); }
        else if (u < J1) { const int v = u - J0, kt = v / 16, nt = v % 16; tconv_tile<false>(a.in[9] + (size_t)layer * 2560 * 1024, 1024, (bf16_t*)(ws + WS_WBAT), 512, kt * 64, nt * 64, t); }
        else if (u < J2) { const int v = u - J1, kt = v / 16, nt = v % 16; tconv_tile<false>(a.in[9] + (size_t)layer * 2560 * 1024 + (size_t)512 * 1024, 1024, (bf16_t*)(ws + WS_WBBT), 1024, kt * 64, nt * 64, t); }
        else if (u < J3) { const int v = u - J2, kt = v / 16, nt = v % 16; tconv_tile<false>(a.in[9] + (size_t)layer * 2560 * 1024 + (size_t)1536 * 1024, 1024, (bf16_t*)(ws + WS_WBCT), 1024, kt * 64, nt * 64, t); }
        else if (u < J4) { const int v = u - J3, kt = v / 16, nt = v % 16; tconv_tile<false>(a.in[10] + (size_t)layer * 1024 * 1024, 1024, (bf16_t*)(ws + WS_WOT), 1024, kt * 64, nt * 64, t); }
        else if (u < J5) { const int v = u - J4, kt = v / 32, nt = v % 32; tconv_tile<false>(a.in[13] + (size_t)layer * 1024 * 2048, 2048, (bf16_t*)(ws + WS_WQT), 1024, kt * 64, nt * 64, t); }
        else if (u < J6) { const int v = u - J5, blk = v & 15, which = v >> 4;
            tconv_tile<false>(a.in[which ? 6 : 4] + ((size_t)layer * 16 + blk) * 4096, 64, (bf16_t*)(ws + (which ? WS_WXT : WS_WAT)) + blk * 4096, 64, 0, 0, t); }
        else if (u < J7) { conv_fp8_rows(a.in[16] + (size_t)layer * 16384 * 1024, ws, u - J6, 0); }
        else if (u < J8) { conv_fp8_rows(a.in[17] + (size_t)layer * 16384 * 1024, ws, u - J7, 1); }
        else if (u < J9) { const int v = u - J8; if (v < 32) conv_unit(a.in[14] + (size_t)layer * 131072, (bf16_t*)(ws + WS_K1B), v); else conv_unit(a.in[15] + (size_t)layer * 131072, (bf16_t*)(ws + WS_K2B), v - 32); }
        else { for (int c = mk_tid(); c < 1024; c += 512) { const float lam = a.in[8][layer * 1024 + c]; const float e = __builtin_amdgcn_exp2f(-lam * 1.4426950408889634f); const float sp = (e < 0.05f) ? e * (1.0f + e * (-0.5f + e * (0.33333333f + e * -0.25f))) : __builtin_amdgcn_logf(1.0f + e) * 0.6931471805599453f; ((float*)(ws + WS_CCH))[c] = -8.0f * sp; } }
    }
}

DI void phase_prologue(const Args& a) {
    unsigned char* ws = a.ws;
    const int tid = mk_tid();
    for (int u = blockIdx.x; u < 2048 + 1536; u += gridDim.x) {
        if (u < 2048) { const int ln = tid & 63; const size_t row = (size_t)u * 8 + (tid >> 6);
            const float* xp = a.in[0] + row * 1024 + 16 * ln; float* xo = (float*)(ws + WS_XF) + row * 1024 + 16 * ln;
            f32x4 o[4];
#pragma unroll
            for (int q = 0; q < 4; ++q) { o[q] = *(const f32x4*)(xp + 4 * q); *(f32x4*)(xo + 4 * q) = o[q]; }
            row_to_fp8(o, ws + WS_X8 + row * 1024, (float*)(ws + WS_XS) + row, ln); }
        else { const int idx = (u - 2048) * 512 + tid;
            const int pos = idx / 192, i = idx % 192;
            const bool isA = i < 64; const int fi = isA ? i : i - 64; const double r = isA ? a.ropeA : a.ropeR;
            double inv = 1.0; for (int k = 0; k < fi; ++k) inv *= r;
            double s, c; sincos_d((double)pos * inv, s, c);
            if (isA) { ((float*)(ws + WS_COSA))[pos * 64 + fi] = (float)c; ((float*)(ws + WS_SINA))[pos * 64 + fi] = (float)s; }
            else { ((float*)(ws + WS_COSR))[pos * 128 + fi] = (float)c; ((float*)(ws + WS_SINR))[pos * 128 + fi] = (float)s; } }
    }
}

DI void phase_rope(const Args& a) {
    unsigned char* ws = a.ws; bf16_t* proj = (bf16_t*)(ws + WS_PROJ);
    for (int u = blockIdx.x; u < NTOK / 8; u += gridDim.x) {
#pragma unroll 1
        for (int i = 0; i < 5; ++i) {
            const int idx = mk_tid() + 512 * i, tk = u * 8 + idx / 320; int it = idx % 320;
            int off, hd, half, head, ch; const float* ct; const float* st; float sc = 1.0f;
            if (it < 192) { off = (it < 96) ? OFF_AQ : OFF_AK; if (it >= 96) it -= 96; hd = 128; half = 64; head = it >> 3; ch = it & 7; ct = (const float*)(ws + WS_COSA); st = (const float*)(ws + WS_SINA); }
            else { it -= 192; off = (it < 64) ? OFF_RQ : OFF_RK; if (it >= 64) { it -= 64; sc = 0.0625f; } hd = 256; half = 128; head = it >> 4; ch = it & 15; ct = (const float*)(ws + WS_COSR); st = (const float*)(ws + WS_SINR); }
            const int pos = tk & (SEQ - 1);
            bf16_t* p1 = proj + (size_t)tk * DIN + off + head * hd + ch * 8; bf16_t* p2 = p1 + half;
            const u32x4 x1 = *(const u32x4*)p1, x2 = *(const u32x4*)p2;
            const float* cp = ct + (size_t)pos * half + ch * 8; const float* sp = st + (size_t)pos * half + ch * 8;
            const f32x4 c0 = *(const f32x4*)cp, c1 = *(const f32x4*)(cp + 4), s0 = *(const f32x4*)sp, s1 = *(const f32x4*)(sp + 4);
            float t1[8], t2[8], cc[8], ss[8];
#pragma unroll
            for (int q = 0; q < 4; ++q) { t1[2 * q] = bflo(x1[q]); t1[2 * q + 1] = bfhi(x1[q]); t2[2 * q] = bflo(x2[q]); t2[2 * q + 1] = bfhi(x2[q]); cc[q] = c0[q]; cc[4 + q] = c1[q]; ss[q] = s0[q]; ss[4 + q] = s1[q]; }
            u32x4 o1, o2;
#pragma unroll
            for (int q = 0; q < 4; ++q) {
                const float a0 = (t1[2 * q] * cc[2 * q] - t2[2 * q] * ss[2 * q]) * sc, a1 = (t1[2 * q + 1] * cc[2 * q + 1] - t2[2 * q + 1] * ss[2 * q + 1]) * sc;
                const float b0 = (t1[2 * q] * ss[2 * q] + t2[2 * q] * cc[2 * q]) * sc, b1 = (t1[2 * q + 1] * ss[2 * q + 1] + t2[2 * q + 1] * cc[2 * q + 1]) * sc;
                o1[q] = pk2(a0, a1); o2[q] = pk2(b0, b1); }
            *(u32x4*)p1 = o1; *(u32x4*)p2 = o2;
        }
    }
}

DI void attn_unit(const Args& a, int unit, LAS unsigned char* lds) {
    unsigned char* ws = a.ws;
    const int tid = mk_tid(), lane = tid & 63, w = __builtin_amdgcn_readfirstlane(tid >> 6), g = lane >> 4, l15 = lane & 15, tq4 = l15 >> 2, tp4 = l15 & 3;
    const int b = unit / 384, rem = unit % 384, h = rem >> 5, bi = rem & 31;
    const int grp = h >> 2, d = (grp == 0) ? 1 : ((grp == 1) ? 4 : 16), nb = 32 / d, r = bi / nb, n = bi % nb;
    const bf16_t* proj = (const bf16_t*)(ws + WS_PROJ) + (size_t)b * SEQ * DIN;
    LAS unsigned char* Ks = lds; LAS unsigned char* Vs = lds + 256 * 288;
#pragma unroll
    for (int i = 0; i < 8; ++i) {
        const int idx = tid + 512 * i, row = idx >> 4, ch = idx & 15, m = 128 * (n - 1) + row;
        u32x4 kv = {0u, 0u, 0u, 0u}, vv = {0u, 0u, 0u, 0u};
        if (m >= 0) { const bf16_t* p = proj + (size_t)(m * d + r) * DIN + h * 128 + ch * 8; kv = *(const u32x4*)(p + OFF_AK); vv = *(const u32x4*)(p + OFF_AV); }
        *(LAS u32x4*)(Ks + row * 288 + ch * 16) = kv; *(LAS u32x4*)(Vs + row * 288 + ch * 16) = vv;
    }
    const int qi = 16 * w + l15;
    const size_t tq = (size_t)(128 * n + qi) * d + r;
    bf16x8 qf[4];
#pragma unroll
    for (int ks = 0; ks < 4; ++ks) qf[ks] = *(const bf16x8*)(proj + tq * DIN + OFF_AQ + h * 128 + 32 * ks + 8 * g);
    __syncthreads();
    const int s0 = w >> 1;
    f32x4 sacc[10];
#pragma unroll
    for (int jj = 0; jj < 10; ++jj) {
        f32x4 acc = {0.f, 0.f, 0.f, 0.f};
#pragma unroll
        for (int ks = 0; ks < 4; ++ks) { const bf16x8 kf = *(const LAS bf16x8*)(Ks + (32 * s0 + 16 * jj + l15) * 288 + (32 * ks + 8 * g) * 2); acc = mfma16(kf, qf[ks], acc); }
        sacc[jj] = acc;
    }
    const float scale = 0.08838834764831845f * 1.4426950408889634f;
    float mx = -1e30f;
#pragma unroll
    for (int jj = 0; jj < 10; ++jj)
#pragma unroll
        for (int rg = 0; rg < 4; ++rg) {
            const int j = 32 * s0 + 16 * jj + 4 * g + rg;
            const bool valid = (j >= qi) && (j <= qi + 128) && (n > 0 || j >= 128);
            const float s = valid ? sacc[jj][rg] * scale : -1e30f;
            sacc[jj][rg] = s; mx = fmaxf(mx, s);
        }
    mx = fmaxf(mx, __shfl_xor(mx, 16)); mx = fmaxf(mx, __shfl_xor(mx, 32));
    float sum = 0.f;
#pragma unroll
    for (int jj = 0; jj < 10; ++jj)
#pragma unroll
        for (int rg = 0; rg < 4; ++rg) { const float p = __builtin_amdgcn_exp2f(sacc[jj][rg] - mx); sacc[jj][rg] = p; sum += p; }
    sum += __shfl_xor(sum, 16); sum += __shfl_xor(sum, 32);
    f32x4 oacc[8];
#pragma unroll
    for (int db = 0; db < 8; ++db) oacc[db] = (f32x4){0.f, 0.f, 0.f, 0.f};
#pragma unroll
    for (int s = 0; s < 5; ++s) {
        u32x4 pw; pw.x = pk2(sacc[2 * s][0], sacc[2 * s][1]); pw.y = pk2(sacc[2 * s][2], sacc[2 * s][3]); pw.z = pk2(sacc[2 * s + 1][0], sacc[2 * s + 1][1]); pw.w = pk2(sacc[2 * s + 1][2], sacc[2 * s + 1][3]);
        const bf16x8 pb = __builtin_bit_cast(bf16x8, pw);
        const int k0 = 32 * (s0 + s) + 4 * g + tq4;
#pragma unroll
        for (int db = 0; db < 8; ++db) {
            const s16x4 lo = trrd(Vs + k0 * 288 + (16 * db + 4 * tp4) * 2), hi = trrd(Vs + (k0 + 16) * 288 + (16 * db + 4 * tp4) * 2);
            oacc[db] = mfma16(cat8(lo, hi), pb, oacc[db]);
        }
    }
    const float inv = 1.0f / sum;
    bf16_t* op = (bf16_t*)(ws + WS_OATT) + ((size_t)b * SEQ + tq) * 1536 + h * 128 + 4 * g;
#pragma unroll
    for (int db = 0; db < 8; ++db) { u32x2 o; o.x = pk2(oacc[db][0] * inv, oacc[db][1] * inv); o.y = pk2(oacc[db][2] * inv, oacc[db][3] * inv); *(u32x2*)(op + 16 * db) = o; }
    if (g == 0) ((float*)(ws + WS_LSE))[((size_t)b * SEQ + tq) * 12 + h] = mx + __builtin_amdgcn_logf(sum);
    __syncthreads();
}

DI void retkv_unit(const Args& a, int unit, LAS unsigned char* lds) {
    unsigned char* ws = a.ws;
    const int tid = mk_tid(), lane = tid & 63, w = __builtin_amdgcn_readfirstlane(tid >> 6), g = lane >> 4, l15 = lane & 15, tq4 = l15 >> 2, tp4 = l15 & 3;
    const int b = unit >> 7, h = (unit >> 5) & 3, c = unit & 31;
    const bf16_t* proj = (const bf16_t*)(ws + WS_PROJ) + ((size_t)b * SEQ + c * 128) * DIN;
    LAS unsigned char* Ks = lds; LAS unsigned char* Vs = lds + 128 * 544;
    const float l2g = log2gamma(h);
#pragma unroll
    for (int i = 0; i < 8; ++i) {
        const int idx = tid + 512 * i, row = idx >> 5, ch = idx & 31;
        const bf16_t* p = proj + (size_t)row * DIN + h * 256 + ch * 8;
        const u32x4 kv = *(const u32x4*)(p + OFF_RK), vv = *(const u32x4*)(p + OFF_RV);
        const float z = exp2f((float)(127 - row) * l2g);
        u32x4 kz;
#pragma unroll
        for (int q = 0; q < 4; ++q) kz[q] = pk2(bflo(kv[q]) * z, bfhi(kv[q]) * z);
        *(LAS u32x4*)(Ks + row * 544 + ch * 16) = kz; *(LAS u32x4*)(Vs + row * 544 + ch * 16) = vv;
    }
    __syncthreads();
#pragma unroll 1
    for (int nh = 0; nh < 2; ++nh) {
        f32x4 acc[2][8];
#pragma unroll
        for (int mb = 0; mb < 2; ++mb)
#pragma unroll
            for (int nb = 0; nb < 8; ++nb) acc[mb][nb] = (f32x4){0.f, 0.f, 0.f, 0.f};
#pragma unroll
        for (int ks = 0; ks < 4; ++ks) {
            const int j0 = 32 * ks + 4 * g + tq4;
            bf16x8 af[2];
#pragma unroll
            for (int mb = 0; mb < 2; ++mb) { const int col = 32 * w + 16 * mb + 4 * tp4; af[mb] = cat8(trrd(Vs + j0 * 544 + col * 2), trrd(Vs + (j0 + 16) * 544 + col * 2)); }
#pragma unroll
            for (int nb = 0; nb < 8; ++nb) {
                const int col = 128 * nh + 16 * nb + 4 * tp4;
                const bf16x8 bfr = cat8(trrd(Ks + j0 * 544 + col * 2), trrd(Ks + (j0 + 16) * 544 + col * 2));
#pragma unroll
                for (int mb = 0; mb < 2; ++mb) acc[mb][nb] = mfma16(af[mb], bfr, acc[mb][nb]);
            }
        }
        bf16_t* kvb = (bf16_t*)(ws + WS_KVB) + ((size_t)((b * 4 + h) * 32 + c)) * 65536 + 128 * nh;
#pragma unroll
        for (int mb = 0; mb < 2; ++mb)
#pragma unroll
            for (int nb = 0; nb < 8; ++nb)
#pragma unroll
                for (int rg = 0; rg < 4; ++rg) kvb[(size_t)(32 * w + 16 * mb + 4 * g + rg) * 256 + 16 * nb + l15] = f2bf(acc[mb][nb][rg]);
    }
    __syncthreads();
}

DI void lru_unit(const Args& a, int layer, int unit, bool fin, LAS unsigned char* lds) {
    unsigned char* ws = a.ws;
    const int tid = mk_tid(), lane = tid & 63, w = __builtin_amdgcn_readfirstlane(tid >> 6), g = lane >> 4, l15 = lane & 15;
    const int b = unit >> 9, c = (unit >> 4) & 31, blk = unit & 15;
    LAS bf16_t* lxs = (LAS bf16_t*)lds;
    LAS float* xcf = (LAS float*)(lds + 16896);
    LAS unsigned char* xcb = lds + 49664;
    LAS float* rgt = (LAS float*)(lds + 68096);
    LAS float* igt = (LAS float*)(lds + 100864);
    LAS float* wst = (LAS float*)(lds + 133632);
    const bf16_t* proj = (const bf16_t*)(ws + WS_PROJ) + (size_t)b * SEQ * DIN;
    for (int idx = tid; idx < 131 * 8; idx += 512) {
        const int row = idx >> 3, ch = idx & 7, tk = c * 128 - 3 + row;
        u32x4 v = {0u, 0u, 0u, 0u};
        if (tk >= 0) v = *(const u32x4*)(proj + (size_t)tk * DIN + OFF_LX + blk * 64 + ch * 8);
        *(LAS u32x4*)(lxs + row * 64 + ch * 8) = v;
    }
    __syncthreads();
    {
        const int ch = tid & 63, gc = blk * 64 + ch;
        const float* cw = a.in[2] + (size_t)layer * 4096;
        const float cw0 = cw[gc], cw1 = cw[1024 + gc], cw2 = cw[2048 + gc], cw3 = cw[3072 + gc], cb = a.in[3][layer * 1024 + gc];
#pragma unroll
        for (int i = 0; i < 16; ++i) {
            const int t = (tid >> 6) + 8 * i;
            const float xc = cb + cw0 * bf2f(lxs[t * 64 + ch]) + cw1 * bf2f(lxs[(t + 1) * 64 + ch]) + cw2 * bf2f(lxs[(t + 2) * 64 + ch]) + cw3 * bf2f(lxs[(t + 3) * 64 + ch]);
            xcf[t * 64 + ch] = xc; *(LAS bf16_t*)(xcb + t * 144 + ch * 2) = f2bf(xc);
        }
    }
    __syncthreads();
#pragma unroll
    for (int gate = 0; gate < 2; ++gate) {
        const bf16_t* WT = (const bf16_t*)(ws + (gate ? WS_WXT : WS_WAT)) + blk * 4096;
        const float* bias = a.in[gate ? 7 : 5] + layer * 1024 + blk * 64;
        LAS float* dst = gate ? igt : rgt;
#pragma unroll
        for (int nb = 0; nb < 4; ++nb) {
            f32x4 acc = {0.f, 0.f, 0.f, 0.f};
#pragma unroll
            for (int ks = 0; ks < 2; ++ks) {
                const bf16x8 af = *(const LAS bf16x8*)(xcb + (16 * w + l15) * 144 + (32 * ks + 8 * g) * 2);
                const bf16x8 bfr = *(const bf16x8*)(WT + (16 * nb + l15) * 64 + 32 * ks + 8 * g);
                acc = mfma16(af, bfr, acc);
            }
            const float bv = bias[16 * nb + l15];
#pragma unroll
            for (int rg = 0; rg < 4; ++rg) dst[(16 * w + 4 * g + rg) * 64 + 16 * nb + l15] = sigm(acc[rg] + bv);
        }
    }
    __syncthreads();
    const int ch = lane, gc = blk * 64 + ch;
    const float cc = ((const float*)(ws + WS_CCH))[gc];
    float av[16], bv[16]; float Aw = 1.0f, Hw = 0.0f;
#pragma unroll
    for (int tt = 0; tt < 16; ++tt) {
        const int t = 16 * w + tt;
        const float la = cc * rgt[t * 64 + ch];
        const float aa = __builtin_amdgcn_exp2f(la * 1.4426950408889634f);
        const float bb = __builtin_amdgcn_sqrtf(fmaxf(1.0f - aa * aa, 0.0f)) * igt[t * 64 + ch] * xcf[t * 64 + ch];
        av[tt] = aa; bv[tt] = bb; Hw = aa * Hw + bb; Aw *= aa;
    }
    wst[w * 64 + ch] = Aw; wst[512 + w * 64 + ch] = Hw;
    __syncthreads();
    float* LA = (float*)(ws + WS_LSTA); float* LH = (float*)(ws + WS_LSTH);
    if (!fin) {
        if (w == 0) {
            float A = 1.0f, H = 0.0f;
#pragma unroll
            for (int ww = 0; ww < 8; ++ww) { const float A_ = wst[ww * 64 + ch], H_ = wst[512 + ww * 64 + ch]; H = A_ * H + H_; A *= A_; }
            LA[(size_t)(b * 32 + c) * 1024 + gc] = A; LH[(size_t)(b * 32 + c) * 1024 + gc] = H;
        }
    } else {
        float hcur = 0.0f;
#pragma unroll
        for (int c0 = 0; c0 < 32; c0 += 16) {
            if (c0 < c) {
                float ta[16], th[16];
#pragma unroll
                for (int q = 0; q < 16; ++q) { const int cp = (c0 + q < c) ? c0 + q : 0; ta[q] = LA[(size_t)(b * 32 + cp) * 1024 + gc]; th[q] = LH[(size_t)(b * 32 + cp) * 1024 + gc]; }
#pragma unroll
                for (int q = 0; q < 16; ++q) hcur = (c0 + q < c) ? ta[q] * hcur + th[q] : hcur;
            }
        }
        for (int ww = 0; ww < w; ++ww) hcur = wst[ww * 64 + ch] * hcur + wst[512 + ww * 64 + ch];
        bf16_t* yb = (bf16_t*)(ws + WS_YB) + ((size_t)b * SEQ + c * 128 + 16 * w) * 1024 + gc;
        const bf16_t* lgp = proj + (size_t)(c * 128 + 16 * w) * DIN + OFF_LG + gc;
#pragma unroll
        for (int tt = 0; tt < 16; ++tt) {
            hcur = av[tt] * hcur + bv[tt];
            const float lgv = bf2f(lgp[(size_t)tt * DIN]);
            yb[(size_t)tt * 1024] = f2bf(hcur * gelu_as(lgv));
        }
    }
    __syncthreads();
}

DI void retscan_unit(const Args& a, int unit) {
    unsigned char* ws = a.ws;
    const int e8 = unit * 512 + mk_tid();
    const int bh = e8 >> 13, within = e8 & 8191, h = bh & 3;
    const float g128 = exp2f(128.0f * log2gamma(h));
    bf16_t* base = (bf16_t*)(ws + WS_KVB) + (size_t)bh * 32 * 65536 + (size_t)within * 8;
    float st[8];
#pragma unroll
    for (int q = 0; q < 8; ++q) st[q] = 0.f;
#pragma unroll 1
    for (int c0 = 0; c0 < 32; c0 += 8) {
        u32x4 kv[8];
#pragma unroll
        for (int q = 0; q < 8; ++q) kv[q] = *(const u32x4*)(base + (size_t)(c0 + q) * 65536);
#pragma unroll
        for (int q = 0; q < 8; ++q) {
            u32x4 o;
#pragma unroll
            for (int j = 0; j < 4; ++j) o[j] = pk2(st[2 * j], st[2 * j + 1]);
            *(u32x4*)(base + (size_t)(c0 + q) * 65536) = o;
#pragma unroll
            for (int j = 0; j < 4; ++j) { st[2 * j] = g128 * st[2 * j] + bflo(kv[q][j]); st[2 * j + 1] = g128 * st[2 * j + 1] + bfhi(kv[q][j]); }
        }
    }
}

DI void attmerge_unit(const Args& a, int unit) {
    unsigned char* ws = a.ws;
    const int idx = unit * 512 + mk_tid(), t = idx >> 6, hp = (idx >> 4) & 3, dc = idx & 15;
    const float* lse = (const float*)(ws + WS_LSE) + (size_t)t * 12;
    const float l0 = lse[hp], l1 = lse[4 + hp], l2 = lse[8 + hp];
    const float m = fmaxf(l0, fmaxf(l1, l2));
    float w0 = __builtin_amdgcn_exp2f(l0 - m), w1 = __builtin_amdgcn_exp2f(l1 - m), w2 = __builtin_amdgcn_exp2f(l2 - m);
    const float is = 1.0f / (w0 + w1 + w2); w0 *= is; w1 *= is; w2 *= is;
    const bf16_t* o = (const bf16_t*)(ws + WS_OATT) + (size_t)t * 1536 + hp * 128 + dc * 8;
    const u32x4 a0 = *(const u32x4*)o, a1 = *(const u32x4*)(o + 512), a2 = *(const u32x4*)(o + 1024);
    u32x4 r;
#pragma unroll
    for (int q = 0; q < 4; ++q) r[q] = pk2(w0 * bflo(a0[q]) + w1 * bflo(a1[q]) + w2 * bflo(a2[q]), w0 * bfhi(a0[q]) + w1 * bfhi(a1[q]) + w2 * bfhi(a2[q]));
    *(u32x4*)((bf16_t*)(ws + WS_YA) + (size_t)t * 512 + hp * 128 + dc * 8) = r;
}

DI void retout_unit(const Args& a, int unit, LAS unsigned char* lds) {
    unsigned char* ws = a.ws;
    const int tid = mk_tid(), lane = tid & 63, w = __builtin_amdgcn_readfirstlane(tid >> 6), g = lane >> 4, l15 = lane & 15, tq4 = l15 >> 2, tp4 = l15 & 3;
    const int b = unit >> 7, h = (unit >> 5) & 3, c = unit & 31;
    const bf16_t* proj = (const bf16_t*)(ws + WS_PROJ) + ((size_t)b * SEQ + c * 128) * DIN;
    const bf16_t* rt = (const bf16_t*)(ws + WS_KVB) + ((size_t)((b * 4 + h) * 32 + c)) * 65536;
    LAS unsigned char* RA = lds; LAS unsigned char* RB = lds + 128 * 544;
    const float l2g = log2gamma(h);
    const int qi = 16 * w + l15;
    bf16x8 qf[8];
#pragma unroll
    for (int ks = 0; ks < 8; ++ks) qf[ks] = *(const bf16x8*)(proj + (size_t)qi * DIN + OFF_RQ + h * 256 + 32 * ks + 8 * g);
#pragma unroll
    for (int i = 0; i < 8; ++i) {
        const int idx = tid + 512 * i, row = idx >> 5, ch = idx & 31;
        *(LAS u32x4*)(RA + row * 544 + ch * 16) = *(const u32x4*)(proj + (size_t)row * DIN + OFF_RK + h * 256 + ch * 8);
        *(LAS u32x4*)(RB + row * 544 + ch * 16) = *(const u32x4*)(rt + (size_t)row * 256 + ch * 8);
    }
    __syncthreads();
    f32x4 sacc[8], oacc[16];
#pragma unroll
    for (int jj = 0; jj < 8; ++jj) {
        f32x4 acc = {0.f, 0.f, 0.f, 0.f};
        if (jj <= w) {
#pragma unroll
            for (int ks = 0; ks < 8; ++ks) { const bf16x8 kf = *(const LAS bf16x8*)(RA + (16 * jj + l15) * 544 + (32 * ks + 8 * g) * 2); acc = mfma16(kf, qf[ks], acc); }
        }
        sacc[jj] = acc;
    }
#pragma unroll
    for (int db = 0; db < 8; ++db) {
        f32x4 acc = {0.f, 0.f, 0.f, 0.f};
#pragma unroll
        for (int ks = 0; ks < 8; ++ks) { const bf16x8 rf = *(const LAS bf16x8*)(RB + (16 * db + l15) * 544 + (32 * ks + 8 * g) * 2); acc = mfma16(rf, qf[ks], acc); }
        oacc[db] = acc;
    }
    __syncthreads();
#pragma unroll
    for (int i = 0; i < 8; ++i) {
        const int idx = tid + 512 * i, row = idx >> 5, ch = idx & 31;
        *(LAS u32x4*)(RA + row * 544 + ch * 16) = *(const u32x4*)(proj + (size_t)row * DIN + OFF_RV + h * 256 + ch * 8);
        *(LAS u32x4*)(RB + row * 544 + ch * 16) = *(const u32x4*)(rt + (size_t)(128 + row) * 256 + ch * 8);
    }
    __syncthreads();
#pragma unroll
    for (int db = 0; db < 8; ++db) {
        f32x4 acc = {0.f, 0.f, 0.f, 0.f};
#pragma unroll
        for (int ks = 0; ks < 8; ++ks) { const bf16x8 rf = *(const LAS bf16x8*)(RB + (16 * db + l15) * 544 + (32 * ks + 8 * g) * 2); acc = mfma16(rf, qf[ks], acc); }
        oacc[8 + db] = acc;
    }
    const float xi = __builtin_amdgcn_exp2f((float)(qi + 1) * l2g);
#pragma unroll
    for (int db = 0; db < 16; ++db) oacc[db] = oacc[db] * xi;
#pragma unroll
    for (int jj = 0; jj < 8; ++jj)
#pragma unroll
        for (int rg = 0; rg < 4; ++rg) { const int j = 16 * jj + 4 * g + rg; sacc[jj][rg] = (qi >= j) ? sacc[jj][rg] * __builtin_amdgcn_exp2f((float)(qi - j) * l2g) : 0.f; }
#pragma unroll
    for (int s = 0; s < 4; ++s) {
        if (2 * s <= w) {
            u32x4 pw; pw.x = pk2(sacc[2 * s][0], sacc[2 * s][1]); pw.y = pk2(sacc[2 * s][2], sacc[2 * s][3]); pw.z = pk2(sacc[2 * s + 1][0], sacc[2 * s + 1][1]); pw.w = pk2(sacc[2 * s + 1][2], sacc[2 * s + 1][3]);
            const bf16x8 pb = __builtin_bit_cast(bf16x8, pw);
            const int k0 = 32 * s + 4 * g + tq4;
#pragma unroll
            for (int db = 0; db < 16; ++db) {
                const s16x4 lo = trrd(RA + k0 * 544 + (16 * db + 4 * tp4) * 2), hi = trrd(RA + (k0 + 16) * 544 + (16 * db + 4 * tp4) * 2);
                oacc[db] = mfma16(cat8(lo, hi), pb, oacc[db]);
            }
        }
    }
    float s1 = 0.f;
#pragma unroll
    for (int db = 0; db < 16; ++db) s1 += (oacc[db][0] + oacc[db][1]) + (oacc[db][2] + oacc[db][3]);
    s1 += __shfl_xor(s1, 16); s1 += __shfl_xor(s1, 32);
    const float mean = s1 * (1.0f / 256.0f);
    float s2 = 0.f;
#pragma unroll
    for (int db = 0; db < 16; ++db)
#pragma unroll
        for (int rg = 0; rg < 4; ++rg) { const float dd = oacc[db][rg] - mean; s2 += dd * dd; }
    s2 += __shfl_xor(s2, 16); s2 += __shfl_xor(s2, 32);
    const float rstd = rsqrtf(s2 * (1.0f / 256.0f) + LN_EPS);
    const bf16_t* rgp = proj + (size_t)qi * DIN + OFF_RG + h * 256 + 4 * g;
    bf16_t* yc = (bf16_t*)(ws + WS_YC) + ((size_t)b * SEQ + c * 128 + qi) * 1024 + h * 256 + 4 * g;
#pragma unroll
    for (int db = 0; db < 16; ++db) {
        const u32x2 gw = *(const u32x2*)(rgp + 16 * db);
        const float g0 = bflo(gw.x), g1 = bfhi(gw.x), g2 = bflo(gw.y), g3 = bfhi(gw.y);
        u32x2 o;
        o.x = pk2(g0 * sigm(g0) * (oacc[db][0] - mean) * rstd, g1 * sigm(g1) * (oacc[db][1] - mean) * rstd);
        o.y = pk2(g2 * sigm(g2) * (oacc[db][2] - mean) * rstd, g3 * sigm(g3) * (oacc[db][3] - mean) * rstd);
        *(u32x2*)(yc + 16 * db) = o;
    }
    __syncthreads();
}

struct EpiBranch {
    static constexpr bool PERM = false, AFTER_DRAIN = false;
    const bf16_t* gate; float* mf; bf16_t* mb; int mode;
    __device__ __forceinline__ void operator()(const f32x4 (&acc)[2][2][4][2], const pg8::Unit& u, int wr, int wc, int fr, int fq) const {
        const int row0 = u.pm * 256 + wr * 64 + fr, col0 = u.pn * 256 + wc * 32 + 4 * fq;
#pragma unroll
        for (int ai = 0; ai < 2; ++ai)
#pragma unroll
            for (int mh = 0; mh < 2; ++mh) {
                u32x2 gw[2][2][2]; f32x4 old[2][2][2];
#pragma unroll
                for (int mm = 0; mm < 2; ++mm) { const size_t row = (size_t)(row0 + ai * 128 + (2 * mh + mm) * 16);
#pragma unroll
                    for (int bj = 0; bj < 2; ++bj)
#pragma unroll
                        for (int n = 0; n < 2; ++n) { const int col = col0 + bj * 128 + n * 16;
                            gw[mm][bj][n] = *(const u32x2*)(gate + row * DIN + col);
                            old[mm][bj][n] = (mode != 0) ? *(const f32x4*)(mf + row * 1024 + col) : (f32x4){0.f, 0.f, 0.f, 0.f}; } }
#pragma unroll
                for (int mm = 0; mm < 2; ++mm) { const size_t row = (size_t)(row0 + ai * 128 + (2 * mh + mm) * 16);
#pragma unroll
                    for (int bj = 0; bj < 2; ++bj)
#pragma unroll
                        for (int n = 0; n < 2; ++n) { const int col = col0 + bj * 128 + n * 16;
                            const u32x2 g2 = gw[mm][bj][n];
                            f32x4 v = acc[ai][bj][2 * mh + mm][n];
                            v[0] = v[0] * sigm(bflo(g2.x)) + old[mm][bj][n][0]; v[1] = v[1] * sigm(bfhi(g2.x)) + old[mm][bj][n][1];
                            v[2] = v[2] * sigm(bflo(g2.y)) + old[mm][bj][n][2]; v[3] = v[3] * sigm(bfhi(g2.y)) + old[mm][bj][n][3];
                            if (mode != 2) *(f32x4*)(mf + row * 1024 + col) = v;
                            else { u32x2 o; o.x = pk2(v[0], v[1]); o.y = pk2(v[2], v[3]); *(u32x2*)(mb + row * 1024 + col) = o; } } }
            }
    }
};
struct EpiInProj {
    static constexpr bool PERM = true, AFTER_DRAIN = false;
    bf16_t* O; const float* cosA; const float* sinA; const float* cosR; const float* sinR; const float* sx; const float* sw;
    __device__ __forceinline__ void operator()(const f32x4 (&acc)[2][2][4][2], const pg8::Unit& u, int wr_, int wc_, int fr_, int fq_) const {
        (void)wr_; (void)wc_; (void)fr_; (void)fq_;
        const int tid = mk_tid(), wid = tid >> 6, lane = tid & 63, wr = wid >> 2, wc = wid & 3, fr = lane & 15, fq = lane >> 4;
        const int row0 = u.pm * 256 + wr * 64 + fr;
        const int pn = u.pn;
        const bool ropeA = pn < 12, ropeR = (pn >= 26 && pn < 34);
        f32x4 cw[2][2];
#pragma unroll
        for (int bj = 0; bj < 2; ++bj)
#pragma unroll
            for (int n = 0; n < 2; ++n) cw[bj][n] = *(const f32x4*)(sw + pn * 256 + bj * 128 + wc * 32 + 8 * fq + 4 * n);
        if (!(ropeA || ropeR)) {
            const int col0 = pn * 256 + wc * 32 + 8 * fq;
#pragma unroll
            for (int ai = 0; ai < 2; ++ai) {
                float rs[4];
#pragma unroll
                for (int m = 0; m < 4; ++m) rs[m] = sx[row0 + ai * 128 + m * 16];
#pragma unroll
                for (int m = 0; m < 4; ++m) { bf16_t* rowp = O + (size_t)(row0 + ai * 128 + m * 16) * DIN + col0;
#pragma unroll
                    for (int bj = 0; bj < 2; ++bj) { const f32x4 v0 = acc[ai][bj][m][0] * cw[bj][0] * rs[m], v1 = acc[ai][bj][m][1] * cw[bj][1] * rs[m];
                        u32x4 w; w.x = pk2(v0[0], v0[1]); w.y = pk2(v0[2], v0[3]); w.z = pk2(v1[0], v1[1]); w.w = pk2(v1[2], v1[3]);
                        *(u32x4*)(rowp + bj * 128) = w; } }
            }
        } else {
            const int half = ropeA ? 64 : 128;
            const float* ct = ropeA ? cosA : cosR; const float* st = ropeA ? sinA : sinR;
            const float sc = (pn >= 30 && pn < 34) ? 0.0625f : 1.0f;
            const int qa = 4 * wc + fq;
#pragma unroll
            for (int ai = 0; ai < 2; ++ai)
#pragma unroll
                for (int mh = 0; mh < 2; ++mh) {
                    float rs[2]; f32x4 cc[2][2], ss[2][2];
#pragma unroll
                    for (int mm = 0; mm < 2; ++mm) { const int row = row0 + ai * 128 + (2 * mh + mm) * 16, pos = row & (SEQ - 1);
                        rs[mm] = sx[row] * sc;
                        cc[mm][0] = *(const f32x4*)(ct + (size_t)pos * half + 4 * qa); ss[mm][0] = *(const f32x4*)(st + (size_t)pos * half + 4 * qa);
                        if (ropeR) { cc[mm][1] = *(const f32x4*)(ct + (size_t)pos * half + 64 + 4 * qa); ss[mm][1] = *(const f32x4*)(st + (size_t)pos * half + 64 + 4 * qa); } }
#pragma unroll
                    for (int mm = 0; mm < 2; ++mm) {
                        const int m = 2 * mh + mm;
                        bf16_t* rowp = O + (size_t)(row0 + ai * 128 + m * 16) * DIN + pn * 256;
#pragma unroll
                        for (int bj = 0; bj < 2; ++bj) {
                            const int q = ropeA ? qa : (16 * bj + qa);
                            const int cbase = ropeA ? bj * 128 : 0;
                            const f32x4 cv = (ropeA || bj == 0) ? cc[mm][0] : cc[mm][1], sv = (ropeA || bj == 0) ? ss[mm][0] : ss[mm][1];
                            const f32x4 t1 = acc[ai][bj][m][0] * cw[bj][0] * rs[mm], t2 = acc[ai][bj][m][1] * cw[bj][1] * rs[mm];
                            const f32x4 o1 = t1 * cv - t2 * sv, o2 = t1 * sv + t2 * cv;
                            u32x2 w1, w2; w1.x = pk2(o1[0], o1[1]); w1.y = pk2(o1[2], o1[3]); w2.x = pk2(o2[0], o2[1]); w2.y = pk2(o2[2], o2[3]);
                            *(u32x2*)(rowp + cbase + 4 * q) = w1; *(u32x2*)(rowp + cbase + half + 4 * q) = w2;
                        }
                    }
                }
        }
    }
};

struct EpiOut {
    static constexpr bool PERM = false, AFTER_DRAIN = false;
    const float* xf; float* z;
    __device__ __forceinline__ void operator()(const f32x4 (&acc)[2][2][4][2], const pg8::Unit& u, int wr, int wc, int fr, int fq) const {
        const int row0 = u.pm * 256 + wr * 64 + fr, col0 = u.pn * 256 + wc * 32 + 4 * fq;
#pragma unroll
        for (int ai = 0; ai < 2; ++ai)
#pragma unroll
            for (int mh = 0; mh < 2; ++mh) {
                f32x4 xv[2][2][2];
#pragma unroll
                for (int mm = 0; mm < 2; ++mm) { const size_t row = (size_t)(row0 + ai * 128 + (2 * mh + mm) * 16);
#pragma unroll
                    for (int bj = 0; bj < 2; ++bj)
#pragma unroll
                        for (int n = 0; n < 2; ++n) xv[mm][bj][n] = *(const f32x4*)(xf + row * 1024 + col0 + bj * 128 + n * 16); }
#pragma unroll
                for (int mm = 0; mm < 2; ++mm) { const size_t row = (size_t)(row0 + ai * 128 + (2 * mh + mm) * 16);
#pragma unroll
                    for (int bj = 0; bj < 2; ++bj)
#pragma unroll
                        for (int n = 0; n < 2; ++n) *(f32x4*)(z + row * 1024 + col0 + bj * 128 + n * 16) = xv[mm][bj][n] * ALPHA + acc[ai][bj][2 * mh + mm][n]; }
            }
    }
};

DI void ln_row(const float* z, const float* gam, const float* bet, float* of, bf16_t* ob, int lane) {
    f32x4 v[4]; float s = 0.f;
#pragma unroll
    for (int i = 0; i < 4; ++i) { v[i] = *(const f32x4*)(z + 256 * i + 4 * lane); s += (v[i][0] + v[i][1]) + (v[i][2] + v[i][3]); }
    const float mean = wsum(s) * (1.0f / 1024.0f);
    float q = 0.f;
#pragma unroll
    for (int i = 0; i < 4; ++i)
#pragma unroll
        for (int j = 0; j < 4; ++j) { const float d = v[i][j] - mean; q += d * d; }
    const float rstd = rsqrtf(wsum(q) * (1.0f / 1024.0f) + LN_EPS);
#pragma unroll
    for (int i = 0; i < 4; ++i) {
        const f32x4 gg = *(const f32x4*)(gam + 256 * i + 4 * lane), bb = *(const f32x4*)(bet + 256 * i + 4 * lane);
        f32x4 o;
#pragma unroll
        for (int j = 0; j < 4; ++j) o[j] = (v[i][j] - mean) * rstd * gg[j] + bb[j];
        *(f32x4*)(of + 256 * i + 4 * lane) = o;
        u32x2 pb; pb.x = pk2(o[0], o[1]); pb.y = pk2(o[2], o[3]); *(u32x2*)(ob + 256 * i + 4 * lane) = pb;
    }
}
DI void phase_ln1(const Args& a, int layer) {
    unsigned char* ws = a.ws;
    const int lane = mk_tid() & 63, w = mk_tid() >> 6;
    for (int u = blockIdx.x; u < NTOK / 8; u += gridDim.x) {
        const size_t row = (size_t)u * 8 + w;
        ln_row((const float*)(ws + WS_MRGF) + row * 1024, a.in[11] + layer * 1024, a.in[12] + layer * 1024, (float*)(ws + WS_XF) + row * 1024, (bf16_t*)(ws + WS_XB) + row * 1024, lane);
    }
}

DI void ins16(float (&L)[16], float x) {
#pragma unroll
    for (int k = 0; k < 16; ++k) { const float hi = fmaxf(L[k], x); x = fminf(L[k], x); L[k] = hi; }
}
DI void merge16(float (&L)[16], int xr) {
    float t[16];
#pragma unroll
    for (int k = 0; k < 16; ++k) t[k] = __shfl_xor(L[k], xr);
#pragma unroll
    for (int k = 0; k < 8; ++k) { const float x = t[k]; t[k] = t[15 - k]; t[15 - k] = x; }
#pragma unroll
    for (int k = 0; k < 16; ++k) t[k] = fmaxf(L[k], t[k]);
#define MK_CE_STAGE(dd) _Pragma("unroll") for (int k = 0; k < 16; ++k) if ((k & (dd)) == 0) { const float hi = fmaxf(t[k], t[k + (dd)]), lo = fminf(t[k], t[k + (dd)]); t[k] = hi; t[k + (dd)] = lo; }
    MK_CE_STAGE(8) MK_CE_STAGE(4) MK_CE_STAGE(2) MK_CE_STAGE(1)
#undef MK_CE_STAGE
#pragma unroll
    for (int k = 0; k < 16; ++k) L[k] = t[k];
}
DI float sel16(const float (&L)[16], unsigned idx) {
    float r = L[0];
#pragma unroll
    for (int k = 1; k < 16; ++k) r = (idx == (unsigned)k) ? L[k] : r;
    return r;
}
DI void top16_half(const bf16_t* qp, const bf16_t* kb, float (&L)[16], int g, int l15) {
    bf16x8 qf[4];
#pragma unroll
    for (int ks = 0; ks < 4; ++ks) qf[ks] = *(const bf16x8*)(qp + 32 * ks + 8 * g);
#pragma unroll
    for (int k = 0; k < 16; ++k) L[k] = -FLT_MAX;
#pragma unroll
    for (int kbk = 0; kbk < 8; ++kbk) {
        f32x4 acc = {0.f, 0.f, 0.f, 0.f};
#pragma unroll
        for (int ks = 0; ks < 4; ++ks) { const bf16x8 kf = *(const bf16x8*)(kb + (size_t)(16 * kbk + l15) * 128 + 32 * ks + 8 * g); acc = mfma16(kf, qf[ks], acc); }
#pragma unroll
        for (int rg = 0; rg < 4; ++rg) { const unsigned key = (unsigned)(16 * kbk + 4 * g + rg); ins16(L, __uint_as_float((__float_as_uint(acc[rg]) & ~0x7Fu) | key)); }
    }
    merge16(L, 16); merge16(L, 32);
}
DI void topk_unit(const Args& a, int unit, LAS unsigned char* lds) {
    unsigned char* ws = a.ws;
    const int tid = mk_tid(), lane = tid & 63, w = __builtin_amdgcn_readfirstlane(tid >> 6), g = lane >> 4, l15 = lane & 15;
    const int tg = w & 3, hs = w >> 2;
    const size_t t = (size_t)unit * 64 + tg * 16 + l15;
    const bf16_t* Q = (const bf16_t*)(ws + WS_Q);
    float K1[16], K2[16];
#pragma unroll
    for (int k = 0; k < 16; ++k) { K1[k] = 0.f; K2[k] = 0.f; }
#pragma unroll 1
    for (int hh = 0; hh < 4; ++hh) {
        const int h = hs * 4 + hh;
        float l1[16], l2[16];
        top16_half(Q + t * 2048 + h * 256, (const bf16_t*)(ws + WS_K1B) + (size_t)h * 16384, l1, g, l15);
        top16_half(Q + t * 2048 + h * 256 + 128, (const bf16_t*)(ws + WS_K2B) + (size_t)h * 16384, l2, g, l15);
        const bool mine = (g == hh);
#pragma unroll
        for (int k = 0; k < 16; ++k) { K1[k] = mine ? l1[k] : K1[k]; K2[k] = mine ? l2[k] : K2[k]; }
    }
    const int h = hs * 4 + g;
    float F[16];
#pragma unroll
    for (int k = 0; k < 16; ++k) F[k] = -FLT_MAX;
#pragma unroll
    for (int ia = 0; ia < 16; ++ia)
#pragma unroll
        for (int ib = 0; ib < 16 / (ia + 1); ++ib) {
            const float s = __uint_as_float(__float_as_uint(K1[ia]) & ~0x7Fu) + __uint_as_float(__float_as_uint(K2[ib]) & ~0x7Fu);
            ins16(F, __uint_as_float((__float_as_uint(s) & ~0xFFu) | (unsigned)(ia * 16 + ib)));
        }
    LAS int* row = (LAS int*)lds + tid * 33;
#pragma unroll
    for (int k = 0; k < 16; ++k) { row[k] = (int)(__float_as_uint(K1[k]) & 0x7Fu); row[16 + k] = (int)(__float_as_uint(K2[k]) & 0x7Fu); }
    float gt[16]; int ei[16]; float gs = 0.f;
    const float cv0 = __uint_as_float(__float_as_uint(F[0]) & ~0xFFu);
#pragma unroll
    for (int k = 0; k < 16; ++k) {
        const unsigned bits = __float_as_uint(F[k]);
        const float cv = __uint_as_float(bits & ~0xFFu);
        gt[k] = __builtin_amdgcn_exp2f((cv - cv0) * 1.4426950408889634f); gs += gt[k];
        const int ia = (int)((bits >> 4) & 15u), ib = (int)(bits & 15u);
        ei[k] = row[ia] * 128 + row[16 + ib];
    }
    const float ig = 1.0f / gs;
    int* ep = (int*)(ws + WS_EID) + (t * 8 + h) * 16; float* gp = (float*)(ws + WS_GATE) + (t * 8 + h) * 16;
#pragma unroll
    for (int q = 0; q < 4; ++q) {
        *(i32x4*)(ep + 4 * q) = (i32x4){ei[4 * q], ei[4 * q + 1], ei[4 * q + 2], ei[4 * q + 3]};
        *(f32x4*)(gp + 4 * q) = (f32x4){gt[4 * q] * ig, gt[4 * q + 1] * ig, gt[4 * q + 2] * ig, gt[4 * q + 3] * ig};
    }
}

typedef float f32x2 __attribute__((ext_vector_type(2)));
#define MK_PEER_LOAD1(j, ereg, kk) { const int e_ = __builtin_amdgcn_readlane(ereg, (kk)); \
        const u32x4* p_ = (const u32x4*)(UV + (size_t)(unsigned)e_ * 2048u); UW[j] = p_[lane]; VW[j] = p_[64 + lane]; }
#define MK_PEER_COMP1(j, usreg, gvreg, kk) { \
        const float us_ = __uint_as_float(__builtin_amdgcn_readlane(__float_as_uint(usreg), (kk))), gv_ = __uint_as_float(__builtin_amdgcn_readlane(__float_as_uint(gvreg), (kk))); \
        f32x2 p2_ = {0.f, 0.f}; \
        _Pragma("unroll") for (int q = 0; q < 4; ++q) { const f32x2 lo_ = __builtin_amdgcn_cvt_pk_f32_fp8((int)UW[j][q], false), hi_ = __builtin_amdgcn_cvt_pk_f32_fp8((int)UW[j][q], true); \
            p2_ += lo_ * x2[2 * q]; p2_ += hi_ * x2[2 * q + 1]; } \
        const float p_ = wsum_dpp(p2_.x + p2_.y) * us_; \
        const float act_ = gelu_as(p_) * gv_; const f32x2 a2_ = {act_, act_}; \
        _Pragma("unroll") for (int q = 0; q < 4; ++q) { const f32x2 lo_ = __builtin_amdgcn_cvt_pk_f32_fp8((int)VW[j][q], false), hi_ = __builtin_amdgcn_cvt_pk_f32_fp8((int)VW[j][q], true); \
            y2[2 * q] += a2_ * lo_; y2[2 * q + 1] += a2_ * hi_; } \
        __builtin_amdgcn_sched_barrier(0); }
DI void peer_token(const unsigned char* UV, int e0, int e1, float us0, float us1, float gv0, float gv1, const f32x2 (&x2)[8], f32x2 (&y2)[8], int lane) {
    u32x4 UW[8], VW[8];
#pragma unroll
    for (int j = 0; j < 8; ++j) MK_PEER_LOAD1(j, e0, j)
#pragma unroll 1
    for (int k = 0; k < 56; k += 8) {
#pragma unroll
        for (int j = 0; j < 8; ++j) { MK_PEER_COMP1(j, us0, gv0, k + j) MK_PEER_LOAD1(j, e0, k + 8 + j) }
    }
#pragma unroll
    for (int j = 0; j < 8; ++j) { MK_PEER_COMP1(j, us0, gv0, 56 + j) MK_PEER_LOAD1(j, e1, j) }
#pragma unroll 1
    for (int k = 0; k < 56; k += 8) {
#pragma unroll
        for (int j = 0; j < 8; ++j) { MK_PEER_COMP1(j, us1, gv1, k + j) MK_PEER_LOAD1(j, e1, k + 8 + j) }
    }
#pragma unroll
    for (int j = 0; j < 8; ++j) { MK_PEER_COMP1(j, us1, gv1, 56 + j) }
}
DI void peer_unit(const Args& a, int layer, int unit, bool dry) {
    unsigned char* ws = a.ws;
    const int tid = mk_tid(), lane = tid & 63, w = __builtin_amdgcn_readfirstlane(tid >> 6);
    const unsigned char* UV = ws + WS_UV8; const float* SC = (const float*)(ws + WS_UVS);
#pragma unroll 1
    for (int i = 0; i < 8; ++i) {
        const size_t t = (size_t)unit * 64 + w * 8 + i;
        f32x2 x2[8], y2[8];
        int e0, e1; float us0, us1, gv0, gv1;
        {
            const int ln = mk_tid() & 63;
            const bf16_t* xbp = (const bf16_t*)(ws + WS_XB) + t * 1024 + 16 * ln;
            const u32x4 xa = *(const u32x4*)xbp, xb = *(const u32x4*)(xbp + 8);
#pragma unroll
            for (int q = 0; q < 4; ++q) { x2[q] = (f32x2){bflo(xa[q]), bfhi(xa[q])}; x2[4 + q] = (f32x2){bflo(xb[q]), bfhi(xb[q])}; }
            const int* ep = (const int*)(ws + WS_EID) + t * 128; const float* gp = (const float*)(ws + WS_GATE) + t * 128;
            e0 = ep[ln]; e1 = ep[64 + ln]; const float g0 = gp[ln], g1 = gp[64 + ln];
            const f32x2 s0 = *(const f32x2*)(SC + 2 * e0), s1 = *(const f32x2*)(SC + 2 * e1);
            us0 = s0.x; us1 = s1.x; gv0 = g0 * s0.y; gv1 = g1 * s1.y;
        }
#pragma unroll
        for (int q = 0; q < 8; ++q) y2[q] = (f32x2){0.f, 0.f};
        peer_token(UV, e0, e1, us0, us1, gv0, gv1, x2, y2, lane);
        {
            const int ln = mk_tid() & 63;
            float* xfp = (float*)(ws + WS_XF) + t * 1024 + 16 * ln;
            float* xfo = dry ? (float*)(ws + WS_MRGF) + t * 1024 + 16 * ln : xfp;
            const float* gam = a.in[18] + layer * 1024 + 16 * ln; const float* bet = a.in[19] + layer * 1024 + 16 * ln;
            float z[16]; float s = 0.f;
#pragma unroll
            for (int q = 0; q < 4; ++q) { const f32x4 xr = *(const f32x4*)(xfp + 4 * q);
#pragma unroll
                for (int j = 0; j < 4; ++j) { z[4 * q + j] = ALPHA * xr[j] + y2[2 * q + (j >> 1)][j & 1]; s += z[4 * q + j]; } }
            const float mean = wsum(s) * (1.0f / 1024.0f);
            float qq = 0.f;
#pragma unroll
            for (int q = 0; q < 16; ++q) { const float d = z[q] - mean; qq += d * d; }
            const float rstd = rsqrtf(wsum(qq) * (1.0f / 1024.0f) + LN_EPS);
            f32x4 o[4];
#pragma unroll
            for (int q = 0; q < 4; ++q) { const f32x4 gq = *(const f32x4*)(gam + 4 * q), bq = *(const f32x4*)(bet + 4 * q);
#pragma unroll
                for (int j = 0; j < 4; ++j) o[q][j] = (z[4 * q + j] - mean) * rstd * gq[j] + bq[j]; }
#pragma unroll
            for (int q = 0; q < 4; ++q) *(f32x4*)(xfo + 4 * q) = o[q];
            if (layer == DEPTH - 1 && !dry) { float* op = a.out + t * 1024 + 16 * ln;
#pragma unroll
                for (int q = 0; q < 4; ++q) *(f32x4*)(op + 4 * q) = o[q]; }
            if (!dry) row_to_fp8(o, ws + WS_X8 + t * 1024, (float*)(ws + WS_XS) + t, ln);
        }
    }
}
}

namespace mk {
constexpr int LDS_ARG_OFF = LDS_BYTES - 16 - 256;
#define MK_NOINL __device__ __forceinline__
DI unsigned long long rfl64(unsigned long long v) { const unsigned lo = __builtin_amdgcn_readfirstlane((unsigned)v), hi = __builtin_amdgcn_readfirstlane((unsigned)(v >> 32)); return ((unsigned long long)hi << 32) | lo; }
DI Args load_args(LAS unsigned char* lds) {
    int aoff = LDS_ARG_OFF; asm volatile("" : "+s"(aoff));
    Args a; const LAS unsigned long long* p = (const LAS unsigned long long*)(lds + aoff);
#pragma unroll
    for (int i = 0; i < 20; ++i) a.in[i] = (const float*)(const __attribute__((address_space(1))) float*)rfl64(p[i]);
    a.out = (float*)(__attribute__((address_space(1))) float*)rfl64(p[20]); a.ws = (unsigned char*)(__attribute__((address_space(1))) unsigned char*)rfl64(p[21]);
    a.ropeA = __longlong_as_double((long long)rfl64(p[22])); a.ropeR = __longlong_as_double((long long)rfl64(p[23])); a.ph_lo = 0; a.ph_hi = 0;
    return a;
}
#define MK_LOADARGS const Args a = load_args(lds); unsigned char* ws = a.ws; const int G = (int)gridDim.x, bid = (int)blockIdx.x; (void)ws; (void)G; (void)bid
MK_NOINL void PG_prologue(LAS unsigned char* lds) { MK_LOADARGS; phase_prologue(a); }
MK_NOINL void P0_conv(LAS unsigned char* lds, int layer) { MK_LOADARGS; phase_conv(a, layer, lds); }
MK_NOINL void P1_inproj(LAS unsigned char* lds, int layer) { MK_LOADARGS; (void)layer;
    pg8::Gemm gm; gm.A = (const bf16_t*)(ws + WS_X8); gm.Bt = (const bf16_t*)(ws + WS_WINT); gm.M = NTOK; gm.N = DIN; gm.K = 512;
    pg8::StaticOrder S; S.init(NTOK, DIN, G, bid);
    EpiInProj E; E.O = (bf16_t*)(ws + WS_PROJ); E.cosA = (const float*)(ws + WS_COSA); E.sinA = (const float*)(ws + WS_SINA); E.cosR = (const float*)(ws + WS_COSR); E.sinR = (const float*)(ws + WS_SINR);
    E.sx = (const float*)(ws + WS_XS); E.sw = (const float*)(ws + WS_WSC);
    pg8::gemm_phase<EpiInProj, pg8::StaticOrder, false, true>(lds, gm, S, E, nullptr); }
MK_NOINL void P2_rope(LAS unsigned char* lds, int layer) { MK_LOADARGS; (void)layer; phase_rope(a); }
MK_NOINL void P3a_attn(LAS unsigned char* lds, int layer) { MK_LOADARGS; (void)layer; for (int u = bid; u < 1536; u += G) attn_unit(a, u, lds); }
MK_NOINL void P3b_retkv(LAS unsigned char* lds, int layer) { MK_LOADARGS; (void)layer; for (int u = bid; u < 512; u += G) retkv_unit(a, u, lds); }
MK_NOINL void P3c_lru(LAS unsigned char* lds, int layer, int fin) { MK_LOADARGS; for (int u = bid; u < 2048; u += G) lru_unit(a, layer, u, fin != 0, lds); }
MK_NOINL void P4a_scan(LAS unsigned char* lds, int layer) { MK_LOADARGS; (void)layer; for (int u = bid; u < 256; u += G) retscan_unit(a, u); }
MK_NOINL void P4c_merge(LAS unsigned char* lds, int layer) { MK_LOADARGS; (void)layer; for (int u = bid; u < 2048; u += G) attmerge_unit(a, u); }
MK_NOINL void P5_retout(LAS unsigned char* lds, int layer) { MK_LOADARGS; (void)layer; for (int u = bid; u < 512; u += G) retout_unit(a, u, lds); }
MK_NOINL void P6_branch(LAS unsigned char* lds, int layer) { MK_LOADARGS; (void)layer;
#pragma unroll 1
    for (int s = 0; s < 3; ++s) {
        pg8::Gemm gm; gm.A = (const bf16_t*)(ws + (s == 0 ? WS_YA : (s == 1 ? WS_YB : WS_YC))); gm.Bt = (const bf16_t*)(ws + (s == 0 ? WS_WBAT : (s == 1 ? WS_WBBT : WS_WBCT)));
        gm.M = NTOK; gm.N = 1024; gm.K = (s == 0) ? 512 : 1024;
        pg8::StaticOrder S; S.init(NTOK, 1024, G, bid);
        EpiBranch E; E.gate = (const bf16_t*)(ws + WS_PROJ) + OFF_GA + 1024 * s; E.mf = (float*)(ws + WS_MRGF); E.mb = (bf16_t*)(ws + WS_MRGB); E.mode = s;
        pg8::gemm_phase<EpiBranch, pg8::StaticOrder, false>(lds, gm, S, E, nullptr);
    } }
MK_NOINL void P7_outproj(LAS unsigned char* lds, int layer) { MK_LOADARGS; (void)layer;
    pg8::Gemm gm; gm.A = (const bf16_t*)(ws + WS_MRGB); gm.Bt = (const bf16_t*)(ws + WS_WOT); gm.M = NTOK; gm.N = 1024; gm.K = 1024;
    pg8::StaticOrder S; S.init(NTOK, 1024, G, bid);
    EpiOut E; E.xf = (const float*)(ws + WS_XF); E.z = (float*)(ws + WS_MRGF);
    pg8::gemm_phase<EpiOut, pg8::StaticOrder, false>(lds, gm, S, E, nullptr); }
MK_NOINL void P8_ln1(LAS unsigned char* lds, int layer) { MK_LOADARGS; phase_ln1(a, layer); }
MK_NOINL void P9_wq(LAS unsigned char* lds, int layer) { MK_LOADARGS; (void)layer;
    pg8::Gemm gm; gm.A = (const bf16_t*)(ws + WS_XB); gm.Bt = (const bf16_t*)(ws + WS_WQT); gm.M = NTOK; gm.N = 2048; gm.K = 1024;
    pg8::StaticOrder S; S.init(NTOK, 2048, G, bid);
    pg8::EpiBf16<0> E; E.O = (bf16_t*)(ws + WS_Q); E.ldc = 2048; E.bias = nullptr; E.split_cols = 0; E.split_stride = 0;
    pg8::gemm_phase<pg8::EpiBf16<0>, pg8::StaticOrder, false>(lds, gm, S, E, nullptr); }
MK_NOINL void P10_topk(LAS unsigned char* lds, int layer) { MK_LOADARGS; (void)layer; for (int u = bid; u < NTOK / 64; u += G) topk_unit(a, u, lds); }
MK_NOINL void P11_peer(LAS unsigned char* lds, int layer, int dry) { MK_LOADARGS; for (int u = bid; u < NTOK / 64; u += G) peer_unit(a, layer, u, dry != 0); }
DI void mk_sync(LAS unsigned char* lds) {
    const Args a = load_args(lds);
    XcdBarrier b; b.bar = (unsigned*)(a.ws + WS_CTL); b.x = xb_xcc_id(); b.st = (volatile LAS unsigned*)(lds + LDS_BAR_OFF);
    xcd_barrier(b);
}
}

#ifndef MK_PHASE_MASK
#define MK_PHASE_MASK 0xFFFu
#endif
#define MK_RUN(k) ((((MK_PHASE_MASK) >> ((k) - pb)) & 1u) && (k) >= ph_lo && (k) < ph_hi)
#define MK_NPHASES (1 + mk::DEPTH * mk::NPH)
#ifndef MK_REP_MASK
#define MK_REP_MASK 0u
#endif
#define MK_REPS(bit) for (int rep_ = 0; rep_ < ((((MK_REP_MASK) >> (bit)) & 1u) ? 2 : 1); ++rep_)
#define MK_SYNC(k) do { if ((k) >= ph_lo && (k) + 1 < ph_hi) { mk::mk_sync(lds); if ((MK_REP_MASK >> 15) & 1u) mk::mk_sync(lds); } } while (0)
__global__ __launch_bounds__(512, 2) void mk_fwd(mk::Args a) {
    using namespace mk;
    extern __shared__ __attribute__((aligned(16))) unsigned char smem_raw[];
    LAS unsigned char* lds = (LAS unsigned char*)smem_raw;
    const int ph_lo = a.ph_lo, ph_hi = a.ph_hi;
    {
        const unsigned* src = (const unsigned*)&a;
        if (threadIdx.x < sizeof(Args) / 4) ((LAS unsigned*)(lds + LDS_ARG_OFF))[threadIdx.x] = src[threadIdx.x];
        if (threadIdx.x == 0) { LAS unsigned* st = (LAS unsigned*)(lds + LDS_BAR_OFF); st[0] = 0u; st[1] = 0u; st[2] = 0u; st[3] = 0u; }
    }
    __syncthreads();
    if (ph_hi - ph_lo > 1) (void)xcd_barrier_post((unsigned*)(a.ws + WS_CTL), (volatile LAS unsigned*)(lds + LDS_BAR_OFF));
    if (0 >= ph_lo && 0 < ph_hi) PG_prologue(lds);
    MK_SYNC(0);
#pragma unroll 1
    for (int layer = 0; layer < DEPTH; ++layer) {
        const int pb = 1 + layer * NPH;
        if (MK_RUN(pb + 0)) MK_REPS(0) P0_conv(lds, layer);
        MK_SYNC(pb + 0);
        if (MK_RUN(pb + 1)) MK_REPS(1) P1_inproj(lds, layer);
        MK_SYNC(pb + 1);
        if (MK_RUN(pb + 3)) { MK_REPS(3) P3a_attn(lds, layer); MK_REPS(12) P3b_retkv(lds, layer); MK_REPS(13) P3c_lru(lds, layer, 0); }
        MK_SYNC(pb + 3);
        if (MK_RUN(pb + 4)) { P4a_scan(lds, layer); MK_REPS(4) { P4c_merge(lds, layer); P3c_lru(lds, layer, 1); } }
        MK_SYNC(pb + 4);
        if (MK_RUN(pb + 5)) MK_REPS(5) P5_retout(lds, layer);
        MK_SYNC(pb + 5);
        if (MK_RUN(pb + 6)) MK_REPS(6) P6_branch(lds, layer);
        MK_SYNC(pb + 6);
        if (MK_RUN(pb + 7)) MK_REPS(7) P7_outproj(lds, layer);
        MK_SYNC(pb + 7);
        if (MK_RUN(pb + 8)) MK_REPS(8) P8_ln1(lds, layer);
        MK_SYNC(pb + 8);
        if (MK_RUN(pb + 9)) MK_REPS(9) P9_wq(lds, layer);
        MK_SYNC(pb + 9);
        if (MK_RUN(pb + 10)) MK_REPS(10) P10_topk(lds, layer);
        MK_SYNC(pb + 10);
        if (MK_RUN(pb + 11)) { if ((MK_REP_MASK >> 11) & 1u) P11_peer(lds, layer, 1); P11_peer(lds, layer, 0); }
        MK_SYNC(pb + 11);
    }
}

#ifndef MK_SINGLE
#define MK_SINGLE 1
#endif
extern "C" void kernel_launch(void* const* d_in, const int* in_sizes, int n_in, void* d_out, int out_size, void* d_ws, size_t ws_size, hipStream_t stream) {
    using namespace mk;
    static int grid = 0;
    if (grid == 0) {
        if (n_in != 20 || out_size != NTOK * D || ws_size < WS_END) { fprintf(stderr, "kernel_launch: unexpected shapes (n_in %d, out %d, ws %zu, need %zu)\n", n_in, out_size, ws_size, (size_t)WS_END); grid = -1; return; }
        int dev = 0, cus = 0, per_cu = 0;
        if (hipGetDevice(&dev) != hipSuccess || hipDeviceGetAttribute(&cus, hipDeviceAttributeMultiprocessorCount, dev) != hipSuccess) { grid = -1; return; }
        if (hipFuncSetAttribute((const void*)mk_fwd, hipFuncAttributeMaxDynamicSharedMemorySize, LDS_BYTES) != hipSuccess) { fprintf(stderr, "kernel_launch: hipFuncSetAttribute failed\n"); grid = -1; return; }
        if (hipOccupancyMaxActiveBlocksPerMultiprocessor(&per_cu, (const void*)mk_fwd, 512, LDS_BYTES) != hipSuccess || per_cu < 1) { fprintf(stderr, "kernel_launch: occupancy query says %d blocks per CU\n", per_cu); (void)hipGetLastError(); grid = -1; return; }
        grid = cus;
    }
    if (grid < 0) return;
    (void)in_sizes;
    Args a{};
    for (int i = 0; i < 20; ++i) a.in[i] = (const float*)d_in[i];
    a.out = (float*)d_out; a.ws = (unsigned char*)d_ws;
    a.ropeA = pow(10000.0, -2.0 / 128.0); a.ropeR = pow(10000.0, -2.0 / 256.0);
#if MK_SINGLE
    (void)hipMemsetAsync((unsigned char*)d_ws + WS_CTL, 0, 16384, stream);
    a.ph_lo = 0; a.ph_hi = MK_NPHASES;
    hipLaunchKernelGGL(mk_fwd, dim3(grid), dim3(512), LDS_BYTES, stream, a);
#else
    for (int p = 0; p < MK_NPHASES; ++p) { a.ph_lo = p; a.ph_hi = p + 1; hipLaunchKernelGGL(mk_fwd, dim3(grid), dim3(512), LDS_BYTES, stream, a); }
#endif
}
```

```cpp
#include <hip/hip_runtime.h>
#include <cstdio>
#include <cstdint>
#include <cmath>
#include <cfloat>
__device__ __forceinline__ int mk_tid() { int t = (int)threadIdx.x; asm volatile("" : "+v"(t)); return t; }
namespace pg8 {
#define PG8_LAS __attribute__((address_space(3)))
typedef unsigned short bf16_t;
typedef short bf16x8 __attribute__((ext_vector_type(8)));
typedef float f32x4 __attribute__((ext_vector_type(4)));
typedef unsigned u32x4 __attribute__((ext_vector_type(4)));
constexpr int BM = 256, BK = 64, HALF = 128, HTB = HALF * BK * 2  , STAGE_BYTES = 8 * HTB, NXCD = 8, WGM = 8;

__host__ __device__ __forceinline__ int lds_byte(int r, int c) { const int st = (r >> 4) * 2 + (c >> 5), rr = r & 15, cc = c & 31, ob = rr * 64 + cc * 2; return st * 1024 + (ob ^ (((ob >> 9) & 1) << 5)); }
__host__ __device__ __forceinline__ void stage_rc(int b, int& R, int& C) { const int st = b / 1024, sb = b % 1024, swz = sb ^ (((sb >> 9) & 1) << 5); R = (st >> 1) * 16 + swz / 64; C = (st & 1) * 32 + (swz % 64) / 2; }
__host__ __device__ __forceinline__ int perm32(int rho) { const int n = rho >> 4, i = rho & 15; return 8 * (i >> 2) + 4 * n + (i & 3); }

struct Unit { int pm, pn; };
struct Gemm { const bf16_t* A; const bf16_t* Bt; int M, N, K; };

struct StaticOrder {
    int nM, nN, nwg, G, c;
    __host__ __device__ void init(int M, int N, int G_, int c_) { nM = M / BM; nN = N / BM; nwg = nM * nN; G = G_; c = c_; }
    __host__ __device__ bool next(int i, Unit& u) const {
        const long L = (long)i * G + c; if (L >= nwg) return false;
        int wgid = (int)L; { const int q = nwg / NXCD, r = nwg % NXCD, xcd = wgid % NXCD, off = wgid / NXCD; wgid = (xcd < r ? xcd * (q + 1) : r * (q + 1) + (xcd - r) * q) + off; }
        const int nig = WGM * nN, gid = wgid / nig, fm = gid * WGM, gsz = (nM - fm) < WGM ? (nM - fm) : WGM;
        u.pm = fm + ((wgid % nig) % gsz); u.pn = (wgid % nig) / gsz; return true;
    }
    __device__ __forceinline__ void a_ready(const Unit&) const {}
    __device__ __forceinline__ void done(const Unit&) const {}
};
__device__ __forceinline__ unsigned cvt_pk_bf16(float lo, float hi) { unsigned r; asm volatile("v_cvt_pk_bf16_f32 %0, %1, %2" : "=v"(r) : "v"(lo), "v"(hi)); return r; }
typedef float f32x2 __attribute__((ext_vector_type(2)));
__device__ __forceinline__ f32x2 gelu_pk(f32x2 v) {
    const f32x2 av = __builtin_elementwise_abs(v), d = av * 0.2316418882f + 1.0f;
    f32x2 t; t.x = __builtin_amdgcn_rcpf(d.x); t.y = __builtin_amdgcn_rcpf(d.y);
    f32x2 q = t * 0.5307027145f + (-0.7265760135f); q = q * t + 0.7107068705f; q = q * t + (-0.142248368f); q = q * t + 0.127414796f; q = q * t;
    const f32x2 s = (v * v) * (-0.72134752044f);
    f32x2 e; e.x = __builtin_amdgcn_exp2f(s.x); e.y = __builtin_amdgcn_exp2f(s.y);
    const f32x2 m = v * (q * e), r = v - m;
    f32x2 o; o.x = v.x < 0.f ? m.x : r.x; o.y = v.y < 0.f ? m.y : r.y; return o;
}

struct EpiF32 {
    static constexpr bool PERM = false, AFTER_DRAIN = false;
    float* C; int ldc; const float* bias;
    __device__ __forceinline__ void operator()(const f32x4 (&acc)[2][2][4][2], const Unit& u, int wr, int wc, int fr, int fq) const {
        const int row0 = u.pm * BM + wr * 64 + fr, col0 = u.pn * BM + wc * 32 + 4 * fq;
        f32x4 bv[2][2];
#pragma unroll
        for (int bj = 0; bj < 2; ++bj)
#pragma unroll
            for (int n = 0; n < 2; ++n) bv[bj][n] = bias ? *(const f32x4*)(bias + col0 + bj * HALF + n * 16) : (f32x4){0.f, 0.f, 0.f, 0.f};
#pragma unroll
        for (int ai = 0; ai < 2; ++ai)
#pragma unroll
            for (int m = 0; m < 4; ++m) { float* rowp = C + (size_t)(row0 + ai * HALF + m * 16) * ldc + col0;
#pragma unroll
                for (int bj = 0; bj < 2; ++bj)
#pragma unroll
                    for (int n = 0; n < 2; ++n) *(f32x4*)(rowp + bj * HALF + n * 16) = acc[ai][bj][m][n] + bv[bj][n]; }
    }
};
template <int ACT  > struct EpiBf16 {
    static constexpr bool PERM = true, AFTER_DRAIN = false;
    bf16_t* O; int ldc; const float* bias; int split_cols; size_t split_stride;
    __device__ __forceinline__ void operator()(const f32x4 (&acc)[2][2][4][2], const Unit& u, int wr, int wc, int fr, int fq) const {
        const int row0 = u.pm * BM + wr * 64 + fr; int colt = u.pn * BM; bf16_t* base = O;
        if (split_cols) { const int t = colt / split_cols; base += (size_t)t * split_stride; colt -= t * split_cols; }
        const int col0 = colt + wc * 32 + 8 * fq, bcol0 = u.pn * BM + wc * 32 + 8 * fq;
        f32x4 bv[2][2];
#pragma unroll
        for (int bj = 0; bj < 2; ++bj)
#pragma unroll
            for (int n = 0; n < 2; ++n) bv[bj][n] = bias ? *(const f32x4*)(bias + bcol0 + bj * HALF + 4 * n) : (f32x4){0.f, 0.f, 0.f, 0.f};
#pragma unroll
        for (int ai = 0; ai < 2; ++ai)
#pragma unroll
            for (int m = 0; m < 4; ++m) { bf16_t* rowp = base + (size_t)(row0 + ai * HALF + m * 16) * ldc + col0;
#pragma unroll
                for (int bj = 0; bj < 2; ++bj) { f32x4 v0 = acc[ai][bj][m][0] + bv[bj][0], v1 = acc[ai][bj][m][1] + bv[bj][1];
                    if (ACT == 1) { f32x2 a = gelu_pk((f32x2){v0[0], v0[1]}), b = gelu_pk((f32x2){v0[2], v0[3]}), c = gelu_pk((f32x2){v1[0], v1[1]}), d = gelu_pk((f32x2){v1[2], v1[3]});
                        v0 = (f32x4){a.x, a.y, b.x, b.y}; v1 = (f32x4){c.x, c.y, d.x, d.y}; }
                    if (ACT == 2) {
#pragma unroll
                        for (int j = 0; j < 4; ++j) { v0[j] = 0.5f * v0[j] * (1.0f + erff(v0[j] * 0.70710678f)); v1[j] = 0.5f * v1[j] * (1.0f + erff(v1[j] * 0.70710678f)); } }
                    u32x4 w; w.x = cvt_pk_bf16(v0[0], v0[1]); w.y = cvt_pk_bf16(v0[2], v0[3]); w.z = cvt_pk_bf16(v1[0], v1[1]); w.w = cvt_pk_bf16(v1[2], v1[3]);
                    *(u32x4*)(rowp + bj * HALF) = w; } }
    }
};

typedef int i32x8 __attribute__((ext_vector_type(8)));
typedef short s16x16 __attribute__((ext_vector_type(16)));
__device__ __forceinline__ i32x8 pg8_cat16(bf16x8 a, bf16x8 b) { return __builtin_bit_cast(i32x8, (s16x16)__builtin_shufflevector(a, b, 0, 1, 2, 3, 4, 5, 6, 7, 8, 9, 10, 11, 12, 13, 14, 15)); }
template <class Epi, class Sched, bool STAMP = false, bool F8 = false, bool WIDE = false>
__device__ __forceinline__ void gemm_phase(PG8_LAS unsigned char* lds, const Gemm g, const Sched& S, const Epi& E, unsigned long long* stamps) {
    const int tid = mk_tid(), wid = __builtin_amdgcn_readfirstlane(tid >> 6), lane = tid & 63, wr = wid >> 2, wc = wid & 3, fr = lane & 15, fq = lane >> 4;
    const int K = g.K, nt = K / BK;
    int ts_lo = 0, ts_hi = 0, nts = 0; const unsigned long long rt_entry = STAMP ? (unsigned long long)wall_clock64() : 0ull;
#define PG8_STAMP() do { if (STAMP && wid == 0 && nts < 64) { const unsigned long long _c = (unsigned long long)clock64(); \
        ts_lo = (lane == nts) ? (int)(unsigned)_c : ts_lo; ts_hi = (lane == nts) ? (int)(unsigned)(_c >> 32) : ts_hi; ++nts; } } while (0)
    PG8_STAMP();
    unsigned voffA, voffB;
    { int R, C; stage_rc(tid * 16, R, C); const int Ri = Epi::PERM ? perm32(R & 31) : (R & 31); const int Rb = WIDE ? (((R >> 5) << 6) + Ri) : ((R & ~31) + Ri);
        voffA = (unsigned)(R * K + C) * 2u; voffB = (unsigned)(Rb * K + C) * 2u; }
    const size_t qstep = (size_t)64 * K * 2;
    const size_t qstepB = WIDE ? (size_t)128 * K * 2 : qstep;
    const size_t hstepB = WIDE ? (size_t)32 * K * 2 : (size_t)HALF * K * 2;
    const size_t kstep = (size_t)(BK * 2);
    const size_t hstep = (size_t)HALF * K * 2;
    const size_t tstep = 2 * hstep;
    const unsigned ldsw = (unsigned)wid * 1024u;
    const int aoff = lds_byte(wr * 64 + fr, fq * 8), boff = lds_byte(wc * 32 + fr, fq * 8);
#define PG8_SA(b, h) (((b) * 2 + (h)) * HTB)
#define PG8_SB(b, h) ((4 + (b) * 2 + (h)) * HTB)
#define PG8_STAGE(bufoff, gbase, voff) PG8_STAGEQ(bufoff, gbase, voff, qstep)
#define PG8_STAGEB(bufoff, gbase, voff) PG8_STAGEQ(bufoff, gbase, voff, qstepB)
#define PG8_STAGEQ(bufoff, gbase, voff, qs) do { const char* _g0 = (const char*)(gbase); const char* _g1 = _g0 + (qs); asm volatile("" : "+s"(_g0), "+s"(_g1));   \
        __builtin_amdgcn_global_load_lds((const unsigned*)(_g0 + (voff)), (PG8_LAS unsigned*)(lds + (bufoff) + ldsw), 16, 0, 0); \
        __builtin_amdgcn_global_load_lds((const unsigned*)(_g1 + (voff)), (PG8_LAS unsigned*)(lds + (bufoff) + ldsw + 8192), 16, 0, 0); } while (0)
#define PG8_LDA(dst, b, h) do { _Pragma("unroll") for (int m = 0; m < 4; ++m) _Pragma("unroll") for (int k = 0; k < 2; ++k) dst[m][k] = *(const PG8_LAS bf16x8*)(lds + PG8_SA(b, h) + aoff + m * 2048 + k * 1024); } while (0)
#define PG8_LDB(dst, b, h) do { _Pragma("unroll") for (int n = 0; n < 2; ++n) _Pragma("unroll") for (int k = 0; k < 2; ++k) dst[n][k] = *(const PG8_LAS bf16x8*)(lds + PG8_SB(b, h) + boff + n * 2048 + k * 1024); } while (0)
#define PG8_MMA(ai, bj, At, Bt) do { __builtin_amdgcn_s_setprio(1); _Pragma("unroll") for (int m = 0; m < 4; ++m) _Pragma("unroll") for (int n = 0; n < 2; ++n) { \
        if constexpr (F8) acc[ai][bj][m][n] = __builtin_amdgcn_mfma_scale_f32_16x16x128_f8f6f4(pg8_cat16(Bt[n][0], Bt[n][1]), pg8_cat16(At[m][0], At[m][1]), acc[ai][bj][m][n], 0, 0, 0, 0, 0, 0); \
        else { _Pragma("unroll") for (int k = 0; k < 2; ++k) acc[ai][bj][m][n] = __builtin_amdgcn_mfma_f32_16x16x32_bf16(Bt[n][k], At[m][k], acc[ai][bj][m][n], 0, 0, 0); } } \
        __builtin_amdgcn_s_setprio(0); } while (0)
#define PG8_WAIT_V(n) asm volatile("s_waitcnt vmcnt(" #n ")" ::: "memory")
#define PG8_WAIT_L(n) asm volatile("s_waitcnt lgkmcnt(" #n ")" ::: "memory")
#define PG8_BAR __builtin_amdgcn_s_barrier()
#define PG8_SCHED __builtin_amdgcn_sched_barrier(0)
    Unit cur, nxt; int ui = 0;
    if (!S.next(0, cur)) return;
    f32x4 acc[2][2][4][2];
    bf16x8 At[4][2], B0[2][2], B1[2][2];
    const char* cA = (const char*)g.A + (size_t)cur.pm * tstep; const char* cB = (const char*)g.Bt + (size_t)cur.pn * tstep;
    S.a_ready(cur);
    PG8_STAGEB(PG8_SB(0, 0), cB, voffB); PG8_STAGE(PG8_SA(0, 0), cA, voffA); PG8_STAGEB(PG8_SB(0, 1), cB + hstepB, voffB); PG8_STAGE(PG8_SA(0, 1), cA + hstep, voffA);
    if (wr == 1) PG8_BAR;
    PG8_WAIT_V(4); PG8_BAR;
    PG8_STAGEB(PG8_SB(1, 0), cB + kstep, voffB); PG8_STAGE(PG8_SA(1, 0), cA + kstep, voffA); PG8_STAGEB(PG8_SB(1, 1), cB + hstepB + kstep, voffB);
    PG8_WAIT_V(6); PG8_BAR;
    PG8_STAMP();
#pragma unroll
    for (int a = 0; a < 2; ++a)
#pragma unroll
        for (int b = 0; b < 2; ++b)
#pragma unroll
            for (int m = 0; m < 4; ++m)
#pragma unroll
                for (int n = 0; n < 2; ++n) acc[a][b][m][n] = (f32x4){0.f, 0.f, 0.f, 0.f};
    for (;;) {
        const bool has_next = S.next(ui + 1, nxt);
        const char* nA = has_next ? (const char*)g.A + (size_t)nxt.pm * tstep : cA; const char* nB = has_next ? (const char*)g.Bt + (size_t)nxt.pn * tstep : cB;
        for (int t = 0; t < nt; t += 2) {
            const bool last = (t == nt - 2);
            const char* a1 = cA + (size_t)(t + 1) * kstep;
            const char* a2 = last ? nA : cA + (size_t)(t + 2) * kstep; const char* b2 = last ? nB : cB + (size_t)(t + 2) * kstep;
            const char* a3 = a2 + kstep; const char* b3 = b2 + kstep;
            if (last && has_next) S.a_ready(nxt);
            PG8_LDB(B0, 0, 0); PG8_SCHED; PG8_LDA(At, 0, 0); PG8_STAGE(PG8_SA(1, 1), a1 + hstep, voffA);
            PG8_WAIT_L(8); PG8_BAR; PG8_WAIT_L(0); PG8_MMA(0, 0, At, B0); PG8_BAR; PG8_SCHED;
            PG8_LDB(B1, 0, 1); PG8_STAGEB(PG8_SB(0, 0), b2, voffB);
            PG8_BAR; PG8_WAIT_L(0); PG8_MMA(0, 1, At, B1); PG8_BAR;
            PG8_LDA(At, 0, 1); PG8_STAGE(PG8_SA(0, 0), a2, voffA);
            PG8_BAR; PG8_WAIT_L(0); PG8_MMA(1, 0, At, B0); PG8_BAR; PG8_SCHED;
            PG8_STAGEB(PG8_SB(0, 1), b2 + hstepB, voffB);
            PG8_WAIT_V(6); PG8_BAR; PG8_MMA(1, 1, At, B1); PG8_BAR;
            PG8_LDB(B0, 1, 0); PG8_SCHED; PG8_LDA(At, 1, 0); PG8_STAGE(PG8_SA(0, 1), a2 + hstep, voffA);
            PG8_WAIT_L(8); PG8_BAR; PG8_WAIT_L(0); PG8_MMA(0, 0, At, B0); PG8_BAR; PG8_SCHED;
            PG8_LDB(B1, 1, 1); PG8_STAGEB(PG8_SB(1, 0), b3, voffB);
            PG8_BAR; PG8_WAIT_L(0); PG8_MMA(0, 1, At, B1); PG8_BAR;
            PG8_LDA(At, 1, 1); PG8_STAGE(PG8_SA(1, 0), a3, voffA);
            PG8_BAR; PG8_WAIT_L(0); PG8_MMA(1, 0, At, B0); PG8_BAR; PG8_SCHED;
            PG8_STAGEB(PG8_SB(1, 1), b3 + hstepB, voffB);
            PG8_WAIT_V(6); PG8_BAR; PG8_MMA(1, 1, At, B1); PG8_BAR;
        }
        PG8_STAMP();
        if constexpr (!Epi::AFTER_DRAIN) { E(acc, cur, wr, wc, fr, fq); S.done(cur); }
        PG8_STAMP();
        if (!has_next) break;
#pragma unroll
        for (int a = 0; a < 2; ++a)
#pragma unroll
            for (int b = 0; b < 2; ++b)
#pragma unroll
                for (int m = 0; m < 4; ++m)
#pragma unroll
                    for (int n = 0; n < 2; ++n) acc[a][b][m][n] = (f32x4){0.f, 0.f, 0.f, 0.f};
        cur = nxt; cA = nA; cB = nB; ++ui;
    }
    PG8_WAIT_V(0);
    if (wr == 0) PG8_BAR;
    PG8_BAR;
    if constexpr (Epi::AFTER_DRAIN) { E.fused(acc, cur, wr, wc, fr, fq, lds, wid, lane); S.done(cur); }
    PG8_STAMP();
    if (STAMP && wid == 0) { stamps[lane] = lane < nts ? (((unsigned long long)(unsigned)ts_hi << 32) | (unsigned)ts_lo) : 0ull;
        if (lane == 62) stamps[62] = rt_entry; if (lane == 63) stamps[63] = (unsigned long long)wall_clock64(); }
#undef PG8_STAMP
#undef PG8_SA
#undef PG8_SB
#undef PG8_STAGE
#undef PG8_STAGEB
#undef PG8_STAGEQ
#undef PG8_LDA
#undef PG8_LDB
#undef PG8_MMA
#undef PG8_WAIT_V
#undef PG8_WAIT_L
#undef PG8_BAR
#undef PG8_SCHED
}
}
#define XB_TMO      128
#define XB_XCNT(j)  (256  + 64 * (j))
#define XB_XSUB(j)  (1280 + 64 * (j))
#define XB_XGEN(j)  (2304 + 64 * (j))
#define XB_TOP      3328
#define XB_TOPGEN   3392
#define XCD_BAR_WORDS 3456
#define XB_SPIN_CAP (1u << 18)
#define LAS __attribute__((address_space(3)))

__device__ __forceinline__ unsigned xb_ld(unsigned* p)              { return __hip_atomic_load(p, __ATOMIC_RELAXED, __HIP_MEMORY_SCOPE_AGENT); }
__device__ __forceinline__ unsigned xb_add(unsigned* p, unsigned v) { return __hip_atomic_fetch_add(p, v, __ATOMIC_RELAXED, __HIP_MEMORY_SCOPE_AGENT); }
__device__ __forceinline__ unsigned xb_xcc_id() { return (unsigned)__builtin_amdgcn_s_getreg((3 << 11) | 20) & 0xFu; }
#define XB_SPIN(cond, bar) do { unsigned _sp = 0; while (cond) { __builtin_amdgcn_s_sleep(1); \
    if ((++_sp & 255u) == 0u) { if (xb_ld(&(bar)[XB_TMO])) break; if (_sp > XB_SPIN_CAP) { atomicAdd(&(bar)[XB_TMO], 1u); break; } } } } while (0)

struct XcdBarrier {
    unsigned* bar; unsigned x;
    volatile LAS unsigned* st;
};

__device__ __forceinline__ XcdBarrier xcd_barrier_post(unsigned* bar, volatile LAS unsigned* st) {
    XcdBarrier b; b.bar = bar; b.x = xb_xcc_id(); b.st = st;
    if (threadIdx.x == 0) (void)xb_add(&bar[XB_XCNT(b.x)], 1u);
    return b;
}
__device__ __forceinline__ void xcd_barrier_complete(unsigned* bar, unsigned x, unsigned& nloc, unsigned& nx) {
    const unsigned G = gridDim.x * gridDim.y * gridDim.z;
    unsigned sum, cnt, mine, sp = 0u;
    for (;;) {
        sum = 0u; cnt = 0u; mine = 0u;
#pragma unroll
        for (unsigned j = 0; j < 16; ++j) { const unsigned c = xb_ld(&bar[XB_XCNT(j)]); sum += c; cnt += (c > 0u) ? 1u : 0u; mine = (j == x) ? c : mine; }
        if (sum == G) break;
        __builtin_amdgcn_s_sleep(1);
        if ((++sp & 255u) == 0u) { if (xb_ld(&bar[XB_TMO])) break; if (sp > XB_SPIN_CAP) { atomicAdd(&bar[XB_TMO], 1u); break; } }
    }
    nloc = mine > 0u ? mine : 1u; nx = cnt > 0u ? cnt : 1u;
}

__device__ __forceinline__ void xcd_barrier(const XcdBarrier& b) {
    asm volatile("s_waitcnt vmcnt(0)" ::: "memory");
    __syncthreads();
    if (threadIdx.x == 0) {
        unsigned* bar = b.bar;
        __builtin_amdgcn_s_waitcnt(0);
        unsigned nloc = b.st[0], nx = b.st[1];
        if (nloc == 0u) { xcd_barrier_complete(bar, b.x, nloc, nx); b.st[0] = nloc; b.st[1] = nx; }
        const unsigned old = xb_add(&bar[XB_XSUB(b.x)], 1u);
        const unsigned gen = old / nloc;
        if (old + 1u == (gen + 1u) * nloc) {
            __builtin_amdgcn_fence(__ATOMIC_RELEASE, "agent");
            asm volatile("s_waitcnt vmcnt(0)" ::: "memory");
            const unsigned og = xb_add(&bar[XB_TOP], 1u);
            const unsigned tg = og / nx;
            if (og + 1u == (tg + 1u) * nx) xb_add(&bar[XB_TOPGEN], 1u);
            else XB_SPIN(xb_ld(&bar[XB_TOPGEN]) == tg, bar);
            __builtin_amdgcn_fence(__ATOMIC_ACQUIRE, "agent");
            xb_add(&bar[XB_XGEN(b.x)], 1u);
            asm volatile("s_waitcnt vmcnt(0)" ::: "memory");
        } else {
            XB_SPIN(xb_ld(&bar[XB_XGEN(b.x)]) == gen, bar);
            __builtin_amdgcn_fence(__ATOMIC_ACQUIRE, "agent");
            asm volatile("s_waitcnt vmcnt(0)" ::: "memory");
        }
    }
    __syncthreads();
}

namespace mk {
using pg8::bf16_t; using pg8::bf16x8; using pg8::f32x4; using pg8::u32x4;
typedef short s16x4 __attribute__((ext_vector_type(4)));
typedef unsigned u32x2 __attribute__((ext_vector_type(2)));
typedef __bf16 bf16x2v __attribute__((ext_vector_type(2)));
typedef int i32x4 __attribute__((ext_vector_type(4)));
#define DI __device__ __forceinline__

constexpr int D = 1024, SEQ = 4096, NTOK = 16384, DEPTH = 4, DIN = 13824;
constexpr int OFF_AQ = 0, OFF_AK = 1536, OFF_AV = 3072, OFF_LX = 4608, OFF_LG = 5632, OFF_RQ = 6656, OFF_RK = 7680, OFF_RV = 8704, OFF_RG = 9728, OFF_GA = 10752;
constexpr float ALPHA = 1.681792830507429f;
constexpr float LN_EPS = 1e-5f;
constexpr float X8_SCALE = 32.0f, W8_SCALE = 2048.0f, F8_MAX = 440.0f;
constexpr int NPH = 12;
constexpr int LDS_BYTES = 148 * 1024;
constexpr int LDS_BAR_OFF = LDS_BYTES - 16;

constexpr size_t WS_CTL  = 0;
constexpr size_t WS_COSA = 16384;
constexpr size_t WS_SINA = WS_COSA + (size_t)4096 * 64 * 4;
constexpr size_t WS_COSR = WS_SINA + (size_t)4096 * 64 * 4;
constexpr size_t WS_SINR = WS_COSR + (size_t)4096 * 128 * 4;
constexpr size_t WS_CCH  = WS_SINR + (size_t)4096 * 128 * 4;
constexpr size_t WS_WAT  = WS_CCH + 4096;
constexpr size_t WS_WXT  = WS_WAT + 131072;
constexpr size_t WS_LSTA = WS_WXT + 131072;
constexpr size_t WS_LSTH = WS_LSTA + 524288;
constexpr size_t WS_K1B  = WS_LSTH + 524288;
constexpr size_t WS_K2B  = WS_K1B + 262144;
constexpr size_t WS_XF   = WS_K2B + 262144;
constexpr size_t WS_XB   = WS_XF + (size_t)NTOK * D * 4;
constexpr size_t WS_WINT = WS_XB + (size_t)NTOK * D * 2;
constexpr size_t WS_WSC  = WS_WINT + (size_t)DIN * 1024;
constexpr size_t WS_X8   = WS_WSC + (size_t)DIN * 4 + 256 - ((size_t)DIN * 4) % 256;
constexpr size_t WS_XS   = WS_X8 + (size_t)NTOK * 1024;
constexpr size_t WS_WBAT = WS_XS + (size_t)NTOK * 4;
constexpr size_t WS_WBBT = WS_WBAT + (size_t)1024 * 512 * 2;
constexpr size_t WS_WBCT = WS_WBBT + (size_t)1024 * 1024 * 2;
constexpr size_t WS_WOT  = WS_WBCT + (size_t)1024 * 1024 * 2;
constexpr size_t WS_WQT  = WS_WOT + (size_t)1024 * 1024 * 2;
constexpr size_t WS_UV8  = WS_WQT + (size_t)2048 * 1024 * 2;
constexpr size_t WS_UVS  = WS_UV8 + (size_t)16384 * 2048;
constexpr size_t WS_PROJ = WS_UVS + (size_t)16384 * 8;
constexpr size_t WS_OATT = WS_PROJ + (size_t)NTOK * DIN * 2;
constexpr size_t WS_LSE  = WS_OATT + (size_t)NTOK * 1536 * 2;
constexpr size_t WS_KVB  = WS_LSE + (size_t)NTOK * 12 * 4;
constexpr size_t WS_YA   = WS_KVB + (size_t)16 * 32 * 65536 * 2;
constexpr size_t WS_YB   = WS_YA + (size_t)NTOK * 512 * 2;
constexpr size_t WS_YC   = WS_YB + (size_t)NTOK * 1024 * 2;
constexpr size_t WS_MRGF = WS_YC + (size_t)NTOK * 1024 * 2;
constexpr size_t WS_MRGB = WS_MRGF + (size_t)NTOK * 1024 * 4;
constexpr size_t WS_END  = WS_MRGB + (size_t)NTOK * 1024 * 2;
constexpr size_t WS_Q    = WS_PROJ;
constexpr size_t WS_EID  = WS_PROJ + (size_t)NTOK * 2048 * 2;
constexpr size_t WS_GATE = WS_EID + (size_t)NTOK * 128 * 4;
static_assert(WS_END <= (size_t)1073741824, "workspace too large");
static_assert(WS_PROJ % 256 == 0 && WS_KVB % 256 == 0 && WS_MRGF % 256 == 0, "alignment");

struct Args { const float* in[20]; float* out; unsigned char* ws; double ropeA, ropeR; int ph_lo, ph_hi; };

DI float bflo(unsigned w) { return __uint_as_float(w << 16); }
DI float bfhi(unsigned w) { return __uint_as_float(w & 0xffff0000u); }
DI float bf2f(bf16_t v) { return __uint_as_float(((unsigned)v) << 16); }
DI unsigned pk2(float lo, float hi) { return pg8::cvt_pk_bf16(lo, hi); }
DI bf16_t f2bf(float f) { return (bf16_t)(pk2(f, 0.f) & 0xffffu); }
DI f32x4 mfma16(bf16x8 a, bf16x8 b, f32x4 c) { return __builtin_amdgcn_mfma_f32_16x16x32_bf16(a, b, c, 0, 0, 0); }
DI s16x4 trrd(LAS unsigned char* p) { return __builtin_amdgcn_ds_read_tr16_b64_v4i16((LAS s16x4*)p); }
DI bf16x8 cat8(s16x4 lo, s16x4 hi) { return __builtin_shufflevector(lo, hi, 0, 1, 2, 3, 4, 5, 6, 7); }
DI float wsum(float v) { v += __shfl_xor(v, 32); v += __shfl_xor(v, 16); v += __shfl_xor(v, 8); v += __shfl_xor(v, 4); v += __shfl_xor(v, 2); v += __shfl_xor(v, 1); return v; }
DI float sigm(float x) { return __builtin_amdgcn_rcpf(1.f + __builtin_amdgcn_exp2f(x * -1.4426950408889634f)); }
DI float gelu_erf(float x) { return 0.5f * x * (1.f + erff(x * 0.70710678118654752f)); }
DI float dot2(unsigned w, unsigned x, float acc) { return __builtin_amdgcn_fdot2_f32_bf16(__builtin_bit_cast(bf16x2v, w), __builtin_bit_cast(bf16x2v, x), acc, false); }
DI float log2gamma(int h) { return log2f(1.0f - exp2f(-5.0f - (float)h)); }

DI float dpp_f(float v, const int ctrl, const int rmask) { return v; }
#define MK_DPP_ADD(v, ctrl, rmask) v += __int_as_float(__builtin_amdgcn_update_dpp(0, __float_as_int(v), (ctrl), (rmask), 0xf, false))
DI float wsum_dpp(float v) {
    MK_DPP_ADD(v, 0xB1, 0xf); MK_DPP_ADD(v, 0x4E, 0xf); MK_DPP_ADD(v, 0x141, 0xf); MK_DPP_ADD(v, 0x140, 0xf);
    MK_DPP_ADD(v, 0x142, 0xa); MK_DPP_ADD(v, 0x143, 0xc);
    return __int_as_float(__builtin_amdgcn_readlane(__float_as_int(v), 63));
}
DI float gelu_as(float v) {
    const float av = fabsf(v), t = __builtin_amdgcn_rcpf(av * 0.2316418882f + 1.0f);
    float q = t * 0.5307027145f + (-0.7265760135f); q = q * t + 0.7107068705f; q = q * t + (-0.142248368f); q = q * t + 0.127414796f; q = q * t;
    const float e = __builtin_amdgcn_exp2f(v * v * (-0.72134752044f));
    const float m = v * (q * e);
    return v < 0.f ? m : v - m;
}
DI void sincos_d(double x, double& s, double& c) {
    const double n = rint(x * 0.63661977236758134308);
    double y = fma(-n, 1.57079632679489655800e+00, x); y = fma(-n, 6.12323399573676603587e-17, y);
    const double y2 = y * y;
    const double sp = y + y * y2 * (-1.0 / 6 + y2 * (1.0 / 120 + y2 * (-1.0 / 5040 + y2 * (1.0 / 362880 + y2 * (-1.0 / 39916800 + y2 * (1.0 / 6227020800.0))))));
    const double cp = 1.0 + y2 * (-0.5 + y2 * (1.0 / 24 + y2 * (-1.0 / 720 + y2 * (1.0 / 40320 + y2 * (-1.0 / 3628800 + y2 * (1.0 / 479001600.0 + y2 * (-1.0 / 87178291200.0)))))));
    const int q = ((int)n) & 3;
    s = (q == 0) ? sp : (q == 1) ? cp : (q == 2) ? -sp : -cp;
    c = (q == 0) ? cp : (q == 1) ? -sp : (q == 2) ? -cp : sp;
}

DI int wperm(int n) {
    if (n < 3072) { const int j = n & 127, jj = j & 63; return (n & ~127) + 8 * (jj >> 2) + (jj & 3) + ((j >= 64) ? 4 : 0); }
    if (n >= OFF_RQ && n < OFF_RV) { const int j = n & 255, jj = j & 127; return (n & ~255) + 8 * (jj >> 2) + (jj & 3) + ((j >= 128) ? 4 : 0); }
    return n;
}

template <bool WPERM>
DI void tconv_tile(const float* src, int ldsrc, bf16_t* dst, int lddst, int k0, int n0, LAS float* t) {
    const int tid = mk_tid();
#pragma unroll
    for (int i = 0; i < 8; ++i) { const int idx = tid + 512 * i, r = idx >> 6, c = idx & 63; t[r * 65 + c] = src[(size_t)(k0 + r) * ldsrc + n0 + c]; }
    __syncthreads();
#pragma unroll
    for (int i = 0; i < 8; ++i) { const int idx = tid + 512 * i, n = idx >> 6, k = idx & 63; const int nr = WPERM ? wperm(n0 + n) : (n0 + n); dst[(size_t)nr * lddst + k0 + k] = f2bf(t[k * 65 + n]); }
    __syncthreads();
}
DI void conv_unit(const float* src, bf16_t* dst, int unit) {
    const size_t i = (size_t)unit * 4096 + (size_t)mk_tid() * 8;
    const f32x4 a = *(const f32x4*)(src + i), b = *(const f32x4*)(src + i + 4);
    u32x4 o; o.x = pk2(a[0], a[1]); o.y = pk2(a[2], a[3]); o.z = pk2(b[0], b[1]); o.w = pk2(b[2], b[3]);
    *(u32x4*)(dst + i) = o;
}
DI void w8_unit(const float* src, unsigned char* ws, int unit, LAS float* t) {
    const int tid = mk_tid(), n0 = unit * 64;
    unsigned char* dst = ws + WS_WINT;
#pragma unroll 1
    for (int k0 = 0; k0 < 1024; k0 += 64) {
#pragma unroll
        for (int i = 0; i < 8; ++i) { const int idx = tid + 512 * i, r = idx >> 6, cc = idx & 63; t[r * 65 + cc] = fminf(fmaxf(src[(size_t)(k0 + r) * DIN + n0 + cc] * W8_SCALE, -F8_MAX), F8_MAX); }
        __syncthreads();
#pragma unroll
        for (int i = 0; i < 2; ++i) { const int idx = tid + 512 * i, n = idx >> 4, k4 = idx & 15;
            int wd = __builtin_amdgcn_cvt_pk_fp8_f32(t[(4 * k4) * 65 + n], t[(4 * k4 + 1) * 65 + n], 0, false);
            wd = __builtin_amdgcn_cvt_pk_fp8_f32(t[(4 * k4 + 2) * 65 + n], t[(4 * k4 + 3) * 65 + n], wd, true);
            *(int*)(dst + (size_t)wperm(n0 + n) * 1024 + k0 + 4 * k4) = wd; }
        __syncthreads();
    }
}
DI void row_to_fp8(const f32x4 (&o)[4], unsigned char* x8row, int ln) {
    u32x4 w;
#pragma unroll
    for (int q = 0; q < 4; ++q) {
        const float a0 = fminf(fmaxf(o[q][0] * X8_SCALE, -F8_MAX), F8_MAX), a1 = fminf(fmaxf(o[q][1] * X8_SCALE, -F8_MAX), F8_MAX), a2 = fminf(fmaxf(o[q][2] * X8_SCALE, -F8_MAX), F8_MAX), a3 = fminf(fmaxf(o[q][3] * X8_SCALE, -F8_MAX), F8_MAX);
        int wd = __builtin_amdgcn_cvt_pk_fp8_f32(a0, a1, 0, false); wd = __builtin_amdgcn_cvt_pk_fp8_f32(a2, a3, wd, true); w[q] = (unsigned)wd; }
    *(u32x4*)(x8row + 16 * ln) = w;
}
typedef float f32x16 __attribute__((ext_vector_type(16)));
typedef float f32x32 __attribute__((ext_vector_type(32)));
typedef unsigned u32x6 __attribute__((ext_vector_type(6)));
typedef _Float16 f16x32 __attribute__((ext_vector_type(32)));
DI float wmax(float m) { m = fmaxf(m, __shfl_xor(m, 32)); m = fmaxf(m, __shfl_xor(m, 16)); m = fmaxf(m, __shfl_xor(m, 8)); m = fmaxf(m, __shfl_xor(m, 4)); m = fmaxf(m, __shfl_xor(m, 2)); m = fmaxf(m, __shfl_xor(m, 1)); return m; }
DI void conv_fp6_rows(const float* usrc, const float* vsrc, unsigned char* ws, int unit) {
    const int tid = mk_tid(), lane = tid & 63, w = tid >> 6;
    const size_t row = (size_t)unit * 8 + w;
    const float* up = usrc + row * 1024 + 16 * lane; const float* vp = vsrc + row * 1024 + 16 * lane;
    f32x16 a, b; float mu = 0.f, mv = 0.f;
#pragma unroll
    for (int q = 0; q < 4; ++q) { const f32x4 x = *(const f32x4*)(up + 4 * q), y = *(const f32x4*)(vp + 4 * q);
#pragma unroll
        for (int j = 0; j < 4; ++j) { a[4 * q + j] = x[j]; b[4 * q + j] = y[j]; mu = fmaxf(mu, fabsf(x[j])); mv = fmaxf(mv, fabsf(y[j])); } }
    mu = wmax(mu); mv = wmax(mv);
    const float su = (mu > 0.f) ? 7.0f / mu : 1.0f, sv = (mv > 0.f) ? 7.0f / mv : 1.0f;
    f16x32 h;
#pragma unroll
    for (int i = 0; i < 16; ++i) { h[i] = (_Float16)(a[i] * su); h[16 + i] = (_Float16)(b[i] * sv); }
    const u32x6 p = __builtin_amdgcn_cvt_scalef32_pk32_fp6_f16(h, 1.0f);
    unsigned char* rec = ws + WS_UV8 + row * 1536;
    *(u32x4*)(rec + 16 * lane) = (u32x4){p[0], p[1], p[2], p[3]};
    *(u32x2*)(rec + 1024 + 8 * lane) = (u32x2){p[4], p[5]};
    if (lane == 0) { float* sp = (float*)(ws + WS_UVS) + row * 2; sp[0] = (mu > 0.f) ? mu * (1.0f / 7.0f) : 1.0f; sp[1] = (mv > 0.f) ? mv * (1.0f / 7.0f) : 1.0f; }
}
DI void phase_conv(const Args& a, int layer, LAS unsigned char* lds) {
    unsigned char* ws = a.ws;
    LAS float* t = (LAS float*)lds;
    const int J0 = 216, J1 = J0 + 128, J2 = J1 + 256, J3 = J2 + 256, J4 = J3 + 256, J5 = J4 + 512, J6 = J5 + 32, J7 = J6 + 2048, J8 = J7, J9 = J8 + 64, J10 = J9 + 1;
    const int total = J10;
    for (int u = blockIdx.x; u < total; u += gridDim.x) {
        if (u < J0) { w8_unit(a.in[1] + (size_t)layer * 1024 * DIN, ws, u, t); }
        else if (u < J1) { const int v = u - J0, kt = v / 16, nt = v % 16; tconv_tile<false>(a.in[9] + (size_t)layer * 2560 * 1024, 1024, (bf16_t*)(ws + WS_WBAT), 512, kt * 64, nt * 64, t); }
        else if (u < J2) { const int v = u - J1, kt = v / 16, nt = v % 16; tconv_tile<false>(a.in[9] + (size_t)layer * 2560 * 1024 + (size_t)512 * 1024, 1024, (bf16_t*)(ws + WS_WBBT), 1024, kt * 64, nt * 64, t); }
        else if (u < J3) { const int v = u - J2, kt = v / 16, nt = v % 16; tconv_tile<false>(a.in[9] + (size_t)layer * 2560 * 1024 + (size_t)1536 * 1024, 1024, (bf16_t*)(ws + WS_WBCT), 1024, kt * 64, nt * 64, t); }
        else if (u < J4) { const int v = u - J3, kt = v / 16, nt = v % 16; tconv_tile<false>(a.in[10] + (size_t)layer * 1024 * 1024, 1024, (bf16_t*)(ws + WS_WOT), 1024, kt * 64, nt * 64, t); }
        else if (u < J5) { const int v = u - J4, kt = v / 32, nt = v % 32; tconv_tile<false>(a.in[13] + (size_t)layer * 1024 * 2048, 2048, (bf16_t*)(ws + WS_WQT), 1024, kt * 64, nt * 64, t); }
        else if (u < J6) { const int v = u - J5, blk = v & 15, which = v >> 4;
            tconv_tile<false>(a.in[which ? 6 : 4] + ((size_t)layer * 16 + blk) * 4096, 64, (bf16_t*)(ws + (which ? WS_WXT : WS_WAT)) + blk * 4096, 64, 0, 0, t); }
        else if (u < J7) { conv_fp6_rows(a.in[16] + (size_t)layer * 16384 * 1024, a.in[17] + (size_t)layer * 16384 * 1024, ws, u - J6); }
        else if (u < J9) { const int v = u - J8; if (v < 32) conv_unit(a.in[14] + (size_t)layer * 131072, (bf16_t*)(ws + WS_K1B), v); else conv_unit(a.in[15] + (size_t)layer * 131072, (bf16_t*)(ws + WS_K2B), v - 32); }
        else { for (int c = mk_tid(); c < 1024; c += 512) { const float lam = a.in[8][layer * 1024 + c]; const float e = __builtin_amdgcn_exp2f(-lam * 1.4426950408889634f); const float sp = (e < 0.05f) ? e * (1.0f + e * (-0.5f + e * (0.33333333f + e * -0.25f))) : __builtin_amdgcn_logf(1.0f + e) * 0.6931471805599453f; ((float*)(ws + WS_CCH))[c] = -8.0f * sp; } }
    }
}

DI void phase_prologue(const Args& a) {
    unsigned char* ws = a.ws;
    const int tid = mk_tid();
    for (int u = blockIdx.x; u < 2048 + 1536; u += gridDim.x) {
        if (u < 2048) { const int ln = tid & 63; const size_t row = (size_t)u * 8 + (tid >> 6);
            const float* xp = a.in[0] + row * 1024 + 16 * ln; float* xo = (float*)(ws + WS_XF) + row * 1024 + 16 * ln;
            f32x4 o[4];
#pragma unroll
            for (int q = 0; q < 4; ++q) { o[q] = *(const f32x4*)(xp + 4 * q); *(f32x4*)(xo + 4 * q) = o[q]; }
            row_to_fp8(o, ws + WS_X8 + row * 1024, ln); }
        else { const int idx = (u - 2048) * 512 + tid;
            const int pos = idx / 192, i = idx % 192;
            const bool isA = i < 64; const int fi = isA ? i : i - 64; const double r = isA ? a.ropeA : a.ropeR;
            double inv = 1.0; for (int k = 0; k < fi; ++k) inv *= r;
            double s, c; sincos_d((double)pos * inv, s, c);
            if (isA) { ((float*)(ws + WS_COSA))[pos * 64 + fi] = (float)c; ((float*)(ws + WS_SINA))[pos * 64 + fi] = (float)s; }
            else { ((float*)(ws + WS_COSR))[pos * 128 + fi] = (float)c; ((float*)(ws + WS_SINR))[pos * 128 + fi] = (float)s; } }
    }
}

DI void phase_rope(const Args& a) {
    unsigned char* ws = a.ws; bf16_t* proj = (bf16_t*)(ws + WS_PROJ);
    for (int u = blockIdx.x; u < NTOK / 8; u += gridDim.x) {
#pragma unroll 1
        for (int i = 0; i < 5; ++i) {
            const int idx = mk_tid() + 512 * i, tk = u * 8 + idx / 320; int it = idx % 320;
            int off, hd, half, head, ch; const float* ct; const float* st; float sc = 1.0f;
            if (it < 192) { off = (it < 96) ? OFF_AQ : OFF_AK; if (it >= 96) it -= 96; hd = 128; half = 64; head = it >> 3; ch = it & 7; ct = (const float*)(ws + WS_COSA); st = (const float*)(ws + WS_SINA); }
            else { it -= 192; off = (it < 64) ? OFF_RQ : OFF_RK; if (it >= 64) { it -= 64; sc = 0.0625f; } hd = 256; half = 128; head = it >> 4; ch = it & 15; ct = (const float*)(ws + WS_COSR); st = (const float*)(ws + WS_SINR); }
            const int pos = tk & (SEQ - 1);
            bf16_t* p1 = proj + (size_t)tk * DIN + off + head * hd + ch * 8; bf16_t* p2 = p1 + half;
            const u32x4 x1 = *(const u32x4*)p1, x2 = *(const u32x4*)p2;
            const float* cp = ct + (size_t)pos * half + ch * 8; const float* sp = st + (size_t)pos * half + ch * 8;
            const f32x4 c0 = *(const f32x4*)cp, c1 = *(const f32x4*)(cp + 4), s0 = *(const f32x4*)sp, s1 = *(const f32x4*)(sp + 4);
            float t1[8], t2[8], cc[8], ss[8];
#pragma unroll
            for (int q = 0; q < 4; ++q) { t1[2 * q] = bflo(x1[q]); t1[2 * q + 1] = bfhi(x1[q]); t2[2 * q] = bflo(x2[q]); t2[2 * q + 1] = bfhi(x2[q]); cc[q] = c0[q]; cc[4 + q] = c1[q]; ss[q] = s0[q]; ss[4 + q] = s1[q]; }
            u32x4 o1, o2;
#pragma unroll
            for (int q = 0; q < 4; ++q) {
                const float a0 = (t1[2 * q] * cc[2 * q] - t2[2 * q] * ss[2 * q]) * sc, a1 = (t1[2 * q + 1] * cc[2 * q + 1] - t2[2 * q + 1] * ss[2 * q + 1]) * sc;
                const float b0 = (t1[2 * q] * ss[2 * q] + t2[2 * q] * cc[2 * q]) * sc, b1 = (t1[2 * q + 1] * ss[2 * q + 1] + t2[2 * q + 1] * cc[2 * q + 1]) * sc;
                o1[q] = pk2(a0, a1); o2[q] = pk2(b0, b1); }
            *(u32x4*)p1 = o1; *(u32x4*)p2 = o2;
        }
    }
}

DI void attn_unit(const Args& a, int unit, LAS unsigned char* lds) {
    unsigned char* ws = a.ws;
    const int tid = mk_tid(), lane = tid & 63, w = __builtin_amdgcn_readfirstlane(tid >> 6), g = lane >> 4, l15 = lane & 15, tq4 = l15 >> 2, tp4 = l15 & 3;
    const int b = unit / 384, rem = unit % 384, h = rem >> 5, bi = rem & 31;
    const int grp = h >> 2, d = (grp == 0) ? 1 : ((grp == 1) ? 4 : 16), nb = 32 / d, r = bi / nb, n = bi % nb;
    const bf16_t* proj = (const bf16_t*)(ws + WS_PROJ) + (size_t)b * SEQ * DIN;
    LAS unsigned char* Ks = lds; LAS unsigned char* Vs = lds + 256 * 288;
#pragma unroll
    for (int i = 0; i < 8; ++i) {
        const int idx = tid + 512 * i, row = idx >> 4, ch = idx & 15, m = 128 * (n - 1) + row;
        u32x4 kv = {0u, 0u, 0u, 0u}, vv = {0u, 0u, 0u, 0u};
        if (m >= 0) { const bf16_t* p = proj + (size_t)(m * d + r) * DIN + h * 128 + ch * 8; kv = *(const u32x4*)(p + OFF_AK); vv = *(const u32x4*)(p + OFF_AV); }
        *(LAS u32x4*)(Ks + row * 288 + ch * 16) = kv; *(LAS u32x4*)(Vs + row * 288 + ch * 16) = vv;
    }
    const int qi = 16 * w + l15;
    const size_t tq = (size_t)(128 * n + qi) * d + r;
    bf16x8 qf[4];
#pragma unroll
    for (int ks = 0; ks < 4; ++ks) qf[ks] = *(const bf16x8*)(proj + tq * DIN + OFF_AQ + h * 128 + 32 * ks + 8 * g);
    __syncthreads();
    const int s0 = w >> 1;
    f32x4 sacc[10];
#pragma unroll
    for (int jj = 0; jj < 10; ++jj) {
        f32x4 acc = {0.f, 0.f, 0.f, 0.f};
#pragma unroll
        for (int ks = 0; ks < 4; ++ks) { const bf16x8 kf = *(const LAS bf16x8*)(Ks + (32 * s0 + 16 * jj + l15) * 288 + (32 * ks + 8 * g) * 2); acc = mfma16(kf, qf[ks], acc); }
        sacc[jj] = acc;
    }
    const float scale = 0.08838834764831845f * 1.4426950408889634f;
    float mx = -1e30f;
#pragma unroll
    for (int jj = 0; jj < 10; ++jj)
#pragma unroll
        for (int rg = 0; rg < 4; ++rg) {
            const int j = 32 * s0 + 16 * jj + 4 * g + rg;
            const bool valid = (j >= qi) && (j <= qi + 128) && (n > 0 || j >= 128);
            const float s = valid ? sacc[jj][rg] * scale : -1e30f;
            sacc[jj][rg] = s; mx = fmaxf(mx, s);
        }
    mx = fmaxf(mx, __shfl_xor(mx, 16)); mx = fmaxf(mx, __shfl_xor(mx, 32));
    float sum = 0.f;
#pragma unroll
    for (int jj = 0; jj < 10; ++jj)
#pragma unroll
        for (int rg = 0; rg < 4; ++rg) { const float p = __builtin_amdgcn_exp2f(sacc[jj][rg] - mx); sacc[jj][rg] = p; sum += p; }
    sum += __shfl_xor(sum, 16); sum += __shfl_xor(sum, 32);
    f32x4 oacc[8];
#pragma unroll
    for (int db = 0; db < 8; ++db) oacc[db] = (f32x4){0.f, 0.f, 0.f, 0.f};
#pragma unroll
    for (int s = 0; s < 5; ++s) {
        u32x4 pw; pw.x = pk2(sacc[2 * s][0], sacc[2 * s][1]); pw.y = pk2(sacc[2 * s][2], sacc[2 * s][3]); pw.z = pk2(sacc[2 * s + 1][0], sacc[2 * s + 1][1]); pw.w = pk2(sacc[2 * s + 1][2], sacc[2 * s + 1][3]);
        const bf16x8 pb = __builtin_bit_cast(bf16x8, pw);
        const int k0 = 32 * (s0 + s) + 4 * g + tq4;
#pragma unroll
        for (int db = 0; db < 8; ++db) {
            const s16x4 lo = trrd(Vs + k0 * 288 + (16 * db + 4 * tp4) * 2), hi = trrd(Vs + (k0 + 16) * 288 + (16 * db + 4 * tp4) * 2);
            oacc[db] = mfma16(cat8(lo, hi), pb, oacc[db]);
        }
    }
    const float inv = 1.0f / sum;
    bf16_t* op = (bf16_t*)(ws + WS_OATT) + ((size_t)b * SEQ + tq) * 1536 + h * 128 + 4 * g;
#pragma unroll
    for (int db = 0; db < 8; ++db) { u32x2 o; o.x = pk2(oacc[db][0] * inv, oacc[db][1] * inv); o.y = pk2(oacc[db][2] * inv, oacc[db][3] * inv); *(u32x2*)(op + 16 * db) = o; }
    if (g == 0) ((float*)(ws + WS_LSE))[((size_t)b * SEQ + tq) * 12 + h] = mx + __builtin_amdgcn_logf(sum);
    __syncthreads();
}

DI void retkv_unit(const Args& a, int unit, LAS unsigned char* lds) {
    unsigned char* ws = a.ws;
    const int tid = mk_tid(), lane = tid & 63, w = __builtin_amdgcn_readfirstlane(tid >> 6), g = lane >> 4, l15 = lane & 15, tq4 = l15 >> 2, tp4 = l15 & 3;
    const int b = unit >> 7, h = (unit >> 5) & 3, c = unit & 31;
    const bf16_t* proj = (const bf16_t*)(ws + WS_PROJ) + ((size_t)b * SEQ + c * 128) * DIN;
    LAS unsigned char* Ks = lds; LAS unsigned char* Vs = lds + 128 * 544;
    const float l2g = log2gamma(h);
#pragma unroll
    for (int i = 0; i < 8; ++i) {
        const int idx = tid + 512 * i, row = idx >> 5, ch = idx & 31;
        const bf16_t* p = proj + (size_t)row * DIN + h * 256 + ch * 8;
        const u32x4 kv = *(const u32x4*)(p + OFF_RK), vv = *(const u32x4*)(p + OFF_RV);
        const float z = exp2f((float)(127 - row) * l2g);
        u32x4 kz;
#pragma unroll
        for (int q = 0; q < 4; ++q) kz[q] = pk2(bflo(kv[q]) * z, bfhi(kv[q]) * z);
        *(LAS u32x4*)(Ks + row * 544 + ch * 16) = kz; *(LAS u32x4*)(Vs + row * 544 + ch * 16) = vv;
    }
    __syncthreads();
#pragma unroll 1
    for (int nh = 0; nh < 2; ++nh) {
        f32x4 acc[2][8];
#pragma unroll
        for (int mb = 0; mb < 2; ++mb)
#pragma unroll
            for (int nb = 0; nb < 8; ++nb) acc[mb][nb] = (f32x4){0.f, 0.f, 0.f, 0.f};
#pragma unroll
        for (int ks = 0; ks < 4; ++ks) {
            const int j0 = 32 * ks + 4 * g + tq4;
            bf16x8 af[2];
#pragma unroll
            for (int mb = 0; mb < 2; ++mb) { const int col = 32 * w + 16 * mb + 4 * tp4; af[mb] = cat8(trrd(Vs + j0 * 544 + col * 2), trrd(Vs + (j0 + 16) * 544 + col * 2)); }
#pragma unroll
            for (int nb = 0; nb < 8; ++nb) {
                const int col = 128 * nh + 16 * nb + 4 * tp4;
                const bf16x8 bfr = cat8(trrd(Ks + j0 * 544 + col * 2), trrd(Ks + (j0 + 16) * 544 + col * 2));
#pragma unroll
                for (int mb = 0; mb < 2; ++mb) acc[mb][nb] = mfma16(af[mb], bfr, acc[mb][nb]);
            }
        }
        bf16_t* kvb = (bf16_t*)(ws + WS_KVB) + ((size_t)((b * 4 + h) * 32 + c)) * 65536 + 128 * nh;
#pragma unroll
        for (int mb = 0; mb < 2; ++mb)
#pragma unroll
            for (int nb = 0; nb < 8; ++nb)
#pragma unroll
                for (int rg = 0; rg < 4; ++rg) kvb[(size_t)(32 * w + 16 * mb + 4 * g + rg) * 256 + 16 * nb + l15] = f2bf(acc[mb][nb][rg]);
    }
    __syncthreads();
}

DI void lru_unit(const Args& a, int layer, int unit, bool fin, LAS unsigned char* lds) {
    unsigned char* ws = a.ws;
    const int tid = mk_tid(), lane = tid & 63, w = __builtin_amdgcn_readfirstlane(tid >> 6), g = lane >> 4, l15 = lane & 15;
    const int b = unit >> 9, c = (unit >> 4) & 31, blk = unit & 15;
    LAS bf16_t* lxs = (LAS bf16_t*)lds;
    LAS float* xcf = (LAS float*)(lds + 16896);
    LAS unsigned char* xcb = lds + 49664;
    LAS float* rgt = (LAS float*)(lds + 68096);
    LAS float* igt = (LAS float*)(lds + 100864);
    LAS float* wst = (LAS float*)(lds + 133632);
    const bf16_t* proj = (const bf16_t*)(ws + WS_PROJ) + (size_t)b * SEQ * DIN;
    for (int idx = tid; idx < 131 * 8; idx += 512) {
        const int row = idx >> 3, ch = idx & 7, tk = c * 128 - 3 + row;
        u32x4 v = {0u, 0u, 0u, 0u};
        if (tk >= 0) v = *(const u32x4*)(proj + (size_t)tk * DIN + OFF_LX + blk * 64 + ch * 8);
        *(LAS u32x4*)(lxs + row * 64 + ch * 8) = v;
    }
    __syncthreads();
    {
        const int ch = tid & 63, gc = blk * 64 + ch;
        const float* cw = a.in[2] + (size_t)layer * 4096;
        const float cw0 = cw[gc], cw1 = cw[1024 + gc], cw2 = cw[2048 + gc], cw3 = cw[3072 + gc], cb = a.in[3][layer * 1024 + gc];
#pragma unroll
        for (int i = 0; i < 16; ++i) {
            const int t = (tid >> 6) + 8 * i;
            const float xc = cb + cw0 * bf2f(lxs[t * 64 + ch]) + cw1 * bf2f(lxs[(t + 1) * 64 + ch]) + cw2 * bf2f(lxs[(t + 2) * 64 + ch]) + cw3 * bf2f(lxs[(t + 3) * 64 + ch]);
            xcf[t * 64 + ch] = xc; *(LAS bf16_t*)(xcb + t * 144 + ch * 2) = f2bf(xc);
        }
    }
    __syncthreads();
#pragma unroll
    for (int gate = 0; gate < 2; ++gate) {
        const bf16_t* WT = (const bf16_t*)(ws + (gate ? WS_WXT : WS_WAT)) + blk * 4096;
        const float* bias = a.in[gate ? 7 : 5] + layer * 1024 + blk * 64;
        LAS float* dst = gate ? igt : rgt;
#pragma unroll
        for (int nb = 0; nb < 4; ++nb) {
            f32x4 acc = {0.f, 0.f, 0.f, 0.f};
#pragma unroll
            for (int ks = 0; ks < 2; ++ks) {
                const bf16x8 af = *(const LAS bf16x8*)(xcb + (16 * w + l15) * 144 + (32 * ks + 8 * g) * 2);
                const bf16x8 bfr = *(const bf16x8*)(WT + (16 * nb + l15) * 64 + 32 * ks + 8 * g);
                acc = mfma16(af, bfr, acc);
            }
            const float bv = bias[16 * nb + l15];
#pragma unroll
            for (int rg = 0; rg < 4; ++rg) dst[(16 * w + 4 * g + rg) * 64 + 16 * nb + l15] = sigm(acc[rg] + bv);
        }
    }
    __syncthreads();
    const int ch = lane, gc = blk * 64 + ch;
    const float cc = ((const float*)(ws + WS_CCH))[gc];
    float av[16], bv[16]; float Aw = 1.0f, Hw = 0.0f;
#pragma unroll
    for (int tt = 0; tt < 16; ++tt) {
        const int t = 16 * w + tt;
        const float la = cc * rgt[t * 64 + ch];
        const float aa = __builtin_amdgcn_exp2f(la * 1.4426950408889634f);
        const float bb = __builtin_amdgcn_sqrtf(fmaxf(1.0f - aa * aa, 0.0f)) * igt[t * 64 + ch] * xcf[t * 64 + ch];
        av[tt] = aa; bv[tt] = bb; Hw = aa * Hw + bb; Aw *= aa;
    }
    wst[w * 64 + ch] = Aw; wst[512 + w * 64 + ch] = Hw;
    __syncthreads();
    float* LA = (float*)(ws + WS_LSTA); float* LH = (float*)(ws + WS_LSTH);
    if (!fin) {
        if (w == 0) {
            float A = 1.0f, H = 0.0f;
#pragma unroll
            for (int ww = 0; ww < 8; ++ww) { const float A_ = wst[ww * 64 + ch], H_ = wst[512 + ww * 64 + ch]; H = A_ * H + H_; A *= A_; }
            LA[(size_t)(b * 32 + c) * 1024 + gc] = A; LH[(size_t)(b * 32 + c) * 1024 + gc] = H;
        }
    } else {
        float hcur = 0.0f;
#pragma unroll
        for (int c0 = 0; c0 < 32; c0 += 16) {
            if (c0 < c) {
                float ta[16], th[16];
#pragma unroll
                for (int q = 0; q < 16; ++q) { const int cp = (c0 + q < c) ? c0 + q : 0; ta[q] = LA[(size_t)(b * 32 + cp) * 1024 + gc]; th[q] = LH[(size_t)(b * 32 + cp) * 1024 + gc]; }
#pragma unroll
                for (int q = 0; q < 16; ++q) hcur = (c0 + q < c) ? ta[q] * hcur + th[q] : hcur;
            }
        }
        for (int ww = 0; ww < w; ++ww) hcur = wst[ww * 64 + ch] * hcur + wst[512 + ww * 64 + ch];
        bf16_t* yb = (bf16_t*)(ws + WS_YB) + ((size_t)b * SEQ + c * 128 + 16 * w) * 1024 + gc;
        const bf16_t* lgp = proj + (size_t)(c * 128 + 16 * w) * DIN + OFF_LG + gc;
#pragma unroll
        for (int tt = 0; tt < 16; ++tt) {
            hcur = av[tt] * hcur + bv[tt];
            const float lgv = bf2f(lgp[(size_t)tt * DIN]);
            yb[(size_t)tt * 1024] = f2bf(hcur * gelu_as(lgv));
        }
    }
    __syncthreads();
}

DI void lru_stripe(const Args& a, int layer, int stripe, LAS unsigned char* lds) {
    unsigned char* ws = a.ws;
    const int tid = mk_tid(), lane = tid & 63, w = __builtin_amdgcn_readfirstlane(tid >> 6), g = lane >> 4, l15 = lane & 15;
    const int b = stripe >> 4, blk = stripe & 15;
    LAS bf16_t* lxs = (LAS bf16_t*)lds;
    LAS bf16_t* lgs0 = (LAS bf16_t*)(lds + 16896);
    LAS unsigned char* xcb = lds + 49664;
    LAS float* rgt = (LAS float*)(lds + 68096);
    LAS float* igt = (LAS float*)(lds + 100864);
    LAS float* wst = (LAS float*)(lds + 133632);
    const bf16_t* proj = (const bf16_t*)(ws + WS_PROJ) + (size_t)b * SEQ * DIN;
    const int gc = blk * 64 + lane;
    const float* cw = a.in[2] + (size_t)layer * 4096;
    const int cch_ = tid & 63, cgc = blk * 64 + cch_;
    const float cw0 = cw[cgc], cw1 = cw[1024 + cgc], cw2 = cw[2048 + cgc], cw3 = cw[3072 + cgc], cb = a.in[3][layer * 1024 + cgc];
    const float cc = ((const float*)(ws + WS_CCH))[gc];
    bf16x8 wfa[4][2], wfx[4][2]; float bia[4], bix[4];
    {
        const bf16_t* WA = (const bf16_t*)(ws + WS_WAT) + blk * 4096; const bf16_t* WX = (const bf16_t*)(ws + WS_WXT) + blk * 4096;
#pragma unroll
        for (int nb = 0; nb < 4; ++nb) {
#pragma unroll
            for (int ks = 0; ks < 2; ++ks) { wfa[nb][ks] = *(const bf16x8*)(WA + (16 * nb + l15) * 64 + 32 * ks + 8 * g); wfx[nb][ks] = *(const bf16x8*)(WX + (16 * nb + l15) * 64 + 32 * ks + 8 * g); }
            bia[nb] = a.in[5][layer * 1024 + blk * 64 + 16 * nb + l15]; bix[nb] = a.in[7][layer * 1024 + blk * 64 + 16 * nb + l15];
        }
    }
    if (tid < 24) *(LAS u32x4*)(lxs + tid * 8) = (u32x4){0u, 0u, 0u, 0u};
    u32x4 plx[2], plg[2];
#pragma unroll
    for (int i = 0; i < 2; ++i) { const int idx = tid + 512 * i, row = idx >> 3, c8 = idx & 7; const bf16_t* p = proj + (size_t)row * DIN + blk * 64 + c8 * 8; plx[i] = *(const u32x4*)(p + OFF_LX); plg[i] = *(const u32x4*)(p + OFF_LG); }
    float hcarry = 0.0f;
#pragma unroll 1
    for (int c = 0; c < 32; ++c) {
        LAS bf16_t* lgs = lgs0 + (c & 1) * 8192;
#pragma unroll
        for (int i = 0; i < 2; ++i) { const int idx = tid + 512 * i, row = idx >> 3, c8 = idx & 7; *(LAS u32x4*)(lxs + (3 + row) * 64 + c8 * 8) = plx[i]; *(LAS u32x4*)(lgs + row * 64 + c8 * 8) = plg[i]; }
        __syncthreads();
        if (c + 1 < 32) {
#pragma unroll
            for (int i = 0; i < 2; ++i) { const int idx = tid + 512 * i, row = idx >> 3, c8 = idx & 7; const bf16_t* p = proj + (size_t)((c + 1) * 128 + row) * DIN + blk * 64 + c8 * 8; plx[i] = *(const u32x4*)(p + OFF_LX); plg[i] = *(const u32x4*)(p + OFF_LG); }
        }
        {
            const int t0 = (tid >> 6) * 16;
            float x0 = bf2f(lxs[t0 * 64 + cch_]), x1 = bf2f(lxs[(t0 + 1) * 64 + cch_]), x2 = bf2f(lxs[(t0 + 2) * 64 + cch_]);
#pragma unroll
            for (int i = 0; i < 16; ++i) {
                const float x3 = bf2f(lxs[(t0 + i + 3) * 64 + cch_]);
                const float xc = cb + cw0 * x0 + cw1 * x1 + cw2 * x2 + cw3 * x3;
                *(LAS bf16_t*)(xcb + (t0 + i) * 144 + cch_ * 2) = f2bf(xc);
                x0 = x1; x1 = x2; x2 = x3;
            }
        }
        __syncthreads();
        if (tid < 24) *(LAS u32x4*)(lxs + tid * 8) = *(const LAS u32x4*)(lxs + 128 * 64 + tid * 8);
        {
            const bf16x8 af0 = *(const LAS bf16x8*)(xcb + (16 * w + l15) * 144 + (8 * g) * 2), af1 = *(const LAS bf16x8*)(xcb + (16 * w + l15) * 144 + (32 + 8 * g) * 2);
#pragma unroll
            for (int nb = 0; nb < 4; ++nb) {
                f32x4 ar = {0.f, 0.f, 0.f, 0.f}, ax = {0.f, 0.f, 0.f, 0.f};
                ar = mfma16(af0, wfa[nb][0], ar); ar = mfma16(af1, wfa[nb][1], ar);
                ax = mfma16(af0, wfx[nb][0], ax); ax = mfma16(af1, wfx[nb][1], ax);
#pragma unroll
                for (int rg = 0; rg < 4; ++rg) { rgt[(16 * w + 4 * g + rg) * 64 + 16 * nb + l15] = sigm(ar[rg] + bia[nb]); igt[(16 * w + 4 * g + rg) * 64 + 16 * nb + l15] = sigm(ax[rg] + bix[nb]); }
            }
        }
        __syncthreads();
        float av[16], bv[16]; float Aw = 1.0f, Hw = 0.0f;
#pragma unroll
        for (int tt = 0; tt < 16; ++tt) {
            const int t = 16 * w + tt;
            const float la = cc * rgt[t * 64 + lane];
            const float aa = __builtin_amdgcn_exp2f(la * 1.4426950408889634f);
            const float bb = __builtin_amdgcn_sqrtf(fmaxf(1.0f - aa * aa, 0.0f)) * igt[t * 64 + lane] * bf2f(*(const LAS bf16_t*)(xcb + t * 144 + lane * 2));
            av[tt] = aa; bv[tt] = bb; Hw = aa * Hw + bb; Aw *= aa;
        }
        wst[w * 64 + lane] = Aw; wst[512 + w * 64 + lane] = Hw;
        __syncthreads();
        float hcur = hcarry, hend = hcarry;
#pragma unroll
        for (int ww = 0; ww < 8; ++ww) { const float A_ = wst[ww * 64 + lane], H_ = wst[512 + ww * 64 + lane]; hend = A_ * hend + H_; if (ww < w) hcur = hend; }
        hcarry = hend;
        bf16_t* yb = (bf16_t*)(ws + WS_YB) + ((size_t)b * SEQ + c * 128 + 16 * w) * 1024 + gc;
#pragma unroll
        for (int tt = 0; tt < 16; ++tt) {
            hcur = av[tt] * hcur + bv[tt];
            const float lgv = bf2f(lgs[(16 * w + tt) * 64 + lane]);
            yb[(size_t)tt * 1024] = f2bf(hcur * gelu_as(lgv));
        }
    }
    __syncthreads();
}

DI void retscan_unit(const Args& a, int unit) {
    unsigned char* ws = a.ws;
    const int e8 = unit * 512 + mk_tid();
    const int bh = e8 >> 13, within = e8 & 8191, h = bh & 3;
    const float g128 = exp2f(128.0f * log2gamma(h));
    bf16_t* base = (bf16_t*)(ws + WS_KVB) + (size_t)bh * 32 * 65536 + (size_t)within * 8;
    float st[8];
#pragma unroll
    for (int q = 0; q < 8; ++q) st[q] = 0.f;
#pragma unroll 1
    for (int c0 = 0; c0 < 32; c0 += 8) {
        u32x4 kv[8];
#pragma unroll
        for (int q = 0; q < 8; ++q) kv[q] = *(const u32x4*)(base + (size_t)(c0 + q) * 65536);
#pragma unroll
        for (int q = 0; q < 8; ++q) {
            u32x4 o;
#pragma unroll
            for (int j = 0; j < 4; ++j) o[j] = pk2(st[2 * j], st[2 * j + 1]);
            *(u32x4*)(base + (size_t)(c0 + q) * 65536) = o;
#pragma unroll
            for (int j = 0; j < 4; ++j) { st[2 * j] = g128 * st[2 * j] + bflo(kv[q][j]); st[2 * j + 1] = g128 * st[2 * j + 1] + bfhi(kv[q][j]); }
        }
    }
}

DI void attmerge_unit(const Args& a, int unit) {
    unsigned char* ws = a.ws;
    const int idx = unit * 512 + mk_tid(), t = idx >> 6, hp = (idx >> 4) & 3, dc = idx & 15;
    const float* lse = (const float*)(ws + WS_LSE) + (size_t)t * 12;
    const float l0 = lse[hp], l1 = lse[4 + hp], l2 = lse[8 + hp];
    const float m = fmaxf(l0, fmaxf(l1, l2));
    float w0 = __builtin_amdgcn_exp2f(l0 - m), w1 = __builtin_amdgcn_exp2f(l1 - m), w2 = __builtin_amdgcn_exp2f(l2 - m);
    const float is = 1.0f / (w0 + w1 + w2); w0 *= is; w1 *= is; w2 *= is;
    const bf16_t* o = (const bf16_t*)(ws + WS_OATT) + (size_t)t * 1536 + hp * 128 + dc * 8;
    const u32x4 a0 = *(const u32x4*)o, a1 = *(const u32x4*)(o + 512), a2 = *(const u32x4*)(o + 1024);
    u32x4 r;
#pragma unroll
    for (int q = 0; q < 4; ++q) r[q] = pk2(w0 * bflo(a0[q]) + w1 * bflo(a1[q]) + w2 * bflo(a2[q]), w0 * bfhi(a0[q]) + w1 * bfhi(a1[q]) + w2 * bfhi(a2[q]));
    *(u32x4*)((bf16_t*)(ws + WS_YA) + (size_t)t * 512 + hp * 128 + dc * 8) = r;
}

DI void retout_unit(const Args& a, int unit, LAS unsigned char* lds) {
    unsigned char* ws = a.ws;
    const int tid = mk_tid(), lane = tid & 63, w = __builtin_amdgcn_readfirstlane(tid >> 6), g = lane >> 4, l15 = lane & 15, tq4 = l15 >> 2, tp4 = l15 & 3;
    const int b = unit >> 7, h = (unit >> 5) & 3, c = unit & 31;
    const bf16_t* proj = (const bf16_t*)(ws + WS_PROJ) + ((size_t)b * SEQ + c * 128) * DIN;
    const bf16_t* rt = (const bf16_t*)(ws + WS_KVB) + ((size_t)((b * 4 + h) * 32 + c)) * 65536;
    LAS unsigned char* RA = lds; LAS unsigned char* RB = lds + 128 * 544;
    const float l2g = log2gamma(h);
    const int qi = 16 * w + l15;
    bf16x8 qf[8];
#pragma unroll
    for (int ks = 0; ks < 8; ++ks) qf[ks] = *(const bf16x8*)(proj + (size_t)qi * DIN + OFF_RQ + h * 256 + 32 * ks + 8 * g);
#pragma unroll
    for (int i = 0; i < 8; ++i) {
        const int idx = tid + 512 * i, row = idx >> 5, ch = idx & 31;
        *(LAS u32x4*)(RA + row * 544 + ch * 16) = *(const u32x4*)(proj + (size_t)row * DIN + OFF_RK + h * 256 + ch * 8);
        *(LAS u32x4*)(RB + row * 544 + ch * 16) = *(const u32x4*)(rt + (size_t)row * 256 + ch * 8);
    }
    __syncthreads();
    f32x4 sacc[8], oacc[16];
#pragma unroll
    for (int jj = 0; jj < 8; ++jj) {
        f32x4 acc = {0.f, 0.f, 0.f, 0.f};
        if (jj <= w) {
#pragma unroll
            for (int ks = 0; ks < 8; ++ks) { const bf16x8 kf = *(const LAS bf16x8*)(RA + (16 * jj + l15) * 544 + (32 * ks + 8 * g) * 2); acc = mfma16(kf, qf[ks], acc); }
        }
        sacc[jj] = acc;
    }
#pragma unroll
    for (int db = 0; db < 8; ++db) {
        f32x4 acc = {0.f, 0.f, 0.f, 0.f};
#pragma unroll
        for (int ks = 0; ks < 8; ++ks) { const bf16x8 rf = *(const LAS bf16x8*)(RB + (16 * db + l15) * 544 + (32 * ks + 8 * g) * 2); acc = mfma16(rf, qf[ks], acc); }
        oacc[db] = acc;
    }
    __syncthreads();
#pragma unroll
    for (int i = 0; i < 8; ++i) {
        const int idx = tid + 512 * i, row = idx >> 5, ch = idx & 31;
        *(LAS u32x4*)(RA + row * 544 + ch * 16) = *(const u32x4*)(proj + (size_t)row * DIN + OFF_RV + h * 256 + ch * 8);
        *(LAS u32x4*)(RB + row * 544 + ch * 16) = *(const u32x4*)(rt + (size_t)(128 + row) * 256 + ch * 8);
    }
    __syncthreads();
#pragma unroll
    for (int db = 0; db < 8; ++db) {
        f32x4 acc = {0.f, 0.f, 0.f, 0.f};
#pragma unroll
        for (int ks = 0; ks < 8; ++ks) { const bf16x8 rf = *(const LAS bf16x8*)(RB + (16 * db + l15) * 544 + (32 * ks + 8 * g) * 2); acc = mfma16(rf, qf[ks], acc); }
        oacc[8 + db] = acc;
    }
    const float xi = __builtin_amdgcn_exp2f((float)(qi + 1) * l2g);
#pragma unroll
    for (int db = 0; db < 16; ++db) oacc[db] = oacc[db] * xi;
#pragma unroll
    for (int jj = 0; jj < 8; ++jj)
#pragma unroll
        for (int rg = 0; rg < 4; ++rg) { const int j = 16 * jj + 4 * g + rg; sacc[jj][rg] = (qi >= j) ? sacc[jj][rg] * __builtin_amdgcn_exp2f((float)(qi - j) * l2g) : 0.f; }
#pragma unroll
    for (int s = 0; s < 4; ++s) {
        if (2 * s <= w) {
            u32x4 pw; pw.x = pk2(sacc[2 * s][0], sacc[2 * s][1]); pw.y = pk2(sacc[2 * s][2], sacc[2 * s][3]); pw.z = pk2(sacc[2 * s + 1][0], sacc[2 * s + 1][1]); pw.w = pk2(sacc[2 * s + 1][2], sacc[2 * s + 1][3]);
            const bf16x8 pb = __builtin_bit_cast(bf16x8, pw);
            const int k0 = 32 * s + 4 * g + tq4;
#pragma unroll
            for (int db = 0; db < 16; ++db) {
                const s16x4 lo = trrd(RA + k0 * 544 + (16 * db + 4 * tp4) * 2), hi = trrd(RA + (k0 + 16) * 544 + (16 * db + 4 * tp4) * 2);
                oacc[db] = mfma16(cat8(lo, hi), pb, oacc[db]);
            }
        }
    }
    float s1 = 0.f;
#pragma unroll
    for (int db = 0; db < 16; ++db) s1 += (oacc[db][0] + oacc[db][1]) + (oacc[db][2] + oacc[db][3]);
    s1 += __shfl_xor(s1, 16); s1 += __shfl_xor(s1, 32);
    const float mean = s1 * (1.0f / 256.0f);
    float s2 = 0.f;
#pragma unroll
    for (int db = 0; db < 16; ++db)
#pragma unroll
        for (int rg = 0; rg < 4; ++rg) { const float dd = oacc[db][rg] - mean; s2 += dd * dd; }
    s2 += __shfl_xor(s2, 16); s2 += __shfl_xor(s2, 32);
    const float rstd = rsqrtf(s2 * (1.0f / 256.0f) + LN_EPS);
    const bf16_t* rgp = proj + (size_t)qi * DIN + OFF_RG + h * 256 + 4 * g;
    bf16_t* yc = (bf16_t*)(ws + WS_YC) + ((size_t)b * SEQ + c * 128 + qi) * 1024 + h * 256 + 4 * g;
#pragma unroll
    for (int db = 0; db < 16; ++db) {
        const u32x2 gw = *(const u32x2*)(rgp + 16 * db);
        const float g0 = bflo(gw.x), g1 = bfhi(gw.x), g2 = bflo(gw.y), g3 = bfhi(gw.y);
        u32x2 o;
        o.x = pk2(g0 * sigm(g0) * (oacc[db][0] - mean) * rstd, g1 * sigm(g1) * (oacc[db][1] - mean) * rstd);
        o.y = pk2(g2 * sigm(g2) * (oacc[db][2] - mean) * rstd, g3 * sigm(g3) * (oacc[db][3] - mean) * rstd);
        *(u32x2*)(yc + 16 * db) = o;
    }
    __syncthreads();
}

struct EpiBranch {
    static constexpr bool PERM = false, AFTER_DRAIN = false;
    const bf16_t* gate; float* mf; bf16_t* mb; int mode;
    __device__ __forceinline__ void operator()(const f32x4 (&acc)[2][2][4][2], const pg8::Unit& u, int wr, int wc, int fr, int fq) const {
        const int row0 = u.pm * 256 + wr * 64 + fr, col0 = u.pn * 256 + wc * 32 + 4 * fq;
#pragma unroll
        for (int ai = 0; ai < 2; ++ai)
#pragma unroll
            for (int mh = 0; mh < 2; ++mh) {
                u32x2 gw[2][2][2]; f32x4 old[2][2][2];
#pragma unroll
                for (int mm = 0; mm < 2; ++mm) { const size_t row = (size_t)(row0 + ai * 128 + (2 * mh + mm) * 16);
#pragma unroll
                    for (int bj = 0; bj < 2; ++bj)
#pragma unroll
                        for (int n = 0; n < 2; ++n) { const int col = col0 + bj * 128 + n * 16;
                            gw[mm][bj][n] = *(const u32x2*)(gate + row * DIN + col);
                            old[mm][bj][n] = (mode != 0) ? *(const f32x4*)(mf + row * 1024 + col) : (f32x4){0.f, 0.f, 0.f, 0.f}; } }
#pragma unroll
                for (int mm = 0; mm < 2; ++mm) { const size_t row = (size_t)(row0 + ai * 128 + (2 * mh + mm) * 16);
#pragma unroll
                    for (int bj = 0; bj < 2; ++bj)
#pragma unroll
                        for (int n = 0; n < 2; ++n) { const int col = col0 + bj * 128 + n * 16;
                            const u32x2 g2 = gw[mm][bj][n];
                            f32x4 v = acc[ai][bj][2 * mh + mm][n];
                            v[0] = v[0] * sigm(bflo(g2.x)) + old[mm][bj][n][0]; v[1] = v[1] * sigm(bfhi(g2.x)) + old[mm][bj][n][1];
                            v[2] = v[2] * sigm(bflo(g2.y)) + old[mm][bj][n][2]; v[3] = v[3] * sigm(bfhi(g2.y)) + old[mm][bj][n][3];
                            if (mode != 2) *(f32x4*)(mf + row * 1024 + col) = v;
                            else { u32x2 o; o.x = pk2(v[0], v[1]); o.y = pk2(v[2], v[3]); *(u32x2*)(mb + row * 1024 + col) = o; } } }
            }
    }
};
#ifndef MK_EPI_AUX
#define MK_EPI_AUX 0
#endif
struct EpiInProj {
    static constexpr bool PERM = true, AFTER_DRAIN = false;
    bf16_t* O; int dry;
    __device__ __forceinline__ void operator()(const f32x4 (&acc)[2][2][4][2], const pg8::Unit& u, int wr_, int wc_, int fr_, int fq_) const {
        (void)wr_; (void)wc_; (void)fr_; (void)fq_;
        if (dry == 1) return;
        const int tid = mk_tid(), wid = tid >> 6, lane = tid & 63, wr = wid >> 2, wc = wid & 3, fr = lane & 15, fq = lane >> 4;
        const __amdgpu_buffer_rsrc_t rsrc = __builtin_amdgcn_make_buffer_rsrc((void*)O, 0, (int)((size_t)NTOK * DIN * 2), 0x00020000);
        const int row0 = u.pm * 256 + wr * 64 + fr;
        const int pn = u.pn;
        const bool ropeA = pn < 12, ropeR = (pn >= 26 && pn < 34);
        const float dsc = 1.0f / (X8_SCALE * W8_SCALE);
        if (!(ropeA || ropeR)) {
            const int col0 = pn * 256 + 64 * wc + 8 * fq;
#pragma unroll
            for (int ai = 0; ai < 2; ++ai) {
#pragma unroll
                for (int m = 0; m < 4; ++m) { const unsigned roff = (unsigned)(((size_t)(row0 + ai * 128 + m * 16) * DIN + col0) * 2);
#pragma unroll
                    for (int bj = 0; bj < 2; ++bj) { const f32x4 v0 = acc[ai][bj][m][0] * dsc, v1 = acc[ai][bj][m][1] * dsc;
                        u32x4 w; w.x = pk2(v0[0], v0[1]); w.y = pk2(v0[2], v0[3]); w.z = pk2(v1[0], v1[1]); w.w = pk2(v1[2], v1[3]);
                        if (dry == 2) { asm volatile("" :: "v"(w)); } else __builtin_amdgcn_raw_buffer_store_b128(w, rsrc, (int)(roff + bj * 64), 0, MK_EPI_AUX); } }
            }
        } else {
            const int half = ropeA ? 64 : 128;
            const float sc = (pn >= 30 && pn < 34) ? 0.0625f : 1.0f;
            const float kf = ropeA ? (-13.287712379549449f / 64.0f) : (-13.287712379549449f / 128.0f);
            const float pos0 = (float)(row0 & (SEQ - 1));
#pragma unroll
            for (int bj = 0; bj < 2; ++bj) {
                const int pc = 64 * wc + 32 * bj + 8 * fq;
                const int cbase = ropeA ? (pc & 128) : 0;
                const int q = ropeA ? ((pc & 127) >> 3) : (pc >> 3);
                f32x4 cb, sb, c16, s16, cb1, sb1;
#pragma unroll
                for (int e = 0; e < 4; ++e) {
                    const float f = __builtin_amdgcn_exp2f((float)(4 * q + e) * kf) * 0.15915494309189535f;
                    const float t0 = __builtin_amdgcn_fractf(pos0 * f), t16 = __builtin_amdgcn_fractf(16.0f * f), t128 = __builtin_amdgcn_fractf(128.0f * f);
                    cb[e] = __builtin_amdgcn_cosf(t0); sb[e] = __builtin_amdgcn_sinf(t0);
                    c16[e] = __builtin_amdgcn_cosf(t16); s16[e] = __builtin_amdgcn_sinf(t16);
                    const float c128 = __builtin_amdgcn_cosf(t128), s128 = __builtin_amdgcn_sinf(t128);
                    cb1[e] = cb[e] * c128 - sb[e] * s128; sb1[e] = sb[e] * c128 + cb[e] * s128;
                }
#pragma unroll
                for (int ai = 0; ai < 2; ++ai) {
                    f32x4 cv = ai ? cb1 : cb, sv = ai ? sb1 : sb;
#pragma unroll
                    for (int m = 0; m < 4; ++m) {
                        const int row = row0 + ai * 128 + m * 16;
                        const unsigned roff = (unsigned)(((size_t)row * DIN + pn * 256) * 2);
                        const float rsc = dsc * sc;
                        const f32x4 t1 = acc[ai][bj][m][0] * rsc, t2 = acc[ai][bj][m][1] * rsc;
                        const f32x4 o1 = t1 * cv - t2 * sv, o2 = t1 * sv + t2 * cv;
                        u32x2 w1, w2; w1.x = pk2(o1[0], o1[1]); w1.y = pk2(o1[2], o1[3]); w2.x = pk2(o2[0], o2[1]); w2.y = pk2(o2[2], o2[3]);
                        if (dry == 2) { asm volatile("" :: "v"(w1), "v"(w2)); }
                        else { __builtin_amdgcn_raw_buffer_store_b64(w1, rsrc, (int)(roff + (cbase + 4 * q) * 2), 0, MK_EPI_AUX); __builtin_amdgcn_raw_buffer_store_b64(w2, rsrc, (int)(roff + (cbase + half + 4 * q) * 2), 0, MK_EPI_AUX); }
                        if (m < 3) { const f32x4 cn = cv * c16 - sv * s16, sn = sv * c16 + cv * s16; cv = cn; sv = sn; }
                    }
                }
            }
        }
    }
};

struct EpiOut {
    static constexpr bool PERM = false, AFTER_DRAIN = false;
    const float* xf; float* z;
    __device__ __forceinline__ void operator()(const f32x4 (&acc)[2][2][4][2], const pg8::Unit& u, int wr, int wc, int fr, int fq) const {
        const int row0 = u.pm * 256 + wr * 64 + fr, col0 = u.pn * 256 + wc * 32 + 4 * fq;
#pragma unroll
        for (int ai = 0; ai < 2; ++ai)
#pragma unroll
            for (int mh = 0; mh < 2; ++mh) {
                f32x4 xv[2][2][2];
#pragma unroll
                for (int mm = 0; mm < 2; ++mm) { const size_t row = (size_t)(row0 + ai * 128 + (2 * mh + mm) * 16);
#pragma unroll
                    for (int bj = 0; bj < 2; ++bj)
#pragma unroll
                        for (int n = 0; n < 2; ++n) xv[mm][bj][n] = *(const f32x4*)(xf + row * 1024 + col0 + bj * 128 + n * 16); }
#pragma unroll
                for (int mm = 0; mm < 2; ++mm) { const size_t row = (size_t)(row0 + ai * 128 + (2 * mh + mm) * 16);
#pragma unroll
                    for (int bj = 0; bj < 2; ++bj)
#pragma unroll
                        for (int n = 0; n < 2; ++n) *(f32x4*)(z + row * 1024 + col0 + bj * 128 + n * 16) = xv[mm][bj][n] * ALPHA + acc[ai][bj][2 * mh + mm][n]; }
            }
    }
};

DI void ln_row(const float* z, const float* gam, const float* bet, float* of, bf16_t* ob, int lane) {
    f32x4 v[4]; float s = 0.f;
#pragma unroll
    for (int i = 0; i < 4; ++i) { v[i] = *(const f32x4*)(z + 256 * i + 4 * lane); s += (v[i][0] + v[i][1]) + (v[i][2] + v[i][3]); }
    const float mean = wsum(s) * (1.0f / 1024.0f);
    float q = 0.f;
#pragma unroll
    for (int i = 0; i < 4; ++i)
#pragma unroll
        for (int j = 0; j < 4; ++j) { const float d = v[i][j] - mean; q += d * d; }
    const float rstd = rsqrtf(wsum(q) * (1.0f / 1024.0f) + LN_EPS);
#pragma unroll
    for (int i = 0; i < 4; ++i) {
        const f32x4 gg = *(const f32x4*)(gam + 256 * i + 4 * lane), bb = *(const f32x4*)(bet + 256 * i + 4 * lane);
        f32x4 o;
#pragma unroll
        for (int j = 0; j < 4; ++j) o[j] = (v[i][j] - mean) * rstd * gg[j] + bb[j];
        *(f32x4*)(of + 256 * i + 4 * lane) = o;
        u32x2 pb; pb.x = pk2(o[0], o[1]); pb.y = pk2(o[2], o[3]); *(u32x2*)(ob + 256 * i + 4 * lane) = pb;
    }
}
DI void phase_ln1(const Args& a, int layer) {
    unsigned char* ws = a.ws;
    const int lane = mk_tid() & 63, w = mk_tid() >> 6;
    for (int u = blockIdx.x; u < NTOK / 8; u += gridDim.x) {
        const size_t row = (size_t)u * 8 + w;
        ln_row((const float*)(ws + WS_MRGF) + row * 1024, a.in[11] + layer * 1024, a.in[12] + layer * 1024, (float*)(ws + WS_XF) + row * 1024, (bf16_t*)(ws + WS_XB) + row * 1024, lane);
    }
}

DI void ins16(float (&L)[16], float x) {
#pragma unroll
    for (int k = 0; k < 16; ++k) { const float hi = fmaxf(L[k], x); x = fminf(L[k], x); L[k] = hi; }
}
DI void merge16(float (&L)[16], int xr) {
    float t[16];
#pragma unroll
    for (int k = 0; k < 16; ++k) t[k] = __shfl_xor(L[k], xr);
#pragma unroll
    for (int k = 0; k < 8; ++k) { const float x = t[k]; t[k] = t[15 - k]; t[15 - k] = x; }
#pragma unroll
    for (int k = 0; k < 16; ++k) t[k] = fmaxf(L[k], t[k]);
#define MK_CE_STAGE(dd) _Pragma("unroll") for (int k = 0; k < 16; ++k) if ((k & (dd)) == 0) { const float hi = fmaxf(t[k], t[k + (dd)]), lo = fminf(t[k], t[k + (dd)]); t[k] = hi; t[k + (dd)] = lo; }
    MK_CE_STAGE(8) MK_CE_STAGE(4) MK_CE_STAGE(2) MK_CE_STAGE(1)
#undef MK_CE_STAGE
#pragma unroll
    for (int k = 0; k < 16; ++k) L[k] = t[k];
}
DI float sel16(const float (&L)[16], unsigned idx) {
    float r = L[0];
#pragma unroll
    for (int k = 1; k < 16; ++k) r = (idx == (unsigned)k) ? L[k] : r;
    return r;
}
DI void top16_half(const bf16_t* qp, const bf16_t* kb, float (&L)[16], int g, int l15) {
    bf16x8 qf[4];
#pragma unroll
    for (int ks = 0; ks < 4; ++ks) qf[ks] = *(const bf16x8*)(qp + 32 * ks + 8 * g);
#pragma unroll
    for (int k = 0; k < 16; ++k) L[k] = -FLT_MAX;
#pragma unroll
    for (int kbk = 0; kbk < 8; ++kbk) {
        f32x4 acc = {0.f, 0.f, 0.f, 0.f};
#pragma unroll
        for (int ks = 0; ks < 4; ++ks) { const bf16x8 kf = *(const bf16x8*)(kb + (size_t)(16 * kbk + l15) * 128 + 32 * ks + 8 * g); acc = mfma16(kf, qf[ks], acc); }
#pragma unroll
        for (int rg = 0; rg < 4; ++rg) { const unsigned key = (unsigned)(16 * kbk + 4 * g + rg); ins16(L, __uint_as_float((__float_as_uint(acc[rg]) & ~0x7Fu) | key)); }
    }
    merge16(L, 16); merge16(L, 32);
}
DI void topk_unit(const Args& a, int unit, LAS unsigned char* lds) {
    unsigned char* ws = a.ws;
    const int tid = mk_tid(), lane = tid & 63, w = __builtin_amdgcn_readfirstlane(tid >> 6), g = lane >> 4, l15 = lane & 15;
    const int tg = w & 3, hs = w >> 2;
    const size_t t = (size_t)unit * 64 + tg * 16 + l15;
    const bf16_t* Q = (const bf16_t*)(ws + WS_Q);
    float K1[16], K2[16];
#pragma unroll
    for (int k = 0; k < 16; ++k) { K1[k] = 0.f; K2[k] = 0.f; }
#pragma unroll 1
    for (int hh = 0; hh < 4; ++hh) {
        const int h = hs * 4 + hh;
        float l1[16], l2[16];
        top16_half(Q + t * 2048 + h * 256, (const bf16_t*)(ws + WS_K1B) + (size_t)h * 16384, l1, g, l15);
        top16_half(Q + t * 2048 + h * 256 + 128, (const bf16_t*)(ws + WS_K2B) + (size_t)h * 16384, l2, g, l15);
        const bool mine = (g == hh);
#pragma unroll
        for (int k = 0; k < 16; ++k) { K1[k] = mine ? l1[k] : K1[k]; K2[k] = mine ? l2[k] : K2[k]; }
    }
    const int h = hs * 4 + g;
    float F[16];
#pragma unroll
    for (int k = 0; k < 16; ++k) F[k] = -FLT_MAX;
#pragma unroll
    for (int ia = 0; ia < 16; ++ia)
#pragma unroll
        for (int ib = 0; ib < 16 / (ia + 1); ++ib) {
            const float s = __uint_as_float(__float_as_uint(K1[ia]) & ~0x7Fu) + __uint_as_float(__float_as_uint(K2[ib]) & ~0x7Fu);
            ins16(F, __uint_as_float((__float_as_uint(s) & ~0xFFu) | (unsigned)(ia * 16 + ib)));
        }
    LAS int* row = (LAS int*)lds + tid * 33;
#pragma unroll
    for (int k = 0; k < 16; ++k) { row[k] = (int)(__float_as_uint(K1[k]) & 0x7Fu); row[16 + k] = (int)(__float_as_uint(K2[k]) & 0x7Fu); }
    float gt[16]; int ei[16]; float gs = 0.f;
    const float cv0 = __uint_as_float(__float_as_uint(F[0]) & ~0xFFu);
#pragma unroll
    for (int k = 0; k < 16; ++k) {
        const unsigned bits = __float_as_uint(F[k]);
        const float cv = __uint_as_float(bits & ~0xFFu);
        gt[k] = __builtin_amdgcn_exp2f((cv - cv0) * 1.4426950408889634f); gs += gt[k];
        const int ia = (int)((bits >> 4) & 15u), ib = (int)(bits & 15u);
        ei[k] = row[ia] * 128 + row[16 + ib];
    }
    const float ig = 1.0f / gs;
    int* ep = (int*)(ws + WS_EID) + (t * 8 + h) * 16; float* gp = (float*)(ws + WS_GATE) + (t * 8 + h) * 16;
#pragma unroll
    for (int q = 0; q < 4; ++q) {
        *(i32x4*)(ep + 4 * q) = (i32x4){ei[4 * q], ei[4 * q + 1], ei[4 * q + 2], ei[4 * q + 3]};
        *(f32x4*)(gp + 4 * q) = (f32x4){gt[4 * q] * ig, gt[4 * q + 1] * ig, gt[4 * q + 2] * ig, gt[4 * q + 3] * ig};
    }
}

typedef float f32x2 __attribute__((ext_vector_type(2)));
#define MK_PEER_LOAD1(j, ereg, kk) { const int e_ = __builtin_amdgcn_readlane(ereg, (kk)); \
        const unsigned char* p_ = UV + (size_t)(unsigned)e_ * 1536u; RA[j] = ((const u32x4*)p_)[lane]; RB[j] = ((const u32x2*)(p_ + 1024))[lane]; }
#define MK_PEER_COMP1(j, usreg, gvreg, kk) { \
        const float us_ = __uint_as_float(__builtin_amdgcn_readlane(__float_as_uint(usreg), (kk))), gv_ = __uint_as_float(__builtin_amdgcn_readlane(__float_as_uint(gvreg), (kk))); \
        const f32x32 r_ = __builtin_amdgcn_cvt_scalef32_pk32_f32_fp6((u32x6){RA[j][0], RA[j][1], RA[j][2], RA[j][3], RB[j][0], RB[j][1]}, 1.0f); \
        f32x2 p2_ = {0.f, 0.f}; \
        _Pragma("unroll") for (int q = 0; q < 8; ++q) p2_ += (f32x2){r_[2 * q], r_[2 * q + 1]} * x2[q]; \
        const float p_ = wsum_dpp(p2_.x + p2_.y) * us_; \
        const float act_ = gelu_as(p_) * gv_; const f32x2 a2_ = {act_, act_}; \
        _Pragma("unroll") for (int q = 0; q < 8; ++q) y2[q] += a2_ * (f32x2){r_[16 + 2 * q], r_[16 + 2 * q + 1]}; \
        __builtin_amdgcn_sched_barrier(0); }
DI void peer_token(const unsigned char* UV, int e0, int e1, float us0, float us1, float gv0, float gv1, const f32x2 (&x2)[8], f32x2 (&y2)[8], int lane) {
    u32x4 RA[8]; u32x2 RB[8];
#pragma unroll
    for (int j = 0; j < 8; ++j) MK_PEER_LOAD1(j, e0, j)
#pragma unroll 1
    for (int k = 0; k < 56; k += 8) {
#pragma unroll
        for (int j = 0; j < 8; ++j) { MK_PEER_COMP1(j, us0, gv0, k + j) MK_PEER_LOAD1(j, e0, k + 8 + j) }
    }
#pragma unroll
    for (int j = 0; j < 8; ++j) { MK_PEER_COMP1(j, us0, gv0, 56 + j) MK_PEER_LOAD1(j, e1, j) }
#pragma unroll 1
    for (int k = 0; k < 56; k += 8) {
#pragma unroll
        for (int j = 0; j < 8; ++j) { MK_PEER_COMP1(j, us1, gv1, k + j) MK_PEER_LOAD1(j, e1, k + 8 + j) }
    }
#pragma unroll
    for (int j = 0; j < 8; ++j) { MK_PEER_COMP1(j, us1, gv1, 56 + j) }
}
DI void peer_unit(const Args& a, int layer, int unit, bool dry) {
    unsigned char* ws = a.ws;
    const int tid = mk_tid(), lane = tid & 63, w = __builtin_amdgcn_readfirstlane(tid >> 6);
    const unsigned char* UV = ws + WS_UV8; const float* SC = (const float*)(ws + WS_UVS);
#pragma unroll 1
    for (int i = 0; i < 8; ++i) {
        const size_t t = (size_t)unit * 64 + w * 8 + i;
        f32x2 x2[8], y2[8];
        int e0, e1; float us0, us1, gv0, gv1;
        {
            const int ln = mk_tid() & 63;
            const bf16_t* xbp = (const bf16_t*)(ws + WS_XB) + t * 1024 + 16 * ln;
            const u32x4 xa = *(const u32x4*)xbp, xb = *(const u32x4*)(xbp + 8);
#pragma unroll
            for (int q = 0; q < 4; ++q) { x2[q] = (f32x2){bflo(xa[q]), bfhi(xa[q])}; x2[4 + q] = (f32x2){bflo(xb[q]), bfhi(xb[q])}; }
            const int* ep = (const int*)(ws + WS_EID) + t * 128; const float* gp = (const float*)(ws + WS_GATE) + t * 128;
            e0 = ep[ln]; e1 = ep[64 + ln]; const float g0 = gp[ln], g1 = gp[64 + ln];
            const f32x2 s0 = *(const f32x2*)(SC + 2 * e0), s1 = *(const f32x2*)(SC + 2 * e1);
            us0 = s0.x; us1 = s1.x; gv0 = g0 * s0.y; gv1 = g1 * s1.y;
        }
#pragma unroll
        for (int q = 0; q < 8; ++q) y2[q] = (f32x2){0.f, 0.f};
        peer_token(UV, e0, e1, us0, us1, gv0, gv1, x2, y2, lane);
        {
            const int ln = mk_tid() & 63;
            float* xfp = (float*)(ws + WS_XF) + t * 1024 + 16 * ln;
            float* xfo = dry ? (float*)(ws + WS_MRGF) + t * 1024 + 16 * ln : xfp;
            const float* gam = a.in[18] + layer * 1024 + 16 * ln; const float* bet = a.in[19] + layer * 1024 + 16 * ln;
            float z[16]; float s = 0.f;
#pragma unroll
            for (int q = 0; q < 4; ++q) { const f32x4 xr = *(const f32x4*)(xfp + 4 * q);
#pragma unroll
                for (int j = 0; j < 4; ++j) { z[4 * q + j] = ALPHA * xr[j] + y2[2 * q + (j >> 1)][j & 1]; s += z[4 * q + j]; } }
            const float mean = wsum(s) * (1.0f / 1024.0f);
            float qq = 0.f;
#pragma unroll
            for (int q = 0; q < 16; ++q) { const float d = z[q] - mean; qq += d * d; }
            const float rstd = rsqrtf(wsum(qq) * (1.0f / 1024.0f) + LN_EPS);
            f32x4 o[4];
#pragma unroll
            for (int q = 0; q < 4; ++q) { const f32x4 gq = *(const f32x4*)(gam + 4 * q), bq = *(const f32x4*)(bet + 4 * q);
#pragma unroll
                for (int j = 0; j < 4; ++j) o[q][j] = (z[4 * q + j] - mean) * rstd * gq[j] + bq[j]; }
#pragma unroll
            for (int q = 0; q < 4; ++q) *(f32x4*)(xfo + 4 * q) = o[q];
            if (layer == DEPTH - 1 && !dry) { float* op = a.out + t * 1024 + 16 * ln;
#pragma unroll
                for (int q = 0; q < 4; ++q) *(f32x4*)(op + 4 * q) = o[q]; }
            if (!dry) row_to_fp8(o, ws + WS_X8 + t * 1024, ln);
        }
    }
}
}

namespace mk {
constexpr int LDS_ARG_OFF = LDS_BYTES - 16 - 256;
#define MK_NOINL __device__ __forceinline__
DI unsigned long long rfl64(unsigned long long v) { const unsigned lo = __builtin_amdgcn_readfirstlane((unsigned)v), hi = __builtin_amdgcn_readfirstlane((unsigned)(v >> 32)); return ((unsigned long long)hi << 32) | lo; }
DI Args load_args(LAS unsigned char* lds) {
    int aoff = LDS_ARG_OFF; asm volatile("" : "+s"(aoff));
    Args a; const LAS unsigned long long* p = (const LAS unsigned long long*)(lds + aoff);
#pragma unroll
    for (int i = 0; i < 20; ++i) a.in[i] = (const float*)(const __attribute__((address_space(1))) float*)rfl64(p[i]);
    a.out = (float*)(__attribute__((address_space(1))) float*)rfl64(p[20]); a.ws = (unsigned char*)(__attribute__((address_space(1))) unsigned char*)rfl64(p[21]);
    a.ropeA = __longlong_as_double((long long)rfl64(p[22])); a.ropeR = __longlong_as_double((long long)rfl64(p[23])); a.ph_lo = 0; a.ph_hi = 0;
    return a;
}
#define MK_LOADARGS const Args a = load_args(lds); unsigned char* ws = a.ws; const int G = (int)gridDim.x, bid = (int)blockIdx.x; (void)ws; (void)G; (void)bid
MK_NOINL void PG_prologue(LAS unsigned char* lds) { MK_LOADARGS; phase_prologue(a); }
MK_NOINL void P0_conv(LAS unsigned char* lds, int layer) { MK_LOADARGS; phase_conv(a, layer, lds); }
MK_NOINL void P1_inproj(LAS unsigned char* lds, int layer, int dry) { MK_LOADARGS; (void)layer;
    pg8::Gemm gm; gm.A = (const bf16_t*)(ws + WS_X8); gm.Bt = (const bf16_t*)(ws + WS_WINT); gm.M = NTOK; gm.N = DIN; gm.K = 512;
    pg8::StaticOrder S; S.init(NTOK, DIN, G, bid);
    EpiInProj E; E.O = (bf16_t*)(ws + WS_PROJ); E.dry = dry;
    pg8::gemm_phase<EpiInProj, pg8::StaticOrder, false, true, true>(lds, gm, S, E, nullptr); }
MK_NOINL void P2_rope(LAS unsigned char* lds, int layer) { MK_LOADARGS; (void)layer; phase_rope(a); }
#ifndef MK_NLRU
#define MK_NLRU 64
#endif
MK_NOINL void P3s_lru(LAS unsigned char* lds, int layer) { MK_LOADARGS; if (bid < MK_NLRU) { for (int s = bid; s < 64; s += MK_NLRU) lru_stripe(a, layer, s, lds); } }
MK_NOINL void P3a_attn(LAS unsigned char* lds, int layer) { MK_LOADARGS; (void)layer; if (bid >= MK_NLRU) { for (int u = bid - MK_NLRU; u < 1536; u += G - MK_NLRU) attn_unit(a, u, lds); } }
MK_NOINL void P3b_retkv(LAS unsigned char* lds, int layer) { MK_LOADARGS; (void)layer; if (bid >= MK_NLRU) { for (int u = bid - MK_NLRU; u < 512; u += G - MK_NLRU) retkv_unit(a, u, lds); } }
MK_NOINL void P3c_lru(LAS unsigned char* lds, int layer, int fin) { MK_LOADARGS; for (int u = bid; u < 2048; u += G) lru_unit(a, layer, u, fin != 0, lds); }
MK_NOINL void P4a_scan(LAS unsigned char* lds, int layer) { MK_LOADARGS; (void)layer; for (int u = bid; u < 256; u += G) retscan_unit(a, u); }
MK_NOINL void P4c_merge(LAS unsigned char* lds, int layer) { MK_LOADARGS; (void)layer; for (int u = bid; u < 2048; u += G) attmerge_unit(a, u); }
MK_NOINL void P5_retout(LAS unsigned char* lds, int layer) { MK_LOADARGS; (void)layer; for (int u = bid; u < 512; u += G) retout_unit(a, u, lds); }
MK_NOINL void P6_branch(LAS unsigned char* lds, int layer) { MK_LOADARGS; (void)layer;
#pragma unroll 1
    for (int s = 0; s < 3; ++s) {
        pg8::Gemm gm; gm.A = (const bf16_t*)(ws + (s == 0 ? WS_YA : (s == 1 ? WS_YB : WS_YC))); gm.Bt = (const bf16_t*)(ws + (s == 0 ? WS_WBAT : (s == 1 ? WS_WBBT : WS_WBCT)));
        gm.M = NTOK; gm.N = 1024; gm.K = (s == 0) ? 512 : 1024;
        pg8::StaticOrder S; S.init(NTOK, 1024, G, bid);
        EpiBranch E; E.gate = (const bf16_t*)(ws + WS_PROJ) + OFF_GA + 1024 * s; E.mf = (float*)(ws + WS_MRGF); E.mb = (bf16_t*)(ws + WS_MRGB); E.mode = s;
        pg8::gemm_phase<EpiBranch, pg8::StaticOrder, false>(lds, gm, S, E, nullptr);
    } }
MK_NOINL void P7_outproj(LAS unsigned char* lds, int layer) { MK_LOADARGS; (void)layer;
    pg8::Gemm gm; gm.A = (const bf16_t*)(ws + WS_MRGB); gm.Bt = (const bf16_t*)(ws + WS_WOT); gm.M = NTOK; gm.N = 1024; gm.K = 1024;
    pg8::StaticOrder S; S.init(NTOK, 1024, G, bid);
    EpiOut E; E.xf = (const float*)(ws + WS_XF); E.z = (float*)(ws + WS_MRGF);
    pg8::gemm_phase<EpiOut, pg8::StaticOrder, false>(lds, gm, S, E, nullptr); }
MK_NOINL void P8_ln1(LAS unsigned char* lds, int layer) { MK_LOADARGS; phase_ln1(a, layer); }
MK_NOINL void P9_wq(LAS unsigned char* lds, int layer) { MK_LOADARGS; (void)layer;
    pg8::Gemm gm; gm.A = (const bf16_t*)(ws + WS_XB); gm.Bt = (const bf16_t*)(ws + WS_WQT); gm.M = NTOK; gm.N = 2048; gm.K = 1024;
    pg8::StaticOrder S; S.init(NTOK, 2048, G, bid);
    pg8::EpiBf16<0> E; E.O = (bf16_t*)(ws + WS_Q); E.ldc = 2048; E.bias = nullptr; E.split_cols = 0; E.split_stride = 0;
    pg8::gemm_phase<pg8::EpiBf16<0>, pg8::StaticOrder, false>(lds, gm, S, E, nullptr); }
MK_NOINL void P10_topk(LAS unsigned char* lds, int layer) { MK_LOADARGS; (void)layer; for (int u = bid; u < NTOK / 64; u += G) topk_unit(a, u, lds); }
MK_NOINL void P11_peer(LAS unsigned char* lds, int layer, int dry) { MK_LOADARGS; for (int u = bid; u < NTOK / 64; u += G) peer_unit(a, layer, u, dry != 0); }
DI void mk_sync(LAS unsigned char* lds) {
    const Args a = load_args(lds);
    XcdBarrier b; b.bar = (unsigned*)(a.ws + WS_CTL); b.x = xb_xcc_id(); b.st = (volatile LAS unsigned*)(lds + LDS_BAR_OFF);
    xcd_barrier(b);
}
}

#ifndef MK_PHASE_MASK
#define MK_PHASE_MASK 0xFFFu
#endif
#define MK_RUN(k) ((((MK_PHASE_MASK) >> ((k) - pb)) & 1u) && (k) >= ph_lo && (k) < ph_hi)
#define MK_NPHASES (1 + mk::DEPTH * mk::NPH)
#ifndef MK_REP_MASK
#define MK_REP_MASK 0u
#endif
#define MK_REPS(bit) for (int rep_ = 0; rep_ < ((((MK_REP_MASK) >> (bit)) & 1u) ? 2 : 1); ++rep_)
#define MK_SYNC(k) do { if ((k) >= ph_lo && (k) + 1 < ph_hi) { mk::mk_sync(lds); if ((MK_REP_MASK >> 15) & 1u) mk::mk_sync(lds); } } while (0)
__global__ __launch_bounds__(512, 2) void mk_fwd(mk::Args a) {
    using namespace mk;
    extern __shared__ __attribute__((aligned(16))) unsigned char smem_raw[];
    LAS unsigned char* lds = (LAS unsigned char*)smem_raw;
    const int ph_lo = a.ph_lo, ph_hi = a.ph_hi;
    {
        const unsigned* src = (const unsigned*)&a;
        if (threadIdx.x < sizeof(Args) / 4) ((LAS unsigned*)(lds + LDS_ARG_OFF))[threadIdx.x] = src[threadIdx.x];
        if (threadIdx.x == 0) { LAS unsigned* st = (LAS unsigned*)(lds + LDS_BAR_OFF); st[0] = 0u; st[1] = 0u; st[2] = 0u; st[3] = 0u; }
    }
    __syncthreads();
    if (ph_hi - ph_lo > 1) (void)xcd_barrier_post((unsigned*)(a.ws + WS_CTL), (volatile LAS unsigned*)(lds + LDS_BAR_OFF));
    if (0 >= ph_lo && 0 < ph_hi) PG_prologue(lds);
    MK_SYNC(0);
#pragma unroll 1
    for (int layer = 0; layer < DEPTH; ++layer) {
        const int pb = 1 + layer * NPH;
        if (MK_RUN(pb + 0)) MK_REPS(0) P0_conv(lds, layer);
        MK_SYNC(pb + 0);
        if (MK_RUN(pb + 1)) { if ((MK_REP_MASK >> 14) & 1u) P1_inproj(lds, layer, 1); if ((MK_REP_MASK >> 16) & 1u) P1_inproj(lds, layer, 2); MK_REPS(1) P1_inproj(lds, layer, 0); }
        MK_SYNC(pb + 1);
        if (MK_RUN(pb + 3)) { MK_REPS(13) P3s_lru(lds, layer); MK_REPS(3) P3a_attn(lds, layer); MK_REPS(12) P3b_retkv(lds, layer); }
        MK_SYNC(pb + 3);
        if (MK_RUN(pb + 4)) { P4a_scan(lds, layer); MK_REPS(4) { P4c_merge(lds, layer); } }
        MK_SYNC(pb + 4);
        if (MK_RUN(pb + 5)) MK_REPS(5) P5_retout(lds, layer);
        MK_SYNC(pb + 5);
        if (MK_RUN(pb + 6)) MK_REPS(6) P6_branch(lds, layer);
        MK_SYNC(pb + 6);
        if (MK_RUN(pb + 7)) MK_REPS(7) P7_outproj(lds, layer);
        MK_SYNC(pb + 7);
        if (MK_RUN(pb + 8)) MK_REPS(8) P8_ln1(lds, layer);
        MK_SYNC(pb + 8);
        if (MK_RUN(pb + 9)) MK_REPS(9) P9_wq(lds, layer);
        MK_SYNC(pb + 9);
        if (MK_RUN(pb + 10)) MK_REPS(10) P10_topk(lds, layer);
        MK_SYNC(pb + 10);
        if (MK_RUN(pb + 11)) { if ((MK_REP_MASK >> 11) & 1u) P11_peer(lds, layer, 1); P11_peer(lds, layer, 0); }
        MK_SYNC(pb + 11);
    }
}

#ifndef MK_SINGLE
#define MK_SINGLE 1
#endif
extern "C" void kernel_launch(void* const* d_in, const int* in_sizes, int n_in, void* d_out, int out_size, void* d_ws, size_t ws_size, hipStream_t stream) {
    using namespace mk;
    static int grid = 0;
    if (grid == 0) {
        if (n_in != 20 || out_size != NTOK * D || ws_size < WS_END) { fprintf(stderr, "kernel_launch: unexpected shapes (n_in %d, out %d, ws %zu, need %zu)\n", n_in, out_size, ws_size, (size_t)WS_END); grid = -1; return; }
        int dev = 0, cus = 0, per_cu = 0;
        if (hipGetDevice(&dev) != hipSuccess || hipDeviceGetAttribute(&cus, hipDeviceAttributeMultiprocessorCount, dev) != hipSuccess) { grid = -1; return; }
        if (hipFuncSetAttribute((const void*)mk_fwd, hipFuncAttributeMaxDynamicSharedMemorySize, LDS_BYTES) != hipSuccess) { fprintf(stderr, "kernel_launch: hipFuncSetAttribute failed\n"); grid = -1; return; }
        if (hipOccupancyMaxActiveBlocksPerMultiprocessor(&per_cu, (const void*)mk_fwd, 512, LDS_BYTES) != hipSuccess || per_cu < 1) { fprintf(stderr, "kernel_launch: occupancy query says %d blocks per CU\n", per_cu); (void)hipGetLastError(); grid = -1; return; }
        grid = cus;
    }
    if (grid < 0) return;
    (void)in_sizes;
    Args a{};
    for (int i = 0; i < 20; ++i) a.in[i] = (const float*)d_in[i];
    a.out = (float*)d_out; a.ws = (unsigned char*)d_ws;
    a.ropeA = pow(10000.0, -2.0 / 128.0); a.ropeR = pow(10000.0, -2.0 / 256.0);
#if MK_SINGLE
    (void)hipMemsetAsync((unsigned char*)d_ws + WS_CTL, 0, 16384, stream);
    a.ph_lo = 0; a.ph_hi = MK_NPHASES;
    hipLaunchKernelGGL(mk_fwd, dim3(grid), dim3(512), LDS_BYTES, stream, a);
#else
    for (int p = 0; p < MK_NPHASES; ++p) { a.ph_lo = p; a.ph_hi = p + 1; hipLaunchKernelGGL(mk_fwd, dim3(grid), dim3(512), LDS_BYTES, stream, a); }
#endif
}
```

```cpp
#include <hip/hip_runtime.h>
#include <cstdio>
#include <cstdint>
#include <cmath>
#include <cfloat>
__device__ __forceinline__ int mk_tid() { int t = (int)threadIdx.x; asm volatile("" : "+v"(t)); return t; }
namespace pg8 {
#define PG8_LAS __attribute__((address_space(3)))
typedef unsigned short bf16_t;
typedef short bf16x8 __attribute__((ext_vector_type(8)));
typedef float f32x4 __attribute__((ext_vector_type(4)));
typedef unsigned u32x4 __attribute__((ext_vector_type(4)));
constexpr int BM = 256, BK = 64, HALF = 128, HTB = HALF * BK * 2  , STAGE_BYTES = 8 * HTB, NXCD = 8, WGM = 8;

__host__ __device__ __forceinline__ int lds_byte(int r, int c) { const int st = (r >> 4) * 2 + (c >> 5), rr = r & 15, cc = c & 31, ob = rr * 64 + cc * 2; return st * 1024 + (ob ^ (((ob >> 9) & 1) << 5)); }
__host__ __device__ __forceinline__ void stage_rc(int b, int& R, int& C) { const int st = b / 1024, sb = b % 1024, swz = sb ^ (((sb >> 9) & 1) << 5); R = (st >> 1) * 16 + swz / 64; C = (st & 1) * 32 + (swz % 64) / 2; }
__host__ __device__ __forceinline__ int perm32(int rho) { const int n = rho >> 4, i = rho & 15; return 8 * (i >> 2) + 4 * n + (i & 3); }

struct Unit { int pm, pn; };
struct Gemm { const bf16_t* A; const bf16_t* Bt; int M, N, K; };

struct StaticOrder {
    int nM, nN, nwg, G, c;
    __host__ __device__ void init(int M, int N, int G_, int c_) { nM = M / BM; nN = N / BM; nwg = nM * nN; G = G_; c = c_; }
    __host__ __device__ bool next(int i, Unit& u) const {
        const long L = (long)i * G + c; if (L >= nwg) return false;
        int wgid = (int)L; { const int q = nwg / NXCD, r = nwg % NXCD, xcd = wgid % NXCD, off = wgid / NXCD; wgid = (xcd < r ? xcd * (q + 1) : r * (q + 1) + (xcd - r) * q) + off; }
        const int nig = WGM * nN, gid = wgid / nig, fm = gid * WGM, gsz = (nM - fm) < WGM ? (nM - fm) : WGM;
        u.pm = fm + ((wgid % nig) % gsz); u.pn = (wgid % nig) / gsz; return true;
    }
    __device__ __forceinline__ void a_ready(const Unit&) const {}
    __device__ __forceinline__ void done(const Unit&) const {}
};
typedef __bf16 pg8_bf16x2 __attribute__((ext_vector_type(2)));
__device__ __forceinline__ unsigned cvt_pk_bf16(float lo, float hi) { const pg8_bf16x2 v = {(__bf16)lo, (__bf16)hi}; return __builtin_bit_cast(unsigned, v); }
typedef float f32x2 __attribute__((ext_vector_type(2)));
__device__ __forceinline__ f32x2 gelu_pk(f32x2 v) {
    const f32x2 av = __builtin_elementwise_abs(v), d = av * 0.2316418882f + 1.0f;
    f32x2 t; t.x = __builtin_amdgcn_rcpf(d.x); t.y = __builtin_amdgcn_rcpf(d.y);
    f32x2 q = t * 0.5307027145f + (-0.7265760135f); q = q * t + 0.7107068705f; q = q * t + (-0.142248368f); q = q * t + 0.127414796f; q = q * t;
    const f32x2 s = (v * v) * (-0.72134752044f);
    f32x2 e; e.x = __builtin_amdgcn_exp2f(s.x); e.y = __builtin_amdgcn_exp2f(s.y);
    const f32x2 m = v * (q * e), r = v - m;
    f32x2 o; o.x = v.x < 0.f ? m.x : r.x; o.y = v.y < 0.f ? m.y : r.y; return o;
}

struct EpiF32 {
    static constexpr bool PERM = false, AFTER_DRAIN = false;
    float* C; int ldc; const float* bias;
    __device__ __forceinline__ void operator()(const f32x4 (&acc)[2][2][4][2], const Unit& u, int wr, int wc, int fr, int fq) const {
        const int row0 = u.pm * BM + wr * 64 + fr, col0 = u.pn * BM + wc * 32 + 4 * fq;
        f32x4 bv[2][2];
#pragma unroll
        for (int bj = 0; bj < 2; ++bj)
#pragma unroll
            for (int n = 0; n < 2; ++n) bv[bj][n] = bias ? *(const f32x4*)(bias + col0 + bj * HALF + n * 16) : (f32x4){0.f, 0.f, 0.f, 0.f};
#pragma unroll
        for (int ai = 0; ai < 2; ++ai)
#pragma unroll
            for (int m = 0; m < 4; ++m) { float* rowp = C + (size_t)(row0 + ai * HALF + m * 16) * ldc + col0;
#pragma unroll
                for (int bj = 0; bj < 2; ++bj)
#pragma unroll
                    for (int n = 0; n < 2; ++n) *(f32x4*)(rowp + bj * HALF + n * 16) = acc[ai][bj][m][n] + bv[bj][n]; }
    }
};
template <int ACT  > struct EpiBf16 {
    static constexpr bool PERM = true, AFTER_DRAIN = false;
    bf16_t* O; int ldc; const float* bias; int split_cols; size_t split_stride;
    __device__ __forceinline__ void operator()(const f32x4 (&acc)[2][2][4][2], const Unit& u, int wr, int wc, int fr, int fq) const {
        const int row0 = u.pm * BM + wr * 64 + fr; int colt = u.pn * BM; bf16_t* base = O;
        if (split_cols) { const int t = colt / split_cols; base += (size_t)t * split_stride; colt -= t * split_cols; }
        const int col0 = colt + wc * 32 + 8 * fq, bcol0 = u.pn * BM + wc * 32 + 8 * fq;
        f32x4 bv[2][2];
#pragma unroll
        for (int bj = 0; bj < 2; ++bj)
#pragma unroll
            for (int n = 0; n < 2; ++n) bv[bj][n] = bias ? *(const f32x4*)(bias + bcol0 + bj * HALF + 4 * n) : (f32x4){0.f, 0.f, 0.f, 0.f};
#pragma unroll
        for (int ai = 0; ai < 2; ++ai)
#pragma unroll
            for (int m = 0; m < 4; ++m) { bf16_t* rowp = base + (size_t)(row0 + ai * HALF + m * 16) * ldc + col0;
#pragma unroll
                for (int bj = 0; bj < 2; ++bj) { f32x4 v0 = acc[ai][bj][m][0] + bv[bj][0], v1 = acc[ai][bj][m][1] + bv[bj][1];
                    if (ACT == 1) { f32x2 a = gelu_pk((f32x2){v0[0], v0[1]}), b = gelu_pk((f32x2){v0[2], v0[3]}), c = gelu_pk((f32x2){v1[0], v1[1]}), d = gelu_pk((f32x2){v1[2], v1[3]});
                        v0 = (f32x4){a.x, a.y, b.x, b.y}; v1 = (f32x4){c.x, c.y, d.x, d.y}; }
                    if (ACT == 2) {
#pragma unroll
                        for (int j = 0; j < 4; ++j) { v0[j] = 0.5f * v0[j] * (1.0f + erff(v0[j] * 0.70710678f)); v1[j] = 0.5f * v1[j] * (1.0f + erff(v1[j] * 0.70710678f)); } }
                    u32x4 w; w.x = cvt_pk_bf16(v0[0], v0[1]); w.y = cvt_pk_bf16(v0[2], v0[3]); w.z = cvt_pk_bf16(v1[0], v1[1]); w.w = cvt_pk_bf16(v1[2], v1[3]);
                    *(u32x4*)(rowp + bj * HALF) = w; } }
    }
};

typedef int i32x8 __attribute__((ext_vector_type(8)));
typedef short s16x16 __attribute__((ext_vector_type(16)));
__device__ __forceinline__ i32x8 pg8_cat16(bf16x8 a, bf16x8 b) { return __builtin_bit_cast(i32x8, (s16x16)__builtin_shufflevector(a, b, 0, 1, 2, 3, 4, 5, 6, 7, 8, 9, 10, 11, 12, 13, 14, 15)); }
template <class Epi, class Sched, bool STAMP = false, bool F8 = false, bool WIDE = false>
__device__ __forceinline__ void gemm_phase(PG8_LAS unsigned char* lds, const Gemm g, const Sched& S, const Epi& E, unsigned long long* stamps) {
    const int tid = mk_tid(), wid = __builtin_amdgcn_readfirstlane(tid >> 6), lane = tid & 63, wr = wid >> 2, wc = wid & 3, fr = lane & 15, fq = lane >> 4;
    const int K = g.K, nt = K / BK;
    int ts_lo = 0, ts_hi = 0, nts = 0; const unsigned long long rt_entry = STAMP ? (unsigned long long)wall_clock64() : 0ull;
#define PG8_STAMP() do { if (STAMP && wid == 0 && nts < 64) { const unsigned long long _c = (unsigned long long)clock64(); \
        ts_lo = (lane == nts) ? (int)(unsigned)_c : ts_lo; ts_hi = (lane == nts) ? (int)(unsigned)(_c >> 32) : ts_hi; ++nts; } } while (0)
    PG8_STAMP();
    unsigned voffA, voffB;
    { int R, C; stage_rc(tid * 16, R, C); const int Ri = Epi::PERM ? perm32(R & 31) : (R & 31); const int Rb = WIDE ? (((R >> 5) << 6) + Ri) : ((R & ~31) + Ri);
        voffA = (unsigned)(R * K + C) * 2u; voffB = (unsigned)(Rb * K + C) * 2u; }
    const size_t qstep = (size_t)64 * K * 2;
    const size_t qstepB = WIDE ? (size_t)128 * K * 2 : qstep;
    const size_t hstepB = WIDE ? (size_t)32 * K * 2 : (size_t)HALF * K * 2;
    const size_t kstep = (size_t)(BK * 2);
    const size_t hstep = (size_t)HALF * K * 2;
    const size_t tstep = 2 * hstep;
    const unsigned ldsw = (unsigned)wid * 1024u;
    const int aoff = lds_byte(wr * 64 + fr, fq * 8), boff = lds_byte(wc * 32 + fr, fq * 8);
#define PG8_SA(b, h) (((b) * 2 + (h)) * HTB)
#define PG8_SB(b, h) ((4 + (b) * 2 + (h)) * HTB)
#define PG8_STAGE(bufoff, gbase, voff) PG8_STAGEQ(bufoff, gbase, voff, qstep)
#define PG8_STAGEB(bufoff, gbase, voff) PG8_STAGEQ(bufoff, gbase, voff, qstepB)
#define PG8_STAGEQ(bufoff, gbase, voff, qs) do { const char* _g0 = (const char*)(gbase); const char* _g1 = _g0 + (qs); asm volatile("" : "+s"(_g0), "+s"(_g1));   \
        __builtin_amdgcn_global_load_lds((const unsigned*)(_g0 + (voff)), (PG8_LAS unsigned*)(lds + (bufoff) + ldsw), 16, 0, 0); \
        __builtin_amdgcn_global_load_lds((const unsigned*)(_g1 + (voff)), (PG8_LAS unsigned*)(lds + (bufoff) + ldsw + 8192), 16, 0, 0); } while (0)
#define PG8_LDA(dst, b, h) do { _Pragma("unroll") for (int m = 0; m < 4; ++m) _Pragma("unroll") for (int k = 0; k < 2; ++k) dst[m][k] = *(const PG8_LAS bf16x8*)(lds + PG8_SA(b, h) + aoff + m * 2048 + k * 1024); } while (0)
#define PG8_LDB(dst, b, h) do { _Pragma("unroll") for (int n = 0; n < 2; ++n) _Pragma("unroll") for (int k = 0; k < 2; ++k) dst[n][k] = *(const PG8_LAS bf16x8*)(lds + PG8_SB(b, h) + boff + n * 2048 + k * 1024); } while (0)
#define PG8_MMA(ai, bj, At, Bt) do { __builtin_amdgcn_s_setprio(1); _Pragma("unroll") for (int m = 0; m < 4; ++m) _Pragma("unroll") for (int n = 0; n < 2; ++n) { \
        if constexpr (F8) acc[ai][bj][m][n] = __builtin_amdgcn_mfma_scale_f32_16x16x128_f8f6f4(pg8_cat16(Bt[n][0], Bt[n][1]), pg8_cat16(At[m][0], At[m][1]), acc[ai][bj][m][n], 0, 0, 0, 0, 0, 0); \
        else { _Pragma("unroll") for (int k = 0; k < 2; ++k) acc[ai][bj][m][n] = __builtin_amdgcn_mfma_f32_16x16x32_bf16(Bt[n][k], At[m][k], acc[ai][bj][m][n], 0, 0, 0); } } \
        __builtin_amdgcn_s_setprio(0); } while (0)
#define PG8_WAIT_V(n) asm volatile("s_waitcnt vmcnt(" #n ")" ::: "memory")
#define PG8_WAIT_L(n) asm volatile("s_waitcnt lgkmcnt(" #n ")" ::: "memory")
#define PG8_BAR __builtin_amdgcn_s_barrier()
#define PG8_SCHED __builtin_amdgcn_sched_barrier(0)
    Unit cur, nxt; int ui = 0;
    if (!S.next(0, cur)) return;
    f32x4 acc[2][2][4][2];
    bf16x8 At[4][2], B0[2][2], B1[2][2];
    const char* cA = (const char*)g.A + (size_t)cur.pm * tstep; const char* cB = (const char*)g.Bt + (size_t)cur.pn * tstep;
    S.a_ready(cur);
    PG8_STAGEB(PG8_SB(0, 0), cB, voffB); PG8_STAGE(PG8_SA(0, 0), cA, voffA); PG8_STAGEB(PG8_SB(0, 1), cB + hstepB, voffB); PG8_STAGE(PG8_SA(0, 1), cA + hstep, voffA);
    if (wr == 1) PG8_BAR;
    PG8_WAIT_V(4); PG8_BAR;
    PG8_STAGEB(PG8_SB(1, 0), cB + kstep, voffB); PG8_STAGE(PG8_SA(1, 0), cA + kstep, voffA); PG8_STAGEB(PG8_SB(1, 1), cB + hstepB + kstep, voffB);
    PG8_WAIT_V(6); PG8_BAR;
    PG8_STAMP();
#pragma unroll
    for (int a = 0; a < 2; ++a)
#pragma unroll
        for (int b = 0; b < 2; ++b)
#pragma unroll
            for (int m = 0; m < 4; ++m)
#pragma unroll
                for (int n = 0; n < 2; ++n) acc[a][b][m][n] = (f32x4){0.f, 0.f, 0.f, 0.f};
    for (;;) {
        const bool has_next = S.next(ui + 1, nxt);
        const char* nA = has_next ? (const char*)g.A + (size_t)nxt.pm * tstep : cA; const char* nB = has_next ? (const char*)g.Bt + (size_t)nxt.pn * tstep : cB;
        for (int t = 0; t < nt; t += 2) {
            const bool last = (t == nt - 2);
            const char* a1 = cA + (size_t)(t + 1) * kstep;
            const char* a2 = last ? nA : cA + (size_t)(t + 2) * kstep; const char* b2 = last ? nB : cB + (size_t)(t + 2) * kstep;
            const char* a3 = a2 + kstep; const char* b3 = b2 + kstep;
            if (last && has_next) S.a_ready(nxt);
            PG8_LDB(B0, 0, 0); PG8_SCHED; PG8_LDA(At, 0, 0); PG8_STAGE(PG8_SA(1, 1), a1 + hstep, voffA);
            PG8_WAIT_L(8); PG8_BAR; PG8_WAIT_L(0); PG8_MMA(0, 0, At, B0); PG8_BAR; PG8_SCHED;
            PG8_LDB(B1, 0, 1); PG8_STAGEB(PG8_SB(0, 0), b2, voffB);
            PG8_BAR; PG8_WAIT_L(0); PG8_MMA(0, 1, At, B1); PG8_BAR;
            PG8_LDA(At, 0, 1); PG8_STAGE(PG8_SA(0, 0), a2, voffA);
            PG8_BAR; PG8_WAIT_L(0); PG8_MMA(1, 0, At, B0); PG8_BAR; PG8_SCHED;
            PG8_STAGEB(PG8_SB(0, 1), b2 + hstepB, voffB);
            PG8_WAIT_V(6); PG8_BAR; PG8_MMA(1, 1, At, B1); PG8_BAR;
            PG8_LDB(B0, 1, 0); PG8_SCHED; PG8_LDA(At, 1, 0); PG8_STAGE(PG8_SA(0, 1), a2 + hstep, voffA);
            PG8_WAIT_L(8); PG8_BAR; PG8_WAIT_L(0); PG8_MMA(0, 0, At, B0); PG8_BAR; PG8_SCHED;
            PG8_LDB(B1, 1, 1); PG8_STAGEB(PG8_SB(1, 0), b3, voffB);
            PG8_BAR; PG8_WAIT_L(0); PG8_MMA(0, 1, At, B1); PG8_BAR;
            PG8_LDA(At, 1, 1); PG8_STAGE(PG8_SA(1, 0), a3, voffA);
            PG8_BAR; PG8_WAIT_L(0); PG8_MMA(1, 0, At, B0); PG8_BAR; PG8_SCHED;
            PG8_STAGEB(PG8_SB(1, 1), b3 + hstepB, voffB);
            PG8_WAIT_V(6); PG8_BAR; PG8_MMA(1, 1, At, B1); PG8_BAR;
        }
        PG8_STAMP();
        if constexpr (!Epi::AFTER_DRAIN) { E(acc, cur, wr, wc, fr, fq); S.done(cur); }
        PG8_STAMP();
        if (!has_next) break;
#pragma unroll
        for (int a = 0; a < 2; ++a)
#pragma unroll
            for (int b = 0; b < 2; ++b)
#pragma unroll
                for (int m = 0; m < 4; ++m)
#pragma unroll
                    for (int n = 0; n < 2; ++n) acc[a][b][m][n] = (f32x4){0.f, 0.f, 0.f, 0.f};
        cur = nxt; cA = nA; cB = nB; ++ui;
    }
    PG8_WAIT_V(0);
    if (wr == 0) PG8_BAR;
    PG8_BAR;
    if constexpr (Epi::AFTER_DRAIN) { E.fused(acc, cur, wr, wc, fr, fq, lds, wid, lane); S.done(cur); }
    PG8_STAMP();
    if (STAMP && wid == 0) { stamps[lane] = lane < nts ? (((unsigned long long)(unsigned)ts_hi << 32) | (unsigned)ts_lo) : 0ull;
        if (lane == 62) stamps[62] = rt_entry; if (lane == 63) stamps[63] = (unsigned long long)wall_clock64(); }
#undef PG8_STAMP
#undef PG8_SA
#undef PG8_SB
#undef PG8_STAGE
#undef PG8_STAGEB
#undef PG8_STAGEQ
#undef PG8_LDA
#undef PG8_LDB
#undef PG8_MMA
#undef PG8_WAIT_V
#undef PG8_WAIT_L
#undef PG8_BAR
#undef PG8_SCHED
}
}
#define XB_TMO      128
#define XB_XCNT(j)  (256  + 64 * (j))
#define XB_XSUB(j)  (1280 + 64 * (j))
#define XB_XGEN(j)  (2304 + 64 * (j))
#define XB_TOP      3328
#define XB_TOPGEN   3392
#define XCD_BAR_WORDS 3456
#define XB_SPIN_CAP (1u << 18)
#define LAS __attribute__((address_space(3)))

__device__ __forceinline__ unsigned xb_ld(unsigned* p)              { return __hip_atomic_load(p, __ATOMIC_RELAXED, __HIP_MEMORY_SCOPE_AGENT); }
__device__ __forceinline__ unsigned xb_add(unsigned* p, unsigned v) { return __hip_atomic_fetch_add(p, v, __ATOMIC_RELAXED, __HIP_MEMORY_SCOPE_AGENT); }
__device__ __forceinline__ unsigned xb_xcc_id() { return (unsigned)__builtin_amdgcn_s_getreg((3 << 11) | 20) & 0xFu; }
#define XB_SPIN(cond, bar) do { unsigned _sp = 0; while (cond) { __builtin_amdgcn_s_sleep(1); \
    if ((++_sp & 255u) == 0u) { if (xb_ld(&(bar)[XB_TMO])) break; if (_sp > XB_SPIN_CAP) { atomicAdd(&(bar)[XB_TMO], 1u); break; } } } } while (0)

struct XcdBarrier {
    unsigned* bar; unsigned x;
    volatile LAS unsigned* st;
};

__device__ __forceinline__ XcdBarrier xcd_barrier_post(unsigned* bar, volatile LAS unsigned* st) {
    XcdBarrier b; b.bar = bar; b.x = xb_xcc_id(); b.st = st;
    if (threadIdx.x == 0) (void)xb_add(&bar[XB_XCNT(b.x)], 1u);
    return b;
}
__device__ __forceinline__ void xcd_barrier_complete(unsigned* bar, unsigned x, unsigned& nloc, unsigned& nx) {
    const unsigned G = gridDim.x * gridDim.y * gridDim.z;
    unsigned sum, cnt, mine, sp = 0u;
    for (;;) {
        sum = 0u; cnt = 0u; mine = 0u;
#pragma unroll
        for (unsigned j = 0; j < 16; ++j) { const unsigned c = xb_ld(&bar[XB_XCNT(j)]); sum += c; cnt += (c > 0u) ? 1u : 0u; mine = (j == x) ? c : mine; }
        if (sum == G) break;
        __builtin_amdgcn_s_sleep(1);
        if ((++sp & 255u) == 0u) { if (xb_ld(&bar[XB_TMO])) break; if (sp > XB_SPIN_CAP) { atomicAdd(&bar[XB_TMO], 1u); break; } }
    }
    nloc = mine > 0u ? mine : 1u; nx = cnt > 0u ? cnt : 1u;
}

__device__ __forceinline__ void xcd_barrier(const XcdBarrier& b) {
    asm volatile("s_waitcnt vmcnt(0)" ::: "memory");
    __syncthreads();
    if (threadIdx.x == 0) {
        unsigned* bar = b.bar;
        __builtin_amdgcn_s_waitcnt(0);
        unsigned nloc = b.st[0], nx = b.st[1];
        if (nloc == 0u) { xcd_barrier_complete(bar, b.x, nloc, nx); b.st[0] = nloc; b.st[1] = nx; }
        const unsigned old = xb_add(&bar[XB_XSUB(b.x)], 1u);
        const unsigned gen = old / nloc;
        if (old + 1u == (gen + 1u) * nloc) {
            __builtin_amdgcn_fence(__ATOMIC_RELEASE, "agent");
            asm volatile("s_waitcnt vmcnt(0)" ::: "memory");
            const unsigned og = xb_add(&bar[XB_TOP], 1u);
            const unsigned tg = og / nx;
            if (og + 1u == (tg + 1u) * nx) xb_add(&bar[XB_TOPGEN], 1u);
            else XB_SPIN(xb_ld(&bar[XB_TOPGEN]) == tg, bar);
            __builtin_amdgcn_fence(__ATOMIC_ACQUIRE, "agent");
            xb_add(&bar[XB_XGEN(b.x)], 1u);
            asm volatile("s_waitcnt vmcnt(0)" ::: "memory");
        } else {
            XB_SPIN(xb_ld(&bar[XB_XGEN(b.x)]) == gen, bar);
            __builtin_amdgcn_fence(__ATOMIC_ACQUIRE, "agent");
            asm volatile("s_waitcnt vmcnt(0)" ::: "memory");
        }
    }
    __syncthreads();
}

namespace mk {
using pg8::bf16_t; using pg8::bf16x8; using pg8::f32x4; using pg8::u32x4;
typedef short s16x4 __attribute__((ext_vector_type(4)));
typedef unsigned u32x2 __attribute__((ext_vector_type(2)));
typedef __bf16 bf16x2v __attribute__((ext_vector_type(2)));
typedef int i32x4 __attribute__((ext_vector_type(4)));
#define DI __device__ __forceinline__

constexpr int D = 1024, SEQ = 4096, NTOK = 16384, DEPTH = 4, DIN = 13824;
constexpr int OFF_AQ = 0, OFF_AK = 1536, OFF_AV = 3072, OFF_LX = 4608, OFF_LG = 5632, OFF_RQ = 6656, OFF_RK = 7680, OFF_RV = 8704, OFF_RG = 9728, OFF_GA = 10752;
constexpr float ALPHA = 1.681792830507429f;
constexpr float LN_EPS = 1e-5f;
constexpr float X8_SCALE = 32.0f, W8_SCALE = 2048.0f, F8_MAX = 440.0f;
constexpr int NPH = 12;
constexpr int LDS_BYTES = 148 * 1024;
constexpr int LDS_BAR_OFF = LDS_BYTES - 16;

constexpr size_t WS_CTL  = 0;
constexpr size_t WS_COSA = 16384;
constexpr size_t WS_SINA = WS_COSA + (size_t)4096 * 64 * 4;
constexpr size_t WS_COSR = WS_SINA + (size_t)4096 * 64 * 4;
constexpr size_t WS_SINR = WS_COSR + (size_t)4096 * 128 * 4;
constexpr size_t WS_CCH  = WS_SINR + (size_t)4096 * 128 * 4;
constexpr size_t WS_WAT  = WS_CCH + 4096;
constexpr size_t WS_WXT  = WS_WAT + 131072;
constexpr size_t WS_LSTA = WS_WXT + 131072;
constexpr size_t WS_LSTH = WS_LSTA + 524288;
constexpr size_t WS_K1B  = WS_LSTH + 524288;
constexpr size_t WS_K2B  = WS_K1B + 262144;
constexpr size_t WS_XF   = WS_K2B + 262144;
constexpr size_t WS_XB   = WS_XF + (size_t)NTOK * D * 4;
constexpr size_t WS_WINT = WS_XB + (size_t)NTOK * D * 2;
constexpr size_t WS_WSC  = WS_WINT + (size_t)DIN * 1024;
constexpr size_t WS_X8   = WS_WSC + (size_t)DIN * 4 + 256 - ((size_t)DIN * 4) % 256;
constexpr size_t WS_XS   = WS_X8 + (size_t)NTOK * 1024;
constexpr size_t WS_WBAT = WS_XS + (size_t)NTOK * 4;
constexpr size_t WS_WBBT = WS_WBAT + (size_t)1024 * 512 * 2;
constexpr size_t WS_WBCT = WS_WBBT + (size_t)1024 * 1024 * 2;
constexpr size_t WS_WOT  = WS_WBCT + (size_t)1024 * 1024 * 2;
constexpr size_t WS_WQT  = WS_WOT + (size_t)1024 * 1024 * 2;
constexpr size_t WS_UV8  = WS_WQT + (size_t)2048 * 1024 * 2;
constexpr size_t WS_UVS  = WS_UV8 + (size_t)16384 * 2048;
constexpr size_t WS_PROJ = WS_UVS + (size_t)16384 * 8;
constexpr size_t WS_OATT = WS_PROJ + (size_t)NTOK * DIN * 2;
constexpr size_t WS_LSE  = WS_OATT + (size_t)NTOK * 1536 * 2;
constexpr size_t WS_KVB  = WS_LSE + (size_t)NTOK * 12 * 4;
constexpr size_t WS_YA   = WS_KVB + (size_t)16 * 32 * 65536 * 2;
constexpr size_t WS_YB   = WS_YA + (size_t)NTOK * 512 * 2;
constexpr size_t WS_YC   = WS_YB + (size_t)NTOK * 1024 * 2;
constexpr size_t WS_MRGF = WS_YC + (size_t)NTOK * 1024 * 2;
constexpr size_t WS_MRGB = WS_MRGF + (size_t)NTOK * 1024 * 4;
constexpr size_t WS_END  = WS_MRGB + (size_t)NTOK * 1024 * 2;
constexpr size_t WS_Q    = WS_PROJ;
constexpr size_t WS_EID  = WS_PROJ + (size_t)NTOK * 2048 * 2;
constexpr size_t WS_GATE = WS_EID + (size_t)NTOK * 128 * 4;
static_assert(WS_END <= (size_t)1073741824, "workspace too large");
static_assert(WS_PROJ % 256 == 0 && WS_KVB % 256 == 0 && WS_MRGF % 256 == 0, "alignment");

struct Args { const float* in[20]; float* out; unsigned char* ws; double ropeA, ropeR; int ph_lo, ph_hi; };

DI float bflo(unsigned w) { return __uint_as_float(w << 16); }
DI float bfhi(unsigned w) { return __uint_as_float(w & 0xffff0000u); }
DI float bf2f(bf16_t v) { return __uint_as_float(((unsigned)v) << 16); }
DI unsigned pk2(float lo, float hi) { return pg8::cvt_pk_bf16(lo, hi); }
DI bf16_t f2bf(float f) { return (bf16_t)(pk2(f, 0.f) & 0xffffu); }
DI f32x4 mfma16(bf16x8 a, bf16x8 b, f32x4 c) { return __builtin_amdgcn_mfma_f32_16x16x32_bf16(a, b, c, 0, 0, 0); }
DI s16x4 trrd(LAS unsigned char* p) { return __builtin_amdgcn_ds_read_tr16_b64_v4i16((LAS s16x4*)p); }
DI bf16x8 cat8(s16x4 lo, s16x4 hi) { return __builtin_shufflevector(lo, hi, 0, 1, 2, 3, 4, 5, 6, 7); }
DI float wsum(float v) { v += __shfl_xor(v, 32); v += __shfl_xor(v, 16); v += __shfl_xor(v, 8); v += __shfl_xor(v, 4); v += __shfl_xor(v, 2); v += __shfl_xor(v, 1); return v; }
DI float sigm(float x) { return __builtin_amdgcn_rcpf(1.f + __builtin_amdgcn_exp2f(x * -1.4426950408889634f)); }
DI float gelu_erf(float x) { return 0.5f * x * (1.f + erff(x * 0.70710678118654752f)); }
DI float dot2(unsigned w, unsigned x, float acc) { return __builtin_amdgcn_fdot2_f32_bf16(__builtin_bit_cast(bf16x2v, w), __builtin_bit_cast(bf16x2v, x), acc, false); }
DI float log2gamma(int h) { return log2f(1.0f - exp2f(-5.0f - (float)h)); }

DI float dpp_f(float v, const int ctrl, const int rmask) { return v; }
#define MK_DPP_ADD(v, ctrl, rmask) v += __int_as_float(__builtin_amdgcn_update_dpp(0, __float_as_int(v), (ctrl), (rmask), 0xf, false))
DI float wsum_dpp(float v) {
    MK_DPP_ADD(v, 0xB1, 0xf); MK_DPP_ADD(v, 0x4E, 0xf); MK_DPP_ADD(v, 0x141, 0xf); MK_DPP_ADD(v, 0x140, 0xf);
    MK_DPP_ADD(v, 0x142, 0xa); MK_DPP_ADD(v, 0x143, 0xc);
    return __int_as_float(__builtin_amdgcn_readlane(__float_as_int(v), 63));
}
DI float gelu_as(float v) {
    const float av = fabsf(v), t = __builtin_amdgcn_rcpf(av * 0.2316418882f + 1.0f);
    float q = t * 0.5307027145f + (-0.7265760135f); q = q * t + 0.7107068705f; q = q * t + (-0.142248368f); q = q * t + 0.127414796f; q = q * t;
    const float e = __builtin_amdgcn_exp2f(v * v * (-0.72134752044f));
    const float m = v * (q * e);
    return v < 0.f ? m : v - m;
}
DI void sincos_d(double x, double& s, double& c) {
    const double n = rint(x * 0.63661977236758134308);
    double y = fma(-n, 1.57079632679489655800e+00, x); y = fma(-n, 6.12323399573676603587e-17, y);
    const double y2 = y * y;
    const double sp = y + y * y2 * (-1.0 / 6 + y2 * (1.0 / 120 + y2 * (-1.0 / 5040 + y2 * (1.0 / 362880 + y2 * (-1.0 / 39916800 + y2 * (1.0 / 6227020800.0))))));
    const double cp = 1.0 + y2 * (-0.5 + y2 * (1.0 / 24 + y2 * (-1.0 / 720 + y2 * (1.0 / 40320 + y2 * (-1.0 / 3628800 + y2 * (1.0 / 479001600.0 + y2 * (-1.0 / 87178291200.0)))))));
    const int q = ((int)n) & 3;
    s = (q == 0) ? sp : (q == 1) ? cp : (q == 2) ? -sp : -cp;
    c = (q == 0) ? cp : (q == 1) ? -sp : (q == 2) ? -cp : sp;
}

DI int wperm(int n) {
    if (n < 3072) { const int j = n & 127, jj = j & 63; return (n & ~127) + 8 * (jj >> 2) + (jj & 3) + ((j >= 64) ? 4 : 0); }
    if (n >= OFF_RQ && n < OFF_RV) { const int j = n & 255, jj = j & 127; return (n & ~255) + 8 * (jj >> 2) + (jj & 3) + ((j >= 128) ? 4 : 0); }
    return n;
}

template <bool WPERM>
DI void tconv_tile(const float* src, int ldsrc, bf16_t* dst, int lddst, int k0, int n0, LAS float* t, float mul = 1.0f) {
    const int tid = mk_tid();
#pragma unroll
    for (int i = 0; i < 8; ++i) { const int idx = tid + 512 * i, r = idx >> 6, c = idx & 63; t[r * 65 + c] = src[(size_t)(k0 + r) * ldsrc + n0 + c]; }
    __syncthreads();
#pragma unroll
    for (int i = 0; i < 8; ++i) { const int idx = tid + 512 * i, n = idx >> 6, k = idx & 63; const int nr = WPERM ? wperm(n0 + n) : (n0 + n); dst[(size_t)nr * lddst + k0 + k] = f2bf(t[k * 65 + n] * mul); }
    __syncthreads();
}
DI void conv_unit(const float* src, bf16_t* dst, int unit) {
    const size_t i = (size_t)unit * 4096 + (size_t)mk_tid() * 8;
    const f32x4 a = *(const f32x4*)(src + i), b = *(const f32x4*)(src + i + 4);
    u32x4 o; o.x = pk2(a[0], a[1]); o.y = pk2(a[2], a[3]); o.z = pk2(b[0], b[1]); o.w = pk2(b[2], b[3]);
    *(u32x4*)(dst + i) = o;
}
DI void w8_unit(const float* src, unsigned char* ws, int unit, LAS float* t) {
    const int tid = mk_tid(), n0 = unit * 64;
    unsigned char* dst = ws + WS_WINT;
#pragma unroll 1
    for (int k0 = 0; k0 < 1024; k0 += 64) {
#pragma unroll
        for (int i = 0; i < 8; ++i) { const int idx = tid + 512 * i, r = idx >> 6, cc = idx & 63; t[r * 65 + cc] = fminf(fmaxf(src[(size_t)(k0 + r) * DIN + n0 + cc] * W8_SCALE, -F8_MAX), F8_MAX); }
        __syncthreads();
#pragma unroll
        for (int i = 0; i < 2; ++i) { const int idx = tid + 512 * i, n = idx >> 4, k4 = idx & 15;
            int wd = __builtin_amdgcn_cvt_pk_fp8_f32(t[(4 * k4) * 65 + n], t[(4 * k4 + 1) * 65 + n], 0, false);
            wd = __builtin_amdgcn_cvt_pk_fp8_f32(t[(4 * k4 + 2) * 65 + n], t[(4 * k4 + 3) * 65 + n], wd, true);
            *(int*)(dst + (size_t)wperm(n0 + n) * 1024 + k0 + 4 * k4) = wd; }
        __syncthreads();
    }
}
DI void row_to_fp8(const f32x4 (&o)[4], unsigned char* x8row, int ln) {
    u32x4 w;
#pragma unroll
    for (int q = 0; q < 4; ++q) {
        const float a0 = fminf(fmaxf(o[q][0] * X8_SCALE, -F8_MAX), F8_MAX), a1 = fminf(fmaxf(o[q][1] * X8_SCALE, -F8_MAX), F8_MAX), a2 = fminf(fmaxf(o[q][2] * X8_SCALE, -F8_MAX), F8_MAX), a3 = fminf(fmaxf(o[q][3] * X8_SCALE, -F8_MAX), F8_MAX);
        int wd = __builtin_amdgcn_cvt_pk_fp8_f32(a0, a1, 0, false); wd = __builtin_amdgcn_cvt_pk_fp8_f32(a2, a3, wd, true); w[q] = (unsigned)wd; }
    *(u32x4*)(x8row + 16 * ln) = w;
}
typedef float f32x16 __attribute__((ext_vector_type(16)));
typedef float f32x32 __attribute__((ext_vector_type(32)));
typedef unsigned u32x6 __attribute__((ext_vector_type(6)));
typedef _Float16 f16x32 __attribute__((ext_vector_type(32)));
DI float wmax(float m) { m = fmaxf(m, __shfl_xor(m, 32)); m = fmaxf(m, __shfl_xor(m, 16)); m = fmaxf(m, __shfl_xor(m, 8)); m = fmaxf(m, __shfl_xor(m, 4)); m = fmaxf(m, __shfl_xor(m, 2)); m = fmaxf(m, __shfl_xor(m, 1)); return m; }
DI void conv_fp6_rows(const float* usrc, const float* vsrc, unsigned char* ws, int unit) {
    const int tid = mk_tid(), lane = tid & 63, w = tid >> 6;
    const size_t row = (size_t)unit * 8 + w;
    const float* up = usrc + row * 1024 + 16 * lane; const float* vp = vsrc + row * 1024 + 16 * lane;
    f32x16 a, b; float mu = 0.f, mv = 0.f;
#pragma unroll
    for (int q = 0; q < 4; ++q) { const f32x4 x = *(const f32x4*)(up + 4 * q), y = *(const f32x4*)(vp + 4 * q);
#pragma unroll
        for (int j = 0; j < 4; ++j) { a[4 * q + j] = x[j]; b[4 * q + j] = y[j]; mu = fmaxf(mu, fabsf(x[j])); mv = fmaxf(mv, fabsf(y[j])); } }
    mu = wmax(mu); mv = wmax(mv);
    const float su = (mu > 0.f) ? 7.0f / mu : 1.0f, sv = (mv > 0.f) ? 7.0f / mv : 1.0f;
    f16x32 h;
#pragma unroll
    for (int i = 0; i < 16; ++i) { h[i] = (_Float16)(a[i] * su); h[16 + i] = (_Float16)(b[i] * sv); }
    const u32x6 p = __builtin_amdgcn_cvt_scalef32_pk32_fp6_f16(h, 1.0f);
    unsigned char* rec = ws + WS_UV8 + row * 1536;
    *(u32x4*)(rec + 16 * lane) = (u32x4){p[0], p[1], p[2], p[3]};
    *(u32x2*)(rec + 1024 + 8 * lane) = (u32x2){p[4], p[5]};
    if (lane == 0) { float* sp = (float*)(ws + WS_UVS) + row * 2; sp[0] = (mu > 0.f) ? mu * (1.0f / 7.0f) : 1.0f; sp[1] = (mv > 0.f) ? mv * (1.0f / 7.0f) : 1.0f; }
}
DI void phase_conv(const Args& a, int layer, LAS unsigned char* lds) {
    unsigned char* ws = a.ws;
    LAS float* t = (LAS float*)lds;
    const int J0 = 216, J1 = J0 + 128, J2 = J1 + 256, J3 = J2 + 256, J4 = J3 + 256, J5 = J4 + 512, J6 = J5 + 32, J7 = J6 + 2048, J8 = J7, J9 = J8 + 64, J10 = J9 + 1;
    const int total = J10;
    for (int u = blockIdx.x; u < total; u += gridDim.x) {
        if (u < J0) { w8_unit(a.in[1] + (size_t)layer * 1024 * DIN, ws, u, t); }
        else if (u < J1) { const int v = u - J0, kt = v / 16, nt = v % 16; tconv_tile<false>(a.in[9] + (size_t)layer * 2560 * 1024, 1024, (bf16_t*)(ws + WS_WBAT), 512, kt * 64, nt * 64, t); }
        else if (u < J2) { const int v = u - J1, kt = v / 16, nt = v % 16; tconv_tile<false>(a.in[9] + (size_t)layer * 2560 * 1024 + (size_t)512 * 1024, 1024, (bf16_t*)(ws + WS_WBBT), 1024, kt * 64, nt * 64, t); }
        else if (u < J3) { const int v = u - J2, kt = v / 16, nt = v % 16; tconv_tile<false>(a.in[9] + (size_t)layer * 2560 * 1024 + (size_t)1536 * 1024, 1024, (bf16_t*)(ws + WS_WBCT), 1024, kt * 64, nt * 64, t); }
        else if (u < J4) { const int v = u - J3, kt = v / 16, nt = v % 16; tconv_tile<false>(a.in[10] + (size_t)layer * 1024 * 1024, 1024, (bf16_t*)(ws + WS_WOT), 1024, kt * 64, nt * 64, t); }
        else if (u < J5) { const int v = u - J4, kt = v / 32, nt = v % 32; tconv_tile<false>(a.in[13] + (size_t)layer * 1024 * 2048, 2048, (bf16_t*)(ws + WS_WQT), 1024, kt * 64, nt * 64, t); }
        else if (u < J6) { const int v = u - J5, blk = v & 15, which = v >> 4;
            tconv_tile<false>(a.in[which ? 6 : 4] + ((size_t)layer * 16 + blk) * 4096, 64, (bf16_t*)(ws + (which ? WS_WXT : WS_WAT)) + blk * 4096, 64, 0, 0, t, -1.4426950408889634f); }
        else if (u < J7) { conv_fp6_rows(a.in[16] + (size_t)layer * 16384 * 1024, a.in[17] + (size_t)layer * 16384 * 1024, ws, u - J6); }
        else if (u < J9) { const int v = u - J8; if (v < 32) conv_unit(a.in[14] + (size_t)layer * 131072, (bf16_t*)(ws + WS_K1B), v); else conv_unit(a.in[15] + (size_t)layer * 131072, (bf16_t*)(ws + WS_K2B), v - 32); }
        else { for (int c = mk_tid(); c < 1024; c += 512) { const float lam = a.in[8][layer * 1024 + c]; const float e = __builtin_amdgcn_exp2f(-lam * 1.4426950408889634f); const float sp = (e < 0.05f) ? e * (1.0f + e * (-0.5f + e * (0.33333333f + e * -0.25f))) : __builtin_amdgcn_logf(1.0f + e) * 0.6931471805599453f; ((float*)(ws + WS_CCH))[c] = -8.0f * sp; } }
    }
}

DI void phase_prologue(const Args& a) {
    unsigned char* ws = a.ws;
    const int tid = mk_tid();
    for (int u = blockIdx.x; u < 2048 + 1536; u += gridDim.x) {
        if (u < 2048) { const int ln = tid & 63; const size_t row = (size_t)u * 8 + (tid >> 6);
            const float* xp = a.in[0] + row * 1024 + 16 * ln; float* xo = (float*)(ws + WS_XF) + row * 1024 + 16 * ln;
            f32x4 o[4];
#pragma unroll
            for (int q = 0; q < 4; ++q) { o[q] = *(const f32x4*)(xp + 4 * q); *(f32x4*)(xo + 4 * q) = o[q]; }
            row_to_fp8(o, ws + WS_X8 + row * 1024, ln); }
        else { const int idx = (u - 2048) * 512 + tid;
            const int pos = idx / 192, i = idx % 192;
            const bool isA = i < 64; const int fi = isA ? i : i - 64; const double r = isA ? a.ropeA : a.ropeR;
            double inv = 1.0; for (int k = 0; k < fi; ++k) inv *= r;
            double s, c; sincos_d((double)pos * inv, s, c);
            if (isA) { ((float*)(ws + WS_COSA))[pos * 64 + fi] = (float)c; ((float*)(ws + WS_SINA))[pos * 64 + fi] = (float)s; }
            else { ((float*)(ws + WS_COSR))[pos * 128 + fi] = (float)c; ((float*)(ws + WS_SINR))[pos * 128 + fi] = (float)s; } }
    }
}

DI void phase_rope(const Args& a) {
    unsigned char* ws = a.ws; bf16_t* proj = (bf16_t*)(ws + WS_PROJ);
    for (int u = blockIdx.x; u < NTOK / 8; u += gridDim.x) {
#pragma unroll 1
        for (int i = 0; i < 5; ++i) {
            const int idx = mk_tid() + 512 * i, tk = u * 8 + idx / 320; int it = idx % 320;
            int off, hd, half, head, ch; const float* ct; const float* st; float sc = 1.0f;
            if (it < 192) { off = (it < 96) ? OFF_AQ : OFF_AK; if (it >= 96) it -= 96; hd = 128; half = 64; head = it >> 3; ch = it & 7; ct = (const float*)(ws + WS_COSA); st = (const float*)(ws + WS_SINA); }
            else { it -= 192; off = (it < 64) ? OFF_RQ : OFF_RK; if (it >= 64) { it -= 64; sc = 0.0625f; } hd = 256; half = 128; head = it >> 4; ch = it & 15; ct = (const float*)(ws + WS_COSR); st = (const float*)(ws + WS_SINR); }
            const int pos = tk & (SEQ - 1);
            bf16_t* p1 = proj + (size_t)tk * DIN + off + head * hd + ch * 8; bf16_t* p2 = p1 + half;
            const u32x4 x1 = *(const u32x4*)p1, x2 = *(const u32x4*)p2;
            const float* cp = ct + (size_t)pos * half + ch * 8; const float* sp = st + (size_t)pos * half + ch * 8;
            const f32x4 c0 = *(const f32x4*)cp, c1 = *(const f32x4*)(cp + 4), s0 = *(const f32x4*)sp, s1 = *(const f32x4*)(sp + 4);
            float t1[8], t2[8], cc[8], ss[8];
#pragma unroll
            for (int q = 0; q < 4; ++q) { t1[2 * q] = bflo(x1[q]); t1[2 * q + 1] = bfhi(x1[q]); t2[2 * q] = bflo(x2[q]); t2[2 * q + 1] = bfhi(x2[q]); cc[q] = c0[q]; cc[4 + q] = c1[q]; ss[q] = s0[q]; ss[4 + q] = s1[q]; }
            u32x4 o1, o2;
#pragma unroll
            for (int q = 0; q < 4; ++q) {
                const float a0 = (t1[2 * q] * cc[2 * q] - t2[2 * q] * ss[2 * q]) * sc, a1 = (t1[2 * q + 1] * cc[2 * q + 1] - t2[2 * q + 1] * ss[2 * q + 1]) * sc;
                const float b0 = (t1[2 * q] * ss[2 * q] + t2[2 * q] * cc[2 * q]) * sc, b1 = (t1[2 * q + 1] * ss[2 * q + 1] + t2[2 * q + 1] * cc[2 * q + 1]) * sc;
                o1[q] = pk2(a0, a1); o2[q] = pk2(b0, b1); }
            *(u32x4*)p1 = o1; *(u32x4*)p2 = o2;
        }
    }
}

DI void attn_unit(const Args& a, int unit, LAS unsigned char* lds) {
    unsigned char* ws = a.ws;
    const int tid = mk_tid(), lane = tid & 63, w = __builtin_amdgcn_readfirstlane(tid >> 6), g = lane >> 4, l15 = lane & 15, tq4 = l15 >> 2, tp4 = l15 & 3;
    const int b = unit / 384, rem = unit % 384, h = rem >> 5, bi = rem & 31;
    const int grp = h >> 2, d = (grp == 0) ? 1 : ((grp == 1) ? 4 : 16), nb = 32 / d, r = bi / nb, n = bi % nb;
    const bf16_t* proj = (const bf16_t*)(ws + WS_PROJ) + (size_t)b * SEQ * DIN;
    LAS unsigned char* Ks = lds; LAS unsigned char* Vs = lds + 256 * 288;
#pragma unroll
    for (int i = 0; i < 8; ++i) {
        const int idx = tid + 512 * i, row = idx >> 4, ch = idx & 15, m = 128 * (n - 1) + row;
        u32x4 kv = {0u, 0u, 0u, 0u}, vv = {0u, 0u, 0u, 0u};
        if (m >= 0) { const bf16_t* p = proj + (size_t)(m * d + r) * DIN + h * 128 + ch * 8; kv = *(const u32x4*)(p + OFF_AK); vv = *(const u32x4*)(p + OFF_AV); }
        *(LAS u32x4*)(Ks + row * 288 + ch * 16) = kv; *(LAS u32x4*)(Vs + row * 288 + ch * 16) = vv;
    }
    const int qi = 16 * w + l15;
    const size_t tq = (size_t)(128 * n + qi) * d + r;
    bf16x8 qf[4];
#pragma unroll
    for (int ks = 0; ks < 4; ++ks) qf[ks] = *(const bf16x8*)(proj + tq * DIN + OFF_AQ + h * 128 + 32 * ks + 8 * g);
    __syncthreads();
    const int s0 = w >> 1;
    f32x4 sacc[10];
#pragma unroll
    for (int jj = 0; jj < 10; ++jj) {
        f32x4 acc = {0.f, 0.f, 0.f, 0.f};
#pragma unroll
        for (int ks = 0; ks < 4; ++ks) { const bf16x8 kf = *(const LAS bf16x8*)(Ks + (32 * s0 + 16 * jj + l15) * 288 + (32 * ks + 8 * g) * 2); acc = mfma16(kf, qf[ks], acc); }
        sacc[jj] = acc;
    }
    const float scale = 0.08838834764831845f * 1.4426950408889634f;
    float mx = -1e30f;
#pragma unroll
    for (int jj = 0; jj < 10; ++jj)
#pragma unroll
        for (int rg = 0; rg < 4; ++rg) {
            const int j = 32 * s0 + 16 * jj + 4 * g + rg;
            const bool valid = (j >= qi) && (j <= qi + 128) && (n > 0 || j >= 128);
            const float s = valid ? sacc[jj][rg] * scale : -1e30f;
            sacc[jj][rg] = s; mx = fmaxf(mx, s);
        }
    mx = fmaxf(mx, __shfl_xor(mx, 16)); mx = fmaxf(mx, __shfl_xor(mx, 32));
    float sum = 0.f;
#pragma unroll
    for (int jj = 0; jj < 10; ++jj)
#pragma unroll
        for (int rg = 0; rg < 4; ++rg) { const float p = __builtin_amdgcn_exp2f(sacc[jj][rg] - mx); sacc[jj][rg] = p; sum += p; }
    sum += __shfl_xor(sum, 16); sum += __shfl_xor(sum, 32);
    f32x4 oacc[8];
#pragma unroll
    for (int db = 0; db < 8; ++db) oacc[db] = (f32x4){0.f, 0.f, 0.f, 0.f};
#pragma unroll
    for (int s = 0; s < 5; ++s) {
        u32x4 pw; pw.x = pk2(sacc[2 * s][0], sacc[2 * s][1]); pw.y = pk2(sacc[2 * s][2], sacc[2 * s][3]); pw.z = pk2(sacc[2 * s + 1][0], sacc[2 * s + 1][1]); pw.w = pk2(sacc[2 * s + 1][2], sacc[2 * s + 1][3]);
        const bf16x8 pb = __builtin_bit_cast(bf16x8, pw);
        const int k0 = 32 * (s0 + s) + 4 * g + tq4;
#pragma unroll
        for (int db = 0; db < 8; ++db) {
            const s16x4 lo = trrd(Vs + k0 * 288 + (16 * db + 4 * tp4) * 2), hi = trrd(Vs + (k0 + 16) * 288 + (16 * db + 4 * tp4) * 2);
            oacc[db] = mfma16(cat8(lo, hi), pb, oacc[db]);
        }
    }
    const float inv = 1.0f / sum;
    bf16_t* op = (bf16_t*)(ws + WS_OATT) + ((size_t)b * SEQ + tq) * 1536 + h * 128 + 4 * g;
#pragma unroll
    for (int db = 0; db < 8; ++db) { u32x2 o; o.x = pk2(oacc[db][0] * inv, oacc[db][1] * inv); o.y = pk2(oacc[db][2] * inv, oacc[db][3] * inv); *(u32x2*)(op + 16 * db) = o; }
    if (g == 0) ((float*)(ws + WS_LSE))[((size_t)b * SEQ + tq) * 12 + h] = mx + __builtin_amdgcn_logf(sum);
    __syncthreads();
}

DI void retkv_unit(const Args& a, int unit, LAS unsigned char* lds) {
    unsigned char* ws = a.ws;
    const int tid = mk_tid(), lane = tid & 63, w = __builtin_amdgcn_readfirstlane(tid >> 6), g = lane >> 4, l15 = lane & 15, tq4 = l15 >> 2, tp4 = l15 & 3;
    const int b = unit >> 7, h = (unit >> 5) & 3, c = unit & 31;
    const bf16_t* proj = (const bf16_t*)(ws + WS_PROJ) + ((size_t)b * SEQ + c * 128) * DIN;
    LAS unsigned char* Ks = lds; LAS unsigned char* Vs = lds + 128 * 544;
    const float l2g = log2gamma(h);
#pragma unroll
    for (int i = 0; i < 8; ++i) {
        const int idx = tid + 512 * i, row = idx >> 5, ch = idx & 31;
        const bf16_t* p = proj + (size_t)row * DIN + h * 256 + ch * 8;
        const u32x4 kv = *(const u32x4*)(p + OFF_RK), vv = *(const u32x4*)(p + OFF_RV);
        const float z = exp2f((float)(127 - row) * l2g);
        u32x4 kz;
#pragma unroll
        for (int q = 0; q < 4; ++q) kz[q] = pk2(bflo(kv[q]) * z, bfhi(kv[q]) * z);
        *(LAS u32x4*)(Ks + row * 544 + ch * 16) = kz; *(LAS u32x4*)(Vs + row * 544 + ch * 16) = vv;
    }
    __syncthreads();
#pragma unroll 1
    for (int nh = 0; nh < 2; ++nh) {
        f32x4 acc[2][8];
#pragma unroll
        for (int mb = 0; mb < 2; ++mb)
#pragma unroll
            for (int nb = 0; nb < 8; ++nb) acc[mb][nb] = (f32x4){0.f, 0.f, 0.f, 0.f};
#pragma unroll
        for (int ks = 0; ks < 4; ++ks) {
            const int j0 = 32 * ks + 4 * g + tq4;
            bf16x8 af[2];
#pragma unroll
            for (int mb = 0; mb < 2; ++mb) { const int col = 32 * w + 16 * mb + 4 * tp4; af[mb] = cat8(trrd(Vs + j0 * 544 + col * 2), trrd(Vs + (j0 + 16) * 544 + col * 2)); }
#pragma unroll
            for (int nb = 0; nb < 8; ++nb) {
                const int col = 128 * nh + 16 * nb + 4 * tp4;
                const bf16x8 bfr = cat8(trrd(Ks + j0 * 544 + col * 2), trrd(Ks + (j0 + 16) * 544 + col * 2));
#pragma unroll
                for (int mb = 0; mb < 2; ++mb) acc[mb][nb] = mfma16(af[mb], bfr, acc[mb][nb]);
            }
        }
        bf16_t* kvb = (bf16_t*)(ws + WS_KVB) + ((size_t)((b * 4 + h) * 32 + c)) * 65536 + 128 * nh;
#pragma unroll
        for (int mb = 0; mb < 2; ++mb)
#pragma unroll
            for (int nb = 0; nb < 8; ++nb)
#pragma unroll
                for (int rg = 0; rg < 4; ++rg) kvb[(size_t)(32 * w + 16 * mb + 4 * g + rg) * 256 + 16 * nb + l15] = f2bf(acc[mb][nb][rg]);
    }
    __syncthreads();
}

DI void lru_unit(const Args& a, int layer, int unit, bool fin, LAS unsigned char* lds) {
    unsigned char* ws = a.ws;
    const int tid = mk_tid(), lane = tid & 63, w = __builtin_amdgcn_readfirstlane(tid >> 6), g = lane >> 4, l15 = lane & 15;
    const int b = unit >> 9, c = (unit >> 4) & 31, blk = unit & 15;
    LAS bf16_t* lxs = (LAS bf16_t*)lds;
    LAS float* xcf = (LAS float*)(lds + 16896);
    LAS unsigned char* xcb = lds + 49664;
    LAS float* rgt = (LAS float*)(lds + 68096);
    LAS float* igt = (LAS float*)(lds + 100864);
    LAS float* wst = (LAS float*)(lds + 133632);
    const bf16_t* proj = (const bf16_t*)(ws + WS_PROJ) + (size_t)b * SEQ * DIN;
    for (int idx = tid; idx < 131 * 8; idx += 512) {
        const int row = idx >> 3, ch = idx & 7, tk = c * 128 - 3 + row;
        u32x4 v = {0u, 0u, 0u, 0u};
        if (tk >= 0) v = *(const u32x4*)(proj + (size_t)tk * DIN + OFF_LX + blk * 64 + ch * 8);
        *(LAS u32x4*)(lxs + row * 64 + ch * 8) = v;
    }
    __syncthreads();
    {
        const int ch = tid & 63, gc = blk * 64 + ch;
        const float* cw = a.in[2] + (size_t)layer * 4096;
        const float cw0 = cw[gc], cw1 = cw[1024 + gc], cw2 = cw[2048 + gc], cw3 = cw[3072 + gc], cb = a.in[3][layer * 1024 + gc];
#pragma unroll
        for (int i = 0; i < 16; ++i) {
            const int t = (tid >> 6) + 8 * i;
            const float xc = cb + cw0 * bf2f(lxs[t * 64 + ch]) + cw1 * bf2f(lxs[(t + 1) * 64 + ch]) + cw2 * bf2f(lxs[(t + 2) * 64 + ch]) + cw3 * bf2f(lxs[(t + 3) * 64 + ch]);
            xcf[t * 64 + ch] = xc; *(LAS bf16_t*)(xcb + t * 144 + ch * 2) = f2bf(xc);
        }
    }
    __syncthreads();
#pragma unroll
    for (int gate = 0; gate < 2; ++gate) {
        const bf16_t* WT = (const bf16_t*)(ws + (gate ? WS_WXT : WS_WAT)) + blk * 4096;
        const float* bias = a.in[gate ? 7 : 5] + layer * 1024 + blk * 64;
        LAS float* dst = gate ? igt : rgt;
#pragma unroll
        for (int nb = 0; nb < 4; ++nb) {
            f32x4 acc = {0.f, 0.f, 0.f, 0.f};
#pragma unroll
            for (int ks = 0; ks < 2; ++ks) {
                const bf16x8 af = *(const LAS bf16x8*)(xcb + (16 * w + l15) * 144 + (32 * ks + 8 * g) * 2);
                const bf16x8 bfr = *(const bf16x8*)(WT + (16 * nb + l15) * 64 + 32 * ks + 8 * g);
                acc = mfma16(af, bfr, acc);
            }
            const float bv = bias[16 * nb + l15];
#pragma unroll
            for (int rg = 0; rg < 4; ++rg) dst[(16 * w + 4 * g + rg) * 64 + 16 * nb + l15] = sigm(acc[rg] + bv);
        }
    }
    __syncthreads();
    const int ch = lane, gc = blk * 64 + ch;
    const float cc = ((const float*)(ws + WS_CCH))[gc];
    float av[16], bv[16]; float Aw = 1.0f, Hw = 0.0f;
#pragma unroll
    for (int tt = 0; tt < 16; ++tt) {
        const int t = 16 * w + tt;
        const float la = cc * rgt[t * 64 + ch];
        const float aa = __builtin_amdgcn_exp2f(la * 1.4426950408889634f);
        const float bb = __builtin_amdgcn_sqrtf(fmaxf(1.0f - aa * aa, 0.0f)) * igt[t * 64 + ch] * xcf[t * 64 + ch];
        av[tt] = aa; bv[tt] = bb; Hw = aa * Hw + bb; Aw *= aa;
    }
    wst[w * 64 + ch] = Aw; wst[512 + w * 64 + ch] = Hw;
    __syncthreads();
    float* LA = (float*)(ws + WS_LSTA); float* LH = (float*)(ws + WS_LSTH);
    if (!fin) {
        if (w == 0) {
            float A = 1.0f, H = 0.0f;
#pragma unroll
            for (int ww = 0; ww < 8; ++ww) { const float A_ = wst[ww * 64 + ch], H_ = wst[512 + ww * 64 + ch]; H = A_ * H + H_; A *= A_; }
            LA[(size_t)(b * 32 + c) * 1024 + gc] = A; LH[(size_t)(b * 32 + c) * 1024 + gc] = H;
        }
    } else {
        float hcur = 0.0f;
#pragma unroll
        for (int c0 = 0; c0 < 32; c0 += 16) {
            if (c0 < c) {
                float ta[16], th[16];
#pragma unroll
                for (int q = 0; q < 16; ++q) { const int cp = (c0 + q < c) ? c0 + q : 0; ta[q] = LA[(size_t)(b * 32 + cp) * 1024 + gc]; th[q] = LH[(size_t)(b * 32 + cp) * 1024 + gc]; }
#pragma unroll
                for (int q = 0; q < 16; ++q) hcur = (c0 + q < c) ? ta[q] * hcur + th[q] : hcur;
            }
        }
        for (int ww = 0; ww < w; ++ww) hcur = wst[ww * 64 + ch] * hcur + wst[512 + ww * 64 + ch];
        bf16_t* yb = (bf16_t*)(ws + WS_YB) + ((size_t)b * SEQ + c * 128 + 16 * w) * 1024 + gc;
        const bf16_t* lgp = proj + (size_t)(c * 128 + 16 * w) * DIN + OFF_LG + gc;
#pragma unroll
        for (int tt = 0; tt < 16; ++tt) {
            hcur = av[tt] * hcur + bv[tt];
            const float lgv = bf2f(lgp[(size_t)tt * DIN]);
            yb[(size_t)tt * 1024] = f2bf(hcur * gelu_as(lgv));
        }
    }
    __syncthreads();
}

DI void lru_stripe(const Args& a, int layer, int stripe, LAS unsigned char* lds) {
    unsigned char* ws = a.ws;
    const int tid = mk_tid(), lane = tid & 63, w = __builtin_amdgcn_readfirstlane(tid >> 6), g = lane >> 4, l15 = lane & 15;
    const int b = stripe >> 4, blk = stripe & 15;
    LAS bf16_t* lxs = (LAS bf16_t*)lds;
    LAS bf16_t* lgs0 = (LAS bf16_t*)(lds + 16896);
    LAS unsigned char* xcb = lds + 49664;
    LAS float* rgt = (LAS float*)(lds + 68096);
    LAS float* igt = (LAS float*)(lds + 100864);
    LAS float* wst = (LAS float*)(lds + 133632);
    const bf16_t* proj = (const bf16_t*)(ws + WS_PROJ) + (size_t)b * SEQ * DIN;
    const int gc = blk * 64 + lane;
    const float* cw = a.in[2] + (size_t)layer * 4096;
    const int cch_ = tid & 63, cgc = blk * 64 + cch_;
    const float cw0 = cw[cgc], cw1 = cw[1024 + cgc], cw2 = cw[2048 + cgc], cw3 = cw[3072 + cgc], cb = a.in[3][layer * 1024 + cgc];
    const float cc = ((const float*)(ws + WS_CCH))[gc] * 1.4426950408889634f;
    float bia[4], bix[4];
    LAS unsigned char* wlds = lds + 137728;
    { const int r = tid >> 3, c8 = tid & 7; *(LAS u32x4*)(wlds + r * 144 + c8 * 16) = *(const u32x4*)((const bf16_t*)(ws + WS_WAT) + blk * 4096 + r * 64 + c8 * 8); }
    bf16x8 wfx[4][2];
#pragma unroll
    for (int nb = 0; nb < 4; ++nb)
#pragma unroll
        for (int ks = 0; ks < 2; ++ks) wfx[nb][ks] = *(const bf16x8*)((const bf16_t*)(ws + WS_WXT) + blk * 4096 + (16 * nb + l15) * 64 + 32 * ks + 8 * g);
#pragma unroll
    for (int nb = 0; nb < 4; ++nb) { bia[nb] = -1.4426950408889634f * a.in[5][layer * 1024 + blk * 64 + 16 * nb + l15]; bix[nb] = -1.4426950408889634f * a.in[7][layer * 1024 + blk * 64 + 16 * nb + l15]; }
    if (tid < 24) *(LAS u32x4*)(lxs + tid * 8) = (u32x4){0u, 0u, 0u, 0u};
    u32x4 plx[2], plg[2];
#pragma unroll
    for (int i = 0; i < 2; ++i) { const int idx = tid + 512 * i, row = idx >> 3, c8 = idx & 7; const bf16_t* p = proj + (size_t)row * DIN + blk * 64 + c8 * 8; plx[i] = *(const u32x4*)(p + OFF_LX); plg[i] = *(const u32x4*)(p + OFF_LG); }
    float hcarry = 0.0f;
#pragma unroll 1
    for (int c = 0; c < 32; ++c) {
        LAS bf16_t* lgs = lgs0 + (c & 1) * 8192;
#pragma unroll
        for (int i = 0; i < 2; ++i) { const int idx = tid + 512 * i, row = idx >> 3, c8 = idx & 7; *(LAS u32x4*)(lxs + (3 + row) * 64 + c8 * 8) = plx[i]; *(LAS u32x4*)(lgs + row * 64 + c8 * 8) = plg[i]; }
        __syncthreads();
        if (c + 1 < 32) {
#pragma unroll
            for (int i = 0; i < 2; ++i) { const int idx = tid + 512 * i, row = idx >> 3, c8 = idx & 7; const bf16_t* p = proj + (size_t)((c + 1) * 128 + row) * DIN + blk * 64 + c8 * 8; plx[i] = *(const u32x4*)(p + OFF_LX); plg[i] = *(const u32x4*)(p + OFF_LG); }
        }
        {
            const int t0 = (tid >> 6) * 16;
            float x0 = bf2f(lxs[t0 * 64 + cch_]), x1 = bf2f(lxs[(t0 + 1) * 64 + cch_]), x2 = bf2f(lxs[(t0 + 2) * 64 + cch_]);
#pragma unroll
            for (int i = 0; i < 16; ++i) {
                const float x3 = bf2f(lxs[(t0 + i + 3) * 64 + cch_]);
                const float xc = cb + cw0 * x0 + cw1 * x1 + cw2 * x2 + cw3 * x3;
                *(LAS bf16_t*)(xcb + (t0 + i) * 144 + cch_ * 2) = f2bf(xc);
                x0 = x1; x1 = x2; x2 = x3;
            }
        }
        __syncthreads();
        if (tid < 24) *(LAS u32x4*)(lxs + tid * 8) = *(const LAS u32x4*)(lxs + 128 * 64 + tid * 8);
        {
            const bf16x8 af0 = *(const LAS bf16x8*)(xcb + (16 * w + l15) * 144 + (8 * g) * 2), af1 = *(const LAS bf16x8*)(xcb + (16 * w + l15) * 144 + (32 + 8 * g) * 2);
#pragma unroll
            for (int nb = 0; nb < 4; ++nb) {
                f32x4 ar = {0.f, 0.f, 0.f, 0.f}, ax = {0.f, 0.f, 0.f, 0.f};
                const LAS unsigned char* wr_ = wlds + (16 * nb + l15) * 144 + 16 * g;
                ar = mfma16(af0, *(const LAS bf16x8*)(wr_), ar); ar = mfma16(af1, *(const LAS bf16x8*)(wr_ + 64), ar);
                ax = mfma16(af0, wfx[nb][0], ax); ax = mfma16(af1, wfx[nb][1], ax);
#pragma unroll
                for (int rg = 0; rg < 4; ++rg) { rgt[(16 * w + 4 * g + rg) * 64 + 16 * nb + l15] = __builtin_amdgcn_rcpf(1.0f + __builtin_amdgcn_exp2f(ar[rg] + bia[nb])); igt[(16 * w + 4 * g + rg) * 64 + 16 * nb + l15] = __builtin_amdgcn_rcpf(1.0f + __builtin_amdgcn_exp2f(ax[rg] + bix[nb])); }
            }
        }
        __syncthreads();
        float av[16], bv[16]; float Aw = 1.0f, Hw = 0.0f;
#pragma unroll
        for (int tt = 0; tt < 16; ++tt) {
            const int t = 16 * w + tt;
            const float aa = __builtin_amdgcn_exp2f(cc * rgt[t * 64 + lane]);
            const float bb = __builtin_amdgcn_sqrtf(fmaxf(1.0f - aa * aa, 0.0f)) * igt[t * 64 + lane] * bf2f(*(const LAS bf16_t*)(xcb + t * 144 + lane * 2));
            av[tt] = aa; bv[tt] = bb; Hw = aa * Hw + bb; Aw *= aa;
        }
        wst[w * 64 + lane] = Aw; wst[512 + w * 64 + lane] = Hw;
        __syncthreads();
        float hcur = hcarry, hend = hcarry;
#pragma unroll
        for (int ww = 0; ww < 8; ++ww) { const float A_ = wst[ww * 64 + lane], H_ = wst[512 + ww * 64 + lane]; hend = A_ * hend + H_; if (ww < w) hcur = hend; }
        hcarry = hend;
        bf16_t* yb = (bf16_t*)(ws + WS_YB) + ((size_t)b * SEQ + c * 128 + 16 * w) * 1024 + gc;
#pragma unroll
        for (int tt = 0; tt < 16; tt += 2) {
            const float h0 = av[tt] * hcur + bv[tt]; hcur = av[tt + 1] * h0 + bv[tt + 1];
            const pg8::f32x2 gl = pg8::gelu_pk((pg8::f32x2){bf2f(lgs[(16 * w + tt) * 64 + lane]), bf2f(lgs[(16 * w + tt + 1) * 64 + lane])});
            yb[(size_t)tt * 1024] = f2bf(h0 * gl.x); yb[(size_t)(tt + 1) * 1024] = f2bf(hcur * gl.y);
        }
    }
    __syncthreads();
}

DI void retscan_unit(const Args& a, int unit) {
    unsigned char* ws = a.ws;
    const int e8 = unit * 512 + mk_tid();
    const int bh = e8 >> 13, within = e8 & 8191, h = bh & 3;
    const float g128 = exp2f(128.0f * log2gamma(h));
    bf16_t* base = (bf16_t*)(ws + WS_KVB) + (size_t)bh * 32 * 65536 + (size_t)within * 8;
    float st[8];
#pragma unroll
    for (int q = 0; q < 8; ++q) st[q] = 0.f;
#pragma unroll 1
    for (int c0 = 0; c0 < 32; c0 += 8) {
        u32x4 kv[8];
#pragma unroll
        for (int q = 0; q < 8; ++q) kv[q] = *(const u32x4*)(base + (size_t)(c0 + q) * 65536);
#pragma unroll
        for (int q = 0; q < 8; ++q) {
            u32x4 o;
#pragma unroll
            for (int j = 0; j < 4; ++j) o[j] = pk2(st[2 * j], st[2 * j + 1]);
            *(u32x4*)(base + (size_t)(c0 + q) * 65536) = o;
#pragma unroll
            for (int j = 0; j < 4; ++j) { st[2 * j] = g128 * st[2 * j] + bflo(kv[q][j]); st[2 * j + 1] = g128 * st[2 * j + 1] + bfhi(kv[q][j]); }
        }
    }
}

DI void attmerge_unit(const Args& a, int unit) {
    unsigned char* ws = a.ws;
    const int idx = unit * 512 + mk_tid(), t = idx >> 6, hp = (idx >> 4) & 3, dc = idx & 15;
    const float* lse = (const float*)(ws + WS_LSE) + (size_t)t * 12;
    const float l0 = lse[hp], l1 = lse[4 + hp], l2 = lse[8 + hp];
    const float m = fmaxf(l0, fmaxf(l1, l2));
    float w0 = __builtin_amdgcn_exp2f(l0 - m), w1 = __builtin_amdgcn_exp2f(l1 - m), w2 = __builtin_amdgcn_exp2f(l2 - m);
    const float is = 1.0f / (w0 + w1 + w2); w0 *= is; w1 *= is; w2 *= is;
    const bf16_t* o = (const bf16_t*)(ws + WS_OATT) + (size_t)t * 1536 + hp * 128 + dc * 8;
    const u32x4 a0 = *(const u32x4*)o, a1 = *(const u32x4*)(o + 512), a2 = *(const u32x4*)(o + 1024);
    u32x4 r;
#pragma unroll
    for (int q = 0; q < 4; ++q) r[q] = pk2(w0 * bflo(a0[q]) + w1 * bflo(a1[q]) + w2 * bflo(a2[q]), w0 * bfhi(a0[q]) + w1 * bfhi(a1[q]) + w2 * bfhi(a2[q]));
    *(u32x4*)((bf16_t*)(ws + WS_YA) + (size_t)t * 512 + hp * 128 + dc * 8) = r;
}

DI void retout_unit(const Args& a, int unit, LAS unsigned char* lds, int dry) {
    unsigned char* ws = a.ws;
    const int tid = mk_tid(), lane = tid & 63, w = __builtin_amdgcn_readfirstlane(tid >> 6), g = lane >> 4, l15 = lane & 15, tq4 = l15 >> 2, tp4 = l15 & 3;
    const int b = unit >> 7, h = (unit >> 5) & 3, c = unit & 31;
    const bf16_t* proj = (const bf16_t*)(ws + WS_PROJ) + ((size_t)b * SEQ + c * 128) * DIN;
    const bf16_t* rt = (const bf16_t*)(ws + WS_KVB) + ((size_t)((b * 4 + h) * 32 + c)) * 65536;
    LAS unsigned char* RA = lds; LAS unsigned char* RB = lds + 128 * 544;
    const float l2g = log2gamma(h);
    const int qi = 16 * w + l15;
    bf16x8 qf[8];
#pragma unroll
    for (int ks = 0; ks < 8; ++ks) qf[ks] = *(const bf16x8*)(proj + (size_t)qi * DIN + OFF_RQ + h * 256 + 32 * ks + 8 * g);
#pragma unroll
    for (int i = 0; i < 8; ++i) {
        const int idx = tid + 512 * i, row = idx >> 5, ch = idx & 31;
        *(LAS u32x4*)(RA + row * 544 + ch * 16) = *(const u32x4*)(proj + (size_t)row * DIN + OFF_RK + h * 256 + ch * 8);
        *(LAS u32x4*)(RB + row * 544 + ch * 16) = *(const u32x4*)(rt + (size_t)row * 256 + ch * 8);
    }
    __syncthreads();
    if (dry == 1) { asm volatile("" :: "v"(qf[0]), "v"(qf[7])); __syncthreads(); return; }
    u32x4 pv[8], pr[8];
#pragma unroll
    for (int i = 0; i < 8; ++i) {
        const int idx = tid + 512 * i, row = idx >> 5, ch = idx & 31;
        pv[i] = *(const u32x4*)(proj + (size_t)row * DIN + OFF_RV + h * 256 + ch * 8);
        pr[i] = *(const u32x4*)(rt + (size_t)(128 + row) * 256 + ch * 8);
    }
    f32x4 sacc[8], oacc[16];
#pragma unroll
    for (int jj = 0; jj < 8; ++jj) {
        f32x4 acc = {0.f, 0.f, 0.f, 0.f};
        if (jj <= w) {
#pragma unroll
            for (int ks = 0; ks < 8; ++ks) { const bf16x8 kf = *(const LAS bf16x8*)(RA + (16 * jj + l15) * 544 + (32 * ks + 8 * g) * 2); acc = mfma16(kf, qf[ks], acc); }
        }
        sacc[jj] = acc;
    }
#pragma unroll
    for (int db = 0; db < 8; ++db) {
        f32x4 acc = {0.f, 0.f, 0.f, 0.f};
#pragma unroll
        for (int ks = 0; ks < 8; ++ks) { const bf16x8 rf = *(const LAS bf16x8*)(RB + (16 * db + l15) * 544 + (32 * ks + 8 * g) * 2); acc = mfma16(rf, qf[ks], acc); }
        oacc[db] = acc;
    }
    __syncthreads();
    if (dry == 2) { asm volatile("" :: "v"(sacc[0]), "v"(sacc[7]), "v"(oacc[0]), "v"(oacc[7])); return; }
#pragma unroll
    for (int i = 0; i < 8; ++i) {
        const int idx = tid + 512 * i, row = idx >> 5, ch = idx & 31;
        *(LAS u32x4*)(RA + row * 544 + ch * 16) = pv[i];
        *(LAS u32x4*)(RB + row * 544 + ch * 16) = pr[i];
    }
    __syncthreads();
#pragma unroll
    for (int db = 0; db < 8; ++db) {
        f32x4 acc = {0.f, 0.f, 0.f, 0.f};
#pragma unroll
        for (int ks = 0; ks < 8; ++ks) { const bf16x8 rf = *(const LAS bf16x8*)(RB + (16 * db + l15) * 544 + (32 * ks + 8 * g) * 2); acc = mfma16(rf, qf[ks], acc); }
        oacc[8 + db] = acc;
    }
    const float xi = __builtin_amdgcn_exp2f((float)(qi + 1) * l2g);
#pragma unroll
    for (int db = 0; db < 16; ++db) oacc[db] = oacc[db] * xi;
#pragma unroll
    for (int jj = 0; jj < 8; ++jj)
#pragma unroll
        for (int rg = 0; rg < 4; ++rg) { const int j = 16 * jj + 4 * g + rg; sacc[jj][rg] = (qi >= j) ? sacc[jj][rg] * __builtin_amdgcn_exp2f((float)(qi - j) * l2g) : 0.f; }
#pragma unroll
    for (int s = 0; s < 4; ++s) {
        if (2 * s <= w) {
            u32x4 pw; pw.x = pk2(sacc[2 * s][0], sacc[2 * s][1]); pw.y = pk2(sacc[2 * s][2], sacc[2 * s][3]); pw.z = pk2(sacc[2 * s + 1][0], sacc[2 * s + 1][1]); pw.w = pk2(sacc[2 * s + 1][2], sacc[2 * s + 1][3]);
            const bf16x8 pb = __builtin_bit_cast(bf16x8, pw);
            const int k0 = 32 * s + 4 * g + tq4;
#pragma unroll
            for (int db = 0; db < 16; ++db) {
                const s16x4 lo = trrd(RA + k0 * 544 + (16 * db + 4 * tp4) * 2), hi = trrd(RA + (k0 + 16) * 544 + (16 * db + 4 * tp4) * 2);
                oacc[db] = mfma16(cat8(lo, hi), pb, oacc[db]);
            }
        }
    }
    float s1 = 0.f;
#pragma unroll
    for (int db = 0; db < 16; ++db) s1 += (oacc[db][0] + oacc[db][1]) + (oacc[db][2] + oacc[db][3]);
    s1 += __shfl_xor(s1, 16); s1 += __shfl_xor(s1, 32);
    const float mean = s1 * (1.0f / 256.0f);
    float s2 = 0.f;
#pragma unroll
    for (int db = 0; db < 16; ++db)
#pragma unroll
        for (int rg = 0; rg < 4; ++rg) { const float dd = oacc[db][rg] - mean; s2 += dd * dd; }
    s2 += __shfl_xor(s2, 16); s2 += __shfl_xor(s2, 32);
    const float rstd = rsqrtf(s2 * (1.0f / 256.0f) + LN_EPS);
    if (dry == 3) { asm volatile("" :: "v"(mean), "v"(rstd), "v"(oacc[0]), "v"(oacc[15])); __syncthreads(); return; }
    __syncthreads();
#pragma unroll
    for (int db = 0; db < 16; ++db) {
        u32x2 o; o.x = pk2((oacc[db][0] - mean) * rstd, (oacc[db][1] - mean) * rstd); o.y = pk2((oacc[db][2] - mean) * rstd, (oacc[db][3] - mean) * rstd);
        *(LAS u32x2*)(RA + qi * 528 + (16 * db + 4 * g) * 2) = o;
    }
    __syncthreads();
#pragma unroll
    for (int i = 0; i < 8; ++i) {
        const int idx = tid + 512 * i, row = idx >> 5, ch = idx & 31;
        const u32x4 nv = *(const LAS u32x4*)(RA + row * 528 + ch * 16);
        const u32x4 gw = *(const u32x4*)(proj + (size_t)row * DIN + OFF_RG + h * 256 + ch * 8);
        u32x4 o;
#pragma unroll
        for (int q = 0; q < 4; ++q) { const float g0 = bflo(gw[q]), g1 = bfhi(gw[q]); o[q] = pk2(g0 * sigm(g0) * bflo(nv[q]), g1 * sigm(g1) * bfhi(nv[q])); }
        *(u32x4*)((bf16_t*)(ws + WS_YC) + ((size_t)b * SEQ + c * 128 + row) * 1024 + h * 256 + ch * 8) = o;
    }
    __syncthreads();
}

struct EpiBranch {
    static constexpr bool PERM = false, AFTER_DRAIN = false;
    const bf16_t* gate; bf16_t* mf; bf16_t* mb; int mode;
    __device__ __forceinline__ void operator()(const f32x4 (&acc)[2][2][4][2], const pg8::Unit& u, int wr, int wc, int fr, int fq) const {
        const int row0 = u.pm * 256 + wr * 64 + fr, col0 = u.pn * 256 + wc * 32 + 4 * fq;
        bf16_t* dst = (mode == 2) ? mb : mf;
#pragma unroll
        for (int ai = 0; ai < 2; ++ai) {
            u32x2 gw[4][2][2], old[4][2][2];
#pragma unroll
            for (int m = 0; m < 4; ++m) { const size_t row = (size_t)(row0 + ai * 128 + m * 16);
#pragma unroll
                for (int bj = 0; bj < 2; ++bj)
#pragma unroll
                    for (int n = 0; n < 2; ++n) { const int col = col0 + bj * 128 + n * 16;
                        gw[m][bj][n] = *(const u32x2*)(gate + row * DIN + col);
                        old[m][bj][n] = (mode != 0) ? *(const u32x2*)(mf + row * 1024 + col) : (u32x2){0u, 0u}; } }
#pragma unroll
            for (int m = 0; m < 4; ++m) { const size_t row = (size_t)(row0 + ai * 128 + m * 16);
#pragma unroll
                for (int bj = 0; bj < 2; ++bj)
#pragma unroll
                    for (int n = 0; n < 2; ++n) { const int col = col0 + bj * 128 + n * 16;
                        const u32x2 g2 = gw[m][bj][n], o2 = old[m][bj][n];
                        f32x4 v = acc[ai][bj][m][n];
                        v[0] = v[0] * sigm(bflo(g2.x)) + bflo(o2.x); v[1] = v[1] * sigm(bfhi(g2.x)) + bfhi(o2.x);
                        v[2] = v[2] * sigm(bflo(g2.y)) + bflo(o2.y); v[3] = v[3] * sigm(bfhi(g2.y)) + bfhi(o2.y);
                        u32x2 o; o.x = pk2(v[0], v[1]); o.y = pk2(v[2], v[3]); *(u32x2*)(dst + row * 1024 + col) = o; } }
        }
    }
};
#ifndef MK_EPI_AUX
#define MK_EPI_AUX 0
#endif
struct EpiInProj {
    static constexpr bool PERM = true, AFTER_DRAIN = false;
    bf16_t* O; int dry;
    __device__ __forceinline__ void operator()(const f32x4 (&acc)[2][2][4][2], const pg8::Unit& u, int wr_, int wc_, int fr_, int fq_) const {
        (void)wr_; (void)wc_; (void)fr_; (void)fq_;
        if (dry == 1) return;
        if (dry == 4) {
#pragma unroll
            for (int ai = 0; ai < 2; ++ai)
#pragma unroll
                for (int bj = 0; bj < 2; ++bj)
#pragma unroll
                    for (int m = 0; m < 4; ++m) { asm volatile("" :: "v"(acc[ai][bj][m][0]), "v"(acc[ai][bj][m][1])); }
            return; }
        const int tid = mk_tid(), wid = tid >> 6, lane = tid & 63, wr = wid >> 2, wc = wid & 3, fr = lane & 15, fq = lane >> 4;
        const __amdgpu_buffer_rsrc_t rsrc = __builtin_amdgcn_make_buffer_rsrc((void*)O, 0, (int)((size_t)NTOK * DIN * 2), 0x00020000);
        const int row0 = u.pm * 256 + wr * 64 + fr;
        const int pn = u.pn;
        const bool ropeA = (dry != 3) && pn < 12, ropeR = (dry != 3) && (pn >= 26 && pn < 34);
        const float dsc = 1.0f / (X8_SCALE * W8_SCALE);
        if (!(ropeA || ropeR)) {
            const int col0 = pn * 256 + 64 * wc + 8 * fq;
#pragma unroll
            for (int ai = 0; ai < 2; ++ai) {
#pragma unroll
                for (int m = 0; m < 4; ++m) { const unsigned roff = (unsigned)(((size_t)(row0 + ai * 128 + m * 16) * DIN + col0) * 2);
#pragma unroll
                    for (int bj = 0; bj < 2; ++bj) { const f32x4 v0 = acc[ai][bj][m][0] * dsc, v1 = acc[ai][bj][m][1] * dsc;
                        u32x4 w; w.x = pk2(v0[0], v0[1]); w.y = pk2(v0[2], v0[3]); w.z = pk2(v1[0], v1[1]); w.w = pk2(v1[2], v1[3]);
                        if (dry >= 2) { asm volatile("" :: "v"(w)); } else __builtin_amdgcn_raw_buffer_store_b128(w, rsrc, (int)(roff + bj * 64), 0, MK_EPI_AUX); } }
            }
        } else {
            const int half = ropeA ? 64 : 128;
            const float sc = (pn >= 30 && pn < 34) ? 0.0625f : 1.0f;
            const float kf = ropeA ? (-13.287712379549449f / 64.0f) : (-13.287712379549449f / 128.0f);
            const float pos0 = (float)(row0 & (SEQ - 1));
#pragma unroll
            for (int bj = 0; bj < 2; ++bj) {
                const int pc = 64 * wc + 32 * bj + 8 * fq;
                const int cbase = ropeA ? (pc & 128) : 0;
                const int q = ropeA ? ((pc & 127) >> 3) : (pc >> 3);
                f32x4 cb, sb, c16, s16, cb1, sb1;
#pragma unroll
                for (int e = 0; e < 4; ++e) {
                    const float f = __builtin_amdgcn_exp2f((float)(4 * q + e) * kf) * 0.15915494309189535f;
                    const float t0 = __builtin_amdgcn_fractf(pos0 * f), t16 = __builtin_amdgcn_fractf(16.0f * f), t128 = __builtin_amdgcn_fractf(128.0f * f);
                    cb[e] = __builtin_amdgcn_cosf(t0); sb[e] = __builtin_amdgcn_sinf(t0);
                    c16[e] = __builtin_amdgcn_cosf(t16); s16[e] = __builtin_amdgcn_sinf(t16);
                    const float c128 = __builtin_amdgcn_cosf(t128), s128 = __builtin_amdgcn_sinf(t128);
                    cb1[e] = cb[e] * c128 - sb[e] * s128; sb1[e] = sb[e] * c128 + cb[e] * s128;
                }
#pragma unroll
                for (int ai = 0; ai < 2; ++ai) {
                    f32x4 cv = ai ? cb1 : cb, sv = ai ? sb1 : sb;
#pragma unroll
                    for (int m = 0; m < 4; ++m) {
                        const int row = row0 + ai * 128 + m * 16;
                        const unsigned roff = (unsigned)(((size_t)row * DIN + pn * 256) * 2);
                        const float rsc = dsc * sc;
                        const f32x4 t1 = acc[ai][bj][m][0] * rsc, t2 = acc[ai][bj][m][1] * rsc;
                        const f32x4 o1 = t1 * cv - t2 * sv, o2 = t1 * sv + t2 * cv;
                        u32x2 w1, w2; w1.x = pk2(o1[0], o1[1]); w1.y = pk2(o1[2], o1[3]); w2.x = pk2(o2[0], o2[1]); w2.y = pk2(o2[2], o2[3]);
                        if (dry == 2) { asm volatile("" :: "v"(w1), "v"(w2)); }
                        else { __builtin_amdgcn_raw_buffer_store_b64(w1, rsrc, (int)(roff + (cbase + 4 * q) * 2), 0, MK_EPI_AUX); __builtin_amdgcn_raw_buffer_store_b64(w2, rsrc, (int)(roff + (cbase + half + 4 * q) * 2), 0, MK_EPI_AUX); }
                        if (m < 3) { const f32x4 cn = cv * c16 - sv * s16, sn = sv * c16 + cv * s16; cv = cn; sv = sn; }
                    }
                }
            }
        }
    }
};

struct EpiOut {
    static constexpr bool PERM = false, AFTER_DRAIN = false;
    const float* xf; float* z;
    __device__ __forceinline__ void operator()(const f32x4 (&acc)[2][2][4][2], const pg8::Unit& u, int wr, int wc, int fr, int fq) const {
        const int row0 = u.pm * 256 + wr * 64 + fr, col0 = u.pn * 256 + wc * 32 + 4 * fq;
#pragma unroll
        for (int ai = 0; ai < 2; ++ai) {
            f32x4 xv[4][2][2];
#pragma unroll
            for (int m = 0; m < 4; ++m) { const size_t row = (size_t)(row0 + ai * 128 + m * 16);
#pragma unroll
                for (int bj = 0; bj < 2; ++bj)
#pragma unroll
                    for (int n = 0; n < 2; ++n) xv[m][bj][n] = *(const f32x4*)(xf + row * 1024 + col0 + bj * 128 + n * 16); }
#pragma unroll
            for (int m = 0; m < 4; ++m) { const size_t row = (size_t)(row0 + ai * 128 + m * 16);
#pragma unroll
                for (int bj = 0; bj < 2; ++bj)
#pragma unroll
                    for (int n = 0; n < 2; ++n) *(f32x4*)(z + row * 1024 + col0 + bj * 128 + n * 16) = xv[m][bj][n] * ALPHA + acc[ai][bj][m][n]; }
        }
    }
};

DI void ln_row(const float* z, const float* gam, const float* bet, float* of, bf16_t* ob, int lane) {
    f32x4 v[4]; float s = 0.f;
#pragma unroll
    for (int i = 0; i < 4; ++i) { v[i] = *(const f32x4*)(z + 256 * i + 4 * lane); s += (v[i][0] + v[i][1]) + (v[i][2] + v[i][3]); }
    const float mean = wsum(s) * (1.0f / 1024.0f);
    float q = 0.f;
#pragma unroll
    for (int i = 0; i < 4; ++i)
#pragma unroll
        for (int j = 0; j < 4; ++j) { const float d = v[i][j] - mean; q += d * d; }
    const float rstd = rsqrtf(wsum(q) * (1.0f / 1024.0f) + LN_EPS);
#pragma unroll
    for (int i = 0; i < 4; ++i) {
        const f32x4 gg = *(const f32x4*)(gam + 256 * i + 4 * lane), bb = *(const f32x4*)(bet + 256 * i + 4 * lane);
        f32x4 o;
#pragma unroll
        for (int j = 0; j < 4; ++j) o[j] = (v[i][j] - mean) * rstd * gg[j] + bb[j];
        *(f32x4*)(of + 256 * i + 4 * lane) = o;
        u32x2 pb; pb.x = pk2(o[0], o[1]); pb.y = pk2(o[2], o[3]); *(u32x2*)(ob + 256 * i + 4 * lane) = pb;
    }
}
DI void phase_ln1(const Args& a, int layer) {
    unsigned char* ws = a.ws;
    const int lane = mk_tid() & 63, w = mk_tid() >> 6;
    for (int u = blockIdx.x; u < NTOK / 8; u += gridDim.x) {
        const size_t row = (size_t)u * 8 + w;
        ln_row((const float*)(ws + WS_MRGF) + row * 1024, a.in[11] + layer * 1024, a.in[12] + layer * 1024, (float*)(ws + WS_XF) + row * 1024, (bf16_t*)(ws + WS_XB) + row * 1024, lane);
    }
}

DI void ins16(float (&L)[16], float x) {
#pragma unroll
    for (int k = 0; k < 16; ++k) { const float hi = fmaxf(L[k], x); x = fminf(L[k], x); L[k] = hi; }
}
DI void merge16(float (&L)[16], int xr) {
    float t[16];
#pragma unroll
    for (int k = 0; k < 16; ++k) t[k] = __shfl_xor(L[k], xr);
#pragma unroll
    for (int k = 0; k < 8; ++k) { const float x = t[k]; t[k] = t[15 - k]; t[15 - k] = x; }
#pragma unroll
    for (int k = 0; k < 16; ++k) t[k] = fmaxf(L[k], t[k]);
#define MK_CE_STAGE(dd) _Pragma("unroll") for (int k = 0; k < 16; ++k) if ((k & (dd)) == 0) { const float hi = fmaxf(t[k], t[k + (dd)]), lo = fminf(t[k], t[k + (dd)]); t[k] = hi; t[k + (dd)] = lo; }
    MK_CE_STAGE(8) MK_CE_STAGE(4) MK_CE_STAGE(2) MK_CE_STAGE(1)
#undef MK_CE_STAGE
#pragma unroll
    for (int k = 0; k < 16; ++k) L[k] = t[k];
}
DI float sel16(const float (&L)[16], unsigned idx) {
    float r = L[0];
#pragma unroll
    for (int k = 1; k < 16; ++k) r = (idx == (unsigned)k) ? L[k] : r;
    return r;
}
#define MK_CE_DESC(v, i, l) { const float hi_ = fmaxf(v[i], v[l]), lo_ = fminf(v[i], v[l]); v[i] = hi_; v[l] = lo_; }
#define MK_CE_ASC(v, i, l)  { const float hi_ = fmaxf(v[i], v[l]), lo_ = fminf(v[i], v[l]); v[i] = lo_; v[l] = hi_; }
#define MK_BITONIC_STAGE(v, kk, jj) _Pragma("unroll") for (int i_ = 0; i_ < 16; ++i_) { if ((i_ & (jj)) == 0) { if ((i_ & (kk)) == 0) MK_CE_DESC(v, i_, i_ + (jj)) else MK_CE_ASC(v, i_, i_ + (jj)) } }
DI void sort16_desc(float (&v)[16]) {
    MK_BITONIC_STAGE(v, 2, 1)
    MK_BITONIC_STAGE(v, 4, 2) MK_BITONIC_STAGE(v, 4, 1)
    MK_BITONIC_STAGE(v, 8, 4) MK_BITONIC_STAGE(v, 8, 2) MK_BITONIC_STAGE(v, 8, 1)
    MK_BITONIC_STAGE(v, 16, 8) MK_BITONIC_STAGE(v, 16, 4) MK_BITONIC_STAGE(v, 16, 2) MK_BITONIC_STAGE(v, 16, 1)
}
DI void top16_of_two(float (&a)[16], const float (&b)[16]) {
#pragma unroll
    for (int k = 0; k < 16; ++k) a[k] = fmaxf(a[k], b[15 - k]);
    MK_BITONIC_STAGE(a, 16, 8) MK_BITONIC_STAGE(a, 16, 4) MK_BITONIC_STAGE(a, 16, 2) MK_BITONIC_STAGE(a, 16, 1)
}
DI void top16_half(const bf16_t* qp, const bf16_t* kb, float (&L)[16], int g, int l15) {
    bf16x8 qf[4];
#pragma unroll
    for (int ks = 0; ks < 4; ++ks) qf[ks] = *(const bf16x8*)(qp + 32 * ks + 8 * g);
    float M[16];
#pragma unroll
    for (int kbk = 0; kbk < 8; ++kbk) {
        f32x4 acc = {0.f, 0.f, 0.f, 0.f};
#pragma unroll
        for (int ks = 0; ks < 4; ++ks) { const bf16x8 kf = *(const bf16x8*)(kb + (size_t)(16 * kbk + l15) * 128 + 32 * ks + 8 * g); acc = mfma16(kf, qf[ks], acc); }
#pragma unroll
        for (int rg = 0; rg < 4; ++rg) { const unsigned key = (unsigned)(16 * kbk + 4 * g + rg); const float x = __uint_as_float((__float_as_uint(acc[rg]) & ~0x7Fu) | key);
            if (kbk < 4) L[4 * kbk + rg] = x; else M[4 * (kbk - 4) + rg] = x; }
    }
    sort16_desc(L); sort16_desc(M); top16_of_two(L, M);
    merge16(L, 16); merge16(L, 32);
}
DI void topk_unit(const Args& a, int unit, LAS unsigned char* lds) {
    unsigned char* ws = a.ws;
    const int tid = mk_tid(), lane = tid & 63, w = __builtin_amdgcn_readfirstlane(tid >> 6), g = lane >> 4, l15 = lane & 15;
    const int tg = w & 3, hs = w >> 2;
    const size_t t = (size_t)unit * 64 + tg * 16 + l15;
    const bf16_t* Q = (const bf16_t*)(ws + WS_Q);
    float K1[16], K2[16];
#pragma unroll
    for (int k = 0; k < 16; ++k) { K1[k] = 0.f; K2[k] = 0.f; }
#pragma unroll 1
    for (int hh = 0; hh < 4; ++hh) {
        const int h = hs * 4 + hh;
        float l1[16], l2[16];
        top16_half(Q + t * 2048 + h * 256, (const bf16_t*)(ws + WS_K1B) + (size_t)h * 16384, l1, g, l15);
        top16_half(Q + t * 2048 + h * 256 + 128, (const bf16_t*)(ws + WS_K2B) + (size_t)h * 16384, l2, g, l15);
        const bool mine = (g == hh);
#pragma unroll
        for (int k = 0; k < 16; ++k) { K1[k] = mine ? l1[k] : K1[k]; K2[k] = mine ? l2[k] : K2[k]; }
    }
    const int h = hs * 4 + g;
    float F[16];
#pragma unroll
    for (int k = 0; k < 16; ++k) F[k] = -FLT_MAX;
#pragma unroll
    for (int ia = 0; ia < 16; ++ia)
#pragma unroll
        for (int ib = 0; ib < 16 / (ia + 1); ++ib) {
            const float s = __uint_as_float(__float_as_uint(K1[ia]) & ~0x7Fu) + __uint_as_float(__float_as_uint(K2[ib]) & ~0x7Fu);
            ins16(F, __uint_as_float((__float_as_uint(s) & ~0xFFu) | (unsigned)(ia * 16 + ib)));
        }
    LAS int* row = (LAS int*)lds + tid * 33;
#pragma unroll
    for (int k = 0; k < 16; ++k) { row[k] = (int)(__float_as_uint(K1[k]) & 0x7Fu); row[16 + k] = (int)(__float_as_uint(K2[k]) & 0x7Fu); }
    float gt[16]; int ei[16]; float gs = 0.f;
    const float cv0 = __uint_as_float(__float_as_uint(F[0]) & ~0xFFu);
#pragma unroll
    for (int k = 0; k < 16; ++k) {
        const unsigned bits = __float_as_uint(F[k]);
        const float cv = __uint_as_float(bits & ~0xFFu);
        gt[k] = __builtin_amdgcn_exp2f((cv - cv0) * 1.4426950408889634f); gs += gt[k];
        const int ia = (int)((bits >> 4) & 15u), ib = (int)(bits & 15u);
        ei[k] = row[ia] * 128 + row[16 + ib];
    }
    const float ig = 1.0f / gs;
    int* ep = (int*)(ws + WS_EID) + (t * 8 + h) * 16; float* gp = (float*)(ws + WS_GATE) + (t * 8 + h) * 16;
#pragma unroll
    for (int q = 0; q < 4; ++q) {
        *(i32x4*)(ep + 4 * q) = (i32x4){ei[4 * q], ei[4 * q + 1], ei[4 * q + 2], ei[4 * q + 3]};
        *(f32x4*)(gp + 4 * q) = (f32x4){gt[4 * q] * ig, gt[4 * q + 1] * ig, gt[4 * q + 2] * ig, gt[4 * q + 3] * ig};
    }
}

typedef float f32x2 __attribute__((ext_vector_type(2)));
#define MK_PEER_LOAD1(j, ereg, kk) { const int e_ = __builtin_amdgcn_readlane(ereg, (kk)); \
        const unsigned char* p_ = UV + (size_t)(unsigned)e_ * 1536u; RA[j] = ((const u32x4*)p_)[lane]; RB[j] = ((const u32x2*)(p_ + 1024))[lane]; }
#define MK_PEER_COMP1(j, usreg, gvreg, kk) { \
        const float us_ = __uint_as_float(__builtin_amdgcn_readlane(__float_as_uint(usreg), (kk))), gv_ = __uint_as_float(__builtin_amdgcn_readlane(__float_as_uint(gvreg), (kk))); \
        const f32x32 r_ = __builtin_amdgcn_cvt_scalef32_pk32_f32_fp6((u32x6){RA[j][0], RA[j][1], RA[j][2], RA[j][3], RB[j][0], RB[j][1]}, 1.0f); \
        f32x2 p2_ = {0.f, 0.f}; \
        _Pragma("unroll") for (int q = 0; q < 8; ++q) p2_ += (f32x2){r_[2 * q], r_[2 * q + 1]} * x2[q]; \
        const float p_ = wsum_dpp(p2_.x + p2_.y) * us_; \
        const float act_ = gelu_as(p_) * gv_; const f32x2 a2_ = {act_, act_}; \
        _Pragma("unroll") for (int q = 0; q < 8; ++q) y2[q] += a2_ * (f32x2){r_[16 + 2 * q], r_[16 + 2 * q + 1]}; \
        __builtin_amdgcn_sched_barrier(0); }
DI void peer_token(const unsigned char* UV, int e0, int e1, float us0, float us1, float gv0, float gv1, const f32x2 (&x2)[8], f32x2 (&y2)[8], int lane) {
    u32x4 RA[8]; u32x2 RB[8];
#pragma unroll
    for (int j = 0; j < 8; ++j) MK_PEER_LOAD1(j, e0, j)
#pragma unroll 1
    for (int k = 0; k < 56; k += 8) {
#pragma unroll
        for (int j = 0; j < 8; ++j) { MK_PEER_COMP1(j, us0, gv0, k + j) MK_PEER_LOAD1(j, e0, k + 8 + j) }
    }
#pragma unroll
    for (int j = 0; j < 8; ++j) { MK_PEER_COMP1(j, us0, gv0, 56 + j) MK_PEER_LOAD1(j, e1, j) }
#pragma unroll 1
    for (int k = 0; k < 56; k += 8) {
#pragma unroll
        for (int j = 0; j < 8; ++j) { MK_PEER_COMP1(j, us1, gv1, k + j) MK_PEER_LOAD1(j, e1, k + 8 + j) }
    }
#pragma unroll
    for (int j = 0; j < 8; ++j) { MK_PEER_COMP1(j, us1, gv1, 56 + j) }
}
DI void peer_unit(const Args& a, int layer, int unit, bool dry) {
    unsigned char* ws = a.ws;
    const int tid = mk_tid(), lane = tid & 63, w = __builtin_amdgcn_readfirstlane(tid >> 6);
    const unsigned char* UV = ws + WS_UV8; const float* SC = (const float*)(ws + WS_UVS);
#pragma unroll 1
    for (int i = 0; i < 8; ++i) {
        const size_t t = (size_t)unit * 64 + w * 8 + i;
        f32x2 x2[8], y2[8];
        int e0, e1; float us0, us1, gv0, gv1;
        {
            const int ln = mk_tid() & 63;
            const bf16_t* xbp = (const bf16_t*)(ws + WS_XB) + t * 1024 + 16 * ln;
            const u32x4 xa = *(const u32x4*)xbp, xb = *(const u32x4*)(xbp + 8);
#pragma unroll
            for (int q = 0; q < 4; ++q) { x2[q] = (f32x2){bflo(xa[q]), bfhi(xa[q])}; x2[4 + q] = (f32x2){bflo(xb[q]), bfhi(xb[q])}; }
            const int* ep = (const int*)(ws + WS_EID) + t * 128; const float* gp = (const float*)(ws + WS_GATE) + t * 128;
            e0 = ep[ln]; e1 = ep[64 + ln]; const float g0 = gp[ln], g1 = gp[64 + ln];
            const f32x2 s0 = *(const f32x2*)(SC + 2 * e0), s1 = *(const f32x2*)(SC + 2 * e1);
            us0 = s0.x; us1 = s1.x; gv0 = g0 * s0.y; gv1 = g1 * s1.y;
        }
#pragma unroll
        for (int q = 0; q < 8; ++q) y2[q] = (f32x2){0.f, 0.f};
        peer_token(UV, e0, e1, us0, us1, gv0, gv1, x2, y2, lane);
        {
            const int ln = mk_tid() & 63;
            float* xfp = (float*)(ws + WS_XF) + t * 1024 + 16 * ln;
            float* xfo = dry ? (float*)(ws + WS_MRGF) + t * 1024 + 16 * ln : xfp;
            const float* gam = a.in[18] + layer * 1024 + 16 * ln; const float* bet = a.in[19] + layer * 1024 + 16 * ln;
            float z[16]; float s = 0.f;
#pragma unroll
            for (int q = 0; q < 4; ++q) { const f32x4 xr = *(const f32x4*)(xfp + 4 * q);
#pragma unroll
                for (int j = 0; j < 4; ++j) { z[4 * q + j] = ALPHA * xr[j] + y2[2 * q + (j >> 1)][j & 1]; s += z[4 * q + j]; } }
            const float mean = wsum(s) * (1.0f / 1024.0f);
            float qq = 0.f;
#pragma unroll
            for (int q = 0; q < 16; ++q) { const float d = z[q] - mean; qq += d * d; }
            const float rstd = rsqrtf(wsum(qq) * (1.0f / 1024.0f) + LN_EPS);
            f32x4 o[4];
#pragma unroll
            for (int q = 0; q < 4; ++q) { const f32x4 gq = *(const f32x4*)(gam + 4 * q), bq = *(const f32x4*)(bet + 4 * q);
#pragma unroll
                for (int j = 0; j < 4; ++j) o[q][j] = (z[4 * q + j] - mean) * rstd * gq[j] + bq[j]; }
#pragma unroll
            for (int q = 0; q < 4; ++q) *(f32x4*)(xfo + 4 * q) = o[q];
            if (layer == DEPTH - 1 && !dry) { float* op = a.out + t * 1024 + 16 * ln;
#pragma unroll
                for (int q = 0; q < 4; ++q) *(f32x4*)(op + 4 * q) = o[q]; }
            if (!dry) row_to_fp8(o, ws + WS_X8 + t * 1024, ln);
        }
    }
}
}

namespace mk {
constexpr int LDS_ARG_OFF = LDS_BYTES - 16 - 256;
#define MK_NOINL __device__ __forceinline__
DI unsigned long long rfl64(unsigned long long v) { const unsigned lo = __builtin_amdgcn_readfirstlane((unsigned)v), hi = __builtin_amdgcn_readfirstlane((unsigned)(v >> 32)); return ((unsigned long long)hi << 32) | lo; }
DI Args load_args(LAS unsigned char* lds) {
    int aoff = LDS_ARG_OFF; asm volatile("" : "+s"(aoff));
    Args a; const LAS unsigned long long* p = (const LAS unsigned long long*)(lds + aoff);
#pragma unroll
    for (int i = 0; i < 20; ++i) a.in[i] = (const float*)(const __attribute__((address_space(1))) float*)rfl64(p[i]);
    a.out = (float*)(__attribute__((address_space(1))) float*)rfl64(p[20]); a.ws = (unsigned char*)(__attribute__((address_space(1))) unsigned char*)rfl64(p[21]);
    a.ropeA = __longlong_as_double((long long)rfl64(p[22])); a.ropeR = __longlong_as_double((long long)rfl64(p[23])); a.ph_lo = 0; a.ph_hi = 0;
    return a;
}
#define MK_LOADARGS const Args a = load_args(lds); unsigned char* ws = a.ws; const int G = (int)gridDim.x, bid = (int)blockIdx.x; (void)ws; (void)G; (void)bid
MK_NOINL void PG_prologue(LAS unsigned char* lds) { MK_LOADARGS; phase_prologue(a); }
MK_NOINL void P0_conv(LAS unsigned char* lds, int layer) { MK_LOADARGS; phase_conv(a, layer, lds); }
#ifndef MK_STAGGER_TICKS
#define MK_STAGGER_TICKS 140
#endif
MK_NOINL void P1_inproj(LAS unsigned char* lds, int layer, int dry) { MK_LOADARGS; (void)layer;
    pg8::Gemm gm; gm.A = (const bf16_t*)(ws + WS_X8); gm.Bt = (const bf16_t*)(ws + WS_WINT); gm.M = NTOK; gm.N = DIN; gm.K = 512;
    pg8::StaticOrder S; S.init(NTOK, DIN, G, bid);
    EpiInProj E; E.O = (bf16_t*)(ws + WS_PROJ); E.dry = dry;
    pg8::gemm_phase<EpiInProj, pg8::StaticOrder, false, true, true>(lds, gm, S, E, nullptr); }
MK_NOINL void P2_rope(LAS unsigned char* lds, int layer) { MK_LOADARGS; (void)layer; phase_rope(a); }
#ifndef MK_NLRU
#define MK_NLRU 64
#endif
MK_NOINL void P3s_lru(LAS unsigned char* lds, int layer) { MK_LOADARGS; if (bid < MK_NLRU) { for (int s = bid; s < 64; s += MK_NLRU) lru_stripe(a, layer, s, lds); } }
MK_NOINL void P3a_attn(LAS unsigned char* lds, int layer) { MK_LOADARGS; (void)layer; if (bid >= MK_NLRU) { for (int u = bid - MK_NLRU; u < 1536; u += G - MK_NLRU) attn_unit(a, u, lds); } }
MK_NOINL void P3b_retkv(LAS unsigned char* lds, int layer) { MK_LOADARGS; (void)layer; if (bid >= MK_NLRU) { for (int u = bid - MK_NLRU; u < 512; u += G - MK_NLRU) retkv_unit(a, u, lds); } }
MK_NOINL void P4a_scan(LAS unsigned char* lds, int layer) { MK_LOADARGS; (void)layer; for (int u = bid; u < 256; u += G) retscan_unit(a, u); }
MK_NOINL void P4c_merge(LAS unsigned char* lds, int layer) { MK_LOADARGS; (void)layer; for (int u = bid; u < 2048; u += G) attmerge_unit(a, u); }
MK_NOINL void P5_retout(LAS unsigned char* lds, int layer, int dry) { MK_LOADARGS; (void)layer; for (int u = bid; u < 512; u += G) retout_unit(a, u, lds, dry); }
MK_NOINL void P6_branch(LAS unsigned char* lds, int layer) { MK_LOADARGS; (void)layer;
#pragma unroll 1
    for (int s = 0; s < 3; ++s) {
        pg8::Gemm gm; gm.A = (const bf16_t*)(ws + (s == 0 ? WS_YA : (s == 1 ? WS_YB : WS_YC))); gm.Bt = (const bf16_t*)(ws + (s == 0 ? WS_WBAT : (s == 1 ? WS_WBBT : WS_WBCT)));
        gm.M = NTOK; gm.N = 1024; gm.K = (s == 0) ? 512 : 1024;
        pg8::StaticOrder S; S.init(NTOK, 1024, G, bid);
        EpiBranch E; E.gate = (const bf16_t*)(ws + WS_PROJ) + OFF_GA + 1024 * s; E.mf = (bf16_t*)(ws + WS_MRGF); E.mb = (bf16_t*)(ws + WS_MRGB); E.mode = s;
        pg8::gemm_phase<EpiBranch, pg8::StaticOrder, false>(lds, gm, S, E, nullptr);
    } }
MK_NOINL void P7_outproj(LAS unsigned char* lds, int layer) { MK_LOADARGS; (void)layer;
    pg8::Gemm gm; gm.A = (const bf16_t*)(ws + WS_MRGB); gm.Bt = (const bf16_t*)(ws + WS_WOT); gm.M = NTOK; gm.N = 1024; gm.K = 1024;
    pg8::StaticOrder S; S.init(NTOK, 1024, G, bid);
    EpiOut E; E.xf = (const float*)(ws + WS_XF); E.z = (float*)(ws + WS_MRGF);
    pg8::gemm_phase<EpiOut, pg8::StaticOrder, false>(lds, gm, S, E, nullptr); }
MK_NOINL void P8_ln1(LAS unsigned char* lds, int layer) { MK_LOADARGS; phase_ln1(a, layer); }
MK_NOINL void P9_wq(LAS unsigned char* lds, int layer) { MK_LOADARGS; (void)layer;
    pg8::Gemm gm; gm.A = (const bf16_t*)(ws + WS_XB); gm.Bt = (const bf16_t*)(ws + WS_WQT); gm.M = NTOK; gm.N = 2048; gm.K = 1024;
    pg8::StaticOrder S; S.init(NTOK, 2048, G, bid);
    pg8::EpiBf16<0> E; E.O = (bf16_t*)(ws + WS_Q); E.ldc = 2048; E.bias = nullptr; E.split_cols = 0; E.split_stride = 0;
    pg8::gemm_phase<pg8::EpiBf16<0>, pg8::StaticOrder, false>(lds, gm, S, E, nullptr); }
MK_NOINL void P10_topk(LAS unsigned char* lds, int layer) { MK_LOADARGS; (void)layer; for (int u = bid; u < NTOK / 64; u += G) topk_unit(a, u, lds); }
MK_NOINL void P11_peer(LAS unsigned char* lds, int layer, int dry) { MK_LOADARGS; for (int u = bid; u < NTOK / 64; u += G) peer_unit(a, layer, u, dry != 0); }
DI void mk_sync(LAS unsigned char* lds) {
    const Args a = load_args(lds);
    XcdBarrier b; b.bar = (unsigned*)(a.ws + WS_CTL); b.x = xb_xcc_id(); b.st = (volatile LAS unsigned*)(lds + LDS_BAR_OFF);
    xcd_barrier(b);
}
}

#ifndef MK_PHASE_MASK
#define MK_PHASE_MASK 0xFFFu
#endif
#define MK_RUN(k) ((((MK_PHASE_MASK) >> ((k) - pb)) & 1u) && (k) >= ph_lo && (k) < ph_hi)
#define MK_NPHASES (1 + mk::DEPTH * mk::NPH)
#ifndef MK_REP_MASK
#define MK_REP_MASK 0u
#endif
#define MK_REPS(bit) for (int rep_ = 0; rep_ < ((((MK_REP_MASK) >> (bit)) & 1u) ? 2 : 1); ++rep_)
#define MK_SYNC(k) do { if ((k) >= ph_lo && (k) + 1 < ph_hi) { mk::mk_sync(lds); if ((MK_REP_MASK >> 15) & 1u) mk::mk_sync(lds); } } while (0)
__global__ __launch_bounds__(512, 2) void mk_fwd(mk::Args a) {
    using namespace mk;
    extern __shared__ __attribute__((aligned(16))) unsigned char smem_raw[];
    LAS unsigned char* lds = (LAS unsigned char*)smem_raw;
    const int ph_lo = a.ph_lo, ph_hi = a.ph_hi;
    {
        const unsigned* src = (const unsigned*)&a;
        if (threadIdx.x < sizeof(Args) / 4) ((LAS unsigned*)(lds + LDS_ARG_OFF))[threadIdx.x] = src[threadIdx.x];
        if (threadIdx.x == 0) { LAS unsigned* st = (LAS unsigned*)(lds + LDS_BAR_OFF); st[0] = 0u; st[1] = 0u; st[2] = 0u; st[3] = 0u; }
    }
    __syncthreads();
    if (ph_hi - ph_lo > 1) (void)xcd_barrier_post((unsigned*)(a.ws + WS_CTL), (volatile LAS unsigned*)(lds + LDS_BAR_OFF));
    if (0 >= ph_lo && 0 < ph_hi) PG_prologue(lds);
    MK_SYNC(0);
#pragma unroll 1
    for (int layer = 0; layer < DEPTH; ++layer) {
        const int pb = 1 + layer * NPH;
        if (MK_RUN(pb + 0)) MK_REPS(0) P0_conv(lds, layer);
        MK_SYNC(pb + 0);
        if (MK_RUN(pb + 1)) { if ((MK_REP_MASK >> 14) & 1u) P1_inproj(lds, layer, 1); if ((MK_REP_MASK >> 16) & 1u) P1_inproj(lds, layer, 2); if ((MK_REP_MASK >> 17) & 1u) P1_inproj(lds, layer, 3); if ((MK_REP_MASK >> 18) & 1u) P1_inproj(lds, layer, 4); MK_REPS(1) P1_inproj(lds, layer, 0); }
        MK_SYNC(pb + 1);
        if (MK_RUN(pb + 3)) { MK_REPS(13) P3s_lru(lds, layer); MK_REPS(3) P3a_attn(lds, layer); MK_REPS(12) P3b_retkv(lds, layer); }
        MK_SYNC(pb + 3);
        if (MK_RUN(pb + 4)) { P4a_scan(lds, layer); MK_REPS(4) { P4c_merge(lds, layer); } }
        MK_SYNC(pb + 4);
        if (MK_RUN(pb + 5)) { if ((MK_REP_MASK >> 20) & 7u) P5_retout(lds, layer, (int)((MK_REP_MASK >> 20) & 7u)); MK_REPS(5) P5_retout(lds, layer, 0); }
        MK_SYNC(pb + 5);
        if (MK_RUN(pb + 6)) MK_REPS(6) P6_branch(lds, layer);
        MK_SYNC(pb + 6);
        if (MK_RUN(pb + 7)) MK_REPS(7) P7_outproj(lds, layer);
        MK_SYNC(pb + 7);
        if (MK_RUN(pb + 8)) MK_REPS(8) P8_ln1(lds, layer);
        MK_SYNC(pb + 8);
        if (MK_RUN(pb + 9)) MK_REPS(9) P9_wq(lds, layer);
        MK_SYNC(pb + 9);
        if (MK_RUN(pb + 10)) MK_REPS(10) P10_topk(lds, layer);
        MK_SYNC(pb + 10);
        if (MK_RUN(pb + 11)) { if ((MK_REP_MASK >> 11) & 1u) P11_peer(lds, layer, 1); P11_peer(lds, layer, 0); }
        MK_SYNC(pb + 11);
    }
}

#ifndef MK_SINGLE
#define MK_SINGLE 1
#endif
extern "C" void kernel_launch(void* const* d_in, const int* in_sizes, int n_in, void* d_out, int out_size, void* d_ws, size_t ws_size, hipStream_t stream) {
    using namespace mk;
    static int grid = 0;
    if (grid == 0) {
        if (n_in != 20 || out_size != NTOK * D || ws_size < WS_END) { fprintf(stderr, "kernel_launch: unexpected shapes (n_in %d, out %d, ws %zu, need %zu)\n", n_in, out_size, ws_size, (size_t)WS_END); grid = -1; return; }
        int dev = 0, cus = 0, per_cu = 0;
        if (hipGetDevice(&dev) != hipSuccess || hipDeviceGetAttribute(&cus, hipDeviceAttributeMultiprocessorCount, dev) != hipSuccess) { grid = -1; return; }
        if (hipFuncSetAttribute((const void*)mk_fwd, hipFuncAttributeMaxDynamicSharedMemorySize, LDS_BYTES) != hipSuccess) { fprintf(stderr, "kernel_launch: hipFuncSetAttribute failed\n"); grid = -1; return; }
        if (hipOccupancyMaxActiveBlocksPerMultiprocessor(&per_cu, (const void*)mk_fwd, 512, LDS_BYTES) != hipSuccess || per_cu < 1) { fprintf(stderr, "kernel_launch: occupancy query says %d blocks per CU\n", per_cu); (void)hipGetLastError(); grid = -1; return; }
        grid = cus;
    }
    if (grid < 0) return;
    (void)in_sizes;
    Args a{};
    for (int i = 0; i < 20; ++i) a.in[i] = (const float*)d_in[i];
    a.out = (float*)d_out; a.ws = (unsigned char*)d_ws;
    a.ropeA = pow(10000.0, -2.0 / 128.0); a.ropeR = pow(10000.0, -2.0 / 256.0);
#if MK_SINGLE
    (void)hipMemsetAsync((unsigned char*)d_ws + WS_CTL, 0, 16384, stream);
    a.ph_lo = 0; a.ph_hi = MK_NPHASES;
    hipLaunchKernelGGL(mk_fwd, dim3(grid), dim3(512), LDS_BYTES, stream, a);
#else
    for (int p = 0; p < MK_NPHASES; ++p) { a.ph_lo = p; a.ph_hi = p + 1; hipLaunchKernelGGL(mk_fwd, dim3(grid), dim3(512), LDS_BYTES, stream, a); }
#endif
}
```

```cpp
#include <hip/hip_runtime.h>
#include <cstdio>
#include <cstdint>
#include <cmath>
#include <cfloat>
__device__ __forceinline__ int mk_tid() { int t = (int)threadIdx.x; asm volatile("" : "+v"(t)); return t; }
namespace pg8 {
#define PG8_LAS __attribute__((address_space(3)))
typedef unsigned short bf16_t;
typedef short bf16x8 __attribute__((ext_vector_type(8)));
typedef float f32x4 __attribute__((ext_vector_type(4)));
typedef unsigned u32x4 __attribute__((ext_vector_type(4)));
constexpr int BM = 256, BK = 64, HALF = 128, HTB = HALF * BK * 2  , STAGE_BYTES = 8 * HTB, NXCD = 8, WGM = 8;

__host__ __device__ __forceinline__ int lds_byte(int r, int c) { const int st = (r >> 4) * 2 + (c >> 5), rr = r & 15, cc = c & 31, ob = rr * 64 + cc * 2; return st * 1024 + (ob ^ (((ob >> 9) & 1) << 5)); }
__host__ __device__ __forceinline__ void stage_rc(int b, int& R, int& C) { const int st = b / 1024, sb = b % 1024, swz = sb ^ (((sb >> 9) & 1) << 5); R = (st >> 1) * 16 + swz / 64; C = (st & 1) * 32 + (swz % 64) / 2; }
__host__ __device__ __forceinline__ int perm32(int rho) { const int n = rho >> 4, i = rho & 15; return 8 * (i >> 2) + 4 * n + (i & 3); }

struct Unit { int pm, pn; };
struct Gemm { const bf16_t* A; const bf16_t* Bt; int M, N, K; };

struct StaticOrder {
    int nM, nN, nwg, G, c;
    __host__ __device__ void init(int M, int N, int G_, int c_) { nM = M / BM; nN = N / BM; nwg = nM * nN; G = G_; c = c_; }
    __host__ __device__ bool next(int i, Unit& u) const {
        const long L = (long)i * G + c; if (L >= nwg) return false;
        int wgid = (int)L; { const int q = nwg / NXCD, r = nwg % NXCD, xcd = wgid % NXCD, off = wgid / NXCD; wgid = (xcd < r ? xcd * (q + 1) : r * (q + 1) + (xcd - r) * q) + off; }
        const int nig = WGM * nN, gid = wgid / nig, fm = gid * WGM, gsz = (nM - fm) < WGM ? (nM - fm) : WGM;
        u.pm = fm + ((wgid % nig) % gsz); u.pn = (wgid % nig) / gsz; return true;
    }
    __device__ __forceinline__ void a_ready(const Unit&) const {}
    __device__ __forceinline__ void done(const Unit&) const {}
};
typedef __bf16 pg8_bf16x2 __attribute__((ext_vector_type(2)));
__device__ __forceinline__ unsigned cvt_pk_bf16(float lo, float hi) { const pg8_bf16x2 v = {(__bf16)lo, (__bf16)hi}; return __builtin_bit_cast(unsigned, v); }
typedef float f32x2 __attribute__((ext_vector_type(2)));
__device__ __forceinline__ f32x2 gelu_pk(f32x2 v) {
    const f32x2 av = __builtin_elementwise_abs(v), d = av * 0.2316418882f + 1.0f;
    f32x2 t; t.x = __builtin_amdgcn_rcpf(d.x); t.y = __builtin_amdgcn_rcpf(d.y);
    f32x2 q = t * 0.5307027145f + (-0.7265760135f); q = q * t + 0.7107068705f; q = q * t + (-0.142248368f); q = q * t + 0.127414796f; q = q * t;
    const f32x2 s = (v * v) * (-0.72134752044f);
    f32x2 e; e.x = __builtin_amdgcn_exp2f(s.x); e.y = __builtin_amdgcn_exp2f(s.y);
    const f32x2 m = v * (q * e), r = v - m;
    f32x2 o; o.x = v.x < 0.f ? m.x : r.x; o.y = v.y < 0.f ? m.y : r.y; return o;
}

struct EpiF32 {
    static constexpr bool PERM = false, AFTER_DRAIN = false;
    float* C; int ldc; const float* bias;
    __device__ __forceinline__ void operator()(const f32x4 (&acc)[2][2][4][2], const Unit& u, int wr, int wc, int fr, int fq) const {
        const int row0 = u.pm * BM + wr * 64 + fr, col0 = u.pn * BM + wc * 32 + 4 * fq;
        f32x4 bv[2][2];
#pragma unroll
        for (int bj = 0; bj < 2; ++bj)
#pragma unroll
            for (int n = 0; n < 2; ++n) bv[bj][n] = bias ? *(const f32x4*)(bias + col0 + bj * HALF + n * 16) : (f32x4){0.f, 0.f, 0.f, 0.f};
#pragma unroll
        for (int ai = 0; ai < 2; ++ai)
#pragma unroll
            for (int m = 0; m < 4; ++m) { float* rowp = C + (size_t)(row0 + ai * HALF + m * 16) * ldc + col0;
#pragma unroll
                for (int bj = 0; bj < 2; ++bj)
#pragma unroll
                    for (int n = 0; n < 2; ++n) *(f32x4*)(rowp + bj * HALF + n * 16) = acc[ai][bj][m][n] + bv[bj][n]; }
    }
};
template <int ACT  > struct EpiBf16 {
    static constexpr bool PERM = true, AFTER_DRAIN = false;
    bf16_t* O; int ldc; const float* bias; int split_cols; size_t split_stride;
    __device__ __forceinline__ void operator()(const f32x4 (&acc)[2][2][4][2], const Unit& u, int wr, int wc, int fr, int fq) const {
        const int row0 = u.pm * BM + wr * 64 + fr; int colt = u.pn * BM; bf16_t* base = O;
        if (split_cols) { const int t = colt / split_cols; base += (size_t)t * split_stride; colt -= t * split_cols; }
        const int col0 = colt + wc * 32 + 8 * fq, bcol0 = u.pn * BM + wc * 32 + 8 * fq;
        f32x4 bv[2][2];
#pragma unroll
        for (int bj = 0; bj < 2; ++bj)
#pragma unroll
            for (int n = 0; n < 2; ++n) bv[bj][n] = bias ? *(const f32x4*)(bias + bcol0 + bj * HALF + 4 * n) : (f32x4){0.f, 0.f, 0.f, 0.f};
#pragma unroll
        for (int ai = 0; ai < 2; ++ai)
#pragma unroll
            for (int m = 0; m < 4; ++m) { bf16_t* rowp = base + (size_t)(row0 + ai * HALF + m * 16) * ldc + col0;
#pragma unroll
                for (int bj = 0; bj < 2; ++bj) { f32x4 v0 = acc[ai][bj][m][0] + bv[bj][0], v1 = acc[ai][bj][m][1] + bv[bj][1];
                    if (ACT == 1) { f32x2 a = gelu_pk((f32x2){v0[0], v0[1]}), b = gelu_pk((f32x2){v0[2], v0[3]}), c = gelu_pk((f32x2){v1[0], v1[1]}), d = gelu_pk((f32x2){v1[2], v1[3]});
                        v0 = (f32x4){a.x, a.y, b.x, b.y}; v1 = (f32x4){c.x, c.y, d.x, d.y}; }
                    if (ACT == 2) {
#pragma unroll
                        for (int j = 0; j < 4; ++j) { v0[j] = 0.5f * v0[j] * (1.0f + erff(v0[j] * 0.70710678f)); v1[j] = 0.5f * v1[j] * (1.0f + erff(v1[j] * 0.70710678f)); } }
                    u32x4 w; w.x = cvt_pk_bf16(v0[0], v0[1]); w.y = cvt_pk_bf16(v0[2], v0[3]); w.z = cvt_pk_bf16(v1[0], v1[1]); w.w = cvt_pk_bf16(v1[2], v1[3]);
                    *(u32x4*)(rowp + bj * HALF) = w; } }
    }
};

typedef int i32x8 __attribute__((ext_vector_type(8)));
typedef short s16x16 __attribute__((ext_vector_type(16)));
__device__ __forceinline__ i32x8 pg8_cat16(bf16x8 a, bf16x8 b) { return __builtin_bit_cast(i32x8, (s16x16)__builtin_shufflevector(a, b, 0, 1, 2, 3, 4, 5, 6, 7, 8, 9, 10, 11, 12, 13, 14, 15)); }
template <class Epi, class Sched, bool STAMP = false, bool F8 = false, bool WIDE = false>
__device__ __forceinline__ void gemm_phase(PG8_LAS unsigned char* lds, const Gemm g, const Sched& S, const Epi& E, unsigned long long* stamps) {
    const int tid = mk_tid(), wid = __builtin_amdgcn_readfirstlane(tid >> 6), lane = tid & 63, wr = wid >> 2, wc = wid & 3, fr = lane & 15, fq = lane >> 4;
    const int K = g.K, nt = K / BK;
    int ts_lo = 0, ts_hi = 0, nts = 0; const unsigned long long rt_entry = STAMP ? (unsigned long long)wall_clock64() : 0ull;
#define PG8_STAMP() do { if (STAMP && wid == 0 && nts < 64) { const unsigned long long _c = (unsigned long long)clock64(); \
        ts_lo = (lane == nts) ? (int)(unsigned)_c : ts_lo; ts_hi = (lane == nts) ? (int)(unsigned)(_c >> 32) : ts_hi; ++nts; } } while (0)
    PG8_STAMP();
    unsigned voffA, voffB;
    { int R, C; stage_rc(tid * 16, R, C); const int Ri = Epi::PERM ? perm32(R & 31) : (R & 31); const int Rb = WIDE ? (((R >> 5) << 6) + Ri) : ((R & ~31) + Ri);
        voffA = (unsigned)(R * K + C) * 2u; voffB = (unsigned)(Rb * K + C) * 2u; }
    const size_t qstep = (size_t)64 * K * 2;
    const size_t qstepB = WIDE ? (size_t)128 * K * 2 : qstep;
    const size_t hstepB = WIDE ? (size_t)32 * K * 2 : (size_t)HALF * K * 2;
    const size_t kstep = (size_t)(BK * 2);
    const size_t hstep = (size_t)HALF * K * 2;
    const size_t tstep = 2 * hstep;
    const unsigned ldsw = (unsigned)wid * 1024u;
    const int aoff = lds_byte(wr * 64 + fr, fq * 8), boff = lds_byte(wc * 32 + fr, fq * 8);
#define PG8_SA(b, h) (((b) * 2 + (h)) * HTB)
#define PG8_SB(b, h) ((4 + (b) * 2 + (h)) * HTB)
#define PG8_STAGE(bufoff, gbase, voff) PG8_STAGEQ(bufoff, gbase, voff, qstep)
#define PG8_STAGEB(bufoff, gbase, voff) PG8_STAGEQ(bufoff, gbase, voff, qstepB)
#define PG8_STAGEQ(bufoff, gbase, voff, qs) do { const char* _g0 = (const char*)(gbase); const char* _g1 = _g0 + (qs); asm volatile("" : "+s"(_g0), "+s"(_g1));   \
        __builtin_amdgcn_global_load_lds((const unsigned*)(_g0 + (voff)), (PG8_LAS unsigned*)(lds + (bufoff) + ldsw), 16, 0, 0); \
        __builtin_amdgcn_global_load_lds((const unsigned*)(_g1 + (voff)), (PG8_LAS unsigned*)(lds + (bufoff) + ldsw + 8192), 16, 0, 0); } while (0)
#define PG8_LDA(dst, b, h) do { _Pragma("unroll") for (int m = 0; m < 4; ++m) _Pragma("unroll") for (int k = 0; k < 2; ++k) dst[m][k] = *(const PG8_LAS bf16x8*)(lds + PG8_SA(b, h) + aoff + m * 2048 + k * 1024); } while (0)
#define PG8_LDB(dst, b, h) do { _Pragma("unroll") for (int n = 0; n < 2; ++n) _Pragma("unroll") for (int k = 0; k < 2; ++k) dst[n][k] = *(const PG8_LAS bf16x8*)(lds + PG8_SB(b, h) + boff + n * 2048 + k * 1024); } while (0)
#define PG8_MMA(ai, bj, At, Bt) do { __builtin_amdgcn_s_setprio(1); _Pragma("unroll") for (int m = 0; m < 4; ++m) _Pragma("unroll") for (int n = 0; n < 2; ++n) { \
        if constexpr (F8) acc[ai][bj][m][n] = __builtin_amdgcn_mfma_scale_f32_16x16x128_f8f6f4(pg8_cat16(Bt[n][0], Bt[n][1]), pg8_cat16(At[m][0], At[m][1]), acc[ai][bj][m][n], 0, 0, 0, 0, 0, 0); \
        else { _Pragma("unroll") for (int k = 0; k < 2; ++k) acc[ai][bj][m][n] = __builtin_amdgcn_mfma_f32_16x16x32_bf16(Bt[n][k], At[m][k], acc[ai][bj][m][n], 0, 0, 0); } } \
        __builtin_amdgcn_s_setprio(0); } while (0)
#define PG8_WAIT_V(n) asm volatile("s_waitcnt vmcnt(" #n ")" ::: "memory")
#define PG8_WAIT_L(n) asm volatile("s_waitcnt lgkmcnt(" #n ")" ::: "memory")
#define PG8_BAR __builtin_amdgcn_s_barrier()
#define PG8_SCHED __builtin_amdgcn_sched_barrier(0)
    Unit cur, nxt; int ui = 0;
    if (!S.next(0, cur)) return;
    f32x4 acc[2][2][4][2];
    bf16x8 At[4][2], B0[2][2], B1[2][2];
    const char* cA = (const char*)g.A + (size_t)cur.pm * tstep; const char* cB = (const char*)g.Bt + (size_t)cur.pn * tstep;
    S.a_ready(cur);
    PG8_STAGEB(PG8_SB(0, 0), cB, voffB); PG8_STAGE(PG8_SA(0, 0), cA, voffA); PG8_STAGEB(PG8_SB(0, 1), cB + hstepB, voffB); PG8_STAGE(PG8_SA(0, 1), cA + hstep, voffA);
    if (wr == 1) PG8_BAR;
    PG8_WAIT_V(4); PG8_BAR;
    PG8_STAGEB(PG8_SB(1, 0), cB + kstep, voffB); PG8_STAGE(PG8_SA(1, 0), cA + kstep, voffA); PG8_STAGEB(PG8_SB(1, 1), cB + hstepB + kstep, voffB);
    PG8_WAIT_V(6); PG8_BAR;
    PG8_STAMP();
#pragma unroll
    for (int a = 0; a < 2; ++a)
#pragma unroll
        for (int b = 0; b < 2; ++b)
#pragma unroll
            for (int m = 0; m < 4; ++m)
#pragma unroll
                for (int n = 0; n < 2; ++n) acc[a][b][m][n] = (f32x4){0.f, 0.f, 0.f, 0.f};
    for (;;) {
        const bool has_next = S.next(ui + 1, nxt);
        const char* nA = has_next ? (const char*)g.A + (size_t)nxt.pm * tstep : cA; const char* nB = has_next ? (const char*)g.Bt + (size_t)nxt.pn * tstep : cB;
        for (int t = 0; t < nt; t += 2) {
            const bool last = (t == nt - 2);
            const char* a1 = cA + (size_t)(t + 1) * kstep;
            const char* a2 = last ? nA : cA + (size_t)(t + 2) * kstep; const char* b2 = last ? nB : cB + (size_t)(t + 2) * kstep;
            const char* a3 = a2 + kstep; const char* b3 = b2 + kstep;
            if (last && has_next) S.a_ready(nxt);
            PG8_LDB(B0, 0, 0); PG8_SCHED; PG8_LDA(At, 0, 0); PG8_STAGE(PG8_SA(1, 1), a1 + hstep, voffA);
            PG8_WAIT_L(8); PG8_BAR; PG8_WAIT_L(0); PG8_MMA(0, 0, At, B0); PG8_BAR; PG8_SCHED;
            PG8_LDB(B1, 0, 1); PG8_STAGEB(PG8_SB(0, 0), b2, voffB);
            PG8_BAR; PG8_WAIT_L(0); PG8_MMA(0, 1, At, B1); PG8_BAR;
            PG8_LDA(At, 0, 1); PG8_STAGE(PG8_SA(0, 0), a2, voffA);
            PG8_BAR; PG8_WAIT_L(0); PG8_MMA(1, 0, At, B0); PG8_BAR; PG8_SCHED;
            PG8_STAGEB(PG8_SB(0, 1), b2 + hstepB, voffB);
            PG8_WAIT_V(6); PG8_BAR; PG8_MMA(1, 1, At, B1); PG8_BAR;
            PG8_LDB(B0, 1, 0); PG8_SCHED; PG8_LDA(At, 1, 0); PG8_STAGE(PG8_SA(0, 1), a2 + hstep, voffA);
            PG8_WAIT_L(8); PG8_BAR; PG8_WAIT_L(0); PG8_MMA(0, 0, At, B0); PG8_BAR; PG8_SCHED;
            PG8_LDB(B1, 1, 1); PG8_STAGEB(PG8_SB(1, 0), b3, voffB);
            PG8_BAR; PG8_WAIT_L(0); PG8_MMA(0, 1, At, B1); PG8_BAR;
            PG8_LDA(At, 1, 1); PG8_STAGE(PG8_SA(1, 0), a3, voffA);
            PG8_BAR; PG8_WAIT_L(0); PG8_MMA(1, 0, At, B0); PG8_BAR; PG8_SCHED;
            PG8_STAGEB(PG8_SB(1, 1), b3 + hstepB, voffB);
            PG8_WAIT_V(6); PG8_BAR; PG8_MMA(1, 1, At, B1); PG8_BAR;
        }
        PG8_STAMP();
        if constexpr (!Epi::AFTER_DRAIN) { E(acc, cur, wr, wc, fr, fq); S.done(cur); }
        PG8_STAMP();
        if (!has_next) break;
#pragma unroll
        for (int a = 0; a < 2; ++a)
#pragma unroll
            for (int b = 0; b < 2; ++b)
#pragma unroll
                for (int m = 0; m < 4; ++m)
#pragma unroll
                    for (int n = 0; n < 2; ++n) acc[a][b][m][n] = (f32x4){0.f, 0.f, 0.f, 0.f};
        cur = nxt; cA = nA; cB = nB; ++ui;
    }
    PG8_WAIT_V(0);
    if (wr == 0) PG8_BAR;
    PG8_BAR;
    if constexpr (Epi::AFTER_DRAIN) { E.fused(acc, cur, wr, wc, fr, fq, lds, wid, lane); S.done(cur); }
    PG8_STAMP();
    if (STAMP && wid == 0) { stamps[lane] = lane < nts ? (((unsigned long long)(unsigned)ts_hi << 32) | (unsigned)ts_lo) : 0ull;
        if (lane == 62) stamps[62] = rt_entry; if (lane == 63) stamps[63] = (unsigned long long)wall_clock64(); }
#undef PG8_STAMP
#undef PG8_SA
#undef PG8_SB
#undef PG8_STAGE
#undef PG8_STAGEB
#undef PG8_STAGEQ
#undef PG8_LDA
#undef PG8_LDB
#undef PG8_MMA
#undef PG8_WAIT_V
#undef PG8_WAIT_L
#undef PG8_BAR
#undef PG8_SCHED
}
}
#define XB_TMO      128
#define XB_XCNT(j)  (256  + 64 * (j))
#define XB_XSUB(j)  (1280 + 64 * (j))
#define XB_XGEN(j)  (2304 + 64 * (j))
#define XB_TOP      3328
#define XB_TOPGEN   3392
#define XCD_BAR_WORDS 3456
#define XB_SPIN_CAP (1u << 18)
#define LAS __attribute__((address_space(3)))

__device__ __forceinline__ unsigned xb_ld(unsigned* p)              { return __hip_atomic_load(p, __ATOMIC_RELAXED, __HIP_MEMORY_SCOPE_AGENT); }
__device__ __forceinline__ unsigned xb_add(unsigned* p, unsigned v) { return __hip_atomic_fetch_add(p, v, __ATOMIC_RELAXED, __HIP_MEMORY_SCOPE_AGENT); }
__device__ __forceinline__ unsigned xb_xcc_id() { return (unsigned)__builtin_amdgcn_s_getreg((3 << 11) | 20) & 0xFu; }
#define XB_SPIN(cond, bar) do { unsigned _sp = 0; while (cond) { __builtin_amdgcn_s_sleep(1); \
    if ((++_sp & 255u) == 0u) { if (xb_ld(&(bar)[XB_TMO])) break; if (_sp > XB_SPIN_CAP) { atomicAdd(&(bar)[XB_TMO], 1u); break; } } } } while (0)

struct XcdBarrier {
    unsigned* bar; unsigned x;
    volatile LAS unsigned* st;
};

__device__ __forceinline__ XcdBarrier xcd_barrier_post(unsigned* bar, volatile LAS unsigned* st) {
    XcdBarrier b; b.bar = bar; b.x = xb_xcc_id(); b.st = st;
    if (threadIdx.x == 0) (void)xb_add(&bar[XB_XCNT(b.x)], 1u);
    return b;
}
__device__ __forceinline__ void xcd_barrier_complete(unsigned* bar, unsigned x, unsigned& nloc, unsigned& nx) {
    const unsigned G = gridDim.x * gridDim.y * gridDim.z;
    unsigned sum, cnt, mine, sp = 0u;
    for (;;) {
        sum = 0u; cnt = 0u; mine = 0u;
#pragma unroll
        for (unsigned j = 0; j < 16; ++j) { const unsigned c = xb_ld(&bar[XB_XCNT(j)]); sum += c; cnt += (c > 0u) ? 1u : 0u; mine = (j == x) ? c : mine; }
        if (sum == G) break;
        __builtin_amdgcn_s_sleep(1);
        if ((++sp & 255u) == 0u) { if (xb_ld(&bar[XB_TMO])) break; if (sp > XB_SPIN_CAP) { atomicAdd(&bar[XB_TMO], 1u); break; } }
    }
    nloc = mine > 0u ? mine : 1u; nx = cnt > 0u ? cnt : 1u;
}

__device__ __forceinline__ void xcd_barrier(const XcdBarrier& b) {
    asm volatile("s_waitcnt vmcnt(0)" ::: "memory");
    __syncthreads();
    if (threadIdx.x == 0) {
        unsigned* bar = b.bar;
        __builtin_amdgcn_s_waitcnt(0);
        unsigned nloc = b.st[0], nx = b.st[1];
        if (nloc == 0u) { xcd_barrier_complete(bar, b.x, nloc, nx); b.st[0] = nloc; b.st[1] = nx; }
        const unsigned old = xb_add(&bar[XB_XSUB(b.x)], 1u);
        const unsigned gen = old / nloc;
        if (old + 1u == (gen + 1u) * nloc) {
            __builtin_amdgcn_fence(__ATOMIC_RELEASE, "agent");
            asm volatile("s_waitcnt vmcnt(0)" ::: "memory");
            const unsigned og = xb_add(&bar[XB_TOP], 1u);
            const unsigned tg = og / nx;
            if (og + 1u == (tg + 1u) * nx) xb_add(&bar[XB_TOPGEN], 1u);
            else XB_SPIN(xb_ld(&bar[XB_TOPGEN]) == tg, bar);
            __builtin_amdgcn_fence(__ATOMIC_ACQUIRE, "agent");
            xb_add(&bar[XB_XGEN(b.x)], 1u);
            asm volatile("s_waitcnt vmcnt(0)" ::: "memory");
        } else {
            XB_SPIN(xb_ld(&bar[XB_XGEN(b.x)]) == gen, bar);
            __builtin_amdgcn_fence(__ATOMIC_ACQUIRE, "agent");
            asm volatile("s_waitcnt vmcnt(0)" ::: "memory");
        }
    }
    __syncthreads();
}

namespace mk {
using pg8::bf16_t; using pg8::bf16x8; using pg8::f32x4; using pg8::u32x4;
typedef short s16x4 __attribute__((ext_vector_type(4)));
typedef unsigned u32x2 __attribute__((ext_vector_type(2)));
typedef __bf16 bf16x2v __attribute__((ext_vector_type(2)));
typedef int i32x4 __attribute__((ext_vector_type(4)));
#define DI __device__ __forceinline__

constexpr int D = 1024, SEQ = 4096, NTOK = 16384, DEPTH = 4, DIN = 13824;
constexpr int OFF_AQ = 0, OFF_AK = 1536, OFF_AV = 3072, OFF_LX = 4608, OFF_LG = 5632, OFF_RQ = 6656, OFF_RK = 7680, OFF_RV = 8704, OFF_RG = 9728, OFF_GA = 10752;
constexpr float ALPHA = 1.681792830507429f;
constexpr float LN_EPS = 1e-5f;
constexpr float X8_SCALE = 32.0f, W8_SCALE = 2048.0f, F8_MAX = 440.0f;
constexpr int NPH = 12;
constexpr int LDS_BYTES = 148 * 1024;
constexpr int LDS_BAR_OFF = LDS_BYTES - 16;

constexpr size_t WS_CTL  = 0;
constexpr size_t WS_COSA = 16384;
constexpr size_t WS_SINA = WS_COSA + (size_t)4096 * 64 * 4;
constexpr size_t WS_COSR = WS_SINA + (size_t)4096 * 64 * 4;
constexpr size_t WS_SINR = WS_COSR + (size_t)4096 * 128 * 4;
constexpr size_t WS_CCH  = WS_SINR + (size_t)4096 * 128 * 4;
constexpr size_t WS_WAT  = WS_CCH + 4096;
constexpr size_t WS_WXT  = WS_WAT + 131072;
constexpr size_t WS_LSTA = WS_WXT + 131072;
constexpr size_t WS_LSTH = WS_LSTA + 524288;
constexpr size_t WS_K1B  = WS_LSTH + 524288;
constexpr size_t WS_K2B  = WS_K1B + 262144;
constexpr size_t WS_XF   = WS_K2B + 262144;
constexpr size_t WS_XB   = WS_XF + (size_t)NTOK * D * 4;
constexpr size_t WS_WINT = WS_XB + (size_t)NTOK * D * 2;
constexpr size_t WS_WSC  = WS_WINT + (size_t)DIN * 1024;
constexpr size_t WS_X8   = WS_WSC + (size_t)DIN * 4 + 256 - ((size_t)DIN * 4) % 256;
constexpr size_t WS_XS   = WS_X8 + (size_t)NTOK * 1024;
constexpr size_t WS_WBAT = WS_XS + (size_t)NTOK * 4;
constexpr size_t WS_WBBT = WS_WBAT + (size_t)1024 * 512 * 2;
constexpr size_t WS_WBCT = WS_WBBT + (size_t)1024 * 1024 * 2;
constexpr size_t WS_WOT  = WS_WBCT + (size_t)1024 * 1024 * 2;
constexpr size_t WS_WQT  = WS_WOT + (size_t)1024 * 1024 * 2;
constexpr size_t WS_UV8  = WS_WQT + (size_t)2048 * 1024 * 2;
constexpr size_t WS_UVS  = WS_UV8 + (size_t)16384 * 2048;
constexpr size_t WS_PROJ = WS_UVS + (size_t)16384 * 8;
constexpr size_t WS_OATT = WS_PROJ + (size_t)NTOK * DIN * 2;
constexpr size_t WS_LSE  = WS_OATT + (size_t)NTOK * 1536 * 2;
constexpr size_t WS_KVB  = WS_LSE + (size_t)NTOK * 12 * 4;
constexpr size_t WS_YA   = WS_KVB + (size_t)16 * 32 * 65536 * 2;
constexpr size_t WS_YB   = WS_YA + (size_t)NTOK * 512 * 2;
constexpr size_t WS_YC   = WS_YB + (size_t)NTOK * 1024 * 2;
constexpr size_t WS_MRGF = WS_YC + (size_t)NTOK * 1024 * 2;
constexpr size_t WS_MRGB = WS_MRGF + (size_t)NTOK * 1024 * 4;
constexpr size_t WS_END  = WS_MRGB + (size_t)NTOK * 1024 * 2;
constexpr size_t WS_Q    = WS_PROJ;
constexpr size_t WS_EID  = WS_PROJ + (size_t)NTOK * 2048 * 2;
constexpr size_t WS_GATE = WS_EID + (size_t)NTOK * 128 * 4;
static_assert(WS_END <= (size_t)1073741824, "workspace too large");
static_assert(WS_PROJ % 256 == 0 && WS_KVB % 256 == 0 && WS_MRGF % 256 == 0, "alignment");

struct Args { const float* in[20]; float* out; unsigned char* ws; double ropeA, ropeR; int ph_lo, ph_hi; };

DI float bflo(unsigned w) { return __uint_as_float(w << 16); }
DI float bfhi(unsigned w) { return __uint_as_float(w & 0xffff0000u); }
DI float bf2f(bf16_t v) { return __uint_as_float(((unsigned)v) << 16); }
DI unsigned pk2(float lo, float hi) { return pg8::cvt_pk_bf16(lo, hi); }
DI bf16_t f2bf(float f) { return (bf16_t)(pk2(f, 0.f) & 0xffffu); }
DI f32x4 mfma16(bf16x8 a, bf16x8 b, f32x4 c) { return __builtin_amdgcn_mfma_f32_16x16x32_bf16(a, b, c, 0, 0, 0); }
DI s16x4 trrd(LAS unsigned char* p) { return __builtin_amdgcn_ds_read_tr16_b64_v4i16((LAS s16x4*)p); }
DI bf16x8 cat8(s16x4 lo, s16x4 hi) { return __builtin_shufflevector(lo, hi, 0, 1, 2, 3, 4, 5, 6, 7); }
DI float wsum(float v) { v += __shfl_xor(v, 32); v += __shfl_xor(v, 16); v += __shfl_xor(v, 8); v += __shfl_xor(v, 4); v += __shfl_xor(v, 2); v += __shfl_xor(v, 1); return v; }
DI float sigm(float x) { return __builtin_amdgcn_rcpf(1.f + __builtin_amdgcn_exp2f(x * -1.4426950408889634f)); }
DI float gelu_erf(float x) { return 0.5f * x * (1.f + erff(x * 0.70710678118654752f)); }
DI float dot2(unsigned w, unsigned x, float acc) { return __builtin_amdgcn_fdot2_f32_bf16(__builtin_bit_cast(bf16x2v, w), __builtin_bit_cast(bf16x2v, x), acc, false); }
DI float log2gamma(int h) { return log2f(1.0f - exp2f(-5.0f - (float)h)); }

#define MK_DPP_ADD(v, ctrl, rmask) v += __int_as_float(__builtin_amdgcn_update_dpp(0, __float_as_int(v), (ctrl), (rmask), 0xf, false))
DI float wsum_dpp(float v) {
    MK_DPP_ADD(v, 0xB1, 0xf); MK_DPP_ADD(v, 0x4E, 0xf); MK_DPP_ADD(v, 0x141, 0xf); MK_DPP_ADD(v, 0x140, 0xf);
    MK_DPP_ADD(v, 0x142, 0xa); MK_DPP_ADD(v, 0x143, 0xc);
    return __int_as_float(__builtin_amdgcn_readlane(__float_as_int(v), 63));
}
DI float gelu_as(float v) {
    const float av = fabsf(v), t = __builtin_amdgcn_rcpf(av * 0.2316418882f + 1.0f);
    float q = t * 0.5307027145f + (-0.7265760135f); q = q * t + 0.7107068705f; q = q * t + (-0.142248368f); q = q * t + 0.127414796f; q = q * t;
    const float e = __builtin_amdgcn_exp2f(v * v * (-0.72134752044f));
    const float m = v * (q * e);
    return v < 0.f ? m : v - m;
}
DI int wperm(int n) {
    if (n < 3072) { const int j = n & 127, jj = j & 63; return (n & ~127) + 8 * (jj >> 2) + (jj & 3) + ((j >= 64) ? 4 : 0); }
    if (n >= OFF_RQ && n < OFF_RV) { const int j = n & 255, jj = j & 127; return (n & ~255) + 8 * (jj >> 2) + (jj & 3) + ((j >= 128) ? 4 : 0); }
    return n;
}

template <bool WPERM>
DI void tconv_tile(const float* src, int ldsrc, bf16_t* dst, int lddst, int k0, int n0, LAS float* t, float mul = 1.0f) {
    const int tid = mk_tid();
#pragma unroll
    for (int i = 0; i < 8; ++i) { const int idx = tid + 512 * i, r = idx >> 6, c = idx & 63; t[r * 65 + c] = src[(size_t)(k0 + r) * ldsrc + n0 + c]; }
    __syncthreads();
#pragma unroll
    for (int i = 0; i < 8; ++i) { const int idx = tid + 512 * i, n = idx >> 6, k = idx & 63; const int nr = WPERM ? wperm(n0 + n) : (n0 + n); dst[(size_t)nr * lddst + k0 + k] = f2bf(t[k * 65 + n] * mul); }
    __syncthreads();
}
DI void conv_unit(const float* src, bf16_t* dst, int unit) {
    const size_t i = (size_t)unit * 4096 + (size_t)mk_tid() * 8;
    const f32x4 a = *(const f32x4*)(src + i), b = *(const f32x4*)(src + i + 4);
    u32x4 o; o.x = pk2(a[0], a[1]); o.y = pk2(a[2], a[3]); o.z = pk2(b[0], b[1]); o.w = pk2(b[2], b[3]);
    *(u32x4*)(dst + i) = o;
}
DI void w8_unit(const float* src, unsigned char* ws, int unit, LAS float* t) {
    const int tid = mk_tid(), n0 = unit * 64;
    unsigned char* dst = ws + WS_WINT;
#pragma unroll 1
    for (int k0 = 0; k0 < 1024; k0 += 64) {
#pragma unroll
        for (int i = 0; i < 8; ++i) { const int idx = tid + 512 * i, r = idx >> 6, cc = idx & 63; t[r * 65 + cc] = fminf(fmaxf(src[(size_t)(k0 + r) * DIN + n0 + cc] * W8_SCALE, -F8_MAX), F8_MAX); }
        __syncthreads();
#pragma unroll
        for (int i = 0; i < 2; ++i) { const int idx = tid + 512 * i, n = idx >> 4, k4 = idx & 15;
            int wd = __builtin_amdgcn_cvt_pk_fp8_f32(t[(4 * k4) * 65 + n], t[(4 * k4 + 1) * 65 + n], 0, false);
            wd = __builtin_amdgcn_cvt_pk_fp8_f32(t[(4 * k4 + 2) * 65 + n], t[(4 * k4 + 3) * 65 + n], wd, true);
            *(int*)(dst + (size_t)wperm(n0 + n) * 1024 + k0 + 4 * k4) = wd; }
        __syncthreads();
    }
}
DI void row_to_fp8(const f32x4 (&o)[4], unsigned char* x8row, int ln) {
    u32x4 w;
#pragma unroll
    for (int q = 0; q < 4; ++q) {
        const float a0 = fminf(fmaxf(o[q][0] * X8_SCALE, -F8_MAX), F8_MAX), a1 = fminf(fmaxf(o[q][1] * X8_SCALE, -F8_MAX), F8_MAX), a2 = fminf(fmaxf(o[q][2] * X8_SCALE, -F8_MAX), F8_MAX), a3 = fminf(fmaxf(o[q][3] * X8_SCALE, -F8_MAX), F8_MAX);
        int wd = __builtin_amdgcn_cvt_pk_fp8_f32(a0, a1, 0, false); wd = __builtin_amdgcn_cvt_pk_fp8_f32(a2, a3, wd, true); w[q] = (unsigned)wd; }
    *(u32x4*)(x8row + 16 * ln) = w;
}
typedef float f32x16 __attribute__((ext_vector_type(16)));
typedef float f32x32 __attribute__((ext_vector_type(32)));
typedef unsigned u32x6 __attribute__((ext_vector_type(6)));
typedef _Float16 f16x32 __attribute__((ext_vector_type(32)));
DI float wmax(float m) { m = fmaxf(m, __shfl_xor(m, 32)); m = fmaxf(m, __shfl_xor(m, 16)); m = fmaxf(m, __shfl_xor(m, 8)); m = fmaxf(m, __shfl_xor(m, 4)); m = fmaxf(m, __shfl_xor(m, 2)); m = fmaxf(m, __shfl_xor(m, 1)); return m; }
DI void conv_fp6_rows(const float* usrc, const float* vsrc, unsigned char* ws, int unit) {
    const int tid = mk_tid(), lane = tid & 63, w = tid >> 6;
    const size_t row = (size_t)unit * 8 + w;
    const float* up = usrc + row * 1024 + 16 * lane; const float* vp = vsrc + row * 1024 + 16 * lane;
    f32x16 a, b; float mu = 0.f, mv = 0.f;
#pragma unroll
    for (int q = 0; q < 4; ++q) { const f32x4 x = *(const f32x4*)(up + 4 * q), y = *(const f32x4*)(vp + 4 * q);
#pragma unroll
        for (int j = 0; j < 4; ++j) { a[4 * q + j] = x[j]; b[4 * q + j] = y[j]; mu = fmaxf(mu, fabsf(x[j])); mv = fmaxf(mv, fabsf(y[j])); } }
    mu = wmax(mu); mv = wmax(mv);
    const float su = (mu > 0.f) ? 7.0f / mu : 1.0f, sv = (mv > 0.f) ? 7.0f / mv : 1.0f;
    f16x32 h;
#pragma unroll
    for (int i = 0; i < 16; ++i) { h[i] = (_Float16)(a[i] * su); h[16 + i] = (_Float16)(b[i] * sv); }
    const u32x6 p = __builtin_amdgcn_cvt_scalef32_pk32_fp6_f16(h, 1.0f);
    unsigned char* rec = ws + WS_UV8 + row * 1536;
    *(u32x4*)(rec + 16 * lane) = (u32x4){p[0], p[1], p[2], p[3]};
    *(u32x2*)(rec + 1024 + 8 * lane) = (u32x2){p[4], p[5]};
    if (lane == 0) { float* sp = (float*)(ws + WS_UVS) + row * 2; sp[0] = (mu > 0.f) ? mu * (1.0f / 7.0f) : 1.0f; sp[1] = (mv > 0.f) ? mv * (1.0f / 7.0f) : 1.0f; }
}
DI void phase_conv(const Args& a, int layer, LAS unsigned char* lds) {
    unsigned char* ws = a.ws;
    LAS float* t = (LAS float*)lds;
    const int J0 = 216, J1 = J0 + 128, J2 = J1 + 256, J3 = J2 + 256, J4 = J3 + 256, J5 = J4 + 512, J6 = J5 + 32, J7 = J6 + 2048, J8 = J7, J9 = J8 + 64, J10 = J9 + 1;
    const int total = J10;
    for (int u = blockIdx.x; u < total; u += gridDim.x) {
        if (u < J0) { w8_unit(a.in[1] + (size_t)layer * 1024 * DIN, ws, u, t); }
        else if (u < J1) { const int v = u - J0, kt = v / 16, nt = v % 16; tconv_tile<false>(a.in[9] + (size_t)layer * 2560 * 1024, 1024, (bf16_t*)(ws + WS_WBAT), 512, kt * 64, nt * 64, t); }
        else if (u < J2) { const int v = u - J1, kt = v / 16, nt = v % 16; tconv_tile<false>(a.in[9] + (size_t)layer * 2560 * 1024 + (size_t)512 * 1024, 1024, (bf16_t*)(ws + WS_WBBT), 1024, kt * 64, nt * 64, t); }
        else if (u < J3) { const int v = u - J2, kt = v / 16, nt = v % 16; tconv_tile<false>(a.in[9] + (size_t)layer * 2560 * 1024 + (size_t)1536 * 1024, 1024, (bf16_t*)(ws + WS_WBCT), 1024, kt * 64, nt * 64, t); }
        else if (u < J4) { const int v = u - J3, kt = v / 16, nt = v % 16; tconv_tile<false>(a.in[10] + (size_t)layer * 1024 * 1024, 1024, (bf16_t*)(ws + WS_WOT), 1024, kt * 64, nt * 64, t); }
        else if (u < J5) { const int v = u - J4, kt = v / 32, nt = v % 32; tconv_tile<false>(a.in[13] + (size_t)layer * 1024 * 2048, 2048, (bf16_t*)(ws + WS_WQT), 1024, kt * 64, nt * 64, t); }
        else if (u < J6) { const int v = u - J5, blk = v & 15, which = v >> 4;
            tconv_tile<false>(a.in[which ? 6 : 4] + ((size_t)layer * 16 + blk) * 4096, 64, (bf16_t*)(ws + (which ? WS_WXT : WS_WAT)) + blk * 4096, 64, 0, 0, t, -1.4426950408889634f); }
        else if (u < J7) { conv_fp6_rows(a.in[16] + (size_t)layer * 16384 * 1024, a.in[17] + (size_t)layer * 16384 * 1024, ws, u - J6); }
        else if (u < J9) { const int v = u - J8; if (v < 32) conv_unit(a.in[14] + (size_t)layer * 131072, (bf16_t*)(ws + WS_K1B), v); else conv_unit(a.in[15] + (size_t)layer * 131072, (bf16_t*)(ws + WS_K2B), v - 32); }
        else { for (int c = mk_tid(); c < 1024; c += 512) { const float lam = a.in[8][layer * 1024 + c]; const float e = __builtin_amdgcn_exp2f(-lam * 1.4426950408889634f); const float sp = (e < 0.05f) ? e * (1.0f + e * (-0.5f + e * (0.33333333f + e * -0.25f))) : __builtin_amdgcn_logf(1.0f + e) * 0.6931471805599453f; ((float*)(ws + WS_CCH))[c] = -8.0f * sp; } }
    }
}

DI void phase_prologue(const Args& a) {
    unsigned char* ws = a.ws;
    const int tid = mk_tid();
    for (int u = blockIdx.x; u < 2048; u += gridDim.x) {
        { const int ln = tid & 63; const size_t row = (size_t)u * 8 + (tid >> 6);
            const float* xp = a.in[0] + row * 1024 + 16 * ln; float* xo = (float*)(ws + WS_XF) + row * 1024 + 16 * ln;
            f32x4 o[4];
#pragma unroll
            for (int q = 0; q < 4; ++q) { o[q] = *(const f32x4*)(xp + 4 * q); *(f32x4*)(xo + 4 * q) = o[q]; }
            row_to_fp8(o, ws + WS_X8 + row * 1024, ln); }
    }
}

DI void attn_unit(const Args& a, int unit, LAS unsigned char* lds) {
    unsigned char* ws = a.ws;
    const int tid = mk_tid(), lane = tid & 63, w = __builtin_amdgcn_readfirstlane(tid >> 6), g = lane >> 4, l15 = lane & 15, tq4 = l15 >> 2, tp4 = l15 & 3;
    const int b = unit / 384, rem = unit % 384, h = rem >> 5, bi = rem & 31;
    const int grp = h >> 2, d = (grp == 0) ? 1 : ((grp == 1) ? 4 : 16), nb = 32 / d, r = bi / nb, n = bi % nb;
    const bf16_t* proj = (const bf16_t*)(ws + WS_PROJ) + (size_t)b * SEQ * DIN;
    LAS unsigned char* Ks = lds; LAS unsigned char* Vs = lds + 256 * 288;
#pragma unroll
    for (int i = 0; i < 8; ++i) {
        const int idx = tid + 512 * i, row = idx >> 4, ch = idx & 15, m = 128 * (n - 1) + row;
        u32x4 kv = {0u, 0u, 0u, 0u}, vv = {0u, 0u, 0u, 0u};
        if (m >= 0) { const bf16_t* p = proj + (size_t)(m * d + r) * DIN + h * 128 + ch * 8; kv = *(const u32x4*)(p + OFF_AK); vv = *(const u32x4*)(p + OFF_AV); }
        *(LAS u32x4*)(Ks + row * 288 + ch * 16) = kv; *(LAS u32x4*)(Vs + row * 288 + ch * 16) = vv;
    }
    const int qi = 16 * w + l15;
    const size_t tq = (size_t)(128 * n + qi) * d + r;
    bf16x8 qf[4];
#pragma unroll
    for (int ks = 0; ks < 4; ++ks) qf[ks] = *(const bf16x8*)(proj + tq * DIN + OFF_AQ + h * 128 + 32 * ks + 8 * g);
    __syncthreads();
    const int s0 = w >> 1;
    f32x4 sacc[10];
#pragma unroll
    for (int jj = 0; jj < 10; ++jj) {
        f32x4 acc = {0.f, 0.f, 0.f, 0.f};
#pragma unroll
        for (int ks = 0; ks < 4; ++ks) { const bf16x8 kf = *(const LAS bf16x8*)(Ks + (32 * s0 + 16 * jj + l15) * 288 + (32 * ks + 8 * g) * 2); acc = mfma16(kf, qf[ks], acc); }
        sacc[jj] = acc;
    }
    const float scale = 0.08838834764831845f * 1.4426950408889634f;
    float mx = -1e30f;
#pragma unroll
    for (int jj = 0; jj < 10; ++jj)
#pragma unroll
        for (int rg = 0; rg < 4; ++rg) {
            const int j = 32 * s0 + 16 * jj + 4 * g + rg;
            const bool valid = (j >= qi) && (j <= qi + 128) && (n > 0 || j >= 128);
            const float s = valid ? sacc[jj][rg] * scale : -1e30f;
            sacc[jj][rg] = s; mx = fmaxf(mx, s);
        }
    mx = fmaxf(mx, __shfl_xor(mx, 16)); mx = fmaxf(mx, __shfl_xor(mx, 32));
    float sum = 0.f;
#pragma unroll
    for (int jj = 0; jj < 10; ++jj)
#pragma unroll
        for (int rg = 0; rg < 4; ++rg) { const float p = __builtin_amdgcn_exp2f(sacc[jj][rg] - mx); sacc[jj][rg] = p; sum += p; }
    sum += __shfl_xor(sum, 16); sum += __shfl_xor(sum, 32);
    f32x4 oacc[8];
#pragma unroll
    for (int db = 0; db < 8; ++db) oacc[db] = (f32x4){0.f, 0.f, 0.f, 0.f};
#pragma unroll
    for (int s = 0; s < 5; ++s) {
        u32x4 pw; pw.x = pk2(sacc[2 * s][0], sacc[2 * s][1]); pw.y = pk2(sacc[2 * s][2], sacc[2 * s][3]); pw.z = pk2(sacc[2 * s + 1][0], sacc[2 * s + 1][1]); pw.w = pk2(sacc[2 * s + 1][2], sacc[2 * s + 1][3]);
        const bf16x8 pb = __builtin_bit_cast(bf16x8, pw);
        const int k0 = 32 * (s0 + s) + 4 * g + tq4;
#pragma unroll
        for (int db = 0; db < 8; ++db) {
            const s16x4 lo = trrd(Vs + k0 * 288 + (16 * db + 4 * tp4) * 2), hi = trrd(Vs + (k0 + 16) * 288 + (16 * db + 4 * tp4) * 2);
            oacc[db] = mfma16(cat8(lo, hi), pb, oacc[db]);
        }
    }
    const float inv = 1.0f / sum;
    bf16_t* op = (bf16_t*)(ws + WS_OATT) + ((size_t)b * SEQ + tq) * 1536 + h * 128 + 4 * g;
#pragma unroll
    for (int db = 0; db < 8; ++db) { u32x2 o; o.x = pk2(oacc[db][0] * inv, oacc[db][1] * inv); o.y = pk2(oacc[db][2] * inv, oacc[db][3] * inv); *(u32x2*)(op + 16 * db) = o; }
    if (g == 0) ((float*)(ws + WS_LSE))[((size_t)b * SEQ + tq) * 12 + h] = mx + __builtin_amdgcn_logf(sum);
    __syncthreads();
}

DI void retkv_unit(const Args& a, int unit, LAS unsigned char* lds) {
    unsigned char* ws = a.ws;
    const int tid = mk_tid(), lane = tid & 63, w = __builtin_amdgcn_readfirstlane(tid >> 6), g = lane >> 4, l15 = lane & 15, tq4 = l15 >> 2, tp4 = l15 & 3;
    const int b = unit >> 7, h = (unit >> 5) & 3, c = unit & 31;
    const bf16_t* proj = (const bf16_t*)(ws + WS_PROJ) + ((size_t)b * SEQ + c * 128) * DIN;
    LAS unsigned char* Ks = lds; LAS unsigned char* Vs = lds + 128 * 544;
    const float l2g = log2gamma(h);
#pragma unroll
    for (int i = 0; i < 8; ++i) {
        const int idx = tid + 512 * i, row = idx >> 5, ch = idx & 31;
        const bf16_t* p = proj + (size_t)row * DIN + h * 256 + ch * 8;
        const u32x4 kv = *(const u32x4*)(p + OFF_RK), vv = *(const u32x4*)(p + OFF_RV);
        const float z = exp2f((float)(127 - row) * l2g);
        u32x4 kz;
#pragma unroll
        for (int q = 0; q < 4; ++q) kz[q] = pk2(bflo(kv[q]) * z, bfhi(kv[q]) * z);
        *(LAS u32x4*)(Ks + row * 544 + ch * 16) = kz; *(LAS u32x4*)(Vs + row * 544 + ch * 16) = vv;
    }
    __syncthreads();
#pragma unroll 1
    for (int nh = 0; nh < 2; ++nh) {
        f32x4 acc[2][8];
#pragma unroll
        for (int mb = 0; mb < 2; ++mb)
#pragma unroll
            for (int nb = 0; nb < 8; ++nb) acc[mb][nb] = (f32x4){0.f, 0.f, 0.f, 0.f};
#pragma unroll
        for (int ks = 0; ks < 4; ++ks) {
            const int j0 = 32 * ks + 4 * g + tq4;
            bf16x8 af[2];
#pragma unroll
            for (int mb = 0; mb < 2; ++mb) { const int col = 32 * w + 16 * mb + 4 * tp4; af[mb] = cat8(trrd(Vs + j0 * 544 + col * 2), trrd(Vs + (j0 + 16) * 544 + col * 2)); }
#pragma unroll
            for (int nb = 0; nb < 8; ++nb) {
                const int col = 128 * nh + 16 * nb + 4 * tp4;
                const bf16x8 bfr = cat8(trrd(Ks + j0 * 544 + col * 2), trrd(Ks + (j0 + 16) * 544 + col * 2));
#pragma unroll
                for (int mb = 0; mb < 2; ++mb) acc[mb][nb] = mfma16(af[mb], bfr, acc[mb][nb]);
            }
        }
        bf16_t* kvb = (bf16_t*)(ws + WS_KVB) + ((size_t)((b * 4 + h) * 32 + c)) * 65536 + 128 * nh;
#pragma unroll
        for (int mb = 0; mb < 2; ++mb)
#pragma unroll
            for (int nb = 0; nb < 8; ++nb)
#pragma unroll
                for (int rg = 0; rg < 4; ++rg) kvb[(size_t)(32 * w + 16 * mb + 4 * g + rg) * 256 + 16 * nb + l15] = f2bf(acc[mb][nb][rg]);
    }
    __syncthreads();
}

DI void lru_stripe(const Args& a, int layer, int stripe, LAS unsigned char* lds) {
    unsigned char* ws = a.ws;
    const int tid = mk_tid(), lane = tid & 63, w = __builtin_amdgcn_readfirstlane(tid >> 6), g = lane >> 4, l15 = lane & 15;
    const int b = stripe >> 4, blk = stripe & 15;
    LAS bf16_t* lxs = (LAS bf16_t*)lds;
    LAS bf16_t* lgs0 = (LAS bf16_t*)(lds + 16896);
    LAS unsigned char* xcb = lds + 49664;
    LAS float* rgt = (LAS float*)(lds + 68096);
    LAS float* igt = (LAS float*)(lds + 100864);
    LAS float* wst = (LAS float*)(lds + 133632);
    const bf16_t* proj = (const bf16_t*)(ws + WS_PROJ) + (size_t)b * SEQ * DIN;
    const int gc = blk * 64 + lane;
    const float* cw = a.in[2] + (size_t)layer * 4096;
    const int cch_ = tid & 63, cgc = blk * 64 + cch_;
    const float cw0 = cw[cgc], cw1 = cw[1024 + cgc], cw2 = cw[2048 + cgc], cw3 = cw[3072 + cgc], cb = a.in[3][layer * 1024 + cgc];
    const float cc = ((const float*)(ws + WS_CCH))[gc] * 1.4426950408889634f;
    float bia[4], bix[4];
    LAS unsigned char* wlds = lds + 137728;
    { const int r = tid >> 3, c8 = tid & 7; *(LAS u32x4*)(wlds + r * 144 + c8 * 16) = *(const u32x4*)((const bf16_t*)(ws + WS_WAT) + blk * 4096 + r * 64 + c8 * 8); }
    bf16x8 wfx[4][2];
#pragma unroll
    for (int nb = 0; nb < 4; ++nb)
#pragma unroll
        for (int ks = 0; ks < 2; ++ks) wfx[nb][ks] = *(const bf16x8*)((const bf16_t*)(ws + WS_WXT) + blk * 4096 + (16 * nb + l15) * 64 + 32 * ks + 8 * g);
#pragma unroll
    for (int nb = 0; nb < 4; ++nb) { bia[nb] = -1.4426950408889634f * a.in[5][layer * 1024 + blk * 64 + 16 * nb + l15]; bix[nb] = -1.4426950408889634f * a.in[7][layer * 1024 + blk * 64 + 16 * nb + l15]; }
    if (tid < 24) *(LAS u32x4*)(lxs + tid * 8) = (u32x4){0u, 0u, 0u, 0u};
    u32x4 plx[2], plg[2];
#pragma unroll
    for (int i = 0; i < 2; ++i) { const int idx = tid + 512 * i, row = idx >> 3, c8 = idx & 7; const bf16_t* p = proj + (size_t)row * DIN + blk * 64 + c8 * 8; plx[i] = *(const u32x4*)(p + OFF_LX); plg[i] = *(const u32x4*)(p + OFF_LG); }
    float hcarry = 0.0f;
#pragma unroll 1
    for (int c = 0; c < 32; ++c) {
        LAS bf16_t* lgs = lgs0 + (c & 1) * 8192;
#pragma unroll
        for (int i = 0; i < 2; ++i) { const int idx = tid + 512 * i, row = idx >> 3, c8 = idx & 7; *(LAS u32x4*)(lxs + (3 + row) * 64 + c8 * 8) = plx[i]; *(LAS u32x4*)(lgs + row * 64 + c8 * 8) = plg[i]; }
        __syncthreads();
        if (c + 1 < 32) {
#pragma unroll
            for (int i = 0; i < 2; ++i) { const int idx = tid + 512 * i, row = idx >> 3, c8 = idx & 7; const bf16_t* p = proj + (size_t)((c + 1) * 128 + row) * DIN + blk * 64 + c8 * 8; plx[i] = *(const u32x4*)(p + OFF_LX); plg[i] = *(const u32x4*)(p + OFF_LG); }
        }
        {
            const int t0 = (tid >> 6) * 16;
            float x0 = bf2f(lxs[t0 * 64 + cch_]), x1 = bf2f(lxs[(t0 + 1) * 64 + cch_]), x2 = bf2f(lxs[(t0 + 2) * 64 + cch_]);
#pragma unroll
            for (int i = 0; i < 16; ++i) {
                const float x3 = bf2f(lxs[(t0 + i + 3) * 64 + cch_]);
                const float xc = cb + cw0 * x0 + cw1 * x1 + cw2 * x2 + cw3 * x3;
                *(LAS bf16_t*)(xcb + (t0 + i) * 144 + cch_ * 2) = f2bf(xc);
                x0 = x1; x1 = x2; x2 = x3;
            }
        }
        __syncthreads();
        if (tid < 24) *(LAS u32x4*)(lxs + tid * 8) = *(const LAS u32x4*)(lxs + 128 * 64 + tid * 8);
        {
            const bf16x8 af0 = *(const LAS bf16x8*)(xcb + (16 * w + l15) * 144 + (8 * g) * 2), af1 = *(const LAS bf16x8*)(xcb + (16 * w + l15) * 144 + (32 + 8 * g) * 2);
#pragma unroll
            for (int nb = 0; nb < 4; ++nb) {
                f32x4 ar = {0.f, 0.f, 0.f, 0.f}, ax = {0.f, 0.f, 0.f, 0.f};
                const LAS unsigned char* wr_ = wlds + (16 * nb + l15) * 144 + 16 * g;
                ar = mfma16(af0, *(const LAS bf16x8*)(wr_), ar); ar = mfma16(af1, *(const LAS bf16x8*)(wr_ + 64), ar);
                ax = mfma16(af0, wfx[nb][0], ax); ax = mfma16(af1, wfx[nb][1], ax);
#pragma unroll
                for (int rg = 0; rg < 4; ++rg) { rgt[(16 * w + 4 * g + rg) * 64 + 16 * nb + l15] = __builtin_amdgcn_rcpf(1.0f + __builtin_amdgcn_exp2f(ar[rg] + bia[nb])); igt[(16 * w + 4 * g + rg) * 64 + 16 * nb + l15] = __builtin_amdgcn_rcpf(1.0f + __builtin_amdgcn_exp2f(ax[rg] + bix[nb])); }
            }
        }
        __syncthreads();
        float av[16], bv[16]; float Aw = 1.0f, Hw = 0.0f;
#pragma unroll
        for (int tt = 0; tt < 16; ++tt) {
            const int t = 16 * w + tt;
            const float aa = __builtin_amdgcn_exp2f(cc * rgt[t * 64 + lane]);
            const float bb = __builtin_amdgcn_sqrtf(fmaxf(1.0f - aa * aa, 0.0f)) * igt[t * 64 + lane] * bf2f(*(const LAS bf16_t*)(xcb + t * 144 + lane * 2));
            av[tt] = aa; bv[tt] = bb; Hw = aa * Hw + bb; Aw *= aa;
        }
        wst[w * 64 + lane] = Aw; wst[512 + w * 64 + lane] = Hw;
        __syncthreads();
        float hcur = hcarry, hend = hcarry;
#pragma unroll
        for (int ww = 0; ww < 8; ++ww) { const float A_ = wst[ww * 64 + lane], H_ = wst[512 + ww * 64 + lane]; hend = A_ * hend + H_; if (ww < w) hcur = hend; }
        hcarry = hend;
        bf16_t* yb = (bf16_t*)(ws + WS_YB) + ((size_t)b * SEQ + c * 128 + 16 * w) * 1024 + gc;
#pragma unroll
        for (int tt = 0; tt < 16; tt += 2) {
            const float h0 = av[tt] * hcur + bv[tt]; hcur = av[tt + 1] * h0 + bv[tt + 1];
            const pg8::f32x2 gl = pg8::gelu_pk((pg8::f32x2){bf2f(lgs[(16 * w + tt) * 64 + lane]), bf2f(lgs[(16 * w + tt + 1) * 64 + lane])});
            yb[(size_t)tt * 1024] = f2bf(h0 * gl.x); yb[(size_t)(tt + 1) * 1024] = f2bf(hcur * gl.y);
        }
    }
    __syncthreads();
}

DI void retscan_unit(const Args& a, int unit) {
    unsigned char* ws = a.ws;
    const int e8 = unit * 512 + mk_tid();
    const int bh = e8 >> 13, within = e8 & 8191, h = bh & 3;
    const float g128 = exp2f(128.0f * log2gamma(h));
    bf16_t* base = (bf16_t*)(ws + WS_KVB) + (size_t)bh * 32 * 65536 + (size_t)within * 8;
    float st[8];
#pragma unroll
    for (int q = 0; q < 8; ++q) st[q] = 0.f;
#pragma unroll 1
    for (int c0 = 0; c0 < 32; c0 += 8) {
        u32x4 kv[8];
#pragma unroll
        for (int q = 0; q < 8; ++q) kv[q] = *(const u32x4*)(base + (size_t)(c0 + q) * 65536);
#pragma unroll
        for (int q = 0; q < 8; ++q) {
            u32x4 o;
#pragma unroll
            for (int j = 0; j < 4; ++j) o[j] = pk2(st[2 * j], st[2 * j + 1]);
            *(u32x4*)(base + (size_t)(c0 + q) * 65536) = o;
#pragma unroll
            for (int j = 0; j < 4; ++j) { st[2 * j] = g128 * st[2 * j] + bflo(kv[q][j]); st[2 * j + 1] = g128 * st[2 * j + 1] + bfhi(kv[q][j]); }
        }
    }
}

DI void attmerge_unit(const Args& a, int unit) {
    unsigned char* ws = a.ws;
    const int idx = unit * 512 + mk_tid(), t = idx >> 6, hp = (idx >> 4) & 3, dc = idx & 15;
    const float* lse = (const float*)(ws + WS_LSE) + (size_t)t * 12;
    const float l0 = lse[hp], l1 = lse[4 + hp], l2 = lse[8 + hp];
    const float m = fmaxf(l0, fmaxf(l1, l2));
    float w0 = __builtin_amdgcn_exp2f(l0 - m), w1 = __builtin_amdgcn_exp2f(l1 - m), w2 = __builtin_amdgcn_exp2f(l2 - m);
    const float is = 1.0f / (w0 + w1 + w2); w0 *= is; w1 *= is; w2 *= is;
    const bf16_t* o = (const bf16_t*)(ws + WS_OATT) + (size_t)t * 1536 + hp * 128 + dc * 8;
    const u32x4 a0 = *(const u32x4*)o, a1 = *(const u32x4*)(o + 512), a2 = *(const u32x4*)(o + 1024);
    u32x4 r;
#pragma unroll
    for (int q = 0; q < 4; ++q) r[q] = pk2(w0 * bflo(a0[q]) + w1 * bflo(a1[q]) + w2 * bflo(a2[q]), w0 * bfhi(a0[q]) + w1 * bfhi(a1[q]) + w2 * bfhi(a2[q]));
    *(u32x4*)((bf16_t*)(ws + WS_YA) + (size_t)t * 512 + hp * 128 + dc * 8) = r;
}

DI void retout_unit(const Args& a, int unit, LAS unsigned char* lds) {
    unsigned char* ws = a.ws;
    const int tid = mk_tid(), lane = tid & 63, w = __builtin_amdgcn_readfirstlane(tid >> 6), g = lane >> 4, l15 = lane & 15, tq4 = l15 >> 2, tp4 = l15 & 3;
    const int b = unit >> 7, h = (unit >> 5) & 3, c = unit & 31;
    const bf16_t* proj = (const bf16_t*)(ws + WS_PROJ) + ((size_t)b * SEQ + c * 128) * DIN;
    const bf16_t* rt = (const bf16_t*)(ws + WS_KVB) + ((size_t)((b * 4 + h) * 32 + c)) * 65536;
    LAS unsigned char* RA = lds; LAS unsigned char* RB = lds + 128 * 544;
    const float l2g = log2gamma(h);
    const int qi = 16 * w + l15;
    bf16x8 qf[8];
#pragma unroll
    for (int ks = 0; ks < 8; ++ks) qf[ks] = *(const bf16x8*)(proj + (size_t)qi * DIN + OFF_RQ + h * 256 + 32 * ks + 8 * g);
#pragma unroll
    for (int i = 0; i < 8; ++i) {
        const int idx = tid + 512 * i, row = idx >> 5, ch = idx & 31;
        *(LAS u32x4*)(RA + row * 544 + ch * 16) = *(const u32x4*)(proj + (size_t)row * DIN + OFF_RK + h * 256 + ch * 8);
        *(LAS u32x4*)(RB + row * 544 + ch * 16) = *(const u32x4*)(rt + (size_t)row * 256 + ch * 8);
    }
    __syncthreads();
    u32x4 pv[8], pr[8];
#pragma unroll
    for (int i = 0; i < 8; ++i) {
        const int idx = tid + 512 * i, row = idx >> 5, ch = idx & 31;
        pv[i] = *(const u32x4*)(proj + (size_t)row * DIN + OFF_RV + h * 256 + ch * 8);
        pr[i] = *(const u32x4*)(rt + (size_t)(128 + row) * 256 + ch * 8);
    }
    f32x4 sacc[8], oacc[16];
#pragma unroll
    for (int jj = 0; jj < 8; ++jj) {
        f32x4 acc = {0.f, 0.f, 0.f, 0.f};
        if (jj <= w) {
#pragma unroll
            for (int ks = 0; ks < 8; ++ks) { const bf16x8 kf = *(const LAS bf16x8*)(RA + (16 * jj + l15) * 544 + (32 * ks + 8 * g) * 2); acc = mfma16(kf, qf[ks], acc); }
        }
        sacc[jj] = acc;
    }
#pragma unroll
    for (int db = 0; db < 8; ++db) {
        f32x4 acc = {0.f, 0.f, 0.f, 0.f};
#pragma unroll
        for (int ks = 0; ks < 8; ++ks) { const bf16x8 rf = *(const LAS bf16x8*)(RB + (16 * db + l15) * 544 + (32 * ks + 8 * g) * 2); acc = mfma16(rf, qf[ks], acc); }
        oacc[db] = acc;
    }
    __syncthreads();
#pragma unroll
    for (int i = 0; i < 8; ++i) {
        const int idx = tid + 512 * i, row = idx >> 5, ch = idx & 31;
        *(LAS u32x4*)(RA + row * 544 + ch * 16) = pv[i];
        *(LAS u32x4*)(RB + row * 544 + ch * 16) = pr[i];
    }
    __syncthreads();
#pragma unroll
    for (int db = 0; db < 8; ++db) {
        f32x4 acc = {0.f, 0.f, 0.f, 0.f};
#pragma unroll
        for (int ks = 0; ks < 8; ++ks) { const bf16x8 rf = *(const LAS bf16x8*)(RB + (16 * db + l15) * 544 + (32 * ks + 8 * g) * 2); acc = mfma16(rf, qf[ks], acc); }
        oacc[8 + db] = acc;
    }
    const float xi = __builtin_amdgcn_exp2f((float)(qi + 1) * l2g);
#pragma unroll
    for (int db = 0; db < 16; ++db) oacc[db] = oacc[db] * xi;
#pragma unroll
    for (int jj = 0; jj < 8; ++jj)
#pragma unroll
        for (int rg = 0; rg < 4; ++rg) { const int j = 16 * jj + 4 * g + rg; sacc[jj][rg] = (qi >= j) ? sacc[jj][rg] * __builtin_amdgcn_exp2f((float)(qi - j) * l2g) : 0.f; }
#pragma unroll
    for (int s = 0; s < 4; ++s) {
        if (2 * s <= w) {
            u32x4 pw; pw.x = pk2(sacc[2 * s][0], sacc[2 * s][1]); pw.y = pk2(sacc[2 * s][2], sacc[2 * s][3]); pw.z = pk2(sacc[2 * s + 1][0], sacc[2 * s + 1][1]); pw.w = pk2(sacc[2 * s + 1][2], sacc[2 * s + 1][3]);
            const bf16x8 pb = __builtin_bit_cast(bf16x8, pw);
            const int k0 = 32 * s + 4 * g + tq4;
#pragma unroll
            for (int db = 0; db < 16; ++db) {
                const s16x4 lo = trrd(RA + k0 * 544 + (16 * db + 4 * tp4) * 2), hi = trrd(RA + (k0 + 16) * 544 + (16 * db + 4 * tp4) * 2);
                oacc[db] = mfma16(cat8(lo, hi), pb, oacc[db]);
            }
        }
    }
    float s1 = 0.f;
#pragma unroll
    for (int db = 0; db < 16; ++db) s1 += (oacc[db][0] + oacc[db][1]) + (oacc[db][2] + oacc[db][3]);
    s1 += __shfl_xor(s1, 16); s1 += __shfl_xor(s1, 32);
    const float mean = s1 * (1.0f / 256.0f);
    float s2 = 0.f;
#pragma unroll
    for (int db = 0; db < 16; ++db)
#pragma unroll
        for (int rg = 0; rg < 4; ++rg) { const float dd = oacc[db][rg] - mean; s2 += dd * dd; }
    s2 += __shfl_xor(s2, 16); s2 += __shfl_xor(s2, 32);
    const float rstd = rsqrtf(s2 * (1.0f / 256.0f) + LN_EPS);
    __syncthreads();
#pragma unroll
    for (int db = 0; db < 16; ++db) {
        u32x2 o; o.x = pk2((oacc[db][0] - mean) * rstd, (oacc[db][1] - mean) * rstd); o.y = pk2((oacc[db][2] - mean) * rstd, (oacc[db][3] - mean) * rstd);
        *(LAS u32x2*)(RA + qi * 528 + (16 * db + 4 * g) * 2) = o;
    }
    __syncthreads();
#pragma unroll
    for (int i = 0; i < 8; ++i) {
        const int idx = tid + 512 * i, row = idx >> 5, ch = idx & 31;
        const u32x4 nv = *(const LAS u32x4*)(RA + row * 528 + ch * 16);
        const u32x4 gw = *(const u32x4*)(proj + (size_t)row * DIN + OFF_RG + h * 256 + ch * 8);
        u32x4 o;
#pragma unroll
        for (int q = 0; q < 4; ++q) { const float g0 = bflo(gw[q]), g1 = bfhi(gw[q]); o[q] = pk2(g0 * sigm(g0) * bflo(nv[q]), g1 * sigm(g1) * bfhi(nv[q])); }
        *(u32x4*)((bf16_t*)(ws + WS_YC) + ((size_t)b * SEQ + c * 128 + row) * 1024 + h * 256 + ch * 8) = o;
    }
    __syncthreads();
}

struct EpiBranch {
    static constexpr bool PERM = false, AFTER_DRAIN = false;
    const bf16_t* gate; bf16_t* mf; bf16_t* mb; int mode;
    __device__ __forceinline__ void operator()(const f32x4 (&acc)[2][2][4][2], const pg8::Unit& u, int wr, int wc, int fr, int fq) const {
        const int row0 = u.pm * 256 + wr * 64 + fr, col0 = u.pn * 256 + wc * 32 + 4 * fq;
        bf16_t* dst = (mode == 2) ? mb : mf;
#pragma unroll
        for (int ai = 0; ai < 2; ++ai) {
            u32x2 gw[4][2][2], old[4][2][2];
#pragma unroll
            for (int m = 0; m < 4; ++m) { const size_t row = (size_t)(row0 + ai * 128 + m * 16);
#pragma unroll
                for (int bj = 0; bj < 2; ++bj)
#pragma unroll
                    for (int n = 0; n < 2; ++n) { const int col = col0 + bj * 128 + n * 16;
                        gw[m][bj][n] = *(const u32x2*)(gate + row * DIN + col);
                        old[m][bj][n] = (mode != 0) ? *(const u32x2*)(mf + row * 1024 + col) : (u32x2){0u, 0u}; } }
#pragma unroll
            for (int m = 0; m < 4; ++m) { const size_t row = (size_t)(row0 + ai * 128 + m * 16);
#pragma unroll
                for (int bj = 0; bj < 2; ++bj)
#pragma unroll
                    for (int n = 0; n < 2; ++n) { const int col = col0 + bj * 128 + n * 16;
                        const u32x2 g2 = gw[m][bj][n], o2 = old[m][bj][n];
                        f32x4 v = acc[ai][bj][m][n];
                        v[0] = v[0] * sigm(bflo(g2.x)) + bflo(o2.x); v[1] = v[1] * sigm(bfhi(g2.x)) + bfhi(o2.x);
                        v[2] = v[2] * sigm(bflo(g2.y)) + bflo(o2.y); v[3] = v[3] * sigm(bfhi(g2.y)) + bfhi(o2.y);
                        u32x2 o; o.x = pk2(v[0], v[1]); o.y = pk2(v[2], v[3]); *(u32x2*)(dst + row * 1024 + col) = o; } }
        }
    }
};
#ifndef MK_EPI_AUX
#define MK_EPI_AUX 0
#endif
struct EpiInProj {
    static constexpr bool PERM = true, AFTER_DRAIN = false;
    bf16_t* O;
    __device__ __forceinline__ void operator()(const f32x4 (&acc)[2][2][4][2], const pg8::Unit& u, int wr_, int wc_, int fr_, int fq_) const {
        (void)wr_; (void)wc_; (void)fr_; (void)fq_;
        const int tid = mk_tid(), wid = tid >> 6, lane = tid & 63, wr = wid >> 2, wc = wid & 3, fr = lane & 15, fq = lane >> 4;
        const __amdgpu_buffer_rsrc_t rsrc = __builtin_amdgcn_make_buffer_rsrc((void*)O, 0, (int)((size_t)NTOK * DIN * 2), 0x00020000);
        const int row0 = u.pm * 256 + wr * 64 + fr;
        const int pn = u.pn;
        const bool ropeA = pn < 12, ropeR = (pn >= 26 && pn < 34);
        const float dsc = 1.0f / (X8_SCALE * W8_SCALE);
        if (!(ropeA || ropeR)) {
            const int col0 = pn * 256 + 64 * wc + 8 * fq;
#pragma unroll
            for (int ai = 0; ai < 2; ++ai) {
#pragma unroll
                for (int m = 0; m < 4; ++m) { const unsigned roff = (unsigned)(((size_t)(row0 + ai * 128 + m * 16) * DIN + col0) * 2);
#pragma unroll
                    for (int bj = 0; bj < 2; ++bj) { const f32x4 v0 = acc[ai][bj][m][0] * dsc, v1 = acc[ai][bj][m][1] * dsc;
                        u32x4 w; w.x = pk2(v0[0], v0[1]); w.y = pk2(v0[2], v0[3]); w.z = pk2(v1[0], v1[1]); w.w = pk2(v1[2], v1[3]);
                        __builtin_amdgcn_raw_buffer_store_b128(w, rsrc, (int)(roff + bj * 64), 0, MK_EPI_AUX); } }
            }
        } else {
            const int half = ropeA ? 64 : 128;
            const float sc = (pn >= 30 && pn < 34) ? 0.0625f : 1.0f;
            const float kf = ropeA ? (-13.287712379549449f / 64.0f) : (-13.287712379549449f / 128.0f);
            const float pos0 = (float)(row0 & (SEQ - 1));
#pragma unroll
            for (int bj = 0; bj < 2; ++bj) {
                const int pc = 64 * wc + 32 * bj + 8 * fq;
                const int cbase = ropeA ? (pc & 128) : 0;
                const int q = ropeA ? ((pc & 127) >> 3) : (pc >> 3);
                f32x4 cb, sb, c16, s16, cb1, sb1;
#pragma unroll
                for (int e = 0; e < 4; ++e) {
                    const float f = __builtin_amdgcn_exp2f((float)(4 * q + e) * kf) * 0.15915494309189535f;
                    const float t0 = __builtin_amdgcn_fractf(pos0 * f), t16 = __builtin_amdgcn_fractf(16.0f * f), t128 = __builtin_amdgcn_fractf(128.0f * f);
                    cb[e] = __builtin_amdgcn_cosf(t0); sb[e] = __builtin_amdgcn_sinf(t0);
                    c16[e] = __builtin_amdgcn_cosf(t16); s16[e] = __builtin_amdgcn_sinf(t16);
                    const float c128 = __builtin_amdgcn_cosf(t128), s128 = __builtin_amdgcn_sinf(t128);
                    cb1[e] = cb[e] * c128 - sb[e] * s128; sb1[e] = sb[e] * c128 + cb[e] * s128;
                }
#pragma unroll
                for (int ai = 0; ai < 2; ++ai) {
                    f32x4 cv = ai ? cb1 : cb, sv = ai ? sb1 : sb;
#pragma unroll
                    for (int m = 0; m < 4; ++m) {
                        const int row = row0 + ai * 128 + m * 16;
                        const unsigned roff = (unsigned)(((size_t)row * DIN + pn * 256) * 2);
                        const float rsc = dsc * sc;
                        const f32x4 t1 = acc[ai][bj][m][0] * rsc, t2 = acc[ai][bj][m][1] * rsc;
                        const f32x4 o1 = t1 * cv - t2 * sv, o2 = t1 * sv + t2 * cv;
                        u32x2 w1, w2; w1.x = pk2(o1[0], o1[1]); w1.y = pk2(o1[2], o1[3]); w2.x = pk2(o2[0], o2[1]); w2.y = pk2(o2[2], o2[3]);
                        __builtin_amdgcn_raw_buffer_store_b64(w1, rsrc, (int)(roff + (cbase + 4 * q) * 2), 0, MK_EPI_AUX); __builtin_amdgcn_raw_buffer_store_b64(w2, rsrc, (int)(roff + (cbase + half + 4 * q) * 2), 0, MK_EPI_AUX);
                        if (m < 3) { const f32x4 cn = cv * c16 - sv * s16, sn = sv * c16 + cv * s16; cv = cn; sv = sn; }
                    }
                }
            }
        }
    }
};

struct EpiOut {
    static constexpr bool PERM = false, AFTER_DRAIN = false;
    const float* xf; float* z;
    __device__ __forceinline__ void operator()(const f32x4 (&acc)[2][2][4][2], const pg8::Unit& u, int wr, int wc, int fr, int fq) const {
        const int row0 = u.pm * 256 + wr * 64 + fr, col0 = u.pn * 256 + wc * 32 + 4 * fq;
#pragma unroll
        for (int ai = 0; ai < 2; ++ai) {
            f32x4 xv[4][2][2];
#pragma unroll
            for (int m = 0; m < 4; ++m) { const size_t row = (size_t)(row0 + ai * 128 + m * 16);
#pragma unroll
                for (int bj = 0; bj < 2; ++bj)
#pragma unroll
                    for (int n = 0; n < 2; ++n) xv[m][bj][n] = *(const f32x4*)(xf + row * 1024 + col0 + bj * 128 + n * 16); }
#pragma unroll
            for (int m = 0; m < 4; ++m) { const size_t row = (size_t)(row0 + ai * 128 + m * 16);
#pragma unroll
                for (int bj = 0; bj < 2; ++bj)
#pragma unroll
                    for (int n = 0; n < 2; ++n) *(f32x4*)(z + row * 1024 + col0 + bj * 128 + n * 16) = xv[m][bj][n] * ALPHA + acc[ai][bj][m][n]; }
        }
    }
};

DI void ln_row(const float* z, const float* gam, const float* bet, float* of, bf16_t* ob, int lane) {
    f32x4 v[4]; float s = 0.f;
#pragma unroll
    for (int i = 0; i < 4; ++i) { v[i] = *(const f32x4*)(z + 256 * i + 4 * lane); s += (v[i][0] + v[i][1]) + (v[i][2] + v[i][3]); }
    const float mean = wsum(s) * (1.0f / 1024.0f);
    float q = 0.f;
#pragma unroll
    for (int i = 0; i < 4; ++i)
#pragma unroll
        for (int j = 0; j < 4; ++j) { const float d = v[i][j] - mean; q += d * d; }
    const float rstd = rsqrtf(wsum(q) * (1.0f / 1024.0f) + LN_EPS);
#pragma unroll
    for (int i = 0; i < 4; ++i) {
        const f32x4 gg = *(const f32x4*)(gam + 256 * i + 4 * lane), bb = *(const f32x4*)(bet + 256 * i + 4 * lane);
        f32x4 o;
#pragma unroll
        for (int j = 0; j < 4; ++j) o[j] = (v[i][j] - mean) * rstd * gg[j] + bb[j];
        *(f32x4*)(of + 256 * i + 4 * lane) = o;
        u32x2 pb; pb.x = pk2(o[0], o[1]); pb.y = pk2(o[2], o[3]); *(u32x2*)(ob + 256 * i + 4 * lane) = pb;
    }
}
DI void phase_ln1(const Args& a, int layer) {
    unsigned char* ws = a.ws;
    const int lane = mk_tid() & 63, w = mk_tid() >> 6;
    for (int u = blockIdx.x; u < NTOK / 8; u += gridDim.x) {
        const size_t row = (size_t)u * 8 + w;
        ln_row((const float*)(ws + WS_MRGF) + row * 1024, a.in[11] + layer * 1024, a.in[12] + layer * 1024, (float*)(ws + WS_XF) + row * 1024, (bf16_t*)(ws + WS_XB) + row * 1024, lane);
    }
}

DI void ins16(float (&L)[16], float x) {
#pragma unroll
    for (int k = 0; k < 16; ++k) { const float hi = fmaxf(L[k], x); x = fminf(L[k], x); L[k] = hi; }
}
DI void merge16(float (&L)[16], int xr) {
    float t[16];
#pragma unroll
    for (int k = 0; k < 16; ++k) t[k] = __shfl_xor(L[k], xr);
#pragma unroll
    for (int k = 0; k < 8; ++k) { const float x = t[k]; t[k] = t[15 - k]; t[15 - k] = x; }
#pragma unroll
    for (int k = 0; k < 16; ++k) t[k] = fmaxf(L[k], t[k]);
#define MK_CE_STAGE(dd) _Pragma("unroll") for (int k = 0; k < 16; ++k) if ((k & (dd)) == 0) { const float hi = fmaxf(t[k], t[k + (dd)]), lo = fminf(t[k], t[k + (dd)]); t[k] = hi; t[k + (dd)] = lo; }
    MK_CE_STAGE(8) MK_CE_STAGE(4) MK_CE_STAGE(2) MK_CE_STAGE(1)
#undef MK_CE_STAGE
#pragma unroll
    for (int k = 0; k < 16; ++k) L[k] = t[k];
}
#define MK_CE_DESC(v, i, l) { const float hi_ = fmaxf(v[i], v[l]), lo_ = fminf(v[i], v[l]); v[i] = hi_; v[l] = lo_; }
#define MK_CE_ASC(v, i, l)  { const float hi_ = fmaxf(v[i], v[l]), lo_ = fminf(v[i], v[l]); v[i] = lo_; v[l] = hi_; }
#define MK_BITONIC_STAGE(v, kk, jj) _Pragma("unroll") for (int i_ = 0; i_ < 16; ++i_) { if ((i_ & (jj)) == 0) { if ((i_ & (kk)) == 0) MK_CE_DESC(v, i_, i_ + (jj)) else MK_CE_ASC(v, i_, i_ + (jj)) } }
DI void sort16_desc(float (&v)[16]) {
    MK_BITONIC_STAGE(v, 2, 1)
    MK_BITONIC_STAGE(v, 4, 2) MK_BITONIC_STAGE(v, 4, 1)
    MK_BITONIC_STAGE(v, 8, 4) MK_BITONIC_STAGE(v, 8, 2) MK_BITONIC_STAGE(v, 8, 1)
    MK_BITONIC_STAGE(v, 16, 8) MK_BITONIC_STAGE(v, 16, 4) MK_BITONIC_STAGE(v, 16, 2) MK_BITONIC_STAGE(v, 16, 1)
}
DI void top16_of_two(float (&a)[16], const float (&b)[16]) {
#pragma unroll
    for (int k = 0; k < 16; ++k) a[k] = fmaxf(a[k], b[15 - k]);
    MK_BITONIC_STAGE(a, 16, 8) MK_BITONIC_STAGE(a, 16, 4) MK_BITONIC_STAGE(a, 16, 2) MK_BITONIC_STAGE(a, 16, 1)
}
DI void top16_half(const bf16_t* qp, const bf16_t* kb, float (&L)[16], int g, int l15) {
    bf16x8 qf[4];
#pragma unroll
    for (int ks = 0; ks < 4; ++ks) qf[ks] = *(const bf16x8*)(qp + 32 * ks + 8 * g);
    float M[16];
#pragma unroll
    for (int kbk = 0; kbk < 8; ++kbk) {
        f32x4 acc = {0.f, 0.f, 0.f, 0.f};
#pragma unroll
        for (int ks = 0; ks < 4; ++ks) { const bf16x8 kf = *(const bf16x8*)(kb + (size_t)(16 * kbk + l15) * 128 + 32 * ks + 8 * g); acc = mfma16(kf, qf[ks], acc); }
#pragma unroll
        for (int rg = 0; rg < 4; ++rg) { const unsigned key = (unsigned)(16 * kbk + 4 * g + rg); const float x = __uint_as_float((__float_as_uint(acc[rg]) & ~0x7Fu) | key);
            if (kbk < 4) L[4 * kbk + rg] = x; else M[4 * (kbk - 4) + rg] = x; }
    }
    sort16_desc(L); sort16_desc(M); top16_of_two(L, M);
    merge16(L, 16); merge16(L, 32);
}
DI void topk_unit(const Args& a, int unit, LAS unsigned char* lds) {
    unsigned char* ws = a.ws;
    const int tid = mk_tid(), lane = tid & 63, w = __builtin_amdgcn_readfirstlane(tid >> 6), g = lane >> 4, l15 = lane & 15;
    const int tg = w & 3, hs = w >> 2;
    const size_t t = (size_t)unit * 64 + tg * 16 + l15;
    const bf16_t* Q = (const bf16_t*)(ws + WS_Q);
    float K1[16], K2[16];
#pragma unroll
    for (int k = 0; k < 16; ++k) { K1[k] = 0.f; K2[k] = 0.f; }
#pragma unroll 1
    for (int hh = 0; hh < 4; ++hh) {
        const int h = hs * 4 + hh;
        float l1[16], l2[16];
        top16_half(Q + t * 2048 + h * 256, (const bf16_t*)(ws + WS_K1B) + (size_t)h * 16384, l1, g, l15);
        top16_half(Q + t * 2048 + h * 256 + 128, (const bf16_t*)(ws + WS_K2B) + (size_t)h * 16384, l2, g, l15);
        const bool mine = (g == hh);
#pragma unroll
        for (int k = 0; k < 16; ++k) { K1[k] = mine ? l1[k] : K1[k]; K2[k] = mine ? l2[k] : K2[k]; }
    }
    const int h = hs * 4 + g;
    float F[16];
#pragma unroll
    for (int k = 0; k < 16; ++k) F[k] = -FLT_MAX;
#pragma unroll
    for (int ia = 0; ia < 16; ++ia)
#pragma unroll
        for (int ib = 0; ib < 16 / (ia + 1); ++ib) {
            const float s = __uint_as_float(__float_as_uint(K1[ia]) & ~0x7Fu) + __uint_as_float(__float_as_uint(K2[ib]) & ~0x7Fu);
            ins16(F, __uint_as_float((__float_as_uint(s) & ~0xFFu) | (unsigned)(ia * 16 + ib)));
        }
    LAS int* row = (LAS int*)lds + tid * 33;
#pragma unroll
    for (int k = 0; k < 16; ++k) { row[k] = (int)(__float_as_uint(K1[k]) & 0x7Fu); row[16 + k] = (int)(__float_as_uint(K2[k]) & 0x7Fu); }
    float gt[16]; int ei[16]; float gs = 0.f;
    const float cv0 = __uint_as_float(__float_as_uint(F[0]) & ~0xFFu);
#pragma unroll
    for (int k = 0; k < 16; ++k) {
        const unsigned bits = __float_as_uint(F[k]);
        const float cv = __uint_as_float(bits & ~0xFFu);
        gt[k] = __builtin_amdgcn_exp2f((cv - cv0) * 1.4426950408889634f); gs += gt[k];
        const int ia = (int)((bits >> 4) & 15u), ib = (int)(bits & 15u);
        ei[k] = row[ia] * 128 + row[16 + ib];
    }
    const float ig = 1.0f / gs;
    int* ep = (int*)(ws + WS_EID) + (t * 8 + h) * 16; float* gp = (float*)(ws + WS_GATE) + (t * 8 + h) * 16;
#pragma unroll
    for (int q = 0; q < 4; ++q) {
        *(i32x4*)(ep + 4 * q) = (i32x4){ei[4 * q], ei[4 * q + 1], ei[4 * q + 2], ei[4 * q + 3]};
        *(f32x4*)(gp + 4 * q) = (f32x4){gt[4 * q] * ig, gt[4 * q + 1] * ig, gt[4 * q + 2] * ig, gt[4 * q + 3] * ig};
    }
}

typedef float f32x2 __attribute__((ext_vector_type(2)));
#define MK_PEER_LOAD1(j, ereg, kk) { const int e_ = __builtin_amdgcn_readlane(ereg, (kk)); \
        const unsigned char* p_ = UV + (size_t)(unsigned)e_ * 1536u; RA[j] = ((const u32x4*)p_)[lane]; RB[j] = ((const u32x2*)(p_ + 1024))[lane]; }
#define MK_PEER_COMP1(j, usreg, gvreg, kk) { \
        const float us_ = __uint_as_float(__builtin_amdgcn_readlane(__float_as_uint(usreg), (kk))), gv_ = __uint_as_float(__builtin_amdgcn_readlane(__float_as_uint(gvreg), (kk))); \
        const f32x32 r_ = __builtin_amdgcn_cvt_scalef32_pk32_f32_fp6((u32x6){RA[j][0], RA[j][1], RA[j][2], RA[j][3], RB[j][0], RB[j][1]}, 1.0f); \
        f32x2 p2_ = {0.f, 0.f}; \
        _Pragma("unroll") for (int q = 0; q < 8; ++q) p2_ += (f32x2){r_[2 * q], r_[2 * q + 1]} * x2[q]; \
        const float p_ = wsum_dpp(p2_.x + p2_.y) * us_; \
        const float act_ = gelu_as(p_) * gv_; const f32x2 a2_ = {act_, act_}; \
        _Pragma("unroll") for (int q = 0; q < 8; ++q) y2[q] += a2_ * (f32x2){r_[16 + 2 * q], r_[16 + 2 * q + 1]}; \
        __builtin_amdgcn_sched_barrier(0); }
DI void peer_token(const unsigned char* UV, int e0, int e1, float us0, float us1, float gv0, float gv1, const f32x2 (&x2)[8], f32x2 (&y2)[8], int lane) {
    u32x4 RA[8]; u32x2 RB[8];
#pragma unroll
    for (int j = 0; j < 8; ++j) MK_PEER_LOAD1(j, e0, j)
#pragma unroll 1
    for (int k = 0; k < 56; k += 8) {
#pragma unroll
        for (int j = 0; j < 8; ++j) { MK_PEER_COMP1(j, us0, gv0, k + j) MK_PEER_LOAD1(j, e0, k + 8 + j) }
    }
#pragma unroll
    for (int j = 0; j < 8; ++j) { MK_PEER_COMP1(j, us0, gv0, 56 + j) MK_PEER_LOAD1(j, e1, j) }
#pragma unroll 1
    for (int k = 0; k < 56; k += 8) {
#pragma unroll
        for (int j = 0; j < 8; ++j) { MK_PEER_COMP1(j, us1, gv1, k + j) MK_PEER_LOAD1(j, e1, k + 8 + j) }
    }
#pragma unroll
    for (int j = 0; j < 8; ++j) { MK_PEER_COMP1(j, us1, gv1, 56 + j) }
}
DI void peer_unit(const Args& a, int layer, int unit) {
    unsigned char* ws = a.ws;
    const int tid = mk_tid(), lane = tid & 63, w = __builtin_amdgcn_readfirstlane(tid >> 6);
    const unsigned char* UV = ws + WS_UV8; const float* SC = (const float*)(ws + WS_UVS);
#pragma unroll 1
    for (int i = 0; i < 8; ++i) {
        const size_t t = (size_t)unit * 64 + w * 8 + i;
        f32x2 x2[8], y2[8];
        int e0, e1; float us0, us1, gv0, gv1;
        {
            const int ln = mk_tid() & 63;
            const bf16_t* xbp = (const bf16_t*)(ws + WS_XB) + t * 1024 + 16 * ln;
            const u32x4 xa = *(const u32x4*)xbp, xb = *(const u32x4*)(xbp + 8);
#pragma unroll
            for (int q = 0; q < 4; ++q) { x2[q] = (f32x2){bflo(xa[q]), bfhi(xa[q])}; x2[4 + q] = (f32x2){bflo(xb[q]), bfhi(xb[q])}; }
            const int* ep = (const int*)(ws + WS_EID) + t * 128; const float* gp = (const float*)(ws + WS_GATE) + t * 128;
            e0 = ep[ln]; e1 = ep[64 + ln]; const float g0 = gp[ln], g1 = gp[64 + ln];
            const f32x2 s0 = *(const f32x2*)(SC + 2 * e0), s1 = *(const f32x2*)(SC + 2 * e1);
            us0 = s0.x; us1 = s1.x; gv0 = g0 * s0.y; gv1 = g1 * s1.y;
        }
#pragma unroll
        for (int q = 0; q < 8; ++q) y2[q] = (f32x2){0.f, 0.f};
        peer_token(UV, e0, e1, us0, us1, gv0, gv1, x2, y2, lane);
        {
            const int ln = mk_tid() & 63;
            float* xfp = (float*)(ws + WS_XF) + t * 1024 + 16 * ln;
            const float* gam = a.in[18] + layer * 1024 + 16 * ln; const float* bet = a.in[19] + layer * 1024 + 16 * ln;
            float z[16]; float s = 0.f;
#pragma unroll
            for (int q = 0; q < 4; ++q) { const f32x4 xr = *(const f32x4*)(xfp + 4 * q);
#pragma unroll
                for (int j = 0; j < 4; ++j) { z[4 * q + j] = ALPHA * xr[j] + y2[2 * q + (j >> 1)][j & 1]; s += z[4 * q + j]; } }
            const float mean = wsum(s) * (1.0f / 1024.0f);
            float qq = 0.f;
#pragma unroll
            for (int q = 0; q < 16; ++q) { const float d = z[q] - mean; qq += d * d; }
            const float rstd = rsqrtf(wsum(qq) * (1.0f / 1024.0f) + LN_EPS);
            f32x4 o[4];
#pragma unroll
            for (int q = 0; q < 4; ++q) { const f32x4 gq = *(const f32x4*)(gam + 4 * q), bq = *(const f32x4*)(bet + 4 * q);
#pragma unroll
                for (int j = 0; j < 4; ++j) o[q][j] = (z[4 * q + j] - mean) * rstd * gq[j] + bq[j]; }
#pragma unroll
            for (int q = 0; q < 4; ++q) *(f32x4*)(xfp + 4 * q) = o[q];
            if (layer == DEPTH - 1) { float* op = a.out + t * 1024 + 16 * ln;
#pragma unroll
                for (int q = 0; q < 4; ++q) *(f32x4*)(op + 4 * q) = o[q]; }
            row_to_fp8(o, ws + WS_X8 + t * 1024, ln);
        }
    }
}
}

namespace mk {
constexpr int LDS_ARG_OFF = LDS_BYTES - 16 - 256;
#define MK_NOINL __device__ __forceinline__
DI unsigned long long rfl64(unsigned long long v) { const unsigned lo = __builtin_amdgcn_readfirstlane((unsigned)v), hi = __builtin_amdgcn_readfirstlane((unsigned)(v >> 32)); return ((unsigned long long)hi << 32) | lo; }
DI Args load_args(LAS unsigned char* lds) {
    int aoff = LDS_ARG_OFF; asm volatile("" : "+s"(aoff));
    Args a; const LAS unsigned long long* p = (const LAS unsigned long long*)(lds + aoff);
#pragma unroll
    for (int i = 0; i < 20; ++i) a.in[i] = (const float*)(const __attribute__((address_space(1))) float*)rfl64(p[i]);
    a.out = (float*)(__attribute__((address_space(1))) float*)rfl64(p[20]); a.ws = (unsigned char*)(__attribute__((address_space(1))) unsigned char*)rfl64(p[21]);
    a.ropeA = __longlong_as_double((long long)rfl64(p[22])); a.ropeR = __longlong_as_double((long long)rfl64(p[23])); a.ph_lo = 0; a.ph_hi = 0;
    return a;
}
#define MK_LOADARGS const Args a = load_args(lds); unsigned char* ws = a.ws; const int G = (int)gridDim.x, bid = (int)blockIdx.x; (void)ws; (void)G; (void)bid
MK_NOINL void PG_prologue(LAS unsigned char* lds) { MK_LOADARGS; phase_prologue(a); }
MK_NOINL void P0_conv(LAS unsigned char* lds, int layer) { MK_LOADARGS; phase_conv(a, layer, lds); }
#ifndef MK_STAGGER_TICKS
#define MK_STAGGER_TICKS 140
#endif
MK_NOINL void P1_inproj(LAS unsigned char* lds, int layer) { MK_LOADARGS; (void)layer;
    pg8::Gemm gm; gm.A = (const bf16_t*)(ws + WS_X8); gm.Bt = (const bf16_t*)(ws + WS_WINT); gm.M = NTOK; gm.N = DIN; gm.K = 512;
    pg8::StaticOrder S; S.init(NTOK, DIN, G, bid);
    EpiInProj E; E.O = (bf16_t*)(ws + WS_PROJ);
    pg8::gemm_phase<EpiInProj, pg8::StaticOrder, false, true, true>(lds, gm, S, E, nullptr); }
#ifndef MK_NLRU
#define MK_NLRU 64
#endif
MK_NOINL void P3s_lru(LAS unsigned char* lds, int layer) { MK_LOADARGS; if (bid < MK_NLRU) { for (int s = bid; s < 64; s += MK_NLRU) lru_stripe(a, layer, s, lds); } }
MK_NOINL void P3a_attn(LAS unsigned char* lds, int layer) { MK_LOADARGS; (void)layer; if (bid >= MK_NLRU) { for (int u = bid - MK_NLRU; u < 1536; u += G - MK_NLRU) attn_unit(a, u, lds); } }
MK_NOINL void P3b_retkv(LAS unsigned char* lds, int layer) { MK_LOADARGS; (void)layer; if (bid >= MK_NLRU) { for (int u = bid - MK_NLRU; u < 512; u += G - MK_NLRU) retkv_unit(a, u, lds); } }
MK_NOINL void P4a_scan(LAS unsigned char* lds, int layer) { MK_LOADARGS; (void)layer; for (int u = bid; u < 256; u += G) retscan_unit(a, u); }
MK_NOINL void P4c_merge(LAS unsigned char* lds, int layer) { MK_LOADARGS; (void)layer; for (int u = bid; u < 2048; u += G) attmerge_unit(a, u); }
MK_NOINL void P5_retout(LAS unsigned char* lds, int layer) { MK_LOADARGS; (void)layer; for (int u = bid; u < 512; u += G) retout_unit(a, u, lds); }
MK_NOINL void P6_branch(LAS unsigned char* lds, int layer) { MK_LOADARGS; (void)layer;
#pragma unroll 1
    for (int s = 0; s < 3; ++s) {
        pg8::Gemm gm; gm.A = (const bf16_t*)(ws + (s == 0 ? WS_YA : (s == 1 ? WS_YB : WS_YC))); gm.Bt = (const bf16_t*)(ws + (s == 0 ? WS_WBAT : (s == 1 ? WS_WBBT : WS_WBCT)));
        gm.M = NTOK; gm.N = 1024; gm.K = (s == 0) ? 512 : 1024;
        pg8::StaticOrder S; S.init(NTOK, 1024, G, bid);
        EpiBranch E; E.gate = (const bf16_t*)(ws + WS_PROJ) + OFF_GA + 1024 * s; E.mf = (bf16_t*)(ws + WS_MRGF); E.mb = (bf16_t*)(ws + WS_MRGB); E.mode = s;
        pg8::gemm_phase<EpiBranch, pg8::StaticOrder, false>(lds, gm, S, E, nullptr);
    } }
MK_NOINL void P7_outproj(LAS unsigned char* lds, int layer) { MK_LOADARGS; (void)layer;
    pg8::Gemm gm; gm.A = (const bf16_t*)(ws + WS_MRGB); gm.Bt = (const bf16_t*)(ws + WS_WOT); gm.M = NTOK; gm.N = 1024; gm.K = 1024;
    pg8::StaticOrder S; S.init(NTOK, 1024, G, bid);
    EpiOut E; E.xf = (const float*)(ws + WS_XF); E.z = (float*)(ws + WS_MRGF);
    pg8::gemm_phase<EpiOut, pg8::StaticOrder, false>(lds, gm, S, E, nullptr); }
MK_NOINL void P8_ln1(LAS unsigned char* lds, int layer) { MK_LOADARGS; phase_ln1(a, layer); }
MK_NOINL void P9_wq(LAS unsigned char* lds, int layer) { MK_LOADARGS; (void)layer;
    pg8::Gemm gm; gm.A = (const bf16_t*)(ws + WS_XB); gm.Bt = (const bf16_t*)(ws + WS_WQT); gm.M = NTOK; gm.N = 2048; gm.K = 1024;
    pg8::StaticOrder S; S.init(NTOK, 2048, G, bid);
    pg8::EpiBf16<0> E; E.O = (bf16_t*)(ws + WS_Q); E.ldc = 2048; E.bias = nullptr; E.split_cols = 0; E.split_stride = 0;
    pg8::gemm_phase<pg8::EpiBf16<0>, pg8::StaticOrder, false>(lds, gm, S, E, nullptr); }
MK_NOINL void P10_topk(LAS unsigned char* lds, int layer) { MK_LOADARGS; (void)layer; for (int u = bid; u < NTOK / 64; u += G) topk_unit(a, u, lds); }
MK_NOINL void P11_peer(LAS unsigned char* lds, int layer) { MK_LOADARGS; for (int u = bid; u < NTOK / 64; u += G) peer_unit(a, layer, u); }
DI void mk_sync(LAS unsigned char* lds) {
    const Args a = load_args(lds);
    XcdBarrier b; b.bar = (unsigned*)(a.ws + WS_CTL); b.x = xb_xcc_id(); b.st = (volatile LAS unsigned*)(lds + LDS_BAR_OFF);
    xcd_barrier(b);
}
}

#ifndef MK_PHASE_MASK
#define MK_PHASE_MASK 0xFFFu
#endif
#define MK_RUN(k) ((((MK_PHASE_MASK) >> ((k) - pb)) & 1u) && (k) >= ph_lo && (k) < ph_hi)
#define MK_NPHASES (1 + mk::DEPTH * mk::NPH)

#define MK_SYNC(k) do { if ((k) >= ph_lo && (k) + 1 < ph_hi) mk::mk_sync(lds); } while (0)
__global__ __launch_bounds__(512, 2) void mk_fwd(mk::Args a) {
    using namespace mk;
    extern __shared__ __attribute__((aligned(16))) unsigned char smem_raw[];
    LAS unsigned char* lds = (LAS unsigned char*)smem_raw;
    const int ph_lo = a.ph_lo, ph_hi = a.ph_hi;
    {
        const unsigned* src = (const unsigned*)&a;
        if (threadIdx.x < sizeof(Args) / 4) ((LAS unsigned*)(lds + LDS_ARG_OFF))[threadIdx.x] = src[threadIdx.x];
        if (threadIdx.x == 0) { LAS unsigned* st = (LAS unsigned*)(lds + LDS_BAR_OFF); st[0] = 0u; st[1] = 0u; st[2] = 0u; st[3] = 0u; }
    }
    __syncthreads();
    if (ph_hi - ph_lo > 1) (void)xcd_barrier_post((unsigned*)(a.ws + WS_CTL), (volatile LAS unsigned*)(lds + LDS_BAR_OFF));
    if (0 >= ph_lo && 0 < ph_hi) PG_prologue(lds);
    MK_SYNC(0);
#pragma unroll 1
    for (int layer = 0; layer < DEPTH; ++layer) {
        const int pb = 1 + layer * NPH;
        if (MK_RUN(pb + 0)) P0_conv(lds, layer);
        MK_SYNC(pb + 0);
        if (MK_RUN(pb + 1)) P1_inproj(lds, layer);
        MK_SYNC(pb + 1);
        if (MK_RUN(pb + 3)) { P3s_lru(lds, layer); P3a_attn(lds, layer); P3b_retkv(lds, layer); }
        MK_SYNC(pb + 3);
        if (MK_RUN(pb + 4)) { P4a_scan(lds, layer); P4c_merge(lds, layer); }
        MK_SYNC(pb + 4);
        if (MK_RUN(pb + 5)) P5_retout(lds, layer);
        MK_SYNC(pb + 5);
        if (MK_RUN(pb + 6)) P6_branch(lds, layer);
        MK_SYNC(pb + 6);
        if (MK_RUN(pb + 7)) P7_outproj(lds, layer);
        MK_SYNC(pb + 7);
        if (MK_RUN(pb + 8)) P8_ln1(lds, layer);
        MK_SYNC(pb + 8);
        if (MK_RUN(pb + 9)) P9_wq(lds, layer);
        MK_SYNC(pb + 9);
        if (MK_RUN(pb + 10)) P10_topk(lds, layer);
        MK_SYNC(pb + 10);
        if (MK_RUN(pb + 11)) P11_peer(lds, layer);
        MK_SYNC(pb + 11);
    }
}

#ifndef MK_SINGLE
#define MK_SINGLE 1
#endif
extern "C" void kernel_launch(void* const* d_in, const int* in_sizes, int n_in, void* d_out, int out_size, void* d_ws, size_t ws_size, hipStream_t stream) {
    using namespace mk;
    static int grid = 0;
    if (grid == 0) {
        if (n_in != 20 || out_size != NTOK * D || ws_size < WS_END) { fprintf(stderr, "kernel_launch: unexpected shapes (n_in %d, out %d, ws %zu, need %zu)\n", n_in, out_size, ws_size, (size_t)WS_END); grid = -1; return; }
        int dev = 0, cus = 0, per_cu = 0;
        if (hipGetDevice(&dev) != hipSuccess || hipDeviceGetAttribute(&cus, hipDeviceAttributeMultiprocessorCount, dev) != hipSuccess) { grid = -1; return; }
        if (hipFuncSetAttribute((const void*)mk_fwd, hipFuncAttributeMaxDynamicSharedMemorySize, LDS_BYTES) != hipSuccess) { fprintf(stderr, "kernel_launch: hipFuncSetAttribute failed\n"); grid = -1; return; }
        if (hipOccupancyMaxActiveBlocksPerMultiprocessor(&per_cu, (const void*)mk_fwd, 512, LDS_BYTES) != hipSuccess || per_cu < 1) { fprintf(stderr, "kernel_launch: occupancy query says %d blocks per CU\n", per_cu); (void)hipGetLastError(); grid = -1; return; }
        grid = cus;
    }
    if (grid < 0) return;
    (void)in_sizes;
    Args a{};
    for (int i = 0; i < 20; ++i) a.in[i] = (const float*)d_in[i];
    a.out = (float*)d_out; a.ws = (unsigned char*)d_ws;
    a.ropeA = pow(10000.0, -2.0 / 128.0); a.ropeR = pow(10000.0, -2.0 / 256.0);
#if MK_SINGLE
    (void)hipMemsetAsync((unsigned char*)d_ws + WS_CTL, 0, 16384, stream);
    a.ph_lo = 0; a.ph_hi = MK_NPHASES;
    hipLaunchKernelGGL(mk_fwd, dim3(grid), dim3(512), LDS_BYTES, stream, a);
#else
    for (int p = 0; p < MK_NPHASES; ++p) { a.ph_lo = p; a.ph_hi = p + 1; hipLaunchKernelGGL(mk_fwd, dim3(grid), dim3(512), LDS_BYTES, stream, a); }
#endif
}
```

```cpp
#include <hip/hip_runtime.h>
#include <cstdio>
#include <cstdint>
#include <cmath>
#include <cfloat>
__device__ __forceinline__ int mk_tid() { int t = (int)threadIdx.x; asm volatile("" : "+v"(t)); return t; }
namespace pg8 {
#define PG8_LAS __attribute__((address_space(3)))
typedef unsigned short bf16_t;
typedef short bf16x8 __attribute__((ext_vector_type(8)));
typedef float f32x4 __attribute__((ext_vector_type(4)));
typedef unsigned u32x4 __attribute__((ext_vector_type(4)));
constexpr int BM = 256, BK = 64, HALF = 128, HTB = HALF * BK * 2  , STAGE_BYTES = 8 * HTB, NXCD = 8, WGM = 8;

__host__ __device__ __forceinline__ int lds_byte(int r, int c) { const int st = (r >> 4) * 2 + (c >> 5), rr = r & 15, cc = c & 31, ob = rr * 64 + cc * 2; return st * 1024 + (ob ^ (((ob >> 9) & 1) << 5)); }
__host__ __device__ __forceinline__ void stage_rc(int b, int& R, int& C) { const int st = b / 1024, sb = b % 1024, swz = sb ^ (((sb >> 9) & 1) << 5); R = (st >> 1) * 16 + swz / 64; C = (st & 1) * 32 + (swz % 64) / 2; }
__host__ __device__ __forceinline__ int perm32(int rho) { const int n = rho >> 4, i = rho & 15; return 8 * (i >> 2) + 4 * n + (i & 3); }

struct Unit { int pm, pn; };
struct Gemm { const bf16_t* A; const bf16_t* Bt; int M, N, K; };

struct StaticOrder {
    int nM, nN, nwg, G, c;
    __host__ __device__ void init(int M, int N, int G_, int c_) { nM = M / BM; nN = N / BM; nwg = nM * nN; G = G_; c = c_; }
    __host__ __device__ bool next(int i, Unit& u) const {
        const long L = (long)i * G + c; if (L >= nwg) return false;
        int wgid = (int)L; { const int q = nwg / NXCD, r = nwg % NXCD, xcd = wgid % NXCD, off = wgid / NXCD; wgid = (xcd < r ? xcd * (q + 1) : r * (q + 1) + (xcd - r) * q) + off; }
        const int nig = WGM * nN, gid = wgid / nig, fm = gid * WGM, gsz = (nM - fm) < WGM ? (nM - fm) : WGM;
        u.pm = fm + ((wgid % nig) % gsz); u.pn = (wgid % nig) / gsz; return true;
    }
    __device__ __forceinline__ void a_ready(const Unit&) const {}
    __device__ __forceinline__ void done(const Unit&) const {}
};
typedef __bf16 pg8_bf16x2 __attribute__((ext_vector_type(2)));
__device__ __forceinline__ unsigned cvt_pk_bf16(float lo, float hi) { const pg8_bf16x2 v = {(__bf16)lo, (__bf16)hi}; return __builtin_bit_cast(unsigned, v); }
typedef float f32x2 __attribute__((ext_vector_type(2)));
__device__ __forceinline__ f32x2 gelu_pk(f32x2 v) {
    const f32x2 av = __builtin_elementwise_abs(v), d = av * 0.2316418882f + 1.0f;
    f32x2 t; t.x = __builtin_amdgcn_rcpf(d.x); t.y = __builtin_amdgcn_rcpf(d.y);
    f32x2 q = t * 0.5307027145f + (-0.7265760135f); q = q * t + 0.7107068705f; q = q * t + (-0.142248368f); q = q * t + 0.127414796f; q = q * t;
    const f32x2 s = (v * v) * (-0.72134752044f);
    f32x2 e; e.x = __builtin_amdgcn_exp2f(s.x); e.y = __builtin_amdgcn_exp2f(s.y);
    const f32x2 m = v * (q * e), r = v - m;
    f32x2 o; o.x = v.x < 0.f ? m.x : r.x; o.y = v.y < 0.f ? m.y : r.y; return o;
}

struct EpiF32 {
    static constexpr bool PERM = false, AFTER_DRAIN = false;
    float* C; int ldc; const float* bias;
    __device__ __forceinline__ void operator()(const f32x4 (&acc)[2][2][4][2], const Unit& u, int wr, int wc, int fr, int fq) const {
        const int row0 = u.pm * BM + wr * 64 + fr, col0 = u.pn * BM + wc * 32 + 4 * fq;
        f32x4 bv[2][2];
#pragma unroll
        for (int bj = 0; bj < 2; ++bj)
#pragma unroll
            for (int n = 0; n < 2; ++n) bv[bj][n] = bias ? *(const f32x4*)(bias + col0 + bj * HALF + n * 16) : (f32x4){0.f, 0.f, 0.f, 0.f};
#pragma unroll
        for (int ai = 0; ai < 2; ++ai)
#pragma unroll
            for (int m = 0; m < 4; ++m) { float* rowp = C + (size_t)(row0 + ai * HALF + m * 16) * ldc + col0;
#pragma unroll
                for (int bj = 0; bj < 2; ++bj)
#pragma unroll
                    for (int n = 0; n < 2; ++n) *(f32x4*)(rowp + bj * HALF + n * 16) = acc[ai][bj][m][n] + bv[bj][n]; }
    }
};
template <int ACT  > struct EpiBf16 {
    static constexpr bool PERM = true, AFTER_DRAIN = false;
    bf16_t* O; int ldc; const float* bias; int split_cols; size_t split_stride;
    __device__ __forceinline__ void operator()(const f32x4 (&acc)[2][2][4][2], const Unit& u, int wr, int wc, int fr, int fq) const {
        const int row0 = u.pm * BM + wr * 64 + fr; int colt = u.pn * BM; bf16_t* base = O;
        if (split_cols) { const int t = colt / split_cols; base += (size_t)t * split_stride; colt -= t * split_cols; }
        const int col0 = colt + wc * 32 + 8 * fq, bcol0 = u.pn * BM + wc * 32 + 8 * fq;
        f32x4 bv[2][2];
#pragma unroll
        for (int bj = 0; bj < 2; ++bj)
#pragma unroll
            for (int n = 0; n < 2; ++n) bv[bj][n] = bias ? *(const f32x4*)(bias + bcol0 + bj * HALF + 4 * n) : (f32x4){0.f, 0.f, 0.f, 0.f};
#pragma unroll
        for (int ai = 0; ai < 2; ++ai)
#pragma unroll
            for (int m = 0; m < 4; ++m) { bf16_t* rowp = base + (size_t)(row0 + ai * HALF + m * 16) * ldc + col0;
#pragma unroll
                for (int bj = 0; bj < 2; ++bj) { f32x4 v0 = acc[ai][bj][m][0] + bv[bj][0], v1 = acc[ai][bj][m][1] + bv[bj][1];
                    if (ACT == 1) { f32x2 a = gelu_pk((f32x2){v0[0], v0[1]}), b = gelu_pk((f32x2){v0[2], v0[3]}), c = gelu_pk((f32x2){v1[0], v1[1]}), d = gelu_pk((f32x2){v1[2], v1[3]});
                        v0 = (f32x4){a.x, a.y, b.x, b.y}; v1 = (f32x4){c.x, c.y, d.x, d.y}; }
                    if (ACT == 2) {
#pragma unroll
                        for (int j = 0; j < 4; ++j) { v0[j] = 0.5f * v0[j] * (1.0f + erff(v0[j] * 0.70710678f)); v1[j] = 0.5f * v1[j] * (1.0f + erff(v1[j] * 0.70710678f)); } }
                    u32x4 w; w.x = cvt_pk_bf16(v0[0], v0[1]); w.y = cvt_pk_bf16(v0[2], v0[3]); w.z = cvt_pk_bf16(v1[0], v1[1]); w.w = cvt_pk_bf16(v1[2], v1[3]);
                    *(u32x4*)(rowp + bj * HALF) = w; } }
    }
};

typedef int i32x8 __attribute__((ext_vector_type(8)));
typedef short s16x16 __attribute__((ext_vector_type(16)));
__device__ __forceinline__ i32x8 pg8_cat16(bf16x8 a, bf16x8 b) { return __builtin_bit_cast(i32x8, (s16x16)__builtin_shufflevector(a, b, 0, 1, 2, 3, 4, 5, 6, 7, 8, 9, 10, 11, 12, 13, 14, 15)); }
template <class Epi, class Sched, bool STAMP = false, bool F8 = false, bool WIDE = false>
__device__ __forceinline__ void gemm_phase(PG8_LAS unsigned char* lds, const Gemm g, const Sched& S, const Epi& E, unsigned long long* stamps) {
    const int tid = mk_tid(), wid = __builtin_amdgcn_readfirstlane(tid >> 6), lane = tid & 63, wr = wid >> 2, wc = wid & 3, fr = lane & 15, fq = lane >> 4;
    const int K = g.K, nt = K / BK;
    int ts_lo = 0, ts_hi = 0, nts = 0; const unsigned long long rt_entry = STAMP ? (unsigned long long)wall_clock64() : 0ull;
#define PG8_STAMP() do { if (STAMP && wid == 0 && nts < 64) { const unsigned long long _c = (unsigned long long)clock64(); \
        ts_lo = (lane == nts) ? (int)(unsigned)_c : ts_lo; ts_hi = (lane == nts) ? (int)(unsigned)(_c >> 32) : ts_hi; ++nts; } } while (0)
    PG8_STAMP();
    unsigned voffA, voffB;
    { int R, C; stage_rc(tid * 16, R, C); const int Ri = Epi::PERM ? perm32(R & 31) : (R & 31); const int Rb = WIDE ? (((R >> 5) << 6) + Ri) : ((R & ~31) + Ri);
        voffA = (unsigned)(R * K + C) * 2u; voffB = (unsigned)(Rb * K + C) * 2u; }
    const size_t qstep = (size_t)64 * K * 2;
    const size_t qstepB = WIDE ? (size_t)128 * K * 2 : qstep;
    const size_t hstepB = WIDE ? (size_t)32 * K * 2 : (size_t)HALF * K * 2;
    const size_t kstep = (size_t)(BK * 2);
    const size_t hstep = (size_t)HALF * K * 2;
    const size_t tstep = 2 * hstep;
    const unsigned ldsw = (unsigned)wid * 1024u;
    const int aoff = lds_byte(wr * 64 + fr, fq * 8), boff = lds_byte(wc * 32 + fr, fq * 8);
#define PG8_SA(b, h) (((b) * 2 + (h)) * HTB)
#define PG8_SB(b, h) ((4 + (b) * 2 + (h)) * HTB)
#define PG8_STAGE(bufoff, gbase, voff) PG8_STAGEQ(bufoff, gbase, voff, qstep)
#define PG8_STAGEB(bufoff, gbase, voff) PG8_STAGEQ(bufoff, gbase, voff, qstepB)
#define PG8_STAGEQ(bufoff, gbase, voff, qs) do { const char* _g0 = (const char*)(gbase); const char* _g1 = _g0 + (qs); asm volatile("" : "+s"(_g0), "+s"(_g1));   \
        __builtin_amdgcn_global_load_lds((const unsigned*)(_g0 + (voff)), (PG8_LAS unsigned*)(lds + (bufoff) + ldsw), 16, 0, 0); \
        __builtin_amdgcn_global_load_lds((const unsigned*)(_g1 + (voff)), (PG8_LAS unsigned*)(lds + (bufoff) + ldsw + 8192), 16, 0, 0); } while (0)
#define PG8_LDA(dst, b, h) do { _Pragma("unroll") for (int m = 0; m < 4; ++m) _Pragma("unroll") for (int k = 0; k < 2; ++k) dst[m][k] = *(const PG8_LAS bf16x8*)(lds + PG8_SA(b, h) + aoff + m * 2048 + k * 1024); } while (0)
#define PG8_LDB(dst, b, h) do { _Pragma("unroll") for (int n = 0; n < 2; ++n) _Pragma("unroll") for (int k = 0; k < 2; ++k) dst[n][k] = *(const PG8_LAS bf16x8*)(lds + PG8_SB(b, h) + boff + n * 2048 + k * 1024); } while (0)
#define PG8_MMA(ai, bj, At, Bt) do { __builtin_amdgcn_s_setprio(1); _Pragma("unroll") for (int m = 0; m < 4; ++m) _Pragma("unroll") for (int n = 0; n < 2; ++n) { \
        if constexpr (F8) acc[ai][bj][m][n] = __builtin_amdgcn_mfma_scale_f32_16x16x128_f8f6f4(pg8_cat16(Bt[n][0], Bt[n][1]), pg8_cat16(At[m][0], At[m][1]), acc[ai][bj][m][n], 0, 0, 0, 0, 0, 0); \
        else { _Pragma("unroll") for (int k = 0; k < 2; ++k) acc[ai][bj][m][n] = __builtin_amdgcn_mfma_f32_16x16x32_bf16(Bt[n][k], At[m][k], acc[ai][bj][m][n], 0, 0, 0); } } \
        __builtin_amdgcn_s_setprio(0); } while (0)
#define PG8_WAIT_V(n) asm volatile("s_waitcnt vmcnt(" #n ")" ::: "memory")
#define PG8_WAIT_L(n) asm volatile("s_waitcnt lgkmcnt(" #n ")" ::: "memory")
#define PG8_BAR __builtin_amdgcn_s_barrier()
#define PG8_SCHED __builtin_amdgcn_sched_barrier(0)
    Unit cur, nxt; int ui = 0;
    if (!S.next(0, cur)) return;
    f32x4 acc[2][2][4][2];
    bf16x8 At[4][2], B0[2][2], B1[2][2];
    const char* cA = (const char*)g.A + (size_t)cur.pm * tstep; const char* cB = (const char*)g.Bt + (size_t)cur.pn * tstep;
    S.a_ready(cur);
    PG8_STAGEB(PG8_SB(0, 0), cB, voffB); PG8_STAGE(PG8_SA(0, 0), cA, voffA); PG8_STAGEB(PG8_SB(0, 1), cB + hstepB, voffB); PG8_STAGE(PG8_SA(0, 1), cA + hstep, voffA);
    if (wr == 1) PG8_BAR;
    PG8_WAIT_V(4); PG8_BAR;
    PG8_STAGEB(PG8_SB(1, 0), cB + kstep, voffB); PG8_STAGE(PG8_SA(1, 0), cA + kstep, voffA); PG8_STAGEB(PG8_SB(1, 1), cB + hstepB + kstep, voffB);
    PG8_WAIT_V(6); PG8_BAR;
    PG8_STAMP();
#pragma unroll
    for (int a = 0; a < 2; ++a)
#pragma unroll
        for (int b = 0; b < 2; ++b)
#pragma unroll
            for (int m = 0; m < 4; ++m)
#pragma unroll
                for (int n = 0; n < 2; ++n) acc[a][b][m][n] = (f32x4){0.f, 0.f, 0.f, 0.f};
    for (;;) {
        const bool has_next = S.next(ui + 1, nxt);
        const char* nA = has_next ? (const char*)g.A + (size_t)nxt.pm * tstep : cA; const char* nB = has_next ? (const char*)g.Bt + (size_t)nxt.pn * tstep : cB;
        for (int t = 0; t < nt; t += 2) {
            const bool last = (t == nt - 2);
            const char* a1 = cA + (size_t)(t + 1) * kstep;
            const char* a2 = last ? nA : cA + (size_t)(t + 2) * kstep; const char* b2 = last ? nB : cB + (size_t)(t + 2) * kstep;
            const char* a3 = a2 + kstep; const char* b3 = b2 + kstep;
            if (last && has_next) S.a_ready(nxt);
            PG8_LDB(B0, 0, 0); PG8_SCHED; PG8_LDA(At, 0, 0); PG8_STAGE(PG8_SA(1, 1), a1 + hstep, voffA);
            PG8_WAIT_L(8); PG8_BAR; PG8_WAIT_L(0); PG8_MMA(0, 0, At, B0); PG8_BAR; PG8_SCHED;
            PG8_LDB(B1, 0, 1); PG8_STAGEB(PG8_SB(0, 0), b2, voffB);
            PG8_BAR; PG8_WAIT_L(0); PG8_MMA(0, 1, At, B1); PG8_BAR;
            PG8_LDA(At, 0, 1); PG8_STAGE(PG8_SA(0, 0), a2, voffA);
            PG8_BAR; PG8_WAIT_L(0); PG8_MMA(1, 0, At, B0); PG8_BAR; PG8_SCHED;
            PG8_STAGEB(PG8_SB(0, 1), b2 + hstepB, voffB);
            PG8_WAIT_V(6); PG8_BAR; PG8_MMA(1, 1, At, B1); PG8_BAR;
            PG8_LDB(B0, 1, 0); PG8_SCHED; PG8_LDA(At, 1, 0); PG8_STAGE(PG8_SA(0, 1), a2 + hstep, voffA);
            PG8_WAIT_L(8); PG8_BAR; PG8_WAIT_L(0); PG8_MMA(0, 0, At, B0); PG8_BAR; PG8_SCHED;
            PG8_LDB(B1, 1, 1); PG8_STAGEB(PG8_SB(1, 0), b3, voffB);
            PG8_BAR; PG8_WAIT_L(0); PG8_MMA(0, 1, At, B1); PG8_BAR;
            PG8_LDA(At, 1, 1); PG8_STAGE(PG8_SA(1, 0), a3, voffA);
            PG8_BAR; PG8_WAIT_L(0); PG8_MMA(1, 0, At, B0); PG8_BAR; PG8_SCHED;
            PG8_STAGEB(PG8_SB(1, 1), b3 + hstepB, voffB);
            PG8_WAIT_V(6); PG8_BAR; PG8_MMA(1, 1, At, B1); PG8_BAR;
        }
        PG8_STAMP();
        if constexpr (!Epi::AFTER_DRAIN) { E(acc, cur, wr, wc, fr, fq); S.done(cur); }
        PG8_STAMP();
        if (!has_next) break;
#pragma unroll
        for (int a = 0; a < 2; ++a)
#pragma unroll
            for (int b = 0; b < 2; ++b)
#pragma unroll
                for (int m = 0; m < 4; ++m)
#pragma unroll
                    for (int n = 0; n < 2; ++n) acc[a][b][m][n] = (f32x4){0.f, 0.f, 0.f, 0.f};
        cur = nxt; cA = nA; cB = nB; ++ui;
    }
    PG8_WAIT_V(0);
    if (wr == 0) PG8_BAR;
    PG8_BAR;
    if constexpr (Epi::AFTER_DRAIN) { E.fused(acc, cur, wr, wc, fr, fq, lds, wid, lane); S.done(cur); }
    PG8_STAMP();
    if (STAMP && wid == 0) { stamps[lane] = lane < nts ? (((unsigned long long)(unsigned)ts_hi << 32) | (unsigned)ts_lo) : 0ull;
        if (lane == 62) stamps[62] = rt_entry; if (lane == 63) stamps[63] = (unsigned long long)wall_clock64(); }
#undef PG8_STAMP
#undef PG8_SA
#undef PG8_SB
#undef PG8_STAGE
#undef PG8_STAGEB
#undef PG8_STAGEQ
#undef PG8_LDA
#undef PG8_LDB
#undef PG8_MMA
#undef PG8_WAIT_V
#undef PG8_WAIT_L
#undef PG8_BAR
#undef PG8_SCHED
}
}
#define XB_TMO      128
#define XB_XCNT(j)  (256  + 64 * (j))
#define XB_XSUB(j)  (1280 + 64 * (j))
#define XB_XGEN(j)  (2304 + 64 * (j))
#define XB_TOP      3328
#define XB_TOPGEN   3392
#define XCD_BAR_WORDS 3456
#define XB_SPIN_CAP (1u << 18)
#define LAS __attribute__((address_space(3)))

__device__ __forceinline__ unsigned xb_ld(unsigned* p)              { return __hip_atomic_load(p, __ATOMIC_RELAXED, __HIP_MEMORY_SCOPE_AGENT); }
__device__ __forceinline__ unsigned xb_add(unsigned* p, unsigned v) { return __hip_atomic_fetch_add(p, v, __ATOMIC_RELAXED, __HIP_MEMORY_SCOPE_AGENT); }
__device__ __forceinline__ unsigned xb_xcc_id() { return (unsigned)__builtin_amdgcn_s_getreg((3 << 11) | 20) & 0xFu; }
#define XB_SPIN(cond, bar) do { unsigned _sp = 0; while (cond) { __builtin_amdgcn_s_sleep(1); \
    if ((++_sp & 255u) == 0u) { if (xb_ld(&(bar)[XB_TMO])) break; if (_sp > XB_SPIN_CAP) { atomicAdd(&(bar)[XB_TMO], 1u); break; } } } } while (0)

struct XcdBarrier {
    unsigned* bar; unsigned x;
    volatile LAS unsigned* st;
};

__device__ __forceinline__ XcdBarrier xcd_barrier_post(unsigned* bar, volatile LAS unsigned* st) {
    XcdBarrier b; b.bar = bar; b.x = xb_xcc_id(); b.st = st;
    if (threadIdx.x == 0) (void)xb_add(&bar[XB_XCNT(b.x)], 1u);
    return b;
}
__device__ __forceinline__ void xcd_barrier_complete(unsigned* bar, unsigned x, unsigned& nloc, unsigned& nx) {
    const unsigned G = gridDim.x * gridDim.y * gridDim.z;
    unsigned sum, cnt, mine, sp = 0u;
    for (;;) {
        sum = 0u; cnt = 0u; mine = 0u;
#pragma unroll
        for (unsigned j = 0; j < 16; ++j) { const unsigned c = xb_ld(&bar[XB_XCNT(j)]); sum += c; cnt += (c > 0u) ? 1u : 0u; mine = (j == x) ? c : mine; }
        if (sum == G) break;
        __builtin_amdgcn_s_sleep(1);
        if ((++sp & 255u) == 0u) { if (xb_ld(&bar[XB_TMO])) break; if (sp > XB_SPIN_CAP) { atomicAdd(&bar[XB_TMO], 1u); break; } }
    }
    nloc = mine > 0u ? mine : 1u; nx = cnt > 0u ? cnt : 1u;
}

__device__ __forceinline__ void xcd_barrier(const XcdBarrier& b) {
    asm volatile("s_waitcnt vmcnt(0)" ::: "memory");
    __syncthreads();
    if (threadIdx.x == 0) {
        unsigned* bar = b.bar;
        __builtin_amdgcn_s_waitcnt(0);
        unsigned nloc = b.st[0], nx = b.st[1];
        if (nloc == 0u) { xcd_barrier_complete(bar, b.x, nloc, nx); b.st[0] = nloc; b.st[1] = nx; }
        const unsigned old = xb_add(&bar[XB_XSUB(b.x)], 1u);
        const unsigned gen = old / nloc;
        if (old + 1u == (gen + 1u) * nloc) {
            __builtin_amdgcn_fence(__ATOMIC_RELEASE, "agent");
            asm volatile("s_waitcnt vmcnt(0)" ::: "memory");
            const unsigned og = xb_add(&bar[XB_TOP], 1u);
            const unsigned tg = og / nx;
            if (og + 1u == (tg + 1u) * nx) xb_add(&bar[XB_TOPGEN], 1u);
            else XB_SPIN(xb_ld(&bar[XB_TOPGEN]) == tg, bar);
            __builtin_amdgcn_fence(__ATOMIC_ACQUIRE, "agent");
            xb_add(&bar[XB_XGEN(b.x)], 1u);
            asm volatile("s_waitcnt vmcnt(0)" ::: "memory");
        } else {
            XB_SPIN(xb_ld(&bar[XB_XGEN(b.x)]) == gen, bar);
            __builtin_amdgcn_fence(__ATOMIC_ACQUIRE, "agent");
            asm volatile("s_waitcnt vmcnt(0)" ::: "memory");
        }
    }
    __syncthreads();
}

namespace mk {
using pg8::bf16_t; using pg8::bf16x8; using pg8::f32x4; using pg8::u32x4;
typedef short s16x4 __attribute__((ext_vector_type(4)));
typedef unsigned u32x2 __attribute__((ext_vector_type(2)));
typedef __bf16 bf16x2v __attribute__((ext_vector_type(2)));
typedef int i32x4 __attribute__((ext_vector_type(4)));
#define DI __device__ __forceinline__

constexpr int D = 1024, SEQ = 4096, NTOK = 16384, DEPTH = 4, DIN = 13824;
constexpr int OFF_AQ = 0, OFF_AK = 1536, OFF_AV = 3072, OFF_LX = 4608, OFF_LG = 5632, OFF_RQ = 6656, OFF_RK = 7680, OFF_RV = 8704, OFF_RG = 9728, OFF_GA = 10752;
constexpr float ALPHA = 1.681792830507429f;
constexpr float LN_EPS = 1e-5f;
constexpr float X8_SCALE = 32.0f, W8_SCALE = 2048.0f, F8_MAX = 440.0f;
constexpr int NPH = 12;
constexpr int LDS_BYTES = 148 * 1024;
constexpr int LDS_BAR_OFF = LDS_BYTES - 16;

constexpr size_t WS_CTL  = 0;
constexpr size_t WS_COSA = 16384;
constexpr size_t WS_SINA = WS_COSA + (size_t)4096 * 64 * 4;
constexpr size_t WS_COSR = WS_SINA + (size_t)4096 * 64 * 4;
constexpr size_t WS_SINR = WS_COSR + (size_t)4096 * 128 * 4;
constexpr size_t WS_CCH  = WS_SINR + (size_t)4096 * 128 * 4;
constexpr size_t WS_WAT  = WS_CCH + 4096;
constexpr size_t WS_WXT  = WS_WAT + 131072;
constexpr size_t WS_LSTA = WS_WXT + 131072;
constexpr size_t WS_LSTH = WS_LSTA + 524288;
constexpr size_t WS_K1B  = WS_LSTH + 524288;
constexpr size_t WS_K2B  = WS_K1B + 262144;
constexpr size_t WS_XF   = WS_K2B + 262144;
constexpr size_t WS_XB   = WS_XF + (size_t)NTOK * D * 4;
constexpr size_t WS_WINT = WS_XB + (size_t)NTOK * D * 2;
constexpr size_t WS_WSC  = WS_WINT + (size_t)DIN * 1024;
constexpr size_t WS_X8   = WS_WSC + (size_t)DIN * 4 + 256 - ((size_t)DIN * 4) % 256;
constexpr size_t WS_XS   = WS_X8 + (size_t)NTOK * 1024;
constexpr size_t WS_WBAT = WS_XS + (size_t)NTOK * 4;
constexpr size_t WS_WBBT = WS_WBAT + (size_t)1024 * 512 * 2;
constexpr size_t WS_WBCT = WS_WBBT + (size_t)1024 * 1024 * 2;
constexpr size_t WS_WOT  = WS_WBCT + (size_t)1024 * 1024 * 2;
constexpr size_t WS_WQT  = WS_WOT + (size_t)1024 * 1024 * 2;
constexpr size_t WS_UV8  = WS_WQT + (size_t)2048 * 1024 * 2;
constexpr size_t WS_UVS  = WS_UV8 + (size_t)16384 * 2048;
constexpr size_t WS_PROJ = WS_UVS + (size_t)16384 * 8;
constexpr size_t WS_OATT = WS_PROJ + (size_t)NTOK * DIN * 2;
constexpr size_t WS_LSE  = WS_OATT + (size_t)NTOK * 1536 * 2;
constexpr size_t WS_KVB  = WS_LSE + (size_t)NTOK * 12 * 4;
constexpr size_t WS_YA   = WS_KVB + (size_t)16 * 32 * 65536 * 2;
constexpr size_t WS_YB   = WS_YA + (size_t)NTOK * 512 * 2;
constexpr size_t WS_YC   = WS_YB + (size_t)NTOK * 1024 * 2;
constexpr size_t WS_MRGF = WS_YC + (size_t)NTOK * 1024 * 2;
constexpr size_t WS_MRGB = WS_MRGF + (size_t)NTOK * 1024 * 4;
constexpr size_t WS_END  = WS_MRGB + (size_t)NTOK * 1024 * 2;
constexpr size_t WS_Q    = WS_PROJ;
constexpr size_t WS_EID  = WS_PROJ + (size_t)NTOK * 2048 * 2;
constexpr size_t WS_GATE = WS_EID + (size_t)NTOK * 128 * 4;
static_assert(WS_END <= (size_t)1073741824, "workspace too large");
static_assert(WS_PROJ % 256 == 0 && WS_KVB % 256 == 0 && WS_MRGF % 256 == 0, "alignment");

struct Args { const float* in[20]; float* out; unsigned char* ws; double ropeA, ropeR; int ph_lo, ph_hi; };

DI float bflo(unsigned w) { return __uint_as_float(w << 16); }
DI float bfhi(unsigned w) { return __uint_as_float(w & 0xffff0000u); }
DI float bf2f(bf16_t v) { return __uint_as_float(((unsigned)v) << 16); }
DI unsigned pk2(float lo, float hi) { return pg8::cvt_pk_bf16(lo, hi); }
DI bf16_t f2bf(float f) { return (bf16_t)(pk2(f, 0.f) & 0xffffu); }
DI f32x4 mfma16(bf16x8 a, bf16x8 b, f32x4 c) { return __builtin_amdgcn_mfma_f32_16x16x32_bf16(a, b, c, 0, 0, 0); }
DI s16x4 trrd(LAS unsigned char* p) { return __builtin_amdgcn_ds_read_tr16_b64_v4i16((LAS s16x4*)p); }
DI bf16x8 cat8(s16x4 lo, s16x4 hi) { return __builtin_shufflevector(lo, hi, 0, 1, 2, 3, 4, 5, 6, 7); }
DI float wsum(float v) { v += __shfl_xor(v, 32); v += __shfl_xor(v, 16); v += __shfl_xor(v, 8); v += __shfl_xor(v, 4); v += __shfl_xor(v, 2); v += __shfl_xor(v, 1); return v; }
DI float sigm(float x) { return __builtin_amdgcn_rcpf(1.f + __builtin_amdgcn_exp2f(x * -1.4426950408889634f)); }
DI float gelu_erf(float x) { return 0.5f * x * (1.f + erff(x * 0.70710678118654752f)); }
DI float dot2(unsigned w, unsigned x, float acc) { return __builtin_amdgcn_fdot2_f32_bf16(__builtin_bit_cast(bf16x2v, w), __builtin_bit_cast(bf16x2v, x), acc, false); }
DI float log2gamma(int h) { return log2f(1.0f - exp2f(-5.0f - (float)h)); }

#define MK_DPP_ADD(v, ctrl, rmask) v += __int_as_float(__builtin_amdgcn_update_dpp(0, __float_as_int(v), (ctrl), (rmask), 0xf, false))
DI float wsum_dpp(float v) {
    MK_DPP_ADD(v, 0xB1, 0xf); MK_DPP_ADD(v, 0x4E, 0xf); MK_DPP_ADD(v, 0x141, 0xf); MK_DPP_ADD(v, 0x140, 0xf);
    MK_DPP_ADD(v, 0x142, 0xa); MK_DPP_ADD(v, 0x143, 0xc);
    return __int_as_float(__builtin_amdgcn_readlane(__float_as_int(v), 63));
}
DI float gelu_as(float v) {
    const float av = fabsf(v), t = __builtin_amdgcn_rcpf(av * 0.2316418882f + 1.0f);
    float q = t * 0.5307027145f + (-0.7265760135f); q = q * t + 0.7107068705f; q = q * t + (-0.142248368f); q = q * t + 0.127414796f; q = q * t;
    const float e = __builtin_amdgcn_exp2f(v * v * (-0.72134752044f));
    const float m = v * (q * e);
    return v < 0.f ? m : v - m;
}
DI int wperm(int n) {
    if (n < 3072) { const int j = n & 127, jj = j & 63; return (n & ~127) + 8 * (jj >> 2) + (jj & 3) + ((j >= 64) ? 4 : 0); }
    if (n >= OFF_RQ && n < OFF_RV) { const int j = n & 255, jj = j & 127; return (n & ~255) + 8 * (jj >> 2) + (jj & 3) + ((j >= 128) ? 4 : 0); }
    return n;
}

template <bool WPERM>
DI void tconv_tile(const float* src, int ldsrc, bf16_t* dst, int lddst, int k0, int n0, LAS float* t, float mul = 1.0f) {
    const int tid = mk_tid();
#pragma unroll
    for (int i = 0; i < 8; ++i) { const int idx = tid + 512 * i, r = idx >> 6, c = idx & 63; t[r * 65 + c] = src[(size_t)(k0 + r) * ldsrc + n0 + c]; }
    __syncthreads();
#pragma unroll
    for (int i = 0; i < 8; ++i) { const int idx = tid + 512 * i, n = idx >> 6, k = idx & 63; const int nr = WPERM ? wperm(n0 + n) : (n0 + n); dst[(size_t)nr * lddst + k0 + k] = f2bf(t[k * 65 + n] * mul); }
    __syncthreads();
}
DI void conv_unit(const float* src, bf16_t* dst, int unit) {
    const size_t i = (size_t)unit * 4096 + (size_t)mk_tid() * 8;
    const f32x4 a = *(const f32x4*)(src + i), b = *(const f32x4*)(src + i + 4);
    u32x4 o; o.x = pk2(a[0], a[1]); o.y = pk2(a[2], a[3]); o.z = pk2(b[0], b[1]); o.w = pk2(b[2], b[3]);
    *(u32x4*)(dst + i) = o;
}
DI void w8_unit(const float* src, unsigned char* ws, int unit, LAS float* t) {
    const int tid = mk_tid(), n0 = unit * 64;
    unsigned char* dst = ws + WS_WINT;
#pragma unroll 1
    for (int k0 = 0; k0 < 1024; k0 += 64) {
#pragma unroll
        for (int i = 0; i < 8; ++i) { const int idx = tid + 512 * i, r = idx >> 6, cc = idx & 63; t[r * 65 + cc] = fminf(fmaxf(src[(size_t)(k0 + r) * DIN + n0 + cc] * W8_SCALE, -F8_MAX), F8_MAX); }
        __syncthreads();
#pragma unroll
        for (int i = 0; i < 2; ++i) { const int idx = tid + 512 * i, n = idx >> 4, k4 = idx & 15;
            int wd = __builtin_amdgcn_cvt_pk_fp8_f32(t[(4 * k4) * 65 + n], t[(4 * k4 + 1) * 65 + n], 0, false);
            wd = __builtin_amdgcn_cvt_pk_fp8_f32(t[(4 * k4 + 2) * 65 + n], t[(4 * k4 + 3) * 65 + n], wd, true);
            *(int*)(dst + (size_t)wperm(n0 + n) * 1024 + k0 + 4 * k4) = wd; }
        __syncthreads();
    }
}
DI void row_to_fp8(const f32x4 (&o)[4], unsigned char* x8row, int ln) {
    u32x4 w;
#pragma unroll
    for (int q = 0; q < 4; ++q) {
        const float a0 = fminf(fmaxf(o[q][0] * X8_SCALE, -F8_MAX), F8_MAX), a1 = fminf(fmaxf(o[q][1] * X8_SCALE, -F8_MAX), F8_MAX), a2 = fminf(fmaxf(o[q][2] * X8_SCALE, -F8_MAX), F8_MAX), a3 = fminf(fmaxf(o[q][3] * X8_SCALE, -F8_MAX), F8_MAX);
        int wd = __builtin_amdgcn_cvt_pk_fp8_f32(a0, a1, 0, false); wd = __builtin_amdgcn_cvt_pk_fp8_f32(a2, a3, wd, true); w[q] = (unsigned)wd; }
    *(u32x4*)(x8row + 16 * ln) = w;
}
typedef float f32x16 __attribute__((ext_vector_type(16)));
typedef float f32x32 __attribute__((ext_vector_type(32)));
typedef unsigned u32x6 __attribute__((ext_vector_type(6)));
typedef _Float16 f16x32 __attribute__((ext_vector_type(32)));
DI float wmax(float m) { m = fmaxf(m, __shfl_xor(m, 32)); m = fmaxf(m, __shfl_xor(m, 16)); m = fmaxf(m, __shfl_xor(m, 8)); m = fmaxf(m, __shfl_xor(m, 4)); m = fmaxf(m, __shfl_xor(m, 2)); m = fmaxf(m, __shfl_xor(m, 1)); return m; }
DI void conv_fp6_rows(const float* usrc, const float* vsrc, unsigned char* ws, int unit) {
    const int tid = mk_tid(), lane = tid & 63, w = tid >> 6;
    const size_t row = (size_t)unit * 8 + w;
    const float* up = usrc + row * 1024 + 16 * lane; const float* vp = vsrc + row * 1024 + 16 * lane;
    f32x16 a, b; float mu = 0.f, mv = 0.f;
#pragma unroll
    for (int q = 0; q < 4; ++q) { const f32x4 x = *(const f32x4*)(up + 4 * q), y = *(const f32x4*)(vp + 4 * q);
#pragma unroll
        for (int j = 0; j < 4; ++j) { a[4 * q + j] = x[j]; b[4 * q + j] = y[j]; mu = fmaxf(mu, fabsf(x[j])); mv = fmaxf(mv, fabsf(y[j])); } }
    mu = wmax(mu); mv = wmax(mv);
    const float su = (mu > 0.f) ? 7.0f / mu : 1.0f, sv = (mv > 0.f) ? 7.0f / mv : 1.0f;
    f16x32 h;
#pragma unroll
    for (int i = 0; i < 16; ++i) { h[i] = (_Float16)(a[i] * su); h[16 + i] = (_Float16)(b[i] * sv); }
    const u32x6 p = __builtin_amdgcn_cvt_scalef32_pk32_fp6_f16(h, 1.0f);
    unsigned char* rec = ws + WS_UV8 + row * 1536;
    *(u32x4*)(rec + 16 * lane) = (u32x4){p[0], p[1], p[2], p[3]};
    *(u32x2*)(rec + 1024 + 8 * lane) = (u32x2){p[4], p[5]};
    if (lane == 0) { float* sp = (float*)(ws + WS_UVS) + row * 2; sp[0] = (mu > 0.f) ? mu * (1.0f / 7.0f) : 1.0f; sp[1] = (mv > 0.f) ? mv * (1.0f / 7.0f) : 1.0f; }
}
DI void phase_conv(const Args& a, int layer, LAS unsigned char* lds) {
    unsigned char* ws = a.ws;
    LAS float* t = (LAS float*)lds;
    const int J0 = 216, J1 = J0 + 128, J2 = J1 + 256, J3 = J2 + 256, J4 = J3 + 256, J5 = J4 + 512, J6 = J5 + 32, J7 = J6 + 2048, J8 = J7, J9 = J8 + 64, J10 = J9 + 1;
    const int total = J10;
    for (int u = blockIdx.x; u < total; u += gridDim.x) {
        if (u < J0) { w8_unit(a.in[1] + (size_t)layer * 1024 * DIN, ws, u, t); }
        else if (u < J1) { const int v = u - J0, kt = v / 16, nt = v % 16; tconv_tile<false>(a.in[9] + (size_t)layer * 2560 * 1024, 1024, (bf16_t*)(ws + WS_WBAT), 512, kt * 64, nt * 64, t); }
        else if (u < J2) { const int v = u - J1, kt = v / 16, nt = v % 16; tconv_tile<false>(a.in[9] + (size_t)layer * 2560 * 1024 + (size_t)512 * 1024, 1024, (bf16_t*)(ws + WS_WBBT), 1024, kt * 64, nt * 64, t); }
        else if (u < J3) { const int v = u - J2, kt = v / 16, nt = v % 16; tconv_tile<false>(a.in[9] + (size_t)layer * 2560 * 1024 + (size_t)1536 * 1024, 1024, (bf16_t*)(ws + WS_WBCT), 1024, kt * 64, nt * 64, t); }
        else if (u < J4) { const int v = u - J3, kt = v / 16, nt = v % 16; tconv_tile<false>(a.in[10] + (size_t)layer * 1024 * 1024, 1024, (bf16_t*)(ws + WS_WOT), 1024, kt * 64, nt * 64, t); }
        else if (u < J5) { const int v = u - J4, kt = v / 32, nt = v % 32; tconv_tile<false>(a.in[13] + (size_t)layer * 1024 * 2048, 2048, (bf16_t*)(ws + WS_WQT), 1024, kt * 64, nt * 64, t); }
        else if (u < J6) { const int v = u - J5, blk = v & 15, which = v >> 4;
            tconv_tile<false>(a.in[which ? 6 : 4] + ((size_t)layer * 16 + blk) * 4096, 64, (bf16_t*)(ws + (which ? WS_WXT : WS_WAT)) + blk * 4096, 64, 0, 0, t, -1.4426950408889634f); }
        else if (u < J7) { conv_fp6_rows(a.in[16] + (size_t)layer * 16384 * 1024, a.in[17] + (size_t)layer * 16384 * 1024, ws, u - J6); }
        else if (u < J9) { const int v = u - J8; if (v < 32) conv_unit(a.in[14] + (size_t)layer * 131072, (bf16_t*)(ws + WS_K1B), v); else conv_unit(a.in[15] + (size_t)layer * 131072, (bf16_t*)(ws + WS_K2B), v - 32); }
        else { for (int c = mk_tid(); c < 1024; c += 512) { const float lam = a.in[8][layer * 1024 + c]; const float e = __builtin_amdgcn_exp2f(-lam * 1.4426950408889634f); const float sp = (e < 0.05f) ? e * (1.0f + e * (-0.5f + e * (0.33333333f + e * -0.25f))) : __builtin_amdgcn_logf(1.0f + e) * 0.6931471805599453f; ((float*)(ws + WS_CCH))[c] = -8.0f * sp; } }
    }
}

DI void phase_prologue(const Args& a) {
    unsigned char* ws = a.ws;
    const int tid = mk_tid();
    for (int u = blockIdx.x; u < 2048; u += gridDim.x) {
        { const int ln = tid & 63; const size_t row = (size_t)u * 8 + (tid >> 6);
            const float* xp = a.in[0] + row * 1024 + 16 * ln; float* xo = (float*)(ws + WS_XF) + row * 1024 + 16 * ln;
            f32x4 o[4];
#pragma unroll
            for (int q = 0; q < 4; ++q) { o[q] = *(const f32x4*)(xp + 4 * q); *(f32x4*)(xo + 4 * q) = o[q]; }
            row_to_fp8(o, ws + WS_X8 + row * 1024, ln); }
    }
}

DI void attn_unit(const Args& a, int unit, LAS unsigned char* lds) {
    unsigned char* ws = a.ws;
    const int tid = mk_tid(), lane = tid & 63, w = __builtin_amdgcn_readfirstlane(tid >> 6), g = lane >> 4, l15 = lane & 15, tq4 = l15 >> 2, tp4 = l15 & 3;
    const int b = unit / 384, rem = unit % 384, h = rem >> 5, bi = rem & 31;
    const int grp = h >> 2, d = (grp == 0) ? 1 : ((grp == 1) ? 4 : 16), nb = 32 / d, r = bi / nb, n = bi % nb;
    const bf16_t* proj = (const bf16_t*)(ws + WS_PROJ) + (size_t)b * SEQ * DIN;
    LAS unsigned char* Ks = lds; LAS unsigned char* Vs = lds + 256 * 288;
#pragma unroll
    for (int i = 0; i < 8; ++i) {
        const int idx = tid + 512 * i, row = idx >> 4, ch = idx & 15, m = 128 * (n - 1) + row;
        u32x4 kv = {0u, 0u, 0u, 0u}, vv = {0u, 0u, 0u, 0u};
        if (m >= 0) { const bf16_t* p = proj + (size_t)(m * d + r) * DIN + h * 128 + ch * 8; kv = *(const u32x4*)(p + OFF_AK); vv = *(const u32x4*)(p + OFF_AV); }
        *(LAS u32x4*)(Ks + row * 288 + ch * 16) = kv; *(LAS u32x4*)(Vs + row * 288 + ch * 16) = vv;
    }
    const int qi = 16 * w + l15;
    const size_t tq = (size_t)(128 * n + qi) * d + r;
    bf16x8 qf[4];
#pragma unroll
    for (int ks = 0; ks < 4; ++ks) qf[ks] = *(const bf16x8*)(proj + tq * DIN + OFF_AQ + h * 128 + 32 * ks + 8 * g);
    __syncthreads();
    const int s0 = w >> 1;
    f32x4 sacc[10];
#pragma unroll
    for (int jj = 0; jj < 10; ++jj) {
        f32x4 acc = {0.f, 0.f, 0.f, 0.f};
#pragma unroll
        for (int ks = 0; ks < 4; ++ks) { const bf16x8 kf = *(const LAS bf16x8*)(Ks + (32 * s0 + 16 * jj + l15) * 288 + (32 * ks + 8 * g) * 2); acc = mfma16(kf, qf[ks], acc); }
        sacc[jj] = acc;
    }
    const float scale = 0.08838834764831845f * 1.4426950408889634f;
    float mx = -1e30f;
#pragma unroll
    for (int jj = 0; jj < 10; ++jj)
#pragma unroll
        for (int rg = 0; rg < 4; ++rg) {
            const int j = 32 * s0 + 16 * jj + 4 * g + rg;
            const bool valid = (j >= qi) && (j <= qi + 128) && (n > 0 || j >= 128);
            const float s = valid ? sacc[jj][rg] * scale : -1e30f;
            sacc[jj][rg] = s; mx = fmaxf(mx, s);
        }
    mx = fmaxf(mx, __shfl_xor(mx, 16)); mx = fmaxf(mx, __shfl_xor(mx, 32));
    float sum = 0.f;
#pragma unroll
    for (int jj = 0; jj < 10; ++jj)
#pragma unroll
        for (int rg = 0; rg < 4; ++rg) { const float p = __builtin_amdgcn_exp2f(sacc[jj][rg] - mx); sacc[jj][rg] = p; sum += p; }
    sum += __shfl_xor(sum, 16); sum += __shfl_xor(sum, 32);
    f32x4 oacc[8];
#pragma unroll
    for (int db = 0; db < 8; ++db) oacc[db] = (f32x4){0.f, 0.f, 0.f, 0.f};
#pragma unroll
    for (int s = 0; s < 5; ++s) {
        u32x4 pw; pw.x = pk2(sacc[2 * s][0], sacc[2 * s][1]); pw.y = pk2(sacc[2 * s][2], sacc[2 * s][3]); pw.z = pk2(sacc[2 * s + 1][0], sacc[2 * s + 1][1]); pw.w = pk2(sacc[2 * s + 1][2], sacc[2 * s + 1][3]);
        const bf16x8 pb = __builtin_bit_cast(bf16x8, pw);
        const int k0 = 32 * (s0 + s) + 4 * g + tq4;
#pragma unroll
        for (int db = 0; db < 8; ++db) {
            const s16x4 lo = trrd(Vs + k0 * 288 + (16 * db + 4 * tp4) * 2), hi = trrd(Vs + (k0 + 16) * 288 + (16 * db + 4 * tp4) * 2);
            oacc[db] = mfma16(cat8(lo, hi), pb, oacc[db]);
        }
    }
    const float inv = 1.0f / sum;
    bf16_t* op = (bf16_t*)(ws + WS_OATT) + ((size_t)b * SEQ + tq) * 1536 + h * 128 + 4 * g;
#pragma unroll
    for (int db = 0; db < 8; ++db) { u32x2 o; o.x = pk2(oacc[db][0] * inv, oacc[db][1] * inv); o.y = pk2(oacc[db][2] * inv, oacc[db][3] * inv); *(u32x2*)(op + 16 * db) = o; }
    if (g == 0) ((float*)(ws + WS_LSE))[((size_t)b * SEQ + tq) * 12 + h] = mx + __builtin_amdgcn_logf(sum);
    __syncthreads();
}

DI void retkv_unit(const Args& a, int unit, LAS unsigned char* lds) {
    unsigned char* ws = a.ws;
    const int tid = mk_tid(), lane = tid & 63, w = __builtin_amdgcn_readfirstlane(tid >> 6), g = lane >> 4, l15 = lane & 15, tq4 = l15 >> 2, tp4 = l15 & 3;
    const int b = unit >> 7, h = (unit >> 5) & 3, c = unit & 31;
    const bf16_t* proj = (const bf16_t*)(ws + WS_PROJ) + ((size_t)b * SEQ + c * 128) * DIN;
    LAS unsigned char* Ks = lds; LAS unsigned char* Vs = lds + 128 * 544;
    const float l2g = log2gamma(h);
#pragma unroll
    for (int i = 0; i < 8; ++i) {
        const int idx = tid + 512 * i, row = idx >> 5, ch = idx & 31;
        const bf16_t* p = proj + (size_t)row * DIN + h * 256 + ch * 8;
        const u32x4 kv = *(const u32x4*)(p + OFF_RK), vv = *(const u32x4*)(p + OFF_RV);
        const float z = exp2f((float)(127 - row) * l2g);
        u32x4 kz;
#pragma unroll
        for (int q = 0; q < 4; ++q) kz[q] = pk2(bflo(kv[q]) * z, bfhi(kv[q]) * z);
        *(LAS u32x4*)(Ks + row * 544 + ch * 16) = kz; *(LAS u32x4*)(Vs + row * 544 + ch * 16) = vv;
    }
    __syncthreads();
#pragma unroll 1
    for (int nh = 0; nh < 2; ++nh) {
        f32x4 acc[2][8];
#pragma unroll
        for (int mb = 0; mb < 2; ++mb)
#pragma unroll
            for (int nb = 0; nb < 8; ++nb) acc[mb][nb] = (f32x4){0.f, 0.f, 0.f, 0.f};
#pragma unroll
        for (int ks = 0; ks < 4; ++ks) {
            const int j0 = 32 * ks + 4 * g + tq4;
            bf16x8 af[2];
#pragma unroll
            for (int mb = 0; mb < 2; ++mb) { const int col = 32 * w + 16 * mb + 4 * tp4; af[mb] = cat8(trrd(Vs + j0 * 544 + col * 2), trrd(Vs + (j0 + 16) * 544 + col * 2)); }
#pragma unroll
            for (int nb = 0; nb < 8; ++nb) {
                const int col = 128 * nh + 16 * nb + 4 * tp4;
                const bf16x8 bfr = cat8(trrd(Ks + j0 * 544 + col * 2), trrd(Ks + (j0 + 16) * 544 + col * 2));
#pragma unroll
                for (int mb = 0; mb < 2; ++mb) acc[mb][nb] = mfma16(af[mb], bfr, acc[mb][nb]);
            }
        }
        bf16_t* kvb = (bf16_t*)(ws + WS_KVB) + ((size_t)((b * 4 + h) * 32 + c)) * 65536 + 128 * nh;
#pragma unroll
        for (int mb = 0; mb < 2; ++mb)
#pragma unroll
            for (int nb = 0; nb < 8; ++nb)
#pragma unroll
                for (int rg = 0; rg < 4; ++rg) kvb[(size_t)(32 * w + 16 * mb + 4 * g + rg) * 256 + 16 * nb + l15] = f2bf(acc[mb][nb][rg]);
    }
    __syncthreads();
}

DI void lru_stripe(const Args& a, int layer, int stripe, LAS unsigned char* lds) {
    unsigned char* ws = a.ws;
    const int tid = mk_tid(), lane = tid & 63, w = __builtin_amdgcn_readfirstlane(tid >> 6), g = lane >> 4, l15 = lane & 15;
    const int b = stripe >> 4, blk = stripe & 15;
    LAS bf16_t* lxs = (LAS bf16_t*)lds;
    LAS bf16_t* lgs0 = (LAS bf16_t*)(lds + 16896);
    LAS unsigned char* xcb = lds + 49664;
    LAS float* rgt = (LAS float*)(lds + 68096);
    LAS float* igt = (LAS float*)(lds + 100864);
    LAS float* wst = (LAS float*)(lds + 133632);
    const bf16_t* proj = (const bf16_t*)(ws + WS_PROJ) + (size_t)b * SEQ * DIN;
    const int gc = blk * 64 + lane;
    const float* cw = a.in[2] + (size_t)layer * 4096;
    const int cch_ = tid & 63, cgc = blk * 64 + cch_;
    const float cw0 = cw[cgc], cw1 = cw[1024 + cgc], cw2 = cw[2048 + cgc], cw3 = cw[3072 + cgc], cb = a.in[3][layer * 1024 + cgc];
    const float cc = ((const float*)(ws + WS_CCH))[gc] * 1.4426950408889634f;
    float bia[4], bix[4];
    LAS unsigned char* wlds = lds + 137728;
    { const int r = tid >> 3, c8 = tid & 7; *(LAS u32x4*)(wlds + r * 144 + c8 * 16) = *(const u32x4*)((const bf16_t*)(ws + WS_WAT) + blk * 4096 + r * 64 + c8 * 8); }
    bf16x8 wfx[4][2];
#pragma unroll
    for (int nb = 0; nb < 4; ++nb)
#pragma unroll
        for (int ks = 0; ks < 2; ++ks) wfx[nb][ks] = *(const bf16x8*)((const bf16_t*)(ws + WS_WXT) + blk * 4096 + (16 * nb + l15) * 64 + 32 * ks + 8 * g);
#pragma unroll
    for (int nb = 0; nb < 4; ++nb) { bia[nb] = -1.4426950408889634f * a.in[5][layer * 1024 + blk * 64 + 16 * nb + l15]; bix[nb] = -1.4426950408889634f * a.in[7][layer * 1024 + blk * 64 + 16 * nb + l15]; }
    if (tid < 24) *(LAS u32x4*)(lxs + tid * 8) = (u32x4){0u, 0u, 0u, 0u};
    u32x4 plx[2], plg[2];
#pragma unroll
    for (int i = 0; i < 2; ++i) { const int idx = tid + 512 * i, row = idx >> 3, c8 = idx & 7; const bf16_t* p = proj + (size_t)row * DIN + blk * 64 + c8 * 8; plx[i] = *(const u32x4*)(p + OFF_LX); plg[i] = *(const u32x4*)(p + OFF_LG); }
    float hcarry = 0.0f;
#pragma unroll 1
    for (int c = 0; c < 32; ++c) {
        LAS bf16_t* lgs = lgs0 + (c & 1) * 8192;
#pragma unroll
        for (int i = 0; i < 2; ++i) { const int idx = tid + 512 * i, row = idx >> 3, c8 = idx & 7; *(LAS u32x4*)(lxs + (3 + row) * 64 + c8 * 8) = plx[i]; *(LAS u32x4*)(lgs + row * 64 + c8 * 8) = plg[i]; }
        __syncthreads();
        if (c + 1 < 32) {
#pragma unroll
            for (int i = 0; i < 2; ++i) { const int idx = tid + 512 * i, row = idx >> 3, c8 = idx & 7; const bf16_t* p = proj + (size_t)((c + 1) * 128 + row) * DIN + blk * 64 + c8 * 8; plx[i] = *(const u32x4*)(p + OFF_LX); plg[i] = *(const u32x4*)(p + OFF_LG); }
        }
        {
            const int t0 = (tid >> 6) * 16;
            float x0 = bf2f(lxs[t0 * 64 + cch_]), x1 = bf2f(lxs[(t0 + 1) * 64 + cch_]), x2 = bf2f(lxs[(t0 + 2) * 64 + cch_]);
#pragma unroll
            for (int i = 0; i < 16; ++i) {
                const float x3 = bf2f(lxs[(t0 + i + 3) * 64 + cch_]);
                const float xc = cb + cw0 * x0 + cw1 * x1 + cw2 * x2 + cw3 * x3;
                *(LAS bf16_t*)(xcb + (t0 + i) * 144 + cch_ * 2) = f2bf(xc);
                x0 = x1; x1 = x2; x2 = x3;
            }
        }
        __syncthreads();
        if (tid < 24) *(LAS u32x4*)(lxs + tid * 8) = *(const LAS u32x4*)(lxs + 128 * 64 + tid * 8);
        {
            const bf16x8 af0 = *(const LAS bf16x8*)(xcb + (16 * w + l15) * 144 + (8 * g) * 2), af1 = *(const LAS bf16x8*)(xcb + (16 * w + l15) * 144 + (32 + 8 * g) * 2);
#pragma unroll
            for (int nb = 0; nb < 4; ++nb) {
                f32x4 ar = {0.f, 0.f, 0.f, 0.f}, ax = {0.f, 0.f, 0.f, 0.f};
                const LAS unsigned char* wr_ = wlds + (16 * nb + l15) * 144 + 16 * g;
                ar = mfma16(af0, *(const LAS bf16x8*)(wr_), ar); ar = mfma16(af1, *(const LAS bf16x8*)(wr_ + 64), ar);
                ax = mfma16(af0, wfx[nb][0], ax); ax = mfma16(af1, wfx[nb][1], ax);
#pragma unroll
                for (int rg = 0; rg < 4; ++rg) { rgt[(16 * w + 4 * g + rg) * 64 + 16 * nb + l15] = __builtin_amdgcn_rcpf(1.0f + __builtin_amdgcn_exp2f(ar[rg] + bia[nb])); igt[(16 * w + 4 * g + rg) * 64 + 16 * nb + l15] = __builtin_amdgcn_rcpf(1.0f + __builtin_amdgcn_exp2f(ax[rg] + bix[nb])); }
            }
        }
        __syncthreads();
        float av[16], bv[16]; float Aw = 1.0f, Hw = 0.0f;
#pragma unroll
        for (int tt = 0; tt < 16; ++tt) {
            const int t = 16 * w + tt;
            const float aa = __builtin_amdgcn_exp2f(cc * rgt[t * 64 + lane]);
            const float bb = __builtin_amdgcn_sqrtf(fmaxf(1.0f - aa * aa, 0.0f)) * igt[t * 64 + lane] * bf2f(*(const LAS bf16_t*)(xcb + t * 144 + lane * 2));
            av[tt] = aa; bv[tt] = bb; Hw = aa * Hw + bb; Aw *= aa;
        }
        wst[w * 64 + lane] = Aw; wst[512 + w * 64 + lane] = Hw;
        __syncthreads();
        float hcur = hcarry, hend = hcarry;
#pragma unroll
        for (int ww = 0; ww < 8; ++ww) { const float A_ = wst[ww * 64 + lane], H_ = wst[512 + ww * 64 + lane]; hend = A_ * hend + H_; if (ww < w) hcur = hend; }
        hcarry = hend;
        bf16_t* yb = (bf16_t*)(ws + WS_YB) + ((size_t)b * SEQ + c * 128 + 16 * w) * 1024 + gc;
#pragma unroll
        for (int tt = 0; tt < 16; tt += 2) {
            const float h0 = av[tt] * hcur + bv[tt]; hcur = av[tt + 1] * h0 + bv[tt + 1];
            const pg8::f32x2 gl = pg8::gelu_pk((pg8::f32x2){bf2f(lgs[(16 * w + tt) * 64 + lane]), bf2f(lgs[(16 * w + tt + 1) * 64 + lane])});
            yb[(size_t)tt * 1024] = f2bf(h0 * gl.x); yb[(size_t)(tt + 1) * 1024] = f2bf(hcur * gl.y);
        }
    }
    __syncthreads();
}

DI void retscan_unit(const Args& a, int unit) {
    unsigned char* ws = a.ws;
    const int e8 = unit * 512 + mk_tid();
    const int bh = e8 >> 13, within = e8 & 8191, h = bh & 3;
    const float g128 = exp2f(128.0f * log2gamma(h));
    bf16_t* base = (bf16_t*)(ws + WS_KVB) + (size_t)bh * 32 * 65536 + (size_t)within * 8;
    float st[8];
#pragma unroll
    for (int q = 0; q < 8; ++q) st[q] = 0.f;
#pragma unroll 1
    for (int c0 = 0; c0 < 32; c0 += 8) {
        u32x4 kv[8];
#pragma unroll
        for (int q = 0; q < 8; ++q) kv[q] = *(const u32x4*)(base + (size_t)(c0 + q) * 65536);
#pragma unroll
        for (int q = 0; q < 8; ++q) {
            u32x4 o;
#pragma unroll
            for (int j = 0; j < 4; ++j) o[j] = pk2(st[2 * j], st[2 * j + 1]);
            *(u32x4*)(base + (size_t)(c0 + q) * 65536) = o;
#pragma unroll
            for (int j = 0; j < 4; ++j) { st[2 * j] = g128 * st[2 * j] + bflo(kv[q][j]); st[2 * j + 1] = g128 * st[2 * j + 1] + bfhi(kv[q][j]); }
        }
    }
}

DI void attmerge_unit(const Args& a, int unit) {
    unsigned char* ws = a.ws;
    const int idx = unit * 512 + mk_tid(), t = idx >> 6, hp = (idx >> 4) & 3, dc = idx & 15;
    const float* lse = (const float*)(ws + WS_LSE) + (size_t)t * 12;
    const float l0 = lse[hp], l1 = lse[4 + hp], l2 = lse[8 + hp];
    const float m = fmaxf(l0, fmaxf(l1, l2));
    float w0 = __builtin_amdgcn_exp2f(l0 - m), w1 = __builtin_amdgcn_exp2f(l1 - m), w2 = __builtin_amdgcn_exp2f(l2 - m);
    const float is = 1.0f / (w0 + w1 + w2); w0 *= is; w1 *= is; w2 *= is;
    const bf16_t* o = (const bf16_t*)(ws + WS_OATT) + (size_t)t * 1536 + hp * 128 + dc * 8;
    const u32x4 a0 = *(const u32x4*)o, a1 = *(const u32x4*)(o + 512), a2 = *(const u32x4*)(o + 1024);
    u32x4 r;
#pragma unroll
    for (int q = 0; q < 4; ++q) r[q] = pk2(w0 * bflo(a0[q]) + w1 * bflo(a1[q]) + w2 * bflo(a2[q]), w0 * bfhi(a0[q]) + w1 * bfhi(a1[q]) + w2 * bfhi(a2[q]));
    *(u32x4*)((bf16_t*)(ws + WS_YA) + (size_t)t * 512 + hp * 128 + dc * 8) = r;
}

DI void retout_unit(const Args& a, int unit, LAS unsigned char* lds) {
    unsigned char* ws = a.ws;
    const int tid = mk_tid(), lane = tid & 63, w = __builtin_amdgcn_readfirstlane(tid >> 6), g = lane >> 4, l15 = lane & 15, tq4 = l15 >> 2, tp4 = l15 & 3;
    const int b = unit >> 7, h = (unit >> 5) & 3, c = unit & 31;
    const bf16_t* proj = (const bf16_t*)(ws + WS_PROJ) + ((size_t)b * SEQ + c * 128) * DIN;
    const bf16_t* rt = (const bf16_t*)(ws + WS_KVB) + ((size_t)((b * 4 + h) * 32 + c)) * 65536;
    LAS unsigned char* RA = lds; LAS unsigned char* RB = lds + 128 * 544;
    const float l2g = log2gamma(h);
    const int qi = 16 * w + l15;
    bf16x8 qf[8];
#pragma unroll
    for (int ks = 0; ks < 8; ++ks) qf[ks] = *(const bf16x8*)(proj + (size_t)qi * DIN + OFF_RQ + h * 256 + 32 * ks + 8 * g);
#pragma unroll
    for (int i = 0; i < 8; ++i) {
        const int idx = tid + 512 * i, row = idx >> 5, ch = idx & 31;
        *(LAS u32x4*)(RA + row * 544 + ch * 16) = *(const u32x4*)(proj + (size_t)row * DIN + OFF_RK + h * 256 + ch * 8);
        *(LAS u32x4*)(RB + row * 544 + ch * 16) = *(const u32x4*)(rt + (size_t)row * 256 + ch * 8);
    }
    __syncthreads();
    u32x4 pv[8], pr[8];
#pragma unroll
    for (int i = 0; i < 8; ++i) {
        const int idx = tid + 512 * i, row = idx >> 5, ch = idx & 31;
        pv[i] = *(const u32x4*)(proj + (size_t)row * DIN + OFF_RV + h * 256 + ch * 8);
        pr[i] = *(const u32x4*)(rt + (size_t)(128 + row) * 256 + ch * 8);
    }
    f32x4 sacc[8], oacc[16];
#pragma unroll
    for (int jj = 0; jj < 8; ++jj) {
        f32x4 acc = {0.f, 0.f, 0.f, 0.f};
        if (jj <= w) {
#pragma unroll
            for (int ks = 0; ks < 8; ++ks) { const bf16x8 kf = *(const LAS bf16x8*)(RA + (16 * jj + l15) * 544 + (32 * ks + 8 * g) * 2); acc = mfma16(kf, qf[ks], acc); }
        }
        sacc[jj] = acc;
    }
#pragma unroll
    for (int db = 0; db < 8; ++db) {
        f32x4 acc = {0.f, 0.f, 0.f, 0.f};
#pragma unroll
        for (int ks = 0; ks < 8; ++ks) { const bf16x8 rf = *(const LAS bf16x8*)(RB + (16 * db + l15) * 544 + (32 * ks + 8 * g) * 2); acc = mfma16(rf, qf[ks], acc); }
        oacc[db] = acc;
    }
    __syncthreads();
#pragma unroll
    for (int i = 0; i < 8; ++i) {
        const int idx = tid + 512 * i, row = idx >> 5, ch = idx & 31;
        *(LAS u32x4*)(RA + row * 544 + ch * 16) = pv[i];
        *(LAS u32x4*)(RB + row * 544 + ch * 16) = pr[i];
    }
    __syncthreads();
#pragma unroll
    for (int db = 0; db < 8; ++db) {
        f32x4 acc = {0.f, 0.f, 0.f, 0.f};
#pragma unroll
        for (int ks = 0; ks < 8; ++ks) { const bf16x8 rf = *(const LAS bf16x8*)(RB + (16 * db + l15) * 544 + (32 * ks + 8 * g) * 2); acc = mfma16(rf, qf[ks], acc); }
        oacc[8 + db] = acc;
    }
    const float xi = __builtin_amdgcn_exp2f((float)(qi + 1) * l2g);
#pragma unroll
    for (int db = 0; db < 16; ++db) oacc[db] = oacc[db] * xi;
#pragma unroll
    for (int jj = 0; jj < 8; ++jj)
#pragma unroll
        for (int rg = 0; rg < 4; ++rg) { const int j = 16 * jj + 4 * g + rg; sacc[jj][rg] = (qi >= j) ? sacc[jj][rg] * __builtin_amdgcn_exp2f((float)(qi - j) * l2g) : 0.f; }
#pragma unroll
    for (int s = 0; s < 4; ++s) {
        if (2 * s <= w) {
            u32x4 pw; pw.x = pk2(sacc[2 * s][0], sacc[2 * s][1]); pw.y = pk2(sacc[2 * s][2], sacc[2 * s][3]); pw.z = pk2(sacc[2 * s + 1][0], sacc[2 * s + 1][1]); pw.w = pk2(sacc[2 * s + 1][2], sacc[2 * s + 1][3]);
            const bf16x8 pb = __builtin_bit_cast(bf16x8, pw);
            const int k0 = 32 * s + 4 * g + tq4;
#pragma unroll
            for (int db = 0; db < 16; ++db) {
                const s16x4 lo = trrd(RA + k0 * 544 + (16 * db + 4 * tp4) * 2), hi = trrd(RA + (k0 + 16) * 544 + (16 * db + 4 * tp4) * 2);
                oacc[db] = mfma16(cat8(lo, hi), pb, oacc[db]);
            }
        }
    }
    float s1 = 0.f;
#pragma unroll
    for (int db = 0; db < 16; ++db) s1 += (oacc[db][0] + oacc[db][1]) + (oacc[db][2] + oacc[db][3]);
    s1 += __shfl_xor(s1, 16); s1 += __shfl_xor(s1, 32);
    const float mean = s1 * (1.0f / 256.0f);
    float s2 = 0.f;
#pragma unroll
    for (int db = 0; db < 16; ++db)
#pragma unroll
        for (int rg = 0; rg < 4; ++rg) { const float dd = oacc[db][rg] - mean; s2 += dd * dd; }
    s2 += __shfl_xor(s2, 16); s2 += __shfl_xor(s2, 32);
    const float rstd = rsqrtf(s2 * (1.0f / 256.0f) + LN_EPS);
    __syncthreads();
#pragma unroll
    for (int db = 0; db < 16; ++db) {
        u32x2 o; o.x = pk2((oacc[db][0] - mean) * rstd, (oacc[db][1] - mean) * rstd); o.y = pk2((oacc[db][2] - mean) * rstd, (oacc[db][3] - mean) * rstd);
        *(LAS u32x2*)(RA + qi * 528 + (16 * db + 4 * g) * 2) = o;
    }
    __syncthreads();
#pragma unroll
    for (int i = 0; i < 8; ++i) {
        const int idx = tid + 512 * i, row = idx >> 5, ch = idx & 31;
        const u32x4 nv = *(const LAS u32x4*)(RA + row * 528 + ch * 16);
        const u32x4 gw = *(const u32x4*)(proj + (size_t)row * DIN + OFF_RG + h * 256 + ch * 8);
        u32x4 o;
#pragma unroll
        for (int q = 0; q < 4; ++q) { const float g0 = bflo(gw[q]), g1 = bfhi(gw[q]); o[q] = pk2(g0 * sigm(g0) * bflo(nv[q]), g1 * sigm(g1) * bfhi(nv[q])); }
        *(u32x4*)((bf16_t*)(ws + WS_YC) + ((size_t)b * SEQ + c * 128 + row) * 1024 + h * 256 + ch * 8) = o;
    }
    __syncthreads();
}

struct EpiBranch {
    static constexpr bool PERM = false, AFTER_DRAIN = false;
    const bf16_t* gate; bf16_t* mf; bf16_t* mb; int mode;
    __device__ __forceinline__ void operator()(const f32x4 (&acc)[2][2][4][2], const pg8::Unit& u, int wr, int wc, int fr, int fq) const {
        const int row0 = u.pm * 256 + wr * 64 + fr, col0 = u.pn * 256 + wc * 32 + 4 * fq;
        bf16_t* dst = (mode == 2) ? mb : mf;
#pragma unroll
        for (int ai = 0; ai < 2; ++ai) {
            u32x2 gw[4][2][2], old[4][2][2];
#pragma unroll
            for (int m = 0; m < 4; ++m) { const size_t row = (size_t)(row0 + ai * 128 + m * 16);
#pragma unroll
                for (int bj = 0; bj < 2; ++bj)
#pragma unroll
                    for (int n = 0; n < 2; ++n) { const int col = col0 + bj * 128 + n * 16;
                        gw[m][bj][n] = *(const u32x2*)(gate + row * DIN + col);
                        old[m][bj][n] = (mode != 0) ? *(const u32x2*)(mf + row * 1024 + col) : (u32x2){0u, 0u}; } }
#pragma unroll
            for (int m = 0; m < 4; ++m) { const size_t row = (size_t)(row0 + ai * 128 + m * 16);
#pragma unroll
                for (int bj = 0; bj < 2; ++bj)
#pragma unroll
                    for (int n = 0; n < 2; ++n) { const int col = col0 + bj * 128 + n * 16;
                        const u32x2 g2 = gw[m][bj][n], o2 = old[m][bj][n];
                        f32x4 v = acc[ai][bj][m][n];
                        v[0] = v[0] * sigm(bflo(g2.x)) + bflo(o2.x); v[1] = v[1] * sigm(bfhi(g2.x)) + bfhi(o2.x);
                        v[2] = v[2] * sigm(bflo(g2.y)) + bflo(o2.y); v[3] = v[3] * sigm(bfhi(g2.y)) + bfhi(o2.y);
                        u32x2 o; o.x = pk2(v[0], v[1]); o.y = pk2(v[2], v[3]); *(u32x2*)(dst + row * 1024 + col) = o; } }
        }
    }
};
#ifndef MK_EPI_AUX
#define MK_EPI_AUX 0
#endif
struct EpiInProj {
    static constexpr bool PERM = true, AFTER_DRAIN = false;
    bf16_t* O;
    __device__ __forceinline__ void operator()(const f32x4 (&acc)[2][2][4][2], const pg8::Unit& u, int wr_, int wc_, int fr_, int fq_) const {
        (void)wr_; (void)wc_; (void)fr_; (void)fq_;
        const int tid = mk_tid(), wid = tid >> 6, lane = tid & 63, wr = wid >> 2, wc = wid & 3, fr = lane & 15, fq = lane >> 4;
        const __amdgpu_buffer_rsrc_t rsrc = __builtin_amdgcn_make_buffer_rsrc((void*)O, 0, (int)((size_t)NTOK * DIN * 2), 0x00020000);
        const int row0 = u.pm * 256 + wr * 64 + fr;
        const int pn = u.pn;
        const bool ropeA = pn < 12, ropeR = (pn >= 26 && pn < 34);
        const float dsc = 1.0f / (X8_SCALE * W8_SCALE);
        if (!(ropeA || ropeR)) {
            const int col0 = pn * 256 + 64 * wc + 8 * fq;
#pragma unroll
            for (int ai = 0; ai < 2; ++ai) {
#pragma unroll
                for (int m = 0; m < 4; ++m) { const unsigned roff = (unsigned)(((size_t)(row0 + ai * 128 + m * 16) * DIN + col0) * 2);
#pragma unroll
                    for (int bj = 0; bj < 2; ++bj) { const f32x4 v0 = acc[ai][bj][m][0] * dsc, v1 = acc[ai][bj][m][1] * dsc;
                        u32x4 w; w.x = pk2(v0[0], v0[1]); w.y = pk2(v0[2], v0[3]); w.z = pk2(v1[0], v1[1]); w.w = pk2(v1[2], v1[3]);
                        __builtin_amdgcn_raw_buffer_store_b128(w, rsrc, (int)(roff + bj * 64), 0, MK_EPI_AUX); } }
            }
        } else {
            const int half = ropeA ? 64 : 128;
            const float sc = (pn >= 30 && pn < 34) ? 0.0625f : 1.0f;
            const float kf = ropeA ? (-13.287712379549449f / 64.0f) : (-13.287712379549449f / 128.0f);
            const float pos0 = (float)(row0 & (SEQ - 1));
#pragma unroll
            for (int bj = 0; bj < 2; ++bj) {
                const int pc = 64 * wc + 32 * bj + 8 * fq;
                const int cbase = ropeA ? (pc & 128) : 0;
                const int q = ropeA ? ((pc & 127) >> 3) : (pc >> 3);
                f32x4 cb, sb, c16, s16, cb1, sb1;
#pragma unroll
                for (int e = 0; e < 4; ++e) {
                    const float f = __builtin_amdgcn_exp2f((float)(4 * q + e) * kf) * 0.15915494309189535f;
                    const float t0 = __builtin_amdgcn_fractf(pos0 * f), t16 = __builtin_amdgcn_fractf(16.0f * f), t128 = __builtin_amdgcn_fractf(128.0f * f);
                    cb[e] = __builtin_amdgcn_cosf(t0); sb[e] = __builtin_amdgcn_sinf(t0);
                    c16[e] = __builtin_amdgcn_cosf(t16); s16[e] = __builtin_amdgcn_sinf(t16);
                    const float c128 = __builtin_amdgcn_cosf(t128), s128 = __builtin_amdgcn_sinf(t128);
                    cb1[e] = cb[e] * c128 - sb[e] * s128; sb1[e] = sb[e] * c128 + cb[e] * s128;
                }
#pragma unroll
                for (int ai = 0; ai < 2; ++ai) {
                    f32x4 cv = ai ? cb1 : cb, sv = ai ? sb1 : sb;
#pragma unroll
                    for (int m = 0; m < 4; ++m) {
                        const int row = row0 + ai * 128 + m * 16;
                        const unsigned roff = (unsigned)(((size_t)row * DIN + pn * 256) * 2);
                        const float rsc = dsc * sc;
                        const f32x4 t1 = acc[ai][bj][m][0] * rsc, t2 = acc[ai][bj][m][1] * rsc;
                        const f32x4 o1 = t1 * cv - t2 * sv, o2 = t1 * sv + t2 * cv;
                        u32x2 w1, w2; w1.x = pk2(o1[0], o1[1]); w1.y = pk2(o1[2], o1[3]); w2.x = pk2(o2[0], o2[1]); w2.y = pk2(o2[2], o2[3]);
                        __builtin_amdgcn_raw_buffer_store_b64(w1, rsrc, (int)(roff + (cbase + 4 * q) * 2), 0, MK_EPI_AUX); __builtin_amdgcn_raw_buffer_store_b64(w2, rsrc, (int)(roff + (cbase + half + 4 * q) * 2), 0, MK_EPI_AUX);
                        if (m < 3) { const f32x4 cn = cv * c16 - sv * s16, sn = sv * c16 + cv * s16; cv = cn; sv = sn; }
                    }
                }
            }
        }
    }
};

struct EpiOut {
    static constexpr bool PERM = false, AFTER_DRAIN = false;
    const float* xf; float* z;
    __device__ __forceinline__ void operator()(const f32x4 (&acc)[2][2][4][2], const pg8::Unit& u, int wr, int wc, int fr, int fq) const {
        const int row0 = u.pm * 256 + wr * 64 + fr, col0 = u.pn * 256 + wc * 32 + 4 * fq;
#pragma unroll
        for (int ai = 0; ai < 2; ++ai) {
            f32x4 xv[4][2][2];
#pragma unroll
            for (int m = 0; m < 4; ++m) { const size_t row = (size_t)(row0 + ai * 128 + m * 16);
#pragma unroll
                for (int bj = 0; bj < 2; ++bj)
#pragma unroll
                    for (int n = 0; n < 2; ++n) xv[m][bj][n] = *(const f32x4*)(xf + row * 1024 + col0 + bj * 128 + n * 16); }
#pragma unroll
            for (int m = 0; m < 4; ++m) { const size_t row = (size_t)(row0 + ai * 128 + m * 16);
#pragma unroll
                for (int bj = 0; bj < 2; ++bj)
#pragma unroll
                    for (int n = 0; n < 2; ++n) *(f32x4*)(z + row * 1024 + col0 + bj * 128 + n * 16) = xv[m][bj][n] * ALPHA + acc[ai][bj][m][n]; }
        }
    }
};

DI void ln_row(const float* z, const float* gam, const float* bet, float* of, bf16_t* ob, int lane) {
    f32x4 v[4]; float s = 0.f;
#pragma unroll
    for (int i = 0; i < 4; ++i) { v[i] = *(const f32x4*)(z + 256 * i + 4 * lane); s += (v[i][0] + v[i][1]) + (v[i][2] + v[i][3]); }
    const float mean = wsum(s) * (1.0f / 1024.0f);
    float q = 0.f;
#pragma unroll
    for (int i = 0; i < 4; ++i)
#pragma unroll
        for (int j = 0; j < 4; ++j) { const float d = v[i][j] - mean; q += d * d; }
    const float rstd = rsqrtf(wsum(q) * (1.0f / 1024.0f) + LN_EPS);
#pragma unroll
    for (int i = 0; i < 4; ++i) {
        const f32x4 gg = *(const f32x4*)(gam + 256 * i + 4 * lane), bb = *(const f32x4*)(bet + 256 * i + 4 * lane);
        f32x4 o;
#pragma unroll
        for (int j = 0; j < 4; ++j) o[j] = (v[i][j] - mean) * rstd * gg[j] + bb[j];
        *(f32x4*)(of + 256 * i + 4 * lane) = o;
        u32x2 pb; pb.x = pk2(o[0], o[1]); pb.y = pk2(o[2], o[3]); *(u32x2*)(ob + 256 * i + 4 * lane) = pb;
    }
}
DI void phase_ln1(const Args& a, int layer) {
    unsigned char* ws = a.ws;
    const int lane = mk_tid() & 63, w = mk_tid() >> 6;
    for (int u = blockIdx.x; u < NTOK / 8; u += gridDim.x) {
        const size_t row = (size_t)u * 8 + w;
        ln_row((const float*)(ws + WS_MRGF) + row * 1024, a.in[11] + layer * 1024, a.in[12] + layer * 1024, (float*)(ws + WS_XF) + row * 1024, (bf16_t*)(ws + WS_XB) + row * 1024, lane);
    }
}

DI void ins16(float (&L)[16], float x) {
#pragma unroll
    for (int k = 0; k < 16; ++k) { const float hi = fmaxf(L[k], x); x = fminf(L[k], x); L[k] = hi; }
}
DI void merge16(float (&L)[16], int xr) {
    float t[16];
#pragma unroll
    for (int k = 0; k < 16; ++k) t[k] = __shfl_xor(L[k], xr);
#pragma unroll
    for (int k = 0; k < 8; ++k) { const float x = t[k]; t[k] = t[15 - k]; t[15 - k] = x; }
#pragma unroll
    for (int k = 0; k < 16; ++k) t[k] = fmaxf(L[k], t[k]);
#define MK_CE_STAGE(dd) _Pragma("unroll") for (int k = 0; k < 16; ++k) if ((k & (dd)) == 0) { const float hi = fmaxf(t[k], t[k + (dd)]), lo = fminf(t[k], t[k + (dd)]); t[k] = hi; t[k + (dd)] = lo; }
    MK_CE_STAGE(8) MK_CE_STAGE(4) MK_CE_STAGE(2) MK_CE_STAGE(1)
#undef MK_CE_STAGE
#pragma unroll
    for (int k = 0; k < 16; ++k) L[k] = t[k];
}
#define MK_CE_DESC(v, i, l) { const float hi_ = fmaxf(v[i], v[l]), lo_ = fminf(v[i], v[l]); v[i] = hi_; v[l] = lo_; }
#define MK_CE_ASC(v, i, l)  { const float hi_ = fmaxf(v[i], v[l]), lo_ = fminf(v[i], v[l]); v[i] = lo_; v[l] = hi_; }
#define MK_BITONIC_STAGE(v, kk, jj) _Pragma("unroll") for (int i_ = 0; i_ < 16; ++i_) { if ((i_ & (jj)) == 0) { if ((i_ & (kk)) == 0) MK_CE_DESC(v, i_, i_ + (jj)) else MK_CE_ASC(v, i_, i_ + (jj)) } }
DI void sort16_desc(float (&v)[16]) {
    MK_BITONIC_STAGE(v, 2, 1)
    MK_BITONIC_STAGE(v, 4, 2) MK_BITONIC_STAGE(v, 4, 1)
    MK_BITONIC_STAGE(v, 8, 4) MK_BITONIC_STAGE(v, 8, 2) MK_BITONIC_STAGE(v, 8, 1)
    MK_BITONIC_STAGE(v, 16, 8) MK_BITONIC_STAGE(v, 16, 4) MK_BITONIC_STAGE(v, 16, 2) MK_BITONIC_STAGE(v, 16, 1)
}
DI void top16_of_two(float (&a)[16], const float (&b)[16]) {
#pragma unroll
    for (int k = 0; k < 16; ++k) a[k] = fmaxf(a[k], b[15 - k]);
    MK_BITONIC_STAGE(a, 16, 8) MK_BITONIC_STAGE(a, 16, 4) MK_BITONIC_STAGE(a, 16, 2) MK_BITONIC_STAGE(a, 16, 1)
}
DI void top16_half(const bf16_t* qp, const LAS unsigned char* kt, float (&L)[16], int g, int l15) {
    bf16x8 qf[4];
#pragma unroll
    for (int ks = 0; ks < 4; ++ks) qf[ks] = *(const bf16x8*)(qp + 32 * ks + 8 * g);
    float M[16];
#pragma unroll
    for (int kbk = 0; kbk < 8; ++kbk) {
        f32x4 acc = {0.f, 0.f, 0.f, 0.f};
#pragma unroll
        for (int ks = 0; ks < 4; ++ks) { const bf16x8 kf = *(const LAS bf16x8*)(kt + (16 * kbk + l15) * 256 + (((4 * ks + g) ^ l15) << 4)); acc = mfma16(kf, qf[ks], acc); }
#pragma unroll
        for (int rg = 0; rg < 4; ++rg) { const unsigned key = (unsigned)(16 * kbk + 4 * g + rg); const float x = __uint_as_float((__float_as_uint(acc[rg]) & ~0x7Fu) | key);
            if (kbk < 4) L[4 * kbk + rg] = x; else M[4 * (kbk - 4) + rg] = x; }
    }
    sort16_desc(L); sort16_desc(M); top16_of_two(L, M);
    merge16(L, 16); merge16(L, 32);
}
DI void topk_unit(const Args& a, int unit, LAS unsigned char* lds) {
    unsigned char* ws = a.ws;
    const int tid = mk_tid(), lane = tid & 63, w = __builtin_amdgcn_readfirstlane(tid >> 6), g = lane >> 4, l15 = lane & 15;
    const int tg = w & 3, hs = w >> 2;
    const size_t t = (size_t)unit * 64 + tg * 16 + l15;
    const bf16_t* Q = (const bf16_t*)(ws + WS_Q);
    LAS unsigned char* tiles = lds + 16384;
    float K1[16], K2[16];
#pragma unroll
    for (int k = 0; k < 16; ++k) { K1[k] = 0.f; K2[k] = 0.f; }
#pragma unroll 1
    for (int hh = 0; hh < 4; ++hh) {
#pragma unroll
        for (int i = 0; i < 16; ++i) {
            const int idx = tid + 512 * i, tile = idx >> 11, row = (idx >> 4) & 127, ch = idx & 15;
            const int hd = ((tile >> 1) ? 4 : 0) + hh;
            const bf16_t* src = (const bf16_t*)(ws + ((tile & 1) ? WS_K2B : WS_K1B)) + ((size_t)hd * 128 + row) * 128 + ch * 8;
            *(LAS u32x4*)(tiles + tile * 32768 + row * 256 + ((ch ^ (row & 15)) << 4)) = *(const u32x4*)src;
        }
        __syncthreads();
        const int h = hs * 4 + hh;
        float l1[16], l2[16];
        top16_half(Q + t * 2048 + h * 256, tiles + (hs * 2) * 32768, l1, g, l15);
        top16_half(Q + t * 2048 + h * 256 + 128, tiles + (hs * 2 + 1) * 32768, l2, g, l15);
        const bool mine = (g == hh);
#pragma unroll
        for (int k = 0; k < 16; ++k) { K1[k] = mine ? l1[k] : K1[k]; K2[k] = mine ? l2[k] : K2[k]; }
        __syncthreads();
    }
    const int h = hs * 4 + g;
    float F[16];
#pragma unroll
    for (int k = 0; k < 16; ++k) F[k] = -FLT_MAX;
#pragma unroll
    for (int ia = 0; ia < 16; ++ia)
#pragma unroll
        for (int ib = 0; ib < 16 / (ia + 1); ++ib) {
            const float s = __uint_as_float(__float_as_uint(K1[ia]) & ~0x7Fu) + __uint_as_float(__float_as_uint(K2[ib]) & ~0x7Fu);
            ins16(F, __uint_as_float((__float_as_uint(s) & ~0xFFu) | (unsigned)(ia * 16 + ib)));
        }
    LAS unsigned char* row = lds + tid * 32;
#pragma unroll
    for (int k = 0; k < 16; ++k) { row[k] = (unsigned char)(__float_as_uint(K1[k]) & 0x7Fu); row[16 + k] = (unsigned char)(__float_as_uint(K2[k]) & 0x7Fu); }
    float gt[16]; int ei[16]; float gs = 0.f;
    const float cv0 = __uint_as_float(__float_as_uint(F[0]) & ~0xFFu);
#pragma unroll
    for (int k = 0; k < 16; ++k) {
        const unsigned bits = __float_as_uint(F[k]);
        const float cv = __uint_as_float(bits & ~0xFFu);
        gt[k] = __builtin_amdgcn_exp2f((cv - cv0) * 1.4426950408889634f); gs += gt[k];
        const int ia = (int)((bits >> 4) & 15u), ib = (int)(bits & 15u);
        ei[k] = (int)row[ia] * 128 + (int)row[16 + ib];
    }
    const float ig = 1.0f / gs;
    int* ep = (int*)(ws + WS_EID) + (t * 8 + h) * 16; float* gp = (float*)(ws + WS_GATE) + (t * 8 + h) * 16;
#pragma unroll
    for (int q = 0; q < 4; ++q) {
        *(i32x4*)(ep + 4 * q) = (i32x4){ei[4 * q], ei[4 * q + 1], ei[4 * q + 2], ei[4 * q + 3]};
        *(f32x4*)(gp + 4 * q) = (f32x4){gt[4 * q] * ig, gt[4 * q + 1] * ig, gt[4 * q + 2] * ig, gt[4 * q + 3] * ig};
    }
    __syncthreads();
}

typedef float f32x2 __attribute__((ext_vector_type(2)));
#define MK_PEER_LOAD1(j, ereg, kk) { const int e_ = __builtin_amdgcn_readlane(ereg, (kk)); \
        const unsigned char* p_ = UV + (size_t)(unsigned)e_ * 1536u; RA[j] = ((const u32x4*)p_)[lane]; RB[j] = ((const u32x2*)(p_ + 1024))[lane]; }
#define MK_PEER_COMP1(j, usreg, gvreg, kk) { \
        const float us_ = __uint_as_float(__builtin_amdgcn_readlane(__float_as_uint(usreg), (kk))), gv_ = __uint_as_float(__builtin_amdgcn_readlane(__float_as_uint(gvreg), (kk))); \
        const f32x32 r_ = __builtin_amdgcn_cvt_scalef32_pk32_f32_fp6((u32x6){RA[j][0], RA[j][1], RA[j][2], RA[j][3], RB[j][0], RB[j][1]}, 1.0f); \
        f32x2 p2_ = {0.f, 0.f}; \
        _Pragma("unroll") for (int q = 0; q < 8; ++q) p2_ += (f32x2){r_[2 * q], r_[2 * q + 1]} * x2[q]; \
        const float p_ = wsum_dpp(p2_.x + p2_.y) * us_; \
        const float act_ = gelu_as(p_) * gv_; const f32x2 a2_ = {act_, act_}; \
        _Pragma("unroll") for (int q = 0; q < 8; ++q) y2[q] += a2_ * (f32x2){r_[16 + 2 * q], r_[16 + 2 * q + 1]}; \
        __builtin_amdgcn_sched_barrier(0); }
DI void peer_token(const unsigned char* UV, int e0, int e1, float us0, float us1, float gv0, float gv1, const f32x2 (&x2)[8], f32x2 (&y2)[8], int lane) {
    u32x4 RA[8]; u32x2 RB[8];
#pragma unroll
    for (int j = 0; j < 8; ++j) MK_PEER_LOAD1(j, e0, j)
#pragma unroll 1
    for (int k = 0; k < 56; k += 8) {
#pragma unroll
        for (int j = 0; j < 8; ++j) { MK_PEER_COMP1(j, us0, gv0, k + j) MK_PEER_LOAD1(j, e0, k + 8 + j) }
    }
#pragma unroll
    for (int j = 0; j < 8; ++j) { MK_PEER_COMP1(j, us0, gv0, 56 + j) MK_PEER_LOAD1(j, e1, j) }
#pragma unroll 1
    for (int k = 0; k < 56; k += 8) {
#pragma unroll
        for (int j = 0; j < 8; ++j) { MK_PEER_COMP1(j, us1, gv1, k + j) MK_PEER_LOAD1(j, e1, k + 8 + j) }
    }
#pragma unroll
    for (int j = 0; j < 8; ++j) { MK_PEER_COMP1(j, us1, gv1, 56 + j) }
}
DI void peer_unit(const Args& a, int layer, int unit) {
    unsigned char* ws = a.ws;
    const int tid = mk_tid(), lane = tid & 63, w = __builtin_amdgcn_readfirstlane(tid >> 6);
    const unsigned char* UV = ws + WS_UV8; const float* SC = (const float*)(ws + WS_UVS);
#pragma unroll 1
    for (int i = 0; i < 8; ++i) {
        const size_t t = (size_t)unit * 64 + w * 8 + i;
        f32x2 x2[8], y2[8];
        int e0, e1; float us0, us1, gv0, gv1;
        {
            const int ln = mk_tid() & 63;
            const bf16_t* xbp = (const bf16_t*)(ws + WS_XB) + t * 1024 + 16 * ln;
            const u32x4 xa = *(const u32x4*)xbp, xb = *(const u32x4*)(xbp + 8);
#pragma unroll
            for (int q = 0; q < 4; ++q) { x2[q] = (f32x2){bflo(xa[q]), bfhi(xa[q])}; x2[4 + q] = (f32x2){bflo(xb[q]), bfhi(xb[q])}; }
            const int* ep = (const int*)(ws + WS_EID) + t * 128; const float* gp = (const float*)(ws + WS_GATE) + t * 128;
            e0 = ep[ln]; e1 = ep[64 + ln]; const float g0 = gp[ln], g1 = gp[64 + ln];
            const f32x2 s0 = *(const f32x2*)(SC + 2 * e0), s1 = *(const f32x2*)(SC + 2 * e1);
            us0 = s0.x; us1 = s1.x; gv0 = g0 * s0.y; gv1 = g1 * s1.y;
        }
#pragma unroll
        for (int q = 0; q < 8; ++q) y2[q] = (f32x2){0.f, 0.f};
        peer_token(UV, e0, e1, us0, us1, gv0, gv1, x2, y2, lane);
        {
            const int ln = mk_tid() & 63;
            float* xfp = (float*)(ws + WS_XF) + t * 1024 + 16 * ln;
            const float* gam = a.in[18] + layer * 1024 + 16 * ln; const float* bet = a.in[19] + layer * 1024 + 16 * ln;
            float z[16]; float s = 0.f;
#pragma unroll
            for (int q = 0; q < 4; ++q) { const f32x4 xr = *(const f32x4*)(xfp + 4 * q);
#pragma unroll
                for (int j = 0; j < 4; ++j) { z[4 * q + j] = ALPHA * xr[j] + y2[2 * q + (j >> 1)][j & 1]; s += z[4 * q + j]; } }
            const float mean = wsum(s) * (1.0f / 1024.0f);
            float qq = 0.f;
#pragma unroll
            for (int q = 0; q < 16; ++q) { const float d = z[q] - mean; qq += d * d; }
            const float rstd = rsqrtf(wsum(qq) * (1.0f / 1024.0f) + LN_EPS);
            f32x4 o[4];
#pragma unroll
            for (int q = 0; q < 4; ++q) { const f32x4 gq = *(const f32x4*)(gam + 4 * q), bq = *(const f32x4*)(bet + 4 * q);
#pragma unroll
                for (int j = 0; j < 4; ++j) o[q][j] = (z[4 * q + j] - mean) * rstd * gq[j] + bq[j]; }
#pragma unroll
            for (int q = 0; q < 4; ++q) *(f32x4*)(xfp + 4 * q) = o[q];
            if (layer == DEPTH - 1) { float* op = a.out + t * 1024 + 16 * ln;
#pragma unroll
                for (int q = 0; q < 4; ++q) *(f32x4*)(op + 4 * q) = o[q]; }
            row_to_fp8(o, ws + WS_X8 + t * 1024, ln);
        }
    }
}
}

namespace mk {
constexpr int LDS_ARG_OFF = LDS_BYTES - 16 - 256;
#define MK_NOINL __device__ __forceinline__
DI unsigned long long rfl64(unsigned long long v) { const unsigned lo = __builtin_amdgcn_readfirstlane((unsigned)v), hi = __builtin_amdgcn_readfirstlane((unsigned)(v >> 32)); return ((unsigned long long)hi << 32) | lo; }
DI Args load_args(LAS unsigned char* lds) {
    int aoff = LDS_ARG_OFF; asm volatile("" : "+s"(aoff));
    Args a; const LAS unsigned long long* p = (const LAS unsigned long long*)(lds + aoff);
#pragma unroll
    for (int i = 0; i < 20; ++i) a.in[i] = (const float*)(const __attribute__((address_space(1))) float*)rfl64(p[i]);
    a.out = (float*)(__attribute__((address_space(1))) float*)rfl64(p[20]); a.ws = (unsigned char*)(__attribute__((address_space(1))) unsigned char*)rfl64(p[21]);
    a.ropeA = __longlong_as_double((long long)rfl64(p[22])); a.ropeR = __longlong_as_double((long long)rfl64(p[23])); a.ph_lo = 0; a.ph_hi = 0;
    return a;
}
#define MK_LOADARGS const Args a = load_args(lds); unsigned char* ws = a.ws; const int G = (int)gridDim.x, bid = (int)blockIdx.x; (void)ws; (void)G; (void)bid
MK_NOINL void PG_prologue(LAS unsigned char* lds) { MK_LOADARGS; phase_prologue(a); }
MK_NOINL void P0_conv(LAS unsigned char* lds, int layer) { MK_LOADARGS; phase_conv(a, layer, lds); }
#ifndef MK_STAGGER_TICKS
#define MK_STAGGER_TICKS 140
#endif
MK_NOINL void P1_inproj(LAS unsigned char* lds, int layer) { MK_LOADARGS; (void)layer;
    pg8::Gemm gm; gm.A = (const bf16_t*)(ws + WS_X8); gm.Bt = (const bf16_t*)(ws + WS_WINT); gm.M = NTOK; gm.N = DIN; gm.K = 512;
    pg8::StaticOrder S; S.init(NTOK, DIN, G, bid);
    EpiInProj E; E.O = (bf16_t*)(ws + WS_PROJ);
    pg8::gemm_phase<EpiInProj, pg8::StaticOrder, false, true, true>(lds, gm, S, E, nullptr); }
#ifndef MK_NLRU
#define MK_NLRU 64
#endif
MK_NOINL void P3s_lru(LAS unsigned char* lds, int layer) { MK_LOADARGS; if (bid < MK_NLRU) { for (int s = bid; s < 64; s += MK_NLRU) lru_stripe(a, layer, s, lds); } }
MK_NOINL void P3a_attn(LAS unsigned char* lds, int layer) { MK_LOADARGS; (void)layer; if (bid >= MK_NLRU) { for (int u = bid - MK_NLRU; u < 1536; u += G - MK_NLRU) attn_unit(a, u, lds); } }
MK_NOINL void P3b_retkv(LAS unsigned char* lds, int layer) { MK_LOADARGS; (void)layer; if (bid >= MK_NLRU) { for (int u = bid - MK_NLRU; u < 512; u += G - MK_NLRU) retkv_unit(a, u, lds); } }
MK_NOINL void P4a_scan(LAS unsigned char* lds, int layer) { MK_LOADARGS; (void)layer; for (int u = bid; u < 256; u += G) retscan_unit(a, u); }
MK_NOINL void P4c_merge(LAS unsigned char* lds, int layer) { MK_LOADARGS; (void)layer; for (int u = bid; u < 2048; u += G) attmerge_unit(a, u); }
MK_NOINL void P5_retout(LAS unsigned char* lds, int layer) { MK_LOADARGS; (void)layer; for (int u = bid; u < 512; u += G) retout_unit(a, u, lds); }
MK_NOINL void P6_branch(LAS unsigned char* lds, int layer) { MK_LOADARGS; (void)layer;
#pragma unroll 1
    for (int s = 0; s < 3; ++s) {
        pg8::Gemm gm; gm.A = (const bf16_t*)(ws + (s == 0 ? WS_YA : (s == 1 ? WS_YB : WS_YC))); gm.Bt = (const bf16_t*)(ws + (s == 0 ? WS_WBAT : (s == 1 ? WS_WBBT : WS_WBCT)));
        gm.M = NTOK; gm.N = 1024; gm.K = (s == 0) ? 512 : 1024;
        pg8::StaticOrder S; S.init(NTOK, 1024, G, bid);
        EpiBranch E; E.gate = (const bf16_t*)(ws + WS_PROJ) + OFF_GA + 1024 * s; E.mf = (bf16_t*)(ws + WS_MRGF); E.mb = (bf16_t*)(ws + WS_MRGB); E.mode = s;
        pg8::gemm_phase<EpiBranch, pg8::StaticOrder, false>(lds, gm, S, E, nullptr);
    } }
MK_NOINL void P7_outproj(LAS unsigned char* lds, int layer) { MK_LOADARGS; (void)layer;
    pg8::Gemm gm; gm.A = (const bf16_t*)(ws + WS_MRGB); gm.Bt = (const bf16_t*)(ws + WS_WOT); gm.M = NTOK; gm.N = 1024; gm.K = 1024;
    pg8::StaticOrder S; S.init(NTOK, 1024, G, bid);
    EpiOut E; E.xf = (const float*)(ws + WS_XF); E.z = (float*)(ws + WS_MRGF);
    pg8::gemm_phase<EpiOut, pg8::StaticOrder, false>(lds, gm, S, E, nullptr); }
MK_NOINL void P8_ln1(LAS unsigned char* lds, int layer) { MK_LOADARGS; phase_ln1(a, layer); }
MK_NOINL void P9_wq(LAS unsigned char* lds, int layer) { MK_LOADARGS; (void)layer;
    pg8::Gemm gm; gm.A = (const bf16_t*)(ws + WS_XB); gm.Bt = (const bf16_t*)(ws + WS_WQT); gm.M = NTOK; gm.N = 2048; gm.K = 1024;
    pg8::StaticOrder S; S.init(NTOK, 2048, G, bid);
    pg8::EpiBf16<0> E; E.O = (bf16_t*)(ws + WS_Q); E.ldc = 2048; E.bias = nullptr; E.split_cols = 0; E.split_stride = 0;
    pg8::gemm_phase<pg8::EpiBf16<0>, pg8::StaticOrder, false>(lds, gm, S, E, nullptr); }
MK_NOINL void P10_topk(LAS unsigned char* lds, int layer) { MK_LOADARGS; (void)layer; for (int u = bid; u < NTOK / 64; u += G) topk_unit(a, u, lds); }
MK_NOINL void P11_peer(LAS unsigned char* lds, int layer) { MK_LOADARGS; for (int u = bid; u < NTOK / 64; u += G) peer_unit(a, layer, u); }
DI void mk_sync(LAS unsigned char* lds) {
    const Args a = load_args(lds);
    XcdBarrier b; b.bar = (unsigned*)(a.ws + WS_CTL); b.x = xb_xcc_id(); b.st = (volatile LAS unsigned*)(lds + LDS_BAR_OFF);
    xcd_barrier(b);
}
}

#ifndef MK_PHASE_MASK
#define MK_PHASE_MASK 0xFFFu
#endif
#define MK_RUN(k) ((((MK_PHASE_MASK) >> ((k) - pb)) & 1u) && (k) >= ph_lo && (k) < ph_hi)
#define MK_NPHASES (1 + mk::DEPTH * mk::NPH)

#define MK_SYNC(k) do { if ((k) >= ph_lo && (k) + 1 < ph_hi) mk::mk_sync(lds); } while (0)
__global__ __launch_bounds__(512, 2) void mk_fwd(mk::Args a) {
    using namespace mk;
    extern __shared__ __attribute__((aligned(16))) unsigned char smem_raw[];
    LAS unsigned char* lds = (LAS unsigned char*)smem_raw;
    const int ph_lo = a.ph_lo, ph_hi = a.ph_hi;
    {
        const unsigned* src = (const unsigned*)&a;
        if (threadIdx.x < sizeof(Args) / 4) ((LAS unsigned*)(lds + LDS_ARG_OFF))[threadIdx.x] = src[threadIdx.x];
        if (threadIdx.x == 0) { LAS unsigned* st = (LAS unsigned*)(lds + LDS_BAR_OFF); st[0] = 0u; st[1] = 0u; st[2] = 0u; st[3] = 0u; }
    }
    __syncthreads();
    if (ph_hi - ph_lo > 1) (void)xcd_barrier_post((unsigned*)(a.ws + WS_CTL), (volatile LAS unsigned*)(lds + LDS_BAR_OFF));
    if (0 >= ph_lo && 0 < ph_hi) PG_prologue(lds);
    MK_SYNC(0);
#pragma unroll 1
    for (int layer = 0; layer < DEPTH; ++layer) {
        const int pb = 1 + layer * NPH;
        if (MK_RUN(pb + 0)) P0_conv(lds, layer);
        MK_SYNC(pb + 0);
        if (MK_RUN(pb + 1)) P1_inproj(lds, layer);
        MK_SYNC(pb + 1);
        if (MK_RUN(pb + 3)) { P3s_lru(lds, layer); P3a_attn(lds, layer); P3b_retkv(lds, layer); }
        MK_SYNC(pb + 3);
        if (MK_RUN(pb + 4)) { P4a_scan(lds, layer); P4c_merge(lds, layer); }
        MK_SYNC(pb + 4);
        if (MK_RUN(pb + 5)) P5_retout(lds, layer);
        MK_SYNC(pb + 5);
        if (MK_RUN(pb + 6)) P6_branch(lds, layer);
        MK_SYNC(pb + 6);
        if (MK_RUN(pb + 7)) P7_outproj(lds, layer);
        MK_SYNC(pb + 7);
        if (MK_RUN(pb + 8)) P8_ln1(lds, layer);
        MK_SYNC(pb + 8);
        if (MK_RUN(pb + 9)) P9_wq(lds, layer);
        MK_SYNC(pb + 9);
        if (MK_RUN(pb + 10)) P10_topk(lds, layer);
        MK_SYNC(pb + 10);
        if (MK_RUN(pb + 11)) P11_peer(lds, layer);
        MK_SYNC(pb + 11);
    }
}

#ifndef MK_SINGLE
#define MK_SINGLE 1
#endif
extern "C" void kernel_launch(void* const* d_in, const int* in_sizes, int n_in, void* d_out, int out_size, void* d_ws, size_t ws_size, hipStream_t stream) {
    using namespace mk;
    static int grid = 0;
    if (grid == 0) {
        if (n_in != 20 || out_size != NTOK * D || ws_size < WS_END) { fprintf(stderr, "kernel_launch: unexpected shapes (n_in %d, out %d, ws %zu, need %zu)\n", n_in, out_size, ws_size, (size_t)WS_END); grid = -1; return; }
        int dev = 0, cus = 0, per_cu = 0;
        if (hipGetDevice(&dev) != hipSuccess || hipDeviceGetAttribute(&cus, hipDeviceAttributeMultiprocessorCount, dev) != hipSuccess) { grid = -1; return; }
        if (hipFuncSetAttribute((const void*)mk_fwd, hipFuncAttributeMaxDynamicSharedMemorySize, LDS_BYTES) != hipSuccess) { fprintf(stderr, "kernel_launch: hipFuncSetAttribute failed\n"); grid = -1; return; }
        if (hipOccupancyMaxActiveBlocksPerMultiprocessor(&per_cu, (const void*)mk_fwd, 512, LDS_BYTES) != hipSuccess || per_cu < 1) { fprintf(stderr, "kernel_launch: occupancy query says %d blocks per CU\n", per_cu); (void)hipGetLastError(); grid = -1; return; }
        grid = cus;
    }
    if (grid < 0) return;
    (void)in_sizes;
    Args a{};
    for (int i = 0; i < 20; ++i) a.in[i] = (const float*)d_in[i];
    a.out = (float*)d_out; a.ws = (unsigned char*)d_ws;
    a.ropeA = pow(10000.0, -2.0 / 128.0); a.ropeR = pow(10000.0, -2.0 / 256.0);
#if MK_SINGLE
    (void)hipMemsetAsync((unsigned char*)d_ws + WS_CTL, 0, 16384, stream);
    a.ph_lo = 0; a.ph_hi = MK_NPHASES;
    hipLaunchKernelGGL(mk_fwd, dim3(grid), dim3(512), LDS_BYTES, stream, a);
#else
    for (int p = 0; p < MK_NPHASES; ++p) { a.ph_lo = p; a.ph_hi = p + 1; hipLaunchKernelGGL(mk_fwd, dim3(grid), dim3(512), LDS_BYTES, stream, a); }
#endif
}
```

```cpp
#include <hip/hip_runtime.h>
#include <cstdio>
#include <cstdint>
#include <cmath>
#include <cfloat>
__device__ __forceinline__ int mk_tid() { int t = (int)threadIdx.x; asm volatile("" : "+v"(t)); return t; }
namespace pg8 {
#define PG8_LAS __attribute__((address_space(3)))
typedef unsigned short bf16_t;
typedef short bf16x8 __attribute__((ext_vector_type(8)));
typedef float f32x4 __attribute__((ext_vector_type(4)));
typedef unsigned u32x4 __attribute__((ext_vector_type(4)));
constexpr int BM = 256, BK = 64, HALF = 128, HTB = HALF * BK * 2  , STAGE_BYTES = 8 * HTB, NXCD = 8, WGM = 8;

__host__ __device__ __forceinline__ int lds_byte(int r, int c) { const int st = (r >> 4) * 2 + (c >> 5), rr = r & 15, cc = c & 31, ob = rr * 64 + cc * 2; return st * 1024 + (ob ^ (((ob >> 9) & 1) << 5)); }
__host__ __device__ __forceinline__ void stage_rc(int b, int& R, int& C) { const int st = b / 1024, sb = b % 1024, swz = sb ^ (((sb >> 9) & 1) << 5); R = (st >> 1) * 16 + swz / 64; C = (st & 1) * 32 + (swz % 64) / 2; }
__host__ __device__ __forceinline__ int perm32(int rho) { const int n = rho >> 4, i = rho & 15; return 8 * (i >> 2) + 4 * n + (i & 3); }

struct Unit { int pm, pn; };
struct Gemm { const bf16_t* A; const bf16_t* Bt; int M, N, K; };

struct StaticOrder {
    int nM, nN, nwg, G, c;
    __host__ __device__ void init(int M, int N, int G_, int c_) { nM = M / BM; nN = N / BM; nwg = nM * nN; G = G_; c = c_; }
    __host__ __device__ bool next(int i, Unit& u) const {
        const long L = (long)i * G + c; if (L >= nwg) return false;
        int wgid = (int)L; { const int q = nwg / NXCD, r = nwg % NXCD, xcd = wgid % NXCD, off = wgid / NXCD; wgid = (xcd < r ? xcd * (q + 1) : r * (q + 1) + (xcd - r) * q) + off; }
        const int nig = WGM * nN, gid = wgid / nig, fm = gid * WGM, gsz = (nM - fm) < WGM ? (nM - fm) : WGM;
        u.pm = fm + ((wgid % nig) % gsz); u.pn = (wgid % nig) / gsz; return true;
    }
    __device__ __forceinline__ void a_ready(const Unit&) const {}
    __device__ __forceinline__ void done(const Unit&) const {}
};
typedef __bf16 pg8_bf16x2 __attribute__((ext_vector_type(2)));
__device__ __forceinline__ unsigned cvt_pk_bf16(float lo, float hi) { const pg8_bf16x2 v = {(__bf16)lo, (__bf16)hi}; return __builtin_bit_cast(unsigned, v); }
typedef float f32x2 __attribute__((ext_vector_type(2)));
__device__ __forceinline__ f32x2 gelu_pk(f32x2 v) {
    const f32x2 av = __builtin_elementwise_abs(v), d = av * 0.2316418882f + 1.0f;
    f32x2 t; t.x = __builtin_amdgcn_rcpf(d.x); t.y = __builtin_amdgcn_rcpf(d.y);
    f32x2 q = t * 0.5307027145f + (-0.7265760135f); q = q * t + 0.7107068705f; q = q * t + (-0.142248368f); q = q * t + 0.127414796f; q = q * t;
    const f32x2 s = (v * v) * (-0.72134752044f);
    f32x2 e; e.x = __builtin_amdgcn_exp2f(s.x); e.y = __builtin_amdgcn_exp2f(s.y);
    const f32x2 m = v * (q * e), r = v - m;
    f32x2 o; o.x = v.x < 0.f ? m.x : r.x; o.y = v.y < 0.f ? m.y : r.y; return o;
}

struct EpiF32 {
    static constexpr bool PERM = false, AFTER_DRAIN = false;
    float* C; int ldc; const float* bias;
    __device__ __forceinline__ void operator()(const f32x4 (&acc)[2][2][4][2], const Unit& u, int wr, int wc, int fr, int fq) const {
        const int row0 = u.pm * BM + wr * 64 + fr, col0 = u.pn * BM + wc * 32 + 4 * fq;
        f32x4 bv[2][2];
#pragma unroll
        for (int bj = 0; bj < 2; ++bj)
#pragma unroll
            for (int n = 0; n < 2; ++n) bv[bj][n] = bias ? *(const f32x4*)(bias + col0 + bj * HALF + n * 16) : (f32x4){0.f, 0.f, 0.f, 0.f};
#pragma unroll
        for (int ai = 0; ai < 2; ++ai)
#pragma unroll
            for (int m = 0; m < 4; ++m) { float* rowp = C + (size_t)(row0 + ai * HALF + m * 16) * ldc + col0;
#pragma unroll
                for (int bj = 0; bj < 2; ++bj)
#pragma unroll
                    for (int n = 0; n < 2; ++n) *(f32x4*)(rowp + bj * HALF + n * 16) = acc[ai][bj][m][n] + bv[bj][n]; }
    }
};
template <int ACT  > struct EpiBf16 {
    static constexpr bool PERM = true, AFTER_DRAIN = false;
    bf16_t* O; int ldc; const float* bias; int split_cols; size_t split_stride;
    __device__ __forceinline__ void operator()(const f32x4 (&acc)[2][2][4][2], const Unit& u, int wr, int wc, int fr, int fq) const {
        const int row0 = u.pm * BM + wr * 64 + fr; int colt = u.pn * BM; bf16_t* base = O;
        if (split_cols) { const int t = colt / split_cols; base += (size_t)t * split_stride; colt -= t * split_cols; }
        const int col0 = colt + wc * 32 + 8 * fq, bcol0 = u.pn * BM + wc * 32 + 8 * fq;
        f32x4 bv[2][2];
#pragma unroll
        for (int bj = 0; bj < 2; ++bj)
#pragma unroll
            for (int n = 0; n < 2; ++n) bv[bj][n] = bias ? *(const f32x4*)(bias + bcol0 + bj * HALF + 4 * n) : (f32x4){0.f, 0.f, 0.f, 0.f};
#pragma unroll
        for (int ai = 0; ai < 2; ++ai)
#pragma unroll
            for (int m = 0; m < 4; ++m) { bf16_t* rowp = base + (size_t)(row0 + ai * HALF + m * 16) * ldc + col0;
#pragma unroll
                for (int bj = 0; bj < 2; ++bj) { f32x4 v0 = acc[ai][bj][m][0] + bv[bj][0], v1 = acc[ai][bj][m][1] + bv[bj][1];
                    if (ACT == 1) { f32x2 a = gelu_pk((f32x2){v0[0], v0[1]}), b = gelu_pk((f32x2){v0[2], v0[3]}), c = gelu_pk((f32x2){v1[0], v1[1]}), d = gelu_pk((f32x2){v1[2], v1[3]});
                        v0 = (f32x4){a.x, a.y, b.x, b.y}; v1 = (f32x4){c.x, c.y, d.x, d.y}; }
                    if (ACT == 2) {
#pragma unroll
                        for (int j = 0; j < 4; ++j) { v0[j] = 0.5f * v0[j] * (1.0f + erff(v0[j] * 0.70710678f)); v1[j] = 0.5f * v1[j] * (1.0f + erff(v1[j] * 0.70710678f)); } }
                    u32x4 w; w.x = cvt_pk_bf16(v0[0], v0[1]); w.y = cvt_pk_bf16(v0[2], v0[3]); w.z = cvt_pk_bf16(v1[0], v1[1]); w.w = cvt_pk_bf16(v1[2], v1[3]);
                    *(u32x4*)(rowp + bj * HALF) = w; } }
    }
};

typedef int i32x8 __attribute__((ext_vector_type(8)));
typedef short s16x16 __attribute__((ext_vector_type(16)));
__device__ __forceinline__ i32x8 pg8_cat16(bf16x8 a, bf16x8 b) { return __builtin_bit_cast(i32x8, (s16x16)__builtin_shufflevector(a, b, 0, 1, 2, 3, 4, 5, 6, 7, 8, 9, 10, 11, 12, 13, 14, 15)); }
template <class Epi, class Sched, bool STAMP = false, bool F8 = false, bool WIDE = false>
__device__ __forceinline__ void gemm_phase(PG8_LAS unsigned char* lds, const Gemm g, const Sched& S, const Epi& E, unsigned long long* stamps) {
    const int tid = mk_tid(), wid = __builtin_amdgcn_readfirstlane(tid >> 6), lane = tid & 63, wr = wid >> 2, wc = wid & 3, fr = lane & 15, fq = lane >> 4;
    const int K = g.K, nt = K / BK;
    int ts_lo = 0, ts_hi = 0, nts = 0; const unsigned long long rt_entry = STAMP ? (unsigned long long)wall_clock64() : 0ull;
#define PG8_STAMP() do { if (STAMP && wid == 0 && nts < 64) { const unsigned long long _c = (unsigned long long)clock64(); \
        ts_lo = (lane == nts) ? (int)(unsigned)_c : ts_lo; ts_hi = (lane == nts) ? (int)(unsigned)(_c >> 32) : ts_hi; ++nts; } } while (0)
    PG8_STAMP();
    unsigned voffA, voffB;
    { int R, C; stage_rc(tid * 16, R, C); const int Ri = Epi::PERM ? perm32(R & 31) : (R & 31); const int Rb = WIDE ? (((R >> 5) << 6) + Ri) : ((R & ~31) + Ri);
        voffA = (unsigned)(R * K + C) * 2u; voffB = (unsigned)(Rb * K + C) * 2u; }
    const size_t qstep = (size_t)64 * K * 2;
    const size_t qstepB = WIDE ? (size_t)128 * K * 2 : qstep;
    const size_t hstepB = WIDE ? (size_t)32 * K * 2 : (size_t)HALF * K * 2;
    const size_t kstep = (size_t)(BK * 2);
    const size_t hstep = (size_t)HALF * K * 2;
    const size_t tstep = 2 * hstep;
    const unsigned ldsw = (unsigned)wid * 1024u;
    const int aoff = lds_byte(wr * 64 + fr, fq * 8), boff = lds_byte(wc * 32 + fr, fq * 8);
#define PG8_SA(b, h) (((b) * 2 + (h)) * HTB)
#define PG8_SB(b, h) ((4 + (b) * 2 + (h)) * HTB)
#define PG8_STAGE(bufoff, gbase, voff) PG8_STAGEQ(bufoff, gbase, voff, qstep)
#define PG8_STAGEB(bufoff, gbase, voff) PG8_STAGEQ(bufoff, gbase, voff, qstepB)
#define PG8_STAGEQ(bufoff, gbase, voff, qs) do { const char* _g0 = (const char*)(gbase); const char* _g1 = _g0 + (qs); asm volatile("" : "+s"(_g0), "+s"(_g1));   \
        __builtin_amdgcn_global_load_lds((const unsigned*)(_g0 + (voff)), (PG8_LAS unsigned*)(lds + (bufoff) + ldsw), 16, 0, 0); \
        __builtin_amdgcn_global_load_lds((const unsigned*)(_g1 + (voff)), (PG8_LAS unsigned*)(lds + (bufoff) + ldsw + 8192), 16, 0, 0); } while (0)
#define PG8_LDA(dst, b, h) do { _Pragma("unroll") for (int m = 0; m < 4; ++m) _Pragma("unroll") for (int k = 0; k < 2; ++k) dst[m][k] = *(const PG8_LAS bf16x8*)(lds + PG8_SA(b, h) + aoff + m * 2048 + k * 1024); } while (0)
#define PG8_LDB(dst, b, h) do { _Pragma("unroll") for (int n = 0; n < 2; ++n) _Pragma("unroll") for (int k = 0; k < 2; ++k) dst[n][k] = *(const PG8_LAS bf16x8*)(lds + PG8_SB(b, h) + boff + n * 2048 + k * 1024); } while (0)
#define PG8_MMA(ai, bj, At, Bt) do { __builtin_amdgcn_s_setprio(1); _Pragma("unroll") for (int m = 0; m < 4; ++m) _Pragma("unroll") for (int n = 0; n < 2; ++n) { \
        if constexpr (F8) acc[ai][bj][m][n] = __builtin_amdgcn_mfma_scale_f32_16x16x128_f8f6f4(pg8_cat16(Bt[n][0], Bt[n][1]), pg8_cat16(At[m][0], At[m][1]), acc[ai][bj][m][n], 0, 0, 0, 0, 0, 0); \
        else { _Pragma("unroll") for (int k = 0; k < 2; ++k) acc[ai][bj][m][n] = __builtin_amdgcn_mfma_f32_16x16x32_bf16(Bt[n][k], At[m][k], acc[ai][bj][m][n], 0, 0, 0); } } \
        __builtin_amdgcn_s_setprio(0); } while (0)
#define PG8_WAIT_V(n) asm volatile("s_waitcnt vmcnt(" #n ")" ::: "memory")
#define PG8_WAIT_L(n) asm volatile("s_waitcnt lgkmcnt(" #n ")" ::: "memory")
#define PG8_BAR __builtin_amdgcn_s_barrier()
#define PG8_SCHED __builtin_amdgcn_sched_barrier(0)
    Unit cur, nxt; int ui = 0;
    if (!S.next(0, cur)) return;
    f32x4 acc[2][2][4][2];
    bf16x8 At[4][2], B0[2][2], B1[2][2];
    const char* cA = (const char*)g.A + (size_t)cur.pm * tstep; const char* cB = (const char*)g.Bt + (size_t)cur.pn * tstep;
    S.a_ready(cur);
    PG8_STAGEB(PG8_SB(0, 0), cB, voffB); PG8_STAGE(PG8_SA(0, 0), cA, voffA); PG8_STAGEB(PG8_SB(0, 1), cB + hstepB, voffB); PG8_STAGE(PG8_SA(0, 1), cA + hstep, voffA);
    if (wr == 1) PG8_BAR;
    PG8_WAIT_V(4); PG8_BAR;
    PG8_STAGEB(PG8_SB(1, 0), cB + kstep, voffB); PG8_STAGE(PG8_SA(1, 0), cA + kstep, voffA); PG8_STAGEB(PG8_SB(1, 1), cB + hstepB + kstep, voffB);
    PG8_WAIT_V(6); PG8_BAR;
    PG8_STAMP();
#pragma unroll
    for (int a = 0; a < 2; ++a)
#pragma unroll
        for (int b = 0; b < 2; ++b)
#pragma unroll
            for (int m = 0; m < 4; ++m)
#pragma unroll
                for (int n = 0; n < 2; ++n) acc[a][b][m][n] = (f32x4){0.f, 0.f, 0.f, 0.f};
    for (;;) {
        const bool has_next = S.next(ui + 1, nxt);
        const char* nA = has_next ? (const char*)g.A + (size_t)nxt.pm * tstep : cA; const char* nB = has_next ? (const char*)g.Bt + (size_t)nxt.pn * tstep : cB;
        for (int t = 0; t < nt; t += 2) {
            const bool last = (t == nt - 2);
            const char* a1 = cA + (size_t)(t + 1) * kstep;
            const char* a2 = last ? nA : cA + (size_t)(t + 2) * kstep; const char* b2 = last ? nB : cB + (size_t)(t + 2) * kstep;
            const char* a3 = a2 + kstep; const char* b3 = b2 + kstep;
            if (last && has_next) S.a_ready(nxt);
            PG8_LDB(B0, 0, 0); PG8_SCHED; PG8_LDA(At, 0, 0); PG8_STAGE(PG8_SA(1, 1), a1 + hstep, voffA);
            PG8_WAIT_L(8); PG8_BAR; PG8_WAIT_L(0); PG8_MMA(0, 0, At, B0); PG8_BAR; PG8_SCHED;
            PG8_LDB(B1, 0, 1); PG8_STAGEB(PG8_SB(0, 0), b2, voffB);
            PG8_BAR; PG8_WAIT_L(0); PG8_MMA(0, 1, At, B1); PG8_BAR;
            PG8_LDA(At, 0, 1); PG8_STAGE(PG8_SA(0, 0), a2, voffA);
            PG8_BAR; PG8_WAIT_L(0); PG8_MMA(1, 0, At, B0); PG8_BAR; PG8_SCHED;
            PG8_STAGEB(PG8_SB(0, 1), b2 + hstepB, voffB);
            PG8_WAIT_V(6); PG8_BAR; PG8_MMA(1, 1, At, B1); PG8_BAR;
            PG8_LDB(B0, 1, 0); PG8_SCHED; PG8_LDA(At, 1, 0); PG8_STAGE(PG8_SA(0, 1), a2 + hstep, voffA);
            PG8_WAIT_L(8); PG8_BAR; PG8_WAIT_L(0); PG8_MMA(0, 0, At, B0); PG8_BAR; PG8_SCHED;
            PG8_LDB(B1, 1, 1); PG8_STAGEB(PG8_SB(1, 0), b3, voffB);
            PG8_BAR; PG8_WAIT_L(0); PG8_MMA(0, 1, At, B1); PG8_BAR;
            PG8_LDA(At, 1, 1); PG8_STAGE(PG8_SA(1, 0), a3, voffA);
            PG8_BAR; PG8_WAIT_L(0); PG8_MMA(1, 0, At, B0); PG8_BAR; PG8_SCHED;
            PG8_STAGEB(PG8_SB(1, 1), b3 + hstepB, voffB);
            PG8_WAIT_V(6); PG8_BAR; PG8_MMA(1, 1, At, B1); PG8_BAR;
        }
        PG8_STAMP();
        if constexpr (!Epi::AFTER_DRAIN) { E(acc, cur, wr, wc, fr, fq); S.done(cur); }
        PG8_STAMP();
        if (!has_next) break;
#pragma unroll
        for (int a = 0; a < 2; ++a)
#pragma unroll
            for (int b = 0; b < 2; ++b)
#pragma unroll
                for (int m = 0; m < 4; ++m)
#pragma unroll
                    for (int n = 0; n < 2; ++n) acc[a][b][m][n] = (f32x4){0.f, 0.f, 0.f, 0.f};
        cur = nxt; cA = nA; cB = nB; ++ui;
    }
    PG8_WAIT_V(0);
    if (wr == 0) PG8_BAR;
    PG8_BAR;
    if constexpr (Epi::AFTER_DRAIN) { E.fused(acc, cur, wr, wc, fr, fq, lds, wid, lane); S.done(cur); }
    PG8_STAMP();
    if (STAMP && wid == 0) { stamps[lane] = lane < nts ? (((unsigned long long)(unsigned)ts_hi << 32) | (unsigned)ts_lo) : 0ull;
        if (lane == 62) stamps[62] = rt_entry; if (lane == 63) stamps[63] = (unsigned long long)wall_clock64(); }
#undef PG8_STAMP
#undef PG8_SA
#undef PG8_SB
#undef PG8_STAGE
#undef PG8_STAGEB
#undef PG8_STAGEQ
#undef PG8_LDA
#undef PG8_LDB
#undef PG8_MMA
#undef PG8_WAIT_V
#undef PG8_WAIT_L
#undef PG8_BAR
#undef PG8_SCHED
}
}
#define XB_TMO      128
#define XB_XCNT(j)  (256  + 64 * (j))
#define XB_XSUB(j)  (1280 + 64 * (j))
#define XB_XGEN(j)  (2304 + 64 * (j))
#define XB_TOP      3328
#define XB_TOPGEN   3392
#define XCD_BAR_WORDS 3456
#define XB_SPIN_CAP (1u << 18)
#define LAS __attribute__((address_space(3)))

__device__ __forceinline__ unsigned xb_ld(unsigned* p)              { return __hip_atomic_load(p, __ATOMIC_RELAXED, __HIP_MEMORY_SCOPE_AGENT); }
__device__ __forceinline__ unsigned xb_add(unsigned* p, unsigned v) { return __hip_atomic_fetch_add(p, v, __ATOMIC_RELAXED, __HIP_MEMORY_SCOPE_AGENT); }
__device__ __forceinline__ unsigned xb_xcc_id() { return (unsigned)__builtin_amdgcn_s_getreg((3 << 11) | 20) & 0xFu; }
#define XB_SPIN(cond, bar) do { unsigned _sp = 0; while (cond) { __builtin_amdgcn_s_sleep(1); \
    if ((++_sp & 255u) == 0u) { if (xb_ld(&(bar)[XB_TMO])) break; if (_sp > XB_SPIN_CAP) { atomicAdd(&(bar)[XB_TMO], 1u); break; } } } } while (0)

struct XcdBarrier {
    unsigned* bar; unsigned x;
    volatile LAS unsigned* st;
};

__device__ __forceinline__ XcdBarrier xcd_barrier_post(unsigned* bar, volatile LAS unsigned* st) {
    XcdBarrier b; b.bar = bar; b.x = xb_xcc_id(); b.st = st;
    if (threadIdx.x == 0) (void)xb_add(&bar[XB_XCNT(b.x)], 1u);
    return b;
}
__device__ __forceinline__ void xcd_barrier_complete(unsigned* bar, unsigned x, unsigned& nloc, unsigned& nx) {
    const unsigned G = gridDim.x * gridDim.y * gridDim.z;
    unsigned sum, cnt, mine, sp = 0u;
    for (;;) {
        sum = 0u; cnt = 0u; mine = 0u;
#pragma unroll
        for (unsigned j = 0; j < 16; ++j) { const unsigned c = xb_ld(&bar[XB_XCNT(j)]); sum += c; cnt += (c > 0u) ? 1u : 0u; mine = (j == x) ? c : mine; }
        if (sum == G) break;
        __builtin_amdgcn_s_sleep(1);
        if ((++sp & 255u) == 0u) { if (xb_ld(&bar[XB_TMO])) break; if (sp > XB_SPIN_CAP) { atomicAdd(&bar[XB_TMO], 1u); break; } }
    }
    nloc = mine > 0u ? mine : 1u; nx = cnt > 0u ? cnt : 1u;
}

__device__ __forceinline__ void xcd_barrier(const XcdBarrier& b) {
    asm volatile("s_waitcnt vmcnt(0)" ::: "memory");
    __syncthreads();
    if (threadIdx.x == 0) {
        unsigned* bar = b.bar;
        __builtin_amdgcn_s_waitcnt(0);
        unsigned nloc = b.st[0], nx = b.st[1];
        if (nloc == 0u) { xcd_barrier_complete(bar, b.x, nloc, nx); b.st[0] = nloc; b.st[1] = nx; }
        const unsigned old = xb_add(&bar[XB_XSUB(b.x)], 1u);
        const unsigned gen = old / nloc;
        if (old + 1u == (gen + 1u) * nloc) {
            __builtin_amdgcn_fence(__ATOMIC_RELEASE, "agent");
            asm volatile("s_waitcnt vmcnt(0)" ::: "memory");
            const unsigned og = xb_add(&bar[XB_TOP], 1u);
            const unsigned tg = og / nx;
            if (og + 1u == (tg + 1u) * nx) xb_add(&bar[XB_TOPGEN], 1u);
            else XB_SPIN(xb_ld(&bar[XB_TOPGEN]) == tg, bar);
            __builtin_amdgcn_fence(__ATOMIC_ACQUIRE, "agent");
            xb_add(&bar[XB_XGEN(b.x)], 1u);
            asm volatile("s_waitcnt vmcnt(0)" ::: "memory");
        } else {
            XB_SPIN(xb_ld(&bar[XB_XGEN(b.x)]) == gen, bar);
            __builtin_amdgcn_fence(__ATOMIC_ACQUIRE, "agent");
            asm volatile("s_waitcnt vmcnt(0)" ::: "memory");
        }
    }
    __syncthreads();
}

namespace mk {
using pg8::bf16_t; using pg8::bf16x8; using pg8::f32x4; using pg8::u32x4;
typedef short s16x4 __attribute__((ext_vector_type(4)));
typedef unsigned u32x2 __attribute__((ext_vector_type(2)));
typedef __bf16 bf16x2v __attribute__((ext_vector_type(2)));
typedef int i32x4 __attribute__((ext_vector_type(4)));
#define DI __device__ __forceinline__

constexpr int D = 1024, SEQ = 4096, NTOK = 16384, DEPTH = 4, DIN = 13824;
constexpr int OFF_AQ = 0, OFF_AK = 1536, OFF_AV = 3072, OFF_LX = 4608, OFF_LG = 5632, OFF_RQ = 6656, OFF_RK = 7680, OFF_RV = 8704, OFF_RG = 9728, OFF_GA = 10752;
constexpr float ALPHA = 1.681792830507429f;
constexpr float LN_EPS = 1e-5f;
constexpr float X8_SCALE = 32.0f, W8_SCALE = 2048.0f, F8_MAX = 440.0f;
constexpr int NPH = 12;
constexpr int LDS_BYTES = 148 * 1024;
constexpr int LDS_BAR_OFF = LDS_BYTES - 16;

constexpr size_t WS_CTL  = 0;
constexpr size_t WS_COSA = 16384;
constexpr size_t WS_SINA = WS_COSA + (size_t)4096 * 64 * 4;
constexpr size_t WS_COSR = WS_SINA + (size_t)4096 * 64 * 4;
constexpr size_t WS_SINR = WS_COSR + (size_t)4096 * 128 * 4;
constexpr size_t WS_CCH  = WS_SINR + (size_t)4096 * 128 * 4;
constexpr size_t WS_WAT  = WS_CCH + 4096;
constexpr size_t WS_WXT  = WS_WAT + 131072;
constexpr size_t WS_LSTA = WS_WXT + 131072;
constexpr size_t WS_LSTH = WS_LSTA + 524288;
constexpr size_t WS_K1B  = WS_LSTH + 524288;
constexpr size_t WS_K2B  = WS_K1B + 262144;
constexpr size_t WS_XF   = WS_K2B + 262144;
constexpr size_t WS_XB   = WS_XF + (size_t)NTOK * D * 4;
constexpr size_t WS_WINT = WS_XB + (size_t)NTOK * D * 2;
constexpr size_t WS_WSC  = WS_WINT + (size_t)DIN * 1024;
constexpr size_t WS_X8   = WS_WSC + (size_t)DIN * 4 + 256 - ((size_t)DIN * 4) % 256;
constexpr size_t WS_XS   = WS_X8 + (size_t)NTOK * 1024;
constexpr size_t WS_WBAT = WS_XS + (size_t)NTOK * 4;
constexpr size_t WS_WBBT = WS_WBAT + (size_t)1024 * 512 * 2;
constexpr size_t WS_WBCT = WS_WBBT + (size_t)1024 * 1024 * 2;
constexpr size_t WS_WOT  = WS_WBCT + (size_t)1024 * 1024 * 2;
constexpr size_t WS_WQT  = WS_WOT + (size_t)1024 * 1024 * 2;
constexpr size_t WS_UV8  = WS_WQT + (size_t)2048 * 1024 * 2;
constexpr size_t WS_UVS  = WS_UV8 + (size_t)16384 * 2048;
constexpr size_t WS_PROJ = WS_UVS + (size_t)16384 * 8;
constexpr size_t WS_OATT = WS_PROJ + (size_t)NTOK * DIN * 2;
constexpr size_t WS_LSE  = WS_OATT + (size_t)NTOK * 1536 * 2;
constexpr size_t WS_KVB  = WS_LSE + (size_t)NTOK * 12 * 4;
constexpr size_t WS_YA   = WS_KVB + (size_t)16 * 32 * 65536 * 2;
constexpr size_t WS_YB   = WS_YA + (size_t)NTOK * 512 * 2;
constexpr size_t WS_YC   = WS_YB + (size_t)NTOK * 1024 * 2;
constexpr size_t WS_MRGF = WS_YC + (size_t)NTOK * 1024 * 2;
constexpr size_t WS_MRGB = WS_MRGF + (size_t)NTOK * 1024 * 4;
constexpr size_t WS_END  = WS_MRGB + (size_t)NTOK * 1024 * 2;
constexpr size_t WS_Q    = WS_PROJ;
constexpr size_t WS_EID  = WS_PROJ + (size_t)NTOK * 2048 * 2;
constexpr size_t WS_GATE = WS_EID + (size_t)NTOK * 128 * 4;
static_assert(WS_END <= (size_t)1073741824, "workspace too large");
static_assert(WS_PROJ % 256 == 0 && WS_KVB % 256 == 0 && WS_MRGF % 256 == 0, "alignment");

struct Args { const float* in[20]; float* out; unsigned char* ws; double ropeA, ropeR; int ph_lo, ph_hi; };

DI float bflo(unsigned w) { return __uint_as_float(w << 16); }
DI float bfhi(unsigned w) { return __uint_as_float(w & 0xffff0000u); }
DI float bf2f(bf16_t v) { return __uint_as_float(((unsigned)v) << 16); }
DI unsigned pk2(float lo, float hi) { return pg8::cvt_pk_bf16(lo, hi); }
DI bf16_t f2bf(float f) { return (bf16_t)(pk2(f, 0.f) & 0xffffu); }
DI f32x4 mfma16(bf16x8 a, bf16x8 b, f32x4 c) { return __builtin_amdgcn_mfma_f32_16x16x32_bf16(a, b, c, 0, 0, 0); }
DI s16x4 trrd(LAS unsigned char* p) { return __builtin_amdgcn_ds_read_tr16_b64_v4i16((LAS s16x4*)p); }
DI bf16x8 cat8(s16x4 lo, s16x4 hi) { return __builtin_shufflevector(lo, hi, 0, 1, 2, 3, 4, 5, 6, 7); }
DI float wsum(float v) { v += __shfl_xor(v, 32); v += __shfl_xor(v, 16); v += __shfl_xor(v, 8); v += __shfl_xor(v, 4); v += __shfl_xor(v, 2); v += __shfl_xor(v, 1); return v; }
DI float sigm(float x) { return __builtin_amdgcn_rcpf(1.f + __builtin_amdgcn_exp2f(x * -1.4426950408889634f)); }
DI float gelu_erf(float x) { return 0.5f * x * (1.f + erff(x * 0.70710678118654752f)); }
DI float dot2(unsigned w, unsigned x, float acc) { return __builtin_amdgcn_fdot2_f32_bf16(__builtin_bit_cast(bf16x2v, w), __builtin_bit_cast(bf16x2v, x), acc, false); }
DI float log2gamma(int h) { return log2f(1.0f - exp2f(-5.0f - (float)h)); }

#define MK_DPP_ADD(v, ctrl, rmask) v += __int_as_float(__builtin_amdgcn_update_dpp(0, __float_as_int(v), (ctrl), (rmask), 0xf, false))
DI float wsum_dpp(float v) {
    MK_DPP_ADD(v, 0xB1, 0xf); MK_DPP_ADD(v, 0x4E, 0xf); MK_DPP_ADD(v, 0x141, 0xf); MK_DPP_ADD(v, 0x140, 0xf);
    MK_DPP_ADD(v, 0x142, 0xa); MK_DPP_ADD(v, 0x143, 0xc);
    return __int_as_float(__builtin_amdgcn_readlane(__float_as_int(v), 63));
}
DI float gelu_as(float v) {
    const float av = fabsf(v), t = __builtin_amdgcn_rcpf(av * 0.2316418882f + 1.0f);
    float q = t * 0.5307027145f + (-0.7265760135f); q = q * t + 0.7107068705f; q = q * t + (-0.142248368f); q = q * t + 0.127414796f; q = q * t;
    const float e = __builtin_amdgcn_exp2f(v * v * (-0.72134752044f));
    const float m = v * (q * e);
    return v < 0.f ? m : v - m;
}
DI int wperm(int n) {
    if (n < 3072) { const int j = n & 127, jj = j & 63; return (n & ~127) + 8 * (jj >> 2) + (jj & 3) + ((j >= 64) ? 4 : 0); }
    if (n >= OFF_RQ && n < OFF_RV) { const int j = n & 255, jj = j & 127; return (n & ~255) + 8 * (jj >> 2) + (jj & 3) + ((j >= 128) ? 4 : 0); }
    return n;
}

template <bool WPERM>
DI void tconv_tile(const float* src, int ldsrc, bf16_t* dst, int lddst, int k0, int n0, LAS float* t, float mul = 1.0f) {
    const int tid = mk_tid();
#pragma unroll
    for (int i = 0; i < 8; ++i) { const int idx = tid + 512 * i, r = idx >> 6, c = idx & 63; t[r * 65 + c] = src[(size_t)(k0 + r) * ldsrc + n0 + c]; }
    __syncthreads();
#pragma unroll
    for (int i = 0; i < 8; ++i) { const int idx = tid + 512 * i, n = idx >> 6, k = idx & 63; const int nr = WPERM ? wperm(n0 + n) : (n0 + n); dst[(size_t)nr * lddst + k0 + k] = f2bf(t[k * 65 + n] * mul); }
    __syncthreads();
}
DI void conv_unit(const float* src, bf16_t* dst, int unit) {
    const size_t i = (size_t)unit * 4096 + (size_t)mk_tid() * 8;
    const f32x4 a = *(const f32x4*)(src + i), b = *(const f32x4*)(src + i + 4);
    u32x4 o; o.x = pk2(a[0], a[1]); o.y = pk2(a[2], a[3]); o.z = pk2(b[0], b[1]); o.w = pk2(b[2], b[3]);
    *(u32x4*)(dst + i) = o;
}
DI void w8_unit(const float* src, unsigned char* ws, int unit, LAS float* t) {
    const int tid = mk_tid(), n0 = unit * 64;
    unsigned char* dst = ws + WS_WINT;
#pragma unroll 1
    for (int k0 = 0; k0 < 1024; k0 += 64) {
#pragma unroll
        for (int i = 0; i < 8; ++i) { const int idx = tid + 512 * i, r = idx >> 6, cc = idx & 63; t[r * 65 + cc] = fminf(fmaxf(src[(size_t)(k0 + r) * DIN + n0 + cc] * W8_SCALE, -F8_MAX), F8_MAX); }
        __syncthreads();
#pragma unroll
        for (int i = 0; i < 2; ++i) { const int idx = tid + 512 * i, n = idx >> 4, k4 = idx & 15;
            int wd = __builtin_amdgcn_cvt_pk_fp8_f32(t[(4 * k4) * 65 + n], t[(4 * k4 + 1) * 65 + n], 0, false);
            wd = __builtin_amdgcn_cvt_pk_fp8_f32(t[(4 * k4 + 2) * 65 + n], t[(4 * k4 + 3) * 65 + n], wd, true);
            *(int*)(dst + (size_t)wperm(n0 + n) * 1024 + k0 + 4 * k4) = wd; }
        __syncthreads();
    }
}
DI void row_to_fp8(const f32x4 (&o)[4], unsigned char* x8row, int ln) {
    u32x4 w;
#pragma unroll
    for (int q = 0; q < 4; ++q) {
        const float a0 = fminf(fmaxf(o[q][0] * X8_SCALE, -F8_MAX), F8_MAX), a1 = fminf(fmaxf(o[q][1] * X8_SCALE, -F8_MAX), F8_MAX), a2 = fminf(fmaxf(o[q][2] * X8_SCALE, -F8_MAX), F8_MAX), a3 = fminf(fmaxf(o[q][3] * X8_SCALE, -F8_MAX), F8_MAX);
        int wd = __builtin_amdgcn_cvt_pk_fp8_f32(a0, a1, 0, false); wd = __builtin_amdgcn_cvt_pk_fp8_f32(a2, a3, wd, true); w[q] = (unsigned)wd; }
    *(u32x4*)(x8row + 16 * ln) = w;
}
typedef float f32x16 __attribute__((ext_vector_type(16)));
typedef float f32x32 __attribute__((ext_vector_type(32)));
typedef unsigned u32x6 __attribute__((ext_vector_type(6)));
typedef _Float16 f16x32 __attribute__((ext_vector_type(32)));
DI float wmax(float m) { m = fmaxf(m, __shfl_xor(m, 32)); m = fmaxf(m, __shfl_xor(m, 16)); m = fmaxf(m, __shfl_xor(m, 8)); m = fmaxf(m, __shfl_xor(m, 4)); m = fmaxf(m, __shfl_xor(m, 2)); m = fmaxf(m, __shfl_xor(m, 1)); return m; }
DI void conv_fp6_rows(const float* usrc, const float* vsrc, unsigned char* ws, int unit) {
    const int tid = mk_tid(), lane = tid & 63, w = tid >> 6;
    const size_t row = (size_t)unit * 8 + w;
    const float* up = usrc + row * 1024 + 16 * lane; const float* vp = vsrc + row * 1024 + 16 * lane;
    f32x16 a, b; float mu = 0.f, mv = 0.f;
#pragma unroll
    for (int q = 0; q < 4; ++q) { const f32x4 x = *(const f32x4*)(up + 4 * q), y = *(const f32x4*)(vp + 4 * q);
#pragma unroll
        for (int j = 0; j < 4; ++j) { a[4 * q + j] = x[j]; b[4 * q + j] = y[j]; mu = fmaxf(mu, fabsf(x[j])); mv = fmaxf(mv, fabsf(y[j])); } }
    mu = wmax(mu); mv = wmax(mv);
    const float su = (mu > 0.f) ? 7.0f / mu : 1.0f, sv = (mv > 0.f) ? 7.0f / mv : 1.0f;
    f16x32 h;
#pragma unroll
    for (int i = 0; i < 16; ++i) { h[i] = (_Float16)(a[i] * su); h[16 + i] = (_Float16)(b[i] * sv); }
    const u32x6 p = __builtin_amdgcn_cvt_scalef32_pk32_fp6_f16(h, 1.0f);
    unsigned char* rec = ws + WS_UV8 + row * 1536;
    *(u32x4*)(rec + 16 * lane) = (u32x4){p[0], p[1], p[2], p[3]};
    *(u32x2*)(rec + 1024 + 8 * lane) = (u32x2){p[4], p[5]};
    if (lane == 0) { float* sp = (float*)(ws + WS_UVS) + row * 2; sp[0] = (mu > 0.f) ? mu * (1.0f / 7.0f) : 1.0f; sp[1] = (mv > 0.f) ? mv * (1.0f / 7.0f) : 1.0f; }
}
DI void phase_conv(const Args& a, int layer, LAS unsigned char* lds) {
    unsigned char* ws = a.ws;
    LAS float* t = (LAS float*)lds;
    const int J0 = 216, J1 = J0 + 128, J2 = J1 + 256, J3 = J2 + 256, J4 = J3 + 256, J5 = J4 + 512, J6 = J5 + 32, J7 = J6 + 2048, J8 = J7, J9 = J8 + 64, J10 = J9 + 1;
    const int total = J10;
    for (int u = blockIdx.x; u < total; u += gridDim.x) {
        if (u < J0) { w8_unit(a.in[1] + (size_t)layer * 1024 * DIN, ws, u, t); }
        else if (u < J1) { const int v = u - J0, kt = v / 16, nt = v % 16; tconv_tile<false>(a.in[9] + (size_t)layer * 2560 * 1024, 1024, (bf16_t*)(ws + WS_WBAT), 512, kt * 64, nt * 64, t); }
        else if (u < J2) { const int v = u - J1, kt = v / 16, nt = v % 16; tconv_tile<false>(a.in[9] + (size_t)layer * 2560 * 1024 + (size_t)512 * 1024, 1024, (bf16_t*)(ws + WS_WBBT), 1024, kt * 64, nt * 64, t); }
        else if (u < J3) { const int v = u - J2, kt = v / 16, nt = v % 16; tconv_tile<false>(a.in[9] + (size_t)layer * 2560 * 1024 + (size_t)1536 * 1024, 1024, (bf16_t*)(ws + WS_WBCT), 1024, kt * 64, nt * 64, t); }
        else if (u < J4) { const int v = u - J3, kt = v / 16, nt = v % 16; tconv_tile<false>(a.in[10] + (size_t)layer * 1024 * 1024, 1024, (bf16_t*)(ws + WS_WOT), 1024, kt * 64, nt * 64, t); }
        else if (u < J5) { const int v = u - J4, kt = v / 32, nt = v % 32; tconv_tile<false>(a.in[13] + (size_t)layer * 1024 * 2048, 2048, (bf16_t*)(ws + WS_WQT), 1024, kt * 64, nt * 64, t); }
        else if (u < J6) { const int v = u - J5, blk = v & 15, which = v >> 4;
            tconv_tile<false>(a.in[which ? 6 : 4] + ((size_t)layer * 16 + blk) * 4096, 64, (bf16_t*)(ws + (which ? WS_WXT : WS_WAT)) + blk * 4096, 64, 0, 0, t, -1.4426950408889634f); }
        else if (u < J7) { conv_fp6_rows(a.in[16] + (size_t)layer * 16384 * 1024, a.in[17] + (size_t)layer * 16384 * 1024, ws, u - J6); }
        else if (u < J9) { const int v = u - J8; if (v < 32) conv_unit(a.in[14] + (size_t)layer * 131072, (bf16_t*)(ws + WS_K1B), v); else conv_unit(a.in[15] + (size_t)layer * 131072, (bf16_t*)(ws + WS_K2B), v - 32); }
        else { for (int c = mk_tid(); c < 1024; c += 512) { const float lam = a.in[8][layer * 1024 + c]; const float e = __builtin_amdgcn_exp2f(-lam * 1.4426950408889634f); const float sp = (e < 0.05f) ? e * (1.0f + e * (-0.5f + e * (0.33333333f + e * -0.25f))) : __builtin_amdgcn_logf(1.0f + e) * 0.6931471805599453f; ((float*)(ws + WS_CCH))[c] = -8.0f * sp; } }
    }
}

DI void phase_prologue(const Args& a) {
    unsigned char* ws = a.ws;
    const int tid = mk_tid();
    for (int u = blockIdx.x; u < 2048; u += gridDim.x) {
        { const int ln = tid & 63; const size_t row = (size_t)u * 8 + (tid >> 6);
            const float* xp = a.in[0] + row * 1024 + 16 * ln; float* xo = (float*)(ws + WS_XF) + row * 1024 + 16 * ln;
            f32x4 o[4];
#pragma unroll
            for (int q = 0; q < 4; ++q) { o[q] = *(const f32x4*)(xp + 4 * q); *(f32x4*)(xo + 4 * q) = o[q]; }
            row_to_fp8(o, ws + WS_X8 + row * 1024, ln); }
    }
}

DI void attn_unit(const Args& a, int unit, LAS unsigned char* lds) {
    unsigned char* ws = a.ws;
    const int tid = mk_tid(), lane = tid & 63, w = __builtin_amdgcn_readfirstlane(tid >> 6), g = lane >> 4, l15 = lane & 15, tq4 = l15 >> 2, tp4 = l15 & 3;
    const int b = unit / 384, rem = unit % 384, h = rem >> 5, bi = rem & 31;
    const int grp = h >> 2, d = (grp == 0) ? 1 : ((grp == 1) ? 4 : 16), nb = 32 / d, r = bi / nb, n = bi % nb;
    const bf16_t* proj = (const bf16_t*)(ws + WS_PROJ) + (size_t)b * SEQ * DIN;
    LAS unsigned char* Ks = lds; LAS unsigned char* Vs = lds + 256 * 288;
#pragma unroll
    for (int i = 0; i < 8; ++i) {
        const int idx = tid + 512 * i, row = idx >> 4, ch = idx & 15, m = 128 * (n - 1) + row;
        u32x4 kv = {0u, 0u, 0u, 0u}, vv = {0u, 0u, 0u, 0u};
        if (m >= 0) { const bf16_t* p = proj + (size_t)(m * d + r) * DIN + h * 128 + ch * 8; kv = *(const u32x4*)(p + OFF_AK); vv = *(const u32x4*)(p + OFF_AV); }
        *(LAS u32x4*)(Ks + row * 288 + ch * 16) = kv; *(LAS u32x4*)(Vs + row * 288 + ch * 16) = vv;
    }
    const int qi = 16 * w + l15;
    const size_t tq = (size_t)(128 * n + qi) * d + r;
    bf16x8 qf[4];
#pragma unroll
    for (int ks = 0; ks < 4; ++ks) qf[ks] = *(const bf16x8*)(proj + tq * DIN + OFF_AQ + h * 128 + 32 * ks + 8 * g);
    __syncthreads();
    const int s0 = w >> 1;
    f32x4 sacc[10];
#pragma unroll
    for (int jj = 0; jj < 10; ++jj) {
        f32x4 acc = {0.f, 0.f, 0.f, 0.f};
#pragma unroll
        for (int ks = 0; ks < 4; ++ks) { const bf16x8 kf = *(const LAS bf16x8*)(Ks + (32 * s0 + 16 * jj + l15) * 288 + (32 * ks + 8 * g) * 2); acc = mfma16(kf, qf[ks], acc); }
        sacc[jj] = acc;
    }
    const float scale = 0.08838834764831845f * 1.4426950408889634f;
    float mx = -1e30f;
#pragma unroll
    for (int jj = 0; jj < 10; ++jj)
#pragma unroll
        for (int rg = 0; rg < 4; ++rg) {
            const int j = 32 * s0 + 16 * jj + 4 * g + rg;
            const bool valid = (j >= qi) && (j <= qi + 128) && (n > 0 || j >= 128);
            const float s = valid ? sacc[jj][rg] * scale : -1e30f;
            sacc[jj][rg] = s; mx = fmaxf(mx, s);
        }
    mx = fmaxf(mx, __shfl_xor(mx, 16)); mx = fmaxf(mx, __shfl_xor(mx, 32));
    float sum = 0.f;
#pragma unroll
    for (int jj = 0; jj < 10; ++jj)
#pragma unroll
        for (int rg = 0; rg < 4; ++rg) { const float p = __builtin_amdgcn_exp2f(sacc[jj][rg] - mx); sacc[jj][rg] = p; sum += p; }
    sum += __shfl_xor(sum, 16); sum += __shfl_xor(sum, 32);
    f32x4 oacc[8];
#pragma unroll
    for (int db = 0; db < 8; ++db) oacc[db] = (f32x4){0.f, 0.f, 0.f, 0.f};
#pragma unroll
    for (int s = 0; s < 5; ++s) {
        u32x4 pw; pw.x = pk2(sacc[2 * s][0], sacc[2 * s][1]); pw.y = pk2(sacc[2 * s][2], sacc[2 * s][3]); pw.z = pk2(sacc[2 * s + 1][0], sacc[2 * s + 1][1]); pw.w = pk2(sacc[2 * s + 1][2], sacc[2 * s + 1][3]);
        const bf16x8 pb = __builtin_bit_cast(bf16x8, pw);
        const int k0 = 32 * (s0 + s) + 4 * g + tq4;
#pragma unroll
        for (int db = 0; db < 8; ++db) {
            const s16x4 lo = trrd(Vs + k0 * 288 + (16 * db + 4 * tp4) * 2), hi = trrd(Vs + (k0 + 16) * 288 + (16 * db + 4 * tp4) * 2);
            oacc[db] = mfma16(cat8(lo, hi), pb, oacc[db]);
        }
    }
    const float inv = 1.0f / sum;
    bf16_t* op = (bf16_t*)(ws + WS_OATT) + ((size_t)b * SEQ + tq) * 1536 + h * 128 + 4 * g;
#pragma unroll
    for (int db = 0; db < 8; ++db) { u32x2 o; o.x = pk2(oacc[db][0] * inv, oacc[db][1] * inv); o.y = pk2(oacc[db][2] * inv, oacc[db][3] * inv); *(u32x2*)(op + 16 * db) = o; }
    if (g == 0) ((float*)(ws + WS_LSE))[((size_t)b * SEQ + tq) * 12 + h] = mx + __builtin_amdgcn_logf(sum);
    __syncthreads();
}

DI void retkv_unit(const Args& a, int unit, LAS unsigned char* lds) {
    unsigned char* ws = a.ws;
    const int tid = mk_tid(), lane = tid & 63, w = __builtin_amdgcn_readfirstlane(tid >> 6), g = lane >> 4, l15 = lane & 15, tq4 = l15 >> 2, tp4 = l15 & 3;
    const int b = unit >> 7, h = (unit >> 5) & 3, c = unit & 31;
    const bf16_t* proj = (const bf16_t*)(ws + WS_PROJ) + ((size_t)b * SEQ + c * 128) * DIN;
    LAS unsigned char* Ks = lds; LAS unsigned char* Vs = lds + 128 * 544;
    const float l2g = log2gamma(h);
#pragma unroll
    for (int i = 0; i < 8; ++i) {
        const int idx = tid + 512 * i, row = idx >> 5, ch = idx & 31;
        const bf16_t* p = proj + (size_t)row * DIN + h * 256 + ch * 8;
        const u32x4 kv = *(const u32x4*)(p + OFF_RK), vv = *(const u32x4*)(p + OFF_RV);
        const float z = exp2f((float)(127 - row) * l2g);
        u32x4 kz;
#pragma unroll
        for (int q = 0; q < 4; ++q) kz[q] = pk2(bflo(kv[q]) * z, bfhi(kv[q]) * z);
        *(LAS u32x4*)(Ks + row * 544 + ch * 16) = kz; *(LAS u32x4*)(Vs + row * 544 + ch * 16) = vv;
    }
    __syncthreads();
#pragma unroll 1
    for (int nh = 0; nh < 2; ++nh) {
        f32x4 acc[2][8];
#pragma unroll
        for (int mb = 0; mb < 2; ++mb)
#pragma unroll
            for (int nb = 0; nb < 8; ++nb) acc[mb][nb] = (f32x4){0.f, 0.f, 0.f, 0.f};
#pragma unroll
        for (int ks = 0; ks < 4; ++ks) {
            const int j0 = 32 * ks + 4 * g + tq4;
            bf16x8 af[2];
#pragma unroll
            for (int mb = 0; mb < 2; ++mb) { const int col = 32 * w + 16 * mb + 4 * tp4; af[mb] = cat8(trrd(Vs + j0 * 544 + col * 2), trrd(Vs + (j0 + 16) * 544 + col * 2)); }
#pragma unroll
            for (int nb = 0; nb < 8; ++nb) {
                const int col = 128 * nh + 16 * nb + 4 * tp4;
                const bf16x8 bfr = cat8(trrd(Ks + j0 * 544 + col * 2), trrd(Ks + (j0 + 16) * 544 + col * 2));
#pragma unroll
                for (int mb = 0; mb < 2; ++mb) acc[mb][nb] = mfma16(af[mb], bfr, acc[mb][nb]);
            }
        }
        bf16_t* kvb = (bf16_t*)(ws + WS_KVB) + ((size_t)((b * 4 + h) * 32 + c)) * 65536 + 128 * nh;
#pragma unroll
        for (int mb = 0; mb < 2; ++mb)
#pragma unroll
            for (int nb = 0; nb < 8; ++nb)
#pragma unroll
                for (int rg = 0; rg < 4; ++rg) kvb[(size_t)(32 * w + 16 * mb + 4 * g + rg) * 256 + 16 * nb + l15] = f2bf(acc[mb][nb][rg]);
    }
    __syncthreads();
}

DI void lru_stripe(const Args& a, int layer, int stripe, LAS unsigned char* lds) {
    unsigned char* ws = a.ws;
    const int tid = mk_tid(), lane = tid & 63, w = __builtin_amdgcn_readfirstlane(tid >> 6), g = lane >> 4, l15 = lane & 15;
    const int b = stripe >> 4, blk = stripe & 15;
    LAS bf16_t* lxs = (LAS bf16_t*)lds;
    LAS bf16_t* lgs0 = (LAS bf16_t*)(lds + 16896);
    LAS unsigned char* xcb = lds + 49664;
    LAS float* rgt = (LAS float*)(lds + 68096);
    LAS float* igt = (LAS float*)(lds + 100864);
    LAS float* wst = (LAS float*)(lds + 133632);
    const bf16_t* proj = (const bf16_t*)(ws + WS_PROJ) + (size_t)b * SEQ * DIN;
    const int gc = blk * 64 + lane;
    const float* cw = a.in[2] + (size_t)layer * 4096;
    const int cch_ = tid & 63, cgc = blk * 64 + cch_;
    const float cw0 = cw[cgc], cw1 = cw[1024 + cgc], cw2 = cw[2048 + cgc], cw3 = cw[3072 + cgc], cb = a.in[3][layer * 1024 + cgc];
    const float cc = ((const float*)(ws + WS_CCH))[gc] * 1.4426950408889634f;
    float bia[4], bix[4];
    LAS unsigned char* wlds = lds + 137728;
    { const int r = tid >> 3, c8 = tid & 7; *(LAS u32x4*)(wlds + r * 144 + c8 * 16) = *(const u32x4*)((const bf16_t*)(ws + WS_WAT) + blk * 4096 + r * 64 + c8 * 8); }
    bf16x8 wfx[4][2];
#pragma unroll
    for (int nb = 0; nb < 4; ++nb)
#pragma unroll
        for (int ks = 0; ks < 2; ++ks) wfx[nb][ks] = *(const bf16x8*)((const bf16_t*)(ws + WS_WXT) + blk * 4096 + (16 * nb + l15) * 64 + 32 * ks + 8 * g);
#pragma unroll
    for (int nb = 0; nb < 4; ++nb) { bia[nb] = -1.4426950408889634f * a.in[5][layer * 1024 + blk * 64 + 16 * nb + l15]; bix[nb] = -1.4426950408889634f * a.in[7][layer * 1024 + blk * 64 + 16 * nb + l15]; }
    if (tid < 24) *(LAS u32x4*)(lxs + tid * 8) = (u32x4){0u, 0u, 0u, 0u};
    u32x4 plx[2], plg[2];
#pragma unroll
    for (int i = 0; i < 2; ++i) { const int idx = tid + 512 * i, row = idx >> 3, c8 = idx & 7; const bf16_t* p = proj + (size_t)row * DIN + blk * 64 + c8 * 8; plx[i] = *(const u32x4*)(p + OFF_LX); plg[i] = *(const u32x4*)(p + OFF_LG); }
    float hcarry = 0.0f;
#pragma unroll 1
    for (int c = 0; c < 32; ++c) {
        LAS bf16_t* lgs = lgs0 + (c & 1) * 8192;
#pragma unroll
        for (int i = 0; i < 2; ++i) { const int idx = tid + 512 * i, row = idx >> 3, c8 = idx & 7; *(LAS u32x4*)(lxs + (3 + row) * 64 + c8 * 8) = plx[i]; *(LAS u32x4*)(lgs + row * 64 + c8 * 8) = plg[i]; }
        __syncthreads();
        if (c + 1 < 32) {
#pragma unroll
            for (int i = 0; i < 2; ++i) { const int idx = tid + 512 * i, row = idx >> 3, c8 = idx & 7; const bf16_t* p = proj + (size_t)((c + 1) * 128 + row) * DIN + blk * 64 + c8 * 8; plx[i] = *(const u32x4*)(p + OFF_LX); plg[i] = *(const u32x4*)(p + OFF_LG); }
        }
        {
            const int t0 = (tid >> 6) * 16;
            float x0 = bf2f(lxs[t0 * 64 + cch_]), x1 = bf2f(lxs[(t0 + 1) * 64 + cch_]), x2 = bf2f(lxs[(t0 + 2) * 64 + cch_]);
#pragma unroll
            for (int i = 0; i < 16; ++i) {
                const float x3 = bf2f(lxs[(t0 + i + 3) * 64 + cch_]);
                const float xc = cb + cw0 * x0 + cw1 * x1 + cw2 * x2 + cw3 * x3;
                *(LAS bf16_t*)(xcb + (t0 + i) * 144 + cch_ * 2) = f2bf(xc);
                x0 = x1; x1 = x2; x2 = x3;
            }
        }
        __syncthreads();
        if (tid < 24) *(LAS u32x4*)(lxs + tid * 8) = *(const LAS u32x4*)(lxs + 128 * 64 + tid * 8);
        {
            const bf16x8 af0 = *(const LAS bf16x8*)(xcb + (16 * w + l15) * 144 + (8 * g) * 2), af1 = *(const LAS bf16x8*)(xcb + (16 * w + l15) * 144 + (32 + 8 * g) * 2);
#pragma unroll
            for (int nb = 0; nb < 4; ++nb) {
                f32x4 ar = {0.f, 0.f, 0.f, 0.f}, ax = {0.f, 0.f, 0.f, 0.f};
                const LAS unsigned char* wr_ = wlds + (16 * nb + l15) * 144 + 16 * g;
                ar = mfma16(af0, *(const LAS bf16x8*)(wr_), ar); ar = mfma16(af1, *(const LAS bf16x8*)(wr_ + 64), ar);
                ax = mfma16(af0, wfx[nb][0], ax); ax = mfma16(af1, wfx[nb][1], ax);
#pragma unroll
                for (int rg = 0; rg < 4; ++rg) { rgt[(16 * w + 4 * g + rg) * 64 + 16 * nb + l15] = __builtin_amdgcn_rcpf(1.0f + __builtin_amdgcn_exp2f(ar[rg] + bia[nb])); igt[(16 * w + 4 * g + rg) * 64 + 16 * nb + l15] = __builtin_amdgcn_rcpf(1.0f + __builtin_amdgcn_exp2f(ax[rg] + bix[nb])); }
            }
        }
        __syncthreads();
        float av[16], bv[16]; float Aw = 1.0f, Hw = 0.0f;
#pragma unroll
        for (int tt = 0; tt < 16; ++tt) {
            const int t = 16 * w + tt;
            const float aa = __builtin_amdgcn_exp2f(cc * rgt[t * 64 + lane]);
            const float bb = __builtin_amdgcn_sqrtf(fmaxf(1.0f - aa * aa, 0.0f)) * igt[t * 64 + lane] * bf2f(*(const LAS bf16_t*)(xcb + t * 144 + lane * 2));
            av[tt] = aa; bv[tt] = bb; Hw = aa * Hw + bb; Aw *= aa;
        }
        wst[w * 64 + lane] = Aw; wst[512 + w * 64 + lane] = Hw;
        __syncthreads();
        float hcur = hcarry, hend = hcarry;
#pragma unroll
        for (int ww = 0; ww < 8; ++ww) { const float A_ = wst[ww * 64 + lane], H_ = wst[512 + ww * 64 + lane]; hend = A_ * hend + H_; if (ww < w) hcur = hend; }
        hcarry = hend;
        bf16_t* yb = (bf16_t*)(ws + WS_YB) + ((size_t)b * SEQ + c * 128 + 16 * w) * 1024 + gc;
#pragma unroll
        for (int tt = 0; tt < 16; tt += 2) {
            const float h0 = av[tt] * hcur + bv[tt]; hcur = av[tt + 1] * h0 + bv[tt + 1];
            const pg8::f32x2 gl = pg8::gelu_pk((pg8::f32x2){bf2f(lgs[(16 * w + tt) * 64 + lane]), bf2f(lgs[(16 * w + tt + 1) * 64 + lane])});
            yb[(size_t)tt * 1024] = f2bf(h0 * gl.x); yb[(size_t)(tt + 1) * 1024] = f2bf(hcur * gl.y);
        }
    }
    __syncthreads();
}

DI void retscan_unit(const Args& a, int unit) {
    unsigned char* ws = a.ws;
    const int e8 = unit * 512 + mk_tid();
    const int bh = e8 >> 13, within = e8 & 8191, h = bh & 3;
    const float g128 = exp2f(128.0f * log2gamma(h));
    bf16_t* base = (bf16_t*)(ws + WS_KVB) + (size_t)bh * 32 * 65536 + (size_t)within * 8;
    float st[8];
#pragma unroll
    for (int q = 0; q < 8; ++q) st[q] = 0.f;
#pragma unroll 1
    for (int c0 = 0; c0 < 32; c0 += 8) {
        u32x4 kv[8];
#pragma unroll
        for (int q = 0; q < 8; ++q) kv[q] = *(const u32x4*)(base + (size_t)(c0 + q) * 65536);
#pragma unroll
        for (int q = 0; q < 8; ++q) {
            u32x4 o;
#pragma unroll
            for (int j = 0; j < 4; ++j) o[j] = pk2(st[2 * j], st[2 * j + 1]);
            *(u32x4*)(base + (size_t)(c0 + q) * 65536) = o;
#pragma unroll
            for (int j = 0; j < 4; ++j) { st[2 * j] = g128 * st[2 * j] + bflo(kv[q][j]); st[2 * j + 1] = g128 * st[2 * j + 1] + bfhi(kv[q][j]); }
        }
    }
}

DI void attmerge_unit(const Args& a, int unit) {
    unsigned char* ws = a.ws;
    const int idx = unit * 512 + mk_tid(), t = idx >> 6, hp = (idx >> 4) & 3, dc = idx & 15;
    const float* lse = (const float*)(ws + WS_LSE) + (size_t)t * 12;
    const float l0 = lse[hp], l1 = lse[4 + hp], l2 = lse[8 + hp];
    const float m = fmaxf(l0, fmaxf(l1, l2));
    float w0 = __builtin_amdgcn_exp2f(l0 - m), w1 = __builtin_amdgcn_exp2f(l1 - m), w2 = __builtin_amdgcn_exp2f(l2 - m);
    const float is = 1.0f / (w0 + w1 + w2); w0 *= is; w1 *= is; w2 *= is;
    const bf16_t* o = (const bf16_t*)(ws + WS_OATT) + (size_t)t * 1536 + hp * 128 + dc * 8;
    const u32x4 a0 = *(const u32x4*)o, a1 = *(const u32x4*)(o + 512), a2 = *(const u32x4*)(o + 1024);
    u32x4 r;
#pragma unroll
    for (int q = 0; q < 4; ++q) r[q] = pk2(w0 * bflo(a0[q]) + w1 * bflo(a1[q]) + w2 * bflo(a2[q]), w0 * bfhi(a0[q]) + w1 * bfhi(a1[q]) + w2 * bfhi(a2[q]));
    *(u32x4*)((bf16_t*)(ws + WS_YA) + (size_t)t * 512 + hp * 128 + dc * 8) = r;
}

DI void retout_unit(const Args& a, int unit, LAS unsigned char* lds) {
    unsigned char* ws = a.ws;
    const int tid = mk_tid(), lane = tid & 63, w = __builtin_amdgcn_readfirstlane(tid >> 6), g = lane >> 4, l15 = lane & 15, tq4 = l15 >> 2, tp4 = l15 & 3;
    const int b = unit >> 7, h = (unit >> 5) & 3, c = unit & 31;
    const bf16_t* proj = (const bf16_t*)(ws + WS_PROJ) + ((size_t)b * SEQ + c * 128) * DIN;
    const bf16_t* rt = (const bf16_t*)(ws + WS_KVB) + ((size_t)((b * 4 + h) * 32 + c)) * 65536;
    LAS unsigned char* RA = lds; LAS unsigned char* RB = lds + 128 * 544;
    const float l2g = log2gamma(h);
    const int qi = 16 * w + l15;
    bf16x8 qf[8];
#pragma unroll
    for (int ks = 0; ks < 8; ++ks) qf[ks] = *(const bf16x8*)(proj + (size_t)qi * DIN + OFF_RQ + h * 256 + 32 * ks + 8 * g);
#pragma unroll
    for (int i = 0; i < 8; ++i) {
        const int idx = tid + 512 * i, row = idx >> 5, ch = idx & 31;
        *(LAS u32x4*)(RA + row * 544 + ch * 16) = *(const u32x4*)(proj + (size_t)row * DIN + OFF_RK + h * 256 + ch * 8);
        *(LAS u32x4*)(RB + row * 544 + ch * 16) = *(const u32x4*)(rt + (size_t)row * 256 + ch * 8);
    }
    __syncthreads();
    u32x4 pv[8], pr[8];
#pragma unroll
    for (int i = 0; i < 8; ++i) {
        const int idx = tid + 512 * i, row = idx >> 5, ch = idx & 31;
        pv[i] = *(const u32x4*)(proj + (size_t)row * DIN + OFF_RV + h * 256 + ch * 8);
        pr[i] = *(const u32x4*)(rt + (size_t)(128 + row) * 256 + ch * 8);
    }
    f32x4 sacc[8], oacc[16];
#pragma unroll
    for (int jj = 0; jj < 8; ++jj) {
        f32x4 acc = {0.f, 0.f, 0.f, 0.f};
        if (jj <= w) {
#pragma unroll
            for (int ks = 0; ks < 8; ++ks) { const bf16x8 kf = *(const LAS bf16x8*)(RA + (16 * jj + l15) * 544 + (32 * ks + 8 * g) * 2); acc = mfma16(kf, qf[ks], acc); }
        }
        sacc[jj] = acc;
    }
#pragma unroll
    for (int db = 0; db < 8; ++db) {
        f32x4 acc = {0.f, 0.f, 0.f, 0.f};
#pragma unroll
        for (int ks = 0; ks < 8; ++ks) { const bf16x8 rf = *(const LAS bf16x8*)(RB + (16 * db + l15) * 544 + (32 * ks + 8 * g) * 2); acc = mfma16(rf, qf[ks], acc); }
        oacc[db] = acc;
    }
    __syncthreads();
#pragma unroll
    for (int i = 0; i < 8; ++i) {
        const int idx = tid + 512 * i, row = idx >> 5, ch = idx & 31;
        *(LAS u32x4*)(RA + row * 544 + ch * 16) = pv[i];
        *(LAS u32x4*)(RB + row * 544 + ch * 16) = pr[i];
    }
    __syncthreads();
#pragma unroll
    for (int db = 0; db < 8; ++db) {
        f32x4 acc = {0.f, 0.f, 0.f, 0.f};
#pragma unroll
        for (int ks = 0; ks < 8; ++ks) { const bf16x8 rf = *(const LAS bf16x8*)(RB + (16 * db + l15) * 544 + (32 * ks + 8 * g) * 2); acc = mfma16(rf, qf[ks], acc); }
        oacc[8 + db] = acc;
    }
    const float xi = __builtin_amdgcn_exp2f((float)(qi + 1) * l2g);
#pragma unroll
    for (int db = 0; db < 16; ++db) oacc[db] = oacc[db] * xi;
#pragma unroll
    for (int jj = 0; jj < 8; ++jj)
#pragma unroll
        for (int rg = 0; rg < 4; ++rg) { const int j = 16 * jj + 4 * g + rg; sacc[jj][rg] = (qi >= j) ? sacc[jj][rg] * __builtin_amdgcn_exp2f((float)(qi - j) * l2g) : 0.f; }
#pragma unroll
    for (int s = 0; s < 4; ++s) {
        if (2 * s <= w) {
            u32x4 pw; pw.x = pk2(sacc[2 * s][0], sacc[2 * s][1]); pw.y = pk2(sacc[2 * s][2], sacc[2 * s][3]); pw.z = pk2(sacc[2 * s + 1][0], sacc[2 * s + 1][1]); pw.w = pk2(sacc[2 * s + 1][2], sacc[2 * s + 1][3]);
            const bf16x8 pb = __builtin_bit_cast(bf16x8, pw);
            const int k0 = 32 * s + 4 * g + tq4;
#pragma unroll
            for (int db = 0; db < 16; ++db) {
                const s16x4 lo = trrd(RA + k0 * 544 + (16 * db + 4 * tp4) * 2), hi = trrd(RA + (k0 + 16) * 544 + (16 * db + 4 * tp4) * 2);
                oacc[db] = mfma16(cat8(lo, hi), pb, oacc[db]);
            }
        }
    }
    float s1 = 0.f;
#pragma unroll
    for (int db = 0; db < 16; ++db) s1 += (oacc[db][0] + oacc[db][1]) + (oacc[db][2] + oacc[db][3]);
    s1 += __shfl_xor(s1, 16); s1 += __shfl_xor(s1, 32);
    const float mean = s1 * (1.0f / 256.0f);
    float s2 = 0.f;
#pragma unroll
    for (int db = 0; db < 16; ++db)
#pragma unroll
        for (int rg = 0; rg < 4; ++rg) { const float dd = oacc[db][rg] - mean; s2 += dd * dd; }
    s2 += __shfl_xor(s2, 16); s2 += __shfl_xor(s2, 32);
    const float rstd = rsqrtf(s2 * (1.0f / 256.0f) + LN_EPS);
    __syncthreads();
#pragma unroll
    for (int db = 0; db < 16; ++db) {
        u32x2 o; o.x = pk2((oacc[db][0] - mean) * rstd, (oacc[db][1] - mean) * rstd); o.y = pk2((oacc[db][2] - mean) * rstd, (oacc[db][3] - mean) * rstd);
        *(LAS u32x2*)(RA + qi * 528 + (16 * db + 4 * g) * 2) = o;
    }
    __syncthreads();
#pragma unroll
    for (int i = 0; i < 8; ++i) {
        const int idx = tid + 512 * i, row = idx >> 5, ch = idx & 31;
        const u32x4 nv = *(const LAS u32x4*)(RA + row * 528 + ch * 16);
        const u32x4 gw = *(const u32x4*)(proj + (size_t)row * DIN + OFF_RG + h * 256 + ch * 8);
        u32x4 o;
#pragma unroll
        for (int q = 0; q < 4; ++q) { const float g0 = bflo(gw[q]), g1 = bfhi(gw[q]); o[q] = pk2(g0 * sigm(g0) * bflo(nv[q]), g1 * sigm(g1) * bfhi(nv[q])); }
        *(u32x4*)((bf16_t*)(ws + WS_YC) + ((size_t)b * SEQ + c * 128 + row) * 1024 + h * 256 + ch * 8) = o;
    }
    __syncthreads();
}

struct EpiBranch {
    static constexpr bool PERM = false, AFTER_DRAIN = false;
    const bf16_t* gate; bf16_t* mf; bf16_t* mb; int mode;
    __device__ __forceinline__ void operator()(const f32x4 (&acc)[2][2][4][2], const pg8::Unit& u, int wr, int wc, int fr, int fq) const {
        const int row0 = u.pm * 256 + wr * 64 + fr, col0 = u.pn * 256 + wc * 32 + 4 * fq;
        bf16_t* dst = (mode == 2) ? mb : mf;
#pragma unroll
        for (int ai = 0; ai < 2; ++ai) {
            u32x2 gw[4][2][2], old[4][2][2];
#pragma unroll
            for (int m = 0; m < 4; ++m) { const size_t row = (size_t)(row0 + ai * 128 + m * 16);
#pragma unroll
                for (int bj = 0; bj < 2; ++bj)
#pragma unroll
                    for (int n = 0; n < 2; ++n) { const int col = col0 + bj * 128 + n * 16;
                        gw[m][bj][n] = *(const u32x2*)(gate + row * DIN + col);
                        old[m][bj][n] = (mode != 0) ? *(const u32x2*)(mf + row * 1024 + col) : (u32x2){0u, 0u}; } }
#pragma unroll
            for (int m = 0; m < 4; ++m) { const size_t row = (size_t)(row0 + ai * 128 + m * 16);
#pragma unroll
                for (int bj = 0; bj < 2; ++bj)
#pragma unroll
                    for (int n = 0; n < 2; ++n) { const int col = col0 + bj * 128 + n * 16;
                        const u32x2 g2 = gw[m][bj][n], o2 = old[m][bj][n];
                        f32x4 v = acc[ai][bj][m][n];
                        v[0] = v[0] * sigm(bflo(g2.x)) + bflo(o2.x); v[1] = v[1] * sigm(bfhi(g2.x)) + bfhi(o2.x);
                        v[2] = v[2] * sigm(bflo(g2.y)) + bflo(o2.y); v[3] = v[3] * sigm(bfhi(g2.y)) + bfhi(o2.y);
                        u32x2 o; o.x = pk2(v[0], v[1]); o.y = pk2(v[2], v[3]); *(u32x2*)(dst + row * 1024 + col) = o; } }
        }
    }
};
#ifndef MK_EPI_AUX
#define MK_EPI_AUX 0
#endif
struct EpiInProj {
    static constexpr bool PERM = true, AFTER_DRAIN = false;
    bf16_t* O;
    __device__ __forceinline__ void operator()(const f32x4 (&acc)[2][2][4][2], const pg8::Unit& u, int wr_, int wc_, int fr_, int fq_) const {
        (void)wr_; (void)wc_; (void)fr_; (void)fq_;
        const int tid = mk_tid(), wid = tid >> 6, lane = tid & 63, wr = wid >> 2, wc = wid & 3, fr = lane & 15, fq = lane >> 4;
        const __amdgpu_buffer_rsrc_t rsrc = __builtin_amdgcn_make_buffer_rsrc((void*)O, 0, (int)((size_t)NTOK * DIN * 2), 0x00020000);
        const int row0 = u.pm * 256 + wr * 64 + fr;
        const int pn = u.pn;
        const bool ropeA = pn < 12, ropeR = (pn >= 26 && pn < 34);
        const float dsc = 1.0f / (X8_SCALE * W8_SCALE);
        if (!(ropeA || ropeR)) {
            const int col0 = pn * 256 + 64 * wc + 8 * fq;
#pragma unroll
            for (int ai = 0; ai < 2; ++ai) {
#pragma unroll
                for (int m = 0; m < 4; ++m) { const unsigned roff = (unsigned)(((size_t)(row0 + ai * 128 + m * 16) * DIN + col0) * 2);
#pragma unroll
                    for (int bj = 0; bj < 2; ++bj) { const f32x4 v0 = acc[ai][bj][m][0] * dsc, v1 = acc[ai][bj][m][1] * dsc;
                        u32x4 w; w.x = pk2(v0[0], v0[1]); w.y = pk2(v0[2], v0[3]); w.z = pk2(v1[0], v1[1]); w.w = pk2(v1[2], v1[3]);
                        __builtin_amdgcn_raw_buffer_store_b128(w, rsrc, (int)(roff + bj * 64), 0, MK_EPI_AUX); } }
            }
        } else {
            const int half = ropeA ? 64 : 128;
            const float sc = (pn >= 30 && pn < 34) ? 0.0625f : 1.0f;
            const float kf = ropeA ? (-13.287712379549449f / 64.0f) : (-13.287712379549449f / 128.0f);
            const float pos0 = (float)(row0 & (SEQ - 1));
#pragma unroll
            for (int bj = 0; bj < 2; ++bj) {
                const int pc = 64 * wc + 32 * bj + 8 * fq;
                const int cbase = ropeA ? (pc & 128) : 0;
                const int q = ropeA ? ((pc & 127) >> 3) : (pc >> 3);
                f32x4 cb, sb, c16, s16, cb1, sb1;
#pragma unroll
                for (int e = 0; e < 4; ++e) {
                    const float f = __builtin_amdgcn_exp2f((float)(4 * q + e) * kf) * 0.15915494309189535f;
                    const float t0 = __builtin_amdgcn_fractf(pos0 * f), t16 = __builtin_amdgcn_fractf(16.0f * f), t128 = __builtin_amdgcn_fractf(128.0f * f);
                    cb[e] = __builtin_amdgcn_cosf(t0); sb[e] = __builtin_amdgcn_sinf(t0);
                    c16[e] = __builtin_amdgcn_cosf(t16); s16[e] = __builtin_amdgcn_sinf(t16);
                    const float c128 = __builtin_amdgcn_cosf(t128), s128 = __builtin_amdgcn_sinf(t128);
                    cb1[e] = cb[e] * c128 - sb[e] * s128; sb1[e] = sb[e] * c128 + cb[e] * s128;
                }
#pragma unroll
                for (int ai = 0; ai < 2; ++ai) {
                    f32x4 cv = ai ? cb1 : cb, sv = ai ? sb1 : sb;
#pragma unroll
                    for (int m = 0; m < 4; ++m) {
                        const int row = row0 + ai * 128 + m * 16;
                        const unsigned roff = (unsigned)(((size_t)row * DIN + pn * 256) * 2);
                        const float rsc = dsc * sc;
                        const f32x4 t1 = acc[ai][bj][m][0] * rsc, t2 = acc[ai][bj][m][1] * rsc;
                        const f32x4 o1 = t1 * cv - t2 * sv, o2 = t1 * sv + t2 * cv;
                        u32x2 w1, w2; w1.x = pk2(o1[0], o1[1]); w1.y = pk2(o1[2], o1[3]); w2.x = pk2(o2[0], o2[1]); w2.y = pk2(o2[2], o2[3]);
                        __builtin_amdgcn_raw_buffer_store_b64(w1, rsrc, (int)(roff + (cbase + 4 * q) * 2), 0, MK_EPI_AUX); __builtin_amdgcn_raw_buffer_store_b64(w2, rsrc, (int)(roff + (cbase + half + 4 * q) * 2), 0, MK_EPI_AUX);
                        if (m < 3) { const f32x4 cn = cv * c16 - sv * s16, sn = sv * c16 + cv * s16; cv = cn; sv = sn; }
                    }
                }
            }
        }
    }
};

struct EpiOut {
    static constexpr bool PERM = false, AFTER_DRAIN = false;
    const float* xf; float* z;
    __device__ __forceinline__ void operator()(const f32x4 (&acc)[2][2][4][2], const pg8::Unit& u, int wr, int wc, int fr, int fq) const {
        const int row0 = u.pm * 256 + wr * 64 + fr, col0 = u.pn * 256 + wc * 32 + 4 * fq;
#pragma unroll
        for (int ai = 0; ai < 2; ++ai) {
            f32x4 xv[4][2][2];
#pragma unroll
            for (int m = 0; m < 4; ++m) { const size_t row = (size_t)(row0 + ai * 128 + m * 16);
#pragma unroll
                for (int bj = 0; bj < 2; ++bj)
#pragma unroll
                    for (int n = 0; n < 2; ++n) xv[m][bj][n] = *(const f32x4*)(xf + row * 1024 + col0 + bj * 128 + n * 16); }
#pragma unroll
            for (int m = 0; m < 4; ++m) { const size_t row = (size_t)(row0 + ai * 128 + m * 16);
#pragma unroll
                for (int bj = 0; bj < 2; ++bj)
#pragma unroll
                    for (int n = 0; n < 2; ++n) *(f32x4*)(z + row * 1024 + col0 + bj * 128 + n * 16) = xv[m][bj][n] * ALPHA + acc[ai][bj][m][n]; }
        }
    }
};

DI void ln_row(const float* z, const float* gam, const float* bet, float* of, bf16_t* ob, int lane) {
    f32x4 v[4]; float s = 0.f;
#pragma unroll
    for (int i = 0; i < 4; ++i) { v[i] = *(const f32x4*)(z + 256 * i + 4 * lane); s += (v[i][0] + v[i][1]) + (v[i][2] + v[i][3]); }
    const float mean = wsum(s) * (1.0f / 1024.0f);
    float q = 0.f;
#pragma unroll
    for (int i = 0; i < 4; ++i)
#pragma unroll
        for (int j = 0; j < 4; ++j) { const float d = v[i][j] - mean; q += d * d; }
    const float rstd = rsqrtf(wsum(q) * (1.0f / 1024.0f) + LN_EPS);
#pragma unroll
    for (int i = 0; i < 4; ++i) {
        const f32x4 gg = *(const f32x4*)(gam + 256 * i + 4 * lane), bb = *(const f32x4*)(bet + 256 * i + 4 * lane);
        f32x4 o;
#pragma unroll
        for (int j = 0; j < 4; ++j) o[j] = (v[i][j] - mean) * rstd * gg[j] + bb[j];
        *(f32x4*)(of + 256 * i + 4 * lane) = o;
        u32x2 pb; pb.x = pk2(o[0], o[1]); pb.y = pk2(o[2], o[3]); *(u32x2*)(ob + 256 * i + 4 * lane) = pb;
    }
}
DI void phase_ln1(const Args& a, int layer) {
    unsigned char* ws = a.ws;
    const int lane = mk_tid() & 63, w = mk_tid() >> 6;
    for (int u = blockIdx.x; u < NTOK / 8; u += gridDim.x) {
        const size_t row = (size_t)u * 8 + w;
        ln_row((const float*)(ws + WS_MRGF) + row * 1024, a.in[11] + layer * 1024, a.in[12] + layer * 1024, (float*)(ws + WS_XF) + row * 1024, (bf16_t*)(ws + WS_XB) + row * 1024, lane);
    }
}

DI void ins16(float (&L)[16], float x) {
#pragma unroll
    for (int k = 0; k < 16; ++k) { const float hi = fmaxf(L[k], x); x = fminf(L[k], x); L[k] = hi; }
}
DI void merge16(float (&L)[16], int xr) {
    float t[16];
#pragma unroll
    for (int k = 0; k < 16; ++k) t[k] = __shfl_xor(L[k], xr);
#pragma unroll
    for (int k = 0; k < 8; ++k) { const float x = t[k]; t[k] = t[15 - k]; t[15 - k] = x; }
#pragma unroll
    for (int k = 0; k < 16; ++k) t[k] = fmaxf(L[k], t[k]);
#define MK_CE_STAGE(dd) _Pragma("unroll") for (int k = 0; k < 16; ++k) if ((k & (dd)) == 0) { const float hi = fmaxf(t[k], t[k + (dd)]), lo = fminf(t[k], t[k + (dd)]); t[k] = hi; t[k + (dd)] = lo; }
    MK_CE_STAGE(8) MK_CE_STAGE(4) MK_CE_STAGE(2) MK_CE_STAGE(1)
#undef MK_CE_STAGE
#pragma unroll
    for (int k = 0; k < 16; ++k) L[k] = t[k];
}
#define MK_CE_DESC(v, i, l) { const float hi_ = fmaxf(v[i], v[l]), lo_ = fminf(v[i], v[l]); v[i] = hi_; v[l] = lo_; }
#define MK_CE_ASC(v, i, l)  { const float hi_ = fmaxf(v[i], v[l]), lo_ = fminf(v[i], v[l]); v[i] = lo_; v[l] = hi_; }
#define MK_BITONIC_STAGE(v, kk, jj) _Pragma("unroll") for (int i_ = 0; i_ < 16; ++i_) { if ((i_ & (jj)) == 0) { if ((i_ & (kk)) == 0) MK_CE_DESC(v, i_, i_ + (jj)) else MK_CE_ASC(v, i_, i_ + (jj)) } }
DI void sort16_desc(float (&v)[16]) {
    MK_BITONIC_STAGE(v, 2, 1)
    MK_BITONIC_STAGE(v, 4, 2) MK_BITONIC_STAGE(v, 4, 1)
    MK_BITONIC_STAGE(v, 8, 4) MK_BITONIC_STAGE(v, 8, 2) MK_BITONIC_STAGE(v, 8, 1)
    MK_BITONIC_STAGE(v, 16, 8) MK_BITONIC_STAGE(v, 16, 4) MK_BITONIC_STAGE(v, 16, 2) MK_BITONIC_STAGE(v, 16, 1)
}
DI void top16_of_two(float (&a)[16], const float (&b)[16]) {
#pragma unroll
    for (int k = 0; k < 16; ++k) a[k] = fmaxf(a[k], b[15 - k]);
    MK_BITONIC_STAGE(a, 16, 8) MK_BITONIC_STAGE(a, 16, 4) MK_BITONIC_STAGE(a, 16, 2) MK_BITONIC_STAGE(a, 16, 1)
}
DI void top16_half(const bf16_t* qp, const LAS unsigned char* kt, float (&L)[16], int g, int l15) {
    bf16x8 qf[4];
#pragma unroll
    for (int ks = 0; ks < 4; ++ks) qf[ks] = *(const bf16x8*)(qp + 32 * ks + 8 * g);
    float M[16];
#pragma unroll
    for (int kbk = 0; kbk < 8; ++kbk) {
        f32x4 acc = {0.f, 0.f, 0.f, 0.f};
#pragma unroll
        for (int ks = 0; ks < 4; ++ks) { const bf16x8 kf = *(const LAS bf16x8*)(kt + (16 * kbk + l15) * 256 + (((4 * ks + g) ^ l15) << 4)); acc = mfma16(kf, qf[ks], acc); }
#pragma unroll
        for (int rg = 0; rg < 4; ++rg) { const unsigned key = (unsigned)(16 * kbk + 4 * g + rg); const float x = __uint_as_float((__float_as_uint(acc[rg]) & ~0x7Fu) | key);
            if (kbk < 4) L[4 * kbk + rg] = x; else M[4 * (kbk - 4) + rg] = x; }
    }
    sort16_desc(L); sort16_desc(M); top16_of_two(L, M);
    merge16(L, 16); merge16(L, 32);
}
DI void topk_unit(const Args& a, int unit, LAS unsigned char* lds) {
    unsigned char* ws = a.ws;
    const int tid = mk_tid(), lane = tid & 63, w = __builtin_amdgcn_readfirstlane(tid >> 6), g = lane >> 4, l15 = lane & 15;
    const int tg = w & 3, hs = w >> 2;
    const size_t t = (size_t)unit * 64 + tg * 16 + l15;
    const bf16_t* Q = (const bf16_t*)(ws + WS_Q);
    LAS unsigned char* tiles = lds + 16384;
    float K1[16], K2[16];
#pragma unroll
    for (int k = 0; k < 16; ++k) { K1[k] = 0.f; K2[k] = 0.f; }
#pragma unroll 1
    for (int hh = 0; hh < 4; ++hh) {
#pragma unroll
        for (int i = 0; i < 16; ++i) {
            const int idx = tid + 512 * i, tile = idx >> 11, row = (idx >> 4) & 127, ch = idx & 15;
            const int hd = ((tile >> 1) ? 4 : 0) + hh;
            const bf16_t* src = (const bf16_t*)(ws + ((tile & 1) ? WS_K2B : WS_K1B)) + ((size_t)hd * 128 + row) * 128 + ch * 8;
            *(LAS u32x4*)(tiles + tile * 32768 + row * 256 + ((ch ^ (row & 15)) << 4)) = *(const u32x4*)src;
        }
        __syncthreads();
        const int h = hs * 4 + hh;
        float l1[16], l2[16];
        top16_half(Q + t * 2048 + h * 256, tiles + (hs * 2) * 32768, l1, g, l15);
        top16_half(Q + t * 2048 + h * 256 + 128, tiles + (hs * 2 + 1) * 32768, l2, g, l15);
        const bool mine = (g == hh);
#pragma unroll
        for (int k = 0; k < 16; ++k) { K1[k] = mine ? l1[k] : K1[k]; K2[k] = mine ? l2[k] : K2[k]; }
        __syncthreads();
    }
    const int h = hs * 4 + g;
    float F[16];
#pragma unroll
    for (int k = 0; k < 16; ++k) F[k] = -FLT_MAX;
#pragma unroll
    for (int ia = 0; ia < 16; ++ia)
#pragma unroll
        for (int ib = 0; ib < 16 / (ia + 1); ++ib) {
            const float s = __uint_as_float(__float_as_uint(K1[ia]) & ~0x7Fu) + __uint_as_float(__float_as_uint(K2[ib]) & ~0x7Fu);
            ins16(F, __uint_as_float((__float_as_uint(s) & ~0xFFu) | (unsigned)(ia * 16 + ib)));
        }
    LAS unsigned char* row = lds + tid * 32;
#pragma unroll
    for (int k = 0; k < 16; ++k) { row[k] = (unsigned char)(__float_as_uint(K1[k]) & 0x7Fu); row[16 + k] = (unsigned char)(__float_as_uint(K2[k]) & 0x7Fu); }
    float gt[16]; int ei[16]; float gs = 0.f;
    const float cv0 = __uint_as_float(__float_as_uint(F[0]) & ~0xFFu);
#pragma unroll
    for (int k = 0; k < 16; ++k) {
        const unsigned bits = __float_as_uint(F[k]);
        const float cv = __uint_as_float(bits & ~0xFFu);
        gt[k] = __builtin_amdgcn_exp2f((cv - cv0) * 1.4426950408889634f); gs += gt[k];
        const int ia = (int)((bits >> 4) & 15u), ib = (int)(bits & 15u);
        ei[k] = (int)row[ia] * 128 + (int)row[16 + ib];
    }
    const float ig = 1.0f / gs;
    int* ep = (int*)(ws + WS_EID) + (t * 8 + h) * 16; float* gp = (float*)(ws + WS_GATE) + (t * 8 + h) * 16;
#pragma unroll
    for (int q = 0; q < 4; ++q) {
        *(i32x4*)(ep + 4 * q) = (i32x4){ei[4 * q], ei[4 * q + 1], ei[4 * q + 2], ei[4 * q + 3]};
        *(f32x4*)(gp + 4 * q) = (f32x4){gt[4 * q] * ig, gt[4 * q + 1] * ig, gt[4 * q + 2] * ig, gt[4 * q + 3] * ig};
    }
    __syncthreads();
}

typedef float f32x2 __attribute__((ext_vector_type(2)));
typedef __bf16 bf16x32 __attribute__((ext_vector_type(32)));
typedef unsigned u32x16 __attribute__((ext_vector_type(16)));
#define MK_PB_LOAD(RA_, RB_, ereg, kb) _Pragma("unroll") for (int j = 0; j < 8; ++j) { const int e_ = __builtin_amdgcn_readlane(ereg, (kb) + j); \
        const unsigned char* p_ = UV + (size_t)(unsigned)e_ * 1536u; RA_[j] = ((const u32x4*)p_)[lane]; RB_[j] = ((const u32x2*)(p_ + 1024))[lane]; }
#define MK_PB_COMP(RA_, RB_, usreg, gvreg, kb) { \
        float pp_[8]; \
        _Pragma("unroll") for (int j = 0; j < 8; ++j) { \
            const u32x16 hw_ = __builtin_bit_cast(u32x16, __builtin_amdgcn_cvt_scalef32_pk32_bf16_fp6((u32x6){RA_[j][0], RA_[j][1], RA_[j][2], RA_[j][3], RB_[j][0], RB_[j][1]}, 1.0f)); \
            float s0_ = 0.f, s1_ = 0.f; \
            _Pragma("unroll") for (int q = 0; q < 4; ++q) { s0_ = dot2(hw_[2 * q], xpk[2 * q], s0_); s1_ = dot2(hw_[2 * q + 1], xpk[2 * q + 1], s1_); } \
            pp_[j] = s0_ + s1_; } \
        float q4_[4], r2_[2]; \
        _Pragma("unroll") for (int i = 0; i < 4; ++i) { const float keep_ = hi32 ? pp_[4 + i] : pp_[i], send_ = hi32 ? pp_[i] : pp_[4 + i]; q4_[i] = keep_ + __shfl_xor(send_, 32); } \
        _Pragma("unroll") for (int i = 0; i < 2; ++i) { const float keep_ = hi16 ? q4_[2 + i] : q4_[i], send_ = hi16 ? q4_[i] : q4_[2 + i]; r2_[i] = keep_ + __shfl_xor(send_, 16); } \
        float tot_ = (hi8 ? r2_[1] : r2_[0]) + __shfl_xor(hi8 ? r2_[0] : r2_[1], 8); \
        tot_ += __shfl_xor(tot_, 4); tot_ += __shfl_xor(tot_, 2); tot_ += __shfl_xor(tot_, 1); \
        const float act_ = gelu_as(tot_ * __shfl(usreg, (kb) + jj)) * __shfl(gvreg, (kb) + jj); \
        _Pragma("unroll") for (int j = 0; j < 8; ++j) { \
            const float aj_ = __uint_as_float(__builtin_amdgcn_readlane(__float_as_uint(act_), 32 * (j >> 2) + 16 * ((j >> 1) & 1) + 8 * (j & 1))); const f32x2 a2_ = {aj_, aj_}; \
            const f32x32 f_ = __builtin_amdgcn_cvt_scalef32_pk32_f32_fp6((u32x6){RA_[j][0], RA_[j][1], RA_[j][2], RA_[j][3], RB_[j][0], RB_[j][1]}, 1.0f); \
            _Pragma("unroll") for (int q = 0; q < 8; ++q) y2[q] += a2_ * (f32x2){f_[16 + 2 * q], f_[16 + 2 * q + 1]}; } }
DI void peer_token(const unsigned char* UV, int e0, int e1, float us0, float us1, float gv0, float gv1, const unsigned (&xpk)[8], f32x2 (&y2)[8], int lane) {
    const bool hi32 = (lane & 32) != 0, hi16 = (lane & 16) != 0, hi8 = (lane & 8) != 0;
    const int jj = ((lane >> 5) & 1) * 4 + ((lane >> 4) & 1) * 2 + ((lane >> 3) & 1);
    u32x4 A0[8], A1[8]; u32x2 B0[8], B1[8];
    MK_PB_LOAD(A0, B0, e0, 0)
#pragma unroll 1
    for (int b = 0; b < 8; b += 2) {
        MK_PB_LOAD(A1, B1, e0, 8 * b + 8)
        MK_PB_COMP(A0, B0, us0, gv0, 8 * b)
        if (b + 2 < 8) { MK_PB_LOAD(A0, B0, e0, 8 * b + 16) } else { MK_PB_LOAD(A0, B0, e1, 0) }
        MK_PB_COMP(A1, B1, us0, gv0, 8 * b + 8)
    }
#pragma unroll 1
    for (int b = 0; b < 8; b += 2) {
        MK_PB_LOAD(A1, B1, e1, 8 * b + 8)
        MK_PB_COMP(A0, B0, us1, gv1, 8 * b)
        if (b + 2 < 8) { MK_PB_LOAD(A0, B0, e1, 8 * b + 16) }
        MK_PB_COMP(A1, B1, us1, gv1, 8 * b + 8)
    }
}
DI void peer_unit(const Args& a, int layer, int unit) {
    unsigned char* ws = a.ws;
    const int tid = mk_tid(), lane = tid & 63, w = __builtin_amdgcn_readfirstlane(tid >> 6);
    const unsigned char* UV = ws + WS_UV8; const float* SC = (const float*)(ws + WS_UVS);
#pragma unroll 1
    for (int i = 0; i < 8; ++i) {
        const size_t t = (size_t)unit * 64 + w * 8 + i;
        unsigned xpk[8]; f32x2 y2[8];
        int e0, e1; float us0, us1, gv0, gv1;
        {
            const int ln = mk_tid() & 63;
            const bf16_t* xbp = (const bf16_t*)(ws + WS_XB) + t * 1024 + 16 * ln;
            const u32x4 xa = *(const u32x4*)xbp, xb = *(const u32x4*)(xbp + 8);
#pragma unroll
            for (int q = 0; q < 4; ++q) { xpk[q] = xa[q]; xpk[4 + q] = xb[q]; }
            const int* ep = (const int*)(ws + WS_EID) + t * 128; const float* gp = (const float*)(ws + WS_GATE) + t * 128;
            e0 = ep[ln]; e1 = ep[64 + ln]; const float g0 = gp[ln], g1 = gp[64 + ln];
            const f32x2 s0 = *(const f32x2*)(SC + 2 * e0), s1 = *(const f32x2*)(SC + 2 * e1);
            us0 = s0.x; us1 = s1.x; gv0 = g0 * s0.y; gv1 = g1 * s1.y;
        }
#pragma unroll
        for (int q = 0; q < 8; ++q) y2[q] = (f32x2){0.f, 0.f};
        peer_token(UV, e0, e1, us0, us1, gv0, gv1, xpk, y2, lane);
        {
            const int ln = mk_tid() & 63;
            float* xfp = (float*)(ws + WS_XF) + t * 1024 + 16 * ln;
            const float* gam = a.in[18] + layer * 1024 + 16 * ln; const float* bet = a.in[19] + layer * 1024 + 16 * ln;
            float z[16]; float s = 0.f;
#pragma unroll
            for (int q = 0; q < 4; ++q) { const f32x4 xr = *(const f32x4*)(xfp + 4 * q);
#pragma unroll
                for (int j = 0; j < 4; ++j) { z[4 * q + j] = ALPHA * xr[j] + y2[2 * q + (j >> 1)][j & 1]; s += z[4 * q + j]; } }
            const float mean = wsum(s) * (1.0f / 1024.0f);
            float qq = 0.f;
#pragma unroll
            for (int q = 0; q < 16; ++q) { const float d = z[q] - mean; qq += d * d; }
            const float rstd = rsqrtf(wsum(qq) * (1.0f / 1024.0f) + LN_EPS);
            f32x4 o[4];
#pragma unroll
            for (int q = 0; q < 4; ++q) { const f32x4 gq = *(const f32x4*)(gam + 4 * q), bq = *(const f32x4*)(bet + 4 * q);
#pragma unroll
                for (int j = 0; j < 4; ++j) o[q][j] = (z[4 * q + j] - mean) * rstd * gq[j] + bq[j]; }
#pragma unroll
            for (int q = 0; q < 4; ++q) *(f32x4*)(xfp + 4 * q) = o[q];
            if (layer == DEPTH - 1) { float* op = a.out + t * 1024 + 16 * ln;
#pragma unroll
                for (int q = 0; q < 4; ++q) *(f32x4*)(op + 4 * q) = o[q]; }
            row_to_fp8(o, ws + WS_X8 + t * 1024, ln);
        }
    }
}
}

namespace mk {
constexpr int LDS_ARG_OFF = LDS_BYTES - 16 - 256;
#define MK_NOINL __device__ __forceinline__
DI unsigned long long rfl64(unsigned long long v) { const unsigned lo = __builtin_amdgcn_readfirstlane((unsigned)v), hi = __builtin_amdgcn_readfirstlane((unsigned)(v >> 32)); return ((unsigned long long)hi << 32) | lo; }
DI Args load_args(LAS unsigned char* lds) {
    int aoff = LDS_ARG_OFF; asm volatile("" : "+s"(aoff));
    Args a; const LAS unsigned long long* p = (const LAS unsigned long long*)(lds + aoff);
#pragma unroll
    for (int i = 0; i < 20; ++i) a.in[i] = (const float*)(const __attribute__((address_space(1))) float*)rfl64(p[i]);
    a.out = (float*)(__attribute__((address_space(1))) float*)rfl64(p[20]); a.ws = (unsigned char*)(__attribute__((address_space(1))) unsigned char*)rfl64(p[21]);
    a.ropeA = __longlong_as_double((long long)rfl64(p[22])); a.ropeR = __longlong_as_double((long long)rfl64(p[23])); a.ph_lo = 0; a.ph_hi = 0;
    return a;
}
#define MK_LOADARGS const Args a = load_args(lds); unsigned char* ws = a.ws; const int G = (int)gridDim.x, bid = (int)blockIdx.x; (void)ws; (void)G; (void)bid
MK_NOINL void PG_prologue(LAS unsigned char* lds) { MK_LOADARGS; phase_prologue(a); }
MK_NOINL void P0_conv(LAS unsigned char* lds, int layer) { MK_LOADARGS; phase_conv(a, layer, lds); }
#ifndef MK_STAGGER_TICKS
#define MK_STAGGER_TICKS 140
#endif
MK_NOINL void P1_inproj(LAS unsigned char* lds, int layer) { MK_LOADARGS; (void)layer;
    pg8::Gemm gm; gm.A = (const bf16_t*)(ws + WS_X8); gm.Bt = (const bf16_t*)(ws + WS_WINT); gm.M = NTOK; gm.N = DIN; gm.K = 512;
    pg8::StaticOrder S; S.init(NTOK, DIN, G, bid);
    EpiInProj E; E.O = (bf16_t*)(ws + WS_PROJ);
    pg8::gemm_phase<EpiInProj, pg8::StaticOrder, false, true, true>(lds, gm, S, E, nullptr); }
#ifndef MK_NLRU
#define MK_NLRU 64
#endif
MK_NOINL void P3s_lru(LAS unsigned char* lds, int layer) { MK_LOADARGS; if (bid < MK_NLRU) { for (int s = bid; s < 64; s += MK_NLRU) lru_stripe(a, layer, s, lds); } }
MK_NOINL void P3a_attn(LAS unsigned char* lds, int layer) { MK_LOADARGS; (void)layer; if (bid >= MK_NLRU) { for (int u = bid - MK_NLRU; u < 1536; u += G - MK_NLRU) attn_unit(a, u, lds); } }
MK_NOINL void P3b_retkv(LAS unsigned char* lds, int layer) { MK_LOADARGS; (void)layer; if (bid >= MK_NLRU) { for (int u = bid - MK_NLRU; u < 512; u += G - MK_NLRU) retkv_unit(a, u, lds); } }
MK_NOINL void P4a_scan(LAS unsigned char* lds, int layer) { MK_LOADARGS; (void)layer; for (int u = bid; u < 256; u += G) retscan_unit(a, u); }
MK_NOINL void P4c_merge(LAS unsigned char* lds, int layer) { MK_LOADARGS; (void)layer; for (int u = bid; u < 2048; u += G) attmerge_unit(a, u); }
MK_NOINL void P5_retout(LAS unsigned char* lds, int layer) { MK_LOADARGS; (void)layer; for (int u = bid; u < 512; u += G) retout_unit(a, u, lds); }
MK_NOINL void P6_branch(LAS unsigned char* lds, int layer) { MK_LOADARGS; (void)layer;
#pragma unroll 1
    for (int s = 0; s < 3; ++s) {
        pg8::Gemm gm; gm.A = (const bf16_t*)(ws + (s == 0 ? WS_YA : (s == 1 ? WS_YB : WS_YC))); gm.Bt = (const bf16_t*)(ws + (s == 0 ? WS_WBAT : (s == 1 ? WS_WBBT : WS_WBCT)));
        gm.M = NTOK; gm.N = 1024; gm.K = (s == 0) ? 512 : 1024;
        pg8::StaticOrder S; S.init(NTOK, 1024, G, bid);
        EpiBranch E; E.gate = (const bf16_t*)(ws + WS_PROJ) + OFF_GA + 1024 * s; E.mf = (bf16_t*)(ws + WS_MRGF); E.mb = (bf16_t*)(ws + WS_MRGB); E.mode = s;
        pg8::gemm_phase<EpiBranch, pg8::StaticOrder, false>(lds, gm, S, E, nullptr);
    } }
MK_NOINL void P7_outproj(LAS unsigned char* lds, int layer) { MK_LOADARGS; (void)layer;
    pg8::Gemm gm; gm.A = (const bf16_t*)(ws + WS_MRGB); gm.Bt = (const bf16_t*)(ws + WS_WOT); gm.M = NTOK; gm.N = 1024; gm.K = 1024;
    pg8::StaticOrder S; S.init(NTOK, 1024, G, bid);
    EpiOut E; E.xf = (const float*)(ws + WS_XF); E.z = (float*)(ws + WS_MRGF);
    pg8::gemm_phase<EpiOut, pg8::StaticOrder, false>(lds, gm, S, E, nullptr); }
MK_NOINL void P8_ln1(LAS unsigned char* lds, int layer) { MK_LOADARGS; phase_ln1(a, layer); }
MK_NOINL void P9_wq(LAS unsigned char* lds, int layer) { MK_LOADARGS; (void)layer;
    pg8::Gemm gm; gm.A = (const bf16_t*)(ws + WS_XB); gm.Bt = (const bf16_t*)(ws + WS_WQT); gm.M = NTOK; gm.N = 2048; gm.K = 1024;
    pg8::StaticOrder S; S.init(NTOK, 2048, G, bid);
    pg8::EpiBf16<0> E; E.O = (bf16_t*)(ws + WS_Q); E.ldc = 2048; E.bias = nullptr; E.split_cols = 0; E.split_stride = 0;
    pg8::gemm_phase<pg8::EpiBf16<0>, pg8::StaticOrder, false>(lds, gm, S, E, nullptr); }
MK_NOINL void P10_topk(LAS unsigned char* lds, int layer) { MK_LOADARGS; (void)layer; for (int u = bid; u < NTOK / 64; u += G) topk_unit(a, u, lds); }
MK_NOINL void P11_peer(LAS unsigned char* lds, int layer) { MK_LOADARGS; for (int u = bid; u < NTOK / 64; u += G) peer_unit(a, layer, u); }
DI void mk_sync(LAS unsigned char* lds) {
    const Args a = load_args(lds);
    XcdBarrier b; b.bar = (unsigned*)(a.ws + WS_CTL); b.x = xb_xcc_id(); b.st = (volatile LAS unsigned*)(lds + LDS_BAR_OFF);
    xcd_barrier(b);
}
}

#ifndef MK_PHASE_MASK
#define MK_PHASE_MASK 0xFFFu
#endif
#define MK_RUN(k) ((((MK_PHASE_MASK) >> ((k) - pb)) & 1u) && (k) >= ph_lo && (k) < ph_hi)
#define MK_NPHASES (1 + mk::DEPTH * mk::NPH)

#define MK_SYNC(k) do { if ((k) >= ph_lo && (k) + 1 < ph_hi) mk::mk_sync(lds); } while (0)
__global__ __launch_bounds__(512, 2) void mk_fwd(mk::Args a) {
    using namespace mk;
    extern __shared__ __attribute__((aligned(16))) unsigned char smem_raw[];
    LAS unsigned char* lds = (LAS unsigned char*)smem_raw;
    const int ph_lo = a.ph_lo, ph_hi = a.ph_hi;
    {
        const unsigned* src = (const unsigned*)&a;
        if (threadIdx.x < sizeof(Args) / 4) ((LAS unsigned*)(lds + LDS_ARG_OFF))[threadIdx.x] = src[threadIdx.x];
        if (threadIdx.x == 0) { LAS unsigned* st = (LAS unsigned*)(lds + LDS_BAR_OFF); st[0] = 0u; st[1] = 0u; st[2] = 0u; st[3] = 0u; }
    }
    __syncthreads();
    if (ph_hi - ph_lo > 1) (void)xcd_barrier_post((unsigned*)(a.ws + WS_CTL), (volatile LAS unsigned*)(lds + LDS_BAR_OFF));
    if (0 >= ph_lo && 0 < ph_hi) PG_prologue(lds);
    MK_SYNC(0);
#pragma unroll 1
    for (int layer = 0; layer < DEPTH; ++layer) {
        const int pb = 1 + layer * NPH;
        if (MK_RUN(pb + 0)) P0_conv(lds, layer);
        MK_SYNC(pb + 0);
        if (MK_RUN(pb + 1)) P1_inproj(lds, layer);
        MK_SYNC(pb + 1);
        if (MK_RUN(pb + 3)) { P3s_lru(lds, layer); P3a_attn(lds, layer); P3b_retkv(lds, layer); }
        MK_SYNC(pb + 3);
        if (MK_RUN(pb + 4)) { P4a_scan(lds, layer); P4c_merge(lds, layer); }
        MK_SYNC(pb + 4);
        if (MK_RUN(pb + 5)) P5_retout(lds, layer);
        MK_SYNC(pb + 5);
        if (MK_RUN(pb + 6)) P6_branch(lds, layer);
        MK_SYNC(pb + 6);
        if (MK_RUN(pb + 7)) P7_outproj(lds, layer);
        MK_SYNC(pb + 7);
        if (MK_RUN(pb + 8)) P8_ln1(lds, layer);
        MK_SYNC(pb + 8);
        if (MK_RUN(pb + 9)) P9_wq(lds, layer);
        MK_SYNC(pb + 9);
        if (MK_RUN(pb + 10)) P10_topk(lds, layer);
        MK_SYNC(pb + 10);
        if (MK_RUN(pb + 11)) P11_peer(lds, layer);
        MK_SYNC(pb + 11);
    }
}

#ifndef MK_SINGLE
#define MK_SINGLE 1
#endif
extern "C" void kernel_launch(void* const* d_in, const int* in_sizes, int n_in, void* d_out, int out_size, void* d_ws, size_t ws_size, hipStream_t stream) {
    using namespace mk;
    static int grid = 0;
    if (grid == 0) {
        if (n_in != 20 || out_size != NTOK * D || ws_size < WS_END) { fprintf(stderr, "kernel_launch: unexpected shapes (n_in %d, out %d, ws %zu, need %zu)\n", n_in, out_size, ws_size, (size_t)WS_END); grid = -1; return; }
        int dev = 0, cus = 0, per_cu = 0;
        if (hipGetDevice(&dev) != hipSuccess || hipDeviceGetAttribute(&cus, hipDeviceAttributeMultiprocessorCount, dev) != hipSuccess) { grid = -1; return; }
        if (hipFuncSetAttribute((const void*)mk_fwd, hipFuncAttributeMaxDynamicSharedMemorySize, LDS_BYTES) != hipSuccess) { fprintf(stderr, "kernel_launch: hipFuncSetAttribute failed\n"); grid = -1; return; }
        if (hipOccupancyMaxActiveBlocksPerMultiprocessor(&per_cu, (const void*)mk_fwd, 512, LDS_BYTES) != hipSuccess || per_cu < 1) { fprintf(stderr, "kernel_launch: occupancy query says %d blocks per CU\n", per_cu); (void)hipGetLastError(); grid = -1; return; }
        grid = cus;
    }
    if (grid < 0) return;
    (void)in_sizes;
    Args a{};
    for (int i = 0; i < 20; ++i) a.in[i] = (const float*)d_in[i];
    a.out = (float*)d_out; a.ws = (unsigned char*)d_ws;
    a.ropeA = pow(10000.0, -2.0 / 128.0); a.ropeR = pow(10000.0, -2.0 / 256.0);
#if MK_SINGLE
    (void)hipMemsetAsync((unsigned char*)d_ws + WS_CTL, 0, 16384, stream);
    a.ph_lo = 0; a.ph_hi = MK_NPHASES;
    hipLaunchKernelGGL(mk_fwd, dim3(grid), dim3(512), LDS_BYTES, stream, a);
#else
    for (int p = 0; p < MK_NPHASES; ++p) { a.ph_lo = p; a.ph_hi = p + 1; hipLaunchKernelGGL(mk_fwd, dim3(grid), dim3(512), LDS_BYTES, stream, a); }
#endif
}
```

```cpp
#include <hip/hip_runtime.h>
#include <cstdio>
#include <cstdint>
#include <cmath>
#include <cfloat>
__device__ __forceinline__ int mk_tid() { int t = (int)threadIdx.x; asm volatile("" : "+v"(t)); return t; }
namespace pg8 {
#define PG8_LAS __attribute__((address_space(3)))
typedef unsigned short bf16_t;
typedef short bf16x8 __attribute__((ext_vector_type(8)));
typedef float f32x4 __attribute__((ext_vector_type(4)));
typedef unsigned u32x4 __attribute__((ext_vector_type(4)));
constexpr int BM = 256, BK = 64, HALF = 128, HTB = HALF * BK * 2  , STAGE_BYTES = 8 * HTB, NXCD = 8, WGM = 8;

__host__ __device__ __forceinline__ int lds_byte(int r, int c) { const int st = (r >> 4) * 2 + (c >> 5), rr = r & 15, cc = c & 31, ob = rr * 64 + cc * 2; return st * 1024 + (ob ^ (((ob >> 9) & 1) << 5)); }
__host__ __device__ __forceinline__ void stage_rc(int b, int& R, int& C) { const int st = b / 1024, sb = b % 1024, swz = sb ^ (((sb >> 9) & 1) << 5); R = (st >> 1) * 16 + swz / 64; C = (st & 1) * 32 + (swz % 64) / 2; }
__host__ __device__ __forceinline__ int perm32(int rho) { const int n = rho >> 4, i = rho & 15; return 8 * (i >> 2) + 4 * n + (i & 3); }

struct Unit { int pm, pn; };
struct Gemm { const bf16_t* A; const bf16_t* Bt; int M, N, K; };

struct StaticOrder {
    int nM, nN, nwg, G, c;
    __host__ __device__ void init(int M, int N, int G_, int c_) { nM = M / BM; nN = N / BM; nwg = nM * nN; G = G_; c = c_; }
    __host__ __device__ bool next(int i, Unit& u) const {
        const long L = (long)i * G + c; if (L >= nwg) return false;
        int wgid = (int)L; { const int q = nwg / NXCD, r = nwg % NXCD, xcd = wgid % NXCD, off = wgid / NXCD; wgid = (xcd < r ? xcd * (q + 1) : r * (q + 1) + (xcd - r) * q) + off; }
        const int nig = WGM * nN, gid = wgid / nig, fm = gid * WGM, gsz = (nM - fm) < WGM ? (nM - fm) : WGM;
        u.pm = fm + ((wgid % nig) % gsz); u.pn = (wgid % nig) / gsz; return true;
    }
    __device__ __forceinline__ void a_ready(const Unit&) const {}
    __device__ __forceinline__ void done(const Unit&) const {}
};
typedef __bf16 pg8_bf16x2 __attribute__((ext_vector_type(2)));
__device__ __forceinline__ unsigned cvt_pk_bf16(float lo, float hi) { const pg8_bf16x2 v = {(__bf16)lo, (__bf16)hi}; return __builtin_bit_cast(unsigned, v); }
typedef float f32x2 __attribute__((ext_vector_type(2)));
__device__ __forceinline__ f32x2 gelu_pk(f32x2 v) {
    const f32x2 av = __builtin_elementwise_abs(v), d = av * 0.2316418882f + 1.0f;
    f32x2 t; t.x = __builtin_amdgcn_rcpf(d.x); t.y = __builtin_amdgcn_rcpf(d.y);
    f32x2 q = t * 0.5307027145f + (-0.7265760135f); q = q * t + 0.7107068705f; q = q * t + (-0.142248368f); q = q * t + 0.127414796f; q = q * t;
    const f32x2 s = (v * v) * (-0.72134752044f);
    f32x2 e; e.x = __builtin_amdgcn_exp2f(s.x); e.y = __builtin_amdgcn_exp2f(s.y);
    const f32x2 m = v * (q * e), r = v - m;
    f32x2 o; o.x = v.x < 0.f ? m.x : r.x; o.y = v.y < 0.f ? m.y : r.y; return o;
}

struct EpiF32 {
    static constexpr bool PERM = false, AFTER_DRAIN = false;
    float* C; int ldc; const float* bias;
    __device__ __forceinline__ void operator()(const f32x4 (&acc)[2][2][4][2], const Unit& u, int wr, int wc, int fr, int fq) const {
        const int row0 = u.pm * BM + wr * 64 + fr, col0 = u.pn * BM + wc * 32 + 4 * fq;
        f32x4 bv[2][2];
#pragma unroll
        for (int bj = 0; bj < 2; ++bj)
#pragma unroll
            for (int n = 0; n < 2; ++n) bv[bj][n] = bias ? *(const f32x4*)(bias + col0 + bj * HALF + n * 16) : (f32x4){0.f, 0.f, 0.f, 0.f};
#pragma unroll
        for (int ai = 0; ai < 2; ++ai)
#pragma unroll
            for (int m = 0; m < 4; ++m) { float* rowp = C + (size_t)(row0 + ai * HALF + m * 16) * ldc + col0;
#pragma unroll
                for (int bj = 0; bj < 2; ++bj)
#pragma unroll
                    for (int n = 0; n < 2; ++n) *(f32x4*)(rowp + bj * HALF + n * 16) = acc[ai][bj][m][n] + bv[bj][n]; }
    }
};
template <int ACT  > struct EpiBf16 {
    static constexpr bool PERM = true, AFTER_DRAIN = false;
    bf16_t* O; int ldc; const float* bias; int split_cols; size_t split_stride;
    __device__ __forceinline__ void operator()(const f32x4 (&acc)[2][2][4][2], const Unit& u, int wr, int wc, int fr, int fq) const {
        const int row0 = u.pm * BM + wr * 64 + fr; int colt = u.pn * BM; bf16_t* base = O;
        if (split_cols) { const int t = colt / split_cols; base += (size_t)t * split_stride; colt -= t * split_cols; }
        const int col0 = colt + wc * 32 + 8 * fq, bcol0 = u.pn * BM + wc * 32 + 8 * fq;
        f32x4 bv[2][2];
#pragma unroll
        for (int bj = 0; bj < 2; ++bj)
#pragma unroll
            for (int n = 0; n < 2; ++n) bv[bj][n] = bias ? *(const f32x4*)(bias + bcol0 + bj * HALF + 4 * n) : (f32x4){0.f, 0.f, 0.f, 0.f};
#pragma unroll
        for (int ai = 0; ai < 2; ++ai)
#pragma unroll
            for (int m = 0; m < 4; ++m) { bf16_t* rowp = base + (size_t)(row0 + ai * HALF + m * 16) * ldc + col0;
#pragma unroll
                for (int bj = 0; bj < 2; ++bj) { f32x4 v0 = acc[ai][bj][m][0] + bv[bj][0], v1 = acc[ai][bj][m][1] + bv[bj][1];
                    if (ACT == 1) { f32x2 a = gelu_pk((f32x2){v0[0], v0[1]}), b = gelu_pk((f32x2){v0[2], v0[3]}), c = gelu_pk((f32x2){v1[0], v1[1]}), d = gelu_pk((f32x2){v1[2], v1[3]});
                        v0 = (f32x4){a.x, a.y, b.x, b.y}; v1 = (f32x4){c.x, c.y, d.x, d.y}; }
                    if (ACT == 2) {
#pragma unroll
                        for (int j = 0; j < 4; ++j) { v0[j] = 0.5f * v0[j] * (1.0f + erff(v0[j] * 0.70710678f)); v1[j] = 0.5f * v1[j] * (1.0f + erff(v1[j] * 0.70710678f)); } }
                    u32x4 w; w.x = cvt_pk_bf16(v0[0], v0[1]); w.y = cvt_pk_bf16(v0[2], v0[3]); w.z = cvt_pk_bf16(v1[0], v1[1]); w.w = cvt_pk_bf16(v1[2], v1[3]);
                    *(u32x4*)(rowp + bj * HALF) = w; } }
    }
};

typedef int i32x8 __attribute__((ext_vector_type(8)));
typedef short s16x16 __attribute__((ext_vector_type(16)));
__device__ __forceinline__ i32x8 pg8_cat16(bf16x8 a, bf16x8 b) { return __builtin_bit_cast(i32x8, (s16x16)__builtin_shufflevector(a, b, 0, 1, 2, 3, 4, 5, 6, 7, 8, 9, 10, 11, 12, 13, 14, 15)); }
template <class Epi, class Sched, bool STAMP = false, bool F8 = false, bool WIDE = false>
__device__ __forceinline__ void gemm_phase(PG8_LAS unsigned char* lds, const Gemm g, const Sched& S, const Epi& E, unsigned long long* stamps) {
    const int tid = mk_tid(), wid = __builtin_amdgcn_readfirstlane(tid >> 6), lane = tid & 63, wr = wid >> 2, wc = wid & 3, fr = lane & 15, fq = lane >> 4;
    const int K = g.K, nt = K / BK;
    int ts_lo = 0, ts_hi = 0, nts = 0; const unsigned long long rt_entry = STAMP ? (unsigned long long)wall_clock64() : 0ull;
#define PG8_STAMP() do { if (STAMP && wid == 0 && nts < 64) { const unsigned long long _c = (unsigned long long)clock64(); \
        ts_lo = (lane == nts) ? (int)(unsigned)_c : ts_lo; ts_hi = (lane == nts) ? (int)(unsigned)(_c >> 32) : ts_hi; ++nts; } } while (0)
    PG8_STAMP();
    unsigned voffA, voffB;
    { int R, C; stage_rc(tid * 16, R, C); const int Ri = Epi::PERM ? perm32(R & 31) : (R & 31); const int Rb = WIDE ? (((R >> 5) << 6) + Ri) : ((R & ~31) + Ri);
        voffA = (unsigned)(R * K + C) * 2u; voffB = (unsigned)(Rb * K + C) * 2u; }
    const size_t qstep = (size_t)64 * K * 2;
    const size_t qstepB = WIDE ? (size_t)128 * K * 2 : qstep;
    const size_t hstepB = WIDE ? (size_t)32 * K * 2 : (size_t)HALF * K * 2;
    const size_t kstep = (size_t)(BK * 2);
    const size_t hstep = (size_t)HALF * K * 2;
    const size_t tstep = 2 * hstep;
    const unsigned ldsw = (unsigned)wid * 1024u;
    const int aoff = lds_byte(wr * 64 + fr, fq * 8), boff = lds_byte(wc * 32 + fr, fq * 8);
#define PG8_SA(b, h) (((b) * 2 + (h)) * HTB)
#define PG8_SB(b, h) ((4 + (b) * 2 + (h)) * HTB)
#define PG8_STAGE(bufoff, gbase, voff) PG8_STAGEQ(bufoff, gbase, voff, qstep)
#define PG8_STAGEB(bufoff, gbase, voff) PG8_STAGEQ(bufoff, gbase, voff, qstepB)
#define PG8_STAGEQ(bufoff, gbase, voff, qs) do { const char* _g0 = (const char*)(gbase); const char* _g1 = _g0 + (qs); asm volatile("" : "+s"(_g0), "+s"(_g1));   \
        __builtin_amdgcn_global_load_lds((const unsigned*)(_g0 + (voff)), (PG8_LAS unsigned*)(lds + (bufoff) + ldsw), 16, 0, 0); \
        __builtin_amdgcn_global_load_lds((const unsigned*)(_g1 + (voff)), (PG8_LAS unsigned*)(lds + (bufoff) + ldsw + 8192), 16, 0, 0); } while (0)
#define PG8_LDA(dst, b, h) do { _Pragma("unroll") for (int m = 0; m < 4; ++m) _Pragma("unroll") for (int k = 0; k < 2; ++k) dst[m][k] = *(const PG8_LAS bf16x8*)(lds + PG8_SA(b, h) + aoff + m * 2048 + k * 1024); } while (0)
#define PG8_LDB(dst, b, h) do { _Pragma("unroll") for (int n = 0; n < 2; ++n) _Pragma("unroll") for (int k = 0; k < 2; ++k) dst[n][k] = *(const PG8_LAS bf16x8*)(lds + PG8_SB(b, h) + boff + n * 2048 + k * 1024); } while (0)
#define PG8_MMA(ai, bj, At, Bt) do { __builtin_amdgcn_s_setprio(1); _Pragma("unroll") for (int m = 0; m < 4; ++m) _Pragma("unroll") for (int n = 0; n < 2; ++n) { \
        if constexpr (F8) acc[ai][bj][m][n] = __builtin_amdgcn_mfma_scale_f32_16x16x128_f8f6f4(pg8_cat16(Bt[n][0], Bt[n][1]), pg8_cat16(At[m][0], At[m][1]), acc[ai][bj][m][n], 0, 0, 0, 0, 0, 0); \
        else { _Pragma("unroll") for (int k = 0; k < 2; ++k) acc[ai][bj][m][n] = __builtin_amdgcn_mfma_f32_16x16x32_bf16(Bt[n][k], At[m][k], acc[ai][bj][m][n], 0, 0, 0); } } \
        __builtin_amdgcn_s_setprio(0); } while (0)
#define PG8_WAIT_V(n) asm volatile("s_waitcnt vmcnt(" #n ")" ::: "memory")
#define PG8_WAIT_L(n) asm volatile("s_waitcnt lgkmcnt(" #n ")" ::: "memory")
#define PG8_BAR __builtin_amdgcn_s_barrier()
#define PG8_SCHED __builtin_amdgcn_sched_barrier(0)
    Unit cur, nxt; int ui = 0;
    if (!S.next(0, cur)) return;
    f32x4 acc[2][2][4][2];
    bf16x8 At[4][2], B0[2][2], B1[2][2];
    const char* cA = (const char*)g.A + (size_t)cur.pm * tstep; const char* cB = (const char*)g.Bt + (size_t)cur.pn * tstep;
    S.a_ready(cur);
    PG8_STAGEB(PG8_SB(0, 0), cB, voffB); PG8_STAGE(PG8_SA(0, 0), cA, voffA); PG8_STAGEB(PG8_SB(0, 1), cB + hstepB, voffB); PG8_STAGE(PG8_SA(0, 1), cA + hstep, voffA);
    if (wr == 1) PG8_BAR;
    PG8_WAIT_V(4); PG8_BAR;
    PG8_STAGEB(PG8_SB(1, 0), cB + kstep, voffB); PG8_STAGE(PG8_SA(1, 0), cA + kstep, voffA); PG8_STAGEB(PG8_SB(1, 1), cB + hstepB + kstep, voffB);
    PG8_WAIT_V(6); PG8_BAR;
    PG8_STAMP();
#pragma unroll
    for (int a = 0; a < 2; ++a)
#pragma unroll
        for (int b = 0; b < 2; ++b)
#pragma unroll
            for (int m = 0; m < 4; ++m)
#pragma unroll
                for (int n = 0; n < 2; ++n) acc[a][b][m][n] = (f32x4){0.f, 0.f, 0.f, 0.f};
    for (;;) {
        const bool has_next = S.next(ui + 1, nxt);
        const char* nA = has_next ? (const char*)g.A + (size_t)nxt.pm * tstep : cA; const char* nB = has_next ? (const char*)g.Bt + (size_t)nxt.pn * tstep : cB;
        for (int t = 0; t < nt; t += 2) {
            const bool last = (t == nt - 2);
            const char* a1 = cA + (size_t)(t + 1) * kstep;
            const char* a2 = last ? nA : cA + (size_t)(t + 2) * kstep; const char* b2 = last ? nB : cB + (size_t)(t + 2) * kstep;
            const char* a3 = a2 + kstep; const char* b3 = b2 + kstep;
            if (last && has_next) S.a_ready(nxt);
            PG8_LDB(B0, 0, 0); PG8_SCHED; PG8_LDA(At, 0, 0); PG8_STAGE(PG8_SA(1, 1), a1 + hstep, voffA);
            PG8_WAIT_L(8); PG8_BAR; PG8_WAIT_L(0); PG8_MMA(0, 0, At, B0); PG8_BAR; PG8_SCHED;
            PG8_LDB(B1, 0, 1); PG8_STAGEB(PG8_SB(0, 0), b2, voffB);
            PG8_BAR; PG8_WAIT_L(0); PG8_MMA(0, 1, At, B1); PG8_BAR;
            PG8_LDA(At, 0, 1); PG8_STAGE(PG8_SA(0, 0), a2, voffA);
            PG8_BAR; PG8_WAIT_L(0); PG8_MMA(1, 0, At, B0); PG8_BAR; PG8_SCHED;
            PG8_STAGEB(PG8_SB(0, 1), b2 + hstepB, voffB);
            PG8_WAIT_V(6); PG8_BAR; PG8_MMA(1, 1, At, B1); PG8_BAR;
            PG8_LDB(B0, 1, 0); PG8_SCHED; PG8_LDA(At, 1, 0); PG8_STAGE(PG8_SA(0, 1), a2 + hstep, voffA);
            PG8_WAIT_L(8); PG8_BAR; PG8_WAIT_L(0); PG8_MMA(0, 0, At, B0); PG8_BAR; PG8_SCHED;
            PG8_LDB(B1, 1, 1); PG8_STAGEB(PG8_SB(1, 0), b3, voffB);
            PG8_BAR; PG8_WAIT_L(0); PG8_MMA(0, 1, At, B1); PG8_BAR;
            PG8_LDA(At, 1, 1); PG8_STAGE(PG8_SA(1, 0), a3, voffA);
            PG8_BAR; PG8_WAIT_L(0); PG8_MMA(1, 0, At, B0); PG8_BAR; PG8_SCHED;
            PG8_STAGEB(PG8_SB(1, 1), b3 + hstepB, voffB);
            PG8_WAIT_V(6); PG8_BAR; PG8_MMA(1, 1, At, B1); PG8_BAR;
        }
        PG8_STAMP();
        if constexpr (!Epi::AFTER_DRAIN) { E(acc, cur, wr, wc, fr, fq); S.done(cur); }
        PG8_STAMP();
        if (!has_next) break;
#pragma unroll
        for (int a = 0; a < 2; ++a)
#pragma unroll
            for (int b = 0; b < 2; ++b)
#pragma unroll
                for (int m = 0; m < 4; ++m)
#pragma unroll
                    for (int n = 0; n < 2; ++n) acc[a][b][m][n] = (f32x4){0.f, 0.f, 0.f, 0.f};
        cur = nxt; cA = nA; cB = nB; ++ui;
    }
    PG8_WAIT_V(0);
    if (wr == 0) PG8_BAR;
    PG8_BAR;
    if constexpr (Epi::AFTER_DRAIN) { E.fused(acc, cur, wr, wc, fr, fq, lds, wid, lane); S.done(cur); }
    PG8_STAMP();
    if (STAMP && wid == 0) { stamps[lane] = lane < nts ? (((unsigned long long)(unsigned)ts_hi << 32) | (unsigned)ts_lo) : 0ull;
        if (lane == 62) stamps[62] = rt_entry; if (lane == 63) stamps[63] = (unsigned long long)wall_clock64(); }
#undef PG8_STAMP
#undef PG8_SA
#undef PG8_SB
#undef PG8_STAGE
#undef PG8_STAGEB
#undef PG8_STAGEQ
#undef PG8_LDA
#undef PG8_LDB
#undef PG8_MMA
#undef PG8_WAIT_V
#undef PG8_WAIT_L
#undef PG8_BAR
#undef PG8_SCHED
}
}
#define XB_TMO      128
#define XB_XCNT(j)  (256  + 64 * (j))
#define XB_XSUB(j)  (1280 + 64 * (j))
#define XB_XGEN(j)  (2304 + 64 * (j))
#define XB_TOP      3328
#define XB_TOPGEN   3392
#define XCD_BAR_WORDS 3456
#define XB_SPIN_CAP (1u << 18)
#define LAS __attribute__((address_space(3)))

__device__ __forceinline__ unsigned xb_ld(unsigned* p)              { return __hip_atomic_load(p, __ATOMIC_RELAXED, __HIP_MEMORY_SCOPE_AGENT); }
__device__ __forceinline__ unsigned xb_add(unsigned* p, unsigned v) { return __hip_atomic_fetch_add(p, v, __ATOMIC_RELAXED, __HIP_MEMORY_SCOPE_AGENT); }
__device__ __forceinline__ unsigned xb_xcc_id() { return (unsigned)__builtin_amdgcn_s_getreg((3 << 11) | 20) & 0xFu; }
#define XB_SPIN(cond, bar) do { unsigned _sp = 0; while (cond) { __builtin_amdgcn_s_sleep(1); \
    if ((++_sp & 255u) == 0u) { if (xb_ld(&(bar)[XB_TMO])) break; if (_sp > XB_SPIN_CAP) { atomicAdd(&(bar)[XB_TMO], 1u); break; } } } } while (0)

struct XcdBarrier {
    unsigned* bar; unsigned x;
    volatile LAS unsigned* st;
};

__device__ __forceinline__ XcdBarrier xcd_barrier_post(unsigned* bar, volatile LAS unsigned* st) {
    XcdBarrier b; b.bar = bar; b.x = xb_xcc_id(); b.st = st;
    if (threadIdx.x == 0) (void)xb_add(&bar[XB_XCNT(b.x)], 1u);
    return b;
}
__device__ __forceinline__ void xcd_barrier_complete(unsigned* bar, unsigned x, unsigned& nloc, unsigned& nx) {
    const unsigned G = gridDim.x * gridDim.y * gridDim.z;
    unsigned sum, cnt, mine, sp = 0u;
    for (;;) {
        sum = 0u; cnt = 0u; mine = 0u;
#pragma unroll
        for (unsigned j = 0; j < 16; ++j) { const unsigned c = xb_ld(&bar[XB_XCNT(j)]); sum += c; cnt += (c > 0u) ? 1u : 0u; mine = (j == x) ? c : mine; }
        if (sum == G) break;
        __builtin_amdgcn_s_sleep(1);
        if ((++sp & 255u) == 0u) { if (xb_ld(&bar[XB_TMO])) break; if (sp > XB_SPIN_CAP) { atomicAdd(&bar[XB_TMO], 1u); break; } }
    }
    nloc = mine > 0u ? mine : 1u; nx = cnt > 0u ? cnt : 1u;
}

__device__ __forceinline__ void xcd_barrier(const XcdBarrier& b) {
    asm volatile("s_waitcnt vmcnt(0)" ::: "memory");
    __syncthreads();
    if (threadIdx.x == 0) {
        unsigned* bar = b.bar;
        __builtin_amdgcn_s_waitcnt(0);
        unsigned nloc = b.st[0], nx = b.st[1];
        if (nloc == 0u) { xcd_barrier_complete(bar, b.x, nloc, nx); b.st[0] = nloc; b.st[1] = nx; }
        const unsigned old = xb_add(&bar[XB_XSUB(b.x)], 1u);
        const unsigned gen = old / nloc;
        if (old + 1u == (gen + 1u) * nloc) {
            __builtin_amdgcn_fence(__ATOMIC_RELEASE, "agent");
            asm volatile("s_waitcnt vmcnt(0)" ::: "memory");
            const unsigned og = xb_add(&bar[XB_TOP], 1u);
            const unsigned tg = og / nx;
            if (og + 1u == (tg + 1u) * nx) xb_add(&bar[XB_TOPGEN], 1u);
            else XB_SPIN(xb_ld(&bar[XB_TOPGEN]) == tg, bar);
            __builtin_amdgcn_fence(__ATOMIC_ACQUIRE, "agent");
            xb_add(&bar[XB_XGEN(b.x)], 1u);
            asm volatile("s_waitcnt vmcnt(0)" ::: "memory");
        } else {
            XB_SPIN(xb_ld(&bar[XB_XGEN(b.x)]) == gen, bar);
            __builtin_amdgcn_fence(__ATOMIC_ACQUIRE, "agent");
            asm volatile("s_waitcnt vmcnt(0)" ::: "memory");
        }
    }
    __syncthreads();
}

namespace mk {
using pg8::bf16_t; using pg8::bf16x8; using pg8::f32x4; using pg8::u32x4;
typedef short s16x4 __attribute__((ext_vector_type(4)));
typedef unsigned u32x2 __attribute__((ext_vector_type(2)));
typedef __bf16 bf16x2v __attribute__((ext_vector_type(2)));
typedef int i32x4 __attribute__((ext_vector_type(4)));
#define DI __device__ __forceinline__

constexpr int D = 1024, SEQ = 4096, NTOK = 16384, DEPTH = 4, DIN = 13824;
constexpr int OFF_AQ = 0, OFF_AK = 1536, OFF_AV = 3072, OFF_LX = 4608, OFF_LG = 5632, OFF_RQ = 6656, OFF_RK = 7680, OFF_RV = 8704, OFF_RG = 9728, OFF_GA = 10752;
constexpr float ALPHA = 1.681792830507429f;
constexpr float LN_EPS = 1e-5f;
constexpr float X8_SCALE = 32.0f, W8_SCALE = 2048.0f, F8_MAX = 440.0f;
constexpr int NPH = 12;
constexpr int LDS_BYTES = 148 * 1024;
constexpr int LDS_BAR_OFF = LDS_BYTES - 16;

constexpr size_t WS_CTL  = 0;
constexpr size_t WS_COSA = 16384;
constexpr size_t WS_SINA = WS_COSA + (size_t)4096 * 64 * 4;
constexpr size_t WS_COSR = WS_SINA + (size_t)4096 * 64 * 4;
constexpr size_t WS_SINR = WS_COSR + (size_t)4096 * 128 * 4;
constexpr size_t WS_CCH  = WS_SINR + (size_t)4096 * 128 * 4;
constexpr size_t WS_WAT  = WS_CCH + 4096;
constexpr size_t WS_WXT  = WS_WAT + 131072;
constexpr size_t WS_LSTA = WS_WXT + 131072;
constexpr size_t WS_LSTH = WS_LSTA + 524288;
constexpr size_t WS_K1B  = WS_LSTH + 524288;
constexpr size_t WS_K2B  = WS_K1B + 262144;
constexpr size_t WS_XF   = WS_K2B + 262144;
constexpr size_t WS_XB   = WS_XF + (size_t)NTOK * D * 4;
constexpr size_t WS_WINT = WS_XB + (size_t)NTOK * D * 2;
constexpr size_t WS_WSC  = WS_WINT + (size_t)DIN * 1024;
constexpr size_t WS_X8   = WS_WSC + (size_t)DIN * 4 + 256 - ((size_t)DIN * 4) % 256;
constexpr size_t WS_XS   = WS_X8 + (size_t)NTOK * 1024;
constexpr size_t WS_WBAT = WS_XS + (size_t)NTOK * 4;
constexpr size_t WS_WBBT = WS_WBAT + (size_t)1024 * 512 * 2;
constexpr size_t WS_WBCT = WS_WBBT + (size_t)1024 * 1024 * 2;
constexpr size_t WS_WOT  = WS_WBCT + (size_t)1024 * 1024 * 2;
constexpr size_t WS_WQT  = WS_WOT + (size_t)1024 * 1024 * 2;
constexpr size_t WS_UV8  = WS_WQT + (size_t)2048 * 1024 * 2;
constexpr size_t WS_UVS  = WS_UV8 + (size_t)16384 * 2048;
constexpr size_t WS_PROJ = WS_UVS + (size_t)16384 * 8;
constexpr size_t WS_OATT = WS_PROJ + (size_t)NTOK * DIN * 2;
constexpr size_t WS_LSE  = WS_OATT + (size_t)NTOK * 1536 * 2;
constexpr size_t WS_KVB  = WS_LSE + (size_t)NTOK * 12 * 4;
constexpr size_t WS_YA   = WS_KVB + (size_t)16 * 32 * 65536 * 2;
constexpr size_t WS_YB   = WS_YA + (size_t)NTOK * 512 * 2;
constexpr size_t WS_YC   = WS_YB + (size_t)NTOK * 1024 * 2;
constexpr size_t WS_MRGF = WS_YC + (size_t)NTOK * 1024 * 2;
constexpr size_t WS_MRGB = WS_MRGF + (size_t)NTOK * 1024 * 4;
constexpr size_t WS_END  = WS_MRGB + (size_t)NTOK * 1024 * 2;
constexpr size_t WS_Q    = WS_PROJ;
constexpr size_t WS_EID  = WS_PROJ + (size_t)NTOK * 2048 * 2;
constexpr size_t WS_GATE = WS_EID + (size_t)NTOK * 128 * 4;
static_assert(WS_END <= (size_t)1073741824, "workspace too large");
static_assert(WS_PROJ % 256 == 0 && WS_KVB % 256 == 0 && WS_MRGF % 256 == 0, "alignment");

struct Args { const float* in[20]; float* out; unsigned char* ws; double ropeA, ropeR; int ph_lo, ph_hi; };

DI float bflo(unsigned w) { return __uint_as_float(w << 16); }
DI float bfhi(unsigned w) { return __uint_as_float(w & 0xffff0000u); }
DI float bf2f(bf16_t v) { return __uint_as_float(((unsigned)v) << 16); }
DI unsigned pk2(float lo, float hi) { return pg8::cvt_pk_bf16(lo, hi); }
DI bf16_t f2bf(float f) { return (bf16_t)(pk2(f, 0.f) & 0xffffu); }
DI f32x4 mfma16(bf16x8 a, bf16x8 b, f32x4 c) { return __builtin_amdgcn_mfma_f32_16x16x32_bf16(a, b, c, 0, 0, 0); }
DI s16x4 trrd(LAS unsigned char* p) { return __builtin_amdgcn_ds_read_tr16_b64_v4i16((LAS s16x4*)p); }
DI bf16x8 cat8(s16x4 lo, s16x4 hi) { return __builtin_shufflevector(lo, hi, 0, 1, 2, 3, 4, 5, 6, 7); }
DI float wsum(float v) { v += __shfl_xor(v, 32); v += __shfl_xor(v, 16); v += __shfl_xor(v, 8); v += __shfl_xor(v, 4); v += __shfl_xor(v, 2); v += __shfl_xor(v, 1); return v; }
DI float sigm(float x) { return __builtin_amdgcn_rcpf(1.f + __builtin_amdgcn_exp2f(x * -1.4426950408889634f)); }
DI float gelu_erf(float x) { return 0.5f * x * (1.f + erff(x * 0.70710678118654752f)); }
DI float dot2(unsigned w, unsigned x, float acc) { return __builtin_amdgcn_fdot2_f32_bf16(__builtin_bit_cast(bf16x2v, w), __builtin_bit_cast(bf16x2v, x), acc, false); }
DI float log2gamma(int h) { return log2f(1.0f - exp2f(-5.0f - (float)h)); }

#define MK_DPP_ADD(v, ctrl, rmask) v += __int_as_float(__builtin_amdgcn_update_dpp(0, __float_as_int(v), (ctrl), (rmask), 0xf, false))
DI float wsum_dpp(float v) {
    MK_DPP_ADD(v, 0xB1, 0xf); MK_DPP_ADD(v, 0x4E, 0xf); MK_DPP_ADD(v, 0x141, 0xf); MK_DPP_ADD(v, 0x140, 0xf);
    MK_DPP_ADD(v, 0x142, 0xa); MK_DPP_ADD(v, 0x143, 0xc);
    return __int_as_float(__builtin_amdgcn_readlane(__float_as_int(v), 63));
}
DI float gelu_as(float v) {
    const float av = fabsf(v), t = __builtin_amdgcn_rcpf(av * 0.2316418882f + 1.0f);
    float q = t * 0.5307027145f + (-0.7265760135f); q = q * t + 0.7107068705f; q = q * t + (-0.142248368f); q = q * t + 0.127414796f; q = q * t;
    const float e = __builtin_amdgcn_exp2f(v * v * (-0.72134752044f));
    const float m = v * (q * e);
    return v < 0.f ? m : v - m;
}
DI int wperm(int n) {
    if (n < 3072) { const int j = n & 127, jj = j & 63; return (n & ~127) + 8 * (jj >> 2) + (jj & 3) + ((j >= 64) ? 4 : 0); }
    if (n >= OFF_RQ && n < OFF_RV) { const int j = n & 255, jj = j & 127; return (n & ~255) + 8 * (jj >> 2) + (jj & 3) + ((j >= 128) ? 4 : 0); }
    return n;
}

template <bool WPERM>
DI void tconv_tile(const float* src, int ldsrc, bf16_t* dst, int lddst, int k0, int n0, LAS float* t, float mul = 1.0f) {
    const int tid = mk_tid();
#pragma unroll
    for (int i = 0; i < 8; ++i) { const int idx = tid + 512 * i, r = idx >> 6, c = idx & 63; t[r * 65 + c] = src[(size_t)(k0 + r) * ldsrc + n0 + c]; }
    __syncthreads();
#pragma unroll
    for (int i = 0; i < 8; ++i) { const int idx = tid + 512 * i, n = idx >> 6, k = idx & 63; const int nr = WPERM ? wperm(n0 + n) : (n0 + n); dst[(size_t)nr * lddst + k0 + k] = f2bf(t[k * 65 + n] * mul); }
    __syncthreads();
}
DI void conv_unit(const float* src, bf16_t* dst, int unit) {
    const size_t i = (size_t)unit * 4096 + (size_t)mk_tid() * 8;
    const f32x4 a = *(const f32x4*)(src + i), b = *(const f32x4*)(src + i + 4);
    u32x4 o; o.x = pk2(a[0], a[1]); o.y = pk2(a[2], a[3]); o.z = pk2(b[0], b[1]); o.w = pk2(b[2], b[3]);
    *(u32x4*)(dst + i) = o;
}
DI void w8_unit(const float* src, unsigned char* ws, int unit, LAS float* t) {
    const int tid = mk_tid(), n0 = unit * 64;
    unsigned char* dst = ws + WS_WINT;
#pragma unroll 1
    for (int k0 = 0; k0 < 1024; k0 += 64) {
#pragma unroll
        for (int i = 0; i < 8; ++i) { const int idx = tid + 512 * i, r = idx >> 6, cc = idx & 63; t[r * 65 + cc] = fminf(fmaxf(src[(size_t)(k0 + r) * DIN + n0 + cc] * W8_SCALE, -F8_MAX), F8_MAX); }
        __syncthreads();
#pragma unroll
        for (int i = 0; i < 2; ++i) { const int idx = tid + 512 * i, n = idx >> 4, k4 = idx & 15;
            int wd = __builtin_amdgcn_cvt_pk_fp8_f32(t[(4 * k4) * 65 + n], t[(4 * k4 + 1) * 65 + n], 0, false);
            wd = __builtin_amdgcn_cvt_pk_fp8_f32(t[(4 * k4 + 2) * 65 + n], t[(4 * k4 + 3) * 65 + n], wd, true);
            *(int*)(dst + (size_t)wperm(n0 + n) * 1024 + k0 + 4 * k4) = wd; }
        __syncthreads();
    }
}
DI void row_to_fp8(const f32x4 (&o)[4], unsigned char* x8row, int ln) {
    u32x4 w;
#pragma unroll
    for (int q = 0; q < 4; ++q) {
        const float a0 = fminf(fmaxf(o[q][0] * X8_SCALE, -F8_MAX), F8_MAX), a1 = fminf(fmaxf(o[q][1] * X8_SCALE, -F8_MAX), F8_MAX), a2 = fminf(fmaxf(o[q][2] * X8_SCALE, -F8_MAX), F8_MAX), a3 = fminf(fmaxf(o[q][3] * X8_SCALE, -F8_MAX), F8_MAX);
        int wd = __builtin_amdgcn_cvt_pk_fp8_f32(a0, a1, 0, false); wd = __builtin_amdgcn_cvt_pk_fp8_f32(a2, a3, wd, true); w[q] = (unsigned)wd; }
    *(u32x4*)(x8row + 16 * ln) = w;
}
typedef float f32x16 __attribute__((ext_vector_type(16)));
typedef float f32x32 __attribute__((ext_vector_type(32)));
typedef unsigned u32x6 __attribute__((ext_vector_type(6)));
typedef _Float16 f16x32 __attribute__((ext_vector_type(32)));
DI float wmax(float m) { m = fmaxf(m, __shfl_xor(m, 32)); m = fmaxf(m, __shfl_xor(m, 16)); m = fmaxf(m, __shfl_xor(m, 8)); m = fmaxf(m, __shfl_xor(m, 4)); m = fmaxf(m, __shfl_xor(m, 2)); m = fmaxf(m, __shfl_xor(m, 1)); return m; }
DI void conv_fp6_rows(const float* usrc, const float* vsrc, unsigned char* ws, int unit) {
    const int tid = mk_tid(), lane = tid & 63, w = tid >> 6;
    const size_t row = (size_t)unit * 8 + w;
    const float* up = usrc + row * 1024 + 16 * lane; const float* vp = vsrc + row * 1024 + 16 * lane;
    f32x16 a, b; float mu = 0.f, mv = 0.f;
#pragma unroll
    for (int q = 0; q < 4; ++q) { const f32x4 x = *(const f32x4*)(up + 4 * q), y = *(const f32x4*)(vp + 4 * q);
#pragma unroll
        for (int j = 0; j < 4; ++j) { a[4 * q + j] = x[j]; b[4 * q + j] = y[j]; mu = fmaxf(mu, fabsf(x[j])); mv = fmaxf(mv, fabsf(y[j])); } }
    mu = wmax(mu); mv = wmax(mv);
    const float su = (mu > 0.f) ? 7.0f / mu : 1.0f, sv = (mv > 0.f) ? 7.0f / mv : 1.0f;
    f16x32 h;
#pragma unroll
    for (int i = 0; i < 16; ++i) { h[i] = (_Float16)(a[i] * su); h[16 + i] = (_Float16)(b[i] * sv); }
    const u32x6 p = __builtin_amdgcn_cvt_scalef32_pk32_fp6_f16(h, 1.0f);
    unsigned char* rec = ws + WS_UV8 + row * 1536;
    *(u32x4*)(rec + 16 * lane) = (u32x4){p[0], p[1], p[2], p[3]};
    *(u32x2*)(rec + 1024 + 8 * lane) = (u32x2){p[4], p[5]};
    if (lane == 0) { float* sp = (float*)(ws + WS_UVS) + row * 2; sp[0] = (mu > 0.f) ? mu * (1.0f / 7.0f) : 1.0f; sp[1] = (mv > 0.f) ? mv * (1.0f / 7.0f) : 1.0f; }
}
DI void phase_conv(const Args& a, int layer, LAS unsigned char* lds) {
    unsigned char* ws = a.ws;
    LAS float* t = (LAS float*)lds;
    const int J0 = 216, J1 = J0 + 128, J2 = J1 + 256, J3 = J2 + 256, J4 = J3 + 256, J5 = J4 + 512, J6 = J5 + 32, J7 = J6 + 2048, J8 = J7, J9 = J8 + 64, J10 = J9 + 1;
    const int total = J10;
    for (int u = blockIdx.x; u < total; u += gridDim.x) {
        if (u < J0) { w8_unit(a.in[1] + (size_t)layer * 1024 * DIN, ws, u, t); }
        else if (u < J1) { const int v = u - J0, kt = v / 16, nt = v % 16; tconv_tile<false>(a.in[9] + (size_t)layer * 2560 * 1024, 1024, (bf16_t*)(ws + WS_WBAT), 512, kt * 64, nt * 64, t); }
        else if (u < J2) { const int v = u - J1, kt = v / 16, nt = v % 16; tconv_tile<false>(a.in[9] + (size_t)layer * 2560 * 1024 + (size_t)512 * 1024, 1024, (bf16_t*)(ws + WS_WBBT), 1024, kt * 64, nt * 64, t); }
        else if (u < J3) { const int v = u - J2, kt = v / 16, nt = v % 16; tconv_tile<false>(a.in[9] + (size_t)layer * 2560 * 1024 + (size_t)1536 * 1024, 1024, (bf16_t*)(ws + WS_WBCT), 1024, kt * 64, nt * 64, t); }
        else if (u < J4) { const int v = u - J3, kt = v / 16, nt = v % 16; tconv_tile<false>(a.in[10] + (size_t)layer * 1024 * 1024, 1024, (bf16_t*)(ws + WS_WOT), 1024, kt * 64, nt * 64, t); }
        else if (u < J5) { const int v = u - J4, kt = v / 32, nt = v % 32; tconv_tile<false>(a.in[13] + (size_t)layer * 1024 * 2048, 2048, (bf16_t*)(ws + WS_WQT), 1024, kt * 64, nt * 64, t); }
        else if (u < J6) { const int v = u - J5, blk = v & 15, which = v >> 4;
            tconv_tile<false>(a.in[which ? 6 : 4] + ((size_t)layer * 16 + blk) * 4096, 64, (bf16_t*)(ws + (which ? WS_WXT : WS_WAT)) + blk * 4096, 64, 0, 0, t, -1.4426950408889634f); }
        else if (u < J7) { conv_fp6_rows(a.in[16] + (size_t)layer * 16384 * 1024, a.in[17] + (size_t)layer * 16384 * 1024, ws, u - J6); }
        else if (u < J9) { const int v = u - J8; if (v < 32) conv_unit(a.in[14] + (size_t)layer * 131072, (bf16_t*)(ws + WS_K1B), v); else conv_unit(a.in[15] + (size_t)layer * 131072, (bf16_t*)(ws + WS_K2B), v - 32); }
        else { for (int c = mk_tid(); c < 1024; c += 512) { const float lam = a.in[8][layer * 1024 + c]; const float e = __builtin_amdgcn_exp2f(-lam * 1.4426950408889634f); const float sp = (e < 0.05f) ? e * (1.0f + e * (-0.5f + e * (0.33333333f + e * -0.25f))) : __builtin_amdgcn_logf(1.0f + e) * 0.6931471805599453f; ((float*)(ws + WS_CCH))[c] = -8.0f * sp; } }
    }
}

DI void phase_prologue(const Args& a) {
    unsigned char* ws = a.ws;
    const int tid = mk_tid();
    for (int u = blockIdx.x; u < 2048; u += gridDim.x) {
        { const int ln = tid & 63; const size_t row = (size_t)u * 8 + (tid >> 6);
            const float* xp = a.in[0] + row * 1024 + 16 * ln; float* xo = (float*)(ws + WS_XF) + row * 1024 + 16 * ln;
            f32x4 o[4];
#pragma unroll
            for (int q = 0; q < 4; ++q) { o[q] = *(const f32x4*)(xp + 4 * q); *(f32x4*)(xo + 4 * q) = o[q]; }
            row_to_fp8(o, ws + WS_X8 + row * 1024, ln); }
    }
}

DI void attn_unit(const Args& a, int unit, LAS unsigned char* lds) {
    unsigned char* ws = a.ws;
    const int tid = mk_tid(), lane = tid & 63, w = __builtin_amdgcn_readfirstlane(tid >> 6), g = lane >> 4, l15 = lane & 15, tq4 = l15 >> 2, tp4 = l15 & 3;
    const int b = unit / 384, rem = unit % 384, h = rem >> 5, bi = rem & 31;
    const int grp = h >> 2, d = (grp == 0) ? 1 : ((grp == 1) ? 4 : 16), nb = 32 / d, r = bi / nb, n = bi % nb;
    const bf16_t* proj = (const bf16_t*)(ws + WS_PROJ) + (size_t)b * SEQ * DIN;
    LAS unsigned char* Ks = lds; LAS unsigned char* Vs = lds + 256 * 288;
#pragma unroll
    for (int i = 0; i < 8; ++i) {
        const int idx = tid + 512 * i, row = idx >> 4, ch = idx & 15, m = 128 * (n - 1) + row;
        u32x4 kv = {0u, 0u, 0u, 0u}, vv = {0u, 0u, 0u, 0u};
        if (m >= 0) { const bf16_t* p = proj + (size_t)(m * d + r) * DIN + h * 128 + ch * 8; kv = *(const u32x4*)(p + OFF_AK); vv = *(const u32x4*)(p + OFF_AV); }
        *(LAS u32x4*)(Ks + row * 288 + ch * 16) = kv; *(LAS u32x4*)(Vs + row * 288 + ch * 16) = vv;
    }
    const int qi = 16 * w + l15;
    const size_t tq = (size_t)(128 * n + qi) * d + r;
    bf16x8 qf[4];
#pragma unroll
    for (int ks = 0; ks < 4; ++ks) qf[ks] = *(const bf16x8*)(proj + tq * DIN + OFF_AQ + h * 128 + 32 * ks + 8 * g);
    __syncthreads();
    const int s0 = w >> 1;
    f32x4 sacc[10];
#pragma unroll
    for (int jj = 0; jj < 10; ++jj) {
        f32x4 acc = {0.f, 0.f, 0.f, 0.f};
#pragma unroll
        for (int ks = 0; ks < 4; ++ks) { const bf16x8 kf = *(const LAS bf16x8*)(Ks + (32 * s0 + 16 * jj + l15) * 288 + (32 * ks + 8 * g) * 2); acc = mfma16(kf, qf[ks], acc); }
        sacc[jj] = acc;
    }
    const float scale = 0.08838834764831845f * 1.4426950408889634f;
    float mx = -1e30f;
#pragma unroll
    for (int jj = 0; jj < 10; ++jj)
#pragma unroll
        for (int rg = 0; rg < 4; ++rg) {
            const int j = 32 * s0 + 16 * jj + 4 * g + rg;
            const bool valid = (j >= qi) && (j <= qi + 128) && (n > 0 || j >= 128);
            const float s = valid ? sacc[jj][rg] * scale : -1e30f;
            sacc[jj][rg] = s; mx = fmaxf(mx, s);
        }
    mx = fmaxf(mx, __shfl_xor(mx, 16)); mx = fmaxf(mx, __shfl_xor(mx, 32));
    float sum = 0.f;
#pragma unroll
    for (int jj = 0; jj < 10; ++jj)
#pragma unroll
        for (int rg = 0; rg < 4; ++rg) { const float p = __builtin_amdgcn_exp2f(sacc[jj][rg] - mx); sacc[jj][rg] = p; sum += p; }
    sum += __shfl_xor(sum, 16); sum += __shfl_xor(sum, 32);
    f32x4 oacc[8];
#pragma unroll
    for (int db = 0; db < 8; ++db) oacc[db] = (f32x4){0.f, 0.f, 0.f, 0.f};
#pragma unroll
    for (int s = 0; s < 5; ++s) {
        u32x4 pw; pw.x = pk2(sacc[2 * s][0], sacc[2 * s][1]); pw.y = pk2(sacc[2 * s][2], sacc[2 * s][3]); pw.z = pk2(sacc[2 * s + 1][0], sacc[2 * s + 1][1]); pw.w = pk2(sacc[2 * s + 1][2], sacc[2 * s + 1][3]);
        const bf16x8 pb = __builtin_bit_cast(bf16x8, pw);
        const int k0 = 32 * (s0 + s) + 4 * g + tq4;
#pragma unroll
        for (int db = 0; db < 8; ++db) {
            const s16x4 lo = trrd(Vs + k0 * 288 + (16 * db + 4 * tp4) * 2), hi = trrd(Vs + (k0 + 16) * 288 + (16 * db + 4 * tp4) * 2);
            oacc[db] = mfma16(cat8(lo, hi), pb, oacc[db]);
        }
    }
    const float inv = 1.0f / sum;
    bf16_t* op = (bf16_t*)(ws + WS_OATT) + ((size_t)b * SEQ + tq) * 1536 + h * 128 + 4 * g;
#pragma unroll
    for (int db = 0; db < 8; ++db) { u32x2 o; o.x = pk2(oacc[db][0] * inv, oacc[db][1] * inv); o.y = pk2(oacc[db][2] * inv, oacc[db][3] * inv); *(u32x2*)(op + 16 * db) = o; }
    if (g == 0) ((float*)(ws + WS_LSE))[((size_t)b * SEQ + tq) * 12 + h] = mx + __builtin_amdgcn_logf(sum);
    __syncthreads();
}

DI void retkv_unit(const Args& a, int unit, LAS unsigned char* lds) {
    unsigned char* ws = a.ws;
    const int tid = mk_tid(), lane = tid & 63, w = __builtin_amdgcn_readfirstlane(tid >> 6), g = lane >> 4, l15 = lane & 15, tq4 = l15 >> 2, tp4 = l15 & 3;
    const int b = unit >> 7, h = (unit >> 5) & 3, c = unit & 31;
    const bf16_t* proj = (const bf16_t*)(ws + WS_PROJ) + ((size_t)b * SEQ + c * 128) * DIN;
    LAS unsigned char* Ks = lds; LAS unsigned char* Vs = lds + 128 * 544;
    const float l2g = log2gamma(h);
#pragma unroll
    for (int i = 0; i < 8; ++i) {
        const int idx = tid + 512 * i, row = idx >> 5, ch = idx & 31;
        const bf16_t* p = proj + (size_t)row * DIN + h * 256 + ch * 8;
        const u32x4 kv = *(const u32x4*)(p + OFF_RK), vv = *(const u32x4*)(p + OFF_RV);
        const float z = exp2f((float)(127 - row) * l2g);
        u32x4 kz;
#pragma unroll
        for (int q = 0; q < 4; ++q) kz[q] = pk2(bflo(kv[q]) * z, bfhi(kv[q]) * z);
        *(LAS u32x4*)(Ks + row * 544 + ch * 16) = kz; *(LAS u32x4*)(Vs + row * 544 + ch * 16) = vv;
    }
    __syncthreads();
#pragma unroll 1
    for (int nh = 0; nh < 2; ++nh) {
        f32x4 acc[2][8];
#pragma unroll
        for (int mb = 0; mb < 2; ++mb)
#pragma unroll
            for (int nb = 0; nb < 8; ++nb) acc[mb][nb] = (f32x4){0.f, 0.f, 0.f, 0.f};
#pragma unroll
        for (int ks = 0; ks < 4; ++ks) {
            const int j0 = 32 * ks + 4 * g + tq4;
            bf16x8 af[2];
#pragma unroll
            for (int mb = 0; mb < 2; ++mb) { const int col = 32 * w + 16 * mb + 4 * tp4; af[mb] = cat8(trrd(Vs + j0 * 544 + col * 2), trrd(Vs + (j0 + 16) * 544 + col * 2)); }
#pragma unroll
            for (int nb = 0; nb < 8; ++nb) {
                const int col = 128 * nh + 16 * nb + 4 * tp4;
                const bf16x8 bfr = cat8(trrd(Ks + j0 * 544 + col * 2), trrd(Ks + (j0 + 16) * 544 + col * 2));
#pragma unroll
                for (int mb = 0; mb < 2; ++mb) acc[mb][nb] = mfma16(af[mb], bfr, acc[mb][nb]);
            }
        }
        bf16_t* kvb = (bf16_t*)(ws + WS_KVB) + ((size_t)((b * 4 + h) * 32 + c)) * 65536 + 128 * nh;
#pragma unroll
        for (int mb = 0; mb < 2; ++mb)
#pragma unroll
            for (int nb = 0; nb < 8; ++nb)
#pragma unroll
                for (int rg = 0; rg < 4; ++rg) kvb[(size_t)(32 * w + 16 * mb + 4 * g + rg) * 256 + 16 * nb + l15] = f2bf(acc[mb][nb][rg]);
    }
    __syncthreads();
}

DI void lru_stripe(const Args& a, int layer, int stripe, LAS unsigned char* lds) {
    unsigned char* ws = a.ws;
    const int tid = mk_tid(), lane = tid & 63, w = __builtin_amdgcn_readfirstlane(tid >> 6), g = lane >> 4, l15 = lane & 15;
    const int b = stripe >> 4, blk = stripe & 15;
    LAS bf16_t* lxs = (LAS bf16_t*)lds;
    LAS bf16_t* lgs0 = (LAS bf16_t*)(lds + 16896);
    LAS unsigned char* xcb = lds + 49664;
    LAS float* rgt = (LAS float*)(lds + 68096);
    LAS float* igt = (LAS float*)(lds + 100864);
    LAS float* wst = (LAS float*)(lds + 133632);
    const bf16_t* proj = (const bf16_t*)(ws + WS_PROJ) + (size_t)b * SEQ * DIN;
    const int gc = blk * 64 + lane;
    const float* cw = a.in[2] + (size_t)layer * 4096;
    const int cch_ = tid & 63, cgc = blk * 64 + cch_;
    const float cw0 = cw[cgc], cw1 = cw[1024 + cgc], cw2 = cw[2048 + cgc], cw3 = cw[3072 + cgc], cb = a.in[3][layer * 1024 + cgc];
    const float cc = ((const float*)(ws + WS_CCH))[gc] * 1.4426950408889634f;
    float bia[4], bix[4];
    LAS unsigned char* wlds = lds + 137728;
    { const int r = tid >> 3, c8 = tid & 7; *(LAS u32x4*)(wlds + r * 144 + c8 * 16) = *(const u32x4*)((const bf16_t*)(ws + WS_WAT) + blk * 4096 + r * 64 + c8 * 8); }
    bf16x8 wfx[4][2];
#pragma unroll
    for (int nb = 0; nb < 4; ++nb)
#pragma unroll
        for (int ks = 0; ks < 2; ++ks) wfx[nb][ks] = *(const bf16x8*)((const bf16_t*)(ws + WS_WXT) + blk * 4096 + (16 * nb + l15) * 64 + 32 * ks + 8 * g);
#pragma unroll
    for (int nb = 0; nb < 4; ++nb) { bia[nb] = -1.4426950408889634f * a.in[5][layer * 1024 + blk * 64 + 16 * nb + l15]; bix[nb] = -1.4426950408889634f * a.in[7][layer * 1024 + blk * 64 + 16 * nb + l15]; }
    if (tid < 24) *(LAS u32x4*)(lxs + tid * 8) = (u32x4){0u, 0u, 0u, 0u};
    u32x4 plx[2], plg[2];
#pragma unroll
    for (int i = 0; i < 2; ++i) { const int idx = tid + 512 * i, row = idx >> 3, c8 = idx & 7; const bf16_t* p = proj + (size_t)row * DIN + blk * 64 + c8 * 8; plx[i] = *(const u32x4*)(p + OFF_LX); plg[i] = *(const u32x4*)(p + OFF_LG); }
    float hcarry = 0.0f;
#pragma unroll 1
    for (int c = 0; c < 32; ++c) {
        LAS bf16_t* lgs = lgs0 + (c & 1) * 8192;
#pragma unroll
        for (int i = 0; i < 2; ++i) { const int idx = tid + 512 * i, row = idx >> 3, c8 = idx & 7; *(LAS u32x4*)(lxs + (3 + row) * 64 + c8 * 8) = plx[i]; *(LAS u32x4*)(lgs + row * 64 + c8 * 8) = plg[i]; }
        __syncthreads();
        if (c + 1 < 32) {
#pragma unroll
            for (int i = 0; i < 2; ++i) { const int idx = tid + 512 * i, row = idx >> 3, c8 = idx & 7; const bf16_t* p = proj + (size_t)((c + 1) * 128 + row) * DIN + blk * 64 + c8 * 8; plx[i] = *(const u32x4*)(p + OFF_LX); plg[i] = *(const u32x4*)(p + OFF_LG); }
        }
        {
            const int t0 = (tid >> 6) * 16;
            float x0 = bf2f(lxs[t0 * 64 + cch_]), x1 = bf2f(lxs[(t0 + 1) * 64 + cch_]), x2 = bf2f(lxs[(t0 + 2) * 64 + cch_]);
#pragma unroll
            for (int i = 0; i < 16; ++i) {
                const float x3 = bf2f(lxs[(t0 + i + 3) * 64 + cch_]);
                const float xc = cb + cw0 * x0 + cw1 * x1 + cw2 * x2 + cw3 * x3;
                *(LAS bf16_t*)(xcb + (t0 + i) * 144 + cch_ * 2) = f2bf(xc);
                x0 = x1; x1 = x2; x2 = x3;
            }
        }
        __syncthreads();
        if (tid < 24) *(LAS u32x4*)(lxs + tid * 8) = *(const LAS u32x4*)(lxs + 128 * 64 + tid * 8);
        {
            const bf16x8 af0 = *(const LAS bf16x8*)(xcb + (16 * w + l15) * 144 + (8 * g) * 2), af1 = *(const LAS bf16x8*)(xcb + (16 * w + l15) * 144 + (32 + 8 * g) * 2);
#pragma unroll
            for (int nb = 0; nb < 4; ++nb) {
                f32x4 ar = {0.f, 0.f, 0.f, 0.f}, ax = {0.f, 0.f, 0.f, 0.f};
                const LAS unsigned char* wr_ = wlds + (16 * nb + l15) * 144 + 16 * g;
                ar = mfma16(af0, *(const LAS bf16x8*)(wr_), ar); ar = mfma16(af1, *(const LAS bf16x8*)(wr_ + 64), ar);
                ax = mfma16(af0, wfx[nb][0], ax); ax = mfma16(af1, wfx[nb][1], ax);
#pragma unroll
                for (int rg = 0; rg < 4; ++rg) { rgt[(16 * w + 4 * g + rg) * 64 + 16 * nb + l15] = __builtin_amdgcn_rcpf(1.0f + __builtin_amdgcn_exp2f(ar[rg] + bia[nb])); igt[(16 * w + 4 * g + rg) * 64 + 16 * nb + l15] = __builtin_amdgcn_rcpf(1.0f + __builtin_amdgcn_exp2f(ax[rg] + bix[nb])); }
            }
        }
        __syncthreads();
        float av[16], bv[16]; float Aw = 1.0f, Hw = 0.0f;
#pragma unroll
        for (int tt = 0; tt < 16; ++tt) {
            const int t = 16 * w + tt;
            const float aa = __builtin_amdgcn_exp2f(cc * rgt[t * 64 + lane]);
            const float bb = __builtin_amdgcn_sqrtf(fmaxf(1.0f - aa * aa, 0.0f)) * igt[t * 64 + lane] * bf2f(*(const LAS bf16_t*)(xcb + t * 144 + lane * 2));
            av[tt] = aa; bv[tt] = bb; Hw = aa * Hw + bb; Aw *= aa;
        }
        wst[w * 64 + lane] = Aw; wst[512 + w * 64 + lane] = Hw;
        __syncthreads();
        float hcur = hcarry, hend = hcarry;
#pragma unroll
        for (int ww = 0; ww < 8; ++ww) { const float A_ = wst[ww * 64 + lane], H_ = wst[512 + ww * 64 + lane]; hend = A_ * hend + H_; if (ww < w) hcur = hend; }
        hcarry = hend;
        bf16_t* yb = (bf16_t*)(ws + WS_YB) + ((size_t)b * SEQ + c * 128 + 16 * w) * 1024 + gc;
#pragma unroll
        for (int tt = 0; tt < 16; tt += 2) {
            const float h0 = av[tt] * hcur + bv[tt]; hcur = av[tt + 1] * h0 + bv[tt + 1];
            yb[(size_t)tt * 1024] = f2bf(h0 * bf2f(lgs[(16 * w + tt) * 64 + lane])); yb[(size_t)(tt + 1) * 1024] = f2bf(hcur * bf2f(lgs[(16 * w + tt + 1) * 64 + lane]));
        }
    }
    __syncthreads();
}

DI void retscan_unit(const Args& a, int unit) {
    unsigned char* ws = a.ws;
    const int e8 = unit * 512 + mk_tid();
    const int bh = e8 >> 13, within = e8 & 8191, h = bh & 3;
    const float g128 = exp2f(128.0f * log2gamma(h));
    bf16_t* base = (bf16_t*)(ws + WS_KVB) + (size_t)bh * 32 * 65536 + (size_t)within * 8;
    float st[8];
#pragma unroll
    for (int q = 0; q < 8; ++q) st[q] = 0.f;
#pragma unroll 1
    for (int c0 = 0; c0 < 32; c0 += 8) {
        u32x4 kv[8];
#pragma unroll
        for (int q = 0; q < 8; ++q) kv[q] = *(const u32x4*)(base + (size_t)(c0 + q) * 65536);
#pragma unroll
        for (int q = 0; q < 8; ++q) {
            u32x4 o;
#pragma unroll
            for (int j = 0; j < 4; ++j) o[j] = pk2(st[2 * j], st[2 * j + 1]);
            *(u32x4*)(base + (size_t)(c0 + q) * 65536) = o;
#pragma unroll
            for (int j = 0; j < 4; ++j) { st[2 * j] = g128 * st[2 * j] + bflo(kv[q][j]); st[2 * j + 1] = g128 * st[2 * j + 1] + bfhi(kv[q][j]); }
        }
    }
}

DI void attmerge_unit(const Args& a, int unit) {
    unsigned char* ws = a.ws;
    const int idx = unit * 512 + mk_tid(), t = idx >> 6, hp = (idx >> 4) & 3, dc = idx & 15;
    const float* lse = (const float*)(ws + WS_LSE) + (size_t)t * 12;
    const float l0 = lse[hp], l1 = lse[4 + hp], l2 = lse[8 + hp];
    const float m = fmaxf(l0, fmaxf(l1, l2));
    float w0 = __builtin_amdgcn_exp2f(l0 - m), w1 = __builtin_amdgcn_exp2f(l1 - m), w2 = __builtin_amdgcn_exp2f(l2 - m);
    const float is = 1.0f / (w0 + w1 + w2); w0 *= is; w1 *= is; w2 *= is;
    const bf16_t* o = (const bf16_t*)(ws + WS_OATT) + (size_t)t * 1536 + hp * 128 + dc * 8;
    const u32x4 a0 = *(const u32x4*)o, a1 = *(const u32x4*)(o + 512), a2 = *(const u32x4*)(o + 1024);
    u32x4 r;
#pragma unroll
    for (int q = 0; q < 4; ++q) r[q] = pk2(w0 * bflo(a0[q]) + w1 * bflo(a1[q]) + w2 * bflo(a2[q]), w0 * bfhi(a0[q]) + w1 * bfhi(a1[q]) + w2 * bfhi(a2[q]));
    *(u32x4*)((bf16_t*)(ws + WS_YA) + (size_t)t * 512 + hp * 128 + dc * 8) = r;
}

DI void retout_unit(const Args& a, int unit, LAS unsigned char* lds) {
    unsigned char* ws = a.ws;
    const int tid = mk_tid(), lane = tid & 63, w = __builtin_amdgcn_readfirstlane(tid >> 6), g = lane >> 4, l15 = lane & 15, tq4 = l15 >> 2, tp4 = l15 & 3;
    const int b = unit >> 7, h = (unit >> 5) & 3, c = unit & 31;
    const bf16_t* proj = (const bf16_t*)(ws + WS_PROJ) + ((size_t)b * SEQ + c * 128) * DIN;
    const bf16_t* rt = (const bf16_t*)(ws + WS_KVB) + ((size_t)((b * 4 + h) * 32 + c)) * 65536;
    LAS unsigned char* RA = lds; LAS unsigned char* RB = lds + 128 * 544;
    const float l2g = log2gamma(h);
    const int qi = 16 * w + l15;
    bf16x8 qf[8];
#pragma unroll
    for (int ks = 0; ks < 8; ++ks) qf[ks] = *(const bf16x8*)(proj + (size_t)qi * DIN + OFF_RQ + h * 256 + 32 * ks + 8 * g);
#pragma unroll
    for (int i = 0; i < 8; ++i) {
        const int idx = tid + 512 * i, row = idx >> 5, ch = idx & 31;
        *(LAS u32x4*)(RA + row * 544 + ch * 16) = *(const u32x4*)(proj + (size_t)row * DIN + OFF_RK + h * 256 + ch * 8);
        *(LAS u32x4*)(RB + row * 544 + ch * 16) = *(const u32x4*)(rt + (size_t)row * 256 + ch * 8);
    }
    __syncthreads();
    u32x4 pv[8], pr[8];
#pragma unroll
    for (int i = 0; i < 8; ++i) {
        const int idx = tid + 512 * i, row = idx >> 5, ch = idx & 31;
        pv[i] = *(const u32x4*)(proj + (size_t)row * DIN + OFF_RV + h * 256 + ch * 8);
        pr[i] = *(const u32x4*)(rt + (size_t)(128 + row) * 256 + ch * 8);
    }
    f32x4 sacc[8], oacc[16];
#pragma unroll
    for (int jj = 0; jj < 8; ++jj) {
        f32x4 acc = {0.f, 0.f, 0.f, 0.f};
        if (jj <= w) {
#pragma unroll
            for (int ks = 0; ks < 8; ++ks) { const bf16x8 kf = *(const LAS bf16x8*)(RA + (16 * jj + l15) * 544 + (32 * ks + 8 * g) * 2); acc = mfma16(kf, qf[ks], acc); }
        }
        sacc[jj] = acc;
    }
#pragma unroll
    for (int db = 0; db < 8; ++db) {
        f32x4 acc = {0.f, 0.f, 0.f, 0.f};
#pragma unroll
        for (int ks = 0; ks < 8; ++ks) { const bf16x8 rf = *(const LAS bf16x8*)(RB + (16 * db + l15) * 544 + (32 * ks + 8 * g) * 2); acc = mfma16(rf, qf[ks], acc); }
        oacc[db] = acc;
    }
    __syncthreads();
#pragma unroll
    for (int i = 0; i < 8; ++i) {
        const int idx = tid + 512 * i, row = idx >> 5, ch = idx & 31;
        *(LAS u32x4*)(RA + row * 544 + ch * 16) = pv[i];
        *(LAS u32x4*)(RB + row * 544 + ch * 16) = pr[i];
    }
    __syncthreads();
#pragma unroll
    for (int db = 0; db < 8; ++db) {
        f32x4 acc = {0.f, 0.f, 0.f, 0.f};
#pragma unroll
        for (int ks = 0; ks < 8; ++ks) { const bf16x8 rf = *(const LAS bf16x8*)(RB + (16 * db + l15) * 544 + (32 * ks + 8 * g) * 2); acc = mfma16(rf, qf[ks], acc); }
        oacc[8 + db] = acc;
    }
    const float xi = __builtin_amdgcn_exp2f((float)(qi + 1) * l2g);
#pragma unroll
    for (int db = 0; db < 16; ++db) oacc[db] = oacc[db] * xi;
#pragma unroll
    for (int jj = 0; jj < 8; ++jj)
#pragma unroll
        for (int rg = 0; rg < 4; ++rg) { const int j = 16 * jj + 4 * g + rg; sacc[jj][rg] = (qi >= j) ? sacc[jj][rg] * __builtin_amdgcn_exp2f((float)(qi - j) * l2g) : 0.f; }
#pragma unroll
    for (int s = 0; s < 4; ++s) {
        if (2 * s <= w) {
            u32x4 pw; pw.x = pk2(sacc[2 * s][0], sacc[2 * s][1]); pw.y = pk2(sacc[2 * s][2], sacc[2 * s][3]); pw.z = pk2(sacc[2 * s + 1][0], sacc[2 * s + 1][1]); pw.w = pk2(sacc[2 * s + 1][2], sacc[2 * s + 1][3]);
            const bf16x8 pb = __builtin_bit_cast(bf16x8, pw);
            const int k0 = 32 * s + 4 * g + tq4;
#pragma unroll
            for (int db = 0; db < 16; ++db) {
                const s16x4 lo = trrd(RA + k0 * 544 + (16 * db + 4 * tp4) * 2), hi = trrd(RA + (k0 + 16) * 544 + (16 * db + 4 * tp4) * 2);
                oacc[db] = mfma16(cat8(lo, hi), pb, oacc[db]);
            }
        }
    }
    float s1 = 0.f;
#pragma unroll
    for (int db = 0; db < 16; ++db) s1 += (oacc[db][0] + oacc[db][1]) + (oacc[db][2] + oacc[db][3]);
    s1 += __shfl_xor(s1, 16); s1 += __shfl_xor(s1, 32);
    const float mean = s1 * (1.0f / 256.0f);
    float s2 = 0.f;
#pragma unroll
    for (int db = 0; db < 16; ++db)
#pragma unroll
        for (int rg = 0; rg < 4; ++rg) { const float dd = oacc[db][rg] - mean; s2 += dd * dd; }
    s2 += __shfl_xor(s2, 16); s2 += __shfl_xor(s2, 32);
    const float rstd = rsqrtf(s2 * (1.0f / 256.0f) + LN_EPS);
    __syncthreads();
#pragma unroll
    for (int db = 0; db < 16; ++db) {
        u32x2 o; o.x = pk2((oacc[db][0] - mean) * rstd, (oacc[db][1] - mean) * rstd); o.y = pk2((oacc[db][2] - mean) * rstd, (oacc[db][3] - mean) * rstd);
        *(LAS u32x2*)(RA + qi * 528 + (16 * db + 4 * g) * 2) = o;
    }
    __syncthreads();
#pragma unroll
    for (int i = 0; i < 8; ++i) {
        const int idx = tid + 512 * i, row = idx >> 5, ch = idx & 31;
        const u32x4 nv = *(const LAS u32x4*)(RA + row * 528 + ch * 16);
        const u32x4 gw = *(const u32x4*)(proj + (size_t)row * DIN + OFF_RG + h * 256 + ch * 8);
        u32x4 o;
#pragma unroll
        for (int q = 0; q < 4; ++q) { const float g0 = bflo(gw[q]), g1 = bfhi(gw[q]); o[q] = pk2(g0 * sigm(g0) * bflo(nv[q]), g1 * sigm(g1) * bfhi(nv[q])); }
        *(u32x4*)((bf16_t*)(ws + WS_YC) + ((size_t)b * SEQ + c * 128 + row) * 1024 + h * 256 + ch * 8) = o;
    }
    __syncthreads();
}

struct EpiBranch {
    static constexpr bool PERM = false, AFTER_DRAIN = false;
    const bf16_t* gate; bf16_t* mf; bf16_t* mb; int mode;
    __device__ __forceinline__ void operator()(const f32x4 (&acc)[2][2][4][2], const pg8::Unit& u, int wr, int wc, int fr, int fq) const {
        const int row0 = u.pm * 256 + wr * 64 + fr, col0 = u.pn * 256 + wc * 32 + 4 * fq;
        bf16_t* dst = (mode == 2) ? mb : mf;
#pragma unroll
        for (int ai = 0; ai < 2; ++ai) {
            u32x2 gw[4][2][2], old[4][2][2];
#pragma unroll
            for (int m = 0; m < 4; ++m) { const size_t row = (size_t)(row0 + ai * 128 + m * 16);
#pragma unroll
                for (int bj = 0; bj < 2; ++bj)
#pragma unroll
                    for (int n = 0; n < 2; ++n) { const int col = col0 + bj * 128 + n * 16;
                        gw[m][bj][n] = *(const u32x2*)(gate + row * DIN + col);
                        old[m][bj][n] = (mode != 0) ? *(const u32x2*)(mf + row * 1024 + col) : (u32x2){0u, 0u}; } }
#pragma unroll
            for (int m = 0; m < 4; ++m) { const size_t row = (size_t)(row0 + ai * 128 + m * 16);
#pragma unroll
                for (int bj = 0; bj < 2; ++bj)
#pragma unroll
                    for (int n = 0; n < 2; ++n) { const int col = col0 + bj * 128 + n * 16;
                        const u32x2 g2 = gw[m][bj][n], o2 = old[m][bj][n];
                        f32x4 v = acc[ai][bj][m][n];
                        v[0] = v[0] * sigm(bflo(g2.x)) + bflo(o2.x); v[1] = v[1] * sigm(bfhi(g2.x)) + bfhi(o2.x);
                        v[2] = v[2] * sigm(bflo(g2.y)) + bflo(o2.y); v[3] = v[3] * sigm(bfhi(g2.y)) + bfhi(o2.y);
                        u32x2 o; o.x = pk2(v[0], v[1]); o.y = pk2(v[2], v[3]); *(u32x2*)(dst + row * 1024 + col) = o; } }
        }
    }
};
#ifndef MK_EPI_AUX
#define MK_EPI_AUX 0
#endif
struct EpiInProj {
    static constexpr bool PERM = true, AFTER_DRAIN = false;
    bf16_t* O;
    __device__ __forceinline__ void operator()(const f32x4 (&acc)[2][2][4][2], const pg8::Unit& u, int wr_, int wc_, int fr_, int fq_) const {
        (void)wr_; (void)wc_; (void)fr_; (void)fq_;
        const int tid = mk_tid(), wid = tid >> 6, lane = tid & 63, wr = wid >> 2, wc = wid & 3, fr = lane & 15, fq = lane >> 4;
        const __amdgpu_buffer_rsrc_t rsrc = __builtin_amdgcn_make_buffer_rsrc((void*)O, 0, (int)((size_t)NTOK * DIN * 2), 0x00020000);
        const int row0 = u.pm * 256 + wr * 64 + fr;
        const int pn = u.pn;
        const bool ropeA = pn < 12, ropeR = (pn >= 26 && pn < 34);
        const float dsc = 1.0f / (X8_SCALE * W8_SCALE);
        if (!(ropeA || ropeR)) {
            const int col0 = pn * 256 + 64 * wc + 8 * fq;
            const bool isLG = (pn >= 22 && pn < 26);
#pragma unroll
            for (int ai = 0; ai < 2; ++ai) {
#pragma unroll
                for (int m = 0; m < 4; ++m) { const unsigned roff = (unsigned)(((size_t)(row0 + ai * 128 + m * 16) * DIN + col0) * 2);
#pragma unroll
                    for (int bj = 0; bj < 2; ++bj) { f32x4 v0 = acc[ai][bj][m][0] * dsc, v1 = acc[ai][bj][m][1] * dsc;
                        if (isLG) { const pg8::f32x2 g0 = pg8::gelu_pk((pg8::f32x2){v0[0], v0[1]}), g1 = pg8::gelu_pk((pg8::f32x2){v0[2], v0[3]}), g2 = pg8::gelu_pk((pg8::f32x2){v1[0], v1[1]}), g3 = pg8::gelu_pk((pg8::f32x2){v1[2], v1[3]});
                            v0 = (f32x4){g0.x, g0.y, g1.x, g1.y}; v1 = (f32x4){g2.x, g2.y, g3.x, g3.y}; }
                        u32x4 w; w.x = pk2(v0[0], v0[1]); w.y = pk2(v0[2], v0[3]); w.z = pk2(v1[0], v1[1]); w.w = pk2(v1[2], v1[3]);
                        __builtin_amdgcn_raw_buffer_store_b128(w, rsrc, (int)(roff + bj * 64), 0, MK_EPI_AUX); } }
            }
        } else {
            const int half = ropeA ? 64 : 128;
            const float sc = (pn >= 30 && pn < 34) ? 0.0625f : 1.0f;
            const float kf = ropeA ? (-13.287712379549449f / 64.0f) : (-13.287712379549449f / 128.0f);
            const float pos0 = (float)(row0 & (SEQ - 1));
#pragma unroll
            for (int bj = 0; bj < 2; ++bj) {
                const int pc = 64 * wc + 32 * bj + 8 * fq;
                const int cbase = ropeA ? (pc & 128) : 0;
                const int q = ropeA ? ((pc & 127) >> 3) : (pc >> 3);
                f32x4 cb, sb, c16, s16, cb1, sb1;
#pragma unroll
                for (int e = 0; e < 4; ++e) {
                    const float f = __builtin_amdgcn_exp2f((float)(4 * q + e) * kf) * 0.15915494309189535f;
                    const float t0 = __builtin_amdgcn_fractf(pos0 * f), t16 = __builtin_amdgcn_fractf(16.0f * f), t128 = __builtin_amdgcn_fractf(128.0f * f);
                    cb[e] = __builtin_amdgcn_cosf(t0); sb[e] = __builtin_amdgcn_sinf(t0);
                    c16[e] = __builtin_amdgcn_cosf(t16); s16[e] = __builtin_amdgcn_sinf(t16);
                    const float c128 = __builtin_amdgcn_cosf(t128), s128 = __builtin_amdgcn_sinf(t128);
                    cb1[e] = cb[e] * c128 - sb[e] * s128; sb1[e] = sb[e] * c128 + cb[e] * s128;
                }
#pragma unroll
                for (int ai = 0; ai < 2; ++ai) {
                    f32x4 cv = ai ? cb1 : cb, sv = ai ? sb1 : sb;
#pragma unroll
                    for (int m = 0; m < 4; ++m) {
                        const int row = row0 + ai * 128 + m * 16;
                        const unsigned roff = (unsigned)(((size_t)row * DIN + pn * 256) * 2);
                        const float rsc = dsc * sc;
                        const f32x4 t1 = acc[ai][bj][m][0] * rsc, t2 = acc[ai][bj][m][1] * rsc;
                        const f32x4 o1 = t1 * cv - t2 * sv, o2 = t1 * sv + t2 * cv;
                        u32x2 w1, w2; w1.x = pk2(o1[0], o1[1]); w1.y = pk2(o1[2], o1[3]); w2.x = pk2(o2[0], o2[1]); w2.y = pk2(o2[2], o2[3]);
                        __builtin_amdgcn_raw_buffer_store_b64(w1, rsrc, (int)(roff + (cbase + 4 * q) * 2), 0, MK_EPI_AUX); __builtin_amdgcn_raw_buffer_store_b64(w2, rsrc, (int)(roff + (cbase + half + 4 * q) * 2), 0, MK_EPI_AUX);
                        if (m < 3) { const f32x4 cn = cv * c16 - sv * s16, sn = sv * c16 + cv * s16; cv = cn; sv = sn; }
                    }
                }
            }
        }
    }
};

struct EpiOut {
    static constexpr bool PERM = false, AFTER_DRAIN = false;
    const float* xf; float* z;
    __device__ __forceinline__ void operator()(const f32x4 (&acc)[2][2][4][2], const pg8::Unit& u, int wr, int wc, int fr, int fq) const {
        const int row0 = u.pm * 256 + wr * 64 + fr, col0 = u.pn * 256 + wc * 32 + 4 * fq;
#pragma unroll
        for (int ai = 0; ai < 2; ++ai) {
            f32x4 xv[4][2][2];
#pragma unroll
            for (int m = 0; m < 4; ++m) { const size_t row = (size_t)(row0 + ai * 128 + m * 16);
#pragma unroll
                for (int bj = 0; bj < 2; ++bj)
#pragma unroll
                    for (int n = 0; n < 2; ++n) xv[m][bj][n] = *(const f32x4*)(xf + row * 1024 + col0 + bj * 128 + n * 16); }
#pragma unroll
            for (int m = 0; m < 4; ++m) { const size_t row = (size_t)(row0 + ai * 128 + m * 16);
#pragma unroll
                for (int bj = 0; bj < 2; ++bj)
#pragma unroll
                    for (int n = 0; n < 2; ++n) *(f32x4*)(z + row * 1024 + col0 + bj * 128 + n * 16) = xv[m][bj][n] * ALPHA + acc[ai][bj][m][n]; }
        }
    }
};

DI void ln_row(const float* z, const float* gam, const float* bet, float* of, bf16_t* ob, int lane) {
    f32x4 v[4]; float s = 0.f;
#pragma unroll
    for (int i = 0; i < 4; ++i) { v[i] = *(const f32x4*)(z + 256 * i + 4 * lane); s += (v[i][0] + v[i][1]) + (v[i][2] + v[i][3]); }
    const float mean = wsum(s) * (1.0f / 1024.0f);
    float q = 0.f;
#pragma unroll
    for (int i = 0; i < 4; ++i)
#pragma unroll
        for (int j = 0; j < 4; ++j) { const float d = v[i][j] - mean; q += d * d; }
    const float rstd = rsqrtf(wsum(q) * (1.0f / 1024.0f) + LN_EPS);
#pragma unroll
    for (int i = 0; i < 4; ++i) {
        const f32x4 gg = *(const f32x4*)(gam + 256 * i + 4 * lane), bb = *(const f32x4*)(bet + 256 * i + 4 * lane);
        f32x4 o;
#pragma unroll
        for (int j = 0; j < 4; ++j) o[j] = (v[i][j] - mean) * rstd * gg[j] + bb[j];
        *(f32x4*)(of + 256 * i + 4 * lane) = o;
        u32x2 pb; pb.x = pk2(o[0], o[1]); pb.y = pk2(o[2], o[3]); *(u32x2*)(ob + 256 * i + 4 * lane) = pb;
    }
}
DI void phase_ln1(const Args& a, int layer) {
    unsigned char* ws = a.ws;
    const int lane = mk_tid() & 63, w = mk_tid() >> 6;
    for (int u = blockIdx.x; u < NTOK / 8; u += gridDim.x) {
        const size_t row = (size_t)u * 8 + w;
        ln_row((const float*)(ws + WS_MRGF) + row * 1024, a.in[11] + layer * 1024, a.in[12] + layer * 1024, (float*)(ws + WS_XF) + row * 1024, (bf16_t*)(ws + WS_XB) + row * 1024, lane);
    }
}

DI void ins16(float (&L)[16], float x) {
#pragma unroll
    for (int k = 0; k < 16; ++k) { const float hi = fmaxf(L[k], x); x = fminf(L[k], x); L[k] = hi; }
}
DI void merge16(float (&L)[16], int xr) {
    float t[16];
#pragma unroll
    for (int k = 0; k < 16; ++k) t[k] = __shfl_xor(L[k], xr);
#pragma unroll
    for (int k = 0; k < 8; ++k) { const float x = t[k]; t[k] = t[15 - k]; t[15 - k] = x; }
#pragma unroll
    for (int k = 0; k < 16; ++k) t[k] = fmaxf(L[k], t[k]);
#define MK_CE_STAGE(dd) _Pragma("unroll") for (int k = 0; k < 16; ++k) if ((k & (dd)) == 0) { const float hi = fmaxf(t[k], t[k + (dd)]), lo = fminf(t[k], t[k + (dd)]); t[k] = hi; t[k + (dd)] = lo; }
    MK_CE_STAGE(8) MK_CE_STAGE(4) MK_CE_STAGE(2) MK_CE_STAGE(1)
#undef MK_CE_STAGE
#pragma unroll
    for (int k = 0; k < 16; ++k) L[k] = t[k];
}
#define MK_CE_DESC(v, i, l) { const float hi_ = fmaxf(v[i], v[l]), lo_ = fminf(v[i], v[l]); v[i] = hi_; v[l] = lo_; }
#define MK_CE_ASC(v, i, l)  { const float hi_ = fmaxf(v[i], v[l]), lo_ = fminf(v[i], v[l]); v[i] = lo_; v[l] = hi_; }
#define MK_BITONIC_STAGE(v, kk, jj) _Pragma("unroll") for (int i_ = 0; i_ < 16; ++i_) { if ((i_ & (jj)) == 0) { if ((i_ & (kk)) == 0) MK_CE_DESC(v, i_, i_ + (jj)) else MK_CE_ASC(v, i_, i_ + (jj)) } }
DI void sort16_desc(float (&v)[16]) {
    MK_BITONIC_STAGE(v, 2, 1)
    MK_BITONIC_STAGE(v, 4, 2) MK_BITONIC_STAGE(v, 4, 1)
    MK_BITONIC_STAGE(v, 8, 4) MK_BITONIC_STAGE(v, 8, 2) MK_BITONIC_STAGE(v, 8, 1)
    MK_BITONIC_STAGE(v, 16, 8) MK_BITONIC_STAGE(v, 16, 4) MK_BITONIC_STAGE(v, 16, 2) MK_BITONIC_STAGE(v, 16, 1)
}
DI void top16_of_two(float (&a)[16], const float (&b)[16]) {
#pragma unroll
    for (int k = 0; k < 16; ++k) a[k] = fmaxf(a[k], b[15 - k]);
    MK_BITONIC_STAGE(a, 16, 8) MK_BITONIC_STAGE(a, 16, 4) MK_BITONIC_STAGE(a, 16, 2) MK_BITONIC_STAGE(a, 16, 1)
}
DI void top16_half(const bf16_t* qp, const LAS unsigned char* kt, float (&L)[16], int g, int l15) {
    bf16x8 qf[4];
#pragma unroll
    for (int ks = 0; ks < 4; ++ks) qf[ks] = *(const bf16x8*)(qp + 32 * ks + 8 * g);
    float M[16];
#pragma unroll
    for (int kbk = 0; kbk < 8; ++kbk) {
        f32x4 acc = {0.f, 0.f, 0.f, 0.f};
#pragma unroll
        for (int ks = 0; ks < 4; ++ks) { const bf16x8 kf = *(const LAS bf16x8*)(kt + (16 * kbk + l15) * 256 + (((4 * ks + g) ^ l15) << 4)); acc = mfma16(kf, qf[ks], acc); }
#pragma unroll
        for (int rg = 0; rg < 4; ++rg) { const unsigned key = (unsigned)(16 * kbk + 4 * g + rg); const float x = __uint_as_float((__float_as_uint(acc[rg]) & ~0x7Fu) | key);
            if (kbk < 4) L[4 * kbk + rg] = x; else M[4 * (kbk - 4) + rg] = x; }
    }
    sort16_desc(L); sort16_desc(M); top16_of_two(L, M);
    merge16(L, 16); merge16(L, 32);
}
DI void topk_unit(const Args& a, int unit, LAS unsigned char* lds) {
    unsigned char* ws = a.ws;
    const int tid = mk_tid(), lane = tid & 63, w = __builtin_amdgcn_readfirstlane(tid >> 6), g = lane >> 4, l15 = lane & 15;
    const int tg = w & 3, hs = w >> 2;
    const size_t t = (size_t)unit * 64 + tg * 16 + l15;
    const bf16_t* Q = (const bf16_t*)(ws + WS_Q);
    LAS unsigned char* tiles = lds + 16384;
    float K1[16], K2[16];
#pragma unroll
    for (int k = 0; k < 16; ++k) { K1[k] = 0.f; K2[k] = 0.f; }
#pragma unroll 1
    for (int hh = 0; hh < 4; ++hh) {
#pragma unroll
        for (int i = 0; i < 16; ++i) {
            const int idx = tid + 512 * i, tile = idx >> 11, row = (idx >> 4) & 127, ch = idx & 15;
            const int hd = ((tile >> 1) ? 4 : 0) + hh;
            const bf16_t* src = (const bf16_t*)(ws + ((tile & 1) ? WS_K2B : WS_K1B)) + ((size_t)hd * 128 + row) * 128 + ch * 8;
            *(LAS u32x4*)(tiles + tile * 32768 + row * 256 + ((ch ^ (row & 15)) << 4)) = *(const u32x4*)src;
        }
        __syncthreads();
        const int h = hs * 4 + hh;
        float l1[16], l2[16];
        top16_half(Q + t * 2048 + h * 256, tiles + (hs * 2) * 32768, l1, g, l15);
        top16_half(Q + t * 2048 + h * 256 + 128, tiles + (hs * 2 + 1) * 32768, l2, g, l15);
        const bool mine = (g == hh);
#pragma unroll
        for (int k = 0; k < 16; ++k) { K1[k] = mine ? l1[k] : K1[k]; K2[k] = mine ? l2[k] : K2[k]; }
        __syncthreads();
    }
    const int h = hs * 4 + g;
    float F[16];
#pragma unroll
    for (int k = 0; k < 16; ++k) F[k] = -FLT_MAX;
#pragma unroll
    for (int ia = 0; ia < 16; ++ia)
#pragma unroll
        for (int ib = 0; ib < 16 / (ia + 1); ++ib) {
            const float s = __uint_as_float(__float_as_uint(K1[ia]) & ~0x7Fu) + __uint_as_float(__float_as_uint(K2[ib]) & ~0x7Fu);
            ins16(F, __uint_as_float((__float_as_uint(s) & ~0xFFu) | (unsigned)(ia * 16 + ib)));
        }
    LAS unsigned char* row = lds + tid * 32;
#pragma unroll
    for (int k = 0; k < 16; ++k) { row[k] = (unsigned char)(__float_as_uint(K1[k]) & 0x7Fu); row[16 + k] = (unsigned char)(__float_as_uint(K2[k]) & 0x7Fu); }
    float gt[16]; int ei[16]; float gs = 0.f;
    const float cv0 = __uint_as_float(__float_as_uint(F[0]) & ~0xFFu);
#pragma unroll
    for (int k = 0; k < 16; ++k) {
        const unsigned bits = __float_as_uint(F[k]);
        const float cv = __uint_as_float(bits & ~0xFFu);
        gt[k] = __builtin_amdgcn_exp2f((cv - cv0) * 1.4426950408889634f); gs += gt[k];
        const int ia = (int)((bits >> 4) & 15u), ib = (int)(bits & 15u);
        ei[k] = (int)row[ia] * 128 + (int)row[16 + ib];
    }
    const float ig = 1.0f / gs;
    int* ep = (int*)(ws + WS_EID) + (t * 8 + h) * 16; float* gp = (float*)(ws + WS_GATE) + (t * 8 + h) * 16;
#pragma unroll
    for (int q = 0; q < 4; ++q) {
        *(i32x4*)(ep + 4 * q) = (i32x4){ei[4 * q], ei[4 * q + 1], ei[4 * q + 2], ei[4 * q + 3]};
        *(f32x4*)(gp + 4 * q) = (f32x4){gt[4 * q] * ig, gt[4 * q + 1] * ig, gt[4 * q + 2] * ig, gt[4 * q + 3] * ig};
    }
    __syncthreads();
}

typedef float f32x2 __attribute__((ext_vector_type(2)));
typedef __bf16 bf16x32 __attribute__((ext_vector_type(32)));
typedef unsigned u32x16 __attribute__((ext_vector_type(16)));
#define MK_PB_LOAD(RA_, RB_, ereg, kb) _Pragma("unroll") for (int j = 0; j < 8; ++j) { const int e_ = __builtin_amdgcn_readlane(ereg, (kb) + j); \
        const unsigned char* p_ = UV + (size_t)(unsigned)e_ * 1536u; RA_[j] = ((const u32x4*)p_)[lane]; RB_[j] = ((const u32x2*)(p_ + 1024))[lane]; }
#define MK_PB_COMP(RA_, RB_, usreg, gvreg, kb) { \
        float pp_[8]; \
        _Pragma("unroll") for (int j = 0; j < 8; ++j) { \
            const u32x16 hw_ = __builtin_bit_cast(u32x16, __builtin_amdgcn_cvt_scalef32_pk32_bf16_fp6((u32x6){RA_[j][0], RA_[j][1], RA_[j][2], RA_[j][3], RB_[j][0], RB_[j][1]}, 1.0f)); \
            float s0_ = 0.f, s1_ = 0.f; \
            _Pragma("unroll") for (int q = 0; q < 4; ++q) { s0_ = dot2(hw_[2 * q], xpk[2 * q], s0_); s1_ = dot2(hw_[2 * q + 1], xpk[2 * q + 1], s1_); } \
            pp_[j] = s0_ + s1_; } \
        float q4_[4], r2_[2]; \
        _Pragma("unroll") for (int i = 0; i < 4; ++i) { const float keep_ = hi32 ? pp_[4 + i] : pp_[i], send_ = hi32 ? pp_[i] : pp_[4 + i]; q4_[i] = keep_ + __shfl_xor(send_, 32); } \
        _Pragma("unroll") for (int i = 0; i < 2; ++i) { const float keep_ = hi16 ? q4_[2 + i] : q4_[i], send_ = hi16 ? q4_[i] : q4_[2 + i]; r2_[i] = keep_ + __shfl_xor(send_, 16); } \
        float tot_ = (hi8 ? r2_[1] : r2_[0]) + __shfl_xor(hi8 ? r2_[0] : r2_[1], 8); \
        tot_ += __shfl_xor(tot_, 4); tot_ += __shfl_xor(tot_, 2); tot_ += __shfl_xor(tot_, 1); \
        const float act_ = gelu_as(tot_ * __shfl(usreg, (kb) + jj)) * __shfl(gvreg, (kb) + jj); \
        _Pragma("unroll") for (int j = 0; j < 8; ++j) { \
            const float aj_ = __uint_as_float(__builtin_amdgcn_readlane(__float_as_uint(act_), 32 * (j >> 2) + 16 * ((j >> 1) & 1) + 8 * (j & 1))); const f32x2 a2_ = {aj_, aj_}; \
            const f32x32 f_ = __builtin_amdgcn_cvt_scalef32_pk32_f32_fp6((u32x6){RA_[j][0], RA_[j][1], RA_[j][2], RA_[j][3], RB_[j][0], RB_[j][1]}, 1.0f); \
            _Pragma("unroll") for (int q = 0; q < 8; ++q) y2[q] += a2_ * (f32x2){f_[16 + 2 * q], f_[16 + 2 * q + 1]}; } }
DI void peer_token(const unsigned char* UV, int e0, int e1, float us0, float us1, float gv0, float gv1, const unsigned (&xpk)[8], f32x2 (&y2)[8], int lane) {
    const bool hi32 = (lane & 32) != 0, hi16 = (lane & 16) != 0, hi8 = (lane & 8) != 0;
    const int jj = ((lane >> 5) & 1) * 4 + ((lane >> 4) & 1) * 2 + ((lane >> 3) & 1);
    u32x4 A0[8], A1[8]; u32x2 B0[8], B1[8];
    MK_PB_LOAD(A0, B0, e0, 0)
#pragma unroll 1
    for (int b = 0; b < 8; b += 2) {
        MK_PB_LOAD(A1, B1, e0, 8 * b + 8)
        MK_PB_COMP(A0, B0, us0, gv0, 8 * b)
        if (b + 2 < 8) { MK_PB_LOAD(A0, B0, e0, 8 * b + 16) } else { MK_PB_LOAD(A0, B0, e1, 0) }
        MK_PB_COMP(A1, B1, us0, gv0, 8 * b + 8)
    }
#pragma unroll 1
    for (int b = 0; b < 8; b += 2) {
        MK_PB_LOAD(A1, B1, e1, 8 * b + 8)
        MK_PB_COMP(A0, B0, us1, gv1, 8 * b)
        if (b + 2 < 8) { MK_PB_LOAD(A0, B0, e1, 8 * b + 16) }
        MK_PB_COMP(A1, B1, us1, gv1, 8 * b + 8)
    }
}
DI void peer_unit(const Args& a, int layer, int unit) {
    unsigned char* ws = a.ws;
    const int tid = mk_tid(), lane = tid & 63, w = __builtin_amdgcn_readfirstlane(tid >> 6);
    const unsigned char* UV = ws + WS_UV8; const float* SC = (const float*)(ws + WS_UVS);
#pragma unroll 1
    for (int i = 0; i < 8; ++i) {
        const size_t t = (size_t)unit * 64 + w * 8 + i;
        unsigned xpk[8]; f32x2 y2[8];
        int e0, e1; float us0, us1, gv0, gv1;
        {
            const int ln = mk_tid() & 63;
            const bf16_t* xbp = (const bf16_t*)(ws + WS_XB) + t * 1024 + 16 * ln;
            const u32x4 xa = *(const u32x4*)xbp, xb = *(const u32x4*)(xbp + 8);
#pragma unroll
            for (int q = 0; q < 4; ++q) { xpk[q] = xa[q]; xpk[4 + q] = xb[q]; }
            const int* ep = (const int*)(ws + WS_EID) + t * 128; const float* gp = (const float*)(ws + WS_GATE) + t * 128;
            e0 = ep[ln]; e1 = ep[64 + ln]; const float g0 = gp[ln], g1 = gp[64 + ln];
            const f32x2 s0 = *(const f32x2*)(SC + 2 * e0), s1 = *(const f32x2*)(SC + 2 * e1);
            us0 = s0.x; us1 = s1.x; gv0 = g0 * s0.y; gv1 = g1 * s1.y;
        }
#pragma unroll
        for (int q = 0; q < 8; ++q) y2[q] = (f32x2){0.f, 0.f};
        peer_token(UV, e0, e1, us0, us1, gv0, gv1, xpk, y2, lane);
        {
            const int ln = mk_tid() & 63;
            float* xfp = (float*)(ws + WS_XF) + t * 1024 + 16 * ln;
            const float* gam = a.in[18] + layer * 1024 + 16 * ln; const float* bet = a.in[19] + layer * 1024 + 16 * ln;
            float z[16]; float s = 0.f;
#pragma unroll
            for (int q = 0; q < 4; ++q) { const f32x4 xr = *(const f32x4*)(xfp + 4 * q);
#pragma unroll
                for (int j = 0; j < 4; ++j) { z[4 * q + j] = ALPHA * xr[j] + y2[2 * q + (j >> 1)][j & 1]; s += z[4 * q + j]; } }
            const float mean = wsum(s) * (1.0f / 1024.0f);
            float qq = 0.f;
#pragma unroll
            for (int q = 0; q < 16; ++q) { const float d = z[q] - mean; qq += d * d; }
            const float rstd = rsqrtf(wsum(qq) * (1.0f / 1024.0f) + LN_EPS);
            f32x4 o[4];
#pragma unroll
            for (int q = 0; q < 4; ++q) { const f32x4 gq = *(const f32x4*)(gam + 4 * q), bq = *(const f32x4*)(bet + 4 * q);
#pragma unroll
                for (int j = 0; j < 4; ++j) o[q][j] = (z[4 * q + j] - mean) * rstd * gq[j] + bq[j]; }
#pragma unroll
            for (int q = 0; q < 4; ++q) *(f32x4*)(xfp + 4 * q) = o[q];
            if (layer == DEPTH - 1) { float* op = a.out + t * 1024 + 16 * ln;
#pragma unroll
                for (int q = 0; q < 4; ++q) *(f32x4*)(op + 4 * q) = o[q]; }
            row_to_fp8(o, ws + WS_X8 + t * 1024, ln);
        }
    }
}
}

namespace mk {
constexpr int LDS_ARG_OFF = LDS_BYTES - 16 - 256;
#define MK_NOINL __device__ __forceinline__
DI unsigned long long rfl64(unsigned long long v) { const unsigned lo = __builtin_amdgcn_readfirstlane((unsigned)v), hi = __builtin_amdgcn_readfirstlane((unsigned)(v >> 32)); return ((unsigned long long)hi << 32) | lo; }
DI Args load_args(LAS unsigned char* lds) {
    int aoff = LDS_ARG_OFF; asm volatile("" : "+s"(aoff));
    Args a; const LAS unsigned long long* p = (const LAS unsigned long long*)(lds + aoff);
#pragma unroll
    for (int i = 0; i < 20; ++i) a.in[i] = (const float*)(const __attribute__((address_space(1))) float*)rfl64(p[i]);
    a.out = (float*)(__attribute__((address_space(1))) float*)rfl64(p[20]); a.ws = (unsigned char*)(__attribute__((address_space(1))) unsigned char*)rfl64(p[21]);
    a.ropeA = __longlong_as_double((long long)rfl64(p[22])); a.ropeR = __longlong_as_double((long long)rfl64(p[23])); a.ph_lo = 0; a.ph_hi = 0;
    return a;
}
#define MK_LOADARGS const Args a = load_args(lds); unsigned char* ws = a.ws; const int G = (int)gridDim.x, bid = (int)blockIdx.x; (void)ws; (void)G; (void)bid
MK_NOINL void PG_prologue(LAS unsigned char* lds) { MK_LOADARGS; phase_prologue(a); }
MK_NOINL void P0_conv(LAS unsigned char* lds, int layer) { MK_LOADARGS; phase_conv(a, layer, lds); }
#ifndef MK_STAGGER_TICKS
#define MK_STAGGER_TICKS 140
#endif
MK_NOINL void P1_inproj(LAS unsigned char* lds, int layer) { MK_LOADARGS; (void)layer;
    pg8::Gemm gm; gm.A = (const bf16_t*)(ws + WS_X8); gm.Bt = (const bf16_t*)(ws + WS_WINT); gm.M = NTOK; gm.N = DIN; gm.K = 512;
    pg8::StaticOrder S; S.init(NTOK, DIN, G, bid);
    EpiInProj E; E.O = (bf16_t*)(ws + WS_PROJ);
    pg8::gemm_phase<EpiInProj, pg8::StaticOrder, false, true, true>(lds, gm, S, E, nullptr); }
#ifndef MK_NLRU
#define MK_NLRU 64
#endif
MK_NOINL void P3s_lru(LAS unsigned char* lds, int layer) { MK_LOADARGS; if (bid < MK_NLRU) { for (int s = bid; s < 64; s += MK_NLRU) lru_stripe(a, layer, s, lds); } }
MK_NOINL void P3a_attn(LAS unsigned char* lds, int layer) { MK_LOADARGS; (void)layer; if (bid >= MK_NLRU) { for (int u = bid - MK_NLRU; u < 1536; u += G - MK_NLRU) attn_unit(a, u, lds); } }
MK_NOINL void P3b_retkv(LAS unsigned char* lds, int layer) { MK_LOADARGS; (void)layer; if (bid >= MK_NLRU) { for (int u = bid - MK_NLRU; u < 512; u += G - MK_NLRU) retkv_unit(a, u, lds); } }
MK_NOINL void P4a_scan(LAS unsigned char* lds, int layer) { MK_LOADARGS; (void)layer; for (int u = bid; u < 256; u += G) retscan_unit(a, u); }
MK_NOINL void P4c_merge(LAS unsigned char* lds, int layer) { MK_LOADARGS; (void)layer; for (int u = bid; u < 2048; u += G) attmerge_unit(a, u); }
MK_NOINL void P5_retout(LAS unsigned char* lds, int layer) { MK_LOADARGS; (void)layer; for (int u = bid; u < 512; u += G) retout_unit(a, u, lds); }
MK_NOINL void P6_branch(LAS unsigned char* lds, int layer) { MK_LOADARGS; (void)layer;
#pragma unroll 1
    for (int s = 0; s < 3; ++s) {
        pg8::Gemm gm; gm.A = (const bf16_t*)(ws + (s == 0 ? WS_YA : (s == 1 ? WS_YB : WS_YC))); gm.Bt = (const bf16_t*)(ws + (s == 0 ? WS_WBAT : (s == 1 ? WS_WBBT : WS_WBCT)));
        gm.M = NTOK; gm.N = 1024; gm.K = (s == 0) ? 512 : 1024;
        pg8::StaticOrder S; S.init(NTOK, 1024, G, bid);
        EpiBranch E; E.gate = (const bf16_t*)(ws + WS_PROJ) + OFF_GA + 1024 * s; E.mf = (bf16_t*)(ws + WS_MRGF); E.mb = (bf16_t*)(ws + WS_MRGB); E.mode = s;
        pg8::gemm_phase<EpiBranch, pg8::StaticOrder, false>(lds, gm, S, E, nullptr);
    } }
MK_NOINL void P7_outproj(LAS unsigned char* lds, int layer) { MK_LOADARGS; (void)layer;
    pg8::Gemm gm; gm.A = (const bf16_t*)(ws + WS_MRGB); gm.Bt = (const bf16_t*)(ws + WS_WOT); gm.M = NTOK; gm.N = 1024; gm.K = 1024;
    pg8::StaticOrder S; S.init(NTOK, 1024, G, bid);
    EpiOut E; E.xf = (const float*)(ws + WS_XF); E.z = (float*)(ws + WS_MRGF);
    pg8::gemm_phase<EpiOut, pg8::StaticOrder, false>(lds, gm, S, E, nullptr); }
MK_NOINL void P8_ln1(LAS unsigned char* lds, int layer) { MK_LOADARGS; phase_ln1(a, layer); }
MK_NOINL void P9_wq(LAS unsigned char* lds, int layer) { MK_LOADARGS; (void)layer;
    pg8::Gemm gm; gm.A = (const bf16_t*)(ws + WS_XB); gm.Bt = (const bf16_t*)(ws + WS_WQT); gm.M = NTOK; gm.N = 2048; gm.K = 1024;
    pg8::StaticOrder S; S.init(NTOK, 2048, G, bid);
    pg8::EpiBf16<0> E; E.O = (bf16_t*)(ws + WS_Q); E.ldc = 2048; E.bias = nullptr; E.split_cols = 0; E.split_stride = 0;
    pg8::gemm_phase<pg8::EpiBf16<0>, pg8::StaticOrder, false>(lds, gm, S, E, nullptr); }
MK_NOINL void P10_topk(LAS unsigned char* lds, int layer) { MK_LOADARGS; (void)layer; for (int u = bid; u < NTOK / 64; u += G) topk_unit(a, u, lds); }
MK_NOINL void P11_peer(LAS unsigned char* lds, int layer) { MK_LOADARGS; for (int u = bid; u < NTOK / 64; u += G) peer_unit(a, layer, u); }
DI void mk_sync(LAS unsigned char* lds) {
    const Args a = load_args(lds);
    XcdBarrier b; b.bar = (unsigned*)(a.ws + WS_CTL); b.x = xb_xcc_id(); b.st = (volatile LAS unsigned*)(lds + LDS_BAR_OFF);
    xcd_barrier(b);
}
}

#ifndef MK_PHASE_MASK
#define MK_PHASE_MASK 0xFFFu
#endif
#define MK_RUN(k) ((((MK_PHASE_MASK) >> ((k) - pb)) & 1u) && (k) >= ph_lo && (k) < ph_hi)
#define MK_NPHASES (1 + mk::DEPTH * mk::NPH)

#define MK_SYNC(k) do { if ((k) >= ph_lo && (k) + 1 < ph_hi) mk::mk_sync(lds); } while (0)
__global__ __launch_bounds__(512, 2) void mk_fwd(mk::Args a) {
    using namespace mk;
    extern __shared__ __attribute__((aligned(16))) unsigned char smem_raw[];
    LAS unsigned char* lds = (LAS unsigned char*)smem_raw;
    const int ph_lo = a.ph_lo, ph_hi = a.ph_hi;
    {
        const unsigned* src = (const unsigned*)&a;
        if (threadIdx.x < sizeof(Args) / 4) ((LAS unsigned*)(lds + LDS_ARG_OFF))[threadIdx.x] = src[threadIdx.x];
        if (threadIdx.x == 0) { LAS unsigned* st = (LAS unsigned*)(lds + LDS_BAR_OFF); st[0] = 0u; st[1] = 0u; st[2] = 0u; st[3] = 0u; }
    }
    __syncthreads();
    if (ph_hi - ph_lo > 1) (void)xcd_barrier_post((unsigned*)(a.ws + WS_CTL), (volatile LAS unsigned*)(lds + LDS_BAR_OFF));
    if (0 >= ph_lo && 0 < ph_hi) PG_prologue(lds);
    MK_SYNC(0);
#pragma unroll 1
    for (int layer = 0; layer < DEPTH; ++layer) {
        const int pb = 1 + layer * NPH;
        if (MK_RUN(pb + 0)) P0_conv(lds, layer);
        MK_SYNC(pb + 0);
        if (MK_RUN(pb + 1)) P1_inproj(lds, layer);
        MK_SYNC(pb + 1);
        if (MK_RUN(pb + 3)) { P3s_lru(lds, layer); P3a_attn(lds, layer); P3b_retkv(lds, layer); }
        MK_SYNC(pb + 3);
        if (MK_RUN(pb + 4)) { P4a_scan(lds, layer); P4c_merge(lds, layer); }
        MK_SYNC(pb + 4);
        if (MK_RUN(pb + 5)) P5_retout(lds, layer);
        MK_SYNC(pb + 5);
        if (MK_RUN(pb + 6)) P6_branch(lds, layer);
        MK_SYNC(pb + 6);
        if (MK_RUN(pb + 7)) P7_outproj(lds, layer);
        MK_SYNC(pb + 7);
        if (MK_RUN(pb + 8)) P8_ln1(lds, layer);
        MK_SYNC(pb + 8);
        if (MK_RUN(pb + 9)) P9_wq(lds, layer);
        MK_SYNC(pb + 9);
        if (MK_RUN(pb + 10)) P10_topk(lds, layer);
        MK_SYNC(pb + 10);
        if (MK_RUN(pb + 11)) P11_peer(lds, layer);
        MK_SYNC(pb + 11);
    }
}

#ifndef MK_SINGLE
#define MK_SINGLE 1
#endif
extern "C" void kernel_launch(void* const* d_in, const int* in_sizes, int n_in, void* d_out, int out_size, void* d_ws, size_t ws_size, hipStream_t stream) {
    using namespace mk;
    static int grid = 0;
    if (grid == 0) {
        if (n_in != 20 || out_size != NTOK * D || ws_size < WS_END) { fprintf(stderr, "kernel_launch: unexpected shapes (n_in %d, out %d, ws %zu, need %zu)\n", n_in, out_size, ws_size, (size_t)WS_END); grid = -1; return; }
        int dev = 0, cus = 0, per_cu = 0;
        if (hipGetDevice(&dev) != hipSuccess || hipDeviceGetAttribute(&cus, hipDeviceAttributeMultiprocessorCount, dev) != hipSuccess) { grid = -1; return; }
        if (hipFuncSetAttribute((const void*)mk_fwd, hipFuncAttributeMaxDynamicSharedMemorySize, LDS_BYTES) != hipSuccess) { fprintf(stderr, "kernel_launch: hipFuncSetAttribute failed\n"); grid = -1; return; }
        if (hipOccupancyMaxActiveBlocksPerMultiprocessor(&per_cu, (const void*)mk_fwd, 512, LDS_BYTES) != hipSuccess || per_cu < 1) { fprintf(stderr, "kernel_launch: occupancy query says %d blocks per CU\n", per_cu); (void)hipGetLastError(); grid = -1; return; }
        grid = cus;
    }
    if (grid < 0) return;
    (void)in_sizes;
    Args a{};
    for (int i = 0; i < 20; ++i) a.in[i] = (const float*)d_in[i];
    a.out = (float*)d_out; a.ws = (unsigned char*)d_ws;
    a.ropeA = pow(10000.0, -2.0 / 128.0); a.ropeR = pow(10000.0, -2.0 / 256.0);
#if MK_SINGLE
    (void)hipMemsetAsync((unsigned char*)d_ws + WS_CTL, 0, 16384, stream);
    a.ph_lo = 0; a.ph_hi = MK_NPHASES;
    hipLaunchKernelGGL(mk_fwd, dim3(grid), dim3(512), LDS_BYTES, stream, a);
#else
    for (int p = 0; p < MK_NPHASES; ++p) { a.ph_lo = p; a.ph_hi = p + 1; hipLaunchKernelGGL(mk_fwd, dim3(grid), dim3(512), LDS_BYTES, stream, a); }
#endif
}
```

```cpp
#include <hip/hip_runtime.h>
#include <cstdio>
#include <cstdint>
#include <cmath>
#include <cfloat>
__device__ __forceinline__ int mk_tid() { int t = (int)threadIdx.x; asm volatile("" : "+v"(t)); return t; }
namespace pg8 {
#define PG8_LAS __attribute__((address_space(3)))
typedef unsigned short bf16_t;
typedef short bf16x8 __attribute__((ext_vector_type(8)));
typedef float f32x4 __attribute__((ext_vector_type(4)));
typedef unsigned u32x4 __attribute__((ext_vector_type(4)));
constexpr int BM = 256, BK = 64, HALF = 128, HTB = HALF * BK * 2  , STAGE_BYTES = 8 * HTB, NXCD = 8, WGM = 8;

__host__ __device__ __forceinline__ int lds_byte(int r, int c) { const int st = (r >> 4) * 2 + (c >> 5), rr = r & 15, cc = c & 31, ob = rr * 64 + cc * 2; return st * 1024 + (ob ^ (((ob >> 9) & 1) << 5)); }
__host__ __device__ __forceinline__ void stage_rc(int b, int& R, int& C) { const int st = b / 1024, sb = b % 1024, swz = sb ^ (((sb >> 9) & 1) << 5); R = (st >> 1) * 16 + swz / 64; C = (st & 1) * 32 + (swz % 64) / 2; }
__host__ __device__ __forceinline__ int perm32(int rho) { const int n = rho >> 4, i = rho & 15; return 8 * (i >> 2) + 4 * n + (i & 3); }

struct Unit { int pm, pn; };
struct Gemm { const bf16_t* A; const bf16_t* Bt; int M, N, K; };

struct StaticOrder {
    int nM, nN, nwg, G, c;
    __host__ __device__ void init(int M, int N, int G_, int c_) { nM = M / BM; nN = N / BM; nwg = nM * nN; G = G_; c = c_; }
    __host__ __device__ bool next(int i, Unit& u) const {
        const long L = (long)i * G + c; if (L >= nwg) return false;
        int wgid = (int)L; { const int q = nwg / NXCD, r = nwg % NXCD, xcd = wgid % NXCD, off = wgid / NXCD; wgid = (xcd < r ? xcd * (q + 1) : r * (q + 1) + (xcd - r) * q) + off; }
        const int nig = WGM * nN, gid = wgid / nig, fm = gid * WGM, gsz = (nM - fm) < WGM ? (nM - fm) : WGM;
        u.pm = fm + ((wgid % nig) % gsz); u.pn = (wgid % nig) / gsz; return true;
    }
    __device__ __forceinline__ void a_ready(const Unit&) const {}
    __device__ __forceinline__ void done(const Unit&) const {}
};
typedef __bf16 pg8_bf16x2 __attribute__((ext_vector_type(2)));
__device__ __forceinline__ unsigned cvt_pk_bf16(float lo, float hi) { const pg8_bf16x2 v = {(__bf16)lo, (__bf16)hi}; return __builtin_bit_cast(unsigned, v); }
typedef float f32x2 __attribute__((ext_vector_type(2)));
__device__ __forceinline__ f32x2 gelu_pk(f32x2 v) {
    const f32x2 av = __builtin_elementwise_abs(v), d = av * 0.2316418882f + 1.0f;
    f32x2 t; t.x = __builtin_amdgcn_rcpf(d.x); t.y = __builtin_amdgcn_rcpf(d.y);
    f32x2 q = t * 0.5307027145f + (-0.7265760135f); q = q * t + 0.7107068705f; q = q * t + (-0.142248368f); q = q * t + 0.127414796f; q = q * t;
    const f32x2 s = (v * v) * (-0.72134752044f);
    f32x2 e; e.x = __builtin_amdgcn_exp2f(s.x); e.y = __builtin_amdgcn_exp2f(s.y);
    const f32x2 m = v * (q * e), r = v - m;
    f32x2 o; o.x = v.x < 0.f ? m.x : r.x; o.y = v.y < 0.f ? m.y : r.y; return o;
}

struct EpiF32 {
    static constexpr bool PERM = false, AFTER_DRAIN = false;
    float* C; int ldc; const float* bias;
    __device__ __forceinline__ void operator()(const f32x4 (&acc)[2][2][4][2], const Unit& u, int wr, int wc, int fr, int fq) const {
        const int row0 = u.pm * BM + wr * 64 + fr, col0 = u.pn * BM + wc * 32 + 4 * fq;
        f32x4 bv[2][2];
#pragma unroll
        for (int bj = 0; bj < 2; ++bj)
#pragma unroll
            for (int n = 0; n < 2; ++n) bv[bj][n] = bias ? *(const f32x4*)(bias + col0 + bj * HALF + n * 16) : (f32x4){0.f, 0.f, 0.f, 0.f};
#pragma unroll
        for (int ai = 0; ai < 2; ++ai)
#pragma unroll
            for (int m = 0; m < 4; ++m) { float* rowp = C + (size_t)(row0 + ai * HALF + m * 16) * ldc + col0;
#pragma unroll
                for (int bj = 0; bj < 2; ++bj)
#pragma unroll
                    for (int n = 0; n < 2; ++n) *(f32x4*)(rowp + bj * HALF + n * 16) = acc[ai][bj][m][n] + bv[bj][n]; }
    }
};
template <int ACT  > struct EpiBf16 {
    static constexpr bool PERM = true, AFTER_DRAIN = false;
    bf16_t* O; int ldc; const float* bias; int split_cols; size_t split_stride;
    __device__ __forceinline__ void operator()(const f32x4 (&acc)[2][2][4][2], const Unit& u, int wr, int wc, int fr, int fq) const {
        const int row0 = u.pm * BM + wr * 64 + fr; int colt = u.pn * BM; bf16_t* base = O;
        if (split_cols) { const int t = colt / split_cols; base += (size_t)t * split_stride; colt -= t * split_cols; }
        const int col0 = colt + wc * 32 + 8 * fq, bcol0 = u.pn * BM + wc * 32 + 8 * fq;
        f32x4 bv[2][2];
#pragma unroll
        for (int bj = 0; bj < 2; ++bj)
#pragma unroll
            for (int n = 0; n < 2; ++n) bv[bj][n] = bias ? *(const f32x4*)(bias + bcol0 + bj * HALF + 4 * n) : (f32x4){0.f, 0.f, 0.f, 0.f};
#pragma unroll
        for (int ai = 0; ai < 2; ++ai)
#pragma unroll
            for (int m = 0; m < 4; ++m) { bf16_t* rowp = base + (size_t)(row0 + ai * HALF + m * 16) * ldc + col0;
#pragma unroll
                for (int bj = 0; bj < 2; ++bj) { f32x4 v0 = acc[ai][bj][m][0] + bv[bj][0], v1 = acc[ai][bj][m][1] + bv[bj][1];
                    if (ACT == 1) { f32x2 a = gelu_pk((f32x2){v0[0], v0[1]}), b = gelu_pk((f32x2){v0[2], v0[3]}), c = gelu_pk((f32x2){v1[0], v1[1]}), d = gelu_pk((f32x2){v1[2], v1[3]});
                        v0 = (f32x4){a.x, a.y, b.x, b.y}; v1 = (f32x4){c.x, c.y, d.x, d.y}; }
                    if (ACT == 2) {
#pragma unroll
                        for (int j = 0; j < 4; ++j) { v0[j] = 0.5f * v0[j] * (1.0f + erff(v0[j] * 0.70710678f)); v1[j] = 0.5f * v1[j] * (1.0f + erff(v1[j] * 0.70710678f)); } }
                    u32x4 w; w.x = cvt_pk_bf16(v0[0], v0[1]); w.y = cvt_pk_bf16(v0[2], v0[3]); w.z = cvt_pk_bf16(v1[0], v1[1]); w.w = cvt_pk_bf16(v1[2], v1[3]);
                    *(u32x4*)(rowp + bj * HALF) = w; } }
    }
};

typedef int i32x8 __attribute__((ext_vector_type(8)));
typedef short s16x16 __attribute__((ext_vector_type(16)));
__device__ __forceinline__ i32x8 pg8_cat16(bf16x8 a, bf16x8 b) { return __builtin_bit_cast(i32x8, (s16x16)__builtin_shufflevector(a, b, 0, 1, 2, 3, 4, 5, 6, 7, 8, 9, 10, 11, 12, 13, 14, 15)); }
template <class Epi, class Sched, bool STAMP = false, bool F8 = false, bool WIDE = false>
__device__ __forceinline__ void gemm_phase(PG8_LAS unsigned char* lds, const Gemm g, const Sched& S, const Epi& E, unsigned long long* stamps) {
    const int tid = mk_tid(), wid = __builtin_amdgcn_readfirstlane(tid >> 6), lane = tid & 63, wr = wid >> 2, wc = wid & 3, fr = lane & 15, fq = lane >> 4;
    const int K = g.K, nt = K / BK;
    int ts_lo = 0, ts_hi = 0, nts = 0; const unsigned long long rt_entry = STAMP ? (unsigned long long)wall_clock64() : 0ull;
#define PG8_STAMP() do { if (STAMP && wid == 0 && nts < 64) { const unsigned long long _c = (unsigned long long)clock64(); \
        ts_lo = (lane == nts) ? (int)(unsigned)_c : ts_lo; ts_hi = (lane == nts) ? (int)(unsigned)(_c >> 32) : ts_hi; ++nts; } } while (0)
    PG8_STAMP();
    unsigned voffA, voffB;
    { int R, C; stage_rc(tid * 16, R, C); const int Ri = Epi::PERM ? perm32(R & 31) : (R & 31); const int Rb = WIDE ? (((R >> 5) << 6) + Ri) : ((R & ~31) + Ri);
        voffA = (unsigned)(R * K + C) * 2u; voffB = (unsigned)(Rb * K + C) * 2u; }
    const size_t qstep = (size_t)64 * K * 2;
    const size_t qstepB = WIDE ? (size_t)128 * K * 2 : qstep;
    const size_t hstepB = WIDE ? (size_t)32 * K * 2 : (size_t)HALF * K * 2;
    const size_t kstep = (size_t)(BK * 2);
    const size_t hstep = (size_t)HALF * K * 2;
    const size_t tstep = 2 * hstep;
    const unsigned ldsw = (unsigned)wid * 1024u;
    const int aoff = lds_byte(wr * 64 + fr, fq * 8), boff = lds_byte(wc * 32 + fr, fq * 8);
#define PG8_SA(b, h) (((b) * 2 + (h)) * HTB)
#define PG8_SB(b, h) ((4 + (b) * 2 + (h)) * HTB)
#define PG8_STAGE(bufoff, gbase, voff) PG8_STAGEQ(bufoff, gbase, voff, qstep)
#define PG8_STAGEB(bufoff, gbase, voff) PG8_STAGEQ(bufoff, gbase, voff, qstepB)
#define PG8_STAGEQ(bufoff, gbase, voff, qs) do { const char* _g0 = (const char*)(gbase); const char* _g1 = _g0 + (qs); asm volatile("" : "+s"(_g0), "+s"(_g1));   \
        __builtin_amdgcn_global_load_lds((const unsigned*)(_g0 + (voff)), (PG8_LAS unsigned*)(lds + (bufoff) + ldsw), 16, 0, 0); \
        __builtin_amdgcn_global_load_lds((const unsigned*)(_g1 + (voff)), (PG8_LAS unsigned*)(lds + (bufoff) + ldsw + 8192), 16, 0, 0); } while (0)
#define PG8_LDA(dst, b, h) do { _Pragma("unroll") for (int m = 0; m < 4; ++m) _Pragma("unroll") for (int k = 0; k < 2; ++k) dst[m][k] = *(const PG8_LAS bf16x8*)(lds + PG8_SA(b, h) + aoff + m * 2048 + k * 1024); } while (0)
#define PG8_LDB(dst, b, h) do { _Pragma("unroll") for (int n = 0; n < 2; ++n) _Pragma("unroll") for (int k = 0; k < 2; ++k) dst[n][k] = *(const PG8_LAS bf16x8*)(lds + PG8_SB(b, h) + boff + n * 2048 + k * 1024); } while (0)
#define PG8_MMA(ai, bj, At, Bt) do { __builtin_amdgcn_s_setprio(1); _Pragma("unroll") for (int m = 0; m < 4; ++m) _Pragma("unroll") for (int n = 0; n < 2; ++n) { \
        if constexpr (F8) acc[ai][bj][m][n] = __builtin_amdgcn_mfma_scale_f32_16x16x128_f8f6f4(pg8_cat16(Bt[n][0], Bt[n][1]), pg8_cat16(At[m][0], At[m][1]), acc[ai][bj][m][n], 0, 0, 0, 0, 0, 0); \
        else { _Pragma("unroll") for (int k = 0; k < 2; ++k) acc[ai][bj][m][n] = __builtin_amdgcn_mfma_f32_16x16x32_bf16(Bt[n][k], At[m][k], acc[ai][bj][m][n], 0, 0, 0); } } \
        __builtin_amdgcn_s_setprio(0); } while (0)
#define PG8_WAIT_V(n) asm volatile("s_waitcnt vmcnt(" #n ")" ::: "memory")
#define PG8_WAIT_L(n) asm volatile("s_waitcnt lgkmcnt(" #n ")" ::: "memory")
#define PG8_BAR __builtin_amdgcn_s_barrier()
#define PG8_SCHED __builtin_amdgcn_sched_barrier(0)
    Unit cur, nxt; int ui = 0;
    if (!S.next(0, cur)) return;
    f32x4 acc[2][2][4][2];
    bf16x8 At[4][2], B0[2][2], B1[2][2];
    const char* cA = (const char*)g.A + (size_t)cur.pm * tstep; const char* cB = (const char*)g.Bt + (size_t)cur.pn * tstep;
    S.a_ready(cur);
    PG8_STAGEB(PG8_SB(0, 0), cB, voffB); PG8_STAGE(PG8_SA(0, 0), cA, voffA); PG8_STAGEB(PG8_SB(0, 1), cB + hstepB, voffB); PG8_STAGE(PG8_SA(0, 1), cA + hstep, voffA);
    if (wr == 1) PG8_BAR;
    PG8_WAIT_V(4); PG8_BAR;
    PG8_STAGEB(PG8_SB(1, 0), cB + kstep, voffB); PG8_STAGE(PG8_SA(1, 0), cA + kstep, voffA); PG8_STAGEB(PG8_SB(1, 1), cB + hstepB + kstep, voffB);
    PG8_WAIT_V(6); PG8_BAR;
    PG8_STAMP();
#pragma unroll
    for (int a = 0; a < 2; ++a)
#pragma unroll
        for (int b = 0; b < 2; ++b)
#pragma unroll
            for (int m = 0; m < 4; ++m)
#pragma unroll
                for (int n = 0; n < 2; ++n) acc[a][b][m][n] = (f32x4){0.f, 0.f, 0.f, 0.f};
    for (;;) {
        const bool has_next = S.next(ui + 1, nxt);
        const char* nA = has_next ? (const char*)g.A + (size_t)nxt.pm * tstep : cA; const char* nB = has_next ? (const char*)g.Bt + (size_t)nxt.pn * tstep : cB;
        for (int t = 0; t < nt; t += 2) {
            const bool last = (t == nt - 2);
            const char* a1 = cA + (size_t)(t + 1) * kstep;
            const char* a2 = last ? nA : cA + (size_t)(t + 2) * kstep; const char* b2 = last ? nB : cB + (size_t)(t + 2) * kstep;
            const char* a3 = a2 + kstep; const char* b3 = b2 + kstep;
            if (last && has_next) S.a_ready(nxt);
            PG8_LDB(B0, 0, 0); PG8_SCHED; PG8_LDA(At, 0, 0); PG8_STAGE(PG8_SA(1, 1), a1 + hstep, voffA);
            PG8_WAIT_L(8); PG8_BAR; PG8_WAIT_L(0); PG8_MMA(0, 0, At, B0); PG8_BAR; PG8_SCHED;
            PG8_LDB(B1, 0, 1); PG8_STAGEB(PG8_SB(0, 0), b2, voffB);
            PG8_BAR; PG8_WAIT_L(0); PG8_MMA(0, 1, At, B1); PG8_BAR;
            PG8_LDA(At, 0, 1); PG8_STAGE(PG8_SA(0, 0), a2, voffA);
            PG8_BAR; PG8_WAIT_L(0); PG8_MMA(1, 0, At, B0); PG8_BAR; PG8_SCHED;
            PG8_STAGEB(PG8_SB(0, 1), b2 + hstepB, voffB);
            PG8_WAIT_V(6); PG8_BAR; PG8_MMA(1, 1, At, B1); PG8_BAR;
            PG8_LDB(B0, 1, 0); PG8_SCHED; PG8_LDA(At, 1, 0); PG8_STAGE(PG8_SA(0, 1), a2 + hstep, voffA);
            PG8_WAIT_L(8); PG8_BAR; PG8_WAIT_L(0); PG8_MMA(0, 0, At, B0); PG8_BAR; PG8_SCHED;
            PG8_LDB(B1, 1, 1); PG8_STAGEB(PG8_SB(1, 0), b3, voffB);
            PG8_BAR; PG8_WAIT_L(0); PG8_MMA(0, 1, At, B1); PG8_BAR;
            PG8_LDA(At, 1, 1); PG8_STAGE(PG8_SA(1, 0), a3, voffA);
            PG8_BAR; PG8_WAIT_L(0); PG8_MMA(1, 0, At, B0); PG8_BAR; PG8_SCHED;
            PG8_STAGEB(PG8_SB(1, 1), b3 + hstepB, voffB);
            PG8_WAIT_V(6); PG8_BAR; PG8_MMA(1, 1, At, B1); PG8_BAR;
        }
        PG8_STAMP();
        if constexpr (!Epi::AFTER_DRAIN) { E(acc, cur, wr, wc, fr, fq); S.done(cur); }
        PG8_STAMP();
        if (!has_next) break;
#pragma unroll
        for (int a = 0; a < 2; ++a)
#pragma unroll
            for (int b = 0; b < 2; ++b)
#pragma unroll
                for (int m = 0; m < 4; ++m)
#pragma unroll
                    for (int n = 0; n < 2; ++n) acc[a][b][m][n] = (f32x4){0.f, 0.f, 0.f, 0.f};
        cur = nxt; cA = nA; cB = nB; ++ui;
    }
    PG8_WAIT_V(0);
    if (wr == 0) PG8_BAR;
    PG8_BAR;
    if constexpr (Epi::AFTER_DRAIN) { E.fused(acc, cur, wr, wc, fr, fq, lds, wid, lane); S.done(cur); }
    PG8_STAMP();
    if (STAMP && wid == 0) { stamps[lane] = lane < nts ? (((unsigned long long)(unsigned)ts_hi << 32) | (unsigned)ts_lo) : 0ull;
        if (lane == 62) stamps[62] = rt_entry; if (lane == 63) stamps[63] = (unsigned long long)wall_clock64(); }
#undef PG8_STAMP
#undef PG8_SA
#undef PG8_SB
#undef PG8_STAGE
#undef PG8_STAGEB
#undef PG8_STAGEQ
#undef PG8_LDA
#undef PG8_LDB
#undef PG8_MMA
#undef PG8_WAIT_V
#undef PG8_WAIT_L
#undef PG8_BAR
#undef PG8_SCHED
}
}
#define XB_TMO      128
#define XB_XCNT(j)  (256  + 64 * (j))
#define XB_XSUB(j)  (1280 + 64 * (j))
#define XB_XGEN(j)  (2304 + 64 * (j))
#define XB_TOP      3328
#define XB_TOPGEN   3392
#define XCD_BAR_WORDS 3456
#define XB_SPIN_CAP (1u << 18)
#define LAS __attribute__((address_space(3)))

__device__ __forceinline__ unsigned xb_ld(unsigned* p)              { return __hip_atomic_load(p, __ATOMIC_RELAXED, __HIP_MEMORY_SCOPE_AGENT); }
__device__ __forceinline__ unsigned xb_add(unsigned* p, unsigned v) { return __hip_atomic_fetch_add(p, v, __ATOMIC_RELAXED, __HIP_MEMORY_SCOPE_AGENT); }
__device__ __forceinline__ unsigned xb_xcc_id() { return (unsigned)__builtin_amdgcn_s_getreg((3 << 11) | 20) & 0xFu; }
#define XB_SPIN(cond, bar) do { unsigned _sp = 0; while (cond) { __builtin_amdgcn_s_sleep(1); \
    if ((++_sp & 255u) == 0u) { if (xb_ld(&(bar)[XB_TMO])) break; if (_sp > XB_SPIN_CAP) { atomicAdd(&(bar)[XB_TMO], 1u); break; } } } } while (0)

struct XcdBarrier {
    unsigned* bar; unsigned x;
    volatile LAS unsigned* st;
};

__device__ __forceinline__ XcdBarrier xcd_barrier_post(unsigned* bar, volatile LAS unsigned* st) {
    XcdBarrier b; b.bar = bar; b.x = xb_xcc_id(); b.st = st;
    if (threadIdx.x == 0) (void)xb_add(&bar[XB_XCNT(b.x)], 1u);
    return b;
}
__device__ __forceinline__ void xcd_barrier_complete(unsigned* bar, unsigned x, unsigned& nloc, unsigned& nx) {
    const unsigned G = gridDim.x * gridDim.y * gridDim.z;
    unsigned sum, cnt, mine, sp = 0u;
    for (;;) {
        sum = 0u; cnt = 0u; mine = 0u;
#pragma unroll
        for (unsigned j = 0; j < 16; ++j) { const unsigned c = xb_ld(&bar[XB_XCNT(j)]); sum += c; cnt += (c > 0u) ? 1u : 0u; mine = (j == x) ? c : mine; }
        if (sum == G) break;
        __builtin_amdgcn_s_sleep(1);
        if ((++sp & 255u) == 0u) { if (xb_ld(&bar[XB_TMO])) break; if (sp > XB_SPIN_CAP) { atomicAdd(&bar[XB_TMO], 1u); break; } }
    }
    nloc = mine > 0u ? mine : 1u; nx = cnt > 0u ? cnt : 1u;
}

__device__ __forceinline__ void xcd_barrier(const XcdBarrier& b) {
    asm volatile("s_waitcnt vmcnt(0)" ::: "memory");
    __syncthreads();
    if (threadIdx.x == 0) {
        unsigned* bar = b.bar;
        __builtin_amdgcn_s_waitcnt(0);
        unsigned nloc = b.st[0], nx = b.st[1];
        if (nloc == 0u) { xcd_barrier_complete(bar, b.x, nloc, nx); b.st[0] = nloc; b.st[1] = nx; }
        const unsigned old = xb_add(&bar[XB_XSUB(b.x)], 1u);
        const unsigned gen = old / nloc;
        if (old + 1u == (gen + 1u) * nloc) {
            __builtin_amdgcn_fence(__ATOMIC_RELEASE, "agent");
            asm volatile("s_waitcnt vmcnt(0)" ::: "memory");
            const unsigned og = xb_add(&bar[XB_TOP], 1u);
            const unsigned tg = og / nx;
            if (og + 1u == (tg + 1u) * nx) xb_add(&bar[XB_TOPGEN], 1u);
            else XB_SPIN(xb_ld(&bar[XB_TOPGEN]) == tg, bar);
            __builtin_amdgcn_fence(__ATOMIC_ACQUIRE, "agent");
            xb_add(&bar[XB_XGEN(b.x)], 1u);
            asm volatile("s_waitcnt vmcnt(0)" ::: "memory");
        } else {
            XB_SPIN(xb_ld(&bar[XB_XGEN(b.x)]) == gen, bar);
            __builtin_amdgcn_fence(__ATOMIC_ACQUIRE, "agent");
            asm volatile("s_waitcnt vmcnt(0)" ::: "memory");
        }
    }
    __syncthreads();
}

namespace mk {
using pg8::bf16_t; using pg8::bf16x8; using pg8::f32x4; using pg8::u32x4;
typedef short s16x4 __attribute__((ext_vector_type(4)));
typedef unsigned u32x2 __attribute__((ext_vector_type(2)));
typedef __bf16 bf16x2v __attribute__((ext_vector_type(2)));
typedef int i32x4 __attribute__((ext_vector_type(4)));
#define DI __device__ __forceinline__

constexpr int D = 1024, SEQ = 4096, NTOK = 16384, DEPTH = 4, DIN = 13824;
constexpr int OFF_AQ = 0, OFF_AK = 1536, OFF_AV = 3072, OFF_LX = 4608, OFF_LG = 5632, OFF_RQ = 6656, OFF_RK = 7680, OFF_RV = 8704, OFF_RG = 9728, OFF_GA = 10752;
constexpr float ALPHA = 1.681792830507429f;
constexpr float LN_EPS = 1e-5f;
constexpr float X8_SCALE = 32.0f, W8_SCALE = 2048.0f, F8_MAX = 440.0f;
constexpr int NPH = 12;
constexpr int LDS_BYTES = 148 * 1024;
constexpr int LDS_BAR_OFF = LDS_BYTES - 16;

constexpr size_t WS_CTL  = 0;
constexpr size_t WS_COSA = 16384;
constexpr size_t WS_SINA = WS_COSA + (size_t)4096 * 64 * 4;
constexpr size_t WS_COSR = WS_SINA + (size_t)4096 * 64 * 4;
constexpr size_t WS_SINR = WS_COSR + (size_t)4096 * 128 * 4;
constexpr size_t WS_CCH  = WS_SINR + (size_t)4096 * 128 * 4;
constexpr size_t WS_WAT  = WS_CCH + 4096;
constexpr size_t WS_WXT  = WS_WAT + 131072;
constexpr size_t WS_LSTA = WS_WXT + 131072;
constexpr size_t WS_LSTH = WS_LSTA + 524288;
constexpr size_t WS_K1B  = WS_LSTH + 524288;
constexpr size_t WS_K2B  = WS_K1B + 262144;
constexpr size_t WS_XF   = WS_K2B + 262144;
constexpr size_t WS_XB   = WS_XF + (size_t)NTOK * D * 4;
constexpr size_t WS_WINT = WS_XB + (size_t)NTOK * D * 2;
constexpr size_t WS_WSC  = WS_WINT + (size_t)DIN * 1024;
constexpr size_t WS_X8   = WS_WSC + (size_t)DIN * 4 + 256 - ((size_t)DIN * 4) % 256;
constexpr size_t WS_XS   = WS_X8 + (size_t)NTOK * 1024;
constexpr size_t WS_WBAT = WS_XS + (size_t)NTOK * 4;
constexpr size_t WS_WBBT = WS_WBAT + (size_t)1024 * 512 * 2;
constexpr size_t WS_WBCT = WS_WBBT + (size_t)1024 * 1024 * 2;
constexpr size_t WS_WOT  = WS_WBCT + (size_t)1024 * 1024 * 2;
constexpr size_t WS_WQT  = WS_WOT + (size_t)1024 * 1024 * 2;
constexpr size_t WS_UV8  = WS_WQT + (size_t)2048 * 1024 * 2;
constexpr size_t WS_UVS  = WS_UV8 + (size_t)16384 * 2048;
constexpr size_t WS_PROJ = WS_UVS + (size_t)16384 * 8;
constexpr size_t WS_OATT = WS_PROJ + (size_t)NTOK * DIN * 2;
constexpr size_t WS_LSE  = WS_OATT + (size_t)NTOK * 1536 * 2;
constexpr size_t WS_KVB  = WS_LSE + (size_t)NTOK * 12 * 4;
constexpr size_t WS_YA   = WS_KVB + (size_t)16 * 32 * 65536 * 2;
constexpr size_t WS_YB   = WS_YA + (size_t)NTOK * 512 * 2;
constexpr size_t WS_YC   = WS_YB + (size_t)NTOK * 1024 * 2;
constexpr size_t WS_MRGF = WS_YC + (size_t)NTOK * 1024 * 2;
constexpr size_t WS_MRGB = WS_MRGF + (size_t)NTOK * 1024 * 4;
constexpr size_t WS_END  = WS_MRGB + (size_t)NTOK * 1024 * 2;
constexpr size_t WS_Q    = WS_PROJ;
constexpr size_t WS_EID  = WS_PROJ + (size_t)NTOK * 2048 * 2;
constexpr size_t WS_GATE = WS_EID + (size_t)NTOK * 128 * 4;
static_assert(WS_END <= (size_t)1073741824, "workspace too large");
static_assert(WS_PROJ % 256 == 0 && WS_KVB % 256 == 0 && WS_MRGF % 256 == 0, "alignment");

struct Args { const float* in[20]; float* out; unsigned char* ws; double ropeA, ropeR; int ph_lo, ph_hi; };

DI size_t pjo(size_t row, int col) { return ((size_t)(col >> 8) * NTOK + row) * 256 + (size_t)(col & 255); }
DI float bflo(unsigned w) { return __uint_as_float(w << 16); }
DI float bfhi(unsigned w) { return __uint_as_float(w & 0xffff0000u); }
DI float bf2f(bf16_t v) { return __uint_as_float(((unsigned)v) << 16); }
DI unsigned pk2(float lo, float hi) { return pg8::cvt_pk_bf16(lo, hi); }
DI bf16_t f2bf(float f) { return (bf16_t)(pk2(f, 0.f) & 0xffffu); }
DI f32x4 mfma16(bf16x8 a, bf16x8 b, f32x4 c) { return __builtin_amdgcn_mfma_f32_16x16x32_bf16(a, b, c, 0, 0, 0); }
DI s16x4 trrd(LAS unsigned char* p) { return __builtin_amdgcn_ds_read_tr16_b64_v4i16((LAS s16x4*)p); }
DI bf16x8 cat8(s16x4 lo, s16x4 hi) { return __builtin_shufflevector(lo, hi, 0, 1, 2, 3, 4, 5, 6, 7); }
DI float wsum(float v) { v += __shfl_xor(v, 32); v += __shfl_xor(v, 16); v += __shfl_xor(v, 8); v += __shfl_xor(v, 4); v += __shfl_xor(v, 2); v += __shfl_xor(v, 1); return v; }
DI float sigm(float x) { return __builtin_amdgcn_rcpf(1.f + __builtin_amdgcn_exp2f(x * -1.4426950408889634f)); }
DI float gelu_erf(float x) { return 0.5f * x * (1.f + erff(x * 0.70710678118654752f)); }
DI float dot2(unsigned w, unsigned x, float acc) { return __builtin_amdgcn_fdot2_f32_bf16(__builtin_bit_cast(bf16x2v, w), __builtin_bit_cast(bf16x2v, x), acc, false); }
DI float log2gamma(int h) { return log2f(1.0f - exp2f(-5.0f - (float)h)); }

#define MK_DPP_ADD(v, ctrl, rmask) v += __int_as_float(__builtin_amdgcn_update_dpp(0, __float_as_int(v), (ctrl), (rmask), 0xf, false))
DI float wsum_dpp(float v) {
    MK_DPP_ADD(v, 0xB1, 0xf); MK_DPP_ADD(v, 0x4E, 0xf); MK_DPP_ADD(v, 0x141, 0xf); MK_DPP_ADD(v, 0x140, 0xf);
    MK_DPP_ADD(v, 0x142, 0xa); MK_DPP_ADD(v, 0x143, 0xc);
    return __int_as_float(__builtin_amdgcn_readlane(__float_as_int(v), 63));
}
DI float gelu_as(float v) {
    const float av = fabsf(v), t = __builtin_amdgcn_rcpf(av * 0.2316418882f + 1.0f);
    float q = t * 0.5307027145f + (-0.7265760135f); q = q * t + 0.7107068705f; q = q * t + (-0.142248368f); q = q * t + 0.127414796f; q = q * t;
    const float e = __builtin_amdgcn_exp2f(v * v * (-0.72134752044f));
    const float m = v * (q * e);
    return v < 0.f ? m : v - m;
}
DI int wperm(int n) {
    if (n < 3072) { const int j = n & 127, jj = j & 63; return (n & ~127) + 8 * (jj >> 2) + (jj & 3) + ((j >= 64) ? 4 : 0); }
    if (n >= OFF_RQ && n < OFF_RV) { const int j = n & 255, jj = j & 127; return (n & ~255) + 8 * (jj >> 2) + (jj & 3) + ((j >= 128) ? 4 : 0); }
    return n;
}

template <bool WPERM>
DI void tconv_tile(const float* src, int ldsrc, bf16_t* dst, int lddst, int k0, int n0, LAS float* t, float mul = 1.0f) {
    const int tid = mk_tid();
#pragma unroll
    for (int i = 0; i < 8; ++i) { const int idx = tid + 512 * i, r = idx >> 6, c = idx & 63; t[r * 65 + c] = src[(size_t)(k0 + r) * ldsrc + n0 + c]; }
    __syncthreads();
#pragma unroll
    for (int i = 0; i < 8; ++i) { const int idx = tid + 512 * i, n = idx >> 6, k = idx & 63; const int nr = WPERM ? wperm(n0 + n) : (n0 + n); dst[(size_t)nr * lddst + k0 + k] = f2bf(t[k * 65 + n] * mul); }
    __syncthreads();
}
DI void conv_unit(const float* src, bf16_t* dst, int unit) {
    const size_t i = (size_t)unit * 4096 + (size_t)mk_tid() * 8;
    const f32x4 a = *(const f32x4*)(src + i), b = *(const f32x4*)(src + i + 4);
    u32x4 o; o.x = pk2(a[0], a[1]); o.y = pk2(a[2], a[3]); o.z = pk2(b[0], b[1]); o.w = pk2(b[2], b[3]);
    *(u32x4*)(dst + i) = o;
}
DI void w8_unit(const float* src, unsigned char* ws, int unit, LAS float* t) {
    const int tid = mk_tid(), n0 = unit * 64;
    unsigned char* dst = ws + WS_WINT;
#pragma unroll 1
    for (int k0 = 0; k0 < 1024; k0 += 64) {
#pragma unroll
        for (int i = 0; i < 8; ++i) { const int idx = tid + 512 * i, r = idx >> 6, cc = idx & 63; t[r * 65 + cc] = fminf(fmaxf(src[(size_t)(k0 + r) * DIN + n0 + cc] * W8_SCALE, -F8_MAX), F8_MAX); }
        __syncthreads();
#pragma unroll
        for (int i = 0; i < 2; ++i) { const int idx = tid + 512 * i, n = idx >> 4, k4 = idx & 15;
            int wd = __builtin_amdgcn_cvt_pk_fp8_f32(t[(4 * k4) * 65 + n], t[(4 * k4 + 1) * 65 + n], 0, false);
            wd = __builtin_amdgcn_cvt_pk_fp8_f32(t[(4 * k4 + 2) * 65 + n], t[(4 * k4 + 3) * 65 + n], wd, true);
            *(int*)(dst + (size_t)wperm(n0 + n) * 1024 + k0 + 4 * k4) = wd; }
        __syncthreads();
    }
}
DI void row_to_fp8(const f32x4 (&o)[4], unsigned char* x8row, int ln) {
    u32x4 w;
#pragma unroll
    for (int q = 0; q < 4; ++q) {
        const float a0 = fminf(fmaxf(o[q][0] * X8_SCALE, -F8_MAX), F8_MAX), a1 = fminf(fmaxf(o[q][1] * X8_SCALE, -F8_MAX), F8_MAX), a2 = fminf(fmaxf(o[q][2] * X8_SCALE, -F8_MAX), F8_MAX), a3 = fminf(fmaxf(o[q][3] * X8_SCALE, -F8_MAX), F8_MAX);
        int wd = __builtin_amdgcn_cvt_pk_fp8_f32(a0, a1, 0, false); wd = __builtin_amdgcn_cvt_pk_fp8_f32(a2, a3, wd, true); w[q] = (unsigned)wd; }
    *(u32x4*)(x8row + 16 * ln) = w;
}
typedef float f32x16 __attribute__((ext_vector_type(16)));
typedef float f32x32 __attribute__((ext_vector_type(32)));
typedef unsigned u32x6 __attribute__((ext_vector_type(6)));
typedef _Float16 f16x32 __attribute__((ext_vector_type(32)));
DI float wmax(float m) { m = fmaxf(m, __shfl_xor(m, 32)); m = fmaxf(m, __shfl_xor(m, 16)); m = fmaxf(m, __shfl_xor(m, 8)); m = fmaxf(m, __shfl_xor(m, 4)); m = fmaxf(m, __shfl_xor(m, 2)); m = fmaxf(m, __shfl_xor(m, 1)); return m; }
DI void conv_fp6_rows(const float* usrc, const float* vsrc, unsigned char* ws, int unit) {
    const int tid = mk_tid(), lane = tid & 63, w = tid >> 6;
    const size_t row = (size_t)unit * 8 + w;
    const float* up = usrc + row * 1024 + 16 * lane; const float* vp = vsrc + row * 1024 + 16 * lane;
    f32x16 a, b; float mu = 0.f, mv = 0.f;
#pragma unroll
    for (int q = 0; q < 4; ++q) { const f32x4 x = *(const f32x4*)(up + 4 * q), y = *(const f32x4*)(vp + 4 * q);
#pragma unroll
        for (int j = 0; j < 4; ++j) { a[4 * q + j] = x[j]; b[4 * q + j] = y[j]; mu = fmaxf(mu, fabsf(x[j])); mv = fmaxf(mv, fabsf(y[j])); } }
    mu = wmax(mu); mv = wmax(mv);
    const float su = (mu > 0.f) ? 7.0f / mu : 1.0f, sv = (mv > 0.f) ? 7.0f / mv : 1.0f;
    f16x32 h;
#pragma unroll
    for (int i = 0; i < 16; ++i) { h[i] = (_Float16)(a[i] * su); h[16 + i] = (_Float16)(b[i] * sv); }
    const u32x6 p = __builtin_amdgcn_cvt_scalef32_pk32_fp6_f16(h, 1.0f);
    unsigned char* rec = ws + WS_UV8 + row * 1536;
    *(u32x4*)(rec + 16 * lane) = (u32x4){p[0], p[1], p[2], p[3]};
    *(u32x2*)(rec + 1024 + 8 * lane) = (u32x2){p[4], p[5]};
    if (lane == 0) { float* sp = (float*)(ws + WS_UVS) + row * 2; sp[0] = (mu > 0.f) ? mu * (1.0f / 7.0f) : 1.0f; sp[1] = (mv > 0.f) ? mv * (1.0f / 7.0f) : 1.0f; }
}
DI void phase_conv(const Args& a, int layer, LAS unsigned char* lds) {
    unsigned char* ws = a.ws;
    LAS float* t = (LAS float*)lds;
    const int J0 = 216, J1 = J0 + 128, J2 = J1 + 256, J3 = J2 + 256, J4 = J3 + 256, J5 = J4 + 512, J6 = J5 + 32, J7 = J6 + 2048, J8 = J7, J9 = J8 + 64, J10 = J9 + 1;
    const int total = J10;
    for (int u = blockIdx.x; u < total; u += gridDim.x) {
        if (u < J0) { w8_unit(a.in[1] + (size_t)layer * 1024 * DIN, ws, u, t); }
        else if (u < J1) { const int v = u - J0, kt = v / 16, nt = v % 16; tconv_tile<false>(a.in[9] + (size_t)layer * 2560 * 1024, 1024, (bf16_t*)(ws + WS_WBAT), 512, kt * 64, nt * 64, t); }
        else if (u < J2) { const int v = u - J1, kt = v / 16, nt = v % 16; tconv_tile<false>(a.in[9] + (size_t)layer * 2560 * 1024 + (size_t)512 * 1024, 1024, (bf16_t*)(ws + WS_WBBT), 1024, kt * 64, nt * 64, t); }
        else if (u < J3) { const int v = u - J2, kt = v / 16, nt = v % 16; tconv_tile<false>(a.in[9] + (size_t)layer * 2560 * 1024 + (size_t)1536 * 1024, 1024, (bf16_t*)(ws + WS_WBCT), 1024, kt * 64, nt * 64, t); }
        else if (u < J4) { const int v = u - J3, kt = v / 16, nt = v % 16; tconv_tile<false>(a.in[10] + (size_t)layer * 1024 * 1024, 1024, (bf16_t*)(ws + WS_WOT), 1024, kt * 64, nt * 64, t); }
        else if (u < J5) { const int v = u - J4, kt = v / 32, nt = v % 32; tconv_tile<false>(a.in[13] + (size_t)layer * 1024 * 2048, 2048, (bf16_t*)(ws + WS_WQT), 1024, kt * 64, nt * 64, t); }
        else if (u < J6) { const int v = u - J5, blk = v & 15, which = v >> 4;
            tconv_tile<false>(a.in[which ? 6 : 4] + ((size_t)layer * 16 + blk) * 4096, 64, (bf16_t*)(ws + (which ? WS_WXT : WS_WAT)) + blk * 4096, 64, 0, 0, t, -1.4426950408889634f); }
        else if (u < J7) { conv_fp6_rows(a.in[16] + (size_t)layer * 16384 * 1024, a.in[17] + (size_t)layer * 16384 * 1024, ws, u - J6); }
        else if (u < J9) { const int v = u - J8; if (v < 32) conv_unit(a.in[14] + (size_t)layer * 131072, (bf16_t*)(ws + WS_K1B), v); else conv_unit(a.in[15] + (size_t)layer * 131072, (bf16_t*)(ws + WS_K2B), v - 32); }
        else { for (int c = mk_tid(); c < 1024; c += 512) { const float lam = a.in[8][layer * 1024 + c]; const float e = __builtin_amdgcn_exp2f(-lam * 1.4426950408889634f); const float sp = (e < 0.05f) ? e * (1.0f + e * (-0.5f + e * (0.33333333f + e * -0.25f))) : __builtin_amdgcn_logf(1.0f + e) * 0.6931471805599453f; ((float*)(ws + WS_CCH))[c] = -8.0f * sp; } }
    }
}

DI void phase_prologue(const Args& a) {
    unsigned char* ws = a.ws;
    const int tid = mk_tid();
    for (int u = blockIdx.x; u < 2048; u += gridDim.x) {
        { const int ln = tid & 63; const size_t row = (size_t)u * 8 + (tid >> 6);
            const float* xp = a.in[0] + row * 1024 + 16 * ln; float* xo = (float*)(ws + WS_XF) + row * 1024 + 16 * ln;
            f32x4 o[4];
#pragma unroll
            for (int q = 0; q < 4; ++q) { o[q] = *(const f32x4*)(xp + 4 * q); *(f32x4*)(xo + 4 * q) = o[q]; }
            row_to_fp8(o, ws + WS_X8 + row * 1024, ln); }
    }
}

DI void attn_unit(const Args& a, int unit, LAS unsigned char* lds) {
    unsigned char* ws = a.ws;
    const int tid = mk_tid(), lane = tid & 63, w = __builtin_amdgcn_readfirstlane(tid >> 6), g = lane >> 4, l15 = lane & 15, tq4 = l15 >> 2, tp4 = l15 & 3;
    const int b = unit / 384, rem = unit % 384, h = rem >> 5, bi = rem & 31;
    const int grp = h >> 2, d = (grp == 0) ? 1 : ((grp == 1) ? 4 : 16), nb = 32 / d, r = bi / nb, n = bi % nb;
    const bf16_t* proj = (const bf16_t*)(ws + WS_PROJ); const size_t brow = (size_t)b * SEQ;
    LAS unsigned char* Ks = lds; LAS unsigned char* Vs = lds + 256 * 288;
#pragma unroll
    for (int i = 0; i < 8; ++i) {
        const int idx = tid + 512 * i, row = idx >> 4, ch = idx & 15, m = 128 * (n - 1) + row;
        u32x4 kv = {0u, 0u, 0u, 0u}, vv = {0u, 0u, 0u, 0u};
        if (m >= 0) { const size_t gr = brow + (size_t)(m * d + r); kv = *(const u32x4*)(proj + pjo(gr, OFF_AK + h * 128 + ch * 8)); vv = *(const u32x4*)(proj + pjo(gr, OFF_AV + h * 128 + ch * 8)); }
        *(LAS u32x4*)(Ks + row * 288 + ch * 16) = kv; *(LAS u32x4*)(Vs + row * 288 + ch * 16) = vv;
    }
    const int qi = 16 * w + l15;
    const size_t tq = (size_t)(128 * n + qi) * d + r;
    bf16x8 qf[4];
#pragma unroll
    for (int ks = 0; ks < 4; ++ks) qf[ks] = *(const bf16x8*)(proj + pjo(brow + tq, OFF_AQ + h * 128 + 32 * ks + 8 * g));
    __syncthreads();
    const int s0 = w >> 1;
    f32x4 sacc[10];
#pragma unroll
    for (int jj = 0; jj < 10; ++jj) {
        f32x4 acc = {0.f, 0.f, 0.f, 0.f};
#pragma unroll
        for (int ks = 0; ks < 4; ++ks) { const bf16x8 kf = *(const LAS bf16x8*)(Ks + (32 * s0 + 16 * jj + l15) * 288 + (32 * ks + 8 * g) * 2); acc = mfma16(kf, qf[ks], acc); }
        sacc[jj] = acc;
    }
    const float scale = 0.08838834764831845f * 1.4426950408889634f;
    float mx = -1e30f;
#pragma unroll
    for (int jj = 0; jj < 10; ++jj)
#pragma unroll
        for (int rg = 0; rg < 4; ++rg) {
            const int j = 32 * s0 + 16 * jj + 4 * g + rg;
            const bool valid = (j >= qi) && (j <= qi + 128) && (n > 0 || j >= 128);
            const float s = valid ? sacc[jj][rg] * scale : -1e30f;
            sacc[jj][rg] = s; mx = fmaxf(mx, s);
        }
    mx = fmaxf(mx, __shfl_xor(mx, 16)); mx = fmaxf(mx, __shfl_xor(mx, 32));
    float sum = 0.f;
#pragma unroll
    for (int jj = 0; jj < 10; ++jj)
#pragma unroll
        for (int rg = 0; rg < 4; ++rg) { const float p = __builtin_amdgcn_exp2f(sacc[jj][rg] - mx); sacc[jj][rg] = p; sum += p; }
    sum += __shfl_xor(sum, 16); sum += __shfl_xor(sum, 32);
    f32x4 oacc[8];
#pragma unroll
    for (int db = 0; db < 8; ++db) oacc[db] = (f32x4){0.f, 0.f, 0.f, 0.f};
#pragma unroll
    for (int s = 0; s < 5; ++s) {
        u32x4 pw; pw.x = pk2(sacc[2 * s][0], sacc[2 * s][1]); pw.y = pk2(sacc[2 * s][2], sacc[2 * s][3]); pw.z = pk2(sacc[2 * s + 1][0], sacc[2 * s + 1][1]); pw.w = pk2(sacc[2 * s + 1][2], sacc[2 * s + 1][3]);
        const bf16x8 pb = __builtin_bit_cast(bf16x8, pw);
        const int k0 = 32 * (s0 + s) + 4 * g + tq4;
#pragma unroll
        for (int db = 0; db < 8; ++db) {
            const s16x4 lo = trrd(Vs + k0 * 288 + (16 * db + 4 * tp4) * 2), hi = trrd(Vs + (k0 + 16) * 288 + (16 * db + 4 * tp4) * 2);
            oacc[db] = mfma16(cat8(lo, hi), pb, oacc[db]);
        }
    }
    const float inv = 1.0f / sum;
    bf16_t* op = (bf16_t*)(ws + WS_OATT) + ((size_t)b * SEQ + tq) * 1536 + h * 128 + 4 * g;
#pragma unroll
    for (int db = 0; db < 8; ++db) { u32x2 o; o.x = pk2(oacc[db][0] * inv, oacc[db][1] * inv); o.y = pk2(oacc[db][2] * inv, oacc[db][3] * inv); *(u32x2*)(op + 16 * db) = o; }
    if (g == 0) ((float*)(ws + WS_LSE))[((size_t)b * SEQ + tq) * 12 + h] = mx + __builtin_amdgcn_logf(sum);
    __syncthreads();
}

DI void retkv_unit(const Args& a, int unit, LAS unsigned char* lds) {
    unsigned char* ws = a.ws;
    const int tid = mk_tid(), lane = tid & 63, w = __builtin_amdgcn_readfirstlane(tid >> 6), g = lane >> 4, l15 = lane & 15, tq4 = l15 >> 2, tp4 = l15 & 3;
    const int b = unit >> 7, h = (unit >> 5) & 3, c = unit & 31;
    const bf16_t* proj = (const bf16_t*)(ws + WS_PROJ); const size_t brow = (size_t)b * SEQ + c * 128;
    LAS unsigned char* Ks = lds; LAS unsigned char* Vs = lds + 128 * 544;
    const float l2g = log2gamma(h);
#pragma unroll
    for (int i = 0; i < 8; ++i) {
        const int idx = tid + 512 * i, row = idx >> 5, ch = idx & 31;
        const u32x4 kv = *(const u32x4*)(proj + pjo(brow + row, OFF_RK + h * 256 + ch * 8)), vv = *(const u32x4*)(proj + pjo(brow + row, OFF_RV + h * 256 + ch * 8));
        const float z = exp2f((float)(127 - row) * l2g);
        u32x4 kz;
#pragma unroll
        for (int q = 0; q < 4; ++q) kz[q] = pk2(bflo(kv[q]) * z, bfhi(kv[q]) * z);
        *(LAS u32x4*)(Ks + row * 544 + ch * 16) = kz; *(LAS u32x4*)(Vs + row * 544 + ch * 16) = vv;
    }
    __syncthreads();
#pragma unroll 1
    for (int nh = 0; nh < 2; ++nh) {
        f32x4 acc[2][8];
#pragma unroll
        for (int mb = 0; mb < 2; ++mb)
#pragma unroll
            for (int nb = 0; nb < 8; ++nb) acc[mb][nb] = (f32x4){0.f, 0.f, 0.f, 0.f};
#pragma unroll
        for (int ks = 0; ks < 4; ++ks) {
            const int j0 = 32 * ks + 4 * g + tq4;
            bf16x8 af[2];
#pragma unroll
            for (int mb = 0; mb < 2; ++mb) { const int col = 32 * w + 16 * mb + 4 * tp4; af[mb] = cat8(trrd(Vs + j0 * 544 + col * 2), trrd(Vs + (j0 + 16) * 544 + col * 2)); }
#pragma unroll
            for (int nb = 0; nb < 8; ++nb) {
                const int col = 128 * nh + 16 * nb + 4 * tp4;
                const bf16x8 bfr = cat8(trrd(Ks + j0 * 544 + col * 2), trrd(Ks + (j0 + 16) * 544 + col * 2));
#pragma unroll
                for (int mb = 0; mb < 2; ++mb) acc[mb][nb] = mfma16(af[mb], bfr, acc[mb][nb]);
            }
        }
        bf16_t* kvb = (bf16_t*)(ws + WS_KVB) + ((size_t)((b * 4 + h) * 32 + c)) * 65536 + 128 * nh;
#pragma unroll
        for (int mb = 0; mb < 2; ++mb)
#pragma unroll
            for (int nb = 0; nb < 8; ++nb)
#pragma unroll
                for (int rg = 0; rg < 4; ++rg) kvb[(size_t)(32 * w + 16 * mb + 4 * g + rg) * 256 + 16 * nb + l15] = f2bf(acc[mb][nb][rg]);
    }
    __syncthreads();
}

DI void lru_stripe(const Args& a, int layer, int stripe, LAS unsigned char* lds) {
    unsigned char* ws = a.ws;
    const int tid = mk_tid(), lane = tid & 63, w = __builtin_amdgcn_readfirstlane(tid >> 6), g = lane >> 4, l15 = lane & 15;
    const int b = stripe >> 4, blk = stripe & 15;
    LAS bf16_t* lxs = (LAS bf16_t*)lds;
    LAS bf16_t* lgs0 = (LAS bf16_t*)(lds + 16896);
    LAS unsigned char* xcb = lds + 49664;
    LAS float* rgt = (LAS float*)(lds + 68096);
    LAS float* igt = (LAS float*)(lds + 100864);
    LAS float* wst = (LAS float*)(lds + 133632);
    const bf16_t* proj = (const bf16_t*)(ws + WS_PROJ); const size_t brow = (size_t)b * SEQ;
    const int gc = blk * 64 + lane;
    const float* cw = a.in[2] + (size_t)layer * 4096;
    const int cch_ = tid & 63, cgc = blk * 64 + cch_;
    const float cw0 = cw[cgc], cw1 = cw[1024 + cgc], cw2 = cw[2048 + cgc], cw3 = cw[3072 + cgc], cb = a.in[3][layer * 1024 + cgc];
    const float cc = ((const float*)(ws + WS_CCH))[gc] * 1.4426950408889634f;
    float bia[4], bix[4];
    LAS unsigned char* wlds = lds + 137728;
    { const int r = tid >> 3, c8 = tid & 7; *(LAS u32x4*)(wlds + r * 144 + c8 * 16) = *(const u32x4*)((const bf16_t*)(ws + WS_WAT) + blk * 4096 + r * 64 + c8 * 8); }
    bf16x8 wfx[4][2];
#pragma unroll
    for (int nb = 0; nb < 4; ++nb)
#pragma unroll
        for (int ks = 0; ks < 2; ++ks) wfx[nb][ks] = *(const bf16x8*)((const bf16_t*)(ws + WS_WXT) + blk * 4096 + (16 * nb + l15) * 64 + 32 * ks + 8 * g);
#pragma unroll
    for (int nb = 0; nb < 4; ++nb) { bia[nb] = -1.4426950408889634f * a.in[5][layer * 1024 + blk * 64 + 16 * nb + l15]; bix[nb] = -1.4426950408889634f * a.in[7][layer * 1024 + blk * 64 + 16 * nb + l15]; }
    if (tid < 24) *(LAS u32x4*)(lxs + tid * 8) = (u32x4){0u, 0u, 0u, 0u};
    u32x4 plx[2], plg[2];
#pragma unroll
    for (int i = 0; i < 2; ++i) { const int idx = tid + 512 * i, row = idx >> 3, c8 = idx & 7; plx[i] = *(const u32x4*)(proj + pjo(brow + row, OFF_LX + blk * 64 + c8 * 8)); plg[i] = *(const u32x4*)(proj + pjo(brow + row, OFF_LG + blk * 64 + c8 * 8)); }
    float hcarry = 0.0f;
#pragma unroll 1
    for (int c = 0; c < 32; ++c) {
        LAS bf16_t* lgs = lgs0 + (c & 1) * 8192;
#pragma unroll
        for (int i = 0; i < 2; ++i) { const int idx = tid + 512 * i, row = idx >> 3, c8 = idx & 7; *(LAS u32x4*)(lxs + (3 + row) * 64 + c8 * 8) = plx[i]; *(LAS u32x4*)(lgs + row * 64 + c8 * 8) = plg[i]; }
        __syncthreads();
        if (c + 1 < 32) {
#pragma unroll
            for (int i = 0; i < 2; ++i) { const int idx = tid + 512 * i, row = idx >> 3, c8 = idx & 7; const size_t gr = brow + (size_t)((c + 1) * 128 + row); plx[i] = *(const u32x4*)(proj + pjo(gr, OFF_LX + blk * 64 + c8 * 8)); plg[i] = *(const u32x4*)(proj + pjo(gr, OFF_LG + blk * 64 + c8 * 8)); }
        }
        {
            const int t0 = (tid >> 6) * 16;
            float x0 = bf2f(lxs[t0 * 64 + cch_]), x1 = bf2f(lxs[(t0 + 1) * 64 + cch_]), x2 = bf2f(lxs[(t0 + 2) * 64 + cch_]);
#pragma unroll
            for (int i = 0; i < 16; ++i) {
                const float x3 = bf2f(lxs[(t0 + i + 3) * 64 + cch_]);
                const float xc = cb + cw0 * x0 + cw1 * x1 + cw2 * x2 + cw3 * x3;
                *(LAS bf16_t*)(xcb + (t0 + i) * 144 + cch_ * 2) = f2bf(xc);
                x0 = x1; x1 = x2; x2 = x3;
            }
        }
        __syncthreads();
        if (tid < 24) *(LAS u32x4*)(lxs + tid * 8) = *(const LAS u32x4*)(lxs + 128 * 64 + tid * 8);
        {
            const bf16x8 af0 = *(const LAS bf16x8*)(xcb + (16 * w + l15) * 144 + (8 * g) * 2), af1 = *(const LAS bf16x8*)(xcb + (16 * w + l15) * 144 + (32 + 8 * g) * 2);
#pragma unroll
            for (int nb = 0; nb < 4; ++nb) {
                f32x4 ar = {0.f, 0.f, 0.f, 0.f}, ax = {0.f, 0.f, 0.f, 0.f};
                const LAS unsigned char* wr_ = wlds + (16 * nb + l15) * 144 + 16 * g;
                ar = mfma16(af0, *(const LAS bf16x8*)(wr_), ar); ar = mfma16(af1, *(const LAS bf16x8*)(wr_ + 64), ar);
                ax = mfma16(af0, wfx[nb][0], ax); ax = mfma16(af1, wfx[nb][1], ax);
#pragma unroll
                for (int rg = 0; rg < 4; ++rg) { rgt[(16 * w + 4 * g + rg) * 64 + 16 * nb + l15] = __builtin_amdgcn_rcpf(1.0f + __builtin_amdgcn_exp2f(ar[rg] + bia[nb])); igt[(16 * w + 4 * g + rg) * 64 + 16 * nb + l15] = __builtin_amdgcn_rcpf(1.0f + __builtin_amdgcn_exp2f(ax[rg] + bix[nb])); }
            }
        }
        __syncthreads();
        float av[16], bv[16]; float Aw = 1.0f, Hw = 0.0f;
#pragma unroll
        for (int tt = 0; tt < 16; ++tt) {
            const int t = 16 * w + tt;
            const float aa = __builtin_amdgcn_exp2f(cc * rgt[t * 64 + lane]);
            const float bb = __builtin_amdgcn_sqrtf(fmaxf(1.0f - aa * aa, 0.0f)) * igt[t * 64 + lane] * bf2f(*(const LAS bf16_t*)(xcb + t * 144 + lane * 2));
            av[tt] = aa; bv[tt] = bb; Hw = aa * Hw + bb; Aw *= aa;
        }
        wst[w * 64 + lane] = Aw; wst[512 + w * 64 + lane] = Hw;
        __syncthreads();
        float hcur = hcarry, hend = hcarry;
#pragma unroll
        for (int ww = 0; ww < 8; ++ww) { const float A_ = wst[ww * 64 + lane], H_ = wst[512 + ww * 64 + lane]; hend = A_ * hend + H_; if (ww < w) hcur = hend; }
        hcarry = hend;
        bf16_t* yb = (bf16_t*)(ws + WS_YB) + ((size_t)b * SEQ + c * 128 + 16 * w) * 1024 + gc;
#pragma unroll
        for (int tt = 0; tt < 16; tt += 2) {
            const float h0 = av[tt] * hcur + bv[tt]; hcur = av[tt + 1] * h0 + bv[tt + 1];
            yb[(size_t)tt * 1024] = f2bf(h0 * bf2f(lgs[(16 * w + tt) * 64 + lane])); yb[(size_t)(tt + 1) * 1024] = f2bf(hcur * bf2f(lgs[(16 * w + tt + 1) * 64 + lane]));
        }
    }
    __syncthreads();
}

DI void retscan_unit(const Args& a, int unit) {
    unsigned char* ws = a.ws;
    const int e8 = unit * 512 + mk_tid();
    const int bh = e8 >> 13, within = e8 & 8191, h = bh & 3;
    const float g128 = exp2f(128.0f * log2gamma(h));
    bf16_t* base = (bf16_t*)(ws + WS_KVB) + (size_t)bh * 32 * 65536 + (size_t)within * 8;
    float st[8];
#pragma unroll
    for (int q = 0; q < 8; ++q) st[q] = 0.f;
#pragma unroll 1
    for (int c0 = 0; c0 < 32; c0 += 8) {
        u32x4 kv[8];
#pragma unroll
        for (int q = 0; q < 8; ++q) kv[q] = *(const u32x4*)(base + (size_t)(c0 + q) * 65536);
#pragma unroll
        for (int q = 0; q < 8; ++q) {
            u32x4 o;
#pragma unroll
            for (int j = 0; j < 4; ++j) o[j] = pk2(st[2 * j], st[2 * j + 1]);
            *(u32x4*)(base + (size_t)(c0 + q) * 65536) = o;
#pragma unroll
            for (int j = 0; j < 4; ++j) { st[2 * j] = g128 * st[2 * j] + bflo(kv[q][j]); st[2 * j + 1] = g128 * st[2 * j + 1] + bfhi(kv[q][j]); }
        }
    }
}

DI void attmerge_unit(const Args& a, int unit) {
    unsigned char* ws = a.ws;
    const int idx = unit * 512 + mk_tid(), t = idx >> 6, hp = (idx >> 4) & 3, dc = idx & 15;
    const float* lse = (const float*)(ws + WS_LSE) + (size_t)t * 12;
    const float l0 = lse[hp], l1 = lse[4 + hp], l2 = lse[8 + hp];
    const float m = fmaxf(l0, fmaxf(l1, l2));
    float w0 = __builtin_amdgcn_exp2f(l0 - m), w1 = __builtin_amdgcn_exp2f(l1 - m), w2 = __builtin_amdgcn_exp2f(l2 - m);
    const float is = 1.0f / (w0 + w1 + w2); w0 *= is; w1 *= is; w2 *= is;
    const bf16_t* o = (const bf16_t*)(ws + WS_OATT) + (size_t)t * 1536 + hp * 128 + dc * 8;
    const u32x4 a0 = *(const u32x4*)o, a1 = *(const u32x4*)(o + 512), a2 = *(const u32x4*)(o + 1024);
    u32x4 r;
#pragma unroll
    for (int q = 0; q < 4; ++q) r[q] = pk2(w0 * bflo(a0[q]) + w1 * bflo(a1[q]) + w2 * bflo(a2[q]), w0 * bfhi(a0[q]) + w1 * bfhi(a1[q]) + w2 * bfhi(a2[q]));
    *(u32x4*)((bf16_t*)(ws + WS_YA) + (size_t)t * 512 + hp * 128 + dc * 8) = r;
}

DI void retout_unit(const Args& a, int unit, LAS unsigned char* lds) {
    unsigned char* ws = a.ws;
    const int tid = mk_tid(), lane = tid & 63, w = __builtin_amdgcn_readfirstlane(tid >> 6), g = lane >> 4, l15 = lane & 15, tq4 = l15 >> 2, tp4 = l15 & 3;
    const int b = unit >> 7, h = (unit >> 5) & 3, c = unit & 31;
    const bf16_t* proj = (const bf16_t*)(ws + WS_PROJ); const size_t brow = (size_t)b * SEQ + c * 128;
    const bf16_t* rt = (const bf16_t*)(ws + WS_KVB) + ((size_t)((b * 4 + h) * 32 + c)) * 65536;
    LAS unsigned char* RA = lds; LAS unsigned char* RB = lds + 128 * 544;
    const float l2g = log2gamma(h);
    const int qi = 16 * w + l15;
    bf16x8 qf[8];
#pragma unroll
    for (int ks = 0; ks < 8; ++ks) qf[ks] = *(const bf16x8*)(proj + pjo(brow + qi, OFF_RQ + h * 256 + 32 * ks + 8 * g));
#pragma unroll
    for (int i = 0; i < 8; ++i) {
        const int idx = tid + 512 * i, row = idx >> 5, ch = idx & 31;
        *(LAS u32x4*)(RA + row * 544 + ch * 16) = *(const u32x4*)(proj + pjo(brow + row, OFF_RK + h * 256 + ch * 8));
        *(LAS u32x4*)(RB + row * 544 + ch * 16) = *(const u32x4*)(rt + (size_t)row * 256 + ch * 8);
    }
    __syncthreads();
    u32x4 pv[8], pr[8];
#pragma unroll
    for (int i = 0; i < 8; ++i) {
        const int idx = tid + 512 * i, row = idx >> 5, ch = idx & 31;
        pv[i] = *(const u32x4*)(proj + pjo(brow + row, OFF_RV + h * 256 + ch * 8));
        pr[i] = *(const u32x4*)(rt + (size_t)(128 + row) * 256 + ch * 8);
    }
    f32x4 sacc[8], oacc[16];
#pragma unroll
    for (int jj = 0; jj < 8; ++jj) {
        f32x4 acc = {0.f, 0.f, 0.f, 0.f};
        if (jj <= w) {
#pragma unroll
            for (int ks = 0; ks < 8; ++ks) { const bf16x8 kf = *(const LAS bf16x8*)(RA + (16 * jj + l15) * 544 + (32 * ks + 8 * g) * 2); acc = mfma16(kf, qf[ks], acc); }
        }
        sacc[jj] = acc;
    }
#pragma unroll
    for (int db = 0; db < 8; ++db) {
        f32x4 acc = {0.f, 0.f, 0.f, 0.f};
#pragma unroll
        for (int ks = 0; ks < 8; ++ks) { const bf16x8 rf = *(const LAS bf16x8*)(RB + (16 * db + l15) * 544 + (32 * ks + 8 * g) * 2); acc = mfma16(rf, qf[ks], acc); }
        oacc[db] = acc;
    }
    __syncthreads();
#pragma unroll
    for (int i = 0; i < 8; ++i) {
        const int idx = tid + 512 * i, row = idx >> 5, ch = idx & 31;
        *(LAS u32x4*)(RA + row * 544 + ch * 16) = pv[i];
        *(LAS u32x4*)(RB + row * 544 + ch * 16) = pr[i];
    }
    __syncthreads();
#pragma unroll
    for (int db = 0; db < 8; ++db) {
        f32x4 acc = {0.f, 0.f, 0.f, 0.f};
#pragma unroll
        for (int ks = 0; ks < 8; ++ks) { const bf16x8 rf = *(const LAS bf16x8*)(RB + (16 * db + l15) * 544 + (32 * ks + 8 * g) * 2); acc = mfma16(rf, qf[ks], acc); }
        oacc[8 + db] = acc;
    }
    const float xi = __builtin_amdgcn_exp2f((float)(qi + 1) * l2g);
#pragma unroll
    for (int db = 0; db < 16; ++db) oacc[db] = oacc[db] * xi;
#pragma unroll
    for (int jj = 0; jj < 8; ++jj)
#pragma unroll
        for (int rg = 0; rg < 4; ++rg) { const int j = 16 * jj + 4 * g + rg; sacc[jj][rg] = (qi >= j) ? sacc[jj][rg] * __builtin_amdgcn_exp2f((float)(qi - j) * l2g) : 0.f; }
#pragma unroll
    for (int s = 0; s < 4; ++s) {
        if (2 * s <= w) {
            u32x4 pw; pw.x = pk2(sacc[2 * s][0], sacc[2 * s][1]); pw.y = pk2(sacc[2 * s][2], sacc[2 * s][3]); pw.z = pk2(sacc[2 * s + 1][0], sacc[2 * s + 1][1]); pw.w = pk2(sacc[2 * s + 1][2], sacc[2 * s + 1][3]);
            const bf16x8 pb = __builtin_bit_cast(bf16x8, pw);
            const int k0 = 32 * s + 4 * g + tq4;
#pragma unroll
            for (int db = 0; db < 16; ++db) {
                const s16x4 lo = trrd(RA + k0 * 544 + (16 * db + 4 * tp4) * 2), hi = trrd(RA + (k0 + 16) * 544 + (16 * db + 4 * tp4) * 2);
                oacc[db] = mfma16(cat8(lo, hi), pb, oacc[db]);
            }
        }
    }
    float s1 = 0.f;
#pragma unroll
    for (int db = 0; db < 16; ++db) s1 += (oacc[db][0] + oacc[db][1]) + (oacc[db][2] + oacc[db][3]);
    s1 += __shfl_xor(s1, 16); s1 += __shfl_xor(s1, 32);
    const float mean = s1 * (1.0f / 256.0f);
    float s2 = 0.f;
#pragma unroll
    for (int db = 0; db < 16; ++db)
#pragma unroll
        for (int rg = 0; rg < 4; ++rg) { const float dd = oacc[db][rg] - mean; s2 += dd * dd; }
    s2 += __shfl_xor(s2, 16); s2 += __shfl_xor(s2, 32);
    const float rstd = rsqrtf(s2 * (1.0f / 256.0f) + LN_EPS);
    __syncthreads();
#pragma unroll
    for (int db = 0; db < 16; ++db) {
        u32x2 o; o.x = pk2((oacc[db][0] - mean) * rstd, (oacc[db][1] - mean) * rstd); o.y = pk2((oacc[db][2] - mean) * rstd, (oacc[db][3] - mean) * rstd);
        *(LAS u32x2*)(RA + qi * 528 + (16 * db + 4 * g) * 2) = o;
    }
    __syncthreads();
#pragma unroll
    for (int i = 0; i < 8; ++i) {
        const int idx = tid + 512 * i, row = idx >> 5, ch = idx & 31;
        const u32x4 nv = *(const LAS u32x4*)(RA + row * 528 + ch * 16);
        const u32x4 gw = *(const u32x4*)(proj + pjo(brow + row, OFF_RG + h * 256 + ch * 8));
        u32x4 o;
#pragma unroll
        for (int q = 0; q < 4; ++q) { const float g0 = bflo(gw[q]), g1 = bfhi(gw[q]); o[q] = pk2(g0 * sigm(g0) * bflo(nv[q]), g1 * sigm(g1) * bfhi(nv[q])); }
        *(u32x4*)((bf16_t*)(ws + WS_YC) + ((size_t)b * SEQ + c * 128 + row) * 1024 + h * 256 + ch * 8) = o;
    }
    __syncthreads();
}

struct EpiBranch {
    static constexpr bool PERM = false, AFTER_DRAIN = false;
    const bf16_t* gate; int gcol; bf16_t* mf; bf16_t* mb; int mode;
    __device__ __forceinline__ void operator()(const f32x4 (&acc)[2][2][4][2], const pg8::Unit& u, int wr, int wc, int fr, int fq) const {
        const int row0 = u.pm * 256 + wr * 64 + fr, col0 = u.pn * 256 + wc * 32 + 4 * fq;
        bf16_t* dst = (mode == 2) ? mb : mf;
#pragma unroll
        for (int ai = 0; ai < 2; ++ai) {
            u32x2 gw[4][2][2], old[4][2][2];
#pragma unroll
            for (int m = 0; m < 4; ++m) { const size_t row = (size_t)(row0 + ai * 128 + m * 16);
#pragma unroll
                for (int bj = 0; bj < 2; ++bj)
#pragma unroll
                    for (int n = 0; n < 2; ++n) { const int col = col0 + bj * 128 + n * 16;
                        gw[m][bj][n] = *(const u32x2*)(gate + pjo(row, gcol + col));
                        old[m][bj][n] = (mode != 0) ? *(const u32x2*)(mf + row * 1024 + col) : (u32x2){0u, 0u}; } }
#pragma unroll
            for (int m = 0; m < 4; ++m) { const size_t row = (size_t)(row0 + ai * 128 + m * 16);
#pragma unroll
                for (int bj = 0; bj < 2; ++bj)
#pragma unroll
                    for (int n = 0; n < 2; ++n) { const int col = col0 + bj * 128 + n * 16;
                        const u32x2 g2 = gw[m][bj][n], o2 = old[m][bj][n];
                        f32x4 v = acc[ai][bj][m][n];
                        v[0] = v[0] * sigm(bflo(g2.x)) + bflo(o2.x); v[1] = v[1] * sigm(bfhi(g2.x)) + bfhi(o2.x);
                        v[2] = v[2] * sigm(bflo(g2.y)) + bflo(o2.y); v[3] = v[3] * sigm(bfhi(g2.y)) + bfhi(o2.y);
                        u32x2 o; o.x = pk2(v[0], v[1]); o.y = pk2(v[2], v[3]); *(u32x2*)(dst + row * 1024 + col) = o; } }
        }
    }
};
#ifndef MK_EPI_AUX
#define MK_EPI_AUX 0
#endif
struct EpiInProj {
    static constexpr bool PERM = true, AFTER_DRAIN = false;
    bf16_t* O;
    __device__ __forceinline__ void operator()(const f32x4 (&acc)[2][2][4][2], const pg8::Unit& u, int wr_, int wc_, int fr_, int fq_) const {
        (void)wr_; (void)wc_; (void)fr_; (void)fq_;
        const int tid = mk_tid(), wid = tid >> 6, lane = tid & 63, wr = wid >> 2, wc = wid & 3, fr = lane & 15, fq = lane >> 4;
        const __amdgpu_buffer_rsrc_t rsrc = __builtin_amdgcn_make_buffer_rsrc((void*)O, 0, (int)((size_t)NTOK * DIN * 2), 0x00020000);
        const int row0 = u.pm * 256 + wr * 64 + fr;
        const int pn = u.pn;
        const bool ropeA = pn < 12, ropeR = (pn >= 26 && pn < 34);
        const float dsc = 1.0f / (X8_SCALE * W8_SCALE);
        if (!(ropeA || ropeR)) {
            const int col0 = pn * 256 + 64 * wc + 8 * fq;
            const bool isLG = (pn >= 22 && pn < 26);
#pragma unroll
            for (int ai = 0; ai < 2; ++ai) {
#pragma unroll
                for (int m = 0; m < 4; ++m) { const unsigned roff = (unsigned)(pjo((size_t)(row0 + ai * 128 + m * 16), col0) * 2);
#pragma unroll
                    for (int bj = 0; bj < 2; ++bj) { f32x4 v0 = acc[ai][bj][m][0] * dsc, v1 = acc[ai][bj][m][1] * dsc;
                        if (isLG) { const pg8::f32x2 g0 = pg8::gelu_pk((pg8::f32x2){v0[0], v0[1]}), g1 = pg8::gelu_pk((pg8::f32x2){v0[2], v0[3]}), g2 = pg8::gelu_pk((pg8::f32x2){v1[0], v1[1]}), g3 = pg8::gelu_pk((pg8::f32x2){v1[2], v1[3]});
                            v0 = (f32x4){g0.x, g0.y, g1.x, g1.y}; v1 = (f32x4){g2.x, g2.y, g3.x, g3.y}; }
                        u32x4 w; w.x = pk2(v0[0], v0[1]); w.y = pk2(v0[2], v0[3]); w.z = pk2(v1[0], v1[1]); w.w = pk2(v1[2], v1[3]);
                        __builtin_amdgcn_raw_buffer_store_b128(w, rsrc, (int)(roff + bj * 64), 0, MK_EPI_AUX); } }
            }
        } else {
            const int half = ropeA ? 64 : 128;
            const float sc = (pn >= 30 && pn < 34) ? 0.0625f : 1.0f;
            const float kf = ropeA ? (-13.287712379549449f / 64.0f) : (-13.287712379549449f / 128.0f);
            const float pos0 = (float)(row0 & (SEQ - 1));
#pragma unroll
            for (int bj = 0; bj < 2; ++bj) {
                const int pc = 64 * wc + 32 * bj + 8 * fq;
                const int cbase = ropeA ? (pc & 128) : 0;
                const int q = ropeA ? ((pc & 127) >> 3) : (pc >> 3);
                f32x4 cb, sb, c16, s16, cb1, sb1;
#pragma unroll
                for (int e = 0; e < 4; ++e) {
                    const float f = __builtin_amdgcn_exp2f((float)(4 * q + e) * kf) * 0.15915494309189535f;
                    const float t0 = __builtin_amdgcn_fractf(pos0 * f), t16 = __builtin_amdgcn_fractf(16.0f * f), t128 = __builtin_amdgcn_fractf(128.0f * f);
                    cb[e] = __builtin_amdgcn_cosf(t0); sb[e] = __builtin_amdgcn_sinf(t0);
                    c16[e] = __builtin_amdgcn_cosf(t16); s16[e] = __builtin_amdgcn_sinf(t16);
                    const float c128 = __builtin_amdgcn_cosf(t128), s128 = __builtin_amdgcn_sinf(t128);
                    cb1[e] = cb[e] * c128 - sb[e] * s128; sb1[e] = sb[e] * c128 + cb[e] * s128;
                }
#pragma unroll
                for (int ai = 0; ai < 2; ++ai) {
                    f32x4 cv = ai ? cb1 : cb, sv = ai ? sb1 : sb;
#pragma unroll
                    for (int m = 0; m < 4; ++m) {
                        const int row = row0 + ai * 128 + m * 16;
                        const unsigned roff = (unsigned)(pjo((size_t)row, pn * 256) * 2);
                        const float rsc = dsc * sc;
                        const f32x4 t1 = acc[ai][bj][m][0] * rsc, t2 = acc[ai][bj][m][1] * rsc;
                        const f32x4 o1 = t1 * cv - t2 * sv, o2 = t1 * sv + t2 * cv;
                        u32x2 w1, w2; w1.x = pk2(o1[0], o1[1]); w1.y = pk2(o1[2], o1[3]); w2.x = pk2(o2[0], o2[1]); w2.y = pk2(o2[2], o2[3]);
                        __builtin_amdgcn_raw_buffer_store_b64(w1, rsrc, (int)(roff + (cbase + 4 * q) * 2), 0, MK_EPI_AUX); __builtin_amdgcn_raw_buffer_store_b64(w2, rsrc, (int)(roff + (cbase + half + 4 * q) * 2), 0, MK_EPI_AUX);
                        if (m < 3) { const f32x4 cn = cv * c16 - sv * s16, sn = sv * c16 + cv * s16; cv = cn; sv = sn; }
                    }
                }
            }
        }
    }
};

struct EpiOut {
    static constexpr bool PERM = false, AFTER_DRAIN = false;
    const float* xf; float* z;
    __device__ __forceinline__ void operator()(const f32x4 (&acc)[2][2][4][2], const pg8::Unit& u, int wr, int wc, int fr, int fq) const {
        const int row0 = u.pm * 256 + wr * 64 + fr, col0 = u.pn * 256 + wc * 32 + 4 * fq;
#pragma unroll
        for (int ai = 0; ai < 2; ++ai) {
            f32x4 xv[4][2][2];
#pragma unroll
            for (int m = 0; m < 4; ++m) { const size_t row = (size_t)(row0 + ai * 128 + m * 16);
#pragma unroll
                for (int bj = 0; bj < 2; ++bj)
#pragma unroll
                    for (int n = 0; n < 2; ++n) xv[m][bj][n] = *(const f32x4*)(xf + row * 1024 + col0 + bj * 128 + n * 16); }
#pragma unroll
            for (int m = 0; m < 4; ++m) { const size_t row = (size_t)(row0 + ai * 128 + m * 16);
#pragma unroll
                for (int bj = 0; bj < 2; ++bj)
#pragma unroll
                    for (int n = 0; n < 2; ++n) *(f32x4*)(z + row * 1024 + col0 + bj * 128 + n * 16) = xv[m][bj][n] * ALPHA + acc[ai][bj][m][n]; }
        }
    }
};

DI void ln_row(const float* z, const float* gam, const float* bet, float* of, bf16_t* ob, int lane) {
    f32x4 v[4]; float s = 0.f;
#pragma unroll
    for (int i = 0; i < 4; ++i) { v[i] = *(const f32x4*)(z + 256 * i + 4 * lane); s += (v[i][0] + v[i][1]) + (v[i][2] + v[i][3]); }
    const float mean = wsum(s) * (1.0f / 1024.0f);
    float q = 0.f;
#pragma unroll
    for (int i = 0; i < 4; ++i)
#pragma unroll
        for (int j = 0; j < 4; ++j) { const float d = v[i][j] - mean; q += d * d; }
    const float rstd = rsqrtf(wsum(q) * (1.0f / 1024.0f) + LN_EPS);
#pragma unroll
    for (int i = 0; i < 4; ++i) {
        const f32x4 gg = *(const f32x4*)(gam + 256 * i + 4 * lane), bb = *(const f32x4*)(bet + 256 * i + 4 * lane);
        f32x4 o;
#pragma unroll
        for (int j = 0; j < 4; ++j) o[j] = (v[i][j] - mean) * rstd * gg[j] + bb[j];
        *(f32x4*)(of + 256 * i + 4 * lane) = o;
        u32x2 pb; pb.x = pk2(o[0], o[1]); pb.y = pk2(o[2], o[3]); *(u32x2*)(ob + 256 * i + 4 * lane) = pb;
    }
}
DI void phase_ln1(const Args& a, int layer) {
    unsigned char* ws = a.ws;
    const int lane = mk_tid() & 63, w = mk_tid() >> 6;
    for (int u = blockIdx.x; u < NTOK / 8; u += gridDim.x) {
        const size_t row = (size_t)u * 8 + w;
        ln_row((const float*)(ws + WS_MRGF) + row * 1024, a.in[11] + layer * 1024, a.in[12] + layer * 1024, (float*)(ws + WS_XF) + row * 1024, (bf16_t*)(ws + WS_XB) + row * 1024, lane);
    }
}

DI void ins16(float (&L)[16], float x) {
#pragma unroll
    for (int k = 0; k < 16; ++k) { const float hi = fmaxf(L[k], x); x = fminf(L[k], x); L[k] = hi; }
}
DI void merge16(float (&L)[16], int xr) {
    float t[16];
#pragma unroll
    for (int k = 0; k < 16; ++k) t[k] = __shfl_xor(L[k], xr);
#pragma unroll
    for (int k = 0; k < 8; ++k) { const float x = t[k]; t[k] = t[15 - k]; t[15 - k] = x; }
#pragma unroll
    for (int k = 0; k < 16; ++k) t[k] = fmaxf(L[k], t[k]);
#define MK_CE_STAGE(dd) _Pragma("unroll") for (int k = 0; k < 16; ++k) if ((k & (dd)) == 0) { const float hi = fmaxf(t[k], t[k + (dd)]), lo = fminf(t[k], t[k + (dd)]); t[k] = hi; t[k + (dd)] = lo; }
    MK_CE_STAGE(8) MK_CE_STAGE(4) MK_CE_STAGE(2) MK_CE_STAGE(1)
#undef MK_CE_STAGE
#pragma unroll
    for (int k = 0; k < 16; ++k) L[k] = t[k];
}
#define MK_CE_DESC(v, i, l) { const float hi_ = fmaxf(v[i], v[l]), lo_ = fminf(v[i], v[l]); v[i] = hi_; v[l] = lo_; }
#define MK_CE_ASC(v, i, l)  { const float hi_ = fmaxf(v[i], v[l]), lo_ = fminf(v[i], v[l]); v[i] = lo_; v[l] = hi_; }
#define MK_BITONIC_STAGE(v, kk, jj) _Pragma("unroll") for (int i_ = 0; i_ < 16; ++i_) { if ((i_ & (jj)) == 0) { if ((i_ & (kk)) == 0) MK_CE_DESC(v, i_, i_ + (jj)) else MK_CE_ASC(v, i_, i_ + (jj)) } }
DI void sort16_desc(float (&v)[16]) {
    MK_BITONIC_STAGE(v, 2, 1)
    MK_BITONIC_STAGE(v, 4, 2) MK_BITONIC_STAGE(v, 4, 1)
    MK_BITONIC_STAGE(v, 8, 4) MK_BITONIC_STAGE(v, 8, 2) MK_BITONIC_STAGE(v, 8, 1)
    MK_BITONIC_STAGE(v, 16, 8) MK_BITONIC_STAGE(v, 16, 4) MK_BITONIC_STAGE(v, 16, 2) MK_BITONIC_STAGE(v, 16, 1)
}
DI void top16_of_two(float (&a)[16], const float (&b)[16]) {
#pragma unroll
    for (int k = 0; k < 16; ++k) a[k] = fmaxf(a[k], b[15 - k]);
    MK_BITONIC_STAGE(a, 16, 8) MK_BITONIC_STAGE(a, 16, 4) MK_BITONIC_STAGE(a, 16, 2) MK_BITONIC_STAGE(a, 16, 1)
}
DI void top16_half(const bf16_t* qp, const LAS unsigned char* kt, float (&L)[16], int g, int l15) {
    bf16x8 qf[4];
#pragma unroll
    for (int ks = 0; ks < 4; ++ks) qf[ks] = *(const bf16x8*)(qp + 32 * ks + 8 * g);
    float M[16];
#pragma unroll
    for (int kbk = 0; kbk < 8; ++kbk) {
        f32x4 acc = {0.f, 0.f, 0.f, 0.f};
#pragma unroll
        for (int ks = 0; ks < 4; ++ks) { const bf16x8 kf = *(const LAS bf16x8*)(kt + (16 * kbk + l15) * 256 + (((4 * ks + g) ^ l15) << 4)); acc = mfma16(kf, qf[ks], acc); }
#pragma unroll
        for (int rg = 0; rg < 4; ++rg) { const unsigned key = (unsigned)(16 * kbk + 4 * g + rg); const float x = __uint_as_float((__float_as_uint(acc[rg]) & ~0x7Fu) | key);
            if (kbk < 4) L[4 * kbk + rg] = x; else M[4 * (kbk - 4) + rg] = x; }
    }
    sort16_desc(L); sort16_desc(M); top16_of_two(L, M);
    merge16(L, 16); merge16(L, 32);
}
DI void topk_unit(const Args& a, int unit, LAS unsigned char* lds) {
    unsigned char* ws = a.ws;
    const int tid = mk_tid(), lane = tid & 63, w = __builtin_amdgcn_readfirstlane(tid >> 6), g = lane >> 4, l15 = lane & 15;
    const int tg = w & 3, hs = w >> 2;
    const size_t t = (size_t)unit * 64 + tg * 16 + l15;
    const bf16_t* Q = (const bf16_t*)(ws + WS_Q);
    LAS unsigned char* tiles = lds + 16384;
    float K1[16], K2[16];
#pragma unroll
    for (int k = 0; k < 16; ++k) { K1[k] = 0.f; K2[k] = 0.f; }
#pragma unroll 1
    for (int hh = 0; hh < 4; ++hh) {
#pragma unroll
        for (int i = 0; i < 16; ++i) {
            const int idx = tid + 512 * i, tile = idx >> 11, row = (idx >> 4) & 127, ch = idx & 15;
            const int hd = ((tile >> 1) ? 4 : 0) + hh;
            const bf16_t* src = (const bf16_t*)(ws + ((tile & 1) ? WS_K2B : WS_K1B)) + ((size_t)hd * 128 + row) * 128 + ch * 8;
            *(LAS u32x4*)(tiles + tile * 32768 + row * 256 + ((ch ^ (row & 15)) << 4)) = *(const u32x4*)src;
        }
        __syncthreads();
        const int h = hs * 4 + hh;
        float l1[16], l2[16];
        top16_half(Q + t * 2048 + h * 256, tiles + (hs * 2) * 32768, l1, g, l15);
        top16_half(Q + t * 2048 + h * 256 + 128, tiles + (hs * 2 + 1) * 32768, l2, g, l15);
        const bool mine = (g == hh);
#pragma unroll
        for (int k = 0; k < 16; ++k) { K1[k] = mine ? l1[k] : K1[k]; K2[k] = mine ? l2[k] : K2[k]; }
        __syncthreads();
    }
    const int h = hs * 4 + g;
    float F[16];
#pragma unroll
    for (int k = 0; k < 16; ++k) F[k] = -FLT_MAX;
#pragma unroll
    for (int ia = 0; ia < 16; ++ia)
#pragma unroll
        for (int ib = 0; ib < 16 / (ia + 1); ++ib) {
            const float s = __uint_as_float(__float_as_uint(K1[ia]) & ~0x7Fu) + __uint_as_float(__float_as_uint(K2[ib]) & ~0x7Fu);
            ins16(F, __uint_as_float((__float_as_uint(s) & ~0xFFu) | (unsigned)(ia * 16 + ib)));
        }
    LAS unsigned char* row = lds + tid * 32;
#pragma unroll
    for (int k = 0; k < 16; ++k) { row[k] = (unsigned char)(__float_as_uint(K1[k]) & 0x7Fu); row[16 + k] = (unsigned char)(__float_as_uint(K2[k]) & 0x7Fu); }
    float gt[16]; int ei[16]; float gs = 0.f;
    const float cv0 = __uint_as_float(__float_as_uint(F[0]) & ~0xFFu);
#pragma unroll
    for (int k = 0; k < 16; ++k) {
        const unsigned bits = __float_as_uint(F[k]);
        const float cv = __uint_as_float(bits & ~0xFFu);
        gt[k] = __builtin_amdgcn_exp2f((cv - cv0) * 1.4426950408889634f); gs += gt[k];
        const int ia = (int)((bits >> 4) & 15u), ib = (int)(bits & 15u);
        ei[k] = (int)row[ia] * 128 + (int)row[16 + ib];
    }
    const float ig = 1.0f / gs;
    int* ep = (int*)(ws + WS_EID) + (t * 8 + h) * 16; float* gp = (float*)(ws + WS_GATE) + (t * 8 + h) * 16;
#pragma unroll
    for (int q = 0; q < 4; ++q) {
        *(i32x4*)(ep + 4 * q) = (i32x4){ei[4 * q], ei[4 * q + 1], ei[4 * q + 2], ei[4 * q + 3]};
        *(f32x4*)(gp + 4 * q) = (f32x4){gt[4 * q] * ig, gt[4 * q + 1] * ig, gt[4 * q + 2] * ig, gt[4 * q + 3] * ig};
    }
    __syncthreads();
}

typedef float f32x2 __attribute__((ext_vector_type(2)));
typedef __bf16 bf16x32 __attribute__((ext_vector_type(32)));
typedef unsigned u32x16 __attribute__((ext_vector_type(16)));
#define MK_PB_LOAD(RA_, RB_, ereg, kb) _Pragma("unroll") for (int j = 0; j < 8; ++j) { const int e_ = __builtin_amdgcn_readlane(ereg, (kb) + j); \
        const unsigned char* p_ = UV + (size_t)(unsigned)e_ * 1536u; RA_[j] = ((const u32x4*)p_)[lane]; RB_[j] = ((const u32x2*)(p_ + 1024))[lane]; }
#define MK_PB_COMP(RA_, RB_, usreg, gvreg, kb) { \
        float pp_[8]; \
        _Pragma("unroll") for (int j = 0; j < 8; ++j) { \
            const u32x16 hw_ = __builtin_bit_cast(u32x16, __builtin_amdgcn_cvt_scalef32_pk32_bf16_fp6((u32x6){RA_[j][0], RA_[j][1], RA_[j][2], RA_[j][3], RB_[j][0], RB_[j][1]}, 1.0f)); \
            float s0_ = 0.f, s1_ = 0.f; \
            _Pragma("unroll") for (int q = 0; q < 4; ++q) { s0_ = dot2(hw_[2 * q], xpk[2 * q], s0_); s1_ = dot2(hw_[2 * q + 1], xpk[2 * q + 1], s1_); } \
            pp_[j] = s0_ + s1_; } \
        float q4_[4], r2_[2]; \
        _Pragma("unroll") for (int i = 0; i < 4; ++i) { const float keep_ = hi32 ? pp_[4 + i] : pp_[i], send_ = hi32 ? pp_[i] : pp_[4 + i]; q4_[i] = keep_ + __shfl_xor(send_, 32); } \
        _Pragma("unroll") for (int i = 0; i < 2; ++i) { const float keep_ = hi16 ? q4_[2 + i] : q4_[i], send_ = hi16 ? q4_[i] : q4_[2 + i]; r2_[i] = keep_ + __shfl_xor(send_, 16); } \
        float tot_ = (hi8 ? r2_[1] : r2_[0]) + __shfl_xor(hi8 ? r2_[0] : r2_[1], 8); \
        tot_ += __shfl_xor(tot_, 4); tot_ += __shfl_xor(tot_, 2); tot_ += __shfl_xor(tot_, 1); \
        const float act_ = gelu_as(tot_ * __shfl(usreg, (kb) + jj)) * __shfl(gvreg, (kb) + jj); \
        _Pragma("unroll") for (int j = 0; j < 8; ++j) { \
            const float aj_ = __uint_as_float(__builtin_amdgcn_readlane(__float_as_uint(act_), 32 * (j >> 2) + 16 * ((j >> 1) & 1) + 8 * (j & 1))); const f32x2 a2_ = {aj_, aj_}; \
            const f32x32 f_ = __builtin_amdgcn_cvt_scalef32_pk32_f32_fp6((u32x6){RA_[j][0], RA_[j][1], RA_[j][2], RA_[j][3], RB_[j][0], RB_[j][1]}, 1.0f); \
            _Pragma("unroll") for (int q = 0; q < 8; ++q) y2[q] += a2_ * (f32x2){f_[16 + 2 * q], f_[16 + 2 * q + 1]}; } }
DI void peer_token(const unsigned char* UV, int e0, int e1, float us0, float us1, float gv0, float gv1, const unsigned (&xpk)[8], f32x2 (&y2)[8], int lane) {
    const bool hi32 = (lane & 32) != 0, hi16 = (lane & 16) != 0, hi8 = (lane & 8) != 0;
    const int jj = ((lane >> 5) & 1) * 4 + ((lane >> 4) & 1) * 2 + ((lane >> 3) & 1);
    u32x4 A0[8], A1[8]; u32x2 B0[8], B1[8];
    MK_PB_LOAD(A0, B0, e0, 0)
#pragma unroll 1
    for (int b = 0; b < 8; b += 2) {
        MK_PB_LOAD(A1, B1, e0, 8 * b + 8)
        MK_PB_COMP(A0, B0, us0, gv0, 8 * b)
        if (b + 2 < 8) { MK_PB_LOAD(A0, B0, e0, 8 * b + 16) } else { MK_PB_LOAD(A0, B0, e1, 0) }
        MK_PB_COMP(A1, B1, us0, gv0, 8 * b + 8)
    }
#pragma unroll 1
    for (int b = 0; b < 8; b += 2) {
        MK_PB_LOAD(A1, B1, e1, 8 * b + 8)
        MK_PB_COMP(A0, B0, us1, gv1, 8 * b)
        if (b + 2 < 8) { MK_PB_LOAD(A0, B0, e1, 8 * b + 16) }
        MK_PB_COMP(A1, B1, us1, gv1, 8 * b + 8)
    }
}
DI void peer_unit(const Args& a, int layer, int unit) {
    unsigned char* ws = a.ws;
    const int tid = mk_tid(), lane = tid & 63, w = __builtin_amdgcn_readfirstlane(tid >> 6);
    const unsigned char* UV = ws + WS_UV8; const float* SC = (const float*)(ws + WS_UVS);
#pragma unroll 1
    for (int i = 0; i < 8; ++i) {
        const size_t t = (size_t)unit * 64 + w * 8 + i;
        unsigned xpk[8]; f32x2 y2[8];
        int e0, e1; float us0, us1, gv0, gv1;
        {
            const int ln = mk_tid() & 63;
            const bf16_t* xbp = (const bf16_t*)(ws + WS_XB) + t * 1024 + 16 * ln;
            const u32x4 xa = *(const u32x4*)xbp, xb = *(const u32x4*)(xbp + 8);
#pragma unroll
            for (int q = 0; q < 4; ++q) { xpk[q] = xa[q]; xpk[4 + q] = xb[q]; }
            const int* ep = (const int*)(ws + WS_EID) + t * 128; const float* gp = (const float*)(ws + WS_GATE) + t * 128;
            e0 = ep[ln]; e1 = ep[64 + ln]; const float g0 = gp[ln], g1 = gp[64 + ln];
            const f32x2 s0 = *(const f32x2*)(SC + 2 * e0), s1 = *(const f32x2*)(SC + 2 * e1);
            us0 = s0.x; us1 = s1.x; gv0 = g0 * s0.y; gv1 = g1 * s1.y;
        }
#pragma unroll
        for (int q = 0; q < 8; ++q) y2[q] = (f32x2){0.f, 0.f};
        peer_token(UV, e0, e1, us0, us1, gv0, gv1, xpk, y2, lane);
        {
            const int ln = mk_tid() & 63;
            float* xfp = (float*)(ws + WS_XF) + t * 1024 + 16 * ln;
            const float* gam = a.in[18] + layer * 1024 + 16 * ln; const float* bet = a.in[19] + layer * 1024 + 16 * ln;
            float z[16]; float s = 0.f;
#pragma unroll
            for (int q = 0; q < 4; ++q) { const f32x4 xr = *(const f32x4*)(xfp + 4 * q);
#pragma unroll
                for (int j = 0; j < 4; ++j) { z[4 * q + j] = ALPHA * xr[j] + y2[2 * q + (j >> 1)][j & 1]; s += z[4 * q + j]; } }
            const float mean = wsum(s) * (1.0f / 1024.0f);
            float qq = 0.f;
#pragma unroll
            for (int q = 0; q < 16; ++q) { const float d = z[q] - mean; qq += d * d; }
            const float rstd = rsqrtf(wsum(qq) * (1.0f / 1024.0f) + LN_EPS);
            f32x4 o[4];
#pragma unroll
            for (int q = 0; q < 4; ++q) { const f32x4 gq = *(const f32x4*)(gam + 4 * q), bq = *(const f32x4*)(bet + 4 * q);
#pragma unroll
                for (int j = 0; j < 4; ++j) o[q][j] = (z[4 * q + j] - mean) * rstd * gq[j] + bq[j]; }
#pragma unroll
            for (int q = 0; q < 4; ++q) *(f32x4*)(xfp + 4 * q) = o[q];
            if (layer == DEPTH - 1) { float* op = a.out + t * 1024 + 16 * ln;
#pragma unroll
                for (int q = 0; q < 4; ++q) *(f32x4*)(op + 4 * q) = o[q]; }
            row_to_fp8(o, ws + WS_X8 + t * 1024, ln);
        }
    }
}
}

namespace mk {
constexpr int LDS_ARG_OFF = LDS_BYTES - 16 - 256;
#define MK_NOINL __device__ __forceinline__
DI unsigned long long rfl64(unsigned long long v) { const unsigned lo = __builtin_amdgcn_readfirstlane((unsigned)v), hi = __builtin_amdgcn_readfirstlane((unsigned)(v >> 32)); return ((unsigned long long)hi << 32) | lo; }
DI Args load_args(LAS unsigned char* lds) {
    int aoff = LDS_ARG_OFF; asm volatile("" : "+s"(aoff));
    Args a; const LAS unsigned long long* p = (const LAS unsigned long long*)(lds + aoff);
#pragma unroll
    for (int i = 0; i < 20; ++i) a.in[i] = (const float*)(const __attribute__((address_space(1))) float*)rfl64(p[i]);
    a.out = (float*)(__attribute__((address_space(1))) float*)rfl64(p[20]); a.ws = (unsigned char*)(__attribute__((address_space(1))) unsigned char*)rfl64(p[21]);
    a.ropeA = __longlong_as_double((long long)rfl64(p[22])); a.ropeR = __longlong_as_double((long long)rfl64(p[23])); a.ph_lo = 0; a.ph_hi = 0;
    return a;
}
#define MK_LOADARGS const Args a = load_args(lds); unsigned char* ws = a.ws; const int G = (int)gridDim.x, bid = (int)blockIdx.x; (void)ws; (void)G; (void)bid
MK_NOINL void PG_prologue(LAS unsigned char* lds) { MK_LOADARGS; phase_prologue(a); }
MK_NOINL void P0_conv(LAS unsigned char* lds, int layer) { MK_LOADARGS; phase_conv(a, layer, lds); }
#ifndef MK_STAGGER_TICKS
#define MK_STAGGER_TICKS 140
#endif
MK_NOINL void P1_inproj(LAS unsigned char* lds, int layer) { MK_LOADARGS; (void)layer;
    pg8::Gemm gm; gm.A = (const bf16_t*)(ws + WS_X8); gm.Bt = (const bf16_t*)(ws + WS_WINT); gm.M = NTOK; gm.N = DIN; gm.K = 512;
    pg8::StaticOrder S; S.init(NTOK, DIN, G, bid);
    EpiInProj E; E.O = (bf16_t*)(ws + WS_PROJ);
    pg8::gemm_phase<EpiInProj, pg8::StaticOrder, false, true, true>(lds, gm, S, E, nullptr); }
#ifndef MK_NLRU
#define MK_NLRU 64
#endif
MK_NOINL void P3s_lru(LAS unsigned char* lds, int layer) { MK_LOADARGS; if (bid < MK_NLRU) { for (int s = bid; s < 64; s += MK_NLRU) lru_stripe(a, layer, s, lds); } }
MK_NOINL void P3a_attn(LAS unsigned char* lds, int layer) { MK_LOADARGS; (void)layer; if (bid >= MK_NLRU) { for (int u = bid - MK_NLRU; u < 1536; u += G - MK_NLRU) attn_unit(a, u, lds); } }
MK_NOINL void P3b_retkv(LAS unsigned char* lds, int layer) { MK_LOADARGS; (void)layer; if (bid >= MK_NLRU) { for (int u = bid - MK_NLRU; u < 512; u += G - MK_NLRU) retkv_unit(a, u, lds); } }
MK_NOINL void P4a_scan(LAS unsigned char* lds, int layer) { MK_LOADARGS; (void)layer; for (int u = bid; u < 256; u += G) retscan_unit(a, u); }
MK_NOINL void P4c_merge(LAS unsigned char* lds, int layer) { MK_LOADARGS; (void)layer; for (int u = bid; u < 2048; u += G) attmerge_unit(a, u); }
MK_NOINL void P5_retout(LAS unsigned char* lds, int layer) { MK_LOADARGS; (void)layer; for (int u = bid; u < 512; u += G) retout_unit(a, u, lds); }
MK_NOINL void P6_branch(LAS unsigned char* lds, int layer) { MK_LOADARGS; (void)layer;
#pragma unroll 1
    for (int s = 0; s < 3; ++s) {
        pg8::Gemm gm; gm.A = (const bf16_t*)(ws + (s == 0 ? WS_YA : (s == 1 ? WS_YB : WS_YC))); gm.Bt = (const bf16_t*)(ws + (s == 0 ? WS_WBAT : (s == 1 ? WS_WBBT : WS_WBCT)));
        gm.M = NTOK; gm.N = 1024; gm.K = (s == 0) ? 512 : 1024;
        pg8::StaticOrder S; S.init(NTOK, 1024, G, bid);
        EpiBranch E; E.gate = (const bf16_t*)(ws + WS_PROJ); E.gcol = OFF_GA + 1024 * s; E.mf = (bf16_t*)(ws + WS_MRGF); E.mb = (bf16_t*)(ws + WS_MRGB); E.mode = s;
        pg8::gemm_phase<EpiBranch, pg8::StaticOrder, false>(lds, gm, S, E, nullptr);
    } }
MK_NOINL void P7_outproj(LAS unsigned char* lds, int layer) { MK_LOADARGS; (void)layer;
    pg8::Gemm gm; gm.A = (const bf16_t*)(ws + WS_MRGB); gm.Bt = (const bf16_t*)(ws + WS_WOT); gm.M = NTOK; gm.N = 1024; gm.K = 1024;
    pg8::StaticOrder S; S.init(NTOK, 1024, G, bid);
    EpiOut E; E.xf = (const float*)(ws + WS_XF); E.z = (float*)(ws + WS_MRGF);
    pg8::gemm_phase<EpiOut, pg8::StaticOrder, false>(lds, gm, S, E, nullptr); }
MK_NOINL void P8_ln1(LAS unsigned char* lds, int layer) { MK_LOADARGS; phase_ln1(a, layer); }
MK_NOINL void P9_wq(LAS unsigned char* lds, int layer) { MK_LOADARGS; (void)layer;
    pg8::Gemm gm; gm.A = (const bf16_t*)(ws + WS_XB); gm.Bt = (const bf16_t*)(ws + WS_WQT); gm.M = NTOK; gm.N = 2048; gm.K = 1024;
    pg8::StaticOrder S; S.init(NTOK, 2048, G, bid);
    pg8::EpiBf16<0> E; E.O = (bf16_t*)(ws + WS_Q); E.ldc = 2048; E.bias = nullptr; E.split_cols = 0; E.split_stride = 0;
    pg8::gemm_phase<pg8::EpiBf16<0>, pg8::StaticOrder, false>(lds, gm, S, E, nullptr); }
MK_NOINL void P10_topk(LAS unsigned char* lds, int layer) { MK_LOADARGS; (void)layer; for (int u = bid; u < NTOK / 64; u += G) topk_unit(a, u, lds); }
MK_NOINL void P11_peer(LAS unsigned char* lds, int layer) { MK_LOADARGS; for (int u = bid; u < NTOK / 64; u += G) peer_unit(a, layer, u); }
DI void mk_sync(LAS unsigned char* lds) {
    const Args a = load_args(lds);
    XcdBarrier b; b.bar = (unsigned*)(a.ws + WS_CTL); b.x = xb_xcc_id(); b.st = (volatile LAS unsigned*)(lds + LDS_BAR_OFF);
    xcd_barrier(b);
}
}

#ifndef MK_PHASE_MASK
#define MK_PHASE_MASK 0xFFFu
#endif
#define MK_RUN(k) ((((MK_PHASE_MASK) >> ((k) - pb)) & 1u) && (k) >= ph_lo && (k) < ph_hi)
#define MK_NPHASES (1 + mk::DEPTH * mk::NPH)

#define MK_SYNC(k) do { if ((k) >= ph_lo && (k) + 1 < ph_hi) mk::mk_sync(lds); } while (0)
__global__ __launch_bounds__(512, 2) void mk_fwd(mk::Args a) {
    using namespace mk;
    extern __shared__ __attribute__((aligned(16))) unsigned char smem_raw[];
    LAS unsigned char* lds = (LAS unsigned char*)smem_raw;
    const int ph_lo = a.ph_lo, ph_hi = a.ph_hi;
    {
        const unsigned* src = (const unsigned*)&a;
        if (threadIdx.x < sizeof(Args) / 4) ((LAS unsigned*)(lds + LDS_ARG_OFF))[threadIdx.x] = src[threadIdx.x];
        if (threadIdx.x == 0) { LAS unsigned* st = (LAS unsigned*)(lds + LDS_BAR_OFF); st[0] = 0u; st[1] = 0u; st[2] = 0u; st[3] = 0u; }
    }
    __syncthreads();
    if (ph_hi - ph_lo > 1) (void)xcd_barrier_post((unsigned*)(a.ws + WS_CTL), (volatile LAS unsigned*)(lds + LDS_BAR_OFF));
    if (0 >= ph_lo && 0 < ph_hi) PG_prologue(lds);
    MK_SYNC(0);
#pragma unroll 1
    for (int layer = 0; layer < DEPTH; ++layer) {
        const int pb = 1 + layer * NPH;
        if (MK_RUN(pb + 0)) P0_conv(lds, layer);
        MK_SYNC(pb + 0);
        if (MK_RUN(pb + 1)) P1_inproj(lds, layer);
        MK_SYNC(pb + 1);
        if (MK_RUN(pb + 3)) { P3s_lru(lds, layer); P3a_attn(lds, layer); P3b_retkv(lds, layer); }
        MK_SYNC(pb + 3);
        if (MK_RUN(pb + 4)) { P4a_scan(lds, layer); P4c_merge(lds, layer); }
        MK_SYNC(pb + 4);
        if (MK_RUN(pb + 5)) P5_retout(lds, layer);
        MK_SYNC(pb + 5);
        if (MK_RUN(pb + 6)) P6_branch(lds, layer);
        MK_SYNC(pb + 6);
        if (MK_RUN(pb + 7)) P7_outproj(lds, layer);
        MK_SYNC(pb + 7);
        if (MK_RUN(pb + 8)) P8_ln1(lds, layer);
        MK_SYNC(pb + 8);
        if (MK_RUN(pb + 9)) P9_wq(lds, layer);
        MK_SYNC(pb + 9);
        if (MK_RUN(pb + 10)) P10_topk(lds, layer);
        MK_SYNC(pb + 10);
        if (MK_RUN(pb + 11)) P11_peer(lds, layer);
        MK_SYNC(pb + 11);
    }
}

#ifndef MK_SINGLE
#define MK_SINGLE 1
#endif
extern "C" void kernel_launch(void* const* d_in, const int* in_sizes, int n_in, void* d_out, int out_size, void* d_ws, size_t ws_size, hipStream_t stream) {
    using namespace mk;
    static int grid = 0;
    if (grid == 0) {
        if (n_in != 20 || out_size != NTOK * D || ws_size < WS_END) { fprintf(stderr, "kernel_launch: unexpected shapes (n_in %d, out %d, ws %zu, need %zu)\n", n_in, out_size, ws_size, (size_t)WS_END); grid = -1; return; }
        int dev = 0, cus = 0, per_cu = 0;
        if (hipGetDevice(&dev) != hipSuccess || hipDeviceGetAttribute(&cus, hipDeviceAttributeMultiprocessorCount, dev) != hipSuccess) { grid = -1; return; }
        if (hipFuncSetAttribute((const void*)mk_fwd, hipFuncAttributeMaxDynamicSharedMemorySize, LDS_BYTES) != hipSuccess) { fprintf(stderr, "kernel_launch: hipFuncSetAttribute failed\n"); grid = -1; return; }
        if (hipOccupancyMaxActiveBlocksPerMultiprocessor(&per_cu, (const void*)mk_fwd, 512, LDS_BYTES) != hipSuccess || per_cu < 1) { fprintf(stderr, "kernel_launch: occupancy query says %d blocks per CU\n", per_cu); (void)hipGetLastError(); grid = -1; return; }
        grid = cus;
    }
    if (grid < 0) return;
    (void)in_sizes;
    Args a{};
    for (int i = 0; i < 20; ++i) a.in[i] = (const float*)d_in[i];
    a.out = (float*)d_out; a.ws = (unsigned char*)d_ws;
    a.ropeA = pow(10000.0, -2.0 / 128.0); a.ropeR = pow(10000.0, -2.0 / 256.0);
#if MK_SINGLE
    (void)hipMemsetAsync((unsigned char*)d_ws + WS_CTL, 0, 16384, stream);
    a.ph_lo = 0; a.ph_hi = MK_NPHASES;
    hipLaunchKernelGGL(mk_fwd, dim3(grid), dim3(512), LDS_BYTES, stream, a);
#else
    for (int p = 0; p < MK_NPHASES; ++p) { a.ph_lo = p; a.ph_hi = p + 1; hipLaunchKernelGGL(mk_fwd, dim3(grid), dim3(512), LDS_BYTES, stream, a); }
#endif
}
```

```cpp
#include <hip/hip_runtime.h>
#include <cstdio>
#include <cstdint>
#include <cmath>
#include <cfloat>
__device__ __forceinline__ int mk_tid() { int t = (int)threadIdx.x; asm volatile("" : "+v"(t)); return t; }
namespace pg8 {
#define PG8_LAS __attribute__((address_space(3)))
typedef unsigned short bf16_t;
typedef short bf16x8 __attribute__((ext_vector_type(8)));
typedef float f32x4 __attribute__((ext_vector_type(4)));
typedef unsigned u32x4 __attribute__((ext_vector_type(4)));
constexpr int BM = 256, BK = 64, HALF = 128, HTB = HALF * BK * 2  , STAGE_BYTES = 8 * HTB, NXCD = 8, WGM = 8;

__host__ __device__ __forceinline__ int lds_byte(int r, int c) { const int st = (r >> 4) * 2 + (c >> 5), rr = r & 15, cc = c & 31, ob = rr * 64 + cc * 2; return st * 1024 + (ob ^ (((ob >> 9) & 1) << 5)); }
__host__ __device__ __forceinline__ void stage_rc(int b, int& R, int& C) { const int st = b / 1024, sb = b % 1024, swz = sb ^ (((sb >> 9) & 1) << 5); R = (st >> 1) * 16 + swz / 64; C = (st & 1) * 32 + (swz % 64) / 2; }
__host__ __device__ __forceinline__ int perm32(int rho) { const int n = rho >> 4, i = rho & 15; return 8 * (i >> 2) + 4 * n + (i & 3); }

struct Unit { int pm, pn; };
struct Gemm { const bf16_t* A; const bf16_t* Bt; int M, N, K; };

struct StaticOrder {
    int nM, nN, nwg, G, c;
    __host__ __device__ void init(int M, int N, int G_, int c_) { nM = M / BM; nN = N / BM; nwg = nM * nN; G = G_; c = c_; }
    __host__ __device__ bool next(int i, Unit& u) const {
        const long L = (long)i * G + c; if (L >= nwg) return false;
        int wgid = (int)L; { const int q = nwg / NXCD, r = nwg % NXCD, xcd = wgid % NXCD, off = wgid / NXCD; wgid = (xcd < r ? xcd * (q + 1) : r * (q + 1) + (xcd - r) * q) + off; }
        const int nig = WGM * nN, gid = wgid / nig, fm = gid * WGM, gsz = (nM - fm) < WGM ? (nM - fm) : WGM;
        u.pm = fm + ((wgid % nig) % gsz); u.pn = (wgid % nig) / gsz; return true;
    }
    __device__ __forceinline__ void a_ready(const Unit&) const {}
    __device__ __forceinline__ void done(const Unit&) const {}
};
typedef __bf16 pg8_bf16x2 __attribute__((ext_vector_type(2)));
__device__ __forceinline__ unsigned cvt_pk_bf16(float lo, float hi) { const pg8_bf16x2 v = {(__bf16)lo, (__bf16)hi}; return __builtin_bit_cast(unsigned, v); }
typedef float f32x2 __attribute__((ext_vector_type(2)));
__device__ __forceinline__ f32x2 gelu_pk(f32x2 v) {
    const f32x2 av = __builtin_elementwise_abs(v), d = av * 0.2316418882f + 1.0f;
    f32x2 t; t.x = __builtin_amdgcn_rcpf(d.x); t.y = __builtin_amdgcn_rcpf(d.y);
    f32x2 q = t * 0.5307027145f + (-0.7265760135f); q = q * t + 0.7107068705f; q = q * t + (-0.142248368f); q = q * t + 0.127414796f; q = q * t;
    const f32x2 s = (v * v) * (-0.72134752044f);
    f32x2 e; e.x = __builtin_amdgcn_exp2f(s.x); e.y = __builtin_amdgcn_exp2f(s.y);
    const f32x2 m = v * (q * e), r = v - m;
    f32x2 o; o.x = v.x < 0.f ? m.x : r.x; o.y = v.y < 0.f ? m.y : r.y; return o;
}

struct EpiF32 {
    static constexpr bool PERM = false, AFTER_DRAIN = false;
    float* C; int ldc; const float* bias;
    __device__ __forceinline__ void operator()(const f32x4 (&acc)[2][2][4][2], const Unit& u, int wr, int wc, int fr, int fq) const {
        const int row0 = u.pm * BM + wr * 64 + fr, col0 = u.pn * BM + wc * 32 + 4 * fq;
        f32x4 bv[2][2];
#pragma unroll
        for (int bj = 0; bj < 2; ++bj)
#pragma unroll
            for (int n = 0; n < 2; ++n) bv[bj][n] = bias ? *(const f32x4*)(bias + col0 + bj * HALF + n * 16) : (f32x4){0.f, 0.f, 0.f, 0.f};
#pragma unroll
        for (int ai = 0; ai < 2; ++ai)
#pragma unroll
            for (int m = 0; m < 4; ++m) { float* rowp = C + (size_t)(row0 + ai * HALF + m * 16) * ldc + col0;
#pragma unroll
                for (int bj = 0; bj < 2; ++bj)
#pragma unroll
                    for (int n = 0; n < 2; ++n) *(f32x4*)(rowp + bj * HALF + n * 16) = acc[ai][bj][m][n] + bv[bj][n]; }
    }
};
template <int ACT  > struct EpiBf16 {
    static constexpr bool PERM = true, AFTER_DRAIN = false;
    bf16_t* O; int ldc; const float* bias; int split_cols; size_t split_stride;
    __device__ __forceinline__ void operator()(const f32x4 (&acc)[2][2][4][2], const Unit& u, int wr, int wc, int fr, int fq) const {
        const int row0 = u.pm * BM + wr * 64 + fr; int colt = u.pn * BM; bf16_t* base = O;
        if (split_cols) { const int t = colt / split_cols; base += (size_t)t * split_stride; colt -= t * split_cols; }
        const int col0 = colt + wc * 32 + 8 * fq, bcol0 = u.pn * BM + wc * 32 + 8 * fq;
        f32x4 bv[2][2];
#pragma unroll
        for (int bj = 0; bj < 2; ++bj)
#pragma unroll
            for (int n = 0; n < 2; ++n) bv[bj][n] = bias ? *(const f32x4*)(bias + bcol0 + bj * HALF + 4 * n) : (f32x4){0.f, 0.f, 0.f, 0.f};
#pragma unroll
        for (int ai = 0; ai < 2; ++ai)
#pragma unroll
            for (int m = 0; m < 4; ++m) { bf16_t* rowp = base + (size_t)(row0 + ai * HALF + m * 16) * ldc + col0;
#pragma unroll
                for (int bj = 0; bj < 2; ++bj) { f32x4 v0 = acc[ai][bj][m][0] + bv[bj][0], v1 = acc[ai][bj][m][1] + bv[bj][1];
                    if (ACT == 1) { f32x2 a = gelu_pk((f32x2){v0[0], v0[1]}), b = gelu_pk((f32x2){v0[2], v0[3]}), c = gelu_pk((f32x2){v1[0], v1[1]}), d = gelu_pk((f32x2){v1[2], v1[3]});
                        v0 = (f32x4){a.x, a.y, b.x, b.y}; v1 = (f32x4){c.x, c.y, d.x, d.y}; }
                    if (ACT == 2) {
#pragma unroll
                        for (int j = 0; j < 4; ++j) { v0[j] = 0.5f * v0[j] * (1.0f + erff(v0[j] * 0.70710678f)); v1[j] = 0.5f * v1[j] * (1.0f + erff(v1[j] * 0.70710678f)); } }
                    u32x4 w; w.x = cvt_pk_bf16(v0[0], v0[1]); w.y = cvt_pk_bf16(v0[2], v0[3]); w.z = cvt_pk_bf16(v1[0], v1[1]); w.w = cvt_pk_bf16(v1[2], v1[3]);
                    *(u32x4*)(rowp + bj * HALF) = w; } }
    }
};

typedef int i32x8 __attribute__((ext_vector_type(8)));
typedef short s16x16 __attribute__((ext_vector_type(16)));
__device__ __forceinline__ i32x8 pg8_cat16(bf16x8 a, bf16x8 b) { return __builtin_bit_cast(i32x8, (s16x16)__builtin_shufflevector(a, b, 0, 1, 2, 3, 4, 5, 6, 7, 8, 9, 10, 11, 12, 13, 14, 15)); }
template <class Epi, class Sched, bool STAMP = false, bool F8 = false, bool WIDE = false>
__device__ __forceinline__ void gemm_phase(PG8_LAS unsigned char* lds, const Gemm g, const Sched& S, const Epi& E, unsigned long long* stamps) {
    const int tid = mk_tid(), wid = __builtin_amdgcn_readfirstlane(tid >> 6), lane = tid & 63, wr = wid >> 2, wc = wid & 3, fr = lane & 15, fq = lane >> 4;
    const int K = g.K, nt = K / BK;
    int ts_lo = 0, ts_hi = 0, nts = 0; const unsigned long long rt_entry = STAMP ? (unsigned long long)wall_clock64() : 0ull;
#define PG8_STAMP() do { if (STAMP && wid == 0 && nts < 64) { const unsigned long long _c = (unsigned long long)clock64(); \
        ts_lo = (lane == nts) ? (int)(unsigned)_c : ts_lo; ts_hi = (lane == nts) ? (int)(unsigned)(_c >> 32) : ts_hi; ++nts; } } while (0)
    PG8_STAMP();
    unsigned voffA, voffB;
    { int R, C; stage_rc(tid * 16, R, C); const int Ri = Epi::PERM ? perm32(R & 31) : (R & 31); const int Rb = WIDE ? (((R >> 5) << 6) + Ri) : ((R & ~31) + Ri);
        voffA = (unsigned)(R * K + C) * 2u; voffB = (unsigned)(Rb * K + C) * 2u; }
    const size_t qstep = (size_t)64 * K * 2;
    const size_t qstepB = WIDE ? (size_t)128 * K * 2 : qstep;
    const size_t hstepB = WIDE ? (size_t)32 * K * 2 : (size_t)HALF * K * 2;
    const size_t kstep = (size_t)(BK * 2);
    const size_t hstep = (size_t)HALF * K * 2;
    const size_t tstep = 2 * hstep;
    const unsigned ldsw = (unsigned)wid * 1024u;
    const int aoff = lds_byte(wr * 64 + fr, fq * 8), boff = lds_byte(wc * 32 + fr, fq * 8);
#define PG8_SA(b, h) (((b) * 2 + (h)) * HTB)
#define PG8_SB(b, h) ((4 + (b) * 2 + (h)) * HTB)
#define PG8_STAGE(bufoff, gbase, voff) PG8_STAGEQ(bufoff, gbase, voff, qstep)
#define PG8_STAGEB(bufoff, gbase, voff) PG8_STAGEQ(bufoff, gbase, voff, qstepB)
#define PG8_STAGEQ(bufoff, gbase, voff, qs) do { const char* _g0 = (const char*)(gbase); const char* _g1 = _g0 + (qs); asm volatile("" : "+s"(_g0), "+s"(_g1));   \
        __builtin_amdgcn_global_load_lds((const unsigned*)(_g0 + (voff)), (PG8_LAS unsigned*)(lds + (bufoff) + ldsw), 16, 0, 0); \
        __builtin_amdgcn_global_load_lds((const unsigned*)(_g1 + (voff)), (PG8_LAS unsigned*)(lds + (bufoff) + ldsw + 8192), 16, 0, 0); } while (0)
#define PG8_LDA(dst, b, h) do { _Pragma("unroll") for (int m = 0; m < 4; ++m) _Pragma("unroll") for (int k = 0; k < 2; ++k) dst[m][k] = *(const PG8_LAS bf16x8*)(lds + PG8_SA(b, h) + aoff + m * 2048 + k * 1024); } while (0)
#define PG8_LDB(dst, b, h) do { _Pragma("unroll") for (int n = 0; n < 2; ++n) _Pragma("unroll") for (int k = 0; k < 2; ++k) dst[n][k] = *(const PG8_LAS bf16x8*)(lds + PG8_SB(b, h) + boff + n * 2048 + k * 1024); } while (0)
#define PG8_MMA(ai, bj, At, Bt) do { __builtin_amdgcn_s_setprio(1); _Pragma("unroll") for (int m = 0; m < 4; ++m) _Pragma("unroll") for (int n = 0; n < 2; ++n) { \
        if constexpr (F8) acc[ai][bj][m][n] = __builtin_amdgcn_mfma_scale_f32_16x16x128_f8f6f4(pg8_cat16(Bt[n][0], Bt[n][1]), pg8_cat16(At[m][0], At[m][1]), acc[ai][bj][m][n], 0, 0, 0, 0, 0, 0); \
        else { _Pragma("unroll") for (int k = 0; k < 2; ++k) acc[ai][bj][m][n] = __builtin_amdgcn_mfma_f32_16x16x32_bf16(Bt[n][k], At[m][k], acc[ai][bj][m][n], 0, 0, 0); } } \
        __builtin_amdgcn_s_setprio(0); } while (0)
#define PG8_WAIT_V(n) asm volatile("s_waitcnt vmcnt(" #n ")" ::: "memory")
#define PG8_WAIT_L(n) asm volatile("s_waitcnt lgkmcnt(" #n ")" ::: "memory")
#define PG8_BAR __builtin_amdgcn_s_barrier()
#define PG8_SCHED __builtin_amdgcn_sched_barrier(0)
    Unit cur, nxt; int ui = 0;
    if (!S.next(0, cur)) return;
    f32x4 acc[2][2][4][2];
    bf16x8 At[4][2], B0[2][2], B1[2][2];
    const char* cA = (const char*)g.A + (size_t)cur.pm * tstep; const char* cB = (const char*)g.Bt + (size_t)cur.pn * tstep;
    S.a_ready(cur);
    PG8_STAGEB(PG8_SB(0, 0), cB, voffB); PG8_STAGE(PG8_SA(0, 0), cA, voffA); PG8_STAGEB(PG8_SB(0, 1), cB + hstepB, voffB); PG8_STAGE(PG8_SA(0, 1), cA + hstep, voffA);
    if (wr == 1) PG8_BAR;
    PG8_WAIT_V(4); PG8_BAR;
    PG8_STAGEB(PG8_SB(1, 0), cB + kstep, voffB); PG8_STAGE(PG8_SA(1, 0), cA + kstep, voffA); PG8_STAGEB(PG8_SB(1, 1), cB + hstepB + kstep, voffB);
    PG8_WAIT_V(6); PG8_BAR;
    PG8_STAMP();
#pragma unroll
    for (int a = 0; a < 2; ++a)
#pragma unroll
        for (int b = 0; b < 2; ++b)
#pragma unroll
            for (int m = 0; m < 4; ++m)
#pragma unroll
                for (int n = 0; n < 2; ++n) acc[a][b][m][n] = (f32x4){0.f, 0.f, 0.f, 0.f};
    for (;;) {
        const bool has_next = S.next(ui + 1, nxt);
        const char* nA = has_next ? (const char*)g.A + (size_t)nxt.pm * tstep : cA; const char* nB = has_next ? (const char*)g.Bt + (size_t)nxt.pn * tstep : cB;
        for (int t = 0; t < nt; t += 2) {
            const bool last = (t == nt - 2);
            const char* a1 = cA + (size_t)(t + 1) * kstep;
            const char* a2 = last ? nA : cA + (size_t)(t + 2) * kstep; const char* b2 = last ? nB : cB + (size_t)(t + 2) * kstep;
            const char* a3 = a2 + kstep; const char* b3 = b2 + kstep;
            if (last && has_next) S.a_ready(nxt);
            PG8_LDB(B0, 0, 0); PG8_SCHED; PG8_LDA(At, 0, 0); PG8_STAGE(PG8_SA(1, 1), a1 + hstep, voffA);
            PG8_WAIT_L(8); PG8_BAR; PG8_WAIT_L(0); PG8_MMA(0, 0, At, B0); PG8_BAR; PG8_SCHED;
            PG8_LDB(B1, 0, 1); PG8_STAGEB(PG8_SB(0, 0), b2, voffB);
            PG8_BAR; PG8_WAIT_L(0); PG8_MMA(0, 1, At, B1); PG8_BAR;
            PG8_LDA(At, 0, 1); PG8_STAGE(PG8_SA(0, 0), a2, voffA);
            PG8_BAR; PG8_WAIT_L(0); PG8_MMA(1, 0, At, B0); PG8_BAR; PG8_SCHED;
            PG8_STAGEB(PG8_SB(0, 1), b2 + hstepB, voffB);
            PG8_WAIT_V(6); PG8_BAR; PG8_MMA(1, 1, At, B1); PG8_BAR;
            PG8_LDB(B0, 1, 0); PG8_SCHED; PG8_LDA(At, 1, 0); PG8_STAGE(PG8_SA(0, 1), a2 + hstep, voffA);
            PG8_WAIT_L(8); PG8_BAR; PG8_WAIT_L(0); PG8_MMA(0, 0, At, B0); PG8_BAR; PG8_SCHED;
            PG8_LDB(B1, 1, 1); PG8_STAGEB(PG8_SB(1, 0), b3, voffB);
            PG8_BAR; PG8_WAIT_L(0); PG8_MMA(0, 1, At, B1); PG8_BAR;
            PG8_LDA(At, 1, 1); PG8_STAGE(PG8_SA(1, 0), a3, voffA);
            PG8_BAR; PG8_WAIT_L(0); PG8_MMA(1, 0, At, B0); PG8_BAR; PG8_SCHED;
            PG8_STAGEB(PG8_SB(1, 1), b3 + hstepB, voffB);
            PG8_WAIT_V(6); PG8_BAR; PG8_MMA(1, 1, At, B1); PG8_BAR;
        }
        PG8_STAMP();
        if constexpr (!Epi::AFTER_DRAIN) { E(acc, cur, wr, wc, fr, fq); S.done(cur); }
        PG8_STAMP();
        if (!has_next) break;
#pragma unroll
        for (int a = 0; a < 2; ++a)
#pragma unroll
            for (int b = 0; b < 2; ++b)
#pragma unroll
                for (int m = 0; m < 4; ++m)
#pragma unroll
                    for (int n = 0; n < 2; ++n) acc[a][b][m][n] = (f32x4){0.f, 0.f, 0.f, 0.f};
        cur = nxt; cA = nA; cB = nB; ++ui;
    }
    PG8_WAIT_V(0);
    if (wr == 0) PG8_BAR;
    PG8_BAR;
    if constexpr (Epi::AFTER_DRAIN) { E.fused(acc, cur, wr, wc, fr, fq, lds, wid, lane); S.done(cur); }
    PG8_STAMP();
    if (STAMP && wid == 0) { stamps[lane] = lane < nts ? (((unsigned long long)(unsigned)ts_hi << 32) | (unsigned)ts_lo) : 0ull;
        if (lane == 62) stamps[62] = rt_entry; if (lane == 63) stamps[63] = (unsigned long long)wall_clock64(); }
#undef PG8_STAMP
#undef PG8_SA
#undef PG8_SB
#undef PG8_STAGE
#undef PG8_STAGEB
#undef PG8_STAGEQ
#undef PG8_LDA
#undef PG8_LDB
#undef PG8_MMA
#undef PG8_WAIT_V
#undef PG8_WAIT_L
#undef PG8_BAR
#undef PG8_SCHED
}
}
#define XB_TMO      128
#define XB_XCNT(j)  (256  + 64 * (j))
#define XB_XSUB(j)  (1280 + 64 * (j))
#define XB_XGEN(j)  (2304 + 64 * (j))
#define XB_TOP      3328
#define XB_TOPGEN   3392
#define XCD_BAR_WORDS 3456
#define XB_SPIN_CAP (1u << 18)
#define LAS __attribute__((address_space(3)))

__device__ __forceinline__ unsigned xb_ld(unsigned* p)              { return __hip_atomic_load(p, __ATOMIC_RELAXED, __HIP_MEMORY_SCOPE_AGENT); }
__device__ __forceinline__ unsigned xb_add(unsigned* p, unsigned v) { return __hip_atomic_fetch_add(p, v, __ATOMIC_RELAXED, __HIP_MEMORY_SCOPE_AGENT); }
__device__ __forceinline__ unsigned xb_xcc_id() { return (unsigned)__builtin_amdgcn_s_getreg((3 << 11) | 20) & 0xFu; }
#define XB_SPIN(cond, bar) do { unsigned _sp = 0; while (cond) { __builtin_amdgcn_s_sleep(1); \
    if ((++_sp & 255u) == 0u) { if (xb_ld(&(bar)[XB_TMO])) break; if (_sp > XB_SPIN_CAP) { atomicAdd(&(bar)[XB_TMO], 1u); break; } } } } while (0)

struct XcdBarrier {
    unsigned* bar; unsigned x;
    volatile LAS unsigned* st;
};

__device__ __forceinline__ XcdBarrier xcd_barrier_post(unsigned* bar, volatile LAS unsigned* st) {
    XcdBarrier b; b.bar = bar; b.x = xb_xcc_id(); b.st = st;
    if (threadIdx.x == 0) (void)xb_add(&bar[XB_XCNT(b.x)], 1u);
    return b;
}
__device__ __forceinline__ void xcd_barrier_complete(unsigned* bar, unsigned x, unsigned& nloc, unsigned& nx) {
    const unsigned G = gridDim.x * gridDim.y * gridDim.z;
    unsigned sum, cnt, mine, sp = 0u;
    for (;;) {
        sum = 0u; cnt = 0u; mine = 0u;
#pragma unroll
        for (unsigned j = 0; j < 16; ++j) { const unsigned c = xb_ld(&bar[XB_XCNT(j)]); sum += c; cnt += (c > 0u) ? 1u : 0u; mine = (j == x) ? c : mine; }
        if (sum == G) break;
        __builtin_amdgcn_s_sleep(1);
        if ((++sp & 255u) == 0u) { if (xb_ld(&bar[XB_TMO])) break; if (sp > XB_SPIN_CAP) { atomicAdd(&bar[XB_TMO], 1u); break; } }
    }
    nloc = mine > 0u ? mine : 1u; nx = cnt > 0u ? cnt : 1u;
}

__device__ __forceinline__ void xcd_barrier(const XcdBarrier& b) {
    asm volatile("s_waitcnt vmcnt(0)" ::: "memory");
    __syncthreads();
    if (threadIdx.x == 0) {
        unsigned* bar = b.bar;
        __builtin_amdgcn_s_waitcnt(0);
        unsigned nloc = b.st[0], nx = b.st[1];
        if (nloc == 0u) { xcd_barrier_complete(bar, b.x, nloc, nx); b.st[0] = nloc; b.st[1] = nx; }
        const unsigned old = xb_add(&bar[XB_XSUB(b.x)], 1u);
        const unsigned gen = old / nloc;
        if (old + 1u == (gen + 1u) * nloc) {
            __builtin_amdgcn_fence(__ATOMIC_RELEASE, "agent");
            asm volatile("s_waitcnt vmcnt(0)" ::: "memory");
            const unsigned og = xb_add(&bar[XB_TOP], 1u);
            const unsigned tg = og / nx;
            if (og + 1u == (tg + 1u) * nx) xb_add(&bar[XB_TOPGEN], 1u);
            else XB_SPIN(xb_ld(&bar[XB_TOPGEN]) == tg, bar);
            __builtin_amdgcn_fence(__ATOMIC_ACQUIRE, "agent");
            xb_add(&bar[XB_XGEN(b.x)], 1u);
            asm volatile("s_waitcnt vmcnt(0)" ::: "memory");
        } else {
            XB_SPIN(xb_ld(&bar[XB_XGEN(b.x)]) == gen, bar);
            __builtin_amdgcn_fence(__ATOMIC_ACQUIRE, "agent");
            asm volatile("s_waitcnt vmcnt(0)" ::: "memory");
        }
    }
    __syncthreads();
}

namespace mk {
using pg8::bf16_t; using pg8::bf16x8; using pg8::f32x4; using pg8::u32x4;
typedef short s16x4 __attribute__((ext_vector_type(4)));
typedef unsigned u32x2 __attribute__((ext_vector_type(2)));
typedef __bf16 bf16x2v __attribute__((ext_vector_type(2)));
typedef int i32x4 __attribute__((ext_vector_type(4)));
#define DI __device__ __forceinline__

constexpr int D = 1024, SEQ = 4096, NTOK = 16384, DEPTH = 4, DIN = 13824;
constexpr int OFF_AQ = 0, OFF_AK = 1536, OFF_AV = 3072, OFF_LX = 4608, OFF_LG = 5632, OFF_RQ = 6656, OFF_RK = 7680, OFF_RV = 8704, OFF_RG = 9728, OFF_GA = 10752;
constexpr float ALPHA = 1.681792830507429f;
constexpr float LN_EPS = 1e-5f;
constexpr float X8_SCALE = 32.0f, W8_SCALE = 2048.0f, F8_MAX = 440.0f;
constexpr int NPH = 12;
constexpr int LDS_BYTES = 148 * 1024;
constexpr int LDS_BAR_OFF = LDS_BYTES - 16;

constexpr size_t WS_CTL  = 0;
constexpr size_t WS_COSA = 16384;
constexpr size_t WS_SINA = WS_COSA + (size_t)4096 * 64 * 4;
constexpr size_t WS_COSR = WS_SINA + (size_t)4096 * 64 * 4;
constexpr size_t WS_SINR = WS_COSR + (size_t)4096 * 128 * 4;
constexpr size_t WS_CCH  = WS_SINR + (size_t)4096 * 128 * 4;
constexpr size_t WS_WAT  = WS_CCH + 4096;
constexpr size_t WS_WXT  = WS_WAT + 131072;
constexpr size_t WS_LSTA = WS_WXT + 131072;
constexpr size_t WS_LSTH = WS_LSTA + 524288;
constexpr size_t WS_K1B  = WS_LSTH + 524288;
constexpr size_t WS_K2B  = WS_K1B + 262144;
constexpr size_t WS_XF   = WS_K2B + 262144;
constexpr size_t WS_XB   = WS_XF + (size_t)NTOK * D * 4;
constexpr size_t WS_WINT = WS_XB + (size_t)NTOK * D * 2;
constexpr size_t WS_WSC  = WS_WINT + (size_t)DIN * 1024;
constexpr size_t WS_X8   = WS_WSC + (size_t)DIN * 4 + 256 - ((size_t)DIN * 4) % 256;
constexpr size_t WS_XS   = WS_X8 + (size_t)NTOK * 1024;
constexpr size_t WS_WBAT = WS_XS + (size_t)NTOK * 4;
constexpr size_t WS_WBBT = WS_WBAT + (size_t)1024 * 512 * 2;
constexpr size_t WS_WBCT = WS_WBBT + (size_t)1024 * 1024 * 2;
constexpr size_t WS_WOT  = WS_WBCT + (size_t)1024 * 1024 * 2;
constexpr size_t WS_WQT  = WS_WOT + (size_t)1024 * 1024 * 2;
constexpr size_t WS_UV8  = WS_WQT + (size_t)2048 * 1024 * 2;
constexpr size_t WS_UVS  = WS_UV8 + (size_t)16384 * 2048;
constexpr size_t WS_PROJ = WS_UVS + (size_t)16384 * 8;
constexpr size_t WS_OATT = WS_PROJ + (size_t)NTOK * DIN * 2;
constexpr size_t WS_LSE  = WS_OATT + (size_t)NTOK * 1536 * 2;
constexpr size_t WS_KVB  = WS_LSE + (size_t)NTOK * 12 * 4;
constexpr size_t WS_YA   = WS_KVB + (size_t)16 * 32 * 65536 * 2;
constexpr size_t WS_YB   = WS_YA + (size_t)NTOK * 512 * 2;
constexpr size_t WS_YC   = WS_YB + (size_t)NTOK * 1024 * 2;
constexpr size_t WS_MRGF = WS_YC + (size_t)NTOK * 1024 * 2;
constexpr size_t WS_MRGB = WS_MRGF + (size_t)NTOK * 1024 * 4;
constexpr size_t WS_END  = WS_MRGB + (size_t)NTOK * 1024 * 2;
constexpr size_t WS_Q    = WS_PROJ;
constexpr size_t WS_EID  = WS_PROJ + (size_t)NTOK * 2048 * 2;
constexpr size_t WS_GATE = WS_EID + (size_t)NTOK * 128 * 4;
static_assert(WS_END <= (size_t)1073741824, "workspace too large");
static_assert(WS_PROJ % 256 == 0 && WS_KVB % 256 == 0 && WS_MRGF % 256 == 0, "alignment");

struct Args { const float* in[20]; float* out; unsigned char* ws; double ropeA, ropeR; int ph_lo, ph_hi; };

DI size_t pjo(size_t row, int col) { return ((size_t)(col >> 8) * NTOK + row) * 256 + (size_t)(col & 255); }
DI float bflo(unsigned w) { return __uint_as_float(w << 16); }
DI float bfhi(unsigned w) { return __uint_as_float(w & 0xffff0000u); }
DI float bf2f(bf16_t v) { return __uint_as_float(((unsigned)v) << 16); }
DI unsigned pk2(float lo, float hi) { return pg8::cvt_pk_bf16(lo, hi); }
DI bf16_t f2bf(float f) { return (bf16_t)(pk2(f, 0.f) & 0xffffu); }
DI f32x4 mfma16(bf16x8 a, bf16x8 b, f32x4 c) { return __builtin_amdgcn_mfma_f32_16x16x32_bf16(a, b, c, 0, 0, 0); }
DI s16x4 trrd(LAS unsigned char* p) { return __builtin_amdgcn_ds_read_tr16_b64_v4i16((LAS s16x4*)p); }
DI bf16x8 cat8(s16x4 lo, s16x4 hi) { return __builtin_shufflevector(lo, hi, 0, 1, 2, 3, 4, 5, 6, 7); }
DI float wsum(float v) { v += __shfl_xor(v, 32); v += __shfl_xor(v, 16); v += __shfl_xor(v, 8); v += __shfl_xor(v, 4); v += __shfl_xor(v, 2); v += __shfl_xor(v, 1); return v; }
DI float sigm(float x) { return __builtin_amdgcn_rcpf(1.f + __builtin_amdgcn_exp2f(x * -1.4426950408889634f)); }
DI float gelu_erf(float x) { return 0.5f * x * (1.f + erff(x * 0.70710678118654752f)); }
DI float dot2(unsigned w, unsigned x, float acc) { return __builtin_amdgcn_fdot2_f32_bf16(__builtin_bit_cast(bf16x2v, w), __builtin_bit_cast(bf16x2v, x), acc, false); }
DI float log2gamma(int h) { return log2f(1.0f - exp2f(-5.0f - (float)h)); }

#define MK_DPP_ADD(v, ctrl, rmask) v += __int_as_float(__builtin_amdgcn_update_dpp(0, __float_as_int(v), (ctrl), (rmask), 0xf, false))
DI float wsum_dpp(float v) {
    MK_DPP_ADD(v, 0xB1, 0xf); MK_DPP_ADD(v, 0x4E, 0xf); MK_DPP_ADD(v, 0x141, 0xf); MK_DPP_ADD(v, 0x140, 0xf);
    MK_DPP_ADD(v, 0x142, 0xa); MK_DPP_ADD(v, 0x143, 0xc);
    return __int_as_float(__builtin_amdgcn_readlane(__float_as_int(v), 63));
}
DI float gelu_as(float v) {
    const float av = fabsf(v), t = __builtin_amdgcn_rcpf(av * 0.2316418882f + 1.0f);
    float q = t * 0.5307027145f + (-0.7265760135f); q = q * t + 0.7107068705f; q = q * t + (-0.142248368f); q = q * t + 0.127414796f; q = q * t;
    const float e = __builtin_amdgcn_exp2f(v * v * (-0.72134752044f));
    const float m = v * (q * e);
    return v < 0.f ? m : v - m;
}
DI int wperm(int n) {
    if (n < 3072) { const int j = n & 127, bj = j >> 6, jj = j & 63; return (n & ~127) + 64 * (jj >> 5) + 32 * bj + (jj & 31); }
    if (n >= OFF_RQ && n < OFF_RV) { const int j = n & 255, bj = j >> 7, jj = j & 127; return (n & ~255) + 64 * (jj >> 5) + 32 * bj + (jj & 31); }
    return n;
}
template <bool WPERM>
DI void tconv_tile(const float* src, int ldsrc, bf16_t* dst, int lddst, int k0, int n0, LAS float* t, float mul = 1.0f) {
    const int tid = mk_tid();
#pragma unroll
    for (int i = 0; i < 8; ++i) { const int idx = tid + 512 * i, r = idx >> 6, c = idx & 63; t[r * 65 + c] = src[(size_t)(k0 + r) * ldsrc + n0 + c]; }
    __syncthreads();
#pragma unroll
    for (int i = 0; i < 8; ++i) { const int idx = tid + 512 * i, n = idx >> 6, k = idx & 63; const int nr = WPERM ? wperm(n0 + n) : (n0 + n); dst[(size_t)nr * lddst + k0 + k] = f2bf(t[k * 65 + n] * mul); }
    __syncthreads();
}
DI void conv_unit(const float* src, bf16_t* dst, int unit) {
    const size_t i = (size_t)unit * 4096 + (size_t)mk_tid() * 8;
    const f32x4 a = *(const f32x4*)(src + i), b = *(const f32x4*)(src + i + 4);
    u32x4 o; o.x = pk2(a[0], a[1]); o.y = pk2(a[2], a[3]); o.z = pk2(b[0], b[1]); o.w = pk2(b[2], b[3]);
    *(u32x4*)(dst + i) = o;
}
DI void w8_unit(const float* src, unsigned char* ws, int unit, LAS float* t) {
    const int tid = mk_tid(), n0 = unit * 64;
    unsigned char* dst = ws + WS_WINT;
#pragma unroll 1
    for (int k0 = 0; k0 < 1024; k0 += 64) {
#pragma unroll
        for (int i = 0; i < 8; ++i) { const int idx = tid + 512 * i, r = idx >> 6, cc = idx & 63; t[r * 65 + cc] = fminf(fmaxf(src[(size_t)(k0 + r) * DIN + n0 + cc] * W8_SCALE, -F8_MAX), F8_MAX); }
        __syncthreads();
#pragma unroll
        for (int i = 0; i < 2; ++i) { const int idx = tid + 512 * i, n = idx >> 4, k4 = idx & 15;
            int wd = __builtin_amdgcn_cvt_pk_fp8_f32(t[(4 * k4) * 65 + n], t[(4 * k4 + 1) * 65 + n], 0, false);
            wd = __builtin_amdgcn_cvt_pk_fp8_f32(t[(4 * k4 + 2) * 65 + n], t[(4 * k4 + 3) * 65 + n], wd, true);
            *(int*)(dst + (size_t)wperm(n0 + n) * 1024 + k0 + 4 * k4) = wd; }
        __syncthreads();
    }
}
DI void row_to_fp8(const f32x4 (&o)[4], unsigned char* x8row, int ln) {
    u32x4 w;
#pragma unroll
    for (int q = 0; q < 4; ++q) {
        const float a0 = fminf(fmaxf(o[q][0] * X8_SCALE, -F8_MAX), F8_MAX), a1 = fminf(fmaxf(o[q][1] * X8_SCALE, -F8_MAX), F8_MAX), a2 = fminf(fmaxf(o[q][2] * X8_SCALE, -F8_MAX), F8_MAX), a3 = fminf(fmaxf(o[q][3] * X8_SCALE, -F8_MAX), F8_MAX);
        int wd = __builtin_amdgcn_cvt_pk_fp8_f32(a0, a1, 0, false); wd = __builtin_amdgcn_cvt_pk_fp8_f32(a2, a3, wd, true); w[q] = (unsigned)wd; }
    *(u32x4*)(x8row + 16 * ln) = w;
}
typedef float f32x16 __attribute__((ext_vector_type(16)));
typedef float f32x32 __attribute__((ext_vector_type(32)));
typedef unsigned u32x6 __attribute__((ext_vector_type(6)));
typedef _Float16 f16x32 __attribute__((ext_vector_type(32)));
DI float wmax(float m) { m = fmaxf(m, __shfl_xor(m, 32)); m = fmaxf(m, __shfl_xor(m, 16)); m = fmaxf(m, __shfl_xor(m, 8)); m = fmaxf(m, __shfl_xor(m, 4)); m = fmaxf(m, __shfl_xor(m, 2)); m = fmaxf(m, __shfl_xor(m, 1)); return m; }
DI void conv_fp6_rows(const float* usrc, const float* vsrc, unsigned char* ws, int unit) {
    const int tid = mk_tid(), lane = tid & 63, w = tid >> 6;
    const size_t row = (size_t)unit * 8 + w;
    const float* up = usrc + row * 1024 + 16 * lane; const float* vp = vsrc + row * 1024 + 16 * lane;
    f32x16 a, b; float mu = 0.f, mv = 0.f;
#pragma unroll
    for (int q = 0; q < 4; ++q) { const f32x4 x = *(const f32x4*)(up + 4 * q), y = *(const f32x4*)(vp + 4 * q);
#pragma unroll
        for (int j = 0; j < 4; ++j) { a[4 * q + j] = x[j]; b[4 * q + j] = y[j]; mu = fmaxf(mu, fabsf(x[j])); mv = fmaxf(mv, fabsf(y[j])); } }
    mu = wmax(mu); mv = wmax(mv);
    const float su = (mu > 0.f) ? 7.0f / mu : 1.0f, sv = (mv > 0.f) ? 7.0f / mv : 1.0f;
    f16x32 h;
#pragma unroll
    for (int i = 0; i < 16; ++i) { h[i] = (_Float16)(a[i] * su); h[16 + i] = (_Float16)(b[i] * sv); }
    const u32x6 p = __builtin_amdgcn_cvt_scalef32_pk32_fp6_f16(h, 1.0f);
    unsigned char* rec = ws + WS_UV8 + row * 1536;
    *(u32x4*)(rec + 16 * lane) = (u32x4){p[0], p[1], p[2], p[3]};
    *(u32x2*)(rec + 1024 + 8 * lane) = (u32x2){p[4], p[5]};
    if (lane == 0) { float* sp = (float*)(ws + WS_UVS) + row * 2; sp[0] = (mu > 0.f) ? mu * (1.0f / 7.0f) : 1.0f; sp[1] = (mv > 0.f) ? mv * (1.0f / 7.0f) : 1.0f; }
}
DI void phase_conv(const Args& a, int layer, LAS unsigned char* lds) {
    unsigned char* ws = a.ws;
    LAS float* t = (LAS float*)lds;
    const int J0 = 216, J1 = J0 + 128, J2 = J1 + 256, J3 = J2 + 256, J4 = J3 + 256, J5 = J4 + 512, J6 = J5 + 32, J7 = J6 + 2048, J8 = J7, J9 = J8 + 64, J10 = J9 + 1;
    const int total = J10;
    for (int u = blockIdx.x; u < total; u += gridDim.x) {
        if (u < J0) { w8_unit(a.in[1] + (size_t)layer * 1024 * DIN, ws, u, t); }
        else if (u < J1) { const int v = u - J0, kt = v / 16, nt = v % 16; tconv_tile<false>(a.in[9] + (size_t)layer * 2560 * 1024, 1024, (bf16_t*)(ws + WS_WBAT), 512, kt * 64, nt * 64, t); }
        else if (u < J2) { const int v = u - J1, kt = v / 16, nt = v % 16; tconv_tile<false>(a.in[9] + (size_t)layer * 2560 * 1024 + (size_t)512 * 1024, 1024, (bf16_t*)(ws + WS_WBBT), 1024, kt * 64, nt * 64, t); }
        else if (u < J3) { const int v = u - J2, kt = v / 16, nt = v % 16; tconv_tile<false>(a.in[9] + (size_t)layer * 2560 * 1024 + (size_t)1536 * 1024, 1024, (bf16_t*)(ws + WS_WBCT), 1024, kt * 64, nt * 64, t); }
        else if (u < J4) { const int v = u - J3, kt = v / 16, nt = v % 16; tconv_tile<false>(a.in[10] + (size_t)layer * 1024 * 1024, 1024, (bf16_t*)(ws + WS_WOT), 1024, kt * 64, nt * 64, t); }
        else if (u < J5) { const int v = u - J4, kt = v / 32, nt = v % 32; tconv_tile<false>(a.in[13] + (size_t)layer * 1024 * 2048, 2048, (bf16_t*)(ws + WS_WQT), 1024, kt * 64, nt * 64, t); }
        else if (u < J6) { const int v = u - J5, blk = v & 15, which = v >> 4;
            tconv_tile<false>(a.in[which ? 6 : 4] + ((size_t)layer * 16 + blk) * 4096, 64, (bf16_t*)(ws + (which ? WS_WXT : WS_WAT)) + blk * 4096, 64, 0, 0, t, -1.4426950408889634f); }
        else if (u < J7) { conv_fp6_rows(a.in[16] + (size_t)layer * 16384 * 1024, a.in[17] + (size_t)layer * 16384 * 1024, ws, u - J6); }
        else if (u < J9) { const int v = u - J8; if (v < 32) conv_unit(a.in[14] + (size_t)layer * 131072, (bf16_t*)(ws + WS_K1B), v); else conv_unit(a.in[15] + (size_t)layer * 131072, (bf16_t*)(ws + WS_K2B), v - 32); }
        else { for (int c = mk_tid(); c < 1024; c += 512) { const float lam = a.in[8][layer * 1024 + c]; const float e = __builtin_amdgcn_exp2f(-lam * 1.4426950408889634f); const float sp = (e < 0.05f) ? e * (1.0f + e * (-0.5f + e * (0.33333333f + e * -0.25f))) : __builtin_amdgcn_logf(1.0f + e) * 0.6931471805599453f; ((float*)(ws + WS_CCH))[c] = -8.0f * sp; } }
    }
}

DI void phase_prologue(const Args& a) {
    unsigned char* ws = a.ws;
    const int tid = mk_tid();
    for (int u = blockIdx.x; u < 2048; u += gridDim.x) {
        { const int ln = tid & 63; const size_t row = (size_t)u * 8 + (tid >> 6);
            const float* xp = a.in[0] + row * 1024 + 16 * ln; float* xo = (float*)(ws + WS_XF) + row * 1024 + 16 * ln;
            f32x4 o[4];
#pragma unroll
            for (int q = 0; q < 4; ++q) { o[q] = *(const f32x4*)(xp + 4 * q); *(f32x4*)(xo + 4 * q) = o[q]; }
            row_to_fp8(o, ws + WS_X8 + row * 1024, ln); }
    }
}

DI void attn_unit(const Args& a, int unit, LAS unsigned char* lds) {
    unsigned char* ws = a.ws;
    const int tid = mk_tid(), lane = tid & 63, w = __builtin_amdgcn_readfirstlane(tid >> 6), g = lane >> 4, l15 = lane & 15, tq4 = l15 >> 2, tp4 = l15 & 3;
    const int b = unit / 384, rem = unit % 384, h = rem >> 5, bi = rem & 31;
    const int grp = h >> 2, d = (grp == 0) ? 1 : ((grp == 1) ? 4 : 16), nb = 32 / d, r = bi / nb, n = bi % nb;
    const bf16_t* proj = (const bf16_t*)(ws + WS_PROJ); const size_t brow = (size_t)b * SEQ;
    LAS unsigned char* Ks = lds; LAS unsigned char* Vs = lds + 256 * 288;
#pragma unroll
    for (int i = 0; i < 8; ++i) {
        const int idx = tid + 512 * i, row = idx >> 4, ch = idx & 15, m = 128 * (n - 1) + row;
        u32x4 kv = {0u, 0u, 0u, 0u}, vv = {0u, 0u, 0u, 0u};
        if (m >= 0) { const size_t gr = brow + (size_t)(m * d + r); kv = *(const u32x4*)(proj + pjo(gr, OFF_AK + h * 128 + ch * 8)); vv = *(const u32x4*)(proj + pjo(gr, OFF_AV + h * 128 + ch * 8)); }
        *(LAS u32x4*)(Ks + row * 288 + ch * 16) = kv; *(LAS u32x4*)(Vs + row * 288 + ch * 16) = vv;
    }
    const int qi = 16 * w + l15;
    const size_t tq = (size_t)(128 * n + qi) * d + r;
    bf16x8 qf[4];
#pragma unroll
    for (int ks = 0; ks < 4; ++ks) qf[ks] = *(const bf16x8*)(proj + pjo(brow + tq, OFF_AQ + h * 128 + 32 * ks + 8 * g));
    __syncthreads();
    const int s0 = w >> 1;
    f32x4 sacc[10];
#pragma unroll
    for (int jj = 0; jj < 10; ++jj) {
        f32x4 acc = {0.f, 0.f, 0.f, 0.f};
#pragma unroll
        for (int ks = 0; ks < 4; ++ks) { const bf16x8 kf = *(const LAS bf16x8*)(Ks + (32 * s0 + 16 * jj + l15) * 288 + (32 * ks + 8 * g) * 2); acc = mfma16(kf, qf[ks], acc); }
        sacc[jj] = acc;
    }
    const float scale = 0.08838834764831845f * 1.4426950408889634f;
    float mx = -1e30f;
#pragma unroll
    for (int jj = 0; jj < 10; ++jj)
#pragma unroll
        for (int rg = 0; rg < 4; ++rg) {
            const int j = 32 * s0 + 16 * jj + 4 * g + rg;
            const bool valid = (j >= qi) && (j <= qi + 128) && (n > 0 || j >= 128);
            const float s = valid ? sacc[jj][rg] * scale : -1e30f;
            sacc[jj][rg] = s; mx = fmaxf(mx, s);
        }
    mx = fmaxf(mx, __shfl_xor(mx, 16)); mx = fmaxf(mx, __shfl_xor(mx, 32));
    float sum = 0.f;
#pragma unroll
    for (int jj = 0; jj < 10; ++jj)
#pragma unroll
        for (int rg = 0; rg < 4; ++rg) { const float p = __builtin_amdgcn_exp2f(sacc[jj][rg] - mx); sacc[jj][rg] = p; sum += p; }
    sum += __shfl_xor(sum, 16); sum += __shfl_xor(sum, 32);
    f32x4 oacc[8];
#pragma unroll
    for (int db = 0; db < 8; ++db) oacc[db] = (f32x4){0.f, 0.f, 0.f, 0.f};
#pragma unroll
    for (int s = 0; s < 5; ++s) {
        u32x4 pw; pw.x = pk2(sacc[2 * s][0], sacc[2 * s][1]); pw.y = pk2(sacc[2 * s][2], sacc[2 * s][3]); pw.z = pk2(sacc[2 * s + 1][0], sacc[2 * s + 1][1]); pw.w = pk2(sacc[2 * s + 1][2], sacc[2 * s + 1][3]);
        const bf16x8 pb = __builtin_bit_cast(bf16x8, pw);
        const int k0 = 32 * (s0 + s) + 4 * g + tq4;
#pragma unroll
        for (int db = 0; db < 8; ++db) {
            const s16x4 lo = trrd(Vs + k0 * 288 + (16 * db + 4 * tp4) * 2), hi = trrd(Vs + (k0 + 16) * 288 + (16 * db + 4 * tp4) * 2);
            oacc[db] = mfma16(cat8(lo, hi), pb, oacc[db]);
        }
    }
    const float inv = 1.0f / sum;
    bf16_t* op = (bf16_t*)(ws + WS_OATT) + ((size_t)b * SEQ + tq) * 1536 + h * 128 + 4 * g;
#pragma unroll
    for (int db = 0; db < 8; ++db) { u32x2 o; o.x = pk2(oacc[db][0] * inv, oacc[db][1] * inv); o.y = pk2(oacc[db][2] * inv, oacc[db][3] * inv); *(u32x2*)(op + 16 * db) = o; }
    if (g == 0) ((float*)(ws + WS_LSE))[((size_t)b * SEQ + tq) * 12 + h] = mx + __builtin_amdgcn_logf(sum);
    __syncthreads();
}

DI void retkv_unit(const Args& a, int unit, LAS unsigned char* lds) {
    unsigned char* ws = a.ws;
    const int tid = mk_tid(), lane = tid & 63, w = __builtin_amdgcn_readfirstlane(tid >> 6), g = lane >> 4, l15 = lane & 15, tq4 = l15 >> 2, tp4 = l15 & 3;
    const int b = unit >> 7, h = (unit >> 5) & 3, c = unit & 31;
    const bf16_t* proj = (const bf16_t*)(ws + WS_PROJ); const size_t brow = (size_t)b * SEQ + c * 128;
    LAS unsigned char* Ks = lds; LAS unsigned char* Vs = lds + 128 * 544;
    const float l2g = log2gamma(h);
#pragma unroll
    for (int i = 0; i < 8; ++i) {
        const int idx = tid + 512 * i, row = idx >> 5, ch = idx & 31;
        const u32x4 kv = *(const u32x4*)(proj + pjo(brow + row, OFF_RK + h * 256 + ch * 8)), vv = *(const u32x4*)(proj + pjo(brow + row, OFF_RV + h * 256 + ch * 8));
        const float z = exp2f((float)(127 - row) * l2g);
        u32x4 kz;
#pragma unroll
        for (int q = 0; q < 4; ++q) kz[q] = pk2(bflo(kv[q]) * z, bfhi(kv[q]) * z);
        *(LAS u32x4*)(Ks + row * 544 + ch * 16) = kz; *(LAS u32x4*)(Vs + row * 544 + ch * 16) = vv;
    }
    __syncthreads();
#pragma unroll 1
    for (int nh = 0; nh < 2; ++nh) {
        f32x4 acc[2][8];
#pragma unroll
        for (int mb = 0; mb < 2; ++mb)
#pragma unroll
            for (int nb = 0; nb < 8; ++nb) acc[mb][nb] = (f32x4){0.f, 0.f, 0.f, 0.f};
#pragma unroll
        for (int ks = 0; ks < 4; ++ks) {
            const int j0 = 32 * ks + 4 * g + tq4;
            bf16x8 af[2];
#pragma unroll
            for (int mb = 0; mb < 2; ++mb) { const int col = 32 * w + 16 * mb + 4 * tp4; af[mb] = cat8(trrd(Vs + j0 * 544 + col * 2), trrd(Vs + (j0 + 16) * 544 + col * 2)); }
#pragma unroll
            for (int nb = 0; nb < 8; ++nb) {
                const int col = 128 * nh + 16 * nb + 4 * tp4;
                const bf16x8 bfr = cat8(trrd(Ks + j0 * 544 + col * 2), trrd(Ks + (j0 + 16) * 544 + col * 2));
#pragma unroll
                for (int mb = 0; mb < 2; ++mb) acc[mb][nb] = mfma16(af[mb], bfr, acc[mb][nb]);
            }
        }
        bf16_t* kvb = (bf16_t*)(ws + WS_KVB) + ((size_t)((b * 4 + h) * 32 + c)) * 65536 + 128 * nh;
#pragma unroll
        for (int mb = 0; mb < 2; ++mb)
#pragma unroll
            for (int nb = 0; nb < 8; ++nb)
#pragma unroll
                for (int rg = 0; rg < 4; ++rg) kvb[(size_t)(32 * w + 16 * mb + 4 * g + rg) * 256 + 16 * nb + l15] = f2bf(acc[mb][nb][rg]);
    }
    __syncthreads();
}

DI void lru_stripe(const Args& a, int layer, int stripe, LAS unsigned char* lds) {
    unsigned char* ws = a.ws;
    const int tid = mk_tid(), lane = tid & 63, w = __builtin_amdgcn_readfirstlane(tid >> 6), g = lane >> 4, l15 = lane & 15;
    const int b = stripe >> 4, blk = stripe & 15;
    LAS bf16_t* lxs = (LAS bf16_t*)lds;
    LAS bf16_t* lgs0 = (LAS bf16_t*)(lds + 16896);
    LAS unsigned char* xcb = lds + 49664;
    LAS float* rgt = (LAS float*)(lds + 68096);
    LAS float* igt = (LAS float*)(lds + 100864);
    LAS float* wst = (LAS float*)(lds + 133632);
    const bf16_t* proj = (const bf16_t*)(ws + WS_PROJ); const size_t brow = (size_t)b * SEQ;
    const int gc = blk * 64 + lane;
    const float* cw = a.in[2] + (size_t)layer * 4096;
    const int cch_ = tid & 63, cgc = blk * 64 + cch_;
    const float cw0 = cw[cgc], cw1 = cw[1024 + cgc], cw2 = cw[2048 + cgc], cw3 = cw[3072 + cgc], cb = a.in[3][layer * 1024 + cgc];
    const float cc = ((const float*)(ws + WS_CCH))[gc] * 1.4426950408889634f;
    float bia[4], bix[4];
    LAS unsigned char* wlds = lds + 137728;
    { const int r = tid >> 3, c8 = tid & 7; *(LAS u32x4*)(wlds + r * 144 + c8 * 16) = *(const u32x4*)((const bf16_t*)(ws + WS_WAT) + blk * 4096 + r * 64 + c8 * 8); }
    bf16x8 wfx[4][2];
#pragma unroll
    for (int nb = 0; nb < 4; ++nb)
#pragma unroll
        for (int ks = 0; ks < 2; ++ks) wfx[nb][ks] = *(const bf16x8*)((const bf16_t*)(ws + WS_WXT) + blk * 4096 + (16 * nb + l15) * 64 + 32 * ks + 8 * g);
#pragma unroll
    for (int nb = 0; nb < 4; ++nb) { bia[nb] = -1.4426950408889634f * a.in[5][layer * 1024 + blk * 64 + 16 * nb + l15]; bix[nb] = -1.4426950408889634f * a.in[7][layer * 1024 + blk * 64 + 16 * nb + l15]; }
    if (tid < 24) *(LAS u32x4*)(lxs + tid * 8) = (u32x4){0u, 0u, 0u, 0u};
    u32x4 plx[2], plg[2];
#pragma unroll
    for (int i = 0; i < 2; ++i) { const int idx = tid + 512 * i, row = idx >> 3, c8 = idx & 7; plx[i] = *(const u32x4*)(proj + pjo(brow + row, OFF_LX + blk * 64 + c8 * 8)); plg[i] = *(const u32x4*)(proj + pjo(brow + row, OFF_LG + blk * 64 + c8 * 8)); }
    float hcarry = 0.0f;
#pragma unroll 1
    for (int c = 0; c < 32; ++c) {
        LAS bf16_t* lgs = lgs0 + (c & 1) * 8192;
#pragma unroll
        for (int i = 0; i < 2; ++i) { const int idx = tid + 512 * i, row = idx >> 3, c8 = idx & 7; *(LAS u32x4*)(lxs + (3 + row) * 64 + c8 * 8) = plx[i]; *(LAS u32x4*)(lgs + row * 64 + c8 * 8) = plg[i]; }
        __syncthreads();
        if (c + 1 < 32) {
#pragma unroll
            for (int i = 0; i < 2; ++i) { const int idx = tid + 512 * i, row = idx >> 3, c8 = idx & 7; const size_t gr = brow + (size_t)((c + 1) * 128 + row); plx[i] = *(const u32x4*)(proj + pjo(gr, OFF_LX + blk * 64 + c8 * 8)); plg[i] = *(const u32x4*)(proj + pjo(gr, OFF_LG + blk * 64 + c8 * 8)); }
        }
        {
            const int t0 = (tid >> 6) * 16;
            float x0 = bf2f(lxs[t0 * 64 + cch_]), x1 = bf2f(lxs[(t0 + 1) * 64 + cch_]), x2 = bf2f(lxs[(t0 + 2) * 64 + cch_]);
#pragma unroll
            for (int i = 0; i < 16; ++i) {
                const float x3 = bf2f(lxs[(t0 + i + 3) * 64 + cch_]);
                const float xc = cb + cw0 * x0 + cw1 * x1 + cw2 * x2 + cw3 * x3;
                *(LAS bf16_t*)(xcb + (t0 + i) * 144 + cch_ * 2) = f2bf(xc);
                x0 = x1; x1 = x2; x2 = x3;
            }
        }
        __syncthreads();
        if (tid < 24) *(LAS u32x4*)(lxs + tid * 8) = *(const LAS u32x4*)(lxs + 128 * 64 + tid * 8);
        {
            const bf16x8 af0 = *(const LAS bf16x8*)(xcb + (16 * w + l15) * 144 + (8 * g) * 2), af1 = *(const LAS bf16x8*)(xcb + (16 * w + l15) * 144 + (32 + 8 * g) * 2);
#pragma unroll
            for (int nb = 0; nb < 4; ++nb) {
                f32x4 ar = {0.f, 0.f, 0.f, 0.f}, ax = {0.f, 0.f, 0.f, 0.f};
                const LAS unsigned char* wr_ = wlds + (16 * nb + l15) * 144 + 16 * g;
                ar = mfma16(af0, *(const LAS bf16x8*)(wr_), ar); ar = mfma16(af1, *(const LAS bf16x8*)(wr_ + 64), ar);
                ax = mfma16(af0, wfx[nb][0], ax); ax = mfma16(af1, wfx[nb][1], ax);
#pragma unroll
                for (int rg = 0; rg < 4; ++rg) { rgt[(16 * w + 4 * g + rg) * 64 + 16 * nb + l15] = __builtin_amdgcn_rcpf(1.0f + __builtin_amdgcn_exp2f(ar[rg] + bia[nb])); igt[(16 * w + 4 * g + rg) * 64 + 16 * nb + l15] = __builtin_amdgcn_rcpf(1.0f + __builtin_amdgcn_exp2f(ax[rg] + bix[nb])); }
            }
        }
        __syncthreads();
        float av[16], bv[16]; float Aw = 1.0f, Hw = 0.0f;
#pragma unroll
        for (int tt = 0; tt < 16; ++tt) {
            const int t = 16 * w + tt;
            const float aa = __builtin_amdgcn_exp2f(cc * rgt[t * 64 + lane]);
            const float bb = __builtin_amdgcn_sqrtf(fmaxf(1.0f - aa * aa, 0.0f)) * igt[t * 64 + lane] * bf2f(*(const LAS bf16_t*)(xcb + t * 144 + lane * 2));
            av[tt] = aa; bv[tt] = bb; Hw = aa * Hw + bb; Aw *= aa;
        }
        wst[w * 64 + lane] = Aw; wst[512 + w * 64 + lane] = Hw;
        __syncthreads();
        float hcur = hcarry, hend = hcarry;
#pragma unroll
        for (int ww = 0; ww < 8; ++ww) { const float A_ = wst[ww * 64 + lane], H_ = wst[512 + ww * 64 + lane]; hend = A_ * hend + H_; if (ww < w) hcur = hend; }
        hcarry = hend;
        bf16_t* yb = (bf16_t*)(ws + WS_YB) + ((size_t)b * SEQ + c * 128 + 16 * w) * 1024 + gc;
#pragma unroll
        for (int tt = 0; tt < 16; tt += 2) {
            const float h0 = av[tt] * hcur + bv[tt]; hcur = av[tt + 1] * h0 + bv[tt + 1];
            yb[(size_t)tt * 1024] = f2bf(h0 * bf2f(lgs[(16 * w + tt) * 64 + lane])); yb[(size_t)(tt + 1) * 1024] = f2bf(hcur * bf2f(lgs[(16 * w + tt + 1) * 64 + lane]));
        }
    }
    __syncthreads();
}

DI void retscan_unit(const Args& a, int unit) {
    unsigned char* ws = a.ws;
    const int e8 = unit * 512 + mk_tid();
    const int bh = e8 >> 13, within = e8 & 8191, h = bh & 3;
    const float g128 = exp2f(128.0f * log2gamma(h));
    bf16_t* base = (bf16_t*)(ws + WS_KVB) + (size_t)bh * 32 * 65536 + (size_t)within * 8;
    float st[8];
#pragma unroll
    for (int q = 0; q < 8; ++q) st[q] = 0.f;
#pragma unroll 1
    for (int c0 = 0; c0 < 32; c0 += 8) {
        u32x4 kv[8];
#pragma unroll
        for (int q = 0; q < 8; ++q) kv[q] = *(const u32x4*)(base + (size_t)(c0 + q) * 65536);
#pragma unroll
        for (int q = 0; q < 8; ++q) {
            u32x4 o;
#pragma unroll
            for (int j = 0; j < 4; ++j) o[j] = pk2(st[2 * j], st[2 * j + 1]);
            *(u32x4*)(base + (size_t)(c0 + q) * 65536) = o;
#pragma unroll
            for (int j = 0; j < 4; ++j) { st[2 * j] = g128 * st[2 * j] + bflo(kv[q][j]); st[2 * j + 1] = g128 * st[2 * j + 1] + bfhi(kv[q][j]); }
        }
    }
}

DI void attmerge_unit(const Args& a, int unit) {
    unsigned char* ws = a.ws;
    const int idx = unit * 512 + mk_tid(), t = idx >> 6, hp = (idx >> 4) & 3, dc = idx & 15;
    const float* lse = (const float*)(ws + WS_LSE) + (size_t)t * 12;
    const float l0 = lse[hp], l1 = lse[4 + hp], l2 = lse[8 + hp];
    const float m = fmaxf(l0, fmaxf(l1, l2));
    float w0 = __builtin_amdgcn_exp2f(l0 - m), w1 = __builtin_amdgcn_exp2f(l1 - m), w2 = __builtin_amdgcn_exp2f(l2 - m);
    const float is = 1.0f / (w0 + w1 + w2); w0 *= is; w1 *= is; w2 *= is;
    const bf16_t* o = (const bf16_t*)(ws + WS_OATT) + (size_t)t * 1536 + hp * 128 + dc * 8;
    const u32x4 a0 = *(const u32x4*)o, a1 = *(const u32x4*)(o + 512), a2 = *(const u32x4*)(o + 1024);
    u32x4 r;
#pragma unroll
    for (int q = 0; q < 4; ++q) r[q] = pk2(w0 * bflo(a0[q]) + w1 * bflo(a1[q]) + w2 * bflo(a2[q]), w0 * bfhi(a0[q]) + w1 * bfhi(a1[q]) + w2 * bfhi(a2[q]));
    *(u32x4*)((bf16_t*)(ws + WS_YA) + (size_t)t * 512 + hp * 128 + dc * 8) = r;
}

DI void retout_unit(const Args& a, int unit, LAS unsigned char* lds) {
    unsigned char* ws = a.ws;
    const int tid = mk_tid(), lane = tid & 63, w = __builtin_amdgcn_readfirstlane(tid >> 6), g = lane >> 4, l15 = lane & 15, tq4 = l15 >> 2, tp4 = l15 & 3;
    const int b = unit >> 7, h = (unit >> 5) & 3, c = unit & 31;
    const bf16_t* proj = (const bf16_t*)(ws + WS_PROJ); const size_t brow = (size_t)b * SEQ + c * 128;
    const bf16_t* rt = (const bf16_t*)(ws + WS_KVB) + ((size_t)((b * 4 + h) * 32 + c)) * 65536;
    LAS unsigned char* RA = lds; LAS unsigned char* RB = lds + 128 * 544;
    const float l2g = log2gamma(h);
    const int qi = 16 * w + l15;
    bf16x8 qf[8];
#pragma unroll
    for (int ks = 0; ks < 8; ++ks) qf[ks] = *(const bf16x8*)(proj + pjo(brow + qi, OFF_RQ + h * 256 + 32 * ks + 8 * g));
#pragma unroll
    for (int i = 0; i < 8; ++i) {
        const int idx = tid + 512 * i, row = idx >> 5, ch = idx & 31;
        *(LAS u32x4*)(RA + row * 544 + ch * 16) = *(const u32x4*)(proj + pjo(brow + row, OFF_RK + h * 256 + ch * 8));
        *(LAS u32x4*)(RB + row * 544 + ch * 16) = *(const u32x4*)(rt + (size_t)row * 256 + ch * 8);
    }
    __syncthreads();
    u32x4 pv[8], pr[8];
#pragma unroll
    for (int i = 0; i < 8; ++i) {
        const int idx = tid + 512 * i, row = idx >> 5, ch = idx & 31;
        pv[i] = *(const u32x4*)(proj + pjo(brow + row, OFF_RV + h * 256 + ch * 8));
        pr[i] = *(const u32x4*)(rt + (size_t)(128 + row) * 256 + ch * 8);
    }
    f32x4 sacc[8], oacc[16];
#pragma unroll
    for (int jj = 0; jj < 8; ++jj) {
        f32x4 acc = {0.f, 0.f, 0.f, 0.f};
        if (jj <= w) {
#pragma unroll
            for (int ks = 0; ks < 8; ++ks) { const bf16x8 kf = *(const LAS bf16x8*)(RA + (16 * jj + l15) * 544 + (32 * ks + 8 * g) * 2); acc = mfma16(kf, qf[ks], acc); }
        }
        sacc[jj] = acc;
    }
#pragma unroll
    for (int db = 0; db < 8; ++db) {
        f32x4 acc = {0.f, 0.f, 0.f, 0.f};
#pragma unroll
        for (int ks = 0; ks < 8; ++ks) { const bf16x8 rf = *(const LAS bf16x8*)(RB + (16 * db + l15) * 544 + (32 * ks + 8 * g) * 2); acc = mfma16(rf, qf[ks], acc); }
        oacc[db] = acc;
    }
    __syncthreads();
#pragma unroll
    for (int i = 0; i < 8; ++i) {
        const int idx = tid + 512 * i, row = idx >> 5, ch = idx & 31;
        *(LAS u32x4*)(RA + row * 544 + ch * 16) = pv[i];
        *(LAS u32x4*)(RB + row * 544 + ch * 16) = pr[i];
    }
    __syncthreads();
#pragma unroll
    for (int db = 0; db < 8; ++db) {
        f32x4 acc = {0.f, 0.f, 0.f, 0.f};
#pragma unroll
        for (int ks = 0; ks < 8; ++ks) { const bf16x8 rf = *(const LAS bf16x8*)(RB + (16 * db + l15) * 544 + (32 * ks + 8 * g) * 2); acc = mfma16(rf, qf[ks], acc); }
        oacc[8 + db] = acc;
    }
    const float xi = __builtin_amdgcn_exp2f((float)(qi + 1) * l2g);
#pragma unroll
    for (int db = 0; db < 16; ++db) oacc[db] = oacc[db] * xi;
#pragma unroll
    for (int jj = 0; jj < 8; ++jj)
#pragma unroll
        for (int rg = 0; rg < 4; ++rg) { const int j = 16 * jj + 4 * g + rg; sacc[jj][rg] = (qi >= j) ? sacc[jj][rg] * __builtin_amdgcn_exp2f((float)(qi - j) * l2g) : 0.f; }
#pragma unroll
    for (int s = 0; s < 4; ++s) {
        if (2 * s <= w) {
            u32x4 pw; pw.x = pk2(sacc[2 * s][0], sacc[2 * s][1]); pw.y = pk2(sacc[2 * s][2], sacc[2 * s][3]); pw.z = pk2(sacc[2 * s + 1][0], sacc[2 * s + 1][1]); pw.w = pk2(sacc[2 * s + 1][2], sacc[2 * s + 1][3]);
            const bf16x8 pb = __builtin_bit_cast(bf16x8, pw);
            const int k0 = 32 * s + 4 * g + tq4;
#pragma unroll
            for (int db = 0; db < 16; ++db) {
                const s16x4 lo = trrd(RA + k0 * 544 + (16 * db + 4 * tp4) * 2), hi = trrd(RA + (k0 + 16) * 544 + (16 * db + 4 * tp4) * 2);
                oacc[db] = mfma16(cat8(lo, hi), pb, oacc[db]);
            }
        }
    }
    float s1 = 0.f;
#pragma unroll
    for (int db = 0; db < 16; ++db) s1 += (oacc[db][0] + oacc[db][1]) + (oacc[db][2] + oacc[db][3]);
    s1 += __shfl_xor(s1, 16); s1 += __shfl_xor(s1, 32);
    const float mean = s1 * (1.0f / 256.0f);
    float s2 = 0.f;
#pragma unroll
    for (int db = 0; db < 16; ++db)
#pragma unroll
        for (int rg = 0; rg < 4; ++rg) { const float dd = oacc[db][rg] - mean; s2 += dd * dd; }
    s2 += __shfl_xor(s2, 16); s2 += __shfl_xor(s2, 32);
    const float rstd = rsqrtf(s2 * (1.0f / 256.0f) + LN_EPS);
    __syncthreads();
#pragma unroll
    for (int db = 0; db < 16; ++db) {
        u32x2 o; o.x = pk2((oacc[db][0] - mean) * rstd, (oacc[db][1] - mean) * rstd); o.y = pk2((oacc[db][2] - mean) * rstd, (oacc[db][3] - mean) * rstd);
        *(LAS u32x2*)(RA + qi * 528 + (16 * db + 4 * g) * 2) = o;
    }
    __syncthreads();
#pragma unroll
    for (int i = 0; i < 8; ++i) {
        const int idx = tid + 512 * i, row = idx >> 5, ch = idx & 31;
        const u32x4 nv = *(const LAS u32x4*)(RA + row * 528 + ch * 16);
        const u32x4 gw = *(const u32x4*)(proj + pjo(brow + row, OFF_RG + h * 256 + ch * 8));
        u32x4 o;
#pragma unroll
        for (int q = 0; q < 4; ++q) { const float g0 = bflo(gw[q]), g1 = bfhi(gw[q]); o[q] = pk2(g0 * sigm(g0) * bflo(nv[q]), g1 * sigm(g1) * bfhi(nv[q])); }
        *(u32x4*)((bf16_t*)(ws + WS_YC) + ((size_t)b * SEQ + c * 128 + row) * 1024 + h * 256 + ch * 8) = o;
    }
    __syncthreads();
}

struct EpiBranch {
    static constexpr bool PERM = false, AFTER_DRAIN = false;
    const bf16_t* gate; int gcol; bf16_t* mf; bf16_t* mb; int mode;
    __device__ __forceinline__ void operator()(const f32x4 (&acc)[2][2][4][2], const pg8::Unit& u, int wr, int wc, int fr, int fq) const {
        const int row0 = u.pm * 256 + wr * 64 + fr, col0 = u.pn * 256 + wc * 32 + 4 * fq;
        bf16_t* dst = (mode == 2) ? mb : mf;
#pragma unroll
        for (int ai = 0; ai < 2; ++ai) {
            u32x2 gw[4][2][2], old[4][2][2];
#pragma unroll
            for (int m = 0; m < 4; ++m) { const size_t row = (size_t)(row0 + ai * 128 + m * 16);
#pragma unroll
                for (int bj = 0; bj < 2; ++bj)
#pragma unroll
                    for (int n = 0; n < 2; ++n) { const int col = col0 + bj * 128 + n * 16;
                        gw[m][bj][n] = *(const u32x2*)(gate + pjo(row, gcol + col));
                        old[m][bj][n] = (mode != 0) ? *(const u32x2*)(mf + row * 1024 + col) : (u32x2){0u, 0u}; } }
#pragma unroll
            for (int m = 0; m < 4; ++m) { const size_t row = (size_t)(row0 + ai * 128 + m * 16);
#pragma unroll
                for (int bj = 0; bj < 2; ++bj)
#pragma unroll
                    for (int n = 0; n < 2; ++n) { const int col = col0 + bj * 128 + n * 16;
                        const u32x2 g2 = gw[m][bj][n], o2 = old[m][bj][n];
                        f32x4 v = acc[ai][bj][m][n];
                        v[0] = v[0] * sigm(bflo(g2.x)) + bflo(o2.x); v[1] = v[1] * sigm(bfhi(g2.x)) + bfhi(o2.x);
                        v[2] = v[2] * sigm(bflo(g2.y)) + bflo(o2.y); v[3] = v[3] * sigm(bfhi(g2.y)) + bfhi(o2.y);
                        u32x2 o; o.x = pk2(v[0], v[1]); o.y = pk2(v[2], v[3]); *(u32x2*)(dst + row * 1024 + col) = o; } }
        }
    }
};
#ifndef MK_EPI_AUX
#define MK_EPI_AUX 0
#endif
struct EpiInProj {
    static constexpr bool PERM = true, AFTER_DRAIN = false;
    bf16_t* O;
    __device__ __forceinline__ void operator()(const f32x4 (&acc)[2][2][4][2], const pg8::Unit& u, int wr_, int wc_, int fr_, int fq_) const {
        (void)wr_; (void)wc_; (void)fr_; (void)fq_;
        const int tid = mk_tid(), wid = tid >> 6, lane = tid & 63, wr = wid >> 2, wc = wid & 3, fr = lane & 15, fq = lane >> 4;
        const __amdgpu_buffer_rsrc_t rsrc = __builtin_amdgcn_make_buffer_rsrc((void*)O, 0, (int)((size_t)NTOK * DIN * 2), 0x00020000);
        const int row0 = u.pm * 256 + wr * 64 + fr;
        const int pn = u.pn;
        const bool ropeA = pn < 12, ropeR = (pn >= 26 && pn < 34);
        const float dsc = 1.0f / (X8_SCALE * W8_SCALE);
        if (!(ropeA || ropeR)) {
            const int col0 = pn * 256 + 64 * wc + 8 * fq;
            const bool isLG = (pn >= 22 && pn < 26);
#pragma unroll
            for (int ai = 0; ai < 2; ++ai) {
#pragma unroll
                for (int m = 0; m < 4; ++m) { const unsigned roff = (unsigned)(pjo((size_t)(row0 + ai * 128 + m * 16), col0) * 2);
#pragma unroll
                    for (int bj = 0; bj < 2; ++bj) { f32x4 v0 = acc[ai][bj][m][0] * dsc, v1 = acc[ai][bj][m][1] * dsc;
                        if (isLG) { const pg8::f32x2 g0 = pg8::gelu_pk((pg8::f32x2){v0[0], v0[1]}), g1 = pg8::gelu_pk((pg8::f32x2){v0[2], v0[3]}), g2 = pg8::gelu_pk((pg8::f32x2){v1[0], v1[1]}), g3 = pg8::gelu_pk((pg8::f32x2){v1[2], v1[3]});
                            v0 = (f32x4){g0.x, g0.y, g1.x, g1.y}; v1 = (f32x4){g2.x, g2.y, g3.x, g3.y}; }
                        u32x4 w; w.x = pk2(v0[0], v0[1]); w.y = pk2(v0[2], v0[3]); w.z = pk2(v1[0], v1[1]); w.w = pk2(v1[2], v1[3]);
                        __builtin_amdgcn_raw_buffer_store_b128(w, rsrc, (int)(roff + bj * 64), 0, MK_EPI_AUX); } }
            }
        } else {
            const int half = ropeA ? 64 : 128;
            const float sc = dsc * ((pn >= 30 && pn < 34) ? 0.0625f : 1.0f);
            const float kf = ropeA ? (-13.287712379549449f / 64.0f) : (-13.287712379549449f / 128.0f);
            const float pos0 = (float)(row0 & (SEQ - 1));
            const int j0 = ropeA ? (32 * (wc & 1) + 8 * fq) : (32 * wc + 8 * fq);
            const int lcol = ropeA ? (128 * (wc >> 1) + j0) : j0;
            float cb[8], sb[8], c16[8], s16[8], cb1[8], sb1[8];
#pragma unroll
            for (int i = 0; i < 8; ++i) {
                const float f = __builtin_amdgcn_exp2f((float)(j0 + i) * kf) * 0.15915494309189535f;
                const float t0 = __builtin_amdgcn_fractf(pos0 * f), t16 = __builtin_amdgcn_fractf(16.0f * f), t128 = __builtin_amdgcn_fractf(128.0f * f);
                cb[i] = __builtin_amdgcn_cosf(t0); sb[i] = __builtin_amdgcn_sinf(t0);
                c16[i] = __builtin_amdgcn_cosf(t16); s16[i] = __builtin_amdgcn_sinf(t16);
                const float c128 = __builtin_amdgcn_cosf(t128), s128 = __builtin_amdgcn_sinf(t128);
                cb1[i] = cb[i] * c128 - sb[i] * s128; sb1[i] = sb[i] * c128 + cb[i] * s128;
            }
#pragma unroll
            for (int ai = 0; ai < 2; ++ai) {
                float cv[8], sv[8];
#pragma unroll
                for (int i = 0; i < 8; ++i) { cv[i] = ai ? cb1[i] : cb[i]; sv[i] = ai ? sb1[i] : sb[i]; }
#pragma unroll
                for (int m = 0; m < 4; ++m) {
                    const int row = row0 + ai * 128 + m * 16;
                    const unsigned roff = (unsigned)(pjo((size_t)row, pn * 256 + lcol) * 2);
                    float o1[8], o2[8];
#pragma unroll
                    for (int i = 0; i < 8; ++i) { const float t1 = acc[ai][0][m][i >> 2][i & 3] * sc, t2 = acc[ai][1][m][i >> 2][i & 3] * sc; o1[i] = t1 * cv[i] - t2 * sv[i]; o2[i] = t1 * sv[i] + t2 * cv[i]; }
                    u32x4 w1, w2;
#pragma unroll
                    for (int q = 0; q < 4; ++q) { w1[q] = pk2(o1[2 * q], o1[2 * q + 1]); w2[q] = pk2(o2[2 * q], o2[2 * q + 1]); }
                    __builtin_amdgcn_raw_buffer_store_b128(w1, rsrc, (int)roff, 0, MK_EPI_AUX);
                    __builtin_amdgcn_raw_buffer_store_b128(w2, rsrc, (int)(roff + half * 2), 0, MK_EPI_AUX);
                    if (m < 3) {
#pragma unroll
                        for (int i = 0; i < 8; ++i) { const float cn = cv[i] * c16[i] - sv[i] * s16[i], sn = sv[i] * c16[i] + cv[i] * s16[i]; cv[i] = cn; sv[i] = sn; } }
                }
            }
        }
    }
};

struct EpiOut {
    static constexpr bool PERM = false, AFTER_DRAIN = false;
    const float* xf; float* z;
    __device__ __forceinline__ void operator()(const f32x4 (&acc)[2][2][4][2], const pg8::Unit& u, int wr, int wc, int fr, int fq) const {
        const int row0 = u.pm * 256 + wr * 64 + fr, col0 = u.pn * 256 + wc * 32 + 4 * fq;
#pragma unroll
        for (int ai = 0; ai < 2; ++ai) {
            f32x4 xv[4][2][2];
#pragma unroll
            for (int m = 0; m < 4; ++m) { const size_t row = (size_t)(row0 + ai * 128 + m * 16);
#pragma unroll
                for (int bj = 0; bj < 2; ++bj)
#pragma unroll
                    for (int n = 0; n < 2; ++n) xv[m][bj][n] = *(const f32x4*)(xf + row * 1024 + col0 + bj * 128 + n * 16); }
#pragma unroll
            for (int m = 0; m < 4; ++m) { const size_t row = (size_t)(row0 + ai * 128 + m * 16);
#pragma unroll
                for (int bj = 0; bj < 2; ++bj)
#pragma unroll
                    for (int n = 0; n < 2; ++n) *(f32x4*)(z + row * 1024 + col0 + bj * 128 + n * 16) = xv[m][bj][n] * ALPHA + acc[ai][bj][m][n]; }
        }
    }
};

DI void ln_row(const float* z, const float* gam, const float* bet, float* of, bf16_t* ob, int lane) {
    f32x4 v[4]; float s = 0.f;
#pragma unroll
    for (int i = 0; i < 4; ++i) { v[i] = *(const f32x4*)(z + 256 * i + 4 * lane); s += (v[i][0] + v[i][1]) + (v[i][2] + v[i][3]); }
    const float mean = wsum(s) * (1.0f / 1024.0f);
    float q = 0.f;
#pragma unroll
    for (int i = 0; i < 4; ++i)
#pragma unroll
        for (int j = 0; j < 4; ++j) { const float d = v[i][j] - mean; q += d * d; }
    const float rstd = rsqrtf(wsum(q) * (1.0f / 1024.0f) + LN_EPS);
#pragma unroll
    for (int i = 0; i < 4; ++i) {
        const f32x4 gg = *(const f32x4*)(gam + 256 * i + 4 * lane), bb = *(const f32x4*)(bet + 256 * i + 4 * lane);
        f32x4 o;
#pragma unroll
        for (int j = 0; j < 4; ++j) o[j] = (v[i][j] - mean) * rstd * gg[j] + bb[j];
        *(f32x4*)(of + 256 * i + 4 * lane) = o;
        u32x2 pb; pb.x = pk2(o[0], o[1]); pb.y = pk2(o[2], o[3]); *(u32x2*)(ob + 256 * i + 4 * lane) = pb;
    }
}
DI void phase_ln1(const Args& a, int layer) {
    unsigned char* ws = a.ws;
    const int lane = mk_tid() & 63, w = mk_tid() >> 6;
    for (int u = blockIdx.x; u < NTOK / 8; u += gridDim.x) {
        const size_t row = (size_t)u * 8 + w;
        ln_row((const float*)(ws + WS_MRGF) + row * 1024, a.in[11] + layer * 1024, a.in[12] + layer * 1024, (float*)(ws + WS_XF) + row * 1024, (bf16_t*)(ws + WS_XB) + row * 1024, lane);
    }
}

DI void ins16(float (&L)[16], float x) {
#pragma unroll
    for (int k = 0; k < 16; ++k) { const float hi = fmaxf(L[k], x); x = fminf(L[k], x); L[k] = hi; }
}
DI void merge16(float (&L)[16], int xr) {
    float t[16];
#pragma unroll
    for (int k = 0; k < 16; ++k) t[k] = __shfl_xor(L[k], xr);
#pragma unroll
    for (int k = 0; k < 8; ++k) { const float x = t[k]; t[k] = t[15 - k]; t[15 - k] = x; }
#pragma unroll
    for (int k = 0; k < 16; ++k) t[k] = fmaxf(L[k], t[k]);
#define MK_CE_STAGE(dd) _Pragma("unroll") for (int k = 0; k < 16; ++k) if ((k & (dd)) == 0) { const float hi = fmaxf(t[k], t[k + (dd)]), lo = fminf(t[k], t[k + (dd)]); t[k] = hi; t[k + (dd)] = lo; }
    MK_CE_STAGE(8) MK_CE_STAGE(4) MK_CE_STAGE(2) MK_CE_STAGE(1)
#undef MK_CE_STAGE
#pragma unroll
    for (int k = 0; k < 16; ++k) L[k] = t[k];
}
#define MK_CE_DESC(v, i, l) { const float hi_ = fmaxf(v[i], v[l]), lo_ = fminf(v[i], v[l]); v[i] = hi_; v[l] = lo_; }
#define MK_CE_ASC(v, i, l)  { const float hi_ = fmaxf(v[i], v[l]), lo_ = fminf(v[i], v[l]); v[i] = lo_; v[l] = hi_; }
#define MK_BITONIC_STAGE(v, kk, jj) _Pragma("unroll") for (int i_ = 0; i_ < 16; ++i_) { if ((i_ & (jj)) == 0) { if ((i_ & (kk)) == 0) MK_CE_DESC(v, i_, i_ + (jj)) else MK_CE_ASC(v, i_, i_ + (jj)) } }
DI void sort16_desc(float (&v)[16]) {
    MK_BITONIC_STAGE(v, 2, 1)
    MK_BITONIC_STAGE(v, 4, 2) MK_BITONIC_STAGE(v, 4, 1)
    MK_BITONIC_STAGE(v, 8, 4) MK_BITONIC_STAGE(v, 8, 2) MK_BITONIC_STAGE(v, 8, 1)
    MK_BITONIC_STAGE(v, 16, 8) MK_BITONIC_STAGE(v, 16, 4) MK_BITONIC_STAGE(v, 16, 2) MK_BITONIC_STAGE(v, 16, 1)
}
DI void top16_of_two(float (&a)[16], const float (&b)[16]) {
#pragma unroll
    for (int k = 0; k < 16; ++k) a[k] = fmaxf(a[k], b[15 - k]);
    MK_BITONIC_STAGE(a, 16, 8) MK_BITONIC_STAGE(a, 16, 4) MK_BITONIC_STAGE(a, 16, 2) MK_BITONIC_STAGE(a, 16, 1)
}
DI void top16_half(const bf16_t* qp, const LAS unsigned char* kt, float (&L)[16], int g, int l15) {
    bf16x8 qf[4];
#pragma unroll
    for (int ks = 0; ks < 4; ++ks) qf[ks] = *(const bf16x8*)(qp + 32 * ks + 8 * g);
    float M[16];
#pragma unroll
    for (int kbk = 0; kbk < 8; ++kbk) {
        f32x4 acc = {0.f, 0.f, 0.f, 0.f};
#pragma unroll
        for (int ks = 0; ks < 4; ++ks) { const bf16x8 kf = *(const LAS bf16x8*)(kt + (16 * kbk + l15) * 256 + (((4 * ks + g) ^ l15) << 4)); acc = mfma16(kf, qf[ks], acc); }
#pragma unroll
        for (int rg = 0; rg < 4; ++rg) { const unsigned key = (unsigned)(16 * kbk + 4 * g + rg); const float x = __uint_as_float((__float_as_uint(acc[rg]) & ~0x7Fu) | key);
            if (kbk < 4) L[4 * kbk + rg] = x; else M[4 * (kbk - 4) + rg] = x; }
    }
    sort16_desc(L); sort16_desc(M); top16_of_two(L, M);
    merge16(L, 16); merge16(L, 32);
}
DI void topk_unit(const Args& a, int unit, LAS unsigned char* lds) {
    unsigned char* ws = a.ws;
    const int tid = mk_tid(), lane = tid & 63, w = __builtin_amdgcn_readfirstlane(tid >> 6), g = lane >> 4, l15 = lane & 15;
    const int tg = w & 3, hs = w >> 2;
    const size_t t = (size_t)unit * 64 + tg * 16 + l15;
    const bf16_t* Q = (const bf16_t*)(ws + WS_Q);
    LAS unsigned char* tiles = lds + 16384;
    float K1[16], K2[16];
#pragma unroll
    for (int k = 0; k < 16; ++k) { K1[k] = 0.f; K2[k] = 0.f; }
#pragma unroll 1
    for (int hh = 0; hh < 4; ++hh) {
#pragma unroll
        for (int i = 0; i < 16; ++i) {
            const int idx = tid + 512 * i, tile = idx >> 11, row = (idx >> 4) & 127, ch = idx & 15;
            const int hd = ((tile >> 1) ? 4 : 0) + hh;
            const bf16_t* src = (const bf16_t*)(ws + ((tile & 1) ? WS_K2B : WS_K1B)) + ((size_t)hd * 128 + row) * 128 + ch * 8;
            *(LAS u32x4*)(tiles + tile * 32768 + row * 256 + ((ch ^ (row & 15)) << 4)) = *(const u32x4*)src;
        }
        __syncthreads();
        const int h = hs * 4 + hh;
        float l1[16], l2[16];
        top16_half(Q + t * 2048 + h * 256, tiles + (hs * 2) * 32768, l1, g, l15);
        top16_half(Q + t * 2048 + h * 256 + 128, tiles + (hs * 2 + 1) * 32768, l2, g, l15);
        const bool mine = (g == hh);
#pragma unroll
        for (int k = 0; k < 16; ++k) { K1[k] = mine ? l1[k] : K1[k]; K2[k] = mine ? l2[k] : K2[k]; }
        __syncthreads();
    }
    const int h = hs * 4 + g;
    float F[16];
#pragma unroll
    for (int k = 0; k < 16; ++k) F[k] = -FLT_MAX;
#pragma unroll
    for (int ia = 0; ia < 16; ++ia)
#pragma unroll
        for (int ib = 0; ib < 16 / (ia + 1); ++ib) {
            const float s = __uint_as_float(__float_as_uint(K1[ia]) & ~0x7Fu) + __uint_as_float(__float_as_uint(K2[ib]) & ~0x7Fu);
            ins16(F, __uint_as_float((__float_as_uint(s) & ~0xFFu) | (unsigned)(ia * 16 + ib)));
        }
    LAS unsigned char* row = lds + tid * 32;
#pragma unroll
    for (int k = 0; k < 16; ++k) { row[k] = (unsigned char)(__float_as_uint(K1[k]) & 0x7Fu); row[16 + k] = (unsigned char)(__float_as_uint(K2[k]) & 0x7Fu); }
    float gt[16]; int ei[16]; float gs = 0.f;
    const float cv0 = __uint_as_float(__float_as_uint(F[0]) & ~0xFFu);
#pragma unroll
    for (int k = 0; k < 16; ++k) {
        const unsigned bits = __float_as_uint(F[k]);
        const float cv = __uint_as_float(bits & ~0xFFu);
        gt[k] = __builtin_amdgcn_exp2f((cv - cv0) * 1.4426950408889634f); gs += gt[k];
        const int ia = (int)((bits >> 4) & 15u), ib = (int)(bits & 15u);
        ei[k] = (int)row[ia] * 128 + (int)row[16 + ib];
    }
    const float ig = 1.0f / gs;
    int* ep = (int*)(ws + WS_EID) + (t * 8 + h) * 16; float* gp = (float*)(ws + WS_GATE) + (t * 8 + h) * 16;
#pragma unroll
    for (int q = 0; q < 4; ++q) {
        *(i32x4*)(ep + 4 * q) = (i32x4){ei[4 * q], ei[4 * q + 1], ei[4 * q + 2], ei[4 * q + 3]};
        *(f32x4*)(gp + 4 * q) = (f32x4){gt[4 * q] * ig, gt[4 * q + 1] * ig, gt[4 * q + 2] * ig, gt[4 * q + 3] * ig};
    }
    __syncthreads();
}

typedef float f32x2 __attribute__((ext_vector_type(2)));
typedef __bf16 bf16x32 __attribute__((ext_vector_type(32)));
typedef unsigned u32x16 __attribute__((ext_vector_type(16)));
#define MK_PB_LOAD(RA_, RB_, ereg, kb) _Pragma("unroll") for (int j = 0; j < 8; ++j) { const int e_ = __builtin_amdgcn_readlane(ereg, (kb) + j); \
        const unsigned char* p_ = UV + (size_t)(unsigned)e_ * 1536u; RA_[j] = ((const u32x4*)p_)[lane]; RB_[j] = ((const u32x2*)(p_ + 1024))[lane]; }
#define MK_PB_COMP(RA_, RB_, usreg, gvreg, kb) { \
        float pp_[8]; \
        _Pragma("unroll") for (int j = 0; j < 8; ++j) { \
            const u32x16 hw_ = __builtin_bit_cast(u32x16, __builtin_amdgcn_cvt_scalef32_pk32_bf16_fp6((u32x6){RA_[j][0], RA_[j][1], RA_[j][2], RA_[j][3], RB_[j][0], RB_[j][1]}, 1.0f)); \
            float s0_ = 0.f, s1_ = 0.f; \
            _Pragma("unroll") for (int q = 0; q < 4; ++q) { s0_ = dot2(hw_[2 * q], xpk[2 * q], s0_); s1_ = dot2(hw_[2 * q + 1], xpk[2 * q + 1], s1_); } \
            pp_[j] = s0_ + s1_; } \
        float q4_[4], r2_[2]; \
        _Pragma("unroll") for (int i = 0; i < 4; ++i) { const float keep_ = hi32 ? pp_[4 + i] : pp_[i], send_ = hi32 ? pp_[i] : pp_[4 + i]; q4_[i] = keep_ + __shfl_xor(send_, 32); } \
        _Pragma("unroll") for (int i = 0; i < 2; ++i) { const float keep_ = hi16 ? q4_[2 + i] : q4_[i], send_ = hi16 ? q4_[i] : q4_[2 + i]; r2_[i] = keep_ + __shfl_xor(send_, 16); } \
        float tot_ = (hi8 ? r2_[1] : r2_[0]) + __shfl_xor(hi8 ? r2_[0] : r2_[1], 8); \
        tot_ += __shfl_xor(tot_, 4); tot_ += __shfl_xor(tot_, 2); tot_ += __shfl_xor(tot_, 1); \
        const float act_ = gelu_as(tot_ * __shfl(usreg, (kb) + jj)) * __shfl(gvreg, (kb) + jj); \
        _Pragma("unroll") for (int j = 0; j < 8; ++j) { \
            const float aj_ = __uint_as_float(__builtin_amdgcn_readlane(__float_as_uint(act_), 32 * (j >> 2) + 16 * ((j >> 1) & 1) + 8 * (j & 1))); const f32x2 a2_ = {aj_, aj_}; \
            const f32x32 f_ = __builtin_amdgcn_cvt_scalef32_pk32_f32_fp6((u32x6){RA_[j][0], RA_[j][1], RA_[j][2], RA_[j][3], RB_[j][0], RB_[j][1]}, 1.0f); \
            _Pragma("unroll") for (int q = 0; q < 8; ++q) y2[q] += a2_ * (f32x2){f_[16 + 2 * q], f_[16 + 2 * q + 1]}; } }
DI void peer_token(const unsigned char* UV, int e0, int e1, float us0, float us1, float gv0, float gv1, const unsigned (&xpk)[8], f32x2 (&y2)[8], int lane) {
    const bool hi32 = (lane & 32) != 0, hi16 = (lane & 16) != 0, hi8 = (lane & 8) != 0;
    const int jj = ((lane >> 5) & 1) * 4 + ((lane >> 4) & 1) * 2 + ((lane >> 3) & 1);
    u32x4 A0[8], A1[8]; u32x2 B0[8], B1[8];
    MK_PB_LOAD(A0, B0, e0, 0)
#pragma unroll 1
    for (int b = 0; b < 8; b += 2) {
        MK_PB_LOAD(A1, B1, e0, 8 * b + 8)
        MK_PB_COMP(A0, B0, us0, gv0, 8 * b)
        if (b + 2 < 8) { MK_PB_LOAD(A0, B0, e0, 8 * b + 16) } else { MK_PB_LOAD(A0, B0, e1, 0) }
        MK_PB_COMP(A1, B1, us0, gv0, 8 * b + 8)
    }
#pragma unroll 1
    for (int b = 0; b < 8; b += 2) {
        MK_PB_LOAD(A1, B1, e1, 8 * b + 8)
        MK_PB_COMP(A0, B0, us1, gv1, 8 * b)
        if (b + 2 < 8) { MK_PB_LOAD(A0, B0, e1, 8 * b + 16) }
        MK_PB_COMP(A1, B1, us1, gv1, 8 * b + 8)
    }
}
DI void peer_unit(const Args& a, int layer, int unit) {
    unsigned char* ws = a.ws;
    const int tid = mk_tid(), lane = tid & 63, w = __builtin_amdgcn_readfirstlane(tid >> 6);
    const unsigned char* UV = ws + WS_UV8; const float* SC = (const float*)(ws + WS_UVS);
#pragma unroll 1
    for (int i = 0; i < 8; ++i) {
        const size_t t = (size_t)unit * 64 + w * 8 + i;
        unsigned xpk[8]; f32x2 y2[8];
        int e0, e1; float us0, us1, gv0, gv1;
        {
            const int ln = mk_tid() & 63;
            const bf16_t* xbp = (const bf16_t*)(ws + WS_XB) + t * 1024 + 16 * ln;
            const u32x4 xa = *(const u32x4*)xbp, xb = *(const u32x4*)(xbp + 8);
#pragma unroll
            for (int q = 0; q < 4; ++q) { xpk[q] = xa[q]; xpk[4 + q] = xb[q]; }
            const int* ep = (const int*)(ws + WS_EID) + t * 128; const float* gp = (const float*)(ws + WS_GATE) + t * 128;
            e0 = ep[ln]; e1 = ep[64 + ln]; const float g0 = gp[ln], g1 = gp[64 + ln];
            const f32x2 s0 = *(const f32x2*)(SC + 2 * e0), s1 = *(const f32x2*)(SC + 2 * e1);
            us0 = s0.x; us1 = s1.x; gv0 = g0 * s0.y; gv1 = g1 * s1.y;
        }
#pragma unroll
        for (int q = 0; q < 8; ++q) y2[q] = (f32x2){0.f, 0.f};
        peer_token(UV, e0, e1, us0, us1, gv0, gv1, xpk, y2, lane);
        {
            const int ln = mk_tid() & 63;
            float* xfp = (float*)(ws + WS_XF) + t * 1024 + 16 * ln;
            const float* gam = a.in[18] + layer * 1024 + 16 * ln; const float* bet = a.in[19] + layer * 1024 + 16 * ln;
            float z[16]; float s = 0.f;
#pragma unroll
            for (int q = 0; q < 4; ++q) { const f32x4 xr = *(const f32x4*)(xfp + 4 * q);
#pragma unroll
                for (int j = 0; j < 4; ++j) { z[4 * q + j] = ALPHA * xr[j] + y2[2 * q + (j >> 1)][j & 1]; s += z[4 * q + j]; } }
            const float mean = wsum(s) * (1.0f / 1024.0f);
            float qq = 0.f;
#pragma unroll
            for (int q = 0; q < 16; ++q) { const float d = z[q] - mean; qq += d * d; }
            const float rstd = rsqrtf(wsum(qq) * (1.0f / 1024.0f) + LN_EPS);
            f32x4 o[4];
#pragma unroll
            for (int q = 0; q < 4; ++q) { const f32x4 gq = *(const f32x4*)(gam + 4 * q), bq = *(const f32x4*)(bet + 4 * q);
#pragma unroll
                for (int j = 0; j < 4; ++j) o[q][j] = (z[4 * q + j] - mean) * rstd * gq[j] + bq[j]; }
#pragma unroll
            for (int q = 0; q < 4; ++q) *(f32x4*)(xfp + 4 * q) = o[q];
            if (layer == DEPTH - 1) { float* op = a.out + t * 1024 + 16 * ln;
#pragma unroll
                for (int q = 0; q < 4; ++q) *(f32x4*)(op + 4 * q) = o[q]; }
            row_to_fp8(o, ws + WS_X8 + t * 1024, ln);
        }
    }
}
}

namespace mk {
constexpr int LDS_ARG_OFF = LDS_BYTES - 16 - 256;
#define MK_NOINL __device__ __forceinline__
DI unsigned long long rfl64(unsigned long long v) { const unsigned lo = __builtin_amdgcn_readfirstlane((unsigned)v), hi = __builtin_amdgcn_readfirstlane((unsigned)(v >> 32)); return ((unsigned long long)hi << 32) | lo; }
DI Args load_args(LAS unsigned char* lds) {
    int aoff = LDS_ARG_OFF; asm volatile("" : "+s"(aoff));
    Args a; const LAS unsigned long long* p = (const LAS unsigned long long*)(lds + aoff);
#pragma unroll
    for (int i = 0; i < 20; ++i) a.in[i] = (const float*)(const __attribute__((address_space(1))) float*)rfl64(p[i]);
    a.out = (float*)(__attribute__((address_space(1))) float*)rfl64(p[20]); a.ws = (unsigned char*)(__attribute__((address_space(1))) unsigned char*)rfl64(p[21]);
    a.ropeA = __longlong_as_double((long long)rfl64(p[22])); a.ropeR = __longlong_as_double((long long)rfl64(p[23])); a.ph_lo = 0; a.ph_hi = 0;
    return a;
}
#define MK_LOADARGS const Args a = load_args(lds); unsigned char* ws = a.ws; const int G = (int)gridDim.x, bid = (int)blockIdx.x; (void)ws; (void)G; (void)bid
MK_NOINL void PG_prologue(LAS unsigned char* lds) { MK_LOADARGS; phase_prologue(a); }
MK_NOINL void P0_conv(LAS unsigned char* lds, int layer) { MK_LOADARGS; phase_conv(a, layer, lds); }
#ifndef MK_STAGGER_TICKS
#define MK_STAGGER_TICKS 140
#endif
MK_NOINL void P1_inproj(LAS unsigned char* lds, int layer) { MK_LOADARGS; (void)layer;
    pg8::Gemm gm; gm.A = (const bf16_t*)(ws + WS_X8); gm.Bt = (const bf16_t*)(ws + WS_WINT); gm.M = NTOK; gm.N = DIN; gm.K = 512;
    pg8::StaticOrder S; S.init(NTOK, DIN, G, bid);
    EpiInProj E; E.O = (bf16_t*)(ws + WS_PROJ);
    pg8::gemm_phase<EpiInProj, pg8::StaticOrder, false, true, true>(lds, gm, S, E, nullptr); }
#ifndef MK_NLRU
#define MK_NLRU 64
#endif
MK_NOINL void P3s_lru(LAS unsigned char* lds, int layer) { MK_LOADARGS; if (bid < MK_NLRU) { for (int s = bid; s < 64; s += MK_NLRU) lru_stripe(a, layer, s, lds); } }
MK_NOINL void P3a_attn(LAS unsigned char* lds, int layer) { MK_LOADARGS; (void)layer; if (bid >= MK_NLRU) { for (int u = bid - MK_NLRU; u < 1536; u += G - MK_NLRU) attn_unit(a, u, lds); } }
MK_NOINL void P3b_retkv(LAS unsigned char* lds, int layer) { MK_LOADARGS; (void)layer; if (bid >= MK_NLRU) { for (int u = bid - MK_NLRU; u < 512; u += G - MK_NLRU) retkv_unit(a, u, lds); } }
MK_NOINL void P4a_scan(LAS unsigned char* lds, int layer) { MK_LOADARGS; (void)layer; for (int u = bid; u < 256; u += G) retscan_unit(a, u); }
MK_NOINL void P4c_merge(LAS unsigned char* lds, int layer) { MK_LOADARGS; (void)layer; for (int u = bid; u < 2048; u += G) attmerge_unit(a, u); }
MK_NOINL void P5_retout(LAS unsigned char* lds, int layer) { MK_LOADARGS; (void)layer; for (int u = bid; u < 512; u += G) retout_unit(a, u, lds); }
MK_NOINL void P6_branch(LAS unsigned char* lds, int layer) { MK_LOADARGS; (void)layer;
#pragma unroll 1
    for (int s = 0; s < 3; ++s) {
        pg8::Gemm gm; gm.A = (const bf16_t*)(ws + (s == 0 ? WS_YA : (s == 1 ? WS_YB : WS_YC))); gm.Bt = (const bf16_t*)(ws + (s == 0 ? WS_WBAT : (s == 1 ? WS_WBBT : WS_WBCT)));
        gm.M = NTOK; gm.N = 1024; gm.K = (s == 0) ? 512 : 1024;
        pg8::StaticOrder S; S.init(NTOK, 1024, G, bid);
        EpiBranch E; E.gate = (const bf16_t*)(ws + WS_PROJ); E.gcol = OFF_GA + 1024 * s; E.mf = (bf16_t*)(ws + WS_MRGF); E.mb = (bf16_t*)(ws + WS_MRGB); E.mode = s;
        pg8::gemm_phase<EpiBranch, pg8::StaticOrder, false>(lds, gm, S, E, nullptr);
    } }
MK_NOINL void P7_outproj(LAS unsigned char* lds, int layer) { MK_LOADARGS; (void)layer;
    pg8::Gemm gm; gm.A = (const bf16_t*)(ws + WS_MRGB); gm.Bt = (const bf16_t*)(ws + WS_WOT); gm.M = NTOK; gm.N = 1024; gm.K = 1024;
    pg8::StaticOrder S; S.init(NTOK, 1024, G, bid);
    EpiOut E; E.xf = (const float*)(ws + WS_XF); E.z = (float*)(ws + WS_MRGF);
    pg8::gemm_phase<EpiOut, pg8::StaticOrder, false>(lds, gm, S, E, nullptr); }
MK_NOINL void P8_ln1(LAS unsigned char* lds, int layer) { MK_LOADARGS; phase_ln1(a, layer); }
MK_NOINL void P9_wq(LAS unsigned char* lds, int layer) { MK_LOADARGS; (void)layer;
    pg8::Gemm gm; gm.A = (const bf16_t*)(ws + WS_XB); gm.Bt = (const bf16_t*)(ws + WS_WQT); gm.M = NTOK; gm.N = 2048; gm.K = 1024;
    pg8::StaticOrder S; S.init(NTOK, 2048, G, bid);
    pg8::EpiBf16<0> E; E.O = (bf16_t*)(ws + WS_Q); E.ldc = 2048; E.bias = nullptr; E.split_cols = 0; E.split_stride = 0;
    pg8::gemm_phase<pg8::EpiBf16<0>, pg8::StaticOrder, false>(lds, gm, S, E, nullptr); }
MK_NOINL void P10_topk(LAS unsigned char* lds, int layer) { MK_LOADARGS; (void)layer; for (int u = bid; u < NTOK / 64; u += G) topk_unit(a, u, lds); }
MK_NOINL void P11_peer(LAS unsigned char* lds, int layer) { MK_LOADARGS; for (int u = bid; u < NTOK / 64; u += G) peer_unit(a, layer, u); }
DI void mk_sync(LAS unsigned char* lds) {
    const Args a = load_args(lds);
    XcdBarrier b; b.bar = (unsigned*)(a.ws + WS_CTL); b.x = xb_xcc_id(); b.st = (volatile LAS unsigned*)(lds + LDS_BAR_OFF);
    xcd_barrier(b);
}
}

#ifndef MK_PHASE_MASK
#define MK_PHASE_MASK 0xFFFu
#endif
#define MK_RUN(k) ((((MK_PHASE_MASK) >> ((k) - pb)) & 1u) && (k) >= ph_lo && (k) < ph_hi)
#define MK_NPHASES (1 + mk::DEPTH * mk::NPH)

#define MK_SYNC(k) do { if ((k) >= ph_lo && (k) + 1 < ph_hi) mk::mk_sync(lds); } while (0)
__global__ __launch_bounds__(512, 2) void mk_fwd(mk::Args a) {
    using namespace mk;
    extern __shared__ __attribute__((aligned(16))) unsigned char smem_raw[];
    LAS unsigned char* lds = (LAS unsigned char*)smem_raw;
    const int ph_lo = a.ph_lo, ph_hi = a.ph_hi;
    {
        const unsigned* src = (const unsigned*)&a;
        if (threadIdx.x < sizeof(Args) / 4) ((LAS unsigned*)(lds + LDS_ARG_OFF))[threadIdx.x] = src[threadIdx.x];
        if (threadIdx.x == 0) { LAS unsigned* st = (LAS unsigned*)(lds + LDS_BAR_OFF); st[0] = 0u; st[1] = 0u; st[2] = 0u; st[3] = 0u; }
    }
    __syncthreads();
    if (ph_hi - ph_lo > 1) (void)xcd_barrier_post((unsigned*)(a.ws + WS_CTL), (volatile LAS unsigned*)(lds + LDS_BAR_OFF));
    if (0 >= ph_lo && 0 < ph_hi) PG_prologue(lds);
    MK_SYNC(0);
#pragma unroll 1
    for (int layer = 0; layer < DEPTH; ++layer) {
        const int pb = 1 + layer * NPH;
        if (MK_RUN(pb + 0)) P0_conv(lds, layer);
        MK_SYNC(pb + 0);
        if (MK_RUN(pb + 1)) P1_inproj(lds, layer);
        MK_SYNC(pb + 1);
        if (MK_RUN(pb + 3)) { P3s_lru(lds, layer); P3a_attn(lds, layer); P3b_retkv(lds, layer); }
        MK_SYNC(pb + 3);
        if (MK_RUN(pb + 4)) { P4a_scan(lds, layer); P4c_merge(lds, layer); }
        MK_SYNC(pb + 4);
        if (MK_RUN(pb + 5)) P5_retout(lds, layer);
        MK_SYNC(pb + 5);
        if (MK_RUN(pb + 6)) P6_branch(lds, layer);
        MK_SYNC(pb + 6);
        if (MK_RUN(pb + 7)) P7_outproj(lds, layer);
        MK_SYNC(pb + 7);
        if (MK_RUN(pb + 8)) P8_ln1(lds, layer);
        MK_SYNC(pb + 8);
        if (MK_RUN(pb + 9)) P9_wq(lds, layer);
        MK_SYNC(pb + 9);
        if (MK_RUN(pb + 10)) P10_topk(lds, layer);
        MK_SYNC(pb + 10);
        if (MK_RUN(pb + 11)) P11_peer(lds, layer);
        MK_SYNC(pb + 11);
    }
}

#ifndef MK_SINGLE
#define MK_SINGLE 1
#endif
extern "C" void kernel_launch(void* const* d_in, const int* in_sizes, int n_in, void* d_out, int out_size, void* d_ws, size_t ws_size, hipStream_t stream) {
    using namespace mk;
    static int grid = 0;
    if (grid == 0) {
        if (n_in != 20 || out_size != NTOK * D || ws_size < WS_END) { fprintf(stderr, "kernel_launch: unexpected shapes (n_in %d, out %d, ws %zu, need %zu)\n", n_in, out_size, ws_size, (size_t)WS_END); grid = -1; return; }
        int dev = 0, cus = 0, per_cu = 0;
        if (hipGetDevice(&dev) != hipSuccess || hipDeviceGetAttribute(&cus, hipDeviceAttributeMultiprocessorCount, dev) != hipSuccess) { grid = -1; return; }
        if (hipFuncSetAttribute((const void*)mk_fwd, hipFuncAttributeMaxDynamicSharedMemorySize, LDS_BYTES) != hipSuccess) { fprintf(stderr, "kernel_launch: hipFuncSetAttribute failed\n"); grid = -1; return; }
        if (hipOccupancyMaxActiveBlocksPerMultiprocessor(&per_cu, (const void*)mk_fwd, 512, LDS_BYTES) != hipSuccess || per_cu < 1) { fprintf(stderr, "kernel_launch: occupancy query says %d blocks per CU\n", per_cu); (void)hipGetLastError(); grid = -1; return; }
        grid = cus;
    }
    if (grid < 0) return;
    (void)in_sizes;
    Args a{};
    for (int i = 0; i < 20; ++i) a.in[i] = (const float*)d_in[i];
    a.out = (float*)d_out; a.ws = (unsigned char*)d_ws;
    a.ropeA = pow(10000.0, -2.0 / 128.0); a.ropeR = pow(10000.0, -2.0 / 256.0);
#if MK_SINGLE
    (void)hipMemsetAsync((unsigned char*)d_ws + WS_CTL, 0, 16384, stream);
    a.ph_lo = 0; a.ph_hi = MK_NPHASES;
    hipLaunchKernelGGL(mk_fwd, dim3(grid), dim3(512), LDS_BYTES, stream, a);
#else
    for (int p = 0; p < MK_NPHASES; ++p) { a.ph_lo = p; a.ph_hi = p + 1; hipLaunchKernelGGL(mk_fwd, dim3(grid), dim3(512), LDS_BYTES, stream, a); }
#endif
}
```

```cpp
#include <hip/hip_runtime.h>
#include <cstdio>
#include <cstdint>
#include <cmath>
#include <cfloat>
__device__ __forceinline__ int mk_tid() { int t = (int)threadIdx.x; asm volatile("" : "+v"(t)); return t; }
namespace pg8 {
#define PG8_LAS __attribute__((address_space(3)))
typedef unsigned short bf16_t;
typedef short bf16x8 __attribute__((ext_vector_type(8)));
typedef float f32x4 __attribute__((ext_vector_type(4)));
typedef unsigned u32x4 __attribute__((ext_vector_type(4)));
constexpr int BM = 256, BK = 64, HALF = 128, HTB = HALF * BK * 2  , STAGE_BYTES = 8 * HTB, NXCD = 8, WGM = 8;

__host__ __device__ __forceinline__ int lds_byte(int r, int c) { const int st = (r >> 4) * 2 + (c >> 5), rr = r & 15, cc = c & 31, ob = rr * 64 + cc * 2; return st * 1024 + (ob ^ (((ob >> 9) & 1) << 5)); }
__host__ __device__ __forceinline__ void stage_rc(int b, int& R, int& C) { const int st = b / 1024, sb = b % 1024, swz = sb ^ (((sb >> 9) & 1) << 5); R = (st >> 1) * 16 + swz / 64; C = (st & 1) * 32 + (swz % 64) / 2; }
__host__ __device__ __forceinline__ int perm32(int rho) { const int n = rho >> 4, i = rho & 15; return 8 * (i >> 2) + 4 * n + (i & 3); }

struct Unit { int pm, pn; };
struct Gemm { const bf16_t* A; const bf16_t* Bt; int M, N, K; };

struct StaticOrder {
    int nM, nN, nwg, G, c;
    __host__ __device__ void init(int M, int N, int G_, int c_) { nM = M / BM; nN = N / BM; nwg = nM * nN; G = G_; c = c_; }
    __host__ __device__ bool next(int i, Unit& u) const {
        const long L = (long)i * G + c; if (L >= nwg) return false;
        int wgid = (int)L; { const int q = nwg / NXCD, r = nwg % NXCD, xcd = wgid % NXCD, off = wgid / NXCD; wgid = (xcd < r ? xcd * (q + 1) : r * (q + 1) + (xcd - r) * q) + off; }
        const int nig = WGM * nN, gid = wgid / nig, fm = gid * WGM, gsz = (nM - fm) < WGM ? (nM - fm) : WGM;
        u.pm = fm + ((wgid % nig) % gsz); u.pn = (wgid % nig) / gsz; return true;
    }
    __device__ __forceinline__ void a_ready(const Unit&) const {}
    __device__ __forceinline__ void done(const Unit&) const {}
};
typedef __bf16 pg8_bf16x2 __attribute__((ext_vector_type(2)));
__device__ __forceinline__ unsigned cvt_pk_bf16(float lo, float hi) { const pg8_bf16x2 v = {(__bf16)lo, (__bf16)hi}; return __builtin_bit_cast(unsigned, v); }
typedef float f32x2 __attribute__((ext_vector_type(2)));
__device__ __forceinline__ f32x2 gelu_pk(f32x2 v) {
    const f32x2 av = __builtin_elementwise_abs(v), d = av * 0.2316418882f + 1.0f;
    f32x2 t; t.x = __builtin_amdgcn_rcpf(d.x); t.y = __builtin_amdgcn_rcpf(d.y);
    f32x2 q = t * 0.5307027145f + (-0.7265760135f); q = q * t + 0.7107068705f; q = q * t + (-0.142248368f); q = q * t + 0.127414796f; q = q * t;
    const f32x2 s = (v * v) * (-0.72134752044f);
    f32x2 e; e.x = __builtin_amdgcn_exp2f(s.x); e.y = __builtin_amdgcn_exp2f(s.y);
    const f32x2 m = v * (q * e), r = v - m;
    f32x2 o; o.x = v.x < 0.f ? m.x : r.x; o.y = v.y < 0.f ? m.y : r.y; return o;
}

struct EpiF32 {
    static constexpr bool PERM = false, AFTER_DRAIN = false;
    float* C; int ldc; const float* bias;
    __device__ __forceinline__ void operator()(const f32x4 (&acc)[2][2][4][2], const Unit& u, int wr, int wc, int fr, int fq) const {
        const int row0 = u.pm * BM + wr * 64 + fr, col0 = u.pn * BM + wc * 32 + 4 * fq;
        f32x4 bv[2][2];
#pragma unroll
        for (int bj = 0; bj < 2; ++bj)
#pragma unroll
            for (int n = 0; n < 2; ++n) bv[bj][n] = bias ? *(const f32x4*)(bias + col0 + bj * HALF + n * 16) : (f32x4){0.f, 0.f, 0.f, 0.f};
#pragma unroll
        for (int ai = 0; ai < 2; ++ai)
#pragma unroll
            for (int m = 0; m < 4; ++m) { float* rowp = C + (size_t)(row0 + ai * HALF + m * 16) * ldc + col0;
#pragma unroll
                for (int bj = 0; bj < 2; ++bj)
#pragma unroll
                    for (int n = 0; n < 2; ++n) *(f32x4*)(rowp + bj * HALF + n * 16) = acc[ai][bj][m][n] + bv[bj][n]; }
    }
};
template <int ACT  > struct EpiBf16 {
    static constexpr bool PERM = true, AFTER_DRAIN = false;
    bf16_t* O; int ldc; const float* bias; int split_cols; size_t split_stride;
    __device__ __forceinline__ void operator()(const f32x4 (&acc)[2][2][4][2], const Unit& u, int wr, int wc, int fr, int fq) const {
        const int row0 = u.pm * BM + wr * 64 + fr; int colt = u.pn * BM; bf16_t* base = O;
        if (split_cols) { const int t = colt / split_cols; base += (size_t)t * split_stride; colt -= t * split_cols; }
        const int col0 = colt + wc * 32 + 8 * fq, bcol0 = u.pn * BM + wc * 32 + 8 * fq;
        f32x4 bv[2][2];
#pragma unroll
        for (int bj = 0; bj < 2; ++bj)
#pragma unroll
            for (int n = 0; n < 2; ++n) bv[bj][n] = bias ? *(const f32x4*)(bias + bcol0 + bj * HALF + 4 * n) : (f32x4){0.f, 0.f, 0.f, 0.f};
#pragma unroll
        for (int ai = 0; ai < 2; ++ai)
#pragma unroll
            for (int m = 0; m < 4; ++m) { bf16_t* rowp = base + (size_t)(row0 + ai * HALF + m * 16) * ldc + col0;
#pragma unroll
                for (int bj = 0; bj < 2; ++bj) { f32x4 v0 = acc[ai][bj][m][0] + bv[bj][0], v1 = acc[ai][bj][m][1] + bv[bj][1];
                    if (ACT == 1) { f32x2 a = gelu_pk((f32x2){v0[0], v0[1]}), b = gelu_pk((f32x2){v0[2], v0[3]}), c = gelu_pk((f32x2){v1[0], v1[1]}), d = gelu_pk((f32x2){v1[2], v1[3]});
                        v0 = (f32x4){a.x, a.y, b.x, b.y}; v1 = (f32x4){c.x, c.y, d.x, d.y}; }
                    if (ACT == 2) {
#pragma unroll
                        for (int j = 0; j < 4; ++j) { v0[j] = 0.5f * v0[j] * (1.0f + erff(v0[j] * 0.70710678f)); v1[j] = 0.5f * v1[j] * (1.0f + erff(v1[j] * 0.70710678f)); } }
                    u32x4 w; w.x = cvt_pk_bf16(v0[0], v0[1]); w.y = cvt_pk_bf16(v0[2], v0[3]); w.z = cvt_pk_bf16(v1[0], v1[1]); w.w = cvt_pk_bf16(v1[2], v1[3]);
                    *(u32x4*)(rowp + bj * HALF) = w; } }
    }
};

typedef int i32x8 __attribute__((ext_vector_type(8)));
typedef short s16x16 __attribute__((ext_vector_type(16)));
__device__ __forceinline__ i32x8 pg8_cat16(bf16x8 a, bf16x8 b) { return __builtin_bit_cast(i32x8, (s16x16)__builtin_shufflevector(a, b, 0, 1, 2, 3, 4, 5, 6, 7, 8, 9, 10, 11, 12, 13, 14, 15)); }
template <class Epi, class Sched, bool STAMP = false, bool F8 = false, bool WIDE = false>
__device__ __forceinline__ void gemm_phase(PG8_LAS unsigned char* lds, const Gemm g, const Sched& S, const Epi& E, unsigned long long* stamps) {
    const int tid = mk_tid(), wid = __builtin_amdgcn_readfirstlane(tid >> 6), lane = tid & 63, wr = wid >> 2, wc = wid & 3, fr = lane & 15, fq = lane >> 4;
    const int K = g.K, nt = K / BK;
    int ts_lo = 0, ts_hi = 0, nts = 0; const unsigned long long rt_entry = STAMP ? (unsigned long long)wall_clock64() : 0ull;
#define PG8_STAMP() do { if (STAMP && wid == 0 && nts < 64) { const unsigned long long _c = (unsigned long long)clock64(); \
        ts_lo = (lane == nts) ? (int)(unsigned)_c : ts_lo; ts_hi = (lane == nts) ? (int)(unsigned)(_c >> 32) : ts_hi; ++nts; } } while (0)
    PG8_STAMP();
    unsigned voffA, voffB;
    { int R, C; stage_rc(tid * 16, R, C); const int Ri = Epi::PERM ? perm32(R & 31) : (R & 31); const int Rb = WIDE ? (((R >> 5) << 6) + Ri) : ((R & ~31) + Ri);
        voffA = (unsigned)(R * K + C) * 2u; voffB = (unsigned)(Rb * K + C) * 2u; }
    const size_t qstep = (size_t)64 * K * 2;
    const size_t qstepB = WIDE ? (size_t)128 * K * 2 : qstep;
    const size_t hstepB = WIDE ? (size_t)32 * K * 2 : (size_t)HALF * K * 2;
    const size_t kstep = (size_t)(BK * 2);
    const size_t hstep = (size_t)HALF * K * 2;
    const size_t tstep = 2 * hstep;
    const unsigned ldsw = (unsigned)wid * 1024u;
    const int aoff = lds_byte(wr * 64 + fr, fq * 8), boff = lds_byte(wc * 32 + fr, fq * 8);
#define PG8_SA(b, h) (((b) * 2 + (h)) * HTB)
#define PG8_SB(b, h) ((4 + (b) * 2 + (h)) * HTB)
#define PG8_STAGE(bufoff, gbase, voff) PG8_STAGEQ(bufoff, gbase, voff, qstep)
#define PG8_STAGEB(bufoff, gbase, voff) PG8_STAGEQ(bufoff, gbase, voff, qstepB)
#define PG8_STAGEQ(bufoff, gbase, voff, qs) do { const char* _g0 = (const char*)(gbase); const char* _g1 = _g0 + (qs); asm volatile("" : "+s"(_g0), "+s"(_g1));   \
        __builtin_amdgcn_global_load_lds((const unsigned*)(_g0 + (voff)), (PG8_LAS unsigned*)(lds + (bufoff) + ldsw), 16, 0, 0); \
        __builtin_amdgcn_global_load_lds((const unsigned*)(_g1 + (voff)), (PG8_LAS unsigned*)(lds + (bufoff) + ldsw + 8192), 16, 0, 0); } while (0)
#define PG8_LDA(dst, b, h) do { _Pragma("unroll") for (int m = 0; m < 4; ++m) _Pragma("unroll") for (int k = 0; k < 2; ++k) dst[m][k] = *(const PG8_LAS bf16x8*)(lds + PG8_SA(b, h) + aoff + m * 2048 + k * 1024); } while (0)
#define PG8_LDB(dst, b, h) do { _Pragma("unroll") for (int n = 0; n < 2; ++n) _Pragma("unroll") for (int k = 0; k < 2; ++k) dst[n][k] = *(const PG8_LAS bf16x8*)(lds + PG8_SB(b, h) + boff + n * 2048 + k * 1024); } while (0)
#define PG8_MMA(ai, bj, At, Bt) do { __builtin_amdgcn_s_setprio(1); _Pragma("unroll") for (int m = 0; m < 4; ++m) _Pragma("unroll") for (int n = 0; n < 2; ++n) { \
        if constexpr (F8) acc[ai][bj][m][n] = __builtin_amdgcn_mfma_scale_f32_16x16x128_f8f6f4(pg8_cat16(Bt[n][0], Bt[n][1]), pg8_cat16(At[m][0], At[m][1]), acc[ai][bj][m][n], 0, 0, 0, 0, 0, 0); \
        else { _Pragma("unroll") for (int k = 0; k < 2; ++k) acc[ai][bj][m][n] = __builtin_amdgcn_mfma_f32_16x16x32_bf16(Bt[n][k], At[m][k], acc[ai][bj][m][n], 0, 0, 0); } } \
        __builtin_amdgcn_s_setprio(0); } while (0)
#define PG8_WAIT_V(n) asm volatile("s_waitcnt vmcnt(" #n ")" ::: "memory")
#define PG8_WAIT_L(n) asm volatile("s_waitcnt lgkmcnt(" #n ")" ::: "memory")
#define PG8_BAR __builtin_amdgcn_s_barrier()
#define PG8_SCHED __builtin_amdgcn_sched_barrier(0)
    Unit cur, nxt; int ui = 0;
    if (!S.next(0, cur)) return;
    f32x4 acc[2][2][4][2];
    bf16x8 At[4][2], B0[2][2], B1[2][2];
    const char* cA = (const char*)g.A + (size_t)cur.pm * tstep; const char* cB = (const char*)g.Bt + (size_t)cur.pn * tstep;
    S.a_ready(cur);
    PG8_STAGEB(PG8_SB(0, 0), cB, voffB); PG8_STAGE(PG8_SA(0, 0), cA, voffA); PG8_STAGEB(PG8_SB(0, 1), cB + hstepB, voffB); PG8_STAGE(PG8_SA(0, 1), cA + hstep, voffA);
    if (wr == 1) PG8_BAR;
    PG8_WAIT_V(4); PG8_BAR;
    PG8_STAGEB(PG8_SB(1, 0), cB + kstep, voffB); PG8_STAGE(PG8_SA(1, 0), cA + kstep, voffA); PG8_STAGEB(PG8_SB(1, 1), cB + hstepB + kstep, voffB);
    PG8_WAIT_V(6); PG8_BAR;
    PG8_STAMP();
#pragma unroll
    for (int a = 0; a < 2; ++a)
#pragma unroll
        for (int b = 0; b < 2; ++b)
#pragma unroll
            for (int m = 0; m < 4; ++m)
#pragma unroll
                for (int n = 0; n < 2; ++n) acc[a][b][m][n] = (f32x4){0.f, 0.f, 0.f, 0.f};
    for (;;) {
        const bool has_next = S.next(ui + 1, nxt);
        const char* nA = has_next ? (const char*)g.A + (size_t)nxt.pm * tstep : cA; const char* nB = has_next ? (const char*)g.Bt + (size_t)nxt.pn * tstep : cB;
        for (int t = 0; t < nt; t += 2) {
            const bool last = (t == nt - 2);
            const char* a1 = cA + (size_t)(t + 1) * kstep;
            const char* a2 = last ? nA : cA + (size_t)(t + 2) * kstep; const char* b2 = last ? nB : cB + (size_t)(t + 2) * kstep;
            const char* a3 = a2 + kstep; const char* b3 = b2 + kstep;
            if (last && has_next) S.a_ready(nxt);
            PG8_LDB(B0, 0, 0); PG8_SCHED; PG8_LDA(At, 0, 0); PG8_STAGE(PG8_SA(1, 1), a1 + hstep, voffA);
            PG8_WAIT_L(8); PG8_BAR; PG8_WAIT_L(0); PG8_MMA(0, 0, At, B0); PG8_BAR; PG8_SCHED;
            PG8_LDB(B1, 0, 1); PG8_STAGEB(PG8_SB(0, 0), b2, voffB);
            PG8_BAR; PG8_WAIT_L(0); PG8_MMA(0, 1, At, B1); PG8_BAR;
            PG8_LDA(At, 0, 1); PG8_STAGE(PG8_SA(0, 0), a2, voffA);
            PG8_BAR; PG8_WAIT_L(0); PG8_MMA(1, 0, At, B0); PG8_BAR; PG8_SCHED;
            PG8_STAGEB(PG8_SB(0, 1), b2 + hstepB, voffB);
            PG8_WAIT_V(6); PG8_BAR; PG8_MMA(1, 1, At, B1); PG8_BAR;
            PG8_LDB(B0, 1, 0); PG8_SCHED; PG8_LDA(At, 1, 0); PG8_STAGE(PG8_SA(0, 1), a2 + hstep, voffA);
            PG8_WAIT_L(8); PG8_BAR; PG8_WAIT_L(0); PG8_MMA(0, 0, At, B0); PG8_BAR; PG8_SCHED;
            PG8_LDB(B1, 1, 1); PG8_STAGEB(PG8_SB(1, 0), b3, voffB);
            PG8_BAR; PG8_WAIT_L(0); PG8_MMA(0, 1, At, B1); PG8_BAR;
            PG8_LDA(At, 1, 1); PG8_STAGE(PG8_SA(1, 0), a3, voffA);
            PG8_BAR; PG8_WAIT_L(0); PG8_MMA(1, 0, At, B0); PG8_BAR; PG8_SCHED;
            PG8_STAGEB(PG8_SB(1, 1), b3 + hstepB, voffB);
            PG8_WAIT_V(6); PG8_BAR; PG8_MMA(1, 1, At, B1); PG8_BAR;
        }
        PG8_STAMP();
        if constexpr (!Epi::AFTER_DRAIN) { E(acc, cur, wr, wc, fr, fq); S.done(cur); }
        PG8_STAMP();
        if (!has_next) break;
#pragma unroll
        for (int a = 0; a < 2; ++a)
#pragma unroll
            for (int b = 0; b < 2; ++b)
#pragma unroll
                for (int m = 0; m < 4; ++m)
#pragma unroll
                    for (int n = 0; n < 2; ++n) acc[a][b][m][n] = (f32x4){0.f, 0.f, 0.f, 0.f};
        cur = nxt; cA = nA; cB = nB; ++ui;
    }
    PG8_WAIT_V(0);
    if (wr == 0) PG8_BAR;
    PG8_BAR;
    if constexpr (Epi::AFTER_DRAIN) { E.fused(acc, cur, wr, wc, fr, fq, lds, wid, lane); S.done(cur); }
    PG8_STAMP();
    if (STAMP && wid == 0) { stamps[lane] = lane < nts ? (((unsigned long long)(unsigned)ts_hi << 32) | (unsigned)ts_lo) : 0ull;
        if (lane == 62) stamps[62] = rt_entry; if (lane == 63) stamps[63] = (unsigned long long)wall_clock64(); }
#undef PG8_STAMP
#undef PG8_SA
#undef PG8_SB
#undef PG8_STAGE
#undef PG8_STAGEB
#undef PG8_STAGEQ
#undef PG8_LDA
#undef PG8_LDB
#undef PG8_MMA
#undef PG8_WAIT_V
#undef PG8_WAIT_L
#undef PG8_BAR
#undef PG8_SCHED
}
}
#define XB_TMO      128
#define XB_XCNT(j)  (256  + 64 * (j))
#define XB_XSUB(j)  (1280 + 64 * (j))
#define XB_XGEN(j)  (2304 + 64 * (j))
#define XB_TOP      3328
#define XB_TOPGEN   3392
#define XCD_BAR_WORDS 3456
#define XB_SPIN_CAP (1u << 18)
#define LAS __attribute__((address_space(3)))

__device__ __forceinline__ unsigned xb_ld(unsigned* p)              { return __hip_atomic_load(p, __ATOMIC_RELAXED, __HIP_MEMORY_SCOPE_AGENT); }
__device__ __forceinline__ unsigned xb_add(unsigned* p, unsigned v) { return __hip_atomic_fetch_add(p, v, __ATOMIC_RELAXED, __HIP_MEMORY_SCOPE_AGENT); }
__device__ __forceinline__ unsigned xb_xcc_id() { return (unsigned)__builtin_amdgcn_s_getreg((3 << 11) | 20) & 0xFu; }
#define XB_SPIN(cond, bar) do { unsigned _sp = 0; while (cond) { __builtin_amdgcn_s_sleep(1); \
    if ((++_sp & 255u) == 0u) { if (xb_ld(&(bar)[XB_TMO])) break; if (_sp > XB_SPIN_CAP) { atomicAdd(&(bar)[XB_TMO], 1u); break; } } } } while (0)

struct XcdBarrier {
    unsigned* bar; unsigned x;
    volatile LAS unsigned* st;
};

__device__ __forceinline__ XcdBarrier xcd_barrier_post(unsigned* bar, volatile LAS unsigned* st) {
    XcdBarrier b; b.bar = bar; b.x = xb_xcc_id(); b.st = st;
    if (threadIdx.x == 0) (void)xb_add(&bar[XB_XCNT(b.x)], 1u);
    return b;
}
__device__ __forceinline__ void xcd_barrier_complete(unsigned* bar, unsigned x, unsigned& nloc, unsigned& nx) {
    const unsigned G = gridDim.x * gridDim.y * gridDim.z;
    unsigned sum, cnt, mine, sp = 0u;
    for (;;) {
        sum = 0u; cnt = 0u; mine = 0u;
#pragma unroll
        for (unsigned j = 0; j < 16; ++j) { const unsigned c = xb_ld(&bar[XB_XCNT(j)]); sum += c; cnt += (c > 0u) ? 1u : 0u; mine = (j == x) ? c : mine; }
        if (sum == G) break;
        __builtin_amdgcn_s_sleep(1);
        if ((++sp & 255u) == 0u) { if (xb_ld(&bar[XB_TMO])) break; if (sp > XB_SPIN_CAP) { atomicAdd(&bar[XB_TMO], 1u); break; } }
    }
    nloc = mine > 0u ? mine : 1u; nx = cnt > 0u ? cnt : 1u;
}

__device__ __forceinline__ void xcd_barrier(const XcdBarrier& b) {
    asm volatile("s_waitcnt vmcnt(0)" ::: "memory");
    __syncthreads();
    if (threadIdx.x == 0) {
        unsigned* bar = b.bar;
        __builtin_amdgcn_s_waitcnt(0);
        unsigned nloc = b.st[0], nx = b.st[1];
        if (nloc == 0u) { xcd_barrier_complete(bar, b.x, nloc, nx); b.st[0] = nloc; b.st[1] = nx; }
        const unsigned old = xb_add(&bar[XB_XSUB(b.x)], 1u);
        const unsigned gen = old / nloc;
        if (old + 1u == (gen + 1u) * nloc) {
            __builtin_amdgcn_fence(__ATOMIC_RELEASE, "agent");
            asm volatile("s_waitcnt vmcnt(0)" ::: "memory");
            const unsigned og = xb_add(&bar[XB_TOP], 1u);
            const unsigned tg = og / nx;
            if (og + 1u == (tg + 1u) * nx) xb_add(&bar[XB_TOPGEN], 1u);
            else XB_SPIN(xb_ld(&bar[XB_TOPGEN]) == tg, bar);
            __builtin_amdgcn_fence(__ATOMIC_ACQUIRE, "agent");
            xb_add(&bar[XB_XGEN(b.x)], 1u);
            asm volatile("s_waitcnt vmcnt(0)" ::: "memory");
        } else {
            XB_SPIN(xb_ld(&bar[XB_XGEN(b.x)]) == gen, bar);
            __builtin_amdgcn_fence(__ATOMIC_ACQUIRE, "agent");
            asm volatile("s_waitcnt vmcnt(0)" ::: "memory");
        }
    }
    __syncthreads();
}

namespace mk {
using pg8::bf16_t; using pg8::bf16x8; using pg8::f32x4; using pg8::u32x4;
typedef short s16x4 __attribute__((ext_vector_type(4)));
typedef unsigned u32x2 __attribute__((ext_vector_type(2)));
typedef __bf16 bf16x2v __attribute__((ext_vector_type(2)));
typedef int i32x4 __attribute__((ext_vector_type(4)));
#define DI __device__ __forceinline__

constexpr int D = 1024, SEQ = 4096, NTOK = 16384, DEPTH = 4, DIN = 13824;
constexpr int OFF_AQ = 0, OFF_AK = 1536, OFF_AV = 3072, OFF_LX = 4608, OFF_LG = 5632, OFF_RQ = 6656, OFF_RK = 7680, OFF_RV = 8704, OFF_RG = 9728, OFF_GA = 10752;
constexpr float ALPHA = 1.681792830507429f;
constexpr float LN_EPS = 1e-5f;
constexpr float X8_SCALE = 32.0f, W8_SCALE = 2048.0f, F8_MAX = 440.0f;
constexpr int NPH = 12;
constexpr int LDS_BYTES = 148 * 1024;
constexpr int LDS_BAR_OFF = LDS_BYTES - 16;

constexpr size_t WS_CTL  = 0;
constexpr size_t WS_COSA = 16384;
constexpr size_t WS_SINA = WS_COSA + (size_t)4096 * 64 * 4;
constexpr size_t WS_COSR = WS_SINA + (size_t)4096 * 64 * 4;
constexpr size_t WS_SINR = WS_COSR + (size_t)4096 * 128 * 4;
constexpr size_t WS_CCH  = WS_SINR + (size_t)4096 * 128 * 4;
constexpr size_t WS_WAT  = WS_CCH + 4096;
constexpr size_t WS_WXT  = WS_WAT + 131072;
constexpr size_t WS_LSTA = WS_WXT + 131072;
constexpr size_t WS_LSTH = WS_LSTA + 524288;
constexpr size_t WS_K1B  = WS_LSTH + 524288;
constexpr size_t WS_K2B  = WS_K1B + 262144;
constexpr size_t WS_XF   = WS_K2B + 262144;
constexpr size_t WS_XB   = WS_XF + (size_t)NTOK * D * 4;
constexpr size_t WS_WINT = WS_XB + (size_t)NTOK * D * 2;
constexpr size_t WS_WSC  = WS_WINT + (size_t)DIN * 1024;
constexpr size_t WS_X8   = WS_WSC + (size_t)DIN * 4 + 256 - ((size_t)DIN * 4) % 256;
constexpr size_t WS_XS   = WS_X8 + (size_t)NTOK * 1024;
constexpr size_t WS_WBAT = WS_XS + (size_t)NTOK * 4;
constexpr size_t WS_WBBT = WS_WBAT + (size_t)1024 * 512 * 2;
constexpr size_t WS_WBCT = WS_WBBT + (size_t)1024 * 1024 * 2;
constexpr size_t WS_WOT  = WS_WBCT + (size_t)1024 * 1024 * 2;
constexpr size_t WS_WQT  = WS_WOT + (size_t)1024 * 1024 * 2;
constexpr size_t WS_UV8  = WS_WQT + (size_t)2048 * 1024 * 2;
constexpr size_t WS_UVS  = WS_UV8 + (size_t)16384 * 2048;
constexpr size_t WS_PROJ = WS_UVS + (size_t)16384 * 8;
constexpr size_t WS_OATT = WS_PROJ + (size_t)NTOK * DIN * 2;
constexpr size_t WS_LSE  = WS_OATT + (size_t)NTOK * 1536 * 2;
constexpr size_t WS_KVB  = WS_LSE + (size_t)NTOK * 12 * 4;
constexpr size_t WS_YA   = WS_KVB + (size_t)16 * 32 * 65536 * 2;
constexpr size_t WS_YB   = WS_YA + (size_t)NTOK * 512 * 2;
constexpr size_t WS_YC   = WS_YB + (size_t)NTOK * 1024 * 2;
constexpr size_t WS_MRGF = WS_YC + (size_t)NTOK * 1024 * 2;
constexpr size_t WS_MRGB = WS_MRGF + (size_t)NTOK * 1024 * 4;
constexpr size_t WS_END  = WS_MRGB + (size_t)NTOK * 1024 * 2;
constexpr size_t WS_Q    = WS_PROJ;
constexpr size_t WS_EID  = WS_PROJ + (size_t)NTOK * 2048 * 2;
constexpr size_t WS_GATE = WS_EID + (size_t)NTOK * 128 * 4;
static_assert(WS_END <= (size_t)1073741824, "workspace too large");
static_assert(WS_PROJ % 256 == 0 && WS_KVB % 256 == 0 && WS_MRGF % 256 == 0, "alignment");

struct Args { const float* in[20]; float* out; unsigned char* ws; double ropeA, ropeR; int ph_lo, ph_hi; };

DI size_t pjo(size_t row, int col) { return ((size_t)(col >> 8) * NTOK + row) * 256 + (size_t)(col & 255); }
DI float bflo(unsigned w) { return __uint_as_float(w << 16); }
DI float bfhi(unsigned w) { return __uint_as_float(w & 0xffff0000u); }
DI float bf2f(bf16_t v) { return __uint_as_float(((unsigned)v) << 16); }
DI unsigned pk2(float lo, float hi) { return pg8::cvt_pk_bf16(lo, hi); }
DI bf16_t f2bf(float f) { return (bf16_t)(pk2(f, 0.f) & 0xffffu); }
DI f32x4 mfma16(bf16x8 a, bf16x8 b, f32x4 c) { return __builtin_amdgcn_mfma_f32_16x16x32_bf16(a, b, c, 0, 0, 0); }
DI s16x4 trrd(LAS unsigned char* p) { return __builtin_amdgcn_ds_read_tr16_b64_v4i16((LAS s16x4*)p); }
DI bf16x8 cat8(s16x4 lo, s16x4 hi) { return __builtin_shufflevector(lo, hi, 0, 1, 2, 3, 4, 5, 6, 7); }
DI float wsum(float v) { v += __shfl_xor(v, 32); v += __shfl_xor(v, 16); v += __shfl_xor(v, 8); v += __shfl_xor(v, 4); v += __shfl_xor(v, 2); v += __shfl_xor(v, 1); return v; }
DI float sigm(float x) { return __builtin_amdgcn_rcpf(1.f + __builtin_amdgcn_exp2f(x * -1.4426950408889634f)); }
DI float gelu_erf(float x) { return 0.5f * x * (1.f + erff(x * 0.70710678118654752f)); }
DI float dot2(unsigned w, unsigned x, float acc) { return __builtin_amdgcn_fdot2_f32_bf16(__builtin_bit_cast(bf16x2v, w), __builtin_bit_cast(bf16x2v, x), acc, false); }
DI float log2gamma(int h) { return log2f(1.0f - exp2f(-5.0f - (float)h)); }

#define MK_DPP_ADD(v, ctrl, rmask) v += __int_as_float(__builtin_amdgcn_update_dpp(0, __float_as_int(v), (ctrl), (rmask), 0xf, false))
DI float wsum_dpp(float v) {
    MK_DPP_ADD(v, 0xB1, 0xf); MK_DPP_ADD(v, 0x4E, 0xf); MK_DPP_ADD(v, 0x141, 0xf); MK_DPP_ADD(v, 0x140, 0xf);
    MK_DPP_ADD(v, 0x142, 0xa); MK_DPP_ADD(v, 0x143, 0xc);
    return __int_as_float(__builtin_amdgcn_readlane(__float_as_int(v), 63));
}
DI float gelu_as(float v) {
    const float av = fabsf(v), t = __builtin_amdgcn_rcpf(av * 0.2316418882f + 1.0f);
    float q = t * 0.5307027145f + (-0.7265760135f); q = q * t + 0.7107068705f; q = q * t + (-0.142248368f); q = q * t + 0.127414796f; q = q * t;
    const float e = __builtin_amdgcn_exp2f(v * v * (-0.72134752044f));
    const float m = v * (q * e);
    return v < 0.f ? m : v - m;
}
DI int wperm(int n) {
    if (n < 3072) { const int j = n & 127, bj = j >> 6, jj = j & 63; return (n & ~127) + 64 * (jj >> 5) + 32 * bj + (jj & 31); }
    if (n >= OFF_RQ && n < OFF_RV) { const int j = n & 255, bj = j >> 7, jj = j & 127; return (n & ~255) + 64 * (jj >> 5) + 32 * bj + (jj & 31); }
    return n;
}
template <bool WPERM>
DI void tconv_tile(const float* src, int ldsrc, bf16_t* dst, int lddst, int k0, int n0, LAS float* t, float mul = 1.0f) {
    const int tid = mk_tid();
#pragma unroll
    for (int i = 0; i < 8; ++i) { const int idx = tid + 512 * i, r = idx >> 6, c = idx & 63; t[r * 65 + c] = src[(size_t)(k0 + r) * ldsrc + n0 + c]; }
    __syncthreads();
#pragma unroll
    for (int i = 0; i < 8; ++i) { const int idx = tid + 512 * i, n = idx >> 6, k = idx & 63; const int nr = WPERM ? wperm(n0 + n) : (n0 + n); dst[(size_t)nr * lddst + k0 + k] = f2bf(t[k * 65 + n] * mul); }
    __syncthreads();
}
DI void conv_unit(const float* src, bf16_t* dst, int unit) {
    const size_t i = (size_t)unit * 4096 + (size_t)mk_tid() * 8;
    const f32x4 a = *(const f32x4*)(src + i), b = *(const f32x4*)(src + i + 4);
    u32x4 o; o.x = pk2(a[0], a[1]); o.y = pk2(a[2], a[3]); o.z = pk2(b[0], b[1]); o.w = pk2(b[2], b[3]);
    *(u32x4*)(dst + i) = o;
}
DI void w8_unit(const float* src, unsigned char* ws, int unit, LAS float* t) {
    const int tid = mk_tid(), n0 = unit * 64;
    unsigned char* dst = ws + WS_WINT;
#pragma unroll 1
    for (int k0 = 0; k0 < 1024; k0 += 64) {
#pragma unroll
        for (int i = 0; i < 8; ++i) { const int idx = tid + 512 * i, r = idx >> 6, cc = idx & 63; t[r * 65 + cc] = fminf(fmaxf(src[(size_t)(k0 + r) * DIN + n0 + cc] * W8_SCALE, -F8_MAX), F8_MAX); }
        __syncthreads();
#pragma unroll
        for (int i = 0; i < 2; ++i) { const int idx = tid + 512 * i, n = idx >> 4, k4 = idx & 15;
            int wd = __builtin_amdgcn_cvt_pk_fp8_f32(t[(4 * k4) * 65 + n], t[(4 * k4 + 1) * 65 + n], 0, false);
            wd = __builtin_amdgcn_cvt_pk_fp8_f32(t[(4 * k4 + 2) * 65 + n], t[(4 * k4 + 3) * 65 + n], wd, true);
            *(int*)(dst + (size_t)wperm(n0 + n) * 1024 + k0 + 4 * k4) = wd; }
        __syncthreads();
    }
}
DI void row_to_fp8(const f32x4 (&o)[4], unsigned char* x8row, int ln) {
    u32x4 w;
#pragma unroll
    for (int q = 0; q < 4; ++q) {
        const float a0 = fminf(fmaxf(o[q][0] * X8_SCALE, -F8_MAX), F8_MAX), a1 = fminf(fmaxf(o[q][1] * X8_SCALE, -F8_MAX), F8_MAX), a2 = fminf(fmaxf(o[q][2] * X8_SCALE, -F8_MAX), F8_MAX), a3 = fminf(fmaxf(o[q][3] * X8_SCALE, -F8_MAX), F8_MAX);
        int wd = __builtin_amdgcn_cvt_pk_fp8_f32(a0, a1, 0, false); wd = __builtin_amdgcn_cvt_pk_fp8_f32(a2, a3, wd, true); w[q] = (unsigned)wd; }
    *(u32x4*)(x8row + 16 * ln) = w;
}
typedef float f32x16 __attribute__((ext_vector_type(16)));
typedef float f32x32 __attribute__((ext_vector_type(32)));
typedef unsigned u32x6 __attribute__((ext_vector_type(6)));
typedef _Float16 f16x32 __attribute__((ext_vector_type(32)));
constexpr unsigned UVREC = 1280;
DI float wmax(float m) { m = fmaxf(m, __shfl_xor(m, 32)); m = fmaxf(m, __shfl_xor(m, 16)); m = fmaxf(m, __shfl_xor(m, 8)); m = fmaxf(m, __shfl_xor(m, 4)); m = fmaxf(m, __shfl_xor(m, 2)); m = fmaxf(m, __shfl_xor(m, 1)); return m; }
DI void conv_fp6_rows(const float* usrc, const float* vsrc, unsigned char* ws, int unit) {
    const int tid = mk_tid(), lane = tid & 63, w = tid >> 6;
    const size_t row = (size_t)unit * 8 + w;
    const float* up = usrc + row * 1024 + 16 * lane; const float* vp = vsrc + row * 1024 + 16 * lane;
    f32x16 a, b; float mu = 0.f, mv = 0.f;
#pragma unroll
    for (int q = 0; q < 4; ++q) { const f32x4 x = *(const f32x4*)(up + 4 * q), y = *(const f32x4*)(vp + 4 * q);
#pragma unroll
        for (int j = 0; j < 4; ++j) { a[4 * q + j] = x[j]; b[4 * q + j] = y[j]; mu = fmaxf(mu, fabsf(x[j])); mv = fmaxf(mv, fabsf(y[j])); } }
    mu = wmax(mu); mv = wmax(mv);
    const float su = (mu > 0.f) ? 7.0f / mu : 1.0f, sv = (mv > 0.f) ? 6.0f / mv : 1.0f;
    f16x32 h;
#pragma unroll
    for (int i = 0; i < 16; ++i) { h[i] = (_Float16)(a[i] * su); h[16 + i] = (_Float16)0.f; }
    const u32x6 p = __builtin_amdgcn_cvt_scalef32_pk32_fp6_f16(h, 1.0f);
    unsigned v0 = 0u, v1 = 0u;
#define MK_PK4(i) v0 = __builtin_amdgcn_cvt_scalef32_pk_fp4_f32(v0, b[2 * i] * sv, b[2 * i + 1] * sv, 1.0f, i); v1 = __builtin_amdgcn_cvt_scalef32_pk_fp4_f32(v1, b[8 + 2 * i] * sv, b[8 + 2 * i + 1] * sv, 1.0f, i);
    MK_PK4(0) MK_PK4(1) MK_PK4(2) MK_PK4(3)
#undef MK_PK4
    unsigned char* rec = ws + WS_UV8 + row * UVREC;
    *(u32x4*)(rec + 16 * lane) = (u32x4){p[0], p[1], p[2], v0};
    *(unsigned*)(rec + 1024 + 4 * lane) = v1;
    if (lane == 0) { float* sp = (float*)(ws + WS_UVS) + row * 2; sp[0] = (mu > 0.f) ? mu * (1.0f / 7.0f) : 1.0f; sp[1] = (mv > 0.f) ? mv * (1.0f / 6.0f) : 1.0f; }
}
DI void phase_conv(const Args& a, int layer, LAS unsigned char* lds) {
    unsigned char* ws = a.ws;
    LAS float* t = (LAS float*)lds;
    const int J0 = 216, J1 = J0 + 128, J2 = J1 + 256, J3 = J2 + 256, J4 = J3 + 256, J5 = J4 + 512, J6 = J5 + 32, J7 = J6 + 2048, J8 = J7, J9 = J8 + 64, J10 = J9 + 1;
    const int total = J10;
    for (int u = blockIdx.x; u < total; u += gridDim.x) {
        if (u < J0) { w8_unit(a.in[1] + (size_t)layer * 1024 * DIN, ws, u, t); }
        else if (u < J1) { const int v = u - J0, kt = v / 16, nt = v % 16; tconv_tile<false>(a.in[9] + (size_t)layer * 2560 * 1024, 1024, (bf16_t*)(ws + WS_WBAT), 512, kt * 64, nt * 64, t); }
        else if (u < J2) { const int v = u - J1, kt = v / 16, nt = v % 16; tconv_tile<false>(a.in[9] + (size_t)layer * 2560 * 1024 + (size_t)512 * 1024, 1024, (bf16_t*)(ws + WS_WBBT), 1024, kt * 64, nt * 64, t); }
        else if (u < J3) { const int v = u - J2, kt = v / 16, nt = v % 16; tconv_tile<false>(a.in[9] + (size_t)layer * 2560 * 1024 + (size_t)1536 * 1024, 1024, (bf16_t*)(ws + WS_WBCT), 1024, kt * 64, nt * 64, t); }
        else if (u < J4) { const int v = u - J3, kt = v / 16, nt = v % 16; tconv_tile<false>(a.in[10] + (size_t)layer * 1024 * 1024, 1024, (bf16_t*)(ws + WS_WOT), 1024, kt * 64, nt * 64, t); }
        else if (u < J5) { const int v = u - J4, kt = v / 32, nt = v % 32; tconv_tile<false>(a.in[13] + (size_t)layer * 1024 * 2048, 2048, (bf16_t*)(ws + WS_WQT), 1024, kt * 64, nt * 64, t); }
        else if (u < J6) { const int v = u - J5, blk = v & 15, which = v >> 4;
            tconv_tile<false>(a.in[which ? 6 : 4] + ((size_t)layer * 16 + blk) * 4096, 64, (bf16_t*)(ws + (which ? WS_WXT : WS_WAT)) + blk * 4096, 64, 0, 0, t, -1.4426950408889634f); }
        else if (u < J7) { conv_fp6_rows(a.in[16] + (size_t)layer * 16384 * 1024, a.in[17] + (size_t)layer * 16384 * 1024, ws, u - J6); }
        else if (u < J9) { const int v = u - J8; if (v < 32) conv_unit(a.in[14] + (size_t)layer * 131072, (bf16_t*)(ws + WS_K1B), v); else conv_unit(a.in[15] + (size_t)layer * 131072, (bf16_t*)(ws + WS_K2B), v - 32); }
        else { for (int c = mk_tid(); c < 1024; c += 512) { const float lam = a.in[8][layer * 1024 + c]; const float e = __builtin_amdgcn_exp2f(-lam * 1.4426950408889634f); const float sp = (e < 0.05f) ? e * (1.0f + e * (-0.5f + e * (0.33333333f + e * -0.25f))) : __builtin_amdgcn_logf(1.0f + e) * 0.6931471805599453f; ((float*)(ws + WS_CCH))[c] = -8.0f * sp; } }
    }
}

DI void phase_prologue(const Args& a) {
    unsigned char* ws = a.ws;
    const int tid = mk_tid();
    for (int u = blockIdx.x; u < 2048; u += gridDim.x) {
        { const int ln = tid & 63; const size_t row = (size_t)u * 8 + (tid >> 6);
            const float* xp = a.in[0] + row * 1024 + 16 * ln; float* xo = (float*)(ws + WS_XF) + row * 1024 + 16 * ln;
            f32x4 o[4];
#pragma unroll
            for (int q = 0; q < 4; ++q) { o[q] = *(const f32x4*)(xp + 4 * q); *(f32x4*)(xo + 4 * q) = o[q]; }
            row_to_fp8(o, ws + WS_X8 + row * 1024, ln); }
    }
}

DI void attn_unit(const Args& a, int unit, LAS unsigned char* lds) {
    unsigned char* ws = a.ws;
    const int tid = mk_tid(), lane = tid & 63, w = __builtin_amdgcn_readfirstlane(tid >> 6), g = lane >> 4, l15 = lane & 15, tq4 = l15 >> 2, tp4 = l15 & 3;
    const int b = unit / 384, rem = unit % 384, h = rem >> 5, bi = rem & 31;
    const int grp = h >> 2, d = (grp == 0) ? 1 : ((grp == 1) ? 4 : 16), nb = 32 / d, r = bi / nb, n = bi % nb;
    const bf16_t* proj = (const bf16_t*)(ws + WS_PROJ); const size_t brow = (size_t)b * SEQ;
    LAS unsigned char* Ks = lds; LAS unsigned char* Vs = lds + 256 * 288;
#pragma unroll
    for (int i = 0; i < 8; ++i) {
        const int idx = tid + 512 * i, row = idx >> 4, ch = idx & 15, m = 128 * (n - 1) + row;
        u32x4 kv = {0u, 0u, 0u, 0u}, vv = {0u, 0u, 0u, 0u};
        if (m >= 0) { const size_t gr = brow + (size_t)(m * d + r); kv = *(const u32x4*)(proj + pjo(gr, OFF_AK + h * 128 + ch * 8)); vv = *(const u32x4*)(proj + pjo(gr, OFF_AV + h * 128 + ch * 8)); }
        *(LAS u32x4*)(Ks + row * 288 + ch * 16) = kv; *(LAS u32x4*)(Vs + row * 288 + ch * 16) = vv;
    }
    const int qi = 16 * w + l15;
    const size_t tq = (size_t)(128 * n + qi) * d + r;
    bf16x8 qf[4];
#pragma unroll
    for (int ks = 0; ks < 4; ++ks) qf[ks] = *(const bf16x8*)(proj + pjo(brow + tq, OFF_AQ + h * 128 + 32 * ks + 8 * g));
    __syncthreads();
    const int s0 = w >> 1;
    f32x4 sacc[10];
#pragma unroll
    for (int jj = 0; jj < 10; ++jj) {
        f32x4 acc = {0.f, 0.f, 0.f, 0.f};
#pragma unroll
        for (int ks = 0; ks < 4; ++ks) { const bf16x8 kf = *(const LAS bf16x8*)(Ks + (32 * s0 + 16 * jj + l15) * 288 + (32 * ks + 8 * g) * 2); acc = mfma16(kf, qf[ks], acc); }
        sacc[jj] = acc;
    }
    const float scale = 0.08838834764831845f * 1.4426950408889634f;
    float mx = -1e30f;
#pragma unroll
    for (int jj = 0; jj < 10; ++jj)
#pragma unroll
        for (int rg = 0; rg < 4; ++rg) {
            const int j = 32 * s0 + 16 * jj + 4 * g + rg;
            const bool valid = (j >= qi) && (j <= qi + 128) && (n > 0 || j >= 128);
            const float s = valid ? sacc[jj][rg] * scale : -1e30f;
            sacc[jj][rg] = s; mx = fmaxf(mx, s);
        }
    mx = fmaxf(mx, __shfl_xor(mx, 16)); mx = fmaxf(mx, __shfl_xor(mx, 32));
    float sum = 0.f;
#pragma unroll
    for (int jj = 0; jj < 10; ++jj)
#pragma unroll
        for (int rg = 0; rg < 4; ++rg) { const float p = __builtin_amdgcn_exp2f(sacc[jj][rg] - mx); sacc[jj][rg] = p; sum += p; }
    sum += __shfl_xor(sum, 16); sum += __shfl_xor(sum, 32);
    f32x4 oacc[8];
#pragma unroll
    for (int db = 0; db < 8; ++db) oacc[db] = (f32x4){0.f, 0.f, 0.f, 0.f};
#pragma unroll
    for (int s = 0; s < 5; ++s) {
        u32x4 pw; pw.x = pk2(sacc[2 * s][0], sacc[2 * s][1]); pw.y = pk2(sacc[2 * s][2], sacc[2 * s][3]); pw.z = pk2(sacc[2 * s + 1][0], sacc[2 * s + 1][1]); pw.w = pk2(sacc[2 * s + 1][2], sacc[2 * s + 1][3]);
        const bf16x8 pb = __builtin_bit_cast(bf16x8, pw);
        const int k0 = 32 * (s0 + s) + 4 * g + tq4;
#pragma unroll
        for (int db = 0; db < 8; ++db) {
            const s16x4 lo = trrd(Vs + k0 * 288 + (16 * db + 4 * tp4) * 2), hi = trrd(Vs + (k0 + 16) * 288 + (16 * db + 4 * tp4) * 2);
            oacc[db] = mfma16(cat8(lo, hi), pb, oacc[db]);
        }
    }
    const float inv = 1.0f / sum;
    bf16_t* op = (bf16_t*)(ws + WS_OATT) + ((size_t)b * SEQ + tq) * 1536 + h * 128 + 4 * g;
#pragma unroll
    for (int db = 0; db < 8; ++db) { u32x2 o; o.x = pk2(oacc[db][0] * inv, oacc[db][1] * inv); o.y = pk2(oacc[db][2] * inv, oacc[db][3] * inv); *(u32x2*)(op + 16 * db) = o; }
    if (g == 0) ((float*)(ws + WS_LSE))[((size_t)b * SEQ + tq) * 12 + h] = mx + __builtin_amdgcn_logf(sum);
    __syncthreads();
}

DI void retkv_unit(const Args& a, int unit, LAS unsigned char* lds) {
    unsigned char* ws = a.ws;
    const int tid = mk_tid(), lane = tid & 63, w = __builtin_amdgcn_readfirstlane(tid >> 6), g = lane >> 4, l15 = lane & 15, tq4 = l15 >> 2, tp4 = l15 & 3;
    const int b = unit >> 7, h = (unit >> 5) & 3, c = unit & 31;
    const bf16_t* proj = (const bf16_t*)(ws + WS_PROJ); const size_t brow = (size_t)b * SEQ + c * 128;
    LAS unsigned char* Ks = lds; LAS unsigned char* Vs = lds + 128 * 544;
    const float l2g = log2gamma(h);
#pragma unroll
    for (int i = 0; i < 8; ++i) {
        const int idx = tid + 512 * i, row = idx >> 5, ch = idx & 31;
        const u32x4 kv = *(const u32x4*)(proj + pjo(brow + row, OFF_RK + h * 256 + ch * 8)), vv = *(const u32x4*)(proj + pjo(brow + row, OFF_RV + h * 256 + ch * 8));
        const float z = exp2f((float)(127 - row) * l2g);
        u32x4 kz;
#pragma unroll
        for (int q = 0; q < 4; ++q) kz[q] = pk2(bflo(kv[q]) * z, bfhi(kv[q]) * z);
        *(LAS u32x4*)(Ks + row * 544 + ch * 16) = kz; *(LAS u32x4*)(Vs + row * 544 + ch * 16) = vv;
    }
    __syncthreads();
#pragma unroll 1
    for (int nh = 0; nh < 2; ++nh) {
        f32x4 acc[2][8];
#pragma unroll
        for (int mb = 0; mb < 2; ++mb)
#pragma unroll
            for (int nb = 0; nb < 8; ++nb) acc[mb][nb] = (f32x4){0.f, 0.f, 0.f, 0.f};
#pragma unroll
        for (int ks = 0; ks < 4; ++ks) {
            const int j0 = 32 * ks + 4 * g + tq4;
            bf16x8 af[2];
#pragma unroll
            for (int mb = 0; mb < 2; ++mb) { const int col = 32 * w + 16 * mb + 4 * tp4; af[mb] = cat8(trrd(Vs + j0 * 544 + col * 2), trrd(Vs + (j0 + 16) * 544 + col * 2)); }
#pragma unroll
            for (int nb = 0; nb < 8; ++nb) {
                const int col = 128 * nh + 16 * nb + 4 * tp4;
                const bf16x8 bfr = cat8(trrd(Ks + j0 * 544 + col * 2), trrd(Ks + (j0 + 16) * 544 + col * 2));
#pragma unroll
                for (int mb = 0; mb < 2; ++mb) acc[mb][nb] = mfma16(af[mb], bfr, acc[mb][nb]);
            }
        }
        bf16_t* kvb = (bf16_t*)(ws + WS_KVB) + ((size_t)((b * 4 + h) * 32 + c)) * 65536 + 128 * nh;
#pragma unroll
        for (int mb = 0; mb < 2; ++mb)
#pragma unroll
            for (int nb = 0; nb < 8; ++nb)
#pragma unroll
                for (int rg = 0; rg < 4; ++rg) kvb[(size_t)(32 * w + 16 * mb + 4 * g + rg) * 256 + 16 * nb + l15] = f2bf(acc[mb][nb][rg]);
    }
    __syncthreads();
}

DI void lru_stripe(const Args& a, int layer, int stripe, LAS unsigned char* lds) {
    unsigned char* ws = a.ws;
    const int tid = mk_tid(), lane = tid & 63, w = __builtin_amdgcn_readfirstlane(tid >> 6), g = lane >> 4, l15 = lane & 15;
    const int b = stripe >> 4, blk = stripe & 15;
    LAS bf16_t* lxs = (LAS bf16_t*)lds;
    LAS bf16_t* lgs0 = (LAS bf16_t*)(lds + 16896);
    LAS unsigned char* xcb = lds + 49664;
    LAS float* rgt = (LAS float*)(lds + 68096);
    LAS float* igt = (LAS float*)(lds + 100864);
    LAS float* wst = (LAS float*)(lds + 133632);
    const bf16_t* proj = (const bf16_t*)(ws + WS_PROJ); const size_t brow = (size_t)b * SEQ;
    const int gc = blk * 64 + lane;
    const float* cw = a.in[2] + (size_t)layer * 4096;
    const int cch_ = tid & 63, cgc = blk * 64 + cch_;
    const float cw0 = cw[cgc], cw1 = cw[1024 + cgc], cw2 = cw[2048 + cgc], cw3 = cw[3072 + cgc], cb = a.in[3][layer * 1024 + cgc];
    const float cc = ((const float*)(ws + WS_CCH))[gc] * 1.4426950408889634f;
    float bia[4], bix[4];
    LAS unsigned char* wlds = lds + 137728;
    { const int r = tid >> 3, c8 = tid & 7; *(LAS u32x4*)(wlds + r * 144 + c8 * 16) = *(const u32x4*)((const bf16_t*)(ws + WS_WAT) + blk * 4096 + r * 64 + c8 * 8); }
    bf16x8 wfx[4][2];
#pragma unroll
    for (int nb = 0; nb < 4; ++nb)
#pragma unroll
        for (int ks = 0; ks < 2; ++ks) wfx[nb][ks] = *(const bf16x8*)((const bf16_t*)(ws + WS_WXT) + blk * 4096 + (16 * nb + l15) * 64 + 32 * ks + 8 * g);
#pragma unroll
    for (int nb = 0; nb < 4; ++nb) { bia[nb] = -1.4426950408889634f * a.in[5][layer * 1024 + blk * 64 + 16 * nb + l15]; bix[nb] = -1.4426950408889634f * a.in[7][layer * 1024 + blk * 64 + 16 * nb + l15]; }
    if (tid < 24) *(LAS u32x4*)(lxs + tid * 8) = (u32x4){0u, 0u, 0u, 0u};
    u32x4 plx[2], plg[2];
#pragma unroll
    for (int i = 0; i < 2; ++i) { const int idx = tid + 512 * i, row = idx >> 3, c8 = idx & 7; plx[i] = *(const u32x4*)(proj + pjo(brow + row, OFF_LX + blk * 64 + c8 * 8)); plg[i] = *(const u32x4*)(proj + pjo(brow + row, OFF_LG + blk * 64 + c8 * 8)); }
    float hcarry = 0.0f;
#pragma unroll 1
    for (int c = 0; c < 32; ++c) {
        LAS bf16_t* lgs = lgs0 + (c & 1) * 8192;
#pragma unroll
        for (int i = 0; i < 2; ++i) { const int idx = tid + 512 * i, row = idx >> 3, c8 = idx & 7; *(LAS u32x4*)(lxs + (3 + row) * 64 + c8 * 8) = plx[i]; *(LAS u32x4*)(lgs + row * 64 + c8 * 8) = plg[i]; }
        __syncthreads();
        if (c + 1 < 32) {
#pragma unroll
            for (int i = 0; i < 2; ++i) { const int idx = tid + 512 * i, row = idx >> 3, c8 = idx & 7; const size_t gr = brow + (size_t)((c + 1) * 128 + row); plx[i] = *(const u32x4*)(proj + pjo(gr, OFF_LX + blk * 64 + c8 * 8)); plg[i] = *(const u32x4*)(proj + pjo(gr, OFF_LG + blk * 64 + c8 * 8)); }
        }
        {
            const int t0 = (tid >> 6) * 16;
            float x0 = bf2f(lxs[t0 * 64 + cch_]), x1 = bf2f(lxs[(t0 + 1) * 64 + cch_]), x2 = bf2f(lxs[(t0 + 2) * 64 + cch_]);
#pragma unroll
            for (int i = 0; i < 16; ++i) {
                const float x3 = bf2f(lxs[(t0 + i + 3) * 64 + cch_]);
                const float xc = cb + cw0 * x0 + cw1 * x1 + cw2 * x2 + cw3 * x3;
                *(LAS bf16_t*)(xcb + (t0 + i) * 144 + cch_ * 2) = f2bf(xc);
                x0 = x1; x1 = x2; x2 = x3;
            }
        }
        __syncthreads();
        if (tid < 24) *(LAS u32x4*)(lxs + tid * 8) = *(const LAS u32x4*)(lxs + 128 * 64 + tid * 8);
        {
            const bf16x8 af0 = *(const LAS bf16x8*)(xcb + (16 * w + l15) * 144 + (8 * g) * 2), af1 = *(const LAS bf16x8*)(xcb + (16 * w + l15) * 144 + (32 + 8 * g) * 2);
#pragma unroll
            for (int nb = 0; nb < 4; ++nb) {
                f32x4 ar = {0.f, 0.f, 0.f, 0.f}, ax = {0.f, 0.f, 0.f, 0.f};
                const LAS unsigned char* wr_ = wlds + (16 * nb + l15) * 144 + 16 * g;
                ar = mfma16(af0, *(const LAS bf16x8*)(wr_), ar); ar = mfma16(af1, *(const LAS bf16x8*)(wr_ + 64), ar);
                ax = mfma16(af0, wfx[nb][0], ax); ax = mfma16(af1, wfx[nb][1], ax);
#pragma unroll
                for (int rg = 0; rg < 4; ++rg) { rgt[(16 * w + 4 * g + rg) * 64 + 16 * nb + l15] = __builtin_amdgcn_rcpf(1.0f + __builtin_amdgcn_exp2f(ar[rg] + bia[nb])); igt[(16 * w + 4 * g + rg) * 64 + 16 * nb + l15] = __builtin_amdgcn_rcpf(1.0f + __builtin_amdgcn_exp2f(ax[rg] + bix[nb])); }
            }
        }
        __syncthreads();
        float av[16], bv[16]; float Aw = 1.0f, Hw = 0.0f;
#pragma unroll
        for (int tt = 0; tt < 16; ++tt) {
            const int t = 16 * w + tt;
            const float aa = __builtin_amdgcn_exp2f(cc * rgt[t * 64 + lane]);
            const float bb = __builtin_amdgcn_sqrtf(fmaxf(1.0f - aa * aa, 0.0f)) * igt[t * 64 + lane] * bf2f(*(const LAS bf16_t*)(xcb + t * 144 + lane * 2));
            av[tt] = aa; bv[tt] = bb; Hw = aa * Hw + bb; Aw *= aa;
        }
        wst[w * 64 + lane] = Aw; wst[512 + w * 64 + lane] = Hw;
        __syncthreads();
        float hcur = hcarry, hend = hcarry;
#pragma unroll
        for (int ww = 0; ww < 8; ++ww) { const float A_ = wst[ww * 64 + lane], H_ = wst[512 + ww * 64 + lane]; hend = A_ * hend + H_; if (ww < w) hcur = hend; }
        hcarry = hend;
        bf16_t* yb = (bf16_t*)(ws + WS_YB) + ((size_t)b * SEQ + c * 128 + 16 * w) * 1024 + gc;
#pragma unroll
        for (int tt = 0; tt < 16; tt += 2) {
            const float h0 = av[tt] * hcur + bv[tt]; hcur = av[tt + 1] * h0 + bv[tt + 1];
            yb[(size_t)tt * 1024] = f2bf(h0 * bf2f(lgs[(16 * w + tt) * 64 + lane])); yb[(size_t)(tt + 1) * 1024] = f2bf(hcur * bf2f(lgs[(16 * w + tt + 1) * 64 + lane]));
        }
    }
    __syncthreads();
}

DI void retscan_unit(const Args& a, int unit) {
    unsigned char* ws = a.ws;
    const int e8 = unit * 512 + mk_tid();
    const int bh = e8 >> 13, within = e8 & 8191, h = bh & 3;
    const float g128 = exp2f(128.0f * log2gamma(h));
    bf16_t* base = (bf16_t*)(ws + WS_KVB) + (size_t)bh * 32 * 65536 + (size_t)within * 8;
    float st[8];
#pragma unroll
    for (int q = 0; q < 8; ++q) st[q] = 0.f;
#pragma unroll 1
    for (int c0 = 0; c0 < 32; c0 += 8) {
        u32x4 kv[8];
#pragma unroll
        for (int q = 0; q < 8; ++q) kv[q] = *(const u32x4*)(base + (size_t)(c0 + q) * 65536);
#pragma unroll
        for (int q = 0; q < 8; ++q) {
            u32x4 o;
#pragma unroll
            for (int j = 0; j < 4; ++j) o[j] = pk2(st[2 * j], st[2 * j + 1]);
            *(u32x4*)(base + (size_t)(c0 + q) * 65536) = o;
#pragma unroll
            for (int j = 0; j < 4; ++j) { st[2 * j] = g128 * st[2 * j] + bflo(kv[q][j]); st[2 * j + 1] = g128 * st[2 * j + 1] + bfhi(kv[q][j]); }
        }
    }
}

DI void attmerge_unit(const Args& a, int unit) {
    unsigned char* ws = a.ws;
    const int idx = unit * 512 + mk_tid(), t = idx >> 6, hp = (idx >> 4) & 3, dc = idx & 15;
    const float* lse = (const float*)(ws + WS_LSE) + (size_t)t * 12;
    const float l0 = lse[hp], l1 = lse[4 + hp], l2 = lse[8 + hp];
    const float m = fmaxf(l0, fmaxf(l1, l2));
    float w0 = __builtin_amdgcn_exp2f(l0 - m), w1 = __builtin_amdgcn_exp2f(l1 - m), w2 = __builtin_amdgcn_exp2f(l2 - m);
    const float is = 1.0f / (w0 + w1 + w2); w0 *= is; w1 *= is; w2 *= is;
    const bf16_t* o = (const bf16_t*)(ws + WS_OATT) + (size_t)t * 1536 + hp * 128 + dc * 8;
    const u32x4 a0 = *(const u32x4*)o, a1 = *(const u32x4*)(o + 512), a2 = *(const u32x4*)(o + 1024);
    u32x4 r;
#pragma unroll
    for (int q = 0; q < 4; ++q) r[q] = pk2(w0 * bflo(a0[q]) + w1 * bflo(a1[q]) + w2 * bflo(a2[q]), w0 * bfhi(a0[q]) + w1 * bfhi(a1[q]) + w2 * bfhi(a2[q]));
    *(u32x4*)((bf16_t*)(ws + WS_YA) + (size_t)t * 512 + hp * 128 + dc * 8) = r;
}

DI void retout_unit(const Args& a, int unit, LAS unsigned char* lds) {
    unsigned char* ws = a.ws;
    const int tid = mk_tid(), lane = tid & 63, w = __builtin_amdgcn_readfirstlane(tid >> 6), g = lane >> 4, l15 = lane & 15, tq4 = l15 >> 2, tp4 = l15 & 3;
    const int b = unit >> 7, h = (unit >> 5) & 3, c = unit & 31;
    const bf16_t* proj = (const bf16_t*)(ws + WS_PROJ); const size_t brow = (size_t)b * SEQ + c * 128;
    const bf16_t* rt = (const bf16_t*)(ws + WS_KVB) + ((size_t)((b * 4 + h) * 32 + c)) * 65536;
    LAS unsigned char* RA = lds; LAS unsigned char* RB = lds + 128 * 544;
    const float l2g = log2gamma(h);
    const int qi = 16 * w + l15;
    bf16x8 qf[8];
#pragma unroll
    for (int ks = 0; ks < 8; ++ks) qf[ks] = *(const bf16x8*)(proj + pjo(brow + qi, OFF_RQ + h * 256 + 32 * ks + 8 * g));
#pragma unroll
    for (int i = 0; i < 8; ++i) {
        const int idx = tid + 512 * i, row = idx >> 5, ch = idx & 31;
        *(LAS u32x4*)(RA + row * 544 + ch * 16) = *(const u32x4*)(proj + pjo(brow + row, OFF_RK + h * 256 + ch * 8));
        *(LAS u32x4*)(RB + row * 544 + ch * 16) = *(const u32x4*)(rt + (size_t)row * 256 + ch * 8);
    }
    __syncthreads();
    u32x4 pv[8], pr[8];
#pragma unroll
    for (int i = 0; i < 8; ++i) {
        const int idx = tid + 512 * i, row = idx >> 5, ch = idx & 31;
        pv[i] = *(const u32x4*)(proj + pjo(brow + row, OFF_RV + h * 256 + ch * 8));
        pr[i] = *(const u32x4*)(rt + (size_t)(128 + row) * 256 + ch * 8);
    }
    f32x4 sacc[8], oacc[16];
#pragma unroll
    for (int jj = 0; jj < 8; ++jj) {
        f32x4 acc = {0.f, 0.f, 0.f, 0.f};
        if (jj <= w) {
#pragma unroll
            for (int ks = 0; ks < 8; ++ks) { const bf16x8 kf = *(const LAS bf16x8*)(RA + (16 * jj + l15) * 544 + (32 * ks + 8 * g) * 2); acc = mfma16(kf, qf[ks], acc); }
        }
        sacc[jj] = acc;
    }
#pragma unroll
    for (int db = 0; db < 8; ++db) {
        f32x4 acc = {0.f, 0.f, 0.f, 0.f};
#pragma unroll
        for (int ks = 0; ks < 8; ++ks) { const bf16x8 rf = *(const LAS bf16x8*)(RB + (16 * db + l15) * 544 + (32 * ks + 8 * g) * 2); acc = mfma16(rf, qf[ks], acc); }
        oacc[db] = acc;
    }
    __syncthreads();
#pragma unroll
    for (int i = 0; i < 8; ++i) {
        const int idx = tid + 512 * i, row = idx >> 5, ch = idx & 31;
        *(LAS u32x4*)(RA + row * 544 + ch * 16) = pv[i];
        *(LAS u32x4*)(RB + row * 544 + ch * 16) = pr[i];
    }
    __syncthreads();
#pragma unroll
    for (int db = 0; db < 8; ++db) {
        f32x4 acc = {0.f, 0.f, 0.f, 0.f};
#pragma unroll
        for (int ks = 0; ks < 8; ++ks) { const bf16x8 rf = *(const LAS bf16x8*)(RB + (16 * db + l15) * 544 + (32 * ks + 8 * g) * 2); acc = mfma16(rf, qf[ks], acc); }
        oacc[8 + db] = acc;
    }
    const float xi = __builtin_amdgcn_exp2f((float)(qi + 1) * l2g);
#pragma unroll
    for (int db = 0; db < 16; ++db) oacc[db] = oacc[db] * xi;
#pragma unroll
    for (int jj = 0; jj < 8; ++jj)
#pragma unroll
        for (int rg = 0; rg < 4; ++rg) { const int j = 16 * jj + 4 * g + rg; sacc[jj][rg] = (qi >= j) ? sacc[jj][rg] * __builtin_amdgcn_exp2f((float)(qi - j) * l2g) : 0.f; }
#pragma unroll
    for (int s = 0; s < 4; ++s) {
        if (2 * s <= w) {
            u32x4 pw; pw.x = pk2(sacc[2 * s][0], sacc[2 * s][1]); pw.y = pk2(sacc[2 * s][2], sacc[2 * s][3]); pw.z = pk2(sacc[2 * s + 1][0], sacc[2 * s + 1][1]); pw.w = pk2(sacc[2 * s + 1][2], sacc[2 * s + 1][3]);
            const bf16x8 pb = __builtin_bit_cast(bf16x8, pw);
            const int k0 = 32 * s + 4 * g + tq4;
#pragma unroll
            for (int db = 0; db < 16; ++db) {
                const s16x4 lo = trrd(RA + k0 * 544 + (16 * db + 4 * tp4) * 2), hi = trrd(RA + (k0 + 16) * 544 + (16 * db + 4 * tp4) * 2);
                oacc[db] = mfma16(cat8(lo, hi), pb, oacc[db]);
            }
        }
    }
    float s1 = 0.f;
#pragma unroll
    for (int db = 0; db < 16; ++db) s1 += (oacc[db][0] + oacc[db][1]) + (oacc[db][2] + oacc[db][3]);
    s1 += __shfl_xor(s1, 16); s1 += __shfl_xor(s1, 32);
    const float mean = s1 * (1.0f / 256.0f);
    float s2 = 0.f;
#pragma unroll
    for (int db = 0; db < 16; ++db)
#pragma unroll
        for (int rg = 0; rg < 4; ++rg) { const float dd = oacc[db][rg] - mean; s2 += dd * dd; }
    s2 += __shfl_xor(s2, 16); s2 += __shfl_xor(s2, 32);
    const float rstd = rsqrtf(s2 * (1.0f / 256.0f) + LN_EPS);
    __syncthreads();
#pragma unroll
    for (int db = 0; db < 16; ++db) {
        u32x2 o; o.x = pk2((oacc[db][0] - mean) * rstd, (oacc[db][1] - mean) * rstd); o.y = pk2((oacc[db][2] - mean) * rstd, (oacc[db][3] - mean) * rstd);
        *(LAS u32x2*)(RA + qi * 528 + (16 * db + 4 * g) * 2) = o;
    }
    __syncthreads();
#pragma unroll
    for (int i = 0; i < 8; ++i) {
        const int idx = tid + 512 * i, row = idx >> 5, ch = idx & 31;
        const u32x4 nv = *(const LAS u32x4*)(RA + row * 528 + ch * 16);
        const u32x4 gw = *(const u32x4*)(proj + pjo(brow + row, OFF_RG + h * 256 + ch * 8));
        u32x4 o;
#pragma unroll
        for (int q = 0; q < 4; ++q) { const float g0 = bflo(gw[q]), g1 = bfhi(gw[q]); o[q] = pk2(g0 * sigm(g0) * bflo(nv[q]), g1 * sigm(g1) * bfhi(nv[q])); }
        *(u32x4*)((bf16_t*)(ws + WS_YC) + ((size_t)b * SEQ + c * 128 + row) * 1024 + h * 256 + ch * 8) = o;
    }
    __syncthreads();
}

struct EpiBranch {
    static constexpr bool PERM = false, AFTER_DRAIN = false;
    const bf16_t* gate; int gcol; bf16_t* mf; bf16_t* mb; int mode;
    __device__ __forceinline__ void operator()(const f32x4 (&acc)[2][2][4][2], const pg8::Unit& u, int wr, int wc, int fr, int fq) const {
        const int row0 = u.pm * 256 + wr * 64 + fr, col0 = u.pn * 256 + wc * 32 + 4 * fq;
        bf16_t* dst = (mode == 2) ? mb : mf;
#pragma unroll
        for (int ai = 0; ai < 2; ++ai) {
            u32x2 gw[4][2][2], old[4][2][2];
#pragma unroll
            for (int m = 0; m < 4; ++m) { const size_t row = (size_t)(row0 + ai * 128 + m * 16);
#pragma unroll
                for (int bj = 0; bj < 2; ++bj)
#pragma unroll
                    for (int n = 0; n < 2; ++n) { const int col = col0 + bj * 128 + n * 16;
                        gw[m][bj][n] = *(const u32x2*)(gate + pjo(row, gcol + col));
                        old[m][bj][n] = (mode != 0) ? *(const u32x2*)(mf + row * 1024 + col) : (u32x2){0u, 0u}; } }
#pragma unroll
            for (int m = 0; m < 4; ++m) { const size_t row = (size_t)(row0 + ai * 128 + m * 16);
#pragma unroll
                for (int bj = 0; bj < 2; ++bj)
#pragma unroll
                    for (int n = 0; n < 2; ++n) { const int col = col0 + bj * 128 + n * 16;
                        const u32x2 g2 = gw[m][bj][n], o2 = old[m][bj][n];
                        f32x4 v = acc[ai][bj][m][n];
                        v[0] = v[0] * sigm(bflo(g2.x)) + bflo(o2.x); v[1] = v[1] * sigm(bfhi(g2.x)) + bfhi(o2.x);
                        v[2] = v[2] * sigm(bflo(g2.y)) + bflo(o2.y); v[3] = v[3] * sigm(bfhi(g2.y)) + bfhi(o2.y);
                        u32x2 o; o.x = pk2(v[0], v[1]); o.y = pk2(v[2], v[3]); *(u32x2*)(dst + row * 1024 + col) = o; } }
        }
    }
};
#ifndef MK_EPI_AUX
#define MK_EPI_AUX 0
#endif
struct EpiInProj {
    static constexpr bool PERM = true, AFTER_DRAIN = false;
    bf16_t* O;
    __device__ __forceinline__ void operator()(const f32x4 (&acc)[2][2][4][2], const pg8::Unit& u, int wr_, int wc_, int fr_, int fq_) const {
        (void)wr_; (void)wc_; (void)fr_; (void)fq_;
        const int tid = mk_tid(), wid = tid >> 6, lane = tid & 63, wr = wid >> 2, wc = wid & 3, fr = lane & 15, fq = lane >> 4;
        const __amdgpu_buffer_rsrc_t rsrc = __builtin_amdgcn_make_buffer_rsrc((void*)O, 0, (int)((size_t)NTOK * DIN * 2), 0x00020000);
        const int row0 = u.pm * 256 + wr * 64 + fr;
        const int pn = u.pn;
        const bool ropeA = pn < 12, ropeR = (pn >= 26 && pn < 34);
        const float dsc = 1.0f / (X8_SCALE * W8_SCALE);
        if (!(ropeA || ropeR)) {
            const int col0 = pn * 256 + 64 * wc + 8 * fq;
            const bool isLG = (pn >= 22 && pn < 26);
#pragma unroll
            for (int ai = 0; ai < 2; ++ai) {
#pragma unroll
                for (int m = 0; m < 4; ++m) { const unsigned roff = (unsigned)(pjo((size_t)(row0 + ai * 128 + m * 16), col0) * 2);
#pragma unroll
                    for (int bj = 0; bj < 2; ++bj) { f32x4 v0 = acc[ai][bj][m][0] * dsc, v1 = acc[ai][bj][m][1] * dsc;
                        if (isLG) { const pg8::f32x2 g0 = pg8::gelu_pk((pg8::f32x2){v0[0], v0[1]}), g1 = pg8::gelu_pk((pg8::f32x2){v0[2], v0[3]}), g2 = pg8::gelu_pk((pg8::f32x2){v1[0], v1[1]}), g3 = pg8::gelu_pk((pg8::f32x2){v1[2], v1[3]});
                            v0 = (f32x4){g0.x, g0.y, g1.x, g1.y}; v1 = (f32x4){g2.x, g2.y, g3.x, g3.y}; }
                        u32x4 w; w.x = pk2(v0[0], v0[1]); w.y = pk2(v0[2], v0[3]); w.z = pk2(v1[0], v1[1]); w.w = pk2(v1[2], v1[3]);
                        __builtin_amdgcn_raw_buffer_store_b128(w, rsrc, (int)(roff + bj * 64), 0, MK_EPI_AUX); } }
            }
        } else {
            const int half = ropeA ? 64 : 128;
            const float sc = dsc * ((pn >= 30 && pn < 34) ? 0.0625f : 1.0f);
            const float kf = ropeA ? (-13.287712379549449f / 64.0f) : (-13.287712379549449f / 128.0f);
            const float pos0 = (float)(row0 & (SEQ - 1));
            const int j0 = ropeA ? (32 * (wc & 1) + 8 * fq) : (32 * wc + 8 * fq);
            const int lcol = ropeA ? (128 * (wc >> 1) + j0) : j0;
            float cb[8], sb[8], c16[8], s16[8], cb1[8], sb1[8];
#pragma unroll
            for (int i = 0; i < 8; ++i) {
                const float f = __builtin_amdgcn_exp2f((float)(j0 + i) * kf) * 0.15915494309189535f;
                const float t0 = __builtin_amdgcn_fractf(pos0 * f), t16 = __builtin_amdgcn_fractf(16.0f * f), t128 = __builtin_amdgcn_fractf(128.0f * f);
                cb[i] = __builtin_amdgcn_cosf(t0); sb[i] = __builtin_amdgcn_sinf(t0);
                c16[i] = __builtin_amdgcn_cosf(t16); s16[i] = __builtin_amdgcn_sinf(t16);
                const float c128 = __builtin_amdgcn_cosf(t128), s128 = __builtin_amdgcn_sinf(t128);
                cb1[i] = cb[i] * c128 - sb[i] * s128; sb1[i] = sb[i] * c128 + cb[i] * s128;
            }
#pragma unroll
            for (int ai = 0; ai < 2; ++ai) {
                float cv[8], sv[8];
#pragma unroll
                for (int i = 0; i < 8; ++i) { cv[i] = ai ? cb1[i] : cb[i]; sv[i] = ai ? sb1[i] : sb[i]; }
#pragma unroll
                for (int m = 0; m < 4; ++m) {
                    const int row = row0 + ai * 128 + m * 16;
                    const unsigned roff = (unsigned)(pjo((size_t)row, pn * 256 + lcol) * 2);
                    float o1[8], o2[8];
#pragma unroll
                    for (int i = 0; i < 8; ++i) { const float t1 = acc[ai][0][m][i >> 2][i & 3] * sc, t2 = acc[ai][1][m][i >> 2][i & 3] * sc; o1[i] = t1 * cv[i] - t2 * sv[i]; o2[i] = t1 * sv[i] + t2 * cv[i]; }
                    u32x4 w1, w2;
#pragma unroll
                    for (int q = 0; q < 4; ++q) { w1[q] = pk2(o1[2 * q], o1[2 * q + 1]); w2[q] = pk2(o2[2 * q], o2[2 * q + 1]); }
                    __builtin_amdgcn_raw_buffer_store_b128(w1, rsrc, (int)roff, 0, MK_EPI_AUX);
                    __builtin_amdgcn_raw_buffer_store_b128(w2, rsrc, (int)(roff + half * 2), 0, MK_EPI_AUX);
                    if (m < 3) {
#pragma unroll
                        for (int i = 0; i < 8; ++i) { const float cn = cv[i] * c16[i] - sv[i] * s16[i], sn = sv[i] * c16[i] + cv[i] * s16[i]; cv[i] = cn; sv[i] = sn; } }
                }
            }
        }
    }
};

struct EpiOut {
    static constexpr bool PERM = false, AFTER_DRAIN = false;
    const float* xf; float* z;
    __device__ __forceinline__ void operator()(const f32x4 (&acc)[2][2][4][2], const pg8::Unit& u, int wr, int wc, int fr, int fq) const {
        const int row0 = u.pm * 256 + wr * 64 + fr, col0 = u.pn * 256 + wc * 32 + 4 * fq;
#pragma unroll
        for (int ai = 0; ai < 2; ++ai) {
            f32x4 xv[4][2][2];
#pragma unroll
            for (int m = 0; m < 4; ++m) { const size_t row = (size_t)(row0 + ai * 128 + m * 16);
#pragma unroll
                for (int bj = 0; bj < 2; ++bj)
#pragma unroll
                    for (int n = 0; n < 2; ++n) xv[m][bj][n] = *(const f32x4*)(xf + row * 1024 + col0 + bj * 128 + n * 16); }
#pragma unroll
            for (int m = 0; m < 4; ++m) { const size_t row = (size_t)(row0 + ai * 128 + m * 16);
#pragma unroll
                for (int bj = 0; bj < 2; ++bj)
#pragma unroll
                    for (int n = 0; n < 2; ++n) *(f32x4*)(z + row * 1024 + col0 + bj * 128 + n * 16) = xv[m][bj][n] * ALPHA + acc[ai][bj][m][n]; }
        }
    }
};

DI void ln_row(const float* z, const float* gam, const float* bet, float* of, bf16_t* ob, int lane) {
    f32x4 v[4]; float s = 0.f;
#pragma unroll
    for (int i = 0; i < 4; ++i) { v[i] = *(const f32x4*)(z + 256 * i + 4 * lane); s += (v[i][0] + v[i][1]) + (v[i][2] + v[i][3]); }
    const float mean = wsum(s) * (1.0f / 1024.0f);
    float q = 0.f;
#pragma unroll
    for (int i = 0; i < 4; ++i)
#pragma unroll
        for (int j = 0; j < 4; ++j) { const float d = v[i][j] - mean; q += d * d; }
    const float rstd = rsqrtf(wsum(q) * (1.0f / 1024.0f) + LN_EPS);
#pragma unroll
    for (int i = 0; i < 4; ++i) {
        const f32x4 gg = *(const f32x4*)(gam + 256 * i + 4 * lane), bb = *(const f32x4*)(bet + 256 * i + 4 * lane);
        f32x4 o;
#pragma unroll
        for (int j = 0; j < 4; ++j) o[j] = (v[i][j] - mean) * rstd * gg[j] + bb[j];
        *(f32x4*)(of + 256 * i + 4 * lane) = o;
        u32x2 pb; pb.x = pk2(o[0], o[1]); pb.y = pk2(o[2], o[3]); *(u32x2*)(ob + 256 * i + 4 * lane) = pb;
    }
}
DI void phase_ln1(const Args& a, int layer) {
    unsigned char* ws = a.ws;
    const int lane = mk_tid() & 63, w = mk_tid() >> 6;
    for (int u = blockIdx.x; u < NTOK / 8; u += gridDim.x) {
        const size_t row = (size_t)u * 8 + w;
        ln_row((const float*)(ws + WS_MRGF) + row * 1024, a.in[11] + layer * 1024, a.in[12] + layer * 1024, (float*)(ws + WS_XF) + row * 1024, (bf16_t*)(ws + WS_XB) + row * 1024, lane);
    }
}

DI void ins16(float (&L)[16], float x) {
#pragma unroll
    for (int k = 0; k < 16; ++k) { const float hi = fmaxf(L[k], x); x = fminf(L[k], x); L[k] = hi; }
}
DI void merge16(float (&L)[16], int xr) {
    float t[16];
#pragma unroll
    for (int k = 0; k < 16; ++k) t[k] = __shfl_xor(L[k], xr);
#pragma unroll
    for (int k = 0; k < 8; ++k) { const float x = t[k]; t[k] = t[15 - k]; t[15 - k] = x; }
#pragma unroll
    for (int k = 0; k < 16; ++k) t[k] = fmaxf(L[k], t[k]);
#define MK_CE_STAGE(dd) _Pragma("unroll") for (int k = 0; k < 16; ++k) if ((k & (dd)) == 0) { const float hi = fmaxf(t[k], t[k + (dd)]), lo = fminf(t[k], t[k + (dd)]); t[k] = hi; t[k + (dd)] = lo; }
    MK_CE_STAGE(8) MK_CE_STAGE(4) MK_CE_STAGE(2) MK_CE_STAGE(1)
#undef MK_CE_STAGE
#pragma unroll
    for (int k = 0; k < 16; ++k) L[k] = t[k];
}
#define MK_CE_DESC(v, i, l) { const float hi_ = fmaxf(v[i], v[l]), lo_ = fminf(v[i], v[l]); v[i] = hi_; v[l] = lo_; }
#define MK_CE_ASC(v, i, l)  { const float hi_ = fmaxf(v[i], v[l]), lo_ = fminf(v[i], v[l]); v[i] = lo_; v[l] = hi_; }
#define MK_BITONIC_STAGE(v, kk, jj) _Pragma("unroll") for (int i_ = 0; i_ < 16; ++i_) { if ((i_ & (jj)) == 0) { if ((i_ & (kk)) == 0) MK_CE_DESC(v, i_, i_ + (jj)) else MK_CE_ASC(v, i_, i_ + (jj)) } }
DI void sort16_desc(float (&v)[16]) {
    MK_BITONIC_STAGE(v, 2, 1)
    MK_BITONIC_STAGE(v, 4, 2) MK_BITONIC_STAGE(v, 4, 1)
    MK_BITONIC_STAGE(v, 8, 4) MK_BITONIC_STAGE(v, 8, 2) MK_BITONIC_STAGE(v, 8, 1)
    MK_BITONIC_STAGE(v, 16, 8) MK_BITONIC_STAGE(v, 16, 4) MK_BITONIC_STAGE(v, 16, 2) MK_BITONIC_STAGE(v, 16, 1)
}
DI void top16_of_two(float (&a)[16], const float (&b)[16]) {
#pragma unroll
    for (int k = 0; k < 16; ++k) a[k] = fmaxf(a[k], b[15 - k]);
    MK_BITONIC_STAGE(a, 16, 8) MK_BITONIC_STAGE(a, 16, 4) MK_BITONIC_STAGE(a, 16, 2) MK_BITONIC_STAGE(a, 16, 1)
}
DI void top16_half(const bf16_t* qp, const LAS unsigned char* kt, float (&L)[16], int g, int l15) {
    bf16x8 qf[4];
#pragma unroll
    for (int ks = 0; ks < 4; ++ks) qf[ks] = *(const bf16x8*)(qp + 32 * ks + 8 * g);
    float M[16];
#pragma unroll
    for (int kbk = 0; kbk < 8; ++kbk) {
        f32x4 acc = {0.f, 0.f, 0.f, 0.f};
#pragma unroll
        for (int ks = 0; ks < 4; ++ks) { const bf16x8 kf = *(const LAS bf16x8*)(kt + (16 * kbk + l15) * 256 + (((4 * ks + g) ^ l15) << 4)); acc = mfma16(kf, qf[ks], acc); }
#pragma unroll
        for (int rg = 0; rg < 4; ++rg) { const unsigned key = (unsigned)(16 * kbk + 4 * g + rg); const float x = __uint_as_float((__float_as_uint(acc[rg]) & ~0x7Fu) | key);
            if (kbk < 4) L[4 * kbk + rg] = x; else M[4 * (kbk - 4) + rg] = x; }
    }
    sort16_desc(L); sort16_desc(M); top16_of_two(L, M);
    merge16(L, 16); merge16(L, 32);
}
DI void topk_unit(const Args& a, int unit, LAS unsigned char* lds) {
    unsigned char* ws = a.ws;
    const int tid = mk_tid(), lane = tid & 63, w = __builtin_amdgcn_readfirstlane(tid >> 6), g = lane >> 4, l15 = lane & 15;
    const int tg = w & 3, hs = w >> 2;
    const size_t t = (size_t)unit * 64 + tg * 16 + l15;
    const bf16_t* Q = (const bf16_t*)(ws + WS_Q);
    LAS unsigned char* tiles = lds + 16384;
    float K1[16], K2[16];
#pragma unroll
    for (int k = 0; k < 16; ++k) { K1[k] = 0.f; K2[k] = 0.f; }
#pragma unroll 1
    for (int hh = 0; hh < 4; ++hh) {
#pragma unroll
        for (int i = 0; i < 16; ++i) {
            const int idx = tid + 512 * i, tile = idx >> 11, row = (idx >> 4) & 127, ch = idx & 15;
            const int hd = ((tile >> 1) ? 4 : 0) + hh;
            const bf16_t* src = (const bf16_t*)(ws + ((tile & 1) ? WS_K2B : WS_K1B)) + ((size_t)hd * 128 + row) * 128 + ch * 8;
            *(LAS u32x4*)(tiles + tile * 32768 + row * 256 + ((ch ^ (row & 15)) << 4)) = *(const u32x4*)src;
        }
        __syncthreads();
        const int h = hs * 4 + hh;
        float l1[16], l2[16];
        top16_half(Q + t * 2048 + h * 256, tiles + (hs * 2) * 32768, l1, g, l15);
        top16_half(Q + t * 2048 + h * 256 + 128, tiles + (hs * 2 + 1) * 32768, l2, g, l15);
        const bool mine = (g == hh);
#pragma unroll
        for (int k = 0; k < 16; ++k) { K1[k] = mine ? l1[k] : K1[k]; K2[k] = mine ? l2[k] : K2[k]; }
        __syncthreads();
    }
    const int h = hs * 4 + g;
    float F[16];
#pragma unroll
    for (int k = 0; k < 16; ++k) F[k] = -FLT_MAX;
#pragma unroll
    for (int ia = 0; ia < 16; ++ia)
#pragma unroll
        for (int ib = 0; ib < 16 / (ia + 1); ++ib) {
            const float s = __uint_as_float(__float_as_uint(K1[ia]) & ~0x7Fu) + __uint_as_float(__float_as_uint(K2[ib]) & ~0x7Fu);
            ins16(F, __uint_as_float((__float_as_uint(s) & ~0xFFu) | (unsigned)(ia * 16 + ib)));
        }
    LAS unsigned char* row = lds + tid * 32;
#pragma unroll
    for (int k = 0; k < 16; ++k) { row[k] = (unsigned char)(__float_as_uint(K1[k]) & 0x7Fu); row[16 + k] = (unsigned char)(__float_as_uint(K2[k]) & 0x7Fu); }
    float gt[16]; int ei[16]; float gs = 0.f;
    const float cv0 = __uint_as_float(__float_as_uint(F[0]) & ~0xFFu);
#pragma unroll
    for (int k = 0; k < 16; ++k) {
        const unsigned bits = __float_as_uint(F[k]);
        const float cv = __uint_as_float(bits & ~0xFFu);
        gt[k] = __builtin_amdgcn_exp2f((cv - cv0) * 1.4426950408889634f); gs += gt[k];
        const int ia = (int)((bits >> 4) & 15u), ib = (int)(bits & 15u);
        ei[k] = (int)row[ia] * 128 + (int)row[16 + ib];
    }
    const float ig = 1.0f / gs;
    int* ep = (int*)(ws + WS_EID) + (t * 8 + h) * 16; float* gp = (float*)(ws + WS_GATE) + (t * 8 + h) * 16;
#pragma unroll
    for (int q = 0; q < 4; ++q) {
        *(i32x4*)(ep + 4 * q) = (i32x4){ei[4 * q], ei[4 * q + 1], ei[4 * q + 2], ei[4 * q + 3]};
        *(f32x4*)(gp + 4 * q) = (f32x4){gt[4 * q] * ig, gt[4 * q + 1] * ig, gt[4 * q + 2] * ig, gt[4 * q + 3] * ig};
    }
    __syncthreads();
}

typedef float f32x2 __attribute__((ext_vector_type(2)));
typedef __bf16 bf16x32 __attribute__((ext_vector_type(32)));
typedef unsigned u32x16 __attribute__((ext_vector_type(16)));
#define MK_PB_LOAD(RA_, RB_, ereg, kb) _Pragma("unroll") for (int j = 0; j < 8; ++j) { const int e_ = __builtin_amdgcn_readlane(ereg, (kb) + j); \
        const unsigned char* p_ = UV + (size_t)(unsigned)e_ * UVREC; RA_[j] = ((const u32x4*)p_)[lane]; RB_[j] = ((const unsigned*)(p_ + 1024))[lane]; }
#define MK_PB_COMP(RA_, RB_, usreg, gvreg, kb) { \
        float pp_[8]; \
        _Pragma("unroll") for (int j = 0; j < 8; ++j) { \
            const u32x16 hw_ = __builtin_bit_cast(u32x16, __builtin_amdgcn_cvt_scalef32_pk32_bf16_fp6((u32x6){RA_[j][0], RA_[j][1], RA_[j][2], 0u, 0u, 0u}, 1.0f)); \
            float s0_ = 0.f, s1_ = 0.f; \
            _Pragma("unroll") for (int q = 0; q < 4; ++q) { s0_ = dot2(hw_[2 * q], xpk[2 * q], s0_); s1_ = dot2(hw_[2 * q + 1], xpk[2 * q + 1], s1_); } \
            pp_[j] = s0_ + s1_; } \
        float q4_[4], r2_[2]; \
        _Pragma("unroll") for (int i = 0; i < 4; ++i) { const float keep_ = hi32 ? pp_[4 + i] : pp_[i], send_ = hi32 ? pp_[i] : pp_[4 + i]; q4_[i] = keep_ + __shfl_xor(send_, 32); } \
        _Pragma("unroll") for (int i = 0; i < 2; ++i) { const float keep_ = hi16 ? q4_[2 + i] : q4_[i], send_ = hi16 ? q4_[i] : q4_[2 + i]; r2_[i] = keep_ + __shfl_xor(send_, 16); } \
        float tot_ = (hi8 ? r2_[1] : r2_[0]) + __shfl_xor(hi8 ? r2_[0] : r2_[1], 8); \
        tot_ += __shfl_xor(tot_, 4); tot_ += __shfl_xor(tot_, 2); tot_ += __shfl_xor(tot_, 1); \
        const float act_ = gelu_as(tot_ * __shfl(usreg, (kb) + jj)) * __shfl(gvreg, (kb) + jj); \
        _Pragma("unroll") for (int j = 0; j < 8; ++j) { \
            const float aj_ = __uint_as_float(__builtin_amdgcn_readlane(__float_as_uint(act_), 32 * (j >> 2) + 16 * ((j >> 1) & 1) + 8 * (j & 1))); const f32x2 a2_ = {aj_, aj_}; \
            y2[0] += a2_ * __builtin_amdgcn_cvt_scalef32_pk_f32_fp4(RA_[j][3], 1.0f, 0); y2[1] += a2_ * __builtin_amdgcn_cvt_scalef32_pk_f32_fp4(RA_[j][3], 1.0f, 1); \
            y2[2] += a2_ * __builtin_amdgcn_cvt_scalef32_pk_f32_fp4(RA_[j][3], 1.0f, 2); y2[3] += a2_ * __builtin_amdgcn_cvt_scalef32_pk_f32_fp4(RA_[j][3], 1.0f, 3); \
            y2[4] += a2_ * __builtin_amdgcn_cvt_scalef32_pk_f32_fp4(RB_[j], 1.0f, 0); y2[5] += a2_ * __builtin_amdgcn_cvt_scalef32_pk_f32_fp4(RB_[j], 1.0f, 1); \
            y2[6] += a2_ * __builtin_amdgcn_cvt_scalef32_pk_f32_fp4(RB_[j], 1.0f, 2); y2[7] += a2_ * __builtin_amdgcn_cvt_scalef32_pk_f32_fp4(RB_[j], 1.0f, 3); } }
DI void peer_token(const unsigned char* UV, int e0, int e1, float us0, float us1, float gv0, float gv1, const unsigned (&xpk)[8], f32x2 (&y2)[8], int lane) {
    const bool hi32 = (lane & 32) != 0, hi16 = (lane & 16) != 0, hi8 = (lane & 8) != 0;
    const int jj = ((lane >> 5) & 1) * 4 + ((lane >> 4) & 1) * 2 + ((lane >> 3) & 1);
    u32x4 A0[8], A1[8]; unsigned B0[8], B1[8];
    MK_PB_LOAD(A0, B0, e0, 0)
#pragma unroll 1
    for (int b = 0; b < 8; b += 2) {
        MK_PB_LOAD(A1, B1, e0, 8 * b + 8)
        MK_PB_COMP(A0, B0, us0, gv0, 8 * b)
        if (b + 2 < 8) { MK_PB_LOAD(A0, B0, e0, 8 * b + 16) } else { MK_PB_LOAD(A0, B0, e1, 0) }
        MK_PB_COMP(A1, B1, us0, gv0, 8 * b + 8)
    }
#pragma unroll 1
    for (int b = 0; b < 8; b += 2) {
        MK_PB_LOAD(A1, B1, e1, 8 * b + 8)
        MK_PB_COMP(A0, B0, us1, gv1, 8 * b)
        if (b + 2 < 8) { MK_PB_LOAD(A0, B0, e1, 8 * b + 16) }
        MK_PB_COMP(A1, B1, us1, gv1, 8 * b + 8)
    }
}
DI void peer_unit(const Args& a, int layer, int unit) {
    unsigned char* ws = a.ws;
    const int tid = mk_tid(), lane = tid & 63, w = __builtin_amdgcn_readfirstlane(tid >> 6);
    const unsigned char* UV = ws + WS_UV8; const float* SC = (const float*)(ws + WS_UVS);
#pragma unroll 1
    for (int i = 0; i < 8; ++i) {
        const size_t t = (size_t)unit * 64 + w * 8 + i;
        unsigned xpk[8]; f32x2 y2[8];
        int e0, e1; float us0, us1, gv0, gv1;
        {
            const int ln = mk_tid() & 63;
            const bf16_t* xbp = (const bf16_t*)(ws + WS_XB) + t * 1024 + 16 * ln;
            const u32x4 xa = *(const u32x4*)xbp, xb = *(const u32x4*)(xbp + 8);
#pragma unroll
            for (int q = 0; q < 4; ++q) { xpk[q] = xa[q]; xpk[4 + q] = xb[q]; }
            const int* ep = (const int*)(ws + WS_EID) + t * 128; const float* gp = (const float*)(ws + WS_GATE) + t * 128;
            e0 = ep[ln]; e1 = ep[64 + ln]; const float g0 = gp[ln], g1 = gp[64 + ln];
            const f32x2 s0 = *(const f32x2*)(SC + 2 * e0), s1 = *(const f32x2*)(SC + 2 * e1);
            us0 = s0.x; us1 = s1.x; gv0 = g0 * s0.y; gv1 = g1 * s1.y;
        }
#pragma unroll
        for (int q = 0; q < 8; ++q) y2[q] = (f32x2){0.f, 0.f};
        peer_token(UV, e0, e1, us0, us1, gv0, gv1, xpk, y2, lane);
        {
            const int ln = mk_tid() & 63;
            float* xfp = (float*)(ws + WS_XF) + t * 1024 + 16 * ln;
            const float* gam = a.in[18] + layer * 1024 + 16 * ln; const float* bet = a.in[19] + layer * 1024 + 16 * ln;
            float z[16]; float s = 0.f;
#pragma unroll
            for (int q = 0; q < 4; ++q) { const f32x4 xr = *(const f32x4*)(xfp + 4 * q);
#pragma unroll
                for (int j = 0; j < 4; ++j) { z[4 * q + j] = ALPHA * xr[j] + y2[2 * q + (j >> 1)][j & 1]; s += z[4 * q + j]; } }
            const float mean = wsum(s) * (1.0f / 1024.0f);
            float qq = 0.f;
#pragma unroll
            for (int q = 0; q < 16; ++q) { const float d = z[q] - mean; qq += d * d; }
            const float rstd = rsqrtf(wsum(qq) * (1.0f / 1024.0f) + LN_EPS);
            f32x4 o[4];
#pragma unroll
            for (int q = 0; q < 4; ++q) { const f32x4 gq = *(const f32x4*)(gam + 4 * q), bq = *(const f32x4*)(bet + 4 * q);
#pragma unroll
                for (int j = 0; j < 4; ++j) o[q][j] = (z[4 * q + j] - mean) * rstd * gq[j] + bq[j]; }
#pragma unroll
            for (int q = 0; q < 4; ++q) *(f32x4*)(xfp + 4 * q) = o[q];
            if (layer == DEPTH - 1) { float* op = a.out + t * 1024 + 16 * ln;
#pragma unroll
                for (int q = 0; q < 4; ++q) *(f32x4*)(op + 4 * q) = o[q]; }
            row_to_fp8(o, ws + WS_X8 + t * 1024, ln);
        }
    }
}
}

namespace mk {
constexpr int LDS_ARG_OFF = LDS_BYTES - 16 - 256;
#define MK_NOINL __device__ __forceinline__
DI unsigned long long rfl64(unsigned long long v) { const unsigned lo = __builtin_amdgcn_readfirstlane((unsigned)v), hi = __builtin_amdgcn_readfirstlane((unsigned)(v >> 32)); return ((unsigned long long)hi << 32) | lo; }
DI Args load_args(LAS unsigned char* lds) {
    int aoff = LDS_ARG_OFF; asm volatile("" : "+s"(aoff));
    Args a; const LAS unsigned long long* p = (const LAS unsigned long long*)(lds + aoff);
#pragma unroll
    for (int i = 0; i < 20; ++i) a.in[i] = (const float*)(const __attribute__((address_space(1))) float*)rfl64(p[i]);
    a.out = (float*)(__attribute__((address_space(1))) float*)rfl64(p[20]); a.ws = (unsigned char*)(__attribute__((address_space(1))) unsigned char*)rfl64(p[21]);
    a.ropeA = __longlong_as_double((long long)rfl64(p[22])); a.ropeR = __longlong_as_double((long long)rfl64(p[23])); a.ph_lo = 0; a.ph_hi = 0;
    return a;
}
#define MK_LOADARGS const Args a = load_args(lds); unsigned char* ws = a.ws; const int G = (int)gridDim.x, bid = (int)blockIdx.x; (void)ws; (void)G; (void)bid
MK_NOINL void PG_prologue(LAS unsigned char* lds) { MK_LOADARGS; phase_prologue(a); }
MK_NOINL void P0_conv(LAS unsigned char* lds, int layer) { MK_LOADARGS; phase_conv(a, layer, lds); }
#ifndef MK_STAGGER_TICKS
#define MK_STAGGER_TICKS 140
#endif
MK_NOINL void P1_inproj(LAS unsigned char* lds, int layer) { MK_LOADARGS; (void)layer;
    pg8::Gemm gm; gm.A = (const bf16_t*)(ws + WS_X8); gm.Bt = (const bf16_t*)(ws + WS_WINT); gm.M = NTOK; gm.N = DIN; gm.K = 512;
    pg8::StaticOrder S; S.init(NTOK, DIN, G, bid);
    EpiInProj E; E.O = (bf16_t*)(ws + WS_PROJ);
    pg8::gemm_phase<EpiInProj, pg8::StaticOrder, false, true, true>(lds, gm, S, E, nullptr); }
#ifndef MK_NLRU
#define MK_NLRU 64
#endif
MK_NOINL void P3s_lru(LAS unsigned char* lds, int layer) { MK_LOADARGS; if (bid < MK_NLRU) { for (int s = bid; s < 64; s += MK_NLRU) lru_stripe(a, layer, s, lds); } }
MK_NOINL void P3a_attn(LAS unsigned char* lds, int layer) { MK_LOADARGS; (void)layer; if (bid >= MK_NLRU) { for (int u = bid - MK_NLRU; u < 1536; u += G - MK_NLRU) attn_unit(a, u, lds); } }
MK_NOINL void P3b_retkv(LAS unsigned char* lds, int layer) { MK_LOADARGS; (void)layer; if (bid >= MK_NLRU) { for (int u = bid - MK_NLRU; u < 512; u += G - MK_NLRU) retkv_unit(a, u, lds); } }
MK_NOINL void P4a_scan(LAS unsigned char* lds, int layer) { MK_LOADARGS; (void)layer; for (int u = bid; u < 256; u += G) retscan_unit(a, u); }
MK_NOINL void P4c_merge(LAS unsigned char* lds, int layer) { MK_LOADARGS; (void)layer; for (int u = bid; u < 2048; u += G) attmerge_unit(a, u); }
MK_NOINL void P5_retout(LAS unsigned char* lds, int layer) { MK_LOADARGS; (void)layer; for (int u = bid; u < 512; u += G) retout_unit(a, u, lds); }
MK_NOINL void P6_branch(LAS unsigned char* lds, int layer) { MK_LOADARGS; (void)layer;
#pragma unroll 1
    for (int s = 0; s < 3; ++s) {
        pg8::Gemm gm; gm.A = (const bf16_t*)(ws + (s == 0 ? WS_YA : (s == 1 ? WS_YB : WS_YC))); gm.Bt = (const bf16_t*)(ws + (s == 0 ? WS_WBAT : (s == 1 ? WS_WBBT : WS_WBCT)));
        gm.M = NTOK; gm.N = 1024; gm.K = (s == 0) ? 512 : 1024;
        pg8::StaticOrder S; S.init(NTOK, 1024, G, bid);
        EpiBranch E; E.gate = (const bf16_t*)(ws + WS_PROJ); E.gcol = OFF_GA + 1024 * s; E.mf = (bf16_t*)(ws + WS_MRGF); E.mb = (bf16_t*)(ws + WS_MRGB); E.mode = s;
        pg8::gemm_phase<EpiBranch, pg8::StaticOrder, false>(lds, gm, S, E, nullptr);
    } }
MK_NOINL void P7_outproj(LAS unsigned char* lds, int layer) { MK_LOADARGS; (void)layer;
    pg8::Gemm gm; gm.A = (const bf16_t*)(ws + WS_MRGB); gm.Bt = (const bf16_t*)(ws + WS_WOT); gm.M = NTOK; gm.N = 1024; gm.K = 1024;
    pg8::StaticOrder S; S.init(NTOK, 1024, G, bid);
    EpiOut E; E.xf = (const float*)(ws + WS_XF); E.z = (float*)(ws + WS_MRGF);
    pg8::gemm_phase<EpiOut, pg8::StaticOrder, false>(lds, gm, S, E, nullptr); }
MK_NOINL void P8_ln1(LAS unsigned char* lds, int layer) { MK_LOADARGS; phase_ln1(a, layer); }
MK_NOINL void P9_wq(LAS unsigned char* lds, int layer) { MK_LOADARGS; (void)layer;
    pg8::Gemm gm; gm.A = (const bf16_t*)(ws + WS_XB); gm.Bt = (const bf16_t*)(ws + WS_WQT); gm.M = NTOK; gm.N = 2048; gm.K = 1024;
    pg8::StaticOrder S; S.init(NTOK, 2048, G, bid);
    pg8::EpiBf16<0> E; E.O = (bf16_t*)(ws + WS_Q); E.ldc = 2048; E.bias = nullptr; E.split_cols = 0; E.split_stride = 0;
    pg8::gemm_phase<pg8::EpiBf16<0>, pg8::StaticOrder, false>(lds, gm, S, E, nullptr); }
MK_NOINL void P10_topk(LAS unsigned char* lds, int layer) { MK_LOADARGS; (void)layer; for (int u = bid; u < NTOK / 64; u += G) topk_unit(a, u, lds); }
MK_NOINL void P11_peer(LAS unsigned char* lds, int layer) { MK_LOADARGS; for (int u = bid; u < NTOK / 64; u += G) peer_unit(a, layer, u); }
DI void mk_sync(LAS unsigned char* lds) {
    const Args a = load_args(lds);
    XcdBarrier b; b.bar = (unsigned*)(a.ws + WS_CTL); b.x = xb_xcc_id(); b.st = (volatile LAS unsigned*)(lds + LDS_BAR_OFF);
    xcd_barrier(b);
}
}

#ifndef MK_PHASE_MASK
#define MK_PHASE_MASK 0xFFFu
#endif
#define MK_RUN(k) ((((MK_PHASE_MASK) >> ((k) - pb)) & 1u) && (k) >= ph_lo && (k) < ph_hi)
#define MK_NPHASES (1 + mk::DEPTH * mk::NPH)

#define MK_SYNC(k) do { if ((k) >= ph_lo && (k) + 1 < ph_hi) mk::mk_sync(lds); } while (0)
__global__ __launch_bounds__(512, 2) void mk_fwd(mk::Args a) {
    using namespace mk;
    extern __shared__ __attribute__((aligned(16))) unsigned char smem_raw[];
    LAS unsigned char* lds = (LAS unsigned char*)smem_raw;
    const int ph_lo = a.ph_lo, ph_hi = a.ph_hi;
    {
        const unsigned* src = (const unsigned*)&a;
        if (threadIdx.x < sizeof(Args) / 4) ((LAS unsigned*)(lds + LDS_ARG_OFF))[threadIdx.x] = src[threadIdx.x];
        if (threadIdx.x == 0) { LAS unsigned* st = (LAS unsigned*)(lds + LDS_BAR_OFF); st[0] = 0u; st[1] = 0u; st[2] = 0u; st[3] = 0u; }
    }
    __syncthreads();
    if (ph_hi - ph_lo > 1) (void)xcd_barrier_post((unsigned*)(a.ws + WS_CTL), (volatile LAS unsigned*)(lds + LDS_BAR_OFF));
    if (0 >= ph_lo && 0 < ph_hi) PG_prologue(lds);
    MK_SYNC(0);
#pragma unroll 1
    for (int layer = 0; layer < DEPTH; ++layer) {
        const int pb = 1 + layer * NPH;
        if (MK_RUN(pb + 0)) P0_conv(lds, layer);
        MK_SYNC(pb + 0);
        if (MK_RUN(pb + 1)) P1_inproj(lds, layer);
        MK_SYNC(pb + 1);
        if (MK_RUN(pb + 3)) { P3s_lru(lds, layer); P3a_attn(lds, layer); P3b_retkv(lds, layer); }
        MK_SYNC(pb + 3);
        if (MK_RUN(pb + 4)) { P4a_scan(lds, layer); P4c_merge(lds, layer); }
        MK_SYNC(pb + 4);
        if (MK_RUN(pb + 5)) P5_retout(lds, layer);
        MK_SYNC(pb + 5);
        if (MK_RUN(pb + 6)) P6_branch(lds, layer);
        MK_SYNC(pb + 6);
        if (MK_RUN(pb + 7)) P7_outproj(lds, layer);
        MK_SYNC(pb + 7);
        if (MK_RUN(pb + 8)) P8_ln1(lds, layer);
        MK_SYNC(pb + 8);
        if (MK_RUN(pb + 9)) P9_wq(lds, layer);
        MK_SYNC(pb + 9);
        if (MK_RUN(pb + 10)) P10_topk(lds, layer);
        MK_SYNC(pb + 10);
        if (MK_RUN(pb + 11)) P11_peer(lds, layer);
        MK_SYNC(pb + 11);
    }
}

#ifndef MK_SINGLE
#define MK_SINGLE 1
#endif
extern "C" void kernel_launch(void* const* d_in, const int* in_sizes, int n_in, void* d_out, int out_size, void* d_ws, size_t ws_size, hipStream_t stream) {
    using namespace mk;
    static int grid = 0;
    if (grid == 0) {
        if (n_in != 20 || out_size != NTOK * D || ws_size < WS_END) { fprintf(stderr, "kernel_launch: unexpected shapes (n_in %d, out %d, ws %zu, need %zu)\n", n_in, out_size, ws_size, (size_t)WS_END); grid = -1; return; }
        int dev = 0, cus = 0, per_cu = 0;
        if (hipGetDevice(&dev) != hipSuccess || hipDeviceGetAttribute(&cus, hipDeviceAttributeMultiprocessorCount, dev) != hipSuccess) { grid = -1; return; }
        if (hipFuncSetAttribute((const void*)mk_fwd, hipFuncAttributeMaxDynamicSharedMemorySize, LDS_BYTES) != hipSuccess) { fprintf(stderr, "kernel_launch: hipFuncSetAttribute failed\n"); grid = -1; return; }
        if (hipOccupancyMaxActiveBlocksPerMultiprocessor(&per_cu, (const void*)mk_fwd, 512, LDS_BYTES) != hipSuccess || per_cu < 1) { fprintf(stderr, "kernel_launch: occupancy query says %d blocks per CU\n", per_cu); (void)hipGetLastError(); grid = -1; return; }
        grid = cus;
    }
    if (grid < 0) return;
    (void)in_sizes;
    Args a{};
    for (int i = 0; i < 20; ++i) a.in[i] = (const float*)d_in[i];
    a.out = (float*)d_out; a.ws = (unsigned char*)d_ws;
    a.ropeA = pow(10000.0, -2.0 / 128.0); a.ropeR = pow(10000.0, -2.0 / 256.0);
#if MK_SINGLE
    (void)hipMemsetAsync((unsigned char*)d_ws + WS_CTL, 0, 16384, stream);
    a.ph_lo = 0; a.ph_hi = MK_NPHASES;
    hipLaunchKernelGGL(mk_fwd, dim3(grid), dim3(512), LDS_BYTES, stream, a);
#else
    for (int p = 0; p < MK_NPHASES; ++p) { a.ph_lo = p; a.ph_hi = p + 1; hipLaunchKernelGGL(mk_fwd, dim3(grid), dim3(512), LDS_BYTES, stream, a); }
#endif
}
```

```cpp
#include <hip/hip_runtime.h>
#include <cstdio>
#include <cstdint>
#include <cmath>
#include <cfloat>
__device__ __forceinline__ int mk_tid() { int t = (int)threadIdx.x; asm volatile("" : "+v"(t)); return t; }
namespace pg8 {
#define PG8_LAS __attribute__((address_space(3)))
typedef unsigned short bf16_t;
typedef short bf16x8 __attribute__((ext_vector_type(8)));
typedef float f32x4 __attribute__((ext_vector_type(4)));
typedef unsigned u32x4 __attribute__((ext_vector_type(4)));
constexpr int BM = 256, BK = 64, HALF = 128, HTB = HALF * BK * 2  , STAGE_BYTES = 8 * HTB, NXCD = 8, WGM = 8;

__host__ __device__ __forceinline__ int lds_byte(int r, int c) { const int st = (r >> 4) * 2 + (c >> 5), rr = r & 15, cc = c & 31, ob = rr * 64 + cc * 2; return st * 1024 + (ob ^ (((ob >> 9) & 1) << 5)); }
__host__ __device__ __forceinline__ void stage_rc(int b, int& R, int& C) { const int st = b / 1024, sb = b % 1024, swz = sb ^ (((sb >> 9) & 1) << 5); R = (st >> 1) * 16 + swz / 64; C = (st & 1) * 32 + (swz % 64) / 2; }
__host__ __device__ __forceinline__ int perm32(int rho) { const int n = rho >> 4, i = rho & 15; return 8 * (i >> 2) + 4 * n + (i & 3); }

struct Unit { int pm, pn; };
struct Gemm { const bf16_t* A; const bf16_t* Bt; int M, N, K; };

struct StaticOrder {
    int nM, nN, nwg, G, c;
    __host__ __device__ void init(int M, int N, int G_, int c_) { nM = M / BM; nN = N / BM; nwg = nM * nN; G = G_; c = c_; }
    __host__ __device__ bool next(int i, Unit& u) const {
        const long L = (long)i * G + c; if (L >= nwg) return false;
        int wgid = (int)L; { const int q = nwg / NXCD, r = nwg % NXCD, xcd = wgid % NXCD, off = wgid / NXCD; wgid = (xcd < r ? xcd * (q + 1) : r * (q + 1) + (xcd - r) * q) + off; }
        const int nig = WGM * nN, gid = wgid / nig, fm = gid * WGM, gsz = (nM - fm) < WGM ? (nM - fm) : WGM;
        u.pm = fm + ((wgid % nig) % gsz); u.pn = (wgid % nig) / gsz; return true;
    }
    __device__ __forceinline__ void a_ready(const Unit&) const {}
    __device__ __forceinline__ void done(const Unit&) const {}
};
typedef __bf16 pg8_bf16x2 __attribute__((ext_vector_type(2)));
__device__ __forceinline__ unsigned cvt_pk_bf16(float lo, float hi) { const pg8_bf16x2 v = {(__bf16)lo, (__bf16)hi}; return __builtin_bit_cast(unsigned, v); }
typedef float f32x2 __attribute__((ext_vector_type(2)));
__device__ __forceinline__ f32x2 gelu_pk(f32x2 v) {
    const f32x2 av = __builtin_elementwise_abs(v), d = av * 0.2316418882f + 1.0f;
    f32x2 t; t.x = __builtin_amdgcn_rcpf(d.x); t.y = __builtin_amdgcn_rcpf(d.y);
    f32x2 q = t * 0.5307027145f + (-0.7265760135f); q = q * t + 0.7107068705f; q = q * t + (-0.142248368f); q = q * t + 0.127414796f; q = q * t;
    const f32x2 s = (v * v) * (-0.72134752044f);
    f32x2 e; e.x = __builtin_amdgcn_exp2f(s.x); e.y = __builtin_amdgcn_exp2f(s.y);
    const f32x2 m = v * (q * e), r = v - m;
    f32x2 o; o.x = v.x < 0.f ? m.x : r.x; o.y = v.y < 0.f ? m.y : r.y; return o;
}

struct EpiF32 {
    static constexpr bool PERM = false, AFTER_DRAIN = false;
    float* C; int ldc; const float* bias;
    __device__ __forceinline__ void operator()(const f32x4 (&acc)[2][2][4][2], const Unit& u, int wr, int wc, int fr, int fq) const {
        const int row0 = u.pm * BM + wr * 64 + fr, col0 = u.pn * BM + wc * 32 + 4 * fq;
        f32x4 bv[2][2];
#pragma unroll
        for (int bj = 0; bj < 2; ++bj)
#pragma unroll
            for (int n = 0; n < 2; ++n) bv[bj][n] = bias ? *(const f32x4*)(bias + col0 + bj * HALF + n * 16) : (f32x4){0.f, 0.f, 0.f, 0.f};
#pragma unroll
        for (int ai = 0; ai < 2; ++ai)
#pragma unroll
            for (int m = 0; m < 4; ++m) { float* rowp = C + (size_t)(row0 + ai * HALF + m * 16) * ldc + col0;
#pragma unroll
                for (int bj = 0; bj < 2; ++bj)
#pragma unroll
                    for (int n = 0; n < 2; ++n) *(f32x4*)(rowp + bj * HALF + n * 16) = acc[ai][bj][m][n] + bv[bj][n]; }
    }
};
template <int ACT  > struct EpiBf16 {
    static constexpr bool PERM = true, AFTER_DRAIN = false;
    bf16_t* O; int ldc; const float* bias; int split_cols; size_t split_stride;
    __device__ __forceinline__ void operator()(const f32x4 (&acc)[2][2][4][2], const Unit& u, int wr, int wc, int fr, int fq) const {
        const int row0 = u.pm * BM + wr * 64 + fr; int colt = u.pn * BM; bf16_t* base = O;
        if (split_cols) { const int t = colt / split_cols; base += (size_t)t * split_stride; colt -= t * split_cols; }
        const int col0 = colt + wc * 32 + 8 * fq, bcol0 = u.pn * BM + wc * 32 + 8 * fq;
        f32x4 bv[2][2];
#pragma unroll
        for (int bj = 0; bj < 2; ++bj)
#pragma unroll
            for (int n = 0; n < 2; ++n) bv[bj][n] = bias ? *(const f32x4*)(bias + bcol0 + bj * HALF + 4 * n) : (f32x4){0.f, 0.f, 0.f, 0.f};
#pragma unroll
        for (int ai = 0; ai < 2; ++ai)
#pragma unroll
            for (int m = 0; m < 4; ++m) { bf16_t* rowp = base + (size_t)(row0 + ai * HALF + m * 16) * ldc + col0;
#pragma unroll
                for (int bj = 0; bj < 2; ++bj) { f32x4 v0 = acc[ai][bj][m][0] + bv[bj][0], v1 = acc[ai][bj][m][1] + bv[bj][1];
                    if (ACT == 1) { f32x2 a = gelu_pk((f32x2){v0[0], v0[1]}), b = gelu_pk((f32x2){v0[2], v0[3]}), c = gelu_pk((f32x2){v1[0], v1[1]}), d = gelu_pk((f32x2){v1[2], v1[3]});
                        v0 = (f32x4){a.x, a.y, b.x, b.y}; v1 = (f32x4){c.x, c.y, d.x, d.y}; }
                    if (ACT == 2) {
#pragma unroll
                        for (int j = 0; j < 4; ++j) { v0[j] = 0.5f * v0[j] * (1.0f + erff(v0[j] * 0.70710678f)); v1[j] = 0.5f * v1[j] * (1.0f + erff(v1[j] * 0.70710678f)); } }
                    u32x4 w; w.x = cvt_pk_bf16(v0[0], v0[1]); w.y = cvt_pk_bf16(v0[2], v0[3]); w.z = cvt_pk_bf16(v1[0], v1[1]); w.w = cvt_pk_bf16(v1[2], v1[3]);
                    *(u32x4*)(rowp + bj * HALF) = w; } }
    }
};

typedef int i32x8 __attribute__((ext_vector_type(8)));
typedef short s16x16 __attribute__((ext_vector_type(16)));
__device__ __forceinline__ i32x8 pg8_cat16(bf16x8 a, bf16x8 b) { return __builtin_bit_cast(i32x8, (s16x16)__builtin_shufflevector(a, b, 0, 1, 2, 3, 4, 5, 6, 7, 8, 9, 10, 11, 12, 13, 14, 15)); }
template <class Epi, class Sched, bool STAMP = false, bool F8 = false, bool WIDE = false>
__device__ __forceinline__ void gemm_phase(PG8_LAS unsigned char* lds, const Gemm g, const Sched& S, const Epi& E, unsigned long long* stamps) {
    const int tid = mk_tid(), wid = __builtin_amdgcn_readfirstlane(tid >> 6), lane = tid & 63, wr = wid >> 2, wc = wid & 3, fr = lane & 15, fq = lane >> 4;
    const int K = g.K, nt = K / BK;
    int ts_lo = 0, ts_hi = 0, nts = 0; const unsigned long long rt_entry = STAMP ? (unsigned long long)wall_clock64() : 0ull;
#define PG8_STAMP() do { if (STAMP && wid == 0 && nts < 64) { const unsigned long long _c = (unsigned long long)clock64(); \
        ts_lo = (lane == nts) ? (int)(unsigned)_c : ts_lo; ts_hi = (lane == nts) ? (int)(unsigned)(_c >> 32) : ts_hi; ++nts; } } while (0)
    PG8_STAMP();
    unsigned voffA, voffB;
    { int R, C; stage_rc(tid * 16, R, C); const int Ri = Epi::PERM ? perm32(R & 31) : (R & 31); const int Rb = WIDE ? (((R >> 5) << 6) + Ri) : ((R & ~31) + Ri);
        voffA = (unsigned)(R * K + C) * 2u; voffB = (unsigned)(Rb * K + C) * 2u; }
    const size_t qstep = (size_t)64 * K * 2;
    const size_t qstepB = WIDE ? (size_t)128 * K * 2 : qstep;
    const size_t hstepB = WIDE ? (size_t)32 * K * 2 : (size_t)HALF * K * 2;
    const size_t kstep = (size_t)(BK * 2);
    const size_t hstep = (size_t)HALF * K * 2;
    const size_t tstep = 2 * hstep;
    const unsigned ldsw = (unsigned)wid * 1024u;
    const int aoff = lds_byte(wr * 64 + fr, fq * 8), boff = lds_byte(wc * 32 + fr, fq * 8);
#define PG8_SA(b, h) (((b) * 2 + (h)) * HTB)
#define PG8_SB(b, h) ((4 + (b) * 2 + (h)) * HTB)
#define PG8_STAGE(bufoff, gbase, voff) PG8_STAGEQ(bufoff, gbase, voff, qstep)
#define PG8_STAGEB(bufoff, gbase, voff) PG8_STAGEQ(bufoff, gbase, voff, qstepB)
#define PG8_STAGEQ(bufoff, gbase, voff, qs) do { const char* _g0 = (const char*)(gbase); const char* _g1 = _g0 + (qs); asm volatile("" : "+s"(_g0), "+s"(_g1));   \
        __builtin_amdgcn_global_load_lds((const unsigned*)(_g0 + (voff)), (PG8_LAS unsigned*)(lds + (bufoff) + ldsw), 16, 0, 0); \
        __builtin_amdgcn_global_load_lds((const unsigned*)(_g1 + (voff)), (PG8_LAS unsigned*)(lds + (bufoff) + ldsw + 8192), 16, 0, 0); } while (0)
#define PG8_LDA(dst, b, h) do { _Pragma("unroll") for (int m = 0; m < 4; ++m) _Pragma("unroll") for (int k = 0; k < 2; ++k) dst[m][k] = *(const PG8_LAS bf16x8*)(lds + PG8_SA(b, h) + aoff + m * 2048 + k * 1024); } while (0)
#define PG8_LDB(dst, b, h) do { _Pragma("unroll") for (int n = 0; n < 2; ++n) _Pragma("unroll") for (int k = 0; k < 2; ++k) dst[n][k] = *(const PG8_LAS bf16x8*)(lds + PG8_SB(b, h) + boff + n * 2048 + k * 1024); } while (0)
#define PG8_MMA(ai, bj, At, Bt) do { __builtin_amdgcn_s_setprio(1); _Pragma("unroll") for (int m = 0; m < 4; ++m) _Pragma("unroll") for (int n = 0; n < 2; ++n) { \
        if constexpr (F8) acc[ai][bj][m][n] = __builtin_amdgcn_mfma_scale_f32_16x16x128_f8f6f4(pg8_cat16(Bt[n][0], Bt[n][1]), pg8_cat16(At[m][0], At[m][1]), acc[ai][bj][m][n], 0, 0, 0, 0, 0, 0); \
        else { _Pragma("unroll") for (int k = 0; k < 2; ++k) acc[ai][bj][m][n] = __builtin_amdgcn_mfma_f32_16x16x32_bf16(Bt[n][k], At[m][k], acc[ai][bj][m][n], 0, 0, 0); } } \
        __builtin_amdgcn_s_setprio(0); } while (0)
#define PG8_WAIT_V(n) asm volatile("s_waitcnt vmcnt(" #n ")" ::: "memory")
#define PG8_WAIT_L(n) asm volatile("s_waitcnt lgkmcnt(" #n ")" ::: "memory")
#define PG8_BAR __builtin_amdgcn_s_barrier()
#define PG8_SCHED __builtin_amdgcn_sched_barrier(0)
    Unit cur, nxt; int ui = 0;
    if (!S.next(0, cur)) return;
    f32x4 acc[2][2][4][2];
    bf16x8 At[4][2], B0[2][2], B1[2][2];
    const char* cA = (const char*)g.A + (size_t)cur.pm * tstep; const char* cB = (const char*)g.Bt + (size_t)cur.pn * tstep;
    S.a_ready(cur);
    PG8_STAGEB(PG8_SB(0, 0), cB, voffB); PG8_STAGE(PG8_SA(0, 0), cA, voffA); PG8_STAGEB(PG8_SB(0, 1), cB + hstepB, voffB); PG8_STAGE(PG8_SA(0, 1), cA + hstep, voffA);
    if (wr == 1) PG8_BAR;
    PG8_WAIT_V(4); PG8_BAR;
    PG8_STAGEB(PG8_SB(1, 0), cB + kstep, voffB); PG8_STAGE(PG8_SA(1, 0), cA + kstep, voffA); PG8_STAGEB(PG8_SB(1, 1), cB + hstepB + kstep, voffB);
    PG8_WAIT_V(6); PG8_BAR;
    PG8_STAMP();
#pragma unroll
    for (int a = 0; a < 2; ++a)
#pragma unroll
        for (int b = 0; b < 2; ++b)
#pragma unroll
            for (int m = 0; m < 4; ++m)
#pragma unroll
                for (int n = 0; n < 2; ++n) acc[a][b][m][n] = (f32x4){0.f, 0.f, 0.f, 0.f};
    for (;;) {
        const bool has_next = S.next(ui + 1, nxt);
        const char* nA = has_next ? (const char*)g.A + (size_t)nxt.pm * tstep : cA; const char* nB = has_next ? (const char*)g.Bt + (size_t)nxt.pn * tstep : cB;
        for (int t = 0; t < nt; t += 2) {
            const bool last = (t == nt - 2);
            const char* a1 = cA + (size_t)(t + 1) * kstep;
            const char* a2 = last ? nA : cA + (size_t)(t + 2) * kstep; const char* b2 = last ? nB : cB + (size_t)(t + 2) * kstep;
            const char* a3 = a2 + kstep; const char* b3 = b2 + kstep;
            if (last && has_next) S.a_ready(nxt);
            PG8_LDB(B0, 0, 0); PG8_SCHED; PG8_LDA(At, 0, 0); PG8_STAGE(PG8_SA(1, 1), a1 + hstep, voffA);
            PG8_WAIT_L(8); PG8_BAR; PG8_WAIT_L(0); PG8_MMA(0, 0, At, B0); PG8_BAR; PG8_SCHED;
            PG8_LDB(B1, 0, 1); PG8_STAGEB(PG8_SB(0, 0), b2, voffB);
            PG8_BAR; PG8_WAIT_L(0); PG8_MMA(0, 1, At, B1); PG8_BAR;
            PG8_LDA(At, 0, 1); PG8_STAGE(PG8_SA(0, 0), a2, voffA);
            PG8_BAR; PG8_WAIT_L(0); PG8_MMA(1, 0, At, B0); PG8_BAR; PG8_SCHED;
            PG8_STAGEB(PG8_SB(0, 1), b2 + hstepB, voffB);
            PG8_WAIT_V(6); PG8_BAR; PG8_MMA(1, 1, At, B1); PG8_BAR;
            PG8_LDB(B0, 1, 0); PG8_SCHED; PG8_LDA(At, 1, 0); PG8_STAGE(PG8_SA(0, 1), a2 + hstep, voffA);
            PG8_WAIT_L(8); PG8_BAR; PG8_WAIT_L(0); PG8_MMA(0, 0, At, B0); PG8_BAR; PG8_SCHED;
            PG8_LDB(B1, 1, 1); PG8_STAGEB(PG8_SB(1, 0), b3, voffB);
            PG8_BAR; PG8_WAIT_L(0); PG8_MMA(0, 1, At, B1); PG8_BAR;
            PG8_LDA(At, 1, 1); PG8_STAGE(PG8_SA(1, 0), a3, voffA);
            PG8_BAR; PG8_WAIT_L(0); PG8_MMA(1, 0, At, B0); PG8_BAR; PG8_SCHED;
            PG8_STAGEB(PG8_SB(1, 1), b3 + hstepB, voffB);
            PG8_WAIT_V(6); PG8_BAR; PG8_MMA(1, 1, At, B1); PG8_BAR;
        }
        PG8_STAMP();
        if constexpr (!Epi::AFTER_DRAIN) { E(acc, cur, wr, wc, fr, fq); S.done(cur); }
        PG8_STAMP();
        if (!has_next) break;
#pragma unroll
        for (int a = 0; a < 2; ++a)
#pragma unroll
            for (int b = 0; b < 2; ++b)
#pragma unroll
                for (int m = 0; m < 4; ++m)
#pragma unroll
                    for (int n = 0; n < 2; ++n) acc[a][b][m][n] = (f32x4){0.f, 0.f, 0.f, 0.f};
        cur = nxt; cA = nA; cB = nB; ++ui;
    }
    PG8_WAIT_V(0);
    if (wr == 0) PG8_BAR;
    PG8_BAR;
    if constexpr (Epi::AFTER_DRAIN) { E.fused(acc, cur, wr, wc, fr, fq, lds, wid, lane); S.done(cur); }
    PG8_STAMP();
    if (STAMP && wid == 0) { stamps[lane] = lane < nts ? (((unsigned long long)(unsigned)ts_hi << 32) | (unsigned)ts_lo) : 0ull;
        if (lane == 62) stamps[62] = rt_entry; if (lane == 63) stamps[63] = (unsigned long long)wall_clock64(); }
#undef PG8_STAMP
#undef PG8_SA
#undef PG8_SB
#undef PG8_STAGE
#undef PG8_STAGEB
#undef PG8_STAGEQ
#undef PG8_LDA
#undef PG8_LDB
#undef PG8_MMA
#undef PG8_WAIT_V
#undef PG8_WAIT_L
#undef PG8_BAR
#undef PG8_SCHED
}
}
#define XB_TMO      128
#define XB_XCNT(j)  (256  + 64 * (j))
#define XB_XSUB(j)  (1280 + 64 * (j))
#define XB_XGEN(j)  (2304 + 64 * (j))
#define XB_TOP      3328
#define XB_TOPGEN   3392
#define XCD_BAR_WORDS 3456
#define XB_SPIN_CAP (1u << 18)
#define LAS __attribute__((address_space(3)))

__device__ __forceinline__ unsigned xb_ld(unsigned* p)              { return __hip_atomic_load(p, __ATOMIC_RELAXED, __HIP_MEMORY_SCOPE_AGENT); }
__device__ __forceinline__ unsigned xb_add(unsigned* p, unsigned v) { return __hip_atomic_fetch_add(p, v, __ATOMIC_RELAXED, __HIP_MEMORY_SCOPE_AGENT); }
__device__ __forceinline__ unsigned xb_xcc_id() { return (unsigned)__builtin_amdgcn_s_getreg((3 << 11) | 20) & 0xFu; }
#define XB_SPIN(cond, bar) do { unsigned _sp = 0; while (cond) { __builtin_amdgcn_s_sleep(1); \
    if ((++_sp & 255u) == 0u) { if (xb_ld(&(bar)[XB_TMO])) break; if (_sp > XB_SPIN_CAP) { atomicAdd(&(bar)[XB_TMO], 1u); break; } } } } while (0)

struct XcdBarrier {
    unsigned* bar; unsigned x;
    volatile LAS unsigned* st;
};

__device__ __forceinline__ XcdBarrier xcd_barrier_post(unsigned* bar, volatile LAS unsigned* st) {
    XcdBarrier b; b.bar = bar; b.x = xb_xcc_id(); b.st = st;
    if (threadIdx.x == 0) (void)xb_add(&bar[XB_XCNT(b.x)], 1u);
    return b;
}
__device__ __forceinline__ void xcd_barrier_complete(unsigned* bar, unsigned x, unsigned& nloc, unsigned& nx) {
    const unsigned G = gridDim.x * gridDim.y * gridDim.z;
    unsigned sum, cnt, mine, sp = 0u;
    for (;;) {
        sum = 0u; cnt = 0u; mine = 0u;
#pragma unroll
        for (unsigned j = 0; j < 16; ++j) { const unsigned c = xb_ld(&bar[XB_XCNT(j)]); sum += c; cnt += (c > 0u) ? 1u : 0u; mine = (j == x) ? c : mine; }
        if (sum == G) break;
        __builtin_amdgcn_s_sleep(1);
        if ((++sp & 255u) == 0u) { if (xb_ld(&bar[XB_TMO])) break; if (sp > XB_SPIN_CAP) { atomicAdd(&bar[XB_TMO], 1u); break; } }
    }
    nloc = mine > 0u ? mine : 1u; nx = cnt > 0u ? cnt : 1u;
}

__device__ __forceinline__ void xcd_barrier(const XcdBarrier& b) {
    asm volatile("s_waitcnt vmcnt(0)" ::: "memory");
    __syncthreads();
    if (threadIdx.x == 0) {
        unsigned* bar = b.bar;
        __builtin_amdgcn_s_waitcnt(0);
        unsigned nloc = b.st[0], nx = b.st[1];
        if (nloc == 0u) { xcd_barrier_complete(bar, b.x, nloc, nx); b.st[0] = nloc; b.st[1] = nx; }
        const unsigned old = xb_add(&bar[XB_XSUB(b.x)], 1u);
        const unsigned gen = old / nloc;
        if (old + 1u == (gen + 1u) * nloc) {
            __builtin_amdgcn_fence(__ATOMIC_RELEASE, "agent");
            asm volatile("s_waitcnt vmcnt(0)" ::: "memory");
            const unsigned og = xb_add(&bar[XB_TOP], 1u);
            const unsigned tg = og / nx;
            if (og + 1u == (tg + 1u) * nx) xb_add(&bar[XB_TOPGEN], 1u);
            else XB_SPIN(xb_ld(&bar[XB_TOPGEN]) == tg, bar);
            __builtin_amdgcn_fence(__ATOMIC_ACQUIRE, "agent");
            xb_add(&bar[XB_XGEN(b.x)], 1u);
            asm volatile("s_waitcnt vmcnt(0)" ::: "memory");
        } else {
            XB_SPIN(xb_ld(&bar[XB_XGEN(b.x)]) == gen, bar);
            __builtin_amdgcn_fence(__ATOMIC_ACQUIRE, "agent");
            asm volatile("s_waitcnt vmcnt(0)" ::: "memory");
        }
    }
    __syncthreads();
}

namespace mk {
using pg8::bf16_t; using pg8::bf16x8; using pg8::f32x4; using pg8::u32x4;
typedef short s16x4 __attribute__((ext_vector_type(4)));
typedef unsigned u32x2 __attribute__((ext_vector_type(2)));
typedef __bf16 bf16x2v __attribute__((ext_vector_type(2)));
typedef int i32x4 __attribute__((ext_vector_type(4)));
#define DI __device__ __forceinline__

constexpr int D = 1024, SEQ = 4096, NTOK = 16384, DEPTH = 4, DIN = 13824;
constexpr int OFF_AQ = 0, OFF_AK = 1536, OFF_AV = 3072, OFF_LX = 4608, OFF_LG = 5632, OFF_RQ = 6656, OFF_RK = 7680, OFF_RV = 8704, OFF_RG = 9728, OFF_GA = 10752;
constexpr float ALPHA = 1.681792830507429f;
constexpr float LN_EPS = 1e-5f;
constexpr float X8_SCALE = 32.0f, W8_SCALE = 2048.0f, F8_MAX = 440.0f;
constexpr int NPH = 12;
constexpr int LDS_BYTES = 148 * 1024;
constexpr int LDS_BAR_OFF = LDS_BYTES - 16;

constexpr size_t WS_CTL  = 0;
constexpr size_t WS_COSA = 16384;
constexpr size_t WS_SINA = WS_COSA + (size_t)4096 * 64 * 4;
constexpr size_t WS_COSR = WS_SINA + (size_t)4096 * 64 * 4;
constexpr size_t WS_SINR = WS_COSR + (size_t)4096 * 128 * 4;
constexpr size_t WS_CCH  = WS_SINR + (size_t)4096 * 128 * 4;
constexpr size_t WS_WAT  = WS_CCH + 4096;
constexpr size_t WS_WXT  = WS_WAT + 131072;
constexpr size_t WS_LSTA = WS_WXT + 131072;
constexpr size_t WS_LSTH = WS_LSTA + 524288;
constexpr size_t WS_K1B  = WS_LSTH + 524288;
constexpr size_t WS_K2B  = WS_K1B + 262144;
constexpr size_t WS_XF   = WS_K2B + 262144;
constexpr size_t WS_XB   = WS_XF + (size_t)NTOK * D * 4;
constexpr size_t WS_WINT = WS_XB + (size_t)NTOK * D * 2;
constexpr size_t WS_WSC  = WS_WINT + (size_t)DIN * 1024;
constexpr size_t WS_X8   = WS_WSC + (size_t)DIN * 4 + 256 - ((size_t)DIN * 4) % 256;
constexpr size_t WS_XS   = WS_X8 + (size_t)NTOK * 1024;
constexpr size_t WS_WBAT = WS_XS + (size_t)NTOK * 4;
constexpr size_t WS_WBBT = WS_WBAT + (size_t)1024 * 512 * 2;
constexpr size_t WS_WBCT = WS_WBBT + (size_t)1024 * 1024 * 2;
constexpr size_t WS_WOT  = WS_WBCT + (size_t)1024 * 1024 * 2;
constexpr size_t WS_WQT  = WS_WOT + (size_t)1024 * 1024 * 2;
constexpr size_t WS_UV8  = WS_WQT + (size_t)2048 * 1024 * 2;
constexpr size_t WS_UVS  = WS_UV8 + (size_t)16384 * 2048;
constexpr size_t WS_PROJ = WS_UVS + (size_t)16384 * 8;
constexpr size_t WS_OATT = WS_PROJ + (size_t)NTOK * DIN * 2;
constexpr size_t WS_LSE  = WS_OATT + (size_t)NTOK * 1536 * 2;
constexpr size_t WS_KVB  = WS_LSE + (size_t)NTOK * 12 * 4;
constexpr size_t WS_YA   = WS_KVB + (size_t)16 * 32 * 65536 * 2;
constexpr size_t WS_YB   = WS_YA + (size_t)NTOK * 512 * 2;
constexpr size_t WS_YC   = WS_YB + (size_t)NTOK * 1024 * 2;
constexpr size_t WS_MRGF = WS_YC + (size_t)NTOK * 1024 * 2;
constexpr size_t WS_MRGB = WS_MRGF + (size_t)NTOK * 1024 * 4;
constexpr size_t WS_END  = WS_MRGB + (size_t)NTOK * 1024 * 2;
constexpr size_t WS_Q    = WS_PROJ;
constexpr size_t WS_EID  = WS_PROJ + (size_t)NTOK * 2048 * 2;
constexpr size_t WS_GATE = WS_EID + (size_t)NTOK * 128 * 4;
static_assert(WS_END <= (size_t)1073741824, "workspace too large");
static_assert(WS_PROJ % 256 == 0 && WS_KVB % 256 == 0 && WS_MRGF % 256 == 0, "alignment");

struct Args { const float* in[20]; float* out; unsigned char* ws; double ropeA, ropeR; int ph_lo, ph_hi; };

DI size_t pjo(size_t row, int col) { return ((size_t)(col >> 8) * NTOK + row) * 256 + (size_t)(col & 255); }
DI float bflo(unsigned w) { return __uint_as_float(w << 16); }
DI float bfhi(unsigned w) { return __uint_as_float(w & 0xffff0000u); }
DI float bf2f(bf16_t v) { return __uint_as_float(((unsigned)v) << 16); }
DI unsigned pk2(float lo, float hi) { return pg8::cvt_pk_bf16(lo, hi); }
DI bf16_t f2bf(float f) { return (bf16_t)(pk2(f, 0.f) & 0xffffu); }
DI f32x4 mfma16(bf16x8 a, bf16x8 b, f32x4 c) { return __builtin_amdgcn_mfma_f32_16x16x32_bf16(a, b, c, 0, 0, 0); }
DI s16x4 trrd(LAS unsigned char* p) { return __builtin_amdgcn_ds_read_tr16_b64_v4i16((LAS s16x4*)p); }
DI bf16x8 cat8(s16x4 lo, s16x4 hi) { return __builtin_shufflevector(lo, hi, 0, 1, 2, 3, 4, 5, 6, 7); }
DI float wsum(float v) { v += __shfl_xor(v, 32); v += __shfl_xor(v, 16); v += __shfl_xor(v, 8); v += __shfl_xor(v, 4); v += __shfl_xor(v, 2); v += __shfl_xor(v, 1); return v; }
DI float sigm(float x) { return __builtin_amdgcn_rcpf(1.f + __builtin_amdgcn_exp2f(x * -1.4426950408889634f)); }
DI float gelu_erf(float x) { return 0.5f * x * (1.f + erff(x * 0.70710678118654752f)); }
DI float dot2(unsigned w, unsigned x, float acc) { return __builtin_amdgcn_fdot2_f32_bf16(__builtin_bit_cast(bf16x2v, w), __builtin_bit_cast(bf16x2v, x), acc, false); }
DI float log2gamma(int h) { return log2f(1.0f - exp2f(-5.0f - (float)h)); }

#define MK_DPP_ADD(v, ctrl, rmask) v += __int_as_float(__builtin_amdgcn_update_dpp(0, __float_as_int(v), (ctrl), (rmask), 0xf, false))
DI float wsum_dpp(float v) {
    MK_DPP_ADD(v, 0xB1, 0xf); MK_DPP_ADD(v, 0x4E, 0xf); MK_DPP_ADD(v, 0x141, 0xf); MK_DPP_ADD(v, 0x140, 0xf);
    MK_DPP_ADD(v, 0x142, 0xa); MK_DPP_ADD(v, 0x143, 0xc);
    return __int_as_float(__builtin_amdgcn_readlane(__float_as_int(v), 63));
}
DI float gelu_as(float v) {
    const float av = fabsf(v), t = __builtin_amdgcn_rcpf(av * 0.2316418882f + 1.0f);
    float q = t * 0.5307027145f + (-0.7265760135f); q = q * t + 0.7107068705f; q = q * t + (-0.142248368f); q = q * t + 0.127414796f; q = q * t;
    const float e = __builtin_amdgcn_exp2f(v * v * (-0.72134752044f));
    const float m = v * (q * e);
    return v < 0.f ? m : v - m;
}
DI int wperm(int n) {
    if (n < 3072) { const int j = n & 127, bj = j >> 6, jj = j & 63; return (n & ~127) + 64 * (jj >> 5) + 32 * bj + (jj & 31); }
    if (n >= OFF_RQ && n < OFF_RV) { const int j = n & 255, bj = j >> 7, jj = j & 127; return (n & ~255) + 64 * (jj >> 5) + 32 * bj + (jj & 31); }
    return n;
}
template <bool WPERM>
DI void tconv_tile(const float* src, int ldsrc, bf16_t* dst, int lddst, int k0, int n0, LAS float* t, float mul = 1.0f) {
    const int tid = mk_tid();
#pragma unroll
    for (int i = 0; i < 8; ++i) { const int idx = tid + 512 * i, r = idx >> 6, c = idx & 63; t[r * 65 + c] = src[(size_t)(k0 + r) * ldsrc + n0 + c]; }
    __syncthreads();
#pragma unroll
    for (int i = 0; i < 8; ++i) { const int idx = tid + 512 * i, n = idx >> 6, k = idx & 63; const int nr = WPERM ? wperm(n0 + n) : (n0 + n); dst[(size_t)nr * lddst + k0 + k] = f2bf(t[k * 65 + n] * mul); }
    __syncthreads();
}
DI void conv_unit(const float* src, bf16_t* dst, int unit) {
    const size_t i = (size_t)unit * 4096 + (size_t)mk_tid() * 8;
    const f32x4 a = *(const f32x4*)(src + i), b = *(const f32x4*)(src + i + 4);
    u32x4 o; o.x = pk2(a[0], a[1]); o.y = pk2(a[2], a[3]); o.z = pk2(b[0], b[1]); o.w = pk2(b[2], b[3]);
    *(u32x4*)(dst + i) = o;
}
DI void w8_unit(const float* src, unsigned char* ws, int unit, LAS float* t) {
    const int tid = mk_tid(), n0 = unit * 64;
    unsigned char* dst = ws + WS_WINT;
#pragma unroll 1
    for (int k0 = 0; k0 < 1024; k0 += 64) {
#pragma unroll
        for (int i = 0; i < 8; ++i) { const int idx = tid + 512 * i, r = idx >> 6, cc = idx & 63; t[r * 65 + cc] = fminf(fmaxf(src[(size_t)(k0 + r) * DIN + n0 + cc] * W8_SCALE, -F8_MAX), F8_MAX); }
        __syncthreads();
#pragma unroll
        for (int i = 0; i < 2; ++i) { const int idx = tid + 512 * i, n = idx >> 4, k4 = idx & 15;
            int wd = __builtin_amdgcn_cvt_pk_fp8_f32(t[(4 * k4) * 65 + n], t[(4 * k4 + 1) * 65 + n], 0, false);
            wd = __builtin_amdgcn_cvt_pk_fp8_f32(t[(4 * k4 + 2) * 65 + n], t[(4 * k4 + 3) * 65 + n], wd, true);
            *(int*)(dst + (size_t)wperm(n0 + n) * 1024 + k0 + 4 * k4) = wd; }
        __syncthreads();
    }
}
DI void row_to_fp8(const f32x4 (&o)[4], unsigned char* x8row, int ln) {
    u32x4 w;
#pragma unroll
    for (int q = 0; q < 4; ++q) {
        const float a0 = fminf(fmaxf(o[q][0] * X8_SCALE, -F8_MAX), F8_MAX), a1 = fminf(fmaxf(o[q][1] * X8_SCALE, -F8_MAX), F8_MAX), a2 = fminf(fmaxf(o[q][2] * X8_SCALE, -F8_MAX), F8_MAX), a3 = fminf(fmaxf(o[q][3] * X8_SCALE, -F8_MAX), F8_MAX);
        int wd = __builtin_amdgcn_cvt_pk_fp8_f32(a0, a1, 0, false); wd = __builtin_amdgcn_cvt_pk_fp8_f32(a2, a3, wd, true); w[q] = (unsigned)wd; }
    *(u32x4*)(x8row + 16 * ln) = w;
}
typedef float f32x16 __attribute__((ext_vector_type(16)));
constexpr unsigned UVREC = 1024;
DI float wmax(float m) { m = fmaxf(m, __shfl_xor(m, 32)); m = fmaxf(m, __shfl_xor(m, 16)); m = fmaxf(m, __shfl_xor(m, 8)); m = fmaxf(m, __shfl_xor(m, 4)); m = fmaxf(m, __shfl_xor(m, 2)); m = fmaxf(m, __shfl_xor(m, 1)); return m; }
DI void conv_fp6_rows(const float* usrc, const float* vsrc, unsigned char* ws, int unit) {
    const int tid = mk_tid(), lane = tid & 63, w = tid >> 6;
    const size_t row = (size_t)unit * 8 + w;
    const float* up = usrc + row * 1024 + 16 * lane; const float* vp = vsrc + row * 1024 + 16 * lane;
    f32x16 a, b; float mu = 0.f, mv = 0.f;
#pragma unroll
    for (int q = 0; q < 4; ++q) { const f32x4 x = *(const f32x4*)(up + 4 * q), y = *(const f32x4*)(vp + 4 * q);
#pragma unroll
        for (int j = 0; j < 4; ++j) { a[4 * q + j] = x[j]; b[4 * q + j] = y[j]; mu = fmaxf(mu, fabsf(x[j])); mv = fmaxf(mv, fabsf(y[j])); } }
    mu = wmax(mu); mv = wmax(mv);
    const float su = (mu > 0.f) ? 6.0f / mu : 1.0f, sv = (mv > 0.f) ? 6.0f / mv : 1.0f;
    unsigned u0 = 0u, u1 = 0u, v0 = 0u, v1 = 0u;
#define MK_PK4(i) u0 = __builtin_amdgcn_cvt_scalef32_pk_fp4_f32(u0, a[2 * i] * su, a[2 * i + 1] * su, 1.0f, i); u1 = __builtin_amdgcn_cvt_scalef32_pk_fp4_f32(u1, a[8 + 2 * i] * su, a[8 + 2 * i + 1] * su, 1.0f, i); \
                  v0 = __builtin_amdgcn_cvt_scalef32_pk_fp4_f32(v0, b[2 * i] * sv, b[2 * i + 1] * sv, 1.0f, i); v1 = __builtin_amdgcn_cvt_scalef32_pk_fp4_f32(v1, b[8 + 2 * i] * sv, b[8 + 2 * i + 1] * sv, 1.0f, i);
    MK_PK4(0) MK_PK4(1) MK_PK4(2) MK_PK4(3)
#undef MK_PK4
    unsigned char* rec = ws + WS_UV8 + row * UVREC;
    *(u32x4*)(rec + 16 * lane) = (u32x4){u0, u1, v0, v1};
    if (lane == 0) { float* sp = (float*)(ws + WS_UVS) + row * 2; sp[0] = (mu > 0.f) ? mu * (1.0f / 6.0f) : 1.0f; sp[1] = (mv > 0.f) ? mv * (1.0f / 6.0f) : 1.0f; }
}
DI void phase_conv(const Args& a, int layer, LAS unsigned char* lds) {
    unsigned char* ws = a.ws;
    LAS float* t = (LAS float*)lds;
    const int J0 = 216, J1 = J0 + 128, J2 = J1 + 256, J3 = J2 + 256, J4 = J3 + 256, J5 = J4 + 512, J6 = J5 + 32, J7 = J6 + 2048, J8 = J7, J9 = J8 + 64, J10 = J9 + 1;
    const int total = J10;
    for (int u = blockIdx.x; u < total; u += gridDim.x) {
        if (u < J0) { w8_unit(a.in[1] + (size_t)layer * 1024 * DIN, ws, u, t); }
        else if (u < J1) { const int v = u - J0, kt = v / 16, nt = v % 16; tconv_tile<false>(a.in[9] + (size_t)layer * 2560 * 1024, 1024, (bf16_t*)(ws + WS_WBAT), 512, kt * 64, nt * 64, t); }
        else if (u < J2) { const int v = u - J1, kt = v / 16, nt = v % 16; tconv_tile<false>(a.in[9] + (size_t)layer * 2560 * 1024 + (size_t)512 * 1024, 1024, (bf16_t*)(ws + WS_WBBT), 1024, kt * 64, nt * 64, t); }
        else if (u < J3) { const int v = u - J2, kt = v / 16, nt = v % 16; tconv_tile<false>(a.in[9] + (size_t)layer * 2560 * 1024 + (size_t)1536 * 1024, 1024, (bf16_t*)(ws + WS_WBCT), 1024, kt * 64, nt * 64, t); }
        else if (u < J4) { const int v = u - J3, kt = v / 16, nt = v % 16; tconv_tile<false>(a.in[10] + (size_t)layer * 1024 * 1024, 1024, (bf16_t*)(ws + WS_WOT), 1024, kt * 64, nt * 64, t); }
        else if (u < J5) { const int v = u - J4, kt = v / 32, nt = v % 32; tconv_tile<false>(a.in[13] + (size_t)layer * 1024 * 2048, 2048, (bf16_t*)(ws + WS_WQT), 1024, kt * 64, nt * 64, t); }
        else if (u < J6) { const int v = u - J5, blk = v & 15, which = v >> 4;
            tconv_tile<false>(a.in[which ? 6 : 4] + ((size_t)layer * 16 + blk) * 4096, 64, (bf16_t*)(ws + (which ? WS_WXT : WS_WAT)) + blk * 4096, 64, 0, 0, t, -1.4426950408889634f); }
        else if (u < J7) { conv_fp6_rows(a.in[16] + (size_t)layer * 16384 * 1024, a.in[17] + (size_t)layer * 16384 * 1024, ws, u - J6); }
        else if (u < J9) { const int v = u - J8; if (v < 32) conv_unit(a.in[14] + (size_t)layer * 131072, (bf16_t*)(ws + WS_K1B), v); else conv_unit(a.in[15] + (size_t)layer * 131072, (bf16_t*)(ws + WS_K2B), v - 32); }
        else { for (int c = mk_tid(); c < 1024; c += 512) { const float lam = a.in[8][layer * 1024 + c]; const float e = __builtin_amdgcn_exp2f(-lam * 1.4426950408889634f); const float sp = (e < 0.05f) ? e * (1.0f + e * (-0.5f + e * (0.33333333f + e * -0.25f))) : __builtin_amdgcn_logf(1.0f + e) * 0.6931471805599453f; ((float*)(ws + WS_CCH))[c] = -8.0f * sp; } }
    }
}

DI void phase_prologue(const Args& a) {
    unsigned char* ws = a.ws;
    const int tid = mk_tid();
    for (int u = blockIdx.x; u < 2048; u += gridDim.x) {
        { const int ln = tid & 63; const size_t row = (size_t)u * 8 + (tid >> 6);
            const float* xp = a.in[0] + row * 1024 + 16 * ln; float* xo = (float*)(ws + WS_XF) + row * 1024 + 16 * ln;
            f32x4 o[4];
#pragma unroll
            for (int q = 0; q < 4; ++q) { o[q] = *(const f32x4*)(xp + 4 * q); *(f32x4*)(xo + 4 * q) = o[q]; }
            row_to_fp8(o, ws + WS_X8 + row * 1024, ln); }
    }
}

DI void attn_unit(const Args& a, int unit, LAS unsigned char* lds) {
    unsigned char* ws = a.ws;
    const int tid = mk_tid(), lane = tid & 63, w = __builtin_amdgcn_readfirstlane(tid >> 6), g = lane >> 4, l15 = lane & 15, tq4 = l15 >> 2, tp4 = l15 & 3;
    const int b = unit / 384, rem = unit % 384, h = rem >> 5, bi = rem & 31;
    const int grp = h >> 2, d = (grp == 0) ? 1 : ((grp == 1) ? 4 : 16), nb = 32 / d, r = bi / nb, n = bi % nb;
    const bf16_t* proj = (const bf16_t*)(ws + WS_PROJ); const size_t brow = (size_t)b * SEQ;
    LAS unsigned char* Ks = lds; LAS unsigned char* Vs = lds + 256 * 288;
#pragma unroll
    for (int i = 0; i < 8; ++i) {
        const int idx = tid + 512 * i, row = idx >> 4, ch = idx & 15, m = 128 * (n - 1) + row;
        u32x4 kv = {0u, 0u, 0u, 0u}, vv = {0u, 0u, 0u, 0u};
        if (m >= 0) { const size_t gr = brow + (size_t)(m * d + r); kv = *(const u32x4*)(proj + pjo(gr, OFF_AK + h * 128 + ch * 8)); vv = *(const u32x4*)(proj + pjo(gr, OFF_AV + h * 128 + ch * 8)); }
        *(LAS u32x4*)(Ks + row * 288 + ch * 16) = kv; *(LAS u32x4*)(Vs + row * 288 + ch * 16) = vv;
    }
    const int qi = 16 * w + l15;
    const size_t tq = (size_t)(128 * n + qi) * d + r;
    bf16x8 qf[4];
#pragma unroll
    for (int ks = 0; ks < 4; ++ks) qf[ks] = *(const bf16x8*)(proj + pjo(brow + tq, OFF_AQ + h * 128 + 32 * ks + 8 * g));
    __syncthreads();
    const int s0 = w >> 1;
    f32x4 sacc[10];
#pragma unroll
    for (int jj = 0; jj < 10; ++jj) {
        f32x4 acc = {0.f, 0.f, 0.f, 0.f};
#pragma unroll
        for (int ks = 0; ks < 4; ++ks) { const bf16x8 kf = *(const LAS bf16x8*)(Ks + (32 * s0 + 16 * jj + l15) * 288 + (32 * ks + 8 * g) * 2); acc = mfma16(kf, qf[ks], acc); }
        sacc[jj] = acc;
    }
    const float scale = 0.08838834764831845f * 1.4426950408889634f;
    float mx = -1e30f;
#pragma unroll
    for (int jj = 0; jj < 10; ++jj)
#pragma unroll
        for (int rg = 0; rg < 4; ++rg) {
            const int j = 32 * s0 + 16 * jj + 4 * g + rg;
            const bool valid = (j >= qi) && (j <= qi + 128) && (n > 0 || j >= 128);
            const float s = valid ? sacc[jj][rg] * scale : -1e30f;
            sacc[jj][rg] = s; mx = fmaxf(mx, s);
        }
    mx = fmaxf(mx, __shfl_xor(mx, 16)); mx = fmaxf(mx, __shfl_xor(mx, 32));
    float sum = 0.f;
#pragma unroll
    for (int jj = 0; jj < 10; ++jj)
#pragma unroll
        for (int rg = 0; rg < 4; ++rg) { const float p = __builtin_amdgcn_exp2f(sacc[jj][rg] - mx); sacc[jj][rg] = p; sum += p; }
    sum += __shfl_xor(sum, 16); sum += __shfl_xor(sum, 32);
    f32x4 oacc[8];
#pragma unroll
    for (int db = 0; db < 8; ++db) oacc[db] = (f32x4){0.f, 0.f, 0.f, 0.f};
#pragma unroll
    for (int s = 0; s < 5; ++s) {
        u32x4 pw; pw.x = pk2(sacc[2 * s][0], sacc[2 * s][1]); pw.y = pk2(sacc[2 * s][2], sacc[2 * s][3]); pw.z = pk2(sacc[2 * s + 1][0], sacc[2 * s + 1][1]); pw.w = pk2(sacc[2 * s + 1][2], sacc[2 * s + 1][3]);
        const bf16x8 pb = __builtin_bit_cast(bf16x8, pw);
        const int k0 = 32 * (s0 + s) + 4 * g + tq4;
#pragma unroll
        for (int db = 0; db < 8; ++db) {
            const s16x4 lo = trrd(Vs + k0 * 288 + (16 * db + 4 * tp4) * 2), hi = trrd(Vs + (k0 + 16) * 288 + (16 * db + 4 * tp4) * 2);
            oacc[db] = mfma16(cat8(lo, hi), pb, oacc[db]);
        }
    }
    const float inv = 1.0f / sum;
    bf16_t* op = (bf16_t*)(ws + WS_OATT) + ((size_t)b * SEQ + tq) * 1536 + h * 128 + 4 * g;
#pragma unroll
    for (int db = 0; db < 8; ++db) { u32x2 o; o.x = pk2(oacc[db][0] * inv, oacc[db][1] * inv); o.y = pk2(oacc[db][2] * inv, oacc[db][3] * inv); *(u32x2*)(op + 16 * db) = o; }
    if (g == 0) ((float*)(ws + WS_LSE))[((size_t)b * SEQ + tq) * 12 + h] = mx + __builtin_amdgcn_logf(sum);
    __syncthreads();
}

DI void retkv_unit(const Args& a, int unit, LAS unsigned char* lds) {
    unsigned char* ws = a.ws;
    const int tid = mk_tid(), lane = tid & 63, w = __builtin_amdgcn_readfirstlane(tid >> 6), g = lane >> 4, l15 = lane & 15, tq4 = l15 >> 2, tp4 = l15 & 3;
    const int b = unit >> 7, h = (unit >> 5) & 3, c = unit & 31;
    const bf16_t* proj = (const bf16_t*)(ws + WS_PROJ); const size_t brow = (size_t)b * SEQ + c * 128;
    LAS unsigned char* Ks = lds; LAS unsigned char* Vs = lds + 128 * 544;
    const float l2g = log2gamma(h);
#pragma unroll
    for (int i = 0; i < 8; ++i) {
        const int idx = tid + 512 * i, row = idx >> 5, ch = idx & 31;
        const u32x4 kv = *(const u32x4*)(proj + pjo(brow + row, OFF_RK + h * 256 + ch * 8)), vv = *(const u32x4*)(proj + pjo(brow + row, OFF_RV + h * 256 + ch * 8));
        const float z = exp2f((float)(127 - row) * l2g);
        u32x4 kz;
#pragma unroll
        for (int q = 0; q < 4; ++q) kz[q] = pk2(bflo(kv[q]) * z, bfhi(kv[q]) * z);
        *(LAS u32x4*)(Ks + row * 544 + ch * 16) = kz; *(LAS u32x4*)(Vs + row * 544 + ch * 16) = vv;
    }
    __syncthreads();
#pragma unroll 1
    for (int nh = 0; nh < 2; ++nh) {
        f32x4 acc[2][8];
#pragma unroll
        for (int mb = 0; mb < 2; ++mb)
#pragma unroll
            for (int nb = 0; nb < 8; ++nb) acc[mb][nb] = (f32x4){0.f, 0.f, 0.f, 0.f};
#pragma unroll
        for (int ks = 0; ks < 4; ++ks) {
            const int j0 = 32 * ks + 4 * g + tq4;
            bf16x8 af[2];
#pragma unroll
            for (int mb = 0; mb < 2; ++mb) { const int col = 32 * w + 16 * mb + 4 * tp4; af[mb] = cat8(trrd(Vs + j0 * 544 + col * 2), trrd(Vs + (j0 + 16) * 544 + col * 2)); }
#pragma unroll
            for (int nb = 0; nb < 8; ++nb) {
                const int col = 128 * nh + 16 * nb + 4 * tp4;
                const bf16x8 bfr = cat8(trrd(Ks + j0 * 544 + col * 2), trrd(Ks + (j0 + 16) * 544 + col * 2));
#pragma unroll
                for (int mb = 0; mb < 2; ++mb) acc[mb][nb] = mfma16(af[mb], bfr, acc[mb][nb]);
            }
        }
        bf16_t* kvb = (bf16_t*)(ws + WS_KVB) + ((size_t)((b * 4 + h) * 32 + c)) * 65536 + 128 * nh;
#pragma unroll
        for (int mb = 0; mb < 2; ++mb)
#pragma unroll
            for (int nb = 0; nb < 8; ++nb)
#pragma unroll
                for (int rg = 0; rg < 4; ++rg) kvb[(size_t)(32 * w + 16 * mb + 4 * g + rg) * 256 + 16 * nb + l15] = f2bf(acc[mb][nb][rg]);
    }
    __syncthreads();
}

DI void lru_stripe(const Args& a, int layer, int stripe, LAS unsigned char* lds) {
    unsigned char* ws = a.ws;
    const int tid = mk_tid(), lane = tid & 63, w = __builtin_amdgcn_readfirstlane(tid >> 6), g = lane >> 4, l15 = lane & 15;
    const int b = stripe >> 4, blk = stripe & 15;
    LAS bf16_t* lxs = (LAS bf16_t*)lds;
    LAS bf16_t* lgs0 = (LAS bf16_t*)(lds + 16896);
    LAS unsigned char* xcb = lds + 49664;
    LAS float* rgt = (LAS float*)(lds + 68096);
    LAS float* igt = (LAS float*)(lds + 100864);
    LAS float* wst = (LAS float*)(lds + 133632);
    const bf16_t* proj = (const bf16_t*)(ws + WS_PROJ); const size_t brow = (size_t)b * SEQ;
    const int gc = blk * 64 + lane;
    const float* cw = a.in[2] + (size_t)layer * 4096;
    const int cch_ = tid & 63, cgc = blk * 64 + cch_;
    const float cw0 = cw[cgc], cw1 = cw[1024 + cgc], cw2 = cw[2048 + cgc], cw3 = cw[3072 + cgc], cb = a.in[3][layer * 1024 + cgc];
    const float cc = ((const float*)(ws + WS_CCH))[gc] * 1.4426950408889634f;
    float bia[4], bix[4];
    LAS unsigned char* wlds = lds + 137728;
    { const int r = tid >> 3, c8 = tid & 7; *(LAS u32x4*)(wlds + r * 144 + c8 * 16) = *(const u32x4*)((const bf16_t*)(ws + WS_WAT) + blk * 4096 + r * 64 + c8 * 8); }
    bf16x8 wfx[4][2];
#pragma unroll
    for (int nb = 0; nb < 4; ++nb)
#pragma unroll
        for (int ks = 0; ks < 2; ++ks) wfx[nb][ks] = *(const bf16x8*)((const bf16_t*)(ws + WS_WXT) + blk * 4096 + (16 * nb + l15) * 64 + 32 * ks + 8 * g);
#pragma unroll
    for (int nb = 0; nb < 4; ++nb) { bia[nb] = -1.4426950408889634f * a.in[5][layer * 1024 + blk * 64 + 16 * nb + l15]; bix[nb] = -1.4426950408889634f * a.in[7][layer * 1024 + blk * 64 + 16 * nb + l15]; }
    if (tid < 24) *(LAS u32x4*)(lxs + tid * 8) = (u32x4){0u, 0u, 0u, 0u};
    u32x4 plx[2], plg[2];
#pragma unroll
    for (int i = 0; i < 2; ++i) { const int idx = tid + 512 * i, row = idx >> 3, c8 = idx & 7; plx[i] = *(const u32x4*)(proj + pjo(brow + row, OFF_LX + blk * 64 + c8 * 8)); plg[i] = *(const u32x4*)(proj + pjo(brow + row, OFF_LG + blk * 64 + c8 * 8)); }
    float hcarry = 0.0f;
#pragma unroll 1
    for (int c = 0; c < 32; ++c) {
        LAS bf16_t* lgs = lgs0 + (c & 1) * 8192;
#pragma unroll
        for (int i = 0; i < 2; ++i) { const int idx = tid + 512 * i, row = idx >> 3, c8 = idx & 7; *(LAS u32x4*)(lxs + (3 + row) * 64 + c8 * 8) = plx[i]; *(LAS u32x4*)(lgs + row * 64 + c8 * 8) = plg[i]; }
        __syncthreads();
        if (c + 1 < 32) {
#pragma unroll
            for (int i = 0; i < 2; ++i) { const int idx = tid + 512 * i, row = idx >> 3, c8 = idx & 7; const size_t gr = brow + (size_t)((c + 1) * 128 + row); plx[i] = *(const u32x4*)(proj + pjo(gr, OFF_LX + blk * 64 + c8 * 8)); plg[i] = *(const u32x4*)(proj + pjo(gr, OFF_LG + blk * 64 + c8 * 8)); }
        }
        {
            const int t0 = (tid >> 6) * 16;
            float x0 = bf2f(lxs[t0 * 64 + cch_]), x1 = bf2f(lxs[(t0 + 1) * 64 + cch_]), x2 = bf2f(lxs[(t0 + 2) * 64 + cch_]);
#pragma unroll
            for (int i = 0; i < 16; ++i) {
                const float x3 = bf2f(lxs[(t0 + i + 3) * 64 + cch_]);
                const float xc = cb + cw0 * x0 + cw1 * x1 + cw2 * x2 + cw3 * x3;
                *(LAS bf16_t*)(xcb + (t0 + i) * 144 + cch_ * 2) = f2bf(xc);
                x0 = x1; x1 = x2; x2 = x3;
            }
        }
        __syncthreads();
        if (tid < 24) *(LAS u32x4*)(lxs + tid * 8) = *(const LAS u32x4*)(lxs + 128 * 64 + tid * 8);
        {
            const bf16x8 af0 = *(const LAS bf16x8*)(xcb + (16 * w + l15) * 144 + (8 * g) * 2), af1 = *(const LAS bf16x8*)(xcb + (16 * w + l15) * 144 + (32 + 8 * g) * 2);
#pragma unroll
            for (int nb = 0; nb < 4; ++nb) {
                f32x4 ar = {0.f, 0.f, 0.f, 0.f}, ax = {0.f, 0.f, 0.f, 0.f};
                const LAS unsigned char* wr_ = wlds + (16 * nb + l15) * 144 + 16 * g;
                ar = mfma16(af0, *(const LAS bf16x8*)(wr_), ar); ar = mfma16(af1, *(const LAS bf16x8*)(wr_ + 64), ar);
                ax = mfma16(af0, wfx[nb][0], ax); ax = mfma16(af1, wfx[nb][1], ax);
#pragma unroll
                for (int rg = 0; rg < 4; ++rg) { rgt[(16 * w + 4 * g + rg) * 64 + 16 * nb + l15] = __builtin_amdgcn_rcpf(1.0f + __builtin_amdgcn_exp2f(ar[rg] + bia[nb])); igt[(16 * w + 4 * g + rg) * 64 + 16 * nb + l15] = __builtin_amdgcn_rcpf(1.0f + __builtin_amdgcn_exp2f(ax[rg] + bix[nb])); }
            }
        }
        __syncthreads();
        float av[16], bv[16]; float Aw = 1.0f, Hw = 0.0f;
#pragma unroll
        for (int tt = 0; tt < 16; ++tt) {
            const int t = 16 * w + tt;
            const float aa = __builtin_amdgcn_exp2f(cc * rgt[t * 64 + lane]);
            const float bb = __builtin_amdgcn_sqrtf(fmaxf(1.0f - aa * aa, 0.0f)) * igt[t * 64 + lane] * bf2f(*(const LAS bf16_t*)(xcb + t * 144 + lane * 2));
            av[tt] = aa; bv[tt] = bb; Hw = aa * Hw + bb; Aw *= aa;
        }
        wst[w * 64 + lane] = Aw; wst[512 + w * 64 + lane] = Hw;
        __syncthreads();
        float hcur = hcarry, hend = hcarry;
#pragma unroll
        for (int ww = 0; ww < 8; ++ww) { const float A_ = wst[ww * 64 + lane], H_ = wst[512 + ww * 64 + lane]; hend = A_ * hend + H_; if (ww < w) hcur = hend; }
        hcarry = hend;
        bf16_t* yb = (bf16_t*)(ws + WS_YB) + ((size_t)b * SEQ + c * 128 + 16 * w) * 1024 + gc;
#pragma unroll
        for (int tt = 0; tt < 16; tt += 2) {
            const float h0 = av[tt] * hcur + bv[tt]; hcur = av[tt + 1] * h0 + bv[tt + 1];
            yb[(size_t)tt * 1024] = f2bf(h0 * bf2f(lgs[(16 * w + tt) * 64 + lane])); yb[(size_t)(tt + 1) * 1024] = f2bf(hcur * bf2f(lgs[(16 * w + tt + 1) * 64 + lane]));
        }
    }
    __syncthreads();
}

DI void retscan_unit(const Args& a, int unit) {
    unsigned char* ws = a.ws;
    const int e8 = unit * 512 + mk_tid();
    const int bh = e8 >> 13, within = e8 & 8191, h = bh & 3;
    const float g128 = exp2f(128.0f * log2gamma(h));
    bf16_t* base = (bf16_t*)(ws + WS_KVB) + (size_t)bh * 32 * 65536 + (size_t)within * 8;
    float st[8];
#pragma unroll
    for (int q = 0; q < 8; ++q) st[q] = 0.f;
#pragma unroll 1
    for (int c0 = 0; c0 < 32; c0 += 8) {
        u32x4 kv[8];
#pragma unroll
        for (int q = 0; q < 8; ++q) kv[q] = *(const u32x4*)(base + (size_t)(c0 + q) * 65536);
#pragma unroll
        for (int q = 0; q < 8; ++q) {
            u32x4 o;
#pragma unroll
            for (int j = 0; j < 4; ++j) o[j] = pk2(st[2 * j], st[2 * j + 1]);
            *(u32x4*)(base + (size_t)(c0 + q) * 65536) = o;
#pragma unroll
            for (int j = 0; j < 4; ++j) { st[2 * j] = g128 * st[2 * j] + bflo(kv[q][j]); st[2 * j + 1] = g128 * st[2 * j + 1] + bfhi(kv[q][j]); }
        }
    }
}

DI void attmerge_unit(const Args& a, int unit) {
    unsigned char* ws = a.ws;
    const int idx = unit * 512 + mk_tid(), t = idx >> 6, hp = (idx >> 4) & 3, dc = idx & 15;
    const float* lse = (const float*)(ws + WS_LSE) + (size_t)t * 12;
    const float l0 = lse[hp], l1 = lse[4 + hp], l2 = lse[8 + hp];
    const float m = fmaxf(l0, fmaxf(l1, l2));
    float w0 = __builtin_amdgcn_exp2f(l0 - m), w1 = __builtin_amdgcn_exp2f(l1 - m), w2 = __builtin_amdgcn_exp2f(l2 - m);
    const float is = 1.0f / (w0 + w1 + w2); w0 *= is; w1 *= is; w2 *= is;
    const bf16_t* o = (const bf16_t*)(ws + WS_OATT) + (size_t)t * 1536 + hp * 128 + dc * 8;
    const u32x4 a0 = *(const u32x4*)o, a1 = *(const u32x4*)(o + 512), a2 = *(const u32x4*)(o + 1024);
    u32x4 r;
#pragma unroll
    for (int q = 0; q < 4; ++q) r[q] = pk2(w0 * bflo(a0[q]) + w1 * bflo(a1[q]) + w2 * bflo(a2[q]), w0 * bfhi(a0[q]) + w1 * bfhi(a1[q]) + w2 * bfhi(a2[q]));
    *(u32x4*)((bf16_t*)(ws + WS_YA) + (size_t)t * 512 + hp * 128 + dc * 8) = r;
}

DI void retout_unit(const Args& a, int unit, LAS unsigned char* lds) {
    unsigned char* ws = a.ws;
    const int tid = mk_tid(), lane = tid & 63, w = __builtin_amdgcn_readfirstlane(tid >> 6), g = lane >> 4, l15 = lane & 15, tq4 = l15 >> 2, tp4 = l15 & 3;
    const int b = unit >> 7, h = (unit >> 5) & 3, c = unit & 31;
    const bf16_t* proj = (const bf16_t*)(ws + WS_PROJ); const size_t brow = (size_t)b * SEQ + c * 128;
    const bf16_t* rt = (const bf16_t*)(ws + WS_KVB) + ((size_t)((b * 4 + h) * 32 + c)) * 65536;
    LAS unsigned char* RA = lds; LAS unsigned char* RB = lds + 128 * 544;
    const float l2g = log2gamma(h);
    const int qi = 16 * w + l15;
    bf16x8 qf[8];
#pragma unroll
    for (int ks = 0; ks < 8; ++ks) qf[ks] = *(const bf16x8*)(proj + pjo(brow + qi, OFF_RQ + h * 256 + 32 * ks + 8 * g));
#pragma unroll
    for (int i = 0; i < 8; ++i) {
        const int idx = tid + 512 * i, row = idx >> 5, ch = idx & 31;
        *(LAS u32x4*)(RA + row * 544 + ch * 16) = *(const u32x4*)(proj + pjo(brow + row, OFF_RK + h * 256 + ch * 8));
        *(LAS u32x4*)(RB + row * 544 + ch * 16) = *(const u32x4*)(rt + (size_t)row * 256 + ch * 8);
    }
    __syncthreads();
    u32x4 pv[8], pr[8];
#pragma unroll
    for (int i = 0; i < 8; ++i) {
        const int idx = tid + 512 * i, row = idx >> 5, ch = idx & 31;
        pv[i] = *(const u32x4*)(proj + pjo(brow + row, OFF_RV + h * 256 + ch * 8));
        pr[i] = *(const u32x4*)(rt + (size_t)(128 + row) * 256 + ch * 8);
    }
    f32x4 sacc[8], oacc[16];
#pragma unroll
    for (int jj = 0; jj < 8; ++jj) {
        f32x4 acc = {0.f, 0.f, 0.f, 0.f};
        if (jj <= w) {
#pragma unroll
            for (int ks = 0; ks < 8; ++ks) { const bf16x8 kf = *(const LAS bf16x8*)(RA + (16 * jj + l15) * 544 + (32 * ks + 8 * g) * 2); acc = mfma16(kf, qf[ks], acc); }
        }
        sacc[jj] = acc;
    }
#pragma unroll
    for (int db = 0; db < 8; ++db) {
        f32x4 acc = {0.f, 0.f, 0.f, 0.f};
#pragma unroll
        for (int ks = 0; ks < 8; ++ks) { const bf16x8 rf = *(const LAS bf16x8*)(RB + (16 * db + l15) * 544 + (32 * ks + 8 * g) * 2); acc = mfma16(rf, qf[ks], acc); }
        oacc[db] = acc;
    }
    __syncthreads();
#pragma unroll
    for (int i = 0; i < 8; ++i) {
        const int idx = tid + 512 * i, row = idx >> 5, ch = idx & 31;
        *(LAS u32x4*)(RA + row * 544 + ch * 16) = pv[i];
        *(LAS u32x4*)(RB + row * 544 + ch * 16) = pr[i];
    }
    __syncthreads();
#pragma unroll
    for (int db = 0; db < 8; ++db) {
        f32x4 acc = {0.f, 0.f, 0.f, 0.f};
#pragma unroll
        for (int ks = 0; ks < 8; ++ks) { const bf16x8 rf = *(const LAS bf16x8*)(RB + (16 * db + l15) * 544 + (32 * ks + 8 * g) * 2); acc = mfma16(rf, qf[ks], acc); }
        oacc[8 + db] = acc;
    }
    const float xi = __builtin_amdgcn_exp2f((float)(qi + 1) * l2g);
#pragma unroll
    for (int db = 0; db < 16; ++db) oacc[db] = oacc[db] * xi;
#pragma unroll
    for (int jj = 0; jj < 8; ++jj)
#pragma unroll
        for (int rg = 0; rg < 4; ++rg) { const int j = 16 * jj + 4 * g + rg; sacc[jj][rg] = (qi >= j) ? sacc[jj][rg] * __builtin_amdgcn_exp2f((float)(qi - j) * l2g) : 0.f; }
#pragma unroll
    for (int s = 0; s < 4; ++s) {
        if (2 * s <= w) {
            u32x4 pw; pw.x = pk2(sacc[2 * s][0], sacc[2 * s][1]); pw.y = pk2(sacc[2 * s][2], sacc[2 * s][3]); pw.z = pk2(sacc[2 * s + 1][0], sacc[2 * s + 1][1]); pw.w = pk2(sacc[2 * s + 1][2], sacc[2 * s + 1][3]);
            const bf16x8 pb = __builtin_bit_cast(bf16x8, pw);
            const int k0 = 32 * s + 4 * g + tq4;
#pragma unroll
            for (int db = 0; db < 16; ++db) {
                const s16x4 lo = trrd(RA + k0 * 544 + (16 * db + 4 * tp4) * 2), hi = trrd(RA + (k0 + 16) * 544 + (16 * db + 4 * tp4) * 2);
                oacc[db] = mfma16(cat8(lo, hi), pb, oacc[db]);
            }
        }
    }
    float s1 = 0.f;
#pragma unroll
    for (int db = 0; db < 16; ++db) s1 += (oacc[db][0] + oacc[db][1]) + (oacc[db][2] + oacc[db][3]);
    s1 += __shfl_xor(s1, 16); s1 += __shfl_xor(s1, 32);
    const float mean = s1 * (1.0f / 256.0f);
    float s2 = 0.f;
#pragma unroll
    for (int db = 0; db < 16; ++db)
#pragma unroll
        for (int rg = 0; rg < 4; ++rg) { const float dd = oacc[db][rg] - mean; s2 += dd * dd; }
    s2 += __shfl_xor(s2, 16); s2 += __shfl_xor(s2, 32);
    const float rstd = rsqrtf(s2 * (1.0f / 256.0f) + LN_EPS);
    __syncthreads();
#pragma unroll
    for (int db = 0; db < 16; ++db) {
        u32x2 o; o.x = pk2((oacc[db][0] - mean) * rstd, (oacc[db][1] - mean) * rstd); o.y = pk2((oacc[db][2] - mean) * rstd, (oacc[db][3] - mean) * rstd);
        *(LAS u32x2*)(RA + qi * 528 + (16 * db + 4 * g) * 2) = o;
    }
    __syncthreads();
#pragma unroll
    for (int i = 0; i < 8; ++i) {
        const int idx = tid + 512 * i, row = idx >> 5, ch = idx & 31;
        const u32x4 nv = *(const LAS u32x4*)(RA + row * 528 + ch * 16);
        const u32x4 gw = *(const u32x4*)(proj + pjo(brow + row, OFF_RG + h * 256 + ch * 8));
        u32x4 o;
#pragma unroll
        for (int q = 0; q < 4; ++q) { const float g0 = bflo(gw[q]), g1 = bfhi(gw[q]); o[q] = pk2(g0 * sigm(g0) * bflo(nv[q]), g1 * sigm(g1) * bfhi(nv[q])); }
        *(u32x4*)((bf16_t*)(ws + WS_YC) + ((size_t)b * SEQ + c * 128 + row) * 1024 + h * 256 + ch * 8) = o;
    }
    __syncthreads();
}

struct EpiBranch {
    static constexpr bool PERM = false, AFTER_DRAIN = false;
    const bf16_t* gate; int gcol; bf16_t* mf; bf16_t* mb; int mode;
    __device__ __forceinline__ void operator()(const f32x4 (&acc)[2][2][4][2], const pg8::Unit& u, int wr, int wc, int fr, int fq) const {
        const int row0 = u.pm * 256 + wr * 64 + fr, col0 = u.pn * 256 + wc * 32 + 4 * fq;
        bf16_t* dst = (mode == 2) ? mb : mf;
#pragma unroll
        for (int ai = 0; ai < 2; ++ai) {
            u32x2 gw[4][2][2], old[4][2][2];
#pragma unroll
            for (int m = 0; m < 4; ++m) { const size_t row = (size_t)(row0 + ai * 128 + m * 16);
#pragma unroll
                for (int bj = 0; bj < 2; ++bj)
#pragma unroll
                    for (int n = 0; n < 2; ++n) { const int col = col0 + bj * 128 + n * 16;
                        gw[m][bj][n] = *(const u32x2*)(gate + pjo(row, gcol + col));
                        old[m][bj][n] = (mode != 0) ? *(const u32x2*)(mf + row * 1024 + col) : (u32x2){0u, 0u}; } }
#pragma unroll
            for (int m = 0; m < 4; ++m) { const size_t row = (size_t)(row0 + ai * 128 + m * 16);
#pragma unroll
                for (int bj = 0; bj < 2; ++bj)
#pragma unroll
                    for (int n = 0; n < 2; ++n) { const int col = col0 + bj * 128 + n * 16;
                        const u32x2 g2 = gw[m][bj][n], o2 = old[m][bj][n];
                        f32x4 v = acc[ai][bj][m][n];
                        v[0] = v[0] * sigm(bflo(g2.x)) + bflo(o2.x); v[1] = v[1] * sigm(bfhi(g2.x)) + bfhi(o2.x);
                        v[2] = v[2] * sigm(bflo(g2.y)) + bflo(o2.y); v[3] = v[3] * sigm(bfhi(g2.y)) + bfhi(o2.y);
                        u32x2 o; o.x = pk2(v[0], v[1]); o.y = pk2(v[2], v[3]); *(u32x2*)(dst + row * 1024 + col) = o; } }
        }
    }
};
#ifndef MK_EPI_AUX
#define MK_EPI_AUX 0
#endif
struct EpiInProj {
    static constexpr bool PERM = true, AFTER_DRAIN = false;
    bf16_t* O;
    __device__ __forceinline__ void operator()(const f32x4 (&acc)[2][2][4][2], const pg8::Unit& u, int wr_, int wc_, int fr_, int fq_) const {
        (void)wr_; (void)wc_; (void)fr_; (void)fq_;
        const int tid = mk_tid(), wid = tid >> 6, lane = tid & 63, wr = wid >> 2, wc = wid & 3, fr = lane & 15, fq = lane >> 4;
        const __amdgpu_buffer_rsrc_t rsrc = __builtin_amdgcn_make_buffer_rsrc((void*)O, 0, (int)((size_t)NTOK * DIN * 2), 0x00020000);
        const int row0 = u.pm * 256 + wr * 64 + fr;
        const int pn = u.pn;
        const bool ropeA = pn < 12, ropeR = (pn >= 26 && pn < 34);
        const float dsc = 1.0f / (X8_SCALE * W8_SCALE);
        if (!(ropeA || ropeR)) {
            const int col0 = pn * 256 + 64 * wc + 8 * fq;
            const bool isLG = (pn >= 22 && pn < 26);
#pragma unroll
            for (int ai = 0; ai < 2; ++ai) {
#pragma unroll
                for (int m = 0; m < 4; ++m) { const unsigned roff = (unsigned)(pjo((size_t)(row0 + ai * 128 + m * 16), col0) * 2);
#pragma unroll
                    for (int bj = 0; bj < 2; ++bj) { f32x4 v0 = acc[ai][bj][m][0] * dsc, v1 = acc[ai][bj][m][1] * dsc;
                        if (isLG) { const pg8::f32x2 g0 = pg8::gelu_pk((pg8::f32x2){v0[0], v0[1]}), g1 = pg8::gelu_pk((pg8::f32x2){v0[2], v0[3]}), g2 = pg8::gelu_pk((pg8::f32x2){v1[0], v1[1]}), g3 = pg8::gelu_pk((pg8::f32x2){v1[2], v1[3]});
                            v0 = (f32x4){g0.x, g0.y, g1.x, g1.y}; v1 = (f32x4){g2.x, g2.y, g3.x, g3.y}; }
                        u32x4 w; w.x = pk2(v0[0], v0[1]); w.y = pk2(v0[2], v0[3]); w.z = pk2(v1[0], v1[1]); w.w = pk2(v1[2], v1[3]);
                        __builtin_amdgcn_raw_buffer_store_b128(w, rsrc, (int)(roff + bj * 64), 0, MK_EPI_AUX); } }
            }
        } else {
            const int half = ropeA ? 64 : 128;
            const float sc = dsc * ((pn >= 30 && pn < 34) ? 0.0625f : 1.0f);
            const float kf = ropeA ? (-13.287712379549449f / 64.0f) : (-13.287712379549449f / 128.0f);
            const float pos0 = (float)(row0 & (SEQ - 1));
            const int j0 = ropeA ? (32 * (wc & 1) + 8 * fq) : (32 * wc + 8 * fq);
            const int lcol = ropeA ? (128 * (wc >> 1) + j0) : j0;
            float cb[8], sb[8], c16[8], s16[8], cb1[8], sb1[8];
#pragma unroll
            for (int i = 0; i < 8; ++i) {
                const float f = __builtin_amdgcn_exp2f((float)(j0 + i) * kf) * 0.15915494309189535f;
                const float t0 = __builtin_amdgcn_fractf(pos0 * f), t16 = __builtin_amdgcn_fractf(16.0f * f), t128 = __builtin_amdgcn_fractf(128.0f * f);
                cb[i] = __builtin_amdgcn_cosf(t0); sb[i] = __builtin_amdgcn_sinf(t0);
                c16[i] = __builtin_amdgcn_cosf(t16); s16[i] = __builtin_amdgcn_sinf(t16);
                const float c128 = __builtin_amdgcn_cosf(t128), s128 = __builtin_amdgcn_sinf(t128);
                cb1[i] = cb[i] * c128 - sb[i] * s128; sb1[i] = sb[i] * c128 + cb[i] * s128;
            }
#pragma unroll
            for (int ai = 0; ai < 2; ++ai) {
                float cv[8], sv[8];
#pragma unroll
                for (int i = 0; i < 8; ++i) { cv[i] = ai ? cb1[i] : cb[i]; sv[i] = ai ? sb1[i] : sb[i]; }
#pragma unroll
                for (int m = 0; m < 4; ++m) {
                    const int row = row0 + ai * 128 + m * 16;
                    const unsigned roff = (unsigned)(pjo((size_t)row, pn * 256 + lcol) * 2);
                    float o1[8], o2[8];
#pragma unroll
                    for (int i = 0; i < 8; ++i) { const float t1 = acc[ai][0][m][i >> 2][i & 3] * sc, t2 = acc[ai][1][m][i >> 2][i & 3] * sc; o1[i] = t1 * cv[i] - t2 * sv[i]; o2[i] = t1 * sv[i] + t2 * cv[i]; }
                    u32x4 w1, w2;
#pragma unroll
                    for (int q = 0; q < 4; ++q) { w1[q] = pk2(o1[2 * q], o1[2 * q + 1]); w2[q] = pk2(o2[2 * q], o2[2 * q + 1]); }
                    __builtin_amdgcn_raw_buffer_store_b128(w1, rsrc, (int)roff, 0, MK_EPI_AUX);
                    __builtin_amdgcn_raw_buffer_store_b128(w2, rsrc, (int)(roff + half * 2), 0, MK_EPI_AUX);
                    if (m < 3) {
#pragma unroll
                        for (int i = 0; i < 8; ++i) { const float cn = cv[i] * c16[i] - sv[i] * s16[i], sn = sv[i] * c16[i] + cv[i] * s16[i]; cv[i] = cn; sv[i] = sn; } }
                }
            }
        }
    }
};

struct EpiOut {
    static constexpr bool PERM = false, AFTER_DRAIN = false;
    const float* xf; float* z;
    __device__ __forceinline__ void operator()(const f32x4 (&acc)[2][2][4][2], const pg8::Unit& u, int wr, int wc, int fr, int fq) const {
        const int row0 = u.pm * 256 + wr * 64 + fr, col0 = u.pn * 256 + wc * 32 + 4 * fq;
#pragma unroll
        for (int ai = 0; ai < 2; ++ai) {
            f32x4 xv[4][2][2];
#pragma unroll
            for (int m = 0; m < 4; ++m) { const size_t row = (size_t)(row0 + ai * 128 + m * 16);
#pragma unroll
                for (int bj = 0; bj < 2; ++bj)
#pragma unroll
                    for (int n = 0; n < 2; ++n) xv[m][bj][n] = *(const f32x4*)(xf + row * 1024 + col0 + bj * 128 + n * 16); }
#pragma unroll
            for (int m = 0; m < 4; ++m) { const size_t row = (size_t)(row0 + ai * 128 + m * 16);
#pragma unroll
                for (int bj = 0; bj < 2; ++bj)
#pragma unroll
                    for (int n = 0; n < 2; ++n) *(f32x4*)(z + row * 1024 + col0 + bj * 128 + n * 16) = xv[m][bj][n] * ALPHA + acc[ai][bj][m][n]; }
        }
    }
};

DI void ln_row(const float* z, const float* gam, const float* bet, float* of, bf16_t* ob, int lane) {
    f32x4 v[4]; float s = 0.f;
#pragma unroll
    for (int i = 0; i < 4; ++i) { v[i] = *(const f32x4*)(z + 256 * i + 4 * lane); s += (v[i][0] + v[i][1]) + (v[i][2] + v[i][3]); }
    const float mean = wsum(s) * (1.0f / 1024.0f);
    float q = 0.f;
#pragma unroll
    for (int i = 0; i < 4; ++i)
#pragma unroll
        for (int j = 0; j < 4; ++j) { const float d = v[i][j] - mean; q += d * d; }
    const float rstd = rsqrtf(wsum(q) * (1.0f / 1024.0f) + LN_EPS);
#pragma unroll
    for (int i = 0; i < 4; ++i) {
        const f32x4 gg = *(const f32x4*)(gam + 256 * i + 4 * lane), bb = *(const f32x4*)(bet + 256 * i + 4 * lane);
        f32x4 o;
#pragma unroll
        for (int j = 0; j < 4; ++j) o[j] = (v[i][j] - mean) * rstd * gg[j] + bb[j];
        *(f32x4*)(of + 256 * i + 4 * lane) = o;
        u32x2 pb; pb.x = pk2(o[0], o[1]); pb.y = pk2(o[2], o[3]); *(u32x2*)(ob + 256 * i + 4 * lane) = pb;
    }
}
DI void phase_ln1(const Args& a, int layer) {
    unsigned char* ws = a.ws;
    const int lane = mk_tid() & 63, w = mk_tid() >> 6;
    for (int u = blockIdx.x; u < NTOK / 8; u += gridDim.x) {
        const size_t row = (size_t)u * 8 + w;
        ln_row((const float*)(ws + WS_MRGF) + row * 1024, a.in[11] + layer * 1024, a.in[12] + layer * 1024, (float*)(ws + WS_XF) + row * 1024, (bf16_t*)(ws + WS_XB) + row * 1024, lane);
    }
}

DI void ins16(float (&L)[16], float x) {
#pragma unroll
    for (int k = 0; k < 16; ++k) { const float hi = fmaxf(L[k], x); x = fminf(L[k], x); L[k] = hi; }
}
DI void merge16(float (&L)[16], int xr) {
    float t[16];
#pragma unroll
    for (int k = 0; k < 16; ++k) t[k] = __shfl_xor(L[k], xr);
#pragma unroll
    for (int k = 0; k < 8; ++k) { const float x = t[k]; t[k] = t[15 - k]; t[15 - k] = x; }
#pragma unroll
    for (int k = 0; k < 16; ++k) t[k] = fmaxf(L[k], t[k]);
#define MK_CE_STAGE(dd) _Pragma("unroll") for (int k = 0; k < 16; ++k) if ((k & (dd)) == 0) { const float hi = fmaxf(t[k], t[k + (dd)]), lo = fminf(t[k], t[k + (dd)]); t[k] = hi; t[k + (dd)] = lo; }
    MK_CE_STAGE(8) MK_CE_STAGE(4) MK_CE_STAGE(2) MK_CE_STAGE(1)
#undef MK_CE_STAGE
#pragma unroll
    for (int k = 0; k < 16; ++k) L[k] = t[k];
}
#define MK_CE_DESC(v, i, l) { const float hi_ = fmaxf(v[i], v[l]), lo_ = fminf(v[i], v[l]); v[i] = hi_; v[l] = lo_; }
#define MK_CE_ASC(v, i, l)  { const float hi_ = fmaxf(v[i], v[l]), lo_ = fminf(v[i], v[l]); v[i] = lo_; v[l] = hi_; }
#define MK_BITONIC_STAGE(v, kk, jj) _Pragma("unroll") for (int i_ = 0; i_ < 16; ++i_) { if ((i_ & (jj)) == 0) { if ((i_ & (kk)) == 0) MK_CE_DESC(v, i_, i_ + (jj)) else MK_CE_ASC(v, i_, i_ + (jj)) } }
DI void sort16_desc(float (&v)[16]) {
    MK_BITONIC_STAGE(v, 2, 1)
    MK_BITONIC_STAGE(v, 4, 2) MK_BITONIC_STAGE(v, 4, 1)
    MK_BITONIC_STAGE(v, 8, 4) MK_BITONIC_STAGE(v, 8, 2) MK_BITONIC_STAGE(v, 8, 1)
    MK_BITONIC_STAGE(v, 16, 8) MK_BITONIC_STAGE(v, 16, 4) MK_BITONIC_STAGE(v, 16, 2) MK_BITONIC_STAGE(v, 16, 1)
}
DI void top16_of_two(float (&a)[16], const float (&b)[16]) {
#pragma unroll
    for (int k = 0; k < 16; ++k) a[k] = fmaxf(a[k], b[15 - k]);
    MK_BITONIC_STAGE(a, 16, 8) MK_BITONIC_STAGE(a, 16, 4) MK_BITONIC_STAGE(a, 16, 2) MK_BITONIC_STAGE(a, 16, 1)
}
DI void top16_half(const bf16_t* qp, const LAS unsigned char* kt, float (&L)[16], int g, int l15) {
    bf16x8 qf[4];
#pragma unroll
    for (int ks = 0; ks < 4; ++ks) qf[ks] = *(const bf16x8*)(qp + 32 * ks + 8 * g);
    float M[16];
#pragma unroll
    for (int kbk = 0; kbk < 8; ++kbk) {
        f32x4 acc = {0.f, 0.f, 0.f, 0.f};
#pragma unroll
        for (int ks = 0; ks < 4; ++ks) { const bf16x8 kf = *(const LAS bf16x8*)(kt + (16 * kbk + l15) * 256 + (((4 * ks + g) ^ l15) << 4)); acc = mfma16(kf, qf[ks], acc); }
#pragma unroll
        for (int rg = 0; rg < 4; ++rg) { const unsigned key = (unsigned)(16 * kbk + 4 * g + rg); const float x = __uint_as_float((__float_as_uint(acc[rg]) & ~0x7Fu) | key);
            if (kbk < 4) L[4 * kbk + rg] = x; else M[4 * (kbk - 4) + rg] = x; }
    }
    sort16_desc(L); sort16_desc(M); top16_of_two(L, M);
    merge16(L, 16); merge16(L, 32);
}
DI void topk_unit(const Args& a, int unit, LAS unsigned char* lds) {
    unsigned char* ws = a.ws;
    const int tid = mk_tid(), lane = tid & 63, w = __builtin_amdgcn_readfirstlane(tid >> 6), g = lane >> 4, l15 = lane & 15;
    const int tg = w & 3, hs = w >> 2;
    const size_t t = (size_t)unit * 64 + tg * 16 + l15;
    const bf16_t* Q = (const bf16_t*)(ws + WS_Q);
    LAS unsigned char* tiles = lds + 16384;
    float K1[16], K2[16];
#pragma unroll
    for (int k = 0; k < 16; ++k) { K1[k] = 0.f; K2[k] = 0.f; }
#pragma unroll 1
    for (int hh = 0; hh < 4; ++hh) {
#pragma unroll
        for (int i = 0; i < 16; ++i) {
            const int idx = tid + 512 * i, tile = idx >> 11, row = (idx >> 4) & 127, ch = idx & 15;
            const int hd = ((tile >> 1) ? 4 : 0) + hh;
            const bf16_t* src = (const bf16_t*)(ws + ((tile & 1) ? WS_K2B : WS_K1B)) + ((size_t)hd * 128 + row) * 128 + ch * 8;
            *(LAS u32x4*)(tiles + tile * 32768 + row * 256 + ((ch ^ (row & 15)) << 4)) = *(const u32x4*)src;
        }
        __syncthreads();
        const int h = hs * 4 + hh;
        float l1[16], l2[16];
        top16_half(Q + t * 2048 + h * 256, tiles + (hs * 2) * 32768, l1, g, l15);
        top16_half(Q + t * 2048 + h * 256 + 128, tiles + (hs * 2 + 1) * 32768, l2, g, l15);
        const bool mine = (g == hh);
#pragma unroll
        for (int k = 0; k < 16; ++k) { K1[k] = mine ? l1[k] : K1[k]; K2[k] = mine ? l2[k] : K2[k]; }
        __syncthreads();
    }
    const int h = hs * 4 + g;
    float F[16];
#pragma unroll
    for (int k = 0; k < 16; ++k) F[k] = -FLT_MAX;
#pragma unroll
    for (int ia = 0; ia < 16; ++ia)
#pragma unroll
        for (int ib = 0; ib < 16 / (ia + 1); ++ib) {
            const float s = __uint_as_float(__float_as_uint(K1[ia]) & ~0x7Fu) + __uint_as_float(__float_as_uint(K2[ib]) & ~0x7Fu);
            ins16(F, __uint_as_float((__float_as_uint(s) & ~0xFFu) | (unsigned)(ia * 16 + ib)));
        }
    LAS unsigned char* row = lds + tid * 32;
#pragma unroll
    for (int k = 0; k < 16; ++k) { row[k] = (unsigned char)(__float_as_uint(K1[k]) & 0x7Fu); row[16 + k] = (unsigned char)(__float_as_uint(K2[k]) & 0x7Fu); }
    float gt[16]; int ei[16]; float gs = 0.f;
    const float cv0 = __uint_as_float(__float_as_uint(F[0]) & ~0xFFu);
#pragma unroll
    for (int k = 0; k < 16; ++k) {
        const unsigned bits = __float_as_uint(F[k]);
        const float cv = __uint_as_float(bits & ~0xFFu);
        gt[k] = __builtin_amdgcn_exp2f((cv - cv0) * 1.4426950408889634f); gs += gt[k];
        const int ia = (int)((bits >> 4) & 15u), ib = (int)(bits & 15u);
        ei[k] = (int)row[ia] * 128 + (int)row[16 + ib];
    }
    const float ig = 1.0f / gs;
    int* ep = (int*)(ws + WS_EID) + (t * 8 + h) * 16; float* gp = (float*)(ws + WS_GATE) + (t * 8 + h) * 16;
#pragma unroll
    for (int q = 0; q < 4; ++q) {
        *(i32x4*)(ep + 4 * q) = (i32x4){ei[4 * q], ei[4 * q + 1], ei[4 * q + 2], ei[4 * q + 3]};
        *(f32x4*)(gp + 4 * q) = (f32x4){gt[4 * q] * ig, gt[4 * q + 1] * ig, gt[4 * q + 2] * ig, gt[4 * q + 3] * ig};
    }
    __syncthreads();
}

typedef float f32x2 __attribute__((ext_vector_type(2)));
typedef __bf16 bf16x32 __attribute__((ext_vector_type(32)));
typedef unsigned u32x16 __attribute__((ext_vector_type(16)));
#define MK_PB_LOAD(RA_, ereg, kb) _Pragma("unroll") for (int j = 0; j < 8; ++j) { const int e_ = __builtin_amdgcn_readlane(ereg, (kb) + j); \
        RA_[j] = ((const u32x4*)(UV + (size_t)(unsigned)e_ * UVREC))[lane]; }
#define MK_U4(w, s) __builtin_bit_cast(unsigned, __builtin_amdgcn_cvt_scalef32_pk_bf16_fp4(w, 1.0f, s))
#define MK_V4(w, s) __builtin_amdgcn_cvt_scalef32_pk_f32_fp4(w, 1.0f, s)
#define MK_PB_COMP(RA_, usreg, gvreg, kb) { \
        float pp_[8]; \
        _Pragma("unroll") for (int j = 0; j < 8; ++j) { \
            float s0_ = 0.f, s1_ = 0.f; \
            s0_ = dot2(MK_U4(RA_[j][0], 0), xpk[0], s0_); s1_ = dot2(MK_U4(RA_[j][0], 1), xpk[1], s1_); s0_ = dot2(MK_U4(RA_[j][0], 2), xpk[2], s0_); s1_ = dot2(MK_U4(RA_[j][0], 3), xpk[3], s1_); \
            s0_ = dot2(MK_U4(RA_[j][1], 0), xpk[4], s0_); s1_ = dot2(MK_U4(RA_[j][1], 1), xpk[5], s1_); s0_ = dot2(MK_U4(RA_[j][1], 2), xpk[6], s0_); s1_ = dot2(MK_U4(RA_[j][1], 3), xpk[7], s1_); \
            pp_[j] = s0_ + s1_; } \
        float q4_[4], r2_[2]; \
        _Pragma("unroll") for (int i = 0; i < 4; ++i) { const float keep_ = hi32 ? pp_[4 + i] : pp_[i], send_ = hi32 ? pp_[i] : pp_[4 + i]; q4_[i] = keep_ + __shfl_xor(send_, 32); } \
        _Pragma("unroll") for (int i = 0; i < 2; ++i) { const float keep_ = hi16 ? q4_[2 + i] : q4_[i], send_ = hi16 ? q4_[i] : q4_[2 + i]; r2_[i] = keep_ + __shfl_xor(send_, 16); } \
        float tot_ = (hi8 ? r2_[1] : r2_[0]) + __shfl_xor(hi8 ? r2_[0] : r2_[1], 8); \
        tot_ += __shfl_xor(tot_, 4); tot_ += __shfl_xor(tot_, 2); tot_ += __shfl_xor(tot_, 1); \
        const float act_ = gelu_as(tot_ * __shfl(usreg, (kb) + jj)) * __shfl(gvreg, (kb) + jj); \
        _Pragma("unroll") for (int j = 0; j < 8; ++j) { \
            const float aj_ = __uint_as_float(__builtin_amdgcn_readlane(__float_as_uint(act_), 32 * (j >> 2) + 16 * ((j >> 1) & 1) + 8 * (j & 1))); const f32x2 a2_ = {aj_, aj_}; \
            y2[0] += a2_ * MK_V4(RA_[j][2], 0); y2[1] += a2_ * MK_V4(RA_[j][2], 1); y2[2] += a2_ * MK_V4(RA_[j][2], 2); y2[3] += a2_ * MK_V4(RA_[j][2], 3); \
            y2[4] += a2_ * MK_V4(RA_[j][3], 0); y2[5] += a2_ * MK_V4(RA_[j][3], 1); y2[6] += a2_ * MK_V4(RA_[j][3], 2); y2[7] += a2_ * MK_V4(RA_[j][3], 3); } }
DI void peer_token(const unsigned char* UV, int e0, int e1, float us0, float us1, float gv0, float gv1, const unsigned (&xpk)[8], f32x2 (&y2)[8], int lane) {
    const bool hi32 = (lane & 32) != 0, hi16 = (lane & 16) != 0, hi8 = (lane & 8) != 0;
    const int jj = ((lane >> 5) & 1) * 4 + ((lane >> 4) & 1) * 2 + ((lane >> 3) & 1);
    u32x4 A0[8], A1[8];
    MK_PB_LOAD(A0, e0, 0)
#pragma unroll 1
    for (int b = 0; b < 8; b += 2) {
        MK_PB_LOAD(A1, e0, 8 * b + 8)
        MK_PB_COMP(A0, us0, gv0, 8 * b)
        if (b + 2 < 8) { MK_PB_LOAD(A0, e0, 8 * b + 16) } else { MK_PB_LOAD(A0, e1, 0) }
        MK_PB_COMP(A1, us0, gv0, 8 * b + 8)
    }
#pragma unroll 1
    for (int b = 0; b < 8; b += 2) {
        MK_PB_LOAD(A1, e1, 8 * b + 8)
        MK_PB_COMP(A0, us1, gv1, 8 * b)
        if (b + 2 < 8) { MK_PB_LOAD(A0, e1, 8 * b + 16) }
        MK_PB_COMP(A1, us1, gv1, 8 * b + 8)
    }
}
DI void peer_unit(const Args& a, int layer, int unit) {
    unsigned char* ws = a.ws;
    const int tid = mk_tid(), lane = tid & 63, w = __builtin_amdgcn_readfirstlane(tid >> 6);
    const unsigned char* UV = ws + WS_UV8; const float* SC = (const float*)(ws + WS_UVS);
#pragma unroll 1
    for (int i = 0; i < 8; ++i) {
        const size_t t = (size_t)unit * 64 + w * 8 + i;
        unsigned xpk[8]; f32x2 y2[8];
        int e0, e1; float us0, us1, gv0, gv1;
        {
            const int ln = mk_tid() & 63;
            const bf16_t* xbp = (const bf16_t*)(ws + WS_XB) + t * 1024 + 16 * ln;
            const u32x4 xa = *(const u32x4*)xbp, xb = *(const u32x4*)(xbp + 8);
#pragma unroll
            for (int q = 0; q < 4; ++q) { xpk[q] = xa[q]; xpk[4 + q] = xb[q]; }
            const int* ep = (const int*)(ws + WS_EID) + t * 128; const float* gp = (const float*)(ws + WS_GATE) + t * 128;
            e0 = ep[ln]; e1 = ep[64 + ln]; const float g0 = gp[ln], g1 = gp[64 + ln];
            const f32x2 s0 = *(const f32x2*)(SC + 2 * e0), s1 = *(const f32x2*)(SC + 2 * e1);
            us0 = s0.x; us1 = s1.x; gv0 = g0 * s0.y; gv1 = g1 * s1.y;
        }
#pragma unroll
        for (int q = 0; q < 8; ++q) y2[q] = (f32x2){0.f, 0.f};
        peer_token(UV, e0, e1, us0, us1, gv0, gv1, xpk, y2, lane);
        {
            const int ln = mk_tid() & 63;
            float* xfp = (float*)(ws + WS_XF) + t * 1024 + 16 * ln;
            const float* gam = a.in[18] + layer * 1024 + 16 * ln; const float* bet = a.in[19] + layer * 1024 + 16 * ln;
            float z[16]; float s = 0.f;
#pragma unroll
            for (int q = 0; q < 4; ++q) { const f32x4 xr = *(const f32x4*)(xfp + 4 * q);
#pragma unroll
                for (int j = 0; j < 4; ++j) { z[4 * q + j] = ALPHA * xr[j] + y2[2 * q + (j >> 1)][j & 1]; s += z[4 * q + j]; } }
            const float mean = wsum(s) * (1.0f / 1024.0f);
            float qq = 0.f;
#pragma unroll
            for (int q = 0; q < 16; ++q) { const float d = z[q] - mean; qq += d * d; }
            const float rstd = rsqrtf(wsum(qq) * (1.0f / 1024.0f) + LN_EPS);
            f32x4 o[4];
#pragma unroll
            for (int q = 0; q < 4; ++q) { const f32x4 gq = *(const f32x4*)(gam + 4 * q), bq = *(const f32x4*)(bet + 4 * q);
#pragma unroll
                for (int j = 0; j < 4; ++j) o[q][j] = (z[4 * q + j] - mean) * rstd * gq[j] + bq[j]; }
#pragma unroll
            for (int q = 0; q < 4; ++q) *(f32x4*)(xfp + 4 * q) = o[q];
            if (layer == DEPTH - 1) { float* op = a.out + t * 1024 + 16 * ln;
#pragma unroll
                for (int q = 0; q < 4; ++q) *(f32x4*)(op + 4 * q) = o[q]; }
            row_to_fp8(o, ws + WS_X8 + t * 1024, ln);
        }
    }
}
}

namespace mk {
constexpr int LDS_ARG_OFF = LDS_BYTES - 16 - 256;
#define MK_NOINL __device__ __forceinline__
DI unsigned long long rfl64(unsigned long long v) { const unsigned lo = __builtin_amdgcn_readfirstlane((unsigned)v), hi = __builtin_amdgcn_readfirstlane((unsigned)(v >> 32)); return ((unsigned long long)hi << 32) | lo; }
DI Args load_args(LAS unsigned char* lds) {
    int aoff = LDS_ARG_OFF; asm volatile("" : "+s"(aoff));
    Args a; const LAS unsigned long long* p = (const LAS unsigned long long*)(lds + aoff);
#pragma unroll
    for (int i = 0; i < 20; ++i) a.in[i] = (const float*)(const __attribute__((address_space(1))) float*)rfl64(p[i]);
    a.out = (float*)(__attribute__((address_space(1))) float*)rfl64(p[20]); a.ws = (unsigned char*)(__attribute__((address_space(1))) unsigned char*)rfl64(p[21]);
    a.ropeA = __longlong_as_double((long long)rfl64(p[22])); a.ropeR = __longlong_as_double((long long)rfl64(p[23])); a.ph_lo = 0; a.ph_hi = 0;
    return a;
}
#define MK_LOADARGS const Args a = load_args(lds); unsigned char* ws = a.ws; const int G = (int)gridDim.x, bid = (int)blockIdx.x; (void)ws; (void)G; (void)bid
MK_NOINL void PG_prologue(LAS unsigned char* lds) { MK_LOADARGS; phase_prologue(a); }
MK_NOINL void P0_conv(LAS unsigned char* lds, int layer) { MK_LOADARGS; phase_conv(a, layer, lds); }
#ifndef MK_STAGGER_TICKS
#define MK_STAGGER_TICKS 140
#endif
MK_NOINL void P1_inproj(LAS unsigned char* lds, int layer) { MK_LOADARGS; (void)layer;
    pg8::Gemm gm; gm.A = (const bf16_t*)(ws + WS_X8); gm.Bt = (const bf16_t*)(ws + WS_WINT); gm.M = NTOK; gm.N = DIN; gm.K = 512;
    pg8::StaticOrder S; S.init(NTOK, DIN, G, bid);
    EpiInProj E; E.O = (bf16_t*)(ws + WS_PROJ);
    pg8::gemm_phase<EpiInProj, pg8::StaticOrder, false, true, true>(lds, gm, S, E, nullptr); }
#ifndef MK_NLRU
#define MK_NLRU 64
#endif
MK_NOINL void P3s_lru(LAS unsigned char* lds, int layer) { MK_LOADARGS; if (bid < MK_NLRU) { for (int s = bid; s < 64; s += MK_NLRU) lru_stripe(a, layer, s, lds); } }
MK_NOINL void P3a_attn(LAS unsigned char* lds, int layer) { MK_LOADARGS; (void)layer; if (bid >= MK_NLRU) { for (int u = bid - MK_NLRU; u < 1536; u += G - MK_NLRU) attn_unit(a, u, lds); } }
MK_NOINL void P3b_retkv(LAS unsigned char* lds, int layer) { MK_LOADARGS; (void)layer; if (bid >= MK_NLRU) { for (int u = bid - MK_NLRU; u < 512; u += G - MK_NLRU) retkv_unit(a, u, lds); } }
MK_NOINL void P4a_scan(LAS unsigned char* lds, int layer) { MK_LOADARGS; (void)layer; for (int u = bid; u < 256; u += G) retscan_unit(a, u); }
MK_NOINL void P4c_merge(LAS unsigned char* lds, int layer) { MK_LOADARGS; (void)layer; for (int u = bid; u < 2048; u += G) attmerge_unit(a, u); }
MK_NOINL void P5_retout(LAS unsigned char* lds, int layer) { MK_LOADARGS; (void)layer; for (int u = bid; u < 512; u += G) retout_unit(a, u, lds); }
MK_NOINL void P6_branch(LAS unsigned char* lds, int layer) { MK_LOADARGS; (void)layer;
#pragma unroll 1
    for (int s = 0; s < 3; ++s) {
        pg8::Gemm gm; gm.A = (const bf16_t*)(ws + (s == 0 ? WS_YA : (s == 1 ? WS_YB : WS_YC))); gm.Bt = (const bf16_t*)(ws + (s == 0 ? WS_WBAT : (s == 1 ? WS_WBBT : WS_WBCT)));
        gm.M = NTOK; gm.N = 1024; gm.K = (s == 0) ? 512 : 1024;
        pg8::StaticOrder S; S.init(NTOK, 1024, G, bid);
        EpiBranch E; E.gate = (const bf16_t*)(ws + WS_PROJ); E.gcol = OFF_GA + 1024 * s; E.mf = (bf16_t*)(ws + WS_MRGF); E.mb = (bf16_t*)(ws + WS_MRGB); E.mode = s;
        pg8::gemm_phase<EpiBranch, pg8::StaticOrder, false>(lds, gm, S, E, nullptr);
    } }
MK_NOINL void P7_outproj(LAS unsigned char* lds, int layer) { MK_LOADARGS; (void)layer;
    pg8::Gemm gm; gm.A = (const bf16_t*)(ws + WS_MRGB); gm.Bt = (const bf16_t*)(ws + WS_WOT); gm.M = NTOK; gm.N = 1024; gm.K = 1024;
    pg8::StaticOrder S; S.init(NTOK, 1024, G, bid);
    EpiOut E; E.xf = (const float*)(ws + WS_XF); E.z = (float*)(ws + WS_MRGF);
    pg8::gemm_phase<EpiOut, pg8::StaticOrder, false>(lds, gm, S, E, nullptr); }
MK_NOINL void P8_ln1(LAS unsigned char* lds, int layer) { MK_LOADARGS; phase_ln1(a, layer); }
MK_NOINL void P9_wq(LAS unsigned char* lds, int layer) { MK_LOADARGS; (void)layer;
    pg8::Gemm gm; gm.A = (const bf16_t*)(ws + WS_XB); gm.Bt = (const bf16_t*)(ws + WS_WQT); gm.M = NTOK; gm.N = 2048; gm.K = 1024;
    pg8::StaticOrder S; S.init(NTOK, 2048, G, bid);
    pg8::EpiBf16<0> E; E.O = (bf16_t*)(ws + WS_Q); E.ldc = 2048; E.bias = nullptr; E.split_cols = 0; E.split_stride = 0;
    pg8::gemm_phase<pg8::EpiBf16<0>, pg8::StaticOrder, false>(lds, gm, S, E, nullptr); }
MK_NOINL void P10_topk(LAS unsigned char* lds, int layer) { MK_LOADARGS; (void)layer; for (int u = bid; u < NTOK / 64; u += G) topk_unit(a, u, lds); }
MK_NOINL void P11_peer(LAS unsigned char* lds, int layer) { MK_LOADARGS; for (int u = bid; u < NTOK / 64; u += G) peer_unit(a, layer, u); }
DI void mk_sync(LAS unsigned char* lds) {
    const Args a = load_args(lds);
    XcdBarrier b; b.bar = (unsigned*)(a.ws + WS_CTL); b.x = xb_xcc_id(); b.st = (volatile LAS unsigned*)(lds + LDS_BAR_OFF);
    xcd_barrier(b);
}
}

#ifndef MK_PHASE_MASK
#define MK_PHASE_MASK 0xFFFu
#endif
#define MK_RUN(k) ((((MK_PHASE_MASK) >> ((k) - pb)) & 1u) && (k) >= ph_lo && (k) < ph_hi)
#define MK_NPHASES (1 + mk::DEPTH * mk::NPH)

#define MK_SYNC(k) do { if ((k) >= ph_lo && (k) + 1 < ph_hi) mk::mk_sync(lds); } while (0)
__global__ __launch_bounds__(512, 2) void mk_fwd(mk::Args a) {
    using namespace mk;
    extern __shared__ __attribute__((aligned(16))) unsigned char smem_raw[];
    LAS unsigned char* lds = (LAS unsigned char*)smem_raw;
    const int ph_lo = a.ph_lo, ph_hi = a.ph_hi;
    {
        const unsigned* src = (const unsigned*)&a;
        if (threadIdx.x < sizeof(Args) / 4) ((LAS unsigned*)(lds + LDS_ARG_OFF))[threadIdx.x] = src[threadIdx.x];
        if (threadIdx.x == 0) { LAS unsigned* st = (LAS unsigned*)(lds + LDS_BAR_OFF); st[0] = 0u; st[1] = 0u; st[2] = 0u; st[3] = 0u; }
    }
    __syncthreads();
    if (ph_hi - ph_lo > 1) (void)xcd_barrier_post((unsigned*)(a.ws + WS_CTL), (volatile LAS unsigned*)(lds + LDS_BAR_OFF));
    if (0 >= ph_lo && 0 < ph_hi) PG_prologue(lds);
    MK_SYNC(0);
#pragma unroll 1
    for (int layer = 0; layer < DEPTH; ++layer) {
        const int pb = 1 + layer * NPH;
        if (MK_RUN(pb + 0)) P0_conv(lds, layer);
        MK_SYNC(pb + 0);
        if (MK_RUN(pb + 1)) P1_inproj(lds, layer);
        MK_SYNC(pb + 1);
        if (MK_RUN(pb + 3)) { P3s_lru(lds, layer); P3a_attn(lds, layer); P3b_retkv(lds, layer); }
        MK_SYNC(pb + 3);
        if (MK_RUN(pb + 4)) { P4a_scan(lds, layer); P4c_merge(lds, layer); }
        MK_SYNC(pb + 4);
        if (MK_RUN(pb + 5)) P5_retout(lds, layer);
        MK_SYNC(pb + 5);
        if (MK_RUN(pb + 6)) P6_branch(lds, layer);
        MK_SYNC(pb + 6);
        if (MK_RUN(pb + 7)) P7_outproj(lds, layer);
        MK_SYNC(pb + 7);
        if (MK_RUN(pb + 8)) P8_ln1(lds, layer);
        MK_SYNC(pb + 8);
        if (MK_RUN(pb + 9)) P9_wq(lds, layer);
        MK_SYNC(pb + 9);
        if (MK_RUN(pb + 10)) P10_topk(lds, layer);
        MK_SYNC(pb + 10);
        if (MK_RUN(pb + 11)) P11_peer(lds, layer);
        MK_SYNC(pb + 11);
    }
}

#ifndef MK_SINGLE
#define MK_SINGLE 1
#endif
extern "C" void kernel_launch(void* const* d_in, const int* in_sizes, int n_in, void* d_out, int out_size, void* d_ws, size_t ws_size, hipStream_t stream) {
    using namespace mk;
    static int grid = 0;
    if (grid == 0) {
        if (n_in != 20 || out_size != NTOK * D || ws_size < WS_END) { fprintf(stderr, "kernel_launch: unexpected shapes (n_in %d, out %d, ws %zu, need %zu)\n", n_in, out_size, ws_size, (size_t)WS_END); grid = -1; return; }
        int dev = 0, cus = 0, per_cu = 0;
        if (hipGetDevice(&dev) != hipSuccess || hipDeviceGetAttribute(&cus, hipDeviceAttributeMultiprocessorCount, dev) != hipSuccess) { grid = -1; return; }
        if (hipFuncSetAttribute((const void*)mk_fwd, hipFuncAttributeMaxDynamicSharedMemorySize, LDS_BYTES) != hipSuccess) { fprintf(stderr, "kernel_launch: hipFuncSetAttribute failed\n"); grid = -1; return; }
        if (hipOccupancyMaxActiveBlocksPerMultiprocessor(&per_cu, (const void*)mk_fwd, 512, LDS_BYTES) != hipSuccess || per_cu < 1) { fprintf(stderr, "kernel_launch: occupancy query says %d blocks per CU\n", per_cu); (void)hipGetLastError(); grid = -1; return; }
        grid = cus;
    }
    if (grid < 0) return;
    (void)in_sizes;
    Args a{};
    for (int i = 0; i < 20; ++i) a.in[i] = (const float*)d_in[i];
    a.out = (float*)d_out; a.ws = (unsigned char*)d_ws;
    a.ropeA = pow(10000.0, -2.0 / 128.0); a.ropeR = pow(10000.0, -2.0 / 256.0);
#if MK_SINGLE
    (void)hipMemsetAsync((unsigned char*)d_ws + WS_CTL, 0, 16384, stream);
    a.ph_lo = 0; a.ph_hi = MK_NPHASES;
    hipLaunchKernelGGL(mk_fwd, dim3(grid), dim3(512), LDS_BYTES, stream, a);
#else
    for (int p = 0; p < MK_NPHASES; ++p) { a.ph_lo = p; a.ph_hi = p + 1; hipLaunchKernelGGL(mk_fwd, dim3(grid), dim3(512), LDS_BYTES, stream, a); }
#endif
}
```

```cpp
#include <hip/hip_runtime.h>
#include <cstdio>
#include <cstdint>
#include <cmath>
#include <cfloat>
__device__ __forceinline__ int mk_tid() { int t = (int)threadIdx.x; asm volatile("" : "+v"(t)); return t; }
namespace pg8 {
#define PG8_LAS __attribute__((address_space(3)))
typedef unsigned short bf16_t;
typedef short bf16x8 __attribute__((ext_vector_type(8)));
typedef float f32x4 __attribute__((ext_vector_type(4)));
typedef unsigned u32x4 __attribute__((ext_vector_type(4)));
constexpr int BM = 256, BK = 64, HALF = 128, HTB = HALF * BK * 2  , STAGE_BYTES = 8 * HTB, NXCD = 8, WGM = 8;

__host__ __device__ __forceinline__ int lds_byte(int r, int c) { const int st = (r >> 4) * 2 + (c >> 5), rr = r & 15, cc = c & 31, ob = rr * 64 + cc * 2; return st * 1024 + (ob ^ (((ob >> 9) & 1) << 5)); }
__host__ __device__ __forceinline__ void stage_rc(int b, int& R, int& C) { const int st = b / 1024, sb = b % 1024, swz = sb ^ (((sb >> 9) & 1) << 5); R = (st >> 1) * 16 + swz / 64; C = (st & 1) * 32 + (swz % 64) / 2; }
__host__ __device__ __forceinline__ int perm32(int rho) { const int n = rho >> 4, i = rho & 15; return 8 * (i >> 2) + 4 * n + (i & 3); }

struct Unit { int pm, pn; };
struct Gemm { const bf16_t* A; const bf16_t* Bt; int M, N, K; };

struct StaticOrder {
    int nM, nN, nwg, G, c;
    __host__ __device__ void init(int M, int N, int G_, int c_) { nM = M / BM; nN = N / BM; nwg = nM * nN; G = G_; c = c_; }
    __host__ __device__ bool next(int i, Unit& u) const {
        const long L = (long)i * G + c; if (L >= nwg) return false;
        int wgid = (int)L; { const int q = nwg / NXCD, r = nwg % NXCD, xcd = wgid % NXCD, off = wgid / NXCD; wgid = (xcd < r ? xcd * (q + 1) : r * (q + 1) + (xcd - r) * q) + off; }
        const int nig = WGM * nN, gid = wgid / nig, fm = gid * WGM, gsz = (nM - fm) < WGM ? (nM - fm) : WGM;
        u.pm = fm + ((wgid % nig) % gsz); u.pn = (wgid % nig) / gsz; return true;
    }
    __device__ __forceinline__ void a_ready(const Unit&) const {}
    __device__ __forceinline__ void done(const Unit&) const {}
};
typedef __bf16 pg8_bf16x2 __attribute__((ext_vector_type(2)));
__device__ __forceinline__ unsigned cvt_pk_bf16(float lo, float hi) { const pg8_bf16x2 v = {(__bf16)lo, (__bf16)hi}; return __builtin_bit_cast(unsigned, v); }
typedef float f32x2 __attribute__((ext_vector_type(2)));
__device__ __forceinline__ f32x2 gelu_pk(f32x2 v) {
    const f32x2 av = __builtin_elementwise_abs(v), d = av * 0.2316418882f + 1.0f;
    f32x2 t; t.x = __builtin_amdgcn_rcpf(d.x); t.y = __builtin_amdgcn_rcpf(d.y);
    f32x2 q = t * 0.5307027145f + (-0.7265760135f); q = q * t + 0.7107068705f; q = q * t + (-0.142248368f); q = q * t + 0.127414796f; q = q * t;
    const f32x2 s = (v * v) * (-0.72134752044f);
    f32x2 e; e.x = __builtin_amdgcn_exp2f(s.x); e.y = __builtin_amdgcn_exp2f(s.y);
    const f32x2 m = v * (q * e), r = v - m;
    f32x2 o; o.x = v.x < 0.f ? m.x : r.x; o.y = v.y < 0.f ? m.y : r.y; return o;
}

struct EpiF32 {
    static constexpr bool PERM = false, AFTER_DRAIN = false;
    float* C; int ldc; const float* bias;
    __device__ __forceinline__ void operator()(const f32x4 (&acc)[2][2][4][2], const Unit& u, int wr, int wc, int fr, int fq) const {
        const int row0 = u.pm * BM + wr * 64 + fr, col0 = u.pn * BM + wc * 32 + 4 * fq;
        f32x4 bv[2][2];
#pragma unroll
        for (int bj = 0; bj < 2; ++bj)
#pragma unroll
            for (int n = 0; n < 2; ++n) bv[bj][n] = bias ? *(const f32x4*)(bias + col0 + bj * HALF + n * 16) : (f32x4){0.f, 0.f, 0.f, 0.f};
#pragma unroll
        for (int ai = 0; ai < 2; ++ai)
#pragma unroll
            for (int m = 0; m < 4; ++m) { float* rowp = C + (size_t)(row0 + ai * HALF + m * 16) * ldc + col0;
#pragma unroll
                for (int bj = 0; bj < 2; ++bj)
#pragma unroll
                    for (int n = 0; n < 2; ++n) *(f32x4*)(rowp + bj * HALF + n * 16) = acc[ai][bj][m][n] + bv[bj][n]; }
    }
};
template <int ACT  > struct EpiBf16 {
    static constexpr bool PERM = true, AFTER_DRAIN = false;
    bf16_t* O; int ldc; const float* bias; int split_cols; size_t split_stride;
    __device__ __forceinline__ void operator()(const f32x4 (&acc)[2][2][4][2], const Unit& u, int wr, int wc, int fr, int fq) const {
        const int row0 = u.pm * BM + wr * 64 + fr; int colt = u.pn * BM; bf16_t* base = O;
        if (split_cols) { const int t = colt / split_cols; base += (size_t)t * split_stride; colt -= t * split_cols; }
        const int col0 = colt + wc * 32 + 8 * fq, bcol0 = u.pn * BM + wc * 32 + 8 * fq;
        f32x4 bv[2][2];
#pragma unroll
        for (int bj = 0; bj < 2; ++bj)
#pragma unroll
            for (int n = 0; n < 2; ++n) bv[bj][n] = bias ? *(const f32x4*)(bias + bcol0 + bj * HALF + 4 * n) : (f32x4){0.f, 0.f, 0.f, 0.f};
#pragma unroll
        for (int ai = 0; ai < 2; ++ai)
#pragma unroll
            for (int m = 0; m < 4; ++m) { bf16_t* rowp = base + (size_t)(row0 + ai * HALF + m * 16) * ldc + col0;
#pragma unroll
                for (int bj = 0; bj < 2; ++bj) { f32x4 v0 = acc[ai][bj][m][0] + bv[bj][0], v1 = acc[ai][bj][m][1] + bv[bj][1];
                    if (ACT == 1) { f32x2 a = gelu_pk((f32x2){v0[0], v0[1]}), b = gelu_pk((f32x2){v0[2], v0[3]}), c = gelu_pk((f32x2){v1[0], v1[1]}), d = gelu_pk((f32x2){v1[2], v1[3]});
                        v0 = (f32x4){a.x, a.y, b.x, b.y}; v1 = (f32x4){c.x, c.y, d.x, d.y}; }
                    if (ACT == 2) {
#pragma unroll
                        for (int j = 0; j < 4; ++j) { v0[j] = 0.5f * v0[j] * (1.0f + erff(v0[j] * 0.70710678f)); v1[j] = 0.5f * v1[j] * (1.0f + erff(v1[j] * 0.70710678f)); } }
                    u32x4 w; w.x = cvt_pk_bf16(v0[0], v0[1]); w.y = cvt_pk_bf16(v0[2], v0[3]); w.z = cvt_pk_bf16(v1[0], v1[1]); w.w = cvt_pk_bf16(v1[2], v1[3]);
                    *(u32x4*)(rowp + bj * HALF) = w; } }
    }
};

typedef int i32x8 __attribute__((ext_vector_type(8)));
typedef short s16x16 __attribute__((ext_vector_type(16)));
__device__ __forceinline__ i32x8 pg8_cat16(bf16x8 a, bf16x8 b) { return __builtin_bit_cast(i32x8, (s16x16)__builtin_shufflevector(a, b, 0, 1, 2, 3, 4, 5, 6, 7, 8, 9, 10, 11, 12, 13, 14, 15)); }
template <class Epi, class Sched, bool STAMP = false, bool F8 = false, bool WIDE = false>
__device__ __forceinline__ void gemm_phase(PG8_LAS unsigned char* lds, const Gemm g, const Sched& S, const Epi& E, unsigned long long* stamps) {
    const int tid = mk_tid(), wid = __builtin_amdgcn_readfirstlane(tid >> 6), lane = tid & 63, wr = wid >> 2, wc = wid & 3, fr = lane & 15, fq = lane >> 4;
    const int K = g.K, nt = K / BK;
    int ts_lo = 0, ts_hi = 0, nts = 0; const unsigned long long rt_entry = STAMP ? (unsigned long long)wall_clock64() : 0ull;
#define PG8_STAMP() do { if (STAMP && wid == 0 && nts < 64) { const unsigned long long _c = (unsigned long long)clock64(); \
        ts_lo = (lane == nts) ? (int)(unsigned)_c : ts_lo; ts_hi = (lane == nts) ? (int)(unsigned)(_c >> 32) : ts_hi; ++nts; } } while (0)
    PG8_STAMP();
    unsigned voffA, voffB;
    { int R, C; stage_rc(tid * 16, R, C); const int Ri = Epi::PERM ? perm32(R & 31) : (R & 31); const int Rb = WIDE ? (((R >> 5) << 6) + Ri) : ((R & ~31) + Ri);
        voffA = (unsigned)(R * K + C) * 2u; voffB = (unsigned)(Rb * K + C) * 2u; }
    const size_t qstep = (size_t)64 * K * 2;
    const size_t qstepB = WIDE ? (size_t)128 * K * 2 : qstep;
    const size_t hstepB = WIDE ? (size_t)32 * K * 2 : (size_t)HALF * K * 2;
    const size_t kstep = (size_t)(BK * 2);
    const size_t hstep = (size_t)HALF * K * 2;
    const size_t tstep = 2 * hstep;
    const unsigned ldsw = (unsigned)wid * 1024u;
    const int aoff = lds_byte(wr * 64 + fr, fq * 8), boff = lds_byte(wc * 32 + fr, fq * 8);
#define PG8_SA(b, h) (((b) * 2 + (h)) * HTB)
#define PG8_SB(b, h) ((4 + (b) * 2 + (h)) * HTB)
#define PG8_STAGE(bufoff, gbase, voff) PG8_STAGEQ(bufoff, gbase, voff, qstep)
#define PG8_STAGEB(bufoff, gbase, voff) PG8_STAGEQ(bufoff, gbase, voff, qstepB)
#define PG8_STAGEQ(bufoff, gbase, voff, qs) do { const char* _g0 = (const char*)(gbase); const char* _g1 = _g0 + (qs); asm volatile("" : "+s"(_g0), "+s"(_g1));   \
        __builtin_amdgcn_global_load_lds((const unsigned*)(_g0 + (voff)), (PG8_LAS unsigned*)(lds + (bufoff) + ldsw), 16, 0, 0); \
        __builtin_amdgcn_global_load_lds((const unsigned*)(_g1 + (voff)), (PG8_LAS unsigned*)(lds + (bufoff) + ldsw + 8192), 16, 0, 0); } while (0)
#define PG8_LDA(dst, b, h) do { _Pragma("unroll") for (int m = 0; m < 4; ++m) _Pragma("unroll") for (int k = 0; k < 2; ++k) dst[m][k] = *(const PG8_LAS bf16x8*)(lds + PG8_SA(b, h) + aoff + m * 2048 + k * 1024); } while (0)
#define PG8_LDB(dst, b, h) do { _Pragma("unroll") for (int n = 0; n < 2; ++n) _Pragma("unroll") for (int k = 0; k < 2; ++k) dst[n][k] = *(const PG8_LAS bf16x8*)(lds + PG8_SB(b, h) + boff + n * 2048 + k * 1024); } while (0)
#define PG8_MMA(ai, bj, At, Bt) do { __builtin_amdgcn_s_setprio(1); _Pragma("unroll") for (int m = 0; m < 4; ++m) _Pragma("unroll") for (int n = 0; n < 2; ++n) { \
        if constexpr (F8) acc[ai][bj][m][n] = __builtin_amdgcn_mfma_scale_f32_16x16x128_f8f6f4(pg8_cat16(Bt[n][0], Bt[n][1]), pg8_cat16(At[m][0], At[m][1]), acc[ai][bj][m][n], 0, 0, 0, 0, 0, 0); \
        else { _Pragma("unroll") for (int k = 0; k < 2; ++k) acc[ai][bj][m][n] = __builtin_amdgcn_mfma_f32_16x16x32_bf16(Bt[n][k], At[m][k], acc[ai][bj][m][n], 0, 0, 0); } } \
        __builtin_amdgcn_s_setprio(0); } while (0)
#define PG8_WAIT_V(n) asm volatile("s_waitcnt vmcnt(" #n ")" ::: "memory")
#define PG8_WAIT_L(n) asm volatile("s_waitcnt lgkmcnt(" #n ")" ::: "memory")
#define PG8_BAR __builtin_amdgcn_s_barrier()
#define PG8_SCHED __builtin_amdgcn_sched_barrier(0)
    Unit cur, nxt; int ui = 0;
    if (!S.next(0, cur)) return;
    f32x4 acc[2][2][4][2];
    bf16x8 At[4][2], B0[2][2], B1[2][2];
    const char* cA = (const char*)g.A + (size_t)cur.pm * tstep; const char* cB = (const char*)g.Bt + (size_t)cur.pn * tstep;
    S.a_ready(cur);
    PG8_STAGEB(PG8_SB(0, 0), cB, voffB); PG8_STAGE(PG8_SA(0, 0), cA, voffA); PG8_STAGEB(PG8_SB(0, 1), cB + hstepB, voffB); PG8_STAGE(PG8_SA(0, 1), cA + hstep, voffA);
    if (wr == 1) PG8_BAR;
    PG8_WAIT_V(4); PG8_BAR;
    PG8_STAGEB(PG8_SB(1, 0), cB + kstep, voffB); PG8_STAGE(PG8_SA(1, 0), cA + kstep, voffA); PG8_STAGEB(PG8_SB(1, 1), cB + hstepB + kstep, voffB);
    PG8_WAIT_V(6); PG8_BAR;
    PG8_STAMP();
#pragma unroll
    for (int a = 0; a < 2; ++a)
#pragma unroll
        for (int b = 0; b < 2; ++b)
#pragma unroll
            for (int m = 0; m < 4; ++m)
#pragma unroll
                for (int n = 0; n < 2; ++n) acc[a][b][m][n] = (f32x4){0.f, 0.f, 0.f, 0.f};
    for (;;) {
        const bool has_next = S.next(ui + 1, nxt);
        const char* nA = has_next ? (const char*)g.A + (size_t)nxt.pm * tstep : cA; const char* nB = has_next ? (const char*)g.Bt + (size_t)nxt.pn * tstep : cB;
        for (int t = 0; t < nt; t += 2) {
            const bool last = (t == nt - 2);
            const char* a1 = cA + (size_t)(t + 1) * kstep;
            const char* a2 = last ? nA : cA + (size_t)(t + 2) * kstep; const char* b2 = last ? nB : cB + (size_t)(t + 2) * kstep;
            const char* a3 = a2 + kstep; const char* b3 = b2 + kstep;
            if (last && has_next) S.a_ready(nxt);
            PG8_LDB(B0, 0, 0); PG8_SCHED; PG8_LDA(At, 0, 0); PG8_STAGE(PG8_SA(1, 1), a1 + hstep, voffA);
            PG8_WAIT_L(8); PG8_BAR; PG8_WAIT_L(0); PG8_MMA(0, 0, At, B0); PG8_BAR; PG8_SCHED;
            PG8_LDB(B1, 0, 1); PG8_STAGEB(PG8_SB(0, 0), b2, voffB);
            PG8_BAR; PG8_WAIT_L(0); PG8_MMA(0, 1, At, B1); PG8_BAR;
            PG8_LDA(At, 0, 1); PG8_STAGE(PG8_SA(0, 0), a2, voffA);
            PG8_BAR; PG8_WAIT_L(0); PG8_MMA(1, 0, At, B0); PG8_BAR; PG8_SCHED;
            PG8_STAGEB(PG8_SB(0, 1), b2 + hstepB, voffB);
            PG8_WAIT_V(6); PG8_BAR; PG8_MMA(1, 1, At, B1); PG8_BAR;
            PG8_LDB(B0, 1, 0); PG8_SCHED; PG8_LDA(At, 1, 0); PG8_STAGE(PG8_SA(0, 1), a2 + hstep, voffA);
            PG8_WAIT_L(8); PG8_BAR; PG8_WAIT_L(0); PG8_MMA(0, 0, At, B0); PG8_BAR; PG8_SCHED;
            PG8_LDB(B1, 1, 1); PG8_STAGEB(PG8_SB(1, 0), b3, voffB);
            PG8_BAR; PG8_WAIT_L(0); PG8_MMA(0, 1, At, B1); PG8_BAR;
            PG8_LDA(At, 1, 1); PG8_STAGE(PG8_SA(1, 0), a3, voffA);
            PG8_BAR; PG8_WAIT_L(0); PG8_MMA(1, 0, At, B0); PG8_BAR; PG8_SCHED;
            PG8_STAGEB(PG8_SB(1, 1), b3 + hstepB, voffB);
            PG8_WAIT_V(6); PG8_BAR; PG8_MMA(1, 1, At, B1); PG8_BAR;
        }
        PG8_STAMP();
        if constexpr (!Epi::AFTER_DRAIN) { E(acc, cur, wr, wc, fr, fq); S.done(cur); }
        PG8_STAMP();
        if (!has_next) break;
#pragma unroll
        for (int a = 0; a < 2; ++a)
#pragma unroll
            for (int b = 0; b < 2; ++b)
#pragma unroll
                for (int m = 0; m < 4; ++m)
#pragma unroll
                    for (int n = 0; n < 2; ++n) acc[a][b][m][n] = (f32x4){0.f, 0.f, 0.f, 0.f};
        cur = nxt; cA = nA; cB = nB; ++ui;
    }
    PG8_WAIT_V(0);
    if (wr == 0) PG8_BAR;
    PG8_BAR;
    if constexpr (Epi::AFTER_DRAIN) { E.fused(acc, cur, wr, wc, fr, fq, lds, wid, lane); S.done(cur); }
    PG8_STAMP();
    if (STAMP && wid == 0) { stamps[lane] = lane < nts ? (((unsigned long long)(unsigned)ts_hi << 32) | (unsigned)ts_lo) : 0ull;
        if (lane == 62) stamps[62] = rt_entry; if (lane == 63) stamps[63] = (unsigned long long)wall_clock64(); }
#undef PG8_STAMP
#undef PG8_SA
#undef PG8_SB
#undef PG8_STAGE
#undef PG8_STAGEB
#undef PG8_STAGEQ
#undef PG8_LDA
#undef PG8_LDB
#undef PG8_MMA
#undef PG8_WAIT_V
#undef PG8_WAIT_L
#undef PG8_BAR
#undef PG8_SCHED
}
}
#define XB_TMO      128
#define XB_XCNT(j)  (256  + 64 * (j))
#define XB_XSUB(j)  (1280 + 64 * (j))
#define XB_XGEN(j)  (2304 + 64 * (j))
#define XB_TOP      3328
#define XB_TOPGEN   3392
#define XCD_BAR_WORDS 3456
#define XB_SPIN_CAP (1u << 18)
#define LAS __attribute__((address_space(3)))

__device__ __forceinline__ unsigned xb_ld(unsigned* p)              { return __hip_atomic_load(p, __ATOMIC_RELAXED, __HIP_MEMORY_SCOPE_AGENT); }
__device__ __forceinline__ unsigned xb_add(unsigned* p, unsigned v) { return __hip_atomic_fetch_add(p, v, __ATOMIC_RELAXED, __HIP_MEMORY_SCOPE_AGENT); }
__device__ __forceinline__ unsigned xb_xcc_id() { return (unsigned)__builtin_amdgcn_s_getreg((3 << 11) | 20) & 0xFu; }
#define XB_SPIN(cond, bar) do { unsigned _sp = 0; while (cond) { __builtin_amdgcn_s_sleep(1); \
    if ((++_sp & 255u) == 0u) { if (xb_ld(&(bar)[XB_TMO])) break; if (_sp > XB_SPIN_CAP) { atomicAdd(&(bar)[XB_TMO], 1u); break; } } } } while (0)

struct XcdBarrier {
    unsigned* bar; unsigned x;
    volatile LAS unsigned* st;
};

__device__ __forceinline__ XcdBarrier xcd_barrier_post(unsigned* bar, volatile LAS unsigned* st) {
    XcdBarrier b; b.bar = bar; b.x = xb_xcc_id(); b.st = st;
    if (threadIdx.x == 0) (void)xb_add(&bar[XB_XCNT(b.x)], 1u);
    return b;
}
__device__ __forceinline__ void xcd_barrier_complete(unsigned* bar, unsigned x, unsigned& nloc, unsigned& nx) {
    const unsigned G = gridDim.x * gridDim.y * gridDim.z;
    unsigned sum, cnt, mine, sp = 0u;
    for (;;) {
        sum = 0u; cnt = 0u; mine = 0u;
#pragma unroll
        for (unsigned j = 0; j < 16; ++j) { const unsigned c = xb_ld(&bar[XB_XCNT(j)]); sum += c; cnt += (c > 0u) ? 1u : 0u; mine = (j == x) ? c : mine; }
        if (sum == G) break;
        __builtin_amdgcn_s_sleep(1);
        if ((++sp & 255u) == 0u) { if (xb_ld(&bar[XB_TMO])) break; if (sp > XB_SPIN_CAP) { atomicAdd(&bar[XB_TMO], 1u); break; } }
    }
    nloc = mine > 0u ? mine : 1u; nx = cnt > 0u ? cnt : 1u;
}

__device__ __forceinline__ void xcd_barrier(const XcdBarrier& b) {
    asm volatile("s_waitcnt vmcnt(0)" ::: "memory");
    __syncthreads();
    if (threadIdx.x == 0) {
        unsigned* bar = b.bar;
        __builtin_amdgcn_s_waitcnt(0);
        unsigned nloc = b.st[0], nx = b.st[1];
        if (nloc == 0u) { xcd_barrier_complete(bar, b.x, nloc, nx); b.st[0] = nloc; b.st[1] = nx; }
        const unsigned old = xb_add(&bar[XB_XSUB(b.x)], 1u);
        const unsigned gen = old / nloc;
        if (old + 1u == (gen + 1u) * nloc) {
            __builtin_amdgcn_fence(__ATOMIC_RELEASE, "agent");
            asm volatile("s_waitcnt vmcnt(0)" ::: "memory");
            const unsigned og = xb_add(&bar[XB_TOP], 1u);
            const unsigned tg = og / nx;
            if (og + 1u == (tg + 1u) * nx) xb_add(&bar[XB_TOPGEN], 1u);
            else XB_SPIN(xb_ld(&bar[XB_TOPGEN]) == tg, bar);
            __builtin_amdgcn_fence(__ATOMIC_ACQUIRE, "agent");
            xb_add(&bar[XB_XGEN(b.x)], 1u);
            asm volatile("s_waitcnt vmcnt(0)" ::: "memory");
        } else {
            XB_SPIN(xb_ld(&bar[XB_XGEN(b.x)]) == gen, bar);
            __builtin_amdgcn_fence(__ATOMIC_ACQUIRE, "agent");
            asm volatile("s_waitcnt vmcnt(0)" ::: "memory");
        }
    }
    __syncthreads();
}

namespace mk {
using pg8::bf16_t; using pg8::bf16x8; using pg8::f32x4; using pg8::u32x4;
typedef short s16x4 __attribute__((ext_vector_type(4)));
typedef unsigned u32x2 __attribute__((ext_vector_type(2)));
typedef __bf16 bf16x2v __attribute__((ext_vector_type(2)));
typedef int i32x4 __attribute__((ext_vector_type(4)));
#define DI __device__ __forceinline__

constexpr int D = 1024, SEQ = 4096, NTOK = 16384, DEPTH = 4, DIN = 13824;
constexpr int OFF_AQ = 0, OFF_AK = 1536, OFF_AV = 3072, OFF_LX = 4608, OFF_LG = 5632, OFF_RQ = 6656, OFF_RK = 7680, OFF_RV = 8704, OFF_RG = 9728, OFF_GA = 10752;
constexpr float ALPHA = 1.681792830507429f;
constexpr float LN_EPS = 1e-5f;
constexpr float X8_SCALE = 32.0f, W8_SCALE = 2048.0f, F8_MAX = 440.0f;
constexpr int NPH = 12;
constexpr int LDS_BYTES = 148 * 1024;
constexpr int LDS_BAR_OFF = LDS_BYTES - 16;

constexpr size_t WS_CTL  = 0;
constexpr size_t WS_COSA = 16384;
constexpr size_t WS_SINA = WS_COSA + (size_t)4096 * 64 * 4;
constexpr size_t WS_COSR = WS_SINA + (size_t)4096 * 64 * 4;
constexpr size_t WS_SINR = WS_COSR + (size_t)4096 * 128 * 4;
constexpr size_t WS_CCH  = WS_SINR + (size_t)4096 * 128 * 4;
constexpr size_t WS_WAT  = WS_CCH + 4096;
constexpr size_t WS_WXT  = WS_WAT + 131072;
constexpr size_t WS_LSTA = WS_WXT + 131072;
constexpr size_t WS_LSTH = WS_LSTA + 524288;
constexpr size_t WS_K1B  = WS_LSTH + 524288;
constexpr size_t WS_K2B  = WS_K1B + 262144;
constexpr size_t WS_XF   = WS_K2B + 262144;
constexpr size_t WS_XB   = WS_XF + (size_t)NTOK * D * 4;
constexpr size_t WS_WINT = WS_XB + (size_t)NTOK * D * 2;
constexpr size_t WS_WSC  = WS_WINT + (size_t)DIN * 1024;
constexpr size_t WS_X8   = WS_WSC + (size_t)DIN * 4 + 256 - ((size_t)DIN * 4) % 256;
constexpr size_t WS_XS   = WS_X8 + (size_t)NTOK * 1024;
constexpr size_t WS_WBAT = WS_XS + (size_t)NTOK * 4;
constexpr size_t WS_WBBT = WS_WBAT + (size_t)1024 * 512 * 2;
constexpr size_t WS_WBCT = WS_WBBT + (size_t)1024 * 1024 * 2;
constexpr size_t WS_WOT  = WS_WBCT + (size_t)1024 * 1024 * 2;
constexpr size_t WS_WQT  = WS_WOT + (size_t)1024 * 1024 * 2;
constexpr size_t WS_UV8  = WS_WQT + (size_t)2048 * 1024 * 2;
constexpr size_t WS_UVS  = WS_UV8 + (size_t)16384 * 2048;
constexpr size_t WS_PROJ = WS_UVS + (size_t)16384 * 8;
constexpr size_t WS_OATT = WS_PROJ + (size_t)NTOK * DIN * 2;
constexpr size_t WS_LSE  = WS_OATT + (size_t)NTOK * 1536 * 2;
constexpr size_t WS_KVB  = WS_LSE + (size_t)NTOK * 12 * 4;
constexpr size_t WS_YA   = WS_KVB + (size_t)16 * 32 * 65536 * 2;
constexpr size_t WS_YB   = WS_YA + (size_t)NTOK * 512 * 2;
constexpr size_t WS_YC   = WS_YB + (size_t)NTOK * 1024 * 2;
constexpr size_t WS_MRGF = WS_YC + (size_t)NTOK * 1024 * 2;
constexpr size_t WS_MRGB = WS_MRGF + (size_t)NTOK * 1024 * 4;
constexpr size_t WS_END  = WS_MRGB + (size_t)NTOK * 1024 * 2;
constexpr size_t WS_Q    = WS_PROJ;
constexpr size_t WS_EID  = WS_PROJ + (size_t)NTOK * 2048 * 2;
constexpr size_t WS_GATE = WS_EID + (size_t)NTOK * 128 * 4;
static_assert(WS_END <= (size_t)1073741824, "workspace too large");
static_assert(WS_PROJ % 256 == 0 && WS_KVB % 256 == 0 && WS_MRGF % 256 == 0, "alignment");

struct Args { const float* in[20]; float* out; unsigned char* ws; double ropeA, ropeR; int ph_lo, ph_hi; };

DI size_t pjo(size_t row, int col) { return ((size_t)(col >> 8) * NTOK + row) * 256 + (size_t)(col & 255); }
DI float bflo(unsigned w) { return __uint_as_float(w << 16); }
DI float bfhi(unsigned w) { return __uint_as_float(w & 0xffff0000u); }
DI float bf2f(bf16_t v) { return __uint_as_float(((unsigned)v) << 16); }
DI unsigned pk2(float lo, float hi) { return pg8::cvt_pk_bf16(lo, hi); }
DI bf16_t f2bf(float f) { return (bf16_t)(pk2(f, 0.f) & 0xffffu); }
DI f32x4 mfma16(bf16x8 a, bf16x8 b, f32x4 c) { return __builtin_amdgcn_mfma_f32_16x16x32_bf16(a, b, c, 0, 0, 0); }
DI s16x4 trrd(LAS unsigned char* p) { return __builtin_amdgcn_ds_read_tr16_b64_v4i16((LAS s16x4*)p); }
DI bf16x8 cat8(s16x4 lo, s16x4 hi) { return __builtin_shufflevector(lo, hi, 0, 1, 2, 3, 4, 5, 6, 7); }
DI float wsum(float v) { v += __shfl_xor(v, 32); v += __shfl_xor(v, 16); v += __shfl_xor(v, 8); v += __shfl_xor(v, 4); v += __shfl_xor(v, 2); v += __shfl_xor(v, 1); return v; }
DI float sigm(float x) { return __builtin_amdgcn_rcpf(1.f + __builtin_amdgcn_exp2f(x * -1.4426950408889634f)); }
DI float gelu_erf(float x) { return 0.5f * x * (1.f + erff(x * 0.70710678118654752f)); }
DI float dot2(unsigned w, unsigned x, float acc) { return __builtin_amdgcn_fdot2_f32_bf16(__builtin_bit_cast(bf16x2v, w), __builtin_bit_cast(bf16x2v, x), acc, false); }
DI float log2gamma(int h) { return log2f(1.0f - exp2f(-5.0f - (float)h)); }

#define MK_DPP_ADD(v, ctrl, rmask) v += __int_as_float(__builtin_amdgcn_update_dpp(0, __float_as_int(v), (ctrl), (rmask), 0xf, false))
DI float wsum_dpp(float v) {
    MK_DPP_ADD(v, 0xB1, 0xf); MK_DPP_ADD(v, 0x4E, 0xf); MK_DPP_ADD(v, 0x141, 0xf); MK_DPP_ADD(v, 0x140, 0xf);
    MK_DPP_ADD(v, 0x142, 0xa); MK_DPP_ADD(v, 0x143, 0xc);
    return __int_as_float(__builtin_amdgcn_readlane(__float_as_int(v), 63));
}
DI float gelu_as(float v) {
    const float av = fabsf(v), t = __builtin_amdgcn_rcpf(av * 0.2316418882f + 1.0f);
    float q = t * 0.5307027145f + (-0.7265760135f); q = q * t + 0.7107068705f; q = q * t + (-0.142248368f); q = q * t + 0.127414796f; q = q * t;
    const float e = __builtin_amdgcn_exp2f(v * v * (-0.72134752044f));
    const float m = v * (q * e);
    return v < 0.f ? m : v - m;
}
DI int wperm(int n) {
    if (n < 3072) { const int j = n & 127, bj = j >> 6, jj = j & 63; return (n & ~127) + 64 * (jj >> 5) + 32 * bj + (jj & 31); }
    if (n >= OFF_RQ && n < OFF_RV) { const int j = n & 255, bj = j >> 7, jj = j & 127; return (n & ~255) + 64 * (jj >> 5) + 32 * bj + (jj & 31); }
    return n;
}
template <bool WPERM>
DI void tconv_tile(const float* src, int ldsrc, bf16_t* dst, int lddst, int k0, int n0, LAS float* t, float mul = 1.0f) {
    const int tid = mk_tid();
#pragma unroll
    for (int i = 0; i < 8; ++i) { const int idx = tid + 512 * i, r = idx >> 6, c = idx & 63; t[r * 65 + c] = src[(size_t)(k0 + r) * ldsrc + n0 + c]; }
    __syncthreads();
#pragma unroll
    for (int i = 0; i < 8; ++i) { const int idx = tid + 512 * i, n = idx >> 6, k = idx & 63; const int nr = WPERM ? wperm(n0 + n) : (n0 + n); dst[(size_t)nr * lddst + k0 + k] = f2bf(t[k * 65 + n] * mul); }
    __syncthreads();
}
DI void conv_unit(const float* src, bf16_t* dst, int unit) {
    const size_t i = (size_t)unit * 4096 + (size_t)mk_tid() * 8;
    const f32x4 a = *(const f32x4*)(src + i), b = *(const f32x4*)(src + i + 4);
    u32x4 o; o.x = pk2(a[0], a[1]); o.y = pk2(a[2], a[3]); o.z = pk2(b[0], b[1]); o.w = pk2(b[2], b[3]);
    *(u32x4*)(dst + i) = o;
}
DI void w8_unit(const float* src, unsigned char* ws, int unit, LAS float* t) {
    const int tid = mk_tid(), n0 = unit * 64;
    unsigned char* dst = ws + WS_WINT;
#pragma unroll 1
    for (int k0 = 0; k0 < 1024; k0 += 64) {
#pragma unroll
        for (int i = 0; i < 8; ++i) { const int idx = tid + 512 * i, r = idx >> 6, cc = idx & 63; t[r * 65 + cc] = fminf(fmaxf(src[(size_t)(k0 + r) * DIN + n0 + cc] * W8_SCALE, -F8_MAX), F8_MAX); }
        __syncthreads();
#pragma unroll
        for (int i = 0; i < 2; ++i) { const int idx = tid + 512 * i, n = idx >> 4, k4 = idx & 15;
            int wd = __builtin_amdgcn_cvt_pk_fp8_f32(t[(4 * k4) * 65 + n], t[(4 * k4 + 1) * 65 + n], 0, false);
            wd = __builtin_amdgcn_cvt_pk_fp8_f32(t[(4 * k4 + 2) * 65 + n], t[(4 * k4 + 3) * 65 + n], wd, true);
            *(int*)(dst + (size_t)wperm(n0 + n) * 1024 + k0 + 4 * k4) = wd; }
        __syncthreads();
    }
}
DI void row_to_fp8(const f32x4 (&o)[4], unsigned char* x8row, int ln) {
    u32x4 w;
#pragma unroll
    for (int q = 0; q < 4; ++q) {
        const float a0 = fminf(fmaxf(o[q][0] * X8_SCALE, -F8_MAX), F8_MAX), a1 = fminf(fmaxf(o[q][1] * X8_SCALE, -F8_MAX), F8_MAX), a2 = fminf(fmaxf(o[q][2] * X8_SCALE, -F8_MAX), F8_MAX), a3 = fminf(fmaxf(o[q][3] * X8_SCALE, -F8_MAX), F8_MAX);
        int wd = __builtin_amdgcn_cvt_pk_fp8_f32(a0, a1, 0, false); wd = __builtin_amdgcn_cvt_pk_fp8_f32(a2, a3, wd, true); w[q] = (unsigned)wd; }
    *(u32x4*)(x8row + 16 * ln) = w;
}
typedef float f32x16 __attribute__((ext_vector_type(16)));
constexpr unsigned UVREC = 1024;
DI float wmax(float m) { m = fmaxf(m, __shfl_xor(m, 32)); m = fmaxf(m, __shfl_xor(m, 16)); m = fmaxf(m, __shfl_xor(m, 8)); m = fmaxf(m, __shfl_xor(m, 4)); m = fmaxf(m, __shfl_xor(m, 2)); m = fmaxf(m, __shfl_xor(m, 1)); return m; }
DI void conv_fp6_rows(const float* usrc, const float* vsrc, unsigned char* ws, int unit) {
    const int tid = mk_tid(), lane = tid & 63, w = tid >> 6;
    const size_t row = (size_t)unit * 8 + w;
    const float* up = usrc + row * 1024 + 16 * lane; const float* vp = vsrc + row * 1024 + 16 * lane;
    f32x16 a, b; float mu = 0.f, mv = 0.f;
#pragma unroll
    for (int q = 0; q < 4; ++q) { const f32x4 x = *(const f32x4*)(up + 4 * q), y = *(const f32x4*)(vp + 4 * q);
#pragma unroll
        for (int j = 0; j < 4; ++j) { a[4 * q + j] = x[j]; b[4 * q + j] = y[j]; mu = fmaxf(mu, fabsf(x[j])); mv = fmaxf(mv, fabsf(y[j])); } }
    mu = wmax(mu); mv = wmax(mv);
    const float su = (mu > 0.f) ? 6.0f / mu : 1.0f, sv = (mv > 0.f) ? 6.0f / mv : 1.0f;
    unsigned u0 = 0u, u1 = 0u, v0 = 0u, v1 = 0u;
#define MK_PK4(i) u0 = __builtin_amdgcn_cvt_scalef32_pk_fp4_f32(u0, a[2 * i] * su, a[2 * i + 1] * su, 1.0f, i); u1 = __builtin_amdgcn_cvt_scalef32_pk_fp4_f32(u1, a[8 + 2 * i] * su, a[8 + 2 * i + 1] * su, 1.0f, i); \
                  v0 = __builtin_amdgcn_cvt_scalef32_pk_fp4_f32(v0, b[2 * i] * sv, b[2 * i + 1] * sv, 1.0f, i); v1 = __builtin_amdgcn_cvt_scalef32_pk_fp4_f32(v1, b[8 + 2 * i] * sv, b[8 + 2 * i + 1] * sv, 1.0f, i);
    MK_PK4(0) MK_PK4(1) MK_PK4(2) MK_PK4(3)
#undef MK_PK4
    unsigned char* rec = ws + WS_UV8 + row * UVREC;
    *(u32x4*)(rec + 16 * lane) = (u32x4){u0, u1, v0, v1};
    if (lane == 0) { float* sp = (float*)(ws + WS_UVS) + row * 2; sp[0] = (mu > 0.f) ? mu * (1.0f / 6.0f) : 1.0f; sp[1] = (mv > 0.f) ? mv * (1.0f / 6.0f) : 1.0f; }
}
DI void phase_conv(const Args& a, int layer, LAS unsigned char* lds) {
    unsigned char* ws = a.ws;
    LAS float* t = (LAS float*)lds;
    const int J0 = 216, J1 = J0 + 128, J2 = J1 + 256, J3 = J2 + 256, J4 = J3 + 256, J5 = J4 + 512, J6 = J5 + 32, J7 = J6 + 2048, J8 = J7, J9 = J8 + 64, J10 = J9 + 1;
    const int total = J10;
    for (int u = blockIdx.x; u < total; u += gridDim.x) {
        if (u < J0) { w8_unit(a.in[1] + (size_t)layer * 1024 * DIN, ws, u, t); }
        else if (u < J1) { const int v = u - J0, kt = v / 16, nt = v % 16; tconv_tile<false>(a.in[9] + (size_t)layer * 2560 * 1024, 1024, (bf16_t*)(ws + WS_WBAT), 512, kt * 64, nt * 64, t); }
        else if (u < J2) { const int v = u - J1, kt = v / 16, nt = v % 16; tconv_tile<false>(a.in[9] + (size_t)layer * 2560 * 1024 + (size_t)512 * 1024, 1024, (bf16_t*)(ws + WS_WBBT), 1024, kt * 64, nt * 64, t); }
        else if (u < J3) { const int v = u - J2, kt = v / 16, nt = v % 16; tconv_tile<false>(a.in[9] + (size_t)layer * 2560 * 1024 + (size_t)1536 * 1024, 1024, (bf16_t*)(ws + WS_WBCT), 1024, kt * 64, nt * 64, t); }
        else if (u < J4) { const int v = u - J3, kt = v / 16, nt = v % 16; tconv_tile<false>(a.in[10] + (size_t)layer * 1024 * 1024, 1024, (bf16_t*)(ws + WS_WOT), 1024, kt * 64, nt * 64, t); }
        else if (u < J5) { const int v = u - J4, kt = v / 32, nt = v % 32; tconv_tile<false>(a.in[13] + (size_t)layer * 1024 * 2048, 2048, (bf16_t*)(ws + WS_WQT), 1024, kt * 64, nt * 64, t); }
        else if (u < J6) { const int v = u - J5, blk = v & 15, which = v >> 4;
            tconv_tile<false>(a.in[which ? 6 : 4] + ((size_t)layer * 16 + blk) * 4096, 64, (bf16_t*)(ws + (which ? WS_WXT : WS_WAT)) + blk * 4096, 64, 0, 0, t, -1.4426950408889634f); }
        else if (u < J7) { conv_fp6_rows(a.in[16] + (size_t)layer * 16384 * 1024, a.in[17] + (size_t)layer * 16384 * 1024, ws, u - J6); }
        else if (u < J9) { const int v = u - J8; if (v < 32) conv_unit(a.in[14] + (size_t)layer * 131072, (bf16_t*)(ws + WS_K1B), v); else conv_unit(a.in[15] + (size_t)layer * 131072, (bf16_t*)(ws + WS_K2B), v - 32); }
        else { for (int c = mk_tid(); c < 1024; c += 512) { const float lam = a.in[8][layer * 1024 + c]; const float e = __builtin_amdgcn_exp2f(-lam * 1.4426950408889634f); const float sp = (e < 0.05f) ? e * (1.0f + e * (-0.5f + e * (0.33333333f + e * -0.25f))) : __builtin_amdgcn_logf(1.0f + e) * 0.6931471805599453f; ((float*)(ws + WS_CCH))[c] = -8.0f * sp; } }
    }
}

DI void phase_prologue(const Args& a) {
    unsigned char* ws = a.ws;
    const int tid = mk_tid();
    for (int u = blockIdx.x; u < 2048; u += gridDim.x) {
        { const int ln = tid & 63; const size_t row = (size_t)u * 8 + (tid >> 6);
            const float* xp = a.in[0] + row * 1024 + 16 * ln; float* xo = (float*)(ws + WS_XF) + row * 1024 + 16 * ln;
            f32x4 o[4];
#pragma unroll
            for (int q = 0; q < 4; ++q) { o[q] = *(const f32x4*)(xp + 4 * q); *(f32x4*)(xo + 4 * q) = o[q]; }
            row_to_fp8(o, ws + WS_X8 + row * 1024, ln); }
    }
}

DI void attn_unit(const Args& a, int unit, LAS unsigned char* lds) {
    unsigned char* ws = a.ws;
    const int tid = mk_tid(), lane = tid & 63, w = __builtin_amdgcn_readfirstlane(tid >> 6), g = lane >> 4, l15 = lane & 15, tq4 = l15 >> 2, tp4 = l15 & 3;
    const int b = unit / 384, rem = unit % 384, h = rem >> 5, bi = rem & 31;
    const int grp = h >> 2, d = (grp == 0) ? 1 : ((grp == 1) ? 4 : 16), nb = 32 / d, r = bi / nb, n = bi % nb;
    const bf16_t* proj = (const bf16_t*)(ws + WS_PROJ); const size_t brow = (size_t)b * SEQ;
    LAS unsigned char* Ks = lds; LAS unsigned char* Vs = lds + 256 * 288;
#pragma unroll
    for (int i = 0; i < 8; ++i) {
        const int idx = tid + 512 * i, row = idx >> 4, ch = idx & 15, m = 128 * (n - 1) + row;
        u32x4 kv = {0u, 0u, 0u, 0u}, vv = {0u, 0u, 0u, 0u};
        if (m >= 0) { const size_t gr = brow + (size_t)(m * d + r); kv = *(const u32x4*)(proj + pjo(gr, OFF_AK + h * 128 + ch * 8)); vv = *(const u32x4*)(proj + pjo(gr, OFF_AV + h * 128 + ch * 8)); }
        *(LAS u32x4*)(Ks + row * 288 + ch * 16) = kv; *(LAS u32x4*)(Vs + row * 288 + ch * 16) = vv;
    }
    const int qi = 16 * w + l15;
    const size_t tq = (size_t)(128 * n + qi) * d + r;
    bf16x8 qf[4];
#pragma unroll
    for (int ks = 0; ks < 4; ++ks) qf[ks] = *(const bf16x8*)(proj + pjo(brow + tq, OFF_AQ + h * 128 + 32 * ks + 8 * g));
    __syncthreads();
    const int s0 = w >> 1;
    f32x4 sacc[10];
#pragma unroll
    for (int jj = 0; jj < 10; ++jj) {
        f32x4 acc = {0.f, 0.f, 0.f, 0.f};
#pragma unroll
        for (int ks = 0; ks < 4; ++ks) { const bf16x8 kf = *(const LAS bf16x8*)(Ks + (32 * s0 + 16 * jj + l15) * 288 + (32 * ks + 8 * g) * 2); acc = mfma16(kf, qf[ks], acc); }
        sacc[jj] = acc;
    }
    const float scale = 0.08838834764831845f * 1.4426950408889634f;
    float mx = -1e30f;
#pragma unroll
    for (int jj = 0; jj < 10; ++jj)
#pragma unroll
        for (int rg = 0; rg < 4; ++rg) {
            const int j = 32 * s0 + 16 * jj + 4 * g + rg;
            const bool valid = (j >= qi) && (j <= qi + 128) && (n > 0 || j >= 128);
            const float s = valid ? sacc[jj][rg] * scale : -1e30f;
            sacc[jj][rg] = s; mx = fmaxf(mx, s);
        }
    mx = fmaxf(mx, __shfl_xor(mx, 16)); mx = fmaxf(mx, __shfl_xor(mx, 32));
    float sum = 0.f;
#pragma unroll
    for (int jj = 0; jj < 10; ++jj)
#pragma unroll
        for (int rg = 0; rg < 4; ++rg) { const float p = __builtin_amdgcn_exp2f(sacc[jj][rg] - mx); sacc[jj][rg] = p; sum += p; }
    sum += __shfl_xor(sum, 16); sum += __shfl_xor(sum, 32);
    f32x4 oacc[8];
#pragma unroll
    for (int db = 0; db < 8; ++db) oacc[db] = (f32x4){0.f, 0.f, 0.f, 0.f};
#pragma unroll
    for (int s = 0; s < 5; ++s) {
        u32x4 pw; pw.x = pk2(sacc[2 * s][0], sacc[2 * s][1]); pw.y = pk2(sacc[2 * s][2], sacc[2 * s][3]); pw.z = pk2(sacc[2 * s + 1][0], sacc[2 * s + 1][1]); pw.w = pk2(sacc[2 * s + 1][2], sacc[2 * s + 1][3]);
        const bf16x8 pb = __builtin_bit_cast(bf16x8, pw);
        const int k0 = 32 * (s0 + s) + 4 * g + tq4;
#pragma unroll
        for (int db = 0; db < 8; ++db) {
            const s16x4 lo = trrd(Vs + k0 * 288 + (16 * db + 4 * tp4) * 2), hi = trrd(Vs + (k0 + 16) * 288 + (16 * db + 4 * tp4) * 2);
            oacc[db] = mfma16(cat8(lo, hi), pb, oacc[db]);
        }
    }
    const float inv = 1.0f / sum;
    bf16_t* op = (bf16_t*)(ws + WS_OATT) + ((size_t)b * SEQ + tq) * 1536 + h * 128 + 4 * g;
#pragma unroll
    for (int db = 0; db < 8; ++db) { u32x2 o; o.x = pk2(oacc[db][0] * inv, oacc[db][1] * inv); o.y = pk2(oacc[db][2] * inv, oacc[db][3] * inv); *(u32x2*)(op + 16 * db) = o; }
    if (g == 0) ((float*)(ws + WS_LSE))[((size_t)b * SEQ + tq) * 12 + h] = mx + __builtin_amdgcn_logf(sum);
    __syncthreads();
}

DI void retkv_unit(const Args& a, int unit, LAS unsigned char* lds) {
    unsigned char* ws = a.ws;
    const int tid = mk_tid(), lane = tid & 63, w = __builtin_amdgcn_readfirstlane(tid >> 6), g = lane >> 4, l15 = lane & 15, tq4 = l15 >> 2, tp4 = l15 & 3;
    const int b = unit >> 7, h = (unit >> 5) & 3, c = unit & 31;
    const bf16_t* proj = (const bf16_t*)(ws + WS_PROJ); const size_t brow = (size_t)b * SEQ + c * 128;
    LAS unsigned char* Ks = lds; LAS unsigned char* Vs = lds + 128 * 544;
    const float l2g = log2gamma(h);
#pragma unroll
    for (int i = 0; i < 8; ++i) {
        const int idx = tid + 512 * i, row = idx >> 5, ch = idx & 31;
        const u32x4 kv = *(const u32x4*)(proj + pjo(brow + row, OFF_RK + h * 256 + ch * 8)), vv = *(const u32x4*)(proj + pjo(brow + row, OFF_RV + h * 256 + ch * 8));
        const float z = exp2f((float)(127 - row) * l2g);
        u32x4 kz;
#pragma unroll
        for (int q = 0; q < 4; ++q) kz[q] = pk2(bflo(kv[q]) * z, bfhi(kv[q]) * z);
        *(LAS u32x4*)(Ks + row * 544 + ch * 16) = kz; *(LAS u32x4*)(Vs + row * 544 + ch * 16) = vv;
    }
    __syncthreads();
#pragma unroll 1
    for (int nh = 0; nh < 2; ++nh) {
        f32x4 acc[2][8];
#pragma unroll
        for (int mb = 0; mb < 2; ++mb)
#pragma unroll
            for (int nb = 0; nb < 8; ++nb) acc[mb][nb] = (f32x4){0.f, 0.f, 0.f, 0.f};
#pragma unroll
        for (int ks = 0; ks < 4; ++ks) {
            const int j0 = 32 * ks + 4 * g + tq4;
            bf16x8 af[2];
#pragma unroll
            for (int mb = 0; mb < 2; ++mb) { const int col = 32 * w + 16 * mb + 4 * tp4; af[mb] = cat8(trrd(Vs + j0 * 544 + col * 2), trrd(Vs + (j0 + 16) * 544 + col * 2)); }
#pragma unroll
            for (int nb = 0; nb < 8; ++nb) {
                const int col = 128 * nh + 16 * nb + 4 * tp4;
                const bf16x8 bfr = cat8(trrd(Ks + j0 * 544 + col * 2), trrd(Ks + (j0 + 16) * 544 + col * 2));
#pragma unroll
                for (int mb = 0; mb < 2; ++mb) acc[mb][nb] = mfma16(af[mb], bfr, acc[mb][nb]);
            }
        }
        bf16_t* kvb = (bf16_t*)(ws + WS_KVB) + ((size_t)((b * 4 + h) * 32 + c)) * 65536 + 128 * nh;
#pragma unroll
        for (int mb = 0; mb < 2; ++mb)
#pragma unroll
            for (int nb = 0; nb < 8; ++nb)
#pragma unroll
                for (int rg = 0; rg < 4; ++rg) kvb[(size_t)(32 * w + 16 * mb + 4 * g + rg) * 256 + 16 * nb + l15] = f2bf(acc[mb][nb][rg]);
    }
    __syncthreads();
}

DI void lru_stripe(const Args& a, int layer, int stripe, LAS unsigned char* lds) {
    unsigned char* ws = a.ws;
    const int tid = mk_tid(), lane = tid & 63, w = __builtin_amdgcn_readfirstlane(tid >> 6), g = lane >> 4, l15 = lane & 15;
    const int b = stripe >> 4, blk = stripe & 15;
    LAS bf16_t* lxs = (LAS bf16_t*)lds;
    LAS bf16_t* lgs0 = (LAS bf16_t*)(lds + 16896);
    LAS unsigned char* xcb = lds + 49664;
    LAS float* rgt = (LAS float*)(lds + 68096);
    LAS float* igt = (LAS float*)(lds + 100864);
    LAS float* wst = (LAS float*)(lds + 133632);
    const bf16_t* proj = (const bf16_t*)(ws + WS_PROJ); const size_t brow = (size_t)b * SEQ;
    const int gc = blk * 64 + lane;
    const float* cw = a.in[2] + (size_t)layer * 4096;
    const int cch_ = tid & 63, cgc = blk * 64 + cch_;
    const float cw0 = cw[cgc], cw1 = cw[1024 + cgc], cw2 = cw[2048 + cgc], cw3 = cw[3072 + cgc], cb = a.in[3][layer * 1024 + cgc];
    const float cc = ((const float*)(ws + WS_CCH))[gc] * 1.4426950408889634f;
    float bia[4], bix[4];
    LAS unsigned char* wlds = lds + 137728;
    { const int r = tid >> 3, c8 = tid & 7; *(LAS u32x4*)(wlds + r * 144 + c8 * 16) = *(const u32x4*)((const bf16_t*)(ws + WS_WAT) + blk * 4096 + r * 64 + c8 * 8); }
    bf16x8 wfx[4][2];
#pragma unroll
    for (int nb = 0; nb < 4; ++nb)
#pragma unroll
        for (int ks = 0; ks < 2; ++ks) wfx[nb][ks] = *(const bf16x8*)((const bf16_t*)(ws + WS_WXT) + blk * 4096 + (16 * nb + l15) * 64 + 32 * ks + 8 * g);
#pragma unroll
    for (int nb = 0; nb < 4; ++nb) { bia[nb] = -1.4426950408889634f * a.in[5][layer * 1024 + blk * 64 + 16 * nb + l15]; bix[nb] = -1.4426950408889634f * a.in[7][layer * 1024 + blk * 64 + 16 * nb + l15]; }
    if (tid < 24) *(LAS u32x4*)(lxs + tid * 8) = (u32x4){0u, 0u, 0u, 0u};
    u32x4 plx[2], plg[2];
#pragma unroll
    for (int i = 0; i < 2; ++i) { const int idx = tid + 512 * i, row = idx >> 3, c8 = idx & 7; plx[i] = *(const u32x4*)(proj + pjo(brow + row, OFF_LX + blk * 64 + c8 * 8)); plg[i] = *(const u32x4*)(proj + pjo(brow + row, OFF_LG + blk * 64 + c8 * 8)); }
    float hcarry = 0.0f;
#pragma unroll 1
    for (int c = 0; c < 32; ++c) {
        LAS bf16_t* lgs = lgs0 + (c & 1) * 8192;
#pragma unroll
        for (int i = 0; i < 2; ++i) { const int idx = tid + 512 * i, row = idx >> 3, c8 = idx & 7; *(LAS u32x4*)(lxs + (3 + row) * 64 + c8 * 8) = plx[i]; *(LAS u32x4*)(lgs + row * 64 + c8 * 8) = plg[i]; }
        __syncthreads();
        if (c + 1 < 32) {
#pragma unroll
            for (int i = 0; i < 2; ++i) { const int idx = tid + 512 * i, row = idx >> 3, c8 = idx & 7; const size_t gr = brow + (size_t)((c + 1) * 128 + row); plx[i] = *(const u32x4*)(proj + pjo(gr, OFF_LX + blk * 64 + c8 * 8)); plg[i] = *(const u32x4*)(proj + pjo(gr, OFF_LG + blk * 64 + c8 * 8)); }
        }
        {
            const int t0 = (tid >> 6) * 16;
            float x0 = bf2f(lxs[t0 * 64 + cch_]), x1 = bf2f(lxs[(t0 + 1) * 64 + cch_]), x2 = bf2f(lxs[(t0 + 2) * 64 + cch_]);
#pragma unroll
            for (int i = 0; i < 16; ++i) {
                const float x3 = bf2f(lxs[(t0 + i + 3) * 64 + cch_]);
                const float xc = cb + cw0 * x0 + cw1 * x1 + cw2 * x2 + cw3 * x3;
                *(LAS bf16_t*)(xcb + (t0 + i) * 144 + cch_ * 2) = f2bf(xc);
                x0 = x1; x1 = x2; x2 = x3;
            }
        }
        __syncthreads();
        if (tid < 24) *(LAS u32x4*)(lxs + tid * 8) = *(const LAS u32x4*)(lxs + 128 * 64 + tid * 8);
        {
            const bf16x8 af0 = *(const LAS bf16x8*)(xcb + (16 * w + l15) * 144 + (8 * g) * 2), af1 = *(const LAS bf16x8*)(xcb + (16 * w + l15) * 144 + (32 + 8 * g) * 2);
#pragma unroll
            for (int nb = 0; nb < 4; ++nb) {
                f32x4 ar = {0.f, 0.f, 0.f, 0.f}, ax = {0.f, 0.f, 0.f, 0.f};
                const LAS unsigned char* wr_ = wlds + (16 * nb + l15) * 144 + 16 * g;
                ar = mfma16(af0, *(const LAS bf16x8*)(wr_), ar); ar = mfma16(af1, *(const LAS bf16x8*)(wr_ + 64), ar);
                ax = mfma16(af0, wfx[nb][0], ax); ax = mfma16(af1, wfx[nb][1], ax);
#pragma unroll
                for (int rg = 0; rg < 4; ++rg) { rgt[(16 * w + 4 * g + rg) * 64 + 16 * nb + l15] = __builtin_amdgcn_rcpf(1.0f + __builtin_amdgcn_exp2f(ar[rg] + bia[nb])); igt[(16 * w + 4 * g + rg) * 64 + 16 * nb + l15] = __builtin_amdgcn_rcpf(1.0f + __builtin_amdgcn_exp2f(ax[rg] + bix[nb])); }
            }
        }
        __syncthreads();
        float av[16], bv[16]; float Aw = 1.0f, Hw = 0.0f;
#pragma unroll
        for (int tt = 0; tt < 16; ++tt) {
            const int t = 16 * w + tt;
            const float aa = __builtin_amdgcn_exp2f(cc * rgt[t * 64 + lane]);
            const float bb = __builtin_amdgcn_sqrtf(fmaxf(1.0f - aa * aa, 0.0f)) * igt[t * 64 + lane] * bf2f(*(const LAS bf16_t*)(xcb + t * 144 + lane * 2));
            av[tt] = aa; bv[tt] = bb; Hw = aa * Hw + bb; Aw *= aa;
        }
        wst[w * 64 + lane] = Aw; wst[512 + w * 64 + lane] = Hw;
        __syncthreads();
        float hcur = hcarry, hend = hcarry;
#pragma unroll
        for (int ww = 0; ww < 8; ++ww) { const float A_ = wst[ww * 64 + lane], H_ = wst[512 + ww * 64 + lane]; hend = A_ * hend + H_; if (ww < w) hcur = hend; }
        hcarry = hend;
        bf16_t* yb = (bf16_t*)(ws + WS_YB) + ((size_t)b * SEQ + c * 128 + 16 * w) * 1024 + gc;
#pragma unroll
        for (int tt = 0; tt < 16; tt += 2) {
            const float h0 = av[tt] * hcur + bv[tt]; hcur = av[tt + 1] * h0 + bv[tt + 1];
            yb[(size_t)tt * 1024] = f2bf(h0 * bf2f(lgs[(16 * w + tt) * 64 + lane])); yb[(size_t)(tt + 1) * 1024] = f2bf(hcur * bf2f(lgs[(16 * w + tt + 1) * 64 + lane]));
        }
    }
    __syncthreads();
}

DI void retscan_unit(const Args& a, int unit) {
    unsigned char* ws = a.ws;
    const int e8 = unit * 512 + mk_tid();
    const int bh = e8 >> 13, within = e8 & 8191, h = bh & 3;
    const float g128 = exp2f(128.0f * log2gamma(h));
    bf16_t* base = (bf16_t*)(ws + WS_KVB) + (size_t)bh * 32 * 65536 + (size_t)within * 8;
    float st[8];
#pragma unroll
    for (int q = 0; q < 8; ++q) st[q] = 0.f;
#pragma unroll 1
    for (int c0 = 0; c0 < 32; c0 += 8) {
        u32x4 kv[8];
#pragma unroll
        for (int q = 0; q < 8; ++q) kv[q] = *(const u32x4*)(base + (size_t)(c0 + q) * 65536);
#pragma unroll
        for (int q = 0; q < 8; ++q) {
            u32x4 o;
#pragma unroll
            for (int j = 0; j < 4; ++j) o[j] = pk2(st[2 * j], st[2 * j + 1]);
            *(u32x4*)(base + (size_t)(c0 + q) * 65536) = o;
#pragma unroll
            for (int j = 0; j < 4; ++j) { st[2 * j] = g128 * st[2 * j] + bflo(kv[q][j]); st[2 * j + 1] = g128 * st[2 * j + 1] + bfhi(kv[q][j]); }
        }
    }
}

DI void attmerge_unit(const Args& a, int unit) {
    unsigned char* ws = a.ws;
    const int idx = unit * 512 + mk_tid(), t = idx >> 6, hp = (idx >> 4) & 3, dc = idx & 15;
    const float* lse = (const float*)(ws + WS_LSE) + (size_t)t * 12;
    const float l0 = lse[hp], l1 = lse[4 + hp], l2 = lse[8 + hp];
    const float m = fmaxf(l0, fmaxf(l1, l2));
    float w0 = __builtin_amdgcn_exp2f(l0 - m), w1 = __builtin_amdgcn_exp2f(l1 - m), w2 = __builtin_amdgcn_exp2f(l2 - m);
    const float is = 1.0f / (w0 + w1 + w2); w0 *= is; w1 *= is; w2 *= is;
    const bf16_t* o = (const bf16_t*)(ws + WS_OATT) + (size_t)t * 1536 + hp * 128 + dc * 8;
    const u32x4 a0 = *(const u32x4*)o, a1 = *(const u32x4*)(o + 512), a2 = *(const u32x4*)(o + 1024);
    u32x4 r;
#pragma unroll
    for (int q = 0; q < 4; ++q) r[q] = pk2(w0 * bflo(a0[q]) + w1 * bflo(a1[q]) + w2 * bflo(a2[q]), w0 * bfhi(a0[q]) + w1 * bfhi(a1[q]) + w2 * bfhi(a2[q]));
    *(u32x4*)((bf16_t*)(ws + WS_YA) + (size_t)t * 512 + hp * 128 + dc * 8) = r;
}

DI void retout_unit(const Args& a, int unit, LAS unsigned char* lds) {
    unsigned char* ws = a.ws;
    const int tid = mk_tid(), lane = tid & 63, w = __builtin_amdgcn_readfirstlane(tid >> 6), g = lane >> 4, l15 = lane & 15, tq4 = l15 >> 2, tp4 = l15 & 3;
    const int b = unit >> 7, h = (unit >> 5) & 3, c = unit & 31;
    const bf16_t* proj = (const bf16_t*)(ws + WS_PROJ); const size_t brow = (size_t)b * SEQ + c * 128;
    const bf16_t* rt = (const bf16_t*)(ws + WS_KVB) + ((size_t)((b * 4 + h) * 32 + c)) * 65536;
    LAS unsigned char* RA = lds; LAS unsigned char* RB = lds + 128 * 544;
    const float l2g = log2gamma(h);
    const int qi = 16 * w + l15;
    bf16x8 qf[8];
#pragma unroll
    for (int ks = 0; ks < 8; ++ks) qf[ks] = *(const bf16x8*)(proj + pjo(brow + qi, OFF_RQ + h * 256 + 32 * ks + 8 * g));
#pragma unroll
    for (int i = 0; i < 8; ++i) {
        const int idx = tid + 512 * i, row = idx >> 5, ch = idx & 31;
        *(LAS u32x4*)(RA + row * 544 + ch * 16) = *(const u32x4*)(proj + pjo(brow + row, OFF_RK + h * 256 + ch * 8));
        *(LAS u32x4*)(RB + row * 544 + ch * 16) = *(const u32x4*)(rt + (size_t)row * 256 + ch * 8);
    }
    __syncthreads();
    u32x4 pv[8], pr[8];
#pragma unroll
    for (int i = 0; i < 8; ++i) {
        const int idx = tid + 512 * i, row = idx >> 5, ch = idx & 31;
        pv[i] = *(const u32x4*)(proj + pjo(brow + row, OFF_RV + h * 256 + ch * 8));
        pr[i] = *(const u32x4*)(rt + (size_t)(128 + row) * 256 + ch * 8);
    }
    f32x4 sacc[8], oacc[16];
#pragma unroll
    for (int jj = 0; jj < 8; ++jj) {
        f32x4 acc = {0.f, 0.f, 0.f, 0.f};
        if (jj <= w) {
#pragma unroll
            for (int ks = 0; ks < 8; ++ks) { const bf16x8 kf = *(const LAS bf16x8*)(RA + (16 * jj + l15) * 544 + (32 * ks + 8 * g) * 2); acc = mfma16(kf, qf[ks], acc); }
        }
        sacc[jj] = acc;
    }
#pragma unroll
    for (int db = 0; db < 8; ++db) {
        f32x4 acc = {0.f, 0.f, 0.f, 0.f};
#pragma unroll
        for (int ks = 0; ks < 8; ++ks) { const bf16x8 rf = *(const LAS bf16x8*)(RB + (16 * db + l15) * 544 + (32 * ks + 8 * g) * 2); acc = mfma16(rf, qf[ks], acc); }
        oacc[db] = acc;
    }
    __syncthreads();
#pragma unroll
    for (int i = 0; i < 8; ++i) {
        const int idx = tid + 512 * i, row = idx >> 5, ch = idx & 31;
        *(LAS u32x4*)(RA + row * 544 + ch * 16) = pv[i];
        *(LAS u32x4*)(RB + row * 544 + ch * 16) = pr[i];
    }
    __syncthreads();
#pragma unroll
    for (int db = 0; db < 8; ++db) {
        f32x4 acc = {0.f, 0.f, 0.f, 0.f};
#pragma unroll
        for (int ks = 0; ks < 8; ++ks) { const bf16x8 rf = *(const LAS bf16x8*)(RB + (16 * db + l15) * 544 + (32 * ks + 8 * g) * 2); acc = mfma16(rf, qf[ks], acc); }
        oacc[8 + db] = acc;
    }
    const float xi = __builtin_amdgcn_exp2f((float)(qi + 1) * l2g);
#pragma unroll
    for (int db = 0; db < 16; ++db) oacc[db] = oacc[db] * xi;
#pragma unroll
    for (int jj = 0; jj < 8; ++jj)
#pragma unroll
        for (int rg = 0; rg < 4; ++rg) { const int j = 16 * jj + 4 * g + rg; sacc[jj][rg] = (qi >= j) ? sacc[jj][rg] * __builtin_amdgcn_exp2f((float)(qi - j) * l2g) : 0.f; }
#pragma unroll
    for (int s = 0; s < 4; ++s) {
        if (2 * s <= w) {
            u32x4 pw; pw.x = pk2(sacc[2 * s][0], sacc[2 * s][1]); pw.y = pk2(sacc[2 * s][2], sacc[2 * s][3]); pw.z = pk2(sacc[2 * s + 1][0], sacc[2 * s + 1][1]); pw.w = pk2(sacc[2 * s + 1][2], sacc[2 * s + 1][3]);
            const bf16x8 pb = __builtin_bit_cast(bf16x8, pw);
            const int k0 = 32 * s + 4 * g + tq4;
#pragma unroll
            for (int db = 0; db < 16; ++db) {
                const s16x4 lo = trrd(RA + k0 * 544 + (16 * db + 4 * tp4) * 2), hi = trrd(RA + (k0 + 16) * 544 + (16 * db + 4 * tp4) * 2);
                oacc[db] = mfma16(cat8(lo, hi), pb, oacc[db]);
            }
        }
    }
    float s1 = 0.f;
#pragma unroll
    for (int db = 0; db < 16; ++db) s1 += (oacc[db][0] + oacc[db][1]) + (oacc[db][2] + oacc[db][3]);
    s1 += __shfl_xor(s1, 16); s1 += __shfl_xor(s1, 32);
    const float mean = s1 * (1.0f / 256.0f);
    float s2 = 0.f;
#pragma unroll
    for (int db = 0; db < 16; ++db)
#pragma unroll
        for (int rg = 0; rg < 4; ++rg) { const float dd = oacc[db][rg] - mean; s2 += dd * dd; }
    s2 += __shfl_xor(s2, 16); s2 += __shfl_xor(s2, 32);
    const float rstd = rsqrtf(s2 * (1.0f / 256.0f) + LN_EPS);
    __syncthreads();
#pragma unroll
    for (int db = 0; db < 16; ++db) {
        u32x2 o; o.x = pk2((oacc[db][0] - mean) * rstd, (oacc[db][1] - mean) * rstd); o.y = pk2((oacc[db][2] - mean) * rstd, (oacc[db][3] - mean) * rstd);
        *(LAS u32x2*)(RA + qi * 528 + (16 * db + 4 * g) * 2) = o;
    }
    __syncthreads();
#pragma unroll
    for (int i = 0; i < 8; ++i) {
        const int idx = tid + 512 * i, row = idx >> 5, ch = idx & 31;
        const u32x4 nv = *(const LAS u32x4*)(RA + row * 528 + ch * 16);
        const u32x4 gw = *(const u32x4*)(proj + pjo(brow + row, OFF_RG + h * 256 + ch * 8));
        u32x4 o;
#pragma unroll
        for (int q = 0; q < 4; ++q) { const float g0 = bflo(gw[q]), g1 = bfhi(gw[q]); o[q] = pk2(g0 * sigm(g0) * bflo(nv[q]), g1 * sigm(g1) * bfhi(nv[q])); }
        *(u32x4*)((bf16_t*)(ws + WS_YC) + ((size_t)b * SEQ + c * 128 + row) * 1024 + h * 256 + ch * 8) = o;
    }
    __syncthreads();
}

struct EpiBranch {
    static constexpr bool PERM = false, AFTER_DRAIN = false;
    const bf16_t* gate; int gcol; bf16_t* mf; bf16_t* mb; int mode;
    __device__ __forceinline__ void operator()(const f32x4 (&acc)[2][2][4][2], const pg8::Unit& u, int wr, int wc, int fr, int fq) const {
        const int row0 = u.pm * 256 + wr * 64 + fr, col0 = u.pn * 256 + wc * 32 + 4 * fq;
        bf16_t* dst = (mode == 2) ? mb : mf;
#pragma unroll
        for (int ai = 0; ai < 2; ++ai) {
            u32x2 gw[4][2][2], old[4][2][2];
#pragma unroll
            for (int m = 0; m < 4; ++m) { const size_t row = (size_t)(row0 + ai * 128 + m * 16);
#pragma unroll
                for (int bj = 0; bj < 2; ++bj)
#pragma unroll
                    for (int n = 0; n < 2; ++n) { const int col = col0 + bj * 128 + n * 16;
                        gw[m][bj][n] = *(const u32x2*)(gate + pjo(row, gcol + col));
                        old[m][bj][n] = (mode != 0) ? *(const u32x2*)(mf + row * 1024 + col) : (u32x2){0u, 0u}; } }
#pragma unroll
            for (int m = 0; m < 4; ++m) { const size_t row = (size_t)(row0 + ai * 128 + m * 16);
#pragma unroll
                for (int bj = 0; bj < 2; ++bj)
#pragma unroll
                    for (int n = 0; n < 2; ++n) { const int col = col0 + bj * 128 + n * 16;
                        const u32x2 g2 = gw[m][bj][n], o2 = old[m][bj][n];
                        f32x4 v = acc[ai][bj][m][n];
                        v[0] = v[0] * sigm(bflo(g2.x)) + bflo(o2.x); v[1] = v[1] * sigm(bfhi(g2.x)) + bfhi(o2.x);
                        v[2] = v[2] * sigm(bflo(g2.y)) + bflo(o2.y); v[3] = v[3] * sigm(bfhi(g2.y)) + bfhi(o2.y);
                        u32x2 o; o.x = pk2(v[0], v[1]); o.y = pk2(v[2], v[3]); *(u32x2*)(dst + row * 1024 + col) = o; } }
        }
    }
};
#ifndef MK_EPI_AUX
#define MK_EPI_AUX 0
#endif
struct EpiInProj {
    static constexpr bool PERM = true, AFTER_DRAIN = false;
    bf16_t* O;
    __device__ __forceinline__ void operator()(const f32x4 (&acc)[2][2][4][2], const pg8::Unit& u, int wr_, int wc_, int fr_, int fq_) const {
        (void)wr_; (void)wc_; (void)fr_; (void)fq_;
        const int tid = mk_tid(), wid = tid >> 6, lane = tid & 63, wr = wid >> 2, wc = wid & 3, fr = lane & 15, fq = lane >> 4;
        const __amdgpu_buffer_rsrc_t rsrc = __builtin_amdgcn_make_buffer_rsrc((void*)O, 0, (int)((size_t)NTOK * DIN * 2), 0x00020000);
        const int row0 = u.pm * 256 + wr * 64 + fr;
        const int pn = u.pn;
        const bool ropeA = pn < 12, ropeR = (pn >= 26 && pn < 34);
        const float dsc = 1.0f / (X8_SCALE * W8_SCALE);
        if (!(ropeA || ropeR)) {
            const int col0 = pn * 256 + 64 * wc + 8 * fq;
            const bool isLG = (pn >= 22 && pn < 26);
#pragma unroll
            for (int ai = 0; ai < 2; ++ai) {
#pragma unroll
                for (int m = 0; m < 4; ++m) { const unsigned roff = (unsigned)(pjo((size_t)(row0 + ai * 128 + m * 16), col0) * 2);
#pragma unroll
                    for (int bj = 0; bj < 2; ++bj) { f32x4 v0 = acc[ai][bj][m][0] * dsc, v1 = acc[ai][bj][m][1] * dsc;
                        if (isLG) { const pg8::f32x2 g0 = pg8::gelu_pk((pg8::f32x2){v0[0], v0[1]}), g1 = pg8::gelu_pk((pg8::f32x2){v0[2], v0[3]}), g2 = pg8::gelu_pk((pg8::f32x2){v1[0], v1[1]}), g3 = pg8::gelu_pk((pg8::f32x2){v1[2], v1[3]});
                            v0 = (f32x4){g0.x, g0.y, g1.x, g1.y}; v1 = (f32x4){g2.x, g2.y, g3.x, g3.y}; }
                        u32x4 w; w.x = pk2(v0[0], v0[1]); w.y = pk2(v0[2], v0[3]); w.z = pk2(v1[0], v1[1]); w.w = pk2(v1[2], v1[3]);
                        __builtin_amdgcn_raw_buffer_store_b128(w, rsrc, (int)(roff + bj * 64), 0, MK_EPI_AUX); } }
            }
        } else {
            const int half = ropeA ? 64 : 128;
            const float sc = dsc * ((pn >= 30 && pn < 34) ? 0.0625f : 1.0f);
            const float kf = ropeA ? (-13.287712379549449f / 64.0f) : (-13.287712379549449f / 128.0f);
            const float pos0 = (float)(row0 & (SEQ - 1));
            const int j0 = ropeA ? (32 * (wc & 1) + 8 * fq) : (32 * wc + 8 * fq);
            const int lcol = ropeA ? (128 * (wc >> 1) + j0) : j0;
            float cb[8], sb[8], c16[8], s16[8], cb1[8], sb1[8];
#pragma unroll
            for (int i = 0; i < 8; ++i) {
                const float f = __builtin_amdgcn_exp2f((float)(j0 + i) * kf) * 0.15915494309189535f;
                const float t0 = __builtin_amdgcn_fractf(pos0 * f), t16 = __builtin_amdgcn_fractf(16.0f * f), t128 = __builtin_amdgcn_fractf(128.0f * f);
                cb[i] = __builtin_amdgcn_cosf(t0); sb[i] = __builtin_amdgcn_sinf(t0);
                c16[i] = __builtin_amdgcn_cosf(t16); s16[i] = __builtin_amdgcn_sinf(t16);
                const float c128 = __builtin_amdgcn_cosf(t128), s128 = __builtin_amdgcn_sinf(t128);
                cb1[i] = cb[i] * c128 - sb[i] * s128; sb1[i] = sb[i] * c128 + cb[i] * s128;
            }
#pragma unroll
            for (int ai = 0; ai < 2; ++ai) {
                float cv[8], sv[8];
#pragma unroll
                for (int i = 0; i < 8; ++i) { cv[i] = ai ? cb1[i] : cb[i]; sv[i] = ai ? sb1[i] : sb[i]; }
#pragma unroll
                for (int m = 0; m < 4; ++m) {
                    const int row = row0 + ai * 128 + m * 16;
                    const unsigned roff = (unsigned)(pjo((size_t)row, pn * 256 + lcol) * 2);
                    float o1[8], o2[8];
#pragma unroll
                    for (int i = 0; i < 8; ++i) { const float t1 = acc[ai][0][m][i >> 2][i & 3] * sc, t2 = acc[ai][1][m][i >> 2][i & 3] * sc; o1[i] = t1 * cv[i] - t2 * sv[i]; o2[i] = t1 * sv[i] + t2 * cv[i]; }
                    u32x4 w1, w2;
#pragma unroll
                    for (int q = 0; q < 4; ++q) { w1[q] = pk2(o1[2 * q], o1[2 * q + 1]); w2[q] = pk2(o2[2 * q], o2[2 * q + 1]); }
                    __builtin_amdgcn_raw_buffer_store_b128(w1, rsrc, (int)roff, 0, MK_EPI_AUX);
                    __builtin_amdgcn_raw_buffer_store_b128(w2, rsrc, (int)(roff + half * 2), 0, MK_EPI_AUX);
                    if (m < 3) {
#pragma unroll
                        for (int i = 0; i < 8; ++i) { const float cn = cv[i] * c16[i] - sv[i] * s16[i], sn = sv[i] * c16[i] + cv[i] * s16[i]; cv[i] = cn; sv[i] = sn; } }
                }
            }
        }
    }
};

struct EpiOut {
    static constexpr bool PERM = false, AFTER_DRAIN = false;
    const float* xf; float* z;
    __device__ __forceinline__ void operator()(const f32x4 (&acc)[2][2][4][2], const pg8::Unit& u, int wr, int wc, int fr, int fq) const {
        const int row0 = u.pm * 256 + wr * 64 + fr, col0 = u.pn * 256 + wc * 32 + 4 * fq;
#pragma unroll
        for (int ai = 0; ai < 2; ++ai) {
            f32x4 xv[4][2][2];
#pragma unroll
            for (int m = 0; m < 4; ++m) { const size_t row = (size_t)(row0 + ai * 128 + m * 16);
#pragma unroll
                for (int bj = 0; bj < 2; ++bj)
#pragma unroll
                    for (int n = 0; n < 2; ++n) xv[m][bj][n] = *(const f32x4*)(xf + row * 1024 + col0 + bj * 128 + n * 16); }
#pragma unroll
            for (int m = 0; m < 4; ++m) { const size_t row = (size_t)(row0 + ai * 128 + m * 16);
#pragma unroll
                for (int bj = 0; bj < 2; ++bj)
#pragma unroll
                    for (int n = 0; n < 2; ++n) *(f32x4*)(z + row * 1024 + col0 + bj * 128 + n * 16) = xv[m][bj][n] * ALPHA + acc[ai][bj][m][n]; }
        }
    }
};

DI void ln_row(const float* z, const float* gam, const float* bet, float* of, bf16_t* ob, int lane) {
    f32x4 v[4]; float s = 0.f;
#pragma unroll
    for (int i = 0; i < 4; ++i) { v[i] = *(const f32x4*)(z + 256 * i + 4 * lane); s += (v[i][0] + v[i][1]) + (v[i][2] + v[i][3]); }
    const float mean = wsum(s) * (1.0f / 1024.0f);
    float q = 0.f;
#pragma unroll
    for (int i = 0; i < 4; ++i)
#pragma unroll
        for (int j = 0; j < 4; ++j) { const float d = v[i][j] - mean; q += d * d; }
    const float rstd = rsqrtf(wsum(q) * (1.0f / 1024.0f) + LN_EPS);
#pragma unroll
    for (int i = 0; i < 4; ++i) {
        const f32x4 gg = *(const f32x4*)(gam + 256 * i + 4 * lane), bb = *(const f32x4*)(bet + 256 * i + 4 * lane);
        f32x4 o;
#pragma unroll
        for (int j = 0; j < 4; ++j) o[j] = (v[i][j] - mean) * rstd * gg[j] + bb[j];
        *(f32x4*)(of + 256 * i + 4 * lane) = o;
        u32x2 pb; pb.x = pk2(o[0], o[1]); pb.y = pk2(o[2], o[3]); *(u32x2*)(ob + 256 * i + 4 * lane) = pb;
    }
}
DI void phase_ln1(const Args& a, int layer) {
    unsigned char* ws = a.ws;
    const int lane = mk_tid() & 63, w = mk_tid() >> 6;
    for (int u = blockIdx.x; u < NTOK / 8; u += gridDim.x) {
        const size_t row = (size_t)u * 8 + w;
        ln_row((const float*)(ws + WS_MRGF) + row * 1024, a.in[11] + layer * 1024, a.in[12] + layer * 1024, (float*)(ws + WS_XF) + row * 1024, (bf16_t*)(ws + WS_XB) + row * 1024, lane);
    }
}

DI void ins16(float (&L)[16], float x) {
#pragma unroll
    for (int k = 0; k < 16; ++k) { const float hi = fmaxf(L[k], x); x = fminf(L[k], x); L[k] = hi; }
}
DI void merge16(float (&L)[16], int xr) {
    float t[16];
#pragma unroll
    for (int k = 0; k < 16; ++k) t[k] = __shfl_xor(L[k], xr);
#pragma unroll
    for (int k = 0; k < 8; ++k) { const float x = t[k]; t[k] = t[15 - k]; t[15 - k] = x; }
#pragma unroll
    for (int k = 0; k < 16; ++k) t[k] = fmaxf(L[k], t[k]);
#define MK_CE_STAGE(dd) _Pragma("unroll") for (int k = 0; k < 16; ++k) if ((k & (dd)) == 0) { const float hi = fmaxf(t[k], t[k + (dd)]), lo = fminf(t[k], t[k + (dd)]); t[k] = hi; t[k + (dd)] = lo; }
    MK_CE_STAGE(8) MK_CE_STAGE(4) MK_CE_STAGE(2) MK_CE_STAGE(1)
#undef MK_CE_STAGE
#pragma unroll
    for (int k = 0; k < 16; ++k) L[k] = t[k];
}
#define MK_CE_DESC(v, i, l) { const float hi_ = fmaxf(v[i], v[l]), lo_ = fminf(v[i], v[l]); v[i] = hi_; v[l] = lo_; }
#define MK_CE_ASC(v, i, l)  { const float hi_ = fmaxf(v[i], v[l]), lo_ = fminf(v[i], v[l]); v[i] = lo_; v[l] = hi_; }
#define MK_BITONIC_STAGE(v, kk, jj) _Pragma("unroll") for (int i_ = 0; i_ < 16; ++i_) { if ((i_ & (jj)) == 0) { if ((i_ & (kk)) == 0) MK_CE_DESC(v, i_, i_ + (jj)) else MK_CE_ASC(v, i_, i_ + (jj)) } }
DI void sort16_desc(float (&v)[16]) {
    MK_BITONIC_STAGE(v, 2, 1)
    MK_BITONIC_STAGE(v, 4, 2) MK_BITONIC_STAGE(v, 4, 1)
    MK_BITONIC_STAGE(v, 8, 4) MK_BITONIC_STAGE(v, 8, 2) MK_BITONIC_STAGE(v, 8, 1)
    MK_BITONIC_STAGE(v, 16, 8) MK_BITONIC_STAGE(v, 16, 4) MK_BITONIC_STAGE(v, 16, 2) MK_BITONIC_STAGE(v, 16, 1)
}
DI void top16_of_two(float (&a)[16], const float (&b)[16]) {
#pragma unroll
    for (int k = 0; k < 16; ++k) a[k] = fmaxf(a[k], b[15 - k]);
    MK_BITONIC_STAGE(a, 16, 8) MK_BITONIC_STAGE(a, 16, 4) MK_BITONIC_STAGE(a, 16, 2) MK_BITONIC_STAGE(a, 16, 1)
}
DI void top16_half(const bf16_t* qp, const LAS unsigned char* kt, float (&L)[16], int g, int l15) {
    bf16x8 qf[4];
#pragma unroll
    for (int ks = 0; ks < 4; ++ks) qf[ks] = *(const bf16x8*)(qp + 32 * ks + 8 * g);
    float M[16];
#pragma unroll
    for (int kbk = 0; kbk < 8; ++kbk) {
        f32x4 acc = {0.f, 0.f, 0.f, 0.f};
#pragma unroll
        for (int ks = 0; ks < 4; ++ks) { const bf16x8 kf = *(const LAS bf16x8*)(kt + (16 * kbk + l15) * 256 + (((4 * ks + g) ^ l15) << 4)); acc = mfma16(kf, qf[ks], acc); }
#pragma unroll
        for (int rg = 0; rg < 4; ++rg) { const unsigned key = (unsigned)(16 * kbk + 4 * g + rg); const float x = __uint_as_float((__float_as_uint(acc[rg]) & ~0x7Fu) | key);
            if (kbk < 4) L[4 * kbk + rg] = x; else M[4 * (kbk - 4) + rg] = x; }
    }
    sort16_desc(L); sort16_desc(M); top16_of_two(L, M);
    merge16(L, 16); merge16(L, 32);
}
DI void topk_unit(const Args& a, int unit, LAS unsigned char* lds) {
    unsigned char* ws = a.ws;
    const int tid = mk_tid(), lane = tid & 63, w = __builtin_amdgcn_readfirstlane(tid >> 6), g = lane >> 4, l15 = lane & 15;
    const int tg = w & 3, hs = w >> 2;
    const size_t t = (size_t)unit * 64 + tg * 16 + l15;
    const bf16_t* Q = (const bf16_t*)(ws + WS_Q);
    LAS unsigned char* tiles = lds + 16384;
    float K1[16], K2[16];
#pragma unroll
    for (int k = 0; k < 16; ++k) { K1[k] = 0.f; K2[k] = 0.f; }
#pragma unroll 1
    for (int hh = 0; hh < 4; ++hh) {
#pragma unroll
        for (int i = 0; i < 16; ++i) {
            const int idx = tid + 512 * i, tile = idx >> 11, row = (idx >> 4) & 127, ch = idx & 15;
            const int hd = ((tile >> 1) ? 4 : 0) + hh;
            const bf16_t* src = (const bf16_t*)(ws + ((tile & 1) ? WS_K2B : WS_K1B)) + ((size_t)hd * 128 + row) * 128 + ch * 8;
            *(LAS u32x4*)(tiles + tile * 32768 + row * 256 + ((ch ^ (row & 15)) << 4)) = *(const u32x4*)src;
        }
        __syncthreads();
        const int h = hs * 4 + hh;
        float l1[16], l2[16];
        top16_half(Q + t * 2048 + h * 256, tiles + (hs * 2) * 32768, l1, g, l15);
        top16_half(Q + t * 2048 + h * 256 + 128, tiles + (hs * 2 + 1) * 32768, l2, g, l15);
        const bool mine = (g == hh);
#pragma unroll
        for (int k = 0; k < 16; ++k) { K1[k] = mine ? l1[k] : K1[k]; K2[k] = mine ? l2[k] : K2[k]; }
        __syncthreads();
    }
    const int h = hs * 4 + g;
    float F[16];
#pragma unroll
    for (int k = 0; k < 16; ++k) F[k] = -FLT_MAX;
#pragma unroll
    for (int ia = 0; ia < 16; ++ia)
#pragma unroll
        for (int ib = 0; ib < 16 / (ia + 1); ++ib) {
            const float s = __uint_as_float(__float_as_uint(K1[ia]) & ~0x7Fu) + __uint_as_float(__float_as_uint(K2[ib]) & ~0x7Fu);
            ins16(F, __uint_as_float((__float_as_uint(s) & ~0xFFu) | (unsigned)(ia * 16 + ib)));
        }
    LAS unsigned char* row = lds + tid * 32;
#pragma unroll
    for (int k = 0; k < 16; ++k) { row[k] = (unsigned char)(__float_as_uint(K1[k]) & 0x7Fu); row[16 + k] = (unsigned char)(__float_as_uint(K2[k]) & 0x7Fu); }
    float gt[16]; int ei[16]; float gs = 0.f;
    const float cv0 = __uint_as_float(__float_as_uint(F[0]) & ~0xFFu);
#pragma unroll
    for (int k = 0; k < 16; ++k) {
        const unsigned bits = __float_as_uint(F[k]);
        const float cv = __uint_as_float(bits & ~0xFFu);
        gt[k] = __builtin_amdgcn_exp2f((cv - cv0) * 1.4426950408889634f); gs += gt[k];
        const int ia = (int)((bits >> 4) & 15u), ib = (int)(bits & 15u);
        ei[k] = (int)row[ia] * 128 + (int)row[16 + ib];
    }
    const float ig = 1.0f / gs;
    int* ep = (int*)(ws + WS_EID) + (t * 8 + h) * 16; float* gp = (float*)(ws + WS_GATE) + (t * 8 + h) * 16;
#pragma unroll
    for (int q = 0; q < 4; ++q) {
        *(i32x4*)(ep + 4 * q) = (i32x4){ei[4 * q], ei[4 * q + 1], ei[4 * q + 2], ei[4 * q + 3]};
        *(f32x4*)(gp + 4 * q) = (f32x4){gt[4 * q] * ig, gt[4 * q + 1] * ig, gt[4 * q + 2] * ig, gt[4 * q + 3] * ig};
    }
    __syncthreads();
}

typedef float f32x2 __attribute__((ext_vector_type(2)));
typedef __bf16 bf16x32 __attribute__((ext_vector_type(32)));
typedef unsigned u32x16 __attribute__((ext_vector_type(16)));
#define MK_PB_LOAD(RA_, ereg, kb) _Pragma("unroll") for (int j = 0; j < 8; ++j) { const int e_ = __builtin_amdgcn_readlane(ereg, (kb) + j); \
        RA_[j] = ((const u32x4*)(UV + (size_t)(unsigned)e_ * UVREC))[lane]; }
#define MK_U4(w, s) __builtin_bit_cast(unsigned, __builtin_amdgcn_cvt_scalef32_pk_bf16_fp4(w, 1.0f, s))
#define MK_V4(w, s) __builtin_amdgcn_cvt_scalef32_pk_f32_fp4(w, 1.0f, s)
#define MK_PB_COMP(RA_, usreg, gvreg, kb) { \
        float pp_[8]; \
        _Pragma("unroll") for (int j = 0; j < 8; ++j) { \
            float s0_ = 0.f, s1_ = 0.f; \
            s0_ = dot2(MK_U4(RA_[j][0], 0), xpk[0], s0_); s1_ = dot2(MK_U4(RA_[j][0], 1), xpk[1], s1_); s0_ = dot2(MK_U4(RA_[j][0], 2), xpk[2], s0_); s1_ = dot2(MK_U4(RA_[j][0], 3), xpk[3], s1_); \
            s0_ = dot2(MK_U4(RA_[j][1], 0), xpk[4], s0_); s1_ = dot2(MK_U4(RA_[j][1], 1), xpk[5], s1_); s0_ = dot2(MK_U4(RA_[j][1], 2), xpk[6], s0_); s1_ = dot2(MK_U4(RA_[j][1], 3), xpk[7], s1_); \
            pp_[j] = s0_ + s1_; } \
        float q4_[4], r2_[2]; \
        _Pragma("unroll") for (int i = 0; i < 4; ++i) { const float keep_ = hi32 ? pp_[4 + i] : pp_[i], send_ = hi32 ? pp_[i] : pp_[4 + i]; q4_[i] = keep_ + __shfl_xor(send_, 32); } \
        _Pragma("unroll") for (int i = 0; i < 2; ++i) { const float keep_ = hi16 ? q4_[2 + i] : q4_[i], send_ = hi16 ? q4_[i] : q4_[2 + i]; r2_[i] = keep_ + __shfl_xor(send_, 16); } \
        float tot_ = (hi8 ? r2_[1] : r2_[0]) + __shfl_xor(hi8 ? r2_[0] : r2_[1], 8); \
        tot_ += __shfl_xor(tot_, 4); tot_ += __shfl_xor(tot_, 2); tot_ += __shfl_xor(tot_, 1); \
        const float act_ = gelu_as(tot_ * __shfl(usreg, (kb) + jj)) * __shfl(gvreg, (kb) + jj); \
        _Pragma("unroll") for (int j = 0; j < 8; ++j) { \
            const float aj_ = __uint_as_float(__builtin_amdgcn_readlane(__float_as_uint(act_), 32 * (j >> 2) + 16 * ((j >> 1) & 1) + 8 * (j & 1))); const f32x2 a2_ = {aj_, aj_}; \
            y2[0] += a2_ * MK_V4(RA_[j][2], 0); y2[1] += a2_ * MK_V4(RA_[j][2], 1); y2[2] += a2_ * MK_V4(RA_[j][2], 2); y2[3] += a2_ * MK_V4(RA_[j][2], 3); \
            y2[4] += a2_ * MK_V4(RA_[j][3], 0); y2[5] += a2_ * MK_V4(RA_[j][3], 1); y2[6] += a2_ * MK_V4(RA_[j][3], 2); y2[7] += a2_ * MK_V4(RA_[j][3], 3); } }
DI void peer_token(const unsigned char* UV, int e0, int e1, float us0, float us1, float gv0, float gv1, const unsigned (&xpk)[8], f32x2 (&y2)[8], int lane) {
    const bool hi32 = (lane & 32) != 0, hi16 = (lane & 16) != 0, hi8 = (lane & 8) != 0;
    const int jj = ((lane >> 5) & 1) * 4 + ((lane >> 4) & 1) * 2 + ((lane >> 3) & 1);
    u32x4 A0[8], A1[8];
    MK_PB_LOAD(A0, e0, 0)
#pragma unroll 1
    for (int b = 0; b < 8; b += 2) {
        MK_PB_LOAD(A1, e0, 8 * b + 8)
        MK_PB_COMP(A0, us0, gv0, 8 * b)
        if (b + 2 < 8) { MK_PB_LOAD(A0, e0, 8 * b + 16) } else { MK_PB_LOAD(A0, e1, 0) }
        MK_PB_COMP(A1, us0, gv0, 8 * b + 8)
    }
#pragma unroll 1
    for (int b = 0; b < 8; b += 2) {
        MK_PB_LOAD(A1, e1, 8 * b + 8)
        MK_PB_COMP(A0, us1, gv1, 8 * b)
        if (b + 2 < 8) { MK_PB_LOAD(A0, e1, 8 * b + 16) }
        MK_PB_COMP(A1, us1, gv1, 8 * b + 8)
    }
}
DI void peer_unit(const Args& a, int layer, int unit) {
    unsigned char* ws = a.ws;
    const int tid = mk_tid(), lane = tid & 63, w = __builtin_amdgcn_readfirstlane(tid >> 6);
    const unsigned char* UV = ws + WS_UV8; const float* SC = (const float*)(ws + WS_UVS);
#pragma unroll 1
    for (int i = 0; i < 8; ++i) {
        const size_t t = (size_t)unit * 64 + w * 8 + i;
        unsigned xpk[8]; f32x2 y2[8];
        int e0, e1; float us0, us1, gv0, gv1;
        {
            const int ln = mk_tid() & 63;
            const bf16_t* xbp = (const bf16_t*)(ws + WS_XB) + t * 1024 + 16 * ln;
            const u32x4 xa = *(const u32x4*)xbp, xb = *(const u32x4*)(xbp + 8);
#pragma unroll
            for (int q = 0; q < 4; ++q) { xpk[q] = xa[q]; xpk[4 + q] = xb[q]; }
            const int* ep = (const int*)(ws + WS_EID) + t * 128; const float* gp = (const float*)(ws + WS_GATE) + t * 128;
            e0 = ep[ln]; e1 = ep[64 + ln]; const float g0 = gp[ln], g1 = gp[64 + ln];
            const f32x2 s0 = *(const f32x2*)(SC + 2 * e0), s1 = *(const f32x2*)(SC + 2 * e1);
            us0 = s0.x; us1 = s1.x; gv0 = g0 * s0.y; gv1 = g1 * s1.y;
        }
#pragma unroll
        for (int q = 0; q < 8; ++q) y2[q] = (f32x2){0.f, 0.f};
        peer_token(UV, e0, e1, us0, us1, gv0, gv1, xpk, y2, lane);
        {
            const int ln = mk_tid() & 63;
            float* xfp = (float*)(ws + WS_XF) + t * 1024 + 16 * ln;
            const float* gam = a.in[18] + layer * 1024 + 16 * ln; const float* bet = a.in[19] + layer * 1024 + 16 * ln;
            float z[16]; float s = 0.f;
#pragma unroll
            for (int q = 0; q < 4; ++q) { const f32x4 xr = *(const f32x4*)(xfp + 4 * q);
#pragma unroll
                for (int j = 0; j < 4; ++j) { z[4 * q + j] = ALPHA * xr[j] + y2[2 * q + (j >> 1)][j & 1]; s += z[4 * q + j]; } }
            const float mean = wsum(s) * (1.0f / 1024.0f);
            float qq = 0.f;
#pragma unroll
            for (int q = 0; q < 16; ++q) { const float d = z[q] - mean; qq += d * d; }
            const float rstd = rsqrtf(wsum(qq) * (1.0f / 1024.0f) + LN_EPS);
            f32x4 o[4];
#pragma unroll
            for (int q = 0; q < 4; ++q) { const f32x4 gq = *(const f32x4*)(gam + 4 * q), bq = *(const f32x4*)(bet + 4 * q);
#pragma unroll
                for (int j = 0; j < 4; ++j) o[q][j] = (z[4 * q + j] - mean) * rstd * gq[j] + bq[j]; }
#pragma unroll
            for (int q = 0; q < 4; ++q) *(f32x4*)(xfp + 4 * q) = o[q];
            if (layer == DEPTH - 1) { float* op = a.out + t * 1024 + 16 * ln;
#pragma unroll
                for (int q = 0; q < 4; ++q) *(f32x4*)(op + 4 * q) = o[q]; }
            row_to_fp8(o, ws + WS_X8 + t * 1024, ln);
        }
    }
}
}

namespace mk {
constexpr int LDS_ARG_OFF = LDS_BYTES - 16 - 256;
#define MK_NOINL __device__ __forceinline__
DI unsigned long long rfl64(unsigned long long v) { const unsigned lo = __builtin_amdgcn_readfirstlane((unsigned)v), hi = __builtin_amdgcn_readfirstlane((unsigned)(v >> 32)); return ((unsigned long long)hi << 32) | lo; }
DI Args load_args(LAS unsigned char* lds) {
    int aoff = LDS_ARG_OFF; asm volatile("" : "+s"(aoff));
    Args a; const LAS unsigned long long* p = (const LAS unsigned long long*)(lds + aoff);
#pragma unroll
    for (int i = 0; i < 20; ++i) a.in[i] = (const float*)(const __attribute__((address_space(1))) float*)rfl64(p[i]);
    a.out = (float*)(__attribute__((address_space(1))) float*)rfl64(p[20]); a.ws = (unsigned char*)(__attribute__((address_space(1))) unsigned char*)rfl64(p[21]);
    a.ropeA = __longlong_as_double((long long)rfl64(p[22])); a.ropeR = __longlong_as_double((long long)rfl64(p[23])); a.ph_lo = 0; a.ph_hi = 0;
    return a;
}
#define MK_LOADARGS const Args a = load_args(lds); unsigned char* ws = a.ws; const int G = (int)gridDim.x, bid = (int)blockIdx.x; (void)ws; (void)G; (void)bid
MK_NOINL void PG_prologue(LAS unsigned char* lds) { MK_LOADARGS; phase_prologue(a); }
MK_NOINL void P0_conv(LAS unsigned char* lds, int layer) { MK_LOADARGS; phase_conv(a, layer, lds); }
#ifndef MK_STAGGER_TICKS
#define MK_STAGGER_TICKS 140
#endif
MK_NOINL void P1_inproj(LAS unsigned char* lds, int layer) { MK_LOADARGS; (void)layer;
    pg8::Gemm gm; gm.A = (const bf16_t*)(ws + WS_X8); gm.Bt = (const bf16_t*)(ws + WS_WINT); gm.M = NTOK; gm.N = DIN; gm.K = 512;
    pg8::StaticOrder S; S.init(NTOK, DIN, G, bid);
    EpiInProj E; E.O = (bf16_t*)(ws + WS_PROJ);
    pg8::gemm_phase<EpiInProj, pg8::StaticOrder, false, true, true>(lds, gm, S, E, nullptr); }
#ifndef MK_NLRU
#define MK_NLRU 64
#endif
MK_NOINL void P3s_lru(LAS unsigned char* lds, int layer) { MK_LOADARGS; if (bid < MK_NLRU) { for (int s = bid; s < 64; s += MK_NLRU) lru_stripe(a, layer, s, lds); } }
MK_NOINL void P3a_attn(LAS unsigned char* lds, int layer) { MK_LOADARGS; (void)layer; if (bid >= MK_NLRU) { for (int u = bid - MK_NLRU; u < 1536; u += G - MK_NLRU) attn_unit(a, u, lds); } }
MK_NOINL void P3b_retkv(LAS unsigned char* lds, int layer) { MK_LOADARGS; (void)layer; if (bid >= MK_NLRU) { for (int u = bid - MK_NLRU; u < 512; u += G - MK_NLRU) retkv_unit(a, u, lds); } }
MK_NOINL void P4a_scan(LAS unsigned char* lds, int layer) { MK_LOADARGS; (void)layer; for (int u = bid; u < 256; u += G) retscan_unit(a, u); }
MK_NOINL void P4c_merge(LAS unsigned char* lds, int layer) { MK_LOADARGS; (void)layer; for (int u = bid; u < 2048; u += G) attmerge_unit(a, u); }
MK_NOINL void P5_retout(LAS unsigned char* lds, int layer) { MK_LOADARGS; (void)layer; for (int u = bid; u < 512; u += G) retout_unit(a, u, lds); }
MK_NOINL void P6_branch(LAS unsigned char* lds, int layer) { MK_LOADARGS; (void)layer;
#pragma unroll 1
    for (int s = 0; s < 3; ++s) {
        pg8::Gemm gm; gm.A = (const bf16_t*)(ws + (s == 0 ? WS_YA : (s == 1 ? WS_YB : WS_YC))); gm.Bt = (const bf16_t*)(ws + (s == 0 ? WS_WBAT : (s == 1 ? WS_WBBT : WS_WBCT)));
        gm.M = NTOK; gm.N = 1024; gm.K = (s == 0) ? 512 : 1024;
        pg8::StaticOrder S; S.init(NTOK, 1024, G, bid);
        EpiBranch E; E.gate = (const bf16_t*)(ws + WS_PROJ); E.gcol = OFF_GA + 1024 * s; E.mf = (bf16_t*)(ws + WS_MRGF); E.mb = (bf16_t*)(ws + WS_MRGB); E.mode = s;
        pg8::gemm_phase<EpiBranch, pg8::StaticOrder, false>(lds, gm, S, E, nullptr);
    } }
MK_NOINL void P7_outproj(LAS unsigned char* lds, int layer) { MK_LOADARGS; (void)layer;
    pg8::Gemm gm; gm.A = (const bf16_t*)(ws + WS_MRGB); gm.Bt = (const bf16_t*)(ws + WS_WOT); gm.M = NTOK; gm.N = 1024; gm.K = 1024;
    pg8::StaticOrder S; S.init(NTOK, 1024, G, bid);
    EpiOut E; E.xf = (const float*)(ws + WS_XF); E.z = (float*)(ws + WS_MRGF);
    pg8::gemm_phase<EpiOut, pg8::StaticOrder, false>(lds, gm, S, E, nullptr); }
MK_NOINL void P8_ln1(LAS unsigned char* lds, int layer) { MK_LOADARGS; phase_ln1(a, layer); }
MK_NOINL void P9_wq(LAS unsigned char* lds, int layer) { MK_LOADARGS; (void)layer;
    pg8::Gemm gm; gm.A = (const bf16_t*)(ws + WS_XB); gm.Bt = (const bf16_t*)(ws + WS_WQT); gm.M = NTOK; gm.N = 2048; gm.K = 1024;
    pg8::StaticOrder S; S.init(NTOK, 2048, G, bid);
    pg8::EpiBf16<0> E; E.O = (bf16_t*)(ws + WS_Q); E.ldc = 2048; E.bias = nullptr; E.split_cols = 0; E.split_stride = 0;
    pg8::gemm_phase<pg8::EpiBf16<0>, pg8::StaticOrder, false>(lds, gm, S, E, nullptr); }
MK_NOINL void P10_topk(LAS unsigned char* lds, int layer) { MK_LOADARGS; (void)layer; for (int u = bid; u < NTOK / 64; u += G) topk_unit(a, u, lds); }
MK_NOINL void P11_peer(LAS unsigned char* lds, int layer) { MK_LOADARGS; for (int u = bid; u < NTOK / 64; u += G) peer_unit(a, layer, u); }
DI void mk_sync(LAS unsigned char* lds) {
    const Args a = load_args(lds);
    XcdBarrier b; b.bar = (unsigned*)(a.ws + WS_CTL); b.x = xb_xcc_id(); b.st = (volatile LAS unsigned*)(lds + LDS_BAR_OFF);
    xcd_barrier(b);
}
}

#ifndef MK_PHASE_MASK
#define MK_PHASE_MASK 0xFFFu
#endif
#define MK_RUN(k) ((((MK_PHASE_MASK) >> ((k) - pb)) & 1u) && (k) >= ph_lo && (k) < ph_hi)
#define MK_NPHASES (1 + mk::DEPTH * mk::NPH)

#define MK_SYNC(k) do { if ((k) >= ph_lo && (k) + 1 < ph_hi) mk::mk_sync(lds); } while (0)
__global__ __launch_bounds__(512, 2) void mk_fwd(mk::Args a) {
    using namespace mk;
    extern __shared__ __attribute__((aligned(16))) unsigned char smem_raw[];
    LAS unsigned char* lds = (LAS unsigned char*)smem_raw;
    const int ph_lo = a.ph_lo, ph_hi = a.ph_hi;
    {
        const unsigned* src = (const unsigned*)&a;
        if (threadIdx.x < sizeof(Args) / 4) ((LAS unsigned*)(lds + LDS_ARG_OFF))[threadIdx.x] = src[threadIdx.x];
        if (threadIdx.x == 0) { LAS unsigned* st = (LAS unsigned*)(lds + LDS_BAR_OFF); st[0] = 0u; st[1] = 0u; st[2] = 0u; st[3] = 0u; }
    }
    __syncthreads();
    if (ph_hi - ph_lo > 1) (void)xcd_barrier_post((unsigned*)(a.ws + WS_CTL), (volatile LAS unsigned*)(lds + LDS_BAR_OFF));
    if (0 >= ph_lo && 0 < ph_hi) PG_prologue(lds);
    MK_SYNC(0);
#pragma unroll 1
    for (int layer = 0; layer < DEPTH; ++layer) {
        const int pb = 1 + layer * NPH;
        if (MK_RUN(pb + 0)) P0_conv(lds, layer);
        MK_SYNC(pb + 0);
        if (MK_RUN(pb + 1)) P1_inproj(lds, layer);
        MK_SYNC(pb + 1);
        if (MK_RUN(pb + 3)) { P3s_lru(lds, layer); P3a_attn(lds, layer); P3b_retkv(lds, layer); }
        MK_SYNC(pb + 3);
        if (MK_RUN(pb + 4)) { P4a_scan(lds, layer); P4c_merge(lds, layer); }
        MK_SYNC(pb + 4);
        if (MK_RUN(pb + 5)) P5_retout(lds, layer);
        MK_SYNC(pb + 5);
        if (MK_RUN(pb + 6)) P6_branch(lds, layer);
        MK_SYNC(pb + 6);
        if (MK_RUN(pb + 7)) P7_outproj(lds, layer);
        MK_SYNC(pb + 7);
        if (MK_RUN(pb + 8)) P8_ln1(lds, layer);
        MK_SYNC(pb + 8);
        if (MK_RUN(pb + 9)) P9_wq(lds, layer);
        MK_SYNC(pb + 9);
        if (MK_RUN(pb + 10)) P10_topk(lds, layer);
        if (MK_RUN(pb + 11)) P11_peer(lds, layer);
        MK_SYNC(pb + 11);
    }
}

#ifndef MK_SINGLE
#define MK_SINGLE 1
#endif
extern "C" void kernel_launch(void* const* d_in, const int* in_sizes, int n_in, void* d_out, int out_size, void* d_ws, size_t ws_size, hipStream_t stream) {
    using namespace mk;
    static int grid = 0;
    if (grid == 0) {
        if (n_in != 20 || out_size != NTOK * D || ws_size < WS_END) { fprintf(stderr, "kernel_launch: unexpected shapes (n_in %d, out %d, ws %zu, need %zu)\n", n_in, out_size, ws_size, (size_t)WS_END); grid = -1; return; }
        int dev = 0, cus = 0, per_cu = 0;
        if (hipGetDevice(&dev) != hipSuccess || hipDeviceGetAttribute(&cus, hipDeviceAttributeMultiprocessorCount, dev) != hipSuccess) { grid = -1; return; }
        if (hipFuncSetAttribute((const void*)mk_fwd, hipFuncAttributeMaxDynamicSharedMemorySize, LDS_BYTES) != hipSuccess) { fprintf(stderr, "kernel_launch: hipFuncSetAttribute failed\n"); grid = -1; return; }
        if (hipOccupancyMaxActiveBlocksPerMultiprocessor(&per_cu, (const void*)mk_fwd, 512, LDS_BYTES) != hipSuccess || per_cu < 1) { fprintf(stderr, "kernel_launch: occupancy query says %d blocks per CU\n", per_cu); (void)hipGetLastError(); grid = -1; return; }
        grid = cus;
    }
    if (grid < 0) return;
    (void)in_sizes;
    Args a{};
    for (int i = 0; i < 20; ++i) a.in[i] = (const float*)d_in[i];
    a.out = (float*)d_out; a.ws = (unsigned char*)d_ws;
    a.ropeA = pow(10000.0, -2.0 / 128.0); a.ropeR = pow(10000.0, -2.0 / 256.0);
#if MK_SINGLE
    (void)hipMemsetAsync((unsigned char*)d_ws + WS_CTL, 0, 16384, stream);
    a.ph_lo = 0; a.ph_hi = MK_NPHASES;
    hipLaunchKernelGGL(mk_fwd, dim3(grid), dim3(512), LDS_BYTES, stream, a);
#else
    for (int p = 0; p < MK_NPHASES; ++p) { a.ph_lo = p; a.ph_hi = p + 1; hipLaunchKernelGGL(mk_fwd, dim3(grid), dim3(512), LDS_BYTES, stream, a); }
#endif
}
```

```cpp
#include <hip/hip_runtime.h>
#include <cstdio>
#include <cstdint>
#include <cmath>
#include <cfloat>
__device__ __forceinline__ int mk_tid() { int t = (int)threadIdx.x; asm volatile("" : "+v"(t)); return t; }
namespace pg8 {
#define PG8_LAS __attribute__((address_space(3)))
typedef unsigned short bf16_t;
typedef short bf16x8 __attribute__((ext_vector_type(8)));
typedef float f32x4 __attribute__((ext_vector_type(4)));
typedef unsigned u32x4 __attribute__((ext_vector_type(4)));
constexpr int BM = 256, BK = 64, HALF = 128, HTB = HALF * BK * 2  , STAGE_BYTES = 8 * HTB, NXCD = 8, WGM = 8;

__host__ __device__ __forceinline__ int lds_byte(int r, int c) { const int st = (r >> 4) * 2 + (c >> 5), rr = r & 15, cc = c & 31, ob = rr * 64 + cc * 2; return st * 1024 + (ob ^ (((ob >> 9) & 1) << 5)); }
__host__ __device__ __forceinline__ void stage_rc(int b, int& R, int& C) { const int st = b / 1024, sb = b % 1024, swz = sb ^ (((sb >> 9) & 1) << 5); R = (st >> 1) * 16 + swz / 64; C = (st & 1) * 32 + (swz % 64) / 2; }
__host__ __device__ __forceinline__ int perm32(int rho) { const int n = rho >> 4, i = rho & 15; return 8 * (i >> 2) + 4 * n + (i & 3); }

struct Unit { int pm, pn; };
struct Gemm { const bf16_t* A; const bf16_t* Bt; int M, N, K; };

struct StaticOrder {
    int nM, nN, nwg, G, c;
    __host__ __device__ void init(int M, int N, int G_, int c_) { nM = M / BM; nN = N / BM; nwg = nM * nN; G = G_; c = c_; }
    __host__ __device__ bool next(int i, Unit& u) const {
        const long L = (long)i * G + c; if (L >= nwg) return false;
        int wgid = (int)L; { const int q = nwg / NXCD, r = nwg % NXCD, xcd = wgid % NXCD, off = wgid / NXCD; wgid = (xcd < r ? xcd * (q + 1) : r * (q + 1) + (xcd - r) * q) + off; }
        const int nig = WGM * nN, gid = wgid / nig, fm = gid * WGM, gsz = (nM - fm) < WGM ? (nM - fm) : WGM;
        u.pm = fm + ((wgid % nig) % gsz); u.pn = (wgid % nig) / gsz; return true;
    }
    __device__ __forceinline__ void a_ready(const Unit&) const {}
    __device__ __forceinline__ void done(const Unit&) const {}
};
typedef __bf16 pg8_bf16x2 __attribute__((ext_vector_type(2)));
__device__ __forceinline__ unsigned cvt_pk_bf16(float lo, float hi) { const pg8_bf16x2 v = {(__bf16)lo, (__bf16)hi}; return __builtin_bit_cast(unsigned, v); }
typedef float f32x2 __attribute__((ext_vector_type(2)));
__device__ __forceinline__ f32x2 gelu_pk(f32x2 v) {
    const f32x2 av = __builtin_elementwise_abs(v), d = av * 0.2316418882f + 1.0f;
    f32x2 t; t.x = __builtin_amdgcn_rcpf(d.x); t.y = __builtin_amdgcn_rcpf(d.y);
    f32x2 q = t * 0.5307027145f + (-0.7265760135f); q = q * t + 0.7107068705f; q = q * t + (-0.142248368f); q = q * t + 0.127414796f; q = q * t;
    const f32x2 s = (v * v) * (-0.72134752044f);
    f32x2 e; e.x = __builtin_amdgcn_exp2f(s.x); e.y = __builtin_amdgcn_exp2f(s.y);
    const f32x2 m = v * (q * e), r = v - m;
    f32x2 o; o.x = v.x < 0.f ? m.x : r.x; o.y = v.y < 0.f ? m.y : r.y; return o;
}

struct EpiF32 {
    static constexpr bool PERM = false, AFTER_DRAIN = false;
    float* C; int ldc; const float* bias;
    __device__ __forceinline__ void operator()(const f32x4 (&acc)[2][2][4][2], const Unit& u, int wr, int wc, int fr, int fq) const {
        const int row0 = u.pm * BM + wr * 64 + fr, col0 = u.pn * BM + wc * 32 + 4 * fq;
        f32x4 bv[2][2];
#pragma unroll
        for (int bj = 0; bj < 2; ++bj)
#pragma unroll
            for (int n = 0; n < 2; ++n) bv[bj][n] = bias ? *(const f32x4*)(bias + col0 + bj * HALF + n * 16) : (f32x4){0.f, 0.f, 0.f, 0.f};
#pragma unroll
        for (int ai = 0; ai < 2; ++ai)
#pragma unroll
            for (int m = 0; m < 4; ++m) { float* rowp = C + (size_t)(row0 + ai * HALF + m * 16) * ldc + col0;
#pragma unroll
                for (int bj = 0; bj < 2; ++bj)
#pragma unroll
                    for (int n = 0; n < 2; ++n) *(f32x4*)(rowp + bj * HALF + n * 16) = acc[ai][bj][m][n] + bv[bj][n]; }
    }
};
template <int ACT  > struct EpiBf16 {
    static constexpr bool PERM = true, AFTER_DRAIN = false;
    bf16_t* O; int ldc; const float* bias; int split_cols; size_t split_stride;
    __device__ __forceinline__ void operator()(const f32x4 (&acc)[2][2][4][2], const Unit& u, int wr, int wc, int fr, int fq) const {
        const int row0 = u.pm * BM + wr * 64 + fr; int colt = u.pn * BM; bf16_t* base = O;
        if (split_cols) { const int t = colt / split_cols; base += (size_t)t * split_stride; colt -= t * split_cols; }
        const int col0 = colt + wc * 32 + 8 * fq, bcol0 = u.pn * BM + wc * 32 + 8 * fq;
        f32x4 bv[2][2];
#pragma unroll
        for (int bj = 0; bj < 2; ++bj)
#pragma unroll
            for (int n = 0; n < 2; ++n) bv[bj][n] = bias ? *(const f32x4*)(bias + bcol0 + bj * HALF + 4 * n) : (f32x4){0.f, 0.f, 0.f, 0.f};
#pragma unroll
        for (int ai = 0; ai < 2; ++ai)
#pragma unroll
            for (int m = 0; m < 4; ++m) { bf16_t* rowp = base + (size_t)(row0 + ai * HALF + m * 16) * ldc + col0;
#pragma unroll
                for (int bj = 0; bj < 2; ++bj) { f32x4 v0 = acc[ai][bj][m][0] + bv[bj][0], v1 = acc[ai][bj][m][1] + bv[bj][1];
                    if (ACT == 1) { f32x2 a = gelu_pk((f32x2){v0[0], v0[1]}), b = gelu_pk((f32x2){v0[2], v0[3]}), c = gelu_pk((f32x2){v1[0], v1[1]}), d = gelu_pk((f32x2){v1[2], v1[3]});
                        v0 = (f32x4){a.x, a.y, b.x, b.y}; v1 = (f32x4){c.x, c.y, d.x, d.y}; }
                    if (ACT == 2) {
#pragma unroll
                        for (int j = 0; j < 4; ++j) { v0[j] = 0.5f * v0[j] * (1.0f + erff(v0[j] * 0.70710678f)); v1[j] = 0.5f * v1[j] * (1.0f + erff(v1[j] * 0.70710678f)); } }
                    u32x4 w; w.x = cvt_pk_bf16(v0[0], v0[1]); w.y = cvt_pk_bf16(v0[2], v0[3]); w.z = cvt_pk_bf16(v1[0], v1[1]); w.w = cvt_pk_bf16(v1[2], v1[3]);
                    *(u32x4*)(rowp + bj * HALF) = w; } }
    }
};

typedef int i32x8 __attribute__((ext_vector_type(8)));
typedef short s16x16 __attribute__((ext_vector_type(16)));
__device__ __forceinline__ i32x8 pg8_cat16(bf16x8 a, bf16x8 b) { return __builtin_bit_cast(i32x8, (s16x16)__builtin_shufflevector(a, b, 0, 1, 2, 3, 4, 5, 6, 7, 8, 9, 10, 11, 12, 13, 14, 15)); }
template <class E, class = void> struct epi_seg { static constexpr bool value = false; };
template <class E> struct epi_seg<E, decltype((void)E::SEGMENTED)> { static constexpr bool value = E::SEGMENTED; };
template <class Epi, class Sched, bool STAMP = false, bool F8 = false, bool WIDE = false>
__device__ __forceinline__ void gemm_phase(PG8_LAS unsigned char* lds, const Gemm g, const Sched& S, const Epi& E, unsigned long long* stamps) {
    const int tid = mk_tid(), wid = __builtin_amdgcn_readfirstlane(tid >> 6), lane = tid & 63, wr = wid >> 2, wc = wid & 3, fr = lane & 15, fq = lane >> 4;
    const int K = g.K, nt = K / BK;
    int ts_lo = 0, ts_hi = 0, nts = 0; const unsigned long long rt_entry = STAMP ? (unsigned long long)wall_clock64() : 0ull;
#define PG8_STAMP() do { if (STAMP && wid == 0 && nts < 64) { const unsigned long long _c = (unsigned long long)clock64(); \
        ts_lo = (lane == nts) ? (int)(unsigned)_c : ts_lo; ts_hi = (lane == nts) ? (int)(unsigned)(_c >> 32) : ts_hi; ++nts; } } while (0)
    PG8_STAMP();
    unsigned voffA, voffB;
    { int R, C; stage_rc(tid * 16, R, C); const int Ri = Epi::PERM ? perm32(R & 31) : (R & 31); const int Rb = WIDE ? (((R >> 5) << 6) + Ri) : ((R & ~31) + Ri);
        voffA = (unsigned)(R * K + C) * 2u; voffB = (unsigned)(Rb * K + C) * 2u; }
    const size_t qstep = (size_t)64 * K * 2;
    const size_t qstepB = WIDE ? (size_t)128 * K * 2 : qstep;
    const size_t hstepB = WIDE ? (size_t)32 * K * 2 : (size_t)HALF * K * 2;
    const size_t kstep = (size_t)(BK * 2);
    const size_t hstep = (size_t)HALF * K * 2;
    const size_t tstep = 2 * hstep;
    const unsigned ldsw = (unsigned)wid * 1024u;
    const int aoff = lds_byte(wr * 64 + fr, fq * 8), boff = lds_byte(wc * 32 + fr, fq * 8);
#define PG8_SA(b, h) (((b) * 2 + (h)) * HTB)
#define PG8_SB(b, h) ((4 + (b) * 2 + (h)) * HTB)
#define PG8_STAGE(bufoff, gbase, voff) PG8_STAGEQ(bufoff, gbase, voff, qstep)
#define PG8_STAGEB(bufoff, gbase, voff) PG8_STAGEQ(bufoff, gbase, voff, qstepB)
#define PG8_STAGEQ(bufoff, gbase, voff, qs) do { const char* _g0 = (const char*)(gbase); const char* _g1 = _g0 + (qs); asm volatile("" : "+s"(_g0), "+s"(_g1));   \
        __builtin_amdgcn_global_load_lds((const unsigned*)(_g0 + (voff)), (PG8_LAS unsigned*)(lds + (bufoff) + ldsw), 16, 0, 0); \
        __builtin_amdgcn_global_load_lds((const unsigned*)(_g1 + (voff)), (PG8_LAS unsigned*)(lds + (bufoff) + ldsw + 8192), 16, 0, 0); } while (0)
#define PG8_LDA(dst, b, h) do { _Pragma("unroll") for (int m = 0; m < 4; ++m) _Pragma("unroll") for (int k = 0; k < 2; ++k) dst[m][k] = *(const PG8_LAS bf16x8*)(lds + PG8_SA(b, h) + aoff + m * 2048 + k * 1024); } while (0)
#define PG8_LDB(dst, b, h) do { _Pragma("unroll") for (int n = 0; n < 2; ++n) _Pragma("unroll") for (int k = 0; k < 2; ++k) dst[n][k] = *(const PG8_LAS bf16x8*)(lds + PG8_SB(b, h) + boff + n * 2048 + k * 1024); } while (0)
#define PG8_MMA(ai, bj, At, Bt) do { __builtin_amdgcn_s_setprio(1); _Pragma("unroll") for (int m = 0; m < 4; ++m) _Pragma("unroll") for (int n = 0; n < 2; ++n) { \
        if constexpr (F8) acc[ai][bj][m][n] = __builtin_amdgcn_mfma_scale_f32_16x16x128_f8f6f4(pg8_cat16(Bt[n][0], Bt[n][1]), pg8_cat16(At[m][0], At[m][1]), acc[ai][bj][m][n], 0, 0, 0, 0, 0, 0); \
        else { _Pragma("unroll") for (int k = 0; k < 2; ++k) acc[ai][bj][m][n] = __builtin_amdgcn_mfma_f32_16x16x32_bf16(Bt[n][k], At[m][k], acc[ai][bj][m][n], 0, 0, 0); } } \
        __builtin_amdgcn_s_setprio(0); } while (0)
#define PG8_WAIT_V(n) asm volatile("s_waitcnt vmcnt(" #n ")" ::: "memory")
#define PG8_WAIT_L(n) asm volatile("s_waitcnt lgkmcnt(" #n ")" ::: "memory")
#define PG8_BAR __builtin_amdgcn_s_barrier()
#define PG8_SCHED __builtin_amdgcn_sched_barrier(0)
    Unit cur, nxt; int ui = 0;
    if (!S.next(0, cur)) return;
    __builtin_amdgcn_s_waitcnt(0x0F70);
    f32x4 acc[2][2][4][2];
    bf16x8 At[4][2], B0[2][2], B1[2][2];
    const char* cA = (const char*)g.A + (size_t)cur.pm * tstep; const char* cB = (const char*)g.Bt + (size_t)cur.pn * tstep;
    S.a_ready(cur);
    PG8_STAGEB(PG8_SB(0, 0), cB, voffB); PG8_STAGE(PG8_SA(0, 0), cA, voffA); PG8_STAGEB(PG8_SB(0, 1), cB + hstepB, voffB); PG8_STAGE(PG8_SA(0, 1), cA + hstep, voffA);
    if (wr == 1) PG8_BAR;
    PG8_WAIT_V(4); PG8_BAR;
    PG8_STAGEB(PG8_SB(1, 0), cB + kstep, voffB); PG8_STAGE(PG8_SA(1, 0), cA + kstep, voffA); PG8_STAGEB(PG8_SB(1, 1), cB + hstepB + kstep, voffB);
    PG8_WAIT_V(6); PG8_BAR;
    PG8_STAMP();
#pragma unroll
    for (int a = 0; a < 2; ++a)
#pragma unroll
        for (int b = 0; b < 2; ++b)
#pragma unroll
            for (int m = 0; m < 4; ++m)
#pragma unroll
                for (int n = 0; n < 2; ++n) acc[a][b][m][n] = (f32x4){0.f, 0.f, 0.f, 0.f};
    for (;;) {
        const bool has_next = S.next(ui + 1, nxt);
        const char* nA = has_next ? (const char*)g.A + (size_t)nxt.pm * tstep : cA; const char* nB = has_next ? (const char*)g.Bt + (size_t)nxt.pn * tstep : cB;
        for (int t = 0; t < nt; t += 2) {
            const bool last = (t == nt - 2);
            const char* a1 = cA + (size_t)(t + 1) * kstep;
            const char* a2 = last ? nA : cA + (size_t)(t + 2) * kstep; const char* b2 = last ? nB : cB + (size_t)(t + 2) * kstep;
            const char* a3 = a2 + kstep; const char* b3 = b2 + kstep;
            if (last && has_next) S.a_ready(nxt);
            if constexpr (epi_seg<Epi>::value) { if (t == E.t1) E.rescale(acc, cur, 0); else if (t == E.t2) E.rescale(acc, cur, 1); }
            PG8_LDB(B0, 0, 0); PG8_SCHED; PG8_LDA(At, 0, 0); PG8_STAGE(PG8_SA(1, 1), a1 + hstep, voffA);
            PG8_WAIT_L(8); PG8_BAR; PG8_WAIT_L(0); PG8_MMA(0, 0, At, B0); PG8_BAR; PG8_SCHED;
            PG8_LDB(B1, 0, 1); PG8_STAGEB(PG8_SB(0, 0), b2, voffB);
            PG8_BAR; PG8_WAIT_L(0); PG8_MMA(0, 1, At, B1); PG8_BAR;
            PG8_LDA(At, 0, 1); PG8_STAGE(PG8_SA(0, 0), a2, voffA);
            PG8_BAR; PG8_WAIT_L(0); PG8_MMA(1, 0, At, B0); PG8_BAR; PG8_SCHED;
            PG8_STAGEB(PG8_SB(0, 1), b2 + hstepB, voffB);
            PG8_WAIT_V(6); PG8_BAR; PG8_MMA(1, 1, At, B1); PG8_BAR;
            PG8_LDB(B0, 1, 0); PG8_SCHED; PG8_LDA(At, 1, 0); PG8_STAGE(PG8_SA(0, 1), a2 + hstep, voffA);
            PG8_WAIT_L(8); PG8_BAR; PG8_WAIT_L(0); PG8_MMA(0, 0, At, B0); PG8_BAR; PG8_SCHED;
            PG8_LDB(B1, 1, 1); PG8_STAGEB(PG8_SB(1, 0), b3, voffB);
            PG8_BAR; PG8_WAIT_L(0); PG8_MMA(0, 1, At, B1); PG8_BAR;
            PG8_LDA(At, 1, 1); PG8_STAGE(PG8_SA(1, 0), a3, voffA);
            PG8_BAR; PG8_WAIT_L(0); PG8_MMA(1, 0, At, B0); PG8_BAR; PG8_SCHED;
            PG8_STAGEB(PG8_SB(1, 1), b3 + hstepB, voffB);
            PG8_WAIT_V(6); PG8_BAR; PG8_MMA(1, 1, At, B1); PG8_BAR;
        }
        PG8_STAMP();
        if constexpr (!Epi::AFTER_DRAIN) { E(acc, cur, wr, wc, fr, fq); S.done(cur); }
        PG8_STAMP();
        if (!has_next) break;
#pragma unroll
        for (int a = 0; a < 2; ++a)
#pragma unroll
            for (int b = 0; b < 2; ++b)
#pragma unroll
                for (int m = 0; m < 4; ++m)
#pragma unroll
                    for (int n = 0; n < 2; ++n) acc[a][b][m][n] = (f32x4){0.f, 0.f, 0.f, 0.f};
        cur = nxt; cA = nA; cB = nB; ++ui;
    }
    PG8_WAIT_V(0);
    if (wr == 0) PG8_BAR;
    PG8_BAR;
    if constexpr (Epi::AFTER_DRAIN) { E.fused(acc, cur, wr, wc, fr, fq, lds, wid, lane); S.done(cur); }
    PG8_STAMP();
    if (STAMP && wid == 0) { stamps[lane] = lane < nts ? (((unsigned long long)(unsigned)ts_hi << 32) | (unsigned)ts_lo) : 0ull;
        if (lane == 62) stamps[62] = rt_entry; if (lane == 63) stamps[63] = (unsigned long long)wall_clock64(); }
#undef PG8_STAMP
#undef PG8_SA
#undef PG8_SB
#undef PG8_STAGE
#undef PG8_STAGEB
#undef PG8_STAGEQ
#undef PG8_LDA
#undef PG8_LDB
#undef PG8_MMA
#undef PG8_WAIT_V
#undef PG8_WAIT_L
#undef PG8_BAR
#undef PG8_SCHED
}
}
#define XB_TMO      128
#define XB_XCNT(j)  (256  + 64 * (j))
#define XB_XSUB(j)  (1280 + 64 * (j))
#define XB_XGEN(j)  (2304 + 64 * (j))
#define XB_TOP      3328
#define XB_TOPGEN   3392
#define XCD_BAR_WORDS 3456
#define XB_SPIN_CAP (1u << 18)
#define LAS __attribute__((address_space(3)))

__device__ __forceinline__ unsigned xb_ld(unsigned* p)              { return __hip_atomic_load(p, __ATOMIC_RELAXED, __HIP_MEMORY_SCOPE_AGENT); }
__device__ __forceinline__ unsigned xb_add(unsigned* p, unsigned v) { return __hip_atomic_fetch_add(p, v, __ATOMIC_RELAXED, __HIP_MEMORY_SCOPE_AGENT); }
__device__ __forceinline__ unsigned xb_xcc_id() { return (unsigned)__builtin_amdgcn_s_getreg((3 << 11) | 20) & 0xFu; }
#define XB_SPIN(cond, bar) do { unsigned _sp = 0; while (cond) { __builtin_amdgcn_s_sleep(1); \
    if ((++_sp & 255u) == 0u) { if (xb_ld(&(bar)[XB_TMO])) break; if (_sp > XB_SPIN_CAP) { atomicAdd(&(bar)[XB_TMO], 1u); break; } } } } while (0)

struct XcdBarrier {
    unsigned* bar; unsigned x;
    volatile LAS unsigned* st;
};

__device__ __forceinline__ XcdBarrier xcd_barrier_post(unsigned* bar, volatile LAS unsigned* st) {
    XcdBarrier b; b.bar = bar; b.x = xb_xcc_id(); b.st = st;
    if (threadIdx.x == 0) (void)xb_add(&bar[XB_XCNT(b.x)], 1u);
    return b;
}
__device__ __forceinline__ void xcd_barrier_complete(unsigned* bar, unsigned x, unsigned& nloc, unsigned& nx) {
    const unsigned G = gridDim.x * gridDim.y * gridDim.z;
    unsigned sum, cnt, mine, sp = 0u;
    for (;;) {
        sum = 0u; cnt = 0u; mine = 0u;
#pragma unroll
        for (unsigned j = 0; j < 16; ++j) { const unsigned c = xb_ld(&bar[XB_XCNT(j)]); sum += c; cnt += (c > 0u) ? 1u : 0u; mine = (j == x) ? c : mine; }
        if (sum == G) break;
        __builtin_amdgcn_s_sleep(1);
        if ((++sp & 255u) == 0u) { if (xb_ld(&bar[XB_TMO])) break; if (sp > XB_SPIN_CAP) { atomicAdd(&bar[XB_TMO], 1u); break; } }
    }
    nloc = mine > 0u ? mine : 1u; nx = cnt > 0u ? cnt : 1u;
}

__device__ __forceinline__ void xcd_barrier(const XcdBarrier& b) {
    asm volatile("s_waitcnt vmcnt(0)" ::: "memory");
    __syncthreads();
    if (threadIdx.x == 0) {
        unsigned* bar = b.bar;
        __builtin_amdgcn_s_waitcnt(0);
        unsigned nloc = b.st[0], nx = b.st[1];
        if (nloc == 0u) { xcd_barrier_complete(bar, b.x, nloc, nx); b.st[0] = nloc; b.st[1] = nx; }
        const unsigned old = xb_add(&bar[XB_XSUB(b.x)], 1u);
        const unsigned gen = old / nloc;
        if (old + 1u == (gen + 1u) * nloc) {
            __builtin_amdgcn_fence(__ATOMIC_RELEASE, "agent");
            asm volatile("s_waitcnt vmcnt(0)" ::: "memory");
            const unsigned og = xb_add(&bar[XB_TOP], 1u);
            const unsigned tg = og / nx;
            if (og + 1u == (tg + 1u) * nx) xb_add(&bar[XB_TOPGEN], 1u);
            else XB_SPIN(xb_ld(&bar[XB_TOPGEN]) == tg, bar);
            __builtin_amdgcn_fence(__ATOMIC_ACQUIRE, "agent");
            xb_add(&bar[XB_XGEN(b.x)], 1u);
            asm volatile("s_waitcnt vmcnt(0)" ::: "memory");
        } else {
            XB_SPIN(xb_ld(&bar[XB_XGEN(b.x)]) == gen, bar);
            __builtin_amdgcn_fence(__ATOMIC_ACQUIRE, "agent");
            asm volatile("s_waitcnt vmcnt(0)" ::: "memory");
        }
    }
    __syncthreads();
}

namespace mk {
using pg8::bf16_t; using pg8::bf16x8; using pg8::f32x4; using pg8::u32x4;
typedef short s16x4 __attribute__((ext_vector_type(4)));
typedef unsigned u32x2 __attribute__((ext_vector_type(2)));
typedef __bf16 bf16x2v __attribute__((ext_vector_type(2)));
typedef int i32x4 __attribute__((ext_vector_type(4)));
#define DI __device__ __forceinline__

constexpr int D = 1024, SEQ = 4096, NTOK = 16384, DEPTH = 4, DIN = 13824;
constexpr int OFF_AQ = 0, OFF_AK = 1536, OFF_AV = 3072, OFF_LX = 4608, OFF_LG = 5632, OFF_RQ = 6656, OFF_RK = 7680, OFF_RV = 8704, OFF_RG = 9728, OFF_GA = 10752;
constexpr float ALPHA = 1.681792830507429f;
constexpr float LN_EPS = 1e-5f;
constexpr float X8_SCALE = 32.0f, W8_SCALE = 2048.0f, F8_MAX = 440.0f;
constexpr int NPH = 12;
constexpr int LDS_BYTES = 148 * 1024;
constexpr int LDS_BAR_OFF = LDS_BYTES - 16;

constexpr size_t WS_CTL  = 0;
constexpr size_t WS_COSA = 16384;
constexpr size_t WS_SINA = WS_COSA + (size_t)4096 * 64 * 4;
constexpr size_t WS_COSR = WS_SINA + (size_t)4096 * 64 * 4;
constexpr size_t WS_SINR = WS_COSR + (size_t)4096 * 128 * 4;
constexpr size_t WS_CCH  = WS_SINR + (size_t)4096 * 128 * 4;
constexpr size_t WS_WAT  = WS_CCH + 4096;
constexpr size_t WS_WXT  = WS_WAT + 131072;
constexpr size_t WS_LSTA = WS_WXT + 131072;
constexpr size_t WS_LSTH = WS_LSTA + 524288;
constexpr size_t WS_K1B  = WS_LSTH + 524288;
constexpr size_t WS_K2B  = WS_K1B + 262144;
constexpr size_t WS_XF   = WS_K2B + 262144;
constexpr size_t WS_XB   = WS_XF + (size_t)NTOK * D * 4;
constexpr size_t WS_WINT = WS_XB + (size_t)NTOK * D * 2;
constexpr size_t WS_WSC  = WS_WINT + (size_t)DIN * 1024;
constexpr size_t WS_X8   = WS_WSC + (size_t)DIN * 4 + 256 - ((size_t)DIN * 4) % 256;
constexpr size_t WS_XS   = WS_X8 + (size_t)NTOK * 1024;
constexpr size_t WS_WBAT = WS_XS + (size_t)NTOK * 4;
constexpr size_t WS_WBBT = WS_WBAT + (size_t)1024 * 512 * 2;
constexpr size_t WS_WBCT = WS_WBBT + (size_t)1024 * 1024 * 2;
constexpr size_t WS_WOT  = WS_WBCT + (size_t)1024 * 1024 * 2;
constexpr size_t WS_WQT  = WS_WOT + (size_t)1024 * 1024 * 2;
constexpr size_t WS_UV8  = WS_WQT + (size_t)2048 * 1024 * 2;
constexpr size_t WS_UVS  = WS_UV8 + (size_t)16384 * 2048;
constexpr size_t WS_PROJ = WS_UVS + (size_t)16384 * 8;
constexpr size_t WS_OATT = WS_PROJ + (size_t)NTOK * DIN * 2;
constexpr size_t WS_LSE  = WS_OATT + (size_t)NTOK * 1536 * 2;
constexpr size_t WS_KVB  = WS_LSE + (size_t)NTOK * 12 * 4;
constexpr int YLD = 2560;
constexpr size_t WS_YA   = WS_KVB + (size_t)16 * 32 * 65536 * 2;
constexpr size_t WS_YB   = WS_YA + (size_t)NTOK * 512 * 2;
constexpr size_t WS_YC   = WS_YB + (size_t)NTOK * 1024 * 2;
constexpr size_t WS_MRGF = WS_YC + (size_t)NTOK * 1024 * 2;
constexpr size_t WS_MRGB = WS_MRGF + (size_t)NTOK * 1024 * 4;
constexpr size_t WS_END  = WS_MRGB + (size_t)NTOK * 1024 * 2;
constexpr size_t WS_Q    = WS_PROJ;
constexpr size_t WS_EID  = WS_PROJ + (size_t)NTOK * 2048 * 2;
constexpr size_t WS_GATE = WS_EID + (size_t)NTOK * 128 * 4;
static_assert(WS_END <= (size_t)1073741824, "workspace too large");
static_assert(WS_PROJ % 256 == 0 && WS_KVB % 256 == 0 && WS_MRGF % 256 == 0, "alignment");

struct Args { const float* in[20]; float* out; unsigned char* ws; double ropeA, ropeR; int ph_lo, ph_hi; };

DI size_t pjo(size_t row, int col) { return ((size_t)(col >> 8) * NTOK + row) * 256 + (size_t)(col & 255); }
DI float bflo(unsigned w) { return __uint_as_float(w << 16); }
DI float bfhi(unsigned w) { return __uint_as_float(w & 0xffff0000u); }
DI float bf2f(bf16_t v) { return __uint_as_float(((unsigned)v) << 16); }
DI unsigned pk2(float lo, float hi) { return pg8::cvt_pk_bf16(lo, hi); }
DI bf16_t f2bf(float f) { return (bf16_t)(pk2(f, 0.f) & 0xffffu); }
DI f32x4 mfma16(bf16x8 a, bf16x8 b, f32x4 c) { return __builtin_amdgcn_mfma_f32_16x16x32_bf16(a, b, c, 0, 0, 0); }
DI s16x4 trrd(LAS unsigned char* p) { return __builtin_amdgcn_ds_read_tr16_b64_v4i16((LAS s16x4*)p); }
DI bf16x8 cat8(s16x4 lo, s16x4 hi) { return __builtin_shufflevector(lo, hi, 0, 1, 2, 3, 4, 5, 6, 7); }
DI float wsum(float v) { v += __shfl_xor(v, 32); v += __shfl_xor(v, 16); v += __shfl_xor(v, 8); v += __shfl_xor(v, 4); v += __shfl_xor(v, 2); v += __shfl_xor(v, 1); return v; }
DI float sigm(float x) { return __builtin_amdgcn_rcpf(1.f + __builtin_amdgcn_exp2f(x * -1.4426950408889634f)); }
DI float gelu_erf(float x) { return 0.5f * x * (1.f + erff(x * 0.70710678118654752f)); }
DI float dot2(unsigned w, unsigned x, float acc) { return __builtin_amdgcn_fdot2_f32_bf16(__builtin_bit_cast(bf16x2v, w), __builtin_bit_cast(bf16x2v, x), acc, false); }
DI float log2gamma(int h) { return log2f(1.0f - exp2f(-5.0f - (float)h)); }

#define MK_DPP_ADD(v, ctrl, rmask) v += __int_as_float(__builtin_amdgcn_update_dpp(0, __float_as_int(v), (ctrl), (rmask), 0xf, false))
DI float wsum_dpp(float v) {
    MK_DPP_ADD(v, 0xB1, 0xf); MK_DPP_ADD(v, 0x4E, 0xf); MK_DPP_ADD(v, 0x141, 0xf); MK_DPP_ADD(v, 0x140, 0xf);
    MK_DPP_ADD(v, 0x142, 0xa); MK_DPP_ADD(v, 0x143, 0xc);
    return __int_as_float(__builtin_amdgcn_readlane(__float_as_int(v), 63));
}
DI float gelu_as(float v) {
    const float av = fabsf(v), t = __builtin_amdgcn_rcpf(av * 0.2316418882f + 1.0f);
    float q = t * 0.5307027145f + (-0.7265760135f); q = q * t + 0.7107068705f; q = q * t + (-0.142248368f); q = q * t + 0.127414796f; q = q * t;
    const float e = __builtin_amdgcn_exp2f(v * v * (-0.72134752044f));
    const float m = v * (q * e);
    return v < 0.f ? m : v - m;
}
DI int wperm(int n) {
    if (n < 3072) { const int j = n & 127, bj = j >> 6, jj = j & 63; return (n & ~127) + 64 * (jj >> 5) + 32 * bj + (jj & 31); }
    if (n >= OFF_RQ && n < OFF_RV) { const int j = n & 255, bj = j >> 7, jj = j & 127; return (n & ~255) + 64 * (jj >> 5) + 32 * bj + (jj & 31); }
    return n;
}
template <bool WPERM>
DI void tconv_tile(const float* src, int ldsrc, bf16_t* dst, int lddst, int k0, int n0, LAS float* t, float mul = 1.0f) {
    const int tid = mk_tid();
#pragma unroll
    for (int i = 0; i < 8; ++i) { const int idx = tid + 512 * i, r = idx >> 6, c = idx & 63; t[r * 65 + c] = src[(size_t)(k0 + r) * ldsrc + n0 + c]; }
    __syncthreads();
#pragma unroll
    for (int i = 0; i < 8; ++i) { const int idx = tid + 512 * i, n = idx >> 6, k = idx & 63; const int nr = WPERM ? wperm(n0 + n) : (n0 + n); dst[(size_t)nr * lddst + k0 + k] = f2bf(t[k * 65 + n] * mul); }
    __syncthreads();
}
DI void conv_unit(const float* src, bf16_t* dst, int unit) {
    const size_t i = (size_t)unit * 4096 + (size_t)mk_tid() * 8;
    const f32x4 a = *(const f32x4*)(src + i), b = *(const f32x4*)(src + i + 4);
    u32x4 o; o.x = pk2(a[0], a[1]); o.y = pk2(a[2], a[3]); o.z = pk2(b[0], b[1]); o.w = pk2(b[2], b[3]);
    *(u32x4*)(dst + i) = o;
}
DI void w8_unit(const float* src, unsigned char* ws, int unit, LAS float* t) {
    const int tid = mk_tid(), n0 = unit * 64;
    unsigned char* dst = ws + WS_WINT;
#pragma unroll 1
    for (int k0 = 0; k0 < 1024; k0 += 64) {
#pragma unroll
        for (int i = 0; i < 8; ++i) { const int idx = tid + 512 * i, r = idx >> 6, cc = idx & 63; t[r * 65 + cc] = fminf(fmaxf(src[(size_t)(k0 + r) * DIN + n0 + cc] * W8_SCALE, -F8_MAX), F8_MAX); }
        __syncthreads();
#pragma unroll
        for (int i = 0; i < 2; ++i) { const int idx = tid + 512 * i, n = idx >> 4, k4 = idx & 15;
            int wd = __builtin_amdgcn_cvt_pk_fp8_f32(t[(4 * k4) * 65 + n], t[(4 * k4 + 1) * 65 + n], 0, false);
            wd = __builtin_amdgcn_cvt_pk_fp8_f32(t[(4 * k4 + 2) * 65 + n], t[(4 * k4 + 3) * 65 + n], wd, true);
            *(int*)(dst + (size_t)wperm(n0 + n) * 1024 + k0 + 4 * k4) = wd; }
        __syncthreads();
    }
}
DI void row_to_fp8(const f32x4 (&o)[4], unsigned char* x8row, int ln) {
    u32x4 w;
#pragma unroll
    for (int q = 0; q < 4; ++q) {
        const float a0 = fminf(fmaxf(o[q][0] * X8_SCALE, -F8_MAX), F8_MAX), a1 = fminf(fmaxf(o[q][1] * X8_SCALE, -F8_MAX), F8_MAX), a2 = fminf(fmaxf(o[q][2] * X8_SCALE, -F8_MAX), F8_MAX), a3 = fminf(fmaxf(o[q][3] * X8_SCALE, -F8_MAX), F8_MAX);
        int wd = __builtin_amdgcn_cvt_pk_fp8_f32(a0, a1, 0, false); wd = __builtin_amdgcn_cvt_pk_fp8_f32(a2, a3, wd, true); w[q] = (unsigned)wd; }
    *(u32x4*)(x8row + 16 * ln) = w;
}
typedef float f32x16 __attribute__((ext_vector_type(16)));
constexpr unsigned UVREC = 1024;
DI float wmax(float m) { m = fmaxf(m, __shfl_xor(m, 32)); m = fmaxf(m, __shfl_xor(m, 16)); m = fmaxf(m, __shfl_xor(m, 8)); m = fmaxf(m, __shfl_xor(m, 4)); m = fmaxf(m, __shfl_xor(m, 2)); m = fmaxf(m, __shfl_xor(m, 1)); return m; }
DI void conv_fp6_rows(const float* usrc, const float* vsrc, unsigned char* ws, int unit) {
    const int tid = mk_tid(), lane = tid & 63, w = tid >> 6;
    const size_t row = (size_t)unit * 8 + w;
    const float* up = usrc + row * 1024 + 16 * lane; const float* vp = vsrc + row * 1024 + 16 * lane;
    f32x16 a, b; float mu = 0.f, mv = 0.f;
#pragma unroll
    for (int q = 0; q < 4; ++q) { const f32x4 x = *(const f32x4*)(up + 4 * q), y = *(const f32x4*)(vp + 4 * q);
#pragma unroll
        for (int j = 0; j < 4; ++j) { a[4 * q + j] = x[j]; b[4 * q + j] = y[j]; mu = fmaxf(mu, fabsf(x[j])); mv = fmaxf(mv, fabsf(y[j])); } }
    mu = wmax(mu); mv = wmax(mv);
    const float su = (mu > 0.f) ? 6.0f / mu : 1.0f, sv = (mv > 0.f) ? 6.0f / mv : 1.0f;
    unsigned u0 = 0u, u1 = 0u, v0 = 0u, v1 = 0u;
#define MK_PK4(i) u0 = __builtin_amdgcn_cvt_scalef32_pk_fp4_f32(u0, a[2 * i] * su, a[2 * i + 1] * su, 1.0f, i); u1 = __builtin_amdgcn_cvt_scalef32_pk_fp4_f32(u1, a[8 + 2 * i] * su, a[8 + 2 * i + 1] * su, 1.0f, i); \
                  v0 = __builtin_amdgcn_cvt_scalef32_pk_fp4_f32(v0, b[2 * i] * sv, b[2 * i + 1] * sv, 1.0f, i); v1 = __builtin_amdgcn_cvt_scalef32_pk_fp4_f32(v1, b[8 + 2 * i] * sv, b[8 + 2 * i + 1] * sv, 1.0f, i);
    MK_PK4(0) MK_PK4(1) MK_PK4(2) MK_PK4(3)
#undef MK_PK4
    unsigned char* rec = ws + WS_UV8 + row * UVREC;
    *(u32x4*)(rec + 16 * lane) = (u32x4){u0, u1, v0, v1};
    if (lane == 0) { float* sp = (float*)(ws + WS_UVS) + row * 2; sp[0] = (mu > 0.f) ? mu * (1.0f / 6.0f) : 1.0f; sp[1] = (mv > 0.f) ? mv * (1.0f / 6.0f) : 1.0f; }
}
DI void phase_conv(const Args& a, int layer, LAS unsigned char* lds) {
    unsigned char* ws = a.ws;
    LAS float* t = (LAS float*)lds;
    const int J0 = 216, J1 = J0 + 128, J2 = J1 + 256, J3 = J2 + 256, J4 = J3 + 256, J5 = J4 + 512, J6 = J5 + 32, J7 = J6 + 2048, J8 = J7, J9 = J8 + 64, J10 = J9 + 1;
    const int total = J10;
    for (int u = blockIdx.x; u < total; u += gridDim.x) {
        if (u < J0) { w8_unit(a.in[1] + (size_t)layer * 1024 * DIN, ws, u, t); }
        else if (u < J1) { const int v = u - J0, kt = v / 16, nt = v % 16; tconv_tile<false>(a.in[9] + (size_t)layer * 2560 * 1024, 1024, (bf16_t*)(ws + WS_WBAT), YLD, kt * 64, nt * 64, t); }
        else if (u < J2) { const int v = u - J1, kt = v / 16, nt = v % 16; tconv_tile<false>(a.in[9] + (size_t)layer * 2560 * 1024 + (size_t)512 * 1024, 1024, (bf16_t*)(ws + WS_WBAT) + 512, YLD, kt * 64, nt * 64, t); }
        else if (u < J3) { const int v = u - J2, kt = v / 16, nt = v % 16; tconv_tile<false>(a.in[9] + (size_t)layer * 2560 * 1024 + (size_t)1536 * 1024, 1024, (bf16_t*)(ws + WS_WBAT) + 1536, YLD, kt * 64, nt * 64, t); }
        else if (u < J4) { const int v = u - J3, kt = v / 16, nt = v % 16; tconv_tile<false>(a.in[10] + (size_t)layer * 1024 * 1024, 1024, (bf16_t*)(ws + WS_WOT), 1024, kt * 64, nt * 64, t); }
        else if (u < J5) { const int v = u - J4, kt = v / 32, nt = v % 32; tconv_tile<false>(a.in[13] + (size_t)layer * 1024 * 2048, 2048, (bf16_t*)(ws + WS_WQT), 1024, kt * 64, nt * 64, t); }
        else if (u < J6) { const int v = u - J5, blk = v & 15, which = v >> 4;
            tconv_tile<false>(a.in[which ? 6 : 4] + ((size_t)layer * 16 + blk) * 4096, 64, (bf16_t*)(ws + (which ? WS_WXT : WS_WAT)) + blk * 4096, 64, 0, 0, t, -1.4426950408889634f); }
        else if (u < J7) { conv_fp6_rows(a.in[16] + (size_t)layer * 16384 * 1024, a.in[17] + (size_t)layer * 16384 * 1024, ws, u - J6); }
        else if (u < J9) { const int v = u - J8; if (v < 32) conv_unit(a.in[14] + (size_t)layer * 131072, (bf16_t*)(ws + WS_K1B), v); else conv_unit(a.in[15] + (size_t)layer * 131072, (bf16_t*)(ws + WS_K2B), v - 32); }
        else { for (int c = mk_tid(); c < 1024; c += 512) { const float lam = a.in[8][layer * 1024 + c]; const float e = __builtin_amdgcn_exp2f(-lam * 1.4426950408889634f); const float sp = (e < 0.05f) ? e * (1.0f + e * (-0.5f + e * (0.33333333f + e * -0.25f))) : __builtin_amdgcn_logf(1.0f + e) * 0.6931471805599453f; ((float*)(ws + WS_CCH))[c] = -8.0f * sp; } }
    }
}

DI void phase_prologue(const Args& a) {
    unsigned char* ws = a.ws;
    const int tid = mk_tid();
    for (int u = blockIdx.x; u < 2048; u += gridDim.x) {
        { const int ln = tid & 63; const size_t row = (size_t)u * 8 + (tid >> 6);
            const float* xp = a.in[0] + row * 1024 + 16 * ln; float* xo = (float*)(ws + WS_XF) + row * 1024 + 16 * ln;
            f32x4 o[4];
#pragma unroll
            for (int q = 0; q < 4; ++q) { o[q] = *(const f32x4*)(xp + 4 * q); *(f32x4*)(xo + 4 * q) = o[q]; }
            row_to_fp8(o, ws + WS_X8 + row * 1024, ln); }
    }
}

DI void attn_unit(const Args& a, int unit, LAS unsigned char* lds) {
    unsigned char* ws = a.ws;
    const int tid = mk_tid(), lane = tid & 63, w = __builtin_amdgcn_readfirstlane(tid >> 6), g = lane >> 4, l15 = lane & 15, tq4 = l15 >> 2, tp4 = l15 & 3;
    const int b = unit / 384, rem = unit % 384, h = rem >> 5, bi = rem & 31;
    const int grp = h >> 2, d = (grp == 0) ? 1 : ((grp == 1) ? 4 : 16), nb = 32 / d, r = bi / nb, n = bi % nb;
    const bf16_t* proj = (const bf16_t*)(ws + WS_PROJ); const size_t brow = (size_t)b * SEQ;
    LAS unsigned char* Ks = lds; LAS unsigned char* Vs = lds + 256 * 288;
#pragma unroll
    for (int i = 0; i < 8; ++i) {
        const int idx = tid + 512 * i, row = idx >> 4, ch = idx & 15, m = 128 * (n - 1) + row;
        u32x4 kv = {0u, 0u, 0u, 0u}, vv = {0u, 0u, 0u, 0u};
        if (m >= 0) { const size_t gr = brow + (size_t)(m * d + r); kv = *(const u32x4*)(proj + pjo(gr, OFF_AK + h * 128 + ch * 8)); vv = *(const u32x4*)(proj + pjo(gr, OFF_AV + h * 128 + ch * 8)); }
        *(LAS u32x4*)(Ks + row * 288 + ch * 16) = kv; *(LAS u32x4*)(Vs + row * 288 + ch * 16) = vv;
    }
    const int qi = 16 * w + l15;
    const size_t tq = (size_t)(128 * n + qi) * d + r;
    bf16x8 qf[4];
#pragma unroll
    for (int ks = 0; ks < 4; ++ks) qf[ks] = *(const bf16x8*)(proj + pjo(brow + tq, OFF_AQ + h * 128 + 32 * ks + 8 * g));
    __syncthreads();
    const int s0 = w >> 1;
    f32x4 sacc[10];
#pragma unroll
    for (int jj = 0; jj < 10; ++jj) {
        f32x4 acc = {0.f, 0.f, 0.f, 0.f};
#pragma unroll
        for (int ks = 0; ks < 4; ++ks) { const bf16x8 kf = *(const LAS bf16x8*)(Ks + (32 * s0 + 16 * jj + l15) * 288 + (32 * ks + 8 * g) * 2); acc = mfma16(kf, qf[ks], acc); }
        sacc[jj] = acc;
    }
    const float scale = 0.08838834764831845f * 1.4426950408889634f;
    float mx = -1e30f;
#pragma unroll
    for (int jj = 0; jj < 10; ++jj)
#pragma unroll
        for (int rg = 0; rg < 4; ++rg) {
            const int j = 32 * s0 + 16 * jj + 4 * g + rg;
            const bool valid = (j >= qi) && (j <= qi + 128) && (n > 0 || j >= 128);
            const float s = valid ? sacc[jj][rg] * scale : -1e30f;
            sacc[jj][rg] = s; mx = fmaxf(mx, s);
        }
    mx = fmaxf(mx, __shfl_xor(mx, 16)); mx = fmaxf(mx, __shfl_xor(mx, 32));
    float sum = 0.f;
#pragma unroll
    for (int jj = 0; jj < 10; ++jj)
#pragma unroll
        for (int rg = 0; rg < 4; ++rg) { const float p = __builtin_amdgcn_exp2f(sacc[jj][rg] - mx); sacc[jj][rg] = p; sum += p; }
    sum += __shfl_xor(sum, 16); sum += __shfl_xor(sum, 32);
    f32x4 oacc[8];
#pragma unroll
    for (int db = 0; db < 8; ++db) oacc[db] = (f32x4){0.f, 0.f, 0.f, 0.f};
#pragma unroll
    for (int s = 0; s < 5; ++s) {
        u32x4 pw; pw.x = pk2(sacc[2 * s][0], sacc[2 * s][1]); pw.y = pk2(sacc[2 * s][2], sacc[2 * s][3]); pw.z = pk2(sacc[2 * s + 1][0], sacc[2 * s + 1][1]); pw.w = pk2(sacc[2 * s + 1][2], sacc[2 * s + 1][3]);
        const bf16x8 pb = __builtin_bit_cast(bf16x8, pw);
        const int k0 = 32 * (s0 + s) + 4 * g + tq4;
#pragma unroll
        for (int db = 0; db < 8; ++db) {
            const s16x4 lo = trrd(Vs + k0 * 288 + (16 * db + 4 * tp4) * 2), hi = trrd(Vs + (k0 + 16) * 288 + (16 * db + 4 * tp4) * 2);
            oacc[db] = mfma16(cat8(lo, hi), pb, oacc[db]);
        }
    }
    const float inv = 1.0f / sum;
    bf16_t* op = (bf16_t*)(ws + WS_OATT) + ((size_t)b * SEQ + tq) * 1536 + h * 128 + 4 * g;
#pragma unroll
    for (int db = 0; db < 8; ++db) { u32x2 o; o.x = pk2(oacc[db][0] * inv, oacc[db][1] * inv); o.y = pk2(oacc[db][2] * inv, oacc[db][3] * inv); *(u32x2*)(op + 16 * db) = o; }
    if (g == 0) ((float*)(ws + WS_LSE))[((size_t)b * SEQ + tq) * 12 + h] = mx + __builtin_amdgcn_logf(sum);
    __syncthreads();
}

DI void retkv_unit(const Args& a, int unit, LAS unsigned char* lds) {
    unsigned char* ws = a.ws;
    const int tid = mk_tid(), lane = tid & 63, w = __builtin_amdgcn_readfirstlane(tid >> 6), g = lane >> 4, l15 = lane & 15, tq4 = l15 >> 2, tp4 = l15 & 3;
    const int b = unit >> 7, h = (unit >> 5) & 3, c = unit & 31;
    const bf16_t* proj = (const bf16_t*)(ws + WS_PROJ); const size_t brow = (size_t)b * SEQ + c * 128;
    LAS unsigned char* Ks = lds; LAS unsigned char* Vs = lds + 128 * 544;
    const float l2g = log2gamma(h);
#pragma unroll
    for (int i = 0; i < 8; ++i) {
        const int idx = tid + 512 * i, row = idx >> 5, ch = idx & 31;
        const u32x4 kv = *(const u32x4*)(proj + pjo(brow + row, OFF_RK + h * 256 + ch * 8)), vv = *(const u32x4*)(proj + pjo(brow + row, OFF_RV + h * 256 + ch * 8));
        const float z = exp2f((float)(127 - row) * l2g);
        u32x4 kz;
#pragma unroll
        for (int q = 0; q < 4; ++q) kz[q] = pk2(bflo(kv[q]) * z, bfhi(kv[q]) * z);
        *(LAS u32x4*)(Ks + row * 544 + ch * 16) = kz; *(LAS u32x4*)(Vs + row * 544 + ch * 16) = vv;
    }
    __syncthreads();
#pragma unroll 1
    for (int nh = 0; nh < 2; ++nh) {
        f32x4 acc[2][8];
#pragma unroll
        for (int mb = 0; mb < 2; ++mb)
#pragma unroll
            for (int nb = 0; nb < 8; ++nb) acc[mb][nb] = (f32x4){0.f, 0.f, 0.f, 0.f};
#pragma unroll
        for (int ks = 0; ks < 4; ++ks) {
            const int j0 = 32 * ks + 4 * g + tq4;
            bf16x8 af[2];
#pragma unroll
            for (int mb = 0; mb < 2; ++mb) { const int col = 32 * w + 16 * mb + 4 * tp4; af[mb] = cat8(trrd(Vs + j0 * 544 + col * 2), trrd(Vs + (j0 + 16) * 544 + col * 2)); }
#pragma unroll
            for (int nb = 0; nb < 8; ++nb) {
                const int col = 128 * nh + 16 * nb + 4 * tp4;
                const bf16x8 bfr = cat8(trrd(Ks + j0 * 544 + col * 2), trrd(Ks + (j0 + 16) * 544 + col * 2));
#pragma unroll
                for (int mb = 0; mb < 2; ++mb) acc[mb][nb] = mfma16(af[mb], bfr, acc[mb][nb]);
            }
        }
        bf16_t* kvb = (bf16_t*)(ws + WS_KVB) + ((size_t)((b * 4 + h) * 32 + c)) * 65536 + 128 * nh;
#pragma unroll
        for (int mb = 0; mb < 2; ++mb)
#pragma unroll
            for (int nb = 0; nb < 8; ++nb)
#pragma unroll
                for (int rg = 0; rg < 4; ++rg) kvb[(size_t)(32 * w + 16 * mb + 4 * g + rg) * 256 + 16 * nb + l15] = f2bf(acc[mb][nb][rg]);
    }
    __syncthreads();
}

DI void lru_stripe(const Args& a, int layer, int stripe, LAS unsigned char* lds) {
    unsigned char* ws = a.ws;
    const int tid = mk_tid(), lane = tid & 63, w = __builtin_amdgcn_readfirstlane(tid >> 6), g = lane >> 4, l15 = lane & 15;
    const int b = stripe >> 4, blk = stripe & 15;
    LAS bf16_t* lxs = (LAS bf16_t*)lds;
    LAS bf16_t* lgs0 = (LAS bf16_t*)(lds + 16896);
    LAS unsigned char* xcb = lds + 49664;
    LAS float* rgt = (LAS float*)(lds + 68096);
    LAS float* igt = (LAS float*)(lds + 100864);
    LAS float* wst = (LAS float*)(lds + 133632);
    const bf16_t* proj = (const bf16_t*)(ws + WS_PROJ); const size_t brow = (size_t)b * SEQ;
    const int gc = blk * 64 + lane;
    const float* cw = a.in[2] + (size_t)layer * 4096;
    const int cch_ = tid & 63, cgc = blk * 64 + cch_;
    const float cw0 = cw[cgc], cw1 = cw[1024 + cgc], cw2 = cw[2048 + cgc], cw3 = cw[3072 + cgc], cb = a.in[3][layer * 1024 + cgc];
    const float cc = ((const float*)(ws + WS_CCH))[gc] * 1.4426950408889634f;
    float bia[4], bix[4];
    LAS unsigned char* wlds = lds + 137728;
    { const int r = tid >> 3, c8 = tid & 7; *(LAS u32x4*)(wlds + r * 144 + c8 * 16) = *(const u32x4*)((const bf16_t*)(ws + WS_WAT) + blk * 4096 + r * 64 + c8 * 8); }
    bf16x8 wfx[4][2];
#pragma unroll
    for (int nb = 0; nb < 4; ++nb)
#pragma unroll
        for (int ks = 0; ks < 2; ++ks) wfx[nb][ks] = *(const bf16x8*)((const bf16_t*)(ws + WS_WXT) + blk * 4096 + (16 * nb + l15) * 64 + 32 * ks + 8 * g);
#pragma unroll
    for (int nb = 0; nb < 4; ++nb) { bia[nb] = -1.4426950408889634f * a.in[5][layer * 1024 + blk * 64 + 16 * nb + l15]; bix[nb] = -1.4426950408889634f * a.in[7][layer * 1024 + blk * 64 + 16 * nb + l15]; }
    if (tid < 24) *(LAS u32x4*)(lxs + tid * 8) = (u32x4){0u, 0u, 0u, 0u};
    u32x4 plx[2], plg[2];
#pragma unroll
    for (int i = 0; i < 2; ++i) { const int idx = tid + 512 * i, row = idx >> 3, c8 = idx & 7; plx[i] = *(const u32x4*)(proj + pjo(brow + row, OFF_LX + blk * 64 + c8 * 8)); plg[i] = *(const u32x4*)(proj + pjo(brow + row, OFF_LG + blk * 64 + c8 * 8)); }
    float hcarry = 0.0f;
#pragma unroll 1
    for (int c = 0; c < 32; ++c) {
        LAS bf16_t* lgs = lgs0 + (c & 1) * 8192;
#pragma unroll
        for (int i = 0; i < 2; ++i) { const int idx = tid + 512 * i, row = idx >> 3, c8 = idx & 7; *(LAS u32x4*)(lxs + (3 + row) * 64 + c8 * 8) = plx[i]; *(LAS u32x4*)(lgs + row * 64 + c8 * 8) = plg[i]; }
        __syncthreads();
        if (c + 1 < 32) {
#pragma unroll
            for (int i = 0; i < 2; ++i) { const int idx = tid + 512 * i, row = idx >> 3, c8 = idx & 7; const size_t gr = brow + (size_t)((c + 1) * 128 + row); plx[i] = *(const u32x4*)(proj + pjo(gr, OFF_LX + blk * 64 + c8 * 8)); plg[i] = *(const u32x4*)(proj + pjo(gr, OFF_LG + blk * 64 + c8 * 8)); }
        }
        {
            const int t0 = (tid >> 6) * 16;
            float x0 = bf2f(lxs[t0 * 64 + cch_]), x1 = bf2f(lxs[(t0 + 1) * 64 + cch_]), x2 = bf2f(lxs[(t0 + 2) * 64 + cch_]);
#pragma unroll
            for (int i = 0; i < 16; ++i) {
                const float x3 = bf2f(lxs[(t0 + i + 3) * 64 + cch_]);
                const float xc = cb + cw0 * x0 + cw1 * x1 + cw2 * x2 + cw3 * x3;
                *(LAS bf16_t*)(xcb + (t0 + i) * 144 + cch_ * 2) = f2bf(xc);
                x0 = x1; x1 = x2; x2 = x3;
            }
        }
        __syncthreads();
        if (tid < 24) *(LAS u32x4*)(lxs + tid * 8) = *(const LAS u32x4*)(lxs + 128 * 64 + tid * 8);
        {
            const bf16x8 af0 = *(const LAS bf16x8*)(xcb + (16 * w + l15) * 144 + (8 * g) * 2), af1 = *(const LAS bf16x8*)(xcb + (16 * w + l15) * 144 + (32 + 8 * g) * 2);
#pragma unroll
            for (int nb = 0; nb < 4; ++nb) {
                f32x4 ar = {0.f, 0.f, 0.f, 0.f}, ax = {0.f, 0.f, 0.f, 0.f};
                const LAS unsigned char* wr_ = wlds + (16 * nb + l15) * 144 + 16 * g;
                ar = mfma16(af0, *(const LAS bf16x8*)(wr_), ar); ar = mfma16(af1, *(const LAS bf16x8*)(wr_ + 64), ar);
                ax = mfma16(af0, wfx[nb][0], ax); ax = mfma16(af1, wfx[nb][1], ax);
#pragma unroll
                for (int rg = 0; rg < 4; ++rg) { rgt[(16 * w + 4 * g + rg) * 64 + 16 * nb + l15] = __builtin_amdgcn_rcpf(1.0f + __builtin_amdgcn_exp2f(ar[rg] + bia[nb])); igt[(16 * w + 4 * g + rg) * 64 + 16 * nb + l15] = __builtin_amdgcn_rcpf(1.0f + __builtin_amdgcn_exp2f(ax[rg] + bix[nb])); }
            }
        }
        __syncthreads();
        float av[16], bv[16]; float Aw = 1.0f, Hw = 0.0f;
#pragma unroll
        for (int tt = 0; tt < 16; ++tt) {
            const int t = 16 * w + tt;
            const float aa = __builtin_amdgcn_exp2f(cc * rgt[t * 64 + lane]);
            const float bb = __builtin_amdgcn_sqrtf(fmaxf(1.0f - aa * aa, 0.0f)) * igt[t * 64 + lane] * bf2f(*(const LAS bf16_t*)(xcb + t * 144 + lane * 2));
            av[tt] = aa; bv[tt] = bb; Hw = aa * Hw + bb; Aw *= aa;
        }
        wst[w * 64 + lane] = Aw; wst[512 + w * 64 + lane] = Hw;
        __syncthreads();
        float hcur = hcarry, hend = hcarry;
#pragma unroll
        for (int ww = 0; ww < 8; ++ww) { const float A_ = wst[ww * 64 + lane], H_ = wst[512 + ww * 64 + lane]; hend = A_ * hend + H_; if (ww < w) hcur = hend; }
        hcarry = hend;
        bf16_t* yb = (bf16_t*)(ws + WS_YA) + ((size_t)b * SEQ + c * 128 + 16 * w) * YLD + 512 + gc;
#pragma unroll
        for (int tt = 0; tt < 16; tt += 2) {
            const float h0 = av[tt] * hcur + bv[tt]; hcur = av[tt + 1] * h0 + bv[tt + 1];
            yb[(size_t)tt * YLD] = f2bf(h0 * bf2f(lgs[(16 * w + tt) * 64 + lane])); yb[(size_t)(tt + 1) * YLD] = f2bf(hcur * bf2f(lgs[(16 * w + tt + 1) * 64 + lane]));
        }
    }
    __syncthreads();
}

DI void retscan_unit(const Args& a, int unit) {
    unsigned char* ws = a.ws;
    const int e8 = unit * 512 + mk_tid();
    const int bh = e8 >> 13, within = e8 & 8191, h = bh & 3;
    const float g128 = exp2f(128.0f * log2gamma(h));
    bf16_t* base = (bf16_t*)(ws + WS_KVB) + (size_t)bh * 32 * 65536 + (size_t)within * 8;
    float st[8];
#pragma unroll
    for (int q = 0; q < 8; ++q) st[q] = 0.f;
#pragma unroll 1
    for (int c0 = 0; c0 < 32; c0 += 8) {
        u32x4 kv[8];
#pragma unroll
        for (int q = 0; q < 8; ++q) kv[q] = *(const u32x4*)(base + (size_t)(c0 + q) * 65536);
#pragma unroll
        for (int q = 0; q < 8; ++q) {
            u32x4 o;
#pragma unroll
            for (int j = 0; j < 4; ++j) o[j] = pk2(st[2 * j], st[2 * j + 1]);
            *(u32x4*)(base + (size_t)(c0 + q) * 65536) = o;
#pragma unroll
            for (int j = 0; j < 4; ++j) { st[2 * j] = g128 * st[2 * j] + bflo(kv[q][j]); st[2 * j + 1] = g128 * st[2 * j + 1] + bfhi(kv[q][j]); }
        }
    }
}

DI void attmerge_unit(const Args& a, int unit) {
    unsigned char* ws = a.ws;
    const int idx = unit * 512 + mk_tid(), t = idx >> 6, hp = (idx >> 4) & 3, dc = idx & 15;
    const float* lse = (const float*)(ws + WS_LSE) + (size_t)t * 12;
    const float l0 = lse[hp], l1 = lse[4 + hp], l2 = lse[8 + hp];
    const float m = fmaxf(l0, fmaxf(l1, l2));
    float w0 = __builtin_amdgcn_exp2f(l0 - m), w1 = __builtin_amdgcn_exp2f(l1 - m), w2 = __builtin_amdgcn_exp2f(l2 - m);
    const float is = 1.0f / (w0 + w1 + w2); w0 *= is; w1 *= is; w2 *= is;
    const bf16_t* o = (const bf16_t*)(ws + WS_OATT) + (size_t)t * 1536 + hp * 128 + dc * 8;
    const u32x4 a0 = *(const u32x4*)o, a1 = *(const u32x4*)(o + 512), a2 = *(const u32x4*)(o + 1024);
    u32x4 r;
#pragma unroll
    for (int q = 0; q < 4; ++q) r[q] = pk2(w0 * bflo(a0[q]) + w1 * bflo(a1[q]) + w2 * bflo(a2[q]), w0 * bfhi(a0[q]) + w1 * bfhi(a1[q]) + w2 * bfhi(a2[q]));
    *(u32x4*)((bf16_t*)(ws + WS_YA) + (size_t)t * YLD + hp * 128 + dc * 8) = r;
}

DI void retout_unit(const Args& a, int unit, LAS unsigned char* lds) {
    unsigned char* ws = a.ws;
    const int tid = mk_tid(), lane = tid & 63, w = __builtin_amdgcn_readfirstlane(tid >> 6), g = lane >> 4, l15 = lane & 15, tq4 = l15 >> 2, tp4 = l15 & 3;
    const int b = unit >> 7, h = (unit >> 5) & 3, c = unit & 31;
    const bf16_t* proj = (const bf16_t*)(ws + WS_PROJ); const size_t brow = (size_t)b * SEQ + c * 128;
    const bf16_t* rt = (const bf16_t*)(ws + WS_KVB) + ((size_t)((b * 4 + h) * 32 + c)) * 65536;
    LAS unsigned char* RA = lds; LAS unsigned char* RB = lds + 128 * 544;
    const float l2g = log2gamma(h);
    const int qi = 16 * w + l15;
    bf16x8 qf[8];
#pragma unroll
    for (int ks = 0; ks < 8; ++ks) qf[ks] = *(const bf16x8*)(proj + pjo(brow + qi, OFF_RQ + h * 256 + 32 * ks + 8 * g));
#pragma unroll
    for (int i = 0; i < 8; ++i) {
        const int idx = tid + 512 * i, row = idx >> 5, ch = idx & 31;
        *(LAS u32x4*)(RA + row * 544 + ch * 16) = *(const u32x4*)(proj + pjo(brow + row, OFF_RK + h * 256 + ch * 8));
        *(LAS u32x4*)(RB + row * 544 + ch * 16) = *(const u32x4*)(rt + (size_t)row * 256 + ch * 8);
    }
    __syncthreads();
    u32x4 pv[8], pr[8];
#pragma unroll
    for (int i = 0; i < 8; ++i) {
        const int idx = tid + 512 * i, row = idx >> 5, ch = idx & 31;
        pv[i] = *(const u32x4*)(proj + pjo(brow + row, OFF_RV + h * 256 + ch * 8));
        pr[i] = *(const u32x4*)(rt + (size_t)(128 + row) * 256 + ch * 8);
    }
    f32x4 sacc[8], oacc[16];
#pragma unroll
    for (int jj = 0; jj < 8; ++jj) {
        f32x4 acc = {0.f, 0.f, 0.f, 0.f};
        if (jj <= w) {
#pragma unroll
            for (int ks = 0; ks < 8; ++ks) { const bf16x8 kf = *(const LAS bf16x8*)(RA + (16 * jj + l15) * 544 + (32 * ks + 8 * g) * 2); acc = mfma16(kf, qf[ks], acc); }
        }
        sacc[jj] = acc;
    }
#pragma unroll
    for (int db = 0; db < 8; ++db) {
        f32x4 acc = {0.f, 0.f, 0.f, 0.f};
#pragma unroll
        for (int ks = 0; ks < 8; ++ks) { const bf16x8 rf = *(const LAS bf16x8*)(RB + (16 * db + l15) * 544 + (32 * ks + 8 * g) * 2); acc = mfma16(rf, qf[ks], acc); }
        oacc[db] = acc;
    }
    __syncthreads();
#pragma unroll
    for (int i = 0; i < 8; ++i) {
        const int idx = tid + 512 * i, row = idx >> 5, ch = idx & 31;
        *(LAS u32x4*)(RA + row * 544 + ch * 16) = pv[i];
        *(LAS u32x4*)(RB + row * 544 + ch * 16) = pr[i];
    }
    __syncthreads();
#pragma unroll
    for (int db = 0; db < 8; ++db) {
        f32x4 acc = {0.f, 0.f, 0.f, 0.f};
#pragma unroll
        for (int ks = 0; ks < 8; ++ks) { const bf16x8 rf = *(const LAS bf16x8*)(RB + (16 * db + l15) * 544 + (32 * ks + 8 * g) * 2); acc = mfma16(rf, qf[ks], acc); }
        oacc[8 + db] = acc;
    }
    const float xi = __builtin_amdgcn_exp2f((float)(qi + 1) * l2g);
#pragma unroll
    for (int db = 0; db < 16; ++db) oacc[db] = oacc[db] * xi;
#pragma unroll
    for (int jj = 0; jj < 8; ++jj)
#pragma unroll
        for (int rg = 0; rg < 4; ++rg) { const int j = 16 * jj + 4 * g + rg; sacc[jj][rg] = (qi >= j) ? sacc[jj][rg] * __builtin_amdgcn_exp2f((float)(qi - j) * l2g) : 0.f; }
#pragma unroll
    for (int s = 0; s < 4; ++s) {
        if (2 * s <= w) {
            u32x4 pw; pw.x = pk2(sacc[2 * s][0], sacc[2 * s][1]); pw.y = pk2(sacc[2 * s][2], sacc[2 * s][3]); pw.z = pk2(sacc[2 * s + 1][0], sacc[2 * s + 1][1]); pw.w = pk2(sacc[2 * s + 1][2], sacc[2 * s + 1][3]);
            const bf16x8 pb = __builtin_bit_cast(bf16x8, pw);
            const int k0 = 32 * s + 4 * g + tq4;
#pragma unroll
            for (int db = 0; db < 16; ++db) {
                const s16x4 lo = trrd(RA + k0 * 544 + (16 * db + 4 * tp4) * 2), hi = trrd(RA + (k0 + 16) * 544 + (16 * db + 4 * tp4) * 2);
                oacc[db] = mfma16(cat8(lo, hi), pb, oacc[db]);
            }
        }
    }
    float s1 = 0.f;
#pragma unroll
    for (int db = 0; db < 16; ++db) s1 += (oacc[db][0] + oacc[db][1]) + (oacc[db][2] + oacc[db][3]);
    s1 += __shfl_xor(s1, 16); s1 += __shfl_xor(s1, 32);
    const float mean = s1 * (1.0f / 256.0f);
    float s2 = 0.f;
#pragma unroll
    for (int db = 0; db < 16; ++db)
#pragma unroll
        for (int rg = 0; rg < 4; ++rg) { const float dd = oacc[db][rg] - mean; s2 += dd * dd; }
    s2 += __shfl_xor(s2, 16); s2 += __shfl_xor(s2, 32);
    const float rstd = rsqrtf(s2 * (1.0f / 256.0f) + LN_EPS);
    __syncthreads();
#pragma unroll
    for (int db = 0; db < 16; ++db) {
        u32x2 o; o.x = pk2((oacc[db][0] - mean) * rstd, (oacc[db][1] - mean) * rstd); o.y = pk2((oacc[db][2] - mean) * rstd, (oacc[db][3] - mean) * rstd);
        *(LAS u32x2*)(RA + qi * 528 + (16 * db + 4 * g) * 2) = o;
    }
    __syncthreads();
#pragma unroll
    for (int i = 0; i < 8; ++i) {
        const int idx = tid + 512 * i, row = idx >> 5, ch = idx & 31;
        const u32x4 nv = *(const LAS u32x4*)(RA + row * 528 + ch * 16);
        const u32x4 gw = *(const u32x4*)(proj + pjo(brow + row, OFF_RG + h * 256 + ch * 8));
        u32x4 o;
#pragma unroll
        for (int q = 0; q < 4; ++q) { const float g0 = bflo(gw[q]), g1 = bfhi(gw[q]); o[q] = pk2(g0 * sigm(g0) * bflo(nv[q]), g1 * sigm(g1) * bfhi(nv[q])); }
        *(u32x4*)((bf16_t*)(ws + WS_YA) + ((size_t)b * SEQ + c * 128 + row) * YLD + 1536 + h * 256 + ch * 8) = o;
    }
    __syncthreads();
}

struct EpiBranch {
    static constexpr bool PERM = false, AFTER_DRAIN = false, SEGMENTED = true;
    const bf16_t* gate; bf16_t* mb; int t1, t2;
    __device__ __forceinline__ void rescale(f32x4 (&acc)[2][2][4][2], const pg8::Unit& u, int seg) const {
        const int tid = mk_tid(), wid = tid >> 6, lane = tid & 63, wr = wid >> 2, wc = wid & 3, fr = lane & 15, fq = lane >> 4;
        const int row0 = u.pm * 256 + wr * 64 + fr, col0 = u.pn * 256 + wc * 32 + 4 * fq;
        const int gp = OFF_GA + 1024 * seg, gn = gp + 1024;
#pragma unroll
        for (int ai = 0; ai < 2; ++ai) {
            u32x2 wp[4][2][2], wn[4][2][2];
#pragma unroll
            for (int m = 0; m < 4; ++m) { const size_t row = (size_t)(row0 + ai * 128 + m * 16);
#pragma unroll
                for (int bj = 0; bj < 2; ++bj)
#pragma unroll
                    for (int n = 0; n < 2; ++n) { const int col = col0 + bj * 128 + n * 16;
                        wp[m][bj][n] = *(const u32x2*)(gate + pjo(row, gp + col)); wn[m][bj][n] = *(const u32x2*)(gate + pjo(row, gn + col)); } }
#pragma unroll
            for (int m = 0; m < 4; ++m)
#pragma unroll
                for (int bj = 0; bj < 2; ++bj)
#pragma unroll
                    for (int n = 0; n < 2; ++n) { const u32x2 p2 = wp[m][bj][n], n2 = wn[m][bj][n];
                        f32x4 v = acc[ai][bj][m][n];
                        v[0] *= (1.f + ex(bflo(n2.x))) * __builtin_amdgcn_rcpf(1.f + ex(bflo(p2.x))); v[1] *= (1.f + ex(bfhi(n2.x))) * __builtin_amdgcn_rcpf(1.f + ex(bfhi(p2.x)));
                        v[2] *= (1.f + ex(bflo(n2.y))) * __builtin_amdgcn_rcpf(1.f + ex(bflo(p2.y))); v[3] *= (1.f + ex(bfhi(n2.y))) * __builtin_amdgcn_rcpf(1.f + ex(bfhi(p2.y)));
                        acc[ai][bj][m][n] = v; }
        }
    }
    static __device__ __forceinline__ float ex(float x) { return __builtin_amdgcn_exp2f(x * -1.4426950408889634f); }
    __device__ __forceinline__ void operator()(const f32x4 (&acc)[2][2][4][2], const pg8::Unit& u, int wr, int wc, int fr, int fq) const {
        const int row0 = u.pm * 256 + wr * 64 + fr, col0 = u.pn * 256 + wc * 32 + 4 * fq;
        const int gcol = OFF_GA + 2048;
#pragma unroll
        for (int ai = 0; ai < 2; ++ai) {
            u32x2 gw[4][2][2];
#pragma unroll
            for (int m = 0; m < 4; ++m) { const size_t row = (size_t)(row0 + ai * 128 + m * 16);
#pragma unroll
                for (int bj = 0; bj < 2; ++bj)
#pragma unroll
                    for (int n = 0; n < 2; ++n) gw[m][bj][n] = *(const u32x2*)(gate + pjo(row, gcol + col0 + bj * 128 + n * 16)); }
#pragma unroll
            for (int m = 0; m < 4; ++m) { const size_t row = (size_t)(row0 + ai * 128 + m * 16);
#pragma unroll
                for (int bj = 0; bj < 2; ++bj)
#pragma unroll
                    for (int n = 0; n < 2; ++n) { const int col = col0 + bj * 128 + n * 16;
                        const u32x2 g2 = gw[m][bj][n];
                        f32x4 v = acc[ai][bj][m][n];
                        v[0] *= sigm(bflo(g2.x)); v[1] *= sigm(bfhi(g2.x)); v[2] *= sigm(bflo(g2.y)); v[3] *= sigm(bfhi(g2.y));
                        u32x2 o; o.x = pk2(v[0], v[1]); o.y = pk2(v[2], v[3]); *(u32x2*)(mb + row * 1024 + col) = o; } }
        }
    }
};
#ifndef MK_EPI_AUX
#define MK_EPI_AUX 0
#endif
struct EpiInProj {
    static constexpr bool PERM = true, AFTER_DRAIN = false;
    bf16_t* O;
    __device__ __forceinline__ void operator()(const f32x4 (&acc)[2][2][4][2], const pg8::Unit& u, int wr_, int wc_, int fr_, int fq_) const {
        (void)wr_; (void)wc_; (void)fr_; (void)fq_;
        const int tid = mk_tid(), wid = tid >> 6, lane = tid & 63, wr = wid >> 2, wc = wid & 3, fr = lane & 15, fq = lane >> 4;
        const __amdgpu_buffer_rsrc_t rsrc = __builtin_amdgcn_make_buffer_rsrc((void*)O, 0, (int)((size_t)NTOK * DIN * 2), 0x00020000);
        const int row0 = u.pm * 256 + wr * 64 + fr;
        const int pn = u.pn;
        const bool ropeA = pn < 12, ropeR = (pn >= 26 && pn < 34);
        const float dsc = 1.0f / (X8_SCALE * W8_SCALE);
        if (!(ropeA || ropeR)) {
            const int col0 = pn * 256 + 64 * wc + 8 * fq;
            const bool isLG = (pn >= 22 && pn < 26);
#pragma unroll
            for (int ai = 0; ai < 2; ++ai) {
#pragma unroll
                for (int m = 0; m < 4; ++m) { const unsigned roff = (unsigned)(pjo((size_t)(row0 + ai * 128 + m * 16), col0) * 2);
#pragma unroll
                    for (int bj = 0; bj < 2; ++bj) { f32x4 v0 = acc[ai][bj][m][0] * dsc, v1 = acc[ai][bj][m][1] * dsc;
                        if (isLG) { const pg8::f32x2 g0 = pg8::gelu_pk((pg8::f32x2){v0[0], v0[1]}), g1 = pg8::gelu_pk((pg8::f32x2){v0[2], v0[3]}), g2 = pg8::gelu_pk((pg8::f32x2){v1[0], v1[1]}), g3 = pg8::gelu_pk((pg8::f32x2){v1[2], v1[3]});
                            v0 = (f32x4){g0.x, g0.y, g1.x, g1.y}; v1 = (f32x4){g2.x, g2.y, g3.x, g3.y}; }
                        u32x4 w; w.x = pk2(v0[0], v0[1]); w.y = pk2(v0[2], v0[3]); w.z = pk2(v1[0], v1[1]); w.w = pk2(v1[2], v1[3]);
                        __builtin_amdgcn_raw_buffer_store_b128(w, rsrc, (int)(roff + bj * 64), 0, MK_EPI_AUX); } }
            }
        } else {
            const int half = ropeA ? 64 : 128;
            const float sc = dsc * ((pn >= 30 && pn < 34) ? 0.0625f : 1.0f);
            const float kf = ropeA ? (-13.287712379549449f / 64.0f) : (-13.287712379549449f / 128.0f);
            const float pos0 = (float)(row0 & (SEQ - 1));
            const int j0 = ropeA ? (32 * (wc & 1) + 8 * fq) : (32 * wc + 8 * fq);
            const int lcol = ropeA ? (128 * (wc >> 1) + j0) : j0;
            float cb[8], sb[8], c16[8], s16[8], cb1[8], sb1[8];
#pragma unroll
            for (int i = 0; i < 8; ++i) {
                const float f = __builtin_amdgcn_exp2f((float)(j0 + i) * kf) * 0.15915494309189535f;
                const float t0 = __builtin_amdgcn_fractf(pos0 * f), t16 = __builtin_amdgcn_fractf(16.0f * f), t128 = __builtin_amdgcn_fractf(128.0f * f);
                cb[i] = __builtin_amdgcn_cosf(t0); sb[i] = __builtin_amdgcn_sinf(t0);
                c16[i] = __builtin_amdgcn_cosf(t16); s16[i] = __builtin_amdgcn_sinf(t16);
                const float c128 = __builtin_amdgcn_cosf(t128), s128 = __builtin_amdgcn_sinf(t128);
                cb1[i] = cb[i] * c128 - sb[i] * s128; sb1[i] = sb[i] * c128 + cb[i] * s128;
            }
#pragma unroll
            for (int ai = 0; ai < 2; ++ai) {
                float cv[8], sv[8];
#pragma unroll
                for (int i = 0; i < 8; ++i) { cv[i] = ai ? cb1[i] : cb[i]; sv[i] = ai ? sb1[i] : sb[i]; }
#pragma unroll
                for (int m = 0; m < 4; ++m) {
                    const int row = row0 + ai * 128 + m * 16;
                    const unsigned roff = (unsigned)(pjo((size_t)row, pn * 256 + lcol) * 2);
                    float o1[8], o2[8];
#pragma unroll
                    for (int i = 0; i < 8; ++i) { const float t1 = acc[ai][0][m][i >> 2][i & 3] * sc, t2 = acc[ai][1][m][i >> 2][i & 3] * sc; o1[i] = t1 * cv[i] - t2 * sv[i]; o2[i] = t1 * sv[i] + t2 * cv[i]; }
                    u32x4 w1, w2;
#pragma unroll
                    for (int q = 0; q < 4; ++q) { w1[q] = pk2(o1[2 * q], o1[2 * q + 1]); w2[q] = pk2(o2[2 * q], o2[2 * q + 1]); }
                    __builtin_amdgcn_raw_buffer_store_b128(w1, rsrc, (int)roff, 0, MK_EPI_AUX);
                    __builtin_amdgcn_raw_buffer_store_b128(w2, rsrc, (int)(roff + half * 2), 0, MK_EPI_AUX);
                    if (m < 3) {
#pragma unroll
                        for (int i = 0; i < 8; ++i) { const float cn = cv[i] * c16[i] - sv[i] * s16[i], sn = sv[i] * c16[i] + cv[i] * s16[i]; cv[i] = cn; sv[i] = sn; } }
                }
            }
        }
    }
};

struct EpiOut {
    static constexpr bool PERM = false, AFTER_DRAIN = false;
    const float* xf; float* z;
    __device__ __forceinline__ void operator()(const f32x4 (&acc)[2][2][4][2], const pg8::Unit& u, int wr, int wc, int fr, int fq) const {
        const int row0 = u.pm * 256 + wr * 64 + fr, col0 = u.pn * 256 + wc * 32 + 4 * fq;
#pragma unroll
        for (int ai = 0; ai < 2; ++ai) {
            f32x4 xv[4][2][2];
#pragma unroll
            for (int m = 0; m < 4; ++m) { const size_t row = (size_t)(row0 + ai * 128 + m * 16);
#pragma unroll
                for (int bj = 0; bj < 2; ++bj)
#pragma unroll
                    for (int n = 0; n < 2; ++n) xv[m][bj][n] = *(const f32x4*)(xf + row * 1024 + col0 + bj * 128 + n * 16); }
#pragma unroll
            for (int m = 0; m < 4; ++m) { const size_t row = (size_t)(row0 + ai * 128 + m * 16);
#pragma unroll
                for (int bj = 0; bj < 2; ++bj)
#pragma unroll
                    for (int n = 0; n < 2; ++n) *(f32x4*)(z + row * 1024 + col0 + bj * 128 + n * 16) = xv[m][bj][n] * ALPHA + acc[ai][bj][m][n]; }
        }
    }
};

DI void ln_row(const float* z, const float* gam, const float* bet, float* of, bf16_t* ob, int lane) {
    f32x4 v[4]; float s = 0.f;
#pragma unroll
    for (int i = 0; i < 4; ++i) { v[i] = *(const f32x4*)(z + 256 * i + 4 * lane); s += (v[i][0] + v[i][1]) + (v[i][2] + v[i][3]); }
    const float mean = wsum(s) * (1.0f / 1024.0f);
    float q = 0.f;
#pragma unroll
    for (int i = 0; i < 4; ++i)
#pragma unroll
        for (int j = 0; j < 4; ++j) { const float d = v[i][j] - mean; q += d * d; }
    const float rstd = rsqrtf(wsum(q) * (1.0f / 1024.0f) + LN_EPS);
#pragma unroll
    for (int i = 0; i < 4; ++i) {
        const f32x4 gg = *(const f32x4*)(gam + 256 * i + 4 * lane), bb = *(const f32x4*)(bet + 256 * i + 4 * lane);
        f32x4 o;
#pragma unroll
        for (int j = 0; j < 4; ++j) o[j] = (v[i][j] - mean) * rstd * gg[j] + bb[j];
        *(f32x4*)(of + 256 * i + 4 * lane) = o;
        u32x2 pb; pb.x = pk2(o[0], o[1]); pb.y = pk2(o[2], o[3]); *(u32x2*)(ob + 256 * i + 4 * lane) = pb;
    }
}
DI void phase_ln1(const Args& a, int layer) {
    unsigned char* ws = a.ws;
    const int lane = mk_tid() & 63, w = mk_tid() >> 6;
    for (int u = blockIdx.x; u < NTOK / 8; u += gridDim.x) {
        const size_t row = (size_t)u * 8 + w;
        ln_row((const float*)(ws + WS_MRGF) + row * 1024, a.in[11] + layer * 1024, a.in[12] + layer * 1024, (float*)(ws + WS_XF) + row * 1024, (bf16_t*)(ws + WS_XB) + row * 1024, lane);
    }
}

DI void ins16(float (&L)[16], float x) {
#pragma unroll
    for (int k = 0; k < 16; ++k) { const float hi = fmaxf(L[k], x); x = fminf(L[k], x); L[k] = hi; }
}
DI void merge16(float (&L)[16], int xr) {
    float t[16];
#pragma unroll
    for (int k = 0; k < 16; ++k) t[k] = __shfl_xor(L[k], xr);
#pragma unroll
    for (int k = 0; k < 8; ++k) { const float x = t[k]; t[k] = t[15 - k]; t[15 - k] = x; }
#pragma unroll
    for (int k = 0; k < 16; ++k) t[k] = fmaxf(L[k], t[k]);
#define MK_CE_STAGE(dd) _Pragma("unroll") for (int k = 0; k < 16; ++k) if ((k & (dd)) == 0) { const float hi = fmaxf(t[k], t[k + (dd)]), lo = fminf(t[k], t[k + (dd)]); t[k] = hi; t[k + (dd)] = lo; }
    MK_CE_STAGE(8) MK_CE_STAGE(4) MK_CE_STAGE(2) MK_CE_STAGE(1)
#undef MK_CE_STAGE
#pragma unroll
    for (int k = 0; k < 16; ++k) L[k] = t[k];
}
#define MK_CE_DESC(v, i, l) { const float hi_ = fmaxf(v[i], v[l]), lo_ = fminf(v[i], v[l]); v[i] = hi_; v[l] = lo_; }
#define MK_CE_ASC(v, i, l)  { const float hi_ = fmaxf(v[i], v[l]), lo_ = fminf(v[i], v[l]); v[i] = lo_; v[l] = hi_; }
#define MK_BITONIC_STAGE(v, kk, jj) _Pragma("unroll") for (int i_ = 0; i_ < 16; ++i_) { if ((i_ & (jj)) == 0) { if ((i_ & (kk)) == 0) MK_CE_DESC(v, i_, i_ + (jj)) else MK_CE_ASC(v, i_, i_ + (jj)) } }
DI void sort16_desc(float (&v)[16]) {
    MK_BITONIC_STAGE(v, 2, 1)
    MK_BITONIC_STAGE(v, 4, 2) MK_BITONIC_STAGE(v, 4, 1)
    MK_BITONIC_STAGE(v, 8, 4) MK_BITONIC_STAGE(v, 8, 2) MK_BITONIC_STAGE(v, 8, 1)
    MK_BITONIC_STAGE(v, 16, 8) MK_BITONIC_STAGE(v, 16, 4) MK_BITONIC_STAGE(v, 16, 2) MK_BITONIC_STAGE(v, 16, 1)
}
DI void top16_of_two(float (&a)[16], const float (&b)[16]) {
#pragma unroll
    for (int k = 0; k < 16; ++k) a[k] = fmaxf(a[k], b[15 - k]);
    MK_BITONIC_STAGE(a, 16, 8) MK_BITONIC_STAGE(a, 16, 4) MK_BITONIC_STAGE(a, 16, 2) MK_BITONIC_STAGE(a, 16, 1)
}
DI void top16_half(const bf16_t* qp, const LAS unsigned char* kt, float (&L)[16], int g, int l15) {
    bf16x8 qf[4];
#pragma unroll
    for (int ks = 0; ks < 4; ++ks) qf[ks] = *(const bf16x8*)(qp + 32 * ks + 8 * g);
    float M[16];
#pragma unroll
    for (int kbk = 0; kbk < 8; ++kbk) {
        f32x4 acc = {0.f, 0.f, 0.f, 0.f};
#pragma unroll
        for (int ks = 0; ks < 4; ++ks) { const bf16x8 kf = *(const LAS bf16x8*)(kt + (16 * kbk + l15) * 256 + (((4 * ks + g) ^ l15) << 4)); acc = mfma16(kf, qf[ks], acc); }
#pragma unroll
        for (int rg = 0; rg < 4; ++rg) { const unsigned key = (unsigned)(16 * kbk + 4 * g + rg); const float x = __uint_as_float((__float_as_uint(acc[rg]) & ~0x7Fu) | key);
            if (kbk < 4) L[4 * kbk + rg] = x; else M[4 * (kbk - 4) + rg] = x; }
    }
    sort16_desc(L); sort16_desc(M); top16_of_two(L, M);
    merge16(L, 16); merge16(L, 32);
}
DI void topk_unit(const Args& a, int unit, LAS unsigned char* lds) {
    unsigned char* ws = a.ws;
    const int tid = mk_tid(), lane = tid & 63, w = __builtin_amdgcn_readfirstlane(tid >> 6), g = lane >> 4, l15 = lane & 15;
    const int tg = w & 3, hs = w >> 2;
    const size_t t = (size_t)unit * 64 + tg * 16 + l15;
    const bf16_t* Q = (const bf16_t*)(ws + WS_Q);
    LAS unsigned char* tiles = lds + 16384;
    float K1[16], K2[16];
#pragma unroll
    for (int k = 0; k < 16; ++k) { K1[k] = 0.f; K2[k] = 0.f; }
#pragma unroll 1
    for (int hh = 0; hh < 4; ++hh) {
#pragma unroll
        for (int i = 0; i < 16; ++i) {
            const int idx = tid + 512 * i, tile = idx >> 11, row = (idx >> 4) & 127, ch = idx & 15;
            const int hd = ((tile >> 1) ? 4 : 0) + hh;
            const bf16_t* src = (const bf16_t*)(ws + ((tile & 1) ? WS_K2B : WS_K1B)) + ((size_t)hd * 128 + row) * 128 + ch * 8;
            *(LAS u32x4*)(tiles + tile * 32768 + row * 256 + ((ch ^ (row & 15)) << 4)) = *(const u32x4*)src;
        }
        __syncthreads();
        const int h = hs * 4 + hh;
        float l1[16], l2[16];
        top16_half(Q + t * 2048 + h * 256, tiles + (hs * 2) * 32768, l1, g, l15);
        top16_half(Q + t * 2048 + h * 256 + 128, tiles + (hs * 2 + 1) * 32768, l2, g, l15);
        const bool mine = (g == hh);
#pragma unroll
        for (int k = 0; k < 16; ++k) { K1[k] = mine ? l1[k] : K1[k]; K2[k] = mine ? l2[k] : K2[k]; }
        __syncthreads();
    }
    const int h = hs * 4 + g;
    float F[16];
#pragma unroll
    for (int k = 0; k < 16; ++k) F[k] = -FLT_MAX;
#pragma unroll
    for (int ia = 0; ia < 16; ++ia)
#pragma unroll
        for (int ib = 0; ib < 16 / (ia + 1); ++ib) {
            const float s = __uint_as_float(__float_as_uint(K1[ia]) & ~0x7Fu) + __uint_as_float(__float_as_uint(K2[ib]) & ~0x7Fu);
            ins16(F, __uint_as_float((__float_as_uint(s) & ~0xFFu) | (unsigned)(ia * 16 + ib)));
        }
    LAS unsigned char* row = lds + tid * 32;
#pragma unroll
    for (int k = 0; k < 16; ++k) { row[k] = (unsigned char)(__float_as_uint(K1[k]) & 0x7Fu); row[16 + k] = (unsigned char)(__float_as_uint(K2[k]) & 0x7Fu); }
    float gt[16]; int ei[16]; float gs = 0.f;
    const float cv0 = __uint_as_float(__float_as_uint(F[0]) & ~0xFFu);
#pragma unroll
    for (int k = 0; k < 16; ++k) {
        const unsigned bits = __float_as_uint(F[k]);
        const float cv = __uint_as_float(bits & ~0xFFu);
        gt[k] = __builtin_amdgcn_exp2f((cv - cv0) * 1.4426950408889634f); gs += gt[k];
        const int ia = (int)((bits >> 4) & 15u), ib = (int)(bits & 15u);
        ei[k] = (int)row[ia] * 128 + (int)row[16 + ib];
    }
    const float ig = 1.0f / gs;
    int* ep = (int*)(ws + WS_EID) + (t * 8 + h) * 16; float* gp = (float*)(ws + WS_GATE) + (t * 8 + h) * 16;
#pragma unroll
    for (int q = 0; q < 4; ++q) {
        *(i32x4*)(ep + 4 * q) = (i32x4){ei[4 * q], ei[4 * q + 1], ei[4 * q + 2], ei[4 * q + 3]};
        *(f32x4*)(gp + 4 * q) = (f32x4){gt[4 * q] * ig, gt[4 * q + 1] * ig, gt[4 * q + 2] * ig, gt[4 * q + 3] * ig};
    }
    __syncthreads();
}

typedef float f32x2 __attribute__((ext_vector_type(2)));
typedef __bf16 bf16x32 __attribute__((ext_vector_type(32)));
typedef unsigned u32x16 __attribute__((ext_vector_type(16)));
#define MK_PB_LOAD(RA_, ereg, kb) _Pragma("unroll") for (int j = 0; j < 8; ++j) { const int e_ = __builtin_amdgcn_readlane(ereg, (kb) + j); \
        RA_[j] = ((const u32x4*)(UV + (size_t)(unsigned)e_ * UVREC))[lane]; }
#define MK_U4(w, s) __builtin_bit_cast(unsigned, __builtin_amdgcn_cvt_scalef32_pk_bf16_fp4(w, 1.0f, s))
#define MK_V4(w, s) __builtin_amdgcn_cvt_scalef32_pk_f32_fp4(w, 1.0f, s)
#define MK_PB_COMP(RA_, usreg, gvreg, kb) { \
        float pp_[8]; \
        _Pragma("unroll") for (int j = 0; j < 8; ++j) { \
            float s0_ = 0.f, s1_ = 0.f; \
            s0_ = dot2(MK_U4(RA_[j][0], 0), xpk[0], s0_); s1_ = dot2(MK_U4(RA_[j][0], 1), xpk[1], s1_); s0_ = dot2(MK_U4(RA_[j][0], 2), xpk[2], s0_); s1_ = dot2(MK_U4(RA_[j][0], 3), xpk[3], s1_); \
            s0_ = dot2(MK_U4(RA_[j][1], 0), xpk[4], s0_); s1_ = dot2(MK_U4(RA_[j][1], 1), xpk[5], s1_); s0_ = dot2(MK_U4(RA_[j][1], 2), xpk[6], s0_); s1_ = dot2(MK_U4(RA_[j][1], 3), xpk[7], s1_); \
            pp_[j] = s0_ + s1_; } \
        float q4_[4], r2_[2]; \
        _Pragma("unroll") for (int i = 0; i < 4; ++i) { const float keep_ = hi32 ? pp_[4 + i] : pp_[i], send_ = hi32 ? pp_[i] : pp_[4 + i]; q4_[i] = keep_ + __shfl_xor(send_, 32); } \
        _Pragma("unroll") for (int i = 0; i < 2; ++i) { const float keep_ = hi16 ? q4_[2 + i] : q4_[i], send_ = hi16 ? q4_[i] : q4_[2 + i]; r2_[i] = keep_ + __shfl_xor(send_, 16); } \
        float tot_ = (hi8 ? r2_[1] : r2_[0]) + __shfl_xor(hi8 ? r2_[0] : r2_[1], 8); \
        tot_ += __shfl_xor(tot_, 4); tot_ += __shfl_xor(tot_, 2); tot_ += __shfl_xor(tot_, 1); \
        const float act_ = gelu_as(tot_ * __shfl(usreg, (kb) + jj)) * __shfl(gvreg, (kb) + jj); \
        _Pragma("unroll") for (int j = 0; j < 8; ++j) { \
            const float aj_ = __uint_as_float(__builtin_amdgcn_readlane(__float_as_uint(act_), 32 * (j >> 2) + 16 * ((j >> 1) & 1) + 8 * (j & 1))); const f32x2 a2_ = {aj_, aj_}; \
            y2[0] += a2_ * MK_V4(RA_[j][2], 0); y2[1] += a2_ * MK_V4(RA_[j][2], 1); y2[2] += a2_ * MK_V4(RA_[j][2], 2); y2[3] += a2_ * MK_V4(RA_[j][2], 3); \
            y2[4] += a2_ * MK_V4(RA_[j][3], 0); y2[5] += a2_ * MK_V4(RA_[j][3], 1); y2[6] += a2_ * MK_V4(RA_[j][3], 2); y2[7] += a2_ * MK_V4(RA_[j][3], 3); } }
DI void peer_token(const unsigned char* UV, int e0, int e1, float us0, float us1, float gv0, float gv1, const unsigned (&xpk)[8], f32x2 (&y2)[8], int lane) {
    const bool hi32 = (lane & 32) != 0, hi16 = (lane & 16) != 0, hi8 = (lane & 8) != 0;
    const int jj = ((lane >> 5) & 1) * 4 + ((lane >> 4) & 1) * 2 + ((lane >> 3) & 1);
    u32x4 A0[8], A1[8];
    MK_PB_LOAD(A0, e0, 0)
#pragma unroll 1
    for (int b = 0; b < 8; b += 2) {
        MK_PB_LOAD(A1, e0, 8 * b + 8)
        MK_PB_COMP(A0, us0, gv0, 8 * b)
        if (b + 2 < 8) { MK_PB_LOAD(A0, e0, 8 * b + 16) } else { MK_PB_LOAD(A0, e1, 0) }
        MK_PB_COMP(A1, us0, gv0, 8 * b + 8)
    }
#pragma unroll 1
    for (int b = 0; b < 8; b += 2) {
        MK_PB_LOAD(A1, e1, 8 * b + 8)
        MK_PB_COMP(A0, us1, gv1, 8 * b)
        if (b + 2 < 8) { MK_PB_LOAD(A0, e1, 8 * b + 16) }
        MK_PB_COMP(A1, us1, gv1, 8 * b + 8)
    }
}
DI void peer_unit(const Args& a, int layer, int unit) {
    unsigned char* ws = a.ws;
    const int tid = mk_tid(), lane = tid & 63, w = __builtin_amdgcn_readfirstlane(tid >> 6);
    const unsigned char* UV = ws + WS_UV8; const float* SC = (const float*)(ws + WS_UVS);
#pragma unroll 1
    for (int i = 0; i < 8; ++i) {
        const size_t t = (size_t)unit * 64 + w * 8 + i;
        unsigned xpk[8]; f32x2 y2[8];
        int e0, e1; float us0, us1, gv0, gv1;
        {
            const int ln = mk_tid() & 63;
            const bf16_t* xbp = (const bf16_t*)(ws + WS_XB) + t * 1024 + 16 * ln;
            const u32x4 xa = *(const u32x4*)xbp, xb = *(const u32x4*)(xbp + 8);
#pragma unroll
            for (int q = 0; q < 4; ++q) { xpk[q] = xa[q]; xpk[4 + q] = xb[q]; }
            const int* ep = (const int*)(ws + WS_EID) + t * 128; const float* gp = (const float*)(ws + WS_GATE) + t * 128;
            e0 = ep[ln]; e1 = ep[64 + ln]; const float g0 = gp[ln], g1 = gp[64 + ln];
            const f32x2 s0 = *(const f32x2*)(SC + 2 * e0), s1 = *(const f32x2*)(SC + 2 * e1);
            us0 = s0.x; us1 = s1.x; gv0 = g0 * s0.y; gv1 = g1 * s1.y;
        }
#pragma unroll
        for (int q = 0; q < 8; ++q) y2[q] = (f32x2){0.f, 0.f};
        peer_token(UV, e0, e1, us0, us1, gv0, gv1, xpk, y2, lane);
        {
            const int ln = mk_tid() & 63;
            float* xfp = (float*)(ws + WS_XF) + t * 1024 + 16 * ln;
            const float* gam = a.in[18] + layer * 1024 + 16 * ln; const float* bet = a.in[19] + layer * 1024 + 16 * ln;
            float z[16]; float s = 0.f;
#pragma unroll
            for (int q = 0; q < 4; ++q) { const f32x4 xr = *(const f32x4*)(xfp + 4 * q);
#pragma unroll
                for (int j = 0; j < 4; ++j) { z[4 * q + j] = ALPHA * xr[j] + y2[2 * q + (j >> 1)][j & 1]; s += z[4 * q + j]; } }
            const float mean = wsum(s) * (1.0f / 1024.0f);
            float qq = 0.f;
#pragma unroll
            for (int q = 0; q < 16; ++q) { const float d = z[q] - mean; qq += d * d; }
            const float rstd = rsqrtf(wsum(qq) * (1.0f / 1024.0f) + LN_EPS);
            f32x4 o[4];
#pragma unroll
            for (int q = 0; q < 4; ++q) { const f32x4 gq = *(const f32x4*)(gam + 4 * q), bq = *(const f32x4*)(bet + 4 * q);
#pragma unroll
                for (int j = 0; j < 4; ++j) o[q][j] = (z[4 * q + j] - mean) * rstd * gq[j] + bq[j]; }
#pragma unroll
            for (int q = 0; q < 4; ++q) *(f32x4*)(xfp + 4 * q) = o[q];
            if (layer == DEPTH - 1) { float* op = a.out + t * 1024 + 16 * ln;
#pragma unroll
                for (int q = 0; q < 4; ++q) *(f32x4*)(op + 4 * q) = o[q]; }
            row_to_fp8(o, ws + WS_X8 + t * 1024, ln);
        }
    }
}
}

namespace mk {
constexpr int LDS_ARG_OFF = LDS_BYTES - 16 - 256;
#define MK_NOINL __device__ __forceinline__
DI unsigned long long rfl64(unsigned long long v) { const unsigned lo = __builtin_amdgcn_readfirstlane((unsigned)v), hi = __builtin_amdgcn_readfirstlane((unsigned)(v >> 32)); return ((unsigned long long)hi << 32) | lo; }
DI Args load_args(LAS unsigned char* lds) {
    int aoff = LDS_ARG_OFF; asm volatile("" : "+s"(aoff));
    Args a; const LAS unsigned long long* p = (const LAS unsigned long long*)(lds + aoff);
#pragma unroll
    for (int i = 0; i < 20; ++i) a.in[i] = (const float*)(const __attribute__((address_space(1))) float*)rfl64(p[i]);
    a.out = (float*)(__attribute__((address_space(1))) float*)rfl64(p[20]); a.ws = (unsigned char*)(__attribute__((address_space(1))) unsigned char*)rfl64(p[21]);
    a.ropeA = __longlong_as_double((long long)rfl64(p[22])); a.ropeR = __longlong_as_double((long long)rfl64(p[23])); a.ph_lo = 0; a.ph_hi = 0;
    return a;
}
#define MK_LOADARGS const Args a = load_args(lds); unsigned char* ws = a.ws; const int G = (int)gridDim.x, bid = (int)blockIdx.x; (void)ws; (void)G; (void)bid
MK_NOINL void PG_prologue(LAS unsigned char* lds) { MK_LOADARGS; phase_prologue(a); }
MK_NOINL void P0_conv(LAS unsigned char* lds, int layer) { MK_LOADARGS; phase_conv(a, layer, lds); }
#ifndef MK_STAGGER_TICKS
#define MK_STAGGER_TICKS 140
#endif
MK_NOINL void P1_inproj(LAS unsigned char* lds, int layer) { MK_LOADARGS; (void)layer;
    pg8::Gemm gm; gm.A = (const bf16_t*)(ws + WS_X8); gm.Bt = (const bf16_t*)(ws + WS_WINT); gm.M = NTOK; gm.N = DIN; gm.K = 512;
    pg8::StaticOrder S; S.init(NTOK, DIN, G, bid);
    EpiInProj E; E.O = (bf16_t*)(ws + WS_PROJ);
    pg8::gemm_phase<EpiInProj, pg8::StaticOrder, false, true, true>(lds, gm, S, E, nullptr); }
#ifndef MK_NLRU
#define MK_NLRU 64
#endif
MK_NOINL void P3s_lru(LAS unsigned char* lds, int layer) { MK_LOADARGS; if (bid < MK_NLRU) { for (int s = bid; s < 64; s += MK_NLRU) lru_stripe(a, layer, s, lds); } }
MK_NOINL void P3a_attn(LAS unsigned char* lds, int layer) { MK_LOADARGS; (void)layer; if (bid >= MK_NLRU) { for (int u = bid - MK_NLRU; u < 1536; u += G - MK_NLRU) attn_unit(a, u, lds); } }
MK_NOINL void P3b_retkv(LAS unsigned char* lds, int layer) { MK_LOADARGS; (void)layer; if (bid >= MK_NLRU) { for (int u = bid - MK_NLRU; u < 512; u += G - MK_NLRU) retkv_unit(a, u, lds); } }
MK_NOINL void P4a_scan(LAS unsigned char* lds, int layer) { MK_LOADARGS; (void)layer; for (int u = bid; u < 256; u += G) retscan_unit(a, u); }
MK_NOINL void P4c_merge(LAS unsigned char* lds, int layer) { MK_LOADARGS; (void)layer; for (int u = bid; u < 2048; u += G) attmerge_unit(a, u); }
MK_NOINL void P5_retout(LAS unsigned char* lds, int layer) { MK_LOADARGS; (void)layer; for (int u = bid; u < 512; u += G) retout_unit(a, u, lds); }
MK_NOINL void P6_branch(LAS unsigned char* lds, int layer) { MK_LOADARGS; (void)layer;
    pg8::Gemm gm; gm.A = (const bf16_t*)(ws + WS_YA); gm.Bt = (const bf16_t*)(ws + WS_WBAT); gm.M = NTOK; gm.N = 1024; gm.K = YLD;
    pg8::StaticOrder S; S.init(NTOK, 1024, G, bid);
    EpiBranch E; E.gate = (const bf16_t*)(ws + WS_PROJ); E.mb = (bf16_t*)(ws + WS_MRGB); E.t1 = 512 / 64; E.t2 = 1536 / 64;
    pg8::gemm_phase<EpiBranch, pg8::StaticOrder, false>(lds, gm, S, E, nullptr); }
MK_NOINL void P7_outproj(LAS unsigned char* lds, int layer) { MK_LOADARGS; (void)layer;
    pg8::Gemm gm; gm.A = (const bf16_t*)(ws + WS_MRGB); gm.Bt = (const bf16_t*)(ws + WS_WOT); gm.M = NTOK; gm.N = 1024; gm.K = 1024;
    pg8::StaticOrder S; S.init(NTOK, 1024, G, bid);
    EpiOut E; E.xf = (const float*)(ws + WS_XF); E.z = (float*)(ws + WS_MRGF);
    pg8::gemm_phase<EpiOut, pg8::StaticOrder, false>(lds, gm, S, E, nullptr); }
MK_NOINL void P8_ln1(LAS unsigned char* lds, int layer) { MK_LOADARGS; phase_ln1(a, layer); }
MK_NOINL void P9_wq(LAS unsigned char* lds, int layer) { MK_LOADARGS; (void)layer;
    pg8::Gemm gm; gm.A = (const bf16_t*)(ws + WS_XB); gm.Bt = (const bf16_t*)(ws + WS_WQT); gm.M = NTOK; gm.N = 2048; gm.K = 1024;
    pg8::StaticOrder S; S.init(NTOK, 2048, G, bid);
    pg8::EpiBf16<0> E; E.O = (bf16_t*)(ws + WS_Q); E.ldc = 2048; E.bias = nullptr; E.split_cols = 0; E.split_stride = 0;
    pg8::gemm_phase<pg8::EpiBf16<0>, pg8::StaticOrder, false>(lds, gm, S, E, nullptr); }
MK_NOINL void P10_topk(LAS unsigned char* lds, int layer) { MK_LOADARGS; (void)layer; for (int u = bid; u < NTOK / 64; u += G) topk_unit(a, u, lds); }
MK_NOINL void P11_peer(LAS unsigned char* lds, int layer) { MK_LOADARGS; for (int u = bid; u < NTOK / 64; u += G) peer_unit(a, layer, u); }
DI void mk_sync(LAS unsigned char* lds) {
    const Args a = load_args(lds);
    XcdBarrier b; b.bar = (unsigned*)(a.ws + WS_CTL); b.x = xb_xcc_id(); b.st = (volatile LAS unsigned*)(lds + LDS_BAR_OFF);
    xcd_barrier(b);
}
}

#ifndef MK_PHASE_MASK
#define MK_PHASE_MASK 0xFFFu
#endif
#define MK_RUN(k) ((((MK_PHASE_MASK) >> ((k) - pb)) & 1u) && (k) >= ph_lo && (k) < ph_hi)
#define MK_NPHASES (1 + mk::DEPTH * mk::NPH)

#define MK_SYNC(k) do { if ((k) >= ph_lo && (k) + 1 < ph_hi) mk::mk_sync(lds); } while (0)
__global__ __launch_bounds__(512, 2) void mk_fwd(mk::Args a) {
    using namespace mk;
    extern __shared__ __attribute__((aligned(16))) unsigned char smem_raw[];
    LAS unsigned char* lds = (LAS unsigned char*)smem_raw;
    const int ph_lo = a.ph_lo, ph_hi = a.ph_hi;
    {
        const unsigned* src = (const unsigned*)&a;
        if (threadIdx.x < sizeof(Args) / 4) ((LAS unsigned*)(lds + LDS_ARG_OFF))[threadIdx.x] = src[threadIdx.x];
        if (threadIdx.x == 0) { LAS unsigned* st = (LAS unsigned*)(lds + LDS_BAR_OFF); st[0] = 0u; st[1] = 0u; st[2] = 0u; st[3] = 0u; }
    }
    __syncthreads();
    if (ph_hi - ph_lo > 1) (void)xcd_barrier_post((unsigned*)(a.ws + WS_CTL), (volatile LAS unsigned*)(lds + LDS_BAR_OFF));
    if (0 >= ph_lo && 0 < ph_hi) PG_prologue(lds);
    MK_SYNC(0);
#pragma unroll 1
    for (int layer = 0; layer < DEPTH; ++layer) {
        const int pb = 1 + layer * NPH;
        if (MK_RUN(pb + 0)) P0_conv(lds, layer);
        MK_SYNC(pb + 0);
        if (MK_RUN(pb + 1)) P1_inproj(lds, layer);
        MK_SYNC(pb + 1);
        if (MK_RUN(pb + 3)) { P3s_lru(lds, layer); P3a_attn(lds, layer); P3b_retkv(lds, layer); }
        MK_SYNC(pb + 3);
        if (MK_RUN(pb + 4)) { P4a_scan(lds, layer); P4c_merge(lds, layer); }
        MK_SYNC(pb + 4);
        if (MK_RUN(pb + 5)) P5_retout(lds, layer);
        MK_SYNC(pb + 5);
        if (MK_RUN(pb + 6)) P6_branch(lds, layer);
        MK_SYNC(pb + 6);
        if (MK_RUN(pb + 7)) P7_outproj(lds, layer);
        MK_SYNC(pb + 7);
        if (MK_RUN(pb + 8)) P8_ln1(lds, layer);
        MK_SYNC(pb + 8);
        if (MK_RUN(pb + 9)) P9_wq(lds, layer);
        MK_SYNC(pb + 9);
        if (MK_RUN(pb + 10)) P10_topk(lds, layer);
        if (MK_RUN(pb + 11)) P11_peer(lds, layer);
        MK_SYNC(pb + 11);
    }
}

#ifndef MK_SINGLE
#define MK_SINGLE 1
#endif
extern "C" void kernel_launch(void* const* d_in, const int* in_sizes, int n_in, void* d_out, int out_size, void* d_ws, size_t ws_size, hipStream_t stream) {
    using namespace mk;
    static int grid = 0;
    if (grid == 0) {
        if (n_in != 20 || out_size != NTOK * D || ws_size < WS_END) { fprintf(stderr, "kernel_launch: unexpected shapes (n_in %d, out %d, ws %zu, need %zu)\n", n_in, out_size, ws_size, (size_t)WS_END); grid = -1; return; }
        int dev = 0, cus = 0, per_cu = 0;
        if (hipGetDevice(&dev) != hipSuccess || hipDeviceGetAttribute(&cus, hipDeviceAttributeMultiprocessorCount, dev) != hipSuccess) { grid = -1; return; }
        if (hipFuncSetAttribute((const void*)mk_fwd, hipFuncAttributeMaxDynamicSharedMemorySize, LDS_BYTES) != hipSuccess) { fprintf(stderr, "kernel_launch: hipFuncSetAttribute failed\n"); grid = -1; return; }
        if (hipOccupancyMaxActiveBlocksPerMultiprocessor(&per_cu, (const void*)mk_fwd, 512, LDS_BYTES) != hipSuccess || per_cu < 1) { fprintf(stderr, "kernel_launch: occupancy query says %d blocks per CU\n", per_cu); (void)hipGetLastError(); grid = -1; return; }
        grid = cus;
    }
    if (grid < 0) return;
    (void)in_sizes;
    Args a{};
    for (int i = 0; i < 20; ++i) a.in[i] = (const float*)d_in[i];
    a.out = (float*)d_out; a.ws = (unsigned char*)d_ws;
    a.ropeA = pow(10000.0, -2.0 / 128.0); a.ropeR = pow(10000.0, -2.0 / 256.0);
#if MK_SINGLE
    (void)hipMemsetAsync((unsigned char*)d_ws + WS_CTL, 0, 16384, stream);
    a.ph_lo = 0; a.ph_hi = MK_NPHASES;
    hipLaunchKernelGGL(mk_fwd, dim3(grid), dim3(512), LDS_BYTES, stream, a);
#else
    for (int p = 0; p < MK_NPHASES; ++p) { a.ph_lo = p; a.ph_hi = p + 1; hipLaunchKernelGGL(mk_fwd, dim3(grid), dim3(512), LDS_BYTES, stream, a); }
#endif
}
```

```cpp
#include <hip/hip_runtime.h>
#include <cstdio>
#include <cstdint>
#include <cmath>
#include <cfloat>
__device__ __forceinline__ int mk_tid() { int t = (int)threadIdx.x; asm volatile("" : "+v"(t)); return t; }
namespace pg8 {
#define PG8_LAS __attribute__((address_space(3)))
typedef unsigned short bf16_t;
typedef short bf16x8 __attribute__((ext_vector_type(8)));
typedef float f32x4 __attribute__((ext_vector_type(4)));
typedef unsigned u32x4 __attribute__((ext_vector_type(4)));
constexpr int BM = 256, BK = 64, HALF = 128, HTB = HALF * BK * 2  , STAGE_BYTES = 8 * HTB, NXCD = 8, WGM = 8;

__host__ __device__ __forceinline__ int lds_byte(int r, int c) { const int st = (r >> 4) * 2 + (c >> 5), rr = r & 15, cc = c & 31, ob = rr * 64 + cc * 2; return st * 1024 + (ob ^ (((ob >> 9) & 1) << 5)); }
__host__ __device__ __forceinline__ void stage_rc(int b, int& R, int& C) { const int st = b / 1024, sb = b % 1024, swz = sb ^ (((sb >> 9) & 1) << 5); R = (st >> 1) * 16 + swz / 64; C = (st & 1) * 32 + (swz % 64) / 2; }
__host__ __device__ __forceinline__ int perm32(int rho) { const int n = rho >> 4, i = rho & 15; return 8 * (i >> 2) + 4 * n + (i & 3); }

struct Unit { int pm, pn; };
struct Gemm { const bf16_t* A; const bf16_t* Bt; int M, N, K; };

struct StaticOrder {
    int nM, nN, nwg, G, c;
    __host__ __device__ void init(int M, int N, int G_, int c_) { nM = M / BM; nN = N / BM; nwg = nM * nN; G = G_; c = c_; }
    __host__ __device__ bool next(int i, Unit& u) const {
        const long L = (long)i * G + c; if (L >= nwg) return false;
        int wgid = (int)L; { const int q = nwg / NXCD, r = nwg % NXCD, xcd = wgid % NXCD, off = wgid / NXCD; wgid = (xcd < r ? xcd * (q + 1) : r * (q + 1) + (xcd - r) * q) + off; }
        const int nig = WGM * nN, gid = wgid / nig, fm = gid * WGM, gsz = (nM - fm) < WGM ? (nM - fm) : WGM;
        u.pm = fm + ((wgid % nig) % gsz); u.pn = (wgid % nig) / gsz; return true;
    }
    __device__ __forceinline__ void a_ready(const Unit&) const {}
    __device__ __forceinline__ void done(const Unit&) const {}
};
typedef __bf16 pg8_bf16x2 __attribute__((ext_vector_type(2)));
__device__ __forceinline__ unsigned cvt_pk_bf16(float lo, float hi) { const pg8_bf16x2 v = {(__bf16)lo, (__bf16)hi}; return __builtin_bit_cast(unsigned, v); }
typedef float f32x2 __attribute__((ext_vector_type(2)));
__device__ __forceinline__ f32x2 gelu_pk(f32x2 v) {
    const f32x2 av = __builtin_elementwise_abs(v), d = av * 0.2316418882f + 1.0f;
    f32x2 t; t.x = __builtin_amdgcn_rcpf(d.x); t.y = __builtin_amdgcn_rcpf(d.y);
    f32x2 q = t * 0.5307027145f + (-0.7265760135f); q = q * t + 0.7107068705f; q = q * t + (-0.142248368f); q = q * t + 0.127414796f; q = q * t;
    const f32x2 s = (v * v) * (-0.72134752044f);
    f32x2 e; e.x = __builtin_amdgcn_exp2f(s.x); e.y = __builtin_amdgcn_exp2f(s.y);
    const f32x2 m = v * (q * e), r = v - m;
    f32x2 o; o.x = v.x < 0.f ? m.x : r.x; o.y = v.y < 0.f ? m.y : r.y; return o;
}

struct EpiF32 {
    static constexpr bool PERM = false, AFTER_DRAIN = false;
    float* C; int ldc; const float* bias;
    __device__ __forceinline__ void operator()(const f32x4 (&acc)[2][2][4][2], const Unit& u, int wr, int wc, int fr, int fq) const {
        const int row0 = u.pm * BM + wr * 64 + fr, col0 = u.pn * BM + wc * 32 + 4 * fq;
        f32x4 bv[2][2];
#pragma unroll
        for (int bj = 0; bj < 2; ++bj)
#pragma unroll
            for (int n = 0; n < 2; ++n) bv[bj][n] = bias ? *(const f32x4*)(bias + col0 + bj * HALF + n * 16) : (f32x4){0.f, 0.f, 0.f, 0.f};
#pragma unroll
        for (int ai = 0; ai < 2; ++ai)
#pragma unroll
            for (int m = 0; m < 4; ++m) { float* rowp = C + (size_t)(row0 + ai * HALF + m * 16) * ldc + col0;
#pragma unroll
                for (int bj = 0; bj < 2; ++bj)
#pragma unroll
                    for (int n = 0; n < 2; ++n) *(f32x4*)(rowp + bj * HALF + n * 16) = acc[ai][bj][m][n] + bv[bj][n]; }
    }
};
template <int ACT  > struct EpiBf16 {
    static constexpr bool PERM = true, AFTER_DRAIN = false;
    bf16_t* O; int ldc; const float* bias; int split_cols; size_t split_stride;
    __device__ __forceinline__ void operator()(const f32x4 (&acc)[2][2][4][2], const Unit& u, int wr, int wc, int fr, int fq) const {
        const int row0 = u.pm * BM + wr * 64 + fr; int colt = u.pn * BM; bf16_t* base = O;
        if (split_cols) { const int t = colt / split_cols; base += (size_t)t * split_stride; colt -= t * split_cols; }
        const int col0 = colt + wc * 32 + 8 * fq, bcol0 = u.pn * BM + wc * 32 + 8 * fq;
        f32x4 bv[2][2];
#pragma unroll
        for (int bj = 0; bj < 2; ++bj)
#pragma unroll
            for (int n = 0; n < 2; ++n) bv[bj][n] = bias ? *(const f32x4*)(bias + bcol0 + bj * HALF + 4 * n) : (f32x4){0.f, 0.f, 0.f, 0.f};
#pragma unroll
        for (int ai = 0; ai < 2; ++ai)
#pragma unroll
            for (int m = 0; m < 4; ++m) { bf16_t* rowp = base + (size_t)(row0 + ai * HALF + m * 16) * ldc + col0;
#pragma unroll
                for (int bj = 0; bj < 2; ++bj) { f32x4 v0 = acc[ai][bj][m][0] + bv[bj][0], v1 = acc[ai][bj][m][1] + bv[bj][1];
                    if (ACT == 1) { f32x2 a = gelu_pk((f32x2){v0[0], v0[1]}), b = gelu_pk((f32x2){v0[2], v0[3]}), c = gelu_pk((f32x2){v1[0], v1[1]}), d = gelu_pk((f32x2){v1[2], v1[3]});
                        v0 = (f32x4){a.x, a.y, b.x, b.y}; v1 = (f32x4){c.x, c.y, d.x, d.y}; }
                    if (ACT == 2) {
#pragma unroll
                        for (int j = 0; j < 4; ++j) { v0[j] = 0.5f * v0[j] * (1.0f + erff(v0[j] * 0.70710678f)); v1[j] = 0.5f * v1[j] * (1.0f + erff(v1[j] * 0.70710678f)); } }
                    u32x4 w; w.x = cvt_pk_bf16(v0[0], v0[1]); w.y = cvt_pk_bf16(v0[2], v0[3]); w.z = cvt_pk_bf16(v1[0], v1[1]); w.w = cvt_pk_bf16(v1[2], v1[3]);
                    *(u32x4*)(rowp + bj * HALF) = w; } }
    }
};

typedef int i32x8 __attribute__((ext_vector_type(8)));
typedef short s16x16 __attribute__((ext_vector_type(16)));
__device__ __forceinline__ i32x8 pg8_cat16(bf16x8 a, bf16x8 b) { return __builtin_bit_cast(i32x8, (s16x16)__builtin_shufflevector(a, b, 0, 1, 2, 3, 4, 5, 6, 7, 8, 9, 10, 11, 12, 13, 14, 15)); }
template <class E, class = void> struct epi_seg { static constexpr bool value = false; };
template <class E> struct epi_seg<E, decltype((void)E::SEGMENTED)> { static constexpr bool value = E::SEGMENTED; };
template <class Epi, class Sched, bool STAMP = false, bool F8 = false, bool WIDE = false>
__device__ __forceinline__ void gemm_phase(PG8_LAS unsigned char* lds, const Gemm g, const Sched& S, const Epi& E, unsigned long long* stamps) {
    const int tid = mk_tid(), wid = __builtin_amdgcn_readfirstlane(tid >> 6), lane = tid & 63, wr = wid >> 2, wc = wid & 3, fr = lane & 15, fq = lane >> 4;
    const int K = g.K, nt = K / BK;
    int ts_lo = 0, ts_hi = 0, nts = 0; const unsigned long long rt_entry = STAMP ? (unsigned long long)wall_clock64() : 0ull;
#define PG8_STAMP() do { if (STAMP && wid == 0 && nts < 64) { const unsigned long long _c = (unsigned long long)clock64(); \
        ts_lo = (lane == nts) ? (int)(unsigned)_c : ts_lo; ts_hi = (lane == nts) ? (int)(unsigned)(_c >> 32) : ts_hi; ++nts; } } while (0)
    PG8_STAMP();
    unsigned voffA, voffB;
    { int R, C; stage_rc(tid * 16, R, C); const int Ri = Epi::PERM ? perm32(R & 31) : (R & 31); const int Rb = WIDE ? (((R >> 5) << 6) + Ri) : ((R & ~31) + Ri);
        voffA = (unsigned)(R * K + C) * 2u; voffB = (unsigned)(Rb * K + C) * 2u; }
    const size_t qstep = (size_t)64 * K * 2;
    const size_t qstepB = WIDE ? (size_t)128 * K * 2 : qstep;
    const size_t hstepB = WIDE ? (size_t)32 * K * 2 : (size_t)HALF * K * 2;
    const size_t kstep = (size_t)(BK * 2);
    const size_t hstep = (size_t)HALF * K * 2;
    const size_t tstep = 2 * hstep;
    const unsigned ldsw = (unsigned)wid * 1024u;
    const int aoff = lds_byte(wr * 64 + fr, fq * 8), boff = lds_byte(wc * 32 + fr, fq * 8);
#define PG8_SA(b, h) (((b) * 2 + (h)) * HTB)
#define PG8_SB(b, h) ((4 + (b) * 2 + (h)) * HTB)
#define PG8_STAGE(bufoff, gbase, voff) PG8_STAGEQ(bufoff, gbase, voff, qstep)
#define PG8_STAGEB(bufoff, gbase, voff) PG8_STAGEQ(bufoff, gbase, voff, qstepB)
#define PG8_STAGEQ(bufoff, gbase, voff, qs) do { const char* _g0 = (const char*)(gbase); const char* _g1 = _g0 + (qs); asm volatile("" : "+s"(_g0), "+s"(_g1));   \
        __builtin_amdgcn_global_load_lds((const unsigned*)(_g0 + (voff)), (PG8_LAS unsigned*)(lds + (bufoff) + ldsw), 16, 0, 0); \
        __builtin_amdgcn_global_load_lds((const unsigned*)(_g1 + (voff)), (PG8_LAS unsigned*)(lds + (bufoff) + ldsw + 8192), 16, 0, 0); } while (0)
#define PG8_LDA(dst, b, h) do { _Pragma("unroll") for (int m = 0; m < 4; ++m) _Pragma("unroll") for (int k = 0; k < 2; ++k) dst[m][k] = *(const PG8_LAS bf16x8*)(lds + PG8_SA(b, h) + aoff + m * 2048 + k * 1024); } while (0)
#define PG8_LDB(dst, b, h) do { _Pragma("unroll") for (int n = 0; n < 2; ++n) _Pragma("unroll") for (int k = 0; k < 2; ++k) dst[n][k] = *(const PG8_LAS bf16x8*)(lds + PG8_SB(b, h) + boff + n * 2048 + k * 1024); } while (0)
#define PG8_MMA(ai, bj, At, Bt) do { __builtin_amdgcn_s_setprio(1); _Pragma("unroll") for (int m = 0; m < 4; ++m) _Pragma("unroll") for (int n = 0; n < 2; ++n) { \
        if constexpr (F8) acc[ai][bj][m][n] = __builtin_amdgcn_mfma_scale_f32_16x16x128_f8f6f4(pg8_cat16(Bt[n][0], Bt[n][1]), pg8_cat16(At[m][0], At[m][1]), acc[ai][bj][m][n], 0, 0, 0, 0, 0, 0); \
        else { _Pragma("unroll") for (int k = 0; k < 2; ++k) acc[ai][bj][m][n] = __builtin_amdgcn_mfma_f32_16x16x32_bf16(Bt[n][k], At[m][k], acc[ai][bj][m][n], 0, 0, 0); } } \
        __builtin_amdgcn_s_setprio(0); } while (0)
#define PG8_WAIT_V(n) asm volatile("s_waitcnt vmcnt(" #n ")" ::: "memory")
#define PG8_WAIT_L(n) asm volatile("s_waitcnt lgkmcnt(" #n ")" ::: "memory")
#define PG8_BAR __builtin_amdgcn_s_barrier()
#define PG8_SCHED __builtin_amdgcn_sched_barrier(0)
    Unit cur, nxt; int ui = 0;
    if (!S.next(0, cur)) return;
    __builtin_amdgcn_s_waitcnt(0x0F70);
    f32x4 acc[2][2][4][2];
    bf16x8 At[4][2], B0[2][2], B1[2][2];
    const char* cA = (const char*)g.A + (size_t)cur.pm * tstep; const char* cB = (const char*)g.Bt + (size_t)cur.pn * tstep;
    S.a_ready(cur);
    PG8_STAGEB(PG8_SB(0, 0), cB, voffB); PG8_STAGE(PG8_SA(0, 0), cA, voffA); PG8_STAGEB(PG8_SB(0, 1), cB + hstepB, voffB); PG8_STAGE(PG8_SA(0, 1), cA + hstep, voffA);
    if (wr == 1) PG8_BAR;
    PG8_WAIT_V(4); PG8_BAR;
    PG8_STAGEB(PG8_SB(1, 0), cB + kstep, voffB); PG8_STAGE(PG8_SA(1, 0), cA + kstep, voffA); PG8_STAGEB(PG8_SB(1, 1), cB + hstepB + kstep, voffB);
    PG8_WAIT_V(6); PG8_BAR;
    PG8_STAMP();
#pragma unroll
    for (int a = 0; a < 2; ++a)
#pragma unroll
        for (int b = 0; b < 2; ++b)
#pragma unroll
            for (int m = 0; m < 4; ++m)
#pragma unroll
                for (int n = 0; n < 2; ++n) acc[a][b][m][n] = (f32x4){0.f, 0.f, 0.f, 0.f};
    for (;;) {
        const bool has_next = S.next(ui + 1, nxt);
        const char* nA = has_next ? (const char*)g.A + (size_t)nxt.pm * tstep : cA; const char* nB = has_next ? (const char*)g.Bt + (size_t)nxt.pn * tstep : cB;
        for (int t = 0; t < nt; t += 2) {
            const bool last = (t == nt - 2);
            const char* a1 = cA + (size_t)(t + 1) * kstep;
            const char* a2 = last ? nA : cA + (size_t)(t + 2) * kstep; const char* b2 = last ? nB : cB + (size_t)(t + 2) * kstep;
            const char* a3 = a2 + kstep; const char* b3 = b2 + kstep;
            if (last && has_next) S.a_ready(nxt);
            if constexpr (epi_seg<Epi>::value) { if (t == E.t1) E.rescale(acc, cur, 0); else if (t == E.t2) E.rescale(acc, cur, 1); }
            PG8_LDB(B0, 0, 0); PG8_SCHED; PG8_LDA(At, 0, 0); PG8_STAGE(PG8_SA(1, 1), a1 + hstep, voffA);
            PG8_WAIT_L(8); PG8_BAR; PG8_WAIT_L(0); PG8_MMA(0, 0, At, B0); PG8_BAR; PG8_SCHED;
            PG8_LDB(B1, 0, 1); PG8_STAGEB(PG8_SB(0, 0), b2, voffB);
            PG8_BAR; PG8_WAIT_L(0); PG8_MMA(0, 1, At, B1); PG8_BAR;
            PG8_LDA(At, 0, 1); PG8_STAGE(PG8_SA(0, 0), a2, voffA);
            PG8_BAR; PG8_WAIT_L(0); PG8_MMA(1, 0, At, B0); PG8_BAR; PG8_SCHED;
            PG8_STAGEB(PG8_SB(0, 1), b2 + hstepB, voffB);
            PG8_WAIT_V(6); PG8_BAR; PG8_MMA(1, 1, At, B1); PG8_BAR;
            PG8_LDB(B0, 1, 0); PG8_SCHED; PG8_LDA(At, 1, 0); PG8_STAGE(PG8_SA(0, 1), a2 + hstep, voffA);
            PG8_WAIT_L(8); PG8_BAR; PG8_WAIT_L(0); PG8_MMA(0, 0, At, B0); PG8_BAR; PG8_SCHED;
            PG8_LDB(B1, 1, 1); PG8_STAGEB(PG8_SB(1, 0), b3, voffB);
            PG8_BAR; PG8_WAIT_L(0); PG8_MMA(0, 1, At, B1); PG8_BAR;
            PG8_LDA(At, 1, 1); PG8_STAGE(PG8_SA(1, 0), a3, voffA);
            PG8_BAR; PG8_WAIT_L(0); PG8_MMA(1, 0, At, B0); PG8_BAR; PG8_SCHED;
            PG8_STAGEB(PG8_SB(1, 1), b3 + hstepB, voffB);
            PG8_WAIT_V(6); PG8_BAR; PG8_MMA(1, 1, At, B1); PG8_BAR;
        }
        PG8_STAMP();
        if constexpr (!Epi::AFTER_DRAIN) { E(acc, cur, wr, wc, fr, fq); S.done(cur); }
        PG8_STAMP();
        if (!has_next) break;
#pragma unroll
        for (int a = 0; a < 2; ++a)
#pragma unroll
            for (int b = 0; b < 2; ++b)
#pragma unroll
                for (int m = 0; m < 4; ++m)
#pragma unroll
                    for (int n = 0; n < 2; ++n) acc[a][b][m][n] = (f32x4){0.f, 0.f, 0.f, 0.f};
        cur = nxt; cA = nA; cB = nB; ++ui;
    }
    PG8_WAIT_V(0);
    if (wr == 0) PG8_BAR;
    PG8_BAR;
    if constexpr (Epi::AFTER_DRAIN) { E.fused(acc, cur, wr, wc, fr, fq, lds, wid, lane); S.done(cur); }
    PG8_STAMP();
    if (STAMP && wid == 0) { stamps[lane] = lane < nts ? (((unsigned long long)(unsigned)ts_hi << 32) | (unsigned)ts_lo) : 0ull;
        if (lane == 62) stamps[62] = rt_entry; if (lane == 63) stamps[63] = (unsigned long long)wall_clock64(); }
#undef PG8_STAMP
#undef PG8_SA
#undef PG8_SB
#undef PG8_STAGE
#undef PG8_STAGEB
#undef PG8_STAGEQ
#undef PG8_LDA
#undef PG8_LDB
#undef PG8_MMA
#undef PG8_WAIT_V
#undef PG8_WAIT_L
#undef PG8_BAR
#undef PG8_SCHED
}
}
#define XB_TMO      128
#define XB_XCNT(j)  (256  + 64 * (j))
#define XB_XSUB(j)  (1280 + 64 * (j))
#define XB_XGEN(j)  (2304 + 64 * (j))
#define XB_TOP      3328
#define XB_TOPGEN   3392
#define XCD_BAR_WORDS 3456
#define XB_SPIN_CAP (1u << 18)
#define LAS __attribute__((address_space(3)))

__device__ __forceinline__ unsigned xb_ld(unsigned* p)              { return __hip_atomic_load(p, __ATOMIC_RELAXED, __HIP_MEMORY_SCOPE_AGENT); }
__device__ __forceinline__ unsigned xb_add(unsigned* p, unsigned v) { return __hip_atomic_fetch_add(p, v, __ATOMIC_RELAXED, __HIP_MEMORY_SCOPE_AGENT); }
__device__ __forceinline__ unsigned xb_xcc_id() { return (unsigned)__builtin_amdgcn_s_getreg((3 << 11) | 20) & 0xFu; }
#define XB_SPIN(cond, bar) do { unsigned _sp = 0; while (cond) { __builtin_amdgcn_s_sleep(1); \
    if ((++_sp & 255u) == 0u) { if (xb_ld(&(bar)[XB_TMO])) break; if (_sp > XB_SPIN_CAP) { atomicAdd(&(bar)[XB_TMO], 1u); break; } } } } while (0)

struct XcdBarrier {
    unsigned* bar; unsigned x;
    volatile LAS unsigned* st;
};

__device__ __forceinline__ XcdBarrier xcd_barrier_post(unsigned* bar, volatile LAS unsigned* st) {
    XcdBarrier b; b.bar = bar; b.x = xb_xcc_id(); b.st = st;
    if (threadIdx.x == 0) (void)xb_add(&bar[XB_XCNT(b.x)], 1u);
    return b;
}
__device__ __forceinline__ void xcd_barrier_complete(unsigned* bar, unsigned x, unsigned& nloc, unsigned& nx) {
    const unsigned G = gridDim.x * gridDim.y * gridDim.z;
    unsigned sum, cnt, mine, sp = 0u;
    for (;;) {
        sum = 0u; cnt = 0u; mine = 0u;
#pragma unroll
        for (unsigned j = 0; j < 16; ++j) { const unsigned c = xb_ld(&bar[XB_XCNT(j)]); sum += c; cnt += (c > 0u) ? 1u : 0u; mine = (j == x) ? c : mine; }
        if (sum == G) break;
        __builtin_amdgcn_s_sleep(1);
        if ((++sp & 255u) == 0u) { if (xb_ld(&bar[XB_TMO])) break; if (sp > XB_SPIN_CAP) { atomicAdd(&bar[XB_TMO], 1u); break; } }
    }
    nloc = mine > 0u ? mine : 1u; nx = cnt > 0u ? cnt : 1u;
}

__device__ __forceinline__ void xcd_barrier(const XcdBarrier& b) {
    asm volatile("s_waitcnt vmcnt(0)" ::: "memory");
    __syncthreads();
    if (threadIdx.x == 0) {
        unsigned* bar = b.bar;
        __builtin_amdgcn_s_waitcnt(0);
        unsigned nloc = b.st[0], nx = b.st[1];
        if (nloc == 0u) { xcd_barrier_complete(bar, b.x, nloc, nx); b.st[0] = nloc; b.st[1] = nx; }
        const unsigned old = xb_add(&bar[XB_XSUB(b.x)], 1u);
        const unsigned gen = old / nloc;
        if (old + 1u == (gen + 1u) * nloc) {
            __builtin_amdgcn_fence(__ATOMIC_RELEASE, "agent");
            asm volatile("s_waitcnt vmcnt(0)" ::: "memory");
            const unsigned og = xb_add(&bar[XB_TOP], 1u);
            const unsigned tg = og / nx;
            if (og + 1u == (tg + 1u) * nx) xb_add(&bar[XB_TOPGEN], 1u);
            else XB_SPIN(xb_ld(&bar[XB_TOPGEN]) == tg, bar);
            __builtin_amdgcn_fence(__ATOMIC_ACQUIRE, "agent");
            xb_add(&bar[XB_XGEN(b.x)], 1u);
            asm volatile("s_waitcnt vmcnt(0)" ::: "memory");
        } else {
            XB_SPIN(xb_ld(&bar[XB_XGEN(b.x)]) == gen, bar);
            __builtin_amdgcn_fence(__ATOMIC_ACQUIRE, "agent");
            asm volatile("s_waitcnt vmcnt(0)" ::: "memory");
        }
    }
    __syncthreads();
}

namespace mk {
using pg8::bf16_t; using pg8::bf16x8; using pg8::f32x4; using pg8::u32x4;
typedef short s16x4 __attribute__((ext_vector_type(4)));
typedef unsigned u32x2 __attribute__((ext_vector_type(2)));
typedef __bf16 bf16x2v __attribute__((ext_vector_type(2)));
typedef int i32x4 __attribute__((ext_vector_type(4)));
#define DI __device__ __forceinline__

constexpr int D = 1024, SEQ = 4096, NTOK = 16384, DEPTH = 4, DIN = 13824;
constexpr int OFF_AQ = 0, OFF_AK = 1536, OFF_AV = 3072, OFF_LX = 4608, OFF_LG = 5632, OFF_RQ = 6656, OFF_RK = 7680, OFF_RV = 8704, OFF_RG = 9728, OFF_GA = 10752;
constexpr float ALPHA = 1.681792830507429f;
constexpr float LN_EPS = 1e-5f;
constexpr float X8_SCALE = 32.0f, W8_SCALE = 2048.0f, F8_MAX = 440.0f;
constexpr int NPH = 12;
constexpr int LDS_BYTES = 148 * 1024;
constexpr int LDS_BAR_OFF = LDS_BYTES - 16;

constexpr size_t WS_CTL  = 0;
constexpr size_t WS_COSA = 16384;
constexpr size_t WS_SINA = WS_COSA + (size_t)4096 * 64 * 4;
constexpr size_t WS_COSR = WS_SINA + (size_t)4096 * 64 * 4;
constexpr size_t WS_SINR = WS_COSR + (size_t)4096 * 128 * 4;
constexpr size_t WS_CCH  = WS_SINR + (size_t)4096 * 128 * 4;
constexpr size_t WS_WAT  = WS_CCH + 4096;
constexpr size_t WS_WXT  = WS_WAT + 131072;
constexpr size_t WS_LSTA = WS_WXT + 131072;
constexpr size_t WS_LSTH = WS_LSTA + 524288;
constexpr size_t WS_K1B  = WS_LSTH + 524288;
constexpr size_t WS_K2B  = WS_K1B + 262144;
constexpr size_t WS_XF   = WS_K2B + 262144;
constexpr size_t WS_XB   = WS_XF + (size_t)NTOK * D * 4;
constexpr size_t WS_WINT = WS_XB + (size_t)NTOK * D * 2;
constexpr size_t WS_WSC  = WS_WINT + (size_t)DIN * 1024;
constexpr size_t WS_X8   = WS_WSC + (size_t)DIN * 4 + 256 - ((size_t)DIN * 4) % 256;
constexpr size_t WS_XS   = WS_X8 + (size_t)NTOK * 1024;
constexpr size_t WS_WBAT = WS_XS + (size_t)NTOK * 4;
constexpr size_t WS_WBBT = WS_WBAT + (size_t)1024 * 512 * 2;
constexpr size_t WS_WBCT = WS_WBBT + (size_t)1024 * 1024 * 2;
constexpr size_t WS_WOT  = WS_WBCT + (size_t)1024 * 1024 * 2;
constexpr size_t WS_WQT  = WS_WOT + (size_t)1024 * 1024 * 2;
constexpr size_t WS_UV8  = WS_WQT + (size_t)2048 * 1024 * 2;
constexpr size_t WS_UVS  = WS_UV8 + (size_t)16384 * 2048;
constexpr size_t WS_PROJ = WS_UVS + (size_t)16384 * 8;
constexpr size_t WS_OATT = WS_PROJ + (size_t)NTOK * DIN * 2;
constexpr size_t WS_LSE  = WS_OATT + (size_t)NTOK * 1536 * 2;
constexpr size_t WS_KVB  = WS_LSE + (size_t)NTOK * 12 * 4;
constexpr int YLD = 2560;
constexpr size_t WS_YA   = WS_KVB + (size_t)16 * 32 * 65536 * 2;
constexpr size_t WS_YB   = WS_YA + (size_t)NTOK * 512 * 2;
constexpr size_t WS_YC   = WS_YB + (size_t)NTOK * 1024 * 2;
constexpr size_t WS_MRGF = WS_YC + (size_t)NTOK * 1024 * 2;
constexpr size_t WS_MRGB = WS_MRGF + (size_t)NTOK * 1024 * 4;
constexpr size_t WS_END  = WS_MRGB + (size_t)NTOK * 1024 * 2;
constexpr size_t WS_Q    = WS_PROJ;
constexpr size_t WS_EID  = WS_PROJ + (size_t)NTOK * 2048 * 2;
constexpr size_t WS_GATE = WS_EID + (size_t)NTOK * 128 * 4;
static_assert(WS_END <= (size_t)1073741824, "workspace too large");
static_assert(WS_PROJ % 256 == 0 && WS_KVB % 256 == 0 && WS_MRGF % 256 == 0, "alignment");

struct Args { const float* in[20]; float* out; unsigned char* ws; double ropeA, ropeR; int ph_lo, ph_hi; };

DI size_t pjo(size_t row, int col) { return ((size_t)(col >> 8) * NTOK + row) * 256 + (size_t)(col & 255); }
DI float bflo(unsigned w) { return __uint_as_float(w << 16); }
DI float bfhi(unsigned w) { return __uint_as_float(w & 0xffff0000u); }
DI float bf2f(bf16_t v) { return __uint_as_float(((unsigned)v) << 16); }
DI unsigned pk2(float lo, float hi) { return pg8::cvt_pk_bf16(lo, hi); }
DI bf16_t f2bf(float f) { return (bf16_t)(pk2(f, 0.f) & 0xffffu); }
DI f32x4 mfma16(bf16x8 a, bf16x8 b, f32x4 c) { return __builtin_amdgcn_mfma_f32_16x16x32_bf16(a, b, c, 0, 0, 0); }
DI s16x4 trrd(LAS unsigned char* p) { return __builtin_amdgcn_ds_read_tr16_b64_v4i16((LAS s16x4*)p); }
DI bf16x8 cat8(s16x4 lo, s16x4 hi) { return __builtin_shufflevector(lo, hi, 0, 1, 2, 3, 4, 5, 6, 7); }
DI float wsum(float v) { v += __shfl_xor(v, 32); v += __shfl_xor(v, 16); v += __shfl_xor(v, 8); v += __shfl_xor(v, 4); v += __shfl_xor(v, 2); v += __shfl_xor(v, 1); return v; }
DI float sigm(float x) { return __builtin_amdgcn_rcpf(1.f + __builtin_amdgcn_exp2f(x * -1.4426950408889634f)); }
DI float gelu_erf(float x) { return 0.5f * x * (1.f + erff(x * 0.70710678118654752f)); }
DI float dot2(unsigned w, unsigned x, float acc) { return __builtin_amdgcn_fdot2_f32_bf16(__builtin_bit_cast(bf16x2v, w), __builtin_bit_cast(bf16x2v, x), acc, false); }
DI float log2gamma(int h) { return log2f(1.0f - exp2f(-5.0f - (float)h)); }

#define MK_DPP_ADD(v, ctrl, rmask) v += __int_as_float(__builtin_amdgcn_update_dpp(0, __float_as_int(v), (ctrl), (rmask), 0xf, false))
DI float wsum_dpp(float v) {
    MK_DPP_ADD(v, 0xB1, 0xf); MK_DPP_ADD(v, 0x4E, 0xf); MK_DPP_ADD(v, 0x141, 0xf); MK_DPP_ADD(v, 0x140, 0xf);
    MK_DPP_ADD(v, 0x142, 0xa); MK_DPP_ADD(v, 0x143, 0xc);
    return __int_as_float(__builtin_amdgcn_readlane(__float_as_int(v), 63));
}
DI float gelu_as(float v) {
    const float av = fabsf(v), t = __builtin_amdgcn_rcpf(av * 0.2316418882f + 1.0f);
    float q = t * 0.5307027145f + (-0.7265760135f); q = q * t + 0.7107068705f; q = q * t + (-0.142248368f); q = q * t + 0.127414796f; q = q * t;
    const float e = __builtin_amdgcn_exp2f(v * v * (-0.72134752044f));
    const float m = v * (q * e);
    return v < 0.f ? m : v - m;
}
DI int wperm(int n) {
    if (n < 3072) { const int j = n & 127, bj = j >> 6, jj = j & 63; return (n & ~127) + 64 * (jj >> 5) + 32 * bj + (jj & 31); }
    if (n >= OFF_RQ && n < OFF_RV) { const int j = n & 255, bj = j >> 7, jj = j & 127; return (n & ~255) + 64 * (jj >> 5) + 32 * bj + (jj & 31); }
    return n;
}
template <bool WPERM>
DI void tconv_tile(const float* src, int ldsrc, bf16_t* dst, int lddst, int k0, int n0, LAS float* t, float mul = 1.0f) {
    const int tid = mk_tid();
#pragma unroll
    for (int i = 0; i < 8; ++i) { const int idx = tid + 512 * i, r = idx >> 6, c = idx & 63; t[r * 65 + c] = src[(size_t)(k0 + r) * ldsrc + n0 + c]; }
    __syncthreads();
#pragma unroll
    for (int i = 0; i < 8; ++i) { const int idx = tid + 512 * i, n = idx >> 6, k = idx & 63; const int nr = WPERM ? wperm(n0 + n) : (n0 + n); dst[(size_t)nr * lddst + k0 + k] = f2bf(t[k * 65 + n] * mul); }
    __syncthreads();
}
DI void conv_unit(const float* src, bf16_t* dst, int unit) {
    const size_t i = (size_t)unit * 4096 + (size_t)mk_tid() * 8;
    const f32x4 a = *(const f32x4*)(src + i), b = *(const f32x4*)(src + i + 4);
    u32x4 o; o.x = pk2(a[0], a[1]); o.y = pk2(a[2], a[3]); o.z = pk2(b[0], b[1]); o.w = pk2(b[2], b[3]);
    *(u32x4*)(dst + i) = o;
}
DI void w8_unit(const float* src, unsigned char* ws, int unit, LAS float* t) {
    const int tid = mk_tid(), n0 = unit * 64;
    unsigned char* dst = ws + WS_WINT;
#pragma unroll 1
    for (int k0 = 0; k0 < 1024; k0 += 64) {
#pragma unroll
        for (int i = 0; i < 8; ++i) { const int idx = tid + 512 * i, r = idx >> 6, cc = idx & 63; t[r * 65 + cc] = fminf(fmaxf(src[(size_t)(k0 + r) * DIN + n0 + cc] * W8_SCALE, -F8_MAX), F8_MAX); }
        __syncthreads();
#pragma unroll
        for (int i = 0; i < 2; ++i) { const int idx = tid + 512 * i, n = idx >> 4, k4 = idx & 15;
            int wd = __builtin_amdgcn_cvt_pk_fp8_f32(t[(4 * k4) * 65 + n], t[(4 * k4 + 1) * 65 + n], 0, false);
            wd = __builtin_amdgcn_cvt_pk_fp8_f32(t[(4 * k4 + 2) * 65 + n], t[(4 * k4 + 3) * 65 + n], wd, true);
            *(int*)(dst + (size_t)wperm(n0 + n) * 1024 + k0 + 4 * k4) = wd; }
        __syncthreads();
    }
}
DI void row_to_fp8(const f32x4 (&o)[4], unsigned char* x8row, int ln) {
    u32x4 w;
#pragma unroll
    for (int q = 0; q < 4; ++q) {
        const float a0 = fminf(fmaxf(o[q][0] * X8_SCALE, -F8_MAX), F8_MAX), a1 = fminf(fmaxf(o[q][1] * X8_SCALE, -F8_MAX), F8_MAX), a2 = fminf(fmaxf(o[q][2] * X8_SCALE, -F8_MAX), F8_MAX), a3 = fminf(fmaxf(o[q][3] * X8_SCALE, -F8_MAX), F8_MAX);
        int wd = __builtin_amdgcn_cvt_pk_fp8_f32(a0, a1, 0, false); wd = __builtin_amdgcn_cvt_pk_fp8_f32(a2, a3, wd, true); w[q] = (unsigned)wd; }
    *(u32x4*)(x8row + 16 * ln) = w;
}
typedef float f32x16 __attribute__((ext_vector_type(16)));
constexpr unsigned UVREC = 1024;
DI float wmax(float m) { m = fmaxf(m, __shfl_xor(m, 32)); m = fmaxf(m, __shfl_xor(m, 16)); m = fmaxf(m, __shfl_xor(m, 8)); m = fmaxf(m, __shfl_xor(m, 4)); m = fmaxf(m, __shfl_xor(m, 2)); m = fmaxf(m, __shfl_xor(m, 1)); return m; }
DI void conv_fp6_rows(const float* usrc, const float* vsrc, unsigned char* ws, int unit) {
    const int tid = mk_tid(), lane = tid & 63, w = tid >> 6;
    const size_t row = (size_t)unit * 8 + w;
    const float* up = usrc + row * 1024 + 16 * lane; const float* vp = vsrc + row * 1024 + 16 * lane;
    f32x16 a, b; float mu = 0.f, mv = 0.f;
#pragma unroll
    for (int q = 0; q < 4; ++q) { const f32x4 x = *(const f32x4*)(up + 4 * q), y = *(const f32x4*)(vp + 4 * q);
#pragma unroll
        for (int j = 0; j < 4; ++j) { a[4 * q + j] = x[j]; b[4 * q + j] = y[j]; mu = fmaxf(mu, fabsf(x[j])); mv = fmaxf(mv, fabsf(y[j])); } }
    mu = wmax(mu); mv = wmax(mv);
    const float su = (mu > 0.f) ? 6.0f / mu : 1.0f, sv = (mv > 0.f) ? 6.0f / mv : 1.0f;
    unsigned u0 = 0u, u1 = 0u, v0 = 0u, v1 = 0u;
#define MK_PK4(i) u0 = __builtin_amdgcn_cvt_scalef32_pk_fp4_f32(u0, a[2 * i] * su, a[2 * i + 1] * su, 1.0f, i); u1 = __builtin_amdgcn_cvt_scalef32_pk_fp4_f32(u1, a[8 + 2 * i] * su, a[8 + 2 * i + 1] * su, 1.0f, i); \
                  v0 = __builtin_amdgcn_cvt_scalef32_pk_fp4_f32(v0, b[2 * i] * sv, b[2 * i + 1] * sv, 1.0f, i); v1 = __builtin_amdgcn_cvt_scalef32_pk_fp4_f32(v1, b[8 + 2 * i] * sv, b[8 + 2 * i + 1] * sv, 1.0f, i);
    MK_PK4(0) MK_PK4(1) MK_PK4(2) MK_PK4(3)
#undef MK_PK4
    unsigned char* rec = ws + WS_UV8 + row * UVREC;
    *(u32x4*)(rec + 16 * lane) = (u32x4){u0, u1, v0, v1};
    if (lane == 0) { float* sp = (float*)(ws + WS_UVS) + row * 2; sp[0] = (mu > 0.f) ? mu * (1.0f / 6.0f) : 1.0f; sp[1] = (mv > 0.f) ? mv * (1.0f / 6.0f) : 1.0f; }
}
DI void phase_conv(const Args& a, int layer, LAS unsigned char* lds) {
    unsigned char* ws = a.ws;
    LAS float* t = (LAS float*)lds;
    const int J0 = 216, J1 = J0 + 128, J2 = J1 + 256, J3 = J2 + 256, J4 = J3 + 256, J5 = J4 + 512, J6 = J5 + 32, J7 = J6 + 2048, J8 = J7, J9 = J8 + 64, J10 = J9 + 1;
    const int total = J10;
    for (int u = blockIdx.x; u < total; u += gridDim.x) {
        if (u < J0) { w8_unit(a.in[1] + (size_t)layer * 1024 * DIN, ws, u, t); }
        else if (u < J1) { const int v = u - J0, kt = v / 16, nt = v % 16; tconv_tile<false>(a.in[9] + (size_t)layer * 2560 * 1024, 1024, (bf16_t*)(ws + WS_WBAT), YLD, kt * 64, nt * 64, t); }
        else if (u < J2) { const int v = u - J1, kt = v / 16, nt = v % 16; tconv_tile<false>(a.in[9] + (size_t)layer * 2560 * 1024 + (size_t)512 * 1024, 1024, (bf16_t*)(ws + WS_WBAT) + 512, YLD, kt * 64, nt * 64, t); }
        else if (u < J3) { const int v = u - J2, kt = v / 16, nt = v % 16; tconv_tile<false>(a.in[9] + (size_t)layer * 2560 * 1024 + (size_t)1536 * 1024, 1024, (bf16_t*)(ws + WS_WBAT) + 1536, YLD, kt * 64, nt * 64, t); }
        else if (u < J4) { const int v = u - J3, kt = v / 16, nt = v % 16; tconv_tile<false>(a.in[10] + (size_t)layer * 1024 * 1024, 1024, (bf16_t*)(ws + WS_WOT), 1024, kt * 64, nt * 64, t); }
        else if (u < J5) { const int v = u - J4, kt = v / 32, nt = v % 32; tconv_tile<false>(a.in[13] + (size_t)layer * 1024 * 2048, 2048, (bf16_t*)(ws + WS_WQT), 1024, kt * 64, nt * 64, t); }
        else if (u < J6) { const int v = u - J5, blk = v & 15, which = v >> 4;
            tconv_tile<false>(a.in[which ? 6 : 4] + ((size_t)layer * 16 + blk) * 4096, 64, (bf16_t*)(ws + (which ? WS_WXT : WS_WAT)) + blk * 4096, 64, 0, 0, t, -1.4426950408889634f); }
        else if (u < J7) { conv_fp6_rows(a.in[16] + (size_t)layer * 16384 * 1024, a.in[17] + (size_t)layer * 16384 * 1024, ws, u - J6); }
        else if (u < J9) { const int v = u - J8; if (v < 32) conv_unit(a.in[14] + (size_t)layer * 131072, (bf16_t*)(ws + WS_K1B), v); else conv_unit(a.in[15] + (size_t)layer * 131072, (bf16_t*)(ws + WS_K2B), v - 32); }
        else { for (int c = mk_tid(); c < 1024; c += 512) { const float lam = a.in[8][layer * 1024 + c]; const float e = __builtin_amdgcn_exp2f(-lam * 1.4426950408889634f); const float sp = (e < 0.05f) ? e * (1.0f + e * (-0.5f + e * (0.33333333f + e * -0.25f))) : __builtin_amdgcn_logf(1.0f + e) * 0.6931471805599453f; ((float*)(ws + WS_CCH))[c] = -8.0f * sp; } }
    }
}

DI void phase_prologue(const Args& a) {
    unsigned char* ws = a.ws;
    const int tid = mk_tid();
    for (int u = blockIdx.x; u < 2048; u += gridDim.x) {
        { const int ln = tid & 63; const size_t row = (size_t)u * 8 + (tid >> 6);
            const float* xp = a.in[0] + row * 1024 + 16 * ln; float* xo = (float*)(ws + WS_XF) + row * 1024 + 16 * ln;
            f32x4 o[4];
#pragma unroll
            for (int q = 0; q < 4; ++q) { o[q] = *(const f32x4*)(xp + 4 * q); *(f32x4*)(xo + 4 * q) = o[q]; }
            row_to_fp8(o, ws + WS_X8 + row * 1024, ln); }
    }
}

DI void attn_unit(const Args& a, int unit, LAS unsigned char* lds) {
    unsigned char* ws = a.ws;
    const int tid = mk_tid(), lane = tid & 63, w = __builtin_amdgcn_readfirstlane(tid >> 6), g = lane >> 4, l15 = lane & 15, tq4 = l15 >> 2, tp4 = l15 & 3;
    const int b = unit / 384, rem = unit % 384, h = rem >> 5, bi = rem & 31;
    const int grp = h >> 2, d = (grp == 0) ? 1 : ((grp == 1) ? 4 : 16), nb = 32 / d, r = bi / nb, n = bi % nb;
    const bf16_t* proj = (const bf16_t*)(ws + WS_PROJ); const size_t brow = (size_t)b * SEQ;
    LAS unsigned char* Ks = lds; LAS unsigned char* Vs = lds + 256 * 288;
#pragma unroll
    for (int i = 0; i < 8; ++i) {
        const int idx = tid + 512 * i, row = idx >> 4, ch = idx & 15, m = 128 * (n - 1) + row;
        u32x4 kv = {0u, 0u, 0u, 0u}, vv = {0u, 0u, 0u, 0u};
        if (m >= 0) { const size_t gr = brow + (size_t)(m * d + r); kv = *(const u32x4*)(proj + pjo(gr, OFF_AK + h * 128 + ch * 8)); vv = *(const u32x4*)(proj + pjo(gr, OFF_AV + h * 128 + ch * 8)); }
        *(LAS u32x4*)(Ks + row * 288 + ch * 16) = kv; *(LAS u32x4*)(Vs + row * 288 + ch * 16) = vv;
    }
    const int qi = 16 * w + l15;
    const size_t tq = (size_t)(128 * n + qi) * d + r;
    bf16x8 qf[4];
#pragma unroll
    for (int ks = 0; ks < 4; ++ks) qf[ks] = *(const bf16x8*)(proj + pjo(brow + tq, OFF_AQ + h * 128 + 32 * ks + 8 * g));
    __syncthreads();
    const int s0 = w >> 1;
    f32x4 sacc[10];
#pragma unroll
    for (int jj = 0; jj < 10; ++jj) {
        f32x4 acc = {0.f, 0.f, 0.f, 0.f};
#pragma unroll
        for (int ks = 0; ks < 4; ++ks) { const bf16x8 kf = *(const LAS bf16x8*)(Ks + (32 * s0 + 16 * jj + l15) * 288 + (32 * ks + 8 * g) * 2); acc = mfma16(kf, qf[ks], acc); }
        sacc[jj] = acc;
    }
    const float scale = 0.08838834764831845f * 1.4426950408889634f;
    float mx = -1e30f;
#pragma unroll
    for (int jj = 0; jj < 10; ++jj)
#pragma unroll
        for (int rg = 0; rg < 4; ++rg) {
            const int j = 32 * s0 + 16 * jj + 4 * g + rg;
            const bool valid = (j >= qi) && (j <= qi + 128) && (n > 0 || j >= 128);
            const float s = valid ? sacc[jj][rg] * scale : -1e30f;
            sacc[jj][rg] = s; mx = fmaxf(mx, s);
        }
    mx = fmaxf(mx, __shfl_xor(mx, 16)); mx = fmaxf(mx, __shfl_xor(mx, 32));
    float sum = 0.f;
#pragma unroll
    for (int jj = 0; jj < 10; ++jj)
#pragma unroll
        for (int rg = 0; rg < 4; ++rg) { const float p = __builtin_amdgcn_exp2f(sacc[jj][rg] - mx); sacc[jj][rg] = p; sum += p; }
    sum += __shfl_xor(sum, 16); sum += __shfl_xor(sum, 32);
    f32x4 oacc[8];
#pragma unroll
    for (int db = 0; db < 8; ++db) oacc[db] = (f32x4){0.f, 0.f, 0.f, 0.f};
#pragma unroll
    for (int s = 0; s < 5; ++s) {
        u32x4 pw; pw.x = pk2(sacc[2 * s][0], sacc[2 * s][1]); pw.y = pk2(sacc[2 * s][2], sacc[2 * s][3]); pw.z = pk2(sacc[2 * s + 1][0], sacc[2 * s + 1][1]); pw.w = pk2(sacc[2 * s + 1][2], sacc[2 * s + 1][3]);
        const bf16x8 pb = __builtin_bit_cast(bf16x8, pw);
        const int k0 = 32 * (s0 + s) + 4 * g + tq4;
#pragma unroll
        for (int db = 0; db < 8; ++db) {
            const s16x4 lo = trrd(Vs + k0 * 288 + (16 * db + 4 * tp4) * 2), hi = trrd(Vs + (k0 + 16) * 288 + (16 * db + 4 * tp4) * 2);
            oacc[db] = mfma16(cat8(lo, hi), pb, oacc[db]);
        }
    }
    const float inv = 1.0f / sum;
    bf16_t* op = (bf16_t*)(ws + WS_OATT) + ((size_t)b * SEQ + tq) * 1536 + h * 128 + 4 * g;
#pragma unroll
    for (int db = 0; db < 8; ++db) { u32x2 o; o.x = pk2(oacc[db][0] * inv, oacc[db][1] * inv); o.y = pk2(oacc[db][2] * inv, oacc[db][3] * inv); *(u32x2*)(op + 16 * db) = o; }
    if (g == 0) ((float*)(ws + WS_LSE))[((size_t)b * SEQ + tq) * 12 + h] = mx + __builtin_amdgcn_logf(sum);
    __syncthreads();
}

DI void retkv_unit(const Args& a, int unit, LAS unsigned char* lds) {
    unsigned char* ws = a.ws;
    const int tid = mk_tid(), lane = tid & 63, w = __builtin_amdgcn_readfirstlane(tid >> 6), g = lane >> 4, l15 = lane & 15, tq4 = l15 >> 2, tp4 = l15 & 3;
    const int b = unit >> 7, h = (unit >> 5) & 3, c = unit & 31;
    const bf16_t* proj = (const bf16_t*)(ws + WS_PROJ); const size_t brow = (size_t)b * SEQ + c * 128;
    LAS unsigned char* Ks = lds; LAS unsigned char* Vs = lds + 128 * 544;
    const float l2g = log2gamma(h);
#pragma unroll
    for (int i = 0; i < 8; ++i) {
        const int idx = tid + 512 * i, row = idx >> 5, ch = idx & 31;
        const u32x4 kv = *(const u32x4*)(proj + pjo(brow + row, OFF_RK + h * 256 + ch * 8)), vv = *(const u32x4*)(proj + pjo(brow + row, OFF_RV + h * 256 + ch * 8));
        const float z = exp2f((float)(127 - row) * l2g);
        u32x4 kz;
#pragma unroll
        for (int q = 0; q < 4; ++q) kz[q] = pk2(bflo(kv[q]) * z, bfhi(kv[q]) * z);
        *(LAS u32x4*)(Ks + row * 544 + ch * 16) = kz; *(LAS u32x4*)(Vs + row * 544 + ch * 16) = vv;
    }
    __syncthreads();
#pragma unroll 1
    for (int nh = 0; nh < 2; ++nh) {
        f32x4 acc[2][8];
#pragma unroll
        for (int mb = 0; mb < 2; ++mb)
#pragma unroll
            for (int nb = 0; nb < 8; ++nb) acc[mb][nb] = (f32x4){0.f, 0.f, 0.f, 0.f};
#pragma unroll
        for (int ks = 0; ks < 4; ++ks) {
            const int j0 = 32 * ks + 4 * g + tq4;
            bf16x8 af[2];
#pragma unroll
            for (int mb = 0; mb < 2; ++mb) { const int col = 32 * w + 16 * mb + 4 * tp4; af[mb] = cat8(trrd(Vs + j0 * 544 + col * 2), trrd(Vs + (j0 + 16) * 544 + col * 2)); }
#pragma unroll
            for (int nb = 0; nb < 8; ++nb) {
                const int col = 128 * nh + 16 * nb + 4 * tp4;
                const bf16x8 bfr = cat8(trrd(Ks + j0 * 544 + col * 2), trrd(Ks + (j0 + 16) * 544 + col * 2));
#pragma unroll
                for (int mb = 0; mb < 2; ++mb) acc[mb][nb] = mfma16(af[mb], bfr, acc[mb][nb]);
            }
        }
        bf16_t* kvb = (bf16_t*)(ws + WS_KVB) + ((size_t)((b * 4 + h) * 32 + c)) * 65536 + 128 * nh;
#pragma unroll
        for (int mb = 0; mb < 2; ++mb)
#pragma unroll
            for (int nb = 0; nb < 8; ++nb)
#pragma unroll
                for (int rg = 0; rg < 4; ++rg) kvb[(size_t)(32 * w + 16 * mb + 4 * g + rg) * 256 + 16 * nb + l15] = f2bf(acc[mb][nb][rg]);
    }
    __syncthreads();
}

DI void lru_stripe(const Args& a, int layer, int stripe, LAS unsigned char* lds) {
    unsigned char* ws = a.ws;
    const int tid = mk_tid(), lane = tid & 63, w = __builtin_amdgcn_readfirstlane(tid >> 6), g = lane >> 4, l15 = lane & 15;
    const int b = stripe >> 4, blk = stripe & 15;
    LAS bf16_t* lxs = (LAS bf16_t*)lds;
    LAS bf16_t* lgs0 = (LAS bf16_t*)(lds + 16896);
    LAS unsigned char* xcb = lds + 49664;
    LAS float* rgt = (LAS float*)(lds + 68096);
    LAS float* igt = (LAS float*)(lds + 100864);
    LAS float* wst = (LAS float*)(lds + 133632);
    const bf16_t* proj = (const bf16_t*)(ws + WS_PROJ); const size_t brow = (size_t)b * SEQ;
    const int gc = blk * 64 + lane;
    const float* cw = a.in[2] + (size_t)layer * 4096;
    const int cch_ = tid & 63, cgc = blk * 64 + cch_;
    const float cw0 = cw[cgc], cw1 = cw[1024 + cgc], cw2 = cw[2048 + cgc], cw3 = cw[3072 + cgc], cb = a.in[3][layer * 1024 + cgc];
    const float cc = ((const float*)(ws + WS_CCH))[gc] * 1.4426950408889634f;
    float bia[4], bix[4];
    LAS unsigned char* wlds = lds + 137728;
    { const int r = tid >> 3, c8 = tid & 7; *(LAS u32x4*)(wlds + r * 144 + c8 * 16) = *(const u32x4*)((const bf16_t*)(ws + WS_WAT) + blk * 4096 + r * 64 + c8 * 8); }
    bf16x8 wfx[4][2];
#pragma unroll
    for (int nb = 0; nb < 4; ++nb)
#pragma unroll
        for (int ks = 0; ks < 2; ++ks) wfx[nb][ks] = *(const bf16x8*)((const bf16_t*)(ws + WS_WXT) + blk * 4096 + (16 * nb + l15) * 64 + 32 * ks + 8 * g);
#pragma unroll
    for (int nb = 0; nb < 4; ++nb) { bia[nb] = -1.4426950408889634f * a.in[5][layer * 1024 + blk * 64 + 16 * nb + l15]; bix[nb] = -1.4426950408889634f * a.in[7][layer * 1024 + blk * 64 + 16 * nb + l15]; }
    if (tid < 24) *(LAS u32x4*)(lxs + tid * 8) = (u32x4){0u, 0u, 0u, 0u};
    u32x4 plx[2], plg[2];
#pragma unroll
    for (int i = 0; i < 2; ++i) { const int idx = tid + 512 * i, row = idx >> 3, c8 = idx & 7; plx[i] = *(const u32x4*)(proj + pjo(brow + row, OFF_LX + blk * 64 + c8 * 8)); plg[i] = *(const u32x4*)(proj + pjo(brow + row, OFF_LG + blk * 64 + c8 * 8)); }
    float hcarry = 0.0f;
#pragma unroll 1
    for (int c = 0; c < 32; ++c) {
        LAS bf16_t* lgs = lgs0 + (c & 1) * 8192;
#pragma unroll
        for (int i = 0; i < 2; ++i) { const int idx = tid + 512 * i, row = idx >> 3, c8 = idx & 7; *(LAS u32x4*)(lxs + (3 + row) * 64 + c8 * 8) = plx[i]; *(LAS u32x4*)(lgs + row * 64 + c8 * 8) = plg[i]; }
        __syncthreads();
        if (c + 1 < 32) {
#pragma unroll
            for (int i = 0; i < 2; ++i) { const int idx = tid + 512 * i, row = idx >> 3, c8 = idx & 7; const size_t gr = brow + (size_t)((c + 1) * 128 + row); plx[i] = *(const u32x4*)(proj + pjo(gr, OFF_LX + blk * 64 + c8 * 8)); plg[i] = *(const u32x4*)(proj + pjo(gr, OFF_LG + blk * 64 + c8 * 8)); }
        }
        {
            const int t0 = (tid >> 6) * 16;
            float x0 = bf2f(lxs[t0 * 64 + cch_]), x1 = bf2f(lxs[(t0 + 1) * 64 + cch_]), x2 = bf2f(lxs[(t0 + 2) * 64 + cch_]);
#pragma unroll
            for (int i = 0; i < 16; ++i) {
                const float x3 = bf2f(lxs[(t0 + i + 3) * 64 + cch_]);
                const float xc = cb + cw0 * x0 + cw1 * x1 + cw2 * x2 + cw3 * x3;
                *(LAS bf16_t*)(xcb + (t0 + i) * 144 + cch_ * 2) = f2bf(xc);
                x0 = x1; x1 = x2; x2 = x3;
            }
        }
        __syncthreads();
        if (tid < 24) *(LAS u32x4*)(lxs + tid * 8) = *(const LAS u32x4*)(lxs + 128 * 64 + tid * 8);
        {
            const bf16x8 af0 = *(const LAS bf16x8*)(xcb + (16 * w + l15) * 144 + (8 * g) * 2), af1 = *(const LAS bf16x8*)(xcb + (16 * w + l15) * 144 + (32 + 8 * g) * 2);
#pragma unroll
            for (int nb = 0; nb < 4; ++nb) {
                f32x4 ar = {0.f, 0.f, 0.f, 0.f}, ax = {0.f, 0.f, 0.f, 0.f};
                const LAS unsigned char* wr_ = wlds + (16 * nb + l15) * 144 + 16 * g;
                ar = mfma16(af0, *(const LAS bf16x8*)(wr_), ar); ar = mfma16(af1, *(const LAS bf16x8*)(wr_ + 64), ar);
                ax = mfma16(af0, wfx[nb][0], ax); ax = mfma16(af1, wfx[nb][1], ax);
#pragma unroll
                for (int rg = 0; rg < 4; ++rg) { rgt[(16 * w + 4 * g + rg) * 64 + 16 * nb + l15] = __builtin_amdgcn_rcpf(1.0f + __builtin_amdgcn_exp2f(ar[rg] + bia[nb])); igt[(16 * w + 4 * g + rg) * 64 + 16 * nb + l15] = __builtin_amdgcn_rcpf(1.0f + __builtin_amdgcn_exp2f(ax[rg] + bix[nb])); }
            }
        }
        __syncthreads();
        float av[16], bv[16]; float Aw = 1.0f, Hw = 0.0f;
#pragma unroll
        for (int tt = 0; tt < 16; ++tt) {
            const int t = 16 * w + tt;
            const float aa = __builtin_amdgcn_exp2f(cc * rgt[t * 64 + lane]);
            const float bb = __builtin_amdgcn_sqrtf(fmaxf(1.0f - aa * aa, 0.0f)) * igt[t * 64 + lane] * bf2f(*(const LAS bf16_t*)(xcb + t * 144 + lane * 2));
            av[tt] = aa; bv[tt] = bb; Hw = aa * Hw + bb; Aw *= aa;
        }
        wst[w * 64 + lane] = Aw; wst[512 + w * 64 + lane] = Hw;
        __syncthreads();
        float hcur = hcarry, hend = hcarry;
#pragma unroll
        for (int ww = 0; ww < 8; ++ww) { const float A_ = wst[ww * 64 + lane], H_ = wst[512 + ww * 64 + lane]; hend = A_ * hend + H_; if (ww < w) hcur = hend; }
        hcarry = hend;
        bf16_t* yb = (bf16_t*)(ws + WS_YA) + ((size_t)b * SEQ + c * 128 + 16 * w) * YLD + 512 + gc;
#pragma unroll
        for (int tt = 0; tt < 16; tt += 2) {
            const float h0 = av[tt] * hcur + bv[tt]; hcur = av[tt + 1] * h0 + bv[tt + 1];
            yb[(size_t)tt * YLD] = f2bf(h0 * bf2f(lgs[(16 * w + tt) * 64 + lane])); yb[(size_t)(tt + 1) * YLD] = f2bf(hcur * bf2f(lgs[(16 * w + tt + 1) * 64 + lane]));
        }
    }
    __syncthreads();
}

DI void retscan_unit(const Args& a, int unit) {
    unsigned char* ws = a.ws;
    const int e8 = unit * 512 + mk_tid();
    const int bh = e8 >> 13, within = e8 & 8191, h = bh & 3;
    const float g128 = exp2f(128.0f * log2gamma(h));
    bf16_t* base = (bf16_t*)(ws + WS_KVB) + (size_t)bh * 32 * 65536 + (size_t)within * 8;
    float st[8];
#pragma unroll
    for (int q = 0; q < 8; ++q) st[q] = 0.f;
#pragma unroll 1
    for (int c0 = 0; c0 < 32; c0 += 8) {
        u32x4 kv[8];
#pragma unroll
        for (int q = 0; q < 8; ++q) kv[q] = *(const u32x4*)(base + (size_t)(c0 + q) * 65536);
#pragma unroll
        for (int q = 0; q < 8; ++q) {
            u32x4 o;
#pragma unroll
            for (int j = 0; j < 4; ++j) o[j] = pk2(st[2 * j], st[2 * j + 1]);
            *(u32x4*)(base + (size_t)(c0 + q) * 65536) = o;
#pragma unroll
            for (int j = 0; j < 4; ++j) { st[2 * j] = g128 * st[2 * j] + bflo(kv[q][j]); st[2 * j + 1] = g128 * st[2 * j + 1] + bfhi(kv[q][j]); }
        }
    }
}

DI void attmerge_unit(const Args& a, int unit) {
    unsigned char* ws = a.ws;
    const int idx = unit * 512 + mk_tid(), t = idx >> 6, hp = (idx >> 4) & 3, dc = idx & 15;
    const float* lse = (const float*)(ws + WS_LSE) + (size_t)t * 12;
    const float l0 = lse[hp], l1 = lse[4 + hp], l2 = lse[8 + hp];
    const float m = fmaxf(l0, fmaxf(l1, l2));
    float w0 = __builtin_amdgcn_exp2f(l0 - m), w1 = __builtin_amdgcn_exp2f(l1 - m), w2 = __builtin_amdgcn_exp2f(l2 - m);
    const float is = 1.0f / (w0 + w1 + w2); w0 *= is; w1 *= is; w2 *= is;
    const bf16_t* o = (const bf16_t*)(ws + WS_OATT) + (size_t)t * 1536 + hp * 128 + dc * 8;
    const u32x4 a0 = *(const u32x4*)o, a1 = *(const u32x4*)(o + 512), a2 = *(const u32x4*)(o + 1024);
    u32x4 r;
#pragma unroll
    for (int q = 0; q < 4; ++q) r[q] = pk2(w0 * bflo(a0[q]) + w1 * bflo(a1[q]) + w2 * bflo(a2[q]), w0 * bfhi(a0[q]) + w1 * bfhi(a1[q]) + w2 * bfhi(a2[q]));
    *(u32x4*)((bf16_t*)(ws + WS_YA) + (size_t)t * YLD + hp * 128 + dc * 8) = r;
}

DI void retout_unit(const Args& a, int unit, LAS unsigned char* lds) {
    unsigned char* ws = a.ws;
    const int tid = mk_tid(), lane = tid & 63, w = __builtin_amdgcn_readfirstlane(tid >> 6), g = lane >> 4, l15 = lane & 15, tq4 = l15 >> 2, tp4 = l15 & 3;
    const int b = unit >> 7, h = (unit >> 5) & 3, c = unit & 31;
    const bf16_t* proj = (const bf16_t*)(ws + WS_PROJ); const size_t brow = (size_t)b * SEQ + c * 128;
    const bf16_t* rt = (const bf16_t*)(ws + WS_KVB) + ((size_t)((b * 4 + h) * 32 + c)) * 65536;
    LAS unsigned char* RA = lds; LAS unsigned char* RB = lds + 128 * 544;
    const float l2g = log2gamma(h);
    const int qi = 16 * w + l15;
    bf16x8 qf[8];
#pragma unroll
    for (int ks = 0; ks < 8; ++ks) qf[ks] = *(const bf16x8*)(proj + pjo(brow + qi, OFF_RQ + h * 256 + 32 * ks + 8 * g));
#pragma unroll
    for (int i = 0; i < 8; ++i) {
        const int idx = tid + 512 * i, row = idx >> 5, ch = idx & 31;
        *(LAS u32x4*)(RA + row * 544 + ch * 16) = *(const u32x4*)(proj + pjo(brow + row, OFF_RK + h * 256 + ch * 8));
        *(LAS u32x4*)(RB + row * 544 + ch * 16) = *(const u32x4*)(rt + (size_t)row * 256 + ch * 8);
    }
    __syncthreads();
    u32x4 pv[8], pr[8];
#pragma unroll
    for (int i = 0; i < 8; ++i) {
        const int idx = tid + 512 * i, row = idx >> 5, ch = idx & 31;
        pv[i] = *(const u32x4*)(proj + pjo(brow + row, OFF_RV + h * 256 + ch * 8));
        pr[i] = *(const u32x4*)(rt + (size_t)(128 + row) * 256 + ch * 8);
    }
    f32x4 sacc[8], oacc[16];
#pragma unroll
    for (int jj = 0; jj < 8; ++jj) {
        f32x4 acc = {0.f, 0.f, 0.f, 0.f};
        if (jj <= w) {
#pragma unroll
            for (int ks = 0; ks < 8; ++ks) { const bf16x8 kf = *(const LAS bf16x8*)(RA + (16 * jj + l15) * 544 + (32 * ks + 8 * g) * 2); acc = mfma16(kf, qf[ks], acc); }
        }
        sacc[jj] = acc;
    }
#pragma unroll
    for (int db = 0; db < 8; ++db) {
        f32x4 acc = {0.f, 0.f, 0.f, 0.f};
#pragma unroll
        for (int ks = 0; ks < 8; ++ks) { const bf16x8 rf = *(const LAS bf16x8*)(RB + (16 * db + l15) * 544 + (32 * ks + 8 * g) * 2); acc = mfma16(rf, qf[ks], acc); }
        oacc[db] = acc;
    }
    __syncthreads();
#pragma unroll
    for (int i = 0; i < 8; ++i) {
        const int idx = tid + 512 * i, row = idx >> 5, ch = idx & 31;
        *(LAS u32x4*)(RA + row * 544 + ch * 16) = pv[i];
        *(LAS u32x4*)(RB + row * 544 + ch * 16) = pr[i];
    }
    __syncthreads();
#pragma unroll
    for (int db = 0; db < 8; ++db) {
        f32x4 acc = {0.f, 0.f, 0.f, 0.f};
#pragma unroll
        for (int ks = 0; ks < 8; ++ks) { const bf16x8 rf = *(const LAS bf16x8*)(RB + (16 * db + l15) * 544 + (32 * ks + 8 * g) * 2); acc = mfma16(rf, qf[ks], acc); }
        oacc[8 + db] = acc;
    }
    const float xi = __builtin_amdgcn_exp2f((float)(qi + 1) * l2g);
#pragma unroll
    for (int db = 0; db < 16; ++db) oacc[db] = oacc[db] * xi;
#pragma unroll
    for (int jj = 0; jj < 8; ++jj)
#pragma unroll
        for (int rg = 0; rg < 4; ++rg) { const int j = 16 * jj + 4 * g + rg; sacc[jj][rg] = (qi >= j) ? sacc[jj][rg] * __builtin_amdgcn_exp2f((float)(qi - j) * l2g) : 0.f; }
#pragma unroll
    for (int s = 0; s < 4; ++s) {
        if (2 * s <= w) {
            u32x4 pw; pw.x = pk2(sacc[2 * s][0], sacc[2 * s][1]); pw.y = pk2(sacc[2 * s][2], sacc[2 * s][3]); pw.z = pk2(sacc[2 * s + 1][0], sacc[2 * s + 1][1]); pw.w = pk2(sacc[2 * s + 1][2], sacc[2 * s + 1][3]);
            const bf16x8 pb = __builtin_bit_cast(bf16x8, pw);
            const int k0 = 32 * s + 4 * g + tq4;
#pragma unroll
            for (int db = 0; db < 16; ++db) {
                const s16x4 lo = trrd(RA + k0 * 544 + (16 * db + 4 * tp4) * 2), hi = trrd(RA + (k0 + 16) * 544 + (16 * db + 4 * tp4) * 2);
                oacc[db] = mfma16(cat8(lo, hi), pb, oacc[db]);
            }
        }
    }
    float s1 = 0.f;
#pragma unroll
    for (int db = 0; db < 16; ++db) s1 += (oacc[db][0] + oacc[db][1]) + (oacc[db][2] + oacc[db][3]);
    s1 += __shfl_xor(s1, 16); s1 += __shfl_xor(s1, 32);
    const float mean = s1 * (1.0f / 256.0f);
    float s2 = 0.f;
#pragma unroll
    for (int db = 0; db < 16; ++db)
#pragma unroll
        for (int rg = 0; rg < 4; ++rg) { const float dd = oacc[db][rg] - mean; s2 += dd * dd; }
    s2 += __shfl_xor(s2, 16); s2 += __shfl_xor(s2, 32);
    const float rstd = rsqrtf(s2 * (1.0f / 256.0f) + LN_EPS);
    __syncthreads();
#pragma unroll
    for (int db = 0; db < 16; ++db) {
        u32x2 o; o.x = pk2((oacc[db][0] - mean) * rstd, (oacc[db][1] - mean) * rstd); o.y = pk2((oacc[db][2] - mean) * rstd, (oacc[db][3] - mean) * rstd);
        *(LAS u32x2*)(RA + qi * 528 + (16 * db + 4 * g) * 2) = o;
    }
    __syncthreads();
#pragma unroll
    for (int i = 0; i < 8; ++i) {
        const int idx = tid + 512 * i, row = idx >> 5, ch = idx & 31;
        const u32x4 nv = *(const LAS u32x4*)(RA + row * 528 + ch * 16);
        const u32x4 gw = *(const u32x4*)(proj + pjo(brow + row, OFF_RG + h * 256 + ch * 8));
        u32x4 o;
#pragma unroll
        for (int q = 0; q < 4; ++q) { const float g0 = bflo(gw[q]), g1 = bfhi(gw[q]); o[q] = pk2(g0 * sigm(g0) * bflo(nv[q]), g1 * sigm(g1) * bfhi(nv[q])); }
        *(u32x4*)((bf16_t*)(ws + WS_YA) + ((size_t)b * SEQ + c * 128 + row) * YLD + 1536 + h * 256 + ch * 8) = o;
    }
    __syncthreads();
}

struct EpiBranch {
    static constexpr bool PERM = false, AFTER_DRAIN = false, SEGMENTED = true;
    const bf16_t* gate; bf16_t* mb; int t1, t2;
    __device__ __forceinline__ void rescale(f32x4 (&acc)[2][2][4][2], const pg8::Unit& u, int seg) const {
        const int tid = mk_tid(), wid = tid >> 6, lane = tid & 63, wr = wid >> 2, wc = wid & 3, fr = lane & 15, fq = lane >> 4;
        const int row0 = u.pm * 256 + wr * 64 + fr, col0 = u.pn * 256 + wc * 32 + 4 * fq;
        const int gp = OFF_GA + 1024 * seg, gn = gp + 1024;
#pragma unroll
        for (int ai = 0; ai < 2; ++ai) {
            u32x2 wp[4][2][2], wn[4][2][2];
#pragma unroll
            for (int m = 0; m < 4; ++m) { const size_t row = (size_t)(row0 + ai * 128 + m * 16);
#pragma unroll
                for (int bj = 0; bj < 2; ++bj)
#pragma unroll
                    for (int n = 0; n < 2; ++n) { const int col = col0 + bj * 128 + n * 16;
                        wp[m][bj][n] = *(const u32x2*)(gate + pjo(row, gp + col)); wn[m][bj][n] = *(const u32x2*)(gate + pjo(row, gn + col)); } }
#pragma unroll
            for (int m = 0; m < 4; ++m)
#pragma unroll
                for (int bj = 0; bj < 2; ++bj)
#pragma unroll
                    for (int n = 0; n < 2; ++n) { const u32x2 p2 = wp[m][bj][n], n2 = wn[m][bj][n];
                        f32x4 v = acc[ai][bj][m][n];
                        v[0] *= (1.f + ex(bflo(n2.x))) * __builtin_amdgcn_rcpf(1.f + ex(bflo(p2.x))); v[1] *= (1.f + ex(bfhi(n2.x))) * __builtin_amdgcn_rcpf(1.f + ex(bfhi(p2.x)));
                        v[2] *= (1.f + ex(bflo(n2.y))) * __builtin_amdgcn_rcpf(1.f + ex(bflo(p2.y))); v[3] *= (1.f + ex(bfhi(n2.y))) * __builtin_amdgcn_rcpf(1.f + ex(bfhi(p2.y)));
                        acc[ai][bj][m][n] = v; }
        }
    }
    static __device__ __forceinline__ float ex(float x) { return __builtin_amdgcn_exp2f(x * -1.4426950408889634f); }
    __device__ __forceinline__ void operator()(const f32x4 (&acc)[2][2][4][2], const pg8::Unit& u, int wr, int wc, int fr, int fq) const {
        const int row0 = u.pm * 256 + wr * 64 + fr, col0 = u.pn * 256 + wc * 32 + 4 * fq;
        const int gcol = OFF_GA + 2048;
#pragma unroll
        for (int ai = 0; ai < 2; ++ai) {
            u32x2 gw[4][2][2];
#pragma unroll
            for (int m = 0; m < 4; ++m) { const size_t row = (size_t)(row0 + ai * 128 + m * 16);
#pragma unroll
                for (int bj = 0; bj < 2; ++bj)
#pragma unroll
                    for (int n = 0; n < 2; ++n) gw[m][bj][n] = *(const u32x2*)(gate + pjo(row, gcol + col0 + bj * 128 + n * 16)); }
#pragma unroll
            for (int m = 0; m < 4; ++m) { const size_t row = (size_t)(row0 + ai * 128 + m * 16);
#pragma unroll
                for (int bj = 0; bj < 2; ++bj)
#pragma unroll
                    for (int n = 0; n < 2; ++n) { const int col = col0 + bj * 128 + n * 16;
                        const u32x2 g2 = gw[m][bj][n];
                        f32x4 v = acc[ai][bj][m][n];
                        v[0] *= sigm(bflo(g2.x)); v[1] *= sigm(bfhi(g2.x)); v[2] *= sigm(bflo(g2.y)); v[3] *= sigm(bfhi(g2.y));
                        u32x2 o; o.x = pk2(v[0], v[1]); o.y = pk2(v[2], v[3]); *(u32x2*)(mb + row * 1024 + col) = o; } }
        }
    }
};
#ifndef MK_EPI_AUX
#define MK_EPI_AUX 0
#endif
struct EpiInProj {
    static constexpr bool PERM = true, AFTER_DRAIN = false;
    bf16_t* O;
    __device__ __forceinline__ void operator()(const f32x4 (&acc)[2][2][4][2], const pg8::Unit& u, int wr_, int wc_, int fr_, int fq_) const {
        (void)wr_; (void)wc_; (void)fr_; (void)fq_;
        const int tid = mk_tid(), wid = tid >> 6, lane = tid & 63, wr = wid >> 2, wc = wid & 3, fr = lane & 15, fq = lane >> 4;
        const __amdgpu_buffer_rsrc_t rsrc = __builtin_amdgcn_make_buffer_rsrc((void*)O, 0, (int)((size_t)NTOK * DIN * 2), 0x00020000);
        const int row0 = u.pm * 256 + wr * 64 + fr;
        const int pn = u.pn;
        const bool ropeA = pn < 12, ropeR = (pn >= 26 && pn < 34);
        const float dsc = 1.0f / (X8_SCALE * W8_SCALE);
        if (!(ropeA || ropeR)) {
            const int col0 = pn * 256 + 64 * wc + 8 * fq;
            const bool isLG = (pn >= 22 && pn < 26);
#pragma unroll
            for (int ai = 0; ai < 2; ++ai) {
#pragma unroll
                for (int m = 0; m < 4; ++m) { const unsigned roff = (unsigned)(pjo((size_t)(row0 + ai * 128 + m * 16), col0) * 2);
#pragma unroll
                    for (int bj = 0; bj < 2; ++bj) { f32x4 v0 = acc[ai][bj][m][0] * dsc, v1 = acc[ai][bj][m][1] * dsc;
                        if (isLG) { const pg8::f32x2 g0 = pg8::gelu_pk((pg8::f32x2){v0[0], v0[1]}), g1 = pg8::gelu_pk((pg8::f32x2){v0[2], v0[3]}), g2 = pg8::gelu_pk((pg8::f32x2){v1[0], v1[1]}), g3 = pg8::gelu_pk((pg8::f32x2){v1[2], v1[3]});
                            v0 = (f32x4){g0.x, g0.y, g1.x, g1.y}; v1 = (f32x4){g2.x, g2.y, g3.x, g3.y}; }
                        u32x4 w; w.x = pk2(v0[0], v0[1]); w.y = pk2(v0[2], v0[3]); w.z = pk2(v1[0], v1[1]); w.w = pk2(v1[2], v1[3]);
                        __builtin_amdgcn_raw_buffer_store_b128(w, rsrc, (int)(roff + bj * 64), 0, MK_EPI_AUX); } }
            }
        } else {
            const int half = ropeA ? 64 : 128;
            const float sc = dsc * ((pn >= 30 && pn < 34) ? 0.0625f : 1.0f);
            const float kf = ropeA ? (-13.287712379549449f / 64.0f) : (-13.287712379549449f / 128.0f);
            const float pos0 = (float)(row0 & (SEQ - 1));
            const int j0 = ropeA ? (32 * (wc & 1) + 8 * fq) : (32 * wc + 8 * fq);
            const int lcol = ropeA ? (128 * (wc >> 1) + j0) : j0;
            float cb[8], sb[8], c16[8], s16[8], cb1[8], sb1[8];
#pragma unroll
            for (int i = 0; i < 8; ++i) {
                const float f = __builtin_amdgcn_exp2f((float)(j0 + i) * kf) * 0.15915494309189535f;
                const float t0 = __builtin_amdgcn_fractf(pos0 * f), t16 = __builtin_amdgcn_fractf(16.0f * f), t128 = __builtin_amdgcn_fractf(128.0f * f);
                cb[i] = __builtin_amdgcn_cosf(t0); sb[i] = __builtin_amdgcn_sinf(t0);
                c16[i] = __builtin_amdgcn_cosf(t16); s16[i] = __builtin_amdgcn_sinf(t16);
                const float c128 = __builtin_amdgcn_cosf(t128), s128 = __builtin_amdgcn_sinf(t128);
                cb1[i] = cb[i] * c128 - sb[i] * s128; sb1[i] = sb[i] * c128 + cb[i] * s128;
            }
#pragma unroll
            for (int ai = 0; ai < 2; ++ai) {
                float cv[8], sv[8];
#pragma unroll
                for (int i = 0; i < 8; ++i) { cv[i] = ai ? cb1[i] : cb[i]; sv[i] = ai ? sb1[i] : sb[i]; }
#pragma unroll
                for (int m = 0; m < 4; ++m) {
                    const int row = row0 + ai * 128 + m * 16;
                    const unsigned roff = (unsigned)(pjo((size_t)row, pn * 256 + lcol) * 2);
                    float o1[8], o2[8];
#pragma unroll
                    for (int i = 0; i < 8; ++i) { const float t1 = acc[ai][0][m][i >> 2][i & 3] * sc, t2 = acc[ai][1][m][i >> 2][i & 3] * sc; o1[i] = t1 * cv[i] - t2 * sv[i]; o2[i] = t1 * sv[i] + t2 * cv[i]; }
                    u32x4 w1, w2;
#pragma unroll
                    for (int q = 0; q < 4; ++q) { w1[q] = pk2(o1[2 * q], o1[2 * q + 1]); w2[q] = pk2(o2[2 * q], o2[2 * q + 1]); }
                    __builtin_amdgcn_raw_buffer_store_b128(w1, rsrc, (int)roff, 0, MK_EPI_AUX);
                    __builtin_amdgcn_raw_buffer_store_b128(w2, rsrc, (int)(roff + half * 2), 0, MK_EPI_AUX);
                    if (m < 3) {
#pragma unroll
                        for (int i = 0; i < 8; ++i) { const float cn = cv[i] * c16[i] - sv[i] * s16[i], sn = sv[i] * c16[i] + cv[i] * s16[i]; cv[i] = cn; sv[i] = sn; } }
                }
            }
        }
    }
};

struct EpiOut {
    static constexpr bool PERM = false, AFTER_DRAIN = false;
    const float* xf; float* z;
    __device__ __forceinline__ void operator()(const f32x4 (&acc)[2][2][4][2], const pg8::Unit& u, int wr, int wc, int fr, int fq) const {
        const int row0 = u.pm * 256 + wr * 64 + fr, col0 = u.pn * 256 + wc * 32 + 4 * fq;
#pragma unroll
        for (int ai = 0; ai < 2; ++ai) {
            f32x4 xv[4][2][2];
#pragma unroll
            for (int m = 0; m < 4; ++m) { const size_t row = (size_t)(row0 + ai * 128 + m * 16);
#pragma unroll
                for (int bj = 0; bj < 2; ++bj)
#pragma unroll
                    for (int n = 0; n < 2; ++n) xv[m][bj][n] = *(const f32x4*)(xf + row * 1024 + col0 + bj * 128 + n * 16); }
#pragma unroll
            for (int m = 0; m < 4; ++m) { const size_t row = (size_t)(row0 + ai * 128 + m * 16);
#pragma unroll
                for (int bj = 0; bj < 2; ++bj)
#pragma unroll
                    for (int n = 0; n < 2; ++n) *(f32x4*)(z + row * 1024 + col0 + bj * 128 + n * 16) = xv[m][bj][n] * ALPHA + acc[ai][bj][m][n]; }
        }
    }
};

DI void ln_row(const float* z, const float* gam, const float* bet, float* of, bf16_t* ob, int lane) {
    f32x4 v[4]; float s = 0.f;
#pragma unroll
    for (int i = 0; i < 4; ++i) { v[i] = *(const f32x4*)(z + 256 * i + 4 * lane); s += (v[i][0] + v[i][1]) + (v[i][2] + v[i][3]); }
    const float mean = wsum(s) * (1.0f / 1024.0f);
    float q = 0.f;
#pragma unroll
    for (int i = 0; i < 4; ++i)
#pragma unroll
        for (int j = 0; j < 4; ++j) { const float d = v[i][j] - mean; q += d * d; }
    const float rstd = rsqrtf(wsum(q) * (1.0f / 1024.0f) + LN_EPS);
#pragma unroll
    for (int i = 0; i < 4; ++i) {
        const f32x4 gg = *(const f32x4*)(gam + 256 * i + 4 * lane), bb = *(const f32x4*)(bet + 256 * i + 4 * lane);
        f32x4 o;
#pragma unroll
        for (int j = 0; j < 4; ++j) o[j] = (v[i][j] - mean) * rstd * gg[j] + bb[j];
        *(f32x4*)(of + 256 * i + 4 * lane) = o;
        u32x2 pb; pb.x = pk2(o[0], o[1]); pb.y = pk2(o[2], o[3]); *(u32x2*)(ob + 256 * i + 4 * lane) = pb;
    }
}
DI void phase_ln1(const Args& a, int layer) {
    unsigned char* ws = a.ws;
    const int lane = mk_tid() & 63, w = mk_tid() >> 6;
    for (int u = blockIdx.x; u < NTOK / 8; u += gridDim.x) {
        const size_t row = (size_t)u * 8 + w;
        ln_row((const float*)(ws + WS_MRGF) + row * 1024, a.in[11] + layer * 1024, a.in[12] + layer * 1024, (float*)(ws + WS_XF) + row * 1024, (bf16_t*)(ws + WS_XB) + row * 1024, lane);
    }
}

DI void ins16(float (&L)[16], float x) {
#pragma unroll
    for (int k = 0; k < 16; ++k) { const float hi = fmaxf(L[k], x); x = fminf(L[k], x); L[k] = hi; }
}
DI void merge16(float (&L)[16], int xr) {
    float t[16];
#pragma unroll
    for (int k = 0; k < 16; ++k) t[k] = __shfl_xor(L[k], xr);
#pragma unroll
    for (int k = 0; k < 8; ++k) { const float x = t[k]; t[k] = t[15 - k]; t[15 - k] = x; }
#pragma unroll
    for (int k = 0; k < 16; ++k) t[k] = fmaxf(L[k], t[k]);
#define MK_CE_STAGE(dd) _Pragma("unroll") for (int k = 0; k < 16; ++k) if ((k & (dd)) == 0) { const float hi = fmaxf(t[k], t[k + (dd)]), lo = fminf(t[k], t[k + (dd)]); t[k] = hi; t[k + (dd)] = lo; }
    MK_CE_STAGE(8) MK_CE_STAGE(4) MK_CE_STAGE(2) MK_CE_STAGE(1)
#undef MK_CE_STAGE
#pragma unroll
    for (int k = 0; k < 16; ++k) L[k] = t[k];
}
#define MK_CE_DESC(v, i, l) { const float hi_ = fmaxf(v[i], v[l]), lo_ = fminf(v[i], v[l]); v[i] = hi_; v[l] = lo_; }
#define MK_CE_ASC(v, i, l)  { const float hi_ = fmaxf(v[i], v[l]), lo_ = fminf(v[i], v[l]); v[i] = lo_; v[l] = hi_; }
#define MK_BITONIC_STAGE(v, kk, jj) _Pragma("unroll") for (int i_ = 0; i_ < 16; ++i_) { if ((i_ & (jj)) == 0) { if ((i_ & (kk)) == 0) MK_CE_DESC(v, i_, i_ + (jj)) else MK_CE_ASC(v, i_, i_ + (jj)) } }
DI void sort16_desc(float (&v)[16]) {
    MK_BITONIC_STAGE(v, 2, 1)
    MK_BITONIC_STAGE(v, 4, 2) MK_BITONIC_STAGE(v, 4, 1)
    MK_BITONIC_STAGE(v, 8, 4) MK_BITONIC_STAGE(v, 8, 2) MK_BITONIC_STAGE(v, 8, 1)
    MK_BITONIC_STAGE(v, 16, 8) MK_BITONIC_STAGE(v, 16, 4) MK_BITONIC_STAGE(v, 16, 2) MK_BITONIC_STAGE(v, 16, 1)
}
DI void top16_of_two(float (&a)[16], const float (&b)[16]) {
#pragma unroll
    for (int k = 0; k < 16; ++k) a[k] = fmaxf(a[k], b[15 - k]);
    MK_BITONIC_STAGE(a, 16, 8) MK_BITONIC_STAGE(a, 16, 4) MK_BITONIC_STAGE(a, 16, 2) MK_BITONIC_STAGE(a, 16, 1)
}
DI void top16_half(const bf16_t* qp, const LAS unsigned char* kt, float (&L)[16], int g, int l15) {
    bf16x8 qf[4];
#pragma unroll
    for (int ks = 0; ks < 4; ++ks) qf[ks] = *(const bf16x8*)(qp + 32 * ks + 8 * g);
    float M[16];
#pragma unroll
    for (int kbk = 0; kbk < 8; ++kbk) {
        f32x4 acc = {0.f, 0.f, 0.f, 0.f};
#pragma unroll
        for (int ks = 0; ks < 4; ++ks) { const bf16x8 kf = *(const LAS bf16x8*)(kt + (16 * kbk + l15) * 256 + (((4 * ks + g) ^ l15) << 4)); acc = mfma16(kf, qf[ks], acc); }
#pragma unroll
        for (int rg = 0; rg < 4; ++rg) { const unsigned key = (unsigned)(16 * kbk + 4 * g + rg); const float x = __uint_as_float((__float_as_uint(acc[rg]) & ~0x7Fu) | key);
            if (kbk < 4) L[4 * kbk + rg] = x; else M[4 * (kbk - 4) + rg] = x; }
    }
    sort16_desc(L); sort16_desc(M); top16_of_two(L, M);
    merge16(L, 16); merge16(L, 32);
}
DI void topk_unit(const Args& a, int unit, LAS unsigned char* lds) {
    unsigned char* ws = a.ws;
    const int tid = mk_tid(), lane = tid & 63, w = __builtin_amdgcn_readfirstlane(tid >> 6), g = lane >> 4, l15 = lane & 15;
    const int tg = w & 3, hs = w >> 2;
    const size_t t = (size_t)unit * 64 + tg * 16 + l15;
    const bf16_t* Q = (const bf16_t*)(ws + WS_Q);
    LAS unsigned char* tiles = lds + 16384;
    float K1[16], K2[16];
#pragma unroll
    for (int k = 0; k < 16; ++k) { K1[k] = 0.f; K2[k] = 0.f; }
#pragma unroll 1
    for (int hh = 0; hh < 4; ++hh) {
#pragma unroll
        for (int i = 0; i < 16; ++i) {
            const int idx = tid + 512 * i, tile = idx >> 11, row = (idx >> 4) & 127, ch = idx & 15;
            const int hd = ((tile >> 1) ? 4 : 0) + hh;
            const bf16_t* src = (const bf16_t*)(ws + ((tile & 1) ? WS_K2B : WS_K1B)) + ((size_t)hd * 128 + row) * 128 + ch * 8;
            *(LAS u32x4*)(tiles + tile * 32768 + row * 256 + ((ch ^ (row & 15)) << 4)) = *(const u32x4*)src;
        }
        __syncthreads();
        const int h = hs * 4 + hh;
        float l1[16], l2[16];
        top16_half(Q + t * 2048 + h * 256, tiles + (hs * 2) * 32768, l1, g, l15);
        top16_half(Q + t * 2048 + h * 256 + 128, tiles + (hs * 2 + 1) * 32768, l2, g, l15);
        const bool mine = (g == hh);
#pragma unroll
        for (int k = 0; k < 16; ++k) { K1[k] = mine ? l1[k] : K1[k]; K2[k] = mine ? l2[k] : K2[k]; }
        __syncthreads();
    }
    const int h = hs * 4 + g;
    float F[16];
#pragma unroll
    for (int k = 0; k < 16; ++k) F[k] = -FLT_MAX;
#pragma unroll
    for (int ia = 0; ia < 16; ++ia)
#pragma unroll
        for (int ib = 0; ib < 16 / (ia + 1); ++ib) {
            const float s = __uint_as_float(__float_as_uint(K1[ia]) & ~0x7Fu) + __uint_as_float(__float_as_uint(K2[ib]) & ~0x7Fu);
            ins16(F, __uint_as_float((__float_as_uint(s) & ~0xFFu) | (unsigned)(ia * 16 + ib)));
        }
    LAS unsigned char* row = lds + tid * 32;
#pragma unroll
    for (int k = 0; k < 16; ++k) { row[k] = (unsigned char)(__float_as_uint(K1[k]) & 0x7Fu); row[16 + k] = (unsigned char)(__float_as_uint(K2[k]) & 0x7Fu); }
    float gt[16]; int ei[16]; float gs = 0.f;
    const float cv0 = __uint_as_float(__float_as_uint(F[0]) & ~0xFFu);
#pragma unroll
    for (int k = 0; k < 16; ++k) {
        const unsigned bits = __float_as_uint(F[k]);
        const float cv = __uint_as_float(bits & ~0xFFu);
        gt[k] = __builtin_amdgcn_exp2f((cv - cv0) * 1.4426950408889634f); gs += gt[k];
        const int ia = (int)((bits >> 4) & 15u), ib = (int)(bits & 15u);
        ei[k] = (int)row[ia] * 128 + (int)row[16 + ib];
    }
    const float ig = 1.0f / gs;
    int* ep = (int*)(ws + WS_EID) + (t * 8 + h) * 16; float* gp = (float*)(ws + WS_GATE) + (t * 8 + h) * 16;
#pragma unroll
    for (int q = 0; q < 4; ++q) {
        *(i32x4*)(ep + 4 * q) = (i32x4){ei[4 * q], ei[4 * q + 1], ei[4 * q + 2], ei[4 * q + 3]};
        *(f32x4*)(gp + 4 * q) = (f32x4){gt[4 * q] * ig, gt[4 * q + 1] * ig, gt[4 * q + 2] * ig, gt[4 * q + 3] * ig};
    }
    __syncthreads();
}

typedef float f32x2 __attribute__((ext_vector_type(2)));
typedef __bf16 bf16x32 __attribute__((ext_vector_type(32)));
typedef unsigned u32x16 __attribute__((ext_vector_type(16)));
#define MK_PB_LOAD(RA_, ereg, kb) _Pragma("unroll") for (int j = 0; j < 8; ++j) { const int e_ = __builtin_amdgcn_readlane(ereg, (kb) + j); \
        RA_[j] = ((const u32x4*)(UV + (size_t)(unsigned)e_ * UVREC))[lane]; }
#define MK_U4(w, s) __builtin_bit_cast(unsigned, __builtin_amdgcn_cvt_scalef32_pk_bf16_fp4(w, 1.0f, s))
#define MK_V4(w, s) __builtin_amdgcn_cvt_scalef32_pk_f32_fp4(w, 1.0f, s)
#define MK_PB_COMP(RA_, usreg, gvreg, kb) { \
        float pp_[8]; \
        _Pragma("unroll") for (int j = 0; j < 8; ++j) { \
            float s0_ = 0.f, s1_ = 0.f; \
            s0_ = dot2(MK_U4(RA_[j][0], 0), xpk[0], s0_); s1_ = dot2(MK_U4(RA_[j][0], 1), xpk[1], s1_); s0_ = dot2(MK_U4(RA_[j][0], 2), xpk[2], s0_); s1_ = dot2(MK_U4(RA_[j][0], 3), xpk[3], s1_); \
            s0_ = dot2(MK_U4(RA_[j][1], 0), xpk[4], s0_); s1_ = dot2(MK_U4(RA_[j][1], 1), xpk[5], s1_); s0_ = dot2(MK_U4(RA_[j][1], 2), xpk[6], s0_); s1_ = dot2(MK_U4(RA_[j][1], 3), xpk[7], s1_); \
            pp_[j] = s0_ + s1_; } \
        float q4_[4], r2_[2]; \
        _Pragma("unroll") for (int i = 0; i < 4; ++i) { const float keep_ = hi32 ? pp_[4 + i] : pp_[i], send_ = hi32 ? pp_[i] : pp_[4 + i]; q4_[i] = keep_ + __shfl_xor(send_, 32); } \
        _Pragma("unroll") for (int i = 0; i < 2; ++i) { const float keep_ = hi16 ? q4_[2 + i] : q4_[i], send_ = hi16 ? q4_[i] : q4_[2 + i]; r2_[i] = keep_ + __shfl_xor(send_, 16); } \
        float tot_ = (hi8 ? r2_[1] : r2_[0]) + __shfl_xor(hi8 ? r2_[0] : r2_[1], 8); \
        tot_ += __shfl_xor(tot_, 4); tot_ += __shfl_xor(tot_, 2); tot_ += __shfl_xor(tot_, 1); \
        const float act_ = gelu_as(tot_ * __shfl(usreg, (kb) + jj)) * __shfl(gvreg, (kb) + jj); \
        _Pragma("unroll") for (int j = 0; j < 8; ++j) { \
            const float aj_ = __uint_as_float(__builtin_amdgcn_readlane(__float_as_uint(act_), 32 * (j >> 2) + 16 * ((j >> 1) & 1) + 8 * (j & 1))); const f32x2 a2_ = {aj_, aj_}; \
            y2[0] += a2_ * MK_V4(RA_[j][2], 0); y2[1] += a2_ * MK_V4(RA_[j][2], 1); y2[2] += a2_ * MK_V4(RA_[j][2], 2); y2[3] += a2_ * MK_V4(RA_[j][2], 3); \
            y2[4] += a2_ * MK_V4(RA_[j][3], 0); y2[5] += a2_ * MK_V4(RA_[j][3], 1); y2[6] += a2_ * MK_V4(RA_[j][3], 2); y2[7] += a2_ * MK_V4(RA_[j][3], 3); } }
DI void peer_token(const unsigned char* UV, int e0, int e1, float us0, float us1, float gv0, float gv1, const unsigned (&xpk)[8], f32x2 (&y2)[8], int lane) {
    const bool hi32 = (lane & 32) != 0, hi16 = (lane & 16) != 0, hi8 = (lane & 8) != 0;
    const int jj = ((lane >> 5) & 1) * 4 + ((lane >> 4) & 1) * 2 + ((lane >> 3) & 1);
    u32x4 A0[8], A1[8], A2[8];
#define MK_PB_L(RA_, B_) { const int B__ = (B_); const int er_ = (B__ < 8) ? e0 : e1; MK_PB_LOAD(RA_, er_, 8 * (B__ & 7)) }
#define MK_PB_C(RA_, B_) { const int B__ = (B_); const float ur_ = (B__ < 8) ? us0 : us1, gr_ = (B__ < 8) ? gv0 : gv1; MK_PB_COMP(RA_, ur_, gr_, 8 * (B__ & 7)) }
    MK_PB_L(A0, 0) MK_PB_L(A1, 1)
#pragma unroll 1
    for (int B = 0; B < 15; B += 3) {
        MK_PB_L(A2, B + 2) MK_PB_C(A0, B)
        MK_PB_L(A0, B + 3) MK_PB_C(A1, B + 1)
        if (B + 4 < 16) MK_PB_L(A1, B + 4)
        MK_PB_C(A2, B + 2)
    }
    MK_PB_C(A0, 15)
#undef MK_PB_L
#undef MK_PB_C
}
DI void peer_unit(const Args& a, int layer, int unit) {
    unsigned char* ws = a.ws;
    const int tid = mk_tid(), lane = tid & 63, w = __builtin_amdgcn_readfirstlane(tid >> 6);
    const unsigned char* UV = ws + WS_UV8; const float* SC = (const float*)(ws + WS_UVS);
#pragma unroll 1
    for (int i = 0; i < 8; ++i) {
        const size_t t = (size_t)unit * 64 + w * 8 + i;
        unsigned xpk[8]; f32x2 y2[8];
        int e0, e1; float us0, us1, gv0, gv1;
        {
            const int ln = mk_tid() & 63;
            const bf16_t* xbp = (const bf16_t*)(ws + WS_XB) + t * 1024 + 16 * ln;
            const u32x4 xa = *(const u32x4*)xbp, xb = *(const u32x4*)(xbp + 8);
#pragma unroll
            for (int q = 0; q < 4; ++q) { xpk[q] = xa[q]; xpk[4 + q] = xb[q]; }
            const int* ep = (const int*)(ws + WS_EID) + t * 128; const float* gp = (const float*)(ws + WS_GATE) + t * 128;
            e0 = ep[ln]; e1 = ep[64 + ln]; const float g0 = gp[ln], g1 = gp[64 + ln];
            const f32x2 s0 = *(const f32x2*)(SC + 2 * e0), s1 = *(const f32x2*)(SC + 2 * e1);
            us0 = s0.x; us1 = s1.x; gv0 = g0 * s0.y; gv1 = g1 * s1.y;
        }
#pragma unroll
        for (int q = 0; q < 8; ++q) y2[q] = (f32x2){0.f, 0.f};
        peer_token(UV, e0, e1, us0, us1, gv0, gv1, xpk, y2, lane);
        {
            const int ln = mk_tid() & 63;
            float* xfp = (float*)(ws + WS_XF) + t * 1024 + 16 * ln;
            const float* gam = a.in[18] + layer * 1024 + 16 * ln; const float* bet = a.in[19] + layer * 1024 + 16 * ln;
            float z[16]; float s = 0.f;
#pragma unroll
            for (int q = 0; q < 4; ++q) { const f32x4 xr = *(const f32x4*)(xfp + 4 * q);
#pragma unroll
                for (int j = 0; j < 4; ++j) { z[4 * q + j] = ALPHA * xr[j] + y2[2 * q + (j >> 1)][j & 1]; s += z[4 * q + j]; } }
            const float mean = wsum(s) * (1.0f / 1024.0f);
            float qq = 0.f;
#pragma unroll
            for (int q = 0; q < 16; ++q) { const float d = z[q] - mean; qq += d * d; }
            const float rstd = rsqrtf(wsum(qq) * (1.0f / 1024.0f) + LN_EPS);
            f32x4 o[4];
#pragma unroll
            for (int q = 0; q < 4; ++q) { const f32x4 gq = *(const f32x4*)(gam + 4 * q), bq = *(const f32x4*)(bet + 4 * q);
#pragma unroll
                for (int j = 0; j < 4; ++j) o[q][j] = (z[4 * q + j] - mean) * rstd * gq[j] + bq[j]; }
#pragma unroll
            for (int q = 0; q < 4; ++q) *(f32x4*)(xfp + 4 * q) = o[q];
            if (layer == DEPTH - 1) { float* op = a.out + t * 1024 + 16 * ln;
#pragma unroll
                for (int q = 0; q < 4; ++q) *(f32x4*)(op + 4 * q) = o[q]; }
            row_to_fp8(o, ws + WS_X8 + t * 1024, ln);
        }
    }
}
}

namespace mk {
constexpr int LDS_ARG_OFF = LDS_BYTES - 16 - 256;
#define MK_NOINL __device__ __forceinline__
DI unsigned long long rfl64(unsigned long long v) { const unsigned lo = __builtin_amdgcn_readfirstlane((unsigned)v), hi = __builtin_amdgcn_readfirstlane((unsigned)(v >> 32)); return ((unsigned long long)hi << 32) | lo; }
DI Args load_args(LAS unsigned char* lds) {
    int aoff = LDS_ARG_OFF; asm volatile("" : "+s"(aoff));
    Args a; const LAS unsigned long long* p = (const LAS unsigned long long*)(lds + aoff);
#pragma unroll
    for (int i = 0; i < 20; ++i) a.in[i] = (const float*)(const __attribute__((address_space(1))) float*)rfl64(p[i]);
    a.out = (float*)(__attribute__((address_space(1))) float*)rfl64(p[20]); a.ws = (unsigned char*)(__attribute__((address_space(1))) unsigned char*)rfl64(p[21]);
    a.ropeA = __longlong_as_double((long long)rfl64(p[22])); a.ropeR = __longlong_as_double((long long)rfl64(p[23])); a.ph_lo = 0; a.ph_hi = 0;
    return a;
}
#define MK_LOADARGS const Args a = load_args(lds); unsigned char* ws = a.ws; const int G = (int)gridDim.x, bid = (int)blockIdx.x; (void)ws; (void)G; (void)bid
MK_NOINL void PG_prologue(LAS unsigned char* lds) { MK_LOADARGS; phase_prologue(a); }
MK_NOINL void P0_conv(LAS unsigned char* lds, int layer) { MK_LOADARGS; phase_conv(a, layer, lds); }
#ifndef MK_STAGGER_TICKS
#define MK_STAGGER_TICKS 140
#endif
MK_NOINL void P1_inproj(LAS unsigned char* lds, int layer) { MK_LOADARGS; (void)layer;
    pg8::Gemm gm; gm.A = (const bf16_t*)(ws + WS_X8); gm.Bt = (const bf16_t*)(ws + WS_WINT); gm.M = NTOK; gm.N = DIN; gm.K = 512;
    pg8::StaticOrder S; S.init(NTOK, DIN, G, bid);
    EpiInProj E; E.O = (bf16_t*)(ws + WS_PROJ);
    pg8::gemm_phase<EpiInProj, pg8::StaticOrder, false, true, true>(lds, gm, S, E, nullptr); }
#ifndef MK_NLRU
#define MK_NLRU 64
#endif
MK_NOINL void P3s_lru(LAS unsigned char* lds, int layer) { MK_LOADARGS; if (bid < MK_NLRU) { for (int s = bid; s < 64; s += MK_NLRU) lru_stripe(a, layer, s, lds); } }
MK_NOINL void P3a_attn(LAS unsigned char* lds, int layer) { MK_LOADARGS; (void)layer; if (bid >= MK_NLRU) { for (int u = bid - MK_NLRU; u < 1536; u += G - MK_NLRU) attn_unit(a, u, lds); } }
MK_NOINL void P3b_retkv(LAS unsigned char* lds, int layer) { MK_LOADARGS; (void)layer; if (bid >= MK_NLRU) { for (int u = bid - MK_NLRU; u < 512; u += G - MK_NLRU) retkv_unit(a, u, lds); } }
MK_NOINL void P4a_scan(LAS unsigned char* lds, int layer) { MK_LOADARGS; (void)layer; for (int u = bid; u < 256; u += G) retscan_unit(a, u); }
MK_NOINL void P4c_merge(LAS unsigned char* lds, int layer) { MK_LOADARGS; (void)layer; for (int u = bid; u < 2048; u += G) attmerge_unit(a, u); }
MK_NOINL void P5_retout(LAS unsigned char* lds, int layer) { MK_LOADARGS; (void)layer; for (int u = bid; u < 512; u += G) retout_unit(a, u, lds); }
MK_NOINL void P6_branch(LAS unsigned char* lds, int layer) { MK_LOADARGS; (void)layer;
    pg8::Gemm gm; gm.A = (const bf16_t*)(ws + WS_YA); gm.Bt = (const bf16_t*)(ws + WS_WBAT); gm.M = NTOK; gm.N = 1024; gm.K = YLD;
    pg8::StaticOrder S; S.init(NTOK, 1024, G, bid);
    EpiBranch E; E.gate = (const bf16_t*)(ws + WS_PROJ); E.mb = (bf16_t*)(ws + WS_MRGB); E.t1 = 512 / 64; E.t2 = 1536 / 64;
    pg8::gemm_phase<EpiBranch, pg8::StaticOrder, false>(lds, gm, S, E, nullptr); }
MK_NOINL void P7_outproj(LAS unsigned char* lds, int layer) { MK_LOADARGS; (void)layer;
    pg8::Gemm gm; gm.A = (const bf16_t*)(ws + WS_MRGB); gm.Bt = (const bf16_t*)(ws + WS_WOT); gm.M = NTOK; gm.N = 1024; gm.K = 1024;
    pg8::StaticOrder S; S.init(NTOK, 1024, G, bid);
    EpiOut E; E.xf = (const float*)(ws + WS_XF); E.z = (float*)(ws + WS_MRGF);
    pg8::gemm_phase<EpiOut, pg8::StaticOrder, false>(lds, gm, S, E, nullptr); }
MK_NOINL void P8_ln1(LAS unsigned char* lds, int layer) { MK_LOADARGS; phase_ln1(a, layer); }
MK_NOINL void P9_wq(LAS unsigned char* lds, int layer) { MK_LOADARGS; (void)layer;
    pg8::Gemm gm; gm.A = (const bf16_t*)(ws + WS_XB); gm.Bt = (const bf16_t*)(ws + WS_WQT); gm.M = NTOK; gm.N = 2048; gm.K = 1024;
    pg8::StaticOrder S; S.init(NTOK, 2048, G, bid);
    pg8::EpiBf16<0> E; E.O = (bf16_t*)(ws + WS_Q); E.ldc = 2048; E.bias = nullptr; E.split_cols = 0; E.split_stride = 0;
    pg8::gemm_phase<pg8::EpiBf16<0>, pg8::StaticOrder, false>(lds, gm, S, E, nullptr); }
MK_NOINL void P10_topk(LAS unsigned char* lds, int layer) { MK_LOADARGS; (void)layer; for (int u = bid; u < NTOK / 64; u += G) topk_unit(a, u, lds); }
MK_NOINL void P11_peer(LAS unsigned char* lds, int layer) { MK_LOADARGS; for (int u = bid; u < NTOK / 64; u += G) peer_unit(a, layer, u); }
DI void mk_sync(LAS unsigned char* lds) {
    const Args a = load_args(lds);
    XcdBarrier b; b.bar = (unsigned*)(a.ws + WS_CTL); b.x = xb_xcc_id(); b.st = (volatile LAS unsigned*)(lds + LDS_BAR_OFF);
    xcd_barrier(b);
}
}

#ifndef MK_PHASE_MASK
#define MK_PHASE_MASK 0xFFFu
#endif
#define MK_RUN(k) ((((MK_PHASE_MASK) >> ((k) - pb)) & 1u) && (k) >= ph_lo && (k) < ph_hi)
#define MK_NPHASES (1 + mk::DEPTH * mk::NPH)

#define MK_SYNC(k) do { if ((k) >= ph_lo && (k) + 1 < ph_hi) mk::mk_sync(lds); } while (0)
__global__ __launch_bounds__(512, 2) void mk_fwd(mk::Args a) {
    using namespace mk;
    extern __shared__ __attribute__((aligned(16))) unsigned char smem_raw[];
    LAS unsigned char* lds = (LAS unsigned char*)smem_raw;
    const int ph_lo = a.ph_lo, ph_hi = a.ph_hi;
    {
        const unsigned* src = (const unsigned*)&a;
        if (threadIdx.x < sizeof(Args) / 4) ((LAS unsigned*)(lds + LDS_ARG_OFF))[threadIdx.x] = src[threadIdx.x];
        if (threadIdx.x == 0) { LAS unsigned* st = (LAS unsigned*)(lds + LDS_BAR_OFF); st[0] = 0u; st[1] = 0u; st[2] = 0u; st[3] = 0u; }
    }
    __syncthreads();
    if (ph_hi - ph_lo > 1) (void)xcd_barrier_post((unsigned*)(a.ws + WS_CTL), (volatile LAS unsigned*)(lds + LDS_BAR_OFF));
    if (0 >= ph_lo && 0 < ph_hi) PG_prologue(lds);
    MK_SYNC(0);
#pragma unroll 1
    for (int layer = 0; layer < DEPTH; ++layer) {
        const int pb = 1 + layer * NPH;
        if (MK_RUN(pb + 0)) P0_conv(lds, layer);
        MK_SYNC(pb + 0);
        if (MK_RUN(pb + 1)) P1_inproj(lds, layer);
        MK_SYNC(pb + 1);
        if (MK_RUN(pb + 3)) { P3s_lru(lds, layer); P3a_attn(lds, layer); P3b_retkv(lds, layer); }
        MK_SYNC(pb + 3);
        if (MK_RUN(pb + 4)) { P4a_scan(lds, layer); P4c_merge(lds, layer); }
        MK_SYNC(pb + 4);
        if (MK_RUN(pb + 5)) P5_retout(lds, layer);
        MK_SYNC(pb + 5);
        if (MK_RUN(pb + 6)) P6_branch(lds, layer);
        MK_SYNC(pb + 6);
        if (MK_RUN(pb + 7)) P7_outproj(lds, layer);
        MK_SYNC(pb + 7);
        if (MK_RUN(pb + 8)) P8_ln1(lds, layer);
        MK_SYNC(pb + 8);
        if (MK_RUN(pb + 9)) P9_wq(lds, layer);
        MK_SYNC(pb + 9);
        if (MK_RUN(pb + 10)) P10_topk(lds, layer);
        if (MK_RUN(pb + 11)) P11_peer(lds, layer);
        MK_SYNC(pb + 11);
    }
}

#ifndef MK_SINGLE
#define MK_SINGLE 1
#endif
extern "C" void kernel_launch(void* const* d_in, const int* in_sizes, int n_in, void* d_out, int out_size, void* d_ws, size_t ws_size, hipStream_t stream) {
    using namespace mk;
    static int grid = 0;
    if (grid == 0) {
        if (n_in != 20 || out_size != NTOK * D || ws_size < WS_END) { fprintf(stderr, "kernel_launch: unexpected shapes (n_in %d, out %d, ws %zu, need %zu)\n", n_in, out_size, ws_size, (size_t)WS_END); grid = -1; return; }
        int dev = 0, cus = 0, per_cu = 0;
        if (hipGetDevice(&dev) != hipSuccess || hipDeviceGetAttribute(&cus, hipDeviceAttributeMultiprocessorCount, dev) != hipSuccess) { grid = -1; return; }
        if (hipFuncSetAttribute((const void*)mk_fwd, hipFuncAttributeMaxDynamicSharedMemorySize, LDS_BYTES) != hipSuccess) { fprintf(stderr, "kernel_launch: hipFuncSetAttribute failed\n"); grid = -1; return; }
        if (hipOccupancyMaxActiveBlocksPerMultiprocessor(&per_cu, (const void*)mk_fwd, 512, LDS_BYTES) != hipSuccess || per_cu < 1) { fprintf(stderr, "kernel_launch: occupancy query says %d blocks per CU\n", per_cu); (void)hipGetLastError(); grid = -1; return; }
        grid = cus;
    }
    if (grid < 0) return;
    (void)in_sizes;
    Args a{};
    for (int i = 0; i < 20; ++i) a.in[i] = (const float*)d_in[i];
    a.out = (float*)d_out; a.ws = (unsigned char*)d_ws;
    a.ropeA = pow(10000.0, -2.0 / 128.0); a.ropeR = pow(10000.0, -2.0 / 256.0);
#if MK_SINGLE
    (void)hipMemsetAsync((unsigned char*)d_ws + WS_CTL, 0, 16384, stream);
    a.ph_lo = 0; a.ph_hi = MK_NPHASES;
    hipLaunchKernelGGL(mk_fwd, dim3(grid), dim3(512), LDS_BYTES, stream, a);
#else
    for (int p = 0; p < MK_NPHASES; ++p) { a.ph_lo = p; a.ph_hi = p + 1; hipLaunchKernelGGL(mk_fwd, dim3(grid), dim3(512), LDS_BYTES, stream, a); }
#endif
}
```
